# Optimizing an MI355X kernel written in HIP

```python
import functools
import jax, jax.numpy as jnp
from jax import lax
import numpy as np

D_MODEL = 1024
BATCH = 2
SEQ = 16384
DEPTH = 4

GRID_W = 64
CTX_LEN = 256
HEAD_DIM = 64
EPS = 1e-6
HG_HEADS = 4
HG_DK = 64
HG_DV = 64
HG_WIDTH = HG_HEADS * HG_DK
HG_CHUNK = 64
SWA_HEADS = 6
SWA_KV_HEADS = 2
SWA_GROUP = SWA_HEADS // SWA_KV_HEADS
SWA_WINDOW = 128
SWA_BLOCK = 128
ROPE_BASE = 10000.0
NAT_HEADS = 6
NAT_ROWS = 8
NAT_COLS = 16
NAT_QCOLS = 16
NAT_SLAB = 32
MIX_WIDTH = HG_WIDTH + SWA_HEADS * HEAD_DIM + NAT_HEADS * HEAD_DIM
PROJ_SPLITS = (HG_WIDTH,) * 5 + (SWA_HEADS * HEAD_DIM, SWA_KV_HEADS * HEAD_DIM, SWA_KV_HEADS * HEAD_DIM) + (NAT_HEADS * HEAD_DIM,) * 3
PROJ_WIDTH = sum(PROJ_SPLITS)
PEER_HEADS = 8
PEER_NKEYS = 128
PEER_EXPERTS = PEER_NKEYS * PEER_NKEYS
PEER_DK = 256
PEER_TOPK = 16
PEER_BLOCK = 128

kernel_name = "hybrid_hgrn2_swa_natten_peer_dit"


def rms_norm(x, w):
    xf = x.astype(jnp.float32)
    y = xf * lax.rsqrt(jnp.mean(xf * xf, axis=-1, keepdims=True) + EPS)
    return (y * w.astype(jnp.float32)).astype(x.dtype)


def modulate(h, shift, scale):
    return h * (1.0 + scale) + shift


def split_proj(p):
    idx = [int(i) for i in np.cumsum(PROJ_SPLITS)[:-1]]
    return jnp.split(p, idx, axis=-1)


def _heads(a, h):
    return a.reshape(a.shape[0], a.shape[1], h, a.shape[-1] // h)


def joint_softmax(scores, sink=None):
    m = functools.reduce(jnp.maximum, [s.max(axis=-1, keepdims=True) for s in scores])
    if sink is not None:
        m = jnp.maximum(m, sink)
    ps = [jnp.exp(s - m) for s in scores]
    den = ps[0].sum(axis=-1, keepdims=True)
    for p in ps[1:]:
        den = den + p.sum(axis=-1, keepdims=True)
    if sink is not None:
        den = den + jnp.exp(sink - m)
    return [p / den for p in ps]


def axial_rope(x, pos_row, pos_col):
    d = x.shape[-1]
    half = d // 2
    nf = half // 2
    inv_freq = ROPE_BASE ** (-jnp.arange(nf, dtype=jnp.float32) / nf)
    xf = x.astype(jnp.float32)

    def rot(xa, pos):
        ang = pos.astype(jnp.float32)[:, None] * inv_freq
        cos = jnp.cos(ang)[None, :, None, :]
        sin = jnp.sin(ang)[None, :, None, :]
        x1, x2 = xa[..., :nf], xa[..., nf:]
        return jnp.concatenate([x1 * cos - x2 * sin, x2 * cos + x1 * sin], axis=-1)

    out = jnp.concatenate([rot(xf[..., :half], pos_row), rot(xf[..., half:], pos_col)], axis=-1)
    return out.astype(x.dtype)


def gla_chunk_scan(q, k, v, log_f, s0):
    B, L, H, dk = q.shape
    dv = v.shape[-1]
    n = L // HG_CHUNK

    def chunks(a):
        return a.reshape(B, n, HG_CHUNK, H, a.shape[-1]).transpose(1, 0, 3, 2, 4)

    tri = jnp.tril(jnp.ones((HG_CHUNK, HG_CHUNK), dtype=bool))[:, :, None]

    def step(S, inp):
        qc, kc, vc, gc = inp
        b = jnp.cumsum(gc, axis=2)
        b_last = b[:, :, -1:, :]
        decay = jnp.exp(jnp.where(tri, b[:, :, :, None, :] - b[:, :, None, :, :], -jnp.inf))
        scores = jnp.einsum('bhtd,bhsd,bhtsd->bhts', qc, kc, decay)
        o = jnp.einsum('bhts,bhse->bhte', scores, vc) + jnp.einsum('bhtd,bhde->bhte', qc * jnp.exp(b), S)
        S = jnp.exp(b_last)[:, :, 0, :, None] * S + jnp.einsum('bhsd,bhse->bhde', kc * jnp.exp(b_last - b), vc)
        return S, o

    S, o = lax.scan(step, s0, (chunks(q), chunks(k), chunks(v), chunks(log_f)))
    return o.transpose(1, 0, 3, 2, 4).reshape(B, L, H, dv), S


def _hgrn2_gates(z, lb):
    z = z.astype(jnp.float32)
    log_f = jnp.logaddexp(jnp.log(lb), jnp.log1p(-lb) + jax.nn.log_sigmoid(z))
    k = (1.0 - lb) * jax.nn.sigmoid(-z)
    return _heads(log_f, HG_HEADS), _heads(k, HG_HEADS)


def hgrn2_mixer(parts_ctx, parts_lat, lb_fwd, lb_bwd, norm_w, need_ctx):
    def prep(parts):
        q, zf, zb, v, g = parts
        q = _heads(jax.nn.silu(q.astype(jnp.float32)), HG_HEADS)
        v = _heads(v.astype(jnp.float32), HG_HEADS)
        return q, _hgrn2_gates(zf, lb_fwd), _hgrn2_gates(zb, lb_bwd), v, g

    qc, fwd_c, bwd_c, vc, gc = prep(parts_ctx)
    ql, fwd_l, bwd_l, vl, gl = prep(parts_lat)
    s0 = jnp.zeros((qc.shape[0], HG_HEADS, HG_DK, HG_DV), jnp.float32)
    rev = lambda a: jnp.flip(a, axis=1)
    oc_f, sc_f = gla_chunk_scan(qc, fwd_c[1], vc, fwd_c[0], s0)
    ol_f, _ = gla_chunk_scan(ql, fwd_l[1], vl, fwd_l[0], sc_f)
    oc_b, sc_b = gla_chunk_scan(rev(qc), rev(bwd_c[1]), rev(vc), rev(bwd_c[0]), s0)
    ol_b, _ = gla_chunk_scan(rev(ql), rev(bwd_l[1]), rev(vl), rev(bwd_l[0]), sc_b)

    def readout(o, g):
        o = o * lax.rsqrt(jnp.mean(o * o, axis=-1, keepdims=True) + EPS)
        o = o.reshape(o.shape[0], o.shape[1], HG_WIDTH) * norm_w.astype(jnp.float32)
        return (o * jax.nn.silu(g.astype(jnp.float32))).astype(g.dtype)

    out_lat = readout(ol_f + rev(ol_b), gl)
    out_ctx = readout(oc_f + rev(oc_b), gc) if need_ctx else None
    return out_lat, out_ctx


def swa_mixer(parts_ctx, parts_lat, sink, pos_row, pos_col, need_ctx):
    q_c, k_c, v_c = parts_ctx
    q_l, k_l, v_l = parts_lat
    B, L = q_l.shape[:2]
    C = q_c.shape[1]
    scale = HEAD_DIM ** -0.5
    ql = axial_rope(_heads(q_l, SWA_HEADS), pos_row, pos_col)
    kl = axial_rope(_heads(k_l, SWA_KV_HEADS), pos_row, pos_col)
    vl = _heads(v_l, SWA_KV_HEADS)
    qc = _heads(q_c, SWA_HEADS).reshape(B, C, SWA_KV_HEADS, SWA_GROUP, HEAD_DIM)
    kc = _heads(k_c, SWA_KV_HEADS)
    vc = _heads(v_c, SWA_KV_HEADS)
    sink_g = sink.astype(jnp.float32).reshape(SWA_KV_HEADS, SWA_GROUP)[None, :, :, None, None]
    pad = ((0, 0), (SWA_BLOCK, SWA_BLOCK), (0, 0), (0, 0))
    kp, vp = jnp.pad(kl, pad), jnp.pad(vl, pad)
    offs_q = jnp.arange(SWA_BLOCK)
    offs_k = jnp.arange(3 * SWA_BLOCK) - SWA_BLOCK

    def block(i):
        start = i * SWA_BLOCK
        qb = lax.dynamic_slice_in_dim(ql, start, SWA_BLOCK, axis=1).reshape(B, SWA_BLOCK, SWA_KV_HEADS, SWA_GROUP, HEAD_DIM)
        kb = lax.dynamic_slice_in_dim(kp, start, 3 * SWA_BLOCK, axis=1)
        vb = lax.dynamic_slice_in_dim(vp, start, 3 * SWA_BLOCK, axis=1)
        qpos = start + offs_q
        kpos = start + offs_k
        mask = (jnp.abs(qpos[:, None] - kpos[None, :]) <= SWA_WINDOW) & (kpos >= 0)[None, :] & (kpos < L)[None, :]
        s_loc = jnp.einsum('bqkgd,bskd->bkgqs', qb, kb).astype(jnp.float32) * scale
        s_loc = jnp.where(mask, s_loc, -jnp.inf)
        s_ctx = jnp.einsum('bqkgd,bskd->bkgqs', qb, kc).astype(jnp.float32) * scale
        p_loc, p_ctx = joint_softmax([s_loc, s_ctx], sink_g)
        o = jnp.einsum('bkgqs,bskd->bqkgd', p_loc.astype(vb.dtype), vb) + jnp.einsum('bkgqs,bskd->bqkgd', p_ctx.astype(vc.dtype), vc)
        return o.reshape(B, SWA_BLOCK, SWA_HEADS * HEAD_DIM)

    o_lat = lax.map(block, jnp.arange(L // SWA_BLOCK))
    o_lat = o_lat.transpose(1, 0, 2, 3).reshape(B, L, SWA_HEADS * HEAD_DIM).astype(q_l.dtype)
    o_ctx = None
    if need_ctx:
        s = jnp.einsum('bqkgd,bskd->bkgqs', qc, kc).astype(jnp.float32) * scale
        (p,) = joint_softmax([s], sink_g)
        o_ctx = jnp.einsum('bkgqs,bskd->bqkgd', p.astype(vc.dtype), vc).reshape(B, C, SWA_HEADS * HEAD_DIM).astype(q_c.dtype)
    return o_lat, o_ctx


def natten_mixer(parts_ctx, parts_lat, rpb, need_ctx):
    q_c, k_c, v_c = parts_ctx
    q_l, k_l, v_l = parts_lat
    B, L = q_l.shape[:2]
    C = q_c.shape[1]
    rows = L // GRID_W
    wr = min(NAT_ROWS, rows)
    scale = HEAD_DIM ** -0.5
    qg = _heads(q_l, NAT_HEADS).reshape(B, rows, GRID_W, NAT_HEADS, HEAD_DIM)
    kg = _heads(k_l, NAT_HEADS).reshape(B, rows, GRID_W, NAT_HEADS, HEAD_DIM)
    vg = _heads(v_l, NAT_HEADS).reshape(B, rows, GRID_W, NAT_HEADS, HEAD_DIM)
    qc, kc, vc = _heads(q_c, NAT_HEADS), _heads(k_c, NAT_HEADS), _heads(v_c, NAT_HEADS)
    n_cb = GRID_W // NAT_QCOLS
    qcol = np.arange(GRID_W).reshape(n_cb, NAT_QCOLS)
    slab_start = np.clip(np.arange(n_cb) * NAT_QCOLS - NAT_COLS // 2, 0, GRID_W - NAT_SLAB)
    slab_cols = slab_start[:, None] + np.arange(NAT_SLAB)
    win_start = np.clip(qcol - NAT_COLS // 2, 0, GRID_W - NAT_COLS)
    col_mask = (slab_cols[:, None, :] >= win_start[..., None]) & (slab_cols[:, None, :] < win_start[..., None] + NAT_COLS)
    col_idx = slab_cols[:, None, :] - qcol[..., None] + NAT_COLS - 1
    col_mask_b = jnp.asarray(col_mask)[:, :, None, :]
    rpb = rpb.astype(jnp.float32)

    def row_block(r):
        rs = jnp.clip(r - wr // 2, 0, rows - wr)
        q_r = lax.dynamic_index_in_dim(qg, r, axis=1, keepdims=False).reshape(B, n_cb, NAT_QCOLS, NAT_HEADS, HEAD_DIM)
        k_slab = lax.dynamic_slice_in_dim(kg, rs, wr, axis=1)[:, :, slab_cols]
        v_slab = lax.dynamic_slice_in_dim(vg, rs, wr, axis=1)[:, :, slab_cols]
        s = jnp.einsum('bjqhd,brjkhd->bhjqrk', q_r, k_slab).astype(jnp.float32) * scale
        row_idx = rs + jnp.arange(wr) - r + NAT_ROWS - 1
        bias = rpb[:, row_idx[None, None, :, None], col_idx[:, :, None, :]]
        s = jnp.where(col_mask_b, s + bias[None], -jnp.inf)
        s = s.reshape(B, NAT_HEADS, n_cb, NAT_QCOLS, wr * NAT_SLAB)
        s_ctx = jnp.einsum('bjqhd,bshd->bhjqs', q_r, kc).astype(jnp.float32) * scale
        p_loc, p_ctx = joint_softmax([s, s_ctx])
        p_loc = p_loc.reshape(B, NAT_HEADS, n_cb, NAT_QCOLS, wr, NAT_SLAB)
        o = jnp.einsum('bhjqrk,brjkhd->bjqhd', p_loc.astype(v_slab.dtype), v_slab) + jnp.einsum('bhjqs,bshd->bjqhd', p_ctx.astype(vc.dtype), vc)
        return o.reshape(B, GRID_W, NAT_HEADS * HEAD_DIM)

    o_lat = lax.map(row_block, jnp.arange(rows))
    o_lat = o_lat.transpose(1, 0, 2, 3).reshape(B, L, NAT_HEADS * HEAD_DIM).astype(q_l.dtype)
    o_ctx = None
    if need_ctx:
        s = jnp.einsum('bqhd,bshd->bhqs', qc, kc).astype(jnp.float32) * scale
        (p,) = joint_softmax([s])
        o_ctx = jnp.einsum('bhqs,bshd->bqhd', p.astype(vc.dtype), vc).reshape(B, C, NAT_HEADS * HEAD_DIM).astype(q_c.dtype)
    return o_lat, o_ctx


def peer_ffn(h, wq, subkeys, u_tab, v_tab):
    T, D = h.shape

    def block(hb):
        q = (hb @ wq).reshape(PEER_BLOCK, PEER_HEADS, 2, PEER_DK // 2)
        s = jnp.einsum('thpd,hpnd->thpn', q, subkeys).astype(jnp.float32)
        top_s, top_i = lax.top_k(s, PEER_TOPK)
        cand_s = (top_s[:, :, 0, :, None] + top_s[:, :, 1, None, :]).reshape(PEER_BLOCK, PEER_HEADS, PEER_TOPK * PEER_TOPK)
        cand_i = (top_i[:, :, 0, :, None] * PEER_NKEYS + top_i[:, :, 1, None, :]).reshape(PEER_BLOCK, PEER_HEADS, PEER_TOPK * PEER_TOPK)
        best_s, pos = lax.top_k(cand_s, PEER_TOPK)
        idx = jnp.take_along_axis(cand_i, pos, axis=-1)
        g = jax.nn.softmax(best_s, axis=-1)
        a = jax.nn.gelu(jnp.einsum('td,thkd->thk', hb, u_tab[idx]).astype(jnp.float32), approximate=False)
        return jnp.einsum('thk,thkd->td', (g * a).astype(hb.dtype), v_tab[idx])

    return lax.map(block, h.reshape(T // PEER_BLOCK, PEER_BLOCK, D)).reshape(T, D)


def setup_inputs(seed: int = 0) -> dict:
    key = jax.random.key(seed)
    ks = jax.random.split(key, 19)
    D = D_MODEL

    def n(k, shape, s):
        return jax.random.normal(k, shape, jnp.float32) * s

    return {
        "x": n(ks[0], (BATCH, SEQ, D), 1.0),
        "c": n(ks[1], (BATCH, D), 1.0),
        "ctx": n(ks[2], (BATCH, CTX_LEN, D), 1.0),
        "c_ctx": n(ks[3], (D,), 1.0),
        "w_mod": n(ks[4], (DEPTH, D, 6 * D), 0.5 * D ** -0.5),
        "b_mod": n(ks[5], (DEPTH, 6 * D), 0.01),
        "norm_mix_w": 1.0 + n(ks[6], (DEPTH, D), 0.02),
        "norm_ffn_w": 1.0 + n(ks[7], (DEPTH, D), 0.02),
        "w_in": n(ks[8], (DEPTH, D, PROJ_WIDTH), D ** -0.5),
        "hgrn_lb_logits": n(ks[9], (2, DEPTH, HG_WIDTH), 0.5),
        "hgrn_norm_w": 1.0 + n(ks[10], (DEPTH, HG_WIDTH), 0.02),
        "swa_sink": n(ks[11], (DEPTH, SWA_HEADS), 1.0),
        "nat_rpb": n(ks[12], (DEPTH, NAT_HEADS, 2 * NAT_ROWS - 1, 2 * NAT_COLS - 1), 0.5),
        "w_out": n(ks[13], (DEPTH, MIX_WIDTH, D), MIX_WIDTH ** -0.5),
        "peer_wq": n(ks[14], (DEPTH, D, PEER_HEADS * PEER_DK), D ** -0.5),
        "peer_subkeys": n(ks[15], (DEPTH, PEER_HEADS, 2, PEER_NKEYS, PEER_DK // 2), (PEER_DK // 2) ** -0.5),
        "peer_u": n(ks[16], (DEPTH, PEER_EXPERTS, D), D ** -0.5),
        "peer_v": n(ks[17], (DEPTH, PEER_EXPERTS, D), 0.5),
        "final_norm_w": 1.0 + n(ks[18], (D,), 0.02),
    }


def reference(x, c, ctx, c_ctx, w_mod, b_mod, norm_mix_w, norm_ffn_w, w_in, hgrn_lb_logits, hgrn_norm_w,
              swa_sink, nat_rpb, w_out, peer_wq, peer_subkeys, peer_u, peer_v, final_norm_w):
    B, L, D = x.shape
    C = ctx.shape[1]
    pos = jnp.arange(L)
    pos_row, pos_col = pos // GRID_W, pos % GRID_W
    lb = jnp.cumsum(jax.nn.softmax(hgrn_lb_logits.astype(jnp.float32), axis=1), axis=1)
    lb = lb - lb[:, :1]
    xc = ctx
    s_c = jax.nn.silu(c)
    s_cc = jax.nn.silu(c_ctx)
    for l in range(DEPTH):
        last = l == DEPTH - 1
        need_ctx = not last
        mod = jnp.split(s_c @ w_mod[l] + b_mod[l], 6, axis=-1)
        mod_c = jnp.split(s_cc @ w_mod[l] + b_mod[l], 6, axis=-1)
        h = modulate(rms_norm(x, norm_mix_w[l]), mod[0][:, None], mod[1][:, None])
        hc = modulate(rms_norm(xc, norm_mix_w[l]), mod_c[0], mod_c[1])
        pl = split_proj(h @ w_in[l])
        pc = split_proj(hc @ w_in[l])
        a_l, a_c = hgrn2_mixer(pc[:5], pl[:5], lb[0, l], lb[1, l], hgrn_norm_w[l], need_ctx)
        b_l, b_c = swa_mixer(pc[5:8], pl[5:8], swa_sink[l], pos_row, pos_col, need_ctx)
        n_l, n_c = natten_mixer(pc[8:], pl[8:], nat_rpb[l], need_ctx)
        x = x + mod[2][:, None] * (jnp.concatenate([a_l, b_l, n_l], axis=-1) @ w_out[l])
        if need_ctx:
            xc = xc + mod_c[2] * (jnp.concatenate([a_c, b_c, n_c], axis=-1) @ w_out[l])
        h = modulate(rms_norm(x, norm_ffn_w[l]), mod[3][:, None], mod[4][:, None])
        if need_ctx:
            hc = modulate(rms_norm(xc, norm_ffn_w[l]), mod_c[3], mod_c[4])
            tokens = jnp.concatenate([hc.reshape(B * C, D), h.reshape(B * L, D)], axis=0)
            y_all = peer_ffn(tokens, peer_wq[l], peer_subkeys[l], peer_u[l], peer_v[l])
            xc = xc + mod_c[5] * y_all[:B * C].reshape(B, C, D)
            y = y_all[B * C:].reshape(B, L, D)
        else:
            y = peer_ffn(h.reshape(B * L, D), peer_wq[l], peer_subkeys[l], peer_u[l], peer_v[l]).reshape(B, L, D)
        x = x + mod[5][:, None] * y
    return rms_norm(x, final_norm_w)
```

```cpp
#include <hip/hip_runtime.h>
#include <hip/hip_cooperative_groups.h>
#include <cstdio>
#include <cstdint>
namespace cg = cooperative_groups;
#define DI __device__ __forceinline__

typedef unsigned short bf16_t;
typedef float f32x4 __attribute__((ext_vector_type(4)));
typedef unsigned u32x4 __attribute__((ext_vector_type(4)));
typedef unsigned u32x2 __attribute__((ext_vector_type(2)));

constexpr int D = 1024, NB = 2, L = 16384, CL = 256, DEPTH = 4;
constexpr int NCTX = NB * CL, NLAT = NB * L, M = NCTX + NLAT;
constexpr int PW = 3072;
constexpr int C_HQ = 0, C_ZF = 256, C_ZB = 512, C_HV = 768, C_HG = 1024, C_SQ = 1280, C_SK = 1664, C_SV = 1792, C_NQ = 1920, C_NK = 2304, C_NV = 2688;
constexpr int MX_H = 0, MX_S = 256, MX_N = 640;
constexpr float EPS = 1e-6f;
constexpr int NTHREADS = 512, NWAVES = 8;
constexpr int LDS_BYTES = 147456;

constexpr size_t al256(size_t x) { return (x + 255) & ~(size_t)255; }
constexpr size_t WS_X = 0;
constexpr size_t WS_H = WS_X + al256((size_t)M * D * 4);
constexpr size_t WS_P = WS_H + al256((size_t)M * D * 2);
constexpr size_t WS_MIX = WS_P + al256((size_t)M * PW * 2);
constexpr size_t WS_OF = WS_MIX + al256((size_t)M * D * 2);
constexpr size_t WS_OB = WS_OF + al256((size_t)M * 256 * 4);
constexpr size_t WS_PIDX = WS_OB + al256((size_t)M * 256 * 4);
constexpr size_t WS_PG = WS_PIDX + al256((size_t)M * 128 * 4);
constexpr size_t WS_MOD = WS_PG + al256((size_t)M * 128 * 4);
constexpr size_t WS_LB = WS_MOD + al256((size_t)DEPTH * 3 * 6 * D * 4);
constexpr size_t WS_ROPE = WS_LB + al256((size_t)2 * DEPTH * 256 * 4);
constexpr size_t WS_END = WS_ROPE + al256((size_t)(256 + 256 + 64 + 64) * 16 * 4);

struct Args {
    const float *x, *c, *ctx, *c_ctx, *w_mod, *b_mod, *norm_mix_w, *norm_ffn_w, *w_in, *lb_logits, *hgrn_norm_w, *swa_sink, *nat_rpb, *w_out, *peer_wq, *peer_sk, *peer_u, *peer_v, *final_norm_w;
    float* out; unsigned char* ws;
};

DI float bf2f(bf16_t v) { return __uint_as_float((unsigned)v << 16); }
DI bf16_t f2bf(float f) { unsigned u = __float_as_uint(f); return (bf16_t)((u + 0x7fffu + ((u >> 16) & 1u)) >> 16); }
DI unsigned pk2(float lo, float hi) { return (unsigned)f2bf(lo) | ((unsigned)f2bf(hi) << 16); }
DI float wave_sum(float v) {
#pragma unroll
    for (int o = 1; o < 64; o <<= 1) v += __shfl_xor(v, o);
    return v;
}
DI float sigmoidf_(float z) { return 1.0f / (1.0f + __expf(-z)); }
DI float gelu_erf(float v) { return 0.5f * v * (1.0f + erff(v * 0.70710678118654752f)); }
DI int modvec_of_row(int r) { return r < NCTX ? 2 : (r - NCTX) / L; }
DI int batch_of_row(int r) { return r < NCTX ? r / CL : (r - NCTX) / L; }
DI int lat_row(int b, int t) { return NCTX + b * L + t; }
DI int ctx_row(int b, int s) { return b * CL + s; }
DI void unpack8(const u32x4 w, float* o) {
    o[0] = __uint_as_float(w.x << 16); o[1] = __uint_as_float(w.x & 0xffff0000u);
    o[2] = __uint_as_float(w.y << 16); o[3] = __uint_as_float(w.y & 0xffff0000u);
    o[4] = __uint_as_float(w.z << 16); o[5] = __uint_as_float(w.z & 0xffff0000u);
    o[6] = __uint_as_float(w.w << 16); o[7] = __uint_as_float(w.w & 0xffff0000u);
}
DI void load_row64(const bf16_t* p, float (&o)[64]) {
#pragma unroll
    for (int i = 0; i < 8; ++i) { const u32x4 w = *(const u32x4*)(p + 8 * i); unpack8(w, &o[8 * i]); }
}
DI void rope64(float (&x)[64], const float* cr, const float* sr, const float* cc, const float* sc) {
#pragma unroll
    for (int i = 0; i < 16; ++i) {
        const float c1 = cr[i], s1 = sr[i], a = x[i], b = x[16 + i];
        x[i] = a * c1 - b * s1; x[16 + i] = b * c1 + a * s1;
        const float c2 = cc[i], s2 = sc[i], e = x[32 + i], f = x[48 + i];
        x[32 + i] = e * c2 - f * s2; x[48 + i] = f * c2 + e * s2;
    }
}

struct Ctx {
    Args a; int l;
    float* X; bf16_t* H; bf16_t* P; bf16_t* MIX; bf16_t* QP; float* OF; float* OB; int* PIDX; float* PG; float* MOD; float* LB; float* ROPE;
    unsigned char* lds; int tid, lane, wave, gw, ngw;
};

DI void ph_prologue(Ctx& K) {
    const size_t gt = (size_t)blockIdx.x * NTHREADS + K.tid, gs = (size_t)gridDim.x * NTHREADS;
    { const f32x4* s0 = (const f32x4*)K.a.ctx; const f32x4* s1 = (const f32x4*)K.a.x; f32x4* d = (f32x4*)K.X;
      const size_t n0 = (size_t)NCTX * D / 4, n1 = (size_t)NLAT * D / 4;
      for (size_t i = gt; i < n0 + n1; i += gs) d[i] = i < n0 ? s0[i] : s1[i - n0]; }
    for (size_t i = gt; i < (size_t)DEPTH * 6 * D; i += gs) {
        const int l = (int)(i / (6 * D)), col = (int)(i % (6 * D));
        const float* w = K.a.w_mod + (size_t)l * D * 6 * D + col;
        float a0 = 0.f, a1 = 0.f, a2 = 0.f;
        for (int k = 0; k < D; ++k) {
            const float wv = w[(size_t)k * 6 * D];
            const float c0 = K.a.c[k], c1 = K.a.c[D + k], c2 = K.a.c_ctx[k];
            a0 += c0 * sigmoidf_(c0) * wv; a1 += c1 * sigmoidf_(c1) * wv; a2 += c2 * sigmoidf_(c2) * wv;
        }
        const float bb = K.a.b_mod[(size_t)l * 6 * D + col];
        K.MOD[((size_t)l * 3 + 0) * 6 * D + col] = a0 + bb; K.MOD[((size_t)l * 3 + 1) * 6 * D + col] = a1 + bb; K.MOD[((size_t)l * 3 + 2) * 6 * D + col] = a2 + bb;
    }
    for (size_t i = gt; i < 2 * 256; i += gs) {
        const int dir = (int)(i / 256), ch = (int)(i % 256);
        float lg[DEPTH], mx = -1e30f;
#pragma unroll
        for (int l = 0; l < DEPTH; ++l) { lg[l] = K.a.lb_logits[((size_t)dir * DEPTH + l) * 256 + ch]; mx = fmaxf(mx, lg[l]); }
        float s = 0.f;
#pragma unroll
        for (int l = 0; l < DEPTH; ++l) { lg[l] = expf(lg[l] - mx); s += lg[l]; }
        float cum = 0.f;
#pragma unroll
        for (int l = 0; l < DEPTH; ++l) { if (l > 0) cum += lg[l] / s; K.LB[((size_t)dir * DEPTH + l) * 256 + ch] = cum; }
    }
    for (size_t i = gt; i < (256 + 64) * 16; i += gs) {
        const int pos = (int)(i / 16), f = (int)(i % 16);
        const float inv = powf(10000.0f, -(float)f / 16.0f);
        if (pos < 256) { const float ang = (float)pos * inv; K.ROPE[pos * 16 + f] = cosf(ang); K.ROPE[4096 + pos * 16 + f] = sinf(ang); }
        else { const int pc = pos - 256; const float ang = (float)pc * inv; K.ROPE[8192 + pc * 16 + f] = cosf(ang); K.ROPE[8192 + 1024 + pc * 16 + f] = sinf(ang); }
    }
}

DI void ph_norm(Ctx& K, const float* nw, int shift_chunk) {
    const float* modl = K.MOD + (size_t)K.l * 3 * 6 * D;
    for (int r = K.gw; r < M; r += K.ngw) {
        const f32x4* xr = (const f32x4*)(K.X + (size_t)r * D);
        f32x4 v[4]; float ss = 0.f;
#pragma unroll
        for (int j = 0; j < 4; ++j) { v[j] = xr[j * 64 + K.lane]; ss += v[j].x * v[j].x + v[j].y * v[j].y + v[j].z * v[j].z + v[j].w * v[j].w; }
        ss = wave_sum(ss);
        const float rs = rsqrtf(ss * (1.0f / D) + EPS);
        const float* mv = modl + (size_t)modvec_of_row(r) * 6 * D;
        u32x2* ho = (u32x2*)(K.H + (size_t)r * D);
#pragma unroll
        for (int j = 0; j < 4; ++j) {
            const int c4 = j * 64 + K.lane;
            const f32x4 w = ((const f32x4*)nw)[c4], sh = ((const f32x4*)(mv + shift_chunk * D))[c4], sc = ((const f32x4*)(mv + (shift_chunk + 1) * D))[c4];
            f32x4 y; y.x = v[j].x * rs * w.x * (1.f + sc.x) + sh.x; y.y = v[j].y * rs * w.y * (1.f + sc.y) + sh.y; y.z = v[j].z * rs * w.z * (1.f + sc.z) + sh.z; y.w = v[j].w * rs * w.w * (1.f + sc.w) + sh.w;
            u32x2 o; o.x = pk2(y.x, y.y); o.y = pk2(y.z, y.w); ho[c4] = o;
        }
    }
}

template <int EPI> DI void ph_gemm(Ctx& K, const bf16_t* A, const float* W, int N, int Kd, bf16_t* outb) {
    float* As = (float*)K.lds;
    float* Bs = As + 16 * 132;
    const int tilesN = N / 128, ntiles = (M / 128) * tilesN;
    const int ty = K.tid >> 4, tx = K.tid & 15;
    const float* gate = K.MOD + (size_t)K.l * 3 * 6 * D + 2 * D;
    for (int tile = blockIdx.x; tile < ntiles; tile += gridDim.x) {
        const int tm = tile / tilesN, tn = tile % tilesN, m0 = tm * 128, n0 = tn * 128;
        float acc[4][8];
#pragma unroll
        for (int i = 0; i < 4; ++i)
#pragma unroll
            for (int j = 0; j < 8; ++j) acc[i][j] = 0.f;
        for (int k0 = 0; k0 < Kd; k0 += 16) {
            __syncthreads();
            { const int row = K.tid >> 2, kq = K.tid & 3; const u32x2 w = *(const u32x2*)(A + (size_t)(m0 + row) * Kd + k0 + kq * 4);
              As[(kq * 4 + 0) * 132 + row] = __uint_as_float(w.x << 16); As[(kq * 4 + 1) * 132 + row] = __uint_as_float(w.x & 0xffff0000u);
              As[(kq * 4 + 2) * 132 + row] = __uint_as_float(w.y << 16); As[(kq * 4 + 3) * 132 + row] = __uint_as_float(w.y & 0xffff0000u); }
            { const int kk = K.tid >> 5, n4 = K.tid & 31; *(f32x4*)(Bs + kk * 128 + n4 * 4) = *(const f32x4*)(W + (size_t)(k0 + kk) * N + n0 + n4 * 4); }
            __syncthreads();
#pragma unroll
            for (int kk = 0; kk < 16; ++kk) {
                const f32x4 a = *(const f32x4*)(As + kk * 132 + ty * 4);
                const f32x4 b0 = *(const f32x4*)(Bs + kk * 128 + tx * 8), b1 = *(const f32x4*)(Bs + kk * 128 + tx * 8 + 4);
                const float av[4] = {a.x, a.y, a.z, a.w}; const float bv[8] = {b0.x, b0.y, b0.z, b0.w, b1.x, b1.y, b1.z, b1.w};
#pragma unroll
                for (int i = 0; i < 4; ++i)
#pragma unroll
                    for (int j = 0; j < 8; ++j) acc[i][j] += av[i] * bv[j];
            }
        }
#pragma unroll
        for (int i = 0; i < 4; ++i) {
            const int m = m0 + ty * 4 + i, n = n0 + tx * 8;
            if (EPI == 0) {
                u32x4 o; o.x = pk2(acc[i][0], acc[i][1]); o.y = pk2(acc[i][2], acc[i][3]); o.z = pk2(acc[i][4], acc[i][5]); o.w = pk2(acc[i][6], acc[i][7]);
                *(u32x4*)(outb + (size_t)m * N + n) = o;
            } else {
                const float* g = gate + (size_t)modvec_of_row(m) * 6 * D + n; float* xp = K.X + (size_t)m * D + n;
#pragma unroll
                for (int j = 0; j < 8; ++j) xp[j] += g[j] * acc[i][j];
            }
        }
    }
}

DI void ph_rope(Ctx& K) {
    const float* cosr = K.ROPE; const float* sinr = K.ROPE + 4096; const float* cosc = K.ROPE + 8192; const float* sinc = K.ROPE + 8192 + 1024;
    const size_t gt = (size_t)blockIdx.x * NTHREADS + K.tid, gs = (size_t)gridDim.x * NTHREADS;
    for (size_t i = gt; i < (size_t)NLAT * 8 * 16; i += gs) {
        const int f = (int)(i & 15), hh = (int)((i >> 4) & 7), lr = (int)(i >> 7);
        const int t = lr % L, pr = t >> 6, pc = t & 63;
        bf16_t* p = K.P + (size_t)(NCTX + lr) * PW + (hh < 6 ? C_SQ + hh * 64 : C_SK + (hh - 6) * 64);
        const float c1 = cosr[pr * 16 + f], s1 = sinr[pr * 16 + f], c2 = cosc[pc * 16 + f], s2 = sinc[pc * 16 + f];
        const float a = bf2f(p[f]), b = bf2f(p[16 + f]), e = bf2f(p[32 + f]), g = bf2f(p[48 + f]);
        p[f] = f2bf(a * c1 - b * s1); p[16 + f] = f2bf(b * c1 + a * s1); p[32 + f] = f2bf(e * c2 - g * s2); p[48 + f] = f2bf(g * c2 + e * s2);
    }
}

DI int hg_row(int b, int dir, int p) {
    if (dir == 0) return p < CL ? ctx_row(b, p) : lat_row(b, p - CL);
    return p < CL ? ctx_row(b, CL - 1 - p) : lat_row(b, L - 1 - (p - CL));
}
DI void ph_hgrn_naive(Ctx& K) {
    float* sF = (float*)K.lds; float* sK = sF + 4096; float* sQ = sK + 4096; float* sV = sQ + 4096; float* sO = sV + 1024;
    for (int item = blockIdx.x; item < 64; item += gridDim.x) {
        const int chain = item >> 2, e0 = (item & 3) * 16, h = chain & 3, dir = (chain >> 2) & 1, b = chain >> 3;
        const int el = 2 * K.wave + (K.lane >> 5), dl = K.lane & 31;
        const float* lb = K.LB + ((size_t)dir * DEPTH + K.l) * 256 + h * 64;
        float* O = dir ? K.OB : K.OF;
        float S0 = 0.f, S1 = 0.f;
        for (int ch = 0; ch < (CL + L) / 64; ++ch) {
            __syncthreads();
            for (int idx = K.tid; idx < 4096; idx += NTHREADS) {
                const int pos = idx >> 6, d = idx & 63; const bf16_t* pr = K.P + (size_t)hg_row(b, dir, ch * 64 + pos) * PW;
                const float z = bf2f(pr[(dir ? C_ZB : C_ZF) + h * 64 + d]), qr = bf2f(pr[C_HQ + h * 64 + d]), lbv = lb[d];
                const float sg = sigmoidf_(z);
                sF[idx] = lbv + (1.f - lbv) * sg; sK[idx] = (1.f - lbv) * (1.f - sg); sQ[idx] = qr * sigmoidf_(qr);
            }
            for (int idx = K.tid; idx < 1024; idx += NTHREADS) {
                const int pos = idx >> 4, e = idx & 15; sV[idx] = bf2f(K.P[(size_t)hg_row(b, dir, ch * 64 + pos) * PW + C_HV + h * 64 + e0 + e]);
            }
            __syncthreads();
            for (int pos = 0; pos < 64; ++pos) {
                const float f0 = sF[pos * 64 + 2 * dl], f1 = sF[pos * 64 + 2 * dl + 1], k0 = sK[pos * 64 + 2 * dl], k1 = sK[pos * 64 + 2 * dl + 1];
                const float q0 = sQ[pos * 64 + 2 * dl], q1 = sQ[pos * 64 + 2 * dl + 1], v = sV[pos * 16 + el];
                S0 = f0 * S0 + k0 * v; S1 = f1 * S1 + k1 * v;
                float part = S0 * q0 + S1 * q1;
#pragma unroll
                for (int o = 1; o < 32; o <<= 1) part += __shfl_xor(part, o);
                if (dl == 0) sO[pos * 16 + el] = part;
            }
            __syncthreads();
            for (int idx = K.tid; idx < 1024; idx += NTHREADS) {
                const int pos = idx >> 4, e = idx & 15; O[(size_t)hg_row(b, dir, ch * 64 + pos) * 256 + h * 64 + e0 + e] = sO[idx];
            }
        }
    }
}
DI void ph_hgrn_readout(Ctx& K) {
    const float* nw = K.a.hgrn_norm_w + (size_t)K.l * 256;
    for (int r = K.gw; r < M; r += K.ngw) {
        const f32x4 a = ((const f32x4*)(K.OF + (size_t)r * 256))[K.lane], b = ((const f32x4*)(K.OB + (size_t)r * 256))[K.lane];
        f32x4 o = a + b; float ss = o.x * o.x + o.y * o.y + o.z * o.z + o.w * o.w;
        ss += __shfl_xor(ss, 1); ss += __shfl_xor(ss, 2); ss += __shfl_xor(ss, 4); ss += __shfl_xor(ss, 8);
        const float rs = rsqrtf(ss * (1.0f / 64.0f) + EPS);
        const u32x2 gw = *(const u32x2*)(K.P + (size_t)r * PW + C_HG + K.lane * 4);
        const float g0 = __uint_as_float(gw.x << 16), g1 = __uint_as_float(gw.x & 0xffff0000u), g2 = __uint_as_float(gw.y << 16), g3 = __uint_as_float(gw.y & 0xffff0000u);
        const f32x4 w = ((const f32x4*)nw)[K.lane];
        u32x2 out; out.x = pk2(o.x * rs * w.x * g0 * sigmoidf_(g0), o.y * rs * w.y * g1 * sigmoidf_(g1)); out.y = pk2(o.z * rs * w.z * g2 * sigmoidf_(g2), o.w * rs * w.w * g3 * sigmoidf_(g3));
        *(u32x2*)(K.MIX + (size_t)r * D + MX_H + K.lane * 4) = out;
    }
}

DI void att_step(const float (&q)[32], float (&acc)[32], float& m, float& lsum, const bf16_t* krow, const bf16_t* vrow, bool valid, float bias) {
    float s = 0.f;
#pragma unroll
    for (int i = 0; i < 4; ++i) { float kv[8]; unpack8(*(const u32x4*)(krow + 8 * i), kv);
#pragma unroll
        for (int j = 0; j < 8; ++j) s += q[8 * i + j] * kv[j]; }
    s += __shfl_xor(s, 32);
    s += bias;
    const float sv = valid ? s : -3.0e38f;
    const float mn = fmaxf(m, sv), alpha = __expf(m - mn), p = valid ? __expf(sv - mn) : 0.f;
    m = mn; lsum = lsum * alpha + p;
#pragma unroll
    for (int i = 0; i < 4; ++i) { float vv[8]; unpack8(*(const u32x4*)(vrow + 8 * i), vv);
#pragma unroll
        for (int j = 0; j < 8; ++j) acc[8 * i + j] = acc[8 * i + j] * alpha + p * vv[j]; }
}
DI void att_loadq(const bf16_t* p, float (&q)[32]) {
#pragma unroll
    for (int i = 0; i < 4; ++i) { float t[8]; unpack8(*(const u32x4*)(p + 8 * i), t);
#pragma unroll
        for (int j = 0; j < 8; ++j) q[8 * i + j] = t[j] * 0.125f; }
}
DI void att_store(bf16_t* o, const float (&acc)[32], float lsum) {
    const float inv = 1.0f / lsum;
#pragma unroll
    for (int i = 0; i < 4; ++i) { u32x4 w; w.x = pk2(acc[8 * i] * inv, acc[8 * i + 1] * inv); w.y = pk2(acc[8 * i + 2] * inv, acc[8 * i + 3] * inv); w.z = pk2(acc[8 * i + 4] * inv, acc[8 * i + 5] * inv); w.w = pk2(acc[8 * i + 6] * inv, acc[8 * i + 7] * inv); *(u32x4*)(o + 8 * i) = w; }
}
DI void ph_attn_naive(Ctx& K) {
    constexpr int G32 = L / 32, N_SWA = NB * 6 * G32, N_NAT = NB * 6 * G32, N_SC = NB * 6 * (CL / 32), N_NC = NB * 6 * (CL / 32);
    const int qi = K.lane & 31, hd = (K.lane >> 5) * 32;
    for (int item = K.gw; item < N_SWA + N_NAT + N_SC + N_NC; item += K.ngw) {
        float q[32], acc[32];
#pragma unroll
        for (int d = 0; d < 32; ++d) acc[d] = 0.f;
        if (item < N_SWA) {
            const int qg = item % G32, hq = (item / G32) % 6, b = item / G32 / 6, kvh = hq / 3;
            const int t = qg * 32 + qi, row = lat_row(b, t);
            att_loadq(K.P + (size_t)row * PW + C_SQ + hq * 64 + hd, q);
            float m = K.a.swa_sink[K.l * 6 + hq], lsum = 1.0f;
            const int s_lo = max(0, qg * 32 - 128), s_hi = min(L - 1, qg * 32 + 31 + 128);
            for (int s = s_lo; s <= s_hi; ++s) {
                const bf16_t* pr = K.P + (size_t)lat_row(b, s) * PW;
                const int dlt = t - s; const bool valid = dlt <= 128 && dlt >= -128;
                att_step(q, acc, m, lsum, pr + C_SK + kvh * 64 + hd, pr + C_SV + kvh * 64 + hd, valid, 0.f);
            }
            for (int s = 0; s < CL; ++s) {
                const bf16_t* pr = K.P + (size_t)ctx_row(b, s) * PW;
                att_step(q, acc, m, lsum, pr + C_SK + kvh * 64 + hd, pr + C_SV + kvh * 64 + hd, true, 0.f);
            }
            att_store(K.MIX + (size_t)row * D + MX_S + hq * 64 + hd, acc, lsum);
        } else if (item < N_SWA + N_NAT) {
            const int it = item - N_SWA, g = it % G32, r = g >> 1, half = g & 1, h = (it / G32) % 6, b = it / G32 / 6;
            const int c = half * 32 + qi, row = lat_row(b, r * 64 + c);
            att_loadq(K.P + (size_t)row * PW + C_NQ + h * 64 + hd, q);
            float m = -1.0e30f, lsum = 0.f;
            const int rs = min(max(r - 4, 0), L / 64 - 8), ws = min(max(c - 8, 0), 48);
            const float* rpb = K.a.nat_rpb + ((size_t)K.l * 6 + h) * 15 * 31;
            const int kc_lo = half ? 24 : 0, kc_hi = half ? 63 : 39;
            for (int kr = 0; kr < 8; ++kr)
                for (int kc = kc_lo; kc <= kc_hi; ++kc) {
                    const bf16_t* pr = K.P + (size_t)lat_row(b, (rs + kr) * 64 + kc) * PW;
                    const bool valid = kc >= ws && kc < ws + 16;
                    const float bias = valid ? rpb[(rs + kr - r + 7) * 31 + (kc - c + 15)] : 0.f;
                    att_step(q, acc, m, lsum, pr + C_NK + h * 64 + hd, pr + C_NV + h * 64 + hd, valid, bias);
                }
            for (int s = 0; s < CL; ++s) {
                const bf16_t* pr = K.P + (size_t)ctx_row(b, s) * PW;
                att_step(q, acc, m, lsum, pr + C_NK + h * 64 + hd, pr + C_NV + h * 64 + hd, true, 0.f);
            }
            att_store(K.MIX + (size_t)row * D + MX_N + h * 64 + hd, acc, lsum);
        } else {
            const int it = item - N_SWA - N_NAT; const bool nat = it >= N_SC; const int i2 = nat ? it - N_SC : it;
            const int g = i2 % (CL / 32), h = (i2 / (CL / 32)) % 6, b = i2 / (CL / 32) / 6;
            const int row = ctx_row(b, g * 32 + qi);
            const int cq = (nat ? C_NQ + h * 64 : C_SQ + h * 64) + hd, ck = (nat ? C_NK + h * 64 : C_SK + (h / 3) * 64) + hd, cv = (nat ? C_NV + h * 64 : C_SV + (h / 3) * 64) + hd;
            att_loadq(K.P + (size_t)row * PW + cq, q);
            float m = nat ? -1.0e30f : K.a.swa_sink[K.l * 6 + h], lsum = nat ? 0.f : 1.0f;
            for (int s = 0; s < CL; ++s) {
                const bf16_t* pr = K.P + (size_t)ctx_row(b, s) * PW;
                att_step(q, acc, m, lsum, pr + ck, pr + cv, true, 0.f);
            }
            att_store(K.MIX + (size_t)row * D + (nat ? MX_N : MX_S) + h * 64 + hd, acc, lsum);
        }
    }
}

DI void wave_argmax(float& bv, int& bi) {
#pragma unroll
    for (int o = 1; o < 64; o <<= 1) {
        const float ov = __shfl_xor(bv, o); const int oi = __shfl_xor(bi, o);
        if (ov > bv || (ov == bv && oi < bi)) { bv = ov; bi = oi; }
    }
}
DI void ph_peer_select(Ctx& K) {
    const float* SK = K.a.peer_sk + (size_t)K.l * 8 * 2 * 128 * 128;
    for (int item = K.gw; item < M * 8; item += K.ngw) {
        const int r = item >> 3, h = item & 7;
        const bf16_t* qp = K.QP + (size_t)r * 2048 + h * 256;
        float topv[2], sc[2][2]; int topi[2];
#pragma unroll
        for (int p = 0; p < 2; ++p) {
            const float* k0 = SK + (((size_t)h * 2 + p) * 128 + K.lane) * 128; const float* k1 = k0 + 64 * 128;
            float s0 = 0.f, s1 = 0.f;
            for (int d = 0; d < 128; d += 8) {
                float qv[8]; unpack8(*(const u32x4*)(qp + p * 128 + d), qv);
                const f32x4 a0 = *(const f32x4*)(k0 + d), a1 = *(const f32x4*)(k0 + d + 4), b0 = *(const f32x4*)(k1 + d), b1 = *(const f32x4*)(k1 + d + 4);
                s0 += qv[0] * a0.x + qv[1] * a0.y + qv[2] * a0.z + qv[3] * a0.w + qv[4] * a1.x + qv[5] * a1.y + qv[6] * a1.z + qv[7] * a1.w;
                s1 += qv[0] * b0.x + qv[1] * b0.y + qv[2] * b0.z + qv[3] * b0.w + qv[4] * b1.x + qv[5] * b1.y + qv[6] * b1.z + qv[7] * b1.w;
            }
            sc[p][0] = s0; sc[p][1] = s1;
        }
#pragma unroll
        for (int p = 0; p < 2; ++p) {
            float v0 = sc[p][0], v1 = sc[p][1]; float myv = 0.f; int myi = 0;
            for (int k = 0; k < 16; ++k) {
                float bv; int bi; if (v1 > v0) { bv = v1; bi = K.lane + 64; } else { bv = v0; bi = K.lane; }
                wave_argmax(bv, bi);
                if (K.lane == k) { myv = bv; myi = bi; }
                if (bi == K.lane) v0 = -3.0e38f; if (bi == K.lane + 64) v1 = -3.0e38f;
            }
            topv[p] = myv; topi[p] = myi;
        }
        float cv[4]; int ce[4];
#pragma unroll
        for (int i = 0; i < 4; ++i) {
            const int cidx = K.lane + 64 * i, a = cidx >> 4, b = cidx & 15;
            cv[i] = __shfl(topv[0], a) + __shfl(topv[1], b); ce[i] = __shfl(topi[0], a) * 128 + __shfl(topi[1], b);
        }
        float bestv = 0.f; int beste = 0;
        for (int k = 0; k < 16; ++k) {
            float bv = cv[0]; int bi = K.lane;
#pragma unroll
            for (int i = 1; i < 4; ++i) if (cv[i] > bv) { bv = cv[i]; bi = K.lane + 64 * i; }
            wave_argmax(bv, bi);
            const int ow = bi & 63, oi = bi >> 6;
            int ee = oi == 0 ? ce[0] : oi == 1 ? ce[1] : oi == 2 ? ce[2] : ce[3];
            ee = __shfl(ee, ow);
            if (K.lane == k) { bestv = bv; beste = ee; }
            if (K.lane == ow) { if (oi == 0) cv[0] = -3.0e38f; else if (oi == 1) cv[1] = -3.0e38f; else if (oi == 2) cv[2] = -3.0e38f; else cv[3] = -3.0e38f; }
        }
        const float mx = __shfl(bestv, 0);
        float e = K.lane < 16 ? __expf(bestv - mx) : 0.f; float s = e;
        s += __shfl_xor(s, 1); s += __shfl_xor(s, 2); s += __shfl_xor(s, 4); s += __shfl_xor(s, 8);
        if (K.lane < 16) { K.PIDX[(size_t)r * 128 + h * 16 + K.lane] = beste; K.PG[(size_t)r * 128 + h * 16 + K.lane] = e / s; }
    }
}

DI void ph_peer_gather(Ctx& K) {
    const float* U = K.a.peer_u + (size_t)K.l * 16384 * D; const float* V = K.a.peer_v + (size_t)K.l * 16384 * D;
    const float* gate = K.MOD + (size_t)K.l * 3 * 6 * D + 5 * D;
    for (int r = K.gw; r < M; r += K.ngw) {
        f32x4 hv[4], y[4];
#pragma unroll
        for (int j = 0; j < 4; ++j) { const u32x2 w = *(const u32x2*)(K.H + (size_t)r * D + (j * 64 + K.lane) * 4);
            hv[j].x = __uint_as_float(w.x << 16); hv[j].y = __uint_as_float(w.x & 0xffff0000u); hv[j].z = __uint_as_float(w.y << 16); hv[j].w = __uint_as_float(w.y & 0xffff0000u); y[j] = (f32x4){0.f, 0.f, 0.f, 0.f}; }
        for (int k = 0; k < 128; ++k) {
            const int e = K.PIDX[(size_t)r * 128 + k]; const float g = K.PG[(size_t)r * 128 + k];
            const f32x4* ur = (const f32x4*)(U + (size_t)e * D); const f32x4* vr = (const f32x4*)(V + (size_t)e * D);
            float dsum = 0.f; f32x4 vv[4];
#pragma unroll
            for (int j = 0; j < 4; ++j) { const f32x4 u = ur[j * 64 + K.lane]; vv[j] = vr[j * 64 + K.lane]; dsum += u.x * hv[j].x + u.y * hv[j].y + u.z * hv[j].z + u.w * hv[j].w; }
            dsum = wave_sum(dsum);
            const float w = g * gelu_erf(dsum);
#pragma unroll
            for (int j = 0; j < 4; ++j) y[j] += vv[j] * w;
        }
        const float* gv = gate + (size_t)modvec_of_row(r) * 6 * D; f32x4* xr = (f32x4*)(K.X + (size_t)r * D);
#pragma unroll
        for (int j = 0; j < 4; ++j) { const f32x4 gg = ((const f32x4*)gv)[j * 64 + K.lane]; xr[j * 64 + K.lane] += gg * y[j]; }
    }
}

DI void ph_final(Ctx& K) {
    for (int r = K.gw; r < NLAT; r += K.ngw) {
        const f32x4* xr = (const f32x4*)(K.X + (size_t)(NCTX + r) * D); f32x4* o = (f32x4*)(K.a.out + (size_t)r * D);
        f32x4 v[4]; float ss = 0.f;
#pragma unroll
        for (int j = 0; j < 4; ++j) { v[j] = xr[j * 64 + K.lane]; ss += v[j].x * v[j].x + v[j].y * v[j].y + v[j].z * v[j].z + v[j].w * v[j].w; }
        ss = wave_sum(ss); const float rs = rsqrtf(ss * (1.0f / D) + EPS);
#pragma unroll
        for (int j = 0; j < 4; ++j) { const f32x4 w = ((const f32x4*)K.a.final_norm_w)[j * 64 + K.lane]; o[j * 64 + K.lane] = v[j] * rs * w; }
    }
}

constexpr int PH_PER_LAYER = 11, N_PHASES = 2 + PH_PER_LAYER * DEPTH;
__global__ void __launch_bounds__(NTHREADS) mk_fwd(Args args) {
    extern __shared__ __attribute__((aligned(16))) unsigned char lds[];
    cg::grid_group grid = cg::this_grid();
#pragma unroll 1
    for (int ph = 0; ph < N_PHASES; ++ph) {
        int tid = threadIdx.x; asm volatile("" : "+v"(tid));
        unsigned char* ws = args.ws; asm volatile("" : "+s"(ws));
        Ctx K; K.a = args; K.lds = lds; K.tid = tid; K.lane = tid & 63; K.wave = tid >> 6; K.gw = blockIdx.x * NWAVES + K.wave; K.ngw = gridDim.x * NWAVES;
        K.X = (float*)(ws + WS_X); K.H = (bf16_t*)(ws + WS_H); K.P = (bf16_t*)(ws + WS_P); K.QP = K.P; K.MIX = (bf16_t*)(ws + WS_MIX); K.OF = (float*)(ws + WS_OF); K.OB = (float*)(ws + WS_OB);
        K.PIDX = (int*)(ws + WS_PIDX); K.PG = (float*)(ws + WS_PG); K.MOD = (float*)(ws + WS_MOD); K.LB = (float*)(ws + WS_LB); K.ROPE = (float*)(ws + WS_ROPE);
        const int l = ph == 0 ? 0 : (ph - 1) / PH_PER_LAYER, k = ph == 0 ? -1 : (ph == N_PHASES - 1 ? -2 : (ph - 1) % PH_PER_LAYER);
        K.l = l;
        if (k == -1) ph_prologue(K);
        else if (k == -2) ph_final(K);
        else if (k == 0) ph_norm(K, args.norm_mix_w + (size_t)l * D, 0);
        else if (k == 1) ph_gemm<0>(K, K.H, args.w_in + (size_t)l * D * PW, PW, D, K.P);
        else if (k == 2) ph_rope(K);
        else if (k == 3) ph_hgrn_naive(K);
        else if (k == 4) ph_attn_naive(K);
        else if (k == 5) ph_hgrn_readout(K);
        else if (k == 6) ph_gemm<1>(K, K.MIX, args.w_out + (size_t)l * D * D, D, D, nullptr);
        else if (k == 7) ph_norm(K, args.norm_ffn_w + (size_t)l * D, 3);
        else if (k == 8) ph_gemm<0>(K, K.H, args.peer_wq + (size_t)l * D * 2048, 2048, D, K.QP);
        else if (k == 9) ph_peer_select(K);
        else if (k == 10) ph_peer_gather(K);
        if (k != 3) grid.sync();
    }
}

extern "C" void kernel_launch(void* const* d_in, const int* in_sizes, int n_in, void* d_out, int out_size, void* d_ws, size_t ws_size, hipStream_t stream) {
    static int grid = 0;
    if (grid == 0) {
        if (n_in != 19 || out_size != NLAT * D || ws_size < WS_END) { fprintf(stderr, "kernel_launch: unexpected shapes (n_in %d out %d ws %zu need %zu)\n", n_in, out_size, ws_size, (size_t)WS_END); grid = -1; return; }
        int dev = 0, cus = 0, per_cu = 0;
        (void)hipGetDevice(&dev); (void)hipDeviceGetAttribute(&cus, hipDeviceAttributeMultiprocessorCount, dev);
        (void)hipFuncSetAttribute((const void*)mk_fwd, hipFuncAttributeMaxDynamicSharedMemorySize, LDS_BYTES);
        (void)hipOccupancyMaxActiveBlocksPerMultiprocessor(&per_cu, (const void*)mk_fwd, NTHREADS, LDS_BYTES);
        if (per_cu < 1) { fprintf(stderr, "kernel_launch: occupancy query says %d blocks/CU\n", per_cu); grid = -1; return; }
        grid = cus;
    }
    if (grid < 0) return;
    Args a{};
    a.x = (const float*)d_in[0]; a.c = (const float*)d_in[1]; a.ctx = (const float*)d_in[2]; a.c_ctx = (const float*)d_in[3]; a.w_mod = (const float*)d_in[4]; a.b_mod = (const float*)d_in[5];
    a.norm_mix_w = (const float*)d_in[6]; a.norm_ffn_w = (const float*)d_in[7]; a.w_in = (const float*)d_in[8]; a.lb_logits = (const float*)d_in[9]; a.hgrn_norm_w = (const float*)d_in[10];
    a.swa_sink = (const float*)d_in[11]; a.nat_rpb = (const float*)d_in[12]; a.w_out = (const float*)d_in[13]; a.peer_wq = (const float*)d_in[14]; a.peer_sk = (const float*)d_in[15];
    a.peer_u = (const float*)d_in[16]; a.peer_v = (const float*)d_in[17]; a.final_norm_w = (const float*)d_in[18];
    a.out = (float*)d_out; a.ws = (unsigned char*)d_ws;
    void* kargs[] = {&a};
    hipError_t e = hipLaunchCooperativeKernel((const void*)mk_fwd, dim3(grid), dim3(NTHREADS), kargs, LDS_BYTES, stream);
    if (e != hipSuccess) fprintf(stderr, "kernel_launch: cooperative launch failed: %s (grid %d)\n", hipGetErrorString(e), grid);
}
```

```cpp
#include <hip/hip_runtime.h>
#include <hip/hip_cooperative_groups.h>
#include <cstdio>
#include <cstdint>
namespace cg = cooperative_groups;
#define DI __device__ __forceinline__

typedef unsigned short bf16_t;
typedef float f32x4 __attribute__((ext_vector_type(4)));
typedef unsigned u32x4 __attribute__((ext_vector_type(4)));
typedef unsigned u32x2 __attribute__((ext_vector_type(2)));

constexpr int D = 1024, NB = 2, L = 16384, CL = 256, DEPTH = 4;
constexpr int NCTX = NB * CL, NLAT = NB * L, M = NCTX + NLAT;
constexpr int PW = 3072;
constexpr int C_HQ = 0, C_ZF = 256, C_ZB = 512, C_HV = 768, C_HG = 1024, C_SQ = 1280, C_SK = 1664, C_SV = 1792, C_NQ = 1920, C_NK = 2304, C_NV = 2688;
constexpr int MX_H = 0, MX_S = 256, MX_N = 640;
constexpr float EPS = 1e-6f;
constexpr int NTHREADS = 512, NWAVES = 8;
constexpr int LDS_BYTES = 147456;

constexpr size_t al256(size_t x) { return (x + 255) & ~(size_t)255; }
constexpr size_t WS_X = 0;
constexpr size_t WS_H = WS_X + al256((size_t)M * D * 4);
constexpr size_t WS_P = WS_H + al256((size_t)M * D * 2);
constexpr size_t WS_MIX = WS_P + al256((size_t)M * PW * 2);
constexpr size_t WS_OF = WS_MIX + al256((size_t)M * D * 2);
constexpr size_t WS_OB = WS_OF + al256((size_t)M * 256 * 4);
constexpr size_t WS_PIDX = WS_OB + al256((size_t)M * 256 * 4);
constexpr size_t WS_PG = WS_PIDX + al256((size_t)M * 128 * 4);
constexpr size_t WS_MOD = WS_PG + al256((size_t)M * 128 * 4);
constexpr size_t WS_LB = WS_MOD + al256((size_t)DEPTH * 3 * 6 * D * 4);
constexpr size_t WS_ROPE = WS_LB + al256((size_t)2 * DEPTH * 256 * 4);
constexpr size_t WS_WIN = WS_ROPE + al256((size_t)(256 + 256 + 64 + 64) * 16 * 4);
constexpr size_t WS_WOUT = WS_WIN + al256((size_t)DEPTH * PW * D * 2);
constexpr size_t WS_WQ = WS_WOUT + al256((size_t)DEPTH * D * D * 2);
constexpr size_t WS_AC = WS_WQ + al256((size_t)DEPTH * 2048 * D * 2);
constexpr size_t WS_UB_ = 0; constexpr size_t WS_UB = WS_AC + al256((size_t)16 * 260 * 64 * 4); constexpr size_t WS_UB_OLD = WS_WQ + al256((size_t)DEPTH * 2048 * D * 2);
constexpr size_t WS_VB = WS_UB + al256((size_t)DEPTH * 16384 * D * 2);
constexpr size_t WS_END = WS_VB + al256((size_t)DEPTH * 16384 * D * 2);

struct Args {
    const float *x, *c, *ctx, *c_ctx, *w_mod, *b_mod, *norm_mix_w, *norm_ffn_w, *w_in, *lb_logits, *hgrn_norm_w, *swa_sink, *nat_rpb, *w_out, *peer_wq, *peer_sk, *peer_u, *peer_v, *final_norm_w;
    float* out; unsigned char* ws;
};

DI float bf2f(bf16_t v) { return __uint_as_float((unsigned)v << 16); }
DI bf16_t f2bf(float f) { unsigned u = __float_as_uint(f); return (bf16_t)((u + 0x7fffu + ((u >> 16) & 1u)) >> 16); }
DI unsigned pk2(float lo, float hi) { return (unsigned)f2bf(lo) | ((unsigned)f2bf(hi) << 16); }
DI float wave_sum(float v) {
#pragma unroll
    for (int o = 1; o < 64; o <<= 1) v += __shfl_xor(v, o);
    return v;
}
typedef __bf16 bf16x2_t __attribute__((ext_vector_type(2)));
DI float dot2bf(unsigned a, unsigned b, float acc) { return __builtin_amdgcn_fdot2_f32_bf16(__builtin_bit_cast(bf16x2_t, a), __builtin_bit_cast(bf16x2_t, b), acc, false); }
template <int CTRL> DI float dpp_(float x) { return __builtin_bit_cast(float, __builtin_amdgcn_mov_dpp(__builtin_bit_cast(int, x), CTRL, 0xf, 0xf, true)); }
DI float wave_sum_fast(float x) {
    x += dpp_<0xB1>(x); x += dpp_<0x4E>(x); x += dpp_<0x141>(x); x += dpp_<0x128>(x);
    auto s1 = __builtin_amdgcn_permlane16_swap(__float_as_uint(x), __float_as_uint(x), false, false); x = __uint_as_float(s1[0]) + __uint_as_float(s1[1]);
    auto s2 = __builtin_amdgcn_permlane32_swap(__float_as_uint(x), __float_as_uint(x), false, false); return __uint_as_float(s2[0]) + __uint_as_float(s2[1]);
}
DI float sigmoidf_(float z) { return 1.0f / (1.0f + __expf(-z)); }
DI float gelu_erf(float v) { return 0.5f * v * (1.0f + erff(v * 0.70710678118654752f)); }
DI int modvec_of_row(int r) { return r < NCTX ? 2 : (r - NCTX) / L; }
DI int batch_of_row(int r) { return r < NCTX ? r / CL : (r - NCTX) / L; }
DI int lat_row(int b, int t) { return NCTX + b * L + t; }
DI int ctx_row(int b, int s) { return b * CL + s; }
DI void unpack8(const u32x4 w, float* o) {
    o[0] = __uint_as_float(w.x << 16); o[1] = __uint_as_float(w.x & 0xffff0000u);
    o[2] = __uint_as_float(w.y << 16); o[3] = __uint_as_float(w.y & 0xffff0000u);
    o[4] = __uint_as_float(w.z << 16); o[5] = __uint_as_float(w.z & 0xffff0000u);
    o[6] = __uint_as_float(w.w << 16); o[7] = __uint_as_float(w.w & 0xffff0000u);
}
DI void load_row64(const bf16_t* p, float (&o)[64]) {
#pragma unroll
    for (int i = 0; i < 8; ++i) { const u32x4 w = *(const u32x4*)(p + 8 * i); unpack8(w, &o[8 * i]); }
}
DI void rope64(float (&x)[64], const float* cr, const float* sr, const float* cc, const float* sc) {
#pragma unroll
    for (int i = 0; i < 16; ++i) {
        const float c1 = cr[i], s1 = sr[i], a = x[i], b = x[16 + i];
        x[i] = a * c1 - b * s1; x[16 + i] = b * c1 + a * s1;
        const float c2 = cc[i], s2 = sc[i], e = x[32 + i], f = x[48 + i];
        x[32 + i] = e * c2 - f * s2; x[48 + i] = f * c2 + e * s2;
    }
}

namespace pg8 {
#define PG8_LAS __attribute__((address_space(3)))
typedef unsigned short bf16_t;
typedef short bf16x8 __attribute__((ext_vector_type(8)));
typedef float f32x4 __attribute__((ext_vector_type(4)));
typedef unsigned u32x4 __attribute__((ext_vector_type(4)));
constexpr int BM = 256, BK = 64, HALF = 128, HTB = HALF * BK * 2  , STAGE_BYTES = 8 * HTB, NXCD = 8, WGM = 8;

__host__ __device__ __forceinline__ int lds_byte(int r, int c) { const int st = (r >> 4) * 2 + (c >> 5), rr = r & 15, cc = c & 31, ob = rr * 64 + cc * 2; return st * 1024 + (ob ^ (((ob >> 9) & 1) << 5)); }
__host__ __device__ __forceinline__ void stage_rc(int b, int& R, int& C) { const int st = b / 1024, sb = b % 1024, swz = sb ^ (((sb >> 9) & 1) << 5); R = (st >> 1) * 16 + swz / 64; C = (st & 1) * 32 + (swz % 64) / 2; }
__host__ __device__ __forceinline__ int perm32(int rho) { const int n = rho >> 4, i = rho & 15; return 8 * (i >> 2) + 4 * n + (i & 3); }

struct Unit { int pm, pn; };
struct Gemm { const bf16_t* A; const bf16_t* Bt; int M, N, K; };

struct StaticOrder {
    int nM, nN, nwg, G, c;
    __host__ __device__ void init(int M, int N, int G_, int c_) { nM = M / BM; nN = N / BM; nwg = nM * nN; G = G_; c = c_; }
    __host__ __device__ bool next(int i, Unit& u) const {
        const long L = (long)i * G + c; if (L >= nwg) return false;
        int wgid = (int)L; { const int q = nwg / NXCD, r = nwg % NXCD, xcd = wgid % NXCD, off = wgid / NXCD; wgid = (xcd < r ? xcd * (q + 1) : r * (q + 1) + (xcd - r) * q) + off; }
        const int nig = WGM * nN, gid = wgid / nig, fm = gid * WGM, gsz = (nM - fm) < WGM ? (nM - fm) : WGM;
        u.pm = fm + ((wgid % nig) % gsz); u.pn = (wgid % nig) / gsz; return true;
    }
    __device__ __forceinline__ void a_ready(const Unit&) const {}
    __device__ __forceinline__ void done(const Unit&) const {}
};


__device__ __forceinline__ unsigned cvt_pk_bf16(float lo, float hi) { unsigned r; asm volatile("v_cvt_pk_bf16_f32 %0, %1, %2" : "=v"(r) : "v"(lo), "v"(hi)); return r; }
struct EpiStore {
    static constexpr bool PERM = true, AFTER_DRAIN = false;
    bf16_t* O; int ldc;
    __device__ __forceinline__ void operator()(const f32x4 (&acc)[2][2][4][2], const Unit& u, int wr, int wc, int fr, int fq) const {
        const int row0 = u.pm * BM + wr * 64 + fr, col0 = u.pn * BM + wc * 32 + 8 * fq;
#pragma unroll
        for (int ai = 0; ai < 2; ++ai)
#pragma unroll
            for (int m = 0; m < 4; ++m) { bf16_t* rowp = O + (size_t)(row0 + ai * HALF + m * 16) * ldc + col0;
#pragma unroll
                for (int bj = 0; bj < 2; ++bj) { const f32x4 v0 = acc[ai][bj][m][0], v1 = acc[ai][bj][m][1];
                    u32x4 w; w.x = cvt_pk_bf16(v0[0], v0[1]); w.y = cvt_pk_bf16(v0[2], v0[3]); w.z = cvt_pk_bf16(v1[0], v1[1]); w.w = cvt_pk_bf16(v1[2], v1[3]);
                    *(u32x4*)(rowp + bj * HALF) = w; } }
    }
};
struct EpiResid {
    static constexpr bool PERM = false, AFTER_DRAIN = false;
    float* X; int ldc; const float* gate; int gstride, nctx, seqlen;
    __device__ __forceinline__ void operator()(const f32x4 (&acc)[2][2][4][2], const Unit& u, int wr, int wc, int fr, int fq) const {
        const int col0 = u.pn * BM + wc * 32 + 4 * fq;
#pragma unroll
        for (int ai = 0; ai < 2; ++ai)
#pragma unroll
            for (int m = 0; m < 4; ++m) { const int r = u.pm * BM + ai * HALF + wr * 64 + m * 16 + fr; const int vsel = r < nctx ? 2 : (r - nctx) / seqlen;
                float* xr = X + (size_t)r * ldc + col0; const float* gr = gate + (size_t)vsel * gstride + col0;
#pragma unroll
                for (int bj = 0; bj < 2; ++bj)
#pragma unroll
                    for (int n = 0; n < 2; ++n) { const f32x4 g = *(const f32x4*)(gr + bj * HALF + n * 16); f32x4 x = *(const f32x4*)(xr + bj * HALF + n * 16); x += g * acc[ai][bj][m][n]; *(f32x4*)(xr + bj * HALF + n * 16) = x; } }
    }
};
template <class Epi, class Sched, bool ALIGN_EPI = false, bool SP2 = false>
__device__ __forceinline__ void gemm_phase(PG8_LAS unsigned char* lds, const Gemm g, const Sched& S, const Epi& E) {
    int tid_ = threadIdx.x; asm volatile("" : "+v"(tid_));
    const int tid = tid_, wid = __builtin_amdgcn_readfirstlane(tid >> 6), lane = tid & 63, wr = wid >> 2, wc = wid & 3, fr = lane & 15, fq = lane >> 4;
    const int K = g.K, nt = K / BK;
    unsigned voffA[2], voffB[2];
#pragma unroll
    for (int i = 0; i < 2; ++i) { int R, C; stage_rc(tid * 16 + i * 8192, R, C); const int Rb = Epi::PERM ? ((R & ~31) + perm32(R & 31)) : R;
        voffA[i] = (unsigned)(R * K + C) * 2u; voffB[i] = (unsigned)(Rb * K + C) * 2u; }
    const size_t kstep = (size_t)(BK * 2);
    const size_t hstep = (size_t)HALF * K * 2;
    const size_t tstep = 2 * hstep;
    const unsigned ldsw = (unsigned)wid * 1024u;
    const int aoff = lds_byte(wr * 64 + fr, fq * 8), boff = lds_byte(wc * 32 + fr, fq * 8);
#define PG8_SA(b, h) (((b) * 2 + (h)) * HTB)
#define PG8_SB(b, h) ((4 + (b) * 2 + (h)) * HTB)
#define PG8_STAGE(bufoff, gbase, voff) do { _Pragma("unroll") for (int _i = 0; _i < 2; ++_i) \
        __builtin_amdgcn_global_load_lds((const unsigned*)((const char*)(gbase) + (voff)[_i]), (PG8_LAS unsigned*)(lds + (bufoff) + ldsw + _i * 8192), 16, 0, 0); } while (0)
#define PG8_LDA(dst, b, h) do { _Pragma("unroll") for (int m = 0; m < 4; ++m) _Pragma("unroll") for (int k = 0; k < 2; ++k) dst[m][k] = *(const PG8_LAS bf16x8*)(lds + PG8_SA(b, h) + aoff + m * 2048 + k * 1024); } while (0)
#define PG8_LDB(dst, b, h) do { _Pragma("unroll") for (int n = 0; n < 2; ++n) _Pragma("unroll") for (int k = 0; k < 2; ++k) dst[n][k] = *(const PG8_LAS bf16x8*)(lds + PG8_SB(b, h) + boff + n * 2048 + k * 1024); } while (0)
#define PG8_MMA(ai, bj, At, Bt) do { __builtin_amdgcn_s_setprio(1); _Pragma("unroll") for (int m = 0; m < 4; ++m) _Pragma("unroll") for (int n = 0; n < 2; ++n) _Pragma("unroll") for (int k = 0; k < 2; ++k) \
        acc[ai][bj][m][n] = __builtin_amdgcn_mfma_f32_16x16x32_bf16(Bt[n][k], At[m][k], acc[ai][bj][m][n], 0, 0, 0); __builtin_amdgcn_s_setprio(0); } while (0)
#define PG8_WAIT_V(n) asm volatile("s_waitcnt vmcnt(" #n ")" ::: "memory")
#define PG8_WAIT_L(n) asm volatile("s_waitcnt lgkmcnt(" #n ")" ::: "memory")
#define PG8_BAR __builtin_amdgcn_s_barrier()
#define PG8_SCHED __builtin_amdgcn_sched_barrier(0)
    Unit cur, nxt; int ui = 0;
    if (!S.next(0, cur)) return;
    f32x4 acc[2][2][4][2];
#pragma unroll
    for (int a = 0; a < 2; ++a)
#pragma unroll
        for (int b = 0; b < 2; ++b)
#pragma unroll
            for (int m = 0; m < 4; ++m)
#pragma unroll
                for (int n = 0; n < 2; ++n) acc[a][b][m][n] = (f32x4){0.f, 0.f, 0.f, 0.f};
    bf16x8 At[4][2], B0[2][2], B1[2][2];
    const char* cA = (const char*)g.A + (size_t)cur.pm * tstep; const char* cB = (const char*)g.Bt + (size_t)cur.pn * tstep;
    S.a_ready(cur);
    if constexpr (SP2) {
        PG8_STAGE(PG8_SB(0, 0), cB, voffB); PG8_STAGE(PG8_SB(0, 1), cB + hstep, voffB); PG8_STAGE(PG8_SA(0, 0), cA, voffA); PG8_STAGE(PG8_SA(0, 1), cA + hstep, voffA);
        if (wr == 1) PG8_BAR;
        PG8_WAIT_V(2); PG8_BAR;
        PG8_STAGE(PG8_SB(1, 0), cB + kstep, voffB); PG8_STAGE(PG8_SA(1, 0), cA + kstep, voffA); PG8_STAGE(PG8_SB(1, 1), cB + hstep + kstep, voffB);
        PG8_WAIT_V(6); PG8_BAR;
    } else {
        PG8_STAGE(PG8_SB(0, 0), cB, voffB); PG8_STAGE(PG8_SA(0, 0), cA, voffA); PG8_STAGE(PG8_SB(0, 1), cB + hstep, voffB); PG8_STAGE(PG8_SA(0, 1), cA + hstep, voffA);
        if (wr == 1) PG8_BAR;
        PG8_WAIT_V(4); PG8_BAR;
        PG8_STAGE(PG8_SB(1, 0), cB + kstep, voffB); PG8_STAGE(PG8_SA(1, 0), cA + kstep, voffA); PG8_STAGE(PG8_SB(1, 1), cB + hstep + kstep, voffB);
        PG8_WAIT_V(6); PG8_BAR;
    }
    for (;;) {
        const bool has_next = S.next(ui + 1, nxt);
        const char* nA = has_next ? (const char*)g.A + (size_t)nxt.pm * tstep : cA; const char* nB = has_next ? (const char*)g.Bt + (size_t)nxt.pn * tstep : cB;
        for (int t = 0; t < nt; t += 2) {
            const bool last = (t == nt - 2);
            const char* a1 = cA + (size_t)(t + 1) * kstep;
            const char* a2 = last ? nA : cA + (size_t)(t + 2) * kstep; const char* b2 = last ? nB : cB + (size_t)(t + 2) * kstep;
            const char* a3 = a2 + kstep; const char* b3 = b2 + kstep;
            if (last && has_next) S.a_ready(nxt);
            if constexpr (SP2) {
            PG8_LDB(B0, 0, 0); PG8_LDB(B1, 0, 1); PG8_SCHED; PG8_LDA(At, 0, 0); PG8_STAGE(PG8_SA(1, 1), a1 + hstep, voffA);
            PG8_WAIT_V(8); PG8_WAIT_L(0); PG8_BAR; PG8_MMA(0, 0, At, B0); PG8_MMA(0, 1, At, B1); PG8_BAR; PG8_SCHED;
            PG8_LDA(At, 0, 1); PG8_STAGE(PG8_SB(0, 0), b2, voffB); PG8_STAGE(PG8_SB(0, 1), b2 + hstep, voffB); PG8_STAGE(PG8_SA(0, 0), a2, voffA);
            PG8_WAIT_V(8); PG8_WAIT_L(0); PG8_BAR; PG8_MMA(1, 0, At, B0); PG8_MMA(1, 1, At, B1); PG8_BAR; PG8_SCHED;
            PG8_LDB(B0, 1, 0); PG8_LDB(B1, 1, 1); PG8_SCHED; PG8_LDA(At, 1, 0); PG8_STAGE(PG8_SA(0, 1), a2 + hstep, voffA);
            PG8_WAIT_V(8); PG8_WAIT_L(0); PG8_BAR; PG8_MMA(0, 0, At, B0); PG8_MMA(0, 1, At, B1); PG8_BAR; PG8_SCHED;
            PG8_LDA(At, 1, 1); PG8_STAGE(PG8_SB(1, 0), b3, voffB); PG8_STAGE(PG8_SB(1, 1), b3 + hstep, voffB); PG8_STAGE(PG8_SA(1, 0), a3, voffA);
            PG8_WAIT_V(8); PG8_WAIT_L(0); PG8_BAR; PG8_MMA(1, 0, At, B0); PG8_MMA(1, 1, At, B1); PG8_BAR; PG8_SCHED;
            } else {
            PG8_LDB(B0, 0, 0); PG8_SCHED; PG8_LDA(At, 0, 0); PG8_STAGE(PG8_SA(1, 1), a1 + hstep, voffA);
            PG8_WAIT_L(8); PG8_BAR; PG8_WAIT_L(0); PG8_MMA(0, 0, At, B0); PG8_BAR; PG8_SCHED;
            PG8_LDB(B1, 0, 1); PG8_STAGE(PG8_SB(0, 0), b2, voffB);
            PG8_BAR; PG8_WAIT_L(0); PG8_MMA(0, 1, At, B1); PG8_BAR;
            PG8_LDA(At, 0, 1); PG8_STAGE(PG8_SA(0, 0), a2, voffA);
            PG8_BAR; PG8_WAIT_L(0); PG8_MMA(1, 0, At, B0); PG8_BAR; PG8_SCHED;
            PG8_STAGE(PG8_SB(0, 1), b2 + hstep, voffB);
            PG8_WAIT_V(6); PG8_BAR; PG8_MMA(1, 1, At, B1); PG8_BAR;
            PG8_LDB(B0, 1, 0); PG8_SCHED; PG8_LDA(At, 1, 0); PG8_STAGE(PG8_SA(0, 1), a2 + hstep, voffA);
            PG8_WAIT_L(8); PG8_BAR; PG8_WAIT_L(0); PG8_MMA(0, 0, At, B0); PG8_BAR; PG8_SCHED;
            PG8_LDB(B1, 1, 1); PG8_STAGE(PG8_SB(1, 0), b3, voffB);
            PG8_BAR; PG8_WAIT_L(0); PG8_MMA(0, 1, At, B1); PG8_BAR;
            PG8_LDA(At, 1, 1); PG8_STAGE(PG8_SA(1, 0), a3, voffA);
            PG8_BAR; PG8_WAIT_L(0); PG8_MMA(1, 0, At, B0); PG8_BAR; PG8_SCHED;
            PG8_STAGE(PG8_SB(1, 1), b3 + hstep, voffB);
            PG8_WAIT_V(6); PG8_BAR; PG8_MMA(1, 1, At, B1); PG8_BAR;
            }
        }
        if constexpr (ALIGN_EPI) { if (wr == 0) PG8_BAR; }
        if constexpr (!Epi::AFTER_DRAIN) { E(acc, cur, wr, wc, fr, fq); S.done(cur); }
        if (!has_next) break;
#pragma unroll
        for (int a = 0; a < 2; ++a)
#pragma unroll
            for (int b = 0; b < 2; ++b)
#pragma unroll
                for (int m = 0; m < 4; ++m)
#pragma unroll
                    for (int n = 0; n < 2; ++n) acc[a][b][m][n] = (f32x4){0.f, 0.f, 0.f, 0.f};
        cur = nxt; cA = nA; cB = nB; ++ui;
        if constexpr (ALIGN_EPI) { if (wr == 1) PG8_BAR; }
    }
    PG8_WAIT_V(0);
    if constexpr (!ALIGN_EPI) { if (wr == 0) PG8_BAR; }
    PG8_BAR;
    if constexpr (Epi::AFTER_DRAIN) { E.fused(acc, cur, wr, wc, fr, fq, lds, wid, lane); S.done(cur); }
#undef PG8_SA
#undef PG8_SB
#undef PG8_STAGE
#undef PG8_LDA
#undef PG8_LDB
#undef PG8_MMA
#undef PG8_WAIT_V
#undef PG8_WAIT_L
#undef PG8_BAR
#undef PG8_SCHED
}
}

struct Ctx {
    unsigned aoff; int l;
    float* X; bf16_t* H; bf16_t* P; bf16_t* MIX; bf16_t* QP; float* OF; float* OB; int* PIDX; float* PG; float* MOD; float* LB; float* ROPE; bf16_t* WIN; bf16_t* WOUT; bf16_t* WQ; bf16_t* UB; bf16_t* VB; float* ST; float* AC;
    unsigned char* lds; int tid, lane, wave, gw, ngw, bid, nb;
};

#define LAS __attribute__((address_space(3)))
DI void transpose_item(const float* W, int Kd, int N, bf16_t* WT, LAS float* scr, int item, int lane) {
    const int nblk = N / 32, kb = item / nblk, nb = item % nblk, k0 = 64 * kb, n0 = 32 * nb;
#pragma unroll 8
    for (int i = 0; i < 32; ++i) { const int kk = 2 * i + (lane >> 5); scr[kk * 33 + (lane & 31)] = W[(size_t)(k0 + kk) * N + n0 + (lane & 31)]; }
    asm volatile("s_waitcnt lgkmcnt(0)" ::: "memory");
    const int c = lane & 7;
#pragma unroll
    for (int j = 0; j < 4; ++j) { const int n = (lane >> 3) + 8 * j; const LAS float* sp = scr + (8 * c) * 33 + n;
        u32x4 o; o.x = pk2(sp[0 * 33], sp[1 * 33]); o.y = pk2(sp[2 * 33], sp[3 * 33]); o.z = pk2(sp[4 * 33], sp[5 * 33]); o.w = pk2(sp[6 * 33], sp[7 * 33]);
        *(u32x4*)(WT + (size_t)(n0 + n) * Kd + k0 + 8 * c) = o; }
    asm volatile("s_waitcnt lgkmcnt(0)" ::: "memory");
}

template <class T> DI T* argp_(const Ctx& K, unsigned off) {
    const unsigned* p = (const unsigned*)(K.lds + K.aoff + off);
    const unsigned lo = __builtin_amdgcn_readfirstlane(p[0]), hi = __builtin_amdgcn_readfirstlane(p[1]);
    return (T*)(((unsigned long long)hi << 32) | (unsigned long long)lo);
}
#define ARG(f) argp_<const float>(K, (unsigned)__builtin_offsetof(Args, f))

DI void ph_prologue(Ctx& K) {
    {
        LAS float* scr = (LAS float*)((LAS unsigned char*)K.lds + K.wave * 16384);
        constexpr int I_IN = (D / 64) * (PW / 32), I_OUT = (D / 64) * (D / 32), I_Q = (D / 64) * (2048 / 32), I_L = I_IN + I_OUT + I_Q;
        for (int it = K.gw; it < DEPTH * I_L; it += K.ngw) {
            const int l = it / I_L; int r = it % I_L;
            if (r < I_IN) { transpose_item(ARG(w_in) + (size_t)l * D * PW, D, PW, K.WIN + (size_t)l * PW * D, scr, r, K.lane); continue; } r -= I_IN;
            if (r < I_OUT) { transpose_item(ARG(w_out) + (size_t)l * D * D, D, D, K.WOUT + (size_t)l * D * D, scr, r, K.lane); continue; } r -= I_OUT;
            transpose_item(ARG(peer_wq) + (size_t)l * D * 2048, D, 2048, K.WQ + (size_t)l * 2048 * D, scr, r, K.lane);
        }
    }
    const size_t gt = (size_t)K.bid * NTHREADS + K.tid, gs = (size_t)K.nb * NTHREADS;
    { const f32x4* s0 = (const f32x4*)ARG(ctx); const f32x4* s1 = (const f32x4*)ARG(x); f32x4* d = (f32x4*)K.X;
      const size_t n0 = (size_t)NCTX * D / 4, n1 = (size_t)NLAT * D / 4;
      for (size_t i = gt; i < n0 + n1; i += gs) d[i] = i < n0 ? s0[i] : s1[i - n0]; }
    { const size_t n8 = (size_t)DEPTH * 16384 * D / 8;
      for (size_t i = gt; i < 2 * n8; i += gs) {
          const bool isv = i >= n8; const size_t j = isv ? i - n8 : i;
          const f32x4* src = (const f32x4*)(isv ? ARG(peer_v) : ARG(peer_u)) + 2 * j; const f32x4 a = src[0], b = src[1];
          u32x4 o; o.x = pk2(a.x, a.y); o.y = pk2(a.z, a.w); o.z = pk2(b.x, b.y); o.w = pk2(b.z, b.w);
          ((u32x4*)(isv ? K.VB : K.UB))[j] = o; } }
    { float* sv = (float*)K.lds;
      float* part = sv + 3 * D;
      __syncthreads();
      for (int i = K.tid; i < 3 * D; i += NTHREADS) { const int v = i / D, k = i % D; const float c = v < 2 ? ARG(c)[v * D + k] : ARG(c_ctx)[k]; sv[i] = c * sigmoidf_(c); }
      __syncthreads();
      for (int item = K.bid; item < DEPTH * 24; item += K.nb) {
          const int l = item / 24, cb = item % 24;
          const float* w = ARG(w_mod) + (size_t)l * D * 6 * D + cb * 256 + K.lane * 4;
          f32x4 a0 = {0.f, 0.f, 0.f, 0.f}, a1 = a0, a2 = a0;
#pragma unroll 8
          for (int kk = 0; kk < 128; ++kk) { const int k = K.wave * 128 + kk; const f32x4 wv = *(const f32x4*)(w + (size_t)k * 6 * D);
              a0 += wv * sv[k]; a1 += wv * sv[D + k]; a2 += wv * sv[2 * D + k]; }
          *(f32x4*)(part + (K.wave * 3 + 0) * 256 + K.lane * 4) = a0; *(f32x4*)(part + (K.wave * 3 + 1) * 256 + K.lane * 4) = a1; *(f32x4*)(part + (K.wave * 3 + 2) * 256 + K.lane * 4) = a2;
          __syncthreads();
          for (int i = K.tid; i < 768; i += NTHREADS) { const int v = i / 256, cc = i % 256; float sum = 0.f;
#pragma unroll
              for (int w8 = 0; w8 < 8; ++w8) sum += part[(w8 * 3 + v) * 256 + cc];
              const int col = cb * 256 + cc; K.MOD[((size_t)l * 3 + v) * 6 * D + col] = sum + ARG(b_mod)[(size_t)l * 6 * D + col]; }
          __syncthreads();
      } }
    for (size_t i = gt; i < 2 * 256; i += gs) {
        const int dir = (int)(i / 256), ch = (int)(i % 256);
        float lg[DEPTH], mx = -1e30f;
#pragma unroll
        for (int l = 0; l < DEPTH; ++l) { lg[l] = ARG(lb_logits)[((size_t)dir * DEPTH + l) * 256 + ch]; mx = fmaxf(mx, lg[l]); }
        float s = 0.f;
#pragma unroll
        for (int l = 0; l < DEPTH; ++l) { lg[l] = expf(lg[l] - mx); s += lg[l]; }
        float cum = 0.f;
#pragma unroll
        for (int l = 0; l < DEPTH; ++l) { if (l > 0) cum += lg[l] / s; K.LB[((size_t)dir * DEPTH + l) * 256 + ch] = cum; }
    }
    for (size_t i = gt; i < (256 + 64) * 16; i += gs) {
        const int pos = (int)(i / 16), f = (int)(i % 16);
        const float inv = powf(10000.0f, -(float)f / 16.0f);
        if (pos < 256) { const float ang = (float)pos * inv; K.ROPE[pos * 16 + f] = cosf(ang); K.ROPE[4096 + pos * 16 + f] = sinf(ang); }
        else { const int pc = pos - 256; const float ang = (float)pc * inv; K.ROPE[8192 + pc * 16 + f] = cosf(ang); K.ROPE[8192 + 1024 + pc * 16 + f] = sinf(ang); }
    }
}

DI void ph_norm(Ctx& K, const float* nw, int shift_chunk) {
    const float* modl = K.MOD + (size_t)K.l * 3 * 6 * D;
    for (int r = K.gw; r < M; r += K.ngw) {
        const f32x4* xr = (const f32x4*)(K.X + (size_t)r * D);
        f32x4 v[4]; float ss = 0.f;
#pragma unroll
        for (int j = 0; j < 4; ++j) { v[j] = xr[j * 64 + K.lane]; ss += v[j].x * v[j].x + v[j].y * v[j].y + v[j].z * v[j].z + v[j].w * v[j].w; }
        ss = wave_sum(ss);
        const float rs = rsqrtf(ss * (1.0f / D) + EPS);
        const float* mv = modl + (size_t)modvec_of_row(r) * 6 * D;
        u32x2* ho = (u32x2*)(K.H + (size_t)r * D);
#pragma unroll
        for (int j = 0; j < 4; ++j) {
            const int c4 = j * 64 + K.lane;
            const f32x4 w = ((const f32x4*)nw)[c4], sh = ((const f32x4*)(mv + shift_chunk * D))[c4], sc = ((const f32x4*)(mv + (shift_chunk + 1) * D))[c4];
            f32x4 y; y.x = v[j].x * rs * w.x * (1.f + sc.x) + sh.x; y.y = v[j].y * rs * w.y * (1.f + sc.y) + sh.y; y.z = v[j].z * rs * w.z * (1.f + sc.z) + sh.z; y.w = v[j].w * rs * w.w * (1.f + sc.w) + sh.w;
            u32x2 o; o.x = pk2(y.x, y.y); o.y = pk2(y.z, y.w); ho[c4] = o;
        }
    }
}

DI void ph_gemm_store(Ctx& K, const bf16_t* A, const bf16_t* Bt, int N, bf16_t* out) {
    pg8::Gemm g{A, Bt, M, N, D}; pg8::StaticOrder S; S.init(M, N, K.nb, K.bid);
    pg8::EpiStore E{out, N};
    pg8::gemm_phase<pg8::EpiStore, pg8::StaticOrder, true, true>((LAS unsigned char*)K.lds, g, S, E);
}
DI void ph_gemm_resid(Ctx& K, const bf16_t* A, const bf16_t* Bt, int chunk) {
    pg8::Gemm g{A, Bt, M, D, D}; pg8::StaticOrder S; S.init(M, D, K.nb, K.bid);
    pg8::EpiResid E{K.X, D, K.MOD + (size_t)K.l * 3 * 6 * D + (size_t)chunk * D, 6 * D, NCTX, L};
    pg8::gemm_phase<pg8::EpiResid, pg8::StaticOrder, true, true>((LAS unsigned char*)K.lds, g, S, E);
}

DI void ph_rope(Ctx& K) {
    const float* cosr = K.ROPE; const float* sinr = K.ROPE + 4096; const float* cosc = K.ROPE + 8192; const float* sinc = K.ROPE + 8192 + 1024;
    const size_t gt = (size_t)K.bid * NTHREADS + K.tid, gs = (size_t)K.nb * NTHREADS;
    for (size_t i = gt; i < (size_t)NLAT * 8 * 16; i += gs) {
        const int f = (int)(i & 15), hh = (int)((i >> 4) & 7), lr = (int)(i >> 7);
        const int t = lr % L, pr = t >> 6, pc = t & 63;
        bf16_t* p = K.P + (size_t)(NCTX + lr) * PW + (hh < 6 ? C_SQ + hh * 64 : C_SK + (hh - 6) * 64);
        const float c1 = cosr[pr * 16 + f], s1 = sinr[pr * 16 + f], c2 = cosc[pc * 16 + f], s2 = sinc[pc * 16 + f];
        const float a = bf2f(p[f]), b = bf2f(p[16 + f]), e = bf2f(p[32 + f]), g = bf2f(p[48 + f]);
        p[f] = f2bf(a * c1 - b * s1); p[16 + f] = f2bf(b * c1 + a * s1); p[32 + f] = f2bf(e * c2 - g * s2); p[48 + f] = f2bf(g * c2 + e * s2);
    }
}

typedef short bf16x8_t __attribute__((ext_vector_type(8)));
#define MFMA16(a, b, c) __builtin_amdgcn_mfma_f32_16x16x32_bf16((a), (b), (c), 0, 0, 0)
constexpr int HG_NCH = (CL + L) / 64;
constexpr int HG_LFS = 68;
constexpr int HG_TS = 72;
constexpr int HGL_LF = 0, HGL_OM = HGL_LF + 2 * 64 * HG_LFS * 4, HGL_VT = HGL_OM + 2 * 64 * HG_LFS * 4, HGL_KT = HGL_VT + 64 * HG_TS * 2, HGL_SC = HGL_KT, HGL_OD = HGL_SC + 8 * 16 * HG_TS * 2, HGL_END = HGL_OD + 2 * 64 * HG_LFS * 4;
static_assert(HGL_KT + 2 * 64 * HG_TS * 2 <= LDS_BYTES && HGL_END <= LDS_BYTES, "hgrn LDS map");
DI int hg_block_row(int b, int tb, int tok) { return tb < 4 ? ctx_row(b, tb * 64 + tok) : lat_row(b, (tb - 4) * 64 + tok); }
DI int hg_bwd_chunk(int tb) { return tb < 4 ? 3 - tb : 4 + 255 - (tb - 4); }
DI void hg_prep(Ctx& K, int b, int h, int tb) {
    float* LF = (float*)(K.lds + HGL_LF); float* OM = (float*)(K.lds + HGL_OM); bf16_t* VT = (bf16_t*)(K.lds + HGL_VT);
    const int tok = K.tid >> 3, c = K.tid & 7;
    const bf16_t* pr = K.P + (size_t)hg_block_row(b, tb, tok) * PW + h * 64 + 8 * c;
#pragma unroll
    for (int dir = 0; dir < 2; ++dir) {
        float z[8]; unpack8(*(const u32x4*)(pr + (dir ? C_ZB : C_ZF)), z);
        const float* lb = K.LB + ((size_t)dir * DEPTH + K.l) * 256 + h * 64 + 8 * c;
        float lf[8], om[8];
#pragma unroll
        for (int j = 0; j < 8; ++j) { const float lbv = lb[j], sg = sigmoidf_(z[j]); const float f = fmaxf(lbv + (1.f - lbv) * sg, 1e-30f); lf[j] = __logf(f); om[j] = (1.f - lbv) * (1.f - sg); }
        float* lfp = LF + (dir * 64 + tok) * HG_LFS + 8 * c; float* omp = OM + (dir * 64 + tok) * HG_LFS + 8 * c;
        *(f32x4*)lfp = (f32x4){lf[0], lf[1], lf[2], lf[3]}; *(f32x4*)(lfp + 4) = (f32x4){lf[4], lf[5], lf[6], lf[7]};
        *(f32x4*)omp = (f32x4){om[0], om[1], om[2], om[3]}; *(f32x4*)(omp + 4) = (f32x4){om[4], om[5], om[6], om[7]};
    }
    { const u32x4 v = *(const u32x4*)(pr + C_HV);
      const unsigned w[4] = {v.x, v.y, v.z, v.w};
#pragma unroll
      for (int j = 0; j < 4; ++j) { VT[(8 * c + 2 * j) * HG_TS + tok] = (bf16_t)(w[j] & 0xffffu); VT[(8 * c + 2 * j + 1) * HG_TS + tok] = (bf16_t)(w[j] >> 16); } }
    __syncthreads();
    if (K.tid < 128) {
        const int dir = K.tid >> 6, d = K.tid & 63; float* col = LF + dir * 64 * HG_LFS + d;
        float v[64];
#pragma unroll
        for (int p = 0; p < 64; ++p) v[p] = col[(dir ? 63 - p : p) * HG_LFS];
#pragma unroll
        for (int p = 1; p < 64; ++p) v[p] += v[p - 1];
#pragma unroll
        for (int p = 0; p < 64; ++p) col[(dir ? 63 - p : p) * HG_LFS] = v[p];
    }
    __syncthreads();
}
DI void ph_hgrn_A(Ctx& K) {
    float* LF = (float*)(K.lds + HGL_LF); float* OM = (float*)(K.lds + HGL_OM); bf16_t* VT = (bf16_t*)(K.lds + HGL_VT); bf16_t* KT = (bf16_t*)(K.lds + HGL_KT);
    const int r16 = K.lane & 15, g4 = K.lane >> 4;
    for (int item = K.bid; item < NB * 4 * HG_NCH; item += K.nb) {
        const int tb = item % HG_NCH, h = (item / HG_NCH) & 3, b = item / (HG_NCH * 4);
        __syncthreads();
        hg_prep(K, b, h, tb);
        { const int tok = K.tid >> 3, c = K.tid & 7;
#pragma unroll
          for (int dir = 0; dir < 2; ++dir) {
              const float* bl = LF + (dir * 64 + (dir ? 0 : 63)) * HG_LFS + 8 * c; const float* bt = LF + (dir * 64 + tok) * HG_LFS + 8 * c; const float* om = OM + (dir * 64 + tok) * HG_LFS + 8 * c;
#pragma unroll
              for (int j = 0; j < 8; ++j) KT[(dir * 64 + 8 * c + j) * HG_TS + tok] = f2bf(om[j] * __expf(bl[j] - bt[j]));
          }
          if (K.tid < 128) { const int dir = K.tid >> 6, d = K.tid & 63; const int chain = (b * 2 + dir) * 4 + h, ch = dir ? hg_bwd_chunk(tb) : tb;
              K.AC[((size_t)chain * HG_NCH + ch) * 64 + d] = __expf(LF[(dir * 64 + (dir ? 0 : 63)) * HG_LFS + d]); } }
        __syncthreads();
        { const int dir = K.wave >> 2, mi = K.wave & 3; const int chain = (b * 2 + dir) * 4 + h, ch = dir ? hg_bwd_chunk(tb) : tb;
          f32x4 acc[4];
#pragma unroll
          for (int nj = 0; nj < 4; ++nj) acc[nj] = (f32x4){0.f, 0.f, 0.f, 0.f};
#pragma unroll
          for (int ks = 0; ks < 2; ++ks) {
              const bf16x8_t av = *(const bf16x8_t*)(VT + (16 * mi + r16) * HG_TS + 32 * ks + 8 * g4);
#pragma unroll
              for (int nj = 0; nj < 4; ++nj) { const bf16x8_t bv = *(const bf16x8_t*)(KT + (dir * 64 + 16 * nj + r16) * HG_TS + 32 * ks + 8 * g4); acc[nj] = MFMA16(av, bv, acc[nj]); }
          }
          float* st = K.ST + ((size_t)chain * HG_NCH + ch) * 4096;
#pragma unroll
          for (int nj = 0; nj < 4; ++nj)
#pragma unroll
              for (int rg = 0; rg < 4; ++rg) st[(16 * mi + 4 * g4 + rg) * 64 + 16 * nj + r16] = acc[nj][rg];
        }
    }
}
DI void ph_hgrn_B(Ctx& K) {
    const int gt = K.bid * NTHREADS + K.tid;
    if (gt < 16 * 4096) {
        const int chain = gt >> 12, idx = gt & 4095, d = idx & 63;
        float* st = K.ST + (size_t)chain * HG_NCH * 4096 + idx; const float* ac = K.AC + (size_t)chain * HG_NCH * 64 + d;
        float S = 0.f;
#pragma unroll 1
        for (int c0 = 0; c0 < HG_NCH; c0 += 10) {
            float u[10], a[10];
#pragma unroll
            for (int i = 0; i < 10; ++i) { u[i] = st[(size_t)(c0 + i) * 4096]; a[i] = ac[(c0 + i) * 64]; }
#pragma unroll
            for (int i = 0; i < 10; ++i) { st[(size_t)(c0 + i) * 4096] = S; S = a[i] * S + u[i]; }
        }
    }
}
DI void ph_hgrn_C(Ctx& K) {
    float* LF = (float*)(K.lds + HGL_LF); float* OM = (float*)(K.lds + HGL_OM); bf16_t* VT = (bf16_t*)(K.lds + HGL_VT); float* OD = (float*)(K.lds + HGL_OD);
    bf16_t* SC = (bf16_t*)(K.lds + HGL_SC) + K.wave * 16 * HG_TS;
    const int r16 = K.lane & 15, g4 = K.lane >> 4;
    for (int item = K.bid; item < NB * 4 * HG_NCH; item += K.nb) {
        const int tb = item % HG_NCH, h = (item / HG_NCH) & 3, b = item / (HG_NCH * 4);
        __syncthreads();
        hg_prep(K, b, h, tb);
        { const int dir = K.wave >> 2, mi = K.wave & 3; const int chain = (b * 2 + dir) * 4 + h, ch = dir ? hg_bwd_chunk(tb) : tb;
          const float* LFd = LF + dir * 64 * HG_LFS; const float* OMd = OM + dir * 64 * HG_LFS; const float* ref = LFd + 32 * HG_LFS;
          bf16x8_t aq1[2], aq2[2];
          { const int t = 16 * mi + r16; const bf16_t* qr = K.P + (size_t)hg_block_row(b, tb, t) * PW + C_HQ + h * 64;
#pragma unroll
            for (int ks = 0; ks < 2; ++ks) { const int d0 = 32 * ks + 8 * g4; float q[8]; unpack8(*(const u32x4*)(qr + d0), q);
                u32x4 w1, w2; unsigned o1[4], o2[4];
#pragma unroll
                for (int j = 0; j < 4; ++j) { float x1[2], x2[2];
#pragma unroll
                    for (int e = 0; e < 2; ++e) { const int dd = d0 + 2 * j + e; const float qs = q[2 * j + e] * sigmoidf_(q[2 * j + e]); const float bt = LFd[t * HG_LFS + dd]; x1[e] = qs * __expf(bt - ref[dd]); x2[e] = qs * __expf(bt); }
                    o1[j] = pk2(x1[0], x1[1]); o2[j] = pk2(x2[0], x2[1]); }
                w1 = (u32x4){o1[0], o1[1], o1[2], o1[3]}; w2 = (u32x4){o2[0], o2[1], o2[2], o2[3]};
                aq1[ks] = __builtin_bit_cast(bf16x8_t, w1); aq2[ks] = __builtin_bit_cast(bf16x8_t, w2); } }
          f32x4 sc[4];
#pragma unroll
          for (int nj = 0; nj < 4; ++nj) { sc[nj] = (f32x4){0.f, 0.f, 0.f, 0.f}; const int s_ = 16 * nj + r16;
#pragma unroll
              for (int ks = 0; ks < 2; ++ks) { const int d0 = 32 * ks + 8 * g4; unsigned o[4];
#pragma unroll
                  for (int j = 0; j < 4; ++j) { const int dd = d0 + 2 * j; o[j] = pk2(OMd[s_ * HG_LFS + dd] * __expf(ref[dd] - LFd[s_ * HG_LFS + dd]), OMd[s_ * HG_LFS + dd + 1] * __expf(ref[dd + 1] - LFd[s_ * HG_LFS + dd + 1])); }
                  const u32x4 w = (u32x4){o[0], o[1], o[2], o[3]};
                  sc[nj] = MFMA16(aq1[ks], __builtin_bit_cast(bf16x8_t, w), sc[nj]); } }
#pragma unroll
          for (int nj = 0; nj < 4; ++nj)
#pragma unroll
              for (int rg = 0; rg < 4; ++rg) { const int tl = 4 * g4 + rg, t = 16 * mi + tl, s_ = 16 * nj + r16; const bool keep = dir ? (s_ >= t) : (s_ <= t);
                  SC[tl * HG_TS + s_] = f2bf(keep ? sc[nj][rg] : 0.f); }
          asm volatile("s_waitcnt lgkmcnt(0)" ::: "memory");
          f32x4 oacc[4];
#pragma unroll
          for (int nj = 0; nj < 4; ++nj) oacc[nj] = (f32x4){0.f, 0.f, 0.f, 0.f};
          const float* st = K.ST + ((size_t)chain * HG_NCH + ch) * 4096;
#pragma unroll
          for (int ks = 0; ks < 2; ++ks) {
              const bf16x8_t as = *(const bf16x8_t*)(SC + r16 * HG_TS + 32 * ks + 8 * g4);
#pragma unroll
              for (int nj = 0; nj < 4; ++nj) {
                  const bf16x8_t bv = *(const bf16x8_t*)(VT + (16 * nj + r16) * HG_TS + 32 * ks + 8 * g4);
                  oacc[nj] = MFMA16(as, bv, oacc[nj]);
                  const float* sp = st + (16 * nj + r16) * 64 + 32 * ks + 8 * g4; const f32x4 s0 = *(const f32x4*)sp, s1 = *(const f32x4*)(sp + 4);
                  const u32x4 w = (u32x4){pk2(s0.x, s0.y), pk2(s0.z, s0.w), pk2(s1.x, s1.y), pk2(s1.z, s1.w)};
                  oacc[nj] = MFMA16(aq2[ks], __builtin_bit_cast(bf16x8_t, w), oacc[nj]);
              }
          }
#pragma unroll
          for (int nj = 0; nj < 4; ++nj)
#pragma unroll
              for (int rg = 0; rg < 4; ++rg) OD[(dir * 64 + 16 * mi + 4 * g4 + rg) * HG_LFS + 16 * nj + r16] = oacc[nj][rg];
        }
        __syncthreads();
        { const int tok = K.tid >> 3, c = K.tid & 7; const int row = hg_block_row(b, tb, tok);
          const float* o0 = OD + tok * HG_LFS + 8 * c; const float* o1 = OD + (64 + tok) * HG_LFS + 8 * c;
          float o[8], ss = 0.f;
#pragma unroll
          for (int j = 0; j < 8; ++j) { o[j] = o0[j] + o1[j]; ss += o[j] * o[j]; }
          ss += __shfl_xor(ss, 1); ss += __shfl_xor(ss, 2); ss += __shfl_xor(ss, 4);
          const float rs = rsqrtf(ss * (1.0f / 64.0f) + EPS);
          float gq[8]; unpack8(*(const u32x4*)(K.P + (size_t)row * PW + C_HG + h * 64 + 8 * c), gq);
          const float* nw = ARG(hgrn_norm_w) + (size_t)K.l * 256 + h * 64 + 8 * c;
          float y[8];
#pragma unroll
          for (int j = 0; j < 8; ++j) y[j] = o[j] * rs * nw[j] * gq[j] * sigmoidf_(gq[j]);
          u32x4 w; w.x = pk2(y[0], y[1]); w.y = pk2(y[2], y[3]); w.z = pk2(y[4], y[5]); w.w = pk2(y[6], y[7]);
          *(u32x4*)(K.MIX + (size_t)row * D + MX_H + h * 64 + 8 * c) = w; }
    }
}

DI void att_step(const float (&q)[32], float (&acc)[32], float& m, float& lsum, const bf16_t* krow, const bf16_t* vrow, bool valid, float bias) {
    float s = 0.f;
#pragma unroll
    for (int i = 0; i < 4; ++i) { float kv[8]; unpack8(*(const u32x4*)(krow + 8 * i), kv);
#pragma unroll
        for (int j = 0; j < 8; ++j) s += q[8 * i + j] * kv[j]; }
    s += __shfl_xor(s, 32);
    s += bias;
    const float sv = valid ? s : -3.0e38f;
    const float mn = fmaxf(m, sv), alpha = __expf(m - mn), p = valid ? __expf(sv - mn) : 0.f;
    m = mn; lsum = lsum * alpha + p;
#pragma unroll
    for (int i = 0; i < 4; ++i) { float vv[8]; unpack8(*(const u32x4*)(vrow + 8 * i), vv);
#pragma unroll
        for (int j = 0; j < 8; ++j) acc[8 * i + j] = acc[8 * i + j] * alpha + p * vv[j]; }
}
DI void att_loadq(const bf16_t* p, float (&q)[32]) {
#pragma unroll
    for (int i = 0; i < 4; ++i) { float t[8]; unpack8(*(const u32x4*)(p + 8 * i), t);
#pragma unroll
        for (int j = 0; j < 8; ++j) q[8 * i + j] = t[j] * 0.125f; }
}
DI void att_store(bf16_t* o, const float (&acc)[32], float lsum) {
    const float inv = 1.0f / lsum;
#pragma unroll
    for (int i = 0; i < 4; ++i) { u32x4 w; w.x = pk2(acc[8 * i] * inv, acc[8 * i + 1] * inv); w.y = pk2(acc[8 * i + 2] * inv, acc[8 * i + 3] * inv); w.z = pk2(acc[8 * i + 4] * inv, acc[8 * i + 5] * inv); w.w = pk2(acc[8 * i + 6] * inv, acc[8 * i + 7] * inv); *(u32x4*)(o + 8 * i) = w; }
}
DI void ph_attn_naive(Ctx& K) {
    constexpr int G32 = L / 32, N_SWA = NB * 6 * G32, N_NAT = NB * 6 * G32, N_SC = NB * 6 * (CL / 32), N_NC = NB * 6 * (CL / 32);
    const int qi = K.lane & 31, hd = (K.lane >> 5) * 32;
    for (int item = K.gw; item < N_SWA + N_NAT + N_SC + N_NC; item += K.ngw) {
        float q[32], acc[32];
#pragma unroll
        for (int d = 0; d < 32; ++d) acc[d] = 0.f;
        if (item < N_SWA) {
            const int qg = item % G32, hq = (item / G32) % 6, b = item / G32 / 6, kvh = hq / 3;
            const int t = qg * 32 + qi, row = lat_row(b, t);
            att_loadq(K.P + (size_t)row * PW + C_SQ + hq * 64 + hd, q);
            float m = ARG(swa_sink)[K.l * 6 + hq], lsum = 1.0f;
            const int s_lo = max(0, qg * 32 - 128), s_hi = min(L - 1, qg * 32 + 31 + 128);
            for (int s = s_lo; s <= s_hi; ++s) {
                const bf16_t* pr = K.P + (size_t)lat_row(b, s) * PW;
                const int dlt = t - s; const bool valid = dlt <= 128 && dlt >= -128;
                att_step(q, acc, m, lsum, pr + C_SK + kvh * 64 + hd, pr + C_SV + kvh * 64 + hd, valid, 0.f);
            }
            for (int s = 0; s < CL; ++s) {
                const bf16_t* pr = K.P + (size_t)ctx_row(b, s) * PW;
                att_step(q, acc, m, lsum, pr + C_SK + kvh * 64 + hd, pr + C_SV + kvh * 64 + hd, true, 0.f);
            }
            att_store(K.MIX + (size_t)row * D + MX_S + hq * 64 + hd, acc, lsum);
        } else if (item < N_SWA + N_NAT) {
            const int it = item - N_SWA, g = it % G32, r = g >> 1, half = g & 1, h = (it / G32) % 6, b = it / G32 / 6;
            const int c = half * 32 + qi, row = lat_row(b, r * 64 + c);
            att_loadq(K.P + (size_t)row * PW + C_NQ + h * 64 + hd, q);
            float m = -1.0e30f, lsum = 0.f;
            const int rs = min(max(r - 4, 0), L / 64 - 8), ws = min(max(c - 8, 0), 48);
            const float* rpb = ARG(nat_rpb) + ((size_t)K.l * 6 + h) * 15 * 31;
            const int kc_lo = half ? 24 : 0, kc_hi = half ? 63 : 39;
            for (int kr = 0; kr < 8; ++kr)
                for (int kc = kc_lo; kc <= kc_hi; ++kc) {
                    const bf16_t* pr = K.P + (size_t)lat_row(b, (rs + kr) * 64 + kc) * PW;
                    const bool valid = kc >= ws && kc < ws + 16;
                    const float bias = valid ? rpb[(rs + kr - r + 7) * 31 + (kc - c + 15)] : 0.f;
                    att_step(q, acc, m, lsum, pr + C_NK + h * 64 + hd, pr + C_NV + h * 64 + hd, valid, bias);
                }
            for (int s = 0; s < CL; ++s) {
                const bf16_t* pr = K.P + (size_t)ctx_row(b, s) * PW;
                att_step(q, acc, m, lsum, pr + C_NK + h * 64 + hd, pr + C_NV + h * 64 + hd, true, 0.f);
            }
            att_store(K.MIX + (size_t)row * D + MX_N + h * 64 + hd, acc, lsum);
        } else {
            const int it = item - N_SWA - N_NAT; const bool nat = it >= N_SC; const int i2 = nat ? it - N_SC : it;
            const int g = i2 % (CL / 32), h = (i2 / (CL / 32)) % 6, b = i2 / (CL / 32) / 6;
            const int row = ctx_row(b, g * 32 + qi);
            const int cq = (nat ? C_NQ + h * 64 : C_SQ + h * 64) + hd, ck = (nat ? C_NK + h * 64 : C_SK + (h / 3) * 64) + hd, cv = (nat ? C_NV + h * 64 : C_SV + (h / 3) * 64) + hd;
            att_loadq(K.P + (size_t)row * PW + cq, q);
            float m = nat ? -1.0e30f : ARG(swa_sink)[K.l * 6 + h], lsum = nat ? 0.f : 1.0f;
            for (int s = 0; s < CL; ++s) {
                const bf16_t* pr = K.P + (size_t)ctx_row(b, s) * PW;
                att_step(q, acc, m, lsum, pr + ck, pr + cv, true, 0.f);
            }
            att_store(K.MIX + (size_t)row * D + (nat ? MX_N : MX_S) + h * 64 + hd, acc, lsum);
        }
    }
}

DI unsigned fkey(float f) { const unsigned u = __float_as_uint(f); return (u & 0x80000000u) ? ~u : (u | 0x80000000u); }
DI int mbcnt64(unsigned long long m) { return (int)__builtin_amdgcn_mbcnt_hi((unsigned)(m >> 32), __builtin_amdgcn_mbcnt_lo((unsigned)m, 0u)); }
template <int NV> DI unsigned radix_thr16(const unsigned (&k)[NV]) {
    unsigned prefix = 0u;
#pragma unroll 1
    for (int bit = 31; bit >= 0; --bit) {
        const unsigned cand = prefix | (1u << bit); int cnt = 0;
#pragma unroll
        for (int i = 0; i < NV; ++i) cnt += __popcll(__ballot(k[i] >= cand));
        if (cnt >= 16) { prefix = cand; if (cnt == 16) break; }
    }
    return prefix;
}
template <int NV> DI void select16(const unsigned (&k)[NV], unsigned T, bool (&sel)[NV], int (&pos)[NV]) {
    int ngt = 0; unsigned long long gtm[NV], eqm[NV];
#pragma unroll
    for (int i = 0; i < NV; ++i) { gtm[i] = __ballot(k[i] > T); eqm[i] = __ballot(k[i] == T); ngt += __popcll(gtm[i]); }
    const int need = 16 - ngt; int eqbase = 0, selbase = 0;
#pragma unroll
    for (int i = 0; i < NV; ++i) {
        const bool iseq = k[i] == T; const int erank = eqbase + mbcnt64(eqm[i]); eqbase += __popcll(eqm[i]);
        sel[i] = (k[i] > T) || (iseq && erank < need);
        const unsigned long long sm = __ballot(sel[i]); pos[i] = selbase + mbcnt64(sm); selbase += __popcll(sm);
    }
}
constexpr int PS_SCS = 132;
constexpr int PSL_TOP = 8 * 2 * 16 * PS_SCS * 4;
static_assert(PSL_TOP + 8 * 256 <= LDS_BYTES - 256, "peer select LDS map");
DI void ph_peer_select(Ctx& K) {
    const float* SKl = ARG(peer_sk) + (size_t)K.l * 8 * 2 * 128 * 128;
    float* SCR = (float*)K.lds + K.wave * 2 * 16 * PS_SCS; float* TOPV = (float*)(K.lds + PSL_TOP + K.wave * 256); int* TOPI = (int*)(TOPV + 32);
    const int r16 = K.lane & 15, g4 = K.lane >> 4, h = K.wave;
    for (int item = K.bid; item < M / 16; item += K.nb) {
        const int t0 = item * 16;
#pragma unroll 1
        for (int p = 0; p < 2; ++p) {
            float a[32];
            { const bf16_t* qp = K.QP + (size_t)(t0 + r16) * 2048 + h * 256 + p * 128 + 32 * g4;
#pragma unroll
              for (int i = 0; i < 4; ++i) unpack8(*(const u32x4*)(qp + 8 * i), &a[8 * i]); }
            const float* skp = SKl + (((size_t)h * 2 + p) * 128 + r16) * 128 + 32 * g4;
#pragma unroll 1
            for (int nt = 0; nt < 8; nt += 2) {
                float b0[32], b1[32];
#pragma unroll
                for (int i = 0; i < 8; ++i) { const f32x4 v0 = *(const f32x4*)(skp + (size_t)(16 * nt) * 128 + 4 * i), v1 = *(const f32x4*)(skp + (size_t)(16 * nt + 16) * 128 + 4 * i);
                    b0[4 * i] = v0.x; b0[4 * i + 1] = v0.y; b0[4 * i + 2] = v0.z; b0[4 * i + 3] = v0.w; b1[4 * i] = v1.x; b1[4 * i + 1] = v1.y; b1[4 * i + 2] = v1.z; b1[4 * i + 3] = v1.w; }
                f32x4 c0 = {0.f, 0.f, 0.f, 0.f}, c1 = c0;
#pragma unroll
                for (int s_ = 0; s_ < 32; ++s_) { c0 = __builtin_amdgcn_mfma_f32_16x16x4f32(a[s_], b0[s_], c0, 0, 0, 0); c1 = __builtin_amdgcn_mfma_f32_16x16x4f32(a[s_], b1[s_], c1, 0, 0, 0); }
#pragma unroll
                for (int rg = 0; rg < 4; ++rg) { SCR[(p * 16 + 4 * g4 + rg) * PS_SCS + 16 * nt + r16] = c0[rg]; SCR[(p * 16 + 4 * g4 + rg) * PS_SCS + 16 * nt + 16 + r16] = c1[rg]; }
            }
        }
        asm volatile("s_waitcnt lgkmcnt(0)" ::: "memory");
#pragma unroll 1
        for (int tk = 0; tk < 16; ++tk) {
            const int r = t0 + tk;
#pragma unroll
            for (int p = 0; p < 2; ++p) {
                float v[2]; v[0] = SCR[(p * 16 + tk) * PS_SCS + K.lane]; v[1] = SCR[(p * 16 + tk) * PS_SCS + 64 + K.lane];
                unsigned kk[2] = {fkey(v[0]), fkey(v[1])};
                const unsigned T = radix_thr16<2>(kk);
                bool sel[2]; int pos[2]; select16<2>(kk, T, sel, pos);
#pragma unroll
                for (int i = 0; i < 2; ++i) if (sel[i]) { TOPV[p * 16 + pos[i]] = v[i]; TOPI[p * 16 + pos[i]] = K.lane + 64 * i; }
            }
            asm volatile("s_waitcnt lgkmcnt(0)" ::: "memory");
            float cv[4]; int ce[4]; unsigned ck[4];
            { const float vb = TOPV[16 + r16]; const int ib = TOPI[16 + r16];
#pragma unroll
              for (int i = 0; i < 4; ++i) { const int aidx = g4 + 4 * i; cv[i] = TOPV[aidx] + vb; ce[i] = TOPI[aidx] * 128 + ib; ck[i] = fkey(cv[i]); } }
            const unsigned T = radix_thr16<4>(ck);
            bool sel[4]; int pos[4]; select16<4>(ck, T, sel, pos);
            float mx = -3.0e38f;
#pragma unroll
            for (int i = 0; i < 4; ++i) mx = fmaxf(mx, sel[i] ? cv[i] : -3.0e38f);
            mx = fmaxf(mx, dpp_<0xB1>(mx)); mx = fmaxf(mx, dpp_<0x4E>(mx)); mx = fmaxf(mx, dpp_<0x141>(mx)); mx = fmaxf(mx, dpp_<0x128>(mx));
            { auto s1 = __builtin_amdgcn_permlane16_swap(__float_as_uint(mx), __float_as_uint(mx), false, false); mx = fmaxf(__uint_as_float(s1[0]), __uint_as_float(s1[1]));
              auto s2 = __builtin_amdgcn_permlane32_swap(__float_as_uint(mx), __float_as_uint(mx), false, false); mx = fmaxf(__uint_as_float(s2[0]), __uint_as_float(s2[1])); }
            float ex[4], es = 0.f;
#pragma unroll
            for (int i = 0; i < 4; ++i) { ex[i] = sel[i] ? __expf(cv[i] - mx) : 0.f; es += ex[i]; }
            es = wave_sum_fast(es);
            const float inv = 1.0f / es;
#pragma unroll
            for (int i = 0; i < 4; ++i) if (sel[i]) { K.PIDX[(size_t)r * 128 + h * 16 + pos[i]] = ce[i]; K.PG[(size_t)r * 128 + h * 16 + pos[i]] = ex[i] * inv; }
            asm volatile("s_waitcnt lgkmcnt(0)" ::: "memory");
        }
    }
}

DI void ph_peer_gather(Ctx& K) {
    const bf16_t* U = K.UB + (size_t)K.l * 16384 * D; const bf16_t* V = K.VB + (size_t)K.l * 16384 * D;
    const float* gate = K.MOD + (size_t)K.l * 3 * 6 * D + 5 * D;
    for (int r = K.gw; r < M; r += K.ngw) {
        const u32x4 h0 = *(const u32x4*)(K.H + (size_t)r * D + K.lane * 8), h1 = *(const u32x4*)(K.H + (size_t)r * D + 512 + K.lane * 8);
        const int ia = K.PIDX[(size_t)r * 128 + K.lane], ib = K.PIDX[(size_t)r * 128 + 64 + K.lane];
        const float ga = K.PG[(size_t)r * 128 + K.lane], gb = K.PG[(size_t)r * 128 + 64 + K.lane];
        float y[16];
#pragma unroll
        for (int i = 0; i < 16; ++i) y[i] = 0.f;
#pragma unroll 1
        for (int k0 = 0; k0 < 128; k0 += 4) {
            u32x4 ua[4], ub[4], va[4], vb[4]; float g[4];
#pragma unroll
            for (int j = 0; j < 4; ++j) {
                const int kk = (k0 + j) & 63;
                const int e = k0 < 64 ? __builtin_amdgcn_readlane(ia, kk) : __builtin_amdgcn_readlane(ib, kk);
                g[j] = __uint_as_float(k0 < 64 ? __builtin_amdgcn_readlane(__float_as_uint(ga), kk) : __builtin_amdgcn_readlane(__float_as_uint(gb), kk));
                const bf16_t* ur = U + (size_t)e * D + K.lane * 8; const bf16_t* vr = V + (size_t)e * D + K.lane * 8;
                ua[j] = *(const u32x4*)ur; ub[j] = *(const u32x4*)(ur + 512); va[j] = *(const u32x4*)vr; vb[j] = *(const u32x4*)(vr + 512);
            }
#pragma unroll
            for (int j = 0; j < 4; ++j) {
                float d = dot2bf(ua[j].x, h0.x, 0.f); d = dot2bf(ua[j].y, h0.y, d); d = dot2bf(ua[j].z, h0.z, d); d = dot2bf(ua[j].w, h0.w, d);
                d = dot2bf(ub[j].x, h1.x, d); d = dot2bf(ub[j].y, h1.y, d); d = dot2bf(ub[j].z, h1.z, d); d = dot2bf(ub[j].w, h1.w, d);
                d = wave_sum_fast(d);
                const float w = g[j] * gelu_erf(d);
                float t[8];
                unpack8(va[j], t);
#pragma unroll
                for (int i = 0; i < 8; ++i) y[i] += w * t[i];
                unpack8(vb[j], t);
#pragma unroll
                for (int i = 0; i < 8; ++i) y[8 + i] += w * t[i];
            }
        }
        const float* gv = gate + (size_t)modvec_of_row(r) * 6 * D; float* xr = K.X + (size_t)r * D;
#pragma unroll
        for (int hh = 0; hh < 2; ++hh)
#pragma unroll
            for (int q4 = 0; q4 < 2; ++q4) { const int c0 = hh * 512 + K.lane * 8 + q4 * 4; const f32x4 gg = *(const f32x4*)(gv + c0); f32x4 xv = *(const f32x4*)(xr + c0);
                xv.x += gg.x * y[hh * 8 + q4 * 4 + 0]; xv.y += gg.y * y[hh * 8 + q4 * 4 + 1]; xv.z += gg.z * y[hh * 8 + q4 * 4 + 2]; xv.w += gg.w * y[hh * 8 + q4 * 4 + 3]; *(f32x4*)(xr + c0) = xv; }
    }
}

DI void ph_final(Ctx& K) {
    for (int r = K.gw; r < NLAT; r += K.ngw) {
        const f32x4* xr = (const f32x4*)(K.X + (size_t)(NCTX + r) * D); f32x4* o = (f32x4*)(((float*)argp_<float>(K, (unsigned)__builtin_offsetof(Args, out))) + (size_t)r * D);
        f32x4 v[4]; float ss = 0.f;
#pragma unroll
        for (int j = 0; j < 4; ++j) { v[j] = xr[j * 64 + K.lane]; ss += v[j].x * v[j].x + v[j].y * v[j].y + v[j].z * v[j].z + v[j].w * v[j].w; }
        ss = wave_sum(ss); const float rs = rsqrtf(ss * (1.0f / D) + EPS);
#pragma unroll
        for (int j = 0; j < 4; ++j) { const f32x4 w = ((const f32x4*)ARG(final_norm_w))[j * 64 + K.lane]; o[j * 64 + K.lane] = v[j] * rs * w; }
    }
}

constexpr int PH_PER_LAYER = 12, N_PHASES = 2 + PH_PER_LAYER * DEPTH;
__global__ void __launch_bounds__(NTHREADS) mk_fwd(Args args) {
    extern __shared__ __attribute__((aligned(16))) unsigned char lds[];
    cg::grid_group grid = cg::this_grid();
    constexpr unsigned ARGS_OFF = LDS_BYTES - 256;
    if (threadIdx.x == 0) *(Args*)(lds + ARGS_OFF) = args;
    __syncthreads();
#pragma unroll 1
    for (int ph = 0; ph < N_PHASES; ++ph) {
        int tid = threadIdx.x; asm volatile("" : "+v"(tid));
        unsigned aoff = ARGS_OFF; asm volatile("" : "+v"(aoff));
        unsigned char* ws = args.ws; asm volatile("" : "+s"(ws));
        int bid = blockIdx.x; asm volatile("" : "+s"(bid)); int nb = gridDim.x; asm volatile("" : "+s"(nb));
        Ctx K; K.aoff = aoff; K.lds = lds; K.tid = tid; K.lane = tid & 63; K.wave = tid >> 6; K.bid = bid; K.nb = nb; K.gw = bid * NWAVES + K.wave; K.ngw = nb * NWAVES;
        K.X = (float*)(ws + WS_X); K.H = (bf16_t*)(ws + WS_H); K.P = (bf16_t*)(ws + WS_P); K.QP = K.P; K.MIX = (bf16_t*)(ws + WS_MIX); K.OF = (float*)(ws + WS_OF); K.OB = (float*)(ws + WS_OB);
        K.PIDX = (int*)(ws + WS_PIDX); K.PG = (float*)(ws + WS_PG); K.MOD = (float*)(ws + WS_MOD); K.LB = (float*)(ws + WS_LB); K.ROPE = (float*)(ws + WS_ROPE); K.WIN = (bf16_t*)(ws + WS_WIN); K.WOUT = (bf16_t*)(ws + WS_WOUT); K.WQ = (bf16_t*)(ws + WS_WQ); K.UB = (bf16_t*)(ws + WS_UB); K.ST = (float*)(ws + WS_OF); K.AC = (float*)(ws + WS_AC); K.VB = (bf16_t*)(ws + WS_VB);
        const int l = ph == 0 ? 0 : (ph - 1) / PH_PER_LAYER, k = ph == 0 ? -1 : (ph == N_PHASES - 1 ? -2 : (ph - 1) % PH_PER_LAYER);
        K.l = l;
        if (k == -1) ph_prologue(K);
        else if (k == -2) ph_final(K);
        else if (k == 0) ph_norm(K, ARG(norm_mix_w) + (size_t)l * D, 0);
        else if (k == 1) ph_gemm_store(K, K.H, K.WIN + (size_t)l * PW * D, PW, K.P);
        else if (k == 2) ph_rope(K);
        else if (k == 3) ph_hgrn_A(K);
        else if (k == 4) ph_attn_naive(K);
        else if (k == 5) ph_hgrn_B(K);
        else if (k == 6) ph_hgrn_C(K);
        else if (k == 7) ph_gemm_resid(K, K.MIX, K.WOUT + (size_t)l * D * D, 2);
        else if (k == 8) ph_norm(K, ARG(norm_ffn_w) + (size_t)l * D, 3);
        else if (k == 9) ph_gemm_store(K, K.H, K.WQ + (size_t)l * 2048 * D, 2048, K.QP);
        else if (k == 10) ph_peer_select(K);
        else if (k == 11) ph_peer_gather(K);
        if (k != 3) grid.sync();
    }
}

extern "C" void kernel_launch(void* const* d_in, const int* in_sizes, int n_in, void* d_out, int out_size, void* d_ws, size_t ws_size, hipStream_t stream) {
    static int grid = 0;
    if (grid == 0) {
        if (n_in != 19 || out_size != NLAT * D || ws_size < WS_END) { fprintf(stderr, "kernel_launch: unexpected shapes (n_in %d out %d ws %zu need %zu)\n", n_in, out_size, ws_size, (size_t)WS_END); grid = -1; return; }
        int dev = 0, cus = 0, per_cu = 0;
        (void)hipGetDevice(&dev); (void)hipDeviceGetAttribute(&cus, hipDeviceAttributeMultiprocessorCount, dev);
        (void)hipFuncSetAttribute((const void*)mk_fwd, hipFuncAttributeMaxDynamicSharedMemorySize, LDS_BYTES);
        (void)hipOccupancyMaxActiveBlocksPerMultiprocessor(&per_cu, (const void*)mk_fwd, NTHREADS, LDS_BYTES);
        if (per_cu < 1) { fprintf(stderr, "kernel_launch: occupancy query says %d blocks/CU\n", per_cu); grid = -1; return; }
        grid = cus;
    }
    if (grid < 0) return;
    Args a{};
    a.x = (const float*)d_in[0]; a.c = (const float*)d_in[1]; a.ctx = (const float*)d_in[2]; a.c_ctx = (const float*)d_in[3]; a.w_mod = (const float*)d_in[4]; a.b_mod = (const float*)d_in[5];
    a.norm_mix_w = (const float*)d_in[6]; a.norm_ffn_w = (const float*)d_in[7]; a.w_in = (const float*)d_in[8]; a.lb_logits = (const float*)d_in[9]; a.hgrn_norm_w = (const float*)d_in[10];
    a.swa_sink = (const float*)d_in[11]; a.nat_rpb = (const float*)d_in[12]; a.w_out = (const float*)d_in[13]; a.peer_wq = (const float*)d_in[14]; a.peer_sk = (const float*)d_in[15];
    a.peer_u = (const float*)d_in[16]; a.peer_v = (const float*)d_in[17]; a.final_norm_w = (const float*)d_in[18];
    a.out = (float*)d_out; a.ws = (unsigned char*)d_ws;
    void* kargs[] = {&a};
    hipError_t e = hipLaunchCooperativeKernel((const void*)mk_fwd, dim3(grid), dim3(NTHREADS), kargs, LDS_BYTES, stream);
    if (e != hipSuccess) fprintf(stderr, "kernel_launch: cooperative launch failed: %s (grid %d)\n", hipGetErrorString(e), grid);
}
```

```cpp
#include <hip/hip_runtime.h>
#include <hip/hip_cooperative_groups.h>
#include <cstdio>
#include <cstdint>
namespace cg = cooperative_groups;
#define DI __device__ __forceinline__

typedef unsigned short bf16_t;
typedef float f32x4 __attribute__((ext_vector_type(4)));
typedef unsigned u32x4 __attribute__((ext_vector_type(4)));
typedef unsigned u32x2 __attribute__((ext_vector_type(2)));

constexpr int D = 1024, NB = 2, L = 16384, CL = 256, DEPTH = 4;
constexpr int NCTX = NB * CL, NLAT = NB * L, M = NCTX + NLAT;
constexpr int PW = 3072;
constexpr int C_HQ = 0, C_ZF = 256, C_ZB = 512, C_HV = 768, C_HG = 1024, C_SQ = 1280, C_SK = 1664, C_SV = 1792, C_NQ = 1920, C_NK = 2304, C_NV = 2688;
constexpr int MX_H = 0, MX_S = 256, MX_N = 640;
constexpr float EPS = 1e-6f;
constexpr int NTHREADS = 512, NWAVES = 8;
constexpr int LDS_BYTES = 147456;

constexpr size_t al256(size_t x) { return (x + 255) & ~(size_t)255; }
constexpr size_t WS_X = 0;
constexpr size_t WS_H = WS_X + al256((size_t)M * D * 4);
constexpr size_t WS_P = WS_H + al256((size_t)M * D * 2);
constexpr size_t WS_MIX = WS_P + al256((size_t)M * PW * 2);
constexpr size_t WS_OF = WS_MIX + al256((size_t)M * D * 2);
constexpr size_t WS_OB = WS_OF + al256((size_t)M * 256 * 4);
constexpr size_t WS_PIDX = WS_OB + al256((size_t)M * 256 * 4);
constexpr size_t WS_PG = WS_PIDX + al256((size_t)M * 128 * 4);
constexpr size_t WS_MOD = WS_PG + al256((size_t)M * 128 * 4);
constexpr size_t WS_LB = WS_MOD + al256((size_t)DEPTH * 3 * 6 * D * 4);
constexpr size_t WS_ROPE = WS_LB + al256((size_t)2 * DEPTH * 256 * 4);
constexpr size_t WS_WIN = WS_ROPE + al256((size_t)(256 + 256 + 64 + 64) * 16 * 4);
constexpr size_t WS_WOUT = WS_WIN + al256((size_t)DEPTH * PW * D * 2);
constexpr size_t WS_WQ = WS_WOUT + al256((size_t)DEPTH * D * D * 2);
constexpr size_t WS_AC = WS_WQ + al256((size_t)DEPTH * 2048 * D * 2);
constexpr size_t WS_UB_ = 0; constexpr size_t WS_UB = WS_AC + al256((size_t)16 * 260 * 64 * 4); constexpr size_t WS_UB_OLD = WS_WQ + al256((size_t)DEPTH * 2048 * D * 2);
constexpr size_t WS_VB = WS_UB + al256((size_t)DEPTH * 16384 * D * 2);
constexpr size_t WS_END = WS_VB + al256((size_t)DEPTH * 16384 * D * 2);

struct Args {
    const float *x, *c, *ctx, *c_ctx, *w_mod, *b_mod, *norm_mix_w, *norm_ffn_w, *w_in, *lb_logits, *hgrn_norm_w, *swa_sink, *nat_rpb, *w_out, *peer_wq, *peer_sk, *peer_u, *peer_v, *final_norm_w;
    float* out; unsigned char* ws;
};

DI float bf2f(bf16_t v) { return __uint_as_float((unsigned)v << 16); }
DI bf16_t f2bf(float f) { unsigned u = __float_as_uint(f); return (bf16_t)((u + 0x7fffu + ((u >> 16) & 1u)) >> 16); }
DI unsigned pk2(float lo, float hi) { return (unsigned)f2bf(lo) | ((unsigned)f2bf(hi) << 16); }
DI float wave_sum(float v) {
#pragma unroll
    for (int o = 1; o < 64; o <<= 1) v += __shfl_xor(v, o);
    return v;
}
typedef __bf16 bf16x2_t __attribute__((ext_vector_type(2)));
DI float dot2bf(unsigned a, unsigned b, float acc) { return __builtin_amdgcn_fdot2_f32_bf16(__builtin_bit_cast(bf16x2_t, a), __builtin_bit_cast(bf16x2_t, b), acc, false); }
template <int CTRL> DI float dpp_(float x) { return __builtin_bit_cast(float, __builtin_amdgcn_mov_dpp(__builtin_bit_cast(int, x), CTRL, 0xf, 0xf, true)); }
DI float wave_sum_fast(float x) {
    x += dpp_<0xB1>(x); x += dpp_<0x4E>(x); x += dpp_<0x141>(x); x += dpp_<0x128>(x);
    auto s1 = __builtin_amdgcn_permlane16_swap(__float_as_uint(x), __float_as_uint(x), false, false); x = __uint_as_float(s1[0]) + __uint_as_float(s1[1]);
    auto s2 = __builtin_amdgcn_permlane32_swap(__float_as_uint(x), __float_as_uint(x), false, false); return __uint_as_float(s2[0]) + __uint_as_float(s2[1]);
}
DI float sigmoidf_(float z) { return 1.0f / (1.0f + __expf(-z)); }
DI float gelu_erf(float v) { return 0.5f * v * (1.0f + erff(v * 0.70710678118654752f)); }
DI int modvec_of_row(int r) { return r < NCTX ? 2 : (r - NCTX) / L; }
DI int batch_of_row(int r) { return r < NCTX ? r / CL : (r - NCTX) / L; }
DI int lat_row(int b, int t) { return NCTX + b * L + t; }
DI int ctx_row(int b, int s) { return b * CL + s; }
DI void unpack8(const u32x4 w, float* o) {
    o[0] = __uint_as_float(w.x << 16); o[1] = __uint_as_float(w.x & 0xffff0000u);
    o[2] = __uint_as_float(w.y << 16); o[3] = __uint_as_float(w.y & 0xffff0000u);
    o[4] = __uint_as_float(w.z << 16); o[5] = __uint_as_float(w.z & 0xffff0000u);
    o[6] = __uint_as_float(w.w << 16); o[7] = __uint_as_float(w.w & 0xffff0000u);
}
DI void load_row64(const bf16_t* p, float (&o)[64]) {
#pragma unroll
    for (int i = 0; i < 8; ++i) { const u32x4 w = *(const u32x4*)(p + 8 * i); unpack8(w, &o[8 * i]); }
}
DI void rope64(float (&x)[64], const float* cr, const float* sr, const float* cc, const float* sc) {
#pragma unroll
    for (int i = 0; i < 16; ++i) {
        const float c1 = cr[i], s1 = sr[i], a = x[i], b = x[16 + i];
        x[i] = a * c1 - b * s1; x[16 + i] = b * c1 + a * s1;
        const float c2 = cc[i], s2 = sc[i], e = x[32 + i], f = x[48 + i];
        x[32 + i] = e * c2 - f * s2; x[48 + i] = f * c2 + e * s2;
    }
}

namespace pg8 {
#define PG8_LAS __attribute__((address_space(3)))
typedef unsigned short bf16_t;
typedef short bf16x8 __attribute__((ext_vector_type(8)));
typedef float f32x4 __attribute__((ext_vector_type(4)));
typedef unsigned u32x4 __attribute__((ext_vector_type(4)));
constexpr int BM = 256, BK = 64, HALF = 128, HTB = HALF * BK * 2  , STAGE_BYTES = 8 * HTB, NXCD = 8, WGM = 8;

__host__ __device__ __forceinline__ int lds_byte(int r, int c) { const int st = (r >> 4) * 2 + (c >> 5), rr = r & 15, cc = c & 31, ob = rr * 64 + cc * 2; return st * 1024 + (ob ^ (((ob >> 9) & 1) << 5)); }
__host__ __device__ __forceinline__ void stage_rc(int b, int& R, int& C) { const int st = b / 1024, sb = b % 1024, swz = sb ^ (((sb >> 9) & 1) << 5); R = (st >> 1) * 16 + swz / 64; C = (st & 1) * 32 + (swz % 64) / 2; }
__host__ __device__ __forceinline__ int perm32(int rho) { const int n = rho >> 4, i = rho & 15; return 8 * (i >> 2) + 4 * n + (i & 3); }

struct Unit { int pm, pn; };
struct Gemm { const bf16_t* A; const bf16_t* Bt; int M, N, K; };

struct StaticOrder {
    int nM, nN, nwg, G, c;
    __host__ __device__ void init(int M, int N, int G_, int c_) { nM = M / BM; nN = N / BM; nwg = nM * nN; G = G_; c = c_; }
    __host__ __device__ bool next(int i, Unit& u) const {
        const long L = (long)i * G + c; if (L >= nwg) return false;
        int wgid = (int)L; { const int q = nwg / NXCD, r = nwg % NXCD, xcd = wgid % NXCD, off = wgid / NXCD; wgid = (xcd < r ? xcd * (q + 1) : r * (q + 1) + (xcd - r) * q) + off; }
        const int nig = WGM * nN, gid = wgid / nig, fm = gid * WGM, gsz = (nM - fm) < WGM ? (nM - fm) : WGM;
        u.pm = fm + ((wgid % nig) % gsz); u.pn = (wgid % nig) / gsz; return true;
    }
    __device__ __forceinline__ void a_ready(const Unit&) const {}
    __device__ __forceinline__ void done(const Unit&) const {}
};


__device__ __forceinline__ unsigned cvt_pk_bf16(float lo, float hi) { unsigned r; asm volatile("v_cvt_pk_bf16_f32 %0, %1, %2" : "=v"(r) : "v"(lo), "v"(hi)); return r; }
struct EpiStore {
    static constexpr bool PERM = true, AFTER_DRAIN = false;
    bf16_t* O; int ldc;
    __device__ __forceinline__ void operator()(const f32x4 (&acc)[2][2][4][2], const Unit& u, int wr, int wc, int fr, int fq) const {
        const int row0 = u.pm * BM + wr * 64 + fr, col0 = u.pn * BM + wc * 32 + 8 * fq;
#pragma unroll
        for (int ai = 0; ai < 2; ++ai)
#pragma unroll
            for (int m = 0; m < 4; ++m) { bf16_t* rowp = O + (size_t)(row0 + ai * HALF + m * 16) * ldc + col0;
#pragma unroll
                for (int bj = 0; bj < 2; ++bj) { const f32x4 v0 = acc[ai][bj][m][0], v1 = acc[ai][bj][m][1];
                    u32x4 w; w.x = cvt_pk_bf16(v0[0], v0[1]); w.y = cvt_pk_bf16(v0[2], v0[3]); w.z = cvt_pk_bf16(v1[0], v1[1]); w.w = cvt_pk_bf16(v1[2], v1[3]);
                    *(u32x4*)(rowp + bj * HALF) = w; } }
    }
};
struct EpiResid {
    static constexpr bool PERM = false, AFTER_DRAIN = false;
    float* X; int ldc; const float* gate; int gstride, nctx, seqlen;
    __device__ __forceinline__ void operator()(const f32x4 (&acc)[2][2][4][2], const Unit& u, int wr, int wc, int fr, int fq) const {
        const int col0 = u.pn * BM + wc * 32 + 4 * fq;
#pragma unroll
        for (int ai = 0; ai < 2; ++ai)
#pragma unroll
            for (int m = 0; m < 4; ++m) { const int r = u.pm * BM + ai * HALF + wr * 64 + m * 16 + fr; const int vsel = r < nctx ? 2 : (r - nctx) / seqlen;
                float* xr = X + (size_t)r * ldc + col0; const float* gr = gate + (size_t)vsel * gstride + col0;
#pragma unroll
                for (int bj = 0; bj < 2; ++bj)
#pragma unroll
                    for (int n = 0; n < 2; ++n) { const f32x4 g = *(const f32x4*)(gr + bj * HALF + n * 16); f32x4 x = *(const f32x4*)(xr + bj * HALF + n * 16); x += g * acc[ai][bj][m][n]; *(f32x4*)(xr + bj * HALF + n * 16) = x; } }
    }
};
template <class Epi, class Sched, bool ALIGN_EPI = false, bool SP2 = false>
__device__ __forceinline__ void gemm_phase(PG8_LAS unsigned char* lds, const Gemm g, const Sched& S, const Epi& E) {
    int tid_ = threadIdx.x; asm volatile("" : "+v"(tid_));
    const int tid = tid_, wid = __builtin_amdgcn_readfirstlane(tid >> 6), lane = tid & 63, wr = wid >> 2, wc = wid & 3, fr = lane & 15, fq = lane >> 4;
    const int K = g.K, nt = K / BK;
    unsigned voffA[2], voffB[2];
#pragma unroll
    for (int i = 0; i < 2; ++i) { int R, C; stage_rc(tid * 16 + i * 8192, R, C); const int Rb = Epi::PERM ? ((R & ~31) + perm32(R & 31)) : R;
        voffA[i] = (unsigned)(R * K + C) * 2u; voffB[i] = (unsigned)(Rb * K + C) * 2u; }
    const size_t kstep = (size_t)(BK * 2);
    const size_t hstep = (size_t)HALF * K * 2;
    const size_t tstep = 2 * hstep;
    const unsigned ldsw = (unsigned)wid * 1024u;
    const int aoff = lds_byte(wr * 64 + fr, fq * 8), boff = lds_byte(wc * 32 + fr, fq * 8);
#define PG8_SA(b, h) (((b) * 2 + (h)) * HTB)
#define PG8_SB(b, h) ((4 + (b) * 2 + (h)) * HTB)
#define PG8_STAGE(bufoff, gbase, voff) do { _Pragma("unroll") for (int _i = 0; _i < 2; ++_i) \
        __builtin_amdgcn_global_load_lds((const unsigned*)((const char*)(gbase) + (voff)[_i]), (PG8_LAS unsigned*)(lds + (bufoff) + ldsw + _i * 8192), 16, 0, 0); } while (0)
#define PG8_LDA(dst, b, h) do { _Pragma("unroll") for (int m = 0; m < 4; ++m) _Pragma("unroll") for (int k = 0; k < 2; ++k) dst[m][k] = *(const PG8_LAS bf16x8*)(lds + PG8_SA(b, h) + aoff + m * 2048 + k * 1024); } while (0)
#define PG8_LDB(dst, b, h) do { _Pragma("unroll") for (int n = 0; n < 2; ++n) _Pragma("unroll") for (int k = 0; k < 2; ++k) dst[n][k] = *(const PG8_LAS bf16x8*)(lds + PG8_SB(b, h) + boff + n * 2048 + k * 1024); } while (0)
#define PG8_MMA(ai, bj, At, Bt) do { __builtin_amdgcn_s_setprio(1); _Pragma("unroll") for (int m = 0; m < 4; ++m) _Pragma("unroll") for (int n = 0; n < 2; ++n) _Pragma("unroll") for (int k = 0; k < 2; ++k) \
        acc[ai][bj][m][n] = __builtin_amdgcn_mfma_f32_16x16x32_bf16(Bt[n][k], At[m][k], acc[ai][bj][m][n], 0, 0, 0); __builtin_amdgcn_s_setprio(0); } while (0)
#define PG8_WAIT_V(n) asm volatile("s_waitcnt vmcnt(" #n ")" ::: "memory")
#define PG8_WAIT_L(n) asm volatile("s_waitcnt lgkmcnt(" #n ")" ::: "memory")
#define PG8_BAR __builtin_amdgcn_s_barrier()
#define PG8_SCHED __builtin_amdgcn_sched_barrier(0)
    Unit cur, nxt; int ui = 0;
    if (!S.next(0, cur)) return;
    f32x4 acc[2][2][4][2];
#pragma unroll
    for (int a = 0; a < 2; ++a)
#pragma unroll
        for (int b = 0; b < 2; ++b)
#pragma unroll
            for (int m = 0; m < 4; ++m)
#pragma unroll
                for (int n = 0; n < 2; ++n) acc[a][b][m][n] = (f32x4){0.f, 0.f, 0.f, 0.f};
    bf16x8 At[4][2], B0[2][2], B1[2][2];
    const char* cA = (const char*)g.A + (size_t)cur.pm * tstep; const char* cB = (const char*)g.Bt + (size_t)cur.pn * tstep;
    S.a_ready(cur);
    if constexpr (SP2) {
        PG8_STAGE(PG8_SB(0, 0), cB, voffB); PG8_STAGE(PG8_SB(0, 1), cB + hstep, voffB); PG8_STAGE(PG8_SA(0, 0), cA, voffA); PG8_STAGE(PG8_SA(0, 1), cA + hstep, voffA);
        if (wr == 1) PG8_BAR;
        PG8_WAIT_V(2); PG8_BAR;
        PG8_STAGE(PG8_SB(1, 0), cB + kstep, voffB); PG8_STAGE(PG8_SA(1, 0), cA + kstep, voffA); PG8_STAGE(PG8_SB(1, 1), cB + hstep + kstep, voffB);
        PG8_WAIT_V(6); PG8_BAR;
    } else {
        PG8_STAGE(PG8_SB(0, 0), cB, voffB); PG8_STAGE(PG8_SA(0, 0), cA, voffA); PG8_STAGE(PG8_SB(0, 1), cB + hstep, voffB); PG8_STAGE(PG8_SA(0, 1), cA + hstep, voffA);
        if (wr == 1) PG8_BAR;
        PG8_WAIT_V(4); PG8_BAR;
        PG8_STAGE(PG8_SB(1, 0), cB + kstep, voffB); PG8_STAGE(PG8_SA(1, 0), cA + kstep, voffA); PG8_STAGE(PG8_SB(1, 1), cB + hstep + kstep, voffB);
        PG8_WAIT_V(6); PG8_BAR;
    }
    for (;;) {
        const bool has_next = S.next(ui + 1, nxt);
        const char* nA = has_next ? (const char*)g.A + (size_t)nxt.pm * tstep : cA; const char* nB = has_next ? (const char*)g.Bt + (size_t)nxt.pn * tstep : cB;
        for (int t = 0; t < nt; t += 2) {
            const bool last = (t == nt - 2);
            const char* a1 = cA + (size_t)(t + 1) * kstep;
            const char* a2 = last ? nA : cA + (size_t)(t + 2) * kstep; const char* b2 = last ? nB : cB + (size_t)(t + 2) * kstep;
            const char* a3 = a2 + kstep; const char* b3 = b2 + kstep;
            if (last && has_next) S.a_ready(nxt);
            if constexpr (SP2) {
            PG8_LDB(B0, 0, 0); PG8_LDB(B1, 0, 1); PG8_SCHED; PG8_LDA(At, 0, 0); PG8_STAGE(PG8_SA(1, 1), a1 + hstep, voffA);
            PG8_WAIT_V(8); PG8_WAIT_L(0); PG8_BAR; PG8_MMA(0, 0, At, B0); PG8_MMA(0, 1, At, B1); PG8_BAR; PG8_SCHED;
            PG8_LDA(At, 0, 1); PG8_STAGE(PG8_SB(0, 0), b2, voffB); PG8_STAGE(PG8_SB(0, 1), b2 + hstep, voffB); PG8_STAGE(PG8_SA(0, 0), a2, voffA);
            PG8_WAIT_V(8); PG8_WAIT_L(0); PG8_BAR; PG8_MMA(1, 0, At, B0); PG8_MMA(1, 1, At, B1); PG8_BAR; PG8_SCHED;
            PG8_LDB(B0, 1, 0); PG8_LDB(B1, 1, 1); PG8_SCHED; PG8_LDA(At, 1, 0); PG8_STAGE(PG8_SA(0, 1), a2 + hstep, voffA);
            PG8_WAIT_V(8); PG8_WAIT_L(0); PG8_BAR; PG8_MMA(0, 0, At, B0); PG8_MMA(0, 1, At, B1); PG8_BAR; PG8_SCHED;
            PG8_LDA(At, 1, 1); PG8_STAGE(PG8_SB(1, 0), b3, voffB); PG8_STAGE(PG8_SB(1, 1), b3 + hstep, voffB); PG8_STAGE(PG8_SA(1, 0), a3, voffA);
            PG8_WAIT_V(8); PG8_WAIT_L(0); PG8_BAR; PG8_MMA(1, 0, At, B0); PG8_MMA(1, 1, At, B1); PG8_BAR; PG8_SCHED;
            } else {
            PG8_LDB(B0, 0, 0); PG8_SCHED; PG8_LDA(At, 0, 0); PG8_STAGE(PG8_SA(1, 1), a1 + hstep, voffA);
            PG8_WAIT_L(8); PG8_BAR; PG8_WAIT_L(0); PG8_MMA(0, 0, At, B0); PG8_BAR; PG8_SCHED;
            PG8_LDB(B1, 0, 1); PG8_STAGE(PG8_SB(0, 0), b2, voffB);
            PG8_BAR; PG8_WAIT_L(0); PG8_MMA(0, 1, At, B1); PG8_BAR;
            PG8_LDA(At, 0, 1); PG8_STAGE(PG8_SA(0, 0), a2, voffA);
            PG8_BAR; PG8_WAIT_L(0); PG8_MMA(1, 0, At, B0); PG8_BAR; PG8_SCHED;
            PG8_STAGE(PG8_SB(0, 1), b2 + hstep, voffB);
            PG8_WAIT_V(6); PG8_BAR; PG8_MMA(1, 1, At, B1); PG8_BAR;
            PG8_LDB(B0, 1, 0); PG8_SCHED; PG8_LDA(At, 1, 0); PG8_STAGE(PG8_SA(0, 1), a2 + hstep, voffA);
            PG8_WAIT_L(8); PG8_BAR; PG8_WAIT_L(0); PG8_MMA(0, 0, At, B0); PG8_BAR; PG8_SCHED;
            PG8_LDB(B1, 1, 1); PG8_STAGE(PG8_SB(1, 0), b3, voffB);
            PG8_BAR; PG8_WAIT_L(0); PG8_MMA(0, 1, At, B1); PG8_BAR;
            PG8_LDA(At, 1, 1); PG8_STAGE(PG8_SA(1, 0), a3, voffA);
            PG8_BAR; PG8_WAIT_L(0); PG8_MMA(1, 0, At, B0); PG8_BAR; PG8_SCHED;
            PG8_STAGE(PG8_SB(1, 1), b3 + hstep, voffB);
            PG8_WAIT_V(6); PG8_BAR; PG8_MMA(1, 1, At, B1); PG8_BAR;
            }
        }
        if constexpr (ALIGN_EPI) { if (wr == 0) PG8_BAR; }
        if constexpr (!Epi::AFTER_DRAIN) { E(acc, cur, wr, wc, fr, fq); S.done(cur); }
        if (!has_next) break;
#pragma unroll
        for (int a = 0; a < 2; ++a)
#pragma unroll
            for (int b = 0; b < 2; ++b)
#pragma unroll
                for (int m = 0; m < 4; ++m)
#pragma unroll
                    for (int n = 0; n < 2; ++n) acc[a][b][m][n] = (f32x4){0.f, 0.f, 0.f, 0.f};
        cur = nxt; cA = nA; cB = nB; ++ui;
        if constexpr (ALIGN_EPI) { if (wr == 1) PG8_BAR; }
    }
    PG8_WAIT_V(0);
    if constexpr (!ALIGN_EPI) { if (wr == 0) PG8_BAR; }
    PG8_BAR;
    if constexpr (Epi::AFTER_DRAIN) { E.fused(acc, cur, wr, wc, fr, fq, lds, wid, lane); S.done(cur); }
#undef PG8_SA
#undef PG8_SB
#undef PG8_STAGE
#undef PG8_LDA
#undef PG8_LDB
#undef PG8_MMA
#undef PG8_WAIT_V
#undef PG8_WAIT_L
#undef PG8_BAR
#undef PG8_SCHED
}
}

struct Ctx {
    unsigned aoff; int l;
    float* X; bf16_t* H; bf16_t* P; bf16_t* MIX; bf16_t* QP; float* OF; float* OB; int* PIDX; float* PG; float* MOD; float* LB; float* ROPE; bf16_t* WIN; bf16_t* WOUT; bf16_t* WQ; bf16_t* UB; bf16_t* VB; float* ST; float* AC;
    unsigned char* lds; int tid, lane, wave, gw, ngw, bid, nb;
};

#define LAS __attribute__((address_space(3)))
DI void transpose_item(const float* W, int Kd, int N, bf16_t* WT, LAS float* scr, int item, int lane) {
    const int nblk = N / 32, kb = item / nblk, nb = item % nblk, k0 = 64 * kb, n0 = 32 * nb;
#pragma unroll 8
    for (int i = 0; i < 32; ++i) { const int kk = 2 * i + (lane >> 5); scr[kk * 33 + (lane & 31)] = W[(size_t)(k0 + kk) * N + n0 + (lane & 31)]; }
    asm volatile("s_waitcnt lgkmcnt(0)" ::: "memory");
    const int c = lane & 7;
#pragma unroll
    for (int j = 0; j < 4; ++j) { const int n = (lane >> 3) + 8 * j; const LAS float* sp = scr + (8 * c) * 33 + n;
        u32x4 o; o.x = pk2(sp[0 * 33], sp[1 * 33]); o.y = pk2(sp[2 * 33], sp[3 * 33]); o.z = pk2(sp[4 * 33], sp[5 * 33]); o.w = pk2(sp[6 * 33], sp[7 * 33]);
        *(u32x4*)(WT + (size_t)(n0 + n) * Kd + k0 + 8 * c) = o; }
    asm volatile("s_waitcnt lgkmcnt(0)" ::: "memory");
}

template <class T> DI T* argp_(const Ctx& K, unsigned off) {
    const unsigned* p = (const unsigned*)(K.lds + K.aoff + off);
    const unsigned lo = __builtin_amdgcn_readfirstlane(p[0]), hi = __builtin_amdgcn_readfirstlane(p[1]);
    return (T*)(((unsigned long long)hi << 32) | (unsigned long long)lo);
}
#define ARG(f) argp_<const float>(K, (unsigned)__builtin_offsetof(Args, f))

DI void ph_prologue(Ctx& K) {
    {
        LAS float* scr = (LAS float*)((LAS unsigned char*)K.lds + K.wave * 16384);
        constexpr int I_IN = (D / 64) * (PW / 32), I_OUT = (D / 64) * (D / 32), I_Q = (D / 64) * (2048 / 32), I_L = I_IN + I_OUT + I_Q;
        for (int it = K.gw; it < DEPTH * I_L; it += K.ngw) {
            const int l = it / I_L; int r = it % I_L;
            if (r < I_IN) { transpose_item(ARG(w_in) + (size_t)l * D * PW, D, PW, K.WIN + (size_t)l * PW * D, scr, r, K.lane); continue; } r -= I_IN;
            if (r < I_OUT) { transpose_item(ARG(w_out) + (size_t)l * D * D, D, D, K.WOUT + (size_t)l * D * D, scr, r, K.lane); continue; } r -= I_OUT;
            transpose_item(ARG(peer_wq) + (size_t)l * D * 2048, D, 2048, K.WQ + (size_t)l * 2048 * D, scr, r, K.lane);
        }
    }
    const size_t gt = (size_t)K.bid * NTHREADS + K.tid, gs = (size_t)K.nb * NTHREADS;
    { const f32x4* s0 = (const f32x4*)ARG(ctx); const f32x4* s1 = (const f32x4*)ARG(x); f32x4* d = (f32x4*)K.X;
      const size_t n0 = (size_t)NCTX * D / 4, n1 = (size_t)NLAT * D / 4;
      for (size_t i = gt; i < n0 + n1; i += gs) d[i] = i < n0 ? s0[i] : s1[i - n0]; }
    { const size_t n8 = (size_t)DEPTH * 16384 * D / 8;
      for (size_t i = gt; i < 2 * n8; i += gs) {
          const bool isv = i >= n8; const size_t j = isv ? i - n8 : i;
          const f32x4* src = (const f32x4*)(isv ? ARG(peer_v) : ARG(peer_u)) + 2 * j; const f32x4 a = src[0], b = src[1];
          u32x4 o; o.x = pk2(a.x, a.y); o.y = pk2(a.z, a.w); o.z = pk2(b.x, b.y); o.w = pk2(b.z, b.w);
          ((u32x4*)(isv ? K.VB : K.UB))[j] = o; } }
    { float* sv = (float*)K.lds;
      float* part = sv + 3 * D;
      __syncthreads();
      for (int i = K.tid; i < 3 * D; i += NTHREADS) { const int v = i / D, k = i % D; const float c = v < 2 ? ARG(c)[v * D + k] : ARG(c_ctx)[k]; sv[i] = c * sigmoidf_(c); }
      __syncthreads();
      for (int item = K.bid; item < DEPTH * 24; item += K.nb) {
          const int l = item / 24, cb = item % 24;
          const float* w = ARG(w_mod) + (size_t)l * D * 6 * D + cb * 256 + K.lane * 4;
          f32x4 a0 = {0.f, 0.f, 0.f, 0.f}, a1 = a0, a2 = a0;
#pragma unroll 8
          for (int kk = 0; kk < 128; ++kk) { const int k = K.wave * 128 + kk; const f32x4 wv = *(const f32x4*)(w + (size_t)k * 6 * D);
              a0 += wv * sv[k]; a1 += wv * sv[D + k]; a2 += wv * sv[2 * D + k]; }
          *(f32x4*)(part + (K.wave * 3 + 0) * 256 + K.lane * 4) = a0; *(f32x4*)(part + (K.wave * 3 + 1) * 256 + K.lane * 4) = a1; *(f32x4*)(part + (K.wave * 3 + 2) * 256 + K.lane * 4) = a2;
          __syncthreads();
          for (int i = K.tid; i < 768; i += NTHREADS) { const int v = i / 256, cc = i % 256; float sum = 0.f;
#pragma unroll
              for (int w8 = 0; w8 < 8; ++w8) sum += part[(w8 * 3 + v) * 256 + cc];
              const int col = cb * 256 + cc; K.MOD[((size_t)l * 3 + v) * 6 * D + col] = sum + ARG(b_mod)[(size_t)l * 6 * D + col]; }
          __syncthreads();
      } }
    for (size_t i = gt; i < 2 * 256; i += gs) {
        const int dir = (int)(i / 256), ch = (int)(i % 256);
        float lg[DEPTH], mx = -1e30f;
#pragma unroll
        for (int l = 0; l < DEPTH; ++l) { lg[l] = ARG(lb_logits)[((size_t)dir * DEPTH + l) * 256 + ch]; mx = fmaxf(mx, lg[l]); }
        float s = 0.f;
#pragma unroll
        for (int l = 0; l < DEPTH; ++l) { lg[l] = expf(lg[l] - mx); s += lg[l]; }
        float cum = 0.f;
#pragma unroll
        for (int l = 0; l < DEPTH; ++l) { if (l > 0) cum += lg[l] / s; K.LB[((size_t)dir * DEPTH + l) * 256 + ch] = cum; }
    }
    for (size_t i = gt; i < (256 + 64) * 16; i += gs) {
        const int pos = (int)(i / 16), f = (int)(i % 16);
        const float inv = powf(10000.0f, -(float)f / 16.0f);
        if (pos < 256) { const float ang = (float)pos * inv; K.ROPE[pos * 16 + f] = cosf(ang); K.ROPE[4096 + pos * 16 + f] = sinf(ang); }
        else { const int pc = pos - 256; const float ang = (float)pc * inv; K.ROPE[8192 + pc * 16 + f] = cosf(ang); K.ROPE[8192 + 1024 + pc * 16 + f] = sinf(ang); }
    }
}

DI void ph_norm(Ctx& K, const float* nw, int shift_chunk) {
    const float* modl = K.MOD + (size_t)K.l * 3 * 6 * D;
    for (int r = K.gw; r < M; r += K.ngw) {
        const f32x4* xr = (const f32x4*)(K.X + (size_t)r * D);
        f32x4 v[4]; float ss = 0.f;
#pragma unroll
        for (int j = 0; j < 4; ++j) { v[j] = xr[j * 64 + K.lane]; ss += v[j].x * v[j].x + v[j].y * v[j].y + v[j].z * v[j].z + v[j].w * v[j].w; }
        ss = wave_sum(ss);
        const float rs = rsqrtf(ss * (1.0f / D) + EPS);
        const float* mv = modl + (size_t)modvec_of_row(r) * 6 * D;
        u32x2* ho = (u32x2*)(K.H + (size_t)r * D);
#pragma unroll
        for (int j = 0; j < 4; ++j) {
            const int c4 = j * 64 + K.lane;
            const f32x4 w = ((const f32x4*)nw)[c4], sh = ((const f32x4*)(mv + shift_chunk * D))[c4], sc = ((const f32x4*)(mv + (shift_chunk + 1) * D))[c4];
            f32x4 y; y.x = v[j].x * rs * w.x * (1.f + sc.x) + sh.x; y.y = v[j].y * rs * w.y * (1.f + sc.y) + sh.y; y.z = v[j].z * rs * w.z * (1.f + sc.z) + sh.z; y.w = v[j].w * rs * w.w * (1.f + sc.w) + sh.w;
            u32x2 o; o.x = pk2(y.x, y.y); o.y = pk2(y.z, y.w); ho[c4] = o;
        }
    }
}

DI void ph_gemm_store(Ctx& K, const bf16_t* A, const bf16_t* Bt, int N, bf16_t* out) {
    pg8::Gemm g{A, Bt, M, N, D}; pg8::StaticOrder S; S.init(M, N, K.nb, K.bid);
    pg8::EpiStore E{out, N};
    pg8::gemm_phase<pg8::EpiStore, pg8::StaticOrder, true, true>((LAS unsigned char*)K.lds, g, S, E);
}
DI void ph_gemm_resid(Ctx& K, const bf16_t* A, const bf16_t* Bt, int chunk) {
    pg8::Gemm g{A, Bt, M, D, D}; pg8::StaticOrder S; S.init(M, D, K.nb, K.bid);
    pg8::EpiResid E{K.X, D, K.MOD + (size_t)K.l * 3 * 6 * D + (size_t)chunk * D, 6 * D, NCTX, L};
    pg8::gemm_phase<pg8::EpiResid, pg8::StaticOrder, true, true>((LAS unsigned char*)K.lds, g, S, E);
}

DI void ph_rope(Ctx& K) {
    const float* cosr = K.ROPE; const float* sinr = K.ROPE + 4096; const float* cosc = K.ROPE + 8192; const float* sinc = K.ROPE + 8192 + 1024;
    const size_t gt = (size_t)K.bid * NTHREADS + K.tid, gs = (size_t)K.nb * NTHREADS;
    for (size_t i = gt; i < (size_t)NLAT * 8 * 16; i += gs) {
        const int f = (int)(i & 15), hh = (int)((i >> 4) & 7), lr = (int)(i >> 7);
        const int t = lr % L, pr = t >> 6, pc = t & 63;
        bf16_t* p = K.P + (size_t)(NCTX + lr) * PW + (hh < 6 ? C_SQ + hh * 64 : C_SK + (hh - 6) * 64);
        const float c1 = cosr[pr * 16 + f], s1 = sinr[pr * 16 + f], c2 = cosc[pc * 16 + f], s2 = sinc[pc * 16 + f];
        const float a = bf2f(p[f]), b = bf2f(p[16 + f]), e = bf2f(p[32 + f]), g = bf2f(p[48 + f]);
        p[f] = f2bf(a * c1 - b * s1); p[16 + f] = f2bf(b * c1 + a * s1); p[32 + f] = f2bf(e * c2 - g * s2); p[48 + f] = f2bf(g * c2 + e * s2);
    }
}

typedef short bf16x8_t __attribute__((ext_vector_type(8)));
#define MFMA16(a, b, c) __builtin_amdgcn_mfma_f32_16x16x32_bf16((a), (b), (c), 0, 0, 0)
constexpr int HG_NCH = (CL + L) / 64;
constexpr int HG_LFS = 68;
constexpr int HG_TS = 72;
constexpr int HGL_LF = 0, HGL_OM = HGL_LF + 2 * 64 * HG_LFS * 4, HGL_VT = HGL_OM + 2 * 64 * HG_LFS * 4, HGL_KT = HGL_VT + 64 * HG_TS * 2, HGL_SC = HGL_KT, HGL_OD = HGL_SC + 8 * 16 * HG_TS * 2, HGL_END = HGL_OD + 2 * 64 * HG_LFS * 4;
static_assert(HGL_KT + 2 * 64 * HG_TS * 2 <= LDS_BYTES && HGL_END <= LDS_BYTES, "hgrn LDS map");
DI int hg_block_row(int b, int tb, int tok) { return tb < 4 ? ctx_row(b, tb * 64 + tok) : lat_row(b, (tb - 4) * 64 + tok); }
DI int hg_bwd_chunk(int tb) { return tb < 4 ? 3 - tb : 4 + 255 - (tb - 4); }
DI void hg_prep(Ctx& K, int b, int h, int tb) {
    float* LF = (float*)(K.lds + HGL_LF); float* OM = (float*)(K.lds + HGL_OM); bf16_t* VT = (bf16_t*)(K.lds + HGL_VT);
    const int tok = K.tid >> 3, c = K.tid & 7;
    const bf16_t* pr = K.P + (size_t)hg_block_row(b, tb, tok) * PW + h * 64 + 8 * c;
#pragma unroll
    for (int dir = 0; dir < 2; ++dir) {
        float z[8]; unpack8(*(const u32x4*)(pr + (dir ? C_ZB : C_ZF)), z);
        const float* lb = K.LB + ((size_t)dir * DEPTH + K.l) * 256 + h * 64 + 8 * c;
        float lf[8], om[8];
#pragma unroll
        for (int j = 0; j < 8; ++j) { const float lbv = lb[j], sg = sigmoidf_(z[j]); const float f = fmaxf(lbv + (1.f - lbv) * sg, 1e-30f); lf[j] = __logf(f); om[j] = (1.f - lbv) * (1.f - sg); }
        float* lfp = LF + (dir * 64 + tok) * HG_LFS + 8 * c; float* omp = OM + (dir * 64 + tok) * HG_LFS + 8 * c;
        *(f32x4*)lfp = (f32x4){lf[0], lf[1], lf[2], lf[3]}; *(f32x4*)(lfp + 4) = (f32x4){lf[4], lf[5], lf[6], lf[7]};
        *(f32x4*)omp = (f32x4){om[0], om[1], om[2], om[3]}; *(f32x4*)(omp + 4) = (f32x4){om[4], om[5], om[6], om[7]};
    }
    { const u32x4 v = *(const u32x4*)(pr + C_HV);
      const unsigned w[4] = {v.x, v.y, v.z, v.w};
#pragma unroll
      for (int j = 0; j < 4; ++j) { VT[(8 * c + 2 * j) * HG_TS + tok] = (bf16_t)(w[j] & 0xffffu); VT[(8 * c + 2 * j + 1) * HG_TS + tok] = (bf16_t)(w[j] >> 16); } }
    __syncthreads();
    if (K.tid < 128) {
        const int dir = K.tid >> 6, d = K.tid & 63; float* col = LF + dir * 64 * HG_LFS + d;
        float v[64];
#pragma unroll
        for (int p = 0; p < 64; ++p) v[p] = col[(dir ? 63 - p : p) * HG_LFS];
#pragma unroll
        for (int p = 1; p < 64; ++p) v[p] += v[p - 1];
#pragma unroll
        for (int p = 0; p < 64; ++p) col[(dir ? 63 - p : p) * HG_LFS] = v[p];
    }
    __syncthreads();
}
DI void ph_hgrn_A(Ctx& K) {
    float* LF = (float*)(K.lds + HGL_LF); float* OM = (float*)(K.lds + HGL_OM); bf16_t* VT = (bf16_t*)(K.lds + HGL_VT); bf16_t* KT = (bf16_t*)(K.lds + HGL_KT);
    const int r16 = K.lane & 15, g4 = K.lane >> 4;
    for (int item = K.bid; item < NB * 4 * HG_NCH; item += K.nb) {
        const int tb = item % HG_NCH, h = (item / HG_NCH) & 3, b = item / (HG_NCH * 4);
        __syncthreads();
        hg_prep(K, b, h, tb);
        { const int tok = K.tid >> 3, c = K.tid & 7;
#pragma unroll
          for (int dir = 0; dir < 2; ++dir) {
              const float* bl = LF + (dir * 64 + (dir ? 0 : 63)) * HG_LFS + 8 * c; const float* bt = LF + (dir * 64 + tok) * HG_LFS + 8 * c; const float* om = OM + (dir * 64 + tok) * HG_LFS + 8 * c;
#pragma unroll
              for (int j = 0; j < 8; ++j) KT[(dir * 64 + 8 * c + j) * HG_TS + tok] = f2bf(om[j] * __expf(bl[j] - bt[j]));
          }
          if (K.tid < 128) { const int dir = K.tid >> 6, d = K.tid & 63; const int chain = (b * 2 + dir) * 4 + h, ch = dir ? hg_bwd_chunk(tb) : tb;
              K.AC[((size_t)chain * HG_NCH + ch) * 64 + d] = __expf(LF[(dir * 64 + (dir ? 0 : 63)) * HG_LFS + d]); } }
        __syncthreads();
        { const int dir = K.wave >> 2, mi = K.wave & 3; const int chain = (b * 2 + dir) * 4 + h, ch = dir ? hg_bwd_chunk(tb) : tb;
          f32x4 acc[4];
#pragma unroll
          for (int nj = 0; nj < 4; ++nj) acc[nj] = (f32x4){0.f, 0.f, 0.f, 0.f};
#pragma unroll
          for (int ks = 0; ks < 2; ++ks) {
              const bf16x8_t av = *(const bf16x8_t*)(VT + (16 * mi + r16) * HG_TS + 32 * ks + 8 * g4);
#pragma unroll
              for (int nj = 0; nj < 4; ++nj) { const bf16x8_t bv = *(const bf16x8_t*)(KT + (dir * 64 + 16 * nj + r16) * HG_TS + 32 * ks + 8 * g4); acc[nj] = MFMA16(av, bv, acc[nj]); }
          }
          float* st = K.ST + ((size_t)chain * HG_NCH + ch) * 4096;
#pragma unroll
          for (int nj = 0; nj < 4; ++nj)
#pragma unroll
              for (int rg = 0; rg < 4; ++rg) st[(16 * mi + 4 * g4 + rg) * 64 + 16 * nj + r16] = acc[nj][rg];
        }
    }
}
DI void ph_hgrn_B(Ctx& K) {
    const int gt = K.bid * NTHREADS + K.tid;
    if (gt < 16 * 4096) {
        const int chain = gt >> 12, idx = gt & 4095, d = idx & 63;
        float* st = K.ST + (size_t)chain * HG_NCH * 4096 + idx; const float* ac = K.AC + (size_t)chain * HG_NCH * 64 + d;
        float S = 0.f;
#pragma unroll 1
        for (int c0 = 0; c0 < HG_NCH; c0 += 10) {
            float u[10], a[10];
#pragma unroll
            for (int i = 0; i < 10; ++i) { u[i] = st[(size_t)(c0 + i) * 4096]; a[i] = ac[(c0 + i) * 64]; }
#pragma unroll
            for (int i = 0; i < 10; ++i) { st[(size_t)(c0 + i) * 4096] = S; S = a[i] * S + u[i]; }
        }
    }
}
DI void ph_hgrn_C(Ctx& K) {
    float* LF = (float*)(K.lds + HGL_LF); float* OM = (float*)(K.lds + HGL_OM); bf16_t* VT = (bf16_t*)(K.lds + HGL_VT); float* OD = (float*)(K.lds + HGL_OD);
    bf16_t* SC = (bf16_t*)(K.lds + HGL_SC) + K.wave * 16 * HG_TS;
    const int r16 = K.lane & 15, g4 = K.lane >> 4;
    for (int item = K.bid; item < NB * 4 * HG_NCH; item += K.nb) {
        const int tb = item % HG_NCH, h = (item / HG_NCH) & 3, b = item / (HG_NCH * 4);
        __syncthreads();
        hg_prep(K, b, h, tb);
        { const int dir = K.wave >> 2, mi = K.wave & 3; const int chain = (b * 2 + dir) * 4 + h, ch = dir ? hg_bwd_chunk(tb) : tb;
          const float* LFd = LF + dir * 64 * HG_LFS; const float* OMd = OM + dir * 64 * HG_LFS; const float* ref = LFd + 32 * HG_LFS;
          bf16x8_t aq1[2], aq2[2];
          { const int t = 16 * mi + r16; const bf16_t* qr = K.P + (size_t)hg_block_row(b, tb, t) * PW + C_HQ + h * 64;
#pragma unroll
            for (int ks = 0; ks < 2; ++ks) { const int d0 = 32 * ks + 8 * g4; float q[8]; unpack8(*(const u32x4*)(qr + d0), q);
                u32x4 w1, w2; unsigned o1[4], o2[4];
#pragma unroll
                for (int j = 0; j < 4; ++j) { float x1[2], x2[2];
#pragma unroll
                    for (int e = 0; e < 2; ++e) { const int dd = d0 + 2 * j + e; const float qs = q[2 * j + e] * sigmoidf_(q[2 * j + e]); const float bt = LFd[t * HG_LFS + dd]; x1[e] = qs * __expf(bt - ref[dd]); x2[e] = qs * __expf(bt); }
                    o1[j] = pk2(x1[0], x1[1]); o2[j] = pk2(x2[0], x2[1]); }
                w1 = (u32x4){o1[0], o1[1], o1[2], o1[3]}; w2 = (u32x4){o2[0], o2[1], o2[2], o2[3]};
                aq1[ks] = __builtin_bit_cast(bf16x8_t, w1); aq2[ks] = __builtin_bit_cast(bf16x8_t, w2); } }
          f32x4 sc[4];
#pragma unroll
          for (int nj = 0; nj < 4; ++nj) { sc[nj] = (f32x4){0.f, 0.f, 0.f, 0.f}; const int s_ = 16 * nj + r16;
#pragma unroll
              for (int ks = 0; ks < 2; ++ks) { const int d0 = 32 * ks + 8 * g4; unsigned o[4];
#pragma unroll
                  for (int j = 0; j < 4; ++j) { const int dd = d0 + 2 * j; o[j] = pk2(OMd[s_ * HG_LFS + dd] * __expf(ref[dd] - LFd[s_ * HG_LFS + dd]), OMd[s_ * HG_LFS + dd + 1] * __expf(ref[dd + 1] - LFd[s_ * HG_LFS + dd + 1])); }
                  const u32x4 w = (u32x4){o[0], o[1], o[2], o[3]};
                  sc[nj] = MFMA16(aq1[ks], __builtin_bit_cast(bf16x8_t, w), sc[nj]); } }
#pragma unroll
          for (int nj = 0; nj < 4; ++nj)
#pragma unroll
              for (int rg = 0; rg < 4; ++rg) { const int tl = 4 * g4 + rg, t = 16 * mi + tl, s_ = 16 * nj + r16; const bool keep = dir ? (s_ >= t) : (s_ <= t);
                  SC[tl * HG_TS + s_] = f2bf(keep ? sc[nj][rg] : 0.f); }
          asm volatile("s_waitcnt lgkmcnt(0)" ::: "memory");
          f32x4 oacc[4];
#pragma unroll
          for (int nj = 0; nj < 4; ++nj) oacc[nj] = (f32x4){0.f, 0.f, 0.f, 0.f};
          const float* st = K.ST + ((size_t)chain * HG_NCH + ch) * 4096;
#pragma unroll
          for (int ks = 0; ks < 2; ++ks) {
              const bf16x8_t as = *(const bf16x8_t*)(SC + r16 * HG_TS + 32 * ks + 8 * g4);
#pragma unroll
              for (int nj = 0; nj < 4; ++nj) {
                  const bf16x8_t bv = *(const bf16x8_t*)(VT + (16 * nj + r16) * HG_TS + 32 * ks + 8 * g4);
                  oacc[nj] = MFMA16(as, bv, oacc[nj]);
                  const float* sp = st + (16 * nj + r16) * 64 + 32 * ks + 8 * g4; const f32x4 s0 = *(const f32x4*)sp, s1 = *(const f32x4*)(sp + 4);
                  const u32x4 w = (u32x4){pk2(s0.x, s0.y), pk2(s0.z, s0.w), pk2(s1.x, s1.y), pk2(s1.z, s1.w)};
                  oacc[nj] = MFMA16(aq2[ks], __builtin_bit_cast(bf16x8_t, w), oacc[nj]);
              }
          }
#pragma unroll
          for (int nj = 0; nj < 4; ++nj)
#pragma unroll
              for (int rg = 0; rg < 4; ++rg) OD[(dir * 64 + 16 * mi + 4 * g4 + rg) * HG_LFS + 16 * nj + r16] = oacc[nj][rg];
        }
        __syncthreads();
        { const int tok = K.tid >> 3, c = K.tid & 7; const int row = hg_block_row(b, tb, tok);
          const float* o0 = OD + tok * HG_LFS + 8 * c; const float* o1 = OD + (64 + tok) * HG_LFS + 8 * c;
          float o[8], ss = 0.f;
#pragma unroll
          for (int j = 0; j < 8; ++j) { o[j] = o0[j] + o1[j]; ss += o[j] * o[j]; }
          ss += __shfl_xor(ss, 1); ss += __shfl_xor(ss, 2); ss += __shfl_xor(ss, 4);
          const float rs = rsqrtf(ss * (1.0f / 64.0f) + EPS);
          float gq[8]; unpack8(*(const u32x4*)(K.P + (size_t)row * PW + C_HG + h * 64 + 8 * c), gq);
          const float* nw = ARG(hgrn_norm_w) + (size_t)K.l * 256 + h * 64 + 8 * c;
          float y[8];
#pragma unroll
          for (int j = 0; j < 8; ++j) y[j] = o[j] * rs * nw[j] * gq[j] * sigmoidf_(gq[j]);
          u32x4 w; w.x = pk2(y[0], y[1]); w.y = pk2(y[2], y[3]); w.z = pk2(y[4], y[5]); w.w = pk2(y[6], y[7]);
          *(u32x4*)(K.MIX + (size_t)row * D + MX_H + h * 64 + 8 * c) = w; }
    }
}

constexpr int AT_TS = 72;
constexpr int ATL_K = 0, ATL_V = ATL_K + 64 * AT_TS * 2, ATL_P = ATL_V + 64 * AT_TS * 2, ATL_END = ATL_P + 8 * 48 * AT_TS * 2;
static_assert(ATL_END <= LDS_BYTES - 256, "attention LDS map");
DI float dpp_max16(float x) { x = fmaxf(x, dpp_<0xB1>(x)); x = fmaxf(x, dpp_<0x4E>(x)); x = fmaxf(x, dpp_<0x141>(x)); x = fmaxf(x, dpp_<0x128>(x)); return x; }
DI float dpp_sum16(float x) { x += dpp_<0xB1>(x); x += dpp_<0x4E>(x); x += dpp_<0x141>(x); x += dpp_<0x128>(x); return x; }
template <int KIND> DI void attn_item(Ctx& K, int idx, const float* sinkp, const float* rpbp) {
    constexpr int MT = KIND == 0 ? 3 : 2;
    int tid_ = K.tid; asm volatile("" : "+v"(tid_));
    const int lane_ = tid_ & 63, wave_ = tid_ >> 6;
    bf16_t* KT = (bf16_t*)(K.lds + ATL_K); bf16_t* VT = (bf16_t*)(K.lds + ATL_V); bf16_t* PS = (bf16_t*)(K.lds + ATL_P) + wave_ * 48 * AT_TS;
    const int r16 = lane_ & 15, g4 = lane_ >> 4;
    int b, hk, qb = 0;
    if (KIND == 0) { qb = idx & 127; hk = (idx >> 7) & 1; b = idx >> 8; }
    else if (KIND == 1) { qb = idx & 63; hk = (idx >> 6) % 6; b = (idx >> 6) / 6; }
    else { hk = idx % 6; b = idx / 6; }
    const int kcol = (KIND == 0) ? C_SK + hk * 64 : (KIND == 2) ? C_SK + (hk / 3) * 64 : C_NK + hk * 64;
    const int vcol = (KIND == 0) ? C_SV + hk * 64 : (KIND == 2) ? C_SV + (hk / 3) * 64 : C_NV + hk * 64;
    int t0 = 0, nloc = 0;
    if (KIND == 0) { const int k0 = max(2 * qb - 2, 0), k1 = min(2 * qb + 3, L / 64 - 1); t0 = k0; nloc = k1 - k0 + 1; }
    if (KIND == 1) { const int k0 = min(max(4 * qb - 4, 0), L / 64 - 8), k1 = min(max(4 * qb + 3 - 4, 0), L / 64 - 8) + 7; t0 = k0; nloc = k1 - k0 + 1; }
    const int ntiles = nloc + CL / 64;
    int w_r = 0, w_rs = 0;
    if (KIND == 1) { w_r = 4 * qb + (wave_ >> 1); w_rs = min(max(w_r - 4, 0), L / 64 - 8); }
    bf16x8_t qf[MT][2]; int qbase[MT], hq_mt[MT];
#pragma unroll
    for (int mt = 0; mt < MT; ++mt) {
        int arow, hq;
        if (KIND == 0) { const int rho = wave_ * 48 + mt * 16; hq = hk * 3 + rho / 128; hq_mt[mt] = hq; const int tb = 128 * qb + (rho & 127); arow = lat_row(b, tb + r16); qbase[mt] = tb; }
        else if (KIND == 1) { hq = hk; hq_mt[mt] = hq; const int cb = 32 * (wave_ & 1) + 16 * mt; arow = lat_row(b, w_r * 64 + cb + r16); qbase[mt] = cb; }
        else { hq = hk; hq_mt[mt] = hq; const int tb = wave_ * 32 + mt * 16; arow = ctx_row(b, tb + r16); qbase[mt] = 0; }
        const int qcol = (KIND == 0 || KIND == 2) ? C_SQ + hq * 64 : C_NQ + hq * 64;
#pragma unroll
        for (int ks = 0; ks < 2; ++ks) { float q[8]; unpack8(*(const u32x4*)(K.P + (size_t)arow * PW + qcol + 32 * ks + 8 * g4), q);
            const u32x4 w = (u32x4){pk2(q[0] * 0.125f, q[1] * 0.125f), pk2(q[2] * 0.125f, q[3] * 0.125f), pk2(q[4] * 0.125f, q[5] * 0.125f), pk2(q[6] * 0.125f, q[7] * 0.125f)};
            qf[mt][ks] = __builtin_bit_cast(bf16x8_t, w); }
    }
    f32x4 oacc[MT][4]; float mrun[MT][4], lrun[MT][4];
#pragma unroll
    for (int mt = 0; mt < MT; ++mt) {
#pragma unroll
        for (int ne = 0; ne < 4; ++ne) oacc[mt][ne] = (f32x4){0.f, 0.f, 0.f, 0.f};
        const bool has_sink = (KIND == 0 || KIND == 2); const float sk = has_sink ? sinkp[hq_mt[mt]] : -1.0e30f;
#pragma unroll
        for (int rg = 0; rg < 4; ++rg) { mrun[mt][rg] = sk; lrun[mt][rg] = has_sink ? 1.0f : 0.0f; }
    }
    const int lkey = tid_ >> 3, lch = tid_ & 7;
    u32x4 pk_, pv_;
    { const int ti = 0; const int grow = (ti < nloc) ? lat_row(b, (t0 + ti) * 64 + lkey) : ctx_row(b, (ti - nloc) * 64 + lkey);
      const bf16_t* pr = K.P + (size_t)grow * PW + 8 * lch; pk_ = *(const u32x4*)(pr + kcol); pv_ = *(const u32x4*)(pr + vcol); }
#pragma unroll 1
    for (int ti = 0; ti < ntiles; ++ti) {
        __syncthreads();
        *(u32x4*)(KT + lkey * AT_TS + 8 * lch) = pk_;
        { const unsigned w[4] = {pv_.x, pv_.y, pv_.z, pv_.w};
#pragma unroll
          for (int j = 0; j < 4; ++j) { VT[(8 * lch + 2 * j) * AT_TS + lkey] = (bf16_t)(w[j] & 0xffffu); VT[(8 * lch + 2 * j + 1) * AT_TS + lkey] = (bf16_t)(w[j] >> 16); } }
        __syncthreads();
        if (ti + 1 < ntiles) { const int tn = ti + 1; const int grow = (tn < nloc) ? lat_row(b, (t0 + tn) * 64 + lkey) : ctx_row(b, (tn - nloc) * 64 + lkey);
            const bf16_t* pr = K.P + (size_t)grow * PW + 8 * lch; pk_ = *(const u32x4*)(pr + kcol); pv_ = *(const u32x4*)(pr + vcol); }
        const bool local = ti < nloc; const int kunit = t0 + ti;
        bool active = true;
        if (KIND == 0 && local) active = true;
        if (KIND == 1 && local) active = (kunit >= w_rs) && (kunit < w_rs + 8);
        if (active) {
            f32x4 sc[MT][4];
#pragma unroll
            for (int mt = 0; mt < MT; ++mt)
#pragma unroll
                for (int nj = 0; nj < 4; ++nj) sc[mt][nj] = (f32x4){0.f, 0.f, 0.f, 0.f};
#pragma unroll
            for (int nj = 0; nj < 4; ++nj)
#pragma unroll
                for (int ks = 0; ks < 2; ++ks) { const bf16x8_t kf = *(const bf16x8_t*)(KT + (16 * nj + r16) * AT_TS + 32 * ks + 8 * g4);
#pragma unroll
                    for (int mt = 0; mt < MT; ++mt) sc[mt][nj] = MFMA16(qf[mt][ks], kf, sc[mt][nj]); }
            if (local) {
#pragma unroll
                for (int mt = 0; mt < MT; ++mt)
#pragma unroll
                    for (int nj = 0; nj < 4; ++nj)
#pragma unroll
                        for (int rg = 0; rg < 4; ++rg) { const int key = 16 * nj + r16;
                            if (KIND == 0) { const int dl = qbase[mt] + 4 * g4 + rg - (kunit * 64 + key); if (dl > 128 || dl < -128) sc[mt][nj][rg] = -INFINITY; }
                            if (KIND == 1) { const int c = qbase[mt] + 4 * g4 + rg, ws = min(max(c - 8, 0), 48);
                                if (key >= ws && key < ws + 16) sc[mt][nj][rg] += rpbp[(kunit - w_r + 7) * 31 + (key - c + 15)]; else sc[mt][nj][rg] = -INFINITY; } }
            }
#pragma unroll
            for (int mt = 0; mt < MT; ++mt)
#pragma unroll
                for (int rg = 0; rg < 4; ++rg) {
                    float mx = fmaxf(fmaxf(sc[mt][0][rg], sc[mt][1][rg]), fmaxf(sc[mt][2][rg], sc[mt][3][rg]));
                    mx = dpp_max16(mx);
                    const float mn = fmaxf(mrun[mt][rg], mx), alpha = __expf(mrun[mt][rg] - mn); mrun[mt][rg] = mn;
                    float rs_ = 0.f;
#pragma unroll
                    for (int nj = 0; nj < 4; ++nj) { const float pe = __expf(sc[mt][nj][rg] - mn); sc[mt][nj][rg] = pe; rs_ += pe; }
                    rs_ = dpp_sum16(rs_);
                    lrun[mt][rg] = lrun[mt][rg] * alpha + rs_;
#pragma unroll
                    for (int ne = 0; ne < 4; ++ne) oacc[mt][ne][rg] *= alpha;
                }
#pragma unroll
            for (int mt = 0; mt < MT; ++mt)
#pragma unroll
                for (int nj = 0; nj < 4; ++nj)
#pragma unroll
                    for (int rg = 0; rg < 4; ++rg) PS[(16 * mt + 4 * g4 + rg) * AT_TS + 16 * nj + r16] = f2bf(sc[mt][nj][rg]);
            asm volatile("s_waitcnt lgkmcnt(0)" ::: "memory");
#pragma unroll
            for (int ks = 0; ks < 2; ++ks) {
                bf16x8_t pf[MT];
#pragma unroll
                for (int mt = 0; mt < MT; ++mt) pf[mt] = *(const bf16x8_t*)(PS + (16 * mt + r16) * AT_TS + 32 * ks + 8 * g4);
#pragma unroll
                for (int ne = 0; ne < 4; ++ne) { const bf16x8_t vf = *(const bf16x8_t*)(VT + (16 * ne + r16) * AT_TS + 32 * ks + 8 * g4);
#pragma unroll
                    for (int mt = 0; mt < MT; ++mt) oacc[mt][ne] = MFMA16(pf[mt], vf, oacc[mt][ne]); }
            }
            asm volatile("s_waitcnt lgkmcnt(0)" ::: "memory");
        }
    }
#pragma unroll
    for (int mt = 0; mt < MT; ++mt)
#pragma unroll
        for (int rg = 0; rg < 4; ++rg) { const float inv = 1.0f / lrun[mt][rg];
#pragma unroll
            for (int ne = 0; ne < 4; ++ne) PS[(16 * mt + 4 * g4 + rg) * AT_TS + 16 * ne + r16] = f2bf(oacc[mt][ne][rg] * inv); }
    asm volatile("s_waitcnt lgkmcnt(0)" ::: "memory");
#pragma unroll
    for (int mt = 0; mt < MT; ++mt) {
        const int ocol = ((KIND == 0 || KIND == 2) ? MX_S : MX_N) + hq_mt[mt] * 64;
#pragma unroll
        for (int i = 0; i < 2; ++i) { const int rr = (lane_ >> 3) + 8 * i, ch = lane_ & 7;
            const u32x4 v = *(const u32x4*)(PS + (16 * mt + rr) * AT_TS + 8 * ch);
            int grow;
            if (KIND == 0) { const int rho = wave_ * 48 + mt * 16; grow = lat_row(b, 128 * qb + (rho & 127) + rr); }
            else if (KIND == 1) grow = lat_row(b, w_r * 64 + 32 * (wave_ & 1) + 16 * mt + rr);
            else grow = ctx_row(b, wave_ * 32 + mt * 16 + rr);
            *(u32x4*)(K.MIX + (size_t)grow * D + ocol + 8 * ch) = v; }
    }
    asm volatile("s_waitcnt lgkmcnt(0)" ::: "memory");
}
DI void ph_attn(Ctx& K) {
    constexpr int N_SWA = NB * 2 * (L / 128), N_NAT = NB * 6 * (L / 256), N_C = NB * 6;
    const float* sinkp = ARG(swa_sink) + K.l * 6;
    for (int item = K.bid; item < N_SWA + N_NAT + 2 * N_C; item += K.nb) {
        if (item < N_SWA) attn_item<0>(K, item, sinkp, nullptr);
        else if (item < N_SWA + N_NAT) { const int it = item - N_SWA; const int h = (it >> 6) % 6; attn_item<1>(K, it, nullptr, ARG(nat_rpb) + ((size_t)K.l * 6 + h) * 15 * 31); }
        else if (item < N_SWA + N_NAT + N_C) attn_item<2>(K, item - N_SWA - N_NAT, sinkp, nullptr);
        else attn_item<3>(K, item - N_SWA - N_NAT - N_C, nullptr, nullptr);
    }
}

DI unsigned fkey(float f) { const unsigned u = __float_as_uint(f); return (u & 0x80000000u) ? ~u : (u | 0x80000000u); }
DI int mbcnt64(unsigned long long m) { return (int)__builtin_amdgcn_mbcnt_hi((unsigned)(m >> 32), __builtin_amdgcn_mbcnt_lo((unsigned)m, 0u)); }
template <int NV> DI unsigned radix_thr16(const unsigned (&k)[NV]) {
    unsigned prefix = 0u;
#pragma unroll 1
    for (int bit = 31; bit >= 0; --bit) {
        const unsigned cand = prefix | (1u << bit); int cnt = 0;
#pragma unroll
        for (int i = 0; i < NV; ++i) cnt += __popcll(__ballot(k[i] >= cand));
        if (cnt >= 16) { prefix = cand; if (cnt == 16) break; }
    }
    return prefix;
}
template <int NV> DI void select16(const unsigned (&k)[NV], unsigned T, bool (&sel)[NV], int (&pos)[NV]) {
    int ngt = 0; unsigned long long gtm[NV], eqm[NV];
#pragma unroll
    for (int i = 0; i < NV; ++i) { gtm[i] = __ballot(k[i] > T); eqm[i] = __ballot(k[i] == T); ngt += __popcll(gtm[i]); }
    const int need = 16 - ngt; int eqbase = 0, selbase = 0;
#pragma unroll
    for (int i = 0; i < NV; ++i) {
        const bool iseq = k[i] == T; const int erank = eqbase + mbcnt64(eqm[i]); eqbase += __popcll(eqm[i]);
        sel[i] = (k[i] > T) || (iseq && erank < need);
        const unsigned long long sm = __ballot(sel[i]); pos[i] = selbase + mbcnt64(sm); selbase += __popcll(sm);
    }
}
constexpr int PS_SCS = 132;
constexpr int PSL_TOP = 8 * 2 * 16 * PS_SCS * 4;
static_assert(PSL_TOP + 8 * 256 <= LDS_BYTES - 256, "peer select LDS map");
DI void ph_peer_select(Ctx& K) {
    const float* SKl = ARG(peer_sk) + (size_t)K.l * 8 * 2 * 128 * 128;
    float* SCR = (float*)K.lds + K.wave * 2 * 16 * PS_SCS; float* TOPV = (float*)(K.lds + PSL_TOP + K.wave * 256); int* TOPI = (int*)(TOPV + 32);
    const int r16 = K.lane & 15, g4 = K.lane >> 4, h = K.wave;
    for (int item = K.bid; item < M / 16; item += K.nb) {
        const int t0 = item * 16;
#pragma unroll 1
        for (int p = 0; p < 2; ++p) {
            float a[32];
            { const bf16_t* qp = K.QP + (size_t)(t0 + r16) * 2048 + h * 256 + p * 128 + 32 * g4;
#pragma unroll
              for (int i = 0; i < 4; ++i) unpack8(*(const u32x4*)(qp + 8 * i), &a[8 * i]); }
            const float* skp = SKl + (((size_t)h * 2 + p) * 128 + r16) * 128 + 32 * g4;
#pragma unroll 1
            for (int nt = 0; nt < 8; nt += 2) {
                float b0[32], b1[32];
#pragma unroll
                for (int i = 0; i < 8; ++i) { const f32x4 v0 = *(const f32x4*)(skp + (size_t)(16 * nt) * 128 + 4 * i), v1 = *(const f32x4*)(skp + (size_t)(16 * nt + 16) * 128 + 4 * i);
                    b0[4 * i] = v0.x; b0[4 * i + 1] = v0.y; b0[4 * i + 2] = v0.z; b0[4 * i + 3] = v0.w; b1[4 * i] = v1.x; b1[4 * i + 1] = v1.y; b1[4 * i + 2] = v1.z; b1[4 * i + 3] = v1.w; }
                f32x4 c0 = {0.f, 0.f, 0.f, 0.f}, c1 = c0;
#pragma unroll
                for (int s_ = 0; s_ < 32; ++s_) { c0 = __builtin_amdgcn_mfma_f32_16x16x4f32(a[s_], b0[s_], c0, 0, 0, 0); c1 = __builtin_amdgcn_mfma_f32_16x16x4f32(a[s_], b1[s_], c1, 0, 0, 0); }
#pragma unroll
                for (int rg = 0; rg < 4; ++rg) { SCR[(p * 16 + 4 * g4 + rg) * PS_SCS + 16 * nt + r16] = c0[rg]; SCR[(p * 16 + 4 * g4 + rg) * PS_SCS + 16 * nt + 16 + r16] = c1[rg]; }
            }
        }
        asm volatile("s_waitcnt lgkmcnt(0)" ::: "memory");
#pragma unroll 1
        for (int tk = 0; tk < 16; ++tk) {
            const int r = t0 + tk;
#pragma unroll
            for (int p = 0; p < 2; ++p) {
                float v[2]; v[0] = SCR[(p * 16 + tk) * PS_SCS + K.lane]; v[1] = SCR[(p * 16 + tk) * PS_SCS + 64 + K.lane];
                unsigned kk[2] = {fkey(v[0]), fkey(v[1])};
                const unsigned T = radix_thr16<2>(kk);
                bool sel[2]; int pos[2]; select16<2>(kk, T, sel, pos);
#pragma unroll
                for (int i = 0; i < 2; ++i) if (sel[i]) { TOPV[p * 16 + pos[i]] = v[i]; TOPI[p * 16 + pos[i]] = K.lane + 64 * i; }
            }
            asm volatile("s_waitcnt lgkmcnt(0)" ::: "memory");
            float cv[4]; int ce[4]; unsigned ck[4];
            { const float vb = TOPV[16 + r16]; const int ib = TOPI[16 + r16];
#pragma unroll
              for (int i = 0; i < 4; ++i) { const int aidx = g4 + 4 * i; cv[i] = TOPV[aidx] + vb; ce[i] = TOPI[aidx] * 128 + ib; ck[i] = fkey(cv[i]); } }
            const unsigned T = radix_thr16<4>(ck);
            bool sel[4]; int pos[4]; select16<4>(ck, T, sel, pos);
            float mx = -3.0e38f;
#pragma unroll
            for (int i = 0; i < 4; ++i) mx = fmaxf(mx, sel[i] ? cv[i] : -3.0e38f);
            mx = fmaxf(mx, dpp_<0xB1>(mx)); mx = fmaxf(mx, dpp_<0x4E>(mx)); mx = fmaxf(mx, dpp_<0x141>(mx)); mx = fmaxf(mx, dpp_<0x128>(mx));
            { auto s1 = __builtin_amdgcn_permlane16_swap(__float_as_uint(mx), __float_as_uint(mx), false, false); mx = fmaxf(__uint_as_float(s1[0]), __uint_as_float(s1[1]));
              auto s2 = __builtin_amdgcn_permlane32_swap(__float_as_uint(mx), __float_as_uint(mx), false, false); mx = fmaxf(__uint_as_float(s2[0]), __uint_as_float(s2[1])); }
            float ex[4], es = 0.f;
#pragma unroll
            for (int i = 0; i < 4; ++i) { ex[i] = sel[i] ? __expf(cv[i] - mx) : 0.f; es += ex[i]; }
            es = wave_sum_fast(es);
            const float inv = 1.0f / es;
#pragma unroll
            for (int i = 0; i < 4; ++i) if (sel[i]) { K.PIDX[(size_t)r * 128 + h * 16 + pos[i]] = ce[i]; K.PG[(size_t)r * 128 + h * 16 + pos[i]] = ex[i] * inv; }
            asm volatile("s_waitcnt lgkmcnt(0)" ::: "memory");
        }
    }
}

DI void ph_peer_gather(Ctx& K) {
    const bf16_t* U = K.UB + (size_t)K.l * 16384 * D; const bf16_t* V = K.VB + (size_t)K.l * 16384 * D;
    const float* gate = K.MOD + (size_t)K.l * 3 * 6 * D + 5 * D;
    for (int r = K.gw; r < M; r += K.ngw) {
        const u32x4 h0 = *(const u32x4*)(K.H + (size_t)r * D + K.lane * 8), h1 = *(const u32x4*)(K.H + (size_t)r * D + 512 + K.lane * 8);
        const int ia = K.PIDX[(size_t)r * 128 + K.lane], ib = K.PIDX[(size_t)r * 128 + 64 + K.lane];
        const float ga = K.PG[(size_t)r * 128 + K.lane], gb = K.PG[(size_t)r * 128 + 64 + K.lane];
        float y[16];
#pragma unroll
        for (int i = 0; i < 16; ++i) y[i] = 0.f;
#pragma unroll 1
        for (int k0 = 0; k0 < 128; k0 += 4) {
            u32x4 ua[4], ub[4], va[4], vb[4]; float g[4];
#pragma unroll
            for (int j = 0; j < 4; ++j) {
                const int kk = (k0 + j) & 63;
                const int e = k0 < 64 ? __builtin_amdgcn_readlane(ia, kk) : __builtin_amdgcn_readlane(ib, kk);
                g[j] = __uint_as_float(k0 < 64 ? __builtin_amdgcn_readlane(__float_as_uint(ga), kk) : __builtin_amdgcn_readlane(__float_as_uint(gb), kk));
                const bf16_t* ur = U + (size_t)e * D + K.lane * 8; const bf16_t* vr = V + (size_t)e * D + K.lane * 8;
                ua[j] = *(const u32x4*)ur; ub[j] = *(const u32x4*)(ur + 512); va[j] = *(const u32x4*)vr; vb[j] = *(const u32x4*)(vr + 512);
            }
#pragma unroll
            for (int j = 0; j < 4; ++j) {
                float d = dot2bf(ua[j].x, h0.x, 0.f); d = dot2bf(ua[j].y, h0.y, d); d = dot2bf(ua[j].z, h0.z, d); d = dot2bf(ua[j].w, h0.w, d);
                d = dot2bf(ub[j].x, h1.x, d); d = dot2bf(ub[j].y, h1.y, d); d = dot2bf(ub[j].z, h1.z, d); d = dot2bf(ub[j].w, h1.w, d);
                d = wave_sum_fast(d);
                const float w = g[j] * gelu_erf(d);
                float t[8];
                unpack8(va[j], t);
#pragma unroll
                for (int i = 0; i < 8; ++i) y[i] += w * t[i];
                unpack8(vb[j], t);
#pragma unroll
                for (int i = 0; i < 8; ++i) y[8 + i] += w * t[i];
            }
        }
        const float* gv = gate + (size_t)modvec_of_row(r) * 6 * D; float* xr = K.X + (size_t)r * D;
#pragma unroll
        for (int hh = 0; hh < 2; ++hh)
#pragma unroll
            for (int q4 = 0; q4 < 2; ++q4) { const int c0 = hh * 512 + K.lane * 8 + q4 * 4; const f32x4 gg = *(const f32x4*)(gv + c0); f32x4 xv = *(const f32x4*)(xr + c0);
                xv.x += gg.x * y[hh * 8 + q4 * 4 + 0]; xv.y += gg.y * y[hh * 8 + q4 * 4 + 1]; xv.z += gg.z * y[hh * 8 + q4 * 4 + 2]; xv.w += gg.w * y[hh * 8 + q4 * 4 + 3]; *(f32x4*)(xr + c0) = xv; }
    }
}

DI void ph_final(Ctx& K) {
    for (int r = K.gw; r < NLAT; r += K.ngw) {
        const f32x4* xr = (const f32x4*)(K.X + (size_t)(NCTX + r) * D); f32x4* o = (f32x4*)(((float*)argp_<float>(K, (unsigned)__builtin_offsetof(Args, out))) + (size_t)r * D);
        f32x4 v[4]; float ss = 0.f;
#pragma unroll
        for (int j = 0; j < 4; ++j) { v[j] = xr[j * 64 + K.lane]; ss += v[j].x * v[j].x + v[j].y * v[j].y + v[j].z * v[j].z + v[j].w * v[j].w; }
        ss = wave_sum(ss); const float rs = rsqrtf(ss * (1.0f / D) + EPS);
#pragma unroll
        for (int j = 0; j < 4; ++j) { const f32x4 w = ((const f32x4*)ARG(final_norm_w))[j * 64 + K.lane]; o[j * 64 + K.lane] = v[j] * rs * w; }
    }
}

constexpr int PH_PER_LAYER = 12, N_PHASES = 2 + PH_PER_LAYER * DEPTH;
__global__ void __launch_bounds__(NTHREADS) mk_fwd(Args args) {
    extern __shared__ __attribute__((aligned(16))) unsigned char lds[];
    cg::grid_group grid = cg::this_grid();
    constexpr unsigned ARGS_OFF = LDS_BYTES - 256;
    if (threadIdx.x == 0) *(Args*)(lds + ARGS_OFF) = args;
    __syncthreads();
#pragma unroll 1
    for (int ph = 0; ph < N_PHASES; ++ph) {
        int tid = threadIdx.x; asm volatile("" : "+v"(tid));
        unsigned aoff = ARGS_OFF; asm volatile("" : "+v"(aoff));
        unsigned char* ws = args.ws; asm volatile("" : "+s"(ws));
        int bid = blockIdx.x; asm volatile("" : "+s"(bid)); int nb = gridDim.x; asm volatile("" : "+s"(nb));
        Ctx K; K.aoff = aoff; K.lds = lds; K.tid = tid; K.lane = tid & 63; K.wave = tid >> 6; K.bid = bid; K.nb = nb; K.gw = bid * NWAVES + K.wave; K.ngw = nb * NWAVES;
        K.X = (float*)(ws + WS_X); K.H = (bf16_t*)(ws + WS_H); K.P = (bf16_t*)(ws + WS_P); K.QP = K.P; K.MIX = (bf16_t*)(ws + WS_MIX); K.OF = (float*)(ws + WS_OF); K.OB = (float*)(ws + WS_OB);
        K.PIDX = (int*)(ws + WS_PIDX); K.PG = (float*)(ws + WS_PG); K.MOD = (float*)(ws + WS_MOD); K.LB = (float*)(ws + WS_LB); K.ROPE = (float*)(ws + WS_ROPE); K.WIN = (bf16_t*)(ws + WS_WIN); K.WOUT = (bf16_t*)(ws + WS_WOUT); K.WQ = (bf16_t*)(ws + WS_WQ); K.UB = (bf16_t*)(ws + WS_UB); K.ST = (float*)(ws + WS_OF); K.AC = (float*)(ws + WS_AC); K.VB = (bf16_t*)(ws + WS_VB);
        const int l = ph == 0 ? 0 : (ph - 1) / PH_PER_LAYER, k = ph == 0 ? -1 : (ph == N_PHASES - 1 ? -2 : (ph - 1) % PH_PER_LAYER);
        K.l = l;
        if (k == -1) ph_prologue(K);
        else if (k == -2) ph_final(K);
        else if (k == 0) ph_norm(K, ARG(norm_mix_w) + (size_t)l * D, 0);
        else if (k == 1) ph_gemm_store(K, K.H, K.WIN + (size_t)l * PW * D, PW, K.P);
        else if (k == 2) ph_rope(K);
        else if (k == 3) ph_hgrn_A(K);
        else if (k == 4) ph_attn(K);
        else if (k == 5) ph_hgrn_B(K);
        else if (k == 6) ph_hgrn_C(K);
        else if (k == 7) ph_gemm_resid(K, K.MIX, K.WOUT + (size_t)l * D * D, 2);
        else if (k == 8) ph_norm(K, ARG(norm_ffn_w) + (size_t)l * D, 3);
        else if (k == 9) ph_gemm_store(K, K.H, K.WQ + (size_t)l * 2048 * D, 2048, K.QP);
        else if (k == 10) ph_peer_select(K);
        else if (k == 11) ph_peer_gather(K);
        if (k != 3) grid.sync();
    }
}

extern "C" void kernel_launch(void* const* d_in, const int* in_sizes, int n_in, void* d_out, int out_size, void* d_ws, size_t ws_size, hipStream_t stream) {
    static int grid = 0;
    if (grid == 0) {
        if (n_in != 19 || out_size != NLAT * D || ws_size < WS_END) { fprintf(stderr, "kernel_launch: unexpected shapes (n_in %d out %d ws %zu need %zu)\n", n_in, out_size, ws_size, (size_t)WS_END); grid = -1; return; }
        int dev = 0, cus = 0, per_cu = 0;
        (void)hipGetDevice(&dev); (void)hipDeviceGetAttribute(&cus, hipDeviceAttributeMultiprocessorCount, dev);
        (void)hipFuncSetAttribute((const void*)mk_fwd, hipFuncAttributeMaxDynamicSharedMemorySize, LDS_BYTES);
        (void)hipOccupancyMaxActiveBlocksPerMultiprocessor(&per_cu, (const void*)mk_fwd, NTHREADS, LDS_BYTES);
        if (per_cu < 1) { fprintf(stderr, "kernel_launch: occupancy query says %d blocks/CU\n", per_cu); grid = -1; return; }
        grid = cus;
    }
    if (grid < 0) return;
    Args a{};
    a.x = (const float*)d_in[0]; a.c = (const float*)d_in[1]; a.ctx = (const float*)d_in[2]; a.c_ctx = (const float*)d_in[3]; a.w_mod = (const float*)d_in[4]; a.b_mod = (const float*)d_in[5];
    a.norm_mix_w = (const float*)d_in[6]; a.norm_ffn_w = (const float*)d_in[7]; a.w_in = (const float*)d_in[8]; a.lb_logits = (const float*)d_in[9]; a.hgrn_norm_w = (const float*)d_in[10];
    a.swa_sink = (const float*)d_in[11]; a.nat_rpb = (const float*)d_in[12]; a.w_out = (const float*)d_in[13]; a.peer_wq = (const float*)d_in[14]; a.peer_sk = (const float*)d_in[15];
    a.peer_u = (const float*)d_in[16]; a.peer_v = (const float*)d_in[17]; a.final_norm_w = (const float*)d_in[18];
    a.out = (float*)d_out; a.ws = (unsigned char*)d_ws;
    void* kargs[] = {&a};
    hipError_t e = hipLaunchCooperativeKernel((const void*)mk_fwd, dim3(grid), dim3(NTHREADS), kargs, LDS_BYTES, stream);
    if (e != hipSuccess) fprintf(stderr, "kernel_launch: cooperative launch failed: %s (grid %d)\n", hipGetErrorString(e), grid);
}
```

```cpp
#include <hip/hip_runtime.h>
#include <hip/hip_cooperative_groups.h>
#include <cstdio>
#include <cstdint>
namespace cg = cooperative_groups;
#define DI __device__ __forceinline__

typedef unsigned short bf16_t;
typedef float f32x4 __attribute__((ext_vector_type(4)));
typedef unsigned u32x4 __attribute__((ext_vector_type(4)));
typedef unsigned u32x2 __attribute__((ext_vector_type(2)));

constexpr int D = 1024, NB = 2, L = 16384, CL = 256, DEPTH = 4;
constexpr int NCTX = NB * CL, NLAT = NB * L, M = NCTX + NLAT;
constexpr int PW = 3072;
constexpr int C_HQ = 0, C_ZF = 256, C_ZB = 512, C_HV = 768, C_HG = 1024, C_SQ = 1280, C_SK = 1664, C_SV = 1792, C_NQ = 1920, C_NK = 2304, C_NV = 2688;
constexpr int MX_H = 0, MX_S = 256, MX_N = 640;
constexpr float EPS = 1e-6f;
constexpr int NTHREADS = 512, NWAVES = 8;
constexpr int LDS_BYTES = 147456;

constexpr size_t al256(size_t x) { return (x + 255) & ~(size_t)255; }
constexpr size_t WS_X = 0;
constexpr size_t WS_H = WS_X + al256((size_t)M * D * 4);
constexpr size_t WS_P = WS_H + al256((size_t)M * D * 2);
constexpr size_t WS_MIX = WS_P + al256((size_t)M * PW * 2);
constexpr size_t WS_OF = WS_MIX + al256((size_t)M * D * 2);
constexpr size_t WS_OB = WS_OF + al256((size_t)M * 256 * 4);
constexpr size_t WS_PIDX = WS_OB + al256((size_t)M * 256 * 4);
constexpr size_t WS_PG = WS_PIDX + al256((size_t)M * 128 * 4);
constexpr size_t WS_MOD = WS_PG + al256((size_t)M * 128 * 4);
constexpr size_t WS_LB = WS_MOD + al256((size_t)DEPTH * 3 * 6 * D * 4);
constexpr size_t WS_ROPE = WS_LB + al256((size_t)2 * DEPTH * 256 * 4);
constexpr size_t WS_WIN = WS_ROPE + al256((size_t)(256 + 256 + 64 + 64) * 16 * 4);
constexpr size_t WS_WOUT = WS_WIN + al256((size_t)DEPTH * PW * D * 2);
constexpr size_t WS_WQ = WS_WOUT + al256((size_t)DEPTH * D * D * 2);
constexpr size_t WS_AC = WS_WQ + al256((size_t)DEPTH * 2048 * D * 2);
constexpr size_t WS_UB_ = 0; constexpr size_t WS_UB = WS_AC + al256((size_t)16 * 260 * 64 * 4); constexpr size_t WS_UB_OLD = WS_WQ + al256((size_t)DEPTH * 2048 * D * 2);
constexpr size_t WS_VB = WS_UB + al256((size_t)DEPTH * 16384 * D * 2);
constexpr size_t WS_PA = WS_VB + al256((size_t)DEPTH * 16384 * D * 2);
constexpr size_t WS_CTL = WS_PA + al256((size_t)M * 128 * 4);
constexpr size_t CTL_BYTES = 65536;
constexpr size_t WS_END = WS_CTL + CTL_BYTES;

struct Args {
    const float *x, *c, *ctx, *c_ctx, *w_mod, *b_mod, *norm_mix_w, *norm_ffn_w, *w_in, *lb_logits, *hgrn_norm_w, *swa_sink, *nat_rpb, *w_out, *peer_wq, *peer_sk, *peer_u, *peer_v, *final_norm_w;
    float* out; unsigned char* ws;
};

DI float bf2f(bf16_t v) { return __uint_as_float((unsigned)v << 16); }
DI bf16_t f2bf(float f) { unsigned u = __float_as_uint(f); return (bf16_t)((u + 0x7fffu + ((u >> 16) & 1u)) >> 16); }
DI unsigned pk2(float lo, float hi) { return (unsigned)f2bf(lo) | ((unsigned)f2bf(hi) << 16); }
DI float wave_sum(float v) {
#pragma unroll
    for (int o = 1; o < 64; o <<= 1) v += __shfl_xor(v, o);
    return v;
}
typedef __bf16 bf16x2_t __attribute__((ext_vector_type(2)));
DI float dot2bf(unsigned a, unsigned b, float acc) { return __builtin_amdgcn_fdot2_f32_bf16(__builtin_bit_cast(bf16x2_t, a), __builtin_bit_cast(bf16x2_t, b), acc, false); }
template <int CTRL> DI float dpp_(float x) { return __builtin_bit_cast(float, __builtin_amdgcn_mov_dpp(__builtin_bit_cast(int, x), CTRL, 0xf, 0xf, true)); }
DI float wave_sum_fast(float x) {
    x += dpp_<0xB1>(x); x += dpp_<0x4E>(x); x += dpp_<0x141>(x); x += dpp_<0x128>(x);
    auto s1 = __builtin_amdgcn_permlane16_swap(__float_as_uint(x), __float_as_uint(x), false, false); x = __uint_as_float(s1[0]) + __uint_as_float(s1[1]);
    auto s2 = __builtin_amdgcn_permlane32_swap(__float_as_uint(x), __float_as_uint(x), false, false); return __uint_as_float(s2[0]) + __uint_as_float(s2[1]);
}
DI float sigmoidf_(float z) { return 1.0f / (1.0f + __expf(-z)); }
DI float gelu_erf(float v) { return 0.5f * v * (1.0f + erff(v * 0.70710678118654752f)); }
DI int modvec_of_row(int r) { return r < NCTX ? 2 : (r - NCTX) / L; }
DI int batch_of_row(int r) { return r < NCTX ? r / CL : (r - NCTX) / L; }
DI int lat_row(int b, int t) { return NCTX + b * L + t; }
DI int ctx_row(int b, int s) { return b * CL + s; }
DI void unpack8(const u32x4 w, float* o) {
    o[0] = __uint_as_float(w.x << 16); o[1] = __uint_as_float(w.x & 0xffff0000u);
    o[2] = __uint_as_float(w.y << 16); o[3] = __uint_as_float(w.y & 0xffff0000u);
    o[4] = __uint_as_float(w.z << 16); o[5] = __uint_as_float(w.z & 0xffff0000u);
    o[6] = __uint_as_float(w.w << 16); o[7] = __uint_as_float(w.w & 0xffff0000u);
}
DI void load_row64(const bf16_t* p, float (&o)[64]) {
#pragma unroll
    for (int i = 0; i < 8; ++i) { const u32x4 w = *(const u32x4*)(p + 8 * i); unpack8(w, &o[8 * i]); }
}
DI void rope64(float (&x)[64], const float* cr, const float* sr, const float* cc, const float* sc) {
#pragma unroll
    for (int i = 0; i < 16; ++i) {
        const float c1 = cr[i], s1 = sr[i], a = x[i], b = x[16 + i];
        x[i] = a * c1 - b * s1; x[16 + i] = b * c1 + a * s1;
        const float c2 = cc[i], s2 = sc[i], e = x[32 + i], f = x[48 + i];
        x[32 + i] = e * c2 - f * s2; x[48 + i] = f * c2 + e * s2;
    }
}

namespace pg8 {
#define PG8_LAS __attribute__((address_space(3)))
typedef unsigned short bf16_t;
typedef short bf16x8 __attribute__((ext_vector_type(8)));
typedef float f32x4 __attribute__((ext_vector_type(4)));
typedef unsigned u32x4 __attribute__((ext_vector_type(4)));
constexpr int BM = 256, BK = 64, HALF = 128, HTB = HALF * BK * 2  , STAGE_BYTES = 8 * HTB, NXCD = 8, WGM = 8;

__host__ __device__ __forceinline__ int lds_byte(int r, int c) { const int st = (r >> 4) * 2 + (c >> 5), rr = r & 15, cc = c & 31, ob = rr * 64 + cc * 2; return st * 1024 + (ob ^ (((ob >> 9) & 1) << 5)); }
__host__ __device__ __forceinline__ void stage_rc(int b, int& R, int& C) { const int st = b / 1024, sb = b % 1024, swz = sb ^ (((sb >> 9) & 1) << 5); R = (st >> 1) * 16 + swz / 64; C = (st & 1) * 32 + (swz % 64) / 2; }
__host__ __device__ __forceinline__ int perm32(int rho) { const int n = rho >> 4, i = rho & 15; return 8 * (i >> 2) + 4 * n + (i & 3); }

struct Unit { int pm, pn; };
struct Gemm { const bf16_t* A; const bf16_t* Bt; int M, N, K; };

struct StaticOrder {
    int nM, nN, nwg, G, c;
    __host__ __device__ void init(int M, int N, int G_, int c_) { nM = M / BM; nN = N / BM; nwg = nM * nN; G = G_; c = c_; }
    __host__ __device__ bool next(int i, Unit& u) const {
        const long L = (long)i * G + c; if (L >= nwg) return false;
        int wgid = (int)L; { const int q = nwg / NXCD, r = nwg % NXCD, xcd = wgid % NXCD, off = wgid / NXCD; wgid = (xcd < r ? xcd * (q + 1) : r * (q + 1) + (xcd - r) * q) + off; }
        const int nig = WGM * nN, gid = wgid / nig, fm = gid * WGM, gsz = (nM - fm) < WGM ? (nM - fm) : WGM;
        u.pm = fm + ((wgid % nig) % gsz); u.pn = (wgid % nig) / gsz; return true;
    }
    __device__ __forceinline__ void a_ready(const Unit&) const {}
    __device__ __forceinline__ void done(const Unit&) const {}
};


__device__ __forceinline__ unsigned cvt_pk_bf16(float lo, float hi) { unsigned r; asm volatile("v_cvt_pk_bf16_f32 %0, %1, %2" : "=v"(r) : "v"(lo), "v"(hi)); return r; }
struct EpiStore {
    static constexpr bool PERM = true, AFTER_DRAIN = false;
    bf16_t* O; int ldc;
    __device__ __forceinline__ void operator()(const f32x4 (&acc)[2][2][4][2], const Unit& u, int wr, int wc, int fr, int fq) const {
        const int row0 = u.pm * BM + wr * 64 + fr, col0 = u.pn * BM + wc * 32 + 8 * fq;
#pragma unroll
        for (int ai = 0; ai < 2; ++ai)
#pragma unroll
            for (int m = 0; m < 4; ++m) { bf16_t* rowp = O + (size_t)(row0 + ai * HALF + m * 16) * ldc + col0;
#pragma unroll
                for (int bj = 0; bj < 2; ++bj) { const f32x4 v0 = acc[ai][bj][m][0], v1 = acc[ai][bj][m][1];
                    u32x4 w; w.x = cvt_pk_bf16(v0[0], v0[1]); w.y = cvt_pk_bf16(v0[2], v0[3]); w.z = cvt_pk_bf16(v1[0], v1[1]); w.w = cvt_pk_bf16(v1[2], v1[3]);
                    *(u32x4*)(rowp + bj * HALF) = w; } }
    }
};
struct EpiResid {
    static constexpr bool PERM = false, AFTER_DRAIN = false;
    float* X; int ldc; const float* gate; int gstride, nctx, seqlen;
    __device__ __forceinline__ void operator()(const f32x4 (&acc)[2][2][4][2], const Unit& u, int wr, int wc, int fr, int fq) const {
        const int col0 = u.pn * BM + wc * 32 + 4 * fq;
#pragma unroll
        for (int ai = 0; ai < 2; ++ai)
#pragma unroll
            for (int m = 0; m < 4; ++m) { const int r = u.pm * BM + ai * HALF + wr * 64 + m * 16 + fr; const int vsel = r < nctx ? 2 : (r - nctx) / seqlen;
                float* xr = X + (size_t)r * ldc + col0; const float* gr = gate + (size_t)vsel * gstride + col0;
#pragma unroll
                for (int bj = 0; bj < 2; ++bj)
#pragma unroll
                    for (int n = 0; n < 2; ++n) { const f32x4 g = *(const f32x4*)(gr + bj * HALF + n * 16); f32x4 x = *(const f32x4*)(xr + bj * HALF + n * 16); x += g * acc[ai][bj][m][n]; *(f32x4*)(xr + bj * HALF + n * 16) = x; } }
    }
};
template <class Epi, class Sched, bool ALIGN_EPI = false, bool SP2 = false>
__device__ __forceinline__ void gemm_phase(PG8_LAS unsigned char* lds, const Gemm g, const Sched& S, const Epi& E) {
    int tid_ = threadIdx.x; asm volatile("" : "+v"(tid_));
    const int tid = tid_, wid = __builtin_amdgcn_readfirstlane(tid >> 6), lane = tid & 63, wr = wid >> 2, wc = wid & 3, fr = lane & 15, fq = lane >> 4;
    const int K = g.K, nt = K / BK;
    unsigned voffA[2], voffB[2];
#pragma unroll
    for (int i = 0; i < 2; ++i) { int R, C; stage_rc(tid * 16 + i * 8192, R, C); const int Rb = Epi::PERM ? ((R & ~31) + perm32(R & 31)) : R;
        voffA[i] = (unsigned)(R * K + C) * 2u; voffB[i] = (unsigned)(Rb * K + C) * 2u; }
    const size_t kstep = (size_t)(BK * 2);
    const size_t hstep = (size_t)HALF * K * 2;
    const size_t tstep = 2 * hstep;
    const unsigned ldsw = (unsigned)wid * 1024u;
    const int aoff = lds_byte(wr * 64 + fr, fq * 8), boff = lds_byte(wc * 32 + fr, fq * 8);
#define PG8_SA(b, h) (((b) * 2 + (h)) * HTB)
#define PG8_SB(b, h) ((4 + (b) * 2 + (h)) * HTB)
#define PG8_STAGE(bufoff, gbase, voff) do { _Pragma("unroll") for (int _i = 0; _i < 2; ++_i) \
        __builtin_amdgcn_global_load_lds((const unsigned*)((const char*)(gbase) + (voff)[_i]), (PG8_LAS unsigned*)(lds + (bufoff) + ldsw + _i * 8192), 16, 0, 0); } while (0)
#define PG8_LDA(dst, b, h) do { _Pragma("unroll") for (int m = 0; m < 4; ++m) _Pragma("unroll") for (int k = 0; k < 2; ++k) dst[m][k] = *(const PG8_LAS bf16x8*)(lds + PG8_SA(b, h) + aoff + m * 2048 + k * 1024); } while (0)
#define PG8_LDB(dst, b, h) do { _Pragma("unroll") for (int n = 0; n < 2; ++n) _Pragma("unroll") for (int k = 0; k < 2; ++k) dst[n][k] = *(const PG8_LAS bf16x8*)(lds + PG8_SB(b, h) + boff + n * 2048 + k * 1024); } while (0)
#define PG8_MMA(ai, bj, At, Bt) do { __builtin_amdgcn_s_setprio(1); _Pragma("unroll") for (int m = 0; m < 4; ++m) _Pragma("unroll") for (int n = 0; n < 2; ++n) _Pragma("unroll") for (int k = 0; k < 2; ++k) \
        acc[ai][bj][m][n] = __builtin_amdgcn_mfma_f32_16x16x32_bf16(Bt[n][k], At[m][k], acc[ai][bj][m][n], 0, 0, 0); __builtin_amdgcn_s_setprio(0); } while (0)
#define PG8_WAIT_V(n) asm volatile("s_waitcnt vmcnt(" #n ")" ::: "memory")
#define PG8_WAIT_L(n) asm volatile("s_waitcnt lgkmcnt(" #n ")" ::: "memory")
#define PG8_BAR __builtin_amdgcn_s_barrier()
#define PG8_SCHED __builtin_amdgcn_sched_barrier(0)
    Unit cur, nxt; int ui = 0;
    if (!S.next(0, cur)) return;
    f32x4 acc[2][2][4][2];
#pragma unroll
    for (int a = 0; a < 2; ++a)
#pragma unroll
        for (int b = 0; b < 2; ++b)
#pragma unroll
            for (int m = 0; m < 4; ++m)
#pragma unroll
                for (int n = 0; n < 2; ++n) acc[a][b][m][n] = (f32x4){0.f, 0.f, 0.f, 0.f};
    bf16x8 At[4][2], B0[2][2], B1[2][2];
    const char* cA = (const char*)g.A + (size_t)cur.pm * tstep; const char* cB = (const char*)g.Bt + (size_t)cur.pn * tstep;
    S.a_ready(cur);
    if constexpr (SP2) {
        PG8_STAGE(PG8_SB(0, 0), cB, voffB); PG8_STAGE(PG8_SB(0, 1), cB + hstep, voffB); PG8_STAGE(PG8_SA(0, 0), cA, voffA); PG8_STAGE(PG8_SA(0, 1), cA + hstep, voffA);
        if (wr == 1) PG8_BAR;
        PG8_WAIT_V(2); PG8_BAR;
        PG8_STAGE(PG8_SB(1, 0), cB + kstep, voffB); PG8_STAGE(PG8_SA(1, 0), cA + kstep, voffA); PG8_STAGE(PG8_SB(1, 1), cB + hstep + kstep, voffB);
        PG8_WAIT_V(6); PG8_BAR;
    } else {
        PG8_STAGE(PG8_SB(0, 0), cB, voffB); PG8_STAGE(PG8_SA(0, 0), cA, voffA); PG8_STAGE(PG8_SB(0, 1), cB + hstep, voffB); PG8_STAGE(PG8_SA(0, 1), cA + hstep, voffA);
        if (wr == 1) PG8_BAR;
        PG8_WAIT_V(4); PG8_BAR;
        PG8_STAGE(PG8_SB(1, 0), cB + kstep, voffB); PG8_STAGE(PG8_SA(1, 0), cA + kstep, voffA); PG8_STAGE(PG8_SB(1, 1), cB + hstep + kstep, voffB);
        PG8_WAIT_V(6); PG8_BAR;
    }
    for (;;) {
        const bool has_next = S.next(ui + 1, nxt);
        const char* nA = has_next ? (const char*)g.A + (size_t)nxt.pm * tstep : cA; const char* nB = has_next ? (const char*)g.Bt + (size_t)nxt.pn * tstep : cB;
        for (int t = 0; t < nt; t += 2) {
            const bool last = (t == nt - 2);
            const char* a1 = cA + (size_t)(t + 1) * kstep;
            const char* a2 = last ? nA : cA + (size_t)(t + 2) * kstep; const char* b2 = last ? nB : cB + (size_t)(t + 2) * kstep;
            const char* a3 = a2 + kstep; const char* b3 = b2 + kstep;
            if (last && has_next) S.a_ready(nxt);
            if constexpr (SP2) {
            PG8_LDB(B0, 0, 0); PG8_LDB(B1, 0, 1); PG8_SCHED; PG8_LDA(At, 0, 0); PG8_STAGE(PG8_SA(1, 1), a1 + hstep, voffA);
            PG8_WAIT_V(8); PG8_WAIT_L(0); PG8_BAR; PG8_MMA(0, 0, At, B0); PG8_MMA(0, 1, At, B1); PG8_BAR; PG8_SCHED;
            PG8_LDA(At, 0, 1); PG8_STAGE(PG8_SB(0, 0), b2, voffB); PG8_STAGE(PG8_SB(0, 1), b2 + hstep, voffB); PG8_STAGE(PG8_SA(0, 0), a2, voffA);
            PG8_WAIT_V(8); PG8_WAIT_L(0); PG8_BAR; PG8_MMA(1, 0, At, B0); PG8_MMA(1, 1, At, B1); PG8_BAR; PG8_SCHED;
            PG8_LDB(B0, 1, 0); PG8_LDB(B1, 1, 1); PG8_SCHED; PG8_LDA(At, 1, 0); PG8_STAGE(PG8_SA(0, 1), a2 + hstep, voffA);
            PG8_WAIT_V(8); PG8_WAIT_L(0); PG8_BAR; PG8_MMA(0, 0, At, B0); PG8_MMA(0, 1, At, B1); PG8_BAR; PG8_SCHED;
            PG8_LDA(At, 1, 1); PG8_STAGE(PG8_SB(1, 0), b3, voffB); PG8_STAGE(PG8_SB(1, 1), b3 + hstep, voffB); PG8_STAGE(PG8_SA(1, 0), a3, voffA);
            PG8_WAIT_V(8); PG8_WAIT_L(0); PG8_BAR; PG8_MMA(1, 0, At, B0); PG8_MMA(1, 1, At, B1); PG8_BAR; PG8_SCHED;
            } else {
            PG8_LDB(B0, 0, 0); PG8_SCHED; PG8_LDA(At, 0, 0); PG8_STAGE(PG8_SA(1, 1), a1 + hstep, voffA);
            PG8_WAIT_L(8); PG8_BAR; PG8_WAIT_L(0); PG8_MMA(0, 0, At, B0); PG8_BAR; PG8_SCHED;
            PG8_LDB(B1, 0, 1); PG8_STAGE(PG8_SB(0, 0), b2, voffB);
            PG8_BAR; PG8_WAIT_L(0); PG8_MMA(0, 1, At, B1); PG8_BAR;
            PG8_LDA(At, 0, 1); PG8_STAGE(PG8_SA(0, 0), a2, voffA);
            PG8_BAR; PG8_WAIT_L(0); PG8_MMA(1, 0, At, B0); PG8_BAR; PG8_SCHED;
            PG8_STAGE(PG8_SB(0, 1), b2 + hstep, voffB);
            PG8_WAIT_V(6); PG8_BAR; PG8_MMA(1, 1, At, B1); PG8_BAR;
            PG8_LDB(B0, 1, 0); PG8_SCHED; PG8_LDA(At, 1, 0); PG8_STAGE(PG8_SA(0, 1), a2 + hstep, voffA);
            PG8_WAIT_L(8); PG8_BAR; PG8_WAIT_L(0); PG8_MMA(0, 0, At, B0); PG8_BAR; PG8_SCHED;
            PG8_LDB(B1, 1, 1); PG8_STAGE(PG8_SB(1, 0), b3, voffB);
            PG8_BAR; PG8_WAIT_L(0); PG8_MMA(0, 1, At, B1); PG8_BAR;
            PG8_LDA(At, 1, 1); PG8_STAGE(PG8_SA(1, 0), a3, voffA);
            PG8_BAR; PG8_WAIT_L(0); PG8_MMA(1, 0, At, B0); PG8_BAR; PG8_SCHED;
            PG8_STAGE(PG8_SB(1, 1), b3 + hstep, voffB);
            PG8_WAIT_V(6); PG8_BAR; PG8_MMA(1, 1, At, B1); PG8_BAR;
            }
        }
        if constexpr (ALIGN_EPI) { if (wr == 0) PG8_BAR; }
        if constexpr (!Epi::AFTER_DRAIN) { E(acc, cur, wr, wc, fr, fq); S.done(cur); }
        if (!has_next) break;
#pragma unroll
        for (int a = 0; a < 2; ++a)
#pragma unroll
            for (int b = 0; b < 2; ++b)
#pragma unroll
                for (int m = 0; m < 4; ++m)
#pragma unroll
                    for (int n = 0; n < 2; ++n) acc[a][b][m][n] = (f32x4){0.f, 0.f, 0.f, 0.f};
        cur = nxt; cA = nA; cB = nB; ++ui;
        if constexpr (ALIGN_EPI) { if (wr == 1) PG8_BAR; }
    }
    PG8_WAIT_V(0);
    if constexpr (!ALIGN_EPI) { if (wr == 0) PG8_BAR; }
    PG8_BAR;
    if constexpr (Epi::AFTER_DRAIN) { E.fused(acc, cur, wr, wc, fr, fq, lds, wid, lane); S.done(cur); }
#undef PG8_SA
#undef PG8_SB
#undef PG8_STAGE
#undef PG8_LDA
#undef PG8_LDB
#undef PG8_MMA
#undef PG8_WAIT_V
#undef PG8_WAIT_L
#undef PG8_BAR
#undef PG8_SCHED
}
}

struct Ctx {
    unsigned aoff; int l;
    float* X; bf16_t* H; bf16_t* P; bf16_t* MIX; bf16_t* QP; float* OF; float* OB; int* PIDX; float* PG; float* MOD; float* LB; float* ROPE; bf16_t* WIN; bf16_t* WOUT; bf16_t* WQ; bf16_t* UB; bf16_t* VB; float* ST; float* AC; float* PA;
    unsigned char* lds; int tid, lane, wave, gw, ngw, bid, nb;
    int xg, nxg, jx, nloc;
};

#define LAS __attribute__((address_space(3)))
DI void transpose_item(const float* W, int Kd, int N, bf16_t* WT, LAS float* scr, int item, int lane) {
    const int nblk = N / 32, kb = item / nblk, nb = item % nblk, k0 = 64 * kb, n0 = 32 * nb;
#pragma unroll 8
    for (int i = 0; i < 32; ++i) { const int kk = 2 * i + (lane >> 5); scr[kk * 33 + (lane & 31)] = W[(size_t)(k0 + kk) * N + n0 + (lane & 31)]; }
    asm volatile("s_waitcnt lgkmcnt(0)" ::: "memory");
    const int c = lane & 7;
#pragma unroll
    for (int j = 0; j < 4; ++j) { const int n = (lane >> 3) + 8 * j; const LAS float* sp = scr + (8 * c) * 33 + n;
        u32x4 o; o.x = pk2(sp[0 * 33], sp[1 * 33]); o.y = pk2(sp[2 * 33], sp[3 * 33]); o.z = pk2(sp[4 * 33], sp[5 * 33]); o.w = pk2(sp[6 * 33], sp[7 * 33]);
        *(u32x4*)(WT + (size_t)(n0 + n) * Kd + k0 + 8 * c) = o; }
    asm volatile("s_waitcnt lgkmcnt(0)" ::: "memory");
}

template <class T> DI T* argp_(const Ctx& K, unsigned off) {
    const unsigned* p = (const unsigned*)(K.lds + K.aoff + off);
    const unsigned lo = __builtin_amdgcn_readfirstlane(p[0]), hi = __builtin_amdgcn_readfirstlane(p[1]);
    return (T*)(((unsigned long long)hi << 32) | (unsigned long long)lo);
}
#define ARG(f) argp_<const float>(K, (unsigned)__builtin_offsetof(Args, f))

DI void ph_prologue(Ctx& K) {
    {
        LAS float* scr = (LAS float*)((LAS unsigned char*)K.lds + K.wave * 16384);
        constexpr int I_IN = (D / 64) * (PW / 32), I_OUT = (D / 64) * (D / 32), I_Q = (D / 64) * (2048 / 32), I_L = I_IN + I_OUT + I_Q;
        for (int it = K.gw; it < DEPTH * I_L; it += K.ngw) {
            const int l = it / I_L; int r = it % I_L;
            if (r < I_IN) { transpose_item(ARG(w_in) + (size_t)l * D * PW, D, PW, K.WIN + (size_t)l * PW * D, scr, r, K.lane); continue; } r -= I_IN;
            if (r < I_OUT) { transpose_item(ARG(w_out) + (size_t)l * D * D, D, D, K.WOUT + (size_t)l * D * D, scr, r, K.lane); continue; } r -= I_OUT;
            transpose_item(ARG(peer_wq) + (size_t)l * D * 2048, D, 2048, K.WQ + (size_t)l * 2048 * D, scr, r, K.lane);
        }
    }
    const size_t gt = (size_t)K.bid * NTHREADS + K.tid, gs = (size_t)K.nb * NTHREADS;
    { const f32x4* s0 = (const f32x4*)ARG(ctx); const f32x4* s1 = (const f32x4*)ARG(x); f32x4* d = (f32x4*)K.X;
      const size_t n0 = (size_t)NCTX * D / 4, n1 = (size_t)NLAT * D / 4;
      for (size_t i = gt; i < n0 + n1; i += gs) d[i] = i < n0 ? s0[i] : s1[i - n0]; }
    { const size_t n8 = (size_t)DEPTH * 16384 * D / 8;
      for (size_t i = gt; i < 2 * n8; i += gs) {
          const bool isv = i >= n8; const size_t j = isv ? i - n8 : i;
          const f32x4* src = (const f32x4*)(isv ? ARG(peer_v) : ARG(peer_u)) + 2 * j; const f32x4 a = src[0], b = src[1];
          u32x4 o; o.x = pk2(a.x, a.y); o.y = pk2(a.z, a.w); o.z = pk2(b.x, b.y); o.w = pk2(b.z, b.w);
          if (!isv) ((u32x4*)K.UB)[j] = o;
          else { const size_t el = j * 8, le = el >> 10, col = el & 1023, l = le >> 14, e = le & 16383;
                 *(u32x4*)(K.VB + ((l * 16 + (col >> 6)) * 16384 + e) * 64 + (col & 63)) = o; } } }
    { float* sv = (float*)K.lds;
      float* part = sv + 3 * D;
      __syncthreads();
      for (int i = K.tid; i < 3 * D; i += NTHREADS) { const int v = i / D, k = i % D; const float c = v < 2 ? ARG(c)[v * D + k] : ARG(c_ctx)[k]; sv[i] = c * sigmoidf_(c); }
      __syncthreads();
      for (int item = K.bid; item < DEPTH * 24; item += K.nb) {
          const int l = item / 24, cb = item % 24;
          const float* w = ARG(w_mod) + (size_t)l * D * 6 * D + cb * 256 + K.lane * 4;
          f32x4 a0 = {0.f, 0.f, 0.f, 0.f}, a1 = a0, a2 = a0;
#pragma unroll 8
          for (int kk = 0; kk < 128; ++kk) { const int k = K.wave * 128 + kk; const f32x4 wv = *(const f32x4*)(w + (size_t)k * 6 * D);
              a0 += wv * sv[k]; a1 += wv * sv[D + k]; a2 += wv * sv[2 * D + k]; }
          *(f32x4*)(part + (K.wave * 3 + 0) * 256 + K.lane * 4) = a0; *(f32x4*)(part + (K.wave * 3 + 1) * 256 + K.lane * 4) = a1; *(f32x4*)(part + (K.wave * 3 + 2) * 256 + K.lane * 4) = a2;
          __syncthreads();
          for (int i = K.tid; i < 768; i += NTHREADS) { const int v = i / 256, cc = i % 256; float sum = 0.f;
#pragma unroll
              for (int w8 = 0; w8 < 8; ++w8) sum += part[(w8 * 3 + v) * 256 + cc];
              const int col = cb * 256 + cc; K.MOD[((size_t)l * 3 + v) * 6 * D + col] = sum + ARG(b_mod)[(size_t)l * 6 * D + col]; }
          __syncthreads();
      } }
    for (size_t i = gt; i < 2 * 256; i += gs) {
        const int dir = (int)(i / 256), ch = (int)(i % 256);
        float lg[DEPTH], mx = -1e30f;
#pragma unroll
        for (int l = 0; l < DEPTH; ++l) { lg[l] = ARG(lb_logits)[((size_t)dir * DEPTH + l) * 256 + ch]; mx = fmaxf(mx, lg[l]); }
        float s = 0.f;
#pragma unroll
        for (int l = 0; l < DEPTH; ++l) { lg[l] = expf(lg[l] - mx); s += lg[l]; }
        float cum = 0.f;
#pragma unroll
        for (int l = 0; l < DEPTH; ++l) { if (l > 0) cum += lg[l] / s; K.LB[((size_t)dir * DEPTH + l) * 256 + ch] = cum; }
    }
    for (size_t i = gt; i < (256 + 64) * 16; i += gs) {
        const int pos = (int)(i / 16), f = (int)(i % 16);
        const float inv = powf(10000.0f, -(float)f / 16.0f);
        if (pos < 256) { const float ang = (float)pos * inv; K.ROPE[pos * 16 + f] = cosf(ang); K.ROPE[4096 + pos * 16 + f] = sinf(ang); }
        else { const int pc = pos - 256; const float ang = (float)pc * inv; K.ROPE[8192 + pc * 16 + f] = cosf(ang); K.ROPE[8192 + 1024 + pc * 16 + f] = sinf(ang); }
    }
}

DI void ph_norm(Ctx& K, const float* nw, int shift_chunk) {
    const float* modl = K.MOD + (size_t)K.l * 3 * 6 * D;
    for (int r = K.gw; r < M; r += K.ngw) {
        const f32x4* xr = (const f32x4*)(K.X + (size_t)r * D);
        f32x4 v[4]; float ss = 0.f;
#pragma unroll
        for (int j = 0; j < 4; ++j) { v[j] = xr[j * 64 + K.lane]; ss += v[j].x * v[j].x + v[j].y * v[j].y + v[j].z * v[j].z + v[j].w * v[j].w; }
        ss = wave_sum(ss);
        const float rs = rsqrtf(ss * (1.0f / D) + EPS);
        const float* mv = modl + (size_t)modvec_of_row(r) * 6 * D;
        u32x2* ho = (u32x2*)(K.H + (size_t)r * D);
#pragma unroll
        for (int j = 0; j < 4; ++j) {
            const int c4 = j * 64 + K.lane;
            const f32x4 w = ((const f32x4*)nw)[c4], sh = ((const f32x4*)(mv + shift_chunk * D))[c4], sc = ((const f32x4*)(mv + (shift_chunk + 1) * D))[c4];
            f32x4 y; y.x = v[j].x * rs * w.x * (1.f + sc.x) + sh.x; y.y = v[j].y * rs * w.y * (1.f + sc.y) + sh.y; y.z = v[j].z * rs * w.z * (1.f + sc.z) + sh.z; y.w = v[j].w * rs * w.w * (1.f + sc.w) + sh.w;
            u32x2 o; o.x = pk2(y.x, y.y); o.y = pk2(y.z, y.w); ho[c4] = o;
        }
    }
}

DI void ph_gemm_store(Ctx& K, const bf16_t* A, const bf16_t* Bt, int N, bf16_t* out) {
    pg8::Gemm g{A, Bt, M, N, D}; pg8::StaticOrder S; S.init(M, N, K.nb, K.bid);
    pg8::EpiStore E{out, N};
    pg8::gemm_phase<pg8::EpiStore, pg8::StaticOrder, true, true>((LAS unsigned char*)K.lds, g, S, E);
}
DI void ph_gemm_resid(Ctx& K, const bf16_t* A, const bf16_t* Bt, int chunk) {
    pg8::Gemm g{A, Bt, M, D, D}; pg8::StaticOrder S; S.init(M, D, K.nb, K.bid);
    pg8::EpiResid E{K.X, D, K.MOD + (size_t)K.l * 3 * 6 * D + (size_t)chunk * D, 6 * D, NCTX, L};
    pg8::gemm_phase<pg8::EpiResid, pg8::StaticOrder, true, true>((LAS unsigned char*)K.lds, g, S, E);
}

DI void ph_rope(Ctx& K) {
    const float* cosr = K.ROPE; const float* sinr = K.ROPE + 4096; const float* cosc = K.ROPE + 8192; const float* sinc = K.ROPE + 8192 + 1024;
    const size_t gt = (size_t)K.bid * NTHREADS + K.tid, gs = (size_t)K.nb * NTHREADS;
    for (size_t i = gt; i < (size_t)NLAT * 8 * 16; i += gs) {
        const int f = (int)(i & 15), hh = (int)((i >> 4) & 7), lr = (int)(i >> 7);
        const int t = lr % L, pr = t >> 6, pc = t & 63;
        bf16_t* p = K.P + (size_t)(NCTX + lr) * PW + (hh < 6 ? C_SQ + hh * 64 : C_SK + (hh - 6) * 64);
        const float c1 = cosr[pr * 16 + f], s1 = sinr[pr * 16 + f], c2 = cosc[pc * 16 + f], s2 = sinc[pc * 16 + f];
        const float a = bf2f(p[f]), b = bf2f(p[16 + f]), e = bf2f(p[32 + f]), g = bf2f(p[48 + f]);
        p[f] = f2bf(a * c1 - b * s1); p[16 + f] = f2bf(b * c1 + a * s1); p[32 + f] = f2bf(e * c2 - g * s2); p[48 + f] = f2bf(g * c2 + e * s2);
    }
}

typedef short bf16x8_t __attribute__((ext_vector_type(8)));
#define MFMA16(a, b, c) __builtin_amdgcn_mfma_f32_16x16x32_bf16((a), (b), (c), 0, 0, 0)
constexpr int HG_NCH = (CL + L) / 64;
constexpr int HG_LFS = 68;
constexpr int HG_TS = 72;
constexpr int HGL_LF = 0, HGL_OM = HGL_LF + 2 * 64 * HG_LFS * 4, HGL_VT = HGL_OM + 2 * 64 * HG_LFS * 4, HGL_KT = HGL_VT + 64 * HG_TS * 2, HGL_SC = HGL_KT, HGL_OD = HGL_SC + 8 * 16 * HG_TS * 2, HGL_END = HGL_OD + 2 * 64 * HG_LFS * 4;
static_assert(HGL_KT + 2 * 64 * HG_TS * 2 <= LDS_BYTES && HGL_END <= LDS_BYTES, "hgrn LDS map");
DI int hg_block_row(int b, int tb, int tok) { return tb < 4 ? ctx_row(b, tb * 64 + tok) : lat_row(b, (tb - 4) * 64 + tok); }
DI int hg_bwd_chunk(int tb) { return tb < 4 ? 3 - tb : 4 + 255 - (tb - 4); }
DI void hg_prep(Ctx& K, int b, int h, int tb) {
    float* LF = (float*)(K.lds + HGL_LF); float* OM = (float*)(K.lds + HGL_OM); bf16_t* VT = (bf16_t*)(K.lds + HGL_VT);
    const int tok = K.tid >> 3, c = K.tid & 7;
    const bf16_t* pr = K.P + (size_t)hg_block_row(b, tb, tok) * PW + h * 64 + 8 * c;
#pragma unroll
    for (int dir = 0; dir < 2; ++dir) {
        float z[8]; unpack8(*(const u32x4*)(pr + (dir ? C_ZB : C_ZF)), z);
        const float* lb = K.LB + ((size_t)dir * DEPTH + K.l) * 256 + h * 64 + 8 * c;
        float lf[8], om[8];
#pragma unroll
        for (int j = 0; j < 8; ++j) { const float lbv = lb[j], sg = sigmoidf_(z[j]); const float f = fmaxf(lbv + (1.f - lbv) * sg, 1e-30f); lf[j] = __logf(f); om[j] = (1.f - lbv) * (1.f - sg); }
        float* lfp = LF + (dir * 64 + tok) * HG_LFS + 8 * c; float* omp = OM + (dir * 64 + tok) * HG_LFS + 8 * c;
        *(f32x4*)lfp = (f32x4){lf[0], lf[1], lf[2], lf[3]}; *(f32x4*)(lfp + 4) = (f32x4){lf[4], lf[5], lf[6], lf[7]};
        *(f32x4*)omp = (f32x4){om[0], om[1], om[2], om[3]}; *(f32x4*)(omp + 4) = (f32x4){om[4], om[5], om[6], om[7]};
    }
    { const u32x4 v = *(const u32x4*)(pr + C_HV);
      const unsigned w[4] = {v.x, v.y, v.z, v.w};
#pragma unroll
      for (int j = 0; j < 4; ++j) { VT[(8 * c + 2 * j) * HG_TS + tok] = (bf16_t)(w[j] & 0xffffu); VT[(8 * c + 2 * j + 1) * HG_TS + tok] = (bf16_t)(w[j] >> 16); } }
    __syncthreads();
    if (K.tid < 128) {
        const int dir = K.tid >> 6, d = K.tid & 63; float* col = LF + dir * 64 * HG_LFS + d;
        float v[64];
#pragma unroll
        for (int p = 0; p < 64; ++p) v[p] = col[(dir ? 63 - p : p) * HG_LFS];
#pragma unroll
        for (int p = 1; p < 64; ++p) v[p] += v[p - 1];
#pragma unroll
        for (int p = 0; p < 64; ++p) col[(dir ? 63 - p : p) * HG_LFS] = v[p];
    }
    __syncthreads();
}
DI void ph_hgrn_A(Ctx& K) {
    float* LF = (float*)(K.lds + HGL_LF); float* OM = (float*)(K.lds + HGL_OM); bf16_t* VT = (bf16_t*)(K.lds + HGL_VT); bf16_t* KT = (bf16_t*)(K.lds + HGL_KT);
    const int r16 = K.lane & 15, g4 = K.lane >> 4;
    for (int item = K.bid; item < NB * 4 * HG_NCH; item += K.nb) {
        const int tb = item % HG_NCH, h = (item / HG_NCH) & 3, b = item / (HG_NCH * 4);
        __syncthreads();
        hg_prep(K, b, h, tb);
        { const int tok = K.tid >> 3, c = K.tid & 7;
#pragma unroll
          for (int dir = 0; dir < 2; ++dir) {
              const float* bl = LF + (dir * 64 + (dir ? 0 : 63)) * HG_LFS + 8 * c; const float* bt = LF + (dir * 64 + tok) * HG_LFS + 8 * c; const float* om = OM + (dir * 64 + tok) * HG_LFS + 8 * c;
#pragma unroll
              for (int j = 0; j < 8; ++j) KT[(dir * 64 + 8 * c + j) * HG_TS + tok] = f2bf(om[j] * __expf(bl[j] - bt[j]));
          }
          if (K.tid < 128) { const int dir = K.tid >> 6, d = K.tid & 63; const int chain = (b * 2 + dir) * 4 + h, ch = dir ? hg_bwd_chunk(tb) : tb;
              K.AC[((size_t)chain * HG_NCH + ch) * 64 + d] = __expf(LF[(dir * 64 + (dir ? 0 : 63)) * HG_LFS + d]); } }
        __syncthreads();
        { const int dir = K.wave >> 2, mi = K.wave & 3; const int chain = (b * 2 + dir) * 4 + h, ch = dir ? hg_bwd_chunk(tb) : tb;
          f32x4 acc[4];
#pragma unroll
          for (int nj = 0; nj < 4; ++nj) acc[nj] = (f32x4){0.f, 0.f, 0.f, 0.f};
#pragma unroll
          for (int ks = 0; ks < 2; ++ks) {
              const bf16x8_t av = *(const bf16x8_t*)(VT + (16 * mi + r16) * HG_TS + 32 * ks + 8 * g4);
#pragma unroll
              for (int nj = 0; nj < 4; ++nj) { const bf16x8_t bv = *(const bf16x8_t*)(KT + (dir * 64 + 16 * nj + r16) * HG_TS + 32 * ks + 8 * g4); acc[nj] = MFMA16(av, bv, acc[nj]); }
          }
          float* st = K.ST + ((size_t)chain * HG_NCH + ch) * 4096;
#pragma unroll
          for (int nj = 0; nj < 4; ++nj)
#pragma unroll
              for (int rg = 0; rg < 4; ++rg) st[(16 * mi + 4 * g4 + rg) * 64 + 16 * nj + r16] = acc[nj][rg];
        }
    }
}
DI void ph_hgrn_B(Ctx& K) {
    const int gt = K.bid * NTHREADS + K.tid;
    if (gt < 16 * 4096) {
        const int chain = gt >> 12, idx = gt & 4095, d = idx & 63;
        float* st = K.ST + (size_t)chain * HG_NCH * 4096 + idx; const float* ac = K.AC + (size_t)chain * HG_NCH * 64 + d;
        float S = 0.f;
#pragma unroll 1
        for (int c0 = 0; c0 < HG_NCH; c0 += 10) {
            float u[10], a[10];
#pragma unroll
            for (int i = 0; i < 10; ++i) { u[i] = st[(size_t)(c0 + i) * 4096]; a[i] = ac[(c0 + i) * 64]; }
#pragma unroll
            for (int i = 0; i < 10; ++i) { st[(size_t)(c0 + i) * 4096] = S; S = a[i] * S + u[i]; }
        }
    }
}
DI void ph_hgrn_C(Ctx& K) {
    float* LF = (float*)(K.lds + HGL_LF); float* OM = (float*)(K.lds + HGL_OM); bf16_t* VT = (bf16_t*)(K.lds + HGL_VT); float* OD = (float*)(K.lds + HGL_OD);
    bf16_t* SC = (bf16_t*)(K.lds + HGL_SC) + K.wave * 16 * HG_TS;
    const int r16 = K.lane & 15, g4 = K.lane >> 4;
    for (int item = K.bid; item < NB * 4 * HG_NCH; item += K.nb) {
        const int tb = item % HG_NCH, h = (item / HG_NCH) & 3, b = item / (HG_NCH * 4);
        __syncthreads();
        hg_prep(K, b, h, tb);
        { const int dir = K.wave >> 2, mi = K.wave & 3; const int chain = (b * 2 + dir) * 4 + h, ch = dir ? hg_bwd_chunk(tb) : tb;
          const float* LFd = LF + dir * 64 * HG_LFS; const float* OMd = OM + dir * 64 * HG_LFS; const float* ref = LFd + 32 * HG_LFS;
          bf16x8_t aq1[2], aq2[2];
          { const int t = 16 * mi + r16; const bf16_t* qr = K.P + (size_t)hg_block_row(b, tb, t) * PW + C_HQ + h * 64;
#pragma unroll
            for (int ks = 0; ks < 2; ++ks) { const int d0 = 32 * ks + 8 * g4; float q[8]; unpack8(*(const u32x4*)(qr + d0), q);
                u32x4 w1, w2; unsigned o1[4], o2[4];
#pragma unroll
                for (int j = 0; j < 4; ++j) { float x1[2], x2[2];
#pragma unroll
                    for (int e = 0; e < 2; ++e) { const int dd = d0 + 2 * j + e; const float qs = q[2 * j + e] * sigmoidf_(q[2 * j + e]); const float bt = LFd[t * HG_LFS + dd]; x1[e] = qs * __expf(bt - ref[dd]); x2[e] = qs * __expf(bt); }
                    o1[j] = pk2(x1[0], x1[1]); o2[j] = pk2(x2[0], x2[1]); }
                w1 = (u32x4){o1[0], o1[1], o1[2], o1[3]}; w2 = (u32x4){o2[0], o2[1], o2[2], o2[3]};
                aq1[ks] = __builtin_bit_cast(bf16x8_t, w1); aq2[ks] = __builtin_bit_cast(bf16x8_t, w2); } }
          f32x4 sc[4];
#pragma unroll
          for (int nj = 0; nj < 4; ++nj) { sc[nj] = (f32x4){0.f, 0.f, 0.f, 0.f}; const int s_ = 16 * nj + r16;
#pragma unroll
              for (int ks = 0; ks < 2; ++ks) { const int d0 = 32 * ks + 8 * g4; unsigned o[4];
#pragma unroll
                  for (int j = 0; j < 4; ++j) { const int dd = d0 + 2 * j; o[j] = pk2(OMd[s_ * HG_LFS + dd] * __expf(ref[dd] - LFd[s_ * HG_LFS + dd]), OMd[s_ * HG_LFS + dd + 1] * __expf(ref[dd + 1] - LFd[s_ * HG_LFS + dd + 1])); }
                  const u32x4 w = (u32x4){o[0], o[1], o[2], o[3]};
                  sc[nj] = MFMA16(aq1[ks], __builtin_bit_cast(bf16x8_t, w), sc[nj]); } }
#pragma unroll
          for (int nj = 0; nj < 4; ++nj)
#pragma unroll
              for (int rg = 0; rg < 4; ++rg) { const int tl = 4 * g4 + rg, t = 16 * mi + tl, s_ = 16 * nj + r16; const bool keep = dir ? (s_ >= t) : (s_ <= t);
                  SC[tl * HG_TS + s_] = f2bf(keep ? sc[nj][rg] : 0.f); }
          asm volatile("s_waitcnt lgkmcnt(0)" ::: "memory");
          f32x4 oacc[4];
#pragma unroll
          for (int nj = 0; nj < 4; ++nj) oacc[nj] = (f32x4){0.f, 0.f, 0.f, 0.f};
          const float* st = K.ST + ((size_t)chain * HG_NCH + ch) * 4096;
#pragma unroll
          for (int ks = 0; ks < 2; ++ks) {
              const bf16x8_t as = *(const bf16x8_t*)(SC + r16 * HG_TS + 32 * ks + 8 * g4);
#pragma unroll
              for (int nj = 0; nj < 4; ++nj) {
                  const bf16x8_t bv = *(const bf16x8_t*)(VT + (16 * nj + r16) * HG_TS + 32 * ks + 8 * g4);
                  oacc[nj] = MFMA16(as, bv, oacc[nj]);
                  const float* sp = st + (16 * nj + r16) * 64 + 32 * ks + 8 * g4; const f32x4 s0 = *(const f32x4*)sp, s1 = *(const f32x4*)(sp + 4);
                  const u32x4 w = (u32x4){pk2(s0.x, s0.y), pk2(s0.z, s0.w), pk2(s1.x, s1.y), pk2(s1.z, s1.w)};
                  oacc[nj] = MFMA16(aq2[ks], __builtin_bit_cast(bf16x8_t, w), oacc[nj]);
              }
          }
#pragma unroll
          for (int nj = 0; nj < 4; ++nj)
#pragma unroll
              for (int rg = 0; rg < 4; ++rg) OD[(dir * 64 + 16 * mi + 4 * g4 + rg) * HG_LFS + 16 * nj + r16] = oacc[nj][rg];
        }
        __syncthreads();
        { const int tok = K.tid >> 3, c = K.tid & 7; const int row = hg_block_row(b, tb, tok);
          const float* o0 = OD + tok * HG_LFS + 8 * c; const float* o1 = OD + (64 + tok) * HG_LFS + 8 * c;
          float o[8], ss = 0.f;
#pragma unroll
          for (int j = 0; j < 8; ++j) { o[j] = o0[j] + o1[j]; ss += o[j] * o[j]; }
          ss += __shfl_xor(ss, 1); ss += __shfl_xor(ss, 2); ss += __shfl_xor(ss, 4);
          const float rs = rsqrtf(ss * (1.0f / 64.0f) + EPS);
          float gq[8]; unpack8(*(const u32x4*)(K.P + (size_t)row * PW + C_HG + h * 64 + 8 * c), gq);
          const float* nw = ARG(hgrn_norm_w) + (size_t)K.l * 256 + h * 64 + 8 * c;
          float y[8];
#pragma unroll
          for (int j = 0; j < 8; ++j) y[j] = o[j] * rs * nw[j] * gq[j] * sigmoidf_(gq[j]);
          u32x4 w; w.x = pk2(y[0], y[1]); w.y = pk2(y[2], y[3]); w.z = pk2(y[4], y[5]); w.w = pk2(y[6], y[7]);
          *(u32x4*)(K.MIX + (size_t)row * D + MX_H + h * 64 + 8 * c) = w; }
    }
}

constexpr int AT_TS = 72;
constexpr int ATL_K = 0, ATL_V = ATL_K + 64 * AT_TS * 2, ATL_P = ATL_V + 64 * AT_TS * 2, ATL_END = ATL_P + 8 * 48 * AT_TS * 2;
static_assert(ATL_END <= LDS_BYTES - 256, "attention LDS map");
DI float dpp_max16(float x) { x = fmaxf(x, dpp_<0xB1>(x)); x = fmaxf(x, dpp_<0x4E>(x)); x = fmaxf(x, dpp_<0x141>(x)); x = fmaxf(x, dpp_<0x128>(x)); return x; }
DI float dpp_sum16(float x) { x += dpp_<0xB1>(x); x += dpp_<0x4E>(x); x += dpp_<0x141>(x); x += dpp_<0x128>(x); return x; }
template <int KIND> DI void attn_item(Ctx& K, int idx, const float* sinkp, const float* rpbp) {
    constexpr int MT = KIND == 0 ? 3 : 2;
    int tid_ = K.tid; asm volatile("" : "+v"(tid_));
    const int lane_ = tid_ & 63, wave_ = tid_ >> 6;
    bf16_t* KT = (bf16_t*)(K.lds + ATL_K); bf16_t* VT = (bf16_t*)(K.lds + ATL_V); bf16_t* PS = (bf16_t*)(K.lds + ATL_P) + wave_ * 48 * AT_TS;
    const int r16 = lane_ & 15, g4 = lane_ >> 4;
    int b, hk, qb = 0;
    if (KIND == 0) { qb = idx & 127; hk = (idx >> 7) & 1; b = idx >> 8; }
    else if (KIND == 1) { qb = idx & 63; hk = (idx >> 6) % 6; b = (idx >> 6) / 6; }
    else { hk = idx % 6; b = idx / 6; }
    const int kcol = (KIND == 0) ? C_SK + hk * 64 : (KIND == 2) ? C_SK + (hk / 3) * 64 : C_NK + hk * 64;
    const int vcol = (KIND == 0) ? C_SV + hk * 64 : (KIND == 2) ? C_SV + (hk / 3) * 64 : C_NV + hk * 64;
    int t0 = 0, nloc = 0;
    if (KIND == 0) { const int k0 = max(2 * qb - 2, 0), k1 = min(2 * qb + 3, L / 64 - 1); t0 = k0; nloc = k1 - k0 + 1; }
    if (KIND == 1) { const int k0 = min(max(4 * qb - 4, 0), L / 64 - 8), k1 = min(max(4 * qb + 3 - 4, 0), L / 64 - 8) + 7; t0 = k0; nloc = k1 - k0 + 1; }
    const int ntiles = nloc + CL / 64;
    int w_r = 0, w_rs = 0;
    if (KIND == 1) { w_r = 4 * qb + (wave_ >> 1); w_rs = min(max(w_r - 4, 0), L / 64 - 8); }
    bf16x8_t qf[MT][2]; int qbase[MT], hq_mt[MT];
#pragma unroll
    for (int mt = 0; mt < MT; ++mt) {
        int arow, hq;
        if (KIND == 0) { const int rho = wave_ * 48 + mt * 16; hq = hk * 3 + rho / 128; hq_mt[mt] = hq; const int tb = 128 * qb + (rho & 127); arow = lat_row(b, tb + r16); qbase[mt] = tb; }
        else if (KIND == 1) { hq = hk; hq_mt[mt] = hq; const int cb = 32 * (wave_ & 1) + 16 * mt; arow = lat_row(b, w_r * 64 + cb + r16); qbase[mt] = cb; }
        else { hq = hk; hq_mt[mt] = hq; const int tb = wave_ * 32 + mt * 16; arow = ctx_row(b, tb + r16); qbase[mt] = 0; }
        const int qcol = (KIND == 0 || KIND == 2) ? C_SQ + hq * 64 : C_NQ + hq * 64;
#pragma unroll
        for (int ks = 0; ks < 2; ++ks) { float q[8]; unpack8(*(const u32x4*)(K.P + (size_t)arow * PW + qcol + 32 * ks + 8 * g4), q);
            const u32x4 w = (u32x4){pk2(q[0] * 0.125f, q[1] * 0.125f), pk2(q[2] * 0.125f, q[3] * 0.125f), pk2(q[4] * 0.125f, q[5] * 0.125f), pk2(q[6] * 0.125f, q[7] * 0.125f)};
            qf[mt][ks] = __builtin_bit_cast(bf16x8_t, w); }
    }
    f32x4 oacc[MT][4]; float mrun[MT][4], lrun[MT][4];
#pragma unroll
    for (int mt = 0; mt < MT; ++mt) {
#pragma unroll
        for (int ne = 0; ne < 4; ++ne) oacc[mt][ne] = (f32x4){0.f, 0.f, 0.f, 0.f};
        const bool has_sink = (KIND == 0 || KIND == 2); const float sk = has_sink ? sinkp[hq_mt[mt]] : -1.0e30f;
#pragma unroll
        for (int rg = 0; rg < 4; ++rg) { mrun[mt][rg] = sk; lrun[mt][rg] = has_sink ? 1.0f : 0.0f; }
    }
    const int lkey = tid_ >> 3, lch = tid_ & 7;
    u32x4 pk_, pv_;
    { const int ti = 0; const int grow = (ti < nloc) ? lat_row(b, (t0 + ti) * 64 + lkey) : ctx_row(b, (ti - nloc) * 64 + lkey);
      const bf16_t* pr = K.P + (size_t)grow * PW + 8 * lch; pk_ = *(const u32x4*)(pr + kcol); pv_ = *(const u32x4*)(pr + vcol); }
#pragma unroll 1
    for (int ti = 0; ti < ntiles; ++ti) {
        __syncthreads();
        *(u32x4*)(KT + lkey * AT_TS + 8 * lch) = pk_;
        { const unsigned w[4] = {pv_.x, pv_.y, pv_.z, pv_.w};
#pragma unroll
          for (int j = 0; j < 4; ++j) { VT[(8 * lch + 2 * j) * AT_TS + lkey] = (bf16_t)(w[j] & 0xffffu); VT[(8 * lch + 2 * j + 1) * AT_TS + lkey] = (bf16_t)(w[j] >> 16); } }
        __syncthreads();
        if (ti + 1 < ntiles) { const int tn = ti + 1; const int grow = (tn < nloc) ? lat_row(b, (t0 + tn) * 64 + lkey) : ctx_row(b, (tn - nloc) * 64 + lkey);
            const bf16_t* pr = K.P + (size_t)grow * PW + 8 * lch; pk_ = *(const u32x4*)(pr + kcol); pv_ = *(const u32x4*)(pr + vcol); }
        const bool local = ti < nloc; const int kunit = t0 + ti;
        bool active = true;
        if (KIND == 0 && local) active = true;
        if (KIND == 1 && local) active = (kunit >= w_rs) && (kunit < w_rs + 8);
        if (active) {
            f32x4 sc[MT][4];
#pragma unroll
            for (int mt = 0; mt < MT; ++mt)
#pragma unroll
                for (int nj = 0; nj < 4; ++nj) sc[mt][nj] = (f32x4){0.f, 0.f, 0.f, 0.f};
#pragma unroll
            for (int nj = 0; nj < 4; ++nj)
#pragma unroll
                for (int ks = 0; ks < 2; ++ks) { const bf16x8_t kf = *(const bf16x8_t*)(KT + (16 * nj + r16) * AT_TS + 32 * ks + 8 * g4);
#pragma unroll
                    for (int mt = 0; mt < MT; ++mt) sc[mt][nj] = MFMA16(qf[mt][ks], kf, sc[mt][nj]); }
            if (local) {
#pragma unroll
                for (int mt = 0; mt < MT; ++mt)
#pragma unroll
                    for (int nj = 0; nj < 4; ++nj)
#pragma unroll
                        for (int rg = 0; rg < 4; ++rg) { const int key = 16 * nj + r16;
                            if (KIND == 0) { const int dl = qbase[mt] + 4 * g4 + rg - (kunit * 64 + key); if (dl > 128 || dl < -128) sc[mt][nj][rg] = -INFINITY; }
                            if (KIND == 1) { const int c = qbase[mt] + 4 * g4 + rg, ws = min(max(c - 8, 0), 48);
                                if (key >= ws && key < ws + 16) sc[mt][nj][rg] += rpbp[(kunit - w_r + 7) * 31 + (key - c + 15)]; else sc[mt][nj][rg] = -INFINITY; } }
            }
#pragma unroll
            for (int mt = 0; mt < MT; ++mt)
#pragma unroll
                for (int rg = 0; rg < 4; ++rg) {
                    float mx = fmaxf(fmaxf(sc[mt][0][rg], sc[mt][1][rg]), fmaxf(sc[mt][2][rg], sc[mt][3][rg]));
                    mx = dpp_max16(mx);
                    const float mn = fmaxf(mrun[mt][rg], mx), alpha = __expf(mrun[mt][rg] - mn); mrun[mt][rg] = mn;
                    float rs_ = 0.f;
#pragma unroll
                    for (int nj = 0; nj < 4; ++nj) { const float pe = __expf(sc[mt][nj][rg] - mn); sc[mt][nj][rg] = pe; rs_ += pe; }
                    rs_ = dpp_sum16(rs_);
                    lrun[mt][rg] = lrun[mt][rg] * alpha + rs_;
#pragma unroll
                    for (int ne = 0; ne < 4; ++ne) oacc[mt][ne][rg] *= alpha;
                }
#pragma unroll
            for (int mt = 0; mt < MT; ++mt)
#pragma unroll
                for (int nj = 0; nj < 4; ++nj)
#pragma unroll
                    for (int rg = 0; rg < 4; ++rg) PS[(16 * mt + 4 * g4 + rg) * AT_TS + 16 * nj + r16] = f2bf(sc[mt][nj][rg]);
            asm volatile("s_waitcnt lgkmcnt(0)" ::: "memory");
#pragma unroll
            for (int ks = 0; ks < 2; ++ks) {
                bf16x8_t pf[MT];
#pragma unroll
                for (int mt = 0; mt < MT; ++mt) pf[mt] = *(const bf16x8_t*)(PS + (16 * mt + r16) * AT_TS + 32 * ks + 8 * g4);
#pragma unroll
                for (int ne = 0; ne < 4; ++ne) { const bf16x8_t vf = *(const bf16x8_t*)(VT + (16 * ne + r16) * AT_TS + 32 * ks + 8 * g4);
#pragma unroll
                    for (int mt = 0; mt < MT; ++mt) oacc[mt][ne] = MFMA16(pf[mt], vf, oacc[mt][ne]); }
            }
            asm volatile("s_waitcnt lgkmcnt(0)" ::: "memory");
        }
    }
#pragma unroll
    for (int mt = 0; mt < MT; ++mt)
#pragma unroll
        for (int rg = 0; rg < 4; ++rg) { const float inv = 1.0f / lrun[mt][rg];
#pragma unroll
            for (int ne = 0; ne < 4; ++ne) PS[(16 * mt + 4 * g4 + rg) * AT_TS + 16 * ne + r16] = f2bf(oacc[mt][ne][rg] * inv); }
    asm volatile("s_waitcnt lgkmcnt(0)" ::: "memory");
#pragma unroll
    for (int mt = 0; mt < MT; ++mt) {
        const int ocol = ((KIND == 0 || KIND == 2) ? MX_S : MX_N) + hq_mt[mt] * 64;
#pragma unroll
        for (int i = 0; i < 2; ++i) { const int rr = (lane_ >> 3) + 8 * i, ch = lane_ & 7;
            const u32x4 v = *(const u32x4*)(PS + (16 * mt + rr) * AT_TS + 8 * ch);
            int grow;
            if (KIND == 0) { const int rho = wave_ * 48 + mt * 16; grow = lat_row(b, 128 * qb + (rho & 127) + rr); }
            else if (KIND == 1) grow = lat_row(b, w_r * 64 + 32 * (wave_ & 1) + 16 * mt + rr);
            else grow = ctx_row(b, wave_ * 32 + mt * 16 + rr);
            *(u32x4*)(K.MIX + (size_t)grow * D + ocol + 8 * ch) = v; }
    }
    asm volatile("s_waitcnt lgkmcnt(0)" ::: "memory");
}
DI void ph_attn(Ctx& K) {
    constexpr int N_SWA = NB * 2 * (L / 128), N_NAT = NB * 6 * (L / 256), N_C = NB * 6;
    const float* sinkp = ARG(swa_sink) + K.l * 6;
    for (int item = K.bid; item < N_SWA + N_NAT + 2 * N_C; item += K.nb) {
        if (item < N_SWA) attn_item<0>(K, item, sinkp, nullptr);
        else if (item < N_SWA + N_NAT) { const int it = item - N_SWA; const int h = (it >> 6) % 6; attn_item<1>(K, it, nullptr, ARG(nat_rpb) + ((size_t)K.l * 6 + h) * 15 * 31); }
        else if (item < N_SWA + N_NAT + N_C) attn_item<2>(K, item - N_SWA - N_NAT, sinkp, nullptr);
        else attn_item<3>(K, item - N_SWA - N_NAT - N_C, nullptr, nullptr);
    }
}

DI unsigned fkey(float f) { const unsigned u = __float_as_uint(f); return (u & 0x80000000u) ? ~u : (u | 0x80000000u); }
DI int mbcnt64(unsigned long long m) { return (int)__builtin_amdgcn_mbcnt_hi((unsigned)(m >> 32), __builtin_amdgcn_mbcnt_lo((unsigned)m, 0u)); }
template <int NV> DI unsigned radix_thr16(const unsigned (&k)[NV]) {
    unsigned prefix = 0u;
#pragma unroll 1
    for (int bit = 31; bit >= 0; --bit) {
        const unsigned cand = prefix | (1u << bit); int cnt = 0;
#pragma unroll
        for (int i = 0; i < NV; ++i) cnt += __popcll(__ballot(k[i] >= cand));
        if (cnt >= 16) { prefix = cand; if (cnt == 16) break; }
    }
    return prefix;
}
template <int NC, int NV> DI void radix_thr16_multi(const unsigned (&k)[NC][NV], unsigned (&T)[NC]) {
    bool exact[NC];
#pragma unroll
    for (int c = 0; c < NC; ++c) { T[c] = 0u; exact[c] = false; }
#pragma unroll 1
    for (int bit = 31; bit >= 0; --bit) {
        bool all = true;
#pragma unroll
        for (int c = 0; c < NC; ++c) {
            const unsigned cand = T[c] | (1u << bit); int cnt = 0;
#pragma unroll
            for (int i = 0; i < NV; ++i) cnt += __popcll(__ballot(k[c][i] >= cand));
            if (cnt >= 16) { T[c] = cand; exact[c] = (cnt == 16); }
            all = all && exact[c];
        }
        if (all) break;
    }
}
template <int NV> DI void select16(const unsigned (&k)[NV], unsigned T, bool (&sel)[NV], int (&pos)[NV]) {
    int ngt = 0; unsigned long long gtm[NV], eqm[NV];
#pragma unroll
    for (int i = 0; i < NV; ++i) { gtm[i] = __ballot(k[i] > T); eqm[i] = __ballot(k[i] == T); ngt += __popcll(gtm[i]); }
    const int need = 16 - ngt; int eqbase = 0, selbase = 0;
#pragma unroll
    for (int i = 0; i < NV; ++i) {
        const bool iseq = k[i] == T; const int erank = eqbase + mbcnt64(eqm[i]); eqbase += __popcll(eqm[i]);
        sel[i] = (k[i] > T) || (iseq && erank < need);
        const unsigned long long sm = __ballot(sel[i]); pos[i] = selbase + mbcnt64(sm); selbase += __popcll(sm);
    }
}
constexpr int PS_SCS = 132;
constexpr int PSL_TOP = 8 * 2 * 16 * PS_SCS * 4;
static_assert(PSL_TOP + 8 * 512 <= LDS_BYTES - 256, "peer select LDS map");
template <int PROBE> DI void ph_peer_select(Ctx& K) {
    const float* SKl = ARG(peer_sk) + (size_t)K.l * 8 * 2 * 128 * 128;
    float* SCR = (float*)K.lds + K.wave * 2 * 16 * PS_SCS; float* TOPV = (float*)(K.lds + PSL_TOP + K.wave * 512); int* TOPI = (int*)(TOPV + 64);
    const int r16 = K.lane & 15, g4 = K.lane >> 4, h = K.wave;
    for (int item = K.bid; item < M / 16; item += K.nb) {
        const int t0 = item * 16;
#pragma unroll 1
        for (int p = 0; p < 2; ++p) {
            float a[32];
            { const bf16_t* qp = K.QP + (size_t)(t0 + r16) * 2048 + h * 256 + p * 128 + 4 * g4;
#pragma unroll
              for (int i = 0; i < 8; ++i) { const u32x2 w = *(const u32x2*)(qp + 16 * i); a[4 * i] = __uint_as_float(w.x << 16); a[4 * i + 1] = __uint_as_float(w.x & 0xffff0000u); a[4 * i + 2] = __uint_as_float(w.y << 16); a[4 * i + 3] = __uint_as_float(w.y & 0xffff0000u); } }
            const float* skp = SKl + (((size_t)h * 2 + p) * 128 + r16) * 128 + 4 * g4;
#pragma unroll 1
            for (int nt = 0; nt < 8; nt += 2) {
                float b0[32], b1[32];
#pragma unroll
                for (int i = 0; i < 8; ++i) { const f32x4 v0 = *(const f32x4*)(skp + (size_t)(16 * nt) * 128 + 16 * i), v1 = *(const f32x4*)(skp + (size_t)(16 * nt + 16) * 128 + 16 * i);
                    b0[4 * i] = v0.x; b0[4 * i + 1] = v0.y; b0[4 * i + 2] = v0.z; b0[4 * i + 3] = v0.w; b1[4 * i] = v1.x; b1[4 * i + 1] = v1.y; b1[4 * i + 2] = v1.z; b1[4 * i + 3] = v1.w; }
                f32x4 c0 = {0.f, 0.f, 0.f, 0.f}, c1 = c0;
#pragma unroll
                for (int s_ = 0; s_ < 32; ++s_) { c0 = __builtin_amdgcn_mfma_f32_16x16x4f32(a[s_], b0[s_], c0, 0, 0, 0); c1 = __builtin_amdgcn_mfma_f32_16x16x4f32(a[s_], b1[s_], c1, 0, 0, 0); }
#pragma unroll
                for (int rg = 0; rg < 4; ++rg) { SCR[(p * 16 + 4 * g4 + rg) * PS_SCS + 16 * nt + r16] = c0[rg]; SCR[(p * 16 + 4 * g4 + rg) * PS_SCS + 16 * nt + 16 + r16] = c1[rg]; }
            }
        }
        asm volatile("s_waitcnt lgkmcnt(0)" ::: "memory");
        if (PROBE == 1) continue;
#pragma unroll 1
        for (int tk = 0; tk < 16; tk += 2) {
            float v[4][2]; unsigned kk[4][2], T4[4];
#pragma unroll
            for (int c = 0; c < 4; ++c) { const int p = c & 1, rr = c >> 1; v[c][0] = SCR[(p * 16 + tk + rr) * PS_SCS + K.lane]; v[c][1] = SCR[(p * 16 + tk + rr) * PS_SCS + 64 + K.lane]; kk[c][0] = fkey(v[c][0]); kk[c][1] = fkey(v[c][1]); }
            radix_thr16_multi<4, 2>(kk, T4);
#pragma unroll
            for (int c = 0; c < 4; ++c) { bool sel[2]; int pos[2]; select16<2>(kk[c], T4[c], sel, pos);
#pragma unroll
                for (int i = 0; i < 2; ++i) if (sel[i]) { TOPV[c * 16 + pos[i]] = v[c][i]; TOPI[c * 16 + pos[i]] = K.lane + 64 * i; } }
            asm volatile("s_waitcnt lgkmcnt(0)" ::: "memory");
            float cv[2][4]; int ce[2][4]; unsigned ck[2][4], T2[2];
#pragma unroll
            for (int rr = 0; rr < 2; ++rr) { const float vb = TOPV[(2 * rr + 1) * 16 + r16]; const int ib = TOPI[(2 * rr + 1) * 16 + r16];
#pragma unroll
                for (int i = 0; i < 4; ++i) { const int aidx = g4 + 4 * i; cv[rr][i] = TOPV[(2 * rr) * 16 + aidx] + vb; ce[rr][i] = TOPI[(2 * rr) * 16 + aidx] * 128 + ib; ck[rr][i] = fkey(cv[rr][i]); } }
            radix_thr16_multi<2, 4>(ck, T2);
#pragma unroll
            for (int rr = 0; rr < 2; ++rr) {
                const int r = t0 + tk + rr;
                bool sel[4]; int pos[4]; select16<4>(ck[rr], T2[rr], sel, pos);
                float mx = -3.0e38f;
#pragma unroll
                for (int i = 0; i < 4; ++i) mx = fmaxf(mx, sel[i] ? cv[rr][i] : -3.0e38f);
                mx = fmaxf(mx, dpp_<0xB1>(mx)); mx = fmaxf(mx, dpp_<0x4E>(mx)); mx = fmaxf(mx, dpp_<0x141>(mx)); mx = fmaxf(mx, dpp_<0x128>(mx));
                { auto s1 = __builtin_amdgcn_permlane16_swap(__float_as_uint(mx), __float_as_uint(mx), false, false); mx = fmaxf(__uint_as_float(s1[0]), __uint_as_float(s1[1]));
                  auto s2 = __builtin_amdgcn_permlane32_swap(__float_as_uint(mx), __float_as_uint(mx), false, false); mx = fmaxf(__uint_as_float(s2[0]), __uint_as_float(s2[1])); }
                float ex[4], es = 0.f;
#pragma unroll
                for (int i = 0; i < 4; ++i) { ex[i] = sel[i] ? __expf(cv[rr][i] - mx) : 0.f; es += ex[i]; }
                es = wave_sum_fast(es);
                const float inv = 1.0f / es;
#pragma unroll
                for (int i = 0; i < 4; ++i) if (sel[i]) { K.PIDX[(size_t)r * 128 + h * 16 + pos[i]] = ce[rr][i]; K.PG[(size_t)r * 128 + h * 16 + pos[i]] = ex[i] * inv; }
            }
            asm volatile("s_waitcnt lgkmcnt(0)" ::: "memory");
        }
    }
}

constexpr int PUL_H = 0, PUL_SLOT = 2048, PUL_STRIDE = 2560;
struct PuMeta { u32x4 h0, h1; int ia, ib; };
DI void pu_load(const Ctx& K, int r, PuMeta& m) {
    if (r < M) { m.h0 = *(const u32x4*)(K.H + (size_t)r * D + K.lane * 8); m.h1 = *(const u32x4*)(K.H + (size_t)r * D + 512 + K.lane * 8); m.ia = K.PIDX[(size_t)r * 128 + K.lane]; m.ib = K.PIDX[(size_t)r * 128 + 64 + K.lane]; }
}
template <int PROBE> DI void pu_item(const Ctx& K, const bf16_t* U, unsigned char* HL, int* SLOT, int R, int r, const PuMeta& m, int r16, int g4, float& dummy) {
    *(u32x4*)(HL + PUL_H + K.lane * 16) = m.h0; *(u32x4*)(HL + PUL_H + 1024 + K.lane * 16) = m.h1;
    const bool sa = (m.ia >> 10) == R, sb = (m.ib >> 10) == R;
    const unsigned long long ma = __ballot(sa), mb = __ballot(sb);
    const int na = __popcll(ma), n = na + __popcll(mb);
    const int ra = mbcnt64(ma), rb = na + mbcnt64(mb);
#pragma unroll 1
    for (int base = 0; base < n; base += 16) {
        if (sa && ra >= base && ra < base + 16) { SLOT[2 * (ra - base)] = m.ia; SLOT[2 * (ra - base) + 1] = K.lane; }
        if (sb && rb >= base && rb < base + 16) { SLOT[2 * (rb - base)] = m.ib; SLOT[2 * (rb - base) + 1] = 64 + K.lane; }
        asm volatile("s_waitcnt lgkmcnt(0)" ::: "memory");
        const bool valid = base + r16 < n; const int e = valid ? SLOT[2 * r16] : 0;
        const bf16_t* up = U + (size_t)e * D + 8 * g4;
        f32x4 acc = {0.f, 0.f, 0.f, 0.f};
#pragma unroll
        for (int hf = 0; hf < 2; ++hf) {
            u32x4 av[16];
#pragma unroll
            for (int s_ = 0; s_ < 16; ++s_) av[s_] = (valid && PROBE != 3) ? *(const u32x4*)(up + 32 * (16 * hf + s_)) : (u32x4){(unsigned)e, 0u, 0u, 0u};
#pragma unroll
            for (int s_ = 0; s_ < 16; ++s_) { const bf16x8_t hb = *(const bf16x8_t*)(HL + PUL_H + 64 * (16 * hf + s_) + 16 * g4); acc = MFMA16(__builtin_bit_cast(bf16x8_t, av[s_]), hb, acc); }
        }
        const float d = r16 == 0 ? acc[0] : r16 == 1 ? acc[1] : r16 == 2 ? acc[2] : acc[3];
        const int sl = 4 * g4 + r16;
        if (PROBE >= 2) { if (r16 < 4 && base + sl < n) dummy += gelu_erf(d); }
        else if (r16 < 4 && base + sl < n) (PROBE ? K.ST : K.PA)[(size_t)r * 128 + SLOT[2 * sl + 1]] = gelu_erf(d);
        asm volatile("s_waitcnt lgkmcnt(0)" ::: "memory");
    }
}
template <int PROBE> DI void ph_peer_u(Ctx& K) {
    const bf16_t* U = K.UB + (size_t)K.l * 16384 * D;
    unsigned char* HL = K.lds + K.wave * PUL_STRIDE; int* SLOT = (int*)(HL + PUL_SLOT);
    const int r16 = K.lane & 15, g4 = K.lane >> 4;
    const int step = K.nloc * NWAVES;
    constexpr int PD = 4;
    float dummy = 0.f;
    for (int R = K.xg; R < 16; R += K.nxg) {
        int r = K.jx * NWAVES + K.wave;
        PuMeta m[PD];
#pragma unroll
        for (int i = 0; i < PD; ++i) { m[i].h0 = (u32x4){0u, 0u, 0u, 0u}; m[i].h1 = m[i].h0; m[i].ia = 0; m[i].ib = 0; pu_load(K, r + i * step, m[i]); }
#pragma unroll 1
        for (; r < M; r += PD * step) {
#pragma unroll
            for (int i = 0; i < PD; ++i) {
                const int ri = r + i * step;
                if (ri < M) pu_item<PROBE>(K, U, HL, SLOT, R, ri, m[i], r16, g4, dummy);
                pu_load(K, ri + PD * step, m[i]);
            }
        }
    }
    if (PROBE >= 2) K.ST[K.gw * 64 + K.lane] = dummy;
}
struct PvMeta { int ia, ib; float ga, gb, pa, pb; f32x4 x0, x1, g0, g1; };
template <int PROBE> DI void pv_load(const Ctx& K, int r, int c0, int slot, const float* gate, PvMeta& m) {
    if (r < M) { m.ia = K.PIDX[(size_t)r * 128 + K.lane]; m.ib = K.PIDX[(size_t)r * 128 + 64 + K.lane];
        m.ga = K.PG[(size_t)r * 128 + K.lane]; m.pa = K.PA[(size_t)r * 128 + K.lane]; m.gb = K.PG[(size_t)r * 128 + 64 + K.lane]; m.pb = K.PA[(size_t)r * 128 + 64 + K.lane];
        if (slot == 0) { const float* xr = (PROBE ? (const float*)K.P : K.X) + (size_t)r * D + c0; const float* gv = gate + (size_t)modvec_of_row(r) * 6 * D + c0;
            m.x0 = *(const f32x4*)xr; m.x1 = *(const f32x4*)(xr + 4); m.g0 = *(const f32x4*)gv; m.g1 = *(const f32x4*)(gv + 4); } }
}
template <int PROBE> DI void pv_item(const Ctx& K, const bf16_t* V, int r, int c0, int slot, const PvMeta& m) {
    const float wa = m.ga * m.pa, wb = m.gb * m.pb;
    u32x4 vv[16]; float ww[16];
#pragma unroll
    for (int i = 0; i < 16; ++i) {
        const int src = (((8 * i + slot) & 63) << 2);
        const int e = __builtin_amdgcn_ds_bpermute(src, i < 8 ? m.ia : m.ib);
        ww[i] = __uint_as_float((unsigned)__builtin_amdgcn_ds_bpermute(src, (int)__float_as_uint(i < 8 ? wa : wb)));
        vv[i] = *(const u32x4*)(V + (size_t)e * 64);
    }
    float y[8];
#pragma unroll
    for (int i = 0; i < 8; ++i) y[i] = 0.f;
#pragma unroll
    for (int i = 0; i < 16; ++i) { float t[8]; unpack8(vv[i], t);
#pragma unroll
        for (int q = 0; q < 8; ++q) y[q] += ww[i] * t[q]; }
#pragma unroll
    for (int q = 0; q < 8; ++q) { float v = y[q]; v += dpp_<0x128>(v);
        auto s1 = __builtin_amdgcn_permlane16_swap(__float_as_uint(v), __float_as_uint(v), false, false); v = __uint_as_float(s1[0]) + __uint_as_float(s1[1]);
        auto s2 = __builtin_amdgcn_permlane32_swap(__float_as_uint(v), __float_as_uint(v), false, false); y[q] = __uint_as_float(s2[0]) + __uint_as_float(s2[1]); }
    if (slot == 0) { float* xr = (PROBE ? (float*)K.P : K.X) + (size_t)r * D + c0; f32x4 x0 = m.x0, x1 = m.x1;
        x0.x += m.g0.x * y[0]; x0.y += m.g0.y * y[1]; x0.z += m.g0.z * y[2]; x0.w += m.g0.w * y[3]; x1.x += m.g1.x * y[4]; x1.y += m.g1.y * y[5]; x1.z += m.g1.z * y[6]; x1.w += m.g1.w * y[7];
        *(f32x4*)xr = x0; *(f32x4*)(xr + 4) = x1; }
}
template <int PROBE> DI void ph_peer_v(Ctx& K) {
    const int slot = K.lane >> 3, c = K.lane & 7;
    const float* gate = K.MOD + (size_t)K.l * 3 * 6 * D + 5 * D;
    const int step = K.nloc * NWAVES;
    constexpr int PD = 3;
    for (int S = K.xg; S < 16; S += K.nxg) {
        const bf16_t* V = K.VB + ((size_t)K.l * 16 + S) * 16384 * 64 + c * 8;
        const int c0 = S * 64 + c * 8;
        int r = K.jx * NWAVES + K.wave;
        PvMeta m[PD];
#pragma unroll
        for (int i = 0; i < PD; ++i) { m[i].ia = 0; m[i].ib = 0; m[i].ga = m[i].gb = m[i].pa = m[i].pb = 0.f; m[i].x0 = m[i].x1 = m[i].g0 = m[i].g1 = (f32x4){0.f, 0.f, 0.f, 0.f}; pv_load<PROBE>(K, r + i * step, c0, slot, gate, m[i]); }
#pragma unroll 1
        for (; r < M; r += PD * step) {
#pragma unroll
            for (int i = 0; i < PD; ++i) {
                const int ri = r + i * step;
                if (ri < M) pv_item<PROBE>(K, V, ri, c0, slot, m[i]);
                pv_load<PROBE>(K, ri + PD * step, c0, slot, gate, m[i]);
            }
        }
    }
}

DI void ph_final(Ctx& K) {
    for (int r = K.gw; r < NLAT; r += K.ngw) {
        const f32x4* xr = (const f32x4*)(K.X + (size_t)(NCTX + r) * D); f32x4* o = (f32x4*)(((float*)argp_<float>(K, (unsigned)__builtin_offsetof(Args, out))) + (size_t)r * D);
        f32x4 v[4]; float ss = 0.f;
#pragma unroll
        for (int j = 0; j < 4; ++j) { v[j] = xr[j * 64 + K.lane]; ss += v[j].x * v[j].x + v[j].y * v[j].y + v[j].z * v[j].z + v[j].w * v[j].w; }
        ss = wave_sum(ss); const float rs = rsqrtf(ss * (1.0f / D) + EPS);
#pragma unroll
        for (int j = 0; j < 4; ++j) { const f32x4 w = ((const f32x4*)ARG(final_norm_w))[j * 64 + K.lane]; o[j * 64 + K.lane] = v[j] * rs * w; }
    }
}

#define XB_TMO      128
#define XB_XSUB(j)  (1280 + 64 * (j))
#define XB_XGEN(j)  (2304 + 64 * (j))
#define XB_TOP      3328
#define XB_TOPGEN   3392
#define XB_SPIN_CAP (1u << 22)
constexpr int CW_BAR = 4096;
DI unsigned xb_ld(unsigned* p)              { return __hip_atomic_load(p, __ATOMIC_RELAXED, __HIP_MEMORY_SCOPE_AGENT); }
DI unsigned xb_add(unsigned* p, unsigned v) { return __hip_atomic_fetch_add(p, v, __ATOMIC_RELAXED, __HIP_MEMORY_SCOPE_AGENT); }
#define XB_SPIN(cond, bar) do { unsigned _sp = 0; while (cond) { __builtin_amdgcn_s_sleep(1); \
    if ((++_sp & 255u) == 0u) { if (xb_ld(&(bar)[XB_TMO])) break; if (_sp > XB_SPIN_CAP) { atomicAdd(&(bar)[XB_TMO], 1u); break; } } } } while (0)
DI void xcd_barrier(unsigned* bar, unsigned x, unsigned nloc, unsigned nx) {
    asm volatile("s_waitcnt vmcnt(0)" ::: "memory");
    __syncthreads();
    if (threadIdx.x == 0) {
        __builtin_amdgcn_s_waitcnt(0);
        const unsigned old = xb_add(&bar[XB_XSUB(x)], 1u);
        const unsigned gen = old / nloc;
        if (old + 1u == (gen + 1u) * nloc) {
            __builtin_amdgcn_fence(__ATOMIC_RELEASE, "agent");
            asm volatile("s_waitcnt vmcnt(0)" ::: "memory");
            const unsigned og = xb_add(&bar[XB_TOP], 1u);
            const unsigned tg = og / nx;
            if (og + 1u == (tg + 1u) * nx) xb_add(&bar[XB_TOPGEN], 1u);
            else XB_SPIN(xb_ld(&bar[XB_TOPGEN]) == tg, bar);
            __builtin_amdgcn_fence(__ATOMIC_ACQUIRE, "agent");
            xb_add(&bar[XB_XGEN(x)], 1u);
            asm volatile("s_waitcnt vmcnt(0)" ::: "memory");
        } else {
            XB_SPIN(xb_ld(&bar[XB_XGEN(x)]) == gen, bar);
            __builtin_amdgcn_fence(__ATOMIC_ACQUIRE, "agent");
            asm volatile("s_waitcnt vmcnt(0)" ::: "memory");
        }
    }
    __syncthreads();
}

constexpr int PROBE_U = 0, PROBE_V = 0, PROBE_S = 0;
constexpr unsigned DUP_MASK = 0u;
constexpr int PH_PER_LAYER = 13, N_PHASES = 2 + PH_PER_LAYER * DEPTH;
__global__ void __launch_bounds__(NTHREADS) mk_fwd(Args args) {
    extern __shared__ __attribute__((aligned(16))) unsigned char lds[];
    cg::grid_group grid = cg::this_grid();
    constexpr unsigned ARGS_OFF = LDS_BYTES - 256;
    constexpr unsigned MISC_OFF = LDS_BYTES - 64;
    if (threadIdx.x == 0) {
        *(Args*)(lds + ARGS_OFF) = args;
        unsigned* ctl = (unsigned*)(args.ws + WS_CTL); unsigned* misc = (unsigned*)(lds + MISC_OFF);
        const unsigned xcc = (unsigned)__builtin_amdgcn_s_getreg((3 << 11) | 20) & 0xFu;
        misc[0] = xcc; misc[1] = __hip_atomic_fetch_add(ctl + 64 * xcc, 1u, __ATOMIC_RELAXED, __HIP_MEMORY_SCOPE_AGENT);
    }
    __syncthreads();
    int rep = 0;
#pragma unroll 1
    for (int ph = 0; ph < N_PHASES; ++ph) {
        int tid = threadIdx.x; asm volatile("" : "+v"(tid));
        unsigned aoff = ARGS_OFF; asm volatile("" : "+v"(aoff));
        unsigned char* ws = args.ws; asm volatile("" : "+s"(ws));
        int bid = blockIdx.x; asm volatile("" : "+s"(bid)); int nb = gridDim.x; asm volatile("" : "+s"(nb));
        unsigned moff = MISC_OFF; asm volatile("" : "+v"(moff));
        Ctx K; { const unsigned* misc = (const unsigned*)(lds + moff); K.jx = __builtin_amdgcn_readfirstlane(misc[1]); K.xg = __builtin_amdgcn_readfirstlane(misc[2]); K.nxg = __builtin_amdgcn_readfirstlane(misc[3]); K.nloc = __builtin_amdgcn_readfirstlane(misc[4]); }
        K.aoff = aoff; K.lds = lds; K.tid = tid; K.lane = tid & 63; K.wave = tid >> 6; K.bid = bid; K.nb = nb; K.gw = bid * NWAVES + K.wave; K.ngw = nb * NWAVES;
        K.X = (float*)(ws + WS_X); K.H = (bf16_t*)(ws + WS_H); K.P = (bf16_t*)(ws + WS_P); K.QP = K.P; K.MIX = (bf16_t*)(ws + WS_MIX); K.OF = (float*)(ws + WS_OF); K.OB = (float*)(ws + WS_OB);
        K.PIDX = (int*)(ws + WS_PIDX); K.PG = (float*)(ws + WS_PG); K.MOD = (float*)(ws + WS_MOD); K.LB = (float*)(ws + WS_LB); K.ROPE = (float*)(ws + WS_ROPE); K.WIN = (bf16_t*)(ws + WS_WIN); K.WOUT = (bf16_t*)(ws + WS_WOUT); K.WQ = (bf16_t*)(ws + WS_WQ); K.UB = (bf16_t*)(ws + WS_UB); K.ST = (float*)(ws + WS_OF); K.AC = (float*)(ws + WS_AC); K.PA = (float*)(ws + WS_PA); K.VB = (bf16_t*)(ws + WS_VB);
        const int l = ph == 0 ? 0 : (ph - 1) / PH_PER_LAYER, k = ph == 0 ? -1 : (ph == N_PHASES - 1 ? -2 : (ph - 1) % PH_PER_LAYER);
        K.l = l;
        if (k == -1) ph_prologue(K);
        else if (k == -2) ph_final(K);
        else if (k == 0) ph_norm(K, ARG(norm_mix_w) + (size_t)l * D, 0);
        else if (k == 1) ph_gemm_store(K, K.H, K.WIN + (size_t)l * PW * D, PW, K.P);
        else if (k == 2) ph_rope(K);
        else if (k == 3) ph_hgrn_A(K);
        else if (k == 4) ph_attn(K);
        else if (k == 5) ph_hgrn_B(K);
        else if (k == 6) ph_hgrn_C(K);
        else if (k == 7) ph_gemm_resid(K, K.MIX, K.WOUT + (size_t)l * D * D, 2);
        else if (k == 8) ph_norm(K, ARG(norm_ffn_w) + (size_t)l * D, 3);
        else if (k == 9) ph_gemm_store(K, K.H, K.WQ + (size_t)l * 2048 * D, 2048, K.QP);
        else if (k == 10) { ph_peer_select<0>(K); if (PROBE_S) ph_peer_select<PROBE_S>(K); }
        else if (k == 11) { ph_peer_u<0>(K); if (PROBE_U) ph_peer_u<PROBE_U>(K); }
        else if (k == 12) { ph_peer_v<0>(K); if (PROBE_V) ph_peer_v<1>(K); }
        if (k >= 0 && ((DUP_MASK >> k) & 1u)) { ++rep; if (rep < 2) { --ph; continue; } } rep = 0;
        if (ph == 0) grid.sync();
        else if (k != 3 && ph != N_PHASES - 1) { const unsigned* misc = (const unsigned*)(lds + moff); xcd_barrier((unsigned*)(args.ws + WS_CTL) + CW_BAR, misc[0], misc[4], misc[3]); }
        if (ph == 0) {
            if (threadIdx.x == 0) { unsigned* ctl = (unsigned*)(args.ws + WS_CTL); unsigned* misc = (unsigned*)(lds + MISC_OFF); const unsigned xcc = misc[0]; unsigned ord = 0, npop = 0, mine = 1;
                for (unsigned q = 0; q < 16; ++q) { const unsigned cq = __hip_atomic_load(ctl + 64 * q, __ATOMIC_RELAXED, __HIP_MEMORY_SCOPE_AGENT); if (cq) { ++npop; if (q < xcc) ++ord; } if (q == xcc) mine = cq; }
                misc[2] = ord; misc[3] = npop ? npop : 1u; misc[4] = mine ? mine : 1u; }
            __syncthreads();
        }
    }
}

extern "C" void kernel_launch(void* const* d_in, const int* in_sizes, int n_in, void* d_out, int out_size, void* d_ws, size_t ws_size, hipStream_t stream) {
    static int grid = 0;
    if (grid == 0) {
        if (n_in != 19 || out_size != NLAT * D || ws_size < WS_END) { fprintf(stderr, "kernel_launch: unexpected shapes (n_in %d out %d ws %zu need %zu)\n", n_in, out_size, ws_size, (size_t)WS_END); grid = -1; return; }
        int dev = 0, cus = 0, per_cu = 0;
        (void)hipGetDevice(&dev); (void)hipDeviceGetAttribute(&cus, hipDeviceAttributeMultiprocessorCount, dev);
        (void)hipFuncSetAttribute((const void*)mk_fwd, hipFuncAttributeMaxDynamicSharedMemorySize, LDS_BYTES);
        (void)hipOccupancyMaxActiveBlocksPerMultiprocessor(&per_cu, (const void*)mk_fwd, NTHREADS, LDS_BYTES);
        if (per_cu < 1) { fprintf(stderr, "kernel_launch: occupancy query says %d blocks/CU\n", per_cu); grid = -1; return; }
        grid = (cus / 8) * 8;
    }
    if (grid < 0) return;
    Args a{};
    a.x = (const float*)d_in[0]; a.c = (const float*)d_in[1]; a.ctx = (const float*)d_in[2]; a.c_ctx = (const float*)d_in[3]; a.w_mod = (const float*)d_in[4]; a.b_mod = (const float*)d_in[5];
    a.norm_mix_w = (const float*)d_in[6]; a.norm_ffn_w = (const float*)d_in[7]; a.w_in = (const float*)d_in[8]; a.lb_logits = (const float*)d_in[9]; a.hgrn_norm_w = (const float*)d_in[10];
    a.swa_sink = (const float*)d_in[11]; a.nat_rpb = (const float*)d_in[12]; a.w_out = (const float*)d_in[13]; a.peer_wq = (const float*)d_in[14]; a.peer_sk = (const float*)d_in[15];
    a.peer_u = (const float*)d_in[16]; a.peer_v = (const float*)d_in[17]; a.final_norm_w = (const float*)d_in[18];
    a.out = (float*)d_out; a.ws = (unsigned char*)d_ws;
    (void)hipMemsetAsync((unsigned char*)d_ws + WS_CTL, 0, CTL_BYTES, stream);
    void* kargs[] = {&a};
    hipError_t e = hipLaunchCooperativeKernel((const void*)mk_fwd, dim3(grid), dim3(NTHREADS), kargs, LDS_BYTES, stream);
    if (e != hipSuccess) fprintf(stderr, "kernel_launch: cooperative launch failed: %s (grid %d)\n", hipGetErrorString(e), grid);
}
```

```cpp
#include <hip/hip_runtime.h>
#include <hip/hip_cooperative_groups.h>
#include <cstdio>
#include <cstdint>
namespace cg = cooperative_groups;
#define DI __device__ __forceinline__

typedef unsigned short bf16_t;
typedef float f32x4 __attribute__((ext_vector_type(4)));
typedef unsigned u32x4 __attribute__((ext_vector_type(4)));
typedef unsigned u32x2 __attribute__((ext_vector_type(2)));

constexpr int D = 1024, NB = 2, L = 16384, CL = 256, DEPTH = 4;
constexpr int NCTX = NB * CL, NLAT = NB * L, M = NCTX + NLAT;
constexpr int PW = 3072;
constexpr int C_HQ = 0, C_ZF = 256, C_ZB = 512, C_HV = 768, C_HG = 1024, C_SQ = 1280, C_SK = 1664, C_SV = 1792, C_NQ = 1920, C_NK = 2304, C_NV = 2688;
constexpr int MX_H = 0, MX_S = 256, MX_N = 640;
constexpr float EPS = 1e-6f;
constexpr int NTHREADS = 512, NWAVES = 8;
constexpr int LDS_BYTES = 147456;

constexpr size_t al256(size_t x) { return (x + 255) & ~(size_t)255; }
constexpr size_t WS_X = 0;
constexpr size_t WS_H = WS_X + al256((size_t)M * D * 4);
constexpr size_t WS_P = WS_H + al256((size_t)M * D * 2);
constexpr size_t WS_MIX = WS_P + al256((size_t)M * PW * 2);
constexpr size_t WS_OF = WS_MIX + al256((size_t)M * D * 2);
constexpr size_t WS_OB = WS_OF + al256((size_t)M * 256 * 4);
constexpr size_t WS_PIDX = WS_OB + al256((size_t)M * 256 * 4);
constexpr size_t WS_PG = WS_PIDX + al256((size_t)M * 128 * 4);
constexpr size_t WS_MOD = WS_PG + al256((size_t)M * 128 * 4);
constexpr size_t WS_LB = WS_MOD + al256((size_t)DEPTH * 3 * 6 * D * 4);
constexpr size_t WS_ROPE = WS_LB + al256((size_t)2 * DEPTH * 256 * 4);
constexpr size_t WS_WIN = WS_ROPE + al256((size_t)(256 + 256 + 64 + 64) * 16 * 4);
constexpr size_t WS_WOUT = WS_WIN + al256((size_t)DEPTH * PW * D * 2);
constexpr size_t WS_WQ = WS_WOUT + al256((size_t)DEPTH * D * D * 2);
constexpr size_t WS_AC = WS_WQ + al256((size_t)DEPTH * 2048 * D * 2);
constexpr size_t WS_UB_ = 0; constexpr size_t WS_UB = WS_AC + al256((size_t)16 * 260 * 64 * 4); constexpr size_t WS_UB_OLD = WS_WQ + al256((size_t)DEPTH * 2048 * D * 2);
constexpr size_t WS_VB = WS_UB + al256((size_t)DEPTH * 16384 * D * 2);
constexpr size_t WS_PA = WS_VB + al256((size_t)DEPTH * 16384 * D * 2);
constexpr size_t WS_VS = WS_PA + al256((size_t)M * 128 * 4);
constexpr size_t WS_US = WS_VS + al256((size_t)DEPTH * 16384 * 4);
constexpr size_t WS_SKH = WS_US + al256((size_t)DEPTH * 16384 * 4);
constexpr size_t WS_SKL = WS_SKH + al256((size_t)DEPTH * 8 * 2 * 128 * 128 * 2);
constexpr size_t WS_CTL = WS_SKL + al256((size_t)DEPTH * 8 * 2 * 128 * 128 * 2);
constexpr size_t CTL_BYTES = 65536;
constexpr size_t WS_END = WS_CTL + CTL_BYTES;

struct Args {
    const float *x, *c, *ctx, *c_ctx, *w_mod, *b_mod, *norm_mix_w, *norm_ffn_w, *w_in, *lb_logits, *hgrn_norm_w, *swa_sink, *nat_rpb, *w_out, *peer_wq, *peer_sk, *peer_u, *peer_v, *final_norm_w;
    float* out; unsigned char* ws;
};

DI float bf2f(bf16_t v) { return __uint_as_float((unsigned)v << 16); }
DI bf16_t f2bf(float f) { unsigned u = __float_as_uint(f); return (bf16_t)((u + 0x7fffu + ((u >> 16) & 1u)) >> 16); }
DI unsigned pk2(float lo, float hi) { return (unsigned)f2bf(lo) | ((unsigned)f2bf(hi) << 16); }
DI float wave_sum(float v) {
#pragma unroll
    for (int o = 1; o < 64; o <<= 1) v += __shfl_xor(v, o);
    return v;
}
typedef __bf16 bf16x2_t __attribute__((ext_vector_type(2)));
DI float dot2bf(unsigned a, unsigned b, float acc) { return __builtin_amdgcn_fdot2_f32_bf16(__builtin_bit_cast(bf16x2_t, a), __builtin_bit_cast(bf16x2_t, b), acc, false); }
template <int CTRL> DI float dpp_(float x) { return __builtin_bit_cast(float, __builtin_amdgcn_mov_dpp(__builtin_bit_cast(int, x), CTRL, 0xf, 0xf, true)); }
DI float wave_sum_fast(float x) {
    x += dpp_<0xB1>(x); x += dpp_<0x4E>(x); x += dpp_<0x141>(x); x += dpp_<0x128>(x);
    auto s1 = __builtin_amdgcn_permlane16_swap(__float_as_uint(x), __float_as_uint(x), false, false); x = __uint_as_float(s1[0]) + __uint_as_float(s1[1]);
    auto s2 = __builtin_amdgcn_permlane32_swap(__float_as_uint(x), __float_as_uint(x), false, false); return __uint_as_float(s2[0]) + __uint_as_float(s2[1]);
}
DI float sigmoidf_(float z) { return 1.0f / (1.0f + __expf(-z)); }
DI float gelu_erf(float v) { return 0.5f * v * (1.0f + erff(v * 0.70710678118654752f)); }
DI int modvec_of_row(int r) { return r < NCTX ? 2 : (r - NCTX) / L; }
DI int batch_of_row(int r) { return r < NCTX ? r / CL : (r - NCTX) / L; }
DI int lat_row(int b, int t) { return NCTX + b * L + t; }
DI int ctx_row(int b, int s) { return b * CL + s; }
DI void unpack8(const u32x4 w, float* o) {
    o[0] = __uint_as_float(w.x << 16); o[1] = __uint_as_float(w.x & 0xffff0000u);
    o[2] = __uint_as_float(w.y << 16); o[3] = __uint_as_float(w.y & 0xffff0000u);
    o[4] = __uint_as_float(w.z << 16); o[5] = __uint_as_float(w.z & 0xffff0000u);
    o[6] = __uint_as_float(w.w << 16); o[7] = __uint_as_float(w.w & 0xffff0000u);
}
DI void load_row64(const bf16_t* p, float (&o)[64]) {
#pragma unroll
    for (int i = 0; i < 8; ++i) { const u32x4 w = *(const u32x4*)(p + 8 * i); unpack8(w, &o[8 * i]); }
}
DI void rope64(float (&x)[64], const float* cr, const float* sr, const float* cc, const float* sc) {
#pragma unroll
    for (int i = 0; i < 16; ++i) {
        const float c1 = cr[i], s1 = sr[i], a = x[i], b = x[16 + i];
        x[i] = a * c1 - b * s1; x[16 + i] = b * c1 + a * s1;
        const float c2 = cc[i], s2 = sc[i], e = x[32 + i], f = x[48 + i];
        x[32 + i] = e * c2 - f * s2; x[48 + i] = f * c2 + e * s2;
    }
}

namespace pg8 {
#define PG8_LAS __attribute__((address_space(3)))
typedef unsigned short bf16_t;
typedef short bf16x8 __attribute__((ext_vector_type(8)));
typedef float f32x4 __attribute__((ext_vector_type(4)));
typedef unsigned u32x4 __attribute__((ext_vector_type(4)));
constexpr int BM = 256, BK = 64, HALF = 128, HTB = HALF * BK * 2  , STAGE_BYTES = 8 * HTB, NXCD = 8, WGM = 8;

__host__ __device__ __forceinline__ int lds_byte(int r, int c) { const int st = (r >> 4) * 2 + (c >> 5), rr = r & 15, cc = c & 31, ob = rr * 64 + cc * 2; return st * 1024 + (ob ^ (((ob >> 9) & 1) << 5)); }
__host__ __device__ __forceinline__ void stage_rc(int b, int& R, int& C) { const int st = b / 1024, sb = b % 1024, swz = sb ^ (((sb >> 9) & 1) << 5); R = (st >> 1) * 16 + swz / 64; C = (st & 1) * 32 + (swz % 64) / 2; }
__host__ __device__ __forceinline__ int perm32(int rho) { const int n = rho >> 4, i = rho & 15; return 8 * (i >> 2) + 4 * n + (i & 3); }

struct Unit { int pm, pn; };
struct Gemm { const bf16_t* A; const bf16_t* Bt; int M, N, K; };

struct StaticOrder {
    int nM, nN, nwg, G, c;
    __host__ __device__ void init(int M, int N, int G_, int c_) { nM = M / BM; nN = N / BM; nwg = nM * nN; G = G_; c = c_; }
    __host__ __device__ bool next(int i, Unit& u) const {
        const long L = (long)i * G + c; if (L >= nwg) return false;
        int wgid = (int)L; { const int q = nwg / NXCD, r = nwg % NXCD, xcd = wgid % NXCD, off = wgid / NXCD; wgid = (xcd < r ? xcd * (q + 1) : r * (q + 1) + (xcd - r) * q) + off; }
        const int nig = WGM * nN, gid = wgid / nig, fm = gid * WGM, gsz = (nM - fm) < WGM ? (nM - fm) : WGM;
        u.pm = fm + ((wgid % nig) % gsz); u.pn = (wgid % nig) / gsz; return true;
    }
    __device__ __forceinline__ void a_ready(const Unit&) const {}
    __device__ __forceinline__ void done(const Unit&) const {}
};


__device__ __forceinline__ unsigned cvt_pk_bf16(float lo, float hi) { unsigned r; asm volatile("v_cvt_pk_bf16_f32 %0, %1, %2" : "=v"(r) : "v"(lo), "v"(hi)); return r; }
struct EpiStore {
    static constexpr bool PERM = true, AFTER_DRAIN = false;
    bf16_t* O; int ldc;
    __device__ __forceinline__ void operator()(const f32x4 (&acc)[2][2][4][2], const Unit& u, int wr, int wc, int fr, int fq) const {
        const int row0 = u.pm * BM + wr * 64 + fr, col0 = u.pn * BM + wc * 32 + 8 * fq;
#pragma unroll
        for (int ai = 0; ai < 2; ++ai)
#pragma unroll
            for (int m = 0; m < 4; ++m) { bf16_t* rowp = O + (size_t)(row0 + ai * HALF + m * 16) * ldc + col0;
#pragma unroll
                for (int bj = 0; bj < 2; ++bj) { const f32x4 v0 = acc[ai][bj][m][0], v1 = acc[ai][bj][m][1];
                    u32x4 w; w.x = cvt_pk_bf16(v0[0], v0[1]); w.y = cvt_pk_bf16(v0[2], v0[3]); w.z = cvt_pk_bf16(v1[0], v1[1]); w.w = cvt_pk_bf16(v1[2], v1[3]);
                    *(u32x4*)(rowp + bj * HALF) = w; } }
    }
};
struct EpiResid {
    static constexpr bool PERM = false, AFTER_DRAIN = false;
    float* X; int ldc; const float* gate; int gstride, nctx, seqlen;
    __device__ __forceinline__ void operator()(const f32x4 (&acc)[2][2][4][2], const Unit& u, int wr, int wc, int fr, int fq) const {
        const int col0 = u.pn * BM + wc * 32 + 4 * fq;
#pragma unroll
        for (int ai = 0; ai < 2; ++ai)
#pragma unroll
            for (int m = 0; m < 4; ++m) { const int r = u.pm * BM + ai * HALF + wr * 64 + m * 16 + fr; const int vsel = r < nctx ? 2 : (r - nctx) / seqlen;
                float* xr = X + (size_t)r * ldc + col0; const float* gr = gate + (size_t)vsel * gstride + col0;
#pragma unroll
                for (int bj = 0; bj < 2; ++bj)
#pragma unroll
                    for (int n = 0; n < 2; ++n) { const f32x4 g = *(const f32x4*)(gr + bj * HALF + n * 16); f32x4 x = *(const f32x4*)(xr + bj * HALF + n * 16); x += g * acc[ai][bj][m][n]; *(f32x4*)(xr + bj * HALF + n * 16) = x; } }
    }
};
template <class Epi, class Sched, bool ALIGN_EPI = false, bool SP2 = false>
__device__ __forceinline__ void gemm_phase(PG8_LAS unsigned char* lds, const Gemm g, const Sched& S, const Epi& E) {
    int tid_ = threadIdx.x; asm volatile("" : "+v"(tid_));
    const int tid = tid_, wid = __builtin_amdgcn_readfirstlane(tid >> 6), lane = tid & 63, wr = wid >> 2, wc = wid & 3, fr = lane & 15, fq = lane >> 4;
    const int K = g.K, nt = K / BK;
    unsigned voffA[2], voffB[2];
#pragma unroll
    for (int i = 0; i < 2; ++i) { int R, C; stage_rc(tid * 16 + i * 8192, R, C); const int Rb = Epi::PERM ? ((R & ~31) + perm32(R & 31)) : R;
        voffA[i] = (unsigned)(R * K + C) * 2u; voffB[i] = (unsigned)(Rb * K + C) * 2u; }
    const size_t kstep = (size_t)(BK * 2);
    const size_t hstep = (size_t)HALF * K * 2;
    const size_t tstep = 2 * hstep;
    const unsigned ldsw = (unsigned)wid * 1024u;
    const int aoff = lds_byte(wr * 64 + fr, fq * 8), boff = lds_byte(wc * 32 + fr, fq * 8);
#define PG8_SA(b, h) (((b) * 2 + (h)) * HTB)
#define PG8_SB(b, h) ((4 + (b) * 2 + (h)) * HTB)
#define PG8_STAGE(bufoff, gbase, voff) do { _Pragma("unroll") for (int _i = 0; _i < 2; ++_i) \
        __builtin_amdgcn_global_load_lds((const unsigned*)((const char*)(gbase) + (voff)[_i]), (PG8_LAS unsigned*)(lds + (bufoff) + ldsw + _i * 8192), 16, 0, 0); } while (0)
#define PG8_LDA(dst, b, h) do { _Pragma("unroll") for (int m = 0; m < 4; ++m) _Pragma("unroll") for (int k = 0; k < 2; ++k) dst[m][k] = *(const PG8_LAS bf16x8*)(lds + PG8_SA(b, h) + aoff + m * 2048 + k * 1024); } while (0)
#define PG8_LDB(dst, b, h) do { _Pragma("unroll") for (int n = 0; n < 2; ++n) _Pragma("unroll") for (int k = 0; k < 2; ++k) dst[n][k] = *(const PG8_LAS bf16x8*)(lds + PG8_SB(b, h) + boff + n * 2048 + k * 1024); } while (0)
#define PG8_MMA(ai, bj, At, Bt) do { __builtin_amdgcn_s_setprio(1); _Pragma("unroll") for (int m = 0; m < 4; ++m) _Pragma("unroll") for (int n = 0; n < 2; ++n) _Pragma("unroll") for (int k = 0; k < 2; ++k) \
        acc[ai][bj][m][n] = __builtin_amdgcn_mfma_f32_16x16x32_bf16(Bt[n][k], At[m][k], acc[ai][bj][m][n], 0, 0, 0); __builtin_amdgcn_s_setprio(0); } while (0)
#define PG8_WAIT_V(n) asm volatile("s_waitcnt vmcnt(" #n ")" ::: "memory")
#define PG8_WAIT_L(n) asm volatile("s_waitcnt lgkmcnt(" #n ")" ::: "memory")
#define PG8_BAR __builtin_amdgcn_s_barrier()
#define PG8_SCHED __builtin_amdgcn_sched_barrier(0)
    Unit cur, nxt; int ui = 0;
    if (!S.next(0, cur)) return;
    f32x4 acc[2][2][4][2];
#pragma unroll
    for (int a = 0; a < 2; ++a)
#pragma unroll
        for (int b = 0; b < 2; ++b)
#pragma unroll
            for (int m = 0; m < 4; ++m)
#pragma unroll
                for (int n = 0; n < 2; ++n) acc[a][b][m][n] = (f32x4){0.f, 0.f, 0.f, 0.f};
    bf16x8 At[4][2], B0[2][2], B1[2][2];
    const char* cA = (const char*)g.A + (size_t)cur.pm * tstep; const char* cB = (const char*)g.Bt + (size_t)cur.pn * tstep;
    S.a_ready(cur);
    if constexpr (SP2) {
        PG8_STAGE(PG8_SB(0, 0), cB, voffB); PG8_STAGE(PG8_SB(0, 1), cB + hstep, voffB); PG8_STAGE(PG8_SA(0, 0), cA, voffA); PG8_STAGE(PG8_SA(0, 1), cA + hstep, voffA);
        if (wr == 1) PG8_BAR;
        PG8_WAIT_V(2); PG8_BAR;
        PG8_STAGE(PG8_SB(1, 0), cB + kstep, voffB); PG8_STAGE(PG8_SA(1, 0), cA + kstep, voffA); PG8_STAGE(PG8_SB(1, 1), cB + hstep + kstep, voffB);
        PG8_WAIT_V(6); PG8_BAR;
    } else {
        PG8_STAGE(PG8_SB(0, 0), cB, voffB); PG8_STAGE(PG8_SA(0, 0), cA, voffA); PG8_STAGE(PG8_SB(0, 1), cB + hstep, voffB); PG8_STAGE(PG8_SA(0, 1), cA + hstep, voffA);
        if (wr == 1) PG8_BAR;
        PG8_WAIT_V(4); PG8_BAR;
        PG8_STAGE(PG8_SB(1, 0), cB + kstep, voffB); PG8_STAGE(PG8_SA(1, 0), cA + kstep, voffA); PG8_STAGE(PG8_SB(1, 1), cB + hstep + kstep, voffB);
        PG8_WAIT_V(6); PG8_BAR;
    }
    for (;;) {
        const bool has_next = S.next(ui + 1, nxt);
        const char* nA = has_next ? (const char*)g.A + (size_t)nxt.pm * tstep : cA; const char* nB = has_next ? (const char*)g.Bt + (size_t)nxt.pn * tstep : cB;
        for (int t = 0; t < nt; t += 2) {
            const bool last = (t == nt - 2);
            const char* a1 = cA + (size_t)(t + 1) * kstep;
            const char* a2 = last ? nA : cA + (size_t)(t + 2) * kstep; const char* b2 = last ? nB : cB + (size_t)(t + 2) * kstep;
            const char* a3 = a2 + kstep; const char* b3 = b2 + kstep;
            if (last && has_next) S.a_ready(nxt);
            if constexpr (SP2) {
            PG8_LDB(B0, 0, 0); PG8_LDB(B1, 0, 1); PG8_SCHED; PG8_LDA(At, 0, 0); PG8_STAGE(PG8_SA(1, 1), a1 + hstep, voffA);
            PG8_WAIT_V(8); PG8_WAIT_L(0); PG8_BAR; PG8_MMA(0, 0, At, B0); PG8_MMA(0, 1, At, B1); PG8_BAR; PG8_SCHED;
            PG8_LDA(At, 0, 1); PG8_STAGE(PG8_SB(0, 0), b2, voffB); PG8_STAGE(PG8_SB(0, 1), b2 + hstep, voffB); PG8_STAGE(PG8_SA(0, 0), a2, voffA);
            PG8_WAIT_V(8); PG8_WAIT_L(0); PG8_BAR; PG8_MMA(1, 0, At, B0); PG8_MMA(1, 1, At, B1); PG8_BAR; PG8_SCHED;
            PG8_LDB(B0, 1, 0); PG8_LDB(B1, 1, 1); PG8_SCHED; PG8_LDA(At, 1, 0); PG8_STAGE(PG8_SA(0, 1), a2 + hstep, voffA);
            PG8_WAIT_V(8); PG8_WAIT_L(0); PG8_BAR; PG8_MMA(0, 0, At, B0); PG8_MMA(0, 1, At, B1); PG8_BAR; PG8_SCHED;
            PG8_LDA(At, 1, 1); PG8_STAGE(PG8_SB(1, 0), b3, voffB); PG8_STAGE(PG8_SB(1, 1), b3 + hstep, voffB); PG8_STAGE(PG8_SA(1, 0), a3, voffA);
            PG8_WAIT_V(8); PG8_WAIT_L(0); PG8_BAR; PG8_MMA(1, 0, At, B0); PG8_MMA(1, 1, At, B1); PG8_BAR; PG8_SCHED;
            } else {
            PG8_LDB(B0, 0, 0); PG8_SCHED; PG8_LDA(At, 0, 0); PG8_STAGE(PG8_SA(1, 1), a1 + hstep, voffA);
            PG8_WAIT_L(8); PG8_BAR; PG8_WAIT_L(0); PG8_MMA(0, 0, At, B0); PG8_BAR; PG8_SCHED;
            PG8_LDB(B1, 0, 1); PG8_STAGE(PG8_SB(0, 0), b2, voffB);
            PG8_BAR; PG8_WAIT_L(0); PG8_MMA(0, 1, At, B1); PG8_BAR;
            PG8_LDA(At, 0, 1); PG8_STAGE(PG8_SA(0, 0), a2, voffA);
            PG8_BAR; PG8_WAIT_L(0); PG8_MMA(1, 0, At, B0); PG8_BAR; PG8_SCHED;
            PG8_STAGE(PG8_SB(0, 1), b2 + hstep, voffB);
            PG8_WAIT_V(6); PG8_BAR; PG8_MMA(1, 1, At, B1); PG8_BAR;
            PG8_LDB(B0, 1, 0); PG8_SCHED; PG8_LDA(At, 1, 0); PG8_STAGE(PG8_SA(0, 1), a2 + hstep, voffA);
            PG8_WAIT_L(8); PG8_BAR; PG8_WAIT_L(0); PG8_MMA(0, 0, At, B0); PG8_BAR; PG8_SCHED;
            PG8_LDB(B1, 1, 1); PG8_STAGE(PG8_SB(1, 0), b3, voffB);
            PG8_BAR; PG8_WAIT_L(0); PG8_MMA(0, 1, At, B1); PG8_BAR;
            PG8_LDA(At, 1, 1); PG8_STAGE(PG8_SA(1, 0), a3, voffA);
            PG8_BAR; PG8_WAIT_L(0); PG8_MMA(1, 0, At, B0); PG8_BAR; PG8_SCHED;
            PG8_STAGE(PG8_SB(1, 1), b3 + hstep, voffB);
            PG8_WAIT_V(6); PG8_BAR; PG8_MMA(1, 1, At, B1); PG8_BAR;
            }
        }
        if constexpr (ALIGN_EPI) { if (wr == 0) PG8_BAR; }
        if constexpr (!Epi::AFTER_DRAIN) { E(acc, cur, wr, wc, fr, fq); S.done(cur); }
        if (!has_next) break;
#pragma unroll
        for (int a = 0; a < 2; ++a)
#pragma unroll
            for (int b = 0; b < 2; ++b)
#pragma unroll
                for (int m = 0; m < 4; ++m)
#pragma unroll
                    for (int n = 0; n < 2; ++n) acc[a][b][m][n] = (f32x4){0.f, 0.f, 0.f, 0.f};
        cur = nxt; cA = nA; cB = nB; ++ui;
        if constexpr (ALIGN_EPI) { if (wr == 1) PG8_BAR; }
    }
    PG8_WAIT_V(0);
    if constexpr (!ALIGN_EPI) { if (wr == 0) PG8_BAR; }
    PG8_BAR;
    if constexpr (Epi::AFTER_DRAIN) { E.fused(acc, cur, wr, wc, fr, fq, lds, wid, lane); S.done(cur); }
#undef PG8_SA
#undef PG8_SB
#undef PG8_STAGE
#undef PG8_LDA
#undef PG8_LDB
#undef PG8_MMA
#undef PG8_WAIT_V
#undef PG8_WAIT_L
#undef PG8_BAR
#undef PG8_SCHED
}
}

struct Ctx {
    unsigned aoff; int l;
    float* X; bf16_t* H; bf16_t* P; bf16_t* MIX; bf16_t* QP; float* OF; float* OB; int* PIDX; float* PG; float* MOD; float* LB; float* ROPE; bf16_t* WIN; bf16_t* WOUT; bf16_t* WQ; bf16_t* UB; bf16_t* VB; float* ST; float* AC; float* PA; float* VS; float* US; bf16_t* SKH; bf16_t* SKL;
    unsigned char* lds; int tid, lane, wave, gw, ngw, bid, nb;
    int xg, nxg, jx, nloc;
};

#define LAS __attribute__((address_space(3)))
DI void transpose_item(const float* W, int Kd, int N, bf16_t* WT, LAS float* scr, int item, int lane) {
    const int nblk = N / 32, kb = item / nblk, nb = item % nblk, k0 = 64 * kb, n0 = 32 * nb;
#pragma unroll 8
    for (int i = 0; i < 32; ++i) { const int kk = 2 * i + (lane >> 5); scr[kk * 33 + (lane & 31)] = W[(size_t)(k0 + kk) * N + n0 + (lane & 31)]; }
    asm volatile("s_waitcnt lgkmcnt(0)" ::: "memory");
    const int c = lane & 7;
#pragma unroll
    for (int j = 0; j < 4; ++j) { const int n = (lane >> 3) + 8 * j; const LAS float* sp = scr + (8 * c) * 33 + n;
        u32x4 o; o.x = pk2(sp[0 * 33], sp[1 * 33]); o.y = pk2(sp[2 * 33], sp[3 * 33]); o.z = pk2(sp[4 * 33], sp[5 * 33]); o.w = pk2(sp[6 * 33], sp[7 * 33]);
        *(u32x4*)(WT + (size_t)(n0 + n) * Kd + k0 + 8 * c) = o; }
    asm volatile("s_waitcnt lgkmcnt(0)" ::: "memory");
}

template <class T> DI T* argp_(const Ctx& K, unsigned off) {
    const unsigned* p = (const unsigned*)(K.lds + K.aoff + off);
    const unsigned lo = __builtin_amdgcn_readfirstlane(p[0]), hi = __builtin_amdgcn_readfirstlane(p[1]);
    return (T*)(((unsigned long long)hi << 32) | (unsigned long long)lo);
}
#define ARG(f) argp_<const float>(K, (unsigned)__builtin_offsetof(Args, f))

DI void ph_prologue(Ctx& K) {
    {
        LAS float* scr = (LAS float*)((LAS unsigned char*)K.lds + K.wave * 16384);
        constexpr int I_IN = (D / 64) * (PW / 32), I_OUT = (D / 64) * (D / 32), I_Q = (D / 64) * (2048 / 32), I_L = I_IN + I_OUT + I_Q;
        for (int it = K.gw; it < DEPTH * I_L; it += K.ngw) {
            const int l = it / I_L; int r = it % I_L;
            if (r < I_IN) { transpose_item(ARG(w_in) + (size_t)l * D * PW, D, PW, K.WIN + (size_t)l * PW * D, scr, r, K.lane); continue; } r -= I_IN;
            if (r < I_OUT) { transpose_item(ARG(w_out) + (size_t)l * D * D, D, D, K.WOUT + (size_t)l * D * D, scr, r, K.lane); continue; } r -= I_OUT;
            transpose_item(ARG(peer_wq) + (size_t)l * D * 2048, D, 2048, K.WQ + (size_t)l * 2048 * D, scr, r, K.lane);
        }
    }
    const size_t gt = (size_t)K.bid * NTHREADS + K.tid, gs = (size_t)K.nb * NTHREADS;
    { const f32x4* s0 = (const f32x4*)ARG(ctx); const f32x4* s1 = (const f32x4*)ARG(x); f32x4* d = (f32x4*)K.X;
      const size_t n0 = (size_t)NCTX * D / 4, n1 = (size_t)NLAT * D / 4;
      for (size_t i = gt; i < n0 + n1; i += gs) d[i] = i < n0 ? s0[i] : s1[i - n0]; }
    { const float* sk = ARG(peer_sk);
      for (size_t i = gt; i < (size_t)DEPTH * 8 * 2 * 128 * 128; i += gs) { const float v = sk[i]; const bf16_t hi = f2bf(v); K.SKH[i] = hi; K.SKL[i] = f2bf(v - bf2f(hi)); } }
    { const float* pu = ARG(peer_u); unsigned char* UQ = (unsigned char*)K.UB;
      for (int row = K.gw; row < DEPTH * 16384; row += K.ngw) {
          const f32x4* src = (const f32x4*)(pu + (size_t)row * D); f32x4 v[4]; float mx = 0.f;
#pragma unroll
          for (int j = 0; j < 4; ++j) { v[j] = src[j * 64 + K.lane]; mx = fmaxf(mx, fmaxf(fmaxf(fabsf(v[j].x), fabsf(v[j].y)), fmaxf(fabsf(v[j].z), fabsf(v[j].w)))); }
#pragma unroll
          for (int o = 1; o < 64; o <<= 1) mx = fmaxf(mx, __shfl_xor(mx, o));
          const float sc = fmaxf(mx, 1e-30f) * (1.0f / 127.0f), inv = 1.0f / sc;
          if (K.lane == 0) K.US[row] = sc;
#pragma unroll
          for (int j = 0; j < 4; ++j) { const int col = j * 256 + K.lane * 4;
              const unsigned q0 = (unsigned)((int)rintf(v[j].x * inv)) & 0xffu, q1 = (unsigned)((int)rintf(v[j].y * inv)) & 0xffu, q2 = (unsigned)((int)rintf(v[j].z * inv)) & 0xffu, q3 = (unsigned)((int)rintf(v[j].w * inv)) & 0xffu;
              *(unsigned*)(UQ + (size_t)row * D + col) = q0 | (q1 << 8) | (q2 << 16) | (q3 << 24); } } }
    { const float* pv = ARG(peer_v); unsigned char* VQ = (unsigned char*)K.VB;
      for (int row = K.gw; row < DEPTH * 16384; row += K.ngw) {
          const f32x4* src = (const f32x4*)(pv + (size_t)row * D); f32x4 v[4]; float mx = 0.f;
#pragma unroll
          for (int j = 0; j < 4; ++j) { v[j] = src[j * 64 + K.lane]; mx = fmaxf(mx, fmaxf(fmaxf(fabsf(v[j].x), fabsf(v[j].y)), fmaxf(fabsf(v[j].z), fabsf(v[j].w)))); }
#pragma unroll
          for (int o = 1; o < 64; o <<= 1) mx = fmaxf(mx, __shfl_xor(mx, o));
          const float sc = fmaxf(mx, 1e-30f) * (1.0f / 127.0f), inv = 1.0f / sc;
          if (K.lane == 0) K.VS[row] = sc;
          const int l = row >> 14, e = row & 16383;
#pragma unroll
          for (int j = 0; j < 4; ++j) { const int col = j * 256 + K.lane * 4;
              const unsigned q0 = (unsigned)((int)rintf(v[j].x * inv) + 128), q1 = (unsigned)((int)rintf(v[j].y * inv) + 128), q2 = (unsigned)((int)rintf(v[j].z * inv) + 128), q3 = (unsigned)((int)rintf(v[j].w * inv) + 128);
              *(unsigned*)(VQ + (((size_t)l * 8 + (col >> 7)) * 16384 + e) * 128 + (col & 127)) = q0 | (q1 << 8) | (q2 << 16) | (q3 << 24); } } }
    { float* sv = (float*)K.lds;
      float* part = sv + 3 * D;
      __syncthreads();
      for (int i = K.tid; i < 3 * D; i += NTHREADS) { const int v = i / D, k = i % D; const float c = v < 2 ? ARG(c)[v * D + k] : ARG(c_ctx)[k]; sv[i] = c * sigmoidf_(c); }
      __syncthreads();
      for (int item = K.bid; item < DEPTH * 24; item += K.nb) {
          const int l = item / 24, cb = item % 24;
          const float* w = ARG(w_mod) + (size_t)l * D * 6 * D + cb * 256 + K.lane * 4;
          f32x4 a0 = {0.f, 0.f, 0.f, 0.f}, a1 = a0, a2 = a0;
#pragma unroll 8
          for (int kk = 0; kk < 128; ++kk) { const int k = K.wave * 128 + kk; const f32x4 wv = *(const f32x4*)(w + (size_t)k * 6 * D);
              a0 += wv * sv[k]; a1 += wv * sv[D + k]; a2 += wv * sv[2 * D + k]; }
          *(f32x4*)(part + (K.wave * 3 + 0) * 256 + K.lane * 4) = a0; *(f32x4*)(part + (K.wave * 3 + 1) * 256 + K.lane * 4) = a1; *(f32x4*)(part + (K.wave * 3 + 2) * 256 + K.lane * 4) = a2;
          __syncthreads();
          for (int i = K.tid; i < 768; i += NTHREADS) { const int v = i / 256, cc = i % 256; float sum = 0.f;
#pragma unroll
              for (int w8 = 0; w8 < 8; ++w8) sum += part[(w8 * 3 + v) * 256 + cc];
              const int col = cb * 256 + cc; K.MOD[((size_t)l * 3 + v) * 6 * D + col] = sum + ARG(b_mod)[(size_t)l * 6 * D + col]; }
          __syncthreads();
      } }
    for (size_t i = gt; i < 2 * 256; i += gs) {
        const int dir = (int)(i / 256), ch = (int)(i % 256);
        float lg[DEPTH], mx = -1e30f;
#pragma unroll
        for (int l = 0; l < DEPTH; ++l) { lg[l] = ARG(lb_logits)[((size_t)dir * DEPTH + l) * 256 + ch]; mx = fmaxf(mx, lg[l]); }
        float s = 0.f;
#pragma unroll
        for (int l = 0; l < DEPTH; ++l) { lg[l] = expf(lg[l] - mx); s += lg[l]; }
        float cum = 0.f;
#pragma unroll
        for (int l = 0; l < DEPTH; ++l) { if (l > 0) cum += lg[l] / s; K.LB[((size_t)dir * DEPTH + l) * 256 + ch] = cum; }
    }
    for (size_t i = gt; i < (256 + 64) * 16; i += gs) {
        const int pos = (int)(i / 16), f = (int)(i % 16);
        const float inv = powf(10000.0f, -(float)f / 16.0f);
        if (pos < 256) { const float ang = (float)pos * inv; K.ROPE[pos * 16 + f] = cosf(ang); K.ROPE[4096 + pos * 16 + f] = sinf(ang); }
        else { const int pc = pos - 256; const float ang = (float)pc * inv; K.ROPE[8192 + pc * 16 + f] = cosf(ang); K.ROPE[8192 + 1024 + pc * 16 + f] = sinf(ang); }
    }
}

DI void ph_norm(Ctx& K, const float* nw, int shift_chunk) {
    const float* modl = K.MOD + (size_t)K.l * 3 * 6 * D;
    for (int r = K.gw; r < M; r += K.ngw) {
        const f32x4* xr = (const f32x4*)(K.X + (size_t)r * D);
        f32x4 v[4]; float ss = 0.f;
#pragma unroll
        for (int j = 0; j < 4; ++j) { v[j] = xr[j * 64 + K.lane]; ss += v[j].x * v[j].x + v[j].y * v[j].y + v[j].z * v[j].z + v[j].w * v[j].w; }
        ss = wave_sum(ss);
        const float rs = rsqrtf(ss * (1.0f / D) + EPS);
        const float* mv = modl + (size_t)modvec_of_row(r) * 6 * D;
        u32x2* ho = (u32x2*)(K.H + (size_t)r * D);
#pragma unroll
        for (int j = 0; j < 4; ++j) {
            const int c4 = j * 64 + K.lane;
            const f32x4 w = ((const f32x4*)nw)[c4], sh = ((const f32x4*)(mv + shift_chunk * D))[c4], sc = ((const f32x4*)(mv + (shift_chunk + 1) * D))[c4];
            f32x4 y; y.x = v[j].x * rs * w.x * (1.f + sc.x) + sh.x; y.y = v[j].y * rs * w.y * (1.f + sc.y) + sh.y; y.z = v[j].z * rs * w.z * (1.f + sc.z) + sh.z; y.w = v[j].w * rs * w.w * (1.f + sc.w) + sh.w;
            u32x2 o; o.x = pk2(y.x, y.y); o.y = pk2(y.z, y.w); ho[c4] = o;
        }
    }
}

DI void ph_gemm_store(Ctx& K, const bf16_t* A, const bf16_t* Bt, int N, bf16_t* out) {
    pg8::Gemm g{A, Bt, M, N, D}; pg8::StaticOrder S; S.init(M, N, K.nb, K.bid);
    pg8::EpiStore E{out, N};
    pg8::gemm_phase<pg8::EpiStore, pg8::StaticOrder, true, true>((LAS unsigned char*)K.lds, g, S, E);
}
DI void ph_gemm_resid(Ctx& K, const bf16_t* A, const bf16_t* Bt, int chunk) {
    pg8::Gemm g{A, Bt, M, D, D}; pg8::StaticOrder S; S.init(M, D, K.nb, K.bid);
    pg8::EpiResid E{K.X, D, K.MOD + (size_t)K.l * 3 * 6 * D + (size_t)chunk * D, 6 * D, NCTX, L};
    pg8::gemm_phase<pg8::EpiResid, pg8::StaticOrder, true, true>((LAS unsigned char*)K.lds, g, S, E);
}

DI void ph_rope(Ctx& K) {
    const float* cosr = K.ROPE; const float* sinr = K.ROPE + 4096; const float* cosc = K.ROPE + 8192; const float* sinc = K.ROPE + 8192 + 1024;
    const size_t gt = (size_t)K.bid * NTHREADS + K.tid, gs = (size_t)K.nb * NTHREADS;
    for (size_t i = gt; i < (size_t)NLAT * 8 * 16; i += gs) {
        const int f = (int)(i & 15), hh = (int)((i >> 4) & 7), lr = (int)(i >> 7);
        const int t = lr % L, pr = t >> 6, pc = t & 63;
        bf16_t* p = K.P + (size_t)(NCTX + lr) * PW + (hh < 6 ? C_SQ + hh * 64 : C_SK + (hh - 6) * 64);
        const float c1 = cosr[pr * 16 + f], s1 = sinr[pr * 16 + f], c2 = cosc[pc * 16 + f], s2 = sinc[pc * 16 + f];
        const float a = bf2f(p[f]), b = bf2f(p[16 + f]), e = bf2f(p[32 + f]), g = bf2f(p[48 + f]);
        p[f] = f2bf(a * c1 - b * s1); p[16 + f] = f2bf(b * c1 + a * s1); p[32 + f] = f2bf(e * c2 - g * s2); p[48 + f] = f2bf(g * c2 + e * s2);
    }
}

typedef short bf16x8_t __attribute__((ext_vector_type(8)));
#define MFMA16(a, b, c) __builtin_amdgcn_mfma_f32_16x16x32_bf16((a), (b), (c), 0, 0, 0)
constexpr int HG_NCH = (CL + L) / 64;
constexpr int HG_LFS = 68;
constexpr int HG_TS = 72;
constexpr int HGL_LF = 0, HGL_OM = HGL_LF + 2 * 64 * HG_LFS * 4, HGL_VT = HGL_OM + 2 * 64 * HG_LFS * 4, HGL_KT = HGL_VT + 64 * HG_TS * 2, HGL_SC = HGL_KT, HGL_OD = HGL_SC + 8 * 16 * HG_TS * 2, HGL_END = HGL_OD + 2 * 64 * HG_LFS * 4;
static_assert(HGL_KT + 2 * 64 * HG_TS * 2 <= LDS_BYTES && HGL_END <= LDS_BYTES, "hgrn LDS map");
DI int hg_block_row(int b, int tb, int tok) { return tb < 4 ? ctx_row(b, tb * 64 + tok) : lat_row(b, (tb - 4) * 64 + tok); }
DI int hg_bwd_chunk(int tb) { return tb < 4 ? 3 - tb : 4 + 255 - (tb - 4); }
DI void hg_prep(Ctx& K, int b, int h, int tb) {
    float* LF = (float*)(K.lds + HGL_LF); float* OM = (float*)(K.lds + HGL_OM); bf16_t* VT = (bf16_t*)(K.lds + HGL_VT);
    const int tok = K.tid >> 3, c = K.tid & 7;
    const bf16_t* pr = K.P + (size_t)hg_block_row(b, tb, tok) * PW + h * 64 + 8 * c;
#pragma unroll
    for (int dir = 0; dir < 2; ++dir) {
        float z[8]; unpack8(*(const u32x4*)(pr + (dir ? C_ZB : C_ZF)), z);
        const float* lb = K.LB + ((size_t)dir * DEPTH + K.l) * 256 + h * 64 + 8 * c;
        float lf[8], om[8];
#pragma unroll
        for (int j = 0; j < 8; ++j) { const float lbv = lb[j], sg = sigmoidf_(z[j]); const float f = fmaxf(lbv + (1.f - lbv) * sg, 1e-30f); lf[j] = __logf(f); om[j] = (1.f - lbv) * (1.f - sg); }
        float* lfp = LF + (dir * 64 + tok) * HG_LFS + 8 * c; float* omp = OM + (dir * 64 + tok) * HG_LFS + 8 * c;
        *(f32x4*)lfp = (f32x4){lf[0], lf[1], lf[2], lf[3]}; *(f32x4*)(lfp + 4) = (f32x4){lf[4], lf[5], lf[6], lf[7]};
        *(f32x4*)omp = (f32x4){om[0], om[1], om[2], om[3]}; *(f32x4*)(omp + 4) = (f32x4){om[4], om[5], om[6], om[7]};
    }
    { const u32x4 v = *(const u32x4*)(pr + C_HV);
      const unsigned w[4] = {v.x, v.y, v.z, v.w};
#pragma unroll
      for (int j = 0; j < 4; ++j) { VT[(8 * c + 2 * j) * HG_TS + tok] = (bf16_t)(w[j] & 0xffffu); VT[(8 * c + 2 * j + 1) * HG_TS + tok] = (bf16_t)(w[j] >> 16); } }
    __syncthreads();
    if (K.tid < 128) {
        const int dir = K.tid >> 6, d = K.tid & 63; float* col = LF + dir * 64 * HG_LFS + d;
        float v[64];
#pragma unroll
        for (int p = 0; p < 64; ++p) v[p] = col[(dir ? 63 - p : p) * HG_LFS];
#pragma unroll
        for (int p = 1; p < 64; ++p) v[p] += v[p - 1];
#pragma unroll
        for (int p = 0; p < 64; ++p) col[(dir ? 63 - p : p) * HG_LFS] = v[p];
    }
    __syncthreads();
}
DI void ph_hgrn_A(Ctx& K) {
    float* LF = (float*)(K.lds + HGL_LF); float* OM = (float*)(K.lds + HGL_OM); bf16_t* VT = (bf16_t*)(K.lds + HGL_VT); bf16_t* KT = (bf16_t*)(K.lds + HGL_KT);
    const int r16 = K.lane & 15, g4 = K.lane >> 4;
    for (int item = K.bid; item < NB * 4 * HG_NCH; item += K.nb) {
        const int tb = item % HG_NCH, h = (item / HG_NCH) & 3, b = item / (HG_NCH * 4);
        __syncthreads();
        hg_prep(K, b, h, tb);
        { const int tok = K.tid >> 3, c = K.tid & 7;
#pragma unroll
          for (int dir = 0; dir < 2; ++dir) {
              const float* bl = LF + (dir * 64 + (dir ? 0 : 63)) * HG_LFS + 8 * c; const float* bt = LF + (dir * 64 + tok) * HG_LFS + 8 * c; const float* om = OM + (dir * 64 + tok) * HG_LFS + 8 * c;
#pragma unroll
              for (int j = 0; j < 8; ++j) KT[(dir * 64 + 8 * c + j) * HG_TS + tok] = f2bf(om[j] * __expf(bl[j] - bt[j]));
          }
          if (K.tid < 128) { const int dir = K.tid >> 6, d = K.tid & 63; const int chain = (b * 2 + dir) * 4 + h, ch = dir ? hg_bwd_chunk(tb) : tb;
              K.AC[((size_t)chain * HG_NCH + ch) * 64 + d] = __expf(LF[(dir * 64 + (dir ? 0 : 63)) * HG_LFS + d]); } }
        __syncthreads();
        { const int dir = K.wave >> 2, mi = K.wave & 3; const int chain = (b * 2 + dir) * 4 + h, ch = dir ? hg_bwd_chunk(tb) : tb;
          f32x4 acc[4];
#pragma unroll
          for (int nj = 0; nj < 4; ++nj) acc[nj] = (f32x4){0.f, 0.f, 0.f, 0.f};
#pragma unroll
          for (int ks = 0; ks < 2; ++ks) {
              const bf16x8_t av = *(const bf16x8_t*)(VT + (16 * mi + r16) * HG_TS + 32 * ks + 8 * g4);
#pragma unroll
              for (int nj = 0; nj < 4; ++nj) { const bf16x8_t bv = *(const bf16x8_t*)(KT + (dir * 64 + 16 * nj + r16) * HG_TS + 32 * ks + 8 * g4); acc[nj] = MFMA16(av, bv, acc[nj]); }
          }
          float* st = K.ST + ((size_t)chain * HG_NCH + ch) * 4096;
#pragma unroll
          for (int nj = 0; nj < 4; ++nj)
#pragma unroll
              for (int rg = 0; rg < 4; ++rg) st[(16 * mi + 4 * g4 + rg) * 64 + 16 * nj + r16] = acc[nj][rg];
        }
    }
}
DI void ph_hgrn_B(Ctx& K) {
    const int gt = K.bid * NTHREADS + K.tid;
    if (gt < 16 * 4096) {
        const int chain = gt >> 12, idx = gt & 4095, d = idx & 63;
        float* st = K.ST + (size_t)chain * HG_NCH * 4096 + idx; const float* ac = K.AC + (size_t)chain * HG_NCH * 64 + d;
        float S = 0.f;
#pragma unroll 1
        for (int c0 = 0; c0 < HG_NCH; c0 += 10) {
            float u[10], a[10];
#pragma unroll
            for (int i = 0; i < 10; ++i) { u[i] = st[(size_t)(c0 + i) * 4096]; a[i] = ac[(c0 + i) * 64]; }
#pragma unroll
            for (int i = 0; i < 10; ++i) { st[(size_t)(c0 + i) * 4096] = S; S = a[i] * S + u[i]; }
        }
    }
}
DI void ph_hgrn_C(Ctx& K) {
    float* LF = (float*)(K.lds + HGL_LF); float* OM = (float*)(K.lds + HGL_OM); bf16_t* VT = (bf16_t*)(K.lds + HGL_VT); float* OD = (float*)(K.lds + HGL_OD);
    bf16_t* SC = (bf16_t*)(K.lds + HGL_SC) + K.wave * 16 * HG_TS;
    const int r16 = K.lane & 15, g4 = K.lane >> 4;
    for (int item = K.bid; item < NB * 4 * HG_NCH; item += K.nb) {
        const int tb = item % HG_NCH, h = (item / HG_NCH) & 3, b = item / (HG_NCH * 4);
        __syncthreads();
        hg_prep(K, b, h, tb);
        { const int dir = K.wave >> 2, mi = K.wave & 3; const int chain = (b * 2 + dir) * 4 + h, ch = dir ? hg_bwd_chunk(tb) : tb;
          const float* LFd = LF + dir * 64 * HG_LFS; const float* OMd = OM + dir * 64 * HG_LFS; const float* ref = LFd + 32 * HG_LFS;
          bf16x8_t aq1[2], aq2[2];
          { const int t = 16 * mi + r16; const bf16_t* qr = K.P + (size_t)hg_block_row(b, tb, t) * PW + C_HQ + h * 64;
#pragma unroll
            for (int ks = 0; ks < 2; ++ks) { const int d0 = 32 * ks + 8 * g4; float q[8]; unpack8(*(const u32x4*)(qr + d0), q);
                u32x4 w1, w2; unsigned o1[4], o2[4];
#pragma unroll
                for (int j = 0; j < 4; ++j) { float x1[2], x2[2];
#pragma unroll
                    for (int e = 0; e < 2; ++e) { const int dd = d0 + 2 * j + e; const float qs = q[2 * j + e] * sigmoidf_(q[2 * j + e]); const float bt = LFd[t * HG_LFS + dd]; x1[e] = qs * __expf(bt - ref[dd]); x2[e] = qs * __expf(bt); }
                    o1[j] = pk2(x1[0], x1[1]); o2[j] = pk2(x2[0], x2[1]); }
                w1 = (u32x4){o1[0], o1[1], o1[2], o1[3]}; w2 = (u32x4){o2[0], o2[1], o2[2], o2[3]};
                aq1[ks] = __builtin_bit_cast(bf16x8_t, w1); aq2[ks] = __builtin_bit_cast(bf16x8_t, w2); } }
          f32x4 sc[4];
#pragma unroll
          for (int nj = 0; nj < 4; ++nj) { sc[nj] = (f32x4){0.f, 0.f, 0.f, 0.f}; const int s_ = 16 * nj + r16;
#pragma unroll
              for (int ks = 0; ks < 2; ++ks) { const int d0 = 32 * ks + 8 * g4; unsigned o[4];
#pragma unroll
                  for (int j = 0; j < 4; ++j) { const int dd = d0 + 2 * j; o[j] = pk2(OMd[s_ * HG_LFS + dd] * __expf(ref[dd] - LFd[s_ * HG_LFS + dd]), OMd[s_ * HG_LFS + dd + 1] * __expf(ref[dd + 1] - LFd[s_ * HG_LFS + dd + 1])); }
                  const u32x4 w = (u32x4){o[0], o[1], o[2], o[3]};
                  sc[nj] = MFMA16(aq1[ks], __builtin_bit_cast(bf16x8_t, w), sc[nj]); } }
#pragma unroll
          for (int nj = 0; nj < 4; ++nj)
#pragma unroll
              for (int rg = 0; rg < 4; ++rg) { const int tl = 4 * g4 + rg, t = 16 * mi + tl, s_ = 16 * nj + r16; const bool keep = dir ? (s_ >= t) : (s_ <= t);
                  SC[tl * HG_TS + s_] = f2bf(keep ? sc[nj][rg] : 0.f); }
          asm volatile("s_waitcnt lgkmcnt(0)" ::: "memory");
          f32x4 oacc[4];
#pragma unroll
          for (int nj = 0; nj < 4; ++nj) oacc[nj] = (f32x4){0.f, 0.f, 0.f, 0.f};
          const float* st = K.ST + ((size_t)chain * HG_NCH + ch) * 4096;
#pragma unroll
          for (int ks = 0; ks < 2; ++ks) {
              const bf16x8_t as = *(const bf16x8_t*)(SC + r16 * HG_TS + 32 * ks + 8 * g4);
#pragma unroll
              for (int nj = 0; nj < 4; ++nj) {
                  const bf16x8_t bv = *(const bf16x8_t*)(VT + (16 * nj + r16) * HG_TS + 32 * ks + 8 * g4);
                  oacc[nj] = MFMA16(as, bv, oacc[nj]);
                  const float* sp = st + (16 * nj + r16) * 64 + 32 * ks + 8 * g4; const f32x4 s0 = *(const f32x4*)sp, s1 = *(const f32x4*)(sp + 4);
                  const u32x4 w = (u32x4){pk2(s0.x, s0.y), pk2(s0.z, s0.w), pk2(s1.x, s1.y), pk2(s1.z, s1.w)};
                  oacc[nj] = MFMA16(aq2[ks], __builtin_bit_cast(bf16x8_t, w), oacc[nj]);
              }
          }
#pragma unroll
          for (int nj = 0; nj < 4; ++nj)
#pragma unroll
              for (int rg = 0; rg < 4; ++rg) OD[(dir * 64 + 16 * mi + 4 * g4 + rg) * HG_LFS + 16 * nj + r16] = oacc[nj][rg];
        }
        __syncthreads();
        { const int tok = K.tid >> 3, c = K.tid & 7; const int row = hg_block_row(b, tb, tok);
          const float* o0 = OD + tok * HG_LFS + 8 * c; const float* o1 = OD + (64 + tok) * HG_LFS + 8 * c;
          float o[8], ss = 0.f;
#pragma unroll
          for (int j = 0; j < 8; ++j) { o[j] = o0[j] + o1[j]; ss += o[j] * o[j]; }
          ss += __shfl_xor(ss, 1); ss += __shfl_xor(ss, 2); ss += __shfl_xor(ss, 4);
          const float rs = rsqrtf(ss * (1.0f / 64.0f) + EPS);
          float gq[8]; unpack8(*(const u32x4*)(K.P + (size_t)row * PW + C_HG + h * 64 + 8 * c), gq);
          const float* nw = ARG(hgrn_norm_w) + (size_t)K.l * 256 + h * 64 + 8 * c;
          float y[8];
#pragma unroll
          for (int j = 0; j < 8; ++j) y[j] = o[j] * rs * nw[j] * gq[j] * sigmoidf_(gq[j]);
          u32x4 w; w.x = pk2(y[0], y[1]); w.y = pk2(y[2], y[3]); w.z = pk2(y[4], y[5]); w.w = pk2(y[6], y[7]);
          *(u32x4*)(K.MIX + (size_t)row * D + MX_H + h * 64 + 8 * c) = w; }
    }
}

constexpr int AT_TS = 72;
constexpr int ATL_K = 0, ATL_V = ATL_K + 64 * AT_TS * 2, ATL_P = ATL_V + 64 * AT_TS * 2, ATL_END = ATL_P + 8 * 48 * AT_TS * 2;
static_assert(ATL_END <= LDS_BYTES - 256, "attention LDS map");
DI float dpp_max16(float x) { x = fmaxf(x, dpp_<0xB1>(x)); x = fmaxf(x, dpp_<0x4E>(x)); x = fmaxf(x, dpp_<0x141>(x)); x = fmaxf(x, dpp_<0x128>(x)); return x; }
DI float dpp_sum16(float x) { x += dpp_<0xB1>(x); x += dpp_<0x4E>(x); x += dpp_<0x141>(x); x += dpp_<0x128>(x); return x; }
template <int KIND> DI void attn_item(Ctx& K, int idx, const float* sinkp, const float* rpbp) {
    constexpr int MT = KIND == 0 ? 3 : 2;
    int tid_ = K.tid; asm volatile("" : "+v"(tid_));
    const int lane_ = tid_ & 63, wave_ = tid_ >> 6;
    bf16_t* KT = (bf16_t*)(K.lds + ATL_K); bf16_t* VT = (bf16_t*)(K.lds + ATL_V); bf16_t* PS = (bf16_t*)(K.lds + ATL_P) + wave_ * 48 * AT_TS;
    const int r16 = lane_ & 15, g4 = lane_ >> 4;
    int b, hk, qb = 0;
    if (KIND == 0) { qb = idx & 127; hk = (idx >> 7) & 1; b = idx >> 8; }
    else if (KIND == 1) { qb = idx & 63; hk = (idx >> 6) % 6; b = (idx >> 6) / 6; }
    else { hk = idx % 6; b = idx / 6; }
    const int kcol = (KIND == 0) ? C_SK + hk * 64 : (KIND == 2) ? C_SK + (hk / 3) * 64 : C_NK + hk * 64;
    const int vcol = (KIND == 0) ? C_SV + hk * 64 : (KIND == 2) ? C_SV + (hk / 3) * 64 : C_NV + hk * 64;
    int t0 = 0, nloc = 0;
    if (KIND == 0) { const int k0 = max(2 * qb - 2, 0), k1 = min(2 * qb + 3, L / 64 - 1); t0 = k0; nloc = k1 - k0 + 1; }
    if (KIND == 1) { const int k0 = min(max(4 * qb - 4, 0), L / 64 - 8), k1 = min(max(4 * qb + 3 - 4, 0), L / 64 - 8) + 7; t0 = k0; nloc = k1 - k0 + 1; }
    const int ntiles = nloc + CL / 64;
    int w_r = 0, w_rs = 0;
    if (KIND == 1) { w_r = 4 * qb + (wave_ >> 1); w_rs = min(max(w_r - 4, 0), L / 64 - 8); }
    bf16x8_t qf[MT][2]; int qbase[MT], hq_mt[MT];
#pragma unroll
    for (int mt = 0; mt < MT; ++mt) {
        int arow, hq;
        if (KIND == 0) { const int rho = wave_ * 48 + mt * 16; hq = hk * 3 + rho / 128; hq_mt[mt] = hq; const int tb = 128 * qb + (rho & 127); arow = lat_row(b, tb + r16); qbase[mt] = tb; }
        else if (KIND == 1) { hq = hk; hq_mt[mt] = hq; const int cb = 32 * (wave_ & 1) + 16 * mt; arow = lat_row(b, w_r * 64 + cb + r16); qbase[mt] = cb; }
        else { hq = hk; hq_mt[mt] = hq; const int tb = wave_ * 32 + mt * 16; arow = ctx_row(b, tb + r16); qbase[mt] = 0; }
        const int qcol = (KIND == 0 || KIND == 2) ? C_SQ + hq * 64 : C_NQ + hq * 64;
#pragma unroll
        for (int ks = 0; ks < 2; ++ks) { float q[8]; unpack8(*(const u32x4*)(K.P + (size_t)arow * PW + qcol + 32 * ks + 8 * g4), q);
            const u32x4 w = (u32x4){pk2(q[0] * 0.125f, q[1] * 0.125f), pk2(q[2] * 0.125f, q[3] * 0.125f), pk2(q[4] * 0.125f, q[5] * 0.125f), pk2(q[6] * 0.125f, q[7] * 0.125f)};
            qf[mt][ks] = __builtin_bit_cast(bf16x8_t, w); }
    }
    f32x4 oacc[MT][4]; float mrun[MT][4], lrun[MT][4];
#pragma unroll
    for (int mt = 0; mt < MT; ++mt) {
#pragma unroll
        for (int ne = 0; ne < 4; ++ne) oacc[mt][ne] = (f32x4){0.f, 0.f, 0.f, 0.f};
        const bool has_sink = (KIND == 0 || KIND == 2); const float sk = has_sink ? sinkp[hq_mt[mt]] : -1.0e30f;
#pragma unroll
        for (int rg = 0; rg < 4; ++rg) { mrun[mt][rg] = sk; lrun[mt][rg] = has_sink ? 1.0f : 0.0f; }
    }
    const int lkey = tid_ >> 3, lch = tid_ & 7;
    u32x4 pk_, pv_;
    { const int ti = 0; const int grow = (ti < nloc) ? lat_row(b, (t0 + ti) * 64 + lkey) : ctx_row(b, (ti - nloc) * 64 + lkey);
      const bf16_t* pr = K.P + (size_t)grow * PW + 8 * lch; pk_ = *(const u32x4*)(pr + kcol); pv_ = *(const u32x4*)(pr + vcol); }
#pragma unroll 1
    for (int ti = 0; ti < ntiles; ++ti) {
        __syncthreads();
        *(u32x4*)(KT + lkey * AT_TS + 8 * lch) = pk_;
        { const unsigned w[4] = {pv_.x, pv_.y, pv_.z, pv_.w};
#pragma unroll
          for (int j = 0; j < 4; ++j) { VT[(8 * lch + 2 * j) * AT_TS + lkey] = (bf16_t)(w[j] & 0xffffu); VT[(8 * lch + 2 * j + 1) * AT_TS + lkey] = (bf16_t)(w[j] >> 16); } }
        __syncthreads();
        if (ti + 1 < ntiles) { const int tn = ti + 1; const int grow = (tn < nloc) ? lat_row(b, (t0 + tn) * 64 + lkey) : ctx_row(b, (tn - nloc) * 64 + lkey);
            const bf16_t* pr = K.P + (size_t)grow * PW + 8 * lch; pk_ = *(const u32x4*)(pr + kcol); pv_ = *(const u32x4*)(pr + vcol); }
        const bool local = ti < nloc; const int kunit = t0 + ti;
        bool active = true;
        if (KIND == 0 && local) active = true;
        if (KIND == 1 && local) active = (kunit >= w_rs) && (kunit < w_rs + 8);
        if (active) {
            f32x4 sc[MT][4];
#pragma unroll
            for (int mt = 0; mt < MT; ++mt)
#pragma unroll
                for (int nj = 0; nj < 4; ++nj) sc[mt][nj] = (f32x4){0.f, 0.f, 0.f, 0.f};
#pragma unroll
            for (int nj = 0; nj < 4; ++nj)
#pragma unroll
                for (int ks = 0; ks < 2; ++ks) { const bf16x8_t kf = *(const bf16x8_t*)(KT + (16 * nj + r16) * AT_TS + 32 * ks + 8 * g4);
#pragma unroll
                    for (int mt = 0; mt < MT; ++mt) sc[mt][nj] = MFMA16(qf[mt][ks], kf, sc[mt][nj]); }
            if (local) {
#pragma unroll
                for (int mt = 0; mt < MT; ++mt)
#pragma unroll
                    for (int nj = 0; nj < 4; ++nj)
#pragma unroll
                        for (int rg = 0; rg < 4; ++rg) { const int key = 16 * nj + r16;
                            if (KIND == 0) { const int dl = qbase[mt] + 4 * g4 + rg - (kunit * 64 + key); if (dl > 128 || dl < -128) sc[mt][nj][rg] = -INFINITY; }
                            if (KIND == 1) { const int c = qbase[mt] + 4 * g4 + rg, ws = min(max(c - 8, 0), 48);
                                if (key >= ws && key < ws + 16) sc[mt][nj][rg] += rpbp[(kunit - w_r + 7) * 31 + (key - c + 15)]; else sc[mt][nj][rg] = -INFINITY; } }
            }
#pragma unroll
            for (int mt = 0; mt < MT; ++mt)
#pragma unroll
                for (int rg = 0; rg < 4; ++rg) {
                    float mx = fmaxf(fmaxf(sc[mt][0][rg], sc[mt][1][rg]), fmaxf(sc[mt][2][rg], sc[mt][3][rg]));
                    mx = dpp_max16(mx);
                    const float mn = fmaxf(mrun[mt][rg], mx), alpha = __expf(mrun[mt][rg] - mn); mrun[mt][rg] = mn;
                    float rs_ = 0.f;
#pragma unroll
                    for (int nj = 0; nj < 4; ++nj) { const float pe = __expf(sc[mt][nj][rg] - mn); sc[mt][nj][rg] = pe; rs_ += pe; }
                    rs_ = dpp_sum16(rs_);
                    lrun[mt][rg] = lrun[mt][rg] * alpha + rs_;
#pragma unroll
                    for (int ne = 0; ne < 4; ++ne) oacc[mt][ne][rg] *= alpha;
                }
#pragma unroll
            for (int mt = 0; mt < MT; ++mt)
#pragma unroll
                for (int nj = 0; nj < 4; ++nj)
#pragma unroll
                    for (int rg = 0; rg < 4; ++rg) PS[(16 * mt + 4 * g4 + rg) * AT_TS + 16 * nj + r16] = f2bf(sc[mt][nj][rg]);
            asm volatile("s_waitcnt lgkmcnt(0)" ::: "memory");
#pragma unroll
            for (int ks = 0; ks < 2; ++ks) {
                bf16x8_t pf[MT];
#pragma unroll
                for (int mt = 0; mt < MT; ++mt) pf[mt] = *(const bf16x8_t*)(PS + (16 * mt + r16) * AT_TS + 32 * ks + 8 * g4);
#pragma unroll
                for (int ne = 0; ne < 4; ++ne) { const bf16x8_t vf = *(const bf16x8_t*)(VT + (16 * ne + r16) * AT_TS + 32 * ks + 8 * g4);
#pragma unroll
                    for (int mt = 0; mt < MT; ++mt) oacc[mt][ne] = MFMA16(pf[mt], vf, oacc[mt][ne]); }
            }
            asm volatile("s_waitcnt lgkmcnt(0)" ::: "memory");
        }
    }
#pragma unroll
    for (int mt = 0; mt < MT; ++mt)
#pragma unroll
        for (int rg = 0; rg < 4; ++rg) { const float inv = 1.0f / lrun[mt][rg];
#pragma unroll
            for (int ne = 0; ne < 4; ++ne) PS[(16 * mt + 4 * g4 + rg) * AT_TS + 16 * ne + r16] = f2bf(oacc[mt][ne][rg] * inv); }
    asm volatile("s_waitcnt lgkmcnt(0)" ::: "memory");
#pragma unroll
    for (int mt = 0; mt < MT; ++mt) {
        const int ocol = ((KIND == 0 || KIND == 2) ? MX_S : MX_N) + hq_mt[mt] * 64;
#pragma unroll
        for (int i = 0; i < 2; ++i) { const int rr = (lane_ >> 3) + 8 * i, ch = lane_ & 7;
            const u32x4 v = *(const u32x4*)(PS + (16 * mt + rr) * AT_TS + 8 * ch);
            int grow;
            if (KIND == 0) { const int rho = wave_ * 48 + mt * 16; grow = lat_row(b, 128 * qb + (rho & 127) + rr); }
            else if (KIND == 1) grow = lat_row(b, w_r * 64 + 32 * (wave_ & 1) + 16 * mt + rr);
            else grow = ctx_row(b, wave_ * 32 + mt * 16 + rr);
            *(u32x4*)(K.MIX + (size_t)grow * D + ocol + 8 * ch) = v; }
    }
    asm volatile("s_waitcnt lgkmcnt(0)" ::: "memory");
}
DI void ph_attn(Ctx& K) {
    constexpr int N_SWA = NB * 2 * (L / 128), N_NAT = NB * 6 * (L / 256), N_C = NB * 6;
    const float* sinkp = ARG(swa_sink) + K.l * 6;
    for (int item = K.bid; item < N_SWA + N_NAT + 2 * N_C; item += K.nb) {
        if (item < N_SWA) attn_item<0>(K, item, sinkp, nullptr);
        else if (item < N_SWA + N_NAT) { const int it = item - N_SWA; const int h = (it >> 6) % 6; attn_item<1>(K, it, nullptr, ARG(nat_rpb) + ((size_t)K.l * 6 + h) * 15 * 31); }
        else if (item < N_SWA + N_NAT + N_C) attn_item<2>(K, item - N_SWA - N_NAT, sinkp, nullptr);
        else attn_item<3>(K, item - N_SWA - N_NAT - N_C, nullptr, nullptr);
    }
}

DI unsigned fkey(float f) { const unsigned u = __float_as_uint(f); return (u & 0x80000000u) ? ~u : (u | 0x80000000u); }
DI int mbcnt64(unsigned long long m) { return (int)__builtin_amdgcn_mbcnt_hi((unsigned)(m >> 32), __builtin_amdgcn_mbcnt_lo((unsigned)m, 0u)); }
template <int NV> DI unsigned radix_thr16(const unsigned (&k)[NV]) {
    unsigned prefix = 0u;
#pragma unroll 1
    for (int bit = 31; bit >= 0; --bit) {
        const unsigned cand = prefix | (1u << bit); int cnt = 0;
#pragma unroll
        for (int i = 0; i < NV; ++i) cnt += __popcll(__ballot(k[i] >= cand));
        if (cnt >= 16) { prefix = cand; if (cnt == 16) break; }
    }
    return prefix;
}
template <int NC, int NV> DI void radix_thr16_multi(const unsigned (&k)[NC][NV], unsigned (&T)[NC]) {
    bool exact[NC];
#pragma unroll
    for (int c = 0; c < NC; ++c) { T[c] = 0u; exact[c] = false; }
#pragma unroll 1
    for (int bit = 31; bit >= 0; --bit) {
        bool all = true;
#pragma unroll
        for (int c = 0; c < NC; ++c) {
            const unsigned cand = T[c] | (1u << bit); int cnt = 0;
#pragma unroll
            for (int i = 0; i < NV; ++i) cnt += __popcll(__ballot(k[c][i] >= cand));
            if (cnt >= 16) { T[c] = cand; exact[c] = (cnt == 16); }
            all = all && exact[c];
        }
        if (all) break;
    }
}
template <int NV> DI void select16(const unsigned (&k)[NV], unsigned T, bool (&sel)[NV], int (&pos)[NV]) {
    int ngt = 0; unsigned long long gtm[NV], eqm[NV];
#pragma unroll
    for (int i = 0; i < NV; ++i) { gtm[i] = __ballot(k[i] > T); eqm[i] = __ballot(k[i] == T); ngt += __popcll(gtm[i]); }
    const int need = 16 - ngt; int eqbase = 0, selbase = 0;
#pragma unroll
    for (int i = 0; i < NV; ++i) {
        const bool iseq = k[i] == T; const int erank = eqbase + mbcnt64(eqm[i]); eqbase += __popcll(eqm[i]);
        sel[i] = (k[i] > T) || (iseq && erank < need);
        const unsigned long long sm = __ballot(sel[i]); pos[i] = selbase + mbcnt64(sm); selbase += __popcll(sm);
    }
}
constexpr int PS_SCS = 132;
constexpr int PSL_TOP = 8 * 2 * 16 * PS_SCS * 4;
static_assert(PSL_TOP + 8 * 512 <= LDS_BYTES - 256, "peer select LDS map");
template <int PROBE> DI void ph_peer_select(Ctx& K) {
    float* SCR = (float*)K.lds + K.wave * 2 * 16 * PS_SCS; float* TOPV = (float*)(K.lds + PSL_TOP + K.wave * 512); int* TOPI = (int*)(TOPV + 64);
    const int r16 = K.lane & 15, g4 = K.lane >> 4, h = K.wave;
    for (int item = K.bid; item < M / 16; item += K.nb) {
        const int t0 = item * 16;
#pragma unroll 1
        for (int p = 0; p < 2; ++p) {
            bf16x8_t aq[4];
            { const bf16_t* qp = K.QP + (size_t)(t0 + r16) * 2048 + h * 256 + p * 128 + 8 * g4;
#pragma unroll
              for (int ks = 0; ks < 4; ++ks) aq[ks] = *(const bf16x8_t*)(qp + 32 * ks); }
            const size_t kb = (((size_t)K.l * 8 + h) * 2 + p) * 128 * 128 + (size_t)r16 * 128 + 8 * g4;
#pragma unroll 2
            for (int nt = 0; nt < 8; ++nt) {
                bf16x8_t bh[4], bl[4];
#pragma unroll
                for (int ks = 0; ks < 4; ++ks) { bh[ks] = *(const bf16x8_t*)(K.SKH + kb + (size_t)(16 * nt) * 128 + 32 * ks); bl[ks] = *(const bf16x8_t*)(K.SKL + kb + (size_t)(16 * nt) * 128 + 32 * ks); }
                f32x4 c0 = {0.f, 0.f, 0.f, 0.f}, c1 = c0;
#pragma unroll
                for (int ks = 0; ks < 4; ++ks) { c0 = MFMA16(aq[ks], bh[ks], c0); c1 = MFMA16(aq[ks], bl[ks], c1); }
#pragma unroll
                for (int rg = 0; rg < 4; ++rg) SCR[(p * 16 + 4 * g4 + rg) * PS_SCS + 16 * nt + r16] = c0[rg] + c1[rg];
            }
        }
        asm volatile("s_waitcnt lgkmcnt(0)" ::: "memory");
        if (PROBE == 1) continue;
#pragma unroll 1
        for (int tk = 0; tk < 16; tk += 2) {
            float v[4][2]; unsigned kk[4][2], T4[4];
#pragma unroll
            for (int c = 0; c < 4; ++c) { const int p = c & 1, rr = c >> 1; v[c][0] = SCR[(p * 16 + tk + rr) * PS_SCS + K.lane]; v[c][1] = SCR[(p * 16 + tk + rr) * PS_SCS + 64 + K.lane]; kk[c][0] = fkey(v[c][0]); kk[c][1] = fkey(v[c][1]); }
            radix_thr16_multi<4, 2>(kk, T4);
#pragma unroll
            for (int c = 0; c < 4; ++c) { bool sel[2]; int pos[2]; select16<2>(kk[c], T4[c], sel, pos);
#pragma unroll
                for (int i = 0; i < 2; ++i) if (sel[i]) { TOPV[c * 16 + pos[i]] = v[c][i]; TOPI[c * 16 + pos[i]] = K.lane + 64 * i; } }
            asm volatile("s_waitcnt lgkmcnt(0)" ::: "memory");
            float cv[2][4]; int ce[2][4]; unsigned ck[2][4], T2[2];
#pragma unroll
            for (int rr = 0; rr < 2; ++rr) { const float vb = TOPV[(2 * rr + 1) * 16 + r16]; const int ib = TOPI[(2 * rr + 1) * 16 + r16];
#pragma unroll
                for (int i = 0; i < 4; ++i) { const int aidx = g4 + 4 * i; cv[rr][i] = TOPV[(2 * rr) * 16 + aidx] + vb; ce[rr][i] = TOPI[(2 * rr) * 16 + aidx] * 128 + ib; ck[rr][i] = fkey(cv[rr][i]); } }
            radix_thr16_multi<2, 4>(ck, T2);
#pragma unroll
            for (int rr = 0; rr < 2; ++rr) {
                const int r = t0 + tk + rr;
                bool sel[4]; int pos[4]; select16<4>(ck[rr], T2[rr], sel, pos);
                float mx = -3.0e38f;
#pragma unroll
                for (int i = 0; i < 4; ++i) mx = fmaxf(mx, sel[i] ? cv[rr][i] : -3.0e38f);
                mx = fmaxf(mx, dpp_<0xB1>(mx)); mx = fmaxf(mx, dpp_<0x4E>(mx)); mx = fmaxf(mx, dpp_<0x141>(mx)); mx = fmaxf(mx, dpp_<0x128>(mx));
                { auto s1 = __builtin_amdgcn_permlane16_swap(__float_as_uint(mx), __float_as_uint(mx), false, false); mx = fmaxf(__uint_as_float(s1[0]), __uint_as_float(s1[1]));
                  auto s2 = __builtin_amdgcn_permlane32_swap(__float_as_uint(mx), __float_as_uint(mx), false, false); mx = fmaxf(__uint_as_float(s2[0]), __uint_as_float(s2[1])); }
                float ex[4], es = 0.f;
#pragma unroll
                for (int i = 0; i < 4; ++i) { ex[i] = sel[i] ? __expf(cv[rr][i] - mx) : 0.f; es += ex[i]; }
                es = wave_sum_fast(es);
                const float inv = 1.0f / es;
#pragma unroll
                for (int i = 0; i < 4; ++i) if (sel[i]) { K.PIDX[(size_t)r * 128 + h * 16 + pos[i]] = ce[rr][i]; K.PG[(size_t)r * 128 + h * 16 + pos[i]] = ex[i] * inv; }
            }
            asm volatile("s_waitcnt lgkmcnt(0)" ::: "memory");
        }
    }
}

constexpr int PUL_H = 0, PUL_SLOT = 4096, PUL_STRIDE = 4352;
struct PuMeta { u32x4 h0[2], h1[2]; int ia[2], ib[2]; };
DI void pu_load(const Ctx& K, int r0, int step, PuMeta& m) {
#pragma unroll
    for (int q = 0; q < 2; ++q) { const int r = r0 + q * step;
        if (r < M) { m.h0[q] = *(const u32x4*)(K.H + (size_t)r * D + K.lane * 8); m.h1[q] = *(const u32x4*)(K.H + (size_t)r * D + 512 + K.lane * 8); m.ia[q] = K.PIDX[(size_t)r * 128 + K.lane]; m.ib[q] = K.PIDX[(size_t)r * 128 + 64 + K.lane]; }
        else { m.ia[q] = -1; m.ib[q] = -1; } }
}
typedef int i32x4 __attribute__((ext_vector_type(4)));
template <int PROBE> DI void pu_item(const Ctx& K, const unsigned char* U, unsigned char* HL, int* SLOT, int R, int r0, int step, const PuMeta& m, int r16, int g4, float& dummy) {
    float hs[2];
#pragma unroll
    for (int q = 0; q < 2; ++q) {
        float f[16]; unpack8(m.h0[q], &f[0]); unpack8(m.h1[q], &f[8]);
        float mx = 0.f;
#pragma unroll
        for (int i = 0; i < 16; ++i) mx = fmaxf(mx, fabsf(f[i]));
        mx = dpp_max16(mx);
        { auto s1 = __builtin_amdgcn_permlane16_swap(__float_as_uint(mx), __float_as_uint(mx), false, false); mx = fmaxf(__uint_as_float(s1[0]), __uint_as_float(s1[1]));
          auto s2 = __builtin_amdgcn_permlane32_swap(__float_as_uint(mx), __float_as_uint(mx), false, false); mx = fmaxf(__uint_as_float(s2[0]), __uint_as_float(s2[1])); }
        const float sc = fmaxf(mx, 1e-30f) * (1.0f / 127.0f), inv = 1.0f / sc; hs[q] = sc;
        unsigned w[4];
#pragma unroll
        for (int i = 0; i < 4; ++i) w[i] = ((unsigned)((int)rintf(f[4 * i] * inv)) & 0xffu) | (((unsigned)((int)rintf(f[4 * i + 1] * inv)) & 0xffu) << 8) | (((unsigned)((int)rintf(f[4 * i + 2] * inv)) & 0xffu) << 16) | (((unsigned)((int)rintf(f[4 * i + 3] * inv)) & 0xffu) << 24);
        *(u32x2*)(HL + PUL_H + q * 1024 + K.lane * 8) = (u32x2){w[0], w[1]}; *(u32x2*)(HL + PUL_H + q * 1024 + 512 + K.lane * 8) = (u32x2){w[2], w[3]};
    }
    bool sa[2], sb[2]; int ra[2], rb[2]; int n = 0;
#pragma unroll
    for (int q = 0; q < 2; ++q) { sa[q] = (m.ia[q] >> 10) == R; sb[q] = (m.ib[q] >> 10) == R; const unsigned long long ma = __ballot(sa[q]), mb = __ballot(sb[q]);
        ra[q] = n + mbcnt64(ma); n += __popcll(ma); rb[q] = n + mbcnt64(mb); n += __popcll(mb); }
#pragma unroll 1
    for (int base = 0; base < n; base += 16) {
#pragma unroll
        for (int q = 0; q < 2; ++q) {
            if (sa[q] && ra[q] >= base && ra[q] < base + 16) { SLOT[2 * (ra[q] - base)] = m.ia[q]; SLOT[2 * (ra[q] - base) + 1] = q * 128 + K.lane; }
            if (sb[q] && rb[q] >= base && rb[q] < base + 16) { SLOT[2 * (rb[q] - base)] = m.ib[q]; SLOT[2 * (rb[q] - base) + 1] = q * 128 + 64 + K.lane; } }
        asm volatile("s_waitcnt lgkmcnt(0)" ::: "memory");
        const bool valid = base + r16 < n; const int e = valid ? SLOT[2 * r16] : 0;
        const unsigned char* up = U + (size_t)e * D + 16 * g4;
        const unsigned char* hp = HL + PUL_H + (r16 >> 3) * 1024 + 16 * g4;
        i32x4 av[16];
#pragma unroll
        for (int s_ = 0; s_ < 16; ++s_) av[s_] = (valid && PROBE != 3) ? *(const i32x4*)(up + 64 * s_) : (i32x4){0, 0, 0, 0};
        i32x4 acc = {0, 0, 0, 0};
#pragma unroll
        for (int s_ = 0; s_ < 16; ++s_) { const i32x4 hb = *(const i32x4*)(hp + 64 * s_); acc = __builtin_amdgcn_mfma_i32_16x16x64_i8(av[s_], hb, acc, 0, 0, 0); }
        const int rg = r16 & 3; const int di = rg == 0 ? acc[0] : rg == 1 ? acc[1] : rg == 2 ? acc[2] : acc[3];
        const int sl = 4 * g4 + rg;
        if ((r16 & 7) < 4 && base + sl < n) { const int code = SLOT[2 * sl + 1];
            if ((code >> 7) == (r16 >> 3)) {
                const size_t eo = (size_t)K.l * 16384 + SLOT[2 * sl];
                const float d = (float)di * K.US[eo] * ((code >> 7) ? hs[1] : hs[0]);
                const float vsc = K.VS[eo];
                if (PROBE >= 2) dummy += gelu_erf(d);
                else (PROBE ? K.ST : K.PA)[(size_t)(r0 + (code >> 7) * step) * 128 + (code & 127)] = gelu_erf(d) * vsc; } }
        asm volatile("s_waitcnt lgkmcnt(0)" ::: "memory");
    }
}
template <int PROBE> DI void ph_peer_u(Ctx& K) {
    const unsigned char* U = (const unsigned char*)K.UB + (size_t)K.l * 16384 * D;
    unsigned char* HL = K.lds + K.wave * PUL_STRIDE; int* SLOT = (int*)(HL + PUL_SLOT);
    const int r16 = K.lane & 15, g4 = K.lane >> 4;
    const int step = K.nloc * NWAVES;
    constexpr int PD = 2;
    float dummy = 0.f;
    for (int R = K.xg; R < 16; R += K.nxg) {
        int r = K.jx * NWAVES + K.wave;
        PuMeta m[PD];
#pragma unroll
        for (int i = 0; i < PD; ++i) {
#pragma unroll
            for (int q = 0; q < 2; ++q) { m[i].h0[q] = (u32x4){0u, 0u, 0u, 0u}; m[i].h1[q] = m[i].h0[q]; }
            pu_load(K, r + 2 * i * step, step, m[i]); }
#pragma unroll 1
        for (; r < M; r += 2 * PD * step) {
#pragma unroll
            for (int i = 0; i < PD; ++i) {
                const int ri = r + 2 * i * step;
                if (ri < M) pu_item<PROBE>(K, U, HL, SLOT, R, ri, step, m[i], r16, g4, dummy);
                pu_load(K, ri + 2 * PD * step, step, m[i]);
            }
        }
    }
    if (PROBE >= 2) K.ST[K.gw * 64 + K.lane] = dummy;
}
struct PvMeta { int ia, ib; float ga, gb, pa, pb; f32x4 x[4]; };
template <int PROBE> DI void pv_load(const Ctx& K, int r, int c0, int slot, PvMeta& m) {
    if (r < M) { m.ia = K.PIDX[(size_t)r * 128 + K.lane]; m.ib = K.PIDX[(size_t)r * 128 + 64 + K.lane];
        m.ga = K.PG[(size_t)r * 128 + K.lane]; m.pa = K.PA[(size_t)r * 128 + K.lane]; m.gb = K.PG[(size_t)r * 128 + 64 + K.lane]; m.pb = K.PA[(size_t)r * 128 + 64 + K.lane];
        if (slot == 0) { const float* xr = (PROBE ? (const float*)K.P : K.X) + (size_t)r * D + c0;
#pragma unroll
            for (int q = 0; q < 4; ++q) m.x[q] = *(const f32x4*)(xr + 4 * q); } }
}
template <int PROBE> DI void pv_item(const Ctx& K, const unsigned char* V, int r, int c0, int slot, const float* gate, const PvMeta& m) {
    const float wa = m.ga * m.pa, wb = m.gb * m.pb;
    u32x4 vv[16]; float ww[16];
#pragma unroll
    for (int i = 0; i < 16; ++i) {
        const int src = (((8 * i + slot) & 63) << 2);
        const int e = __builtin_amdgcn_ds_bpermute(src, i < 8 ? m.ia : m.ib);
        ww[i] = __uint_as_float((unsigned)__builtin_amdgcn_ds_bpermute(src, (int)__float_as_uint(i < 8 ? wa : wb)));
        vv[i] = *(const u32x4*)(V + (size_t)e * 128);
    }
    float y[16], sw = 0.f;
#pragma unroll
    for (int i = 0; i < 16; ++i) y[i] = 0.f;
#pragma unroll
    for (int i = 0; i < 16; ++i) { sw += ww[i]; const unsigned w4[4] = {vv[i].x, vv[i].y, vv[i].z, vv[i].w};
#pragma unroll
        for (int q = 0; q < 4; ++q) { y[4 * q] += ww[i] * (float)(w4[q] & 0xffu); y[4 * q + 1] += ww[i] * (float)((w4[q] >> 8) & 0xffu); y[4 * q + 2] += ww[i] * (float)((w4[q] >> 16) & 0xffu); y[4 * q + 3] += ww[i] * (float)(w4[q] >> 24); } }
#pragma unroll
    for (int q = 0; q < 16; ++q) y[q] -= 128.f * sw;
#pragma unroll
    for (int q = 0; q < 16; ++q) { float v = y[q]; v += dpp_<0x128>(v);
        auto s1 = __builtin_amdgcn_permlane16_swap(__float_as_uint(v), __float_as_uint(v), false, false); v = __uint_as_float(s1[0]) + __uint_as_float(s1[1]);
        auto s2 = __builtin_amdgcn_permlane32_swap(__float_as_uint(v), __float_as_uint(v), false, false); y[q] = __uint_as_float(s2[0]) + __uint_as_float(s2[1]); }
    if (slot == 0) { float* xr = (PROBE ? (float*)K.P : K.X) + (size_t)r * D + c0; const float* gv = gate + (size_t)modvec_of_row(r) * 6 * D + c0;
#pragma unroll
        for (int q = 0; q < 4; ++q) { const f32x4 g = *(const f32x4*)(gv + 4 * q); f32x4 x = m.x[q];
            x.x += g.x * y[4 * q]; x.y += g.y * y[4 * q + 1]; x.z += g.z * y[4 * q + 2]; x.w += g.w * y[4 * q + 3]; *(f32x4*)(xr + 4 * q) = x; } }
}
template <int PROBE> DI void ph_peer_v(Ctx& K) {
    const int slot = K.lane >> 3, c = K.lane & 7;
    const float* gate = K.MOD + (size_t)K.l * 3 * 6 * D + 5 * D;
    const int step = K.nloc * NWAVES;
    constexpr int PD = 3;
    for (int S = K.xg; S < 8; S += K.nxg) {
        const unsigned char* V = (const unsigned char*)K.VB + ((size_t)K.l * 8 + S) * 16384 * 128 + c * 16;
        const int c0 = S * 128 + c * 16;
        int r = K.jx * NWAVES + K.wave;
        PvMeta m[PD];
#pragma unroll
        for (int i = 0; i < PD; ++i) { m[i].ia = 0; m[i].ib = 0; m[i].ga = m[i].gb = m[i].pa = m[i].pb = 0.f;
#pragma unroll
            for (int q = 0; q < 4; ++q) m[i].x[q] = (f32x4){0.f, 0.f, 0.f, 0.f};
            pv_load<PROBE>(K, r + i * step, c0, slot, m[i]); }
#pragma unroll 1
        for (; r < M; r += PD * step) {
#pragma unroll
            for (int i = 0; i < PD; ++i) {
                const int ri = r + i * step;
                if (ri < M) pv_item<PROBE>(K, V, ri, c0, slot, gate, m[i]);
                pv_load<PROBE>(K, ri + PD * step, c0, slot, m[i]);
            }
        }
    }
}

DI void ph_final(Ctx& K) {
    for (int r = K.gw; r < NLAT; r += K.ngw) {
        const f32x4* xr = (const f32x4*)(K.X + (size_t)(NCTX + r) * D); f32x4* o = (f32x4*)(((float*)argp_<float>(K, (unsigned)__builtin_offsetof(Args, out))) + (size_t)r * D);
        f32x4 v[4]; float ss = 0.f;
#pragma unroll
        for (int j = 0; j < 4; ++j) { v[j] = xr[j * 64 + K.lane]; ss += v[j].x * v[j].x + v[j].y * v[j].y + v[j].z * v[j].z + v[j].w * v[j].w; }
        ss = wave_sum(ss); const float rs = rsqrtf(ss * (1.0f / D) + EPS);
#pragma unroll
        for (int j = 0; j < 4; ++j) { const f32x4 w = ((const f32x4*)ARG(final_norm_w))[j * 64 + K.lane]; o[j * 64 + K.lane] = v[j] * rs * w; }
    }
}

#define XB_TMO      128
#define XB_XSUB(j)  (1280 + 64 * (j))
#define XB_XGEN(j)  (2304 + 64 * (j))
#define XB_TOP      3328
#define XB_TOPGEN   3392
#define XB_SPIN_CAP (1u << 22)
constexpr int CW_BAR = 4096;
DI unsigned xb_ld(unsigned* p)              { return __hip_atomic_load(p, __ATOMIC_RELAXED, __HIP_MEMORY_SCOPE_AGENT); }
DI unsigned xb_add(unsigned* p, unsigned v) { return __hip_atomic_fetch_add(p, v, __ATOMIC_RELAXED, __HIP_MEMORY_SCOPE_AGENT); }
#define XB_SPIN(cond, bar) do { unsigned _sp = 0; while (cond) { __builtin_amdgcn_s_sleep(1); \
    if ((++_sp & 255u) == 0u) { if (xb_ld(&(bar)[XB_TMO])) break; if (_sp > XB_SPIN_CAP) { atomicAdd(&(bar)[XB_TMO], 1u); break; } } } } while (0)
DI void xcd_barrier(unsigned* bar, unsigned x, unsigned nloc, unsigned nx) {
    asm volatile("s_waitcnt vmcnt(0)" ::: "memory");
    __syncthreads();
    if (threadIdx.x == 0) {
        __builtin_amdgcn_s_waitcnt(0);
        const unsigned old = xb_add(&bar[XB_XSUB(x)], 1u);
        const unsigned gen = old / nloc;
        if (old + 1u == (gen + 1u) * nloc) {
            __builtin_amdgcn_fence(__ATOMIC_RELEASE, "agent");
            asm volatile("s_waitcnt vmcnt(0)" ::: "memory");
            const unsigned og = xb_add(&bar[XB_TOP], 1u);
            const unsigned tg = og / nx;
            if (og + 1u == (tg + 1u) * nx) xb_add(&bar[XB_TOPGEN], 1u);
            else XB_SPIN(xb_ld(&bar[XB_TOPGEN]) == tg, bar);
            __builtin_amdgcn_fence(__ATOMIC_ACQUIRE, "agent");
            xb_add(&bar[XB_XGEN(x)], 1u);
            asm volatile("s_waitcnt vmcnt(0)" ::: "memory");
        } else {
            XB_SPIN(xb_ld(&bar[XB_XGEN(x)]) == gen, bar);
            __builtin_amdgcn_fence(__ATOMIC_ACQUIRE, "agent");
            asm volatile("s_waitcnt vmcnt(0)" ::: "memory");
        }
    }
    __syncthreads();
}

constexpr int PROBE_U = 0, PROBE_V = 0, PROBE_S = 0;
constexpr unsigned DUP_MASK = 0u;
constexpr int PH_PER_LAYER = 13, N_PHASES = 2 + PH_PER_LAYER * DEPTH;
__global__ void __launch_bounds__(NTHREADS) mk_fwd(Args args) {
    extern __shared__ __attribute__((aligned(16))) unsigned char lds[];
    cg::grid_group grid = cg::this_grid();
    constexpr unsigned ARGS_OFF = LDS_BYTES - 256;
    constexpr unsigned MISC_OFF = LDS_BYTES - 64;
    if (threadIdx.x == 0) {
        *(Args*)(lds + ARGS_OFF) = args;
        unsigned* ctl = (unsigned*)(args.ws + WS_CTL); unsigned* misc = (unsigned*)(lds + MISC_OFF);
        const unsigned xcc = (unsigned)__builtin_amdgcn_s_getreg((3 << 11) | 20) & 0xFu;
        misc[0] = xcc; misc[1] = __hip_atomic_fetch_add(ctl + 64 * xcc, 1u, __ATOMIC_RELAXED, __HIP_MEMORY_SCOPE_AGENT);
    }
    __syncthreads();
    int rep = 0;
#pragma unroll 1
    for (int ph = 0; ph < N_PHASES; ++ph) {
        int tid = threadIdx.x; asm volatile("" : "+v"(tid));
        unsigned aoff = ARGS_OFF; asm volatile("" : "+v"(aoff));
        unsigned char* ws = args.ws; asm volatile("" : "+s"(ws));
        int bid = blockIdx.x; asm volatile("" : "+s"(bid)); int nb = gridDim.x; asm volatile("" : "+s"(nb));
        unsigned moff = MISC_OFF; asm volatile("" : "+v"(moff));
        Ctx K; { const unsigned* misc = (const unsigned*)(lds + moff); K.jx = __builtin_amdgcn_readfirstlane(misc[1]); K.xg = __builtin_amdgcn_readfirstlane(misc[2]); K.nxg = __builtin_amdgcn_readfirstlane(misc[3]); K.nloc = __builtin_amdgcn_readfirstlane(misc[4]); }
        K.aoff = aoff; K.lds = lds; K.tid = tid; K.lane = tid & 63; K.wave = tid >> 6; K.bid = bid; K.nb = nb; K.gw = bid * NWAVES + K.wave; K.ngw = nb * NWAVES;
        K.X = (float*)(ws + WS_X); K.H = (bf16_t*)(ws + WS_H); K.P = (bf16_t*)(ws + WS_P); K.QP = K.P; K.MIX = (bf16_t*)(ws + WS_MIX); K.OF = (float*)(ws + WS_OF); K.OB = (float*)(ws + WS_OB);
        K.PIDX = (int*)(ws + WS_PIDX); K.PG = (float*)(ws + WS_PG); K.MOD = (float*)(ws + WS_MOD); K.LB = (float*)(ws + WS_LB); K.ROPE = (float*)(ws + WS_ROPE); K.WIN = (bf16_t*)(ws + WS_WIN); K.WOUT = (bf16_t*)(ws + WS_WOUT); K.WQ = (bf16_t*)(ws + WS_WQ); K.UB = (bf16_t*)(ws + WS_UB); K.ST = (float*)(ws + WS_OF); K.AC = (float*)(ws + WS_AC); K.PA = (float*)(ws + WS_PA); K.VS = (float*)(ws + WS_VS); K.US = (float*)(ws + WS_US); K.SKH = (bf16_t*)(ws + WS_SKH); K.SKL = (bf16_t*)(ws + WS_SKL); K.VB = (bf16_t*)(ws + WS_VB);
        const int l = ph == 0 ? 0 : (ph - 1) / PH_PER_LAYER, k = ph == 0 ? -1 : (ph == N_PHASES - 1 ? -2 : (ph - 1) % PH_PER_LAYER);
        K.l = l;
        if (k == -1) ph_prologue(K);
        else if (k == -2) ph_final(K);
        else if (k == 0) ph_norm(K, ARG(norm_mix_w) + (size_t)l * D, 0);
        else if (k == 1) ph_gemm_store(K, K.H, K.WIN + (size_t)l * PW * D, PW, K.P);
        else if (k == 2) ph_rope(K);
        else if (k == 3) ph_hgrn_A(K);
        else if (k == 4) ph_attn(K);
        else if (k == 5) ph_hgrn_B(K);
        else if (k == 6) ph_hgrn_C(K);
        else if (k == 7) ph_gemm_resid(K, K.MIX, K.WOUT + (size_t)l * D * D, 2);
        else if (k == 8) ph_norm(K, ARG(norm_ffn_w) + (size_t)l * D, 3);
        else if (k == 9) ph_gemm_store(K, K.H, K.WQ + (size_t)l * 2048 * D, 2048, K.QP);
        else if (k == 10) { ph_peer_select<0>(K); if (PROBE_S) ph_peer_select<PROBE_S>(K); }
        else if (k == 11) { ph_peer_u<0>(K); if (PROBE_U) ph_peer_u<PROBE_U>(K); }
        else if (k == 12) { ph_peer_v<0>(K); if (PROBE_V) ph_peer_v<1>(K); }
        if (k >= 0 && ((DUP_MASK >> k) & 1u)) { ++rep; if (rep < 2) { --ph; continue; } } rep = 0;
        if (ph == 0) grid.sync();
        else if (k != 3 && ph != N_PHASES - 1) { const unsigned* misc = (const unsigned*)(lds + moff); xcd_barrier((unsigned*)(args.ws + WS_CTL) + CW_BAR, misc[0], misc[4], misc[3]); }
        if (ph == 0) {
            if (threadIdx.x == 0) { unsigned* ctl = (unsigned*)(args.ws + WS_CTL); unsigned* misc = (unsigned*)(lds + MISC_OFF); const unsigned xcc = misc[0]; unsigned ord = 0, npop = 0, mine = 1;
                for (unsigned q = 0; q < 16; ++q) { const unsigned cq = __hip_atomic_load(ctl + 64 * q, __ATOMIC_RELAXED, __HIP_MEMORY_SCOPE_AGENT); if (cq) { ++npop; if (q < xcc) ++ord; } if (q == xcc) mine = cq; }
                misc[2] = ord; misc[3] = npop ? npop : 1u; misc[4] = mine ? mine : 1u; }
            __syncthreads();
        }
    }
}

extern "C" void kernel_launch(void* const* d_in, const int* in_sizes, int n_in, void* d_out, int out_size, void* d_ws, size_t ws_size, hipStream_t stream) {
    static int grid = 0;
    if (grid == 0) {
        if (n_in != 19 || out_size != NLAT * D || ws_size < WS_END) { fprintf(stderr, "kernel_launch: unexpected shapes (n_in %d out %d ws %zu need %zu)\n", n_in, out_size, ws_size, (size_t)WS_END); grid = -1; return; }
        int dev = 0, cus = 0, per_cu = 0;
        (void)hipGetDevice(&dev); (void)hipDeviceGetAttribute(&cus, hipDeviceAttributeMultiprocessorCount, dev);
        (void)hipFuncSetAttribute((const void*)mk_fwd, hipFuncAttributeMaxDynamicSharedMemorySize, LDS_BYTES);
        (void)hipOccupancyMaxActiveBlocksPerMultiprocessor(&per_cu, (const void*)mk_fwd, NTHREADS, LDS_BYTES);
        if (per_cu < 1) { fprintf(stderr, "kernel_launch: occupancy query says %d blocks/CU\n", per_cu); grid = -1; return; }
        grid = (cus / 8) * 8;
    }
    if (grid < 0) return;
    Args a{};
    a.x = (const float*)d_in[0]; a.c = (const float*)d_in[1]; a.ctx = (const float*)d_in[2]; a.c_ctx = (const float*)d_in[3]; a.w_mod = (const float*)d_in[4]; a.b_mod = (const float*)d_in[5];
    a.norm_mix_w = (const float*)d_in[6]; a.norm_ffn_w = (const float*)d_in[7]; a.w_in = (const float*)d_in[8]; a.lb_logits = (const float*)d_in[9]; a.hgrn_norm_w = (const float*)d_in[10];
    a.swa_sink = (const float*)d_in[11]; a.nat_rpb = (const float*)d_in[12]; a.w_out = (const float*)d_in[13]; a.peer_wq = (const float*)d_in[14]; a.peer_sk = (const float*)d_in[15];
    a.peer_u = (const float*)d_in[16]; a.peer_v = (const float*)d_in[17]; a.final_norm_w = (const float*)d_in[18];
    a.out = (float*)d_out; a.ws = (unsigned char*)d_ws;
    (void)hipMemsetAsync((unsigned char*)d_ws + WS_CTL, 0, CTL_BYTES, stream);
    void* kargs[] = {&a};
    hipError_t e = hipLaunchCooperativeKernel((const void*)mk_fwd, dim3(grid), dim3(NTHREADS), kargs, LDS_BYTES, stream);
    if (e != hipSuccess) fprintf(stderr, "kernel_launch: cooperative launch failed: %s (grid %d)\n", hipGetErrorString(e), grid);
}
```

```cpp
#include <hip/hip_runtime.h>
#include <hip/hip_cooperative_groups.h>
#include <cstdio>
#include <cstdint>
namespace cg = cooperative_groups;
#define DI __device__ __forceinline__
#define GP(T, p) ((T*)(__attribute__((address_space(1))) T*)(p))

typedef unsigned short bf16_t;
typedef float f32x4 __attribute__((ext_vector_type(4)));
typedef unsigned u32x4 __attribute__((ext_vector_type(4)));
typedef unsigned u32x2 __attribute__((ext_vector_type(2)));

constexpr int D = 1024, NB = 2, L = 16384, CL = 256, DEPTH = 4;
constexpr int NCTX = NB * CL, NLAT = NB * L, M = NCTX + NLAT;
constexpr int PW = 3072;
constexpr int C_HQ = 0, C_ZF = 256, C_ZB = 512, C_HV = 768, C_HG = 1024, C_SQ = 1280, C_SK = 1664, C_SV = 1792, C_NQ = 1920, C_NK = 2304, C_NV = 2688;
constexpr int MX_H = 0, MX_S = 256, MX_N = 640;
constexpr float EPS = 1e-6f;
constexpr int NTHREADS = 512, NWAVES = 8;
constexpr int LDS_BYTES = 147456;

constexpr size_t al256(size_t x) { return (x + 255) & ~(size_t)255; }
constexpr size_t WS_X = 0;
constexpr size_t WS_H = WS_X + al256((size_t)M * D * 4);
constexpr size_t WS_P = WS_H + al256((size_t)M * D * 2);
constexpr size_t WS_MIX = WS_P + al256((size_t)M * PW * 2);
constexpr size_t WS_OF = WS_MIX + al256((size_t)M * D * 2);
constexpr size_t WS_OB = WS_OF + al256((size_t)M * 256 * 4);
constexpr size_t WS_PIDX = WS_OB + al256((size_t)M * 256 * 4);
constexpr size_t WS_PG = WS_PIDX + al256((size_t)M * 128 * 4);
constexpr size_t WS_MOD = WS_PG + al256((size_t)M * 128 * 4);
constexpr size_t WS_LB = WS_MOD + al256((size_t)DEPTH * 3 * 6 * D * 4);
constexpr size_t WS_ROPE = WS_LB + al256((size_t)2 * DEPTH * 256 * 4);
constexpr size_t WS_WIN = WS_ROPE + al256((size_t)(256 + 256 + 64 + 64) * 16 * 4);
constexpr size_t WS_WOUT = WS_WIN + al256((size_t)DEPTH * PW * D * 2);
constexpr size_t WS_WQ = WS_WOUT + al256((size_t)DEPTH * D * D * 2);
constexpr size_t WS_AC = WS_WQ + al256((size_t)DEPTH * 2048 * D * 2);
constexpr size_t WS_UB_ = 0; constexpr size_t WS_UB = WS_AC + al256((size_t)16 * 260 * 64 * 4); constexpr size_t WS_UB_OLD = WS_WQ + al256((size_t)DEPTH * 2048 * D * 2);
constexpr size_t WS_VB = WS_UB + al256((size_t)DEPTH * 16384 * D * 2);
constexpr size_t WS_PA = WS_VB + al256((size_t)DEPTH * 16384 * D * 2);
constexpr size_t WS_VS = WS_PA + al256((size_t)M * 128 * 4);
constexpr size_t WS_US = WS_VS + al256((size_t)DEPTH * 16384 * 4);
constexpr size_t WS_SKH = WS_US + al256((size_t)DEPTH * 16384 * 4);
constexpr size_t WS_SKL = WS_SKH + al256((size_t)DEPTH * 8 * 2 * 128 * 128 * 2);
constexpr size_t WS_CTL = WS_SKL + al256((size_t)DEPTH * 8 * 2 * 128 * 128 * 2);
constexpr size_t CTL_BYTES = 65536;
constexpr size_t WS_END = WS_CTL + CTL_BYTES;

struct Args {
    const float *x, *c, *ctx, *c_ctx, *w_mod, *b_mod, *norm_mix_w, *norm_ffn_w, *w_in, *lb_logits, *hgrn_norm_w, *swa_sink, *nat_rpb, *w_out, *peer_wq, *peer_sk, *peer_u, *peer_v, *final_norm_w;
    float* out; unsigned char* ws;
};

DI float bf2f(bf16_t v) { return __uint_as_float((unsigned)v << 16); }
DI bf16_t f2bf(float f) { unsigned u = __float_as_uint(f); return (bf16_t)((u + 0x7fffu + ((u >> 16) & 1u)) >> 16); }
DI unsigned pk2(float lo, float hi) { return (unsigned)f2bf(lo) | ((unsigned)f2bf(hi) << 16); }
DI float wave_sum(float v) {
#pragma unroll
    for (int o = 1; o < 64; o <<= 1) v += __shfl_xor(v, o);
    return v;
}
typedef __bf16 bf16x2_t __attribute__((ext_vector_type(2)));
DI float dot2bf(unsigned a, unsigned b, float acc) { return __builtin_amdgcn_fdot2_f32_bf16(__builtin_bit_cast(bf16x2_t, a), __builtin_bit_cast(bf16x2_t, b), acc, false); }
template <int CTRL> DI float dpp_(float x) { return __builtin_bit_cast(float, __builtin_amdgcn_mov_dpp(__builtin_bit_cast(int, x), CTRL, 0xf, 0xf, true)); }
DI float wave_sum_fast(float x) {
    x += dpp_<0xB1>(x); x += dpp_<0x4E>(x); x += dpp_<0x141>(x); x += dpp_<0x128>(x);
    auto s1 = __builtin_amdgcn_permlane16_swap(__float_as_uint(x), __float_as_uint(x), false, false); x = __uint_as_float(s1[0]) + __uint_as_float(s1[1]);
    auto s2 = __builtin_amdgcn_permlane32_swap(__float_as_uint(x), __float_as_uint(x), false, false); return __uint_as_float(s2[0]) + __uint_as_float(s2[1]);
}
DI float sigmoidf_(float z) { return 1.0f / (1.0f + __expf(-z)); }
DI float gelu_erf(float v) { return 0.5f * v * (1.0f + erff(v * 0.70710678118654752f)); }
DI int modvec_of_row(int r) { return r < NCTX ? 2 : (r - NCTX) / L; }
DI int batch_of_row(int r) { return r < NCTX ? r / CL : (r - NCTX) / L; }
DI int lat_row(int b, int t) { return NCTX + b * L + t; }
DI int ctx_row(int b, int s) { return b * CL + s; }
DI void unpack8(const u32x4 w, float* o) {
    o[0] = __uint_as_float(w.x << 16); o[1] = __uint_as_float(w.x & 0xffff0000u);
    o[2] = __uint_as_float(w.y << 16); o[3] = __uint_as_float(w.y & 0xffff0000u);
    o[4] = __uint_as_float(w.z << 16); o[5] = __uint_as_float(w.z & 0xffff0000u);
    o[6] = __uint_as_float(w.w << 16); o[7] = __uint_as_float(w.w & 0xffff0000u);
}
DI void load_row64(const bf16_t* p, float (&o)[64]) {
#pragma unroll
    for (int i = 0; i < 8; ++i) { const u32x4 w = *(const u32x4*)(p + 8 * i); unpack8(w, &o[8 * i]); }
}
DI void rope64(float (&x)[64], const float* cr, const float* sr, const float* cc, const float* sc) {
#pragma unroll
    for (int i = 0; i < 16; ++i) {
        const float c1 = cr[i], s1 = sr[i], a = x[i], b = x[16 + i];
        x[i] = a * c1 - b * s1; x[16 + i] = b * c1 + a * s1;
        const float c2 = cc[i], s2 = sc[i], e = x[32 + i], f = x[48 + i];
        x[32 + i] = e * c2 - f * s2; x[48 + i] = f * c2 + e * s2;
    }
}

namespace pg8 {
#define PG8_LAS __attribute__((address_space(3)))
typedef unsigned short bf16_t;
typedef short bf16x8 __attribute__((ext_vector_type(8)));
typedef float f32x4 __attribute__((ext_vector_type(4)));
typedef unsigned u32x4 __attribute__((ext_vector_type(4)));
constexpr int BM = 256, BK = 64, HALF = 128, HTB = HALF * BK * 2  , STAGE_BYTES = 8 * HTB, NXCD = 8, WGM = 8;

__host__ __device__ __forceinline__ int lds_byte(int r, int c) { const int st = (r >> 4) * 2 + (c >> 5), rr = r & 15, cc = c & 31, ob = rr * 64 + cc * 2; return st * 1024 + (ob ^ (((ob >> 9) & 1) << 5)); }
__host__ __device__ __forceinline__ void stage_rc(int b, int& R, int& C) { const int st = b / 1024, sb = b % 1024, swz = sb ^ (((sb >> 9) & 1) << 5); R = (st >> 1) * 16 + swz / 64; C = (st & 1) * 32 + (swz % 64) / 2; }
__host__ __device__ __forceinline__ int perm32(int rho) { const int n = rho >> 4, i = rho & 15; return 8 * (i >> 2) + 4 * n + (i & 3); }

struct Unit { int pm, pn; };
struct Gemm { const bf16_t* A; const bf16_t* Bt; int M, N, K; };

struct StaticOrder {
    int nM, nN, nwg, G, c;
    __host__ __device__ void init(int M, int N, int G_, int c_) { nM = M / BM; nN = N / BM; nwg = nM * nN; G = G_; c = c_; }
    __host__ __device__ bool next(int i, Unit& u) const {
        const long L = (long)i * G + c; if (L >= nwg) return false;
        int wgid = (int)L; { const int q = nwg / NXCD, r = nwg % NXCD, xcd = wgid % NXCD, off = wgid / NXCD; wgid = (xcd < r ? xcd * (q + 1) : r * (q + 1) + (xcd - r) * q) + off; }
        const int nig = WGM * nN, gid = wgid / nig, fm = gid * WGM, gsz = (nM - fm) < WGM ? (nM - fm) : WGM;
        u.pm = fm + ((wgid % nig) % gsz); u.pn = (wgid % nig) / gsz; return true;
    }
    __device__ __forceinline__ void a_ready(const Unit&) const {}
    __device__ __forceinline__ void done(const Unit&) const {}
};


__device__ __forceinline__ unsigned cvt_pk_bf16(float lo, float hi) { unsigned r; asm volatile("v_cvt_pk_bf16_f32 %0, %1, %2" : "=v"(r) : "v"(lo), "v"(hi)); return r; }
struct EpiStore {
    static constexpr bool PERM = true, AFTER_DRAIN = false;
    bf16_t* O; int ldc;
    __device__ __forceinline__ void operator()(const f32x4 (&acc)[2][2][4][2], const Unit& u, int wr, int wc, int fr, int fq) const {
        const int row0 = u.pm * BM + wr * 64 + fr, col0 = u.pn * BM + wc * 32 + 8 * fq;
#pragma unroll
        for (int ai = 0; ai < 2; ++ai)
#pragma unroll
            for (int m = 0; m < 4; ++m) { bf16_t* rowp = O + (size_t)(row0 + ai * HALF + m * 16) * ldc + col0;
#pragma unroll
                for (int bj = 0; bj < 2; ++bj) { const f32x4 v0 = acc[ai][bj][m][0], v1 = acc[ai][bj][m][1];
                    u32x4 w; w.x = cvt_pk_bf16(v0[0], v0[1]); w.y = cvt_pk_bf16(v0[2], v0[3]); w.z = cvt_pk_bf16(v1[0], v1[1]); w.w = cvt_pk_bf16(v1[2], v1[3]);
                    *(u32x4*)(rowp + bj * HALF) = w; } }
    }
};
struct EpiResid {
    static constexpr bool PERM = false, AFTER_DRAIN = false;
    float* X; int ldc; const float* gate; int gstride, nctx, seqlen;
    __device__ __forceinline__ void operator()(const f32x4 (&acc)[2][2][4][2], const Unit& u, int wr, int wc, int fr, int fq) const {
        const int col0 = u.pn * BM + wc * 32 + 4 * fq;
#pragma unroll
        for (int ai = 0; ai < 2; ++ai)
#pragma unroll
            for (int m = 0; m < 4; ++m) { const int r = u.pm * BM + ai * HALF + wr * 64 + m * 16 + fr; const int vsel = r < nctx ? 2 : (r - nctx) / seqlen;
                float* xr = X + (size_t)r * ldc + col0; const float* gr = gate + (size_t)vsel * gstride + col0;
#pragma unroll
                for (int bj = 0; bj < 2; ++bj)
#pragma unroll
                    for (int n = 0; n < 2; ++n) { const f32x4 g = *(const f32x4*)(gr + bj * HALF + n * 16); f32x4 x = *(const f32x4*)(xr + bj * HALF + n * 16); x += g * acc[ai][bj][m][n]; *(f32x4*)(xr + bj * HALF + n * 16) = x; } }
    }
};
template <class Epi, class Sched, bool ALIGN_EPI = false, bool SP2 = false>
__device__ __forceinline__ void gemm_phase(PG8_LAS unsigned char* lds, const Gemm g, const Sched& S, const Epi& E) {
    int tid_ = threadIdx.x; asm volatile("" : "+v"(tid_));
    const int tid = tid_, wid = __builtin_amdgcn_readfirstlane(tid >> 6), lane = tid & 63, wr = wid >> 2, wc = wid & 3, fr = lane & 15, fq = lane >> 4;
    const int K = g.K, nt = K / BK;
    unsigned voffA[2], voffB[2];
#pragma unroll
    for (int i = 0; i < 2; ++i) { int R, C; stage_rc(tid * 16 + i * 8192, R, C); const int Rb = Epi::PERM ? ((R & ~31) + perm32(R & 31)) : R;
        voffA[i] = (unsigned)(R * K + C) * 2u; voffB[i] = (unsigned)(Rb * K + C) * 2u; }
    const size_t kstep = (size_t)(BK * 2);
    const size_t hstep = (size_t)HALF * K * 2;
    const size_t tstep = 2 * hstep;
    const unsigned ldsw = (unsigned)wid * 1024u;
    const int aoff = lds_byte(wr * 64 + fr, fq * 8), boff = lds_byte(wc * 32 + fr, fq * 8);
#define PG8_SA(b, h) (((b) * 2 + (h)) * HTB)
#define PG8_SB(b, h) ((4 + (b) * 2 + (h)) * HTB)
#define PG8_STAGE(bufoff, gbase, voff) do { _Pragma("unroll") for (int _i = 0; _i < 2; ++_i) \
        __builtin_amdgcn_global_load_lds((const unsigned*)((const char*)(gbase) + (voff)[_i]), (PG8_LAS unsigned*)(lds + (bufoff) + ldsw + _i * 8192), 16, 0, 0); } while (0)
#define PG8_LDA(dst, b, h) do { _Pragma("unroll") for (int m = 0; m < 4; ++m) _Pragma("unroll") for (int k = 0; k < 2; ++k) dst[m][k] = *(const PG8_LAS bf16x8*)(lds + PG8_SA(b, h) + aoff + m * 2048 + k * 1024); } while (0)
#define PG8_LDB(dst, b, h) do { _Pragma("unroll") for (int n = 0; n < 2; ++n) _Pragma("unroll") for (int k = 0; k < 2; ++k) dst[n][k] = *(const PG8_LAS bf16x8*)(lds + PG8_SB(b, h) + boff + n * 2048 + k * 1024); } while (0)
#define PG8_MMA(ai, bj, At, Bt) do { __builtin_amdgcn_s_setprio(1); _Pragma("unroll") for (int m = 0; m < 4; ++m) _Pragma("unroll") for (int n = 0; n < 2; ++n) _Pragma("unroll") for (int k = 0; k < 2; ++k) \
        acc[ai][bj][m][n] = __builtin_amdgcn_mfma_f32_16x16x32_bf16(Bt[n][k], At[m][k], acc[ai][bj][m][n], 0, 0, 0); __builtin_amdgcn_s_setprio(0); } while (0)
#define PG8_WAIT_V(n) asm volatile("s_waitcnt vmcnt(" #n ")" ::: "memory")
#define PG8_WAIT_L(n) asm volatile("s_waitcnt lgkmcnt(" #n ")" ::: "memory")
#define PG8_BAR __builtin_amdgcn_s_barrier()
#define PG8_SCHED __builtin_amdgcn_sched_barrier(0)
    Unit cur, nxt; int ui = 0;
    if (!S.next(0, cur)) return;
    f32x4 acc[2][2][4][2];
#pragma unroll
    for (int a = 0; a < 2; ++a)
#pragma unroll
        for (int b = 0; b < 2; ++b)
#pragma unroll
            for (int m = 0; m < 4; ++m)
#pragma unroll
                for (int n = 0; n < 2; ++n) acc[a][b][m][n] = (f32x4){0.f, 0.f, 0.f, 0.f};
    bf16x8 At[4][2], B0[2][2], B1[2][2];
    const char* cA = (const char*)g.A + (size_t)cur.pm * tstep; const char* cB = (const char*)g.Bt + (size_t)cur.pn * tstep;
    S.a_ready(cur);
    if constexpr (SP2) {
        PG8_STAGE(PG8_SB(0, 0), cB, voffB); PG8_STAGE(PG8_SB(0, 1), cB + hstep, voffB); PG8_STAGE(PG8_SA(0, 0), cA, voffA); PG8_STAGE(PG8_SA(0, 1), cA + hstep, voffA);
        if (wr == 1) PG8_BAR;
        PG8_WAIT_V(2); PG8_BAR;
        PG8_STAGE(PG8_SB(1, 0), cB + kstep, voffB); PG8_STAGE(PG8_SA(1, 0), cA + kstep, voffA); PG8_STAGE(PG8_SB(1, 1), cB + hstep + kstep, voffB);
        PG8_WAIT_V(6); PG8_BAR;
    } else {
        PG8_STAGE(PG8_SB(0, 0), cB, voffB); PG8_STAGE(PG8_SA(0, 0), cA, voffA); PG8_STAGE(PG8_SB(0, 1), cB + hstep, voffB); PG8_STAGE(PG8_SA(0, 1), cA + hstep, voffA);
        if (wr == 1) PG8_BAR;
        PG8_WAIT_V(4); PG8_BAR;
        PG8_STAGE(PG8_SB(1, 0), cB + kstep, voffB); PG8_STAGE(PG8_SA(1, 0), cA + kstep, voffA); PG8_STAGE(PG8_SB(1, 1), cB + hstep + kstep, voffB);
        PG8_WAIT_V(6); PG8_BAR;
    }
    for (;;) {
        const bool has_next = S.next(ui + 1, nxt);
        const char* nA = has_next ? (const char*)g.A + (size_t)nxt.pm * tstep : cA; const char* nB = has_next ? (const char*)g.Bt + (size_t)nxt.pn * tstep : cB;
        for (int t = 0; t < nt; t += 2) {
            const bool last = (t == nt - 2);
            const char* a1 = cA + (size_t)(t + 1) * kstep;
            const char* a2 = last ? nA : cA + (size_t)(t + 2) * kstep; const char* b2 = last ? nB : cB + (size_t)(t + 2) * kstep;
            const char* a3 = a2 + kstep; const char* b3 = b2 + kstep;
            if (last && has_next) S.a_ready(nxt);
            if constexpr (SP2) {
            PG8_LDB(B0, 0, 0); PG8_LDB(B1, 0, 1); PG8_SCHED; PG8_LDA(At, 0, 0); PG8_STAGE(PG8_SA(1, 1), a1 + hstep, voffA);
            PG8_WAIT_V(8); PG8_WAIT_L(0); PG8_BAR; PG8_MMA(0, 0, At, B0); PG8_MMA(0, 1, At, B1); PG8_BAR; PG8_SCHED;
            PG8_LDA(At, 0, 1); PG8_STAGE(PG8_SB(0, 0), b2, voffB); PG8_STAGE(PG8_SB(0, 1), b2 + hstep, voffB); PG8_STAGE(PG8_SA(0, 0), a2, voffA);
            PG8_WAIT_V(8); PG8_WAIT_L(0); PG8_BAR; PG8_MMA(1, 0, At, B0); PG8_MMA(1, 1, At, B1); PG8_BAR; PG8_SCHED;
            PG8_LDB(B0, 1, 0); PG8_LDB(B1, 1, 1); PG8_SCHED; PG8_LDA(At, 1, 0); PG8_STAGE(PG8_SA(0, 1), a2 + hstep, voffA);
            PG8_WAIT_V(8); PG8_WAIT_L(0); PG8_BAR; PG8_MMA(0, 0, At, B0); PG8_MMA(0, 1, At, B1); PG8_BAR; PG8_SCHED;
            PG8_LDA(At, 1, 1); PG8_STAGE(PG8_SB(1, 0), b3, voffB); PG8_STAGE(PG8_SB(1, 1), b3 + hstep, voffB); PG8_STAGE(PG8_SA(1, 0), a3, voffA);
            PG8_WAIT_V(8); PG8_WAIT_L(0); PG8_BAR; PG8_MMA(1, 0, At, B0); PG8_MMA(1, 1, At, B1); PG8_BAR; PG8_SCHED;
            } else {
            PG8_LDB(B0, 0, 0); PG8_SCHED; PG8_LDA(At, 0, 0); PG8_STAGE(PG8_SA(1, 1), a1 + hstep, voffA);
            PG8_WAIT_L(8); PG8_BAR; PG8_WAIT_L(0); PG8_MMA(0, 0, At, B0); PG8_BAR; PG8_SCHED;
            PG8_LDB(B1, 0, 1); PG8_STAGE(PG8_SB(0, 0), b2, voffB);
            PG8_BAR; PG8_WAIT_L(0); PG8_MMA(0, 1, At, B1); PG8_BAR;
            PG8_LDA(At, 0, 1); PG8_STAGE(PG8_SA(0, 0), a2, voffA);
            PG8_BAR; PG8_WAIT_L(0); PG8_MMA(1, 0, At, B0); PG8_BAR; PG8_SCHED;
            PG8_STAGE(PG8_SB(0, 1), b2 + hstep, voffB);
            PG8_WAIT_V(6); PG8_BAR; PG8_MMA(1, 1, At, B1); PG8_BAR;
            PG8_LDB(B0, 1, 0); PG8_SCHED; PG8_LDA(At, 1, 0); PG8_STAGE(PG8_SA(0, 1), a2 + hstep, voffA);
            PG8_WAIT_L(8); PG8_BAR; PG8_WAIT_L(0); PG8_MMA(0, 0, At, B0); PG8_BAR; PG8_SCHED;
            PG8_LDB(B1, 1, 1); PG8_STAGE(PG8_SB(1, 0), b3, voffB);
            PG8_BAR; PG8_WAIT_L(0); PG8_MMA(0, 1, At, B1); PG8_BAR;
            PG8_LDA(At, 1, 1); PG8_STAGE(PG8_SA(1, 0), a3, voffA);
            PG8_BAR; PG8_WAIT_L(0); PG8_MMA(1, 0, At, B0); PG8_BAR; PG8_SCHED;
            PG8_STAGE(PG8_SB(1, 1), b3 + hstep, voffB);
            PG8_WAIT_V(6); PG8_BAR; PG8_MMA(1, 1, At, B1); PG8_BAR;
            }
        }
        if constexpr (ALIGN_EPI) { if (wr == 0) PG8_BAR; }
        if constexpr (!Epi::AFTER_DRAIN) { E(acc, cur, wr, wc, fr, fq); S.done(cur); }
        if (!has_next) break;
#pragma unroll
        for (int a = 0; a < 2; ++a)
#pragma unroll
            for (int b = 0; b < 2; ++b)
#pragma unroll
                for (int m = 0; m < 4; ++m)
#pragma unroll
                    for (int n = 0; n < 2; ++n) acc[a][b][m][n] = (f32x4){0.f, 0.f, 0.f, 0.f};
        cur = nxt; cA = nA; cB = nB; ++ui;
        if constexpr (ALIGN_EPI) { if (wr == 1) PG8_BAR; }
    }
    PG8_WAIT_V(0);
    if constexpr (!ALIGN_EPI) { if (wr == 0) PG8_BAR; }
    PG8_BAR;
    if constexpr (Epi::AFTER_DRAIN) { E.fused(acc, cur, wr, wc, fr, fq, lds, wid, lane); S.done(cur); }
#undef PG8_SA
#undef PG8_SB
#undef PG8_STAGE
#undef PG8_LDA
#undef PG8_LDB
#undef PG8_MMA
#undef PG8_WAIT_V
#undef PG8_WAIT_L
#undef PG8_BAR
#undef PG8_SCHED
}
}

struct Ctx {
    unsigned aoff; int l;
    float* X; bf16_t* H; bf16_t* P; bf16_t* MIX; bf16_t* QP; float* OF; float* OB; int* PIDX; float* PG; float* MOD; float* LB; float* ROPE; bf16_t* WIN; bf16_t* WOUT; bf16_t* WQ; bf16_t* UB; bf16_t* VB; float* ST; float* AC; float* PA; float* VS; float* US; bf16_t* SKH; bf16_t* SKL;
    unsigned char* lds; int tid, lane, wave, gw, ngw, bid, nb;
    int xg, nxg, jx, nloc;
};

#define LAS __attribute__((address_space(3)))
DI void transpose_item(const float* W, int Kd, int N, bf16_t* WT, LAS float* scr, int item, int lane) {
    const int nblk = N / 32, kb = item / nblk, nb = item % nblk, k0 = 64 * kb, n0 = 32 * nb;
#pragma unroll 8
    for (int i = 0; i < 32; ++i) { const int kk = 2 * i + (lane >> 5); scr[kk * 33 + (lane & 31)] = W[(size_t)(k0 + kk) * N + n0 + (lane & 31)]; }
    asm volatile("s_waitcnt lgkmcnt(0)" ::: "memory");
    const int c = lane & 7;
#pragma unroll
    for (int j = 0; j < 4; ++j) { const int n = (lane >> 3) + 8 * j; const LAS float* sp = scr + (8 * c) * 33 + n;
        u32x4 o; o.x = pk2(sp[0 * 33], sp[1 * 33]); o.y = pk2(sp[2 * 33], sp[3 * 33]); o.z = pk2(sp[4 * 33], sp[5 * 33]); o.w = pk2(sp[6 * 33], sp[7 * 33]);
        *(u32x4*)(WT + (size_t)(n0 + n) * Kd + k0 + 8 * c) = o; }
    asm volatile("s_waitcnt lgkmcnt(0)" ::: "memory");
}

template <class T> DI T* argp_(const Ctx& K, unsigned off) {
    const unsigned* p = (const unsigned*)(K.lds + K.aoff + off);
    const unsigned lo = __builtin_amdgcn_readfirstlane(p[0]), hi = __builtin_amdgcn_readfirstlane(p[1]);
    return GP(T, ((unsigned long long)hi << 32) | (unsigned long long)lo);
}
#define ARG(f) argp_<const float>(K, (unsigned)__builtin_offsetof(Args, f))

DI void ph_prologue(Ctx& K) {
    {
        LAS float* scr = (LAS float*)((LAS unsigned char*)K.lds + K.wave * 16384);
        constexpr int I_IN = (D / 64) * (PW / 32), I_OUT = (D / 64) * (D / 32), I_Q = (D / 64) * (2048 / 32), I_L = I_IN + I_OUT + I_Q;
        for (int it = K.gw; it < DEPTH * I_L; it += K.ngw) {
            const int l = it / I_L; int r = it % I_L;
            if (r < I_IN) { transpose_item(ARG(w_in) + (size_t)l * D * PW, D, PW, K.WIN + (size_t)l * PW * D, scr, r, K.lane); continue; } r -= I_IN;
            if (r < I_OUT) { transpose_item(ARG(w_out) + (size_t)l * D * D, D, D, K.WOUT + (size_t)l * D * D, scr, r, K.lane); continue; } r -= I_OUT;
            transpose_item(ARG(peer_wq) + (size_t)l * D * 2048, D, 2048, K.WQ + (size_t)l * 2048 * D, scr, r, K.lane);
        }
    }
    const size_t gt = (size_t)K.bid * NTHREADS + K.tid, gs = (size_t)K.nb * NTHREADS;
    { const f32x4* s0 = (const f32x4*)ARG(ctx); const f32x4* s1 = (const f32x4*)ARG(x); f32x4* d = (f32x4*)K.X;
      const size_t n0 = (size_t)NCTX * D / 4, n1 = (size_t)NLAT * D / 4;
      for (size_t i = gt; i < n0 + n1; i += gs) d[i] = i < n0 ? s0[i] : s1[i - n0]; }
    { const float* sk = ARG(peer_sk);
      for (size_t i = gt; i < (size_t)DEPTH * 8 * 2 * 128 * 128; i += gs) { const float v = sk[i]; const bf16_t hi = f2bf(v); K.SKH[i] = hi; K.SKL[i] = f2bf(v - bf2f(hi)); } }
    { const float* pu = ARG(peer_u); unsigned char* UQ = (unsigned char*)K.UB;
      for (int row = K.gw; row < DEPTH * 16384; row += K.ngw) {
          const f32x4* src = (const f32x4*)(pu + (size_t)row * D); f32x4 v[4]; float mx = 0.f;
#pragma unroll
          for (int j = 0; j < 4; ++j) { v[j] = src[j * 64 + K.lane]; mx = fmaxf(mx, fmaxf(fmaxf(fabsf(v[j].x), fabsf(v[j].y)), fmaxf(fabsf(v[j].z), fabsf(v[j].w)))); }
#pragma unroll
          for (int o = 1; o < 64; o <<= 1) mx = fmaxf(mx, __shfl_xor(mx, o));
          const float sc = fmaxf(mx, 1e-30f) * (1.0f / 127.0f), inv = 1.0f / sc;
          if (K.lane == 0) K.US[row] = sc;
#pragma unroll
          for (int j = 0; j < 4; ++j) { const int col = j * 256 + K.lane * 4;
              const unsigned q0 = (unsigned)((int)rintf(v[j].x * inv)) & 0xffu, q1 = (unsigned)((int)rintf(v[j].y * inv)) & 0xffu, q2 = (unsigned)((int)rintf(v[j].z * inv)) & 0xffu, q3 = (unsigned)((int)rintf(v[j].w * inv)) & 0xffu;
              *(unsigned*)(UQ + (size_t)row * D + col) = q0 | (q1 << 8) | (q2 << 16) | (q3 << 24); } } }
    { const float* pv = ARG(peer_v); unsigned char* VQ = (unsigned char*)K.VB;
      for (int row = K.gw; row < DEPTH * 16384; row += K.ngw) {
          const f32x4* src = (const f32x4*)(pv + (size_t)row * D); f32x4 v[4]; float mx = 0.f;
#pragma unroll
          for (int j = 0; j < 4; ++j) { v[j] = src[j * 64 + K.lane]; mx = fmaxf(mx, fmaxf(fmaxf(fabsf(v[j].x), fabsf(v[j].y)), fmaxf(fabsf(v[j].z), fabsf(v[j].w)))); }
#pragma unroll
          for (int o = 1; o < 64; o <<= 1) mx = fmaxf(mx, __shfl_xor(mx, o));
          const float sc = fmaxf(mx, 1e-30f) * (1.0f / 127.0f), inv = 1.0f / sc;
          if (K.lane == 0) K.VS[row] = sc;
          const int l = row >> 14, e = row & 16383;
#pragma unroll
          for (int j = 0; j < 4; ++j) { const int col = j * 256 + K.lane * 4;
              const unsigned q0 = (unsigned)((int)rintf(v[j].x * inv) + 128), q1 = (unsigned)((int)rintf(v[j].y * inv) + 128), q2 = (unsigned)((int)rintf(v[j].z * inv) + 128), q3 = (unsigned)((int)rintf(v[j].w * inv) + 128);
              *(unsigned*)(VQ + (((size_t)l * 8 + (col >> 7)) * 16384 + e) * 128 + (col & 127)) = q0 | (q1 << 8) | (q2 << 16) | (q3 << 24); } } }
    { float* sv = (float*)K.lds;
      float* part = sv + 3 * D;
      __syncthreads();
      for (int i = K.tid; i < 3 * D; i += NTHREADS) { const int v = i / D, k = i % D; const float c = v < 2 ? ARG(c)[v * D + k] : ARG(c_ctx)[k]; sv[i] = c * sigmoidf_(c); }
      __syncthreads();
      for (int item = K.bid; item < DEPTH * 24; item += K.nb) {
          const int l = item / 24, cb = item % 24;
          const float* w = ARG(w_mod) + (size_t)l * D * 6 * D + cb * 256 + K.lane * 4;
          f32x4 a0 = {0.f, 0.f, 0.f, 0.f}, a1 = a0, a2 = a0;
#pragma unroll 8
          for (int kk = 0; kk < 128; ++kk) { const int k = K.wave * 128 + kk; const f32x4 wv = *(const f32x4*)(w + (size_t)k * 6 * D);
              a0 += wv * sv[k]; a1 += wv * sv[D + k]; a2 += wv * sv[2 * D + k]; }
          *(f32x4*)(part + (K.wave * 3 + 0) * 256 + K.lane * 4) = a0; *(f32x4*)(part + (K.wave * 3 + 1) * 256 + K.lane * 4) = a1; *(f32x4*)(part + (K.wave * 3 + 2) * 256 + K.lane * 4) = a2;
          __syncthreads();
          for (int i = K.tid; i < 768; i += NTHREADS) { const int v = i / 256, cc = i % 256; float sum = 0.f;
#pragma unroll
              for (int w8 = 0; w8 < 8; ++w8) sum += part[(w8 * 3 + v) * 256 + cc];
              const int col = cb * 256 + cc; K.MOD[((size_t)l * 3 + v) * 6 * D + col] = sum + ARG(b_mod)[(size_t)l * 6 * D + col]; }
          __syncthreads();
      } }
    for (size_t i = gt; i < 2 * 256; i += gs) {
        const int dir = (int)(i / 256), ch = (int)(i % 256);
        float lg[DEPTH], mx = -1e30f;
#pragma unroll
        for (int l = 0; l < DEPTH; ++l) { lg[l] = ARG(lb_logits)[((size_t)dir * DEPTH + l) * 256 + ch]; mx = fmaxf(mx, lg[l]); }
        float s = 0.f;
#pragma unroll
        for (int l = 0; l < DEPTH; ++l) { lg[l] = expf(lg[l] - mx); s += lg[l]; }
        float cum = 0.f;
#pragma unroll
        for (int l = 0; l < DEPTH; ++l) { if (l > 0) cum += lg[l] / s; K.LB[((size_t)dir * DEPTH + l) * 256 + ch] = cum; }
    }
    for (size_t i = gt; i < (256 + 64) * 16; i += gs) {
        const int pos = (int)(i / 16), f = (int)(i % 16);
        const float inv = powf(10000.0f, -(float)f / 16.0f);
        if (pos < 256) { const float ang = (float)pos * inv; K.ROPE[pos * 16 + f] = cosf(ang); K.ROPE[4096 + pos * 16 + f] = sinf(ang); }
        else { const int pc = pos - 256; const float ang = (float)pc * inv; K.ROPE[8192 + pc * 16 + f] = cosf(ang); K.ROPE[8192 + 1024 + pc * 16 + f] = sinf(ang); }
    }
}

DI void ph_norm(Ctx& K, const float* nw, int shift_chunk) {
    const float* modl = K.MOD + (size_t)K.l * 3 * 6 * D;
    for (int r = K.gw; r < M; r += K.ngw) {
        const f32x4* xr = (const f32x4*)(K.X + (size_t)r * D);
        f32x4 v[4]; float ss = 0.f;
#pragma unroll
        for (int j = 0; j < 4; ++j) { v[j] = xr[j * 64 + K.lane]; ss += v[j].x * v[j].x + v[j].y * v[j].y + v[j].z * v[j].z + v[j].w * v[j].w; }
        ss = wave_sum(ss);
        const float rs = rsqrtf(ss * (1.0f / D) + EPS);
        const float* mv = modl + (size_t)modvec_of_row(r) * 6 * D;
        u32x2* ho = (u32x2*)(K.H + (size_t)r * D);
#pragma unroll
        for (int j = 0; j < 4; ++j) {
            const int c4 = j * 64 + K.lane;
            const f32x4 w = ((const f32x4*)nw)[c4], sh = ((const f32x4*)(mv + shift_chunk * D))[c4], sc = ((const f32x4*)(mv + (shift_chunk + 1) * D))[c4];
            f32x4 y; y.x = v[j].x * rs * w.x * (1.f + sc.x) + sh.x; y.y = v[j].y * rs * w.y * (1.f + sc.y) + sh.y; y.z = v[j].z * rs * w.z * (1.f + sc.z) + sh.z; y.w = v[j].w * rs * w.w * (1.f + sc.w) + sh.w;
            u32x2 o; o.x = pk2(y.x, y.y); o.y = pk2(y.z, y.w); ho[c4] = o;
        }
    }
}

DI void ph_gemm_store(Ctx& K, const bf16_t* A, const bf16_t* Bt, int N, bf16_t* out) {
    pg8::Gemm g{A, Bt, M, N, D}; pg8::StaticOrder S; S.init(M, N, K.nb, K.bid);
    pg8::EpiStore E{out, N};
    pg8::gemm_phase<pg8::EpiStore, pg8::StaticOrder, true, true>((LAS unsigned char*)K.lds, g, S, E);
}
DI void ph_gemm_resid(Ctx& K, const bf16_t* A, const bf16_t* Bt, int chunk) {
    pg8::Gemm g{A, Bt, M, D, D}; pg8::StaticOrder S; S.init(M, D, K.nb, K.bid);
    pg8::EpiResid E{K.X, D, K.MOD + (size_t)K.l * 3 * 6 * D + (size_t)chunk * D, 6 * D, NCTX, L};
    pg8::gemm_phase<pg8::EpiResid, pg8::StaticOrder, true, true>((LAS unsigned char*)K.lds, g, S, E);
}

DI void ph_rope(Ctx& K) {
    const float* cosr = K.ROPE; const float* sinr = K.ROPE + 4096; const float* cosc = K.ROPE + 8192; const float* sinc = K.ROPE + 8192 + 1024;
    const size_t gt = (size_t)K.bid * NTHREADS + K.tid, gs = (size_t)K.nb * NTHREADS;
    for (size_t i = gt; i < (size_t)NLAT * 8 * 16; i += gs) {
        const int f = (int)(i & 15), hh = (int)((i >> 4) & 7), lr = (int)(i >> 7);
        const int t = lr % L, pr = t >> 6, pc = t & 63;
        bf16_t* p = K.P + (size_t)(NCTX + lr) * PW + (hh < 6 ? C_SQ + hh * 64 : C_SK + (hh - 6) * 64);
        const float c1 = cosr[pr * 16 + f], s1 = sinr[pr * 16 + f], c2 = cosc[pc * 16 + f], s2 = sinc[pc * 16 + f];
        const float a = bf2f(p[f]), b = bf2f(p[16 + f]), e = bf2f(p[32 + f]), g = bf2f(p[48 + f]);
        p[f] = f2bf(a * c1 - b * s1); p[16 + f] = f2bf(b * c1 + a * s1); p[32 + f] = f2bf(e * c2 - g * s2); p[48 + f] = f2bf(g * c2 + e * s2);
    }
}

typedef short bf16x8_t __attribute__((ext_vector_type(8)));
#define MFMA16(a, b, c) __builtin_amdgcn_mfma_f32_16x16x32_bf16((a), (b), (c), 0, 0, 0)
constexpr int HG_NCH = (CL + L) / 64;
constexpr int HG_LFS = 68;
constexpr int HG_TS = 72;
constexpr int HGL_LF = 0, HGL_OM = HGL_LF + 2 * 64 * HG_LFS * 4, HGL_VT = HGL_OM + 2 * 64 * HG_LFS * 4, HGL_KT = HGL_VT + 64 * HG_TS * 2, HGL_SC = HGL_KT, HGL_OD = HGL_SC + 8 * 16 * HG_TS * 2, HGL_END = HGL_OD + 2 * 64 * HG_LFS * 4;
static_assert(HGL_KT + 2 * 64 * HG_TS * 2 <= LDS_BYTES && HGL_END <= LDS_BYTES, "hgrn LDS map");
DI int hg_block_row(int b, int tb, int tok) { return tb < 4 ? ctx_row(b, tb * 64 + tok) : lat_row(b, (tb - 4) * 64 + tok); }
DI int hg_bwd_chunk(int tb) { return tb < 4 ? 3 - tb : 4 + 255 - (tb - 4); }
DI void hg_prep(Ctx& K, int b, int h, int tb) {
    float* LF = (float*)(K.lds + HGL_LF); float* OM = (float*)(K.lds + HGL_OM); bf16_t* VT = (bf16_t*)(K.lds + HGL_VT);
    const int tok = K.tid >> 3, c = K.tid & 7;
    const bf16_t* pr = K.P + (size_t)hg_block_row(b, tb, tok) * PW + h * 64 + 8 * c;
#pragma unroll
    for (int dir = 0; dir < 2; ++dir) {
        float z[8]; unpack8(*(const u32x4*)(pr + (dir ? C_ZB : C_ZF)), z);
        const float* lb = K.LB + ((size_t)dir * DEPTH + K.l) * 256 + h * 64 + 8 * c;
        float lf[8], om[8];
#pragma unroll
        for (int j = 0; j < 8; ++j) { const float lbv = lb[j], sg = sigmoidf_(z[j]); const float f = fmaxf(lbv + (1.f - lbv) * sg, 1e-30f); lf[j] = __logf(f); om[j] = (1.f - lbv) * (1.f - sg); }
        float* lfp = LF + (dir * 64 + tok) * HG_LFS + 8 * c; float* omp = OM + (dir * 64 + tok) * HG_LFS + 8 * c;
        *(f32x4*)lfp = (f32x4){lf[0], lf[1], lf[2], lf[3]}; *(f32x4*)(lfp + 4) = (f32x4){lf[4], lf[5], lf[6], lf[7]};
        *(f32x4*)omp = (f32x4){om[0], om[1], om[2], om[3]}; *(f32x4*)(omp + 4) = (f32x4){om[4], om[5], om[6], om[7]};
    }
    { const u32x4 v = *(const u32x4*)(pr + C_HV);
      const unsigned w[4] = {v.x, v.y, v.z, v.w};
#pragma unroll
      for (int j = 0; j < 4; ++j) { VT[(8 * c + 2 * j) * HG_TS + tok] = (bf16_t)(w[j] & 0xffffu); VT[(8 * c + 2 * j + 1) * HG_TS + tok] = (bf16_t)(w[j] >> 16); } }
    __syncthreads();
    if (K.tid < 128) {
        const int dir = K.tid >> 6, d = K.tid & 63; float* col = LF + dir * 64 * HG_LFS + d;
        float v[64];
#pragma unroll
        for (int p = 0; p < 64; ++p) v[p] = col[(dir ? 63 - p : p) * HG_LFS];
#pragma unroll
        for (int p = 1; p < 64; ++p) v[p] += v[p - 1];
#pragma unroll
        for (int p = 0; p < 64; ++p) col[(dir ? 63 - p : p) * HG_LFS] = v[p];
    }
    __syncthreads();
}
DI void ph_hgrn_A(Ctx& K) {
    float* LF = (float*)(K.lds + HGL_LF); float* OM = (float*)(K.lds + HGL_OM); bf16_t* VT = (bf16_t*)(K.lds + HGL_VT); bf16_t* KT = (bf16_t*)(K.lds + HGL_KT);
    const int r16 = K.lane & 15, g4 = K.lane >> 4;
    for (int item = K.bid; item < NB * 4 * HG_NCH; item += K.nb) {
        const int tb = item % HG_NCH, h = (item / HG_NCH) & 3, b = item / (HG_NCH * 4);
        __syncthreads();
        hg_prep(K, b, h, tb);
        { const int tok = K.tid >> 3, c = K.tid & 7;
#pragma unroll
          for (int dir = 0; dir < 2; ++dir) {
              const float* bl = LF + (dir * 64 + (dir ? 0 : 63)) * HG_LFS + 8 * c; const float* bt = LF + (dir * 64 + tok) * HG_LFS + 8 * c; const float* om = OM + (dir * 64 + tok) * HG_LFS + 8 * c;
#pragma unroll
              for (int j = 0; j < 8; ++j) KT[(dir * 64 + 8 * c + j) * HG_TS + tok] = f2bf(om[j] * __expf(bl[j] - bt[j]));
          }
          if (K.tid < 128) { const int dir = K.tid >> 6, d = K.tid & 63; const int chain = (b * 2 + dir) * 4 + h, ch = dir ? hg_bwd_chunk(tb) : tb;
              K.AC[((size_t)chain * HG_NCH + ch) * 64 + d] = __expf(LF[(dir * 64 + (dir ? 0 : 63)) * HG_LFS + d]); } }
        __syncthreads();
        { const int dir = K.wave >> 2, mi = K.wave & 3; const int chain = (b * 2 + dir) * 4 + h, ch = dir ? hg_bwd_chunk(tb) : tb;
          f32x4 acc[4];
#pragma unroll
          for (int nj = 0; nj < 4; ++nj) acc[nj] = (f32x4){0.f, 0.f, 0.f, 0.f};
#pragma unroll
          for (int ks = 0; ks < 2; ++ks) {
              const bf16x8_t av = *(const bf16x8_t*)(VT + (16 * mi + r16) * HG_TS + 32 * ks + 8 * g4);
#pragma unroll
              for (int nj = 0; nj < 4; ++nj) { const bf16x8_t bv = *(const bf16x8_t*)(KT + (dir * 64 + 16 * nj + r16) * HG_TS + 32 * ks + 8 * g4); acc[nj] = MFMA16(av, bv, acc[nj]); }
          }
          float* st = K.ST + ((size_t)chain * HG_NCH + ch) * 4096;
#pragma unroll
          for (int nj = 0; nj < 4; ++nj)
#pragma unroll
              for (int rg = 0; rg < 4; ++rg) st[(16 * mi + 4 * g4 + rg) * 64 + 16 * nj + r16] = acc[nj][rg];
        }
    }
}
DI void ph_hgrn_B(Ctx& K) {
    const int gt = K.bid * NTHREADS + K.tid;
    if (gt < 16 * 4096) {
        const int chain = gt >> 12, idx = gt & 4095, d = idx & 63;
        float* st = K.ST + (size_t)chain * HG_NCH * 4096 + idx; const float* ac = K.AC + (size_t)chain * HG_NCH * 64 + d;
        float S = 0.f;
#pragma unroll 1
        for (int c0 = 0; c0 < HG_NCH; c0 += 10) {
            float u[10], a[10];
#pragma unroll
            for (int i = 0; i < 10; ++i) { u[i] = st[(size_t)(c0 + i) * 4096]; a[i] = ac[(c0 + i) * 64]; }
#pragma unroll
            for (int i = 0; i < 10; ++i) { st[(size_t)(c0 + i) * 4096] = S; S = a[i] * S + u[i]; }
        }
    }
}
DI void ph_hgrn_C(Ctx& K) {
    float* LF = (float*)(K.lds + HGL_LF); float* OM = (float*)(K.lds + HGL_OM); bf16_t* VT = (bf16_t*)(K.lds + HGL_VT); float* OD = (float*)(K.lds + HGL_OD);
    bf16_t* SC = (bf16_t*)(K.lds + HGL_SC) + K.wave * 16 * HG_TS;
    const int r16 = K.lane & 15, g4 = K.lane >> 4;
    for (int item = K.bid; item < NB * 4 * HG_NCH; item += K.nb) {
        const int tb = item % HG_NCH, h = (item / HG_NCH) & 3, b = item / (HG_NCH * 4);
        __syncthreads();
        hg_prep(K, b, h, tb);
        { const int dir = K.wave >> 2, mi = K.wave & 3; const int chain = (b * 2 + dir) * 4 + h, ch = dir ? hg_bwd_chunk(tb) : tb;
          const float* LFd = LF + dir * 64 * HG_LFS; const float* OMd = OM + dir * 64 * HG_LFS; const float* ref = LFd + 32 * HG_LFS;
          bf16x8_t aq1[2], aq2[2];
          { const int t = 16 * mi + r16; const bf16_t* qr = K.P + (size_t)hg_block_row(b, tb, t) * PW + C_HQ + h * 64;
#pragma unroll
            for (int ks = 0; ks < 2; ++ks) { const int d0 = 32 * ks + 8 * g4; float q[8]; unpack8(*(const u32x4*)(qr + d0), q);
                u32x4 w1, w2; unsigned o1[4], o2[4];
#pragma unroll
                for (int j = 0; j < 4; ++j) { float x1[2], x2[2];
#pragma unroll
                    for (int e = 0; e < 2; ++e) { const int dd = d0 + 2 * j + e; const float qs = q[2 * j + e] * sigmoidf_(q[2 * j + e]); const float bt = LFd[t * HG_LFS + dd]; x1[e] = qs * __expf(bt - ref[dd]); x2[e] = qs * __expf(bt); }
                    o1[j] = pk2(x1[0], x1[1]); o2[j] = pk2(x2[0], x2[1]); }
                w1 = (u32x4){o1[0], o1[1], o1[2], o1[3]}; w2 = (u32x4){o2[0], o2[1], o2[2], o2[3]};
                aq1[ks] = __builtin_bit_cast(bf16x8_t, w1); aq2[ks] = __builtin_bit_cast(bf16x8_t, w2); } }
          f32x4 sc[4];
#pragma unroll
          for (int nj = 0; nj < 4; ++nj) { sc[nj] = (f32x4){0.f, 0.f, 0.f, 0.f}; const int s_ = 16 * nj + r16;
#pragma unroll
              for (int ks = 0; ks < 2; ++ks) { const int d0 = 32 * ks + 8 * g4; unsigned o[4];
#pragma unroll
                  for (int j = 0; j < 4; ++j) { const int dd = d0 + 2 * j; o[j] = pk2(OMd[s_ * HG_LFS + dd] * __expf(ref[dd] - LFd[s_ * HG_LFS + dd]), OMd[s_ * HG_LFS + dd + 1] * __expf(ref[dd + 1] - LFd[s_ * HG_LFS + dd + 1])); }
                  const u32x4 w = (u32x4){o[0], o[1], o[2], o[3]};
                  sc[nj] = MFMA16(aq1[ks], __builtin_bit_cast(bf16x8_t, w), sc[nj]); } }
#pragma unroll
          for (int nj = 0; nj < 4; ++nj)
#pragma unroll
              for (int rg = 0; rg < 4; ++rg) { const int tl = 4 * g4 + rg, t = 16 * mi + tl, s_ = 16 * nj + r16; const bool keep = dir ? (s_ >= t) : (s_ <= t);
                  SC[tl * HG_TS + s_] = f2bf(keep ? sc[nj][rg] : 0.f); }
          asm volatile("s_waitcnt lgkmcnt(0)" ::: "memory");
          f32x4 oacc[4];
#pragma unroll
          for (int nj = 0; nj < 4; ++nj) oacc[nj] = (f32x4){0.f, 0.f, 0.f, 0.f};
          const float* st = K.ST + ((size_t)chain * HG_NCH + ch) * 4096;
#pragma unroll
          for (int ks = 0; ks < 2; ++ks) {
              const bf16x8_t as = *(const bf16x8_t*)(SC + r16 * HG_TS + 32 * ks + 8 * g4);
#pragma unroll
              for (int nj = 0; nj < 4; ++nj) {
                  const bf16x8_t bv = *(const bf16x8_t*)(VT + (16 * nj + r16) * HG_TS + 32 * ks + 8 * g4);
                  oacc[nj] = MFMA16(as, bv, oacc[nj]);
                  const float* sp = st + (16 * nj + r16) * 64 + 32 * ks + 8 * g4; const f32x4 s0 = *(const f32x4*)sp, s1 = *(const f32x4*)(sp + 4);
                  const u32x4 w = (u32x4){pk2(s0.x, s0.y), pk2(s0.z, s0.w), pk2(s1.x, s1.y), pk2(s1.z, s1.w)};
                  oacc[nj] = MFMA16(aq2[ks], __builtin_bit_cast(bf16x8_t, w), oacc[nj]);
              }
          }
#pragma unroll
          for (int nj = 0; nj < 4; ++nj)
#pragma unroll
              for (int rg = 0; rg < 4; ++rg) OD[(dir * 64 + 16 * mi + 4 * g4 + rg) * HG_LFS + 16 * nj + r16] = oacc[nj][rg];
        }
        __syncthreads();
        { const int tok = K.tid >> 3, c = K.tid & 7; const int row = hg_block_row(b, tb, tok);
          const float* o0 = OD + tok * HG_LFS + 8 * c; const float* o1 = OD + (64 + tok) * HG_LFS + 8 * c;
          float o[8], ss = 0.f;
#pragma unroll
          for (int j = 0; j < 8; ++j) { o[j] = o0[j] + o1[j]; ss += o[j] * o[j]; }
          ss += __shfl_xor(ss, 1); ss += __shfl_xor(ss, 2); ss += __shfl_xor(ss, 4);
          const float rs = rsqrtf(ss * (1.0f / 64.0f) + EPS);
          float gq[8]; unpack8(*(const u32x4*)(K.P + (size_t)row * PW + C_HG + h * 64 + 8 * c), gq);
          const float* nw = ARG(hgrn_norm_w) + (size_t)K.l * 256 + h * 64 + 8 * c;
          float y[8];
#pragma unroll
          for (int j = 0; j < 8; ++j) y[j] = o[j] * rs * nw[j] * gq[j] * sigmoidf_(gq[j]);
          u32x4 w; w.x = pk2(y[0], y[1]); w.y = pk2(y[2], y[3]); w.z = pk2(y[4], y[5]); w.w = pk2(y[6], y[7]);
          *(u32x4*)(K.MIX + (size_t)row * D + MX_H + h * 64 + 8 * c) = w; }
    }
}

constexpr int AT_TS = 72;
constexpr int ATL_K = 0, ATL_V = ATL_K + 64 * AT_TS * 2, ATL_P = ATL_V + 64 * AT_TS * 2, ATL_END = ATL_P + 8 * 48 * AT_TS * 2;
static_assert(ATL_END <= LDS_BYTES - 256, "attention LDS map");
DI float dpp_max16(float x) { x = fmaxf(x, dpp_<0xB1>(x)); x = fmaxf(x, dpp_<0x4E>(x)); x = fmaxf(x, dpp_<0x141>(x)); x = fmaxf(x, dpp_<0x128>(x)); return x; }
DI float dpp_sum16(float x) { x += dpp_<0xB1>(x); x += dpp_<0x4E>(x); x += dpp_<0x141>(x); x += dpp_<0x128>(x); return x; }
template <int KIND> DI void attn_item(Ctx& K, int idx, const float* sinkp, const float* rpbp) {
    constexpr int MT = KIND == 0 ? 3 : 2;
    int tid_ = K.tid; asm volatile("" : "+v"(tid_));
    const int lane_ = tid_ & 63, wave_ = tid_ >> 6;
    bf16_t* KT = (bf16_t*)(K.lds + ATL_K); bf16_t* VT = (bf16_t*)(K.lds + ATL_V); bf16_t* PS = (bf16_t*)(K.lds + ATL_P) + wave_ * 48 * AT_TS;
    const int r16 = lane_ & 15, g4 = lane_ >> 4;
    int b, hk, qb = 0;
    if (KIND == 0) { qb = idx & 127; hk = (idx >> 7) & 1; b = idx >> 8; }
    else if (KIND == 1) { qb = idx & 63; hk = (idx >> 6) % 6; b = (idx >> 6) / 6; }
    else { hk = idx % 6; b = idx / 6; }
    const int kcol = (KIND == 0) ? C_SK + hk * 64 : (KIND == 2) ? C_SK + (hk / 3) * 64 : C_NK + hk * 64;
    const int vcol = (KIND == 0) ? C_SV + hk * 64 : (KIND == 2) ? C_SV + (hk / 3) * 64 : C_NV + hk * 64;
    int t0 = 0, nloc = 0;
    if (KIND == 0) { const int k0 = max(2 * qb - 2, 0), k1 = min(2 * qb + 3, L / 64 - 1); t0 = k0; nloc = k1 - k0 + 1; }
    if (KIND == 1) { const int k0 = min(max(4 * qb - 4, 0), L / 64 - 8), k1 = min(max(4 * qb + 3 - 4, 0), L / 64 - 8) + 7; t0 = k0; nloc = k1 - k0 + 1; }
    const int ntiles = nloc + CL / 64;
    int w_r = 0, w_rs = 0;
    if (KIND == 1) { w_r = 4 * qb + (wave_ >> 1); w_rs = min(max(w_r - 4, 0), L / 64 - 8); }
    bf16x8_t qf[MT][2]; int qbase[MT], hq_mt[MT];
#pragma unroll
    for (int mt = 0; mt < MT; ++mt) {
        int arow, hq;
        if (KIND == 0) { const int rho = wave_ * 48 + mt * 16; hq = hk * 3 + rho / 128; hq_mt[mt] = hq; const int tb = 128 * qb + (rho & 127); arow = lat_row(b, tb + r16); qbase[mt] = tb; }
        else if (KIND == 1) { hq = hk; hq_mt[mt] = hq; const int cb = 32 * (wave_ & 1) + 16 * mt; arow = lat_row(b, w_r * 64 + cb + r16); qbase[mt] = cb; }
        else { hq = hk; hq_mt[mt] = hq; const int tb = wave_ * 32 + mt * 16; arow = ctx_row(b, tb + r16); qbase[mt] = 0; }
        const int qcol = (KIND == 0 || KIND == 2) ? C_SQ + hq * 64 : C_NQ + hq * 64;
#pragma unroll
        for (int ks = 0; ks < 2; ++ks) { float q[8]; unpack8(*(const u32x4*)(K.P + (size_t)arow * PW + qcol + 32 * ks + 8 * g4), q);
            const u32x4 w = (u32x4){pk2(q[0] * 0.125f, q[1] * 0.125f), pk2(q[2] * 0.125f, q[3] * 0.125f), pk2(q[4] * 0.125f, q[5] * 0.125f), pk2(q[6] * 0.125f, q[7] * 0.125f)};
            qf[mt][ks] = __builtin_bit_cast(bf16x8_t, w); }
    }
    f32x4 oacc[MT][4]; float mrun[MT][4], lrun[MT][4];
#pragma unroll
    for (int mt = 0; mt < MT; ++mt) {
#pragma unroll
        for (int ne = 0; ne < 4; ++ne) oacc[mt][ne] = (f32x4){0.f, 0.f, 0.f, 0.f};
        const bool has_sink = (KIND == 0 || KIND == 2); const float sk = has_sink ? sinkp[hq_mt[mt]] : -1.0e30f;
#pragma unroll
        for (int rg = 0; rg < 4; ++rg) { mrun[mt][rg] = sk; lrun[mt][rg] = has_sink ? 1.0f : 0.0f; }
    }
    const int lkey = tid_ >> 3, lch = tid_ & 7;
    u32x4 pk_, pv_;
    { const int ti = 0; const int grow = (ti < nloc) ? lat_row(b, (t0 + ti) * 64 + lkey) : ctx_row(b, (ti - nloc) * 64 + lkey);
      const bf16_t* pr = K.P + (size_t)grow * PW + 8 * lch; pk_ = *(const u32x4*)(pr + kcol); pv_ = *(const u32x4*)(pr + vcol); }
#pragma unroll 1
    for (int ti = 0; ti < ntiles; ++ti) {
        __syncthreads();
        *(u32x4*)(KT + lkey * AT_TS + 8 * lch) = pk_;
        { const unsigned w[4] = {pv_.x, pv_.y, pv_.z, pv_.w};
#pragma unroll
          for (int j = 0; j < 4; ++j) { VT[(8 * lch + 2 * j) * AT_TS + lkey] = (bf16_t)(w[j] & 0xffffu); VT[(8 * lch + 2 * j + 1) * AT_TS + lkey] = (bf16_t)(w[j] >> 16); } }
        __syncthreads();
        if (ti + 1 < ntiles) { const int tn = ti + 1; const int grow = (tn < nloc) ? lat_row(b, (t0 + tn) * 64 + lkey) : ctx_row(b, (tn - nloc) * 64 + lkey);
            const bf16_t* pr = K.P + (size_t)grow * PW + 8 * lch; pk_ = *(const u32x4*)(pr + kcol); pv_ = *(const u32x4*)(pr + vcol); }
        const bool local = ti < nloc; const int kunit = t0 + ti;
        bool active = true;
        if (KIND == 0 && local) active = true;
        if (KIND == 1 && local) active = (kunit >= w_rs) && (kunit < w_rs + 8);
        if (active) {
            f32x4 sc[MT][4];
#pragma unroll
            for (int mt = 0; mt < MT; ++mt)
#pragma unroll
                for (int nj = 0; nj < 4; ++nj) sc[mt][nj] = (f32x4){0.f, 0.f, 0.f, 0.f};
#pragma unroll
            for (int nj = 0; nj < 4; ++nj)
#pragma unroll
                for (int ks = 0; ks < 2; ++ks) { const bf16x8_t kf = *(const bf16x8_t*)(KT + (16 * nj + r16) * AT_TS + 32 * ks + 8 * g4);
#pragma unroll
                    for (int mt = 0; mt < MT; ++mt) sc[mt][nj] = MFMA16(qf[mt][ks], kf, sc[mt][nj]); }
            if (local) {
#pragma unroll
                for (int mt = 0; mt < MT; ++mt)
#pragma unroll
                    for (int nj = 0; nj < 4; ++nj)
#pragma unroll
                        for (int rg = 0; rg < 4; ++rg) { const int key = 16 * nj + r16;
                            if (KIND == 0) { const int dl = qbase[mt] + 4 * g4 + rg - (kunit * 64 + key); if (dl > 128 || dl < -128) sc[mt][nj][rg] = -INFINITY; }
                            if (KIND == 1) { const int c = qbase[mt] + 4 * g4 + rg, ws = min(max(c - 8, 0), 48);
                                if (key >= ws && key < ws + 16) sc[mt][nj][rg] += rpbp[(kunit - w_r + 7) * 31 + (key - c + 15)]; else sc[mt][nj][rg] = -INFINITY; } }
            }
#pragma unroll
            for (int mt = 0; mt < MT; ++mt)
#pragma unroll
                for (int rg = 0; rg < 4; ++rg) {
                    float mx = fmaxf(fmaxf(sc[mt][0][rg], sc[mt][1][rg]), fmaxf(sc[mt][2][rg], sc[mt][3][rg]));
                    mx = dpp_max16(mx);
                    const float mn = fmaxf(mrun[mt][rg], mx), alpha = __expf(mrun[mt][rg] - mn); mrun[mt][rg] = mn;
                    float rs_ = 0.f;
#pragma unroll
                    for (int nj = 0; nj < 4; ++nj) { const float pe = __expf(sc[mt][nj][rg] - mn); sc[mt][nj][rg] = pe; rs_ += pe; }
                    rs_ = dpp_sum16(rs_);
                    lrun[mt][rg] = lrun[mt][rg] * alpha + rs_;
#pragma unroll
                    for (int ne = 0; ne < 4; ++ne) oacc[mt][ne][rg] *= alpha;
                }
#pragma unroll
            for (int mt = 0; mt < MT; ++mt)
#pragma unroll
                for (int nj = 0; nj < 4; ++nj)
#pragma unroll
                    for (int rg = 0; rg < 4; ++rg) PS[(16 * mt + 4 * g4 + rg) * AT_TS + 16 * nj + r16] = f2bf(sc[mt][nj][rg]);
            asm volatile("s_waitcnt lgkmcnt(0)" ::: "memory");
#pragma unroll
            for (int ks = 0; ks < 2; ++ks) {
                bf16x8_t pf[MT];
#pragma unroll
                for (int mt = 0; mt < MT; ++mt) pf[mt] = *(const bf16x8_t*)(PS + (16 * mt + r16) * AT_TS + 32 * ks + 8 * g4);
#pragma unroll
                for (int ne = 0; ne < 4; ++ne) { const bf16x8_t vf = *(const bf16x8_t*)(VT + (16 * ne + r16) * AT_TS + 32 * ks + 8 * g4);
#pragma unroll
                    for (int mt = 0; mt < MT; ++mt) oacc[mt][ne] = MFMA16(pf[mt], vf, oacc[mt][ne]); }
            }
            asm volatile("s_waitcnt lgkmcnt(0)" ::: "memory");
        }
    }
#pragma unroll
    for (int mt = 0; mt < MT; ++mt)
#pragma unroll
        for (int rg = 0; rg < 4; ++rg) { const float inv = 1.0f / lrun[mt][rg];
#pragma unroll
            for (int ne = 0; ne < 4; ++ne) PS[(16 * mt + 4 * g4 + rg) * AT_TS + 16 * ne + r16] = f2bf(oacc[mt][ne][rg] * inv); }
    asm volatile("s_waitcnt lgkmcnt(0)" ::: "memory");
#pragma unroll
    for (int mt = 0; mt < MT; ++mt) {
        const int ocol = ((KIND == 0 || KIND == 2) ? MX_S : MX_N) + hq_mt[mt] * 64;
#pragma unroll
        for (int i = 0; i < 2; ++i) { const int rr = (lane_ >> 3) + 8 * i, ch = lane_ & 7;
            const u32x4 v = *(const u32x4*)(PS + (16 * mt + rr) * AT_TS + 8 * ch);
            int grow;
            if (KIND == 0) { const int rho = wave_ * 48 + mt * 16; grow = lat_row(b, 128 * qb + (rho & 127) + rr); }
            else if (KIND == 1) grow = lat_row(b, w_r * 64 + 32 * (wave_ & 1) + 16 * mt + rr);
            else grow = ctx_row(b, wave_ * 32 + mt * 16 + rr);
            *(u32x4*)(K.MIX + (size_t)grow * D + ocol + 8 * ch) = v; }
    }
    asm volatile("s_waitcnt lgkmcnt(0)" ::: "memory");
}
DI void ph_attn(Ctx& K) {
    constexpr int N_SWA = NB * 2 * (L / 128), N_NAT = NB * 6 * (L / 256), N_C = NB * 6;
    const float* sinkp = ARG(swa_sink) + K.l * 6;
    for (int item = K.bid; item < N_SWA + N_NAT + 2 * N_C; item += K.nb) {
        if (item < N_SWA) attn_item<0>(K, item, sinkp, nullptr);
        else if (item < N_SWA + N_NAT) { const int it = item - N_SWA; const int h = (it >> 6) % 6; attn_item<1>(K, it, nullptr, ARG(nat_rpb) + ((size_t)K.l * 6 + h) * 15 * 31); }
        else if (item < N_SWA + N_NAT + N_C) attn_item<2>(K, item - N_SWA - N_NAT, sinkp, nullptr);
        else attn_item<3>(K, item - N_SWA - N_NAT - N_C, nullptr, nullptr);
    }
}

DI unsigned fkey(float f) { const unsigned u = __float_as_uint(f); return (u & 0x80000000u) ? ~u : (u | 0x80000000u); }
DI int mbcnt64(unsigned long long m) { return (int)__builtin_amdgcn_mbcnt_hi((unsigned)(m >> 32), __builtin_amdgcn_mbcnt_lo((unsigned)m, 0u)); }
template <int NV> DI unsigned radix_thr16(const unsigned (&k)[NV]) {
    unsigned prefix = 0u;
#pragma unroll 1
    for (int bit = 31; bit >= 0; --bit) {
        const unsigned cand = prefix | (1u << bit); int cnt = 0;
#pragma unroll
        for (int i = 0; i < NV; ++i) cnt += __popcll(__ballot(k[i] >= cand));
        if (cnt >= 16) { prefix = cand; if (cnt == 16) break; }
    }
    return prefix;
}
template <int NC, int NV> DI void radix_thr16_multi(const unsigned (&k)[NC][NV], unsigned (&T)[NC]) {
    bool exact[NC];
#pragma unroll
    for (int c = 0; c < NC; ++c) { T[c] = 0u; exact[c] = false; }
#pragma unroll 1
    for (int bit = 31; bit >= 0; --bit) {
        bool all = true;
#pragma unroll
        for (int c = 0; c < NC; ++c) {
            const unsigned cand = T[c] | (1u << bit); int cnt = 0;
#pragma unroll
            for (int i = 0; i < NV; ++i) cnt += __popcll(__ballot(k[c][i] >= cand));
            if (cnt >= 16) { T[c] = cand; exact[c] = (cnt == 16); }
            all = all && exact[c];
        }
        if (all) break;
    }
}
template <int NV> DI void select16(const unsigned (&k)[NV], unsigned T, bool (&sel)[NV], int (&pos)[NV]) {
    int ngt = 0; unsigned long long gtm[NV], eqm[NV];
#pragma unroll
    for (int i = 0; i < NV; ++i) { gtm[i] = __ballot(k[i] > T); eqm[i] = __ballot(k[i] == T); ngt += __popcll(gtm[i]); }
    const int need = 16 - ngt; int eqbase = 0, selbase = 0;
#pragma unroll
    for (int i = 0; i < NV; ++i) {
        const bool iseq = k[i] == T; const int erank = eqbase + mbcnt64(eqm[i]); eqbase += __popcll(eqm[i]);
        sel[i] = (k[i] > T) || (iseq && erank < need);
        const unsigned long long sm = __ballot(sel[i]); pos[i] = selbase + mbcnt64(sm); selbase += __popcll(sm);
    }
}
constexpr int PS_SCS = 132;
constexpr int PSL_TOP = 8 * 2 * 16 * PS_SCS * 4;
static_assert(PSL_TOP + 8 * 512 <= LDS_BYTES - 256, "peer select LDS map");
template <int PROBE> DI void ph_peer_select(Ctx& K) {
    float* SCR = (float*)K.lds + K.wave * 2 * 16 * PS_SCS; float* TOPV = (float*)(K.lds + PSL_TOP + K.wave * 512); int* TOPI = (int*)(TOPV + 64);
    const int r16 = K.lane & 15, g4 = K.lane >> 4, h = K.wave;
    for (int item = K.bid; item < M / 16; item += K.nb) {
        const int t0 = item * 16;
#pragma unroll 1
        for (int p = 0; p < 2; ++p) {
            bf16x8_t aq[4];
            { const bf16_t* qp = K.QP + (size_t)(t0 + r16) * 2048 + h * 256 + p * 128 + 8 * g4;
#pragma unroll
              for (int ks = 0; ks < 4; ++ks) aq[ks] = *(const bf16x8_t*)(qp + 32 * ks); }
            const size_t kb = (((size_t)K.l * 8 + h) * 2 + p) * 128 * 128 + (size_t)r16 * 128 + 8 * g4;
#pragma unroll 2
            for (int nt = 0; nt < 8; ++nt) {
                bf16x8_t bh[4], bl[4];
#pragma unroll
                for (int ks = 0; ks < 4; ++ks) { bh[ks] = *(const bf16x8_t*)(K.SKH + kb + (size_t)(16 * nt) * 128 + 32 * ks); bl[ks] = *(const bf16x8_t*)(K.SKL + kb + (size_t)(16 * nt) * 128 + 32 * ks); }
                f32x4 c0 = {0.f, 0.f, 0.f, 0.f}, c1 = c0;
#pragma unroll
                for (int ks = 0; ks < 4; ++ks) { c0 = MFMA16(aq[ks], bh[ks], c0); c1 = MFMA16(aq[ks], bl[ks], c1); }
#pragma unroll
                for (int rg = 0; rg < 4; ++rg) SCR[(p * 16 + 4 * g4 + rg) * PS_SCS + 16 * nt + r16] = c0[rg] + c1[rg];
            }
        }
        asm volatile("s_waitcnt lgkmcnt(0)" ::: "memory");
        if (PROBE == 1) continue;
#pragma unroll 1
        for (int tk = 0; tk < 16; tk += 2) {
            float v[4][2]; unsigned kk[4][2], T4[4];
#pragma unroll
            for (int c = 0; c < 4; ++c) { const int p = c & 1, rr = c >> 1; v[c][0] = SCR[(p * 16 + tk + rr) * PS_SCS + K.lane]; v[c][1] = SCR[(p * 16 + tk + rr) * PS_SCS + 64 + K.lane]; kk[c][0] = fkey(v[c][0]); kk[c][1] = fkey(v[c][1]); }
            radix_thr16_multi<4, 2>(kk, T4);
#pragma unroll
            for (int c = 0; c < 4; ++c) { bool sel[2]; int pos[2]; select16<2>(kk[c], T4[c], sel, pos);
#pragma unroll
                for (int i = 0; i < 2; ++i) if (sel[i]) { TOPV[c * 16 + pos[i]] = v[c][i]; TOPI[c * 16 + pos[i]] = K.lane + 64 * i; } }
            asm volatile("s_waitcnt lgkmcnt(0)" ::: "memory");
            float cv[2][4]; int ce[2][4]; unsigned ck[2][4], T2[2];
#pragma unroll
            for (int rr = 0; rr < 2; ++rr) { const float vb = TOPV[(2 * rr + 1) * 16 + r16]; const int ib = TOPI[(2 * rr + 1) * 16 + r16];
#pragma unroll
                for (int i = 0; i < 4; ++i) { const int aidx = g4 + 4 * i; cv[rr][i] = TOPV[(2 * rr) * 16 + aidx] + vb; ce[rr][i] = TOPI[(2 * rr) * 16 + aidx] * 128 + ib; ck[rr][i] = fkey(cv[rr][i]); } }
            radix_thr16_multi<2, 4>(ck, T2);
#pragma unroll
            for (int rr = 0; rr < 2; ++rr) {
                const int r = t0 + tk + rr;
                bool sel[4]; int pos[4]; select16<4>(ck[rr], T2[rr], sel, pos);
                float mx = -3.0e38f;
#pragma unroll
                for (int i = 0; i < 4; ++i) mx = fmaxf(mx, sel[i] ? cv[rr][i] : -3.0e38f);
                mx = fmaxf(mx, dpp_<0xB1>(mx)); mx = fmaxf(mx, dpp_<0x4E>(mx)); mx = fmaxf(mx, dpp_<0x141>(mx)); mx = fmaxf(mx, dpp_<0x128>(mx));
                { auto s1 = __builtin_amdgcn_permlane16_swap(__float_as_uint(mx), __float_as_uint(mx), false, false); mx = fmaxf(__uint_as_float(s1[0]), __uint_as_float(s1[1]));
                  auto s2 = __builtin_amdgcn_permlane32_swap(__float_as_uint(mx), __float_as_uint(mx), false, false); mx = fmaxf(__uint_as_float(s2[0]), __uint_as_float(s2[1])); }
                float ex[4], es = 0.f;
#pragma unroll
                for (int i = 0; i < 4; ++i) { ex[i] = sel[i] ? __expf(cv[rr][i] - mx) : 0.f; es += ex[i]; }
                es = wave_sum_fast(es);
                const float inv = 1.0f / es;
#pragma unroll
                for (int i = 0; i < 4; ++i) if (sel[i]) { K.PIDX[(size_t)r * 128 + h * 16 + pos[i]] = ce[rr][i]; K.PG[(size_t)r * 128 + h * 16 + pos[i]] = ex[i] * inv; }
            }
            asm volatile("s_waitcnt lgkmcnt(0)" ::: "memory");
        }
    }
}

constexpr int PUL_H = 0, PUL_SLOT = 4096, PUL_STRIDE = 4352;
struct PuMeta { u32x4 h0[2], h1[2]; int ia[2], ib[2]; };
DI void pu_load(const Ctx& K, int r0, int step, PuMeta& m) {
#pragma unroll
    for (int q = 0; q < 2; ++q) { const int r = r0 + q * step;
        if (r < M) { m.h0[q] = *(const u32x4*)(K.H + (size_t)r * D + K.lane * 8); m.h1[q] = *(const u32x4*)(K.H + (size_t)r * D + 512 + K.lane * 8); m.ia[q] = K.PIDX[(size_t)r * 128 + K.lane]; m.ib[q] = K.PIDX[(size_t)r * 128 + 64 + K.lane]; }
        else { m.ia[q] = -1; m.ib[q] = -1; } }
}
typedef int i32x4 __attribute__((ext_vector_type(4)));
template <int PROBE> DI void pu_item(const Ctx& K, const unsigned char* U, unsigned char* HL, int* SLOT, int R, int r0, int step, const PuMeta& m, int r16, int g4, float& dummy) {
    float hs[2];
#pragma unroll
    for (int q = 0; q < 2; ++q) {
        float f[16]; unpack8(m.h0[q], &f[0]); unpack8(m.h1[q], &f[8]);
        float mx = 0.f;
#pragma unroll
        for (int i = 0; i < 16; ++i) mx = fmaxf(mx, fabsf(f[i]));
        mx = dpp_max16(mx);
        { auto s1 = __builtin_amdgcn_permlane16_swap(__float_as_uint(mx), __float_as_uint(mx), false, false); mx = fmaxf(__uint_as_float(s1[0]), __uint_as_float(s1[1]));
          auto s2 = __builtin_amdgcn_permlane32_swap(__float_as_uint(mx), __float_as_uint(mx), false, false); mx = fmaxf(__uint_as_float(s2[0]), __uint_as_float(s2[1])); }
        const float sc = fmaxf(mx, 1e-30f) * (1.0f / 127.0f), inv = 1.0f / sc; hs[q] = sc;
        unsigned w[4];
#pragma unroll
        for (int i = 0; i < 4; ++i) w[i] = ((unsigned)((int)rintf(f[4 * i] * inv)) & 0xffu) | (((unsigned)((int)rintf(f[4 * i + 1] * inv)) & 0xffu) << 8) | (((unsigned)((int)rintf(f[4 * i + 2] * inv)) & 0xffu) << 16) | (((unsigned)((int)rintf(f[4 * i + 3] * inv)) & 0xffu) << 24);
        *(u32x2*)(HL + PUL_H + q * 1024 + K.lane * 8) = (u32x2){w[0], w[1]}; *(u32x2*)(HL + PUL_H + q * 1024 + 512 + K.lane * 8) = (u32x2){w[2], w[3]};
    }
    bool sa[2], sb[2]; int ra[2], rb[2]; int n = 0;
#pragma unroll
    for (int q = 0; q < 2; ++q) { sa[q] = (m.ia[q] >> 11) == R; sb[q] = (m.ib[q] >> 11) == R; const unsigned long long ma = __ballot(sa[q]), mb = __ballot(sb[q]);
        ra[q] = n + mbcnt64(ma); n += __popcll(ma); rb[q] = n + mbcnt64(mb); n += __popcll(mb); }
#pragma unroll 1
    for (int base = 0; base < n; base += 16) {
#pragma unroll
        for (int q = 0; q < 2; ++q) {
            if (sa[q] && ra[q] >= base && ra[q] < base + 16) { SLOT[2 * (ra[q] - base)] = m.ia[q]; SLOT[2 * (ra[q] - base) + 1] = q * 128 + K.lane; }
            if (sb[q] && rb[q] >= base && rb[q] < base + 16) { SLOT[2 * (rb[q] - base)] = m.ib[q]; SLOT[2 * (rb[q] - base) + 1] = q * 128 + 64 + K.lane; } }
        asm volatile("s_waitcnt lgkmcnt(0)" ::: "memory");
        const bool valid = base + r16 < n; const int e = valid ? SLOT[2 * r16] : 0;
        const unsigned char* up = U + (size_t)e * D + 16 * g4;
        const unsigned char* hp = HL + PUL_H + (r16 >> 3) * 1024 + 16 * g4;
        i32x4 av[16];
#pragma unroll
        for (int s_ = 0; s_ < 16; ++s_) av[s_] = (valid && PROBE != 3) ? *(const i32x4*)(up + 64 * s_) : (i32x4){0, 0, 0, 0};
        i32x4 acc = {0, 0, 0, 0};
#pragma unroll
        for (int s_ = 0; s_ < 16; ++s_) { const i32x4 hb = *(const i32x4*)(hp + 64 * s_); acc = __builtin_amdgcn_mfma_i32_16x16x64_i8(av[s_], hb, acc, 0, 0, 0); }
        const int rg = r16 & 3; const int di = rg == 0 ? acc[0] : rg == 1 ? acc[1] : rg == 2 ? acc[2] : acc[3];
        const int sl = 4 * g4 + rg;
        if ((r16 & 7) < 4 && base + sl < n) { const int code = SLOT[2 * sl + 1];
            if ((code >> 7) == (r16 >> 3)) {
                const size_t eo = (size_t)K.l * 16384 + SLOT[2 * sl];
                const float d = (float)di * K.US[eo] * ((code >> 7) ? hs[1] : hs[0]);
                const float vsc = K.VS[eo];
                if (PROBE >= 2) dummy += gelu_erf(d);
                else (PROBE ? K.ST : K.PA)[(size_t)(r0 + (code >> 7) * step) * 128 + (code & 127)] = gelu_erf(d) * vsc; } }
        asm volatile("s_waitcnt lgkmcnt(0)" ::: "memory");
    }
}
template <int PROBE> DI void ph_peer_u(Ctx& K) {
    const unsigned char* U = (const unsigned char*)K.UB + (size_t)K.l * 16384 * D;
    unsigned char* HL = K.lds + K.wave * PUL_STRIDE; int* SLOT = (int*)(HL + PUL_SLOT);
    const int r16 = K.lane & 15, g4 = K.lane >> 4;
    const int step = K.nloc * NWAVES;
    constexpr int PD = 2;
    float dummy = 0.f;
    for (int R = K.xg; R < 8; R += K.nxg) {
        int r = K.jx * NWAVES + K.wave;
        PuMeta m[PD];
#pragma unroll
        for (int i = 0; i < PD; ++i) {
#pragma unroll
            for (int q = 0; q < 2; ++q) { m[i].h0[q] = (u32x4){0u, 0u, 0u, 0u}; m[i].h1[q] = m[i].h0[q]; }
            pu_load(K, r + 2 * i * step, step, m[i]); }
#pragma unroll 1
        for (; r < M; r += 2 * PD * step) {
#pragma unroll
            for (int i = 0; i < PD; ++i) {
                const int ri = r + 2 * i * step;
                if (ri < M) pu_item<PROBE>(K, U, HL, SLOT, R, ri, step, m[i], r16, g4, dummy);
                pu_load(K, ri + 2 * PD * step, step, m[i]);
            }
        }
    }
    if (PROBE >= 2) K.ST[K.gw * 64 + K.lane] = dummy;
}
struct PvMeta { int ia, ib; float ga, gb, pa, pb; };
template <int PROBE> DI void pv_load(const Ctx& K, int r, int c0, int slot, PvMeta& m) {
    if (r < M) { m.ia = K.PIDX[(size_t)r * 128 + K.lane]; m.ib = K.PIDX[(size_t)r * 128 + 64 + K.lane];
        m.ga = K.PG[(size_t)r * 128 + K.lane]; m.pa = K.PA[(size_t)r * 128 + K.lane]; m.gb = K.PG[(size_t)r * 128 + 64 + K.lane]; m.pb = K.PA[(size_t)r * 128 + 64 + K.lane]; }
}
template <int HALF, int PROBE> DI void pv_issue(const unsigned char* V, int slot, const PvMeta& m, u32x4 (&vv)[8], float (&ww)[8]) {
    const float w = HALF ? m.gb * m.pb : m.ga * m.pa; const int ix = HALF ? m.ib : m.ia;
#pragma unroll
    for (int i = 0; i < 8; ++i) {
        const int src = ((8 * i + slot) << 2);
        const int e = __builtin_amdgcn_ds_bpermute(src, ix);
        ww[i] = __uint_as_float((unsigned)__builtin_amdgcn_ds_bpermute(src, (int)__float_as_uint(w)));
        vv[i] = PROBE == 2 ? (u32x4){(unsigned)e, 1u, 2u, 3u} : *(const u32x4*)(V + (size_t)e * 128);
    }
}
typedef float f32x2_ __attribute__((ext_vector_type(2)));
DI void pv_accum(const u32x4 (&vv)[8], const float (&ww)[8], f32x2_ (&y)[8], float& sw) {
#pragma unroll
    for (int i = 0; i < 8; ++i) { sw += ww[i]; const unsigned w4[4] = {vv[i].x, vv[i].y, vv[i].z, vv[i].w}; const f32x2_ w2 = {ww[i], ww[i]};
#pragma unroll
        for (int q = 0; q < 4; ++q) { const f32x2_ lo = {(float)(w4[q] & 0xffu), (float)((w4[q] >> 8) & 0xffu)}, hi = {(float)((w4[q] >> 16) & 0xffu), (float)(w4[q] >> 24)};
            y[2 * q] = __builtin_elementwise_fma(w2, lo, y[2 * q]); y[2 * q + 1] = __builtin_elementwise_fma(w2, hi, y[2 * q + 1]); } }
}
template <int PROBE> DI void pv_item(const Ctx& K, const unsigned char* V, int r, int c0, int slot, const float* gate, const PvMeta& m, const PvMeta& mn, bool has_next, u32x4 (&vA)[8], float (&wA)[8], f32x4 (&pend)[4], float*& pend_ptr) {
    u32x4 vB[8]; float wB[8];
    float* xr = (PROBE ? (float*)K.P : K.X) + (size_t)r * D + c0;
    pv_issue<1, PROBE>(V, slot, m, vB, wB);
    if (slot == 0) {
        if (pend_ptr) {
#pragma unroll
            for (int q = 0; q < 4; ++q) *(f32x4*)(pend_ptr + 4 * q) = pend[q]; }
#pragma unroll
        for (int q = 0; q < 4; ++q) pend[q] = *(const f32x4*)(xr + 4 * q); }
    f32x2_ y2[8]; float sw = 0.f;
#pragma unroll
    for (int i = 0; i < 8; ++i) y2[i] = (f32x2_){0.f, 0.f};
    pv_accum(vA, wA, y2, sw);
    if (has_next) pv_issue<0, PROBE>(V, slot, mn, vA, wA);
    pv_accum(vB, wB, y2, sw);
    float y[16];
#pragma unroll
    for (int q = 0; q < 8; ++q) { y[2 * q] = y2[q].x - 128.f * sw; y[2 * q + 1] = y2[q].y - 128.f * sw; }
#pragma unroll
    for (int q = 0; q < 16; ++q) { float v = y[q]; v += dpp_<0x128>(v);
        auto s1 = __builtin_amdgcn_permlane16_swap(__float_as_uint(v), __float_as_uint(v), false, false); v = __uint_as_float(s1[0]) + __uint_as_float(s1[1]);
        auto s2 = __builtin_amdgcn_permlane32_swap(__float_as_uint(v), __float_as_uint(v), false, false); y[q] = __uint_as_float(s2[0]) + __uint_as_float(s2[1]); }
    if (slot == 0) { const float* gv = gate + (size_t)modvec_of_row(r) * 6 * D + c0;
#pragma unroll
        for (int q = 0; q < 4; ++q) { const f32x4 g = *(const f32x4*)(gv + 4 * q);
            pend[q].x += g.x * y[4 * q]; pend[q].y += g.y * y[4 * q + 1]; pend[q].z += g.z * y[4 * q + 2]; pend[q].w += g.w * y[4 * q + 3]; } }
    pend_ptr = xr;
}
template <int PROBE> DI void ph_peer_v(Ctx& K) {
    const int slot = K.lane >> 3, c = K.lane & 7;
    const float* gate = K.MOD + (size_t)K.l * 3 * 6 * D + 5 * D;
    const int step = K.nloc * NWAVES;
    constexpr int PD = 2;
    for (int S = K.xg; S < 8; S += K.nxg) {
        const unsigned char* V = (const unsigned char*)K.VB + ((size_t)K.l * 8 + S) * 16384 * 128 + c * 16;
        const int c0 = S * 128 + c * 16;
        int r = K.jx * NWAVES + K.wave;
        PvMeta m[PD];
#pragma unroll
        for (int i = 0; i < PD; ++i) { m[i].ia = 0; m[i].ib = 0; m[i].ga = m[i].gb = m[i].pa = m[i].pb = 0.f; pv_load<PROBE>(K, r + i * step, c0, slot, m[i]); }
        u32x4 vA[8]; float wA[8]; f32x4 pend[4]; float* pend_ptr = nullptr;
        if (r < M) pv_issue<0, PROBE>(V, slot, m[0], vA, wA);
#pragma unroll 1
        for (; r < M; r += PD * step) {
#pragma unroll
            for (int i = 0; i < PD; ++i) {
                const int ri = r + i * step;
                if (ri < M) pv_item<PROBE>(K, V, ri, c0, slot, gate, m[i], m[(i + 1) % PD], ri + step < M, vA, wA, pend, pend_ptr);
                pv_load<PROBE>(K, ri + PD * step, c0, slot, m[i]);
            }
        }
        if (slot == 0 && pend_ptr) {
#pragma unroll
            for (int q = 0; q < 4; ++q) *(f32x4*)(pend_ptr + 4 * q) = pend[q]; }
    }
}

DI void ph_final(Ctx& K) {
    for (int r = K.gw; r < NLAT; r += K.ngw) {
        const f32x4* xr = (const f32x4*)(K.X + (size_t)(NCTX + r) * D); f32x4* o = (f32x4*)(((float*)argp_<float>(K, (unsigned)__builtin_offsetof(Args, out))) + (size_t)r * D);
        f32x4 v[4]; float ss = 0.f;
#pragma unroll
        for (int j = 0; j < 4; ++j) { v[j] = xr[j * 64 + K.lane]; ss += v[j].x * v[j].x + v[j].y * v[j].y + v[j].z * v[j].z + v[j].w * v[j].w; }
        ss = wave_sum(ss); const float rs = rsqrtf(ss * (1.0f / D) + EPS);
#pragma unroll
        for (int j = 0; j < 4; ++j) { const f32x4 w = ((const f32x4*)ARG(final_norm_w))[j * 64 + K.lane]; o[j * 64 + K.lane] = v[j] * rs * w; }
    }
}

#define XB_TMO      128
#define XB_XSUB(j)  (1280 + 64 * (j))
#define XB_XGEN(j)  (2304 + 64 * (j))
#define XB_TOP      3328
#define XB_TOPGEN   3392
#define XB_SPIN_CAP (1u << 22)
constexpr int CW_BAR = 4096;
DI unsigned xb_ld(unsigned* p)              { return __hip_atomic_load(p, __ATOMIC_RELAXED, __HIP_MEMORY_SCOPE_AGENT); }
DI unsigned xb_add(unsigned* p, unsigned v) { return __hip_atomic_fetch_add(p, v, __ATOMIC_RELAXED, __HIP_MEMORY_SCOPE_AGENT); }
#define XB_SPIN(cond, bar) do { unsigned _sp = 0; while (cond) { __builtin_amdgcn_s_sleep(1); \
    if ((++_sp & 255u) == 0u) { if (xb_ld(&(bar)[XB_TMO])) break; if (_sp > XB_SPIN_CAP) { atomicAdd(&(bar)[XB_TMO], 1u); break; } } } } while (0)
DI void xcd_barrier(unsigned* bar, unsigned x, unsigned nloc, unsigned nx) {
    asm volatile("s_waitcnt vmcnt(0)" ::: "memory");
    __syncthreads();
    if (threadIdx.x == 0) {
        __builtin_amdgcn_s_waitcnt(0);
        const unsigned old = xb_add(&bar[XB_XSUB(x)], 1u);
        const unsigned gen = old / nloc;
        if (old + 1u == (gen + 1u) * nloc) {
            __builtin_amdgcn_fence(__ATOMIC_RELEASE, "agent");
            asm volatile("s_waitcnt vmcnt(0)" ::: "memory");
            const unsigned og = xb_add(&bar[XB_TOP], 1u);
            const unsigned tg = og / nx;
            if (og + 1u == (tg + 1u) * nx) xb_add(&bar[XB_TOPGEN], 1u);
            else XB_SPIN(xb_ld(&bar[XB_TOPGEN]) == tg, bar);
            __builtin_amdgcn_fence(__ATOMIC_ACQUIRE, "agent");
            xb_add(&bar[XB_XGEN(x)], 1u);
            asm volatile("s_waitcnt vmcnt(0)" ::: "memory");
        } else {
            XB_SPIN(xb_ld(&bar[XB_XGEN(x)]) == gen, bar);
            __builtin_amdgcn_fence(__ATOMIC_ACQUIRE, "agent");
            asm volatile("s_waitcnt vmcnt(0)" ::: "memory");
        }
    }
    __syncthreads();
}

constexpr int PROBE_U = 0, PROBE_V = 0, PROBE_S = 0;
constexpr unsigned DUP_MASK = 0u;
constexpr int PH_PER_LAYER = 13, N_PHASES = 2 + PH_PER_LAYER * DEPTH;
__global__ void __launch_bounds__(NTHREADS) mk_fwd(Args args) {
    extern __shared__ __attribute__((aligned(16))) unsigned char lds[];
    cg::grid_group grid = cg::this_grid();
    constexpr unsigned ARGS_OFF = LDS_BYTES - 256;
    constexpr unsigned MISC_OFF = LDS_BYTES - 64;
    if (threadIdx.x == 0) {
        *(Args*)(lds + ARGS_OFF) = args;
        unsigned* ctl = (unsigned*)(args.ws + WS_CTL); unsigned* misc = (unsigned*)(lds + MISC_OFF);
        const unsigned xcc = (unsigned)__builtin_amdgcn_s_getreg((3 << 11) | 20) & 0xFu;
        misc[0] = xcc; misc[1] = __hip_atomic_fetch_add(ctl + 64 * xcc, 1u, __ATOMIC_RELAXED, __HIP_MEMORY_SCOPE_AGENT);
    }
    __syncthreads();
    int rep = 0;
#pragma unroll 1
    for (int ph = 0; ph < N_PHASES; ++ph) {
        int tid = threadIdx.x; asm volatile("" : "+v"(tid));
        unsigned aoff = ARGS_OFF; asm volatile("" : "+v"(aoff));
        size_t zoff = 0; asm volatile("" : "+s"(zoff));
        unsigned char* ws = args.ws + zoff;
        int bid = blockIdx.x; asm volatile("" : "+s"(bid)); int nb = gridDim.x; asm volatile("" : "+s"(nb));
        unsigned moff = MISC_OFF; asm volatile("" : "+v"(moff));
        Ctx K; { const unsigned* misc = (const unsigned*)(lds + moff); K.jx = __builtin_amdgcn_readfirstlane(misc[1]); K.xg = __builtin_amdgcn_readfirstlane(misc[2]); K.nxg = __builtin_amdgcn_readfirstlane(misc[3]); K.nloc = __builtin_amdgcn_readfirstlane(misc[4]); }
        K.aoff = aoff; K.lds = lds; K.tid = tid; K.lane = tid & 63; K.wave = tid >> 6; K.bid = bid; K.nb = nb; K.gw = bid * NWAVES + K.wave; K.ngw = nb * NWAVES;
        K.X = GP(float, ws + WS_X); K.H = GP(bf16_t, ws + WS_H); K.P = GP(bf16_t, ws + WS_P); K.QP = K.P; K.MIX = GP(bf16_t, ws + WS_MIX); K.OF = GP(float, ws + WS_OF); K.OB = GP(float, ws + WS_OB);
        K.PIDX = GP(int, ws + WS_PIDX); K.PG = GP(float, ws + WS_PG); K.MOD = GP(float, ws + WS_MOD); K.LB = GP(float, ws + WS_LB); K.ROPE = GP(float, ws + WS_ROPE); K.WIN = GP(bf16_t, ws + WS_WIN); K.WOUT = GP(bf16_t, ws + WS_WOUT); K.WQ = GP(bf16_t, ws + WS_WQ);
        K.UB = GP(bf16_t, ws + WS_UB); K.ST = GP(float, ws + WS_OF); K.AC = GP(float, ws + WS_AC); K.PA = GP(float, ws + WS_PA); K.VS = GP(float, ws + WS_VS); K.US = GP(float, ws + WS_US); K.SKH = GP(bf16_t, ws + WS_SKH); K.SKL = GP(bf16_t, ws + WS_SKL); K.VB = GP(bf16_t, ws + WS_VB);
        const int l = ph == 0 ? 0 : (ph - 1) / PH_PER_LAYER, k = ph == 0 ? -1 : (ph == N_PHASES - 1 ? -2 : (ph - 1) % PH_PER_LAYER);
        K.l = l;
        if (k == -1) ph_prologue(K);
        else if (k == -2) ph_final(K);
        else if (k == 0) ph_norm(K, ARG(norm_mix_w) + (size_t)l * D, 0);
        else if (k == 1) ph_gemm_store(K, K.H, K.WIN + (size_t)l * PW * D, PW, K.P);
        else if (k == 2) ph_rope(K);
        else if (k == 3) ph_hgrn_A(K);
        else if (k == 4) ph_attn(K);
        else if (k == 5) ph_hgrn_B(K);
        else if (k == 6) ph_hgrn_C(K);
        else if (k == 7) ph_gemm_resid(K, K.MIX, K.WOUT + (size_t)l * D * D, 2);
        else if (k == 8) ph_norm(K, ARG(norm_ffn_w) + (size_t)l * D, 3);
        else if (k == 9) ph_gemm_store(K, K.H, K.WQ + (size_t)l * 2048 * D, 2048, K.QP);
        else if (k == 10) { ph_peer_select<0>(K); if (PROBE_S) ph_peer_select<PROBE_S>(K); }
        else if (k == 11) { ph_peer_u<0>(K); if (PROBE_U) ph_peer_u<PROBE_U>(K); }
        else if (k == 12) { ph_peer_v<0>(K); if (PROBE_V) ph_peer_v<PROBE_V>(K); }
        if (k >= 0 && ((DUP_MASK >> k) & 1u)) { ++rep; if (rep < 2) { --ph; continue; } } rep = 0;
        if (ph == 0) grid.sync();
        else if (k != 3 && ph != N_PHASES - 1) { const unsigned* misc = (const unsigned*)(lds + moff); xcd_barrier((unsigned*)(args.ws + WS_CTL) + CW_BAR, misc[0], misc[4], misc[3]); }
        if (ph == 0) {
            if (threadIdx.x == 0) { unsigned* ctl = (unsigned*)(args.ws + WS_CTL); unsigned* misc = (unsigned*)(lds + MISC_OFF); const unsigned xcc = misc[0]; unsigned ord = 0, npop = 0, mine = 1;
                for (unsigned q = 0; q < 16; ++q) { const unsigned cq = __hip_atomic_load(ctl + 64 * q, __ATOMIC_RELAXED, __HIP_MEMORY_SCOPE_AGENT); if (cq) { ++npop; if (q < xcc) ++ord; } if (q == xcc) mine = cq; }
                misc[2] = ord; misc[3] = npop ? npop : 1u; misc[4] = mine ? mine : 1u; }
            __syncthreads();
        }
    }
}

extern "C" void kernel_launch(void* const* d_in, const int* in_sizes, int n_in, void* d_out, int out_size, void* d_ws, size_t ws_size, hipStream_t stream) {
    static int grid = 0;
    if (grid == 0) {
        if (n_in != 19 || out_size != NLAT * D || ws_size < WS_END) { fprintf(stderr, "kernel_launch: unexpected shapes (n_in %d out %d ws %zu need %zu)\n", n_in, out_size, ws_size, (size_t)WS_END); grid = -1; return; }
        int dev = 0, cus = 0, per_cu = 0;
        (void)hipGetDevice(&dev); (void)hipDeviceGetAttribute(&cus, hipDeviceAttributeMultiprocessorCount, dev);
        (void)hipFuncSetAttribute((const void*)mk_fwd, hipFuncAttributeMaxDynamicSharedMemorySize, LDS_BYTES);
        (void)hipOccupancyMaxActiveBlocksPerMultiprocessor(&per_cu, (const void*)mk_fwd, NTHREADS, LDS_BYTES);
        if (per_cu < 1) { fprintf(stderr, "kernel_launch: occupancy query says %d blocks/CU\n", per_cu); grid = -1; return; }
        grid = (cus / 8) * 8;
    }
    if (grid < 0) return;
    Args a{};
    a.x = (const float*)d_in[0]; a.c = (const float*)d_in[1]; a.ctx = (const float*)d_in[2]; a.c_ctx = (const float*)d_in[3]; a.w_mod = (const float*)d_in[4]; a.b_mod = (const float*)d_in[5];
    a.norm_mix_w = (const float*)d_in[6]; a.norm_ffn_w = (const float*)d_in[7]; a.w_in = (const float*)d_in[8]; a.lb_logits = (const float*)d_in[9]; a.hgrn_norm_w = (const float*)d_in[10];
    a.swa_sink = (const float*)d_in[11]; a.nat_rpb = (const float*)d_in[12]; a.w_out = (const float*)d_in[13]; a.peer_wq = (const float*)d_in[14]; a.peer_sk = (const float*)d_in[15];
    a.peer_u = (const float*)d_in[16]; a.peer_v = (const float*)d_in[17]; a.final_norm_w = (const float*)d_in[18];
    a.out = (float*)d_out; a.ws = (unsigned char*)d_ws;
    (void)hipMemsetAsync((unsigned char*)d_ws + WS_CTL, 0, CTL_BYTES, stream);
    void* kargs[] = {&a};
    hipError_t e = hipLaunchCooperativeKernel((const void*)mk_fwd, dim3(grid), dim3(NTHREADS), kargs, LDS_BYTES, stream);
    if (e != hipSuccess) fprintf(stderr, "kernel_launch: cooperative launch failed: %s (grid %d)\n", hipGetErrorString(e), grid);
}
```

```cpp
#include <hip/hip_runtime.h>
#include <hip/hip_cooperative_groups.h>
#include <cstdio>
#include <cstdint>
namespace cg = cooperative_groups;
#define DI __device__ __forceinline__
#define GP(T, p) ((T*)(__attribute__((address_space(1))) T*)(p))

typedef unsigned short bf16_t;
typedef float f32x4 __attribute__((ext_vector_type(4)));
typedef unsigned u32x4 __attribute__((ext_vector_type(4)));
typedef unsigned u32x2 __attribute__((ext_vector_type(2)));

constexpr int D = 1024, NB = 2, L = 16384, CL = 256, DEPTH = 4;
constexpr int NCTX = NB * CL, NLAT = NB * L, M = NCTX + NLAT;
constexpr int PW = 3072;
constexpr int C_HQ = 0, C_ZF = 256, C_ZB = 512, C_HV = 768, C_HG = 1024, C_SQ = 1280, C_SK = 1664, C_SV = 1792, C_NQ = 1920, C_NK = 2304, C_NV = 2688;
constexpr int MX_H = 0, MX_S = 256, MX_N = 640;
constexpr float EPS = 1e-6f;
constexpr int NTHREADS = 512, NWAVES = 8;
constexpr int LDS_BYTES = 147456;

constexpr size_t al256(size_t x) { return (x + 255) & ~(size_t)255; }
constexpr size_t WS_X = 0;
constexpr size_t WS_H = WS_X + al256((size_t)M * D * 4);
constexpr size_t WS_P = WS_H + al256((size_t)M * D * 2);
constexpr size_t WS_MIX = WS_P + al256((size_t)M * PW * 2);
constexpr size_t WS_OF = WS_MIX + al256((size_t)M * D * 2);
constexpr size_t WS_OB = WS_OF + al256((size_t)M * 256 * 4);
constexpr size_t WS_PIDX = WS_OB + al256((size_t)M * 256 * 4);
constexpr size_t WS_PG = WS_PIDX + al256((size_t)M * 128 * 4);
constexpr size_t WS_MOD = WS_PG + al256((size_t)M * 128 * 4);
constexpr size_t WS_LB = WS_MOD + al256((size_t)DEPTH * 3 * 6 * D * 4);
constexpr size_t WS_ROPE = WS_LB + al256((size_t)2 * DEPTH * 256 * 4);
constexpr size_t WS_WIN = WS_ROPE + al256((size_t)(256 + 256 + 64 + 64) * 16 * 4);
constexpr size_t WS_WOUT = WS_WIN + al256((size_t)DEPTH * PW * D * 2);
constexpr size_t WS_WQ = WS_WOUT + al256((size_t)DEPTH * D * D * 2);
constexpr size_t WS_AC = WS_WQ + al256((size_t)DEPTH * 2048 * D * 2);
constexpr size_t WS_UB_ = 0; constexpr size_t WS_UB = WS_AC + al256((size_t)16 * 260 * 64 * 4); constexpr size_t WS_UB_OLD = WS_WQ + al256((size_t)DEPTH * 2048 * D * 2);
constexpr size_t WS_VB = WS_UB + al256((size_t)DEPTH * 16384 * D * 2);
constexpr size_t WS_PA = WS_VB + al256((size_t)DEPTH * 16384 * D * 2);
constexpr size_t WS_VS = WS_PA + al256((size_t)M * 128 * 4);
constexpr size_t WS_US = WS_VS + al256((size_t)DEPTH * 16384 * 4);
constexpr size_t WS_H8 = WS_US + al256((size_t)DEPTH * 16384 * 4);
constexpr size_t WS_HS = WS_H8 + al256((size_t)M * D);
constexpr size_t WS_SKH = WS_HS + al256((size_t)M * 4);
constexpr size_t WS_SKL = WS_SKH + al256((size_t)DEPTH * 8 * 2 * 128 * 128 * 2);
constexpr size_t WS_CTL = WS_SKL + al256((size_t)DEPTH * 8 * 2 * 128 * 128 * 2);
constexpr size_t CTL_BYTES = 65536;
constexpr size_t WS_END = WS_CTL + CTL_BYTES;

struct Args {
    const float *x, *c, *ctx, *c_ctx, *w_mod, *b_mod, *norm_mix_w, *norm_ffn_w, *w_in, *lb_logits, *hgrn_norm_w, *swa_sink, *nat_rpb, *w_out, *peer_wq, *peer_sk, *peer_u, *peer_v, *final_norm_w;
    float* out; unsigned char* ws;
};

DI float bf2f(bf16_t v) { return __uint_as_float((unsigned)v << 16); }
DI bf16_t f2bf(float f) { unsigned u = __float_as_uint(f); return (bf16_t)((u + 0x7fffu + ((u >> 16) & 1u)) >> 16); }
DI unsigned pk2(float lo, float hi) { return (unsigned)f2bf(lo) | ((unsigned)f2bf(hi) << 16); }
DI float wave_sum(float v) {
#pragma unroll
    for (int o = 1; o < 64; o <<= 1) v += __shfl_xor(v, o);
    return v;
}
typedef __bf16 bf16x2_t __attribute__((ext_vector_type(2)));
DI float dot2bf(unsigned a, unsigned b, float acc) { return __builtin_amdgcn_fdot2_f32_bf16(__builtin_bit_cast(bf16x2_t, a), __builtin_bit_cast(bf16x2_t, b), acc, false); }
template <int CTRL> DI float dpp_(float x) { return __builtin_bit_cast(float, __builtin_amdgcn_mov_dpp(__builtin_bit_cast(int, x), CTRL, 0xf, 0xf, true)); }
DI float wave_sum_fast(float x) {
    x += dpp_<0xB1>(x); x += dpp_<0x4E>(x); x += dpp_<0x141>(x); x += dpp_<0x128>(x);
    auto s1 = __builtin_amdgcn_permlane16_swap(__float_as_uint(x), __float_as_uint(x), false, false); x = __uint_as_float(s1[0]) + __uint_as_float(s1[1]);
    auto s2 = __builtin_amdgcn_permlane32_swap(__float_as_uint(x), __float_as_uint(x), false, false); return __uint_as_float(s2[0]) + __uint_as_float(s2[1]);
}
DI float sigmoidf_(float z) { return 1.0f / (1.0f + __expf(-z)); }
DI float gelu_erf(float v) { return 0.5f * v * (1.0f + erff(v * 0.70710678118654752f)); }
DI int modvec_of_row(int r) { return r < NCTX ? 2 : (r - NCTX) / L; }
DI int batch_of_row(int r) { return r < NCTX ? r / CL : (r - NCTX) / L; }
DI int lat_row(int b, int t) { return NCTX + b * L + t; }
DI int ctx_row(int b, int s) { return b * CL + s; }
DI void unpack8(const u32x4 w, float* o) {
    o[0] = __uint_as_float(w.x << 16); o[1] = __uint_as_float(w.x & 0xffff0000u);
    o[2] = __uint_as_float(w.y << 16); o[3] = __uint_as_float(w.y & 0xffff0000u);
    o[4] = __uint_as_float(w.z << 16); o[5] = __uint_as_float(w.z & 0xffff0000u);
    o[6] = __uint_as_float(w.w << 16); o[7] = __uint_as_float(w.w & 0xffff0000u);
}
DI void load_row64(const bf16_t* p, float (&o)[64]) {
#pragma unroll
    for (int i = 0; i < 8; ++i) { const u32x4 w = *(const u32x4*)(p + 8 * i); unpack8(w, &o[8 * i]); }
}
DI void rope64(float (&x)[64], const float* cr, const float* sr, const float* cc, const float* sc) {
#pragma unroll
    for (int i = 0; i < 16; ++i) {
        const float c1 = cr[i], s1 = sr[i], a = x[i], b = x[16 + i];
        x[i] = a * c1 - b * s1; x[16 + i] = b * c1 + a * s1;
        const float c2 = cc[i], s2 = sc[i], e = x[32 + i], f = x[48 + i];
        x[32 + i] = e * c2 - f * s2; x[48 + i] = f * c2 + e * s2;
    }
}

namespace pg8 {
#define PG8_LAS __attribute__((address_space(3)))
typedef unsigned short bf16_t;
typedef short bf16x8 __attribute__((ext_vector_type(8)));
typedef float f32x4 __attribute__((ext_vector_type(4)));
typedef unsigned u32x4 __attribute__((ext_vector_type(4)));
constexpr int BM = 256, BK = 64, HALF = 128, HTB = HALF * BK * 2  , STAGE_BYTES = 8 * HTB, NXCD = 8, WGM = 8;

__host__ __device__ __forceinline__ int lds_byte(int r, int c) { const int st = (r >> 4) * 2 + (c >> 5), rr = r & 15, cc = c & 31, ob = rr * 64 + cc * 2; return st * 1024 + (ob ^ (((ob >> 9) & 1) << 5)); }
__host__ __device__ __forceinline__ void stage_rc(int b, int& R, int& C) { const int st = b / 1024, sb = b % 1024, swz = sb ^ (((sb >> 9) & 1) << 5); R = (st >> 1) * 16 + swz / 64; C = (st & 1) * 32 + (swz % 64) / 2; }
__host__ __device__ __forceinline__ int perm32(int rho) { const int n = rho >> 4, i = rho & 15; return 8 * (i >> 2) + 4 * n + (i & 3); }

struct Unit { int pm, pn; };
struct Gemm { const bf16_t* A; const bf16_t* Bt; int M, N, K; };

struct StaticOrder {
    int nM, nN, nwg, G, c;
    __host__ __device__ void init(int M, int N, int G_, int c_) { nM = M / BM; nN = N / BM; nwg = nM * nN; G = G_; c = c_; }
    __host__ __device__ bool next(int i, Unit& u) const {
        const long L = (long)i * G + c; if (L >= nwg) return false;
        int wgid = (int)L; { const int q = nwg / NXCD, r = nwg % NXCD, xcd = wgid % NXCD, off = wgid / NXCD; wgid = (xcd < r ? xcd * (q + 1) : r * (q + 1) + (xcd - r) * q) + off; }
        const int nig = WGM * nN, gid = wgid / nig, fm = gid * WGM, gsz = (nM - fm) < WGM ? (nM - fm) : WGM;
        u.pm = fm + ((wgid % nig) % gsz); u.pn = (wgid % nig) / gsz; return true;
    }
    __device__ __forceinline__ void a_ready(const Unit&) const {}
    __device__ __forceinline__ void done(const Unit&) const {}
};


__device__ __forceinline__ unsigned cvt_pk_bf16(float lo, float hi) { unsigned r; asm volatile("v_cvt_pk_bf16_f32 %0, %1, %2" : "=v"(r) : "v"(lo), "v"(hi)); return r; }
struct EpiStore {
    static constexpr bool PERM = true, AFTER_DRAIN = false;
    bf16_t* O; int ldc;
    __device__ __forceinline__ void operator()(const f32x4 (&acc)[2][2][4][2], const Unit& u, int wr, int wc, int fr, int fq) const {
        const int row0 = u.pm * BM + wr * 64 + fr, col0 = u.pn * BM + wc * 32 + 8 * fq;
#pragma unroll
        for (int ai = 0; ai < 2; ++ai)
#pragma unroll
            for (int m = 0; m < 4; ++m) { bf16_t* rowp = O + (size_t)(row0 + ai * HALF + m * 16) * ldc + col0;
#pragma unroll
                for (int bj = 0; bj < 2; ++bj) { const f32x4 v0 = acc[ai][bj][m][0], v1 = acc[ai][bj][m][1];
                    u32x4 w; w.x = cvt_pk_bf16(v0[0], v0[1]); w.y = cvt_pk_bf16(v0[2], v0[3]); w.z = cvt_pk_bf16(v1[0], v1[1]); w.w = cvt_pk_bf16(v1[2], v1[3]);
                    *(u32x4*)(rowp + bj * HALF) = w; } }
    }
};
struct EpiResid {
    static constexpr bool PERM = false, AFTER_DRAIN = false;
    float* X; int ldc; const float* gate; int gstride, nctx, seqlen;
    __device__ __forceinline__ void operator()(const f32x4 (&acc)[2][2][4][2], const Unit& u, int wr, int wc, int fr, int fq) const {
        const int col0 = u.pn * BM + wc * 32 + 4 * fq;
#pragma unroll
        for (int ai = 0; ai < 2; ++ai)
#pragma unroll
            for (int m = 0; m < 4; ++m) { const int r = u.pm * BM + ai * HALF + wr * 64 + m * 16 + fr; const int vsel = r < nctx ? 2 : (r - nctx) / seqlen;
                float* xr = X + (size_t)r * ldc + col0; const float* gr = gate + (size_t)vsel * gstride + col0;
#pragma unroll
                for (int bj = 0; bj < 2; ++bj)
#pragma unroll
                    for (int n = 0; n < 2; ++n) { const f32x4 g = *(const f32x4*)(gr + bj * HALF + n * 16); f32x4 x = *(const f32x4*)(xr + bj * HALF + n * 16); x += g * acc[ai][bj][m][n]; *(f32x4*)(xr + bj * HALF + n * 16) = x; } }
    }
};
template <class Epi, class Sched, bool ALIGN_EPI = false, bool SP2 = false>
__device__ __forceinline__ void gemm_phase(PG8_LAS unsigned char* lds, const Gemm g, const Sched& S, const Epi& E) {
    int tid_ = threadIdx.x; asm volatile("" : "+v"(tid_));
    const int tid = tid_, wid = __builtin_amdgcn_readfirstlane(tid >> 6), lane = tid & 63, wr = wid >> 2, wc = wid & 3, fr = lane & 15, fq = lane >> 4;
    const int K = g.K, nt = K / BK;
    unsigned voffA[2], voffB[2];
#pragma unroll
    for (int i = 0; i < 2; ++i) { int R, C; stage_rc(tid * 16 + i * 8192, R, C); const int Rb = Epi::PERM ? ((R & ~31) + perm32(R & 31)) : R;
        voffA[i] = (unsigned)(R * K + C) * 2u; voffB[i] = (unsigned)(Rb * K + C) * 2u; }
    const size_t kstep = (size_t)(BK * 2);
    const size_t hstep = (size_t)HALF * K * 2;
    const size_t tstep = 2 * hstep;
    const unsigned ldsw = (unsigned)wid * 1024u;
    const int aoff = lds_byte(wr * 64 + fr, fq * 8), boff = lds_byte(wc * 32 + fr, fq * 8);
#define PG8_SA(b, h) (((b) * 2 + (h)) * HTB)
#define PG8_SB(b, h) ((4 + (b) * 2 + (h)) * HTB)
#define PG8_STAGE(bufoff, gbase, voff) do { _Pragma("unroll") for (int _i = 0; _i < 2; ++_i) \
        __builtin_amdgcn_global_load_lds((const unsigned*)((const char*)(gbase) + (voff)[_i]), (PG8_LAS unsigned*)(lds + (bufoff) + ldsw + _i * 8192), 16, 0, 0); } while (0)
#define PG8_LDA(dst, b, h) do { _Pragma("unroll") for (int m = 0; m < 4; ++m) _Pragma("unroll") for (int k = 0; k < 2; ++k) dst[m][k] = *(const PG8_LAS bf16x8*)(lds + PG8_SA(b, h) + aoff + m * 2048 + k * 1024); } while (0)
#define PG8_LDB(dst, b, h) do { _Pragma("unroll") for (int n = 0; n < 2; ++n) _Pragma("unroll") for (int k = 0; k < 2; ++k) dst[n][k] = *(const PG8_LAS bf16x8*)(lds + PG8_SB(b, h) + boff + n * 2048 + k * 1024); } while (0)
#define PG8_MMA(ai, bj, At, Bt) do { __builtin_amdgcn_s_setprio(1); _Pragma("unroll") for (int m = 0; m < 4; ++m) _Pragma("unroll") for (int n = 0; n < 2; ++n) _Pragma("unroll") for (int k = 0; k < 2; ++k) \
        acc[ai][bj][m][n] = __builtin_amdgcn_mfma_f32_16x16x32_bf16(Bt[n][k], At[m][k], acc[ai][bj][m][n], 0, 0, 0); __builtin_amdgcn_s_setprio(0); } while (0)
#define PG8_WAIT_V(n) asm volatile("s_waitcnt vmcnt(" #n ")" ::: "memory")
#define PG8_WAIT_L(n) asm volatile("s_waitcnt lgkmcnt(" #n ")" ::: "memory")
#define PG8_BAR __builtin_amdgcn_s_barrier()
#define PG8_SCHED __builtin_amdgcn_sched_barrier(0)
    Unit cur, nxt; int ui = 0;
    if (!S.next(0, cur)) return;
    f32x4 acc[2][2][4][2];
#pragma unroll
    for (int a = 0; a < 2; ++a)
#pragma unroll
        for (int b = 0; b < 2; ++b)
#pragma unroll
            for (int m = 0; m < 4; ++m)
#pragma unroll
                for (int n = 0; n < 2; ++n) acc[a][b][m][n] = (f32x4){0.f, 0.f, 0.f, 0.f};
    bf16x8 At[4][2], B0[2][2], B1[2][2];
    const char* cA = (const char*)g.A + (size_t)cur.pm * tstep; const char* cB = (const char*)g.Bt + (size_t)cur.pn * tstep;
    S.a_ready(cur);
    if constexpr (SP2) {
        PG8_STAGE(PG8_SB(0, 0), cB, voffB); PG8_STAGE(PG8_SB(0, 1), cB + hstep, voffB); PG8_STAGE(PG8_SA(0, 0), cA, voffA); PG8_STAGE(PG8_SA(0, 1), cA + hstep, voffA);
        if (wr == 1) PG8_BAR;
        PG8_WAIT_V(2); PG8_BAR;
        PG8_STAGE(PG8_SB(1, 0), cB + kstep, voffB); PG8_STAGE(PG8_SA(1, 0), cA + kstep, voffA); PG8_STAGE(PG8_SB(1, 1), cB + hstep + kstep, voffB);
        PG8_WAIT_V(6); PG8_BAR;
    } else {
        PG8_STAGE(PG8_SB(0, 0), cB, voffB); PG8_STAGE(PG8_SA(0, 0), cA, voffA); PG8_STAGE(PG8_SB(0, 1), cB + hstep, voffB); PG8_STAGE(PG8_SA(0, 1), cA + hstep, voffA);
        if (wr == 1) PG8_BAR;
        PG8_WAIT_V(4); PG8_BAR;
        PG8_STAGE(PG8_SB(1, 0), cB + kstep, voffB); PG8_STAGE(PG8_SA(1, 0), cA + kstep, voffA); PG8_STAGE(PG8_SB(1, 1), cB + hstep + kstep, voffB);
        PG8_WAIT_V(6); PG8_BAR;
    }
    for (;;) {
        const bool has_next = S.next(ui + 1, nxt);
        const char* nA = has_next ? (const char*)g.A + (size_t)nxt.pm * tstep : cA; const char* nB = has_next ? (const char*)g.Bt + (size_t)nxt.pn * tstep : cB;
        for (int t = 0; t < nt; t += 2) {
            const bool last = (t == nt - 2);
            const char* a1 = cA + (size_t)(t + 1) * kstep;
            const char* a2 = last ? nA : cA + (size_t)(t + 2) * kstep; const char* b2 = last ? nB : cB + (size_t)(t + 2) * kstep;
            const char* a3 = a2 + kstep; const char* b3 = b2 + kstep;
            if (last && has_next) S.a_ready(nxt);
            if constexpr (SP2) {
            PG8_LDB(B0, 0, 0); PG8_LDB(B1, 0, 1); PG8_SCHED; PG8_LDA(At, 0, 0); PG8_STAGE(PG8_SA(1, 1), a1 + hstep, voffA);
            PG8_WAIT_V(8); PG8_WAIT_L(0); PG8_BAR; PG8_MMA(0, 0, At, B0); PG8_MMA(0, 1, At, B1); PG8_BAR; PG8_SCHED;
            PG8_LDA(At, 0, 1); PG8_STAGE(PG8_SB(0, 0), b2, voffB); PG8_STAGE(PG8_SB(0, 1), b2 + hstep, voffB); PG8_STAGE(PG8_SA(0, 0), a2, voffA);
            PG8_WAIT_V(8); PG8_WAIT_L(0); PG8_BAR; PG8_MMA(1, 0, At, B0); PG8_MMA(1, 1, At, B1); PG8_BAR; PG8_SCHED;
            PG8_LDB(B0, 1, 0); PG8_LDB(B1, 1, 1); PG8_SCHED; PG8_LDA(At, 1, 0); PG8_STAGE(PG8_SA(0, 1), a2 + hstep, voffA);
            PG8_WAIT_V(8); PG8_WAIT_L(0); PG8_BAR; PG8_MMA(0, 0, At, B0); PG8_MMA(0, 1, At, B1); PG8_BAR; PG8_SCHED;
            PG8_LDA(At, 1, 1); PG8_STAGE(PG8_SB(1, 0), b3, voffB); PG8_STAGE(PG8_SB(1, 1), b3 + hstep, voffB); PG8_STAGE(PG8_SA(1, 0), a3, voffA);
            PG8_WAIT_V(8); PG8_WAIT_L(0); PG8_BAR; PG8_MMA(1, 0, At, B0); PG8_MMA(1, 1, At, B1); PG8_BAR; PG8_SCHED;
            } else {
            PG8_LDB(B0, 0, 0); PG8_SCHED; PG8_LDA(At, 0, 0); PG8_STAGE(PG8_SA(1, 1), a1 + hstep, voffA);
            PG8_WAIT_L(8); PG8_BAR; PG8_WAIT_L(0); PG8_MMA(0, 0, At, B0); PG8_BAR; PG8_SCHED;
            PG8_LDB(B1, 0, 1); PG8_STAGE(PG8_SB(0, 0), b2, voffB);
            PG8_BAR; PG8_WAIT_L(0); PG8_MMA(0, 1, At, B1); PG8_BAR;
            PG8_LDA(At, 0, 1); PG8_STAGE(PG8_SA(0, 0), a2, voffA);
            PG8_BAR; PG8_WAIT_L(0); PG8_MMA(1, 0, At, B0); PG8_BAR; PG8_SCHED;
            PG8_STAGE(PG8_SB(0, 1), b2 + hstep, voffB);
            PG8_WAIT_V(6); PG8_BAR; PG8_MMA(1, 1, At, B1); PG8_BAR;
            PG8_LDB(B0, 1, 0); PG8_SCHED; PG8_LDA(At, 1, 0); PG8_STAGE(PG8_SA(0, 1), a2 + hstep, voffA);
            PG8_WAIT_L(8); PG8_BAR; PG8_WAIT_L(0); PG8_MMA(0, 0, At, B0); PG8_BAR; PG8_SCHED;
            PG8_LDB(B1, 1, 1); PG8_STAGE(PG8_SB(1, 0), b3, voffB);
            PG8_BAR; PG8_WAIT_L(0); PG8_MMA(0, 1, At, B1); PG8_BAR;
            PG8_LDA(At, 1, 1); PG8_STAGE(PG8_SA(1, 0), a3, voffA);
            PG8_BAR; PG8_WAIT_L(0); PG8_MMA(1, 0, At, B0); PG8_BAR; PG8_SCHED;
            PG8_STAGE(PG8_SB(1, 1), b3 + hstep, voffB);
            PG8_WAIT_V(6); PG8_BAR; PG8_MMA(1, 1, At, B1); PG8_BAR;
            }
        }
        if constexpr (ALIGN_EPI) { if (wr == 0) PG8_BAR; }
        if constexpr (!Epi::AFTER_DRAIN) { E(acc, cur, wr, wc, fr, fq); S.done(cur); }
        if (!has_next) break;
#pragma unroll
        for (int a = 0; a < 2; ++a)
#pragma unroll
            for (int b = 0; b < 2; ++b)
#pragma unroll
                for (int m = 0; m < 4; ++m)
#pragma unroll
                    for (int n = 0; n < 2; ++n) acc[a][b][m][n] = (f32x4){0.f, 0.f, 0.f, 0.f};
        cur = nxt; cA = nA; cB = nB; ++ui;
        if constexpr (ALIGN_EPI) { if (wr == 1) PG8_BAR; }
    }
    PG8_WAIT_V(0);
    if constexpr (!ALIGN_EPI) { if (wr == 0) PG8_BAR; }
    PG8_BAR;
    if constexpr (Epi::AFTER_DRAIN) { E.fused(acc, cur, wr, wc, fr, fq, lds, wid, lane); S.done(cur); }
#undef PG8_SA
#undef PG8_SB
#undef PG8_STAGE
#undef PG8_LDA
#undef PG8_LDB
#undef PG8_MMA
#undef PG8_WAIT_V
#undef PG8_WAIT_L
#undef PG8_BAR
#undef PG8_SCHED
}
}

struct Ctx {
    unsigned aoff; int l;
    unsigned char* ws;
    DI float* X() const { return GP(float, ws + WS_X); }
    DI bf16_t* H() const { return GP(bf16_t, ws + WS_H); }
    DI bf16_t* P() const { return GP(bf16_t, ws + WS_P); }
    DI bf16_t* QP() const { return GP(bf16_t, ws + WS_P); }
    DI bf16_t* MIX() const { return GP(bf16_t, ws + WS_MIX); }
    DI float* OF() const { return GP(float, ws + WS_OF); }
    DI float* OB() const { return GP(float, ws + WS_OB); }
    DI int* PIDX() const { return GP(int, ws + WS_PIDX); }
    DI float* PG() const { return GP(float, ws + WS_PG); }
    DI float* MOD() const { return GP(float, ws + WS_MOD); }
    DI float* LB() const { return GP(float, ws + WS_LB); }
    DI float* ROPE() const { return GP(float, ws + WS_ROPE); }
    DI bf16_t* WIN() const { return GP(bf16_t, ws + WS_WIN); }
    DI bf16_t* WOUT() const { return GP(bf16_t, ws + WS_WOUT); }
    DI bf16_t* WQ() const { return GP(bf16_t, ws + WS_WQ); }
    DI bf16_t* UB() const { return GP(bf16_t, ws + WS_UB); }
    DI float* ST() const { return GP(float, ws + WS_OF); }
    DI float* AC() const { return GP(float, ws + WS_AC); }
    DI float* PA() const { return GP(float, ws + WS_PA); }
    DI float* VS() const { return GP(float, ws + WS_VS); }
    DI float* US() const { return GP(float, ws + WS_US); }
    DI bf16_t* SKH() const { return GP(bf16_t, ws + WS_SKH); }
    DI bf16_t* SKL() const { return GP(bf16_t, ws + WS_SKL); }
    DI bf16_t* VB() const { return GP(bf16_t, ws + WS_VB); }
    DI unsigned char* H8() const { return GP(unsigned char, ws + WS_H8); }
    DI float* HS() const { return GP(float, ws + WS_HS); }
    unsigned char* lds; int tid, lane, wave, gw, ngw, bid, nb;
    int xg, nxg, jx, nloc;
};

#define LAS __attribute__((address_space(3)))
DI void transpose_item(const float* W, int Kd, int N, bf16_t* WT, LAS float* scr, int item, int lane) {
    const int nblk = N / 32, kb = item / nblk, nb = item % nblk, k0 = 64 * kb, n0 = 32 * nb;
#pragma unroll 8
    for (int i = 0; i < 32; ++i) { const int kk = 2 * i + (lane >> 5); scr[kk * 33 + (lane & 31)] = W[(size_t)(k0 + kk) * N + n0 + (lane & 31)]; }
    asm volatile("s_waitcnt lgkmcnt(0)" ::: "memory");
    const int c = lane & 7;
#pragma unroll
    for (int j = 0; j < 4; ++j) { const int n = (lane >> 3) + 8 * j; const LAS float* sp = scr + (8 * c) * 33 + n;
        u32x4 o; o.x = pk2(sp[0 * 33], sp[1 * 33]); o.y = pk2(sp[2 * 33], sp[3 * 33]); o.z = pk2(sp[4 * 33], sp[5 * 33]); o.w = pk2(sp[6 * 33], sp[7 * 33]);
        *(u32x4*)(WT + (size_t)(n0 + n) * Kd + k0 + 8 * c) = o; }
    asm volatile("s_waitcnt lgkmcnt(0)" ::: "memory");
}

template <class T> DI T* argp_(const Ctx& K, unsigned off) {
    const unsigned* p = (const unsigned*)(K.lds + K.aoff + off);
    const unsigned lo = __builtin_amdgcn_readfirstlane(p[0]), hi = __builtin_amdgcn_readfirstlane(p[1]);
    return GP(T, ((unsigned long long)hi << 32) | (unsigned long long)lo);
}
#define ARG(f) argp_<const float>(K, (unsigned)__builtin_offsetof(Args, f))

DI void ph_prologue(Ctx& K) {
    {
        LAS float* scr = (LAS float*)((LAS unsigned char*)K.lds + K.wave * 16384);
        constexpr int I_IN = (D / 64) * (PW / 32), I_OUT = (D / 64) * (D / 32), I_Q = (D / 64) * (2048 / 32), I_L = I_IN + I_OUT + I_Q;
        for (int it = K.gw; it < DEPTH * I_L; it += K.ngw) {
            const int l = it / I_L; int r = it % I_L;
            if (r < I_IN) { transpose_item(ARG(w_in) + (size_t)l * D * PW, D, PW, K.WIN() + (size_t)l * PW * D, scr, r, K.lane); continue; } r -= I_IN;
            if (r < I_OUT) { transpose_item(ARG(w_out) + (size_t)l * D * D, D, D, K.WOUT() + (size_t)l * D * D, scr, r, K.lane); continue; } r -= I_OUT;
            transpose_item(ARG(peer_wq) + (size_t)l * D * 2048, D, 2048, K.WQ() + (size_t)l * 2048 * D, scr, r, K.lane);
        }
    }
    const size_t gt = (size_t)K.bid * NTHREADS + K.tid, gs = (size_t)K.nb * NTHREADS;
    { const f32x4* s0 = (const f32x4*)ARG(ctx); const f32x4* s1 = (const f32x4*)ARG(x); f32x4* d = (f32x4*)K.X();
      const size_t n0 = (size_t)NCTX * D / 4, n1 = (size_t)NLAT * D / 4;
      for (size_t i = gt; i < n0 + n1; i += gs) d[i] = i < n0 ? s0[i] : s1[i - n0]; }
    { const float* sk = ARG(peer_sk);
      for (size_t i = gt; i < (size_t)DEPTH * 8 * 2 * 128 * 128; i += gs) { const float v = sk[i]; const bf16_t hi = f2bf(v); K.SKH()[i] = hi; K.SKL()[i] = f2bf(v - bf2f(hi)); } }
    { const float* pu = ARG(peer_u); unsigned char* UQ = (unsigned char*)K.UB();
      for (int row = K.gw; row < DEPTH * 16384; row += K.ngw) {
          const f32x4* src = (const f32x4*)(pu + (size_t)row * D); f32x4 v[4]; float mx = 0.f;
#pragma unroll
          for (int j = 0; j < 4; ++j) { v[j] = src[j * 64 + K.lane]; mx = fmaxf(mx, fmaxf(fmaxf(fabsf(v[j].x), fabsf(v[j].y)), fmaxf(fabsf(v[j].z), fabsf(v[j].w)))); }
#pragma unroll
          for (int o = 1; o < 64; o <<= 1) mx = fmaxf(mx, __shfl_xor(mx, o));
          const float sc = fmaxf(mx, 1e-30f) * (1.0f / 127.0f), inv = 1.0f / sc;
          if (K.lane == 0) K.US()[row] = sc;
#pragma unroll
          for (int j = 0; j < 4; ++j) { const int col = j * 256 + K.lane * 4;
              const unsigned q0 = (unsigned)((int)rintf(v[j].x * inv)) & 0xffu, q1 = (unsigned)((int)rintf(v[j].y * inv)) & 0xffu, q2 = (unsigned)((int)rintf(v[j].z * inv)) & 0xffu, q3 = (unsigned)((int)rintf(v[j].w * inv)) & 0xffu;
              *(unsigned*)(UQ + (size_t)row * D + col) = q0 | (q1 << 8) | (q2 << 16) | (q3 << 24); } } }
    { const float* pv = ARG(peer_v); unsigned char* VQ = (unsigned char*)K.VB();
      for (int row = K.gw; row < DEPTH * 16384; row += K.ngw) {
          const f32x4* src = (const f32x4*)(pv + (size_t)row * D); f32x4 v[4]; float mx = 0.f;
#pragma unroll
          for (int j = 0; j < 4; ++j) { v[j] = src[j * 64 + K.lane]; mx = fmaxf(mx, fmaxf(fmaxf(fabsf(v[j].x), fabsf(v[j].y)), fmaxf(fabsf(v[j].z), fabsf(v[j].w)))); }
#pragma unroll
          for (int o = 1; o < 64; o <<= 1) mx = fmaxf(mx, __shfl_xor(mx, o));
          const float sc = fmaxf(mx, 1e-30f) * (1.0f / 127.0f), inv = 1.0f / sc;
          if (K.lane == 0) K.VS()[row] = sc;
          const int l = row >> 14, e = row & 16383;
#pragma unroll
          for (int j = 0; j < 4; ++j) { const int col = j * 256 + K.lane * 4;
              const unsigned q0 = (unsigned)((int)rintf(v[j].x * inv) + 128), q1 = (unsigned)((int)rintf(v[j].y * inv) + 128), q2 = (unsigned)((int)rintf(v[j].z * inv) + 128), q3 = (unsigned)((int)rintf(v[j].w * inv) + 128);
              *(unsigned*)(VQ + (((size_t)l * 8 + (col >> 7)) * 16384 + e) * 128 + (col & 127)) = q0 | (q1 << 8) | (q2 << 16) | (q3 << 24); } } }
    { float* sv = (float*)K.lds;
      float* part = sv + 3 * D;
      __syncthreads();
      for (int i = K.tid; i < 3 * D; i += NTHREADS) { const int v = i / D, k = i % D; const float c = v < 2 ? ARG(c)[v * D + k] : ARG(c_ctx)[k]; sv[i] = c * sigmoidf_(c); }
      __syncthreads();
      for (int item = K.bid; item < DEPTH * 24; item += K.nb) {
          const int l = item / 24, cb = item % 24;
          const float* w = ARG(w_mod) + (size_t)l * D * 6 * D + cb * 256 + K.lane * 4;
          f32x4 a0 = {0.f, 0.f, 0.f, 0.f}, a1 = a0, a2 = a0;
#pragma unroll 8
          for (int kk = 0; kk < 128; ++kk) { const int k = K.wave * 128 + kk; const f32x4 wv = *(const f32x4*)(w + (size_t)k * 6 * D);
              a0 += wv * sv[k]; a1 += wv * sv[D + k]; a2 += wv * sv[2 * D + k]; }
          *(f32x4*)(part + (K.wave * 3 + 0) * 256 + K.lane * 4) = a0; *(f32x4*)(part + (K.wave * 3 + 1) * 256 + K.lane * 4) = a1; *(f32x4*)(part + (K.wave * 3 + 2) * 256 + K.lane * 4) = a2;
          __syncthreads();
          for (int i = K.tid; i < 768; i += NTHREADS) { const int v = i / 256, cc = i % 256; float sum = 0.f;
#pragma unroll
              for (int w8 = 0; w8 < 8; ++w8) sum += part[(w8 * 3 + v) * 256 + cc];
              const int col = cb * 256 + cc; K.MOD()[((size_t)l * 3 + v) * 6 * D + col] = sum + ARG(b_mod)[(size_t)l * 6 * D + col]; }
          __syncthreads();
      } }
    for (size_t i = gt; i < 2 * 256; i += gs) {
        const int dir = (int)(i / 256), ch = (int)(i % 256);
        float lg[DEPTH], mx = -1e30f;
#pragma unroll
        for (int l = 0; l < DEPTH; ++l) { lg[l] = ARG(lb_logits)[((size_t)dir * DEPTH + l) * 256 + ch]; mx = fmaxf(mx, lg[l]); }
        float s = 0.f;
#pragma unroll
        for (int l = 0; l < DEPTH; ++l) { lg[l] = expf(lg[l] - mx); s += lg[l]; }
        float cum = 0.f;
#pragma unroll
        for (int l = 0; l < DEPTH; ++l) { if (l > 0) cum += lg[l] / s; K.LB()[((size_t)dir * DEPTH + l) * 256 + ch] = cum; }
    }
    for (size_t i = gt; i < (256 + 64) * 16; i += gs) {
        const int pos = (int)(i / 16), f = (int)(i % 16);
        const float inv = powf(10000.0f, -(float)f / 16.0f);
        if (pos < 256) { const float ang = (float)pos * inv; K.ROPE()[pos * 16 + f] = cosf(ang); K.ROPE()[4096 + pos * 16 + f] = sinf(ang); }
        else { const int pc = pos - 256; const float ang = (float)pc * inv; K.ROPE()[8192 + pc * 16 + f] = cosf(ang); K.ROPE()[8192 + 1024 + pc * 16 + f] = sinf(ang); }
    }
}

DI void ph_norm(Ctx& K, const float* nw, int shift_chunk) {
    const float* modl = K.MOD() + (size_t)K.l * 3 * 6 * D;
    for (int r = K.gw; r < M; r += K.ngw) {
        const f32x4* xr = (const f32x4*)(K.X() + (size_t)r * D);
        f32x4 v[4]; float ss = 0.f;
#pragma unroll
        for (int j = 0; j < 4; ++j) { v[j] = xr[j * 64 + K.lane]; ss += v[j].x * v[j].x + v[j].y * v[j].y + v[j].z * v[j].z + v[j].w * v[j].w; }
        ss = wave_sum(ss);
        const float rs = rsqrtf(ss * (1.0f / D) + EPS);
        const float* mv = modl + (size_t)modvec_of_row(r) * 6 * D;
        u32x2* ho = (u32x2*)(K.H() + (size_t)r * D);
#pragma unroll
        for (int j = 0; j < 4; ++j) {
            const int c4 = j * 64 + K.lane;
            const f32x4 w = ((const f32x4*)nw)[c4], sh = ((const f32x4*)(mv + shift_chunk * D))[c4], sc = ((const f32x4*)(mv + (shift_chunk + 1) * D))[c4];
            f32x4 y; y.x = v[j].x * rs * w.x * (1.f + sc.x) + sh.x; y.y = v[j].y * rs * w.y * (1.f + sc.y) + sh.y; y.z = v[j].z * rs * w.z * (1.f + sc.z) + sh.z; y.w = v[j].w * rs * w.w * (1.f + sc.w) + sh.w;
            u32x2 o; o.x = pk2(y.x, y.y); o.y = pk2(y.z, y.w); ho[c4] = o;
            if (shift_chunk == 3) { v[j].x = __uint_as_float(o.x << 16); v[j].y = __uint_as_float(o.x & 0xffff0000u); v[j].z = __uint_as_float(o.y << 16); v[j].w = __uint_as_float(o.y & 0xffff0000u); }
        }
        if (shift_chunk == 3) {
            float mx = 0.f;
#pragma unroll
            for (int j = 0; j < 4; ++j) mx = fmaxf(mx, fmaxf(fmaxf(fabsf(v[j].x), fabsf(v[j].y)), fmaxf(fabsf(v[j].z), fabsf(v[j].w))));
#pragma unroll
            for (int o = 1; o < 64; o <<= 1) mx = fmaxf(mx, __shfl_xor(mx, o));
            const float sc = fmaxf(mx, 1e-30f) * (1.0f / 127.0f), inv = 1.0f / sc;
            if (K.lane == 0) K.HS()[r] = sc;
#pragma unroll
            for (int j = 0; j < 4; ++j) { const unsigned q0 = (unsigned)((int)rintf(v[j].x * inv)) & 0xffu, q1 = (unsigned)((int)rintf(v[j].y * inv)) & 0xffu, q2 = (unsigned)((int)rintf(v[j].z * inv)) & 0xffu, q3 = (unsigned)((int)rintf(v[j].w * inv)) & 0xffu;
                *(unsigned*)(K.H8() + (size_t)r * D + (j * 64 + K.lane) * 4) = q0 | (q1 << 8) | (q2 << 16) | (q3 << 24); }
        }
    }
}

DI void ph_gemm_store(Ctx& K, const bf16_t* A, const bf16_t* Bt, int N, bf16_t* out) {
    pg8::Gemm g{A, Bt, M, N, D}; pg8::StaticOrder S; S.init(M, N, K.nb, K.bid);
    pg8::EpiStore E{out, N};
    pg8::gemm_phase<pg8::EpiStore, pg8::StaticOrder, true, true>((LAS unsigned char*)K.lds, g, S, E);
}
DI void ph_gemm_resid(Ctx& K, const bf16_t* A, const bf16_t* Bt, int chunk) {
    pg8::Gemm g{A, Bt, M, D, D}; pg8::StaticOrder S; S.init(M, D, K.nb, K.bid);
    pg8::EpiResid E{K.X(), D, K.MOD() + (size_t)K.l * 3 * 6 * D + (size_t)chunk * D, 6 * D, NCTX, L};
    pg8::gemm_phase<pg8::EpiResid, pg8::StaticOrder, true, true>((LAS unsigned char*)K.lds, g, S, E);
}

DI void ph_rope(Ctx& K) {
    const float* cosr = K.ROPE(); const float* sinr = K.ROPE() + 4096; const float* cosc = K.ROPE() + 8192; const float* sinc = K.ROPE() + 8192 + 1024;
    const size_t gt = (size_t)K.bid * NTHREADS + K.tid, gs = (size_t)K.nb * NTHREADS;
    for (size_t i = gt; i < (size_t)NLAT * 8 * 16; i += gs) {
        const int f = (int)(i & 15), hh = (int)((i >> 4) & 7), lr = (int)(i >> 7);
        const int t = lr % L, pr = t >> 6, pc = t & 63;
        bf16_t* p = K.P() + (size_t)(NCTX + lr) * PW + (hh < 6 ? C_SQ + hh * 64 : C_SK + (hh - 6) * 64);
        const float c1 = cosr[pr * 16 + f], s1 = sinr[pr * 16 + f], c2 = cosc[pc * 16 + f], s2 = sinc[pc * 16 + f];
        const float a = bf2f(p[f]), b = bf2f(p[16 + f]), e = bf2f(p[32 + f]), g = bf2f(p[48 + f]);
        p[f] = f2bf(a * c1 - b * s1); p[16 + f] = f2bf(b * c1 + a * s1); p[32 + f] = f2bf(e * c2 - g * s2); p[48 + f] = f2bf(g * c2 + e * s2);
    }
}

typedef short bf16x8_t __attribute__((ext_vector_type(8)));
#define MFMA16(a, b, c) __builtin_amdgcn_mfma_f32_16x16x32_bf16((a), (b), (c), 0, 0, 0)
constexpr int HG_NCH = (CL + L) / 64;
constexpr int HG_LFS = 68;
constexpr int HG_TS = 72;
constexpr int HGL_LF = 0, HGL_OM = HGL_LF + 2 * 64 * HG_LFS * 4, HGL_VT = HGL_OM + 2 * 64 * HG_LFS * 4, HGL_KT = HGL_VT + 64 * HG_TS * 2, HGL_SC = HGL_KT, HGL_OD = HGL_SC + 8 * 16 * HG_TS * 2, HGL_END = HGL_OD + 2 * 64 * HG_LFS * 4;
static_assert(HGL_KT + 2 * 64 * HG_TS * 2 <= LDS_BYTES && HGL_END <= LDS_BYTES, "hgrn LDS map");
DI int hg_block_row(int b, int tb, int tok) { return tb < 4 ? ctx_row(b, tb * 64 + tok) : lat_row(b, (tb - 4) * 64 + tok); }
DI int hg_bwd_chunk(int tb) { return tb < 4 ? 3 - tb : 4 + 255 - (tb - 4); }
DI void hg_prep(Ctx& K, int b, int h, int tb) {
    float* LF = (float*)(K.lds + HGL_LF); float* OM = (float*)(K.lds + HGL_OM); bf16_t* VT = (bf16_t*)(K.lds + HGL_VT);
    const int tok = K.tid >> 3, c = K.tid & 7;
    const bf16_t* pr = K.P() + (size_t)hg_block_row(b, tb, tok) * PW + h * 64 + 8 * c;
#pragma unroll
    for (int dir = 0; dir < 2; ++dir) {
        float z[8]; unpack8(*(const u32x4*)(pr + (dir ? C_ZB : C_ZF)), z);
        const float* lb = K.LB() + ((size_t)dir * DEPTH + K.l) * 256 + h * 64 + 8 * c;
        float lf[8], om[8];
#pragma unroll
        for (int j = 0; j < 8; ++j) { const float lbv = lb[j], sg = sigmoidf_(z[j]); const float f = fmaxf(lbv + (1.f - lbv) * sg, 1e-30f); lf[j] = __logf(f); om[j] = (1.f - lbv) * (1.f - sg); }
        float* lfp = LF + (dir * 64 + tok) * HG_LFS + 8 * c; float* omp = OM + (dir * 64 + tok) * HG_LFS + 8 * c;
        *(f32x4*)lfp = (f32x4){lf[0], lf[1], lf[2], lf[3]}; *(f32x4*)(lfp + 4) = (f32x4){lf[4], lf[5], lf[6], lf[7]};
        *(f32x4*)omp = (f32x4){om[0], om[1], om[2], om[3]}; *(f32x4*)(omp + 4) = (f32x4){om[4], om[5], om[6], om[7]};
    }
    { const u32x4 v = *(const u32x4*)(pr + C_HV);
      const unsigned w[4] = {v.x, v.y, v.z, v.w};
#pragma unroll
      for (int j = 0; j < 4; ++j) { VT[(8 * c + 2 * j) * HG_TS + tok] = (bf16_t)(w[j] & 0xffffu); VT[(8 * c + 2 * j + 1) * HG_TS + tok] = (bf16_t)(w[j] >> 16); } }
    __syncthreads();
    if (K.tid < 128) {
        const int dir = K.tid >> 6, d = K.tid & 63; float* col = LF + dir * 64 * HG_LFS + d;
        float v[64];
#pragma unroll
        for (int p = 0; p < 64; ++p) v[p] = col[(dir ? 63 - p : p) * HG_LFS];
#pragma unroll
        for (int p = 1; p < 64; ++p) v[p] += v[p - 1];
#pragma unroll
        for (int p = 0; p < 64; ++p) col[(dir ? 63 - p : p) * HG_LFS] = v[p];
    }
    __syncthreads();
}
DI void ph_hgrn_A(Ctx& K) {
    float* LF = (float*)(K.lds + HGL_LF); float* OM = (float*)(K.lds + HGL_OM); bf16_t* VT = (bf16_t*)(K.lds + HGL_VT); bf16_t* KT = (bf16_t*)(K.lds + HGL_KT);
    const int r16 = K.lane & 15, g4 = K.lane >> 4;
    for (int item = K.bid; item < NB * 4 * HG_NCH; item += K.nb) {
        const int tb = item % HG_NCH, h = (item / HG_NCH) & 3, b = item / (HG_NCH * 4);
        __syncthreads();
        hg_prep(K, b, h, tb);
        { const int tok = K.tid >> 3, c = K.tid & 7;
#pragma unroll
          for (int dir = 0; dir < 2; ++dir) {
              const float* bl = LF + (dir * 64 + (dir ? 0 : 63)) * HG_LFS + 8 * c; const float* bt = LF + (dir * 64 + tok) * HG_LFS + 8 * c; const float* om = OM + (dir * 64 + tok) * HG_LFS + 8 * c;
#pragma unroll
              for (int j = 0; j < 8; ++j) KT[(dir * 64 + 8 * c + j) * HG_TS + tok] = f2bf(om[j] * __expf(bl[j] - bt[j]));
          }
          if (K.tid < 128) { const int dir = K.tid >> 6, d = K.tid & 63; const int chain = (b * 2 + dir) * 4 + h, ch = dir ? hg_bwd_chunk(tb) : tb;
              K.AC()[((size_t)chain * HG_NCH + ch) * 64 + d] = __expf(LF[(dir * 64 + (dir ? 0 : 63)) * HG_LFS + d]); } }
        __syncthreads();
        { const int dir = K.wave >> 2, mi = K.wave & 3; const int chain = (b * 2 + dir) * 4 + h, ch = dir ? hg_bwd_chunk(tb) : tb;
          f32x4 acc[4];
#pragma unroll
          for (int nj = 0; nj < 4; ++nj) acc[nj] = (f32x4){0.f, 0.f, 0.f, 0.f};
#pragma unroll
          for (int ks = 0; ks < 2; ++ks) {
              const bf16x8_t av = *(const bf16x8_t*)(VT + (16 * mi + r16) * HG_TS + 32 * ks + 8 * g4);
#pragma unroll
              for (int nj = 0; nj < 4; ++nj) { const bf16x8_t bv = *(const bf16x8_t*)(KT + (dir * 64 + 16 * nj + r16) * HG_TS + 32 * ks + 8 * g4); acc[nj] = MFMA16(av, bv, acc[nj]); }
          }
          float* st = K.ST() + ((size_t)chain * HG_NCH + ch) * 4096;
#pragma unroll
          for (int nj = 0; nj < 4; ++nj)
#pragma unroll
              for (int rg = 0; rg < 4; ++rg) st[(16 * mi + 4 * g4 + rg) * 64 + 16 * nj + r16] = acc[nj][rg];
        }
    }
}
DI void ph_hgrn_B(Ctx& K) {
    const int gt = K.bid * NTHREADS + K.tid;
    if (gt < 16 * 4096) {
        const int chain = gt >> 12, idx = gt & 4095, d = idx & 63;
        float* st = K.ST() + (size_t)chain * HG_NCH * 4096 + idx; const float* ac = K.AC() + (size_t)chain * HG_NCH * 64 + d;
        float S = 0.f;
#pragma unroll 1
        for (int c0 = 0; c0 < HG_NCH; c0 += 10) {
            float u[10], a[10];
#pragma unroll
            for (int i = 0; i < 10; ++i) { u[i] = st[(size_t)(c0 + i) * 4096]; a[i] = ac[(c0 + i) * 64]; }
#pragma unroll
            for (int i = 0; i < 10; ++i) { st[(size_t)(c0 + i) * 4096] = S; S = a[i] * S + u[i]; }
        }
    }
}
DI void ph_hgrn_C(Ctx& K) {
    float* LF = (float*)(K.lds + HGL_LF); float* OM = (float*)(K.lds + HGL_OM); bf16_t* VT = (bf16_t*)(K.lds + HGL_VT); float* OD = (float*)(K.lds + HGL_OD);
    bf16_t* SC = (bf16_t*)(K.lds + HGL_SC) + K.wave * 16 * HG_TS;
    const int r16 = K.lane & 15, g4 = K.lane >> 4;
    for (int item = K.bid; item < NB * 4 * HG_NCH; item += K.nb) {
        const int tb = item % HG_NCH, h = (item / HG_NCH) & 3, b = item / (HG_NCH * 4);
        __syncthreads();
        hg_prep(K, b, h, tb);
        { const int dir = K.wave >> 2, mi = K.wave & 3; const int chain = (b * 2 + dir) * 4 + h, ch = dir ? hg_bwd_chunk(tb) : tb;
          const float* LFd = LF + dir * 64 * HG_LFS; const float* OMd = OM + dir * 64 * HG_LFS; const float* ref = LFd + 32 * HG_LFS;
          bf16x8_t aq1[2], aq2[2];
          { const int t = 16 * mi + r16; const bf16_t* qr = K.P() + (size_t)hg_block_row(b, tb, t) * PW + C_HQ + h * 64;
#pragma unroll
            for (int ks = 0; ks < 2; ++ks) { const int d0 = 32 * ks + 8 * g4; float q[8]; unpack8(*(const u32x4*)(qr + d0), q);
                u32x4 w1, w2; unsigned o1[4], o2[4];
#pragma unroll
                for (int j = 0; j < 4; ++j) { float x1[2], x2[2];
#pragma unroll
                    for (int e = 0; e < 2; ++e) { const int dd = d0 + 2 * j + e; const float qs = q[2 * j + e] * sigmoidf_(q[2 * j + e]); const float bt = LFd[t * HG_LFS + dd]; x1[e] = qs * __expf(bt - ref[dd]); x2[e] = qs * __expf(bt); }
                    o1[j] = pk2(x1[0], x1[1]); o2[j] = pk2(x2[0], x2[1]); }
                w1 = (u32x4){o1[0], o1[1], o1[2], o1[3]}; w2 = (u32x4){o2[0], o2[1], o2[2], o2[3]};
                aq1[ks] = __builtin_bit_cast(bf16x8_t, w1); aq2[ks] = __builtin_bit_cast(bf16x8_t, w2); } }
          f32x4 sc[4];
#pragma unroll
          for (int nj = 0; nj < 4; ++nj) { sc[nj] = (f32x4){0.f, 0.f, 0.f, 0.f}; const int s_ = 16 * nj + r16;
#pragma unroll
              for (int ks = 0; ks < 2; ++ks) { const int d0 = 32 * ks + 8 * g4; unsigned o[4];
#pragma unroll
                  for (int j = 0; j < 4; ++j) { const int dd = d0 + 2 * j; o[j] = pk2(OMd[s_ * HG_LFS + dd] * __expf(ref[dd] - LFd[s_ * HG_LFS + dd]), OMd[s_ * HG_LFS + dd + 1] * __expf(ref[dd + 1] - LFd[s_ * HG_LFS + dd + 1])); }
                  const u32x4 w = (u32x4){o[0], o[1], o[2], o[3]};
                  sc[nj] = MFMA16(aq1[ks], __builtin_bit_cast(bf16x8_t, w), sc[nj]); } }
#pragma unroll
          for (int nj = 0; nj < 4; ++nj)
#pragma unroll
              for (int rg = 0; rg < 4; ++rg) { const int tl = 4 * g4 + rg, t = 16 * mi + tl, s_ = 16 * nj + r16; const bool keep = dir ? (s_ >= t) : (s_ <= t);
                  SC[tl * HG_TS + s_] = f2bf(keep ? sc[nj][rg] : 0.f); }
          asm volatile("s_waitcnt lgkmcnt(0)" ::: "memory");
          f32x4 oacc[4];
#pragma unroll
          for (int nj = 0; nj < 4; ++nj) oacc[nj] = (f32x4){0.f, 0.f, 0.f, 0.f};
          const float* st = K.ST() + ((size_t)chain * HG_NCH + ch) * 4096;
#pragma unroll
          for (int ks = 0; ks < 2; ++ks) {
              const bf16x8_t as = *(const bf16x8_t*)(SC + r16 * HG_TS + 32 * ks + 8 * g4);
#pragma unroll
              for (int nj = 0; nj < 4; ++nj) {
                  const bf16x8_t bv = *(const bf16x8_t*)(VT + (16 * nj + r16) * HG_TS + 32 * ks + 8 * g4);
                  oacc[nj] = MFMA16(as, bv, oacc[nj]);
                  const float* sp = st + (16 * nj + r16) * 64 + 32 * ks + 8 * g4; const f32x4 s0 = *(const f32x4*)sp, s1 = *(const f32x4*)(sp + 4);
                  const u32x4 w = (u32x4){pk2(s0.x, s0.y), pk2(s0.z, s0.w), pk2(s1.x, s1.y), pk2(s1.z, s1.w)};
                  oacc[nj] = MFMA16(aq2[ks], __builtin_bit_cast(bf16x8_t, w), oacc[nj]);
              }
          }
#pragma unroll
          for (int nj = 0; nj < 4; ++nj)
#pragma unroll
              for (int rg = 0; rg < 4; ++rg) OD[(dir * 64 + 16 * mi + 4 * g4 + rg) * HG_LFS + 16 * nj + r16] = oacc[nj][rg];
        }
        __syncthreads();
        { const int tok = K.tid >> 3, c = K.tid & 7; const int row = hg_block_row(b, tb, tok);
          const float* o0 = OD + tok * HG_LFS + 8 * c; const float* o1 = OD + (64 + tok) * HG_LFS + 8 * c;
          float o[8], ss = 0.f;
#pragma unroll
          for (int j = 0; j < 8; ++j) { o[j] = o0[j] + o1[j]; ss += o[j] * o[j]; }
          ss += __shfl_xor(ss, 1); ss += __shfl_xor(ss, 2); ss += __shfl_xor(ss, 4);
          const float rs = rsqrtf(ss * (1.0f / 64.0f) + EPS);
          float gq[8]; unpack8(*(const u32x4*)(K.P() + (size_t)row * PW + C_HG + h * 64 + 8 * c), gq);
          const float* nw = ARG(hgrn_norm_w) + (size_t)K.l * 256 + h * 64 + 8 * c;
          float y[8];
#pragma unroll
          for (int j = 0; j < 8; ++j) y[j] = o[j] * rs * nw[j] * gq[j] * sigmoidf_(gq[j]);
          u32x4 w; w.x = pk2(y[0], y[1]); w.y = pk2(y[2], y[3]); w.z = pk2(y[4], y[5]); w.w = pk2(y[6], y[7]);
          *(u32x4*)(K.MIX() + (size_t)row * D + MX_H + h * 64 + 8 * c) = w; }
    }
}

constexpr int AT_TS = 72;
constexpr int ATL_K = 0, ATL_V = ATL_K + 64 * AT_TS * 2, ATL_P = ATL_V + 64 * AT_TS * 2, ATL_END = ATL_P + 8 * 48 * AT_TS * 2;
static_assert(ATL_END <= LDS_BYTES - 256, "attention LDS map");
DI float dpp_max16(float x) { x = fmaxf(x, dpp_<0xB1>(x)); x = fmaxf(x, dpp_<0x4E>(x)); x = fmaxf(x, dpp_<0x141>(x)); x = fmaxf(x, dpp_<0x128>(x)); return x; }
DI float dpp_sum16(float x) { x += dpp_<0xB1>(x); x += dpp_<0x4E>(x); x += dpp_<0x141>(x); x += dpp_<0x128>(x); return x; }
template <int KIND> DI void attn_item(Ctx& K, int idx, const float* sinkp, const float* rpbp) {
    constexpr int MT = KIND == 0 ? 3 : 2;
    int tid_ = K.tid; asm volatile("" : "+v"(tid_));
    const int lane_ = tid_ & 63, wave_ = tid_ >> 6;
    bf16_t* KT = (bf16_t*)(K.lds + ATL_K); bf16_t* VT = (bf16_t*)(K.lds + ATL_V); bf16_t* PS = (bf16_t*)(K.lds + ATL_P) + wave_ * 48 * AT_TS;
    const int r16 = lane_ & 15, g4 = lane_ >> 4;
    int b, hk, qb = 0;
    if (KIND == 0) { qb = idx & 127; hk = (idx >> 7) & 1; b = idx >> 8; }
    else if (KIND == 1) { qb = idx & 63; hk = (idx >> 6) % 6; b = (idx >> 6) / 6; }
    else { hk = idx % 6; b = idx / 6; }
    const int kcol = (KIND == 0) ? C_SK + hk * 64 : (KIND == 2) ? C_SK + (hk / 3) * 64 : C_NK + hk * 64;
    const int vcol = (KIND == 0) ? C_SV + hk * 64 : (KIND == 2) ? C_SV + (hk / 3) * 64 : C_NV + hk * 64;
    int t0 = 0, nloc = 0;
    if (KIND == 0) { const int k0 = max(2 * qb - 2, 0), k1 = min(2 * qb + 3, L / 64 - 1); t0 = k0; nloc = k1 - k0 + 1; }
    if (KIND == 1) { const int k0 = min(max(4 * qb - 4, 0), L / 64 - 8), k1 = min(max(4 * qb + 3 - 4, 0), L / 64 - 8) + 7; t0 = k0; nloc = k1 - k0 + 1; }
    const int ntiles = nloc + CL / 64;
    int w_r = 0, w_rs = 0;
    if (KIND == 1) { w_r = 4 * qb + (wave_ >> 1); w_rs = min(max(w_r - 4, 0), L / 64 - 8); }
    bf16x8_t qf[MT][2]; int qbase[MT], hq_mt[MT];
#pragma unroll
    for (int mt = 0; mt < MT; ++mt) {
        int arow, hq;
        if (KIND == 0) { const int rho = wave_ * 48 + mt * 16; hq = hk * 3 + rho / 128; hq_mt[mt] = hq; const int tb = 128 * qb + (rho & 127); arow = lat_row(b, tb + r16); qbase[mt] = tb; }
        else if (KIND == 1) { hq = hk; hq_mt[mt] = hq; const int cb = 32 * (wave_ & 1) + 16 * mt; arow = lat_row(b, w_r * 64 + cb + r16); qbase[mt] = cb; }
        else { hq = hk; hq_mt[mt] = hq; const int tb = wave_ * 32 + mt * 16; arow = ctx_row(b, tb + r16); qbase[mt] = 0; }
        const int qcol = (KIND == 0 || KIND == 2) ? C_SQ + hq * 64 : C_NQ + hq * 64;
#pragma unroll
        for (int ks = 0; ks < 2; ++ks) { float q[8]; unpack8(*(const u32x4*)(K.P() + (size_t)arow * PW + qcol + 32 * ks + 8 * g4), q);
            const u32x4 w = (u32x4){pk2(q[0] * 0.125f, q[1] * 0.125f), pk2(q[2] * 0.125f, q[3] * 0.125f), pk2(q[4] * 0.125f, q[5] * 0.125f), pk2(q[6] * 0.125f, q[7] * 0.125f)};
            qf[mt][ks] = __builtin_bit_cast(bf16x8_t, w); }
    }
    f32x4 oacc[MT][4]; float mrun[MT][4], lrun[MT][4];
#pragma unroll
    for (int mt = 0; mt < MT; ++mt) {
#pragma unroll
        for (int ne = 0; ne < 4; ++ne) oacc[mt][ne] = (f32x4){0.f, 0.f, 0.f, 0.f};
        const bool has_sink = (KIND == 0 || KIND == 2); const float sk = has_sink ? sinkp[hq_mt[mt]] : -1.0e30f;
#pragma unroll
        for (int rg = 0; rg < 4; ++rg) { mrun[mt][rg] = sk; lrun[mt][rg] = has_sink ? 1.0f : 0.0f; }
    }
    const int lkey = tid_ >> 3, lch = tid_ & 7;
    u32x4 pk_, pv_;
    { const int ti = 0; const int grow = (ti < nloc) ? lat_row(b, (t0 + ti) * 64 + lkey) : ctx_row(b, (ti - nloc) * 64 + lkey);
      const bf16_t* pr = K.P() + (size_t)grow * PW + 8 * lch; pk_ = *(const u32x4*)(pr + kcol); pv_ = *(const u32x4*)(pr + vcol); }
#pragma unroll 1
    for (int ti = 0; ti < ntiles; ++ti) {
        __syncthreads();
        *(u32x4*)(KT + lkey * AT_TS + 8 * lch) = pk_;
        { const unsigned w[4] = {pv_.x, pv_.y, pv_.z, pv_.w};
#pragma unroll
          for (int j = 0; j < 4; ++j) { VT[(8 * lch + 2 * j) * AT_TS + lkey] = (bf16_t)(w[j] & 0xffffu); VT[(8 * lch + 2 * j + 1) * AT_TS + lkey] = (bf16_t)(w[j] >> 16); } }
        __syncthreads();
        if (ti + 1 < ntiles) { const int tn = ti + 1; const int grow = (tn < nloc) ? lat_row(b, (t0 + tn) * 64 + lkey) : ctx_row(b, (tn - nloc) * 64 + lkey);
            const bf16_t* pr = K.P() + (size_t)grow * PW + 8 * lch; pk_ = *(const u32x4*)(pr + kcol); pv_ = *(const u32x4*)(pr + vcol); }
        const bool local = ti < nloc; const int kunit = t0 + ti;
        bool active = true;
        if (KIND == 0 && local) active = true;
        if (KIND == 1 && local) active = (kunit >= w_rs) && (kunit < w_rs + 8);
        if (active) {
            f32x4 sc[MT][4];
#pragma unroll
            for (int mt = 0; mt < MT; ++mt)
#pragma unroll
                for (int nj = 0; nj < 4; ++nj) sc[mt][nj] = (f32x4){0.f, 0.f, 0.f, 0.f};
#pragma unroll
            for (int nj = 0; nj < 4; ++nj)
#pragma unroll
                for (int ks = 0; ks < 2; ++ks) { const bf16x8_t kf = *(const bf16x8_t*)(KT + (16 * nj + r16) * AT_TS + 32 * ks + 8 * g4);
#pragma unroll
                    for (int mt = 0; mt < MT; ++mt) sc[mt][nj] = MFMA16(qf[mt][ks], kf, sc[mt][nj]); }
            if (local) {
#pragma unroll
                for (int mt = 0; mt < MT; ++mt)
#pragma unroll
                    for (int nj = 0; nj < 4; ++nj)
#pragma unroll
                        for (int rg = 0; rg < 4; ++rg) { const int key = 16 * nj + r16;
                            if (KIND == 0) { const int dl = qbase[mt] + 4 * g4 + rg - (kunit * 64 + key); if (dl > 128 || dl < -128) sc[mt][nj][rg] = -INFINITY; }
                            if (KIND == 1) { const int c = qbase[mt] + 4 * g4 + rg, ws = min(max(c - 8, 0), 48);
                                if (key >= ws && key < ws + 16) sc[mt][nj][rg] += rpbp[(kunit - w_r + 7) * 31 + (key - c + 15)]; else sc[mt][nj][rg] = -INFINITY; } }
            }
#pragma unroll
            for (int mt = 0; mt < MT; ++mt)
#pragma unroll
                for (int rg = 0; rg < 4; ++rg) {
                    float mx = fmaxf(fmaxf(sc[mt][0][rg], sc[mt][1][rg]), fmaxf(sc[mt][2][rg], sc[mt][3][rg]));
                    mx = dpp_max16(mx);
                    const float mn = fmaxf(mrun[mt][rg], mx), alpha = __expf(mrun[mt][rg] - mn); mrun[mt][rg] = mn;
                    float rs_ = 0.f;
#pragma unroll
                    for (int nj = 0; nj < 4; ++nj) { const float pe = __expf(sc[mt][nj][rg] - mn); sc[mt][nj][rg] = pe; rs_ += pe; }
                    rs_ = dpp_sum16(rs_);
                    lrun[mt][rg] = lrun[mt][rg] * alpha + rs_;
#pragma unroll
                    for (int ne = 0; ne < 4; ++ne) oacc[mt][ne][rg] *= alpha;
                }
#pragma unroll
            for (int mt = 0; mt < MT; ++mt)
#pragma unroll
                for (int nj = 0; nj < 4; ++nj)
#pragma unroll
                    for (int rg = 0; rg < 4; ++rg) PS[(16 * mt + 4 * g4 + rg) * AT_TS + 16 * nj + r16] = f2bf(sc[mt][nj][rg]);
            asm volatile("s_waitcnt lgkmcnt(0)" ::: "memory");
#pragma unroll
            for (int ks = 0; ks < 2; ++ks) {
                bf16x8_t pf[MT];
#pragma unroll
                for (int mt = 0; mt < MT; ++mt) pf[mt] = *(const bf16x8_t*)(PS + (16 * mt + r16) * AT_TS + 32 * ks + 8 * g4);
#pragma unroll
                for (int ne = 0; ne < 4; ++ne) { const bf16x8_t vf = *(const bf16x8_t*)(VT + (16 * ne + r16) * AT_TS + 32 * ks + 8 * g4);
#pragma unroll
                    for (int mt = 0; mt < MT; ++mt) oacc[mt][ne] = MFMA16(pf[mt], vf, oacc[mt][ne]); }
            }
            asm volatile("s_waitcnt lgkmcnt(0)" ::: "memory");
        }
    }
#pragma unroll
    for (int mt = 0; mt < MT; ++mt)
#pragma unroll
        for (int rg = 0; rg < 4; ++rg) { const float inv = 1.0f / lrun[mt][rg];
#pragma unroll
            for (int ne = 0; ne < 4; ++ne) PS[(16 * mt + 4 * g4 + rg) * AT_TS + 16 * ne + r16] = f2bf(oacc[mt][ne][rg] * inv); }
    asm volatile("s_waitcnt lgkmcnt(0)" ::: "memory");
#pragma unroll
    for (int mt = 0; mt < MT; ++mt) {
        const int ocol = ((KIND == 0 || KIND == 2) ? MX_S : MX_N) + hq_mt[mt] * 64;
#pragma unroll
        for (int i = 0; i < 2; ++i) { const int rr = (lane_ >> 3) + 8 * i, ch = lane_ & 7;
            const u32x4 v = *(const u32x4*)(PS + (16 * mt + rr) * AT_TS + 8 * ch);
            int grow;
            if (KIND == 0) { const int rho = wave_ * 48 + mt * 16; grow = lat_row(b, 128 * qb + (rho & 127) + rr); }
            else if (KIND == 1) grow = lat_row(b, w_r * 64 + 32 * (wave_ & 1) + 16 * mt + rr);
            else grow = ctx_row(b, wave_ * 32 + mt * 16 + rr);
            *(u32x4*)(K.MIX() + (size_t)grow * D + ocol + 8 * ch) = v; }
    }
    asm volatile("s_waitcnt lgkmcnt(0)" ::: "memory");
}
DI void ph_attn(Ctx& K) {
    constexpr int N_SWA = NB * 2 * (L / 128), N_NAT = NB * 6 * (L / 256), N_C = NB * 6;
    const float* sinkp = ARG(swa_sink) + K.l * 6;
    for (int item = K.bid; item < N_SWA + N_NAT + 2 * N_C; item += K.nb) {
        if (item < N_SWA) attn_item<0>(K, item, sinkp, nullptr);
        else if (item < N_SWA + N_NAT) { const int it = item - N_SWA; const int h = (it >> 6) % 6; attn_item<1>(K, it, nullptr, ARG(nat_rpb) + ((size_t)K.l * 6 + h) * 15 * 31); }
        else if (item < N_SWA + N_NAT + N_C) attn_item<2>(K, item - N_SWA - N_NAT, sinkp, nullptr);
        else attn_item<3>(K, item - N_SWA - N_NAT - N_C, nullptr, nullptr);
    }
}

DI unsigned fkey(float f) { const unsigned u = __float_as_uint(f); return (u & 0x80000000u) ? ~u : (u | 0x80000000u); }
DI int mbcnt64(unsigned long long m) { return (int)__builtin_amdgcn_mbcnt_hi((unsigned)(m >> 32), __builtin_amdgcn_mbcnt_lo((unsigned)m, 0u)); }
template <int NV> DI unsigned radix_thr16(const unsigned (&k)[NV]) {
    unsigned prefix = 0u;
#pragma unroll 1
    for (int bit = 31; bit >= 0; --bit) {
        const unsigned cand = prefix | (1u << bit); int cnt = 0;
#pragma unroll
        for (int i = 0; i < NV; ++i) cnt += __popcll(__ballot(k[i] >= cand));
        if (cnt >= 16) { prefix = cand; if (cnt == 16) break; }
    }
    return prefix;
}
template <int NC, int NV> DI void radix_thr16_multi(const unsigned (&k)[NC][NV], unsigned (&T)[NC]) {
    bool exact[NC];
#pragma unroll
    for (int c = 0; c < NC; ++c) { T[c] = 0u; exact[c] = false; }
#pragma unroll 1
    for (int bit = 31; bit >= 0; --bit) {
        bool all = true;
#pragma unroll
        for (int c = 0; c < NC; ++c) {
            const unsigned cand = T[c] | (1u << bit); int cnt = 0;
#pragma unroll
            for (int i = 0; i < NV; ++i) cnt += __popcll(__ballot(k[c][i] >= cand));
            if (cnt >= 16) { T[c] = cand; exact[c] = (cnt == 16); }
            all = all && exact[c];
        }
        if (all) break;
    }
}
template <int NV> DI void select16(const unsigned (&k)[NV], unsigned T, bool (&sel)[NV], int (&pos)[NV]) {
    int ngt = 0; unsigned long long gtm[NV], eqm[NV];
#pragma unroll
    for (int i = 0; i < NV; ++i) { gtm[i] = __ballot(k[i] > T); eqm[i] = __ballot(k[i] == T); ngt += __popcll(gtm[i]); }
    const int need = 16 - ngt; int eqbase = 0, selbase = 0;
#pragma unroll
    for (int i = 0; i < NV; ++i) {
        const bool iseq = k[i] == T; const int erank = eqbase + mbcnt64(eqm[i]); eqbase += __popcll(eqm[i]);
        sel[i] = (k[i] > T) || (iseq && erank < need);
        const unsigned long long sm = __ballot(sel[i]); pos[i] = selbase + mbcnt64(sm); selbase += __popcll(sm);
    }
}
template <int CTRL> DI int dppi_(int x) { return __builtin_amdgcn_mov_dpp(x, CTRL, 0xf, 0xf, true); }
DI int row_sum_i(int x) { x += dppi_<0xB1>(x); x += dppi_<0x4E>(x); x += dppi_<0x141>(x); x += dppi_<0x128>(x); return x; }
DI int row_excl_scan_i(int x) { int s_ = x; s_ += dppi_<0x111>(s_); s_ += dppi_<0x112>(s_); s_ += dppi_<0x114>(s_); s_ += dppi_<0x118>(s_); return s_ - x; }
template <int NK> DI unsigned row_radix_thr16(const unsigned (&k)[NK]) {
    unsigned T = 0u; bool exact = false;
#pragma unroll 1
    for (int bit = 31; bit >= 0; --bit) {
        const unsigned cand = T | (1u << bit); int cnt = 0;
#pragma unroll
        for (int i = 0; i < NK; ++i) cnt += (k[i] >= cand) ? 1 : 0;
        cnt = row_sum_i(cnt);
        const bool ge = cnt >= 16; T = ge ? cand : T; exact = ge ? (cnt == 16) : exact;
        if (__ballot(!exact) == 0ull) break;
    }
    return T;
}
template <int NK> DI void row_select16(const unsigned (&k)[NK], unsigned T, bool (&sel)[NK], int (&pos)[NK]) {
    int g = 0, q = 0;
#pragma unroll
    for (int i = 0; i < NK; ++i) { g += (k[i] > T) ? 1 : 0; q += (k[i] == T) ? 1 : 0; }
    const int need = 16 - row_sum_i(g);
    const int a = min(max(need - row_excl_scan_i(q), 0), q);
    int nxt = row_excl_scan_i(g + a), eqs = 0;
#pragma unroll
    for (int i = 0; i < NK; ++i) { const bool iseq = k[i] == T; sel[i] = (k[i] > T) || (iseq && eqs < a); eqs += iseq ? 1 : 0; pos[i] = nxt; nxt += sel[i] ? 1 : 0; }
}
constexpr int PS_SCS = 132;
constexpr int PSL_TOP = 8 * 2 * 16 * PS_SCS * 4;
static_assert(PSL_TOP + 8 * 1024 <= LDS_BYTES - 256, "peer select LDS map");
template <int PROBE> DI void ph_peer_select(Ctx& K) {
    float* SCR = (float*)K.lds + K.wave * 2 * 16 * PS_SCS; float* TOPV = (float*)(K.lds + PSL_TOP + K.wave * 1024); int* TOPI = (int*)(TOPV + 128);
    const int r16 = K.lane & 15, g4 = K.lane >> 4, h = K.wave;
    for (int item = K.bid; item < M / 16; item += K.nb) {
        const int t0 = item * 16;
#pragma unroll 1
        for (int p = 0; p < 2; ++p) {
            bf16x8_t aq[4];
            { const bf16_t* qp = K.QP() + (size_t)(t0 + r16) * 2048 + h * 256 + p * 128 + 8 * g4;
#pragma unroll
              for (int ks = 0; ks < 4; ++ks) aq[ks] = *(const bf16x8_t*)(qp + 32 * ks); }
            const size_t kb = (((size_t)K.l * 8 + h) * 2 + p) * 128 * 128 + (size_t)r16 * 128 + 8 * g4;
#pragma unroll 2
            for (int nt = 0; nt < 8; ++nt) {
                bf16x8_t bh[4], bl[4];
#pragma unroll
                for (int ks = 0; ks < 4; ++ks) { bh[ks] = *(const bf16x8_t*)(K.SKH() + kb + (size_t)(16 * nt) * 128 + 32 * ks); bl[ks] = *(const bf16x8_t*)(K.SKL() + kb + (size_t)(16 * nt) * 128 + 32 * ks); }
                f32x4 c0 = {0.f, 0.f, 0.f, 0.f}, c1 = c0;
#pragma unroll
                for (int ks = 0; ks < 4; ++ks) { c0 = MFMA16(aq[ks], bh[ks], c0); c1 = MFMA16(aq[ks], bl[ks], c1); }
#pragma unroll
                for (int rg = 0; rg < 4; ++rg) SCR[(p * 16 + 4 * g4 + rg) * PS_SCS + 16 * nt + r16] = c0[rg] + c1[rg];
            }
        }
        asm volatile("s_waitcnt lgkmcnt(0)" ::: "memory");
        if (PROBE == 1) continue;
        const int rho = K.lane >> 4, j16 = K.lane & 15;
#pragma unroll 1
        for (int tk = 0; tk < 16; tk += 4) {
#pragma unroll 1
            for (int ps = 0; ps < 2; ++ps) {
                const int p = rho & 1, rr = 2 * ps + (rho >> 1);
                float v[8]; unsigned kk[8];
#pragma unroll
                for (int i = 0; i < 8; ++i) { v[i] = SCR[(p * 16 + tk + rr) * PS_SCS + j16 + 16 * i]; kk[i] = fkey(v[i]); }
                const unsigned T = row_radix_thr16<8>(kk);
                bool sel[8]; int pos[8]; row_select16<8>(kk, T, sel, pos);
#pragma unroll
                for (int i = 0; i < 8; ++i) if (sel[i]) { TOPV[(rr * 2 + p) * 16 + pos[i]] = v[i]; TOPI[(rr * 2 + p) * 16 + pos[i]] = j16 + 16 * i; }
            }
            asm volatile("s_waitcnt lgkmcnt(0)" ::: "memory");
            { const int r = t0 + tk + rho;
              const float vb = TOPV[(rho * 2 + 1) * 16 + j16]; const int ib = TOPI[(rho * 2 + 1) * 16 + j16];
              float cv[16]; unsigned ck[16];
#pragma unroll
              for (int i = 0; i < 16; ++i) { cv[i] = TOPV[(rho * 2) * 16 + i] + vb; ck[i] = fkey(cv[i]); }
              const unsigned T = row_radix_thr16<16>(ck);
              bool sel[16]; int pos[16]; row_select16<16>(ck, T, sel, pos);
              float mx = -3.0e38f;
#pragma unroll
              for (int i = 0; i < 16; ++i) mx = fmaxf(mx, sel[i] ? cv[i] : -3.0e38f);
              mx = dpp_max16(mx);
              float es = 0.f;
#pragma unroll
              for (int i = 0; i < 16; ++i) { cv[i] = sel[i] ? __expf(cv[i] - mx) : 0.f; es += cv[i]; }
              es = dpp_sum16(es);
              const float inv = 1.0f / es;
#pragma unroll
              for (int i = 0; i < 16; ++i) if (sel[i]) { K.PIDX()[(size_t)r * 128 + h * 16 + pos[i]] = TOPI[(rho * 2) * 16 + i] * 128 + ib; K.PG()[(size_t)r * 128 + h * 16 + pos[i]] = cv[i] * inv; }
            }
            asm volatile("s_waitcnt lgkmcnt(0)" ::: "memory");
        }
    }
}

constexpr int PUL_H = 0, PUL_SLOT = 4096, PUL_STRIDE = 4352;
struct PuMeta { float hs[2]; int ia[2], ib[2]; };
DI void pu_load(const Ctx& K, int r0, int step, PuMeta& m, unsigned char* hbuf) {
#pragma unroll
    for (int q = 0; q < 2; ++q) { const int r = r0 + q * step;
        if (r < M) { __builtin_amdgcn_global_load_lds((const unsigned*)(K.H8() + (size_t)r * D + K.lane * 16), (LAS unsigned*)(hbuf + q * 1024), 16, 0, 0);
            m.hs[q] = K.HS()[r]; m.ia[q] = K.PIDX()[(size_t)r * 128 + K.lane]; m.ib[q] = K.PIDX()[(size_t)r * 128 + 64 + K.lane]; }
        else { m.hs[q] = 0.f; m.ia[q] = -1; m.ib[q] = -1; } }
}
typedef int i32x4 __attribute__((ext_vector_type(4)));
template <int PROBE> DI void pu_item(const Ctx& K, const unsigned char* U, unsigned char* HL, int* SLOT, int R, int r0, int step, const PuMeta& m, int r16, int g4, float& dummy) {
    const float hs[2] = {m.hs[0], m.hs[1]};
    bool sa[2], sb[2]; int ra[2], rb[2]; int n = 0;
#pragma unroll
    for (int q = 0; q < 2; ++q) { sa[q] = (m.ia[q] >> 11) == R; sb[q] = (m.ib[q] >> 11) == R; const unsigned long long ma = __ballot(sa[q]), mb = __ballot(sb[q]);
        ra[q] = n + mbcnt64(ma); n += __popcll(ma); rb[q] = n + mbcnt64(mb); n += __popcll(mb); }
#pragma unroll 1
    for (int base = 0; base < n; base += 32) {
#pragma unroll
        for (int q = 0; q < 2; ++q) {
            if (sa[q] && ra[q] >= base && ra[q] < base + 32) { SLOT[2 * (ra[q] - base)] = m.ia[q]; SLOT[2 * (ra[q] - base) + 1] = q * 128 + K.lane; }
            if (sb[q] && rb[q] >= base && rb[q] < base + 32) { SLOT[2 * (rb[q] - base)] = m.ib[q]; SLOT[2 * (rb[q] - base) + 1] = q * 128 + 64 + K.lane; } }
        asm volatile("s_waitcnt lgkmcnt(0)" ::: "memory");
        const unsigned char* hp = HL + (r16 >> 3) * 1024 + 16 * g4;
        i32x4 av[2][16]; bool valid[2];
#pragma unroll
        for (int t = 0; t < 2; ++t) {
            valid[t] = base + 16 * t + r16 < n; const int e = valid[t] ? SLOT[2 * (16 * t + r16)] : 0;
            const unsigned char* up = U + (size_t)e * D + 16 * g4;
#pragma unroll
            for (int s_ = 0; s_ < 16; ++s_) av[t][s_] = (valid[t] && PROBE != 3) ? *(const i32x4*)(up + 64 * s_) : (i32x4){0, 0, 0, 0};
        }
        i32x4 acc[2] = {{0, 0, 0, 0}, {0, 0, 0, 0}};
#pragma unroll
        for (int s_ = 0; s_ < 16; ++s_) { const i32x4 hb = *(const i32x4*)(hp + 64 * s_);
            acc[0] = __builtin_amdgcn_mfma_i32_16x16x64_i8(av[0][s_], hb, acc[0], 0, 0, 0); acc[1] = __builtin_amdgcn_mfma_i32_16x16x64_i8(av[1][s_], hb, acc[1], 0, 0, 0); }
        const int rg = r16 & 3;
#pragma unroll
        for (int t = 0; t < 2; ++t) {
            const int di = rg == 0 ? acc[t][0] : rg == 1 ? acc[t][1] : rg == 2 ? acc[t][2] : acc[t][3];
            const int sl = 16 * t + 4 * g4 + rg;
            if ((r16 & 7) < 4 && base + sl < n) { const int code = SLOT[2 * sl + 1];
                if ((code >> 7) == (r16 >> 3)) {
                    const size_t eo = (size_t)K.l * 16384 + SLOT[2 * sl];
                    const float d = (float)di * K.US()[eo] * ((code >> 7) ? hs[1] : hs[0]);
                    const float vsc = K.VS()[eo];
                    if (PROBE >= 2) dummy += gelu_erf(d);
                    else (PROBE ? K.ST() : K.PA())[(size_t)(r0 + (code >> 7) * step) * 128 + (code & 127)] = gelu_erf(d) * vsc; } }
        }
        asm volatile("s_waitcnt lgkmcnt(0)" ::: "memory");
    }
}
template <int PROBE> DI void ph_peer_u(Ctx& K) {
    const unsigned char* U = (const unsigned char*)K.UB() + (size_t)K.l * 16384 * D;
    unsigned char* HB = K.lds + K.wave * PUL_STRIDE; int* SLOT = (int*)(HB + PUL_SLOT);
    const int r16 = K.lane & 15, g4 = K.lane >> 4;
    const int step = K.nloc * NWAVES;
    float dummy = 0.f;
    for (int R = K.xg; R < 8; R += K.nxg) {
        int r = K.jx * NWAVES + K.wave; int par = 0;
        PuMeta cur, nxt;
        pu_load(K, r, step, cur, HB);
#pragma unroll 1
        for (; r < M; r += 2 * step) {
            asm volatile("s_waitcnt vmcnt(0)" ::: "memory");
            pu_load(K, r + 2 * step, step, nxt, HB + (par ^ 1) * 2048);
            pu_item<PROBE>(K, U, HB + par * 2048, SLOT, R, r, step, cur, r16, g4, dummy);
            cur = nxt; par ^= 1;
        }
    }
    if (PROBE >= 2) K.ST()[K.gw * 64 + K.lane] = dummy;
}
struct PvMeta { int ia, ib; float ga, gb, pa, pb; };
template <int PROBE> DI void pv_load(const Ctx& K, int r, int c0, int slot, PvMeta& m) {
    if (r < M) { m.ia = K.PIDX()[(size_t)r * 128 + K.lane]; m.ib = K.PIDX()[(size_t)r * 128 + 64 + K.lane];
        m.ga = K.PG()[(size_t)r * 128 + K.lane]; m.pa = K.PA()[(size_t)r * 128 + K.lane]; m.gb = K.PG()[(size_t)r * 128 + 64 + K.lane]; m.pb = K.PA()[(size_t)r * 128 + 64 + K.lane]; }
}
template <int HALF, int PROBE> DI void pv_issue(const unsigned char* V, int slot, const PvMeta& m, u32x4 (&vv)[8], float (&ww)[8]) {
    const float w = HALF ? m.gb * m.pb : m.ga * m.pa; const int ix = HALF ? m.ib : m.ia;
#pragma unroll
    for (int i = 0; i < 8; ++i) {
        const int src = ((8 * i + slot) << 2);
        const int e = __builtin_amdgcn_ds_bpermute(src, ix);
        ww[i] = __uint_as_float((unsigned)__builtin_amdgcn_ds_bpermute(src, (int)__float_as_uint(w)));
        vv[i] = PROBE == 2 ? (u32x4){(unsigned)e, 1u, 2u, 3u} : *(const u32x4*)(V + (size_t)e * 128);
    }
}
typedef float f32x2_ __attribute__((ext_vector_type(2)));
DI void pv_accum(const u32x4 (&vv)[8], const float (&ww)[8], f32x2_ (&y)[8], float& sw) {
#pragma unroll
    for (int i = 0; i < 8; ++i) { sw += ww[i]; const unsigned w4[4] = {vv[i].x, vv[i].y, vv[i].z, vv[i].w}; const f32x2_ w2 = {ww[i], ww[i]};
#pragma unroll
        for (int q = 0; q < 4; ++q) { const f32x2_ lo = {(float)(w4[q] & 0xffu), (float)((w4[q] >> 8) & 0xffu)}, hi = {(float)((w4[q] >> 16) & 0xffu), (float)(w4[q] >> 24)};
            y[2 * q] = __builtin_elementwise_fma(w2, lo, y[2 * q]); y[2 * q + 1] = __builtin_elementwise_fma(w2, hi, y[2 * q + 1]); } }
}
template <int PROBE> DI void pv_item(const Ctx& K, const unsigned char* V, int r, int c0, int slot, const float* gate, const PvMeta& m, const PvMeta& mn, bool has_next, u32x4 (&vA)[8], float (&wA)[8], f32x4 (&pend)[4], float*& pend_ptr) {
    u32x4 vB[8]; float wB[8];
    float* xr = (PROBE ? (float*)K.P() : K.X()) + (size_t)r * D + c0;
    pv_issue<1, PROBE>(V, slot, m, vB, wB);
    if (slot == 0) {
        if (pend_ptr) {
#pragma unroll
            for (int q = 0; q < 4; ++q) *(f32x4*)(pend_ptr + 4 * q) = pend[q]; }
#pragma unroll
        for (int q = 0; q < 4; ++q) pend[q] = *(const f32x4*)(xr + 4 * q); }
    f32x2_ y2[8]; float sw = 0.f;
#pragma unroll
    for (int i = 0; i < 8; ++i) y2[i] = (f32x2_){0.f, 0.f};
    pv_accum(vA, wA, y2, sw);
    if (has_next) pv_issue<0, PROBE>(V, slot, mn, vA, wA);
    pv_accum(vB, wB, y2, sw);
    float y[16];
#pragma unroll
    for (int q = 0; q < 8; ++q) { y[2 * q] = y2[q].x - 128.f * sw; y[2 * q + 1] = y2[q].y - 128.f * sw; }
#pragma unroll
    for (int q = 0; q < 16; ++q) { float v = y[q]; v += dpp_<0x128>(v);
        auto s1 = __builtin_amdgcn_permlane16_swap(__float_as_uint(v), __float_as_uint(v), false, false); v = __uint_as_float(s1[0]) + __uint_as_float(s1[1]);
        auto s2 = __builtin_amdgcn_permlane32_swap(__float_as_uint(v), __float_as_uint(v), false, false); y[q] = __uint_as_float(s2[0]) + __uint_as_float(s2[1]); }
    if (slot == 0) { const float* gv = gate + (size_t)modvec_of_row(r) * 6 * D + c0;
#pragma unroll
        for (int q = 0; q < 4; ++q) { const f32x4 g = *(const f32x4*)(gv + 4 * q);
            pend[q].x += g.x * y[4 * q]; pend[q].y += g.y * y[4 * q + 1]; pend[q].z += g.z * y[4 * q + 2]; pend[q].w += g.w * y[4 * q + 3]; } }
    pend_ptr = xr;
}
template <int PROBE> DI void ph_peer_v(Ctx& K) {
    const int slot = K.lane >> 3, c = K.lane & 7;
    const float* gate = K.MOD() + (size_t)K.l * 3 * 6 * D + 5 * D;
    const int step = K.nloc * NWAVES;
    constexpr int PD = 2;
    for (int S = K.xg; S < 8; S += K.nxg) {
        const unsigned char* V = (const unsigned char*)K.VB() + ((size_t)K.l * 8 + S) * 16384 * 128 + c * 16;
        const int c0 = S * 128 + c * 16;
        int r = K.jx * NWAVES + K.wave;
        PvMeta m[PD];
#pragma unroll
        for (int i = 0; i < PD; ++i) { m[i].ia = 0; m[i].ib = 0; m[i].ga = m[i].gb = m[i].pa = m[i].pb = 0.f; pv_load<PROBE>(K, r + i * step, c0, slot, m[i]); }
        u32x4 vA[8]; float wA[8]; f32x4 pend[4]; float* pend_ptr = nullptr;
        if (r < M) pv_issue<0, PROBE>(V, slot, m[0], vA, wA);
#pragma unroll 1
        for (; r < M; r += PD * step) {
#pragma unroll
            for (int i = 0; i < PD; ++i) {
                const int ri = r + i * step;
                if (ri < M) pv_item<PROBE>(K, V, ri, c0, slot, gate, m[i], m[(i + 1) % PD], ri + step < M, vA, wA, pend, pend_ptr);
                pv_load<PROBE>(K, ri + PD * step, c0, slot, m[i]);
            }
        }
        if (slot == 0 && pend_ptr) {
#pragma unroll
            for (int q = 0; q < 4; ++q) *(f32x4*)(pend_ptr + 4 * q) = pend[q]; }
    }
}

DI void ph_final(Ctx& K) {
    for (int r = K.gw; r < NLAT; r += K.ngw) {
        const f32x4* xr = (const f32x4*)(K.X() + (size_t)(NCTX + r) * D); f32x4* o = (f32x4*)(((float*)argp_<float>(K, (unsigned)__builtin_offsetof(Args, out))) + (size_t)r * D);
        f32x4 v[4]; float ss = 0.f;
#pragma unroll
        for (int j = 0; j < 4; ++j) { v[j] = xr[j * 64 + K.lane]; ss += v[j].x * v[j].x + v[j].y * v[j].y + v[j].z * v[j].z + v[j].w * v[j].w; }
        ss = wave_sum(ss); const float rs = rsqrtf(ss * (1.0f / D) + EPS);
#pragma unroll
        for (int j = 0; j < 4; ++j) { const f32x4 w = ((const f32x4*)ARG(final_norm_w))[j * 64 + K.lane]; o[j * 64 + K.lane] = v[j] * rs * w; }
    }
}

#define XB_TMO      128
#define XB_XSUB(j)  (1280 + 64 * (j))
#define XB_XGEN(j)  (2304 + 64 * (j))
#define XB_TOP      3328
#define XB_TOPGEN   3392
#define XB_SPIN_CAP (1u << 22)
constexpr int CW_BAR = 4096;
DI unsigned xb_ld(unsigned* p)              { return __hip_atomic_load(p, __ATOMIC_RELAXED, __HIP_MEMORY_SCOPE_AGENT); }
DI unsigned xb_add(unsigned* p, unsigned v) { return __hip_atomic_fetch_add(p, v, __ATOMIC_RELAXED, __HIP_MEMORY_SCOPE_AGENT); }
#define XB_SPIN(cond, bar) do { unsigned _sp = 0; while (cond) { __builtin_amdgcn_s_sleep(1); \
    if ((++_sp & 255u) == 0u) { if (xb_ld(&(bar)[XB_TMO])) break; if (_sp > XB_SPIN_CAP) { atomicAdd(&(bar)[XB_TMO], 1u); break; } } } } while (0)
DI void xcd_barrier(unsigned* bar, unsigned x, unsigned nloc, unsigned nx) {
    asm volatile("s_waitcnt vmcnt(0)" ::: "memory");
    __syncthreads();
    if (threadIdx.x == 0) {
        __builtin_amdgcn_s_waitcnt(0);
        const unsigned old = xb_add(&bar[XB_XSUB(x)], 1u);
        const unsigned gen = old / nloc;
        if (old + 1u == (gen + 1u) * nloc) {
            __builtin_amdgcn_fence(__ATOMIC_RELEASE, "agent");
            asm volatile("s_waitcnt vmcnt(0)" ::: "memory");
            const unsigned og = xb_add(&bar[XB_TOP], 1u);
            const unsigned tg = og / nx;
            if (og + 1u == (tg + 1u) * nx) xb_add(&bar[XB_TOPGEN], 1u);
            else XB_SPIN(xb_ld(&bar[XB_TOPGEN]) == tg, bar);
            __builtin_amdgcn_fence(__ATOMIC_ACQUIRE, "agent");
            xb_add(&bar[XB_XGEN(x)], 1u);
            asm volatile("s_waitcnt vmcnt(0)" ::: "memory");
        } else {
            XB_SPIN(xb_ld(&bar[XB_XGEN(x)]) == gen, bar);
            __builtin_amdgcn_fence(__ATOMIC_ACQUIRE, "agent");
            asm volatile("s_waitcnt vmcnt(0)" ::: "memory");
        }
    }
    __syncthreads();
}

constexpr int PROBE_U = 0, PROBE_V = 0, PROBE_S = 0;
constexpr unsigned DUP_MASK = 0u;
constexpr int PH_PER_LAYER = 13, N_PHASES = 2 + PH_PER_LAYER * DEPTH;
__global__ void __launch_bounds__(NTHREADS) mk_fwd(Args args) {
    extern __shared__ __attribute__((aligned(16))) unsigned char lds[];
    cg::grid_group grid = cg::this_grid();
    constexpr unsigned ARGS_OFF = LDS_BYTES - 256;
    constexpr unsigned MISC_OFF = LDS_BYTES - 64;
    if (threadIdx.x == 0) {
        *(Args*)(lds + ARGS_OFF) = args;
        unsigned* ctl = (unsigned*)(args.ws + WS_CTL); unsigned* misc = (unsigned*)(lds + MISC_OFF);
        const unsigned xcc = (unsigned)__builtin_amdgcn_s_getreg((3 << 11) | 20) & 0xFu;
        misc[0] = xcc; misc[1] = __hip_atomic_fetch_add(ctl + 64 * xcc, 1u, __ATOMIC_RELAXED, __HIP_MEMORY_SCOPE_AGENT);
    }
    __syncthreads();
    int rep = 0;
#pragma unroll 1
    for (int ph = 0; ph < N_PHASES; ++ph) {
        int tid = threadIdx.x; asm volatile("" : "+v"(tid));
        unsigned aoff = ARGS_OFF; asm volatile("" : "+v"(aoff));
        size_t zoff = 0; asm volatile("" : "+s"(zoff));
        unsigned char* ws = args.ws + zoff;
        int bid = blockIdx.x; asm volatile("" : "+s"(bid)); int nb = gridDim.x; asm volatile("" : "+s"(nb));
        unsigned moff = MISC_OFF; asm volatile("" : "+v"(moff));
        Ctx K; { const unsigned* misc = (const unsigned*)(lds + moff); K.jx = __builtin_amdgcn_readfirstlane(misc[1]); K.xg = __builtin_amdgcn_readfirstlane(misc[2]); K.nxg = __builtin_amdgcn_readfirstlane(misc[3]); K.nloc = __builtin_amdgcn_readfirstlane(misc[4]); }
        K.aoff = aoff; K.lds = lds; K.tid = tid; K.lane = tid & 63; K.wave = tid >> 6; K.bid = bid; K.nb = nb; K.gw = bid * NWAVES + K.wave; K.ngw = nb * NWAVES;
        K.ws = ws;
        const int l = ph == 0 ? 0 : (ph - 1) / PH_PER_LAYER, k = ph == 0 ? -1 : (ph == N_PHASES - 1 ? -2 : (ph - 1) % PH_PER_LAYER);
        K.l = l;
        if (k == -1) ph_prologue(K);
        else if (k == -2) ph_final(K);
        else if (k == 0) ph_norm(K, ARG(norm_mix_w) + (size_t)l * D, 0);
        else if (k == 1) ph_gemm_store(K, K.H(), K.WIN() + (size_t)l * PW * D, PW, K.P());
        else if (k == 2) ph_rope(K);
        else if (k == 3) ph_hgrn_A(K);
        else if (k == 4) ph_attn(K);
        else if (k == 5) ph_hgrn_B(K);
        else if (k == 6) ph_hgrn_C(K);
        else if (k == 7) ph_gemm_resid(K, K.MIX(), K.WOUT() + (size_t)l * D * D, 2);
        else if (k == 8) ph_norm(K, ARG(norm_ffn_w) + (size_t)l * D, 3);
        else if (k == 9) ph_gemm_store(K, K.H(), K.WQ() + (size_t)l * 2048 * D, 2048, K.QP());
        else if (k == 10) { ph_peer_select<0>(K); if (PROBE_S) ph_peer_select<PROBE_S>(K); }
        else if (k == 11) { ph_peer_u<0>(K); if (PROBE_U) ph_peer_u<PROBE_U>(K); }
        else if (k == 12) { ph_peer_v<0>(K); if (PROBE_V) ph_peer_v<PROBE_V>(K); }
        if (k >= 0 && ((DUP_MASK >> k) & 1u)) { ++rep; if (rep < 2) { --ph; continue; } } rep = 0;
        if (ph == 0) grid.sync();
        else if (k != 3 && ph != N_PHASES - 1) { const unsigned* misc = (const unsigned*)(lds + moff); xcd_barrier((unsigned*)(args.ws + WS_CTL) + CW_BAR, misc[0], misc[4], misc[3]); }
        if (ph == 0) {
            if (threadIdx.x == 0) { unsigned* ctl = (unsigned*)(args.ws + WS_CTL); unsigned* misc = (unsigned*)(lds + MISC_OFF); const unsigned xcc = misc[0]; unsigned ord = 0, npop = 0, mine = 1;
                for (unsigned q = 0; q < 16; ++q) { const unsigned cq = __hip_atomic_load(ctl + 64 * q, __ATOMIC_RELAXED, __HIP_MEMORY_SCOPE_AGENT); if (cq) { ++npop; if (q < xcc) ++ord; } if (q == xcc) mine = cq; }
                misc[2] = ord; misc[3] = npop ? npop : 1u; misc[4] = mine ? mine : 1u; }
            __syncthreads();
        }
    }
}

extern "C" void kernel_launch(void* const* d_in, const int* in_sizes, int n_in, void* d_out, int out_size, void* d_ws, size_t ws_size, hipStream_t stream) {
    static int grid = 0;
    if (grid == 0) {
        if (n_in != 19 || out_size != NLAT * D || ws_size < WS_END) { fprintf(stderr, "kernel_launch: unexpected shapes (n_in %d out %d ws %zu need %zu)\n", n_in, out_size, ws_size, (size_t)WS_END); grid = -1; return; }
        int dev = 0, cus = 0, per_cu = 0;
        (void)hipGetDevice(&dev); (void)hipDeviceGetAttribute(&cus, hipDeviceAttributeMultiprocessorCount, dev);
        (void)hipFuncSetAttribute((const void*)mk_fwd, hipFuncAttributeMaxDynamicSharedMemorySize, LDS_BYTES);
        (void)hipOccupancyMaxActiveBlocksPerMultiprocessor(&per_cu, (const void*)mk_fwd, NTHREADS, LDS_BYTES);
        if (per_cu < 1) { fprintf(stderr, "kernel_launch: occupancy query says %d blocks/CU\n", per_cu); grid = -1; return; }
        grid = (cus / 8) * 8;
    }
    if (grid < 0) return;
    Args a{};
    a.x = (const float*)d_in[0]; a.c = (const float*)d_in[1]; a.ctx = (const float*)d_in[2]; a.c_ctx = (const float*)d_in[3]; a.w_mod = (const float*)d_in[4]; a.b_mod = (const float*)d_in[5];
    a.norm_mix_w = (const float*)d_in[6]; a.norm_ffn_w = (const float*)d_in[7]; a.w_in = (const float*)d_in[8]; a.lb_logits = (const float*)d_in[9]; a.hgrn_norm_w = (const float*)d_in[10];
    a.swa_sink = (const float*)d_in[11]; a.nat_rpb = (const float*)d_in[12]; a.w_out = (const float*)d_in[13]; a.peer_wq = (const float*)d_in[14]; a.peer_sk = (const float*)d_in[15];
    a.peer_u = (const float*)d_in[16]; a.peer_v = (const float*)d_in[17]; a.final_norm_w = (const float*)d_in[18];
    a.out = (float*)d_out; a.ws = (unsigned char*)d_ws;
    (void)hipMemsetAsync((unsigned char*)d_ws + WS_CTL, 0, CTL_BYTES, stream);
    void* kargs[] = {&a};
    hipError_t e = hipLaunchCooperativeKernel((const void*)mk_fwd, dim3(grid), dim3(NTHREADS), kargs, LDS_BYTES, stream);
    if (e != hipSuccess) fprintf(stderr, "kernel_launch: cooperative launch failed: %s (grid %d)\n", hipGetErrorString(e), grid);
}
```

```cpp
#include <hip/hip_runtime.h>
#include <hip/hip_cooperative_groups.h>
#include <cstdio>
#include <cstdint>
namespace cg = cooperative_groups;
#define DI __device__ __forceinline__
#define GP(T, p) ((T*)(__attribute__((address_space(1))) T*)(p))

typedef unsigned short bf16_t;
typedef float f32x4 __attribute__((ext_vector_type(4)));
typedef unsigned u32x4 __attribute__((ext_vector_type(4)));
typedef unsigned u32x2 __attribute__((ext_vector_type(2)));

constexpr int D = 1024, NB = 2, L = 16384, CL = 256, DEPTH = 4;
constexpr int NCTX = NB * CL, NLAT = NB * L, M = NCTX + NLAT;
constexpr int PW = 3072;
constexpr int C_HQ = 0, C_ZF = 256, C_ZB = 512, C_HV = 768, C_HG = 1024, C_SQ = 1280, C_SK = 1664, C_SV = 1792, C_NQ = 1920, C_NK = 2304, C_NV = 2688;
constexpr int MX_H = 0, MX_S = 256, MX_N = 640;
constexpr float EPS = 1e-6f;
constexpr int NTHREADS = 512, NWAVES = 8;
constexpr int LDS_BYTES = 147456;

constexpr size_t al256(size_t x) { return (x + 255) & ~(size_t)255; }
constexpr size_t WS_X = 0;
constexpr size_t WS_H = WS_X + al256((size_t)M * D * 4);
constexpr size_t WS_P = WS_H + al256((size_t)M * D * 2);
constexpr size_t WS_MIX = WS_P + al256((size_t)M * PW * 2);
constexpr size_t WS_OF = WS_MIX + al256((size_t)M * D * 2);
constexpr size_t WS_OB = WS_OF + al256((size_t)M * 256 * 4);
constexpr size_t WS_PIDX = WS_OB + al256((size_t)M * 256 * 4);
constexpr size_t WS_PG = WS_PIDX + al256((size_t)M * 128 * 4);
constexpr size_t WS_MOD = WS_PG + al256((size_t)M * 128 * 4);
constexpr size_t WS_LB = WS_MOD + al256((size_t)DEPTH * 3 * 6 * D * 4);
constexpr size_t WS_ROPE = WS_LB + al256((size_t)2 * DEPTH * 256 * 4);
constexpr size_t WS_WIN = WS_ROPE + al256((size_t)(256 + 256 + 64 + 64) * 16 * 4);
constexpr size_t WS_WOUT = WS_WIN + al256((size_t)DEPTH * PW * D * 2);
constexpr size_t WS_WQ = WS_WOUT + al256((size_t)DEPTH * D * D * 2);
constexpr size_t WS_AC = WS_WQ + al256((size_t)DEPTH * 2048 * D * 2);
constexpr size_t WS_UB_ = 0; constexpr size_t WS_UB = WS_AC + al256((size_t)16 * 260 * 64 * 4); constexpr size_t WS_UB_OLD = WS_WQ + al256((size_t)DEPTH * 2048 * D * 2);
constexpr size_t WS_VB = WS_UB + al256((size_t)DEPTH * 16384 * D * 2);
constexpr size_t WS_PA = WS_VB + al256((size_t)DEPTH * 16384 * D * 2);
constexpr size_t WS_VS = WS_PA + al256((size_t)M * 128 * 4);
constexpr size_t WS_US = WS_VS + al256((size_t)DEPTH * 16384 * 4);
constexpr size_t WS_H8 = WS_US + al256((size_t)DEPTH * 16384 * 4);
constexpr size_t WS_HS = WS_H8 + al256((size_t)M * D);
constexpr size_t WS_SKH = WS_HS + al256((size_t)M * 4);
constexpr size_t WS_SKL = WS_SKH + al256((size_t)DEPTH * 8 * 2 * 128 * 128 * 2);
constexpr size_t WS_CTL = WS_SKL + al256((size_t)DEPTH * 8 * 2 * 128 * 128 * 2);
constexpr size_t CTL_BYTES = 65536;
constexpr size_t WS_END = WS_CTL + CTL_BYTES;

struct Args {
    const float *x, *c, *ctx, *c_ctx, *w_mod, *b_mod, *norm_mix_w, *norm_ffn_w, *w_in, *lb_logits, *hgrn_norm_w, *swa_sink, *nat_rpb, *w_out, *peer_wq, *peer_sk, *peer_u, *peer_v, *final_norm_w;
    float* out; unsigned char* ws;
};

DI float bf2f(bf16_t v) { return __uint_as_float((unsigned)v << 16); }
DI bf16_t f2bf(float f) { unsigned u = __float_as_uint(f); return (bf16_t)((u + 0x7fffu + ((u >> 16) & 1u)) >> 16); }
DI unsigned pk2(float lo, float hi) { return (unsigned)f2bf(lo) | ((unsigned)f2bf(hi) << 16); }
DI float wave_sum(float v) {
#pragma unroll
    for (int o = 1; o < 64; o <<= 1) v += __shfl_xor(v, o);
    return v;
}
typedef __bf16 bf16x2_t __attribute__((ext_vector_type(2)));
DI float dot2bf(unsigned a, unsigned b, float acc) { return __builtin_amdgcn_fdot2_f32_bf16(__builtin_bit_cast(bf16x2_t, a), __builtin_bit_cast(bf16x2_t, b), acc, false); }
template <int CTRL> DI float dpp_(float x) { return __builtin_bit_cast(float, __builtin_amdgcn_mov_dpp(__builtin_bit_cast(int, x), CTRL, 0xf, 0xf, true)); }
DI float wave_sum_fast(float x) {
    x += dpp_<0xB1>(x); x += dpp_<0x4E>(x); x += dpp_<0x141>(x); x += dpp_<0x128>(x);
    auto s1 = __builtin_amdgcn_permlane16_swap(__float_as_uint(x), __float_as_uint(x), false, false); x = __uint_as_float(s1[0]) + __uint_as_float(s1[1]);
    auto s2 = __builtin_amdgcn_permlane32_swap(__float_as_uint(x), __float_as_uint(x), false, false); return __uint_as_float(s2[0]) + __uint_as_float(s2[1]);
}
DI float sigmoidf_(float z) { return 1.0f / (1.0f + __expf(-z)); }
DI float gelu_erf(float v) { return 0.5f * v * (1.0f + erff(v * 0.70710678118654752f)); }
DI int modvec_of_row(int r) { return r < NCTX ? 2 : (r - NCTX) / L; }
DI int batch_of_row(int r) { return r < NCTX ? r / CL : (r - NCTX) / L; }
DI int lat_row(int b, int t) { return NCTX + b * L + t; }
DI int ctx_row(int b, int s) { return b * CL + s; }
DI void unpack8(const u32x4 w, float* o) {
    o[0] = __uint_as_float(w.x << 16); o[1] = __uint_as_float(w.x & 0xffff0000u);
    o[2] = __uint_as_float(w.y << 16); o[3] = __uint_as_float(w.y & 0xffff0000u);
    o[4] = __uint_as_float(w.z << 16); o[5] = __uint_as_float(w.z & 0xffff0000u);
    o[6] = __uint_as_float(w.w << 16); o[7] = __uint_as_float(w.w & 0xffff0000u);
}
DI void load_row64(const bf16_t* p, float (&o)[64]) {
#pragma unroll
    for (int i = 0; i < 8; ++i) { const u32x4 w = *(const u32x4*)(p + 8 * i); unpack8(w, &o[8 * i]); }
}
DI void rope64(float (&x)[64], const float* cr, const float* sr, const float* cc, const float* sc) {
#pragma unroll
    for (int i = 0; i < 16; ++i) {
        const float c1 = cr[i], s1 = sr[i], a = x[i], b = x[16 + i];
        x[i] = a * c1 - b * s1; x[16 + i] = b * c1 + a * s1;
        const float c2 = cc[i], s2 = sc[i], e = x[32 + i], f = x[48 + i];
        x[32 + i] = e * c2 - f * s2; x[48 + i] = f * c2 + e * s2;
    }
}

namespace pg8 {
#define PG8_LAS __attribute__((address_space(3)))
typedef unsigned short bf16_t;
typedef short bf16x8 __attribute__((ext_vector_type(8)));
typedef float f32x4 __attribute__((ext_vector_type(4)));
typedef unsigned u32x4 __attribute__((ext_vector_type(4)));
constexpr int BM = 256, BK = 64, HALF = 128, HTB = HALF * BK * 2  , STAGE_BYTES = 8 * HTB, NXCD = 8, WGM = 8;

__host__ __device__ __forceinline__ int lds_byte(int r, int c) { const int st = (r >> 4) * 2 + (c >> 5), rr = r & 15, cc = c & 31, ob = rr * 64 + cc * 2; return st * 1024 + (ob ^ (((ob >> 9) & 1) << 5)); }
__host__ __device__ __forceinline__ void stage_rc(int b, int& R, int& C) { const int st = b / 1024, sb = b % 1024, swz = sb ^ (((sb >> 9) & 1) << 5); R = (st >> 1) * 16 + swz / 64; C = (st & 1) * 32 + (swz % 64) / 2; }
__host__ __device__ __forceinline__ int perm32(int rho) { const int n = rho >> 4, i = rho & 15; return 8 * (i >> 2) + 4 * n + (i & 3); }

struct Unit { int pm, pn; };
struct Gemm { const bf16_t* A; const bf16_t* Bt; int M, N, K; };

struct StaticOrder {
    int nM, nN, nwg, G, c;
    __host__ __device__ void init(int M, int N, int G_, int c_) { nM = M / BM; nN = N / BM; nwg = nM * nN; G = G_; c = c_; }
    __host__ __device__ bool next(int i, Unit& u) const {
        const long L = (long)i * G + c; if (L >= nwg) return false;
        int wgid = (int)L; { const int q = nwg / NXCD, r = nwg % NXCD, xcd = wgid % NXCD, off = wgid / NXCD; wgid = (xcd < r ? xcd * (q + 1) : r * (q + 1) + (xcd - r) * q) + off; }
        const int nig = WGM * nN, gid = wgid / nig, fm = gid * WGM, gsz = (nM - fm) < WGM ? (nM - fm) : WGM;
        u.pm = fm + ((wgid % nig) % gsz); u.pn = (wgid % nig) / gsz; return true;
    }
    __device__ __forceinline__ void a_ready(const Unit&) const {}
    __device__ __forceinline__ void done(const Unit&) const {}
};


__device__ __forceinline__ unsigned cvt_pk_bf16(float lo, float hi) { unsigned r; asm volatile("v_cvt_pk_bf16_f32 %0, %1, %2" : "=v"(r) : "v"(lo), "v"(hi)); return r; }
struct EpiStore {
    static constexpr bool PERM = true, AFTER_DRAIN = false;
    bf16_t* O; int ldc;
    __device__ __forceinline__ void operator()(const f32x4 (&acc)[2][2][4][2], const Unit& u, int wr, int wc, int fr, int fq) const {
        const int row0 = u.pm * BM + wr * 64 + fr, col0 = u.pn * BM + wc * 32 + 8 * fq;
#pragma unroll
        for (int ai = 0; ai < 2; ++ai)
#pragma unroll
            for (int m = 0; m < 4; ++m) { bf16_t* rowp = O + (size_t)(row0 + ai * HALF + m * 16) * ldc + col0;
#pragma unroll
                for (int bj = 0; bj < 2; ++bj) { const f32x4 v0 = acc[ai][bj][m][0], v1 = acc[ai][bj][m][1];
                    u32x4 w; w.x = cvt_pk_bf16(v0[0], v0[1]); w.y = cvt_pk_bf16(v0[2], v0[3]); w.z = cvt_pk_bf16(v1[0], v1[1]); w.w = cvt_pk_bf16(v1[2], v1[3]);
                    *(u32x4*)(rowp + bj * HALF) = w; } }
    }
};
struct EpiResid {
    static constexpr bool PERM = false, AFTER_DRAIN = false;
    float* X; int ldc; const float* gate; int gstride, nctx, seqlen;
    __device__ __forceinline__ void operator()(const f32x4 (&acc)[2][2][4][2], const Unit& u, int wr, int wc, int fr, int fq) const {
        const int col0 = u.pn * BM + wc * 32 + 4 * fq;
#pragma unroll
        for (int ai = 0; ai < 2; ++ai)
#pragma unroll
            for (int m = 0; m < 4; ++m) { const int r = u.pm * BM + ai * HALF + wr * 64 + m * 16 + fr; const int vsel = r < nctx ? 2 : (r - nctx) / seqlen;
                float* xr = X + (size_t)r * ldc + col0; const float* gr = gate + (size_t)vsel * gstride + col0;
#pragma unroll
                for (int bj = 0; bj < 2; ++bj)
#pragma unroll
                    for (int n = 0; n < 2; ++n) { const f32x4 g = *(const f32x4*)(gr + bj * HALF + n * 16); f32x4 x = *(const f32x4*)(xr + bj * HALF + n * 16); x += g * acc[ai][bj][m][n]; *(f32x4*)(xr + bj * HALF + n * 16) = x; } }
    }
};
template <class Epi, class Sched, bool ALIGN_EPI = false, bool SP2 = false>
__device__ __forceinline__ void gemm_phase(PG8_LAS unsigned char* lds, const Gemm g, const Sched& S, const Epi& E) {
    int tid_ = threadIdx.x; asm volatile("" : "+v"(tid_));
    const int tid = tid_, wid = __builtin_amdgcn_readfirstlane(tid >> 6), lane = tid & 63, wr = wid >> 2, wc = wid & 3, fr = lane & 15, fq = lane >> 4;
    const int K = g.K, nt = K / BK;
    unsigned voffA[2], voffB[2];
#pragma unroll
    for (int i = 0; i < 2; ++i) { int R, C; stage_rc(tid * 16 + i * 8192, R, C); const int Rb = Epi::PERM ? ((R & ~31) + perm32(R & 31)) : R;
        voffA[i] = (unsigned)(R * K + C) * 2u; voffB[i] = (unsigned)(Rb * K + C) * 2u; }
    const size_t kstep = (size_t)(BK * 2);
    const size_t hstep = (size_t)HALF * K * 2;
    const size_t tstep = 2 * hstep;
    const unsigned ldsw = (unsigned)wid * 1024u;
    const int aoff = lds_byte(wr * 64 + fr, fq * 8), boff = lds_byte(wc * 32 + fr, fq * 8);
#define PG8_SA(b, h) (((b) * 2 + (h)) * HTB)
#define PG8_SB(b, h) ((4 + (b) * 2 + (h)) * HTB)
#define PG8_STAGE(bufoff, gbase, voff) do { _Pragma("unroll") for (int _i = 0; _i < 2; ++_i) \
        __builtin_amdgcn_global_load_lds((const unsigned*)((const char*)(gbase) + (voff)[_i]), (PG8_LAS unsigned*)(lds + (bufoff) + ldsw + _i * 8192), 16, 0, 0); } while (0)
#define PG8_LDA(dst, b, h) do { _Pragma("unroll") for (int m = 0; m < 4; ++m) _Pragma("unroll") for (int k = 0; k < 2; ++k) dst[m][k] = *(const PG8_LAS bf16x8*)(lds + PG8_SA(b, h) + aoff + m * 2048 + k * 1024); } while (0)
#define PG8_LDB(dst, b, h) do { _Pragma("unroll") for (int n = 0; n < 2; ++n) _Pragma("unroll") for (int k = 0; k < 2; ++k) dst[n][k] = *(const PG8_LAS bf16x8*)(lds + PG8_SB(b, h) + boff + n * 2048 + k * 1024); } while (0)
#define PG8_MMA(ai, bj, At, Bt) do { __builtin_amdgcn_s_setprio(1); _Pragma("unroll") for (int m = 0; m < 4; ++m) _Pragma("unroll") for (int n = 0; n < 2; ++n) _Pragma("unroll") for (int k = 0; k < 2; ++k) \
        acc[ai][bj][m][n] = __builtin_amdgcn_mfma_f32_16x16x32_bf16(Bt[n][k], At[m][k], acc[ai][bj][m][n], 0, 0, 0); __builtin_amdgcn_s_setprio(0); } while (0)
#define PG8_WAIT_V(n) asm volatile("s_waitcnt vmcnt(" #n ")" ::: "memory")
#define PG8_WAIT_L(n) asm volatile("s_waitcnt lgkmcnt(" #n ")" ::: "memory")
#define PG8_BAR __builtin_amdgcn_s_barrier()
#define PG8_SCHED __builtin_amdgcn_sched_barrier(0)
    Unit cur, nxt; int ui = 0;
    if (!S.next(0, cur)) return;
    f32x4 acc[2][2][4][2];
#pragma unroll
    for (int a = 0; a < 2; ++a)
#pragma unroll
        for (int b = 0; b < 2; ++b)
#pragma unroll
            for (int m = 0; m < 4; ++m)
#pragma unroll
                for (int n = 0; n < 2; ++n) acc[a][b][m][n] = (f32x4){0.f, 0.f, 0.f, 0.f};
    bf16x8 At[4][2], B0[2][2], B1[2][2];
    const char* cA = (const char*)g.A + (size_t)cur.pm * tstep; const char* cB = (const char*)g.Bt + (size_t)cur.pn * tstep;
    S.a_ready(cur);
    if constexpr (SP2) {
        PG8_STAGE(PG8_SB(0, 0), cB, voffB); PG8_STAGE(PG8_SB(0, 1), cB + hstep, voffB); PG8_STAGE(PG8_SA(0, 0), cA, voffA); PG8_STAGE(PG8_SA(0, 1), cA + hstep, voffA);
        if (wr == 1) PG8_BAR;
        PG8_WAIT_V(2); PG8_BAR;
        PG8_STAGE(PG8_SB(1, 0), cB + kstep, voffB); PG8_STAGE(PG8_SA(1, 0), cA + kstep, voffA); PG8_STAGE(PG8_SB(1, 1), cB + hstep + kstep, voffB);
        PG8_WAIT_V(6); PG8_BAR;
    } else {
        PG8_STAGE(PG8_SB(0, 0), cB, voffB); PG8_STAGE(PG8_SA(0, 0), cA, voffA); PG8_STAGE(PG8_SB(0, 1), cB + hstep, voffB); PG8_STAGE(PG8_SA(0, 1), cA + hstep, voffA);
        if (wr == 1) PG8_BAR;
        PG8_WAIT_V(4); PG8_BAR;
        PG8_STAGE(PG8_SB(1, 0), cB + kstep, voffB); PG8_STAGE(PG8_SA(1, 0), cA + kstep, voffA); PG8_STAGE(PG8_SB(1, 1), cB + hstep + kstep, voffB);
        PG8_WAIT_V(6); PG8_BAR;
    }
    for (;;) {
        const bool has_next = S.next(ui + 1, nxt);
        const char* nA = has_next ? (const char*)g.A + (size_t)nxt.pm * tstep : cA; const char* nB = has_next ? (const char*)g.Bt + (size_t)nxt.pn * tstep : cB;
        for (int t = 0; t < nt; t += 2) {
            const bool last = (t == nt - 2);
            const char* a1 = cA + (size_t)(t + 1) * kstep;
            const char* a2 = last ? nA : cA + (size_t)(t + 2) * kstep; const char* b2 = last ? nB : cB + (size_t)(t + 2) * kstep;
            const char* a3 = a2 + kstep; const char* b3 = b2 + kstep;
            if (last && has_next) S.a_ready(nxt);
            if constexpr (SP2) {
            PG8_LDB(B0, 0, 0); PG8_LDB(B1, 0, 1); PG8_SCHED; PG8_LDA(At, 0, 0); PG8_STAGE(PG8_SA(1, 1), a1 + hstep, voffA);
            PG8_WAIT_V(8); PG8_WAIT_L(0); PG8_BAR; PG8_MMA(0, 0, At, B0); PG8_MMA(0, 1, At, B1); PG8_BAR; PG8_SCHED;
            PG8_LDA(At, 0, 1); PG8_STAGE(PG8_SB(0, 0), b2, voffB); PG8_STAGE(PG8_SB(0, 1), b2 + hstep, voffB); PG8_STAGE(PG8_SA(0, 0), a2, voffA);
            PG8_WAIT_V(8); PG8_WAIT_L(0); PG8_BAR; PG8_MMA(1, 0, At, B0); PG8_MMA(1, 1, At, B1); PG8_BAR; PG8_SCHED;
            PG8_LDB(B0, 1, 0); PG8_LDB(B1, 1, 1); PG8_SCHED; PG8_LDA(At, 1, 0); PG8_STAGE(PG8_SA(0, 1), a2 + hstep, voffA);
            PG8_WAIT_V(8); PG8_WAIT_L(0); PG8_BAR; PG8_MMA(0, 0, At, B0); PG8_MMA(0, 1, At, B1); PG8_BAR; PG8_SCHED;
            PG8_LDA(At, 1, 1); PG8_STAGE(PG8_SB(1, 0), b3, voffB); PG8_STAGE(PG8_SB(1, 1), b3 + hstep, voffB); PG8_STAGE(PG8_SA(1, 0), a3, voffA);
            PG8_WAIT_V(8); PG8_WAIT_L(0); PG8_BAR; PG8_MMA(1, 0, At, B0); PG8_MMA(1, 1, At, B1); PG8_BAR; PG8_SCHED;
            } else {
            PG8_LDB(B0, 0, 0); PG8_SCHED; PG8_LDA(At, 0, 0); PG8_STAGE(PG8_SA(1, 1), a1 + hstep, voffA);
            PG8_WAIT_L(8); PG8_BAR; PG8_WAIT_L(0); PG8_MMA(0, 0, At, B0); PG8_BAR; PG8_SCHED;
            PG8_LDB(B1, 0, 1); PG8_STAGE(PG8_SB(0, 0), b2, voffB);
            PG8_BAR; PG8_WAIT_L(0); PG8_MMA(0, 1, At, B1); PG8_BAR;
            PG8_LDA(At, 0, 1); PG8_STAGE(PG8_SA(0, 0), a2, voffA);
            PG8_BAR; PG8_WAIT_L(0); PG8_MMA(1, 0, At, B0); PG8_BAR; PG8_SCHED;
            PG8_STAGE(PG8_SB(0, 1), b2 + hstep, voffB);
            PG8_WAIT_V(6); PG8_BAR; PG8_MMA(1, 1, At, B1); PG8_BAR;
            PG8_LDB(B0, 1, 0); PG8_SCHED; PG8_LDA(At, 1, 0); PG8_STAGE(PG8_SA(0, 1), a2 + hstep, voffA);
            PG8_WAIT_L(8); PG8_BAR; PG8_WAIT_L(0); PG8_MMA(0, 0, At, B0); PG8_BAR; PG8_SCHED;
            PG8_LDB(B1, 1, 1); PG8_STAGE(PG8_SB(1, 0), b3, voffB);
            PG8_BAR; PG8_WAIT_L(0); PG8_MMA(0, 1, At, B1); PG8_BAR;
            PG8_LDA(At, 1, 1); PG8_STAGE(PG8_SA(1, 0), a3, voffA);
            PG8_BAR; PG8_WAIT_L(0); PG8_MMA(1, 0, At, B0); PG8_BAR; PG8_SCHED;
            PG8_STAGE(PG8_SB(1, 1), b3 + hstep, voffB);
            PG8_WAIT_V(6); PG8_BAR; PG8_MMA(1, 1, At, B1); PG8_BAR;
            }
        }
        if constexpr (ALIGN_EPI) { if (wr == 0) PG8_BAR; }
        if constexpr (!Epi::AFTER_DRAIN) { E(acc, cur, wr, wc, fr, fq); S.done(cur); }
        if (!has_next) break;
#pragma unroll
        for (int a = 0; a < 2; ++a)
#pragma unroll
            for (int b = 0; b < 2; ++b)
#pragma unroll
                for (int m = 0; m < 4; ++m)
#pragma unroll
                    for (int n = 0; n < 2; ++n) acc[a][b][m][n] = (f32x4){0.f, 0.f, 0.f, 0.f};
        cur = nxt; cA = nA; cB = nB; ++ui;
        if constexpr (ALIGN_EPI) { if (wr == 1) PG8_BAR; }
    }
    PG8_WAIT_V(0);
    if constexpr (!ALIGN_EPI) { if (wr == 0) PG8_BAR; }
    PG8_BAR;
    if constexpr (Epi::AFTER_DRAIN) { E.fused(acc, cur, wr, wc, fr, fq, lds, wid, lane); S.done(cur); }
#undef PG8_SA
#undef PG8_SB
#undef PG8_STAGE
#undef PG8_LDA
#undef PG8_LDB
#undef PG8_MMA
#undef PG8_WAIT_V
#undef PG8_WAIT_L
#undef PG8_BAR
#undef PG8_SCHED
}
}

struct Ctx {
    unsigned aoff; int l;
    unsigned char* ws;
    DI float* X() const { return GP(float, ws + WS_X); }
    DI bf16_t* H() const { return GP(bf16_t, ws + WS_H); }
    DI bf16_t* P() const { return GP(bf16_t, ws + WS_P); }
    DI bf16_t* QP() const { return GP(bf16_t, ws + WS_P); }
    DI bf16_t* MIX() const { return GP(bf16_t, ws + WS_MIX); }
    DI float* OF() const { return GP(float, ws + WS_OF); }
    DI float* OB() const { return GP(float, ws + WS_OB); }
    DI int* PIDX() const { return GP(int, ws + WS_PIDX); }
    DI float* PG() const { return GP(float, ws + WS_PG); }
    DI float* MOD() const { return GP(float, ws + WS_MOD); }
    DI float* LB() const { return GP(float, ws + WS_LB); }
    DI float* ROPE() const { return GP(float, ws + WS_ROPE); }
    DI bf16_t* WIN() const { return GP(bf16_t, ws + WS_WIN); }
    DI bf16_t* WOUT() const { return GP(bf16_t, ws + WS_WOUT); }
    DI bf16_t* WQ() const { return GP(bf16_t, ws + WS_WQ); }
    DI bf16_t* UB() const { return GP(bf16_t, ws + WS_UB); }
    DI float* ST() const { return GP(float, ws + WS_OF); }
    DI float* AC() const { return GP(float, ws + WS_AC); }
    DI float* PA() const { return GP(float, ws + WS_PA); }
    DI float* VS() const { return GP(float, ws + WS_VS); }
    DI float* US() const { return GP(float, ws + WS_US); }
    DI bf16_t* SKH() const { return GP(bf16_t, ws + WS_SKH); }
    DI bf16_t* SKL() const { return GP(bf16_t, ws + WS_SKL); }
    DI bf16_t* VB() const { return GP(bf16_t, ws + WS_VB); }
    DI unsigned char* H8() const { return GP(unsigned char, ws + WS_H8); }
    DI float* HS() const { return GP(float, ws + WS_HS); }
    unsigned char* lds; int tid, lane, wave, gw, ngw, bid, nb;
    int xg, nxg, jx, nloc;
};

#define LAS __attribute__((address_space(3)))
DI void transpose_item(const float* W, int Kd, int N, bf16_t* WT, LAS float* scr, int item, int lane) {
    const int nblk = N / 32, kb = item / nblk, nb = item % nblk, k0 = 64 * kb, n0 = 32 * nb;
#pragma unroll 8
    for (int i = 0; i < 32; ++i) { const int kk = 2 * i + (lane >> 5); scr[kk * 33 + (lane & 31)] = W[(size_t)(k0 + kk) * N + n0 + (lane & 31)]; }
    asm volatile("s_waitcnt lgkmcnt(0)" ::: "memory");
    const int c = lane & 7;
#pragma unroll
    for (int j = 0; j < 4; ++j) { const int n = (lane >> 3) + 8 * j; const LAS float* sp = scr + (8 * c) * 33 + n;
        u32x4 o; o.x = pk2(sp[0 * 33], sp[1 * 33]); o.y = pk2(sp[2 * 33], sp[3 * 33]); o.z = pk2(sp[4 * 33], sp[5 * 33]); o.w = pk2(sp[6 * 33], sp[7 * 33]);
        *(u32x4*)(WT + (size_t)(n0 + n) * Kd + k0 + 8 * c) = o; }
    asm volatile("s_waitcnt lgkmcnt(0)" ::: "memory");
}

template <class T> DI T* argp_(const Ctx& K, unsigned off) {
    const unsigned* p = (const unsigned*)(K.lds + K.aoff + off);
    const unsigned lo = __builtin_amdgcn_readfirstlane(p[0]), hi = __builtin_amdgcn_readfirstlane(p[1]);
    return GP(T, ((unsigned long long)hi << 32) | (unsigned long long)lo);
}
#define ARG(f) argp_<const float>(K, (unsigned)__builtin_offsetof(Args, f))

DI void ph_prologue(Ctx& K) {
    {
        LAS float* scr = (LAS float*)((LAS unsigned char*)K.lds + K.wave * 16384);
        constexpr int I_IN = (D / 64) * (PW / 32), I_OUT = (D / 64) * (D / 32), I_Q = (D / 64) * (2048 / 32), I_L = I_IN + I_OUT + I_Q;
        for (int it = K.gw; it < DEPTH * I_L; it += K.ngw) {
            const int l = it / I_L; int r = it % I_L;
            if (r < I_IN) { transpose_item(ARG(w_in) + (size_t)l * D * PW, D, PW, K.WIN() + (size_t)l * PW * D, scr, r, K.lane); continue; } r -= I_IN;
            if (r < I_OUT) { transpose_item(ARG(w_out) + (size_t)l * D * D, D, D, K.WOUT() + (size_t)l * D * D, scr, r, K.lane); continue; } r -= I_OUT;
            transpose_item(ARG(peer_wq) + (size_t)l * D * 2048, D, 2048, K.WQ() + (size_t)l * 2048 * D, scr, r, K.lane);
        }
    }
    const size_t gt = (size_t)K.bid * NTHREADS + K.tid, gs = (size_t)K.nb * NTHREADS;
    { const f32x4* s0 = (const f32x4*)ARG(ctx); const f32x4* s1 = (const f32x4*)ARG(x); f32x4* d = (f32x4*)K.X();
      const size_t n0 = (size_t)NCTX * D / 4, n1 = (size_t)NLAT * D / 4;
      for (size_t i = gt; i < n0 + n1; i += gs) d[i] = i < n0 ? s0[i] : s1[i - n0]; }
    { const float* sk = ARG(peer_sk);
      for (size_t i = gt; i < (size_t)DEPTH * 8 * 2 * 128 * 128; i += gs) { const float v = sk[i]; const bf16_t hi = f2bf(v); K.SKH()[i] = hi; K.SKL()[i] = f2bf(v - bf2f(hi)); } }
    { const float* pu = ARG(peer_u); unsigned char* UQ = (unsigned char*)K.UB();
      for (int row0 = K.gw; row0 < DEPTH * 16384; row0 += 2 * K.ngw) {
          f32x4 v2[2][4];
#pragma unroll
          for (int t = 0; t < 2; ++t) { const int row = min(row0 + t * K.ngw, DEPTH * 16384 - 1); const f32x4* src = (const f32x4*)(pu + (size_t)row * D);
#pragma unroll
              for (int j = 0; j < 4; ++j) v2[t][j] = src[j * 64 + K.lane]; }
#pragma unroll
          for (int t = 0; t < 2; ++t) { const int row = row0 + t * K.ngw; if (row >= DEPTH * 16384) break;
              float mx = 0.f;
#pragma unroll
              for (int j = 0; j < 4; ++j) mx = fmaxf(mx, fmaxf(fmaxf(fabsf(v2[t][j].x), fabsf(v2[t][j].y)), fmaxf(fabsf(v2[t][j].z), fabsf(v2[t][j].w))));
#pragma unroll
              for (int o = 1; o < 64; o <<= 1) mx = fmaxf(mx, __shfl_xor(mx, o));
              const float sc = fmaxf(mx, 1e-30f) * (1.0f / 127.0f), inv = 1.0f / sc;
              if (K.lane == 0) K.US()[row] = sc;
#pragma unroll
              for (int j = 0; j < 4; ++j) { const int col = j * 256 + K.lane * 4; const f32x4 v = v2[t][j];
                  const unsigned q0 = (unsigned)((int)rintf(v.x * inv)) & 0xffu, q1 = (unsigned)((int)rintf(v.y * inv)) & 0xffu, q2 = (unsigned)((int)rintf(v.z * inv)) & 0xffu, q3 = (unsigned)((int)rintf(v.w * inv)) & 0xffu;
                  *(unsigned*)(UQ + (size_t)row * D + col) = q0 | (q1 << 8) | (q2 << 16) | (q3 << 24); } } } }
    { const float* pv = ARG(peer_v); unsigned char* VQ = (unsigned char*)K.VB();
      for (int row0 = K.gw; row0 < DEPTH * 16384; row0 += 2 * K.ngw) {
          f32x4 v2[2][4];
#pragma unroll
          for (int t = 0; t < 2; ++t) { const int row = min(row0 + t * K.ngw, DEPTH * 16384 - 1); const f32x4* src = (const f32x4*)(pv + (size_t)row * D);
#pragma unroll
              for (int j = 0; j < 4; ++j) v2[t][j] = src[j * 64 + K.lane]; }
#pragma unroll
          for (int t = 0; t < 2; ++t) { const int row = row0 + t * K.ngw; if (row >= DEPTH * 16384) break;
              float mx = 0.f;
#pragma unroll
              for (int j = 0; j < 4; ++j) mx = fmaxf(mx, fmaxf(fmaxf(fabsf(v2[t][j].x), fabsf(v2[t][j].y)), fmaxf(fabsf(v2[t][j].z), fabsf(v2[t][j].w))));
#pragma unroll
              for (int o = 1; o < 64; o <<= 1) mx = fmaxf(mx, __shfl_xor(mx, o));
              const float sc = fmaxf(mx, 1e-30f) * (1.0f / 127.0f), inv = 1.0f / sc;
              if (K.lane == 0) K.VS()[row] = sc;
              const int l = row >> 14, e = row & 16383;
#pragma unroll
              for (int j = 0; j < 4; ++j) { const int col = j * 256 + K.lane * 4; const f32x4 v = v2[t][j];
                  const unsigned q0 = (unsigned)((int)rintf(v.x * inv) + 128), q1 = (unsigned)((int)rintf(v.y * inv) + 128), q2 = (unsigned)((int)rintf(v.z * inv) + 128), q3 = (unsigned)((int)rintf(v.w * inv) + 128);
                  *(unsigned*)(VQ + (((size_t)l * 8 + (col >> 7)) * 16384 + e) * 128 + (col & 127)) = q0 | (q1 << 8) | (q2 << 16) | (q3 << 24); } } } }
    { float* sv = (float*)K.lds;
      float* part = sv + 3 * D;
      __syncthreads();
      for (int i = K.tid; i < 3 * D; i += NTHREADS) { const int v = i / D, k = i % D; const float c = v < 2 ? ARG(c)[v * D + k] : ARG(c_ctx)[k]; sv[i] = c * sigmoidf_(c); }
      __syncthreads();
      for (int item = K.bid; item < DEPTH * 24; item += K.nb) {
          const int l = item / 24, cb = item % 24;
          const float* w = ARG(w_mod) + (size_t)l * D * 6 * D + cb * 256 + K.lane * 4;
          f32x4 a0 = {0.f, 0.f, 0.f, 0.f}, a1 = a0, a2 = a0;
#pragma unroll 8
          for (int kk = 0; kk < 128; ++kk) { const int k = K.wave * 128 + kk; const f32x4 wv = *(const f32x4*)(w + (size_t)k * 6 * D);
              a0 += wv * sv[k]; a1 += wv * sv[D + k]; a2 += wv * sv[2 * D + k]; }
          *(f32x4*)(part + (K.wave * 3 + 0) * 256 + K.lane * 4) = a0; *(f32x4*)(part + (K.wave * 3 + 1) * 256 + K.lane * 4) = a1; *(f32x4*)(part + (K.wave * 3 + 2) * 256 + K.lane * 4) = a2;
          __syncthreads();
          for (int i = K.tid; i < 768; i += NTHREADS) { const int v = i / 256, cc = i % 256; float sum = 0.f;
#pragma unroll
              for (int w8 = 0; w8 < 8; ++w8) sum += part[(w8 * 3 + v) * 256 + cc];
              const int col = cb * 256 + cc; K.MOD()[((size_t)l * 3 + v) * 6 * D + col] = sum + ARG(b_mod)[(size_t)l * 6 * D + col]; }
          __syncthreads();
      } }
    for (size_t i = gt; i < 2 * 256; i += gs) {
        const int dir = (int)(i / 256), ch = (int)(i % 256);
        float lg[DEPTH], mx = -1e30f;
#pragma unroll
        for (int l = 0; l < DEPTH; ++l) { lg[l] = ARG(lb_logits)[((size_t)dir * DEPTH + l) * 256 + ch]; mx = fmaxf(mx, lg[l]); }
        float s = 0.f;
#pragma unroll
        for (int l = 0; l < DEPTH; ++l) { lg[l] = expf(lg[l] - mx); s += lg[l]; }
        float cum = 0.f;
#pragma unroll
        for (int l = 0; l < DEPTH; ++l) { if (l > 0) cum += lg[l] / s; K.LB()[((size_t)dir * DEPTH + l) * 256 + ch] = cum; }
    }
    for (size_t i = gt; i < (256 + 64) * 16; i += gs) {
        const int pos = (int)(i / 16), f = (int)(i % 16);
        const float inv = powf(10000.0f, -(float)f / 16.0f);
        if (pos < 256) { const float ang = (float)pos * inv; K.ROPE()[pos * 16 + f] = cosf(ang); K.ROPE()[4096 + pos * 16 + f] = sinf(ang); }
        else { const int pc = pos - 256; const float ang = (float)pc * inv; K.ROPE()[8192 + pc * 16 + f] = cosf(ang); K.ROPE()[8192 + 1024 + pc * 16 + f] = sinf(ang); }
    }
}

DI void ph_norm(Ctx& K, const float* nw, int shift_chunk) {
    const float* modl = K.MOD() + (size_t)K.l * 3 * 6 * D;
    for (int r = K.gw; r < M; r += K.ngw) {
        const f32x4* xr = (const f32x4*)(K.X() + (size_t)r * D);
        f32x4 v[4]; float ss = 0.f;
#pragma unroll
        for (int j = 0; j < 4; ++j) { v[j] = xr[j * 64 + K.lane]; ss += v[j].x * v[j].x + v[j].y * v[j].y + v[j].z * v[j].z + v[j].w * v[j].w; }
        ss = wave_sum(ss);
        const float rs = rsqrtf(ss * (1.0f / D) + EPS);
        const float* mv = modl + (size_t)modvec_of_row(r) * 6 * D;
        u32x2* ho = (u32x2*)(K.H() + (size_t)r * D);
#pragma unroll
        for (int j = 0; j < 4; ++j) {
            const int c4 = j * 64 + K.lane;
            const f32x4 w = ((const f32x4*)nw)[c4], sh = ((const f32x4*)(mv + shift_chunk * D))[c4], sc = ((const f32x4*)(mv + (shift_chunk + 1) * D))[c4];
            f32x4 y; y.x = v[j].x * rs * w.x * (1.f + sc.x) + sh.x; y.y = v[j].y * rs * w.y * (1.f + sc.y) + sh.y; y.z = v[j].z * rs * w.z * (1.f + sc.z) + sh.z; y.w = v[j].w * rs * w.w * (1.f + sc.w) + sh.w;
            u32x2 o; o.x = pk2(y.x, y.y); o.y = pk2(y.z, y.w); ho[c4] = o;
            if (shift_chunk == 3) { v[j].x = __uint_as_float(o.x << 16); v[j].y = __uint_as_float(o.x & 0xffff0000u); v[j].z = __uint_as_float(o.y << 16); v[j].w = __uint_as_float(o.y & 0xffff0000u); }
        }
        if (shift_chunk == 3) {
            float mx = 0.f;
#pragma unroll
            for (int j = 0; j < 4; ++j) mx = fmaxf(mx, fmaxf(fmaxf(fabsf(v[j].x), fabsf(v[j].y)), fmaxf(fabsf(v[j].z), fabsf(v[j].w))));
#pragma unroll
            for (int o = 1; o < 64; o <<= 1) mx = fmaxf(mx, __shfl_xor(mx, o));
            const float sc = fmaxf(mx, 1e-30f) * (1.0f / 127.0f), inv = 1.0f / sc;
            if (K.lane == 0) K.HS()[r] = sc;
#pragma unroll
            for (int j = 0; j < 4; ++j) { const unsigned q0 = (unsigned)((int)rintf(v[j].x * inv)) & 0xffu, q1 = (unsigned)((int)rintf(v[j].y * inv)) & 0xffu, q2 = (unsigned)((int)rintf(v[j].z * inv)) & 0xffu, q3 = (unsigned)((int)rintf(v[j].w * inv)) & 0xffu;
                *(unsigned*)(K.H8() + (size_t)r * D + (j * 64 + K.lane) * 4) = q0 | (q1 << 8) | (q2 << 16) | (q3 << 24); }
        }
    }
}

DI void ph_gemm_store(Ctx& K, const bf16_t* A, const bf16_t* Bt, int N, bf16_t* out) {
    pg8::Gemm g{A, Bt, M, N, D}; pg8::StaticOrder S; S.init(M, N, K.nb, K.bid);
    pg8::EpiStore E{out, N};
    pg8::gemm_phase<pg8::EpiStore, pg8::StaticOrder, true, true>((LAS unsigned char*)K.lds, g, S, E);
}
DI void ph_gemm_resid(Ctx& K, const bf16_t* A, const bf16_t* Bt, int chunk) {
    pg8::Gemm g{A, Bt, M, D, D}; pg8::StaticOrder S; S.init(M, D, K.nb, K.bid);
    pg8::EpiResid E{K.X(), D, K.MOD() + (size_t)K.l * 3 * 6 * D + (size_t)chunk * D, 6 * D, NCTX, L};
    pg8::gemm_phase<pg8::EpiResid, pg8::StaticOrder, true, true>((LAS unsigned char*)K.lds, g, S, E);
}

DI void ph_rope(Ctx& K) {
    const float* cosr = K.ROPE(); const float* sinr = K.ROPE() + 4096; const float* cosc = K.ROPE() + 8192; const float* sinc = K.ROPE() + 8192 + 1024;
    const size_t gt = (size_t)K.bid * NTHREADS + K.tid, gs = (size_t)K.nb * NTHREADS;
    for (size_t i = gt; i < (size_t)NLAT * 8 * 16; i += gs) {
        const int f = (int)(i & 15), hh = (int)((i >> 4) & 7), lr = (int)(i >> 7);
        const int t = lr % L, pr = t >> 6, pc = t & 63;
        bf16_t* p = K.P() + (size_t)(NCTX + lr) * PW + (hh < 6 ? C_SQ + hh * 64 : C_SK + (hh - 6) * 64);
        const float c1 = cosr[pr * 16 + f], s1 = sinr[pr * 16 + f], c2 = cosc[pc * 16 + f], s2 = sinc[pc * 16 + f];
        const float a = bf2f(p[f]), b = bf2f(p[16 + f]), e = bf2f(p[32 + f]), g = bf2f(p[48 + f]);
        p[f] = f2bf(a * c1 - b * s1); p[16 + f] = f2bf(b * c1 + a * s1); p[32 + f] = f2bf(e * c2 - g * s2); p[48 + f] = f2bf(g * c2 + e * s2);
    }
}

typedef short bf16x8_t __attribute__((ext_vector_type(8)));
#define MFMA16(a, b, c) __builtin_amdgcn_mfma_f32_16x16x32_bf16((a), (b), (c), 0, 0, 0)
constexpr int HG_NCH = (CL + L) / 64;
constexpr int HG_LFS = 68;
constexpr int HG_TS = 72;
constexpr int HGL_LF = 0, HGL_OM = HGL_LF + 2 * 64 * HG_LFS * 4, HGL_VT = HGL_OM + 2 * 64 * HG_LFS * 4, HGL_KT = HGL_VT + 64 * HG_TS * 2, HGL_SC = HGL_KT, HGL_OD = HGL_SC + 8 * 16 * HG_TS * 2, HGL_END = HGL_OD + 2 * 64 * HG_LFS * 4;
static_assert(HGL_KT + 2 * 64 * HG_TS * 2 <= LDS_BYTES && HGL_END <= LDS_BYTES, "hgrn LDS map");
DI int hg_block_row(int b, int tb, int tok) { return tb < 4 ? ctx_row(b, tb * 64 + tok) : lat_row(b, (tb - 4) * 64 + tok); }
DI int hg_bwd_chunk(int tb) { return tb < 4 ? 3 - tb : 4 + 255 - (tb - 4); }
DI void hg_prep(Ctx& K, int b, int h, int tb) {
    float* LF = (float*)(K.lds + HGL_LF); float* OM = (float*)(K.lds + HGL_OM); bf16_t* VT = (bf16_t*)(K.lds + HGL_VT);
    const int tok = K.tid >> 3, c = K.tid & 7;
    const bf16_t* pr = K.P() + (size_t)hg_block_row(b, tb, tok) * PW + h * 64 + 8 * c;
#pragma unroll
    for (int dir = 0; dir < 2; ++dir) {
        float z[8]; unpack8(*(const u32x4*)(pr + (dir ? C_ZB : C_ZF)), z);
        const float* lb = K.LB() + ((size_t)dir * DEPTH + K.l) * 256 + h * 64 + 8 * c;
        float lf[8], om[8];
#pragma unroll
        for (int j = 0; j < 8; ++j) { const float lbv = lb[j], sg = sigmoidf_(z[j]); const float f = fmaxf(lbv + (1.f - lbv) * sg, 1e-30f); lf[j] = __logf(f); om[j] = (1.f - lbv) * (1.f - sg); }
        float* lfp = LF + (dir * 64 + tok) * HG_LFS + 8 * c; float* omp = OM + (dir * 64 + tok) * HG_LFS + 8 * c;
        *(f32x4*)lfp = (f32x4){lf[0], lf[1], lf[2], lf[3]}; *(f32x4*)(lfp + 4) = (f32x4){lf[4], lf[5], lf[6], lf[7]};
        *(f32x4*)omp = (f32x4){om[0], om[1], om[2], om[3]}; *(f32x4*)(omp + 4) = (f32x4){om[4], om[5], om[6], om[7]};
    }
    { const u32x4 v = *(const u32x4*)(pr + C_HV);
      const unsigned w[4] = {v.x, v.y, v.z, v.w};
#pragma unroll
      for (int j = 0; j < 4; ++j) { VT[(8 * c + 2 * j) * HG_TS + tok] = (bf16_t)(w[j] & 0xffffu); VT[(8 * c + 2 * j + 1) * HG_TS + tok] = (bf16_t)(w[j] >> 16); } }
    __syncthreads();
    if (K.tid < 128) {
        const int dir = K.tid >> 6, d = K.tid & 63; float* col = LF + dir * 64 * HG_LFS + d;
        float v[64];
#pragma unroll
        for (int p = 0; p < 64; ++p) v[p] = col[(dir ? 63 - p : p) * HG_LFS];
#pragma unroll
        for (int p = 1; p < 64; ++p) v[p] += v[p - 1];
#pragma unroll
        for (int p = 0; p < 64; ++p) col[(dir ? 63 - p : p) * HG_LFS] = v[p];
    }
    __syncthreads();
}
DI void ph_hgrn_A(Ctx& K) {
    float* LF = (float*)(K.lds + HGL_LF); float* OM = (float*)(K.lds + HGL_OM); bf16_t* VT = (bf16_t*)(K.lds + HGL_VT); bf16_t* KT = (bf16_t*)(K.lds + HGL_KT);
    const int r16 = K.lane & 15, g4 = K.lane >> 4;
    for (int item = K.bid; item < NB * 4 * HG_NCH; item += K.nb) {
        const int tb = item % HG_NCH, h = (item / HG_NCH) & 3, b = item / (HG_NCH * 4);
        __syncthreads();
        hg_prep(K, b, h, tb);
        { const int tok = K.tid >> 3, c = K.tid & 7;
#pragma unroll
          for (int dir = 0; dir < 2; ++dir) {
              const float* bl = LF + (dir * 64 + (dir ? 0 : 63)) * HG_LFS + 8 * c; const float* bt = LF + (dir * 64 + tok) * HG_LFS + 8 * c; const float* om = OM + (dir * 64 + tok) * HG_LFS + 8 * c;
#pragma unroll
              for (int j = 0; j < 8; ++j) KT[(dir * 64 + 8 * c + j) * HG_TS + tok] = f2bf(om[j] * __expf(bl[j] - bt[j]));
          }
          if (K.tid < 128) { const int dir = K.tid >> 6, d = K.tid & 63; const int chain = (b * 2 + dir) * 4 + h, ch = dir ? hg_bwd_chunk(tb) : tb;
              K.AC()[((size_t)chain * HG_NCH + ch) * 64 + d] = __expf(LF[(dir * 64 + (dir ? 0 : 63)) * HG_LFS + d]); } }
        __syncthreads();
        { const int dir = K.wave >> 2, mi = K.wave & 3; const int chain = (b * 2 + dir) * 4 + h, ch = dir ? hg_bwd_chunk(tb) : tb;
          f32x4 acc[4];
#pragma unroll
          for (int nj = 0; nj < 4; ++nj) acc[nj] = (f32x4){0.f, 0.f, 0.f, 0.f};
#pragma unroll
          for (int ks = 0; ks < 2; ++ks) {
              const bf16x8_t av = *(const bf16x8_t*)(VT + (16 * mi + r16) * HG_TS + 32 * ks + 8 * g4);
#pragma unroll
              for (int nj = 0; nj < 4; ++nj) { const bf16x8_t bv = *(const bf16x8_t*)(KT + (dir * 64 + 16 * nj + r16) * HG_TS + 32 * ks + 8 * g4); acc[nj] = MFMA16(av, bv, acc[nj]); }
          }
          float* st = K.ST() + ((size_t)chain * HG_NCH + ch) * 4096;
#pragma unroll
          for (int nj = 0; nj < 4; ++nj)
#pragma unroll
              for (int rg = 0; rg < 4; ++rg) st[(16 * mi + 4 * g4 + rg) * 64 + 16 * nj + r16] = acc[nj][rg];
        }
    }
}
DI void ph_hgrn_B(Ctx& K) {
    const int gt = K.bid * NTHREADS + K.tid;
    if (gt < 16 * 4096) {
        const int chain = gt >> 12, idx = gt & 4095, d = idx & 63;
        float* st = K.ST() + (size_t)chain * HG_NCH * 4096 + idx; const float* ac = K.AC() + (size_t)chain * HG_NCH * 64 + d;
        float S = 0.f;
#pragma unroll 1
        for (int c0 = 0; c0 < HG_NCH; c0 += 26) {
            float u[26], a[26];
#pragma unroll
            for (int i = 0; i < 26; ++i) { u[i] = st[(size_t)(c0 + i) * 4096]; a[i] = ac[(c0 + i) * 64]; }
#pragma unroll
            for (int i = 0; i < 26; ++i) { st[(size_t)(c0 + i) * 4096] = S; S = a[i] * S + u[i]; }
        }
    }
}
DI void ph_hgrn_C(Ctx& K) {
    float* LF = (float*)(K.lds + HGL_LF); float* OM = (float*)(K.lds + HGL_OM); bf16_t* VT = (bf16_t*)(K.lds + HGL_VT); float* OD = (float*)(K.lds + HGL_OD);
    bf16_t* SC = (bf16_t*)(K.lds + HGL_SC) + K.wave * 16 * HG_TS;
    const int r16 = K.lane & 15, g4 = K.lane >> 4;
    for (int item = K.bid; item < NB * 4 * HG_NCH; item += K.nb) {
        const int tb = item % HG_NCH, h = (item / HG_NCH) & 3, b = item / (HG_NCH * 4);
        __syncthreads();
        hg_prep(K, b, h, tb);
        { const int dir = K.wave >> 2, mi = K.wave & 3; const int chain = (b * 2 + dir) * 4 + h, ch = dir ? hg_bwd_chunk(tb) : tb;
          const float* LFd = LF + dir * 64 * HG_LFS; const float* OMd = OM + dir * 64 * HG_LFS; const float* ref = LFd + 32 * HG_LFS;
          bf16x8_t aq1[2], aq2[2];
          { const int t = 16 * mi + r16; const bf16_t* qr = K.P() + (size_t)hg_block_row(b, tb, t) * PW + C_HQ + h * 64;
#pragma unroll
            for (int ks = 0; ks < 2; ++ks) { const int d0 = 32 * ks + 8 * g4; float q[8]; unpack8(*(const u32x4*)(qr + d0), q);
                u32x4 w1, w2; unsigned o1[4], o2[4];
#pragma unroll
                for (int j = 0; j < 4; ++j) { float x1[2], x2[2];
#pragma unroll
                    for (int e = 0; e < 2; ++e) { const int dd = d0 + 2 * j + e; const float qs = q[2 * j + e] * sigmoidf_(q[2 * j + e]); const float bt = LFd[t * HG_LFS + dd]; x1[e] = qs * __expf(bt - ref[dd]); x2[e] = qs * __expf(bt); }
                    o1[j] = pk2(x1[0], x1[1]); o2[j] = pk2(x2[0], x2[1]); }
                w1 = (u32x4){o1[0], o1[1], o1[2], o1[3]}; w2 = (u32x4){o2[0], o2[1], o2[2], o2[3]};
                aq1[ks] = __builtin_bit_cast(bf16x8_t, w1); aq2[ks] = __builtin_bit_cast(bf16x8_t, w2); } }
          f32x4 sc[4];
#pragma unroll
          for (int nj = 0; nj < 4; ++nj) { sc[nj] = (f32x4){0.f, 0.f, 0.f, 0.f}; const int s_ = 16 * nj + r16;
#pragma unroll
              for (int ks = 0; ks < 2; ++ks) { const int d0 = 32 * ks + 8 * g4; unsigned o[4];
#pragma unroll
                  for (int j = 0; j < 4; ++j) { const int dd = d0 + 2 * j; o[j] = pk2(OMd[s_ * HG_LFS + dd] * __expf(ref[dd] - LFd[s_ * HG_LFS + dd]), OMd[s_ * HG_LFS + dd + 1] * __expf(ref[dd + 1] - LFd[s_ * HG_LFS + dd + 1])); }
                  const u32x4 w = (u32x4){o[0], o[1], o[2], o[3]};
                  sc[nj] = MFMA16(aq1[ks], __builtin_bit_cast(bf16x8_t, w), sc[nj]); } }
#pragma unroll
          for (int nj = 0; nj < 4; ++nj)
#pragma unroll
              for (int rg = 0; rg < 4; ++rg) { const int tl = 4 * g4 + rg, t = 16 * mi + tl, s_ = 16 * nj + r16; const bool keep = dir ? (s_ >= t) : (s_ <= t);
                  SC[tl * HG_TS + s_] = f2bf(keep ? sc[nj][rg] : 0.f); }
          asm volatile("s_waitcnt lgkmcnt(0)" ::: "memory");
          f32x4 oacc[4];
#pragma unroll
          for (int nj = 0; nj < 4; ++nj) oacc[nj] = (f32x4){0.f, 0.f, 0.f, 0.f};
          const float* st = K.ST() + ((size_t)chain * HG_NCH + ch) * 4096;
#pragma unroll
          for (int ks = 0; ks < 2; ++ks) {
              const bf16x8_t as = *(const bf16x8_t*)(SC + r16 * HG_TS + 32 * ks + 8 * g4);
#pragma unroll
              for (int nj = 0; nj < 4; ++nj) {
                  const bf16x8_t bv = *(const bf16x8_t*)(VT + (16 * nj + r16) * HG_TS + 32 * ks + 8 * g4);
                  oacc[nj] = MFMA16(as, bv, oacc[nj]);
                  const float* sp = st + (16 * nj + r16) * 64 + 32 * ks + 8 * g4; const f32x4 s0 = *(const f32x4*)sp, s1 = *(const f32x4*)(sp + 4);
                  const u32x4 w = (u32x4){pk2(s0.x, s0.y), pk2(s0.z, s0.w), pk2(s1.x, s1.y), pk2(s1.z, s1.w)};
                  oacc[nj] = MFMA16(aq2[ks], __builtin_bit_cast(bf16x8_t, w), oacc[nj]);
              }
          }
#pragma unroll
          for (int nj = 0; nj < 4; ++nj)
#pragma unroll
              for (int rg = 0; rg < 4; ++rg) OD[(dir * 64 + 16 * mi + 4 * g4 + rg) * HG_LFS + 16 * nj + r16] = oacc[nj][rg];
        }
        __syncthreads();
        { const int tok = K.tid >> 3, c = K.tid & 7; const int row = hg_block_row(b, tb, tok);
          const float* o0 = OD + tok * HG_LFS + 8 * c; const float* o1 = OD + (64 + tok) * HG_LFS + 8 * c;
          float o[8], ss = 0.f;
#pragma unroll
          for (int j = 0; j < 8; ++j) { o[j] = o0[j] + o1[j]; ss += o[j] * o[j]; }
          ss += __shfl_xor(ss, 1); ss += __shfl_xor(ss, 2); ss += __shfl_xor(ss, 4);
          const float rs = rsqrtf(ss * (1.0f / 64.0f) + EPS);
          float gq[8]; unpack8(*(const u32x4*)(K.P() + (size_t)row * PW + C_HG + h * 64 + 8 * c), gq);
          const float* nw = ARG(hgrn_norm_w) + (size_t)K.l * 256 + h * 64 + 8 * c;
          float y[8];
#pragma unroll
          for (int j = 0; j < 8; ++j) y[j] = o[j] * rs * nw[j] * gq[j] * sigmoidf_(gq[j]);
          u32x4 w; w.x = pk2(y[0], y[1]); w.y = pk2(y[2], y[3]); w.z = pk2(y[4], y[5]); w.w = pk2(y[6], y[7]);
          *(u32x4*)(K.MIX() + (size_t)row * D + MX_H + h * 64 + 8 * c) = w; }
    }
}

constexpr int AT_TS = 72;
constexpr int ATL_K = 0, ATL_V = ATL_K + 64 * AT_TS * 2, ATL_P = ATL_V + 64 * AT_TS * 2, ATL_END = ATL_P + 8 * 48 * AT_TS * 2;
static_assert(ATL_END <= LDS_BYTES - 256, "attention LDS map");
DI float dpp_max16(float x) { x = fmaxf(x, dpp_<0xB1>(x)); x = fmaxf(x, dpp_<0x4E>(x)); x = fmaxf(x, dpp_<0x141>(x)); x = fmaxf(x, dpp_<0x128>(x)); return x; }
DI float dpp_sum16(float x) { x += dpp_<0xB1>(x); x += dpp_<0x4E>(x); x += dpp_<0x141>(x); x += dpp_<0x128>(x); return x; }
template <int KIND> DI void attn_item(Ctx& K, int idx, const float* sinkp, const float* rpbp) {
    constexpr int MT = KIND == 0 ? 3 : 2;
    int tid_ = K.tid; asm volatile("" : "+v"(tid_));
    const int lane_ = tid_ & 63, wave_ = tid_ >> 6;
    bf16_t* KT = (bf16_t*)(K.lds + ATL_K); bf16_t* VT = (bf16_t*)(K.lds + ATL_V); bf16_t* PS = (bf16_t*)(K.lds + ATL_P) + wave_ * 48 * AT_TS;
    const int r16 = lane_ & 15, g4 = lane_ >> 4;
    int b, hk, qb = 0;
    if (KIND == 0) { qb = idx & 127; hk = (idx >> 7) & 1; b = idx >> 8; }
    else if (KIND == 1) { qb = idx & 63; hk = (idx >> 6) % 6; b = (idx >> 6) / 6; }
    else { hk = idx % 6; b = idx / 6; }
    const int kcol = (KIND == 0) ? C_SK + hk * 64 : (KIND == 2) ? C_SK + (hk / 3) * 64 : C_NK + hk * 64;
    const int vcol = (KIND == 0) ? C_SV + hk * 64 : (KIND == 2) ? C_SV + (hk / 3) * 64 : C_NV + hk * 64;
    int t0 = 0, nloc = 0;
    if (KIND == 0) { const int k0 = max(2 * qb - 2, 0), k1 = min(2 * qb + 3, L / 64 - 1); t0 = k0; nloc = k1 - k0 + 1; }
    if (KIND == 1) { const int k0 = min(max(4 * qb - 4, 0), L / 64 - 8), k1 = min(max(4 * qb + 3 - 4, 0), L / 64 - 8) + 7; t0 = k0; nloc = k1 - k0 + 1; }
    const int ntiles = nloc + CL / 64;
    int w_r = 0, w_rs = 0;
    if (KIND == 1) { w_r = 4 * qb + (wave_ >> 1); w_rs = min(max(w_r - 4, 0), L / 64 - 8); }
    bf16x8_t qf[MT][2]; int qbase[MT], hq_mt[MT];
#pragma unroll
    for (int mt = 0; mt < MT; ++mt) {
        int arow, hq;
        if (KIND == 0) { const int rho = wave_ * 48 + mt * 16; hq = hk * 3 + rho / 128; hq_mt[mt] = hq; const int tb = 128 * qb + (rho & 127); arow = lat_row(b, tb + r16); qbase[mt] = tb; }
        else if (KIND == 1) { hq = hk; hq_mt[mt] = hq; const int cb = 32 * (wave_ & 1) + 16 * mt; arow = lat_row(b, w_r * 64 + cb + r16); qbase[mt] = cb; }
        else { hq = hk; hq_mt[mt] = hq; const int tb = wave_ * 32 + mt * 16; arow = ctx_row(b, tb + r16); qbase[mt] = 0; }
        const int qcol = (KIND == 0 || KIND == 2) ? C_SQ + hq * 64 : C_NQ + hq * 64;
#pragma unroll
        for (int ks = 0; ks < 2; ++ks) { float q[8]; unpack8(*(const u32x4*)(K.P() + (size_t)arow * PW + qcol + 32 * ks + 8 * g4), q);
            const u32x4 w = (u32x4){pk2(q[0] * 0.125f, q[1] * 0.125f), pk2(q[2] * 0.125f, q[3] * 0.125f), pk2(q[4] * 0.125f, q[5] * 0.125f), pk2(q[6] * 0.125f, q[7] * 0.125f)};
            qf[mt][ks] = __builtin_bit_cast(bf16x8_t, w); }
    }
    f32x4 oacc[MT][4]; float mrun[MT][4], lrun[MT][4];
#pragma unroll
    for (int mt = 0; mt < MT; ++mt) {
#pragma unroll
        for (int ne = 0; ne < 4; ++ne) oacc[mt][ne] = (f32x4){0.f, 0.f, 0.f, 0.f};
        const bool has_sink = (KIND == 0 || KIND == 2); const float sk = has_sink ? sinkp[hq_mt[mt]] : -1.0e30f;
#pragma unroll
        for (int rg = 0; rg < 4; ++rg) { mrun[mt][rg] = sk; lrun[mt][rg] = has_sink ? 1.0f : 0.0f; }
    }
    const int lkey = tid_ >> 3, lch = tid_ & 7;
    u32x4 pk_, pv_;
    { const int ti = 0; const int grow = (ti < nloc) ? lat_row(b, (t0 + ti) * 64 + lkey) : ctx_row(b, (ti - nloc) * 64 + lkey);
      const bf16_t* pr = K.P() + (size_t)grow * PW + 8 * lch; pk_ = *(const u32x4*)(pr + kcol); pv_ = *(const u32x4*)(pr + vcol); }
#pragma unroll 1
    for (int ti = 0; ti < ntiles; ++ti) {
        __syncthreads();
        *(u32x4*)(KT + lkey * AT_TS + 8 * lch) = pk_;
        { const unsigned w[4] = {pv_.x, pv_.y, pv_.z, pv_.w};
#pragma unroll
          for (int j = 0; j < 4; ++j) { VT[(8 * lch + 2 * j) * AT_TS + lkey] = (bf16_t)(w[j] & 0xffffu); VT[(8 * lch + 2 * j + 1) * AT_TS + lkey] = (bf16_t)(w[j] >> 16); } }
        __syncthreads();
        if (ti + 1 < ntiles) { const int tn = ti + 1; const int grow = (tn < nloc) ? lat_row(b, (t0 + tn) * 64 + lkey) : ctx_row(b, (tn - nloc) * 64 + lkey);
            const bf16_t* pr = K.P() + (size_t)grow * PW + 8 * lch; pk_ = *(const u32x4*)(pr + kcol); pv_ = *(const u32x4*)(pr + vcol); }
        const bool local = ti < nloc; const int kunit = t0 + ti;
        bool active = true;
        if (KIND == 0 && local) active = true;
        if (KIND == 1 && local) active = (kunit >= w_rs) && (kunit < w_rs + 8);
        if (active) {
            f32x4 sc[MT][4];
#pragma unroll
            for (int mt = 0; mt < MT; ++mt)
#pragma unroll
                for (int nj = 0; nj < 4; ++nj) sc[mt][nj] = (f32x4){0.f, 0.f, 0.f, 0.f};
#pragma unroll
            for (int nj = 0; nj < 4; ++nj)
#pragma unroll
                for (int ks = 0; ks < 2; ++ks) { const bf16x8_t kf = *(const bf16x8_t*)(KT + (16 * nj + r16) * AT_TS + 32 * ks + 8 * g4);
#pragma unroll
                    for (int mt = 0; mt < MT; ++mt) sc[mt][nj] = MFMA16(qf[mt][ks], kf, sc[mt][nj]); }
            if (local) {
#pragma unroll
                for (int mt = 0; mt < MT; ++mt)
#pragma unroll
                    for (int nj = 0; nj < 4; ++nj)
#pragma unroll
                        for (int rg = 0; rg < 4; ++rg) { const int key = 16 * nj + r16;
                            if (KIND == 0) { const int dl = qbase[mt] + 4 * g4 + rg - (kunit * 64 + key); if (dl > 128 || dl < -128) sc[mt][nj][rg] = -INFINITY; }
                            if (KIND == 1) { const int c = qbase[mt] + 4 * g4 + rg, ws = min(max(c - 8, 0), 48);
                                if (key >= ws && key < ws + 16) sc[mt][nj][rg] += rpbp[(kunit - w_r + 7) * 31 + (key - c + 15)]; else sc[mt][nj][rg] = -INFINITY; } }
            }
#pragma unroll
            for (int mt = 0; mt < MT; ++mt)
#pragma unroll
                for (int rg = 0; rg < 4; ++rg) {
                    float mx = fmaxf(fmaxf(sc[mt][0][rg], sc[mt][1][rg]), fmaxf(sc[mt][2][rg], sc[mt][3][rg]));
                    mx = dpp_max16(mx);
                    const float mn = fmaxf(mrun[mt][rg], mx), alpha = __expf(mrun[mt][rg] - mn); mrun[mt][rg] = mn;
                    float rs_ = 0.f;
#pragma unroll
                    for (int nj = 0; nj < 4; ++nj) { const float pe = __expf(sc[mt][nj][rg] - mn); sc[mt][nj][rg] = pe; rs_ += pe; }
                    rs_ = dpp_sum16(rs_);
                    lrun[mt][rg] = lrun[mt][rg] * alpha + rs_;
#pragma unroll
                    for (int ne = 0; ne < 4; ++ne) oacc[mt][ne][rg] *= alpha;
                }
#pragma unroll
            for (int mt = 0; mt < MT; ++mt)
#pragma unroll
                for (int nj = 0; nj < 4; ++nj)
#pragma unroll
                    for (int rg = 0; rg < 4; ++rg) PS[(16 * mt + 4 * g4 + rg) * AT_TS + 16 * nj + r16] = f2bf(sc[mt][nj][rg]);
            asm volatile("s_waitcnt lgkmcnt(0)" ::: "memory");
#pragma unroll
            for (int ks = 0; ks < 2; ++ks) {
                bf16x8_t pf[MT];
#pragma unroll
                for (int mt = 0; mt < MT; ++mt) pf[mt] = *(const bf16x8_t*)(PS + (16 * mt + r16) * AT_TS + 32 * ks + 8 * g4);
#pragma unroll
                for (int ne = 0; ne < 4; ++ne) { const bf16x8_t vf = *(const bf16x8_t*)(VT + (16 * ne + r16) * AT_TS + 32 * ks + 8 * g4);
#pragma unroll
                    for (int mt = 0; mt < MT; ++mt) oacc[mt][ne] = MFMA16(pf[mt], vf, oacc[mt][ne]); }
            }
            asm volatile("s_waitcnt lgkmcnt(0)" ::: "memory");
        }
    }
#pragma unroll
    for (int mt = 0; mt < MT; ++mt)
#pragma unroll
        for (int rg = 0; rg < 4; ++rg) { const float inv = 1.0f / lrun[mt][rg];
#pragma unroll
            for (int ne = 0; ne < 4; ++ne) PS[(16 * mt + 4 * g4 + rg) * AT_TS + 16 * ne + r16] = f2bf(oacc[mt][ne][rg] * inv); }
    asm volatile("s_waitcnt lgkmcnt(0)" ::: "memory");
#pragma unroll
    for (int mt = 0; mt < MT; ++mt) {
        const int ocol = ((KIND == 0 || KIND == 2) ? MX_S : MX_N) + hq_mt[mt] * 64;
#pragma unroll
        for (int i = 0; i < 2; ++i) { const int rr = (lane_ >> 3) + 8 * i, ch = lane_ & 7;
            const u32x4 v = *(const u32x4*)(PS + (16 * mt + rr) * AT_TS + 8 * ch);
            int grow;
            if (KIND == 0) { const int rho = wave_ * 48 + mt * 16; grow = lat_row(b, 128 * qb + (rho & 127) + rr); }
            else if (KIND == 1) grow = lat_row(b, w_r * 64 + 32 * (wave_ & 1) + 16 * mt + rr);
            else grow = ctx_row(b, wave_ * 32 + mt * 16 + rr);
            *(u32x4*)(K.MIX() + (size_t)grow * D + ocol + 8 * ch) = v; }
    }
    asm volatile("s_waitcnt lgkmcnt(0)" ::: "memory");
}
DI void ph_attn(Ctx& K) {
    constexpr int N_SWA = NB * 2 * (L / 128), N_NAT = NB * 6 * (L / 256), N_C = NB * 6;
    const float* sinkp = ARG(swa_sink) + K.l * 6;
    for (int item = K.bid; item < N_SWA + N_NAT + 2 * N_C; item += K.nb) {
        if (item < N_SWA) attn_item<0>(K, item, sinkp, nullptr);
        else if (item < N_SWA + N_NAT) { const int it = item - N_SWA; const int h = (it >> 6) % 6; attn_item<1>(K, it, nullptr, ARG(nat_rpb) + ((size_t)K.l * 6 + h) * 15 * 31); }
        else if (item < N_SWA + N_NAT + N_C) attn_item<2>(K, item - N_SWA - N_NAT, sinkp, nullptr);
        else attn_item<3>(K, item - N_SWA - N_NAT - N_C, nullptr, nullptr);
    }
}

DI unsigned fkey(float f) { const unsigned u = __float_as_uint(f); return (u & 0x80000000u) ? ~u : (u | 0x80000000u); }
DI int mbcnt64(unsigned long long m) { return (int)__builtin_amdgcn_mbcnt_hi((unsigned)(m >> 32), __builtin_amdgcn_mbcnt_lo((unsigned)m, 0u)); }
template <int NV> DI unsigned radix_thr16(const unsigned (&k)[NV]) {
    unsigned prefix = 0u;
#pragma unroll 1
    for (int bit = 31; bit >= 0; --bit) {
        const unsigned cand = prefix | (1u << bit); int cnt = 0;
#pragma unroll
        for (int i = 0; i < NV; ++i) cnt += __popcll(__ballot(k[i] >= cand));
        if (cnt >= 16) { prefix = cand; if (cnt == 16) break; }
    }
    return prefix;
}
template <int NC, int NV> DI void radix_thr16_multi(const unsigned (&k)[NC][NV], unsigned (&T)[NC]) {
    bool exact[NC];
#pragma unroll
    for (int c = 0; c < NC; ++c) { T[c] = 0u; exact[c] = false; }
#pragma unroll 1
    for (int bit = 31; bit >= 0; --bit) {
        bool all = true;
#pragma unroll
        for (int c = 0; c < NC; ++c) {
            const unsigned cand = T[c] | (1u << bit); int cnt = 0;
#pragma unroll
            for (int i = 0; i < NV; ++i) cnt += __popcll(__ballot(k[c][i] >= cand));
            if (cnt >= 16) { T[c] = cand; exact[c] = (cnt == 16); }
            all = all && exact[c];
        }
        if (all) break;
    }
}
template <int NV> DI void select16(const unsigned (&k)[NV], unsigned T, bool (&sel)[NV], int (&pos)[NV]) {
    int ngt = 0; unsigned long long gtm[NV], eqm[NV];
#pragma unroll
    for (int i = 0; i < NV; ++i) { gtm[i] = __ballot(k[i] > T); eqm[i] = __ballot(k[i] == T); ngt += __popcll(gtm[i]); }
    const int need = 16 - ngt; int eqbase = 0, selbase = 0;
#pragma unroll
    for (int i = 0; i < NV; ++i) {
        const bool iseq = k[i] == T; const int erank = eqbase + mbcnt64(eqm[i]); eqbase += __popcll(eqm[i]);
        sel[i] = (k[i] > T) || (iseq && erank < need);
        const unsigned long long sm = __ballot(sel[i]); pos[i] = selbase + mbcnt64(sm); selbase += __popcll(sm);
    }
}
template <int CTRL> DI int dppi_(int x) { return __builtin_amdgcn_mov_dpp(x, CTRL, 0xf, 0xf, true); }
DI int row_sum_i(int x) { x += dppi_<0xB1>(x); x += dppi_<0x4E>(x); x += dppi_<0x141>(x); x += dppi_<0x128>(x); return x; }
DI int row_excl_scan_i(int x) { int s_ = x; s_ += dppi_<0x111>(s_); s_ += dppi_<0x112>(s_); s_ += dppi_<0x114>(s_); s_ += dppi_<0x118>(s_); return s_ - x; }
template <int NK> DI unsigned row_radix_thr16(const unsigned (&k)[NK]) {
    unsigned T = 0u; bool exact = false;
#pragma unroll 1
    for (int bit = 31; bit >= 0; --bit) {
        const unsigned cand = T | (1u << bit); int cnt = 0;
#pragma unroll
        for (int i = 0; i < NK; ++i) cnt += (k[i] >= cand) ? 1 : 0;
        cnt = row_sum_i(cnt);
        const bool ge = cnt >= 16; T = ge ? cand : T; exact = ge ? (cnt == 16) : exact;
        if (__ballot(!exact) == 0ull) break;
    }
    return T;
}
template <int NK> DI void row_select16(const unsigned (&k)[NK], unsigned T, bool (&sel)[NK], int (&pos)[NK]) {
    int g = 0, q = 0;
#pragma unroll
    for (int i = 0; i < NK; ++i) { g += (k[i] > T) ? 1 : 0; q += (k[i] == T) ? 1 : 0; }
    const int need = 16 - row_sum_i(g);
    const int a = min(max(need - row_excl_scan_i(q), 0), q);
    int nxt = row_excl_scan_i(g + a), eqs = 0;
#pragma unroll
    for (int i = 0; i < NK; ++i) { const bool iseq = k[i] == T; sel[i] = (k[i] > T) || (iseq && eqs < a); eqs += iseq ? 1 : 0; pos[i] = nxt; nxt += sel[i] ? 1 : 0; }
}
constexpr int PS_SCS = 132;
constexpr int PSL_TOP = 8 * 2 * 16 * PS_SCS * 4;
static_assert(PSL_TOP + 8 * 1024 <= LDS_BYTES - 256, "peer select LDS map");
template <int PROBE> DI void ph_peer_select(Ctx& K) {
    float* SCR = (float*)K.lds + K.wave * 2 * 16 * PS_SCS; float* TOPV = (float*)(K.lds + PSL_TOP + K.wave * 1024); int* TOPI = (int*)(TOPV + 128);
    const int r16 = K.lane & 15, g4 = K.lane >> 4, h = K.wave;
    constexpr int N_IT = M / 16, N_FULL = (N_IT / 256) * 256, N_WORK = N_FULL + 4 * (N_IT - N_FULL);
    for (int wk = K.bid; wk < N_WORK; wk += K.nb) {
        const bool part = wk >= N_FULL; const int item = part ? N_FULL + ((wk - N_FULL) >> 2) : wk; const int tk_lo = part ? 4 * ((wk - N_FULL) & 3) : 0, tk_hi = part ? tk_lo + 4 : 16;
        const int t0 = item * 16;
#pragma unroll 1
        for (int p = 0; p < 2; ++p) {
            bf16x8_t aq[4];
            { const bf16_t* qp = K.QP() + (size_t)(t0 + r16) * 2048 + h * 256 + p * 128 + 8 * g4;
#pragma unroll
              for (int ks = 0; ks < 4; ++ks) aq[ks] = *(const bf16x8_t*)(qp + 32 * ks); }
            const size_t kb = (((size_t)K.l * 8 + h) * 2 + p) * 128 * 128 + (size_t)r16 * 128 + 8 * g4;
#pragma unroll 2
            for (int nt = 0; nt < 8; ++nt) {
                bf16x8_t bh[4], bl[4];
#pragma unroll
                for (int ks = 0; ks < 4; ++ks) { bh[ks] = *(const bf16x8_t*)(K.SKH() + kb + (size_t)(16 * nt) * 128 + 32 * ks); bl[ks] = *(const bf16x8_t*)(K.SKL() + kb + (size_t)(16 * nt) * 128 + 32 * ks); }
                f32x4 c0 = {0.f, 0.f, 0.f, 0.f}, c1 = c0;
#pragma unroll
                for (int ks = 0; ks < 4; ++ks) { c0 = MFMA16(aq[ks], bh[ks], c0); c1 = MFMA16(aq[ks], bl[ks], c1); }
#pragma unroll
                for (int rg = 0; rg < 4; ++rg) SCR[(p * 16 + 4 * g4 + rg) * PS_SCS + 16 * nt + r16] = c0[rg] + c1[rg];
            }
        }
        asm volatile("s_waitcnt lgkmcnt(0)" ::: "memory");
        if (PROBE == 1) continue;
        const int rho = K.lane >> 4, j16 = K.lane & 15;
#pragma unroll 1
        for (int tk = tk_lo; tk < tk_hi; tk += 4) {
#pragma unroll 1
            for (int ps = 0; ps < 2; ++ps) {
                const int p = rho & 1, rr = 2 * ps + (rho >> 1);
                float v[8]; unsigned kk[8];
#pragma unroll
                for (int i = 0; i < 8; ++i) { v[i] = SCR[(p * 16 + tk + rr) * PS_SCS + j16 + 16 * i]; kk[i] = fkey(v[i]); }
                const unsigned T = row_radix_thr16<8>(kk);
                bool sel[8]; int pos[8]; row_select16<8>(kk, T, sel, pos);
#pragma unroll
                for (int i = 0; i < 8; ++i) if (sel[i]) { TOPV[(rr * 2 + p) * 16 + pos[i]] = v[i]; TOPI[(rr * 2 + p) * 16 + pos[i]] = j16 + 16 * i; }
            }
            asm volatile("s_waitcnt lgkmcnt(0)" ::: "memory");
            { const int r = t0 + tk + rho;
              const float vb = TOPV[(rho * 2 + 1) * 16 + j16]; const int ib = TOPI[(rho * 2 + 1) * 16 + j16];
              float cv[16]; unsigned ck[16];
#pragma unroll
              for (int i = 0; i < 16; ++i) { cv[i] = TOPV[(rho * 2) * 16 + i] + vb; ck[i] = fkey(cv[i]); }
              const unsigned T = row_radix_thr16<16>(ck);
              bool sel[16]; int pos[16]; row_select16<16>(ck, T, sel, pos);
              float mx = -3.0e38f;
#pragma unroll
              for (int i = 0; i < 16; ++i) mx = fmaxf(mx, sel[i] ? cv[i] : -3.0e38f);
              mx = dpp_max16(mx);
              float es = 0.f;
#pragma unroll
              for (int i = 0; i < 16; ++i) { cv[i] = sel[i] ? __expf(cv[i] - mx) : 0.f; es += cv[i]; }
              es = dpp_sum16(es);
              const float inv = 1.0f / es;
#pragma unroll
              for (int i = 0; i < 16; ++i) if (sel[i]) { K.PIDX()[(size_t)r * 128 + h * 16 + pos[i]] = TOPI[(rho * 2) * 16 + i] * 128 + ib; K.PG()[(size_t)r * 128 + h * 16 + pos[i]] = cv[i] * inv; }
            }
            asm volatile("s_waitcnt lgkmcnt(0)" ::: "memory");
        }
    }
}

constexpr int PUL_H = 0, PUL_SLOT = 4096, PUL_STRIDE = 4352;
struct PuMeta { float hs[2]; int ia[2], ib[2]; };
DI void pu_load(const Ctx& K, int r0, int step, PuMeta& m, unsigned char* hbuf) {
#pragma unroll
    for (int q = 0; q < 2; ++q) { const int r = r0 + q * step;
        if (r < M) { __builtin_amdgcn_global_load_lds((const unsigned*)(K.H8() + (size_t)r * D + K.lane * 16), (LAS unsigned*)(hbuf + q * 1024), 16, 0, 0);
            m.hs[q] = K.HS()[r]; m.ia[q] = K.PIDX()[(size_t)r * 128 + K.lane]; m.ib[q] = K.PIDX()[(size_t)r * 128 + 64 + K.lane]; }
        else { m.hs[q] = 0.f; m.ia[q] = -1; m.ib[q] = -1; } }
}
typedef int i32x4 __attribute__((ext_vector_type(4)));
template <int PROBE> DI void pu_item(const Ctx& K, const unsigned char* U, unsigned char* HL, int* SLOT, int R, int r0, int step, const PuMeta& m, int r16, int g4, float& dummy) {
    const float hs[2] = {m.hs[0], m.hs[1]};
    bool sa[2], sb[2]; int ra[2], rb[2]; int n = 0;
#pragma unroll
    for (int q = 0; q < 2; ++q) { sa[q] = (m.ia[q] >> 11) == R; sb[q] = (m.ib[q] >> 11) == R; const unsigned long long ma = __ballot(sa[q]), mb = __ballot(sb[q]);
        ra[q] = n + mbcnt64(ma); n += __popcll(ma); rb[q] = n + mbcnt64(mb); n += __popcll(mb); }
#pragma unroll 1
    for (int base = 0; base < n; base += 32) {
#pragma unroll
        for (int q = 0; q < 2; ++q) {
            if (sa[q] && ra[q] >= base && ra[q] < base + 32) { SLOT[2 * (ra[q] - base)] = m.ia[q]; SLOT[2 * (ra[q] - base) + 1] = q * 128 + K.lane; }
            if (sb[q] && rb[q] >= base && rb[q] < base + 32) { SLOT[2 * (rb[q] - base)] = m.ib[q]; SLOT[2 * (rb[q] - base) + 1] = q * 128 + 64 + K.lane; } }
        asm volatile("s_waitcnt lgkmcnt(0)" ::: "memory");
        const unsigned char* hp = HL + (r16 >> 3) * 1024 + 16 * g4;
        const bool two = base + 16 < n;
        const int e0 = (base + r16 < n) ? SLOT[2 * r16] : SLOT[0];
        const int e1 = (base + 16 + r16 < n) ? SLOT[2 * (16 + r16)] : SLOT[0];
        const unsigned char* up0 = U + (size_t)e0 * D + 16 * g4; const unsigned char* up1 = U + (size_t)e1 * D + 16 * g4;
        i32x4 av0[16], av1[16];
#pragma unroll
        for (int s_ = 0; s_ < 16; ++s_) av0[s_] = *(const i32x4*)(up0 + 64 * s_);
        if (two) {
#pragma unroll
            for (int s_ = 0; s_ < 16; ++s_) av1[s_] = *(const i32x4*)(up1 + 64 * s_); }
        const int rg = r16 & 3; bool fin[2]; int fcode[2]; float fus[2], fvs[2];
#pragma unroll
        for (int t = 0; t < 2; ++t) { const int sl = 16 * t + 4 * g4 + rg; fin[t] = false; fcode[t] = 0; fus[t] = 0.f; fvs[t] = 0.f;
            if ((r16 & 7) < 4 && base + sl < n) { const int code = SLOT[2 * sl + 1];
                if ((code >> 7) == (r16 >> 3)) { const size_t eo = (size_t)K.l * 16384 + SLOT[2 * sl]; fin[t] = true; fcode[t] = code; fus[t] = K.US()[eo]; fvs[t] = K.VS()[eo]; } } }
        i32x4 acc[2] = {{0, 0, 0, 0}, {0, 0, 0, 0}};
#pragma unroll
        for (int s_ = 0; s_ < 16; ++s_) { const i32x4 hb = *(const i32x4*)(hp + 64 * s_); acc[0] = __builtin_amdgcn_mfma_i32_16x16x64_i8(av0[s_], hb, acc[0], 0, 0, 0); }
        if (two) {
#pragma unroll
            for (int s_ = 0; s_ < 16; ++s_) { const i32x4 hb = *(const i32x4*)(hp + 64 * s_); acc[1] = __builtin_amdgcn_mfma_i32_16x16x64_i8(av1[s_], hb, acc[1], 0, 0, 0); } }
#pragma unroll
        for (int t = 0; t < 2; ++t) {
            const int di = rg == 0 ? acc[t][0] : rg == 1 ? acc[t][1] : rg == 2 ? acc[t][2] : acc[t][3];
            if (fin[t]) { const int code = fcode[t];
                const float d = (float)di * fus[t] * ((code >> 7) ? hs[1] : hs[0]);
                if (PROBE >= 2) dummy += gelu_erf(d);
                else (PROBE ? K.ST() : K.PA())[(size_t)(r0 + (code >> 7) * step) * 128 + (code & 127)] = gelu_erf(d) * fvs[t]; }
        }
        asm volatile("s_waitcnt lgkmcnt(0)" ::: "memory");
    }
}
template <int PROBE> DI void ph_peer_u(Ctx& K) {
    const unsigned char* U = (const unsigned char*)K.UB() + (size_t)K.l * 16384 * D;
    unsigned char* HB = K.lds + K.wave * PUL_STRIDE; int* SLOT = (int*)(HB + PUL_SLOT);
    const int r16 = K.lane & 15, g4 = K.lane >> 4;
    const int step = K.nloc * NWAVES;
    float dummy = 0.f;
    for (int R = K.xg; R < 8; R += K.nxg) {
        int r = K.jx * NWAVES + K.wave; int par = 0;
        PuMeta cur, nxt;
        pu_load(K, r, step, cur, HB);
#pragma unroll 1
        for (; r < M; r += 2 * step) {
            asm volatile("s_waitcnt vmcnt(0)" ::: "memory");
            pu_load(K, r + 2 * step, step, nxt, HB + (par ^ 1) * 2048);
            pu_item<PROBE>(K, U, HB + par * 2048, SLOT, R, r, step, cur, r16, g4, dummy);
            cur = nxt; par ^= 1;
        }
    }
    if (PROBE >= 2) K.ST()[K.gw * 64 + K.lane] = dummy;
}
struct PvMeta { int ia, ib; float ga, gb, pa, pb; };
template <int PROBE> DI void pv_load(const Ctx& K, int r, PvMeta& m) {
    m.ia = K.PIDX()[(size_t)r * 128 + K.lane]; m.ib = K.PIDX()[(size_t)r * 128 + 64 + K.lane];
    m.ga = K.PG()[(size_t)r * 128 + K.lane]; m.pa = K.PA()[(size_t)r * 128 + K.lane]; m.gb = K.PG()[(size_t)r * 128 + 64 + K.lane]; m.pb = K.PA()[(size_t)r * 128 + 64 + K.lane];
}
template <int HALF, int PROBE> DI void pv_issue(const unsigned char* V, int slot, const PvMeta& m, u32x4 (&vv)[8], float (&ww)[8]) {
    const float w = HALF ? m.gb * m.pb : m.ga * m.pa; const int ix = HALF ? m.ib : m.ia;
#pragma unroll
    for (int i = 0; i < 8; ++i) {
        const int src = ((8 * i + slot) << 2);
        const int e = __builtin_amdgcn_ds_bpermute(src, ix);
        ww[i] = __uint_as_float((unsigned)__builtin_amdgcn_ds_bpermute(src, (int)__float_as_uint(w)));
        vv[i] = PROBE == 2 ? (u32x4){(unsigned)e, 1u, 2u, 3u} : *(const u32x4*)(V + (size_t)e * 128);
    }
}
typedef float f32x2_ __attribute__((ext_vector_type(2)));
DI void pv_accum(const u32x4 (&vv)[8], const float (&ww)[8], f32x2_ (&y)[8], float& sw) {
#pragma unroll
    for (int i = 0; i < 8; ++i) { sw += ww[i]; const unsigned w4[4] = {vv[i].x, vv[i].y, vv[i].z, vv[i].w}; const f32x2_ w2 = {ww[i], ww[i]};
#pragma unroll
        for (int q = 0; q < 4; ++q) { const f32x2_ lo = {(float)(w4[q] & 0xffu), (float)((w4[q] >> 8) & 0xffu)}, hi = {(float)((w4[q] >> 16) & 0xffu), (float)(w4[q] >> 24)};
            y[2 * q] = __builtin_elementwise_fma(w2, lo, y[2 * q]); y[2 * q + 1] = __builtin_elementwise_fma(w2, hi, y[2 * q + 1]); } }
}
template <int PROBE> DI void ph_peer_v(Ctx& K) {
    const int slot = K.lane >> 3, c = K.lane & 7;
    const float* gate = K.MOD() + (size_t)K.l * 3 * 6 * D + 5 * D;
    const int step = K.nloc * NWAVES;
    float* Xb = PROBE ? (float*)K.P() : K.X();
    for (int S = K.xg; S < 8; S += K.nxg) {
        const unsigned char* V = (const unsigned char*)K.VB() + ((size_t)K.l * 8 + S) * 16384 * 128 + c * 16;
        const int c0 = S * 128 + c * 16;
        const int r0 = K.jx * NWAVES + K.wave;
        const int nit = r0 < M ? (M - 1 - r0) / step + 1 : 0;
        PvMeta mA, mB; pv_load<PROBE>(K, min(r0, M - 1), mA); pv_load<PROBE>(K, min(r0 + step, M - 1), mB);
        f32x4 xq[4], xprev[4], x2[4], gp[4]; float yp[16]; int rp = -1, mvp = -1; PvMeta m2;
#pragma unroll
        for (int q = 0; q < 4; ++q) { xq[q] = *(const f32x4*)(Xb + (size_t)min(r0, M - 1) * D + c0 + 4 * q); xprev[q] = (f32x4){0.f, 0.f, 0.f, 0.f}; gp[q] = xprev[q]; }
#pragma unroll
        for (int q = 0; q < 16; ++q) yp[q] = 0.f;
#define PV_BODY(XPREV, XQ, XNEW, MA, MC, IT) do { \
            const int r = r0 + (IT) * step; \
            if (rp >= 0) { const int mv = modvec_of_row(rp); \
                if (mv != mvp) { mvp = mv; \
                    _Pragma("unroll") for (int q = 0; q < 4; ++q) gp[q] = *(const f32x4*)(gate + (size_t)mv * 6 * D + c0 + 4 * q); } } \
            { const float zdep = MA.ga * 0.0f; \
                _Pragma("unroll") for (int q = 0; q < 4; ++q) { XPREV[q].x += gp[q].x * yp[4 * q] + zdep; XPREV[q].y += gp[q].y * yp[4 * q + 1] + zdep; XPREV[q].z += gp[q].z * yp[4 * q + 2] + zdep; XPREV[q].w += gp[q].w * yp[4 * q + 3] + zdep; } \
                if (rp >= 0 && slot == 0) { float* xr = Xb + (size_t)rp * D + c0; \
                    _Pragma("unroll") for (int q = 0; q < 4; ++q) *(f32x4*)(xr + 4 * q) = XPREV[q]; } } \
            __builtin_amdgcn_sched_barrier(0); \
            u32x4 vA[8], vB[8]; float wA[8], wB[8]; \
            pv_issue<0, PROBE>(V, slot, MA, vA, wA); \
            pv_issue<1, PROBE>(V, slot, MA, vB, wB); \
            __builtin_amdgcn_sched_barrier(0); \
            { const float* xr = Xb + (size_t)min(r + step, M - 1) * D + c0; \
              _Pragma("unroll") for (int q = 0; q < 4; ++q) XNEW[q] = *(const f32x4*)(xr + 4 * q); } \
            pv_load<PROBE>(K, min(r + 2 * step, M - 1), MC); \
            __builtin_amdgcn_sched_barrier(0); \
            f32x2_ y2[8]; float sw = 0.f; \
            _Pragma("unroll") for (int i = 0; i < 8; ++i) y2[i] = (f32x2_){0.f, 0.f}; \
            pv_accum(vA, wA, y2, sw); \
            pv_accum(vB, wB, y2, sw); \
            _Pragma("unroll") for (int q = 0; q < 8; ++q) { yp[2 * q] = y2[q].x - 128.f * sw; yp[2 * q + 1] = y2[q].y - 128.f * sw; } \
            _Pragma("unroll") for (int q = 0; q < 16; ++q) { float v = yp[q]; v += dpp_<0x128>(v); \
                auto s1 = __builtin_amdgcn_permlane16_swap(__float_as_uint(v), __float_as_uint(v), false, false); v = __uint_as_float(s1[0]) + __uint_as_float(s1[1]); \
                auto s2 = __builtin_amdgcn_permlane32_swap(__float_as_uint(v), __float_as_uint(v), false, false); yp[q] = __uint_as_float(s2[0]) + __uint_as_float(s2[1]); } \
            rp = r; } while (0)
        f32x4 (*xfin)[4] = nullptr; (void)xfin;
        int it = 0;
#pragma unroll 1
        for (; it + 2 < nit; it += 3) {
            PV_BODY(xprev, xq, x2, mA, m2, it);
            PV_BODY(xq, x2, xprev, mB, mA, it + 1);
            PV_BODY(x2, xprev, xq, m2, mB, it + 2);
        }
        if (it < nit) { PV_BODY(xprev, xq, x2, mA, m2, it); ++it;
            if (it < nit) { PV_BODY(xq, x2, xprev, mB, mA, it); ++it;
#pragma unroll
                for (int q = 0; q < 4; ++q) xprev[q] = x2[q]; }
            else {
#pragma unroll
                for (int q = 0; q < 4; ++q) xprev[q] = xq[q]; } }
#undef PV_BODY
        if (rp >= 0) { const int mv = modvec_of_row(rp);
#pragma unroll
            for (int q = 0; q < 4; ++q) gp[q] = *(const f32x4*)(gate + (size_t)mv * 6 * D + c0 + 4 * q);
            if (slot == 0) { float* xr = Xb + (size_t)rp * D + c0;
#pragma unroll
                for (int q = 0; q < 4; ++q) { f32x4 x = xprev[q];
                    x.x += gp[q].x * yp[4 * q]; x.y += gp[q].y * yp[4 * q + 1]; x.z += gp[q].z * yp[4 * q + 2]; x.w += gp[q].w * yp[4 * q + 3]; *(f32x4*)(xr + 4 * q) = x; } } }
    }
}

DI void ph_final(Ctx& K) {
    for (int r = K.gw; r < NLAT; r += K.ngw) {
        const f32x4* xr = (const f32x4*)(K.X() + (size_t)(NCTX + r) * D); f32x4* o = (f32x4*)(((float*)argp_<float>(K, (unsigned)__builtin_offsetof(Args, out))) + (size_t)r * D);
        f32x4 v[4]; float ss = 0.f;
#pragma unroll
        for (int j = 0; j < 4; ++j) { v[j] = xr[j * 64 + K.lane]; ss += v[j].x * v[j].x + v[j].y * v[j].y + v[j].z * v[j].z + v[j].w * v[j].w; }
        ss = wave_sum(ss); const float rs = rsqrtf(ss * (1.0f / D) + EPS);
#pragma unroll
        for (int j = 0; j < 4; ++j) { const f32x4 w = ((const f32x4*)ARG(final_norm_w))[j * 64 + K.lane]; o[j * 64 + K.lane] = v[j] * rs * w; }
    }
}

#define XB_TMO      128
#define XB_XSUB(j)  (1280 + 64 * (j))
#define XB_XGEN(j)  (2304 + 64 * (j))
#define XB_TOP      3328
#define XB_TOPGEN   3392
#define XB_SPIN_CAP (1u << 22)
constexpr int CW_BAR = 4096;
DI unsigned xb_ld(unsigned* p)              { return __hip_atomic_load(p, __ATOMIC_RELAXED, __HIP_MEMORY_SCOPE_AGENT); }
DI unsigned xb_add(unsigned* p, unsigned v) { return __hip_atomic_fetch_add(p, v, __ATOMIC_RELAXED, __HIP_MEMORY_SCOPE_AGENT); }
#define XB_SPIN(cond, bar) do { unsigned _sp = 0; while (cond) { __builtin_amdgcn_s_sleep(1); \
    if ((++_sp & 255u) == 0u) { if (xb_ld(&(bar)[XB_TMO])) break; if (_sp > XB_SPIN_CAP) { atomicAdd(&(bar)[XB_TMO], 1u); break; } } } } while (0)
DI void xcd_barrier(unsigned* bar, unsigned x, unsigned nloc, unsigned nx) {
    asm volatile("s_waitcnt vmcnt(0)" ::: "memory");
    __syncthreads();
    if (threadIdx.x == 0) {
        __builtin_amdgcn_s_waitcnt(0);
        const unsigned old = xb_add(&bar[XB_XSUB(x)], 1u);
        const unsigned gen = old / nloc;
        if (old + 1u == (gen + 1u) * nloc) {
            __builtin_amdgcn_fence(__ATOMIC_RELEASE, "agent");
            asm volatile("s_waitcnt vmcnt(0)" ::: "memory");
            const unsigned og = xb_add(&bar[XB_TOP], 1u);
            const unsigned tg = og / nx;
            if (og + 1u == (tg + 1u) * nx) xb_add(&bar[XB_TOPGEN], 1u);
            else XB_SPIN(xb_ld(&bar[XB_TOPGEN]) == tg, bar);
            __builtin_amdgcn_fence(__ATOMIC_ACQUIRE, "agent");
            xb_add(&bar[XB_XGEN(x)], 1u);
            asm volatile("s_waitcnt vmcnt(0)" ::: "memory");
        } else {
            XB_SPIN(xb_ld(&bar[XB_XGEN(x)]) == gen, bar);
            __builtin_amdgcn_fence(__ATOMIC_ACQUIRE, "agent");
            asm volatile("s_waitcnt vmcnt(0)" ::: "memory");
        }
    }
    __syncthreads();
}

constexpr int PROBE_U = 0, PROBE_V = 0, PROBE_S = 0;
constexpr unsigned DUP_MASK = 0u;
constexpr int PH_PER_LAYER = 13, N_PHASES = 2 + PH_PER_LAYER * DEPTH;
__global__ void __launch_bounds__(NTHREADS) mk_fwd(Args args) {
    extern __shared__ __attribute__((aligned(16))) unsigned char lds[];
    cg::grid_group grid = cg::this_grid();
    constexpr unsigned ARGS_OFF = LDS_BYTES - 256;
    constexpr unsigned MISC_OFF = LDS_BYTES - 64;
    if (threadIdx.x == 0) {
        *(Args*)(lds + ARGS_OFF) = args;
        unsigned* ctl = (unsigned*)(args.ws + WS_CTL); unsigned* misc = (unsigned*)(lds + MISC_OFF);
        const unsigned xcc = (unsigned)__builtin_amdgcn_s_getreg((3 << 11) | 20) & 0xFu;
        misc[0] = xcc; misc[1] = __hip_atomic_fetch_add(ctl + 64 * xcc, 1u, __ATOMIC_RELAXED, __HIP_MEMORY_SCOPE_AGENT);
    }
    __syncthreads();
    int rep = 0;
#pragma unroll 1
    for (int ph = 0; ph < N_PHASES; ++ph) {
        int tid = threadIdx.x; asm volatile("" : "+v"(tid));
        unsigned aoff = ARGS_OFF; asm volatile("" : "+v"(aoff));
        size_t zoff = 0; asm volatile("" : "+s"(zoff));
        unsigned char* ws = args.ws + zoff;
        int bid = blockIdx.x; asm volatile("" : "+s"(bid)); int nb = gridDim.x; asm volatile("" : "+s"(nb));
        unsigned moff = MISC_OFF; asm volatile("" : "+v"(moff));
        Ctx K; { const unsigned* misc = (const unsigned*)(lds + moff); K.jx = __builtin_amdgcn_readfirstlane(misc[1]); K.xg = __builtin_amdgcn_readfirstlane(misc[2]); K.nxg = __builtin_amdgcn_readfirstlane(misc[3]); K.nloc = __builtin_amdgcn_readfirstlane(misc[4]); }
        K.aoff = aoff; K.lds = lds; K.tid = tid; K.lane = tid & 63; K.wave = tid >> 6; K.bid = bid; K.nb = nb; K.gw = bid * NWAVES + K.wave; K.ngw = nb * NWAVES;
        K.ws = ws;
        const int l = ph == 0 ? 0 : (ph - 1) / PH_PER_LAYER, k = ph == 0 ? -1 : (ph == N_PHASES - 1 ? -2 : (ph - 1) % PH_PER_LAYER);
        K.l = l;
        if (k == -1) ph_prologue(K);
        else if (k == -2) ph_final(K);
        else if (k == 0) ph_norm(K, ARG(norm_mix_w) + (size_t)l * D, 0);
        else if (k == 1) ph_gemm_store(K, K.H(), K.WIN() + (size_t)l * PW * D, PW, K.P());
        else if (k == 2) ph_rope(K);
        else if (k == 3) ph_hgrn_A(K);
        else if (k == 4) ph_attn(K);
        else if (k == 5) ph_hgrn_B(K);
        else if (k == 6) ph_hgrn_C(K);
        else if (k == 7) ph_gemm_resid(K, K.MIX(), K.WOUT() + (size_t)l * D * D, 2);
        else if (k == 8) ph_norm(K, ARG(norm_ffn_w) + (size_t)l * D, 3);
        else if (k == 9) ph_gemm_store(K, K.H(), K.WQ() + (size_t)l * 2048 * D, 2048, K.QP());
        else if (k == 10) { ph_peer_select<0>(K); if (PROBE_S) ph_peer_select<PROBE_S>(K); }
        else if (k == 11) { ph_peer_u<0>(K); if (PROBE_U) ph_peer_u<PROBE_U>(K); }
        else if (k == 12) { ph_peer_v<0>(K); if (PROBE_V) ph_peer_v<PROBE_V>(K); }
        if (k >= 0 && ((DUP_MASK >> k) & 1u)) { ++rep; if (rep < 2) { --ph; continue; } } rep = 0;
        if (ph == 0) grid.sync();
        else if (k != 3 && ph != N_PHASES - 1) { const unsigned* misc = (const unsigned*)(lds + moff); xcd_barrier((unsigned*)(args.ws + WS_CTL) + CW_BAR, misc[0], misc[4], misc[3]); }
        if (ph == 0) {
            if (threadIdx.x == 0) { unsigned* ctl = (unsigned*)(args.ws + WS_CTL); unsigned* misc = (unsigned*)(lds + MISC_OFF); const unsigned xcc = misc[0]; unsigned ord = 0, npop = 0, mine = 1;
                for (unsigned q = 0; q < 16; ++q) { const unsigned cq = __hip_atomic_load(ctl + 64 * q, __ATOMIC_RELAXED, __HIP_MEMORY_SCOPE_AGENT); if (cq) { ++npop; if (q < xcc) ++ord; } if (q == xcc) mine = cq; }
                misc[2] = ord; misc[3] = npop ? npop : 1u; misc[4] = mine ? mine : 1u; }
            __syncthreads();
        }
    }
}

extern "C" void kernel_launch(void* const* d_in, const int* in_sizes, int n_in, void* d_out, int out_size, void* d_ws, size_t ws_size, hipStream_t stream) {
    static int grid = 0;
    if (grid == 0) {
        if (n_in != 19 || out_size != NLAT * D || ws_size < WS_END) { fprintf(stderr, "kernel_launch: unexpected shapes (n_in %d out %d ws %zu need %zu)\n", n_in, out_size, ws_size, (size_t)WS_END); grid = -1; return; }
        int dev = 0, cus = 0, per_cu = 0;
        (void)hipGetDevice(&dev); (void)hipDeviceGetAttribute(&cus, hipDeviceAttributeMultiprocessorCount, dev);
        (void)hipFuncSetAttribute((const void*)mk_fwd, hipFuncAttributeMaxDynamicSharedMemorySize, LDS_BYTES);
        (void)hipOccupancyMaxActiveBlocksPerMultiprocessor(&per_cu, (const void*)mk_fwd, NTHREADS, LDS_BYTES);
        if (per_cu < 1) { fprintf(stderr, "kernel_launch: occupancy query says %d blocks/CU\n", per_cu); grid = -1; return; }
        grid = (cus / 8) * 8;
    }
    if (grid < 0) return;
    Args a{};
    a.x = (const float*)d_in[0]; a.c = (const float*)d_in[1]; a.ctx = (const float*)d_in[2]; a.c_ctx = (const float*)d_in[3]; a.w_mod = (const float*)d_in[4]; a.b_mod = (const float*)d_in[5];
    a.norm_mix_w = (const float*)d_in[6]; a.norm_ffn_w = (const float*)d_in[7]; a.w_in = (const float*)d_in[8]; a.lb_logits = (const float*)d_in[9]; a.hgrn_norm_w = (const float*)d_in[10];
    a.swa_sink = (const float*)d_in[11]; a.nat_rpb = (const float*)d_in[12]; a.w_out = (const float*)d_in[13]; a.peer_wq = (const float*)d_in[14]; a.peer_sk = (const float*)d_in[15];
    a.peer_u = (const float*)d_in[16]; a.peer_v = (const float*)d_in[17]; a.final_norm_w = (const float*)d_in[18];
    a.out = (float*)d_out; a.ws = (unsigned char*)d_ws;
    (void)hipMemsetAsync((unsigned char*)d_ws + WS_CTL, 0, CTL_BYTES, stream);
    void* kargs[] = {&a};
    hipError_t e = hipLaunchCooperativeKernel((const void*)mk_fwd, dim3(grid), dim3(NTHREADS), kargs, LDS_BYTES, stream);
    if (e != hipSuccess) fprintf(stderr, "kernel_launch: cooperative launch failed: %s (grid %d)\n", hipGetErrorString(e), grid);
}
```

```cpp
#include <hip/hip_runtime.h>
#include <hip/hip_cooperative_groups.h>
#include <cstdio>
#include <cstdint>
namespace cg = cooperative_groups;
#define DI __device__ __forceinline__
#define GP(T, p) ((T*)(__attribute__((address_space(1))) T*)(p))

typedef unsigned short bf16_t;
typedef float f32x4 __attribute__((ext_vector_type(4)));
typedef unsigned u32x4 __attribute__((ext_vector_type(4)));
typedef unsigned u32x2 __attribute__((ext_vector_type(2)));

constexpr int D = 1024, NB = 2, L = 16384, CL = 256, DEPTH = 4;
constexpr int NCTX = NB * CL, NLAT = NB * L, M = NCTX + NLAT;
constexpr int PW = 3072;
constexpr int C_HQ = 0, C_ZF = 256, C_ZB = 512, C_HV = 768, C_HG = 1024, C_SQ = 1280, C_SK = 1664, C_SV = 1792, C_NQ = 1920, C_NK = 2304, C_NV = 2688;
constexpr int MX_H = 0, MX_S = 256, MX_N = 640;
constexpr float EPS = 1e-6f;
constexpr int NTHREADS = 512, NWAVES = 8;
constexpr int LDS_BYTES = 147456;

constexpr size_t al256(size_t x) { return (x + 255) & ~(size_t)255; }
constexpr size_t WS_X = 0;
constexpr size_t WS_H = WS_X + al256((size_t)M * D * 4);
constexpr size_t WS_P = WS_H + al256((size_t)M * D * 2);
constexpr size_t WS_MIX = WS_P + al256((size_t)M * PW * 2);
constexpr size_t WS_OF = WS_MIX + al256((size_t)M * D * 2);
constexpr size_t WS_OB = WS_OF + al256((size_t)M * 256 * 4);
constexpr size_t WS_PIDX = WS_OB + al256((size_t)M * 256 * 4);
constexpr size_t WS_PG = WS_PIDX + al256((size_t)M * 128 * 4);
constexpr size_t WS_MOD = WS_PG + al256((size_t)M * 128 * 4);
constexpr size_t WS_LB = WS_MOD + al256((size_t)DEPTH * 3 * 6 * D * 4);
constexpr size_t WS_ROPE = WS_LB + al256((size_t)2 * DEPTH * 256 * 4);
constexpr size_t WS_WIN = WS_ROPE + al256((size_t)(256 + 256 + 64 + 64) * 16 * 4);
constexpr size_t WS_WOUT = WS_WIN + al256((size_t)DEPTH * PW * D * 2);
constexpr size_t WS_WQ = WS_WOUT + al256((size_t)DEPTH * D * D * 2);
constexpr size_t WS_AC = WS_WQ + al256((size_t)DEPTH * 2048 * D * 2);
constexpr size_t WS_UB_ = 0; constexpr size_t WS_UB = WS_AC + al256((size_t)16 * 260 * 64 * 4); constexpr size_t WS_UB_OLD = WS_WQ + al256((size_t)DEPTH * 2048 * D * 2);
constexpr size_t WS_VB = WS_UB + al256((size_t)DEPTH * 16384 * D * 2);
constexpr size_t WS_PA = WS_VB + al256((size_t)DEPTH * 16384 * D * 2);
constexpr size_t WS_VS = WS_PA + al256((size_t)M * 128 * 4);
constexpr size_t WS_US = WS_VS + al256((size_t)DEPTH * 16384 * 4);
constexpr size_t WS_H8 = WS_US + al256((size_t)DEPTH * 16384 * 4);
constexpr size_t WS_HS = WS_H8 + al256((size_t)M * D);
constexpr size_t WS_SKH = WS_HS + al256((size_t)M * 4);
constexpr size_t WS_SKL = WS_SKH + al256((size_t)DEPTH * 8 * 2 * 128 * 128 * 2);
constexpr size_t WS_CTL = WS_SKL + al256((size_t)DEPTH * 8 * 2 * 128 * 128 * 2);
constexpr size_t CTL_BYTES = 65536;
constexpr size_t WS_END = WS_CTL + CTL_BYTES;

struct Args {
    const float *x, *c, *ctx, *c_ctx, *w_mod, *b_mod, *norm_mix_w, *norm_ffn_w, *w_in, *lb_logits, *hgrn_norm_w, *swa_sink, *nat_rpb, *w_out, *peer_wq, *peer_sk, *peer_u, *peer_v, *final_norm_w;
    float* out; unsigned char* ws;
};

DI float bf2f(bf16_t v) { return __uint_as_float((unsigned)v << 16); }
DI bf16_t f2bf(float f) { unsigned u = __float_as_uint(f); return (bf16_t)((u + 0x7fffu + ((u >> 16) & 1u)) >> 16); }
DI unsigned pk2(float lo, float hi) { return (unsigned)f2bf(lo) | ((unsigned)f2bf(hi) << 16); }
DI float wave_sum(float v) {
#pragma unroll
    for (int o = 1; o < 64; o <<= 1) v += __shfl_xor(v, o);
    return v;
}
typedef __bf16 bf16x2_t __attribute__((ext_vector_type(2)));
DI float dot2bf(unsigned a, unsigned b, float acc) { return __builtin_amdgcn_fdot2_f32_bf16(__builtin_bit_cast(bf16x2_t, a), __builtin_bit_cast(bf16x2_t, b), acc, false); }
template <int CTRL> DI float dpp_(float x) { return __builtin_bit_cast(float, __builtin_amdgcn_mov_dpp(__builtin_bit_cast(int, x), CTRL, 0xf, 0xf, true)); }
DI float wave_sum_fast(float x) {
    x += dpp_<0xB1>(x); x += dpp_<0x4E>(x); x += dpp_<0x141>(x); x += dpp_<0x128>(x);
    auto s1 = __builtin_amdgcn_permlane16_swap(__float_as_uint(x), __float_as_uint(x), false, false); x = __uint_as_float(s1[0]) + __uint_as_float(s1[1]);
    auto s2 = __builtin_amdgcn_permlane32_swap(__float_as_uint(x), __float_as_uint(x), false, false); return __uint_as_float(s2[0]) + __uint_as_float(s2[1]);
}
DI float sigmoidf_(float z) { return 1.0f / (1.0f + __expf(-z)); }
DI float gelu_erf(float v) { return 0.5f * v * (1.0f + erff(v * 0.70710678118654752f)); }
DI int modvec_of_row(int r) { return r < NCTX ? 2 : (r - NCTX) / L; }
DI int batch_of_row(int r) { return r < NCTX ? r / CL : (r - NCTX) / L; }
DI int lat_row(int b, int t) { return NCTX + b * L + t; }
DI int ctx_row(int b, int s) { return b * CL + s; }
DI void unpack8(const u32x4 w, float* o) {
    o[0] = __uint_as_float(w.x << 16); o[1] = __uint_as_float(w.x & 0xffff0000u);
    o[2] = __uint_as_float(w.y << 16); o[3] = __uint_as_float(w.y & 0xffff0000u);
    o[4] = __uint_as_float(w.z << 16); o[5] = __uint_as_float(w.z & 0xffff0000u);
    o[6] = __uint_as_float(w.w << 16); o[7] = __uint_as_float(w.w & 0xffff0000u);
}
DI void load_row64(const bf16_t* p, float (&o)[64]) {
#pragma unroll
    for (int i = 0; i < 8; ++i) { const u32x4 w = *(const u32x4*)(p + 8 * i); unpack8(w, &o[8 * i]); }
}
DI void rope64(float (&x)[64], const float* cr, const float* sr, const float* cc, const float* sc) {
#pragma unroll
    for (int i = 0; i < 16; ++i) {
        const float c1 = cr[i], s1 = sr[i], a = x[i], b = x[16 + i];
        x[i] = a * c1 - b * s1; x[16 + i] = b * c1 + a * s1;
        const float c2 = cc[i], s2 = sc[i], e = x[32 + i], f = x[48 + i];
        x[32 + i] = e * c2 - f * s2; x[48 + i] = f * c2 + e * s2;
    }
}

namespace pg8 {
#define PG8_LAS __attribute__((address_space(3)))
typedef unsigned short bf16_t;
typedef short bf16x8 __attribute__((ext_vector_type(8)));
typedef float f32x4 __attribute__((ext_vector_type(4)));
typedef unsigned u32x4 __attribute__((ext_vector_type(4)));
constexpr int BM = 256, BK = 64, HALF = 128, HTB = HALF * BK * 2  , STAGE_BYTES = 8 * HTB, NXCD = 8, WGM = 8;

__host__ __device__ __forceinline__ int lds_byte(int r, int c) { const int st = (r >> 4) * 2 + (c >> 5), rr = r & 15, cc = c & 31, ob = rr * 64 + cc * 2; return st * 1024 + (ob ^ (((ob >> 9) & 1) << 5)); }
__host__ __device__ __forceinline__ void stage_rc(int b, int& R, int& C) { const int st = b / 1024, sb = b % 1024, swz = sb ^ (((sb >> 9) & 1) << 5); R = (st >> 1) * 16 + swz / 64; C = (st & 1) * 32 + (swz % 64) / 2; }
__host__ __device__ __forceinline__ int perm32(int rho) { const int n = rho >> 4, i = rho & 15; return 8 * (i >> 2) + 4 * n + (i & 3); }

struct Unit { int pm, pn; };
struct Gemm { const bf16_t* A; const bf16_t* Bt; int M, N, K; };

struct StaticOrder {
    int nM, nN, nwg, G, c;
    __host__ __device__ void init(int M, int N, int G_, int c_) { nM = M / BM; nN = N / BM; nwg = nM * nN; G = G_; c = c_; }
    __host__ __device__ bool next(int i, Unit& u) const {
        const long L = (long)i * G + c; if (L >= nwg) return false;
        int wgid = (int)L; { const int q = nwg / NXCD, r = nwg % NXCD, xcd = wgid % NXCD, off = wgid / NXCD; wgid = (xcd < r ? xcd * (q + 1) : r * (q + 1) + (xcd - r) * q) + off; }
        const int nig = WGM * nN, gid = wgid / nig, fm = gid * WGM, gsz = (nM - fm) < WGM ? (nM - fm) : WGM;
        u.pm = fm + ((wgid % nig) % gsz); u.pn = (wgid % nig) / gsz; return true;
    }
    __device__ __forceinline__ void a_ready(const Unit&) const {}
    __device__ __forceinline__ void done(const Unit&) const {}
};


__device__ __forceinline__ unsigned cvt_pk_bf16(float lo, float hi) { unsigned r; asm volatile("v_cvt_pk_bf16_f32 %0, %1, %2" : "=v"(r) : "v"(lo), "v"(hi)); return r; }
struct EpiStore {
    static constexpr bool PERM = true, AFTER_DRAIN = false;
    bf16_t* O; int ldc;
    __device__ __forceinline__ void operator()(const f32x4 (&acc)[2][2][4][2], const Unit& u, int wr, int wc, int fr, int fq) const {
        const int row0 = u.pm * BM + wr * 64 + fr, col0 = u.pn * BM + wc * 32 + 8 * fq;
#pragma unroll
        for (int ai = 0; ai < 2; ++ai)
#pragma unroll
            for (int m = 0; m < 4; ++m) { bf16_t* rowp = O + (size_t)(row0 + ai * HALF + m * 16) * ldc + col0;
#pragma unroll
                for (int bj = 0; bj < 2; ++bj) { const f32x4 v0 = acc[ai][bj][m][0], v1 = acc[ai][bj][m][1];
                    u32x4 w; w.x = cvt_pk_bf16(v0[0], v0[1]); w.y = cvt_pk_bf16(v0[2], v0[3]); w.z = cvt_pk_bf16(v1[0], v1[1]); w.w = cvt_pk_bf16(v1[2], v1[3]);
                    *(u32x4*)(rowp + bj * HALF) = w; } }
    }
};
struct EpiResid {
    static constexpr bool PERM = false, AFTER_DRAIN = false;
    float* X; int ldc; const float* gate; int gstride, nctx, seqlen;
    __device__ __forceinline__ void operator()(const f32x4 (&acc)[2][2][4][2], const Unit& u, int wr, int wc, int fr, int fq) const {
        const int col0 = u.pn * BM + wc * 32 + 4 * fq;
#pragma unroll
        for (int ai = 0; ai < 2; ++ai)
#pragma unroll
            for (int m = 0; m < 4; ++m) { const int r = u.pm * BM + ai * HALF + wr * 64 + m * 16 + fr; const int vsel = r < nctx ? 2 : (r - nctx) / seqlen;
                float* xr = X + (size_t)r * ldc + col0; const float* gr = gate + (size_t)vsel * gstride + col0;
#pragma unroll
                for (int bj = 0; bj < 2; ++bj)
#pragma unroll
                    for (int n = 0; n < 2; ++n) { const f32x4 g = *(const f32x4*)(gr + bj * HALF + n * 16); f32x4 x = *(const f32x4*)(xr + bj * HALF + n * 16); x += g * acc[ai][bj][m][n]; *(f32x4*)(xr + bj * HALF + n * 16) = x; } }
    }
};
template <class Epi, class Sched, bool ALIGN_EPI = false, bool SP2 = false>
__device__ __forceinline__ void gemm_phase(PG8_LAS unsigned char* lds, const Gemm g, const Sched& S, const Epi& E) {
    int tid_ = threadIdx.x; asm volatile("" : "+v"(tid_));
    const int tid = tid_, wid = __builtin_amdgcn_readfirstlane(tid >> 6), lane = tid & 63, wr = wid >> 2, wc = wid & 3, fr = lane & 15, fq = lane >> 4;
    const int K = g.K, nt = K / BK;
    unsigned voffA[2], voffB[2];
#pragma unroll
    for (int i = 0; i < 2; ++i) { int R, C; stage_rc(tid * 16 + i * 8192, R, C); const int Rb = Epi::PERM ? ((R & ~31) + perm32(R & 31)) : R;
        voffA[i] = (unsigned)(R * K + C) * 2u; voffB[i] = (unsigned)(Rb * K + C) * 2u; }
    const size_t kstep = (size_t)(BK * 2);
    const size_t hstep = (size_t)HALF * K * 2;
    const size_t tstep = 2 * hstep;
    const unsigned ldsw = (unsigned)wid * 1024u;
    const int aoff = lds_byte(wr * 64 + fr, fq * 8), boff = lds_byte(wc * 32 + fr, fq * 8);
#define PG8_SA(b, h) (((b) * 2 + (h)) * HTB)
#define PG8_SB(b, h) ((4 + (b) * 2 + (h)) * HTB)
#define PG8_STAGE(bufoff, gbase, voff) do { _Pragma("unroll") for (int _i = 0; _i < 2; ++_i) \
        __builtin_amdgcn_global_load_lds((const unsigned*)((const char*)(gbase) + (voff)[_i]), (PG8_LAS unsigned*)(lds + (bufoff) + ldsw + _i * 8192), 16, 0, 0); } while (0)
#define PG8_LDA(dst, b, h) do { _Pragma("unroll") for (int m = 0; m < 4; ++m) _Pragma("unroll") for (int k = 0; k < 2; ++k) dst[m][k] = *(const PG8_LAS bf16x8*)(lds + PG8_SA(b, h) + aoff + m * 2048 + k * 1024); } while (0)
#define PG8_LDB(dst, b, h) do { _Pragma("unroll") for (int n = 0; n < 2; ++n) _Pragma("unroll") for (int k = 0; k < 2; ++k) dst[n][k] = *(const PG8_LAS bf16x8*)(lds + PG8_SB(b, h) + boff + n * 2048 + k * 1024); } while (0)
#define PG8_MMA(ai, bj, At, Bt) do { __builtin_amdgcn_s_setprio(1); _Pragma("unroll") for (int m = 0; m < 4; ++m) _Pragma("unroll") for (int n = 0; n < 2; ++n) _Pragma("unroll") for (int k = 0; k < 2; ++k) \
        acc[ai][bj][m][n] = __builtin_amdgcn_mfma_f32_16x16x32_bf16(Bt[n][k], At[m][k], acc[ai][bj][m][n], 0, 0, 0); __builtin_amdgcn_s_setprio(0); } while (0)
#define PG8_WAIT_V(n) asm volatile("s_waitcnt vmcnt(" #n ")" ::: "memory")
#define PG8_WAIT_L(n) asm volatile("s_waitcnt lgkmcnt(" #n ")" ::: "memory")
#define PG8_BAR __builtin_amdgcn_s_barrier()
#define PG8_SCHED __builtin_amdgcn_sched_barrier(0)
    Unit cur, nxt; int ui = 0;
    if (!S.next(0, cur)) return;
    f32x4 acc[2][2][4][2];
#pragma unroll
    for (int a = 0; a < 2; ++a)
#pragma unroll
        for (int b = 0; b < 2; ++b)
#pragma unroll
            for (int m = 0; m < 4; ++m)
#pragma unroll
                for (int n = 0; n < 2; ++n) acc[a][b][m][n] = (f32x4){0.f, 0.f, 0.f, 0.f};
    bf16x8 At[4][2], B0[2][2], B1[2][2];
    const char* cA = (const char*)g.A + (size_t)cur.pm * tstep; const char* cB = (const char*)g.Bt + (size_t)cur.pn * tstep;
    S.a_ready(cur);
    if constexpr (SP2) {
        PG8_STAGE(PG8_SB(0, 0), cB, voffB); PG8_STAGE(PG8_SB(0, 1), cB + hstep, voffB); PG8_STAGE(PG8_SA(0, 0), cA, voffA); PG8_STAGE(PG8_SA(0, 1), cA + hstep, voffA);
        if (wr == 1) PG8_BAR;
        PG8_WAIT_V(2); PG8_BAR;
        PG8_STAGE(PG8_SB(1, 0), cB + kstep, voffB); PG8_STAGE(PG8_SA(1, 0), cA + kstep, voffA); PG8_STAGE(PG8_SB(1, 1), cB + hstep + kstep, voffB);
        PG8_WAIT_V(6); PG8_BAR;
    } else {
        PG8_STAGE(PG8_SB(0, 0), cB, voffB); PG8_STAGE(PG8_SA(0, 0), cA, voffA); PG8_STAGE(PG8_SB(0, 1), cB + hstep, voffB); PG8_STAGE(PG8_SA(0, 1), cA + hstep, voffA);
        if (wr == 1) PG8_BAR;
        PG8_WAIT_V(4); PG8_BAR;
        PG8_STAGE(PG8_SB(1, 0), cB + kstep, voffB); PG8_STAGE(PG8_SA(1, 0), cA + kstep, voffA); PG8_STAGE(PG8_SB(1, 1), cB + hstep + kstep, voffB);
        PG8_WAIT_V(6); PG8_BAR;
    }
    for (;;) {
        const bool has_next = S.next(ui + 1, nxt);
        const char* nA = has_next ? (const char*)g.A + (size_t)nxt.pm * tstep : cA; const char* nB = has_next ? (const char*)g.Bt + (size_t)nxt.pn * tstep : cB;
        for (int t = 0; t < nt; t += 2) {
            const bool last = (t == nt - 2);
            const char* a1 = cA + (size_t)(t + 1) * kstep;
            const char* a2 = last ? nA : cA + (size_t)(t + 2) * kstep; const char* b2 = last ? nB : cB + (size_t)(t + 2) * kstep;
            const char* a3 = a2 + kstep; const char* b3 = b2 + kstep;
            if (last && has_next) S.a_ready(nxt);
            if constexpr (SP2) {
            PG8_LDB(B0, 0, 0); PG8_LDB(B1, 0, 1); PG8_SCHED; PG8_LDA(At, 0, 0); PG8_STAGE(PG8_SA(1, 1), a1 + hstep, voffA);
            PG8_WAIT_V(8); PG8_WAIT_L(0); PG8_BAR; PG8_MMA(0, 0, At, B0); PG8_MMA(0, 1, At, B1); PG8_BAR; PG8_SCHED;
            PG8_LDA(At, 0, 1); PG8_STAGE(PG8_SB(0, 0), b2, voffB); PG8_STAGE(PG8_SB(0, 1), b2 + hstep, voffB); PG8_STAGE(PG8_SA(0, 0), a2, voffA);
            PG8_WAIT_V(8); PG8_WAIT_L(0); PG8_BAR; PG8_MMA(1, 0, At, B0); PG8_MMA(1, 1, At, B1); PG8_BAR; PG8_SCHED;
            PG8_LDB(B0, 1, 0); PG8_LDB(B1, 1, 1); PG8_SCHED; PG8_LDA(At, 1, 0); PG8_STAGE(PG8_SA(0, 1), a2 + hstep, voffA);
            PG8_WAIT_V(8); PG8_WAIT_L(0); PG8_BAR; PG8_MMA(0, 0, At, B0); PG8_MMA(0, 1, At, B1); PG8_BAR; PG8_SCHED;
            PG8_LDA(At, 1, 1); PG8_STAGE(PG8_SB(1, 0), b3, voffB); PG8_STAGE(PG8_SB(1, 1), b3 + hstep, voffB); PG8_STAGE(PG8_SA(1, 0), a3, voffA);
            PG8_WAIT_V(8); PG8_WAIT_L(0); PG8_BAR; PG8_MMA(1, 0, At, B0); PG8_MMA(1, 1, At, B1); PG8_BAR; PG8_SCHED;
            } else {
            PG8_LDB(B0, 0, 0); PG8_SCHED; PG8_LDA(At, 0, 0); PG8_STAGE(PG8_SA(1, 1), a1 + hstep, voffA);
            PG8_WAIT_L(8); PG8_BAR; PG8_WAIT_L(0); PG8_MMA(0, 0, At, B0); PG8_BAR; PG8_SCHED;
            PG8_LDB(B1, 0, 1); PG8_STAGE(PG8_SB(0, 0), b2, voffB);
            PG8_BAR; PG8_WAIT_L(0); PG8_MMA(0, 1, At, B1); PG8_BAR;
            PG8_LDA(At, 0, 1); PG8_STAGE(PG8_SA(0, 0), a2, voffA);
            PG8_BAR; PG8_WAIT_L(0); PG8_MMA(1, 0, At, B0); PG8_BAR; PG8_SCHED;
            PG8_STAGE(PG8_SB(0, 1), b2 + hstep, voffB);
            PG8_WAIT_V(6); PG8_BAR; PG8_MMA(1, 1, At, B1); PG8_BAR;
            PG8_LDB(B0, 1, 0); PG8_SCHED; PG8_LDA(At, 1, 0); PG8_STAGE(PG8_SA(0, 1), a2 + hstep, voffA);
            PG8_WAIT_L(8); PG8_BAR; PG8_WAIT_L(0); PG8_MMA(0, 0, At, B0); PG8_BAR; PG8_SCHED;
            PG8_LDB(B1, 1, 1); PG8_STAGE(PG8_SB(1, 0), b3, voffB);
            PG8_BAR; PG8_WAIT_L(0); PG8_MMA(0, 1, At, B1); PG8_BAR;
            PG8_LDA(At, 1, 1); PG8_STAGE(PG8_SA(1, 0), a3, voffA);
            PG8_BAR; PG8_WAIT_L(0); PG8_MMA(1, 0, At, B0); PG8_BAR; PG8_SCHED;
            PG8_STAGE(PG8_SB(1, 1), b3 + hstep, voffB);
            PG8_WAIT_V(6); PG8_BAR; PG8_MMA(1, 1, At, B1); PG8_BAR;
            }
        }
        if constexpr (ALIGN_EPI) { if (wr == 0) PG8_BAR; }
        if constexpr (!Epi::AFTER_DRAIN) { E(acc, cur, wr, wc, fr, fq); S.done(cur); }
        if (!has_next) break;
#pragma unroll
        for (int a = 0; a < 2; ++a)
#pragma unroll
            for (int b = 0; b < 2; ++b)
#pragma unroll
                for (int m = 0; m < 4; ++m)
#pragma unroll
                    for (int n = 0; n < 2; ++n) acc[a][b][m][n] = (f32x4){0.f, 0.f, 0.f, 0.f};
        cur = nxt; cA = nA; cB = nB; ++ui;
        if constexpr (ALIGN_EPI) { if (wr == 1) PG8_BAR; }
    }
    PG8_WAIT_V(0);
    if constexpr (!ALIGN_EPI) { if (wr == 0) PG8_BAR; }
    PG8_BAR;
    if constexpr (Epi::AFTER_DRAIN) { E.fused(acc, cur, wr, wc, fr, fq, lds, wid, lane); S.done(cur); }
#undef PG8_SA
#undef PG8_SB
#undef PG8_STAGE
#undef PG8_LDA
#undef PG8_LDB
#undef PG8_MMA
#undef PG8_WAIT_V
#undef PG8_WAIT_L
#undef PG8_BAR
#undef PG8_SCHED
}
}

struct Ctx {
    unsigned aoff; int l;
    unsigned char* ws;
    DI float* X() const { return GP(float, ws + WS_X); }
    DI bf16_t* H() const { return GP(bf16_t, ws + WS_H); }
    DI bf16_t* P() const { return GP(bf16_t, ws + WS_P); }
    DI bf16_t* QP() const { return GP(bf16_t, ws + WS_P); }
    DI bf16_t* MIX() const { return GP(bf16_t, ws + WS_MIX); }
    DI float* OF() const { return GP(float, ws + WS_OF); }
    DI float* OB() const { return GP(float, ws + WS_OB); }
    DI int* PIDX() const { return GP(int, ws + WS_PIDX); }
    DI float* PG() const { return GP(float, ws + WS_PG); }
    DI float* MOD() const { return GP(float, ws + WS_MOD); }
    DI float* LB() const { return GP(float, ws + WS_LB); }
    DI float* ROPE() const { return GP(float, ws + WS_ROPE); }
    DI bf16_t* WIN() const { return GP(bf16_t, ws + WS_WIN); }
    DI bf16_t* WOUT() const { return GP(bf16_t, ws + WS_WOUT); }
    DI bf16_t* WQ() const { return GP(bf16_t, ws + WS_WQ); }
    DI bf16_t* UB() const { return GP(bf16_t, ws + WS_UB); }
    DI float* ST() const { return GP(float, ws + WS_OF); }
    DI float* AC() const { return GP(float, ws + WS_AC); }
    DI float* PA() const { return GP(float, ws + WS_PA); }
    DI float* VS() const { return GP(float, ws + WS_VS); }
    DI float* US() const { return GP(float, ws + WS_US); }
    DI bf16_t* SKH() const { return GP(bf16_t, ws + WS_SKH); }
    DI bf16_t* SKL() const { return GP(bf16_t, ws + WS_SKL); }
    DI bf16_t* VB() const { return GP(bf16_t, ws + WS_VB); }
    DI unsigned char* H8() const { return GP(unsigned char, ws + WS_H8); }
    DI float* HS() const { return GP(float, ws + WS_HS); }
    unsigned char* lds; int tid, lane, wave, gw, ngw, bid, nb;
    int xg, nxg, jx, nloc;
};

#define LAS __attribute__((address_space(3)))
DI void transpose_item(const float* W, int Kd, int N, bf16_t* WT, LAS float* scr, int item, int lane) {
    const int nblk = N / 32, kb = item / nblk, nb = item % nblk, k0 = 64 * kb, n0 = 32 * nb;
#pragma unroll 8
    for (int i = 0; i < 32; ++i) { const int kk = 2 * i + (lane >> 5); scr[kk * 33 + (lane & 31)] = W[(size_t)(k0 + kk) * N + n0 + (lane & 31)]; }
    asm volatile("s_waitcnt lgkmcnt(0)" ::: "memory");
    const int c = lane & 7;
#pragma unroll
    for (int j = 0; j < 4; ++j) { const int n = (lane >> 3) + 8 * j; const LAS float* sp = scr + (8 * c) * 33 + n;
        u32x4 o; o.x = pk2(sp[0 * 33], sp[1 * 33]); o.y = pk2(sp[2 * 33], sp[3 * 33]); o.z = pk2(sp[4 * 33], sp[5 * 33]); o.w = pk2(sp[6 * 33], sp[7 * 33]);
        *(u32x4*)(WT + (size_t)(n0 + n) * Kd + k0 + 8 * c) = o; }
    asm volatile("s_waitcnt lgkmcnt(0)" ::: "memory");
}

template <class T> DI T* argp_(const Ctx& K, unsigned off) {
    const unsigned* p = (const unsigned*)(K.lds + K.aoff + off);
    const unsigned lo = __builtin_amdgcn_readfirstlane(p[0]), hi = __builtin_amdgcn_readfirstlane(p[1]);
    return GP(T, ((unsigned long long)hi << 32) | (unsigned long long)lo);
}
#define ARG(f) argp_<const float>(K, (unsigned)__builtin_offsetof(Args, f))

DI void ph_prologue(Ctx& K) {
    {
        LAS float* scr = (LAS float*)((LAS unsigned char*)K.lds + K.wave * 16384);
        constexpr int I_IN = (D / 64) * (PW / 32), I_OUT = (D / 64) * (D / 32), I_Q = (D / 64) * (2048 / 32), I_L = I_IN + I_OUT + I_Q;
        for (int it = K.gw; it < DEPTH * I_L; it += K.ngw) {
            const int l = it / I_L; int r = it % I_L;
            if (r < I_IN) { transpose_item(ARG(w_in) + (size_t)l * D * PW, D, PW, K.WIN() + (size_t)l * PW * D, scr, r, K.lane); continue; } r -= I_IN;
            if (r < I_OUT) { transpose_item(ARG(w_out) + (size_t)l * D * D, D, D, K.WOUT() + (size_t)l * D * D, scr, r, K.lane); continue; } r -= I_OUT;
            transpose_item(ARG(peer_wq) + (size_t)l * D * 2048, D, 2048, K.WQ() + (size_t)l * 2048 * D, scr, r, K.lane);
        }
    }
    const size_t gt = (size_t)K.bid * NTHREADS + K.tid, gs = (size_t)K.nb * NTHREADS;
    { const f32x4* s0 = (const f32x4*)ARG(ctx); const f32x4* s1 = (const f32x4*)ARG(x); f32x4* d = (f32x4*)K.X();
      const size_t n0 = (size_t)NCTX * D / 4, n1 = (size_t)NLAT * D / 4;
      for (size_t i = gt; i < n0 + n1; i += gs) d[i] = i < n0 ? s0[i] : s1[i - n0]; }
    { const float* sk = ARG(peer_sk);
      for (size_t i = gt; i < (size_t)DEPTH * 8 * 2 * 128 * 128; i += gs) { const float v = sk[i]; const bf16_t hi = f2bf(v); K.SKH()[i] = hi; K.SKL()[i] = f2bf(v - bf2f(hi)); } }
    { const float* pu = ARG(peer_u); unsigned char* UQ = (unsigned char*)K.UB();
      for (int row0 = K.gw; row0 < DEPTH * 16384; row0 += 2 * K.ngw) {
          f32x4 v2[2][4];
#pragma unroll
          for (int t = 0; t < 2; ++t) { const int row = min(row0 + t * K.ngw, DEPTH * 16384 - 1); const f32x4* src = (const f32x4*)(pu + (size_t)row * D);
#pragma unroll
              for (int j = 0; j < 4; ++j) v2[t][j] = src[j * 64 + K.lane]; }
#pragma unroll
          for (int t = 0; t < 2; ++t) { const int row = row0 + t * K.ngw; if (row >= DEPTH * 16384) break;
              float mx = 0.f;
#pragma unroll
              for (int j = 0; j < 4; ++j) mx = fmaxf(mx, fmaxf(fmaxf(fabsf(v2[t][j].x), fabsf(v2[t][j].y)), fmaxf(fabsf(v2[t][j].z), fabsf(v2[t][j].w))));
#pragma unroll
              for (int o = 1; o < 64; o <<= 1) mx = fmaxf(mx, __shfl_xor(mx, o));
              const float sc = fmaxf(mx, 1e-30f) * (1.0f / 127.0f), inv = 1.0f / sc;
              if (K.lane == 0) K.US()[row] = sc;
#pragma unroll
              for (int j = 0; j < 4; ++j) { const int col = j * 256 + K.lane * 4; const f32x4 v = v2[t][j];
                  const unsigned q0 = (unsigned)((int)rintf(v.x * inv)) & 0xffu, q1 = (unsigned)((int)rintf(v.y * inv)) & 0xffu, q2 = (unsigned)((int)rintf(v.z * inv)) & 0xffu, q3 = (unsigned)((int)rintf(v.w * inv)) & 0xffu;
                  *(unsigned*)(UQ + (size_t)row * D + col) = q0 | (q1 << 8) | (q2 << 16) | (q3 << 24); } } } }
    { const float* pv = ARG(peer_v); unsigned char* VQ = (unsigned char*)K.VB();
      for (int row0 = K.gw; row0 < DEPTH * 16384; row0 += 2 * K.ngw) {
          f32x4 v2[2][4];
#pragma unroll
          for (int t = 0; t < 2; ++t) { const int row = min(row0 + t * K.ngw, DEPTH * 16384 - 1); const f32x4* src = (const f32x4*)(pv + (size_t)row * D);
#pragma unroll
              for (int j = 0; j < 4; ++j) v2[t][j] = src[j * 64 + K.lane]; }
#pragma unroll
          for (int t = 0; t < 2; ++t) { const int row = row0 + t * K.ngw; if (row >= DEPTH * 16384) break;
              float mx = 0.f;
#pragma unroll
              for (int j = 0; j < 4; ++j) mx = fmaxf(mx, fmaxf(fmaxf(fabsf(v2[t][j].x), fabsf(v2[t][j].y)), fmaxf(fabsf(v2[t][j].z), fabsf(v2[t][j].w))));
#pragma unroll
              for (int o = 1; o < 64; o <<= 1) mx = fmaxf(mx, __shfl_xor(mx, o));
              const float sc = fmaxf(mx, 1e-30f) * (1.0f / 127.0f), inv = 1.0f / sc;
              if (K.lane == 0) K.VS()[row] = sc;
              const int l = row >> 14, e = row & 16383;
#pragma unroll
              for (int j = 0; j < 4; ++j) { const int col = j * 256 + K.lane * 4; const f32x4 v = v2[t][j];
                  const unsigned q0 = (unsigned)((int)rintf(v.x * inv) + 128), q1 = (unsigned)((int)rintf(v.y * inv) + 128), q2 = (unsigned)((int)rintf(v.z * inv) + 128), q3 = (unsigned)((int)rintf(v.w * inv) + 128);
                  *(unsigned*)(VQ + (((size_t)l * 8 + (col >> 7)) * 16384 + e) * 128 + (col & 127)) = q0 | (q1 << 8) | (q2 << 16) | (q3 << 24); } } } }
    { float* sv = (float*)K.lds;
      float* part = sv + 3 * D;
      __syncthreads();
      for (int i = K.tid; i < 3 * D; i += NTHREADS) { const int v = i / D, k = i % D; const float c = v < 2 ? ARG(c)[v * D + k] : ARG(c_ctx)[k]; sv[i] = c * sigmoidf_(c); }
      __syncthreads();
      for (int item = K.bid; item < DEPTH * 24; item += K.nb) {
          const int l = item / 24, cb = item % 24;
          const float* w = ARG(w_mod) + (size_t)l * D * 6 * D + cb * 256 + K.lane * 4;
          f32x4 a0 = {0.f, 0.f, 0.f, 0.f}, a1 = a0, a2 = a0;
#pragma unroll 8
          for (int kk = 0; kk < 128; ++kk) { const int k = K.wave * 128 + kk; const f32x4 wv = *(const f32x4*)(w + (size_t)k * 6 * D);
              a0 += wv * sv[k]; a1 += wv * sv[D + k]; a2 += wv * sv[2 * D + k]; }
          *(f32x4*)(part + (K.wave * 3 + 0) * 256 + K.lane * 4) = a0; *(f32x4*)(part + (K.wave * 3 + 1) * 256 + K.lane * 4) = a1; *(f32x4*)(part + (K.wave * 3 + 2) * 256 + K.lane * 4) = a2;
          __syncthreads();
          for (int i = K.tid; i < 768; i += NTHREADS) { const int v = i / 256, cc = i % 256; float sum = 0.f;
#pragma unroll
              for (int w8 = 0; w8 < 8; ++w8) sum += part[(w8 * 3 + v) * 256 + cc];
              const int col = cb * 256 + cc; K.MOD()[((size_t)l * 3 + v) * 6 * D + col] = sum + ARG(b_mod)[(size_t)l * 6 * D + col]; }
          __syncthreads();
      } }
    for (size_t i = gt; i < 2 * 256; i += gs) {
        const int dir = (int)(i / 256), ch = (int)(i % 256);
        float lg[DEPTH], mx = -1e30f;
#pragma unroll
        for (int l = 0; l < DEPTH; ++l) { lg[l] = ARG(lb_logits)[((size_t)dir * DEPTH + l) * 256 + ch]; mx = fmaxf(mx, lg[l]); }
        float s = 0.f;
#pragma unroll
        for (int l = 0; l < DEPTH; ++l) { lg[l] = expf(lg[l] - mx); s += lg[l]; }
        float cum = 0.f;
#pragma unroll
        for (int l = 0; l < DEPTH; ++l) { if (l > 0) cum += lg[l] / s; K.LB()[((size_t)dir * DEPTH + l) * 256 + ch] = cum; }
    }
    for (size_t i = gt; i < (256 + 64) * 16; i += gs) {
        const int pos = (int)(i / 16), f = (int)(i % 16);
        const float inv = powf(10000.0f, -(float)f / 16.0f);
        if (pos < 256) { const float ang = (float)pos * inv; K.ROPE()[pos * 16 + f] = cosf(ang); K.ROPE()[4096 + pos * 16 + f] = sinf(ang); }
        else { const int pc = pos - 256; const float ang = (float)pc * inv; K.ROPE()[8192 + pc * 16 + f] = cosf(ang); K.ROPE()[8192 + 1024 + pc * 16 + f] = sinf(ang); }
    }
}

DI void ph_norm(Ctx& K, const float* nw, int shift_chunk) {
    const float* modl = K.MOD() + (size_t)K.l * 3 * 6 * D;
    for (int r = K.gw; r < M; r += K.ngw) {
        const f32x4* xr = (const f32x4*)(K.X() + (size_t)r * D);
        f32x4 v[4]; float ss = 0.f;
#pragma unroll
        for (int j = 0; j < 4; ++j) { v[j] = xr[j * 64 + K.lane]; ss += v[j].x * v[j].x + v[j].y * v[j].y + v[j].z * v[j].z + v[j].w * v[j].w; }
        ss = wave_sum(ss);
        const float rs = rsqrtf(ss * (1.0f / D) + EPS);
        const float* mv = modl + (size_t)modvec_of_row(r) * 6 * D;
        u32x2* ho = (u32x2*)(K.H() + (size_t)r * D);
#pragma unroll
        for (int j = 0; j < 4; ++j) {
            const int c4 = j * 64 + K.lane;
            const f32x4 w = ((const f32x4*)nw)[c4], sh = ((const f32x4*)(mv + shift_chunk * D))[c4], sc = ((const f32x4*)(mv + (shift_chunk + 1) * D))[c4];
            f32x4 y; y.x = v[j].x * rs * w.x * (1.f + sc.x) + sh.x; y.y = v[j].y * rs * w.y * (1.f + sc.y) + sh.y; y.z = v[j].z * rs * w.z * (1.f + sc.z) + sh.z; y.w = v[j].w * rs * w.w * (1.f + sc.w) + sh.w;
            u32x2 o; o.x = pk2(y.x, y.y); o.y = pk2(y.z, y.w); ho[c4] = o;
            if (shift_chunk == 3) { v[j].x = __uint_as_float(o.x << 16); v[j].y = __uint_as_float(o.x & 0xffff0000u); v[j].z = __uint_as_float(o.y << 16); v[j].w = __uint_as_float(o.y & 0xffff0000u); }
        }
        if (shift_chunk == 3) {
            float mx = 0.f;
#pragma unroll
            for (int j = 0; j < 4; ++j) mx = fmaxf(mx, fmaxf(fmaxf(fabsf(v[j].x), fabsf(v[j].y)), fmaxf(fabsf(v[j].z), fabsf(v[j].w))));
#pragma unroll
            for (int o = 1; o < 64; o <<= 1) mx = fmaxf(mx, __shfl_xor(mx, o));
            const float sc = fmaxf(mx, 1e-30f) * (1.0f / 127.0f), inv = 1.0f / sc;
            if (K.lane == 0) K.HS()[r] = sc;
#pragma unroll
            for (int j = 0; j < 4; ++j) { const unsigned q0 = (unsigned)((int)rintf(v[j].x * inv)) & 0xffu, q1 = (unsigned)((int)rintf(v[j].y * inv)) & 0xffu, q2 = (unsigned)((int)rintf(v[j].z * inv)) & 0xffu, q3 = (unsigned)((int)rintf(v[j].w * inv)) & 0xffu;
                *(unsigned*)(K.H8() + (size_t)r * D + (j * 64 + K.lane) * 4) = q0 | (q1 << 8) | (q2 << 16) | (q3 << 24); }
        }
    }
}

DI void ph_gemm_store(Ctx& K, const bf16_t* A, const bf16_t* Bt, int N, bf16_t* out) {
    pg8::Gemm g{A, Bt, M, N, D}; pg8::StaticOrder S; S.init(M, N, K.nb, K.bid);
    pg8::EpiStore E{out, N};
    pg8::gemm_phase<pg8::EpiStore, pg8::StaticOrder, true, true>((LAS unsigned char*)K.lds, g, S, E);
}
DI void ph_gemm_resid(Ctx& K, const bf16_t* A, const bf16_t* Bt, int chunk) {
    pg8::Gemm g{A, Bt, M, D, D}; pg8::StaticOrder S; S.init(M, D, K.nb, K.bid);
    pg8::EpiResid E{K.X(), D, K.MOD() + (size_t)K.l * 3 * 6 * D + (size_t)chunk * D, 6 * D, NCTX, L};
    pg8::gemm_phase<pg8::EpiResid, pg8::StaticOrder, true, true>((LAS unsigned char*)K.lds, g, S, E);
}

DI void ph_rope(Ctx& K) {
    const float* cosr = K.ROPE(); const float* sinr = K.ROPE() + 4096; const float* cosc = K.ROPE() + 8192; const float* sinc = K.ROPE() + 8192 + 1024;
    const size_t gt = (size_t)K.bid * NTHREADS + K.tid, gs = (size_t)K.nb * NTHREADS;
    for (size_t i = gt; i < (size_t)NLAT * 8 * 16; i += gs) {
        const int f = (int)(i & 15), hh = (int)((i >> 4) & 7), lr = (int)(i >> 7);
        const int t = lr % L, pr = t >> 6, pc = t & 63;
        bf16_t* p = K.P() + (size_t)(NCTX + lr) * PW + (hh < 6 ? C_SQ + hh * 64 : C_SK + (hh - 6) * 64);
        const float c1 = cosr[pr * 16 + f], s1 = sinr[pr * 16 + f], c2 = cosc[pc * 16 + f], s2 = sinc[pc * 16 + f];
        const float a = bf2f(p[f]), b = bf2f(p[16 + f]), e = bf2f(p[32 + f]), g = bf2f(p[48 + f]);
        p[f] = f2bf(a * c1 - b * s1); p[16 + f] = f2bf(b * c1 + a * s1); p[32 + f] = f2bf(e * c2 - g * s2); p[48 + f] = f2bf(g * c2 + e * s2);
    }
}

typedef short bf16x8_t __attribute__((ext_vector_type(8)));
#define MFMA16(a, b, c) __builtin_amdgcn_mfma_f32_16x16x32_bf16((a), (b), (c), 0, 0, 0)
constexpr int HG_NCH = (CL + L) / 64;
constexpr int HG_LFS = 68;
constexpr int HG_TS = 72;
constexpr int HGL_LF = 0, HGL_OM = HGL_LF + 2 * 64 * HG_LFS * 4, HGL_VT = HGL_OM + 2 * 64 * HG_LFS * 4, HGL_KT = HGL_VT + 64 * HG_TS * 2, HGL_SC = HGL_KT, HGL_OD = HGL_SC + 8 * 16 * HG_TS * 2, HGL_END = HGL_OD + 2 * 64 * HG_LFS * 4;
static_assert(HGL_KT + 2 * 64 * HG_TS * 2 <= LDS_BYTES && HGL_END <= LDS_BYTES, "hgrn LDS map");
DI int hg_block_row(int b, int tb, int tok) { return tb < 4 ? ctx_row(b, tb * 64 + tok) : lat_row(b, (tb - 4) * 64 + tok); }
DI int hg_bwd_chunk(int tb) { return tb < 4 ? 3 - tb : 4 + 255 - (tb - 4); }
DI void hg_prep(Ctx& K, int b, int h, int tb) {
    float* LF = (float*)(K.lds + HGL_LF); float* OM = (float*)(K.lds + HGL_OM); bf16_t* VT = (bf16_t*)(K.lds + HGL_VT);
    const int tok = K.tid >> 3, c = K.tid & 7;
    const bf16_t* pr = K.P() + (size_t)hg_block_row(b, tb, tok) * PW + h * 64 + 8 * c;
#pragma unroll
    for (int dir = 0; dir < 2; ++dir) {
        float z[8]; unpack8(*(const u32x4*)(pr + (dir ? C_ZB : C_ZF)), z);
        const float* lb = K.LB() + ((size_t)dir * DEPTH + K.l) * 256 + h * 64 + 8 * c;
        float lf[8], om[8];
#pragma unroll
        for (int j = 0; j < 8; ++j) { const float lbv = lb[j], sg = sigmoidf_(z[j]); const float f = fmaxf(lbv + (1.f - lbv) * sg, 1e-30f); lf[j] = __logf(f); om[j] = (1.f - lbv) * (1.f - sg); }
        float* lfp = LF + (dir * 64 + tok) * HG_LFS + 8 * c; float* omp = OM + (dir * 64 + tok) * HG_LFS + 8 * c;
        *(f32x4*)lfp = (f32x4){lf[0], lf[1], lf[2], lf[3]}; *(f32x4*)(lfp + 4) = (f32x4){lf[4], lf[5], lf[6], lf[7]};
        *(f32x4*)omp = (f32x4){om[0], om[1], om[2], om[3]}; *(f32x4*)(omp + 4) = (f32x4){om[4], om[5], om[6], om[7]};
    }
    { const u32x4 v = *(const u32x4*)(pr + C_HV);
      const unsigned w[4] = {v.x, v.y, v.z, v.w};
#pragma unroll
      for (int j = 0; j < 4; ++j) { VT[(8 * c + 2 * j) * HG_TS + tok] = (bf16_t)(w[j] & 0xffffu); VT[(8 * c + 2 * j + 1) * HG_TS + tok] = (bf16_t)(w[j] >> 16); } }
    __syncthreads();
    if (K.tid < 128) {
        const int dir = K.tid >> 6, d = K.tid & 63; float* col = LF + dir * 64 * HG_LFS + d;
        float v[64];
#pragma unroll
        for (int p = 0; p < 64; ++p) v[p] = col[(dir ? 63 - p : p) * HG_LFS];
#pragma unroll
        for (int p = 1; p < 64; ++p) v[p] += v[p - 1];
#pragma unroll
        for (int p = 0; p < 64; ++p) col[(dir ? 63 - p : p) * HG_LFS] = v[p];
    }
    __syncthreads();
}
DI void ph_hgrn_A(Ctx& K) {
    float* LF = (float*)(K.lds + HGL_LF); float* OM = (float*)(K.lds + HGL_OM); bf16_t* VT = (bf16_t*)(K.lds + HGL_VT); bf16_t* KT = (bf16_t*)(K.lds + HGL_KT);
    const int r16 = K.lane & 15, g4 = K.lane >> 4;
    for (int item = K.bid; item < NB * 4 * HG_NCH; item += K.nb) {
        const int tb = item % HG_NCH, h = (item / HG_NCH) & 3, b = item / (HG_NCH * 4);
        __syncthreads();
        hg_prep(K, b, h, tb);
        { const int tok = K.tid >> 3, c = K.tid & 7;
#pragma unroll
          for (int dir = 0; dir < 2; ++dir) {
              const float* bl = LF + (dir * 64 + (dir ? 0 : 63)) * HG_LFS + 8 * c; const float* bt = LF + (dir * 64 + tok) * HG_LFS + 8 * c; const float* om = OM + (dir * 64 + tok) * HG_LFS + 8 * c;
#pragma unroll
              for (int j = 0; j < 8; ++j) KT[(dir * 64 + 8 * c + j) * HG_TS + tok] = f2bf(om[j] * __expf(bl[j] - bt[j]));
          }
          if (K.tid < 128) { const int dir = K.tid >> 6, d = K.tid & 63; const int chain = (b * 2 + dir) * 4 + h, ch = dir ? hg_bwd_chunk(tb) : tb;
              K.AC()[((size_t)chain * HG_NCH + ch) * 64 + d] = __expf(LF[(dir * 64 + (dir ? 0 : 63)) * HG_LFS + d]); } }
        __syncthreads();
        { const int dir = K.wave >> 2, mi = K.wave & 3; const int chain = (b * 2 + dir) * 4 + h, ch = dir ? hg_bwd_chunk(tb) : tb;
          f32x4 acc[4];
#pragma unroll
          for (int nj = 0; nj < 4; ++nj) acc[nj] = (f32x4){0.f, 0.f, 0.f, 0.f};
#pragma unroll
          for (int ks = 0; ks < 2; ++ks) {
              const bf16x8_t av = *(const bf16x8_t*)(VT + (16 * mi + r16) * HG_TS + 32 * ks + 8 * g4);
#pragma unroll
              for (int nj = 0; nj < 4; ++nj) { const bf16x8_t bv = *(const bf16x8_t*)(KT + (dir * 64 + 16 * nj + r16) * HG_TS + 32 * ks + 8 * g4); acc[nj] = MFMA16(av, bv, acc[nj]); }
          }
          float* st = K.ST() + ((size_t)chain * HG_NCH + ch) * 4096;
#pragma unroll
          for (int nj = 0; nj < 4; ++nj)
#pragma unroll
              for (int rg = 0; rg < 4; ++rg) st[(16 * mi + 4 * g4 + rg) * 64 + 16 * nj + r16] = acc[nj][rg];
        }
    }
}
DI void ph_hgrn_B(Ctx& K) {
    const int gt = K.bid * NTHREADS + K.tid;
    if (gt < 16 * 4096) {
        const int chain = gt >> 12, idx = gt & 4095, d = idx & 63;
        float* st = K.ST() + (size_t)chain * HG_NCH * 4096 + idx; const float* ac = K.AC() + (size_t)chain * HG_NCH * 64 + d;
        float S = 0.f;
#pragma unroll 1
        for (int c0 = 0; c0 < HG_NCH; c0 += 26) {
            float u[26], a[26];
#pragma unroll
            for (int i = 0; i < 26; ++i) { u[i] = st[(size_t)(c0 + i) * 4096]; a[i] = ac[(c0 + i) * 64]; }
#pragma unroll
            for (int i = 0; i < 26; ++i) { st[(size_t)(c0 + i) * 4096] = S; S = a[i] * S + u[i]; }
        }
    }
}
DI void ph_hgrn_C(Ctx& K) {
    float* LF = (float*)(K.lds + HGL_LF); float* OM = (float*)(K.lds + HGL_OM); bf16_t* VT = (bf16_t*)(K.lds + HGL_VT); float* OD = (float*)(K.lds + HGL_OD);
    bf16_t* SC = (bf16_t*)(K.lds + HGL_SC) + K.wave * 16 * HG_TS;
    const int r16 = K.lane & 15, g4 = K.lane >> 4;
    for (int item = K.bid; item < NB * 4 * HG_NCH; item += K.nb) {
        const int tb = item % HG_NCH, h = (item / HG_NCH) & 3, b = item / (HG_NCH * 4);
        __syncthreads();
        hg_prep(K, b, h, tb);
        { const int dir = K.wave >> 2, mi = K.wave & 3; const int chain = (b * 2 + dir) * 4 + h, ch = dir ? hg_bwd_chunk(tb) : tb;
          const float* LFd = LF + dir * 64 * HG_LFS; const float* OMd = OM + dir * 64 * HG_LFS; const float* ref = LFd + 32 * HG_LFS;
          bf16x8_t aq1[2], aq2[2];
          { const int t = 16 * mi + r16; const bf16_t* qr = K.P() + (size_t)hg_block_row(b, tb, t) * PW + C_HQ + h * 64;
#pragma unroll
            for (int ks = 0; ks < 2; ++ks) { const int d0 = 32 * ks + 8 * g4; float q[8]; unpack8(*(const u32x4*)(qr + d0), q);
                u32x4 w1, w2; unsigned o1[4], o2[4];
#pragma unroll
                for (int j = 0; j < 4; ++j) { float x1[2], x2[2];
#pragma unroll
                    for (int e = 0; e < 2; ++e) { const int dd = d0 + 2 * j + e; const float qs = q[2 * j + e] * sigmoidf_(q[2 * j + e]); const float bt = LFd[t * HG_LFS + dd]; x1[e] = qs * __expf(bt - ref[dd]); x2[e] = qs * __expf(bt); }
                    o1[j] = pk2(x1[0], x1[1]); o2[j] = pk2(x2[0], x2[1]); }
                w1 = (u32x4){o1[0], o1[1], o1[2], o1[3]}; w2 = (u32x4){o2[0], o2[1], o2[2], o2[3]};
                aq1[ks] = __builtin_bit_cast(bf16x8_t, w1); aq2[ks] = __builtin_bit_cast(bf16x8_t, w2); } }
          f32x4 sc[4];
#pragma unroll
          for (int nj = 0; nj < 4; ++nj) { sc[nj] = (f32x4){0.f, 0.f, 0.f, 0.f}; const int s_ = 16 * nj + r16;
#pragma unroll
              for (int ks = 0; ks < 2; ++ks) { const int d0 = 32 * ks + 8 * g4; unsigned o[4];
#pragma unroll
                  for (int j = 0; j < 4; ++j) { const int dd = d0 + 2 * j; o[j] = pk2(OMd[s_ * HG_LFS + dd] * __expf(ref[dd] - LFd[s_ * HG_LFS + dd]), OMd[s_ * HG_LFS + dd + 1] * __expf(ref[dd + 1] - LFd[s_ * HG_LFS + dd + 1])); }
                  const u32x4 w = (u32x4){o[0], o[1], o[2], o[3]};
                  sc[nj] = MFMA16(aq1[ks], __builtin_bit_cast(bf16x8_t, w), sc[nj]); } }
#pragma unroll
          for (int nj = 0; nj < 4; ++nj)
#pragma unroll
              for (int rg = 0; rg < 4; ++rg) { const int tl = 4 * g4 + rg, t = 16 * mi + tl, s_ = 16 * nj + r16; const bool keep = dir ? (s_ >= t) : (s_ <= t);
                  SC[tl * HG_TS + s_] = f2bf(keep ? sc[nj][rg] : 0.f); }
          asm volatile("s_waitcnt lgkmcnt(0)" ::: "memory");
          f32x4 oacc[4];
#pragma unroll
          for (int nj = 0; nj < 4; ++nj) oacc[nj] = (f32x4){0.f, 0.f, 0.f, 0.f};
          const float* st = K.ST() + ((size_t)chain * HG_NCH + ch) * 4096;
#pragma unroll
          for (int ks = 0; ks < 2; ++ks) {
              const bf16x8_t as = *(const bf16x8_t*)(SC + r16 * HG_TS + 32 * ks + 8 * g4);
#pragma unroll
              for (int nj = 0; nj < 4; ++nj) {
                  const bf16x8_t bv = *(const bf16x8_t*)(VT + (16 * nj + r16) * HG_TS + 32 * ks + 8 * g4);
                  oacc[nj] = MFMA16(as, bv, oacc[nj]);
                  const float* sp = st + (16 * nj + r16) * 64 + 32 * ks + 8 * g4; const f32x4 s0 = *(const f32x4*)sp, s1 = *(const f32x4*)(sp + 4);
                  const u32x4 w = (u32x4){pk2(s0.x, s0.y), pk2(s0.z, s0.w), pk2(s1.x, s1.y), pk2(s1.z, s1.w)};
                  oacc[nj] = MFMA16(aq2[ks], __builtin_bit_cast(bf16x8_t, w), oacc[nj]);
              }
          }
#pragma unroll
          for (int nj = 0; nj < 4; ++nj)
#pragma unroll
              for (int rg = 0; rg < 4; ++rg) OD[(dir * 64 + 16 * mi + 4 * g4 + rg) * HG_LFS + 16 * nj + r16] = oacc[nj][rg];
        }
        __syncthreads();
        { const int tok = K.tid >> 3, c = K.tid & 7; const int row = hg_block_row(b, tb, tok);
          const float* o0 = OD + tok * HG_LFS + 8 * c; const float* o1 = OD + (64 + tok) * HG_LFS + 8 * c;
          float o[8], ss = 0.f;
#pragma unroll
          for (int j = 0; j < 8; ++j) { o[j] = o0[j] + o1[j]; ss += o[j] * o[j]; }
          ss += __shfl_xor(ss, 1); ss += __shfl_xor(ss, 2); ss += __shfl_xor(ss, 4);
          const float rs = rsqrtf(ss * (1.0f / 64.0f) + EPS);
          float gq[8]; unpack8(*(const u32x4*)(K.P() + (size_t)row * PW + C_HG + h * 64 + 8 * c), gq);
          const float* nw = ARG(hgrn_norm_w) + (size_t)K.l * 256 + h * 64 + 8 * c;
          float y[8];
#pragma unroll
          for (int j = 0; j < 8; ++j) y[j] = o[j] * rs * nw[j] * gq[j] * sigmoidf_(gq[j]);
          u32x4 w; w.x = pk2(y[0], y[1]); w.y = pk2(y[2], y[3]); w.z = pk2(y[4], y[5]); w.w = pk2(y[6], y[7]);
          *(u32x4*)(K.MIX() + (size_t)row * D + MX_H + h * 64 + 8 * c) = w; }
    }
}

constexpr int AT_TS = 72;
constexpr int ATL_K = 0, ATL_V = ATL_K + 64 * AT_TS * 2, ATL_P = ATL_V + 64 * AT_TS * 2, ATL_END = ATL_P + 8 * 48 * AT_TS * 2;
static_assert(ATL_END <= LDS_BYTES - 256, "attention LDS map");
DI float dpp_max16(float x) { x = fmaxf(x, dpp_<0xB1>(x)); x = fmaxf(x, dpp_<0x4E>(x)); x = fmaxf(x, dpp_<0x141>(x)); x = fmaxf(x, dpp_<0x128>(x)); return x; }
DI float dpp_sum16(float x) { x += dpp_<0xB1>(x); x += dpp_<0x4E>(x); x += dpp_<0x141>(x); x += dpp_<0x128>(x); return x; }
template <int KIND> DI void attn_item(Ctx& K, int idx, const float* sinkp, const float* rpbp) {
    constexpr int MT = KIND == 0 ? 3 : 2;
    int tid_ = K.tid; asm volatile("" : "+v"(tid_));
    const int lane_ = tid_ & 63, wave_ = tid_ >> 6;
    bf16_t* KT = (bf16_t*)(K.lds + ATL_K); bf16_t* VT = (bf16_t*)(K.lds + ATL_V); bf16_t* PS = (bf16_t*)(K.lds + ATL_P) + wave_ * 48 * AT_TS;
    const int r16 = lane_ & 15, g4 = lane_ >> 4;
    int b, hk, qb = 0;
    if (KIND == 0) { qb = idx & 127; hk = (idx >> 7) & 1; b = idx >> 8; }
    else if (KIND == 1) { qb = idx & 63; hk = (idx >> 6) % 6; b = (idx >> 6) / 6; }
    else { hk = idx % 6; b = idx / 6; }
    const int kcol = (KIND == 0) ? C_SK + hk * 64 : (KIND == 2) ? C_SK + (hk / 3) * 64 : C_NK + hk * 64;
    const int vcol = (KIND == 0) ? C_SV + hk * 64 : (KIND == 2) ? C_SV + (hk / 3) * 64 : C_NV + hk * 64;
    int t0 = 0, nloc = 0;
    if (KIND == 0) { const int k0 = max(2 * qb - 2, 0), k1 = min(2 * qb + 3, L / 64 - 1); t0 = k0; nloc = k1 - k0 + 1; }
    if (KIND == 1) { const int k0 = min(max(4 * qb - 4, 0), L / 64 - 8), k1 = min(max(4 * qb + 3 - 4, 0), L / 64 - 8) + 7; t0 = k0; nloc = k1 - k0 + 1; }
    const int ntiles = nloc + CL / 64;
    int w_r = 0, w_rs = 0;
    if (KIND == 1) { w_r = 4 * qb + (wave_ >> 1); w_rs = min(max(w_r - 4, 0), L / 64 - 8); }
    bf16x8_t qf[MT][2]; int qbase[MT], hq_mt[MT];
#pragma unroll
    for (int mt = 0; mt < MT; ++mt) {
        int arow, hq;
        if (KIND == 0) { const int rho = wave_ * 48 + mt * 16; hq = hk * 3 + rho / 128; hq_mt[mt] = hq; const int tb = 128 * qb + (rho & 127); arow = lat_row(b, tb + r16); qbase[mt] = tb; }
        else if (KIND == 1) { hq = hk; hq_mt[mt] = hq; const int cb = 32 * (wave_ & 1) + 16 * mt; arow = lat_row(b, w_r * 64 + cb + r16); qbase[mt] = cb; }
        else { hq = hk; hq_mt[mt] = hq; const int tb = wave_ * 32 + mt * 16; arow = ctx_row(b, tb + r16); qbase[mt] = 0; }
        const int qcol = (KIND == 0 || KIND == 2) ? C_SQ + hq * 64 : C_NQ + hq * 64;
#pragma unroll
        for (int ks = 0; ks < 2; ++ks) { float q[8]; unpack8(*(const u32x4*)(K.P() + (size_t)arow * PW + qcol + 32 * ks + 8 * g4), q);
            const u32x4 w = (u32x4){pk2(q[0] * 0.125f, q[1] * 0.125f), pk2(q[2] * 0.125f, q[3] * 0.125f), pk2(q[4] * 0.125f, q[5] * 0.125f), pk2(q[6] * 0.125f, q[7] * 0.125f)};
            qf[mt][ks] = __builtin_bit_cast(bf16x8_t, w); }
    }
    f32x4 oacc[MT][4]; float mrun[MT][4], lrun[MT][4];
#pragma unroll
    for (int mt = 0; mt < MT; ++mt) {
#pragma unroll
        for (int ne = 0; ne < 4; ++ne) oacc[mt][ne] = (f32x4){0.f, 0.f, 0.f, 0.f};
        const bool has_sink = (KIND == 0 || KIND == 2); const float sk = has_sink ? sinkp[hq_mt[mt]] : -1.0e30f;
#pragma unroll
        for (int rg = 0; rg < 4; ++rg) { mrun[mt][rg] = sk; lrun[mt][rg] = has_sink ? 1.0f : 0.0f; }
    }
    const int lkey = tid_ >> 3, lch = tid_ & 7;
    u32x4 pk_, pv_;
    { const int ti = 0; const int grow = (ti < nloc) ? lat_row(b, (t0 + ti) * 64 + lkey) : ctx_row(b, (ti - nloc) * 64 + lkey);
      const bf16_t* pr = K.P() + (size_t)grow * PW + 8 * lch; pk_ = *(const u32x4*)(pr + kcol); pv_ = *(const u32x4*)(pr + vcol); }
#pragma unroll 1
    for (int ti = 0; ti < ntiles; ++ti) {
        __syncthreads();
        *(u32x4*)(KT + lkey * AT_TS + 8 * lch) = pk_;
        { const unsigned w[4] = {pv_.x, pv_.y, pv_.z, pv_.w};
#pragma unroll
          for (int j = 0; j < 4; ++j) { VT[(8 * lch + 2 * j) * AT_TS + lkey] = (bf16_t)(w[j] & 0xffffu); VT[(8 * lch + 2 * j + 1) * AT_TS + lkey] = (bf16_t)(w[j] >> 16); } }
        __syncthreads();
        if (ti + 1 < ntiles) { const int tn = ti + 1; const int grow = (tn < nloc) ? lat_row(b, (t0 + tn) * 64 + lkey) : ctx_row(b, (tn - nloc) * 64 + lkey);
            const bf16_t* pr = K.P() + (size_t)grow * PW + 8 * lch; pk_ = *(const u32x4*)(pr + kcol); pv_ = *(const u32x4*)(pr + vcol); }
        const bool local = ti < nloc; const int kunit = t0 + ti;
        bool active = true;
        if (KIND == 0 && local) active = true;
        if (KIND == 1 && local) active = (kunit >= w_rs) && (kunit < w_rs + 8);
        if (active) {
            f32x4 sc[MT][4];
#pragma unroll
            for (int mt = 0; mt < MT; ++mt)
#pragma unroll
                for (int nj = 0; nj < 4; ++nj) sc[mt][nj] = (f32x4){0.f, 0.f, 0.f, 0.f};
#pragma unroll
            for (int nj = 0; nj < 4; ++nj)
#pragma unroll
                for (int ks = 0; ks < 2; ++ks) { const bf16x8_t kf = *(const bf16x8_t*)(KT + (16 * nj + r16) * AT_TS + 32 * ks + 8 * g4);
#pragma unroll
                    for (int mt = 0; mt < MT; ++mt) sc[mt][nj] = MFMA16(qf[mt][ks], kf, sc[mt][nj]); }
            if (local) {
#pragma unroll
                for (int mt = 0; mt < MT; ++mt)
#pragma unroll
                    for (int nj = 0; nj < 4; ++nj)
#pragma unroll
                        for (int rg = 0; rg < 4; ++rg) { const int key = 16 * nj + r16;
                            if (KIND == 0) { const int dl = qbase[mt] + 4 * g4 + rg - (kunit * 64 + key); if (dl > 128 || dl < -128) sc[mt][nj][rg] = -INFINITY; }
                            if (KIND == 1) { const int c = qbase[mt] + 4 * g4 + rg, ws = min(max(c - 8, 0), 48);
                                if (key >= ws && key < ws + 16) sc[mt][nj][rg] += rpbp[(kunit - w_r + 7) * 31 + (key - c + 15)]; else sc[mt][nj][rg] = -INFINITY; } }
            }
#pragma unroll
            for (int mt = 0; mt < MT; ++mt)
#pragma unroll
                for (int rg = 0; rg < 4; ++rg) {
                    float mx = fmaxf(fmaxf(sc[mt][0][rg], sc[mt][1][rg]), fmaxf(sc[mt][2][rg], sc[mt][3][rg]));
                    mx = dpp_max16(mx);
                    const float mn = fmaxf(mrun[mt][rg], mx), alpha = __expf(mrun[mt][rg] - mn); mrun[mt][rg] = mn;
                    float rs_ = 0.f;
#pragma unroll
                    for (int nj = 0; nj < 4; ++nj) { const float pe = __expf(sc[mt][nj][rg] - mn); sc[mt][nj][rg] = pe; rs_ += pe; }
                    rs_ = dpp_sum16(rs_);
                    lrun[mt][rg] = lrun[mt][rg] * alpha + rs_;
#pragma unroll
                    for (int ne = 0; ne < 4; ++ne) oacc[mt][ne][rg] *= alpha;
                }
#pragma unroll
            for (int mt = 0; mt < MT; ++mt)
#pragma unroll
                for (int nj = 0; nj < 4; ++nj)
#pragma unroll
                    for (int rg = 0; rg < 4; ++rg) PS[(16 * mt + 4 * g4 + rg) * AT_TS + 16 * nj + r16] = f2bf(sc[mt][nj][rg]);
            asm volatile("s_waitcnt lgkmcnt(0)" ::: "memory");
#pragma unroll
            for (int ks = 0; ks < 2; ++ks) {
                bf16x8_t pf[MT];
#pragma unroll
                for (int mt = 0; mt < MT; ++mt) pf[mt] = *(const bf16x8_t*)(PS + (16 * mt + r16) * AT_TS + 32 * ks + 8 * g4);
#pragma unroll
                for (int ne = 0; ne < 4; ++ne) { const bf16x8_t vf = *(const bf16x8_t*)(VT + (16 * ne + r16) * AT_TS + 32 * ks + 8 * g4);
#pragma unroll
                    for (int mt = 0; mt < MT; ++mt) oacc[mt][ne] = MFMA16(pf[mt], vf, oacc[mt][ne]); }
            }
            asm volatile("s_waitcnt lgkmcnt(0)" ::: "memory");
        }
    }
#pragma unroll
    for (int mt = 0; mt < MT; ++mt)
#pragma unroll
        for (int rg = 0; rg < 4; ++rg) { const float inv = 1.0f / lrun[mt][rg];
#pragma unroll
            for (int ne = 0; ne < 4; ++ne) PS[(16 * mt + 4 * g4 + rg) * AT_TS + 16 * ne + r16] = f2bf(oacc[mt][ne][rg] * inv); }
    asm volatile("s_waitcnt lgkmcnt(0)" ::: "memory");
#pragma unroll
    for (int mt = 0; mt < MT; ++mt) {
        const int ocol = ((KIND == 0 || KIND == 2) ? MX_S : MX_N) + hq_mt[mt] * 64;
#pragma unroll
        for (int i = 0; i < 2; ++i) { const int rr = (lane_ >> 3) + 8 * i, ch = lane_ & 7;
            const u32x4 v = *(const u32x4*)(PS + (16 * mt + rr) * AT_TS + 8 * ch);
            int grow;
            if (KIND == 0) { const int rho = wave_ * 48 + mt * 16; grow = lat_row(b, 128 * qb + (rho & 127) + rr); }
            else if (KIND == 1) grow = lat_row(b, w_r * 64 + 32 * (wave_ & 1) + 16 * mt + rr);
            else grow = ctx_row(b, wave_ * 32 + mt * 16 + rr);
            *(u32x4*)(K.MIX() + (size_t)grow * D + ocol + 8 * ch) = v; }
    }
    asm volatile("s_waitcnt lgkmcnt(0)" ::: "memory");
}
DI void ph_attn(Ctx& K) {
    constexpr int N_SWA = NB * 2 * (L / 128), N_NAT = NB * 6 * (L / 256), N_C = NB * 6;
    const float* sinkp = ARG(swa_sink) + K.l * 6;
    for (int item = K.bid; item < N_SWA + N_NAT + 2 * N_C; item += K.nb) {
        if (item < N_SWA) attn_item<0>(K, item, sinkp, nullptr);
        else if (item < N_SWA + N_NAT) { const int it = item - N_SWA; const int h = (it >> 6) % 6; attn_item<1>(K, it, nullptr, ARG(nat_rpb) + ((size_t)K.l * 6 + h) * 15 * 31); }
        else if (item < N_SWA + N_NAT + N_C) attn_item<2>(K, item - N_SWA - N_NAT, sinkp, nullptr);
        else attn_item<3>(K, item - N_SWA - N_NAT - N_C, nullptr, nullptr);
    }
}

DI unsigned fkey(float f) { const unsigned u = __float_as_uint(f); return (u & 0x80000000u) ? ~u : (u | 0x80000000u); }
DI int mbcnt64(unsigned long long m) { return (int)__builtin_amdgcn_mbcnt_hi((unsigned)(m >> 32), __builtin_amdgcn_mbcnt_lo((unsigned)m, 0u)); }
template <int NV> DI unsigned radix_thr16(const unsigned (&k)[NV]) {
    unsigned prefix = 0u;
#pragma unroll 1
    for (int bit = 31; bit >= 0; --bit) {
        const unsigned cand = prefix | (1u << bit); int cnt = 0;
#pragma unroll
        for (int i = 0; i < NV; ++i) cnt += __popcll(__ballot(k[i] >= cand));
        if (cnt >= 16) { prefix = cand; if (cnt == 16) break; }
    }
    return prefix;
}
template <int NC, int NV> DI void radix_thr16_multi(const unsigned (&k)[NC][NV], unsigned (&T)[NC]) {
    bool exact[NC];
#pragma unroll
    for (int c = 0; c < NC; ++c) { T[c] = 0u; exact[c] = false; }
#pragma unroll 1
    for (int bit = 31; bit >= 0; --bit) {
        bool all = true;
#pragma unroll
        for (int c = 0; c < NC; ++c) {
            const unsigned cand = T[c] | (1u << bit); int cnt = 0;
#pragma unroll
            for (int i = 0; i < NV; ++i) cnt += __popcll(__ballot(k[c][i] >= cand));
            if (cnt >= 16) { T[c] = cand; exact[c] = (cnt == 16); }
            all = all && exact[c];
        }
        if (all) break;
    }
}
template <int NV> DI void select16(const unsigned (&k)[NV], unsigned T, bool (&sel)[NV], int (&pos)[NV]) {
    int ngt = 0; unsigned long long gtm[NV], eqm[NV];
#pragma unroll
    for (int i = 0; i < NV; ++i) { gtm[i] = __ballot(k[i] > T); eqm[i] = __ballot(k[i] == T); ngt += __popcll(gtm[i]); }
    const int need = 16 - ngt; int eqbase = 0, selbase = 0;
#pragma unroll
    for (int i = 0; i < NV; ++i) {
        const bool iseq = k[i] == T; const int erank = eqbase + mbcnt64(eqm[i]); eqbase += __popcll(eqm[i]);
        sel[i] = (k[i] > T) || (iseq && erank < need);
        const unsigned long long sm = __ballot(sel[i]); pos[i] = selbase + mbcnt64(sm); selbase += __popcll(sm);
    }
}
template <int CTRL> DI int dppi_(int x) { return __builtin_amdgcn_mov_dpp(x, CTRL, 0xf, 0xf, true); }
DI int row_sum_i(int x) { x += dppi_<0xB1>(x); x += dppi_<0x4E>(x); x += dppi_<0x141>(x); x += dppi_<0x128>(x); return x; }
DI int row_excl_scan_i(int x) { int s_ = x; s_ += dppi_<0x111>(s_); s_ += dppi_<0x112>(s_); s_ += dppi_<0x114>(s_); s_ += dppi_<0x118>(s_); return s_ - x; }
template <int NK> DI unsigned row_radix_thr16(const unsigned (&k)[NK]) {
    unsigned T = 0u; bool exact = false;
#pragma unroll 1
    for (int bit = 31; bit >= 0; --bit) {
        const unsigned cand = T | (1u << bit); int cnt = 0;
#pragma unroll
        for (int i = 0; i < NK; ++i) cnt += (k[i] >= cand) ? 1 : 0;
        cnt = row_sum_i(cnt);
        const bool ge = cnt >= 16; T = ge ? cand : T; exact = ge ? (cnt == 16) : exact;
        if (__ballot(!exact) == 0ull) break;
    }
    return T;
}
template <int NK> DI void row_select16(const unsigned (&k)[NK], unsigned T, bool (&sel)[NK], int (&pos)[NK]) {
    int g = 0, q = 0;
#pragma unroll
    for (int i = 0; i < NK; ++i) { g += (k[i] > T) ? 1 : 0; q += (k[i] == T) ? 1 : 0; }
    const int need = 16 - row_sum_i(g);
    const int a = min(max(need - row_excl_scan_i(q), 0), q);
    int nxt = row_excl_scan_i(g + a), eqs = 0;
#pragma unroll
    for (int i = 0; i < NK; ++i) { const bool iseq = k[i] == T; sel[i] = (k[i] > T) || (iseq && eqs < a); eqs += iseq ? 1 : 0; pos[i] = nxt; nxt += sel[i] ? 1 : 0; }
}
constexpr int PS_SCS = 132;
constexpr int PSL_TOP = 8 * 2 * 16 * PS_SCS * 4;
static_assert(PSL_TOP + 8 * 1024 <= LDS_BYTES - 256, "peer select LDS map");
template <int PROBE> DI void ph_peer_select(Ctx& K) {
    float* SCR = (float*)K.lds + K.wave * 2 * 16 * PS_SCS; float* TOPV = (float*)(K.lds + PSL_TOP + K.wave * 1024); int* TOPI = (int*)(TOPV + 128);
    const int r16 = K.lane & 15, g4 = K.lane >> 4, h = K.wave;
    constexpr int N_IT = M / 16, N_FULL = (N_IT / 256) * 256, N_WORK = N_FULL + 4 * (N_IT - N_FULL);
    for (int wk = K.bid; wk < N_WORK; wk += K.nb) {
        const bool part = wk >= N_FULL; const int item = part ? N_FULL + ((wk - N_FULL) >> 2) : wk; const int tk_lo = part ? 4 * ((wk - N_FULL) & 3) : 0, tk_hi = part ? tk_lo + 4 : 16;
        const int t0 = item * 16;
#pragma unroll 1
        for (int p = 0; p < 2; ++p) {
            bf16x8_t aq[4];
            { const bf16_t* qp = K.QP() + (size_t)(t0 + r16) * 2048 + h * 256 + p * 128 + 8 * g4;
#pragma unroll
              for (int ks = 0; ks < 4; ++ks) aq[ks] = *(const bf16x8_t*)(qp + 32 * ks); }
            const size_t kb = (((size_t)K.l * 8 + h) * 2 + p) * 128 * 128 + (size_t)r16 * 128 + 8 * g4;
#pragma unroll 2
            for (int nt = 0; nt < 8; ++nt) {
                bf16x8_t bh[4], bl[4];
#pragma unroll
                for (int ks = 0; ks < 4; ++ks) { bh[ks] = *(const bf16x8_t*)(K.SKH() + kb + (size_t)(16 * nt) * 128 + 32 * ks); bl[ks] = *(const bf16x8_t*)(K.SKL() + kb + (size_t)(16 * nt) * 128 + 32 * ks); }
                f32x4 c0 = {0.f, 0.f, 0.f, 0.f}, c1 = c0;
#pragma unroll
                for (int ks = 0; ks < 4; ++ks) { c0 = MFMA16(aq[ks], bh[ks], c0); c1 = MFMA16(aq[ks], bl[ks], c1); }
#pragma unroll
                for (int rg = 0; rg < 4; ++rg) SCR[(p * 16 + 4 * g4 + rg) * PS_SCS + 16 * nt + r16] = c0[rg] + c1[rg];
            }
        }
        asm volatile("s_waitcnt lgkmcnt(0)" ::: "memory");
        if (PROBE == 1) continue;
        const int rho = K.lane >> 4, j16 = K.lane & 15;
#pragma unroll 1
        for (int tk = tk_lo; tk < tk_hi; tk += 4) {
#pragma unroll 1
            for (int ps = 0; ps < 2; ++ps) {
                const int p = rho & 1, rr = 2 * ps + (rho >> 1);
                float v[8]; unsigned kk[8];
#pragma unroll
                for (int i = 0; i < 8; ++i) { v[i] = SCR[(p * 16 + tk + rr) * PS_SCS + j16 + 16 * i]; kk[i] = fkey(v[i]); }
                const unsigned T = row_radix_thr16<8>(kk);
                bool sel[8]; int pos[8]; row_select16<8>(kk, T, sel, pos);
#pragma unroll
                for (int i = 0; i < 8; ++i) if (sel[i]) { TOPV[(rr * 2 + p) * 16 + pos[i]] = v[i]; TOPI[(rr * 2 + p) * 16 + pos[i]] = j16 + 16 * i; }
            }
            asm volatile("s_waitcnt lgkmcnt(0)" ::: "memory");
            { const int r = t0 + tk + rho;
              const float vb = TOPV[(rho * 2 + 1) * 16 + j16]; const int ib = TOPI[(rho * 2 + 1) * 16 + j16];
              float cv[16]; unsigned ck[16];
#pragma unroll
              for (int i = 0; i < 16; ++i) { cv[i] = TOPV[(rho * 2) * 16 + i] + vb; ck[i] = fkey(cv[i]); }
              const unsigned T = row_radix_thr16<16>(ck);
              bool sel[16]; int pos[16]; row_select16<16>(ck, T, sel, pos);
              float mx = -3.0e38f;
#pragma unroll
              for (int i = 0; i < 16; ++i) mx = fmaxf(mx, sel[i] ? cv[i] : -3.0e38f);
              mx = dpp_max16(mx);
              float es = 0.f;
#pragma unroll
              for (int i = 0; i < 16; ++i) { cv[i] = sel[i] ? __expf(cv[i] - mx) : 0.f; es += cv[i]; }
              es = dpp_sum16(es);
              const float inv = 1.0f / es;
#pragma unroll
              for (int i = 0; i < 16; ++i) if (sel[i]) { K.PIDX()[(size_t)r * 128 + h * 16 + pos[i]] = TOPI[(rho * 2) * 16 + i] * 128 + ib; K.PG()[(size_t)r * 128 + h * 16 + pos[i]] = cv[i] * inv; }
            }
            asm volatile("s_waitcnt lgkmcnt(0)" ::: "memory");
        }
    }
}

constexpr int PUL_H = 0, PUL_SLOT = 4096, PUL_STRIDE = 4352;
struct PuMeta { float hs[2]; int ia[2], ib[2]; };
DI void pu_load(const Ctx& K, int r0, int step, PuMeta& m, unsigned char* hbuf) {
#pragma unroll
    for (int q = 0; q < 2; ++q) { const int r = r0 + q * step;
        if (r < M) { __builtin_amdgcn_global_load_lds((const unsigned*)(K.H8() + (size_t)r * D + K.lane * 16), (LAS unsigned*)(hbuf + q * 1024), 16, 0, 0);
            m.hs[q] = K.HS()[r]; m.ia[q] = K.PIDX()[(size_t)r * 128 + K.lane]; m.ib[q] = K.PIDX()[(size_t)r * 128 + 64 + K.lane]; }
        else { m.hs[q] = 0.f; m.ia[q] = -1; m.ib[q] = -1; } }
}
typedef int i32x4 __attribute__((ext_vector_type(4)));
DI int sel4i(const i32x4 v, int k) { return k == 0 ? v[0] : k == 1 ? v[1] : k == 2 ? v[2] : v[3]; }
template <int PROBE> DI void pu_item(const Ctx& K, const unsigned char* U, unsigned char* HL, int* SLOT, int R, int r0, int step, const PuMeta& m, int r16, int g4, float& dummy) {
    const float hs[2] = {m.hs[0], m.hs[1]};
    bool sa[2], sb[2]; int ra[2], rb[2]; int n = 0;
#pragma unroll
    for (int q = 0; q < 2; ++q) { sa[q] = (m.ia[q] >> 11) == R; sb[q] = (m.ib[q] >> 11) == R; const unsigned long long ma = __ballot(sa[q]), mb = __ballot(sb[q]);
        ra[q] = n + mbcnt64(ma); n += __popcll(ma); rb[q] = n + mbcnt64(mb); n += __popcll(mb); }
    const int E = r16 >> 2, qq = r16 & 3, rho = r16 >> 3;
#pragma unroll 1
    for (int base = 0; base < n; base += 32) {
#pragma unroll
        for (int q = 0; q < 2; ++q) {
            if (sa[q] && ra[q] >= base && ra[q] < base + 32) { SLOT[2 * (ra[q] - base)] = m.ia[q]; SLOT[2 * (ra[q] - base) + 1] = q * 128 + K.lane; }
            if (sb[q] && rb[q] >= base && rb[q] < base + 32) { SLOT[2 * (rb[q] - base)] = m.ib[q]; SLOT[2 * (rb[q] - base) + 1] = q * 128 + 64 + K.lane; } }
        asm volatile("s_waitcnt lgkmcnt(0)" ::: "memory");
        const bool two = base + 16 < n;
        i32x4 av[8][4];
#pragma unroll
        for (int t = 0; t < 4; ++t) { const int sl = 4 * t + E; const int e = (base + sl < n) ? SLOT[2 * sl] : SLOT[0]; const unsigned char* up = U + (size_t)e * D + 64 * g4 + 16 * qq;
#pragma unroll
            for (int s_ = 0; s_ < 4; ++s_) av[t][s_] = *(const i32x4*)(up + 256 * s_); }
        if (two) {
#pragma unroll
            for (int t = 4; t < 8; ++t) { const int sl = 4 * t + E; const int e = (base + sl < n) ? SLOT[2 * sl] : SLOT[0]; const unsigned char* up = U + (size_t)e * D + 64 * g4 + 16 * qq;
#pragma unroll
                for (int s_ = 0; s_ < 4; ++s_) av[t][s_] = *(const i32x4*)(up + 256 * s_); } }
        bool fin[2]; int fcode[2]; float fus[2], fvs[2];
#pragma unroll
        for (int p2 = 0; p2 < 2; ++p2) { const int sl = 4 * (4 * p2 + qq) + g4; fin[p2] = false; fcode[p2] = 0; fus[p2] = 0.f; fvs[p2] = 0.f;
            if ((r16 & 7) < 4 && base + sl < n) { const int code = SLOT[2 * sl + 1];
                if ((code >> 7) == rho) { const size_t eo = (size_t)K.l * 16384 + SLOT[2 * sl]; fin[p2] = true; fcode[p2] = code; fus[p2] = K.US()[eo]; fvs[p2] = K.VS()[eo]; } } }
        i32x4 hb[4];
#pragma unroll
        for (int s_ = 0; s_ < 4; ++s_) hb[s_] = *(const i32x4*)(HL + rho * 1024 + 64 * g4 + 16 * qq + 256 * s_);
        int w0, w1 = 0;
        { int rs[4];
#pragma unroll
          for (int t = 0; t < 4; ++t) { i32x4 acc = {0, 0, 0, 0};
#pragma unroll
              for (int s_ = 0; s_ < 4; ++s_) acc = __builtin_amdgcn_mfma_i32_16x16x64_i8(av[t][s_], hb[s_], acc, 0, 0, 0);
              int v = sel4i(acc, qq); v += dppi_<0xB1>(v); v += dppi_<0x4E>(v); rs[t] = v; }
          w0 = qq == 0 ? rs[0] : qq == 1 ? rs[1] : qq == 2 ? rs[2] : rs[3]; }
        if (two) { int rs[4];
#pragma unroll
            for (int t = 0; t < 4; ++t) { i32x4 acc = {0, 0, 0, 0};
#pragma unroll
                for (int s_ = 0; s_ < 4; ++s_) acc = __builtin_amdgcn_mfma_i32_16x16x64_i8(av[4 + t][s_], hb[s_], acc, 0, 0, 0);
                int v = sel4i(acc, qq); v += dppi_<0xB1>(v); v += dppi_<0x4E>(v); rs[t] = v; }
            w1 = qq == 0 ? rs[0] : qq == 1 ? rs[1] : qq == 2 ? rs[2] : rs[3]; }
#pragma unroll
        for (int p2 = 0; p2 < 2; ++p2) {
            const int di = p2 ? w1 : w0;
            if (fin[p2]) { const int code = fcode[p2];
                const float d = (float)di * fus[p2] * ((code >> 7) ? hs[1] : hs[0]);
                if (PROBE >= 2) dummy += gelu_erf(d);
                else (PROBE ? K.ST() : K.PA())[(size_t)(r0 + (code >> 7) * step) * 128 + (code & 127)] = gelu_erf(d) * fvs[p2]; }
        }
        asm volatile("s_waitcnt lgkmcnt(0)" ::: "memory");
    }
}
template <int PROBE> DI void ph_peer_u(Ctx& K) {
    const unsigned char* U = (const unsigned char*)K.UB() + (size_t)K.l * 16384 * D;
    unsigned char* HB = K.lds + K.wave * PUL_STRIDE; int* SLOT = (int*)(HB + PUL_SLOT);
    const int r16 = K.lane & 15, g4 = K.lane >> 4;
    const int step = K.nloc * NWAVES;
    float dummy = 0.f;
    for (int R = K.xg; R < 8; R += K.nxg) {
        int r = K.jx * NWAVES + K.wave; int par = 0;
        PuMeta cur, nxt;
        pu_load(K, r, step, cur, HB);
#pragma unroll 1
        for (; r < M; r += 2 * step) {
            asm volatile("s_waitcnt vmcnt(0)" ::: "memory");
            pu_load(K, r + 2 * step, step, nxt, HB + (par ^ 1) * 2048);
            pu_item<PROBE>(K, U, HB + par * 2048, SLOT, R, r, step, cur, r16, g4, dummy);
            cur = nxt; par ^= 1;
        }
    }
    if (PROBE >= 2) K.ST()[K.gw * 64 + K.lane] = dummy;
}
struct PvMeta { int ia, ib; float ga, gb, pa, pb; };
template <int PROBE> DI void pv_load(const Ctx& K, int r, PvMeta& m) {
    m.ia = K.PIDX()[(size_t)r * 128 + K.lane]; m.ib = K.PIDX()[(size_t)r * 128 + 64 + K.lane];
    m.ga = K.PG()[(size_t)r * 128 + K.lane]; m.pa = K.PA()[(size_t)r * 128 + K.lane]; m.gb = K.PG()[(size_t)r * 128 + 64 + K.lane]; m.pb = K.PA()[(size_t)r * 128 + 64 + K.lane];
}
template <int HALF, int PROBE> DI void pv_issue(const unsigned char* V, int slot, const PvMeta& m, u32x4 (&vv)[8], float (&ww)[8]) {
    const float w = HALF ? m.gb * m.pb : m.ga * m.pa; const int ix = HALF ? m.ib : m.ia;
#pragma unroll
    for (int i = 0; i < 8; ++i) {
        const int src = ((8 * i + slot) << 2);
        const int e = __builtin_amdgcn_ds_bpermute(src, ix);
        ww[i] = __uint_as_float((unsigned)__builtin_amdgcn_ds_bpermute(src, (int)__float_as_uint(w)));
        vv[i] = PROBE == 2 ? (u32x4){(unsigned)e, 1u, 2u, 3u} : *(const u32x4*)(V + (size_t)e * 128);
    }
}
typedef float f32x2_ __attribute__((ext_vector_type(2)));
DI void pv_accum(const u32x4 (&vv)[8], const float (&ww)[8], f32x2_ (&y)[8], float& sw) {
#pragma unroll
    for (int i = 0; i < 8; ++i) { sw += ww[i]; const unsigned w4[4] = {vv[i].x, vv[i].y, vv[i].z, vv[i].w}; const f32x2_ w2 = {ww[i], ww[i]};
#pragma unroll
        for (int q = 0; q < 4; ++q) { const f32x2_ lo = {(float)(w4[q] & 0xffu), (float)((w4[q] >> 8) & 0xffu)}, hi = {(float)((w4[q] >> 16) & 0xffu), (float)(w4[q] >> 24)};
            y[2 * q] = __builtin_elementwise_fma(w2, lo, y[2 * q]); y[2 * q + 1] = __builtin_elementwise_fma(w2, hi, y[2 * q + 1]); } }
}
template <int PROBE> DI void ph_peer_v(Ctx& K) {
    const int slot = K.lane >> 3, c = K.lane & 7;
    const float* gate = K.MOD() + (size_t)K.l * 3 * 6 * D + 5 * D;
    const int step = K.nloc * NWAVES;
    float* Xb = PROBE ? (float*)K.P() : K.X();
    for (int S = K.xg; S < 8; S += K.nxg) {
        const unsigned char* V = (const unsigned char*)K.VB() + ((size_t)K.l * 8 + S) * 16384 * 128 + c * 16;
        const int c0 = S * 128 + c * 16;
        const int r0 = K.jx * NWAVES + K.wave;
        const int nit = r0 < M ? (M - 1 - r0) / step + 1 : 0;
        PvMeta mA, mB; pv_load<PROBE>(K, min(r0, M - 1), mA); pv_load<PROBE>(K, min(r0 + step, M - 1), mB);
        f32x4 xq[4], xprev[4], x2[4], gp[4]; float yp[16]; int rp = -1, mvp = -1; PvMeta m2;
#pragma unroll
        for (int q = 0; q < 4; ++q) { xq[q] = *(const f32x4*)(Xb + (size_t)min(r0, M - 1) * D + c0 + 4 * q); xprev[q] = (f32x4){0.f, 0.f, 0.f, 0.f}; gp[q] = xprev[q]; }
#pragma unroll
        for (int q = 0; q < 16; ++q) yp[q] = 0.f;
#define PV_BODY(XPREV, XQ, XNEW, MA, MC, IT) do { \
            const int r = r0 + (IT) * step; \
            if (rp >= 0) { const int mv = modvec_of_row(rp); \
                if (mv != mvp) { mvp = mv; \
                    _Pragma("unroll") for (int q = 0; q < 4; ++q) gp[q] = *(const f32x4*)(gate + (size_t)mv * 6 * D + c0 + 4 * q); } } \
            { const float zdep = MA.ga * 0.0f; \
                _Pragma("unroll") for (int q = 0; q < 4; ++q) { XPREV[q].x += gp[q].x * yp[4 * q] + zdep; XPREV[q].y += gp[q].y * yp[4 * q + 1] + zdep; XPREV[q].z += gp[q].z * yp[4 * q + 2] + zdep; XPREV[q].w += gp[q].w * yp[4 * q + 3] + zdep; } \
                if (rp >= 0 && slot == 0) { float* xr = Xb + (size_t)rp * D + c0; \
                    _Pragma("unroll") for (int q = 0; q < 4; ++q) *(f32x4*)(xr + 4 * q) = XPREV[q]; } } \
            __builtin_amdgcn_sched_barrier(0); \
            u32x4 vA[8], vB[8]; float wA[8], wB[8]; \
            pv_issue<0, PROBE>(V, slot, MA, vA, wA); \
            pv_issue<1, PROBE>(V, slot, MA, vB, wB); \
            __builtin_amdgcn_sched_barrier(0); \
            { const float* xr = Xb + (size_t)min(r + step, M - 1) * D + c0; \
              _Pragma("unroll") for (int q = 0; q < 4; ++q) XNEW[q] = *(const f32x4*)(xr + 4 * q); } \
            pv_load<PROBE>(K, min(r + 2 * step, M - 1), MC); \
            __builtin_amdgcn_sched_barrier(0); \
            f32x2_ y2[8]; float sw = 0.f; \
            _Pragma("unroll") for (int i = 0; i < 8; ++i) y2[i] = (f32x2_){0.f, 0.f}; \
            pv_accum(vA, wA, y2, sw); \
            pv_accum(vB, wB, y2, sw); \
            _Pragma("unroll") for (int q = 0; q < 8; ++q) { yp[2 * q] = y2[q].x - 128.f * sw; yp[2 * q + 1] = y2[q].y - 128.f * sw; } \
            _Pragma("unroll") for (int q = 0; q < 16; ++q) { float v = yp[q]; v += dpp_<0x128>(v); \
                auto s1 = __builtin_amdgcn_permlane16_swap(__float_as_uint(v), __float_as_uint(v), false, false); v = __uint_as_float(s1[0]) + __uint_as_float(s1[1]); \
                auto s2 = __builtin_amdgcn_permlane32_swap(__float_as_uint(v), __float_as_uint(v), false, false); yp[q] = __uint_as_float(s2[0]) + __uint_as_float(s2[1]); } \
            rp = r; } while (0)
        f32x4 (*xfin)[4] = nullptr; (void)xfin;
        int it = 0;
#pragma unroll 1
        for (; it + 2 < nit; it += 3) {
            PV_BODY(xprev, xq, x2, mA, m2, it);
            PV_BODY(xq, x2, xprev, mB, mA, it + 1);
            PV_BODY(x2, xprev, xq, m2, mB, it + 2);
        }
        if (it < nit) { PV_BODY(xprev, xq, x2, mA, m2, it); ++it;
            if (it < nit) { PV_BODY(xq, x2, xprev, mB, mA, it); ++it;
#pragma unroll
                for (int q = 0; q < 4; ++q) xprev[q] = x2[q]; }
            else {
#pragma unroll
                for (int q = 0; q < 4; ++q) xprev[q] = xq[q]; } }
#undef PV_BODY
        if (rp >= 0) { const int mv = modvec_of_row(rp);
#pragma unroll
            for (int q = 0; q < 4; ++q) gp[q] = *(const f32x4*)(gate + (size_t)mv * 6 * D + c0 + 4 * q);
            if (slot == 0) { float* xr = Xb + (size_t)rp * D + c0;
#pragma unroll
                for (int q = 0; q < 4; ++q) { f32x4 x = xprev[q];
                    x.x += gp[q].x * yp[4 * q]; x.y += gp[q].y * yp[4 * q + 1]; x.z += gp[q].z * yp[4 * q + 2]; x.w += gp[q].w * yp[4 * q + 3]; *(f32x4*)(xr + 4 * q) = x; } } }
    }
}

DI void ph_final(Ctx& K) {
    for (int r = K.gw; r < NLAT; r += K.ngw) {
        const f32x4* xr = (const f32x4*)(K.X() + (size_t)(NCTX + r) * D); f32x4* o = (f32x4*)(((float*)argp_<float>(K, (unsigned)__builtin_offsetof(Args, out))) + (size_t)r * D);
        f32x4 v[4]; float ss = 0.f;
#pragma unroll
        for (int j = 0; j < 4; ++j) { v[j] = xr[j * 64 + K.lane]; ss += v[j].x * v[j].x + v[j].y * v[j].y + v[j].z * v[j].z + v[j].w * v[j].w; }
        ss = wave_sum(ss); const float rs = rsqrtf(ss * (1.0f / D) + EPS);
#pragma unroll
        for (int j = 0; j < 4; ++j) { const f32x4 w = ((const f32x4*)ARG(final_norm_w))[j * 64 + K.lane]; o[j * 64 + K.lane] = v[j] * rs * w; }
    }
}

#define XB_TMO      128
#define XB_XSUB(j)  (1280 + 64 * (j))
#define XB_XGEN(j)  (2304 + 64 * (j))
#define XB_TOP      3328
#define XB_TOPGEN   3392
#define XB_SPIN_CAP (1u << 22)
constexpr int CW_BAR = 4096;
DI unsigned xb_ld(unsigned* p)              { return __hip_atomic_load(p, __ATOMIC_RELAXED, __HIP_MEMORY_SCOPE_AGENT); }
DI unsigned xb_add(unsigned* p, unsigned v) { return __hip_atomic_fetch_add(p, v, __ATOMIC_RELAXED, __HIP_MEMORY_SCOPE_AGENT); }
#define XB_SPIN(cond, bar) do { unsigned _sp = 0; while (cond) { __builtin_amdgcn_s_sleep(1); \
    if ((++_sp & 255u) == 0u) { if (xb_ld(&(bar)[XB_TMO])) break; if (_sp > XB_SPIN_CAP) { atomicAdd(&(bar)[XB_TMO], 1u); break; } } } } while (0)
DI void xcd_barrier(unsigned* bar, unsigned x, unsigned nloc, unsigned nx) {
    asm volatile("s_waitcnt vmcnt(0)" ::: "memory");
    __syncthreads();
    if (threadIdx.x == 0) {
        __builtin_amdgcn_s_waitcnt(0);
        const unsigned old = xb_add(&bar[XB_XSUB(x)], 1u);
        const unsigned gen = old / nloc;
        if (old + 1u == (gen + 1u) * nloc) {
            __builtin_amdgcn_fence(__ATOMIC_RELEASE, "agent");
            asm volatile("s_waitcnt vmcnt(0)" ::: "memory");
            const unsigned og = xb_add(&bar[XB_TOP], 1u);
            const unsigned tg = og / nx;
            if (og + 1u == (tg + 1u) * nx) xb_add(&bar[XB_TOPGEN], 1u);
            else XB_SPIN(xb_ld(&bar[XB_TOPGEN]) == tg, bar);
            __builtin_amdgcn_fence(__ATOMIC_ACQUIRE, "agent");
            xb_add(&bar[XB_XGEN(x)], 1u);
            asm volatile("s_waitcnt vmcnt(0)" ::: "memory");
        } else {
            XB_SPIN(xb_ld(&bar[XB_XGEN(x)]) == gen, bar);
            __builtin_amdgcn_fence(__ATOMIC_ACQUIRE, "agent");
            asm volatile("s_waitcnt vmcnt(0)" ::: "memory");
        }
    }
    __syncthreads();
}

constexpr int PROBE_U = 0, PROBE_V = 0, PROBE_S = 0;
constexpr unsigned DUP_MASK = 0u;
constexpr int PH_PER_LAYER = 13, N_PHASES = 2 + PH_PER_LAYER * DEPTH;
__global__ void __launch_bounds__(NTHREADS) mk_fwd(Args args) {
    extern __shared__ __attribute__((aligned(16))) unsigned char lds[];
    cg::grid_group grid = cg::this_grid();
    constexpr unsigned ARGS_OFF = LDS_BYTES - 256;
    constexpr unsigned MISC_OFF = LDS_BYTES - 64;
    if (threadIdx.x == 0) {
        *(Args*)(lds + ARGS_OFF) = args;
        unsigned* ctl = (unsigned*)(args.ws + WS_CTL); unsigned* misc = (unsigned*)(lds + MISC_OFF);
        const unsigned xcc = (unsigned)__builtin_amdgcn_s_getreg((3 << 11) | 20) & 0xFu;
        misc[0] = xcc; misc[1] = __hip_atomic_fetch_add(ctl + 64 * xcc, 1u, __ATOMIC_RELAXED, __HIP_MEMORY_SCOPE_AGENT);
    }
    __syncthreads();
    int rep = 0;
#pragma unroll 1
    for (int ph = 0; ph < N_PHASES; ++ph) {
        int tid = threadIdx.x; asm volatile("" : "+v"(tid));
        unsigned aoff = ARGS_OFF; asm volatile("" : "+v"(aoff));
        size_t zoff = 0; asm volatile("" : "+s"(zoff));
        unsigned char* ws = args.ws + zoff;
        int bid = blockIdx.x; asm volatile("" : "+s"(bid)); int nb = gridDim.x; asm volatile("" : "+s"(nb));
        unsigned moff = MISC_OFF; asm volatile("" : "+v"(moff));
        Ctx K; { const unsigned* misc = (const unsigned*)(lds + moff); K.jx = __builtin_amdgcn_readfirstlane(misc[1]); K.xg = __builtin_amdgcn_readfirstlane(misc[2]); K.nxg = __builtin_amdgcn_readfirstlane(misc[3]); K.nloc = __builtin_amdgcn_readfirstlane(misc[4]); }
        K.aoff = aoff; K.lds = lds; K.tid = tid; K.lane = tid & 63; K.wave = tid >> 6; K.bid = bid; K.nb = nb; K.gw = bid * NWAVES + K.wave; K.ngw = nb * NWAVES;
        K.ws = ws;
        const int l = ph == 0 ? 0 : (ph - 1) / PH_PER_LAYER, k = ph == 0 ? -1 : (ph == N_PHASES - 1 ? -2 : (ph - 1) % PH_PER_LAYER);
        K.l = l;
        if (k == -1) ph_prologue(K);
        else if (k == -2) ph_final(K);
        else if (k == 0) ph_norm(K, ARG(norm_mix_w) + (size_t)l * D, 0);
        else if (k == 1) ph_gemm_store(K, K.H(), K.WIN() + (size_t)l * PW * D, PW, K.P());
        else if (k == 2) ph_rope(K);
        else if (k == 3) ph_hgrn_A(K);
        else if (k == 4) ph_attn(K);
        else if (k == 5) ph_hgrn_B(K);
        else if (k == 6) ph_hgrn_C(K);
        else if (k == 7) ph_gemm_resid(K, K.MIX(), K.WOUT() + (size_t)l * D * D, 2);
        else if (k == 8) ph_norm(K, ARG(norm_ffn_w) + (size_t)l * D, 3);
        else if (k == 9) ph_gemm_store(K, K.H(), K.WQ() + (size_t)l * 2048 * D, 2048, K.QP());
        else if (k == 10) { ph_peer_select<0>(K); if (PROBE_S) ph_peer_select<PROBE_S>(K); }
        else if (k == 11) { ph_peer_u<0>(K); if (PROBE_U) ph_peer_u<PROBE_U>(K); }
        else if (k == 12) { ph_peer_v<0>(K); if (PROBE_V) ph_peer_v<PROBE_V>(K); }
        if (k >= 0 && ((DUP_MASK >> k) & 1u)) { ++rep; if (rep < 2) { --ph; continue; } } rep = 0;
        if (ph == 0) grid.sync();
        else if (k != 3 && ph != N_PHASES - 1) { const unsigned* misc = (const unsigned*)(lds + moff); xcd_barrier((unsigned*)(args.ws + WS_CTL) + CW_BAR, misc[0], misc[4], misc[3]); }
        if (ph == 0) {
            if (threadIdx.x == 0) { unsigned* ctl = (unsigned*)(args.ws + WS_CTL); unsigned* misc = (unsigned*)(lds + MISC_OFF); const unsigned xcc = misc[0]; unsigned ord = 0, npop = 0, mine = 1;
                for (unsigned q = 0; q < 16; ++q) { const unsigned cq = __hip_atomic_load(ctl + 64 * q, __ATOMIC_RELAXED, __HIP_MEMORY_SCOPE_AGENT); if (cq) { ++npop; if (q < xcc) ++ord; } if (q == xcc) mine = cq; }
                misc[2] = ord; misc[3] = npop ? npop : 1u; misc[4] = mine ? mine : 1u; }
            __syncthreads();
        }
    }
}

extern "C" void kernel_launch(void* const* d_in, const int* in_sizes, int n_in, void* d_out, int out_size, void* d_ws, size_t ws_size, hipStream_t stream) {
    static int grid = 0;
    if (grid == 0) {
        if (n_in != 19 || out_size != NLAT * D || ws_size < WS_END) { fprintf(stderr, "kernel_launch: unexpected shapes (n_in %d out %d ws %zu need %zu)\n", n_in, out_size, ws_size, (size_t)WS_END); grid = -1; return; }
        int dev = 0, cus = 0, per_cu = 0;
        (void)hipGetDevice(&dev); (void)hipDeviceGetAttribute(&cus, hipDeviceAttributeMultiprocessorCount, dev);
        (void)hipFuncSetAttribute((const void*)mk_fwd, hipFuncAttributeMaxDynamicSharedMemorySize, LDS_BYTES);
        (void)hipOccupancyMaxActiveBlocksPerMultiprocessor(&per_cu, (const void*)mk_fwd, NTHREADS, LDS_BYTES);
        if (per_cu < 1) { fprintf(stderr, "kernel_launch: occupancy query says %d blocks/CU\n", per_cu); grid = -1; return; }
        grid = (cus / 8) * 8;
    }
    if (grid < 0) return;
    Args a{};
    a.x = (const float*)d_in[0]; a.c = (const float*)d_in[1]; a.ctx = (const float*)d_in[2]; a.c_ctx = (const float*)d_in[3]; a.w_mod = (const float*)d_in[4]; a.b_mod = (const float*)d_in[5];
    a.norm_mix_w = (const float*)d_in[6]; a.norm_ffn_w = (const float*)d_in[7]; a.w_in = (const float*)d_in[8]; a.lb_logits = (const float*)d_in[9]; a.hgrn_norm_w = (const float*)d_in[10];
    a.swa_sink = (const float*)d_in[11]; a.nat_rpb = (const float*)d_in[12]; a.w_out = (const float*)d_in[13]; a.peer_wq = (const float*)d_in[14]; a.peer_sk = (const float*)d_in[15];
    a.peer_u = (const float*)d_in[16]; a.peer_v = (const float*)d_in[17]; a.final_norm_w = (const float*)d_in[18];
    a.out = (float*)d_out; a.ws = (unsigned char*)d_ws;
    (void)hipMemsetAsync((unsigned char*)d_ws + WS_CTL, 0, CTL_BYTES, stream);
    void* kargs[] = {&a};
    hipError_t e = hipLaunchCooperativeKernel((const void*)mk_fwd, dim3(grid), dim3(NTHREADS), kargs, LDS_BYTES, stream);
    if (e != hipSuccess) fprintf(stderr, "kernel_launch: cooperative launch failed: %s (grid %d)\n", hipGetErrorString(e), grid);
}
```

```cpp
#include <hip/hip_runtime.h>
#include <hip/hip_cooperative_groups.h>
#include <cstdio>
#include <cstdint>
namespace cg = cooperative_groups;
#define DI __device__ __forceinline__
#define GP(T, p) ((T*)(__attribute__((address_space(1))) T*)(p))

typedef unsigned short bf16_t;
typedef float f32x4 __attribute__((ext_vector_type(4)));
typedef unsigned u32x4 __attribute__((ext_vector_type(4)));
typedef unsigned u32x2 __attribute__((ext_vector_type(2)));

constexpr int D = 1024, NB = 2, L = 16384, CL = 256, DEPTH = 4;
constexpr int NCTX = NB * CL, NLAT = NB * L, M = NCTX + NLAT;
constexpr int PW = 3072;
constexpr int C_HQ = 0, C_ZF = 256, C_ZB = 512, C_HV = 768, C_HG = 1024, C_SQ = 1280, C_SK = 1664, C_SV = 1792, C_NQ = 1920, C_NK = 2304, C_NV = 2688;
constexpr int MX_H = 0, MX_S = 256, MX_N = 640;
constexpr float EPS = 1e-6f;
constexpr int NTHREADS = 512, NWAVES = 8;
constexpr int LDS_BYTES = 163840;

constexpr size_t al256(size_t x) { return (x + 255) & ~(size_t)255; }
constexpr size_t WS_X = 0;
constexpr size_t WS_H = WS_X + al256((size_t)M * D * 4);
constexpr size_t WS_P = WS_H + al256((size_t)M * D * 2);
constexpr size_t WS_MIX = WS_P + al256((size_t)M * PW * 2);
constexpr size_t WS_OF = WS_MIX + al256((size_t)M * D * 2);
constexpr size_t WS_OB = WS_OF + al256((size_t)M * 256 * 4);
constexpr size_t WS_PIDX = WS_OB + al256((size_t)M * 256 * 4);
constexpr size_t WS_PG = WS_PIDX + al256((size_t)M * 128 * 4);
constexpr size_t WS_MOD = WS_PG + al256((size_t)M * 128 * 4);
constexpr size_t WS_LB = WS_MOD + al256((size_t)DEPTH * 3 * 6 * D * 4);
constexpr size_t WS_ROPE = WS_LB + al256((size_t)2 * DEPTH * 256 * 4);
constexpr size_t WS_WIN = WS_ROPE + al256((size_t)(256 + 256 + 64 + 64) * 16 * 4);
constexpr size_t WS_WOUT = WS_WIN + al256((size_t)DEPTH * PW * D * 2);
constexpr size_t WS_WQ = WS_WOUT + al256((size_t)DEPTH * D * D * 2);
constexpr size_t WS_AC = WS_WQ + al256((size_t)DEPTH * 2048 * D * 2);
constexpr size_t WS_UB_ = 0; constexpr size_t WS_UB = WS_AC + al256((size_t)16 * 260 * 64 * 4); constexpr size_t WS_UB_OLD = WS_WQ + al256((size_t)DEPTH * 2048 * D * 2);
constexpr size_t WS_VB = WS_UB + al256((size_t)DEPTH * 16384 * D * 2);
constexpr size_t WS_PA = WS_VB + al256((size_t)DEPTH * 16384 * D * 2);
constexpr size_t WS_VS = WS_PA + al256((size_t)M * 128 * 4);
constexpr size_t WS_US = WS_VS + al256((size_t)DEPTH * 16384 * 4);
constexpr size_t WS_H8 = WS_US + al256((size_t)DEPTH * 16384 * 4);
constexpr size_t WS_HS = WS_H8 + al256((size_t)M * D);
constexpr size_t WS_SKH = WS_HS + al256((size_t)M * 4);
constexpr size_t WS_SKL = WS_SKH + al256((size_t)DEPTH * 8 * 2 * 128 * 128 * 2);
constexpr size_t WS_CTL = WS_SKL + al256((size_t)DEPTH * 8 * 2 * 128 * 128 * 2);
constexpr size_t CTL_BYTES = 65536;
constexpr size_t WS_END = WS_CTL + CTL_BYTES;

struct Args {
    const float *x, *c, *ctx, *c_ctx, *w_mod, *b_mod, *norm_mix_w, *norm_ffn_w, *w_in, *lb_logits, *hgrn_norm_w, *swa_sink, *nat_rpb, *w_out, *peer_wq, *peer_sk, *peer_u, *peer_v, *final_norm_w;
    float* out; unsigned char* ws;
};

DI float bf2f(bf16_t v) { return __uint_as_float((unsigned)v << 16); }
DI bf16_t f2bf(float f) { unsigned u = __float_as_uint(f); return (bf16_t)((u + 0x7fffu + ((u >> 16) & 1u)) >> 16); }
DI unsigned pk2(float lo, float hi) { return (unsigned)f2bf(lo) | ((unsigned)f2bf(hi) << 16); }
DI float wave_sum(float v) {
#pragma unroll
    for (int o = 1; o < 64; o <<= 1) v += __shfl_xor(v, o);
    return v;
}
typedef __bf16 bf16x2_t __attribute__((ext_vector_type(2)));
DI float dot2bf(unsigned a, unsigned b, float acc) { return __builtin_amdgcn_fdot2_f32_bf16(__builtin_bit_cast(bf16x2_t, a), __builtin_bit_cast(bf16x2_t, b), acc, false); }
template <int CTRL> DI float dpp_(float x) { return __builtin_bit_cast(float, __builtin_amdgcn_mov_dpp(__builtin_bit_cast(int, x), CTRL, 0xf, 0xf, true)); }
DI float wave_sum_fast(float x) {
    x += dpp_<0xB1>(x); x += dpp_<0x4E>(x); x += dpp_<0x141>(x); x += dpp_<0x128>(x);
    auto s1 = __builtin_amdgcn_permlane16_swap(__float_as_uint(x), __float_as_uint(x), false, false); x = __uint_as_float(s1[0]) + __uint_as_float(s1[1]);
    auto s2 = __builtin_amdgcn_permlane32_swap(__float_as_uint(x), __float_as_uint(x), false, false); return __uint_as_float(s2[0]) + __uint_as_float(s2[1]);
}
DI float sigmoidf_(float z) { return 1.0f / (1.0f + __expf(-z)); }
DI float gelu_erf(float v) { return 0.5f * v * (1.0f + erff(v * 0.70710678118654752f)); }
DI int modvec_of_row(int r) { return r < NCTX ? 2 : (r - NCTX) / L; }
DI int batch_of_row(int r) { return r < NCTX ? r / CL : (r - NCTX) / L; }
DI int lat_row(int b, int t) { return NCTX + b * L + t; }
DI int ctx_row(int b, int s) { return b * CL + s; }
DI void unpack8(const u32x4 w, float* o) {
    o[0] = __uint_as_float(w.x << 16); o[1] = __uint_as_float(w.x & 0xffff0000u);
    o[2] = __uint_as_float(w.y << 16); o[3] = __uint_as_float(w.y & 0xffff0000u);
    o[4] = __uint_as_float(w.z << 16); o[5] = __uint_as_float(w.z & 0xffff0000u);
    o[6] = __uint_as_float(w.w << 16); o[7] = __uint_as_float(w.w & 0xffff0000u);
}
DI void load_row64(const bf16_t* p, float (&o)[64]) {
#pragma unroll
    for (int i = 0; i < 8; ++i) { const u32x4 w = *(const u32x4*)(p + 8 * i); unpack8(w, &o[8 * i]); }
}
DI void rope64(float (&x)[64], const float* cr, const float* sr, const float* cc, const float* sc) {
#pragma unroll
    for (int i = 0; i < 16; ++i) {
        const float c1 = cr[i], s1 = sr[i], a = x[i], b = x[16 + i];
        x[i] = a * c1 - b * s1; x[16 + i] = b * c1 + a * s1;
        const float c2 = cc[i], s2 = sc[i], e = x[32 + i], f = x[48 + i];
        x[32 + i] = e * c2 - f * s2; x[48 + i] = f * c2 + e * s2;
    }
}

namespace pg8 {
#define PG8_LAS __attribute__((address_space(3)))
typedef unsigned short bf16_t;
typedef short bf16x8 __attribute__((ext_vector_type(8)));
typedef float f32x4 __attribute__((ext_vector_type(4)));
typedef unsigned u32x4 __attribute__((ext_vector_type(4)));
constexpr int BM = 256, BK = 64, HALF = 128, HTB = HALF * BK * 2  , STAGE_BYTES = 8 * HTB, NXCD = 8, WGM = 8;

__host__ __device__ __forceinline__ int lds_byte(int r, int c) { const int st = (r >> 4) * 2 + (c >> 5), rr = r & 15, cc = c & 31, ob = rr * 64 + cc * 2; return st * 1024 + (ob ^ (((ob >> 9) & 1) << 5)); }
__host__ __device__ __forceinline__ void stage_rc(int b, int& R, int& C) { const int st = b / 1024, sb = b % 1024, swz = sb ^ (((sb >> 9) & 1) << 5); R = (st >> 1) * 16 + swz / 64; C = (st & 1) * 32 + (swz % 64) / 2; }
__host__ __device__ __forceinline__ int perm32(int rho) { const int n = rho >> 4, i = rho & 15; return 8 * (i >> 2) + 4 * n + (i & 3); }

struct Unit { int pm, pn; };
struct Gemm { const bf16_t* A; const bf16_t* Bt; int M, N, K; };

struct StaticOrder {
    int nM, nN, nwg, G, c;
    __host__ __device__ void init(int M, int N, int G_, int c_) { nM = M / BM; nN = N / BM; nwg = nM * nN; G = G_; c = c_; }
    __host__ __device__ bool next(int i, Unit& u) const {
        const long L = (long)i * G + c; if (L >= nwg) return false;
        int wgid = (int)L; { const int q = nwg / NXCD, r = nwg % NXCD, xcd = wgid % NXCD, off = wgid / NXCD; wgid = (xcd < r ? xcd * (q + 1) : r * (q + 1) + (xcd - r) * q) + off; }
        const int nig = WGM * nN, gid = wgid / nig, fm = gid * WGM, gsz = (nM - fm) < WGM ? (nM - fm) : WGM;
        u.pm = fm + ((wgid % nig) % gsz); u.pn = (wgid % nig) / gsz; return true;
    }
    __device__ __forceinline__ void a_ready(const Unit&) const {}
    __device__ __forceinline__ void done(const Unit&) const {}
};


__device__ __forceinline__ unsigned cvt_pk_bf16(float lo, float hi) { unsigned r; asm volatile("v_cvt_pk_bf16_f32 %0, %1, %2" : "=v"(r) : "v"(lo), "v"(hi)); return r; }
constexpr int EPI_LDS_OFF = STAGE_BYTES, EPI_LDS_WAVE = 2560;
struct EpiStore {
    static constexpr bool PERM = true, AFTER_DRAIN = false;
    bf16_t* O; int ldc; PG8_LAS unsigned char* lds; const float* rope; int nctx, seqlen;
    __device__ __forceinline__ void operator()(const f32x4 (&acc)[2][2][4][2], const Unit& u, int wr, int wc, int fr, int fq) const {
        PG8_LAS unsigned char* T = lds + EPI_LDS_OFF + (wr * 4 + wc) * EPI_LDS_WAVE;
        const int lane = fr + 16 * fq, rr = lane >> 2, cc = lane & 3;
        const int row0 = u.pm * BM + wr * 64, col0 = u.pn * BM + wc * 32;
        const bool dorope = rope != nullptr && (u.pn == 5 || u.pn == 6) && u.pm * BM >= nctx;
#pragma unroll
        for (int ai = 0; ai < 2; ++ai)
#pragma unroll
            for (int m = 0; m < 4; ++m)
#pragma unroll
                for (int bj = 0; bj < 2; ++bj) { const f32x4 v0 = acc[ai][bj][m][0], v1 = acc[ai][bj][m][1];
                    u32x4 w; w.x = cvt_pk_bf16(v0[0], v0[1]); w.y = cvt_pk_bf16(v0[2], v0[3]); w.z = cvt_pk_bf16(v1[0], v1[1]); w.w = cvt_pk_bf16(v1[2], v1[3]);
                    *(PG8_LAS u32x4*)(T + fr * 80 + 16 * fq) = w;
                    asm volatile("s_waitcnt lgkmcnt(0)" ::: "memory");
                    u32x4 o = *(const PG8_LAS u32x4*)(T + rr * 80 + 16 * cc);
                    asm volatile("s_waitcnt lgkmcnt(0)" ::: "memory");
                    const int grow = row0 + ai * HALF + m * 16 + rr;
                    if (dorope) {
                        const int t = (grow - nctx) % seqlen; const bool second = (wc & 1) != 0;
                        const float* ct = rope + (second ? 8192 + (t & 63) * 16 : (t >> 6) * 16) + 8 * (cc & 1); const float* st = ct + (second ? 1024 : 4096);
                        const f32x4 c0 = *(const f32x4*)ct, c1 = *(const f32x4*)(ct + 4), s0 = *(const f32x4*)st, s1 = *(const f32x4*)(st + 4);
                        const float cs[8] = {c0[0], c0[1], c0[2], c0[3], c1[0], c1[1], c1[2], c1[3]}, sn[8] = {s0[0], s0[1], s0[2], s0[3], s1[0], s1[1], s1[2], s1[3]};
                        const unsigned ow[4] = {o.x, o.y, o.z, o.w}; unsigned rw[4];
                        const float sg = cc >= 2 ? 1.0f : -1.0f;
#pragma unroll
                        for (int q = 0; q < 4; ++q) { const unsigned pw = (unsigned)__builtin_amdgcn_mov_dpp((int)ow[q], 0x4E, 0xf, 0xf, true);
                            const float x0 = __uint_as_float(ow[q] << 16), x1 = __uint_as_float(ow[q] & 0xffff0000u), p0 = __uint_as_float(pw << 16), p1 = __uint_as_float(pw & 0xffff0000u);
                            rw[q] = cvt_pk_bf16(x0 * cs[2 * q] + sg * p0 * sn[2 * q], x1 * cs[2 * q + 1] + sg * p1 * sn[2 * q + 1]); }
                        o = (u32x4){rw[0], rw[1], rw[2], rw[3]}; }
                    *(u32x4*)(O + (size_t)grow * ldc + col0 + bj * HALF + 8 * cc) = o; }
    }
};
struct EpiResid {
    static constexpr bool PERM = false, AFTER_DRAIN = false;
    float* X; int ldc; const float* gate; int gstride, nctx, seqlen; PG8_LAS unsigned char* lds;
    __device__ __forceinline__ void operator()(const f32x4 (&acc)[2][2][4][2], const Unit& u, int wr, int wc, int fr, int fq) const {
        PG8_LAS float* T = (PG8_LAS float*)(lds + EPI_LDS_OFF + (wr * 4 + wc) * EPI_LDS_WAVE);
        const int lane = fr + 16 * fq, rr = lane >> 3, cc = lane & 7;
        const int r0 = u.pm * BM; const int vsel = r0 < nctx ? 2 : (r0 - nctx) / seqlen;
        const int row0 = r0 + wr * 64, col0 = u.pn * BM + wc * 32 + 4 * cc;
#pragma unroll
        for (int bj = 0; bj < 2; ++bj) { const f32x4 g = *(const f32x4*)(gate + (size_t)vsel * gstride + col0 + bj * HALF);
#pragma unroll
            for (int ai = 0; ai < 2; ++ai)
#pragma unroll
                for (int m = 0; m < 4; ++m) {
#pragma unroll
                    for (int n = 0; n < 2; ++n) *(PG8_LAS f32x4*)(T + fr * 36 + 16 * n + 4 * fq) = acc[ai][bj][m][n];
                    asm volatile("s_waitcnt lgkmcnt(0)" ::: "memory");
                    const f32x4 t0 = *(const PG8_LAS f32x4*)(T + rr * 36 + 4 * cc), t1 = *(const PG8_LAS f32x4*)(T + (rr + 8) * 36 + 4 * cc);
                    asm volatile("s_waitcnt lgkmcnt(0)" ::: "memory");
                    float* x0 = X + (size_t)(row0 + ai * HALF + m * 16 + rr) * ldc + col0 + bj * HALF; float* x1 = x0 + (size_t)8 * ldc;
                    f32x4 a = *(const f32x4*)x0, b = *(const f32x4*)x1; a += g * t0; b += g * t1; *(f32x4*)x0 = a; *(f32x4*)x1 = b; } }
    }
};

template <class Epi, class Sched, bool ALIGN_EPI = false, bool SP2 = false>
__device__ __forceinline__ void gemm_phase(PG8_LAS unsigned char* lds, const Gemm g, const Sched& S, const Epi& E) {
    int tid_ = threadIdx.x; asm volatile("" : "+v"(tid_));
    const int tid = tid_, wid = __builtin_amdgcn_readfirstlane(tid >> 6), lane = tid & 63, wr = wid >> 2, wc = wid & 3, fr = lane & 15, fq = lane >> 4;
    const int K = g.K, nt = K / BK;
    unsigned voffA[2], voffB[2];
#pragma unroll
    for (int i = 0; i < 2; ++i) { int R, C; stage_rc(tid * 16 + i * 8192, R, C); const int Rb = Epi::PERM ? ((R & ~31) + perm32(R & 31)) : R;
        voffA[i] = (unsigned)(R * K + C) * 2u; voffB[i] = (unsigned)(Rb * K + C) * 2u; }
    const size_t kstep = (size_t)(BK * 2);
    const size_t hstep = (size_t)HALF * K * 2;
    const size_t tstep = 2 * hstep;
    const unsigned ldsw = (unsigned)wid * 1024u;
    const int aoff = lds_byte(wr * 64 + fr, fq * 8), boff = lds_byte(wc * 32 + fr, fq * 8);
#define PG8_SA(b, h) (((b) * 2 + (h)) * HTB)
#define PG8_SB(b, h) ((4 + (b) * 2 + (h)) * HTB)
#define PG8_STAGE(bufoff, gbase, voff) do { _Pragma("unroll") for (int _i = 0; _i < 2; ++_i) \
        __builtin_amdgcn_global_load_lds((const unsigned*)((const char*)(gbase) + (voff)[_i]), (PG8_LAS unsigned*)(lds + (bufoff) + ldsw + _i * 8192), 16, 0, 0); } while (0)
#define PG8_LDA(dst, b, h) do { _Pragma("unroll") for (int m = 0; m < 4; ++m) _Pragma("unroll") for (int k = 0; k < 2; ++k) dst[m][k] = *(const PG8_LAS bf16x8*)(lds + PG8_SA(b, h) + aoff + m * 2048 + k * 1024); } while (0)
#define PG8_LDB(dst, b, h) do { _Pragma("unroll") for (int n = 0; n < 2; ++n) _Pragma("unroll") for (int k = 0; k < 2; ++k) dst[n][k] = *(const PG8_LAS bf16x8*)(lds + PG8_SB(b, h) + boff + n * 2048 + k * 1024); } while (0)
#define PG8_MMA(ai, bj, At, Bt) do { __builtin_amdgcn_s_setprio(1); _Pragma("unroll") for (int m = 0; m < 4; ++m) _Pragma("unroll") for (int n = 0; n < 2; ++n) _Pragma("unroll") for (int k = 0; k < 2; ++k) \
        acc[ai][bj][m][n] = __builtin_amdgcn_mfma_f32_16x16x32_bf16(Bt[n][k], At[m][k], acc[ai][bj][m][n], 0, 0, 0); __builtin_amdgcn_s_setprio(0); } while (0)
#define PG8_WAIT_V(n) asm volatile("s_waitcnt vmcnt(" #n ")" ::: "memory")
#define PG8_WAIT_L(n) asm volatile("s_waitcnt lgkmcnt(" #n ")" ::: "memory")
#define PG8_BAR __builtin_amdgcn_s_barrier()
#define PG8_SCHED __builtin_amdgcn_sched_barrier(0)
    Unit cur, nxt; int ui = 0;
    if (!S.next(0, cur)) return;
    f32x4 acc[2][2][4][2];
#pragma unroll
    for (int a = 0; a < 2; ++a)
#pragma unroll
        for (int b = 0; b < 2; ++b)
#pragma unroll
            for (int m = 0; m < 4; ++m)
#pragma unroll
                for (int n = 0; n < 2; ++n) acc[a][b][m][n] = (f32x4){0.f, 0.f, 0.f, 0.f};
    bf16x8 At[4][2], B0[2][2], B1[2][2];
    const char* cA = (const char*)g.A + (size_t)cur.pm * tstep; const char* cB = (const char*)g.Bt + (size_t)cur.pn * tstep;
    S.a_ready(cur);
    if constexpr (SP2) {
        PG8_STAGE(PG8_SB(0, 0), cB, voffB); PG8_STAGE(PG8_SB(0, 1), cB + hstep, voffB); PG8_STAGE(PG8_SA(0, 0), cA, voffA); PG8_STAGE(PG8_SA(0, 1), cA + hstep, voffA);
        if (wr == 1) PG8_BAR;
        PG8_WAIT_V(2); PG8_BAR;
        PG8_STAGE(PG8_SB(1, 0), cB + kstep, voffB); PG8_STAGE(PG8_SA(1, 0), cA + kstep, voffA); PG8_STAGE(PG8_SB(1, 1), cB + hstep + kstep, voffB);
        PG8_WAIT_V(6); PG8_BAR;
    } else {
        PG8_STAGE(PG8_SB(0, 0), cB, voffB); PG8_STAGE(PG8_SA(0, 0), cA, voffA); PG8_STAGE(PG8_SB(0, 1), cB + hstep, voffB); PG8_STAGE(PG8_SA(0, 1), cA + hstep, voffA);
        if (wr == 1) PG8_BAR;
        PG8_WAIT_V(4); PG8_BAR;
        PG8_STAGE(PG8_SB(1, 0), cB + kstep, voffB); PG8_STAGE(PG8_SA(1, 0), cA + kstep, voffA); PG8_STAGE(PG8_SB(1, 1), cB + hstep + kstep, voffB);
        PG8_WAIT_V(6); PG8_BAR;
    }
    for (;;) {
        const bool has_next = S.next(ui + 1, nxt);
        const char* nA = has_next ? (const char*)g.A + (size_t)nxt.pm * tstep : cA; const char* nB = has_next ? (const char*)g.Bt + (size_t)nxt.pn * tstep : cB;
        for (int t = 0; t < nt; t += 2) {
            const bool last = (t == nt - 2);
            const char* a1 = cA + (size_t)(t + 1) * kstep;
            const char* a2 = last ? nA : cA + (size_t)(t + 2) * kstep; const char* b2 = last ? nB : cB + (size_t)(t + 2) * kstep;
            const char* a3 = a2 + kstep; const char* b3 = b2 + kstep;
            if (last && has_next) S.a_ready(nxt);
            if constexpr (SP2) {
            PG8_LDB(B0, 0, 0); PG8_LDB(B1, 0, 1); PG8_SCHED; PG8_LDA(At, 0, 0); PG8_STAGE(PG8_SA(1, 1), a1 + hstep, voffA);
            PG8_WAIT_V(8); PG8_WAIT_L(0); PG8_BAR; PG8_MMA(0, 0, At, B0); PG8_MMA(0, 1, At, B1); PG8_BAR; PG8_SCHED;
            PG8_LDA(At, 0, 1); PG8_STAGE(PG8_SB(0, 0), b2, voffB); PG8_STAGE(PG8_SB(0, 1), b2 + hstep, voffB); PG8_STAGE(PG8_SA(0, 0), a2, voffA);
            PG8_WAIT_V(8); PG8_WAIT_L(0); PG8_BAR; PG8_MMA(1, 0, At, B0); PG8_MMA(1, 1, At, B1); PG8_BAR; PG8_SCHED;
            PG8_LDB(B0, 1, 0); PG8_LDB(B1, 1, 1); PG8_SCHED; PG8_LDA(At, 1, 0); PG8_STAGE(PG8_SA(0, 1), a2 + hstep, voffA);
            PG8_WAIT_V(8); PG8_WAIT_L(0); PG8_BAR; PG8_MMA(0, 0, At, B0); PG8_MMA(0, 1, At, B1); PG8_BAR; PG8_SCHED;
            PG8_LDA(At, 1, 1); PG8_STAGE(PG8_SB(1, 0), b3, voffB); PG8_STAGE(PG8_SB(1, 1), b3 + hstep, voffB); PG8_STAGE(PG8_SA(1, 0), a3, voffA);
            PG8_WAIT_V(8); PG8_WAIT_L(0); PG8_BAR; PG8_MMA(1, 0, At, B0); PG8_MMA(1, 1, At, B1); PG8_BAR; PG8_SCHED;
            } else {
            PG8_LDB(B0, 0, 0); PG8_SCHED; PG8_LDA(At, 0, 0); PG8_STAGE(PG8_SA(1, 1), a1 + hstep, voffA);
            PG8_WAIT_L(8); PG8_BAR; PG8_WAIT_L(0); PG8_MMA(0, 0, At, B0); PG8_BAR; PG8_SCHED;
            PG8_LDB(B1, 0, 1); PG8_STAGE(PG8_SB(0, 0), b2, voffB);
            PG8_BAR; PG8_WAIT_L(0); PG8_MMA(0, 1, At, B1); PG8_BAR;
            PG8_LDA(At, 0, 1); PG8_STAGE(PG8_SA(0, 0), a2, voffA);
            PG8_BAR; PG8_WAIT_L(0); PG8_MMA(1, 0, At, B0); PG8_BAR; PG8_SCHED;
            PG8_STAGE(PG8_SB(0, 1), b2 + hstep, voffB);
            PG8_WAIT_V(6); PG8_BAR; PG8_MMA(1, 1, At, B1); PG8_BAR;
            PG8_LDB(B0, 1, 0); PG8_SCHED; PG8_LDA(At, 1, 0); PG8_STAGE(PG8_SA(0, 1), a2 + hstep, voffA);
            PG8_WAIT_L(8); PG8_BAR; PG8_WAIT_L(0); PG8_MMA(0, 0, At, B0); PG8_BAR; PG8_SCHED;
            PG8_LDB(B1, 1, 1); PG8_STAGE(PG8_SB(1, 0), b3, voffB);
            PG8_BAR; PG8_WAIT_L(0); PG8_MMA(0, 1, At, B1); PG8_BAR;
            PG8_LDA(At, 1, 1); PG8_STAGE(PG8_SA(1, 0), a3, voffA);
            PG8_BAR; PG8_WAIT_L(0); PG8_MMA(1, 0, At, B0); PG8_BAR; PG8_SCHED;
            PG8_STAGE(PG8_SB(1, 1), b3 + hstep, voffB);
            PG8_WAIT_V(6); PG8_BAR; PG8_MMA(1, 1, At, B1); PG8_BAR;
            }
        }
        if constexpr (ALIGN_EPI) { if (wr == 0) PG8_BAR; }
        if constexpr (!Epi::AFTER_DRAIN) { E(acc, cur, wr, wc, fr, fq); S.done(cur); }
        if (!has_next) break;
#pragma unroll
        for (int a = 0; a < 2; ++a)
#pragma unroll
            for (int b = 0; b < 2; ++b)
#pragma unroll
                for (int m = 0; m < 4; ++m)
#pragma unroll
                    for (int n = 0; n < 2; ++n) acc[a][b][m][n] = (f32x4){0.f, 0.f, 0.f, 0.f};
        cur = nxt; cA = nA; cB = nB; ++ui;
        if constexpr (ALIGN_EPI) { if (wr == 1) PG8_BAR; }
    }
    PG8_WAIT_V(0);
    if constexpr (!ALIGN_EPI) { if (wr == 0) PG8_BAR; }
    PG8_BAR;
    if constexpr (Epi::AFTER_DRAIN) { E.fused(acc, cur, wr, wc, fr, fq, lds, wid, lane); S.done(cur); }
#undef PG8_SA
#undef PG8_SB
#undef PG8_STAGE
#undef PG8_LDA
#undef PG8_LDB
#undef PG8_MMA
#undef PG8_WAIT_V
#undef PG8_WAIT_L
#undef PG8_BAR
#undef PG8_SCHED
}
}

struct Ctx {
    unsigned aoff; int l;
    unsigned char* ws;
    DI float* X() const { return GP(float, ws + WS_X); }
    DI bf16_t* H() const { return GP(bf16_t, ws + WS_H); }
    DI bf16_t* P() const { return GP(bf16_t, ws + WS_P); }
    DI bf16_t* QP() const { return GP(bf16_t, ws + WS_P); }
    DI bf16_t* MIX() const { return GP(bf16_t, ws + WS_MIX); }
    DI float* OF() const { return GP(float, ws + WS_OF); }
    DI float* OB() const { return GP(float, ws + WS_OB); }
    DI int* PIDX() const { return GP(int, ws + WS_PIDX); }
    DI float* PG() const { return GP(float, ws + WS_PG); }
    DI float* MOD() const { return GP(float, ws + WS_MOD); }
    DI float* LB() const { return GP(float, ws + WS_LB); }
    DI float* ROPE() const { return GP(float, ws + WS_ROPE); }
    DI bf16_t* WIN() const { return GP(bf16_t, ws + WS_WIN); }
    DI bf16_t* WOUT() const { return GP(bf16_t, ws + WS_WOUT); }
    DI bf16_t* WQ() const { return GP(bf16_t, ws + WS_WQ); }
    DI bf16_t* UB() const { return GP(bf16_t, ws + WS_UB); }
    DI float* ST() const { return GP(float, ws + WS_OF); }
    DI float* AC() const { return GP(float, ws + WS_AC); }
    DI float* PA() const { return GP(float, ws + WS_PA); }
    DI float* VS() const { return GP(float, ws + WS_VS); }
    DI float* US() const { return GP(float, ws + WS_US); }
    DI bf16_t* SKH() const { return GP(bf16_t, ws + WS_SKH); }
    DI bf16_t* SKL() const { return GP(bf16_t, ws + WS_SKL); }
    DI bf16_t* VB() const { return GP(bf16_t, ws + WS_VB); }
    DI unsigned char* H8() const { return GP(unsigned char, ws + WS_H8); }
    DI float* HS() const { return GP(float, ws + WS_HS); }
    unsigned char* lds; int tid, lane, wave, gw, ngw, bid, nb;
    int xg, nxg, jx, nloc;
};

#define LAS __attribute__((address_space(3)))
DI void transpose_item(const float* W, int Kd, int N, bf16_t* WT, LAS float* scr, int item, int lane) {
    const int nblk = N / 32, kb = item / nblk, nb = item % nblk, k0 = 64 * kb, n0 = 32 * nb;
#pragma unroll 8
    for (int i = 0; i < 32; ++i) { const int kk = 2 * i + (lane >> 5); scr[kk * 33 + (lane & 31)] = W[(size_t)(k0 + kk) * N + n0 + (lane & 31)]; }
    asm volatile("s_waitcnt lgkmcnt(0)" ::: "memory");
    const int c = lane & 7;
#pragma unroll
    for (int j = 0; j < 4; ++j) { const int n = (lane >> 3) + 8 * j; const LAS float* sp = scr + (8 * c) * 33 + n;
        u32x4 o; o.x = pk2(sp[0 * 33], sp[1 * 33]); o.y = pk2(sp[2 * 33], sp[3 * 33]); o.z = pk2(sp[4 * 33], sp[5 * 33]); o.w = pk2(sp[6 * 33], sp[7 * 33]);
        *(u32x4*)(WT + (size_t)(n0 + n) * Kd + k0 + 8 * c) = o; }
    asm volatile("s_waitcnt lgkmcnt(0)" ::: "memory");
}

template <class T> DI T* argp_(const Ctx& K, unsigned off) {
    const unsigned* p = (const unsigned*)(K.lds + K.aoff + off);
    const unsigned lo = __builtin_amdgcn_readfirstlane(p[0]), hi = __builtin_amdgcn_readfirstlane(p[1]);
    return GP(T, ((unsigned long long)hi << 32) | (unsigned long long)lo);
}
#define ARG(f) argp_<const float>(K, (unsigned)__builtin_offsetof(Args, f))

DI void ph_prologue(Ctx& K) {
    {
        LAS float* scr = (LAS float*)((LAS unsigned char*)K.lds + K.wave * 16384);
        constexpr int I_IN = (D / 64) * (PW / 32), I_OUT = (D / 64) * (D / 32), I_Q = (D / 64) * (2048 / 32), I_L = I_IN + I_OUT + I_Q;
        for (int it = K.gw; it < DEPTH * I_L; it += K.ngw) {
            const int l = it / I_L; int r = it % I_L;
            if (r < I_IN) { transpose_item(ARG(w_in) + (size_t)l * D * PW, D, PW, K.WIN() + (size_t)l * PW * D, scr, r, K.lane); continue; } r -= I_IN;
            if (r < I_OUT) { transpose_item(ARG(w_out) + (size_t)l * D * D, D, D, K.WOUT() + (size_t)l * D * D, scr, r, K.lane); continue; } r -= I_OUT;
            transpose_item(ARG(peer_wq) + (size_t)l * D * 2048, D, 2048, K.WQ() + (size_t)l * 2048 * D, scr, r, K.lane);
        }
    }
    const size_t gt = (size_t)K.bid * NTHREADS + K.tid, gs = (size_t)K.nb * NTHREADS;
    { const f32x4* s0 = (const f32x4*)ARG(ctx); const f32x4* s1 = (const f32x4*)ARG(x); f32x4* d = (f32x4*)K.X();
      const size_t n0 = (size_t)NCTX * D / 4, n1 = (size_t)NLAT * D / 4;
      for (size_t i = gt; i < n0 + n1; i += gs) d[i] = i < n0 ? s0[i] : s1[i - n0]; }
    { const float* sk = ARG(peer_sk);
      for (size_t i = gt; i < (size_t)DEPTH * 8 * 2 * 128 * 128; i += gs) { const float v = sk[i]; const bf16_t hi = f2bf(v);
          const size_t lhp = i >> 14; const int key = (int)(i >> 7) & 127, d = (int)i & 127;
          const size_t o = (((lhp * 8 + (key >> 4)) * 4 + (d >> 5)) * 64 + (key & 15) + 16 * ((d >> 3) & 3)) * 8 + (d & 7);
          K.SKH()[o] = hi; K.SKL()[o] = f2bf(v - bf2f(hi)); } }
    { const float* pu = ARG(peer_u); unsigned char* UQ = (unsigned char*)K.UB();
      for (int row0 = K.gw; row0 < DEPTH * 16384; row0 += 2 * K.ngw) {
          f32x4 v2[2][4];
#pragma unroll
          for (int t = 0; t < 2; ++t) { const int row = min(row0 + t * K.ngw, DEPTH * 16384 - 1); const f32x4* src = (const f32x4*)(pu + (size_t)row * D);
#pragma unroll
              for (int j = 0; j < 4; ++j) v2[t][j] = src[j * 64 + K.lane]; }
#pragma unroll
          for (int t = 0; t < 2; ++t) { const int row = row0 + t * K.ngw; if (row >= DEPTH * 16384) break;
              float mx = 0.f;
#pragma unroll
              for (int j = 0; j < 4; ++j) mx = fmaxf(mx, fmaxf(fmaxf(fabsf(v2[t][j].x), fabsf(v2[t][j].y)), fmaxf(fabsf(v2[t][j].z), fabsf(v2[t][j].w))));
#pragma unroll
              for (int o = 1; o < 64; o <<= 1) mx = fmaxf(mx, __shfl_xor(mx, o));
              const float sc = fmaxf(mx, 1e-30f) * (1.0f / 127.0f), inv = 1.0f / sc;
              if (K.lane == 0) K.US()[row] = sc;
#pragma unroll
              for (int j = 0; j < 4; ++j) { const int col = j * 256 + K.lane * 4; const f32x4 v = v2[t][j];
                  const unsigned q0 = (unsigned)((int)rintf(v.x * inv)) & 0xffu, q1 = (unsigned)((int)rintf(v.y * inv)) & 0xffu, q2 = (unsigned)((int)rintf(v.z * inv)) & 0xffu, q3 = (unsigned)((int)rintf(v.w * inv)) & 0xffu;
                  *(unsigned*)(UQ + (size_t)row * D + col) = q0 | (q1 << 8) | (q2 << 16) | (q3 << 24); } } } }
    { const float* pv = ARG(peer_v); unsigned char* VQ = (unsigned char*)K.VB();
      for (int row0 = K.gw; row0 < DEPTH * 16384; row0 += 2 * K.ngw) {
          f32x4 v2[2][4];
#pragma unroll
          for (int t = 0; t < 2; ++t) { const int row = min(row0 + t * K.ngw, DEPTH * 16384 - 1); const f32x4* src = (const f32x4*)(pv + (size_t)row * D);
#pragma unroll
              for (int j = 0; j < 4; ++j) v2[t][j] = src[j * 64 + K.lane]; }
#pragma unroll
          for (int t = 0; t < 2; ++t) { const int row = row0 + t * K.ngw; if (row >= DEPTH * 16384) break;
              float mx = 0.f;
#pragma unroll
              for (int j = 0; j < 4; ++j) mx = fmaxf(mx, fmaxf(fmaxf(fabsf(v2[t][j].x), fabsf(v2[t][j].y)), fmaxf(fabsf(v2[t][j].z), fabsf(v2[t][j].w))));
#pragma unroll
              for (int o = 1; o < 64; o <<= 1) mx = fmaxf(mx, __shfl_xor(mx, o));
              const float sc = fmaxf(mx, 1e-30f) * (1.0f / 127.0f), inv = 1.0f / sc;
              if (K.lane == 0) K.VS()[row] = sc;
              const int l = row >> 14, e = row & 16383;
#pragma unroll
              for (int j = 0; j < 4; ++j) { const int col = j * 256 + K.lane * 4; const f32x4 v = v2[t][j];
                  const unsigned q0 = (unsigned)((int)rintf(v.x * inv) + 128), q1 = (unsigned)((int)rintf(v.y * inv) + 128), q2 = (unsigned)((int)rintf(v.z * inv) + 128), q3 = (unsigned)((int)rintf(v.w * inv) + 128);
                  *(unsigned*)(VQ + (((size_t)l * 8 + (col >> 7)) * 16384 + e) * 128 + (col & 127)) = q0 | (q1 << 8) | (q2 << 16) | (q3 << 24); } } } }
    { float* sv = (float*)K.lds;
      float* part = sv + 3 * D;
      __syncthreads();
      for (int i = K.tid; i < 3 * D; i += NTHREADS) { const int v = i / D, k = i % D; const float c = v < 2 ? ARG(c)[v * D + k] : ARG(c_ctx)[k]; sv[i] = c * sigmoidf_(c); }
      __syncthreads();
      for (int item = K.bid; item < DEPTH * 24; item += K.nb) {
          const int l = item / 24, cb = item % 24;
          const float* w = ARG(w_mod) + (size_t)l * D * 6 * D + cb * 256 + K.lane * 4;
          f32x4 a0 = {0.f, 0.f, 0.f, 0.f}, a1 = a0, a2 = a0;
#pragma unroll 8
          for (int kk = 0; kk < 128; ++kk) { const int k = K.wave * 128 + kk; const f32x4 wv = *(const f32x4*)(w + (size_t)k * 6 * D);
              a0 += wv * sv[k]; a1 += wv * sv[D + k]; a2 += wv * sv[2 * D + k]; }
          *(f32x4*)(part + (K.wave * 3 + 0) * 256 + K.lane * 4) = a0; *(f32x4*)(part + (K.wave * 3 + 1) * 256 + K.lane * 4) = a1; *(f32x4*)(part + (K.wave * 3 + 2) * 256 + K.lane * 4) = a2;
          __syncthreads();
          for (int i = K.tid; i < 768; i += NTHREADS) { const int v = i / 256, cc = i % 256; float sum = 0.f;
#pragma unroll
              for (int w8 = 0; w8 < 8; ++w8) sum += part[(w8 * 3 + v) * 256 + cc];
              const int col = cb * 256 + cc; K.MOD()[((size_t)l * 3 + v) * 6 * D + col] = sum + ARG(b_mod)[(size_t)l * 6 * D + col]; }
          __syncthreads();
      } }
    for (size_t i = gt; i < 2 * 256; i += gs) {
        const int dir = (int)(i / 256), ch = (int)(i % 256);
        float lg[DEPTH], mx = -1e30f;
#pragma unroll
        for (int l = 0; l < DEPTH; ++l) { lg[l] = ARG(lb_logits)[((size_t)dir * DEPTH + l) * 256 + ch]; mx = fmaxf(mx, lg[l]); }
        float s = 0.f;
#pragma unroll
        for (int l = 0; l < DEPTH; ++l) { lg[l] = expf(lg[l] - mx); s += lg[l]; }
        float cum = 0.f;
#pragma unroll
        for (int l = 0; l < DEPTH; ++l) { if (l > 0) cum += lg[l] / s; K.LB()[((size_t)dir * DEPTH + l) * 256 + ch] = cum; }
    }
    for (size_t i = gt; i < (256 + 64) * 16; i += gs) {
        const int pos = (int)(i / 16), f = (int)(i % 16);
        const float inv = powf(10000.0f, -(float)f / 16.0f);
        if (pos < 256) { const float ang = (float)pos * inv; K.ROPE()[pos * 16 + f] = cosf(ang); K.ROPE()[4096 + pos * 16 + f] = sinf(ang); }
        else { const int pc = pos - 256; const float ang = (float)pc * inv; K.ROPE()[8192 + pc * 16 + f] = cosf(ang); K.ROPE()[8192 + 1024 + pc * 16 + f] = sinf(ang); }
    }
}

DI void ph_norm(Ctx& K, const float* nw, int shift_chunk) {
    const float* modl = K.MOD() + (size_t)K.l * 3 * 6 * D;
    for (int r = K.gw; r < M; r += K.ngw) {
        const f32x4* xr = (const f32x4*)(K.X() + (size_t)r * D);
        f32x4 v[4]; float ss = 0.f;
#pragma unroll
        for (int j = 0; j < 4; ++j) { v[j] = xr[j * 64 + K.lane]; ss += v[j].x * v[j].x + v[j].y * v[j].y + v[j].z * v[j].z + v[j].w * v[j].w; }
        ss = wave_sum(ss);
        const float rs = rsqrtf(ss * (1.0f / D) + EPS);
        const float* mv = modl + (size_t)modvec_of_row(r) * 6 * D;
        u32x2* ho = (u32x2*)(K.H() + (size_t)r * D);
#pragma unroll
        for (int j = 0; j < 4; ++j) {
            const int c4 = j * 64 + K.lane;
            const f32x4 w = ((const f32x4*)nw)[c4], sh = ((const f32x4*)(mv + shift_chunk * D))[c4], sc = ((const f32x4*)(mv + (shift_chunk + 1) * D))[c4];
            f32x4 y; y.x = v[j].x * rs * w.x * (1.f + sc.x) + sh.x; y.y = v[j].y * rs * w.y * (1.f + sc.y) + sh.y; y.z = v[j].z * rs * w.z * (1.f + sc.z) + sh.z; y.w = v[j].w * rs * w.w * (1.f + sc.w) + sh.w;
            u32x2 o; o.x = pk2(y.x, y.y); o.y = pk2(y.z, y.w); ho[c4] = o;
            if (shift_chunk == 3) { v[j].x = __uint_as_float(o.x << 16); v[j].y = __uint_as_float(o.x & 0xffff0000u); v[j].z = __uint_as_float(o.y << 16); v[j].w = __uint_as_float(o.y & 0xffff0000u); }
        }
        if (shift_chunk == 3) {
            float mx = 0.f;
#pragma unroll
            for (int j = 0; j < 4; ++j) mx = fmaxf(mx, fmaxf(fmaxf(fabsf(v[j].x), fabsf(v[j].y)), fmaxf(fabsf(v[j].z), fabsf(v[j].w))));
#pragma unroll
            for (int o = 1; o < 64; o <<= 1) mx = fmaxf(mx, __shfl_xor(mx, o));
            const float sc = fmaxf(mx, 1e-30f) * (1.0f / 127.0f), inv = 1.0f / sc;
            if (K.lane == 0) K.HS()[r] = sc;
#pragma unroll
            for (int j = 0; j < 4; ++j) { const unsigned q0 = (unsigned)((int)rintf(v[j].x * inv)) & 0xffu, q1 = (unsigned)((int)rintf(v[j].y * inv)) & 0xffu, q2 = (unsigned)((int)rintf(v[j].z * inv)) & 0xffu, q3 = (unsigned)((int)rintf(v[j].w * inv)) & 0xffu;
                *(unsigned*)(K.H8() + (size_t)r * D + (j * 64 + K.lane) * 4) = q0 | (q1 << 8) | (q2 << 16) | (q3 << 24); }
        }
    }
}

DI void ph_gemm_store(Ctx& K, const bf16_t* A, const bf16_t* Bt, int N, bf16_t* out, const float* rope) {
    pg8::Gemm g{A, Bt, M, N, D}; pg8::StaticOrder S; S.init(M, N, K.nb, K.bid);
    pg8::EpiStore E{out, N, (LAS unsigned char*)K.lds, rope, NCTX, L};
    pg8::gemm_phase<pg8::EpiStore, pg8::StaticOrder, true, true>((LAS unsigned char*)K.lds, g, S, E);
}
DI void ph_gemm_resid(Ctx& K, const bf16_t* A, const bf16_t* Bt, int chunk) {
    pg8::Gemm g{A, Bt, M, D, D}; pg8::StaticOrder S; S.init(M, D, K.nb, K.bid);
    pg8::EpiResid E{K.X(), D, K.MOD() + (size_t)K.l * 3 * 6 * D + (size_t)chunk * D, 6 * D, NCTX, L, (LAS unsigned char*)K.lds};
    pg8::gemm_phase<pg8::EpiResid, pg8::StaticOrder, true, true>((LAS unsigned char*)K.lds, g, S, E);
}

DI void ph_rope(Ctx& K) {
    const float* cosr = K.ROPE(); const float* sinr = K.ROPE() + 4096; const float* cosc = K.ROPE() + 8192; const float* sinc = K.ROPE() + 8192 + 1024;
    const size_t gt = (size_t)K.bid * NTHREADS + K.tid, gs = (size_t)K.nb * NTHREADS;
    for (size_t i = gt; i < (size_t)NLAT * 8 * 16; i += gs) {
        const int f = (int)(i & 15), hh = (int)((i >> 4) & 7), lr = (int)(i >> 7);
        const int t = lr % L, pr = t >> 6, pc = t & 63;
        bf16_t* p = K.P() + (size_t)(NCTX + lr) * PW + (hh < 6 ? C_SQ + hh * 64 : C_SK + (hh - 6) * 64);
        const float c1 = cosr[pr * 16 + f], s1 = sinr[pr * 16 + f], c2 = cosc[pc * 16 + f], s2 = sinc[pc * 16 + f];
        const float a = bf2f(p[f]), b = bf2f(p[16 + f]), e = bf2f(p[32 + f]), g = bf2f(p[48 + f]);
        p[f] = f2bf(a * c1 - b * s1); p[16 + f] = f2bf(b * c1 + a * s1); p[32 + f] = f2bf(e * c2 - g * s2); p[48 + f] = f2bf(g * c2 + e * s2);
    }
}

typedef short bf16x8_t __attribute__((ext_vector_type(8)));
#define MFMA16(a, b, c) __builtin_amdgcn_mfma_f32_16x16x32_bf16((a), (b), (c), 0, 0, 0)
constexpr int HG_NCH = (CL + L) / 64;
constexpr int HG_LFS = 68;
constexpr int HG_TS = 72;
constexpr int HGL_LF = 0, HGL_OM = HGL_LF + 2 * 64 * HG_LFS * 4, HGL_VT = HGL_OM + 2 * 64 * HG_LFS * 4, HGL_KT = HGL_VT + 64 * HG_TS * 2, HGL_SC = HGL_KT, HGL_OD = HGL_SC + 8 * 16 * HG_TS * 2, HGL_END = HGL_OD + 2 * 64 * HG_LFS * 4;
static_assert(HGL_KT + 2 * 64 * HG_TS * 2 <= LDS_BYTES && HGL_END <= LDS_BYTES, "hgrn LDS map");
DI int hg_block_row(int b, int tb, int tok) { return tb < 4 ? ctx_row(b, tb * 64 + tok) : lat_row(b, (tb - 4) * 64 + tok); }
DI int hg_bwd_chunk(int tb) { return tb < 4 ? 3 - tb : 4 + 255 - (tb - 4); }
DI void hg_prep(Ctx& K, int b, int h, int tb) {
    float* LF = (float*)(K.lds + HGL_LF); float* OM = (float*)(K.lds + HGL_OM); bf16_t* VT = (bf16_t*)(K.lds + HGL_VT);
    const int tok = K.tid >> 3, c = K.tid & 7;
    const bf16_t* pr = K.P() + (size_t)hg_block_row(b, tb, tok) * PW + h * 64 + 8 * c;
#pragma unroll
    for (int dir = 0; dir < 2; ++dir) {
        float z[8]; unpack8(*(const u32x4*)(pr + (dir ? C_ZB : C_ZF)), z);
        const float* lb = K.LB() + ((size_t)dir * DEPTH + K.l) * 256 + h * 64 + 8 * c;
        float lf[8], om[8];
#pragma unroll
        for (int j = 0; j < 8; ++j) { const float lbv = lb[j], sg = sigmoidf_(z[j]); const float f = fmaxf(lbv + (1.f - lbv) * sg, 1e-30f); lf[j] = __logf(f); om[j] = (1.f - lbv) * (1.f - sg); }
        float* lfp = LF + (dir * 64 + tok) * HG_LFS + 8 * c; float* omp = OM + (dir * 64 + tok) * HG_LFS + 8 * c;
        *(f32x4*)lfp = (f32x4){lf[0], lf[1], lf[2], lf[3]}; *(f32x4*)(lfp + 4) = (f32x4){lf[4], lf[5], lf[6], lf[7]};
        *(f32x4*)omp = (f32x4){om[0], om[1], om[2], om[3]}; *(f32x4*)(omp + 4) = (f32x4){om[4], om[5], om[6], om[7]};
    }
    { const u32x4 v = *(const u32x4*)(pr + C_HV);
      const unsigned w[4] = {v.x, v.y, v.z, v.w};
#pragma unroll
      for (int j = 0; j < 4; ++j) { VT[(8 * c + 2 * j) * HG_TS + tok] = (bf16_t)(w[j] & 0xffffu); VT[(8 * c + 2 * j + 1) * HG_TS + tok] = (bf16_t)(w[j] >> 16); } }
    __syncthreads();
    if (K.tid < 128) {
        const int dir = K.tid >> 6, d = K.tid & 63; float* col = LF + dir * 64 * HG_LFS + d;
        float v[64];
#pragma unroll
        for (int p = 0; p < 64; ++p) v[p] = col[(dir ? 63 - p : p) * HG_LFS];
#pragma unroll
        for (int p = 1; p < 64; ++p) v[p] += v[p - 1];
#pragma unroll
        for (int p = 0; p < 64; ++p) col[(dir ? 63 - p : p) * HG_LFS] = v[p];
    }
    __syncthreads();
}
DI void ph_hgrn_A(Ctx& K) {
    float* LF = (float*)(K.lds + HGL_LF); float* OM = (float*)(K.lds + HGL_OM); bf16_t* VT = (bf16_t*)(K.lds + HGL_VT); bf16_t* KT = (bf16_t*)(K.lds + HGL_KT);
    const int r16 = K.lane & 15, g4 = K.lane >> 4;
    for (int item = K.bid; item < NB * 4 * HG_NCH; item += K.nb) {
        const int tb = item % HG_NCH, h = (item / HG_NCH) & 3, b = item / (HG_NCH * 4);
        __syncthreads();
        hg_prep(K, b, h, tb);
        { const int tok = K.tid >> 3, c = K.tid & 7;
#pragma unroll
          for (int dir = 0; dir < 2; ++dir) {
              const float* bl = LF + (dir * 64 + (dir ? 0 : 63)) * HG_LFS + 8 * c; const float* bt = LF + (dir * 64 + tok) * HG_LFS + 8 * c; const float* om = OM + (dir * 64 + tok) * HG_LFS + 8 * c;
#pragma unroll
              for (int j = 0; j < 8; ++j) KT[(dir * 64 + 8 * c + j) * HG_TS + tok] = f2bf(om[j] * __expf(bl[j] - bt[j]));
          }
          if (K.tid < 128) { const int dir = K.tid >> 6, d = K.tid & 63; const int chain = (b * 2 + dir) * 4 + h, ch = dir ? hg_bwd_chunk(tb) : tb;
              K.AC()[((size_t)chain * HG_NCH + ch) * 64 + d] = __expf(LF[(dir * 64 + (dir ? 0 : 63)) * HG_LFS + d]); } }
        __syncthreads();
        { const int dir = K.wave >> 2, mi = K.wave & 3; const int chain = (b * 2 + dir) * 4 + h, ch = dir ? hg_bwd_chunk(tb) : tb;
          f32x4 acc[4];
#pragma unroll
          for (int nj = 0; nj < 4; ++nj) acc[nj] = (f32x4){0.f, 0.f, 0.f, 0.f};
#pragma unroll
          for (int ks = 0; ks < 2; ++ks) {
              const bf16x8_t av = *(const bf16x8_t*)(VT + (16 * mi + r16) * HG_TS + 32 * ks + 8 * g4);
#pragma unroll
              for (int nj = 0; nj < 4; ++nj) { const bf16x8_t bv = *(const bf16x8_t*)(KT + (dir * 64 + 16 * nj + r16) * HG_TS + 32 * ks + 8 * g4); acc[nj] = MFMA16(av, bv, acc[nj]); }
          }
          float* st = K.ST() + ((size_t)chain * HG_NCH + ch) * 4096;
#pragma unroll
          for (int nj = 0; nj < 4; ++nj)
#pragma unroll
              for (int rg = 0; rg < 4; ++rg) st[(16 * mi + 4 * g4 + rg) * 64 + 16 * nj + r16] = acc[nj][rg];
        }
    }
}
DI void ph_hgrn_B(Ctx& K) {
    const int gt = K.bid * NTHREADS + K.tid;
    if (gt < 16 * 4096) {
        const int chain = gt >> 12, idx = gt & 4095, d = idx & 63;
        float* st = K.ST() + (size_t)chain * HG_NCH * 4096 + idx; const float* ac = K.AC() + (size_t)chain * HG_NCH * 64 + d;
        float S = 0.f;
#pragma unroll 1
        for (int c0 = 0; c0 < HG_NCH; c0 += 26) {
            float u[26], a[26];
#pragma unroll
            for (int i = 0; i < 26; ++i) { u[i] = st[(size_t)(c0 + i) * 4096]; a[i] = ac[(c0 + i) * 64]; }
#pragma unroll
            for (int i = 0; i < 26; ++i) { st[(size_t)(c0 + i) * 4096] = S; S = a[i] * S + u[i]; }
        }
    }
}
DI void ph_hgrn_C(Ctx& K) {
    float* LF = (float*)(K.lds + HGL_LF); float* OM = (float*)(K.lds + HGL_OM); bf16_t* VT = (bf16_t*)(K.lds + HGL_VT); float* OD = (float*)(K.lds + HGL_OD);
    bf16_t* SC = (bf16_t*)(K.lds + HGL_SC) + K.wave * 16 * HG_TS;
    const int r16 = K.lane & 15, g4 = K.lane >> 4;
    for (int item = K.bid; item < NB * 4 * HG_NCH; item += K.nb) {
        const int tb = item % HG_NCH, h = (item / HG_NCH) & 3, b = item / (HG_NCH * 4);
        __syncthreads();
        hg_prep(K, b, h, tb);
        { const int dir = K.wave >> 2, mi = K.wave & 3; const int chain = (b * 2 + dir) * 4 + h, ch = dir ? hg_bwd_chunk(tb) : tb;
          const float* LFd = LF + dir * 64 * HG_LFS; const float* OMd = OM + dir * 64 * HG_LFS; const float* ref = LFd + 32 * HG_LFS;
          bf16x8_t aq1[2], aq2[2];
          { const int t = 16 * mi + r16; const bf16_t* qr = K.P() + (size_t)hg_block_row(b, tb, t) * PW + C_HQ + h * 64;
#pragma unroll
            for (int ks = 0; ks < 2; ++ks) { const int d0 = 32 * ks + 8 * g4; float q[8]; unpack8(*(const u32x4*)(qr + d0), q);
                u32x4 w1, w2; unsigned o1[4], o2[4];
#pragma unroll
                for (int j = 0; j < 4; ++j) { float x1[2], x2[2];
#pragma unroll
                    for (int e = 0; e < 2; ++e) { const int dd = d0 + 2 * j + e; const float qs = q[2 * j + e] * sigmoidf_(q[2 * j + e]); const float bt = LFd[t * HG_LFS + dd]; x1[e] = qs * __expf(bt - ref[dd]); x2[e] = qs * __expf(bt); }
                    o1[j] = pk2(x1[0], x1[1]); o2[j] = pk2(x2[0], x2[1]); }
                w1 = (u32x4){o1[0], o1[1], o1[2], o1[3]}; w2 = (u32x4){o2[0], o2[1], o2[2], o2[3]};
                aq1[ks] = __builtin_bit_cast(bf16x8_t, w1); aq2[ks] = __builtin_bit_cast(bf16x8_t, w2); } }
          f32x4 sc[4];
#pragma unroll
          for (int nj = 0; nj < 4; ++nj) { sc[nj] = (f32x4){0.f, 0.f, 0.f, 0.f}; const int s_ = 16 * nj + r16;
#pragma unroll
              for (int ks = 0; ks < 2; ++ks) { const int d0 = 32 * ks + 8 * g4; unsigned o[4];
#pragma unroll
                  for (int j = 0; j < 4; ++j) { const int dd = d0 + 2 * j; o[j] = pk2(OMd[s_ * HG_LFS + dd] * __expf(ref[dd] - LFd[s_ * HG_LFS + dd]), OMd[s_ * HG_LFS + dd + 1] * __expf(ref[dd + 1] - LFd[s_ * HG_LFS + dd + 1])); }
                  const u32x4 w = (u32x4){o[0], o[1], o[2], o[3]};
                  sc[nj] = MFMA16(aq1[ks], __builtin_bit_cast(bf16x8_t, w), sc[nj]); } }
#pragma unroll
          for (int nj = 0; nj < 4; ++nj)
#pragma unroll
              for (int rg = 0; rg < 4; ++rg) { const int tl = 4 * g4 + rg, t = 16 * mi + tl, s_ = 16 * nj + r16; const bool keep = dir ? (s_ >= t) : (s_ <= t);
                  SC[tl * HG_TS + s_] = f2bf(keep ? sc[nj][rg] : 0.f); }
          asm volatile("s_waitcnt lgkmcnt(0)" ::: "memory");
          f32x4 oacc[4];
#pragma unroll
          for (int nj = 0; nj < 4; ++nj) oacc[nj] = (f32x4){0.f, 0.f, 0.f, 0.f};
          const float* st = K.ST() + ((size_t)chain * HG_NCH + ch) * 4096;
#pragma unroll
          for (int ks = 0; ks < 2; ++ks) {
              const bf16x8_t as = *(const bf16x8_t*)(SC + r16 * HG_TS + 32 * ks + 8 * g4);
#pragma unroll
              for (int nj = 0; nj < 4; ++nj) {
                  const bf16x8_t bv = *(const bf16x8_t*)(VT + (16 * nj + r16) * HG_TS + 32 * ks + 8 * g4);
                  oacc[nj] = MFMA16(as, bv, oacc[nj]);
                  const float* sp = st + (16 * nj + r16) * 64 + 32 * ks + 8 * g4; const f32x4 s0 = *(const f32x4*)sp, s1 = *(const f32x4*)(sp + 4);
                  const u32x4 w = (u32x4){pk2(s0.x, s0.y), pk2(s0.z, s0.w), pk2(s1.x, s1.y), pk2(s1.z, s1.w)};
                  oacc[nj] = MFMA16(aq2[ks], __builtin_bit_cast(bf16x8_t, w), oacc[nj]);
              }
          }
#pragma unroll
          for (int nj = 0; nj < 4; ++nj)
#pragma unroll
              for (int rg = 0; rg < 4; ++rg) OD[(dir * 64 + 16 * mi + 4 * g4 + rg) * HG_LFS + 16 * nj + r16] = oacc[nj][rg];
        }
        __syncthreads();
        { const int tok = K.tid >> 3, c = K.tid & 7; const int row = hg_block_row(b, tb, tok);
          const float* o0 = OD + tok * HG_LFS + 8 * c; const float* o1 = OD + (64 + tok) * HG_LFS + 8 * c;
          float o[8], ss = 0.f;
#pragma unroll
          for (int j = 0; j < 8; ++j) { o[j] = o0[j] + o1[j]; ss += o[j] * o[j]; }
          ss += __shfl_xor(ss, 1); ss += __shfl_xor(ss, 2); ss += __shfl_xor(ss, 4);
          const float rs = rsqrtf(ss * (1.0f / 64.0f) + EPS);
          float gq[8]; unpack8(*(const u32x4*)(K.P() + (size_t)row * PW + C_HG + h * 64 + 8 * c), gq);
          const float* nw = ARG(hgrn_norm_w) + (size_t)K.l * 256 + h * 64 + 8 * c;
          float y[8];
#pragma unroll
          for (int j = 0; j < 8; ++j) y[j] = o[j] * rs * nw[j] * gq[j] * sigmoidf_(gq[j]);
          u32x4 w; w.x = pk2(y[0], y[1]); w.y = pk2(y[2], y[3]); w.z = pk2(y[4], y[5]); w.w = pk2(y[6], y[7]);
          *(u32x4*)(K.MIX() + (size_t)row * D + MX_H + h * 64 + 8 * c) = w; }
    }
}

constexpr int AT_TS = 72;
constexpr int ATL_K = 0, ATL_V = ATL_K + 64 * AT_TS * 2, ATL_P = ATL_V + 64 * AT_TS * 2, ATL_END = ATL_P + 8 * 48 * AT_TS * 2;
static_assert(ATL_END <= LDS_BYTES - 256, "attention LDS map");
DI float dpp_max16(float x) { x = fmaxf(x, dpp_<0xB1>(x)); x = fmaxf(x, dpp_<0x4E>(x)); x = fmaxf(x, dpp_<0x141>(x)); x = fmaxf(x, dpp_<0x128>(x)); return x; }
DI float dpp_sum16(float x) { x += dpp_<0xB1>(x); x += dpp_<0x4E>(x); x += dpp_<0x141>(x); x += dpp_<0x128>(x); return x; }
template <int KIND> DI void attn_item(Ctx& K, int idx, const float* sinkp, const float* rpbp) {
    constexpr int MT = KIND == 0 ? 3 : 2;
    int tid_ = K.tid; asm volatile("" : "+v"(tid_));
    const int lane_ = tid_ & 63, wave_ = tid_ >> 6;
    bf16_t* KT = (bf16_t*)(K.lds + ATL_K); bf16_t* VT = (bf16_t*)(K.lds + ATL_V); bf16_t* PS = (bf16_t*)(K.lds + ATL_P) + wave_ * 48 * AT_TS;
    const int r16 = lane_ & 15, g4 = lane_ >> 4;
    int b, hk, qb = 0;
    if (KIND == 0) { qb = idx & 127; hk = (idx >> 7) & 1; b = idx >> 8; }
    else if (KIND == 1) { qb = idx & 63; hk = (idx >> 6) % 6; b = (idx >> 6) / 6; }
    else { hk = idx % 6; b = idx / 6; }
    const int kcol = (KIND == 0) ? C_SK + hk * 64 : (KIND == 2) ? C_SK + (hk / 3) * 64 : C_NK + hk * 64;
    const int vcol = (KIND == 0) ? C_SV + hk * 64 : (KIND == 2) ? C_SV + (hk / 3) * 64 : C_NV + hk * 64;
    int t0 = 0, nloc = 0;
    if (KIND == 0) { const int k0 = max(2 * qb - 2, 0), k1 = min(2 * qb + 3, L / 64 - 1); t0 = k0; nloc = k1 - k0 + 1; }
    if (KIND == 1) { const int k0 = min(max(4 * qb - 4, 0), L / 64 - 8), k1 = min(max(4 * qb + 3 - 4, 0), L / 64 - 8) + 7; t0 = k0; nloc = k1 - k0 + 1; }
    const int ntiles = nloc + CL / 64;
    int w_r = 0, w_rs = 0;
    if (KIND == 1) { w_r = 4 * qb + (wave_ >> 1); w_rs = min(max(w_r - 4, 0), L / 64 - 8); }
    bf16x8_t qf[MT][2]; int qbase[MT], hq_mt[MT];
#pragma unroll
    for (int mt = 0; mt < MT; ++mt) {
        int arow, hq;
        if (KIND == 0) { const int rho = wave_ * 48 + mt * 16; hq = hk * 3 + rho / 128; hq_mt[mt] = hq; const int tb = 128 * qb + (rho & 127); arow = lat_row(b, tb + r16); qbase[mt] = tb; }
        else if (KIND == 1) { hq = hk; hq_mt[mt] = hq; const int cb = 32 * (wave_ & 1) + 16 * mt; arow = lat_row(b, w_r * 64 + cb + r16); qbase[mt] = cb; }
        else { hq = hk; hq_mt[mt] = hq; const int tb = wave_ * 32 + mt * 16; arow = ctx_row(b, tb + r16); qbase[mt] = 0; }
        const int qcol = (KIND == 0 || KIND == 2) ? C_SQ + hq * 64 : C_NQ + hq * 64;
#pragma unroll
        for (int ks = 0; ks < 2; ++ks) { float q[8]; unpack8(*(const u32x4*)(K.P() + (size_t)arow * PW + qcol + 32 * ks + 8 * g4), q);
            const u32x4 w = (u32x4){pk2(q[0] * 0.125f, q[1] * 0.125f), pk2(q[2] * 0.125f, q[3] * 0.125f), pk2(q[4] * 0.125f, q[5] * 0.125f), pk2(q[6] * 0.125f, q[7] * 0.125f)};
            qf[mt][ks] = __builtin_bit_cast(bf16x8_t, w); }
    }
    f32x4 oacc[MT][4]; float mrun[MT][4], lrun[MT][4];
#pragma unroll
    for (int mt = 0; mt < MT; ++mt) {
#pragma unroll
        for (int ne = 0; ne < 4; ++ne) oacc[mt][ne] = (f32x4){0.f, 0.f, 0.f, 0.f};
        const bool has_sink = (KIND == 0 || KIND == 2); const float sk = has_sink ? sinkp[hq_mt[mt]] : -1.0e30f;
#pragma unroll
        for (int rg = 0; rg < 4; ++rg) { mrun[mt][rg] = sk; lrun[mt][rg] = has_sink ? 1.0f : 0.0f; }
    }
    const int lkey = tid_ >> 3, lch = tid_ & 7;
    u32x4 pk_, pv_;
    { const int ti = 0; const int grow = (ti < nloc) ? lat_row(b, (t0 + ti) * 64 + lkey) : ctx_row(b, (ti - nloc) * 64 + lkey);
      const bf16_t* pr = K.P() + (size_t)grow * PW + 8 * lch; pk_ = *(const u32x4*)(pr + kcol); pv_ = *(const u32x4*)(pr + vcol); }
#pragma unroll 1
    for (int ti = 0; ti < ntiles; ++ti) {
        __syncthreads();
        *(u32x4*)(KT + lkey * AT_TS + 8 * lch) = pk_;
        { const unsigned w[4] = {pv_.x, pv_.y, pv_.z, pv_.w};
#pragma unroll
          for (int j = 0; j < 4; ++j) { VT[(8 * lch + 2 * j) * AT_TS + lkey] = (bf16_t)(w[j] & 0xffffu); VT[(8 * lch + 2 * j + 1) * AT_TS + lkey] = (bf16_t)(w[j] >> 16); } }
        __syncthreads();
        if (ti + 1 < ntiles) { const int tn = ti + 1; const int grow = (tn < nloc) ? lat_row(b, (t0 + tn) * 64 + lkey) : ctx_row(b, (tn - nloc) * 64 + lkey);
            const bf16_t* pr = K.P() + (size_t)grow * PW + 8 * lch; pk_ = *(const u32x4*)(pr + kcol); pv_ = *(const u32x4*)(pr + vcol); }
        const bool local = ti < nloc; const int kunit = t0 + ti;
        bool active = true;
        if (KIND == 0 && local) active = true;
        if (KIND == 1 && local) active = (kunit >= w_rs) && (kunit < w_rs + 8);
        if (active) {
            f32x4 sc[MT][4];
#pragma unroll
            for (int mt = 0; mt < MT; ++mt)
#pragma unroll
                for (int nj = 0; nj < 4; ++nj) sc[mt][nj] = (f32x4){0.f, 0.f, 0.f, 0.f};
#pragma unroll
            for (int nj = 0; nj < 4; ++nj)
#pragma unroll
                for (int ks = 0; ks < 2; ++ks) { const bf16x8_t kf = *(const bf16x8_t*)(KT + (16 * nj + r16) * AT_TS + 32 * ks + 8 * g4);
#pragma unroll
                    for (int mt = 0; mt < MT; ++mt) sc[mt][nj] = MFMA16(qf[mt][ks], kf, sc[mt][nj]); }
            if (local) {
#pragma unroll
                for (int mt = 0; mt < MT; ++mt)
#pragma unroll
                    for (int nj = 0; nj < 4; ++nj)
#pragma unroll
                        for (int rg = 0; rg < 4; ++rg) { const int key = 16 * nj + r16;
                            if (KIND == 0) { const int dl = qbase[mt] + 4 * g4 + rg - (kunit * 64 + key); if (dl > 128 || dl < -128) sc[mt][nj][rg] = -INFINITY; }
                            if (KIND == 1) { const int c = qbase[mt] + 4 * g4 + rg, ws = min(max(c - 8, 0), 48);
                                if (key >= ws && key < ws + 16) sc[mt][nj][rg] += rpbp[(kunit - w_r + 7) * 31 + (key - c + 15)]; else sc[mt][nj][rg] = -INFINITY; } }
            }
#pragma unroll
            for (int mt = 0; mt < MT; ++mt)
#pragma unroll
                for (int rg = 0; rg < 4; ++rg) {
                    float mx = fmaxf(fmaxf(sc[mt][0][rg], sc[mt][1][rg]), fmaxf(sc[mt][2][rg], sc[mt][3][rg]));
                    mx = dpp_max16(mx);
                    const float mn = fmaxf(mrun[mt][rg], mx), alpha = __expf(mrun[mt][rg] - mn); mrun[mt][rg] = mn;
                    float rs_ = 0.f;
#pragma unroll
                    for (int nj = 0; nj < 4; ++nj) { const float pe = __expf(sc[mt][nj][rg] - mn); sc[mt][nj][rg] = pe; rs_ += pe; }
                    rs_ = dpp_sum16(rs_);
                    lrun[mt][rg] = lrun[mt][rg] * alpha + rs_;
#pragma unroll
                    for (int ne = 0; ne < 4; ++ne) oacc[mt][ne][rg] *= alpha;
                }
#pragma unroll
            for (int mt = 0; mt < MT; ++mt)
#pragma unroll
                for (int nj = 0; nj < 4; ++nj)
#pragma unroll
                    for (int rg = 0; rg < 4; ++rg) PS[(16 * mt + 4 * g4 + rg) * AT_TS + 16 * nj + r16] = f2bf(sc[mt][nj][rg]);
            asm volatile("s_waitcnt lgkmcnt(0)" ::: "memory");
#pragma unroll
            for (int ks = 0; ks < 2; ++ks) {
                bf16x8_t pf[MT];
#pragma unroll
                for (int mt = 0; mt < MT; ++mt) pf[mt] = *(const bf16x8_t*)(PS + (16 * mt + r16) * AT_TS + 32 * ks + 8 * g4);
#pragma unroll
                for (int ne = 0; ne < 4; ++ne) { const bf16x8_t vf = *(const bf16x8_t*)(VT + (16 * ne + r16) * AT_TS + 32 * ks + 8 * g4);
#pragma unroll
                    for (int mt = 0; mt < MT; ++mt) oacc[mt][ne] = MFMA16(pf[mt], vf, oacc[mt][ne]); }
            }
            asm volatile("s_waitcnt lgkmcnt(0)" ::: "memory");
        }
    }
#pragma unroll
    for (int mt = 0; mt < MT; ++mt)
#pragma unroll
        for (int rg = 0; rg < 4; ++rg) { const float inv = 1.0f / lrun[mt][rg];
#pragma unroll
            for (int ne = 0; ne < 4; ++ne) PS[(16 * mt + 4 * g4 + rg) * AT_TS + 16 * ne + r16] = f2bf(oacc[mt][ne][rg] * inv); }
    asm volatile("s_waitcnt lgkmcnt(0)" ::: "memory");
#pragma unroll
    for (int mt = 0; mt < MT; ++mt) {
        const int ocol = ((KIND == 0 || KIND == 2) ? MX_S : MX_N) + hq_mt[mt] * 64;
#pragma unroll
        for (int i = 0; i < 2; ++i) { const int rr = (lane_ >> 3) + 8 * i, ch = lane_ & 7;
            const u32x4 v = *(const u32x4*)(PS + (16 * mt + rr) * AT_TS + 8 * ch);
            int grow;
            if (KIND == 0) { const int rho = wave_ * 48 + mt * 16; grow = lat_row(b, 128 * qb + (rho & 127) + rr); }
            else if (KIND == 1) grow = lat_row(b, w_r * 64 + 32 * (wave_ & 1) + 16 * mt + rr);
            else grow = ctx_row(b, wave_ * 32 + mt * 16 + rr);
            *(u32x4*)(K.MIX() + (size_t)grow * D + ocol + 8 * ch) = v; }
    }
    asm volatile("s_waitcnt lgkmcnt(0)" ::: "memory");
}
DI void ph_attn(Ctx& K) {
    constexpr int N_SWA = NB * 2 * (L / 128), N_NAT = NB * 6 * (L / 256), N_C = NB * 6;
    const float* sinkp = ARG(swa_sink) + K.l * 6;
    for (int item = K.bid; item < N_SWA + N_NAT + 2 * N_C; item += K.nb) {
        if (item < N_SWA) attn_item<0>(K, item, sinkp, nullptr);
        else if (item < N_SWA + N_NAT) { const int it = item - N_SWA; const int h = (it >> 6) % 6; attn_item<1>(K, it, nullptr, ARG(nat_rpb) + ((size_t)K.l * 6 + h) * 15 * 31); }
        else if (item < N_SWA + N_NAT + N_C) attn_item<2>(K, item - N_SWA - N_NAT, sinkp, nullptr);
        else attn_item<3>(K, item - N_SWA - N_NAT - N_C, nullptr, nullptr);
    }
}

DI unsigned fkey(float f) { const unsigned u = __float_as_uint(f); return (u & 0x80000000u) ? ~u : (u | 0x80000000u); }
DI int mbcnt64(unsigned long long m) { return (int)__builtin_amdgcn_mbcnt_hi((unsigned)(m >> 32), __builtin_amdgcn_mbcnt_lo((unsigned)m, 0u)); }
template <int NV> DI unsigned radix_thr16(const unsigned (&k)[NV]) {
    unsigned prefix = 0u;
#pragma unroll 1
    for (int bit = 31; bit >= 0; --bit) {
        const unsigned cand = prefix | (1u << bit); int cnt = 0;
#pragma unroll
        for (int i = 0; i < NV; ++i) cnt += __popcll(__ballot(k[i] >= cand));
        if (cnt >= 16) { prefix = cand; if (cnt == 16) break; }
    }
    return prefix;
}
template <int NC, int NV> DI void radix_thr16_multi(const unsigned (&k)[NC][NV], unsigned (&T)[NC]) {
    bool exact[NC];
#pragma unroll
    for (int c = 0; c < NC; ++c) { T[c] = 0u; exact[c] = false; }
#pragma unroll 1
    for (int bit = 31; bit >= 0; --bit) {
        bool all = true;
#pragma unroll
        for (int c = 0; c < NC; ++c) {
            const unsigned cand = T[c] | (1u << bit); int cnt = 0;
#pragma unroll
            for (int i = 0; i < NV; ++i) cnt += __popcll(__ballot(k[c][i] >= cand));
            if (cnt >= 16) { T[c] = cand; exact[c] = (cnt == 16); }
            all = all && exact[c];
        }
        if (all) break;
    }
}
template <int NV> DI void select16(const unsigned (&k)[NV], unsigned T, bool (&sel)[NV], int (&pos)[NV]) {
    int ngt = 0; unsigned long long gtm[NV], eqm[NV];
#pragma unroll
    for (int i = 0; i < NV; ++i) { gtm[i] = __ballot(k[i] > T); eqm[i] = __ballot(k[i] == T); ngt += __popcll(gtm[i]); }
    const int need = 16 - ngt; int eqbase = 0, selbase = 0;
#pragma unroll
    for (int i = 0; i < NV; ++i) {
        const bool iseq = k[i] == T; const int erank = eqbase + mbcnt64(eqm[i]); eqbase += __popcll(eqm[i]);
        sel[i] = (k[i] > T) || (iseq && erank < need);
        const unsigned long long sm = __ballot(sel[i]); pos[i] = selbase + mbcnt64(sm); selbase += __popcll(sm);
    }
}
template <int CTRL> DI int dppi_(int x) { return __builtin_amdgcn_mov_dpp(x, CTRL, 0xf, 0xf, true); }
DI int row_sum_i(int x) { x += dppi_<0xB1>(x); x += dppi_<0x4E>(x); x += dppi_<0x141>(x); x += dppi_<0x128>(x); return x; }
DI int row_excl_scan_i(int x) { int s_ = x; s_ += dppi_<0x111>(s_); s_ += dppi_<0x112>(s_); s_ += dppi_<0x114>(s_); s_ += dppi_<0x118>(s_); return s_ - x; }
DI unsigned row_minmax_u(unsigned x, bool want_max) {
    unsigned y;
    y = (unsigned)dppi_<0xB1>((int)x); x = want_max ? max(x, y) : min(x, y); y = (unsigned)dppi_<0x4E>((int)x); x = want_max ? max(x, y) : min(x, y);
    y = (unsigned)dppi_<0x141>((int)x); x = want_max ? max(x, y) : min(x, y); y = (unsigned)dppi_<0x128>((int)x); x = want_max ? max(x, y) : min(x, y);
    return x;
}
template <int NK> DI unsigned row_radix_thr16(const unsigned (&k)[NK]) {
    unsigned lm = k[0];
#pragma unroll
    for (int i = 1; i < NK; ++i) lm = max(lm, k[i]);
    unsigned lo = row_minmax_u(lm, false), hi = row_minmax_u(lm, true) + 1u;
    bool done = false;
#pragma unroll 1
    for (int itn = 0; itn < 40; ++itn) {
        const unsigned span = hi - lo; done = done || (span <= 1u);
        const unsigned mid = lo + (span >> 1); int cnt = 0;
#pragma unroll
        for (int i = 0; i < NK; ++i) cnt += (k[i] >= mid) ? 1 : 0;
        cnt = row_sum_i(cnt);
        const bool ge = cnt >= 16;
        if (!done) { if (ge) lo = mid; else hi = mid; }
        done = done || (cnt == 16);
        if (__ballot(!done) == 0ull) break;
    }
    return lo;
}
template <int NK> DI void row_select16(const unsigned (&k)[NK], unsigned T, bool (&sel)[NK], int (&pos)[NK]) {
    int g = 0, q = 0;
#pragma unroll
    for (int i = 0; i < NK; ++i) { g += (k[i] > T) ? 1 : 0; q += (k[i] == T) ? 1 : 0; }
    const int need = 16 - row_sum_i(g);
    const int a = min(max(need - row_excl_scan_i(q), 0), q);
    int nxt = row_excl_scan_i(g + a), eqs = 0;
#pragma unroll
    for (int i = 0; i < NK; ++i) { const bool iseq = k[i] == T; sel[i] = (k[i] > T) || (iseq && eqs < a); eqs += iseq ? 1 : 0; pos[i] = nxt; nxt += sel[i] ? 1 : 0; }
}
constexpr int PS_SCS = 132;
constexpr int PSL_TOP = 8 * 2 * 16 * PS_SCS * 4;
static_assert(PSL_TOP + 8 * 1024 <= LDS_BYTES - 256, "peer select LDS map");
template <int PROBE> DI void ph_peer_select(Ctx& K) {
    float* SCR = (float*)K.lds + K.wave * 2 * 16 * PS_SCS; float* TOPV = (float*)(K.lds + PSL_TOP + K.wave * 1024); int* TOPI = (int*)(TOPV + 128);
    const int r16 = K.lane & 15, g4 = K.lane >> 4, h = K.wave;
    constexpr int N_IT = M / 16, N_FULL = (N_IT / 256) * 256, N_WORK = N_FULL + 4 * (N_IT - N_FULL);
    for (int wk = K.bid; wk < N_WORK; wk += K.nb) {
        const bool part = wk >= N_FULL; const int item = part ? N_FULL + ((wk - N_FULL) >> 2) : wk; const int tk_lo = part ? 4 * ((wk - N_FULL) & 3) : 0, tk_hi = part ? tk_lo + 4 : 16;
        const int t0 = item * 16;
#pragma unroll 1
        for (int p = 0; p < 2; ++p) {
            bf16x8_t aq[4];
            { const bf16_t* qp = K.QP() + (size_t)(t0 + r16) * 2048 + h * 256 + p * 128 + 8 * g4;
#pragma unroll
              for (int ks = 0; ks < 4; ++ks) aq[ks] = *(const bf16x8_t*)(qp + 32 * ks); }
            const size_t kb = (((size_t)K.l * 8 + h) * 2 + p) * 128 * 128 + (size_t)K.lane * 8;
#pragma unroll 2
            for (int nt = 0; nt < 8; ++nt) {
                bf16x8_t bh[4], bl[4];
#pragma unroll
                for (int ks = 0; ks < 4; ++ks) { bh[ks] = *(const bf16x8_t*)(K.SKH() + kb + (size_t)(nt * 4 + ks) * 512); bl[ks] = *(const bf16x8_t*)(K.SKL() + kb + (size_t)(nt * 4 + ks) * 512); }
                f32x4 c0 = {0.f, 0.f, 0.f, 0.f}, c1 = c0;
#pragma unroll
                for (int ks = 0; ks < 4; ++ks) { c0 = MFMA16(aq[ks], bh[ks], c0); c1 = MFMA16(aq[ks], bl[ks], c1); }
#pragma unroll
                for (int rg = 0; rg < 4; ++rg) SCR[(p * 16 + 4 * g4 + rg) * PS_SCS + 16 * nt + r16] = c0[rg] + c1[rg];
            }
        }
        asm volatile("s_waitcnt lgkmcnt(0)" ::: "memory");
        if (PROBE == 1) continue;
        const int rho = K.lane >> 4, j16 = K.lane & 15;
#pragma unroll 1
        for (int tk = tk_lo; tk < tk_hi; tk += 4) {
#pragma unroll 1
            for (int ps = 0; ps < 2; ++ps) {
                const int p = rho & 1, rr = 2 * ps + (rho >> 1);
                float v[8]; unsigned kk[8];
#pragma unroll
                for (int i = 0; i < 8; ++i) { v[i] = SCR[(p * 16 + tk + rr) * PS_SCS + j16 + 16 * i]; kk[i] = fkey(v[i]); }
                const unsigned T = row_radix_thr16<8>(kk);
                bool sel[8]; int pos[8]; row_select16<8>(kk, T, sel, pos);
#pragma unroll
                for (int i = 0; i < 8; ++i) if (sel[i]) { TOPV[(rr * 2 + p) * 16 + pos[i]] = v[i]; TOPI[(rr * 2 + p) * 16 + pos[i]] = j16 + 16 * i; }
            }
            asm volatile("s_waitcnt lgkmcnt(0)" ::: "memory");
            { const int r = t0 + tk + rho;
              const float vb = TOPV[(rho * 2 + 1) * 16 + j16]; const int ib = TOPI[(rho * 2 + 1) * 16 + j16];
              float cv[16]; unsigned ck[16];
#pragma unroll
              for (int i = 0; i < 16; ++i) { cv[i] = TOPV[(rho * 2) * 16 + i] + vb; ck[i] = fkey(cv[i]); }
              const unsigned T = row_radix_thr16<16>(ck);
              bool sel[16]; int pos[16]; row_select16<16>(ck, T, sel, pos);
              float mx = -3.0e38f;
#pragma unroll
              for (int i = 0; i < 16; ++i) mx = fmaxf(mx, sel[i] ? cv[i] : -3.0e38f);
              mx = dpp_max16(mx);
              float es = 0.f;
#pragma unroll
              for (int i = 0; i < 16; ++i) { cv[i] = sel[i] ? __expf(cv[i] - mx) : 0.f; es += cv[i]; }
              es = dpp_sum16(es);
              const float inv = 1.0f / es;
#pragma unroll
              for (int i = 0; i < 16; ++i) if (sel[i]) { K.PIDX()[(size_t)r * 128 + h * 16 + pos[i]] = TOPI[(rho * 2) * 16 + i] * 128 + ib; K.PG()[(size_t)r * 128 + h * 16 + pos[i]] = cv[i] * inv; }
            }
            asm volatile("s_waitcnt lgkmcnt(0)" ::: "memory");
        }
    }
}

constexpr int PUL_H = 0, PUL_SLOT = 4096, PUL_STRIDE = 4352;
struct PuMeta { float hs[2]; int ia[2], ib[2]; };
DI void pu_load(const Ctx& K, int r0, int step, PuMeta& m, unsigned char* hbuf) {
#pragma unroll
    for (int q = 0; q < 2; ++q) { const int r = r0 + q * step;
        if (r < M) { __builtin_amdgcn_global_load_lds((const unsigned*)(K.H8() + (size_t)r * D + K.lane * 16), (LAS unsigned*)(hbuf + q * 1024), 16, 0, 0);
            m.hs[q] = K.HS()[r]; m.ia[q] = K.PIDX()[(size_t)r * 128 + K.lane]; m.ib[q] = K.PIDX()[(size_t)r * 128 + 64 + K.lane]; }
        else { m.hs[q] = 0.f; m.ia[q] = -1; m.ib[q] = -1; } }
}
typedef int i32x4 __attribute__((ext_vector_type(4)));
DI int sel4i(const i32x4 v, int k) { return k == 0 ? v[0] : k == 1 ? v[1] : k == 2 ? v[2] : v[3]; }
template <int PROBE> DI void pu_item(const Ctx& K, const unsigned char* U, unsigned char* HL, int* SLOT, int R, int r0, int step, const PuMeta& m, int r16, int g4, float& dummy) {
    const float hs[2] = {m.hs[0], m.hs[1]};
    bool sa[2], sb[2]; int ra[2], rb[2]; int n = 0;
#pragma unroll
    for (int q = 0; q < 2; ++q) { sa[q] = (m.ia[q] >> 11) == R; sb[q] = (m.ib[q] >> 11) == R; const unsigned long long ma = __ballot(sa[q]), mb = __ballot(sb[q]);
        ra[q] = n + mbcnt64(ma); n += __popcll(ma); rb[q] = n + mbcnt64(mb); n += __popcll(mb); }
    const int E = r16 >> 2, qq = r16 & 3, rho = r16 >> 3;
#pragma unroll 1
    for (int base = 0; base < n; base += 32) {
#pragma unroll
        for (int q = 0; q < 2; ++q) {
            if (sa[q] && ra[q] >= base && ra[q] < base + 32) { SLOT[2 * (ra[q] - base)] = m.ia[q]; SLOT[2 * (ra[q] - base) + 1] = q * 128 + K.lane; }
            if (sb[q] && rb[q] >= base && rb[q] < base + 32) { SLOT[2 * (rb[q] - base)] = m.ib[q]; SLOT[2 * (rb[q] - base) + 1] = q * 128 + 64 + K.lane; } }
        asm volatile("s_waitcnt lgkmcnt(0)" ::: "memory");
        const bool two = base + 16 < n;
        i32x4 av[8][4];
#pragma unroll
        for (int t = 0; t < 4; ++t) { const int sl = 4 * t + E; const int e = (base + sl < n) ? SLOT[2 * sl] : SLOT[0]; const unsigned char* up = U + (size_t)e * D + 64 * g4 + 16 * qq;
#pragma unroll
            for (int s_ = 0; s_ < 4; ++s_) av[t][s_] = *(const i32x4*)(up + 256 * s_); }
        if (two) {
#pragma unroll
            for (int t = 4; t < 8; ++t) { const int sl = 4 * t + E; const int e = (base + sl < n) ? SLOT[2 * sl] : SLOT[0]; const unsigned char* up = U + (size_t)e * D + 64 * g4 + 16 * qq;
#pragma unroll
                for (int s_ = 0; s_ < 4; ++s_) av[t][s_] = *(const i32x4*)(up + 256 * s_); } }
        bool fin[2]; int fcode[2]; float fus[2], fvs[2];
#pragma unroll
        for (int p2 = 0; p2 < 2; ++p2) { const int sl = 4 * (4 * p2 + qq) + g4; fin[p2] = false; fcode[p2] = 0; fus[p2] = 0.f; fvs[p2] = 0.f;
            if ((r16 & 7) < 4 && base + sl < n) { const int code = SLOT[2 * sl + 1];
                if ((code >> 7) == rho) { const size_t eo = (size_t)K.l * 16384 + SLOT[2 * sl]; fin[p2] = true; fcode[p2] = code; fus[p2] = K.US()[eo]; fvs[p2] = K.VS()[eo]; } } }
        i32x4 hb[4];
#pragma unroll
        for (int s_ = 0; s_ < 4; ++s_) hb[s_] = *(const i32x4*)(HL + rho * 1024 + 64 * g4 + 16 * qq + 256 * s_);
        int w0, w1 = 0;
        { int rs[4];
#pragma unroll
          for (int t = 0; t < 4; ++t) { i32x4 acc = {0, 0, 0, 0};
#pragma unroll
              for (int s_ = 0; s_ < 4; ++s_) acc = __builtin_amdgcn_mfma_i32_16x16x64_i8(av[t][s_], hb[s_], acc, 0, 0, 0);
              int v = sel4i(acc, qq); v += dppi_<0xB1>(v); v += dppi_<0x4E>(v); rs[t] = v; }
          w0 = qq == 0 ? rs[0] : qq == 1 ? rs[1] : qq == 2 ? rs[2] : rs[3]; }
        if (two) { int rs[4];
#pragma unroll
            for (int t = 0; t < 4; ++t) { i32x4 acc = {0, 0, 0, 0};
#pragma unroll
                for (int s_ = 0; s_ < 4; ++s_) acc = __builtin_amdgcn_mfma_i32_16x16x64_i8(av[4 + t][s_], hb[s_], acc, 0, 0, 0);
                int v = sel4i(acc, qq); v += dppi_<0xB1>(v); v += dppi_<0x4E>(v); rs[t] = v; }
            w1 = qq == 0 ? rs[0] : qq == 1 ? rs[1] : qq == 2 ? rs[2] : rs[3]; }
#pragma unroll
        for (int p2 = 0; p2 < 2; ++p2) {
            const int di = p2 ? w1 : w0;
            if (fin[p2]) { const int code = fcode[p2];
                const float d = (float)di * fus[p2] * ((code >> 7) ? hs[1] : hs[0]);
                if (PROBE >= 2) dummy += gelu_erf(d);
                else (PROBE ? K.ST() : K.PA())[(size_t)(r0 + (code >> 7) * step) * 128 + (code & 127)] = gelu_erf(d) * fvs[p2]; }
        }
        asm volatile("s_waitcnt lgkmcnt(0)" ::: "memory");
    }
}
template <int PROBE> DI void ph_peer_u(Ctx& K) {
    const unsigned char* U = (const unsigned char*)K.UB() + (size_t)K.l * 16384 * D;
    unsigned char* HB = K.lds + K.wave * PUL_STRIDE; int* SLOT = (int*)(HB + PUL_SLOT);
    const int r16 = K.lane & 15, g4 = K.lane >> 4;
    const int step = K.nloc * NWAVES;
    float dummy = 0.f;
    for (int R = K.xg; R < 8; R += K.nxg) {
        int r = K.jx * NWAVES + K.wave; int par = 0;
        PuMeta cur, nxt;
        pu_load(K, r, step, cur, HB);
#pragma unroll 1
        for (; r < M; r += 2 * step) {
            asm volatile("s_waitcnt vmcnt(0)" ::: "memory");
            pu_load(K, r + 2 * step, step, nxt, HB + (par ^ 1) * 2048);
            pu_item<PROBE>(K, U, HB + par * 2048, SLOT, R, r, step, cur, r16, g4, dummy);
            cur = nxt; par ^= 1;
        }
    }
    if (PROBE >= 2) K.ST()[K.gw * 64 + K.lane] = dummy;
}
struct PvMeta { int ia, ib; float ga, gb, pa, pb; };
template <int PROBE> DI void pv_load(const Ctx& K, int r, PvMeta& m) {
    m.ia = K.PIDX()[(size_t)r * 128 + K.lane]; m.ib = K.PIDX()[(size_t)r * 128 + 64 + K.lane];
    m.ga = K.PG()[(size_t)r * 128 + K.lane]; m.pa = K.PA()[(size_t)r * 128 + K.lane]; m.gb = K.PG()[(size_t)r * 128 + 64 + K.lane]; m.pb = K.PA()[(size_t)r * 128 + 64 + K.lane];
}
template <int HALF, int PROBE> DI void pv_issue(const unsigned char* V, int slot, const PvMeta& m, u32x4 (&vv)[8], float (&ww)[8]) {
    const float w = HALF ? m.gb * m.pb : m.ga * m.pa; const int ix = HALF ? m.ib : m.ia;
#pragma unroll
    for (int i = 0; i < 8; ++i) {
        const int src = ((8 * i + slot) << 2);
        const int e = __builtin_amdgcn_ds_bpermute(src, ix);
        ww[i] = __uint_as_float((unsigned)__builtin_amdgcn_ds_bpermute(src, (int)__float_as_uint(w)));
        vv[i] = PROBE == 2 ? (u32x4){(unsigned)e, 1u, 2u, 3u} : *(const u32x4*)(V + (size_t)e * 128);
    }
}
typedef float f32x2_ __attribute__((ext_vector_type(2)));
DI void pv_accum(const u32x4 (&vv)[8], const float (&ww)[8], f32x2_ (&y)[8], float& sw) {
#pragma unroll
    for (int i = 0; i < 8; ++i) { sw += ww[i]; const unsigned w4[4] = {vv[i].x, vv[i].y, vv[i].z, vv[i].w}; const f32x2_ w2 = {ww[i], ww[i]};
#pragma unroll
        for (int q = 0; q < 4; ++q) { const f32x2_ lo = {(float)(w4[q] & 0xffu), (float)((w4[q] >> 8) & 0xffu)}, hi = {(float)((w4[q] >> 16) & 0xffu), (float)(w4[q] >> 24)};
            y[2 * q] = __builtin_elementwise_fma(w2, lo, y[2 * q]); y[2 * q + 1] = __builtin_elementwise_fma(w2, hi, y[2 * q + 1]); } }
}
template <int PROBE> DI void ph_peer_v(Ctx& K) {
    const int slot = K.lane >> 3, c = K.lane & 7;
    const float* gate = K.MOD() + (size_t)K.l * 3 * 6 * D + 5 * D;
    const int step = K.nloc * NWAVES;
    float* Xb = PROBE ? (float*)K.P() : K.X();
    for (int S = K.xg; S < 8; S += K.nxg) {
        const unsigned char* V = (const unsigned char*)K.VB() + ((size_t)K.l * 8 + S) * 16384 * 128 + c * 16;
        const int c0 = S * 128 + c * 16;
        const int r0 = K.jx * NWAVES + K.wave;
        const int nit = r0 < M ? (M - 1 - r0) / step + 1 : 0;
        PvMeta mA, mB; pv_load<PROBE>(K, min(r0, M - 1), mA); pv_load<PROBE>(K, min(r0 + step, M - 1), mB);
        f32x4 xq[4], xprev[4], x2[4], gp[4]; float yp[16]; int rp = -1, mvp = -1; PvMeta m2;
#pragma unroll
        for (int q = 0; q < 4; ++q) { xq[q] = *(const f32x4*)(Xb + (size_t)min(r0, M - 1) * D + c0 + 4 * q); xprev[q] = (f32x4){0.f, 0.f, 0.f, 0.f}; gp[q] = xprev[q]; }
#pragma unroll
        for (int q = 0; q < 16; ++q) yp[q] = 0.f;
#define PV_BODY(XPREV, XQ, XNEW, MA, MC, IT) do { \
            const int r = r0 + (IT) * step; \
            if (rp >= 0) { const int mv = modvec_of_row(rp); \
                if (mv != mvp) { mvp = mv; \
                    _Pragma("unroll") for (int q = 0; q < 4; ++q) gp[q] = *(const f32x4*)(gate + (size_t)mv * 6 * D + c0 + 4 * q); } } \
            { const float zdep = MA.ga * 0.0f; \
                _Pragma("unroll") for (int q = 0; q < 4; ++q) { XPREV[q].x += gp[q].x * yp[4 * q] + zdep; XPREV[q].y += gp[q].y * yp[4 * q + 1] + zdep; XPREV[q].z += gp[q].z * yp[4 * q + 2] + zdep; XPREV[q].w += gp[q].w * yp[4 * q + 3] + zdep; } \
                if (rp >= 0 && slot == 0) { float* xr = Xb + (size_t)rp * D + c0; \
                    _Pragma("unroll") for (int q = 0; q < 4; ++q) *(f32x4*)(xr + 4 * q) = XPREV[q]; } } \
            __builtin_amdgcn_sched_barrier(0); \
            u32x4 vA[8], vB[8]; float wA[8], wB[8]; \
            pv_issue<0, PROBE>(V, slot, MA, vA, wA); \
            pv_issue<1, PROBE>(V, slot, MA, vB, wB); \
            __builtin_amdgcn_sched_barrier(0); \
            { const float* xr = Xb + (size_t)min(r + step, M - 1) * D + c0; \
              _Pragma("unroll") for (int q = 0; q < 4; ++q) XNEW[q] = *(const f32x4*)(xr + 4 * q); } \
            pv_load<PROBE>(K, min(r + 2 * step, M - 1), MC); \
            __builtin_amdgcn_sched_barrier(0); \
            f32x2_ y2[8]; float sw = 0.f; \
            _Pragma("unroll") for (int i = 0; i < 8; ++i) y2[i] = (f32x2_){0.f, 0.f}; \
            pv_accum(vA, wA, y2, sw); \
            pv_accum(vB, wB, y2, sw); \
            _Pragma("unroll") for (int q = 0; q < 8; ++q) { yp[2 * q] = y2[q].x - 128.f * sw; yp[2 * q + 1] = y2[q].y - 128.f * sw; } \
            _Pragma("unroll") for (int q = 0; q < 16; ++q) { float v = yp[q]; v += dpp_<0x128>(v); \
                auto s1 = __builtin_amdgcn_permlane16_swap(__float_as_uint(v), __float_as_uint(v), false, false); v = __uint_as_float(s1[0]) + __uint_as_float(s1[1]); \
                auto s2 = __builtin_amdgcn_permlane32_swap(__float_as_uint(v), __float_as_uint(v), false, false); yp[q] = __uint_as_float(s2[0]) + __uint_as_float(s2[1]); } \
            rp = r; } while (0)
        f32x4 (*xfin)[4] = nullptr; (void)xfin;
        int it = 0;
#pragma unroll 1
        for (; it + 2 < nit; it += 3) {
            PV_BODY(xprev, xq, x2, mA, m2, it);
            PV_BODY(xq, x2, xprev, mB, mA, it + 1);
            PV_BODY(x2, xprev, xq, m2, mB, it + 2);
        }
        if (it < nit) { PV_BODY(xprev, xq, x2, mA, m2, it); ++it;
            if (it < nit) { PV_BODY(xq, x2, xprev, mB, mA, it); ++it;
#pragma unroll
                for (int q = 0; q < 4; ++q) xprev[q] = x2[q]; }
            else {
#pragma unroll
                for (int q = 0; q < 4; ++q) xprev[q] = xq[q]; } }
#undef PV_BODY
        if (rp >= 0) { const int mv = modvec_of_row(rp);
#pragma unroll
            for (int q = 0; q < 4; ++q) gp[q] = *(const f32x4*)(gate + (size_t)mv * 6 * D + c0 + 4 * q);
            if (slot == 0) { float* xr = Xb + (size_t)rp * D + c0;
#pragma unroll
                for (int q = 0; q < 4; ++q) { f32x4 x = xprev[q];
                    x.x += gp[q].x * yp[4 * q]; x.y += gp[q].y * yp[4 * q + 1]; x.z += gp[q].z * yp[4 * q + 2]; x.w += gp[q].w * yp[4 * q + 3]; *(f32x4*)(xr + 4 * q) = x; } } }
    }
}

DI void ph_final(Ctx& K) {
    for (int r = K.gw; r < NLAT; r += K.ngw) {
        const f32x4* xr = (const f32x4*)(K.X() + (size_t)(NCTX + r) * D); f32x4* o = (f32x4*)(((float*)argp_<float>(K, (unsigned)__builtin_offsetof(Args, out))) + (size_t)r * D);
        f32x4 v[4]; float ss = 0.f;
#pragma unroll
        for (int j = 0; j < 4; ++j) { v[j] = xr[j * 64 + K.lane]; ss += v[j].x * v[j].x + v[j].y * v[j].y + v[j].z * v[j].z + v[j].w * v[j].w; }
        ss = wave_sum(ss); const float rs = rsqrtf(ss * (1.0f / D) + EPS);
#pragma unroll
        for (int j = 0; j < 4; ++j) { const f32x4 w = ((const f32x4*)ARG(final_norm_w))[j * 64 + K.lane]; o[j * 64 + K.lane] = v[j] * rs * w; }
    }
}

#define XB_TMO      128
#define XB_XSUB(j)  (1280 + 64 * (j))
#define XB_XGEN(j)  (2304 + 64 * (j))
#define XB_TOP      3328
#define XB_TOPGEN   3392
#define XB_SPIN_CAP (1u << 22)
constexpr int CW_BAR = 4096;
DI unsigned xb_ld(unsigned* p)              { return __hip_atomic_load(p, __ATOMIC_RELAXED, __HIP_MEMORY_SCOPE_AGENT); }
DI unsigned xb_add(unsigned* p, unsigned v) { return __hip_atomic_fetch_add(p, v, __ATOMIC_RELAXED, __HIP_MEMORY_SCOPE_AGENT); }
#define XB_SPIN(cond, bar) do { unsigned _sp = 0; while (cond) { __builtin_amdgcn_s_sleep(1); \
    if ((++_sp & 255u) == 0u) { if (xb_ld(&(bar)[XB_TMO])) break; if (_sp > XB_SPIN_CAP) { atomicAdd(&(bar)[XB_TMO], 1u); break; } } } } while (0)
DI void xcd_barrier(unsigned* bar, unsigned x, unsigned nloc, unsigned nx) {
    asm volatile("s_waitcnt vmcnt(0)" ::: "memory");
    __syncthreads();
    if (threadIdx.x == 0) {
        __builtin_amdgcn_s_waitcnt(0);
        const unsigned old = xb_add(&bar[XB_XSUB(x)], 1u);
        const unsigned gen = old / nloc;
        if (old + 1u == (gen + 1u) * nloc) {
            __builtin_amdgcn_fence(__ATOMIC_RELEASE, "agent");
            asm volatile("s_waitcnt vmcnt(0)" ::: "memory");
            const unsigned og = xb_add(&bar[XB_TOP], 1u);
            const unsigned tg = og / nx;
            if (og + 1u == (tg + 1u) * nx) xb_add(&bar[XB_TOPGEN], 1u);
            else XB_SPIN(xb_ld(&bar[XB_TOPGEN]) == tg, bar);
            __builtin_amdgcn_fence(__ATOMIC_ACQUIRE, "agent");
            xb_add(&bar[XB_XGEN(x)], 1u);
            asm volatile("s_waitcnt vmcnt(0)" ::: "memory");
        } else {
            XB_SPIN(xb_ld(&bar[XB_XGEN(x)]) == gen, bar);
            __builtin_amdgcn_fence(__ATOMIC_ACQUIRE, "agent");
            asm volatile("s_waitcnt vmcnt(0)" ::: "memory");
        }
    }
    __syncthreads();
}

constexpr int PROBE_U = 0, PROBE_V = 0, PROBE_S = 0;
constexpr unsigned DUP_MASK = 0u;
constexpr int PH_PER_LAYER = 12, N_PHASES = 2 + PH_PER_LAYER * DEPTH;
__global__ void __launch_bounds__(NTHREADS) mk_fwd(Args args) {
    extern __shared__ __attribute__((aligned(16))) unsigned char lds[];
    cg::grid_group grid = cg::this_grid();
    constexpr unsigned ARGS_OFF = LDS_BYTES - 256;
    constexpr unsigned MISC_OFF = LDS_BYTES - 64;
    if (threadIdx.x == 0) {
        *(Args*)(lds + ARGS_OFF) = args;
        unsigned* ctl = (unsigned*)(args.ws + WS_CTL); unsigned* misc = (unsigned*)(lds + MISC_OFF);
        const unsigned xcc = (unsigned)__builtin_amdgcn_s_getreg((3 << 11) | 20) & 0xFu;
        misc[0] = xcc; misc[1] = __hip_atomic_fetch_add(ctl + 64 * xcc, 1u, __ATOMIC_RELAXED, __HIP_MEMORY_SCOPE_AGENT);
    }
    __syncthreads();
    int rep = 0;
#pragma unroll 1
    for (int ph = 0; ph < N_PHASES; ++ph) {
        int tid = threadIdx.x; asm volatile("" : "+v"(tid));
        unsigned aoff = ARGS_OFF; asm volatile("" : "+v"(aoff));
        size_t zoff = 0; asm volatile("" : "+s"(zoff));
        unsigned char* ws = args.ws + zoff;
        int bid = blockIdx.x; asm volatile("" : "+s"(bid)); int nb = gridDim.x; asm volatile("" : "+s"(nb));
        unsigned moff = MISC_OFF; asm volatile("" : "+v"(moff));
        Ctx K; { const unsigned* misc = (const unsigned*)(lds + moff); K.jx = __builtin_amdgcn_readfirstlane(misc[1]); K.xg = __builtin_amdgcn_readfirstlane(misc[2]); K.nxg = __builtin_amdgcn_readfirstlane(misc[3]); K.nloc = __builtin_amdgcn_readfirstlane(misc[4]); }
        K.aoff = aoff; K.lds = lds; K.tid = tid; K.lane = tid & 63; K.wave = tid >> 6; K.bid = bid; K.nb = nb; K.gw = bid * NWAVES + K.wave; K.ngw = nb * NWAVES;
        K.ws = ws;
        const int l = ph == 0 ? 0 : (ph - 1) / PH_PER_LAYER, k = ph == 0 ? -1 : (ph == N_PHASES - 1 ? -2 : (ph - 1) % PH_PER_LAYER);
        K.l = l;
        if (k == -1) ph_prologue(K);
        else if (k == -2) ph_final(K);
        else if (k == 0) ph_norm(K, ARG(norm_mix_w) + (size_t)l * D, 0);
        else if (k == 1) ph_gemm_store(K, K.H(), K.WIN() + (size_t)l * PW * D, PW, K.P(), K.ROPE());
        else if (k == 2) ph_hgrn_A(K);
        else if (k == 3) ph_attn(K);
        else if (k == 4) ph_hgrn_B(K);
        else if (k == 5) ph_hgrn_C(K);
        else if (k == 6) ph_gemm_resid(K, K.MIX(), K.WOUT() + (size_t)l * D * D, 2);
        else if (k == 7) ph_norm(K, ARG(norm_ffn_w) + (size_t)l * D, 3);
        else if (k == 8) ph_gemm_store(K, K.H(), K.WQ() + (size_t)l * 2048 * D, 2048, K.QP(), nullptr);
        else if (k == 9) { ph_peer_select<0>(K); if (PROBE_S) ph_peer_select<PROBE_S>(K); }
        else if (k == 10) { ph_peer_u<0>(K); if (PROBE_U) ph_peer_u<PROBE_U>(K); }
        else if (k == 11) { ph_peer_v<0>(K); if (PROBE_V) ph_peer_v<PROBE_V>(K); }
        if (k >= 0 && ((DUP_MASK >> k) & 1u)) { ++rep; if (rep < 2) { --ph; continue; } } rep = 0;
        if (ph == 0) grid.sync();
        else if (k != 2 && ph != N_PHASES - 1) { const unsigned* misc = (const unsigned*)(lds + moff); xcd_barrier((unsigned*)(args.ws + WS_CTL) + CW_BAR, misc[0], misc[4], misc[3]); }
        if (ph == 0) {
            if (threadIdx.x == 0) { unsigned* ctl = (unsigned*)(args.ws + WS_CTL); unsigned* misc = (unsigned*)(lds + MISC_OFF); const unsigned xcc = misc[0]; unsigned ord = 0, npop = 0, mine = 1;
                for (unsigned q = 0; q < 16; ++q) { const unsigned cq = __hip_atomic_load(ctl + 64 * q, __ATOMIC_RELAXED, __HIP_MEMORY_SCOPE_AGENT); if (cq) { ++npop; if (q < xcc) ++ord; } if (q == xcc) mine = cq; }
                misc[2] = ord; misc[3] = npop ? npop : 1u; misc[4] = mine ? mine : 1u; }
            __syncthreads();
        }
    }
}

extern "C" void kernel_launch(void* const* d_in, const int* in_sizes, int n_in, void* d_out, int out_size, void* d_ws, size_t ws_size, hipStream_t stream) {
    static int grid = 0;
    if (grid == 0) {
        if (n_in != 19 || out_size != NLAT * D || ws_size < WS_END) { fprintf(stderr, "kernel_launch: unexpected shapes (n_in %d out %d ws %zu need %zu)\n", n_in, out_size, ws_size, (size_t)WS_END); grid = -1; return; }
        int dev = 0, cus = 0, per_cu = 0;
        (void)hipGetDevice(&dev); (void)hipDeviceGetAttribute(&cus, hipDeviceAttributeMultiprocessorCount, dev);
        (void)hipFuncSetAttribute((const void*)mk_fwd, hipFuncAttributeMaxDynamicSharedMemorySize, LDS_BYTES);
        (void)hipOccupancyMaxActiveBlocksPerMultiprocessor(&per_cu, (const void*)mk_fwd, NTHREADS, LDS_BYTES);
        if (per_cu < 1) { fprintf(stderr, "kernel_launch: occupancy query says %d blocks/CU\n", per_cu); grid = -1; return; }
        grid = (cus / 8) * 8;
    }
    if (grid < 0) return;
    Args a{};
    a.x = (const float*)d_in[0]; a.c = (const float*)d_in[1]; a.ctx = (const float*)d_in[2]; a.c_ctx = (const float*)d_in[3]; a.w_mod = (const float*)d_in[4]; a.b_mod = (const float*)d_in[5];
    a.norm_mix_w = (const float*)d_in[6]; a.norm_ffn_w = (const float*)d_in[7]; a.w_in = (const float*)d_in[8]; a.lb_logits = (const float*)d_in[9]; a.hgrn_norm_w = (const float*)d_in[10];
    a.swa_sink = (const float*)d_in[11]; a.nat_rpb = (const float*)d_in[12]; a.w_out = (const float*)d_in[13]; a.peer_wq = (const float*)d_in[14]; a.peer_sk = (const float*)d_in[15];
    a.peer_u = (const float*)d_in[16]; a.peer_v = (const float*)d_in[17]; a.final_norm_w = (const float*)d_in[18];
    a.out = (float*)d_out; a.ws = (unsigned char*)d_ws;
    (void)hipMemsetAsync((unsigned char*)d_ws + WS_CTL, 0, CTL_BYTES, stream);
    void* kargs[] = {&a};
    hipError_t e = hipLaunchCooperativeKernel((const void*)mk_fwd, dim3(grid), dim3(NTHREADS), kargs, LDS_BYTES, stream);
    if (e != hipSuccess) fprintf(stderr, "kernel_launch: cooperative launch failed: %s (grid %d)\n", hipGetErrorString(e), grid);
}
```

```cpp
#include <hip/hip_runtime.h>
#include <hip/hip_cooperative_groups.h>
#include <cstdio>
#include <cstdint>
namespace cg = cooperative_groups;
#define DI __device__ __forceinline__
#define GP(T, p) ((T*)(__attribute__((address_space(1))) T*)(p))

typedef unsigned short bf16_t;
typedef float f32x4 __attribute__((ext_vector_type(4)));
typedef unsigned u32x4 __attribute__((ext_vector_type(4)));
typedef unsigned u32x2 __attribute__((ext_vector_type(2)));

constexpr int D = 1024, NB = 2, L = 16384, CL = 256, DEPTH = 4;
constexpr int NCTX = NB * CL, NLAT = NB * L, M = NCTX + NLAT;
constexpr int PW = 3072;
constexpr int C_HQ = 0, C_ZF = 256, C_ZB = 512, C_HV = 768, C_HG = 1024, C_SQ = 1280, C_SK = 1664, C_SV = 1792, C_NQ = 1920, C_NK = 2304, C_NV = 2688;
constexpr int MX_H = 0, MX_S = 256, MX_N = 640;
constexpr float EPS = 1e-6f;
constexpr int NTHREADS = 512, NWAVES = 8;
constexpr int LDS_BYTES = 163840;

constexpr size_t al256(size_t x) { return (x + 255) & ~(size_t)255; }
constexpr size_t WS_X = 0;
constexpr size_t WS_H = WS_X + al256((size_t)M * D * 4);
constexpr size_t WS_P = WS_H + al256((size_t)M * D * 2);
constexpr size_t WS_MIX = WS_P + al256((size_t)M * PW * 2);
constexpr size_t WS_OF = WS_MIX + al256((size_t)M * D * 2);
constexpr size_t WS_OB = WS_OF + al256((size_t)M * 256 * 4);
constexpr size_t WS_PIDX = WS_OB + al256((size_t)M * 256 * 4);
constexpr size_t WS_PG = WS_PIDX + al256((size_t)M * 128 * 4);
constexpr size_t WS_MOD = WS_PG + al256((size_t)M * 128 * 4);
constexpr size_t WS_LB = WS_MOD + al256((size_t)DEPTH * 3 * 6 * D * 4);
constexpr size_t WS_ROPE = WS_LB + al256((size_t)2 * DEPTH * 256 * 4);
constexpr size_t WS_WIN = WS_ROPE + al256((size_t)(256 + 256 + 64 + 64) * 16 * 4);
constexpr size_t WS_WOUT = WS_WIN + al256((size_t)DEPTH * PW * D * 2);
constexpr size_t WS_WQ = WS_WOUT + al256((size_t)DEPTH * D * D * 2);
constexpr size_t WS_AC = WS_WQ + al256((size_t)DEPTH * 2048 * D * 2);
constexpr size_t WS_UB_ = 0; constexpr size_t WS_UB = WS_AC + al256((size_t)16 * 260 * 64 * 4); constexpr size_t WS_UB_OLD = WS_WQ + al256((size_t)DEPTH * 2048 * D * 2);
constexpr size_t WS_VB = WS_UB + al256((size_t)DEPTH * 16384 * D * 2);
constexpr size_t WS_PA = WS_VB + al256((size_t)DEPTH * 16384 * D * 2);
constexpr size_t WS_VS = WS_PA + al256((size_t)M * 128 * 4);
constexpr size_t WS_US = WS_VS + al256((size_t)DEPTH * 16384 * 4);
constexpr size_t WS_H8 = WS_US + al256((size_t)DEPTH * 16384 * 4);
constexpr size_t WS_HS = WS_H8 + al256((size_t)M * D);
constexpr size_t WS_SKH = WS_HS + al256((size_t)M * 4);
constexpr size_t WS_SKL = WS_SKH + al256((size_t)DEPTH * 8 * 2 * 128 * 128 * 2);
constexpr size_t WS_CTL = WS_SKL + al256((size_t)DEPTH * 8 * 2 * 128 * 128 * 2);
constexpr size_t CTL_BYTES = 65536;
constexpr size_t WS_END = WS_CTL + CTL_BYTES;

struct Args {
    const float *x, *c, *ctx, *c_ctx, *w_mod, *b_mod, *norm_mix_w, *norm_ffn_w, *w_in, *lb_logits, *hgrn_norm_w, *swa_sink, *nat_rpb, *w_out, *peer_wq, *peer_sk, *peer_u, *peer_v, *final_norm_w;
    float* out; unsigned char* ws;
};

DI float bf2f(bf16_t v) { return __uint_as_float((unsigned)v << 16); }
DI bf16_t f2bf(float f) { unsigned u = __float_as_uint(f); return (bf16_t)((u + 0x7fffu + ((u >> 16) & 1u)) >> 16); }
DI unsigned pk2(float lo, float hi) { return (unsigned)f2bf(lo) | ((unsigned)f2bf(hi) << 16); }
DI float wave_sum(float v) {
#pragma unroll
    for (int o = 1; o < 64; o <<= 1) v += __shfl_xor(v, o);
    return v;
}
typedef __bf16 bf16x2_t __attribute__((ext_vector_type(2)));
DI float dot2bf(unsigned a, unsigned b, float acc) { return __builtin_amdgcn_fdot2_f32_bf16(__builtin_bit_cast(bf16x2_t, a), __builtin_bit_cast(bf16x2_t, b), acc, false); }
template <int CTRL> DI float dpp_(float x) { return __builtin_bit_cast(float, __builtin_amdgcn_mov_dpp(__builtin_bit_cast(int, x), CTRL, 0xf, 0xf, true)); }
DI float wave_sum_fast(float x) {
    x += dpp_<0xB1>(x); x += dpp_<0x4E>(x); x += dpp_<0x141>(x); x += dpp_<0x128>(x);
    auto s1 = __builtin_amdgcn_permlane16_swap(__float_as_uint(x), __float_as_uint(x), false, false); x = __uint_as_float(s1[0]) + __uint_as_float(s1[1]);
    auto s2 = __builtin_amdgcn_permlane32_swap(__float_as_uint(x), __float_as_uint(x), false, false); return __uint_as_float(s2[0]) + __uint_as_float(s2[1]);
}
DI float sigmoidf_(float z) { return 1.0f / (1.0f + __expf(-z)); }
DI float gelu_erf(float v) { return 0.5f * v * (1.0f + erff(v * 0.70710678118654752f)); }
DI int modvec_of_row(int r) { return r < NCTX ? 2 : (r - NCTX) / L; }
DI int batch_of_row(int r) { return r < NCTX ? r / CL : (r - NCTX) / L; }
DI int lat_row(int b, int t) { return NCTX + b * L + t; }
DI int ctx_row(int b, int s) { return b * CL + s; }
DI void unpack8(const u32x4 w, float* o) {
    o[0] = __uint_as_float(w.x << 16); o[1] = __uint_as_float(w.x & 0xffff0000u);
    o[2] = __uint_as_float(w.y << 16); o[3] = __uint_as_float(w.y & 0xffff0000u);
    o[4] = __uint_as_float(w.z << 16); o[5] = __uint_as_float(w.z & 0xffff0000u);
    o[6] = __uint_as_float(w.w << 16); o[7] = __uint_as_float(w.w & 0xffff0000u);
}
DI void load_row64(const bf16_t* p, float (&o)[64]) {
#pragma unroll
    for (int i = 0; i < 8; ++i) { const u32x4 w = *(const u32x4*)(p + 8 * i); unpack8(w, &o[8 * i]); }
}
DI void rope64(float (&x)[64], const float* cr, const float* sr, const float* cc, const float* sc) {
#pragma unroll
    for (int i = 0; i < 16; ++i) {
        const float c1 = cr[i], s1 = sr[i], a = x[i], b = x[16 + i];
        x[i] = a * c1 - b * s1; x[16 + i] = b * c1 + a * s1;
        const float c2 = cc[i], s2 = sc[i], e = x[32 + i], f = x[48 + i];
        x[32 + i] = e * c2 - f * s2; x[48 + i] = f * c2 + e * s2;
    }
}

namespace pg8 {
#define PG8_LAS __attribute__((address_space(3)))
typedef unsigned short bf16_t;
typedef short bf16x8 __attribute__((ext_vector_type(8)));
typedef float f32x4 __attribute__((ext_vector_type(4)));
typedef unsigned u32x4 __attribute__((ext_vector_type(4)));
constexpr int BM = 256, BK = 64, HALF = 128, HTB = HALF * BK * 2  , STAGE_BYTES = 8 * HTB, NXCD = 8, WGM = 8;

__host__ __device__ __forceinline__ int lds_byte(int r, int c) { const int st = (r >> 4) * 2 + (c >> 5), rr = r & 15, cc = c & 31, ob = rr * 64 + cc * 2; return st * 1024 + (ob ^ (((ob >> 9) & 1) << 5)); }
__host__ __device__ __forceinline__ void stage_rc(int b, int& R, int& C) { const int st = b / 1024, sb = b % 1024, swz = sb ^ (((sb >> 9) & 1) << 5); R = (st >> 1) * 16 + swz / 64; C = (st & 1) * 32 + (swz % 64) / 2; }
__host__ __device__ __forceinline__ int perm32(int rho) { const int n = rho >> 4, i = rho & 15; return 8 * (i >> 2) + 4 * n + (i & 3); }

struct Unit { int pm, pn; };
struct Gemm { const bf16_t* A; const bf16_t* Bt; int M, N, K; };

struct StaticOrder {
    int nM, nN, nwg, G, c;
    __host__ __device__ void init(int M, int N, int G_, int c_) { nM = M / BM; nN = N / BM; nwg = nM * nN; G = G_; c = c_; }
    __host__ __device__ bool next(int i, Unit& u) const {
        const long L = (long)i * G + c; if (L >= nwg) return false;
        int wgid = (int)L; { const int q = nwg / NXCD, r = nwg % NXCD, xcd = wgid % NXCD, off = wgid / NXCD; wgid = (xcd < r ? xcd * (q + 1) : r * (q + 1) + (xcd - r) * q) + off; }
        const int nig = WGM * nN, gid = wgid / nig, fm = gid * WGM, gsz = (nM - fm) < WGM ? (nM - fm) : WGM;
        u.pm = fm + ((wgid % nig) % gsz); u.pn = (wgid % nig) / gsz; return true;
    }
    __device__ __forceinline__ void a_ready(const Unit&) const {}
    __device__ __forceinline__ void done(const Unit&) const {}
};


__device__ __forceinline__ unsigned cvt_pk_bf16(float lo, float hi) { unsigned r; asm volatile("v_cvt_pk_bf16_f32 %0, %1, %2" : "=v"(r) : "v"(lo), "v"(hi)); return r; }
constexpr int EPI_LDS_OFF = STAGE_BYTES, EPI_LDS_WAVE = 2560;
struct EpiStore {
    static constexpr bool PERM = true, AFTER_DRAIN = false;
    bf16_t* O; int ldc; PG8_LAS unsigned char* lds; const float* rope; int nctx, seqlen, rowbase;
    __device__ __forceinline__ void operator()(const f32x4 (&acc)[2][2][4][2], const Unit& u, int wr, int wc, int fr, int fq) const {
        PG8_LAS unsigned char* T = lds + EPI_LDS_OFF + (wr * 4 + wc) * EPI_LDS_WAVE;
        const int lane = fr + 16 * fq, rr = lane >> 2, cc = lane & 3;
        const int row0 = rowbase + u.pm * BM + wr * 64, col0 = u.pn * BM + wc * 32;
        const bool dorope = rope != nullptr && (u.pn == 5 || u.pn == 6) && rowbase + u.pm * BM >= nctx;
#pragma unroll
        for (int ai = 0; ai < 2; ++ai)
#pragma unroll
            for (int m = 0; m < 4; ++m)
#pragma unroll
                for (int bj = 0; bj < 2; ++bj) { const f32x4 v0 = acc[ai][bj][m][0], v1 = acc[ai][bj][m][1];
                    u32x4 w; w.x = cvt_pk_bf16(v0[0], v0[1]); w.y = cvt_pk_bf16(v0[2], v0[3]); w.z = cvt_pk_bf16(v1[0], v1[1]); w.w = cvt_pk_bf16(v1[2], v1[3]);
                    *(PG8_LAS u32x4*)(T + fr * 80 + 16 * fq) = w;
                    asm volatile("s_waitcnt lgkmcnt(0)" ::: "memory");
                    u32x4 o = *(const PG8_LAS u32x4*)(T + rr * 80 + 16 * cc);
                    asm volatile("s_waitcnt lgkmcnt(0)" ::: "memory");
                    const int grow = row0 + ai * HALF + m * 16 + rr;
                    if (dorope) {
                        const int t = (grow - nctx) % seqlen; const bool second = (wc & 1) != 0;
                        const float* ct = rope + (second ? 8192 + (t & 63) * 16 : (t >> 6) * 16) + 8 * (cc & 1); const float* st = ct + (second ? 1024 : 4096);
                        const f32x4 c0 = *(const f32x4*)ct, c1 = *(const f32x4*)(ct + 4), s0 = *(const f32x4*)st, s1 = *(const f32x4*)(st + 4);
                        const float cs[8] = {c0[0], c0[1], c0[2], c0[3], c1[0], c1[1], c1[2], c1[3]}, sn[8] = {s0[0], s0[1], s0[2], s0[3], s1[0], s1[1], s1[2], s1[3]};
                        const unsigned ow[4] = {o.x, o.y, o.z, o.w}; unsigned rw[4];
                        const float sg = cc >= 2 ? 1.0f : -1.0f;
#pragma unroll
                        for (int q = 0; q < 4; ++q) { const unsigned pw = (unsigned)__builtin_amdgcn_mov_dpp((int)ow[q], 0x4E, 0xf, 0xf, true);
                            const float x0 = __uint_as_float(ow[q] << 16), x1 = __uint_as_float(ow[q] & 0xffff0000u), p0 = __uint_as_float(pw << 16), p1 = __uint_as_float(pw & 0xffff0000u);
                            rw[q] = cvt_pk_bf16(x0 * cs[2 * q] + sg * p0 * sn[2 * q], x1 * cs[2 * q + 1] + sg * p1 * sn[2 * q + 1]); }
                        o = (u32x4){rw[0], rw[1], rw[2], rw[3]}; }
                    *(u32x4*)(O + (size_t)grow * ldc + col0 + bj * HALF + 8 * cc) = o; }
    }
};
struct EpiResid {
    static constexpr bool PERM = false, AFTER_DRAIN = false;
    float* X; int ldc; const float* gate; int gstride, nctx, seqlen; PG8_LAS unsigned char* lds; int rowbase;
    __device__ __forceinline__ void operator()(const f32x4 (&acc)[2][2][4][2], const Unit& u, int wr, int wc, int fr, int fq) const {
        PG8_LAS float* T = (PG8_LAS float*)(lds + EPI_LDS_OFF + (wr * 4 + wc) * EPI_LDS_WAVE);
        const int lane = fr + 16 * fq, rr = lane >> 3, cc = lane & 7;
        const int r0 = rowbase + u.pm * BM; const int vsel = r0 < nctx ? 2 : (r0 - nctx) / seqlen;
        const int row0 = r0 + wr * 64, col0 = u.pn * BM + wc * 32 + 4 * cc;
#pragma unroll
        for (int bj = 0; bj < 2; ++bj) { const f32x4 g = *(const f32x4*)(gate + (size_t)vsel * gstride + col0 + bj * HALF);
#pragma unroll
            for (int ai = 0; ai < 2; ++ai)
#pragma unroll
                for (int m = 0; m < 4; ++m) {
#pragma unroll
                    for (int n = 0; n < 2; ++n) *(PG8_LAS f32x4*)(T + fr * 36 + 16 * n + 4 * fq) = acc[ai][bj][m][n];
                    asm volatile("s_waitcnt lgkmcnt(0)" ::: "memory");
                    const f32x4 t0 = *(const PG8_LAS f32x4*)(T + rr * 36 + 4 * cc), t1 = *(const PG8_LAS f32x4*)(T + (rr + 8) * 36 + 4 * cc);
                    asm volatile("s_waitcnt lgkmcnt(0)" ::: "memory");
                    float* x0 = X + (size_t)(row0 + ai * HALF + m * 16 + rr) * ldc + col0 + bj * HALF; float* x1 = x0 + (size_t)8 * ldc;
                    f32x4 a = *(const f32x4*)x0, b = *(const f32x4*)x1; a += g * t0; b += g * t1; *(f32x4*)x0 = a; *(f32x4*)x1 = b; } }
    }
};

template <class Epi, class Sched, bool ALIGN_EPI = false, bool SP2 = false>
__device__ __forceinline__ void gemm_phase(PG8_LAS unsigned char* lds, const Gemm g, const Sched& S, const Epi& E) {
    int tid_ = threadIdx.x; asm volatile("" : "+v"(tid_));
    const int tid = tid_, wid = __builtin_amdgcn_readfirstlane(tid >> 6), lane = tid & 63, wr = wid >> 2, wc = wid & 3, fr = lane & 15, fq = lane >> 4;
    const int K = g.K, nt = K / BK;
    unsigned voffA[2], voffB[2];
#pragma unroll
    for (int i = 0; i < 2; ++i) { int R, C; stage_rc(tid * 16 + i * 8192, R, C); const int Rb = Epi::PERM ? ((R & ~31) + perm32(R & 31)) : R;
        voffA[i] = (unsigned)(R * K + C) * 2u; voffB[i] = (unsigned)(Rb * K + C) * 2u; }
    const size_t kstep = (size_t)(BK * 2);
    const size_t hstep = (size_t)HALF * K * 2;
    const size_t tstep = 2 * hstep;
    const unsigned ldsw = (unsigned)wid * 1024u;
    const int aoff = lds_byte(wr * 64 + fr, fq * 8), boff = lds_byte(wc * 32 + fr, fq * 8);
#define PG8_SA(b, h) (((b) * 2 + (h)) * HTB)
#define PG8_SB(b, h) ((4 + (b) * 2 + (h)) * HTB)
#define PG8_STAGE(bufoff, gbase, voff) do { _Pragma("unroll") for (int _i = 0; _i < 2; ++_i) \
        __builtin_amdgcn_global_load_lds((const unsigned*)((const char*)(gbase) + (voff)[_i]), (PG8_LAS unsigned*)(lds + (bufoff) + ldsw + _i * 8192), 16, 0, 0); } while (0)
#define PG8_LDA(dst, b, h) do { _Pragma("unroll") for (int m = 0; m < 4; ++m) _Pragma("unroll") for (int k = 0; k < 2; ++k) dst[m][k] = *(const PG8_LAS bf16x8*)(lds + PG8_SA(b, h) + aoff + m * 2048 + k * 1024); } while (0)
#define PG8_LDB(dst, b, h) do { _Pragma("unroll") for (int n = 0; n < 2; ++n) _Pragma("unroll") for (int k = 0; k < 2; ++k) dst[n][k] = *(const PG8_LAS bf16x8*)(lds + PG8_SB(b, h) + boff + n * 2048 + k * 1024); } while (0)
#define PG8_MMA(ai, bj, At, Bt) do { __builtin_amdgcn_s_setprio(1); _Pragma("unroll") for (int m = 0; m < 4; ++m) _Pragma("unroll") for (int n = 0; n < 2; ++n) _Pragma("unroll") for (int k = 0; k < 2; ++k) \
        acc[ai][bj][m][n] = __builtin_amdgcn_mfma_f32_16x16x32_bf16(Bt[n][k], At[m][k], acc[ai][bj][m][n], 0, 0, 0); __builtin_amdgcn_s_setprio(0); } while (0)
#define PG8_WAIT_V(n) asm volatile("s_waitcnt vmcnt(" #n ")" ::: "memory")
#define PG8_WAIT_L(n) asm volatile("s_waitcnt lgkmcnt(" #n ")" ::: "memory")
#define PG8_BAR __builtin_amdgcn_s_barrier()
#define PG8_SCHED __builtin_amdgcn_sched_barrier(0)
    Unit cur, nxt; int ui = 0;
    if (!S.next(0, cur)) return;
    f32x4 acc[2][2][4][2];
#pragma unroll
    for (int a = 0; a < 2; ++a)
#pragma unroll
        for (int b = 0; b < 2; ++b)
#pragma unroll
            for (int m = 0; m < 4; ++m)
#pragma unroll
                for (int n = 0; n < 2; ++n) acc[a][b][m][n] = (f32x4){0.f, 0.f, 0.f, 0.f};
    bf16x8 At[4][2], B0[2][2], B1[2][2];
    const char* cA = (const char*)g.A + (size_t)cur.pm * tstep; const char* cB = (const char*)g.Bt + (size_t)cur.pn * tstep;
    S.a_ready(cur);
    if constexpr (SP2) {
        PG8_STAGE(PG8_SB(0, 0), cB, voffB); PG8_STAGE(PG8_SB(0, 1), cB + hstep, voffB); PG8_STAGE(PG8_SA(0, 0), cA, voffA); PG8_STAGE(PG8_SA(0, 1), cA + hstep, voffA);
        if (wr == 1) PG8_BAR;
        PG8_WAIT_V(2); PG8_BAR;
        PG8_STAGE(PG8_SB(1, 0), cB + kstep, voffB); PG8_STAGE(PG8_SA(1, 0), cA + kstep, voffA); PG8_STAGE(PG8_SB(1, 1), cB + hstep + kstep, voffB);
        PG8_WAIT_V(6); PG8_BAR;
    } else {
        PG8_STAGE(PG8_SB(0, 0), cB, voffB); PG8_STAGE(PG8_SA(0, 0), cA, voffA); PG8_STAGE(PG8_SB(0, 1), cB + hstep, voffB); PG8_STAGE(PG8_SA(0, 1), cA + hstep, voffA);
        if (wr == 1) PG8_BAR;
        PG8_WAIT_V(4); PG8_BAR;
        PG8_STAGE(PG8_SB(1, 0), cB + kstep, voffB); PG8_STAGE(PG8_SA(1, 0), cA + kstep, voffA); PG8_STAGE(PG8_SB(1, 1), cB + hstep + kstep, voffB);
        PG8_WAIT_V(6); PG8_BAR;
    }
    for (;;) {
        const bool has_next = S.next(ui + 1, nxt);
        const char* nA = has_next ? (const char*)g.A + (size_t)nxt.pm * tstep : cA; const char* nB = has_next ? (const char*)g.Bt + (size_t)nxt.pn * tstep : cB;
        for (int t = 0; t < nt; t += 2) {
            const bool last = (t == nt - 2);
            const char* a1 = cA + (size_t)(t + 1) * kstep;
            const char* a2 = last ? nA : cA + (size_t)(t + 2) * kstep; const char* b2 = last ? nB : cB + (size_t)(t + 2) * kstep;
            const char* a3 = a2 + kstep; const char* b3 = b2 + kstep;
            if (last && has_next) S.a_ready(nxt);
            if constexpr (SP2) {
            PG8_LDB(B0, 0, 0); PG8_LDB(B1, 0, 1); PG8_SCHED; PG8_LDA(At, 0, 0); PG8_STAGE(PG8_SA(1, 1), a1 + hstep, voffA);
            PG8_WAIT_V(8); PG8_WAIT_L(0); PG8_BAR; PG8_MMA(0, 0, At, B0); PG8_MMA(0, 1, At, B1); PG8_BAR; PG8_SCHED;
            PG8_LDA(At, 0, 1); PG8_STAGE(PG8_SB(0, 0), b2, voffB); PG8_STAGE(PG8_SB(0, 1), b2 + hstep, voffB); PG8_STAGE(PG8_SA(0, 0), a2, voffA);
            PG8_WAIT_V(8); PG8_WAIT_L(0); PG8_BAR; PG8_MMA(1, 0, At, B0); PG8_MMA(1, 1, At, B1); PG8_BAR; PG8_SCHED;
            PG8_LDB(B0, 1, 0); PG8_LDB(B1, 1, 1); PG8_SCHED; PG8_LDA(At, 1, 0); PG8_STAGE(PG8_SA(0, 1), a2 + hstep, voffA);
            PG8_WAIT_V(8); PG8_WAIT_L(0); PG8_BAR; PG8_MMA(0, 0, At, B0); PG8_MMA(0, 1, At, B1); PG8_BAR; PG8_SCHED;
            PG8_LDA(At, 1, 1); PG8_STAGE(PG8_SB(1, 0), b3, voffB); PG8_STAGE(PG8_SB(1, 1), b3 + hstep, voffB); PG8_STAGE(PG8_SA(1, 0), a3, voffA);
            PG8_WAIT_V(8); PG8_WAIT_L(0); PG8_BAR; PG8_MMA(1, 0, At, B0); PG8_MMA(1, 1, At, B1); PG8_BAR; PG8_SCHED;
            } else {
            PG8_LDB(B0, 0, 0); PG8_SCHED; PG8_LDA(At, 0, 0); PG8_STAGE(PG8_SA(1, 1), a1 + hstep, voffA);
            PG8_WAIT_L(8); PG8_BAR; PG8_WAIT_L(0); PG8_MMA(0, 0, At, B0); PG8_BAR; PG8_SCHED;
            PG8_LDB(B1, 0, 1); PG8_STAGE(PG8_SB(0, 0), b2, voffB);
            PG8_BAR; PG8_WAIT_L(0); PG8_MMA(0, 1, At, B1); PG8_BAR;
            PG8_LDA(At, 0, 1); PG8_STAGE(PG8_SA(0, 0), a2, voffA);
            PG8_BAR; PG8_WAIT_L(0); PG8_MMA(1, 0, At, B0); PG8_BAR; PG8_SCHED;
            PG8_STAGE(PG8_SB(0, 1), b2 + hstep, voffB);
            PG8_WAIT_V(6); PG8_BAR; PG8_MMA(1, 1, At, B1); PG8_BAR;
            PG8_LDB(B0, 1, 0); PG8_SCHED; PG8_LDA(At, 1, 0); PG8_STAGE(PG8_SA(0, 1), a2 + hstep, voffA);
            PG8_WAIT_L(8); PG8_BAR; PG8_WAIT_L(0); PG8_MMA(0, 0, At, B0); PG8_BAR; PG8_SCHED;
            PG8_LDB(B1, 1, 1); PG8_STAGE(PG8_SB(1, 0), b3, voffB);
            PG8_BAR; PG8_WAIT_L(0); PG8_MMA(0, 1, At, B1); PG8_BAR;
            PG8_LDA(At, 1, 1); PG8_STAGE(PG8_SA(1, 0), a3, voffA);
            PG8_BAR; PG8_WAIT_L(0); PG8_MMA(1, 0, At, B0); PG8_BAR; PG8_SCHED;
            PG8_STAGE(PG8_SB(1, 1), b3 + hstep, voffB);
            PG8_WAIT_V(6); PG8_BAR; PG8_MMA(1, 1, At, B1); PG8_BAR;
            }
        }
        if constexpr (ALIGN_EPI) { if (wr == 0) PG8_BAR; }
        if constexpr (!Epi::AFTER_DRAIN) { E(acc, cur, wr, wc, fr, fq); S.done(cur); }
        if (!has_next) break;
#pragma unroll
        for (int a = 0; a < 2; ++a)
#pragma unroll
            for (int b = 0; b < 2; ++b)
#pragma unroll
                for (int m = 0; m < 4; ++m)
#pragma unroll
                    for (int n = 0; n < 2; ++n) acc[a][b][m][n] = (f32x4){0.f, 0.f, 0.f, 0.f};
        cur = nxt; cA = nA; cB = nB; ++ui;
        if constexpr (ALIGN_EPI) { if (wr == 1) PG8_BAR; }
    }
    PG8_WAIT_V(0);
    if constexpr (!ALIGN_EPI) { if (wr == 0) PG8_BAR; }
    PG8_BAR;
    if constexpr (Epi::AFTER_DRAIN) { E.fused(acc, cur, wr, wc, fr, fq, lds, wid, lane); S.done(cur); }
#undef PG8_SA
#undef PG8_SB
#undef PG8_STAGE
#undef PG8_LDA
#undef PG8_LDB
#undef PG8_MMA
#undef PG8_WAIT_V
#undef PG8_WAIT_L
#undef PG8_BAR
#undef PG8_SCHED
}
}

struct Ctx {
    unsigned aoff; int l;
    unsigned char* ws;
    DI float* X() const { return GP(float, ws + WS_X); }
    DI bf16_t* H() const { return GP(bf16_t, ws + WS_H); }
    DI bf16_t* P() const { return GP(bf16_t, ws + WS_P); }
    DI bf16_t* QP() const { return GP(bf16_t, ws + WS_P); }
    DI bf16_t* MIX() const { return GP(bf16_t, ws + WS_MIX); }
    DI float* OF() const { return GP(float, ws + WS_OF); }
    DI float* OB() const { return GP(float, ws + WS_OB); }
    DI int* PIDX() const { return GP(int, ws + WS_PIDX); }
    DI float* PG() const { return GP(float, ws + WS_PG); }
    DI float* MOD() const { return GP(float, ws + WS_MOD); }
    DI float* LB() const { return GP(float, ws + WS_LB); }
    DI float* ROPE() const { return GP(float, ws + WS_ROPE); }
    DI bf16_t* WIN() const { return GP(bf16_t, ws + WS_WIN); }
    DI bf16_t* WOUT() const { return GP(bf16_t, ws + WS_WOUT); }
    DI bf16_t* WQ() const { return GP(bf16_t, ws + WS_WQ); }
    DI bf16_t* UB() const { return GP(bf16_t, ws + WS_UB); }
    DI float* ST() const { return GP(float, ws + WS_OF); }
    DI float* AC() const { return GP(float, ws + WS_AC); }
    DI float* PA() const { return GP(float, ws + WS_PA); }
    DI float* VS() const { return GP(float, ws + WS_VS); }
    DI float* US() const { return GP(float, ws + WS_US); }
    DI bf16_t* SKH() const { return GP(bf16_t, ws + WS_SKH); }
    DI bf16_t* SKL() const { return GP(bf16_t, ws + WS_SKL); }
    DI bf16_t* VB() const { return GP(bf16_t, ws + WS_VB); }
    DI unsigned char* H8() const { return GP(unsigned char, ws + WS_H8); }
    DI float* HS() const { return GP(float, ws + WS_HS); }
    unsigned char* lds; int tid, lane, wave, gw, ngw, bid, nb;
    int xg, nxg, jx, nloc;
};

#define LAS __attribute__((address_space(3)))
DI void transpose_item(const float* W, int Kd, int N, bf16_t* WT, LAS float* scr, int item, int lane) {
    const int nblk = N / 32, kb = item / nblk, nb = item % nblk, k0 = 64 * kb, n0 = 32 * nb;
#pragma unroll 8
    for (int i = 0; i < 32; ++i) { const int kk = 2 * i + (lane >> 5); scr[kk * 33 + (lane & 31)] = W[(size_t)(k0 + kk) * N + n0 + (lane & 31)]; }
    asm volatile("s_waitcnt lgkmcnt(0)" ::: "memory");
    const int c = lane & 7;
#pragma unroll
    for (int j = 0; j < 4; ++j) { const int n = (lane >> 3) + 8 * j; const LAS float* sp = scr + (8 * c) * 33 + n;
        u32x4 o; o.x = pk2(sp[0 * 33], sp[1 * 33]); o.y = pk2(sp[2 * 33], sp[3 * 33]); o.z = pk2(sp[4 * 33], sp[5 * 33]); o.w = pk2(sp[6 * 33], sp[7 * 33]);
        *(u32x4*)(WT + (size_t)(n0 + n) * Kd + k0 + 8 * c) = o; }
    asm volatile("s_waitcnt lgkmcnt(0)" ::: "memory");
}

template <class T> DI T* argp_(const Ctx& K, unsigned off) {
    const unsigned* p = (const unsigned*)(K.lds + K.aoff + off);
    const unsigned lo = __builtin_amdgcn_readfirstlane(p[0]), hi = __builtin_amdgcn_readfirstlane(p[1]);
    return GP(T, ((unsigned long long)hi << 32) | (unsigned long long)lo);
}
#define ARG(f) argp_<const float>(K, (unsigned)__builtin_offsetof(Args, f))

DI void ph_prologue(Ctx& K) {
    {
        LAS float* scr = (LAS float*)((LAS unsigned char*)K.lds + K.wave * 16384);
        constexpr int I_IN = (D / 64) * (PW / 32), I_OUT = (D / 64) * (D / 32), I_Q = (D / 64) * (2048 / 32), I_L = I_IN + I_OUT + I_Q;
        for (int it = K.gw; it < DEPTH * I_L; it += K.ngw) {
            const int l = it / I_L; int r = it % I_L;
            if (r < I_IN) { transpose_item(ARG(w_in) + (size_t)l * D * PW, D, PW, K.WIN() + (size_t)l * PW * D, scr, r, K.lane); continue; } r -= I_IN;
            if (r < I_OUT) { transpose_item(ARG(w_out) + (size_t)l * D * D, D, D, K.WOUT() + (size_t)l * D * D, scr, r, K.lane); continue; } r -= I_OUT;
            transpose_item(ARG(peer_wq) + (size_t)l * D * 2048, D, 2048, K.WQ() + (size_t)l * 2048 * D, scr, r, K.lane);
        }
    }
    const size_t gt = (size_t)K.bid * NTHREADS + K.tid, gs = (size_t)K.nb * NTHREADS;
    { const f32x4* s0 = (const f32x4*)ARG(ctx); const f32x4* s1 = (const f32x4*)ARG(x); f32x4* d = (f32x4*)K.X();
      const size_t n0 = (size_t)NCTX * D / 4, n1 = (size_t)NLAT * D / 4;
      for (size_t i = gt; i < n0 + n1; i += gs) d[i] = i < n0 ? s0[i] : s1[i - n0]; }
    { const float* sk = ARG(peer_sk);
      for (size_t i = gt; i < (size_t)DEPTH * 8 * 2 * 128 * 128; i += gs) { const float v = sk[i]; const bf16_t hi = f2bf(v);
          const size_t lhp = i >> 14; const int key = (int)(i >> 7) & 127, d = (int)i & 127;
          const size_t o = (((lhp * 8 + (key >> 4)) * 4 + (d >> 5)) * 64 + (key & 15) + 16 * ((d >> 3) & 3)) * 8 + (d & 7);
          K.SKH()[o] = hi; K.SKL()[o] = f2bf(v - bf2f(hi)); } }
    { const float* pu = ARG(peer_u); unsigned char* UQ = (unsigned char*)K.UB();
      for (int row0 = K.gw; row0 < DEPTH * 16384; row0 += 2 * K.ngw) {
          f32x4 v2[2][4];
#pragma unroll
          for (int t = 0; t < 2; ++t) { const int row = min(row0 + t * K.ngw, DEPTH * 16384 - 1); const f32x4* src = (const f32x4*)(pu + (size_t)row * D);
#pragma unroll
              for (int j = 0; j < 4; ++j) v2[t][j] = src[j * 64 + K.lane]; }
#pragma unroll
          for (int t = 0; t < 2; ++t) { const int row = row0 + t * K.ngw; if (row >= DEPTH * 16384) break;
              float mx = 0.f;
#pragma unroll
              for (int j = 0; j < 4; ++j) mx = fmaxf(mx, fmaxf(fmaxf(fabsf(v2[t][j].x), fabsf(v2[t][j].y)), fmaxf(fabsf(v2[t][j].z), fabsf(v2[t][j].w))));
#pragma unroll
              for (int o = 1; o < 64; o <<= 1) mx = fmaxf(mx, __shfl_xor(mx, o));
              const float sc = fmaxf(mx, 1e-30f) * (1.0f / 127.0f), inv = 1.0f / sc;
              if (K.lane == 0) K.US()[row] = sc;
#pragma unroll
              for (int j = 0; j < 4; ++j) { const int col = j * 256 + K.lane * 4; const f32x4 v = v2[t][j];
                  const unsigned q0 = (unsigned)((int)rintf(v.x * inv)) & 0xffu, q1 = (unsigned)((int)rintf(v.y * inv)) & 0xffu, q2 = (unsigned)((int)rintf(v.z * inv)) & 0xffu, q3 = (unsigned)((int)rintf(v.w * inv)) & 0xffu;
                  *(unsigned*)(UQ + (size_t)row * D + col) = q0 | (q1 << 8) | (q2 << 16) | (q3 << 24); } } } }
    { const float* pv = ARG(peer_v); unsigned char* VQ = (unsigned char*)K.VB();
      for (int row0 = K.gw; row0 < DEPTH * 16384; row0 += 2 * K.ngw) {
          f32x4 v2[2][4];
#pragma unroll
          for (int t = 0; t < 2; ++t) { const int row = min(row0 + t * K.ngw, DEPTH * 16384 - 1); const f32x4* src = (const f32x4*)(pv + (size_t)row * D);
#pragma unroll
              for (int j = 0; j < 4; ++j) v2[t][j] = src[j * 64 + K.lane]; }
#pragma unroll
          for (int t = 0; t < 2; ++t) { const int row = row0 + t * K.ngw; if (row >= DEPTH * 16384) break;
              float mx = 0.f;
#pragma unroll
              for (int j = 0; j < 4; ++j) mx = fmaxf(mx, fmaxf(fmaxf(fabsf(v2[t][j].x), fabsf(v2[t][j].y)), fmaxf(fabsf(v2[t][j].z), fabsf(v2[t][j].w))));
#pragma unroll
              for (int o = 1; o < 64; o <<= 1) mx = fmaxf(mx, __shfl_xor(mx, o));
              const float sc = fmaxf(mx, 1e-30f) * (1.0f / 127.0f), inv = 1.0f / sc;
              if (K.lane == 0) K.VS()[row] = sc;
              const int l = row >> 14, e = row & 16383;
#pragma unroll
              for (int j = 0; j < 4; ++j) { const int col = j * 256 + K.lane * 4; const f32x4 v = v2[t][j];
                  const unsigned q0 = (unsigned)((int)rintf(v.x * inv) + 128), q1 = (unsigned)((int)rintf(v.y * inv) + 128), q2 = (unsigned)((int)rintf(v.z * inv) + 128), q3 = (unsigned)((int)rintf(v.w * inv) + 128);
                  *(unsigned*)(VQ + (((size_t)l * 8 + (col >> 7)) * 16384 + e) * 128 + (col & 127)) = q0 | (q1 << 8) | (q2 << 16) | (q3 << 24); } } } }
    { float* sv = (float*)K.lds;
      float* part = sv + 3 * D;
      __syncthreads();
      for (int i = K.tid; i < 3 * D; i += NTHREADS) { const int v = i / D, k = i % D; const float c = v < 2 ? ARG(c)[v * D + k] : ARG(c_ctx)[k]; sv[i] = c * sigmoidf_(c); }
      __syncthreads();
      for (int item = K.bid; item < DEPTH * 24; item += K.nb) {
          const int l = item / 24, cb = item % 24;
          const float* w = ARG(w_mod) + (size_t)l * D * 6 * D + cb * 256 + K.lane * 4;
          f32x4 a0 = {0.f, 0.f, 0.f, 0.f}, a1 = a0, a2 = a0;
#pragma unroll 8
          for (int kk = 0; kk < 128; ++kk) { const int k = K.wave * 128 + kk; const f32x4 wv = *(const f32x4*)(w + (size_t)k * 6 * D);
              a0 += wv * sv[k]; a1 += wv * sv[D + k]; a2 += wv * sv[2 * D + k]; }
          *(f32x4*)(part + (K.wave * 3 + 0) * 256 + K.lane * 4) = a0; *(f32x4*)(part + (K.wave * 3 + 1) * 256 + K.lane * 4) = a1; *(f32x4*)(part + (K.wave * 3 + 2) * 256 + K.lane * 4) = a2;
          __syncthreads();
          for (int i = K.tid; i < 768; i += NTHREADS) { const int v = i / 256, cc = i % 256; float sum = 0.f;
#pragma unroll
              for (int w8 = 0; w8 < 8; ++w8) sum += part[(w8 * 3 + v) * 256 + cc];
              const int col = cb * 256 + cc; K.MOD()[((size_t)l * 3 + v) * 6 * D + col] = sum + ARG(b_mod)[(size_t)l * 6 * D + col]; }
          __syncthreads();
      } }
    for (size_t i = gt; i < 2 * 256; i += gs) {
        const int dir = (int)(i / 256), ch = (int)(i % 256);
        float lg[DEPTH], mx = -1e30f;
#pragma unroll
        for (int l = 0; l < DEPTH; ++l) { lg[l] = ARG(lb_logits)[((size_t)dir * DEPTH + l) * 256 + ch]; mx = fmaxf(mx, lg[l]); }
        float s = 0.f;
#pragma unroll
        for (int l = 0; l < DEPTH; ++l) { lg[l] = expf(lg[l] - mx); s += lg[l]; }
        float cum = 0.f;
#pragma unroll
        for (int l = 0; l < DEPTH; ++l) { if (l > 0) cum += lg[l] / s; K.LB()[((size_t)dir * DEPTH + l) * 256 + ch] = cum; }
    }
    for (size_t i = gt; i < (256 + 64) * 16; i += gs) {
        const int pos = (int)(i / 16), f = (int)(i % 16);
        const float inv = powf(10000.0f, -(float)f / 16.0f);
        if (pos < 256) { const float ang = (float)pos * inv; K.ROPE()[pos * 16 + f] = cosf(ang); K.ROPE()[4096 + pos * 16 + f] = sinf(ang); }
        else { const int pc = pos - 256; const float ang = (float)pc * inv; K.ROPE()[8192 + pc * 16 + f] = cosf(ang); K.ROPE()[8192 + 1024 + pc * 16 + f] = sinf(ang); }
    }
}

DI void ph_norm(Ctx& K, const float* nw, int shift_chunk) {
    const float* modl = K.MOD() + (size_t)K.l * 3 * 6 * D;
    for (int r = K.gw; r < M; r += K.ngw) {
        const f32x4* xr = (const f32x4*)(K.X() + (size_t)r * D);
        f32x4 v[4]; float ss = 0.f;
#pragma unroll
        for (int j = 0; j < 4; ++j) { v[j] = xr[j * 64 + K.lane]; ss += v[j].x * v[j].x + v[j].y * v[j].y + v[j].z * v[j].z + v[j].w * v[j].w; }
        ss = wave_sum(ss);
        const float rs = rsqrtf(ss * (1.0f / D) + EPS);
        const float* mv = modl + (size_t)modvec_of_row(r) * 6 * D;
        u32x2* ho = (u32x2*)(K.H() + (size_t)r * D);
#pragma unroll
        for (int j = 0; j < 4; ++j) {
            const int c4 = j * 64 + K.lane;
            const f32x4 w = ((const f32x4*)nw)[c4], sh = ((const f32x4*)(mv + shift_chunk * D))[c4], sc = ((const f32x4*)(mv + (shift_chunk + 1) * D))[c4];
            f32x4 y; y.x = v[j].x * rs * w.x * (1.f + sc.x) + sh.x; y.y = v[j].y * rs * w.y * (1.f + sc.y) + sh.y; y.z = v[j].z * rs * w.z * (1.f + sc.z) + sh.z; y.w = v[j].w * rs * w.w * (1.f + sc.w) + sh.w;
            u32x2 o; o.x = pk2(y.x, y.y); o.y = pk2(y.z, y.w); ho[c4] = o;
            if (shift_chunk == 3) { v[j].x = __uint_as_float(o.x << 16); v[j].y = __uint_as_float(o.x & 0xffff0000u); v[j].z = __uint_as_float(o.y << 16); v[j].w = __uint_as_float(o.y & 0xffff0000u); }
        }
        if (shift_chunk == 3) {
            float mx = 0.f;
#pragma unroll
            for (int j = 0; j < 4; ++j) mx = fmaxf(mx, fmaxf(fmaxf(fabsf(v[j].x), fabsf(v[j].y)), fmaxf(fabsf(v[j].z), fabsf(v[j].w))));
#pragma unroll
            for (int o = 1; o < 64; o <<= 1) mx = fmaxf(mx, __shfl_xor(mx, o));
            const float sc = fmaxf(mx, 1e-30f) * (1.0f / 127.0f), inv = 1.0f / sc;
            if (K.lane == 0) K.HS()[r] = sc;
#pragma unroll
            for (int j = 0; j < 4; ++j) { const unsigned q0 = (unsigned)((int)rintf(v[j].x * inv)) & 0xffu, q1 = (unsigned)((int)rintf(v[j].y * inv)) & 0xffu, q2 = (unsigned)((int)rintf(v[j].z * inv)) & 0xffu, q3 = (unsigned)((int)rintf(v[j].w * inv)) & 0xffu;
                *(unsigned*)(K.H8() + (size_t)r * D + (j * 64 + K.lane) * 4) = q0 | (q1 << 8) | (q2 << 16) | (q3 << 24); }
        }
    }
}

typedef short sg_bf16x8 __attribute__((ext_vector_type(8)));
template <int NT, bool RESID> DI void sg_ctx(Ctx& K, const bf16_t* A, const bf16_t* Bt, bf16_t* out, float* X, const float* gate) {
    constexpr int N = 1024 * NT, RS = 272, OFF_B = 64 * RS, BUF = (64 + 32 * NT) * RS;
    int tid = K.tid; asm volatile("" : "+v"(tid));
    const int lane = tid & 63, wave = __builtin_amdgcn_readfirstlane(tid >> 6), r16 = lane & 15, g4 = lane >> 4, mt = wave & 3, nh = wave >> 2;
    const int lrow = tid >> 4, lc = tid & 15;
    for (int u = K.bid; u < 256; u += K.nb) {
        const int xcd = u & 7, j = u >> 3, ct = xcd * 4 + (j & 3), rt = j >> 2;
        const int row0 = 64 * rt, col0 = 32 * NT * ct;
        const bf16_t* ga = A + (size_t)(row0 + lrow) * D + 8 * lc; const bf16_t* gb = Bt + (size_t)(col0 + lrow) * D + 8 * lc;
        u32x4 ra[3][2], rb[3][NT];
        f32x4 acc[NT];
#pragma unroll
        for (int n = 0; n < NT; ++n) acc[n] = (f32x4){0.f, 0.f, 0.f, 0.f};
#define SG_LOAD(s_, c_) do { ra[s_][0] = *(const u32x4*)(ga + 128 * (c_)); ra[s_][1] = *(const u32x4*)(ga + 32 * D + 128 * (c_)); \
        _Pragma("unroll") for (int i_ = 0; i_ < NT; ++i_) rb[s_][i_] = *(const u32x4*)(gb + (size_t)32 * i_ * D + 128 * (c_)); } while (0)
        SG_LOAD(0, 0); SG_LOAD(1, 1); SG_LOAD(2, 2);
        __syncthreads();
#pragma unroll
        for (int c = 0; c < 8; ++c) {
            unsigned char* buf = K.lds + (c & 1) * BUF;
            *(u32x4*)(buf + lrow * RS + 16 * lc) = ra[c % 3][0]; *(u32x4*)(buf + (lrow + 32) * RS + 16 * lc) = ra[c % 3][1];
#pragma unroll
            for (int i = 0; i < NT; ++i) *(u32x4*)(buf + OFF_B + (lrow + 32 * i) * RS + 16 * lc) = rb[c % 3][i];
            if (c + 3 < 8) SG_LOAD(c % 3, c + 3);
            __syncthreads();
#pragma unroll
            for (int ks = 0; ks < 4; ++ks) {
                const sg_bf16x8 af = *(const sg_bf16x8*)(buf + (16 * mt + r16) * RS + 64 * ks + 16 * g4);
#pragma unroll
                for (int n = 0; n < NT; ++n) { const sg_bf16x8 bf = *(const sg_bf16x8*)(buf + OFF_B + (16 * (NT * nh + n) + r16) * RS + 64 * ks + 16 * g4);
                    acc[n] = __builtin_amdgcn_mfma_f32_16x16x32_bf16(bf, af, acc[n], 0, 0, 0); }
            }
        }
#undef SG_LOAD
        const int row = row0 + 16 * mt + r16;
#pragma unroll
        for (int n = 0; n < NT; ++n) { const int col = col0 + 16 * (NT * nh + n) + 4 * g4;
            if constexpr (RESID) { float* xp = X + (size_t)row * D + col; const f32x4 g = *(const f32x4*)(gate + col); f32x4 x = *(const f32x4*)xp; x += g * acc[n]; *(f32x4*)xp = x; }
            else { u32x2 o; o.x = pk2(acc[n][0], acc[n][1]); o.y = pk2(acc[n][2], acc[n][3]); *(u32x2*)(out + (size_t)row * N + col) = o; } }
        __syncthreads();
    }
}
DI void ph_gemm_store(Ctx& K, const bf16_t* A, const bf16_t* Bt, int N, bf16_t* out, const float* rope) {
    { pg8::Gemm g{A + (size_t)NCTX * D, Bt, NLAT, N, D}; pg8::StaticOrder S; S.init(NLAT, N, K.nb, K.bid);
      pg8::EpiStore E{out, N, (LAS unsigned char*)K.lds, rope, NCTX, L, NCTX};
      pg8::gemm_phase<pg8::EpiStore, pg8::StaticOrder, true, true>((LAS unsigned char*)K.lds, g, S, E); }
    if (N == PW) sg_ctx<3, false>(K, A, Bt, out, nullptr, nullptr); else sg_ctx<2, false>(K, A, Bt, out, nullptr, nullptr);
}
DI void ph_gemm_resid(Ctx& K, const bf16_t* A, const bf16_t* Bt, int chunk) {
    const float* gate = K.MOD() + (size_t)K.l * 3 * 6 * D + (size_t)chunk * D;
    { pg8::Gemm g{A + (size_t)NCTX * D, Bt, NLAT, D, D}; pg8::StaticOrder S; S.init(NLAT, D, K.nb, K.bid);
      pg8::EpiResid E{K.X(), D, gate, 6 * D, NCTX, L, (LAS unsigned char*)K.lds, NCTX};
      pg8::gemm_phase<pg8::EpiResid, pg8::StaticOrder, true, true>((LAS unsigned char*)K.lds, g, S, E); }
    sg_ctx<1, true>(K, A, Bt, nullptr, K.X(), gate + (size_t)2 * 6 * D);
}

DI void ph_rope(Ctx& K) {
    const float* cosr = K.ROPE(); const float* sinr = K.ROPE() + 4096; const float* cosc = K.ROPE() + 8192; const float* sinc = K.ROPE() + 8192 + 1024;
    const size_t gt = (size_t)K.bid * NTHREADS + K.tid, gs = (size_t)K.nb * NTHREADS;
    for (size_t i = gt; i < (size_t)NLAT * 8 * 16; i += gs) {
        const int f = (int)(i & 15), hh = (int)((i >> 4) & 7), lr = (int)(i >> 7);
        const int t = lr % L, pr = t >> 6, pc = t & 63;
        bf16_t* p = K.P() + (size_t)(NCTX + lr) * PW + (hh < 6 ? C_SQ + hh * 64 : C_SK + (hh - 6) * 64);
        const float c1 = cosr[pr * 16 + f], s1 = sinr[pr * 16 + f], c2 = cosc[pc * 16 + f], s2 = sinc[pc * 16 + f];
        const float a = bf2f(p[f]), b = bf2f(p[16 + f]), e = bf2f(p[32 + f]), g = bf2f(p[48 + f]);
        p[f] = f2bf(a * c1 - b * s1); p[16 + f] = f2bf(b * c1 + a * s1); p[32 + f] = f2bf(e * c2 - g * s2); p[48 + f] = f2bf(g * c2 + e * s2);
    }
}

typedef short bf16x8_t __attribute__((ext_vector_type(8)));
#define MFMA16(a, b, c) __builtin_amdgcn_mfma_f32_16x16x32_bf16((a), (b), (c), 0, 0, 0)
constexpr int HG_NCH = (CL + L) / 64;
constexpr int HG_LFS = 68;
constexpr int HG_TS = 72;
constexpr int HGL_LF = 0, HGL_OM = HGL_LF + 2 * 64 * HG_LFS * 4, HGL_VT = HGL_OM + 2 * 64 * HG_LFS * 4, HGL_KT = HGL_VT + 64 * HG_TS * 2, HGL_SC = HGL_KT, HGL_OD = HGL_SC + 8 * 16 * HG_TS * 2, HGL_END = HGL_OD + 2 * 64 * HG_LFS * 4;
static_assert(HGL_KT + 2 * 64 * HG_TS * 2 <= LDS_BYTES && HGL_END <= LDS_BYTES, "hgrn LDS map");
DI int hg_block_row(int b, int tb, int tok) { return tb < 4 ? ctx_row(b, tb * 64 + tok) : lat_row(b, (tb - 4) * 64 + tok); }
DI int hg_bwd_chunk(int tb) { return tb < 4 ? 3 - tb : 4 + 255 - (tb - 4); }
DI void hg_prep(Ctx& K, int b, int h, int tb) {
    float* LF = (float*)(K.lds + HGL_LF); float* OM = (float*)(K.lds + HGL_OM); bf16_t* VT = (bf16_t*)(K.lds + HGL_VT);
    const int tok = K.tid >> 3, c = K.tid & 7;
    const bf16_t* pr = K.P() + (size_t)hg_block_row(b, tb, tok) * PW + h * 64 + 8 * c;
#pragma unroll
    for (int dir = 0; dir < 2; ++dir) {
        float z[8]; unpack8(*(const u32x4*)(pr + (dir ? C_ZB : C_ZF)), z);
        const float* lb = K.LB() + ((size_t)dir * DEPTH + K.l) * 256 + h * 64 + 8 * c;
        float lf[8], om[8];
#pragma unroll
        for (int j = 0; j < 8; ++j) { const float lbv = lb[j], sg = sigmoidf_(z[j]); const float f = fmaxf(lbv + (1.f - lbv) * sg, 1e-30f); lf[j] = __logf(f); om[j] = (1.f - lbv) * (1.f - sg); }
        float* lfp = LF + (dir * 64 + tok) * HG_LFS + 8 * c; float* omp = OM + (dir * 64 + tok) * HG_LFS + 8 * c;
        *(f32x4*)lfp = (f32x4){lf[0], lf[1], lf[2], lf[3]}; *(f32x4*)(lfp + 4) = (f32x4){lf[4], lf[5], lf[6], lf[7]};
        *(f32x4*)omp = (f32x4){om[0], om[1], om[2], om[3]}; *(f32x4*)(omp + 4) = (f32x4){om[4], om[5], om[6], om[7]};
    }
    { const u32x4 v = *(const u32x4*)(pr + C_HV);
      const unsigned w[4] = {v.x, v.y, v.z, v.w};
#pragma unroll
      for (int j = 0; j < 4; ++j) { VT[(8 * c + 2 * j) * HG_TS + tok] = (bf16_t)(w[j] & 0xffffu); VT[(8 * c + 2 * j + 1) * HG_TS + tok] = (bf16_t)(w[j] >> 16); } }
    __syncthreads();
    if (K.tid < 128) {
        const int dir = K.tid >> 6, d = K.tid & 63; float* col = LF + dir * 64 * HG_LFS + d;
        float v[64];
#pragma unroll
        for (int p = 0; p < 64; ++p) v[p] = col[(dir ? 63 - p : p) * HG_LFS];
#pragma unroll
        for (int p = 1; p < 64; ++p) v[p] += v[p - 1];
#pragma unroll
        for (int p = 0; p < 64; ++p) col[(dir ? 63 - p : p) * HG_LFS] = v[p];
    }
    __syncthreads();
}
DI void ph_hgrn_A(Ctx& K) {
    float* LF = (float*)(K.lds + HGL_LF); float* OM = (float*)(K.lds + HGL_OM); bf16_t* VT = (bf16_t*)(K.lds + HGL_VT); bf16_t* KT = (bf16_t*)(K.lds + HGL_KT);
    const int r16 = K.lane & 15, g4 = K.lane >> 4;
    for (int item = K.bid; item < NB * 4 * HG_NCH; item += K.nb) {
        const int tb = item % HG_NCH, h = (item / HG_NCH) & 3, b = item / (HG_NCH * 4);
        __syncthreads();
        hg_prep(K, b, h, tb);
        { const int tok = K.tid >> 3, c = K.tid & 7;
#pragma unroll
          for (int dir = 0; dir < 2; ++dir) {
              const float* bl = LF + (dir * 64 + (dir ? 0 : 63)) * HG_LFS + 8 * c; const float* bt = LF + (dir * 64 + tok) * HG_LFS + 8 * c; const float* om = OM + (dir * 64 + tok) * HG_LFS + 8 * c;
#pragma unroll
              for (int j = 0; j < 8; ++j) KT[(dir * 64 + 8 * c + j) * HG_TS + tok] = f2bf(om[j] * __expf(bl[j] - bt[j]));
          }
          if (K.tid < 128) { const int dir = K.tid >> 6, d = K.tid & 63; const int chain = (b * 2 + dir) * 4 + h, ch = dir ? hg_bwd_chunk(tb) : tb;
              K.AC()[((size_t)chain * HG_NCH + ch) * 64 + d] = __expf(LF[(dir * 64 + (dir ? 0 : 63)) * HG_LFS + d]); } }
        __syncthreads();
        { const int dir = K.wave >> 2, mi = K.wave & 3; const int chain = (b * 2 + dir) * 4 + h, ch = dir ? hg_bwd_chunk(tb) : tb;
          f32x4 acc[4];
#pragma unroll
          for (int nj = 0; nj < 4; ++nj) acc[nj] = (f32x4){0.f, 0.f, 0.f, 0.f};
#pragma unroll
          for (int ks = 0; ks < 2; ++ks) {
              const bf16x8_t av = *(const bf16x8_t*)(VT + (16 * mi + r16) * HG_TS + 32 * ks + 8 * g4);
#pragma unroll
              for (int nj = 0; nj < 4; ++nj) { const bf16x8_t bv = *(const bf16x8_t*)(KT + (dir * 64 + 16 * nj + r16) * HG_TS + 32 * ks + 8 * g4); acc[nj] = MFMA16(av, bv, acc[nj]); }
          }
          float* st = K.ST() + ((size_t)chain * HG_NCH + ch) * 4096;
#pragma unroll
          for (int nj = 0; nj < 4; ++nj)
#pragma unroll
              for (int rg = 0; rg < 4; ++rg) st[(16 * mi + 4 * g4 + rg) * 64 + 16 * nj + r16] = acc[nj][rg];
        }
    }
}
DI void ph_hgrn_B(Ctx& K) {
    const int gt = K.bid * NTHREADS + K.tid;
    if (gt < 16 * 4096) {
        const int chain = gt >> 12, idx = gt & 4095, d = idx & 63;
        float* st = K.ST() + (size_t)chain * HG_NCH * 4096 + idx; const float* ac = K.AC() + (size_t)chain * HG_NCH * 64 + d;
        float S = 0.f;
#pragma unroll 1
        for (int c0 = 0; c0 < HG_NCH; c0 += 26) {
            float u[26], a[26];
#pragma unroll
            for (int i = 0; i < 26; ++i) { u[i] = st[(size_t)(c0 + i) * 4096]; a[i] = ac[(c0 + i) * 64]; }
#pragma unroll
            for (int i = 0; i < 26; ++i) { st[(size_t)(c0 + i) * 4096] = S; S = a[i] * S + u[i]; }
        }
    }
}
DI void ph_hgrn_C(Ctx& K) {
    float* LF = (float*)(K.lds + HGL_LF); float* OM = (float*)(K.lds + HGL_OM); bf16_t* VT = (bf16_t*)(K.lds + HGL_VT); float* OD = (float*)(K.lds + HGL_OD);
    bf16_t* SC = (bf16_t*)(K.lds + HGL_SC) + K.wave * 16 * HG_TS;
    const int r16 = K.lane & 15, g4 = K.lane >> 4;
    for (int item = K.bid; item < NB * 4 * HG_NCH; item += K.nb) {
        const int tb = item % HG_NCH, h = (item / HG_NCH) & 3, b = item / (HG_NCH * 4);
        __syncthreads();
        hg_prep(K, b, h, tb);
        { const int dir = K.wave >> 2, mi = K.wave & 3; const int chain = (b * 2 + dir) * 4 + h, ch = dir ? hg_bwd_chunk(tb) : tb;
          const float* LFd = LF + dir * 64 * HG_LFS; const float* OMd = OM + dir * 64 * HG_LFS; const float* ref = LFd + 32 * HG_LFS;
          bf16x8_t aq1[2], aq2[2];
          { const int t = 16 * mi + r16; const bf16_t* qr = K.P() + (size_t)hg_block_row(b, tb, t) * PW + C_HQ + h * 64;
#pragma unroll
            for (int ks = 0; ks < 2; ++ks) { const int d0 = 32 * ks + 8 * g4; float q[8]; unpack8(*(const u32x4*)(qr + d0), q);
                u32x4 w1, w2; unsigned o1[4], o2[4];
#pragma unroll
                for (int j = 0; j < 4; ++j) { float x1[2], x2[2];
#pragma unroll
                    for (int e = 0; e < 2; ++e) { const int dd = d0 + 2 * j + e; const float qs = q[2 * j + e] * sigmoidf_(q[2 * j + e]); const float bt = LFd[t * HG_LFS + dd]; x1[e] = qs * __expf(bt - ref[dd]); x2[e] = qs * __expf(bt); }
                    o1[j] = pk2(x1[0], x1[1]); o2[j] = pk2(x2[0], x2[1]); }
                w1 = (u32x4){o1[0], o1[1], o1[2], o1[3]}; w2 = (u32x4){o2[0], o2[1], o2[2], o2[3]};
                aq1[ks] = __builtin_bit_cast(bf16x8_t, w1); aq2[ks] = __builtin_bit_cast(bf16x8_t, w2); } }
          f32x4 sc[4];
#pragma unroll
          for (int nj = 0; nj < 4; ++nj) { sc[nj] = (f32x4){0.f, 0.f, 0.f, 0.f}; const int s_ = 16 * nj + r16;
#pragma unroll
              for (int ks = 0; ks < 2; ++ks) { const int d0 = 32 * ks + 8 * g4; unsigned o[4];
#pragma unroll
                  for (int j = 0; j < 4; ++j) { const int dd = d0 + 2 * j; o[j] = pk2(OMd[s_ * HG_LFS + dd] * __expf(ref[dd] - LFd[s_ * HG_LFS + dd]), OMd[s_ * HG_LFS + dd + 1] * __expf(ref[dd + 1] - LFd[s_ * HG_LFS + dd + 1])); }
                  const u32x4 w = (u32x4){o[0], o[1], o[2], o[3]};
                  sc[nj] = MFMA16(aq1[ks], __builtin_bit_cast(bf16x8_t, w), sc[nj]); } }
#pragma unroll
          for (int nj = 0; nj < 4; ++nj)
#pragma unroll
              for (int rg = 0; rg < 4; ++rg) { const int tl = 4 * g4 + rg, t = 16 * mi + tl, s_ = 16 * nj + r16; const bool keep = dir ? (s_ >= t) : (s_ <= t);
                  SC[tl * HG_TS + s_] = f2bf(keep ? sc[nj][rg] : 0.f); }
          asm volatile("s_waitcnt lgkmcnt(0)" ::: "memory");
          f32x4 oacc[4];
#pragma unroll
          for (int nj = 0; nj < 4; ++nj) oacc[nj] = (f32x4){0.f, 0.f, 0.f, 0.f};
          const float* st = K.ST() + ((size_t)chain * HG_NCH + ch) * 4096;
#pragma unroll
          for (int ks = 0; ks < 2; ++ks) {
              const bf16x8_t as = *(const bf16x8_t*)(SC + r16 * HG_TS + 32 * ks + 8 * g4);
#pragma unroll
              for (int nj = 0; nj < 4; ++nj) {
                  const bf16x8_t bv = *(const bf16x8_t*)(VT + (16 * nj + r16) * HG_TS + 32 * ks + 8 * g4);
                  oacc[nj] = MFMA16(as, bv, oacc[nj]);
                  const float* sp = st + (16 * nj + r16) * 64 + 32 * ks + 8 * g4; const f32x4 s0 = *(const f32x4*)sp, s1 = *(const f32x4*)(sp + 4);
                  const u32x4 w = (u32x4){pk2(s0.x, s0.y), pk2(s0.z, s0.w), pk2(s1.x, s1.y), pk2(s1.z, s1.w)};
                  oacc[nj] = MFMA16(aq2[ks], __builtin_bit_cast(bf16x8_t, w), oacc[nj]);
              }
          }
#pragma unroll
          for (int nj = 0; nj < 4; ++nj)
#pragma unroll
              for (int rg = 0; rg < 4; ++rg) OD[(dir * 64 + 16 * mi + 4 * g4 + rg) * HG_LFS + 16 * nj + r16] = oacc[nj][rg];
        }
        __syncthreads();
        { const int tok = K.tid >> 3, c = K.tid & 7; const int row = hg_block_row(b, tb, tok);
          const float* o0 = OD + tok * HG_LFS + 8 * c; const float* o1 = OD + (64 + tok) * HG_LFS + 8 * c;
          float o[8], ss = 0.f;
#pragma unroll
          for (int j = 0; j < 8; ++j) { o[j] = o0[j] + o1[j]; ss += o[j] * o[j]; }
          ss += __shfl_xor(ss, 1); ss += __shfl_xor(ss, 2); ss += __shfl_xor(ss, 4);
          const float rs = rsqrtf(ss * (1.0f / 64.0f) + EPS);
          float gq[8]; unpack8(*(const u32x4*)(K.P() + (size_t)row * PW + C_HG + h * 64 + 8 * c), gq);
          const float* nw = ARG(hgrn_norm_w) + (size_t)K.l * 256 + h * 64 + 8 * c;
          float y[8];
#pragma unroll
          for (int j = 0; j < 8; ++j) y[j] = o[j] * rs * nw[j] * gq[j] * sigmoidf_(gq[j]);
          u32x4 w; w.x = pk2(y[0], y[1]); w.y = pk2(y[2], y[3]); w.z = pk2(y[4], y[5]); w.w = pk2(y[6], y[7]);
          *(u32x4*)(K.MIX() + (size_t)row * D + MX_H + h * 64 + 8 * c) = w; }
    }
}

constexpr int AT_TS = 72;
constexpr int ATL_K = 0, ATL_V = ATL_K + 64 * AT_TS * 2, ATL_P = ATL_V + 64 * AT_TS * 2, ATL_END = ATL_P + 8 * 48 * AT_TS * 2;
static_assert(ATL_END <= LDS_BYTES - 256, "attention LDS map");
DI float dpp_max16(float x) { x = fmaxf(x, dpp_<0xB1>(x)); x = fmaxf(x, dpp_<0x4E>(x)); x = fmaxf(x, dpp_<0x141>(x)); x = fmaxf(x, dpp_<0x128>(x)); return x; }
DI float dpp_sum16(float x) { x += dpp_<0xB1>(x); x += dpp_<0x4E>(x); x += dpp_<0x141>(x); x += dpp_<0x128>(x); return x; }
template <int KIND> DI void attn_item(Ctx& K, int idx, const float* sinkp, const float* rpbp) {
    constexpr int MT = KIND == 0 ? 3 : 2;
    int tid_ = K.tid; asm volatile("" : "+v"(tid_));
    const int lane_ = tid_ & 63, wave_ = tid_ >> 6;
    bf16_t* KT = (bf16_t*)(K.lds + ATL_K); bf16_t* VT = (bf16_t*)(K.lds + ATL_V); bf16_t* PS = (bf16_t*)(K.lds + ATL_P) + wave_ * 48 * AT_TS;
    const int r16 = lane_ & 15, g4 = lane_ >> 4;
    int b, hk, qb = 0;
    if (KIND == 0) { qb = idx & 127; hk = (idx >> 7) & 1; b = idx >> 8; }
    else if (KIND == 1) { qb = idx & 63; hk = (idx >> 6) % 6; b = (idx >> 6) / 6; }
    else { hk = idx % 6; b = idx / 6; }
    const int kcol = (KIND == 0) ? C_SK + hk * 64 : (KIND == 2) ? C_SK + (hk / 3) * 64 : C_NK + hk * 64;
    const int vcol = (KIND == 0) ? C_SV + hk * 64 : (KIND == 2) ? C_SV + (hk / 3) * 64 : C_NV + hk * 64;
    int t0 = 0, nloc = 0;
    if (KIND == 0) { const int k0 = max(2 * qb - 2, 0), k1 = min(2 * qb + 3, L / 64 - 1); t0 = k0; nloc = k1 - k0 + 1; }
    if (KIND == 1) { const int k0 = min(max(4 * qb - 4, 0), L / 64 - 8), k1 = min(max(4 * qb + 3 - 4, 0), L / 64 - 8) + 7; t0 = k0; nloc = k1 - k0 + 1; }
    const int ntiles = nloc + CL / 64;
    int w_r = 0, w_rs = 0;
    if (KIND == 1) { w_r = 4 * qb + (wave_ >> 1); w_rs = min(max(w_r - 4, 0), L / 64 - 8); }
    bf16x8_t qf[MT][2]; int qbase[MT], hq_mt[MT];
#pragma unroll
    for (int mt = 0; mt < MT; ++mt) {
        int arow, hq;
        if (KIND == 0) { const int rho = wave_ * 48 + mt * 16; hq = hk * 3 + rho / 128; hq_mt[mt] = hq; const int tb = 128 * qb + (rho & 127); arow = lat_row(b, tb + r16); qbase[mt] = tb; }
        else if (KIND == 1) { hq = hk; hq_mt[mt] = hq; const int cb = 32 * (wave_ & 1) + 16 * mt; arow = lat_row(b, w_r * 64 + cb + r16); qbase[mt] = cb; }
        else { hq = hk; hq_mt[mt] = hq; const int tb = wave_ * 32 + mt * 16; arow = ctx_row(b, tb + r16); qbase[mt] = 0; }
        const int qcol = (KIND == 0 || KIND == 2) ? C_SQ + hq * 64 : C_NQ + hq * 64;
#pragma unroll
        for (int ks = 0; ks < 2; ++ks) { float q[8]; unpack8(*(const u32x4*)(K.P() + (size_t)arow * PW + qcol + 32 * ks + 8 * g4), q);
            const u32x4 w = (u32x4){pk2(q[0] * 0.125f, q[1] * 0.125f), pk2(q[2] * 0.125f, q[3] * 0.125f), pk2(q[4] * 0.125f, q[5] * 0.125f), pk2(q[6] * 0.125f, q[7] * 0.125f)};
            qf[mt][ks] = __builtin_bit_cast(bf16x8_t, w); }
    }
    f32x4 oacc[MT][4]; float mrun[MT][4], lrun[MT][4];
#pragma unroll
    for (int mt = 0; mt < MT; ++mt) {
#pragma unroll
        for (int ne = 0; ne < 4; ++ne) oacc[mt][ne] = (f32x4){0.f, 0.f, 0.f, 0.f};
        const bool has_sink = (KIND == 0 || KIND == 2); const float sk = has_sink ? sinkp[hq_mt[mt]] : -1.0e30f;
#pragma unroll
        for (int rg = 0; rg < 4; ++rg) { mrun[mt][rg] = sk; lrun[mt][rg] = has_sink ? 1.0f : 0.0f; }
    }
    const int lkey = tid_ >> 3, lch = tid_ & 7;
    u32x4 pk_, pv_;
    { const int ti = 0; const int grow = (ti < nloc) ? lat_row(b, (t0 + ti) * 64 + lkey) : ctx_row(b, (ti - nloc) * 64 + lkey);
      const bf16_t* pr = K.P() + (size_t)grow * PW + 8 * lch; pk_ = *(const u32x4*)(pr + kcol); pv_ = *(const u32x4*)(pr + vcol); }
#pragma unroll 1
    for (int ti = 0; ti < ntiles; ++ti) {
        __syncthreads();
        *(u32x4*)(KT + lkey * AT_TS + 8 * lch) = pk_;
        { const unsigned w[4] = {pv_.x, pv_.y, pv_.z, pv_.w};
          const int vsw = (((lkey >> 3) ^ lch) << 3) + (lkey & 7);
#pragma unroll
          for (int j = 0; j < 4; ++j) { VT[(8 * lch + 2 * j) * AT_TS + vsw] = (bf16_t)(w[j] & 0xffffu); VT[(8 * lch + 2 * j + 1) * AT_TS + vsw] = (bf16_t)(w[j] >> 16); } }
        __syncthreads();
        if (ti + 1 < ntiles) { const int tn = ti + 1; const int grow = (tn < nloc) ? lat_row(b, (t0 + tn) * 64 + lkey) : ctx_row(b, (tn - nloc) * 64 + lkey);
            const bf16_t* pr = K.P() + (size_t)grow * PW + 8 * lch; pk_ = *(const u32x4*)(pr + kcol); pv_ = *(const u32x4*)(pr + vcol); }
        const bool local = ti < nloc; const int kunit = t0 + ti;
        bool active = true;
        if (KIND == 0 && local) active = true;
        if (KIND == 1 && local) active = (kunit >= w_rs) && (kunit < w_rs + 8);
        if (active) {
            f32x4 sc[MT][4];
#pragma unroll
            for (int mt = 0; mt < MT; ++mt)
#pragma unroll
                for (int nj = 0; nj < 4; ++nj) sc[mt][nj] = (f32x4){0.f, 0.f, 0.f, 0.f};
#pragma unroll
            for (int nj = 0; nj < 4; ++nj)
#pragma unroll
                for (int ks = 0; ks < 2; ++ks) { const bf16x8_t kf = *(const bf16x8_t*)(KT + (16 * nj + r16) * AT_TS + 32 * ks + 8 * g4);
#pragma unroll
                    for (int mt = 0; mt < MT; ++mt) sc[mt][nj] = MFMA16(qf[mt][ks], kf, sc[mt][nj]); }
            if (local) {
#pragma unroll
                for (int mt = 0; mt < MT; ++mt)
#pragma unroll
                    for (int nj = 0; nj < 4; ++nj)
#pragma unroll
                        for (int rg = 0; rg < 4; ++rg) { const int key = 16 * nj + r16;
                            if (KIND == 0) { const int dl = qbase[mt] + 4 * g4 + rg - (kunit * 64 + key); if (dl > 128 || dl < -128) sc[mt][nj][rg] = -INFINITY; }
                            if (KIND == 1) { const int c = qbase[mt] + 4 * g4 + rg, ws = min(max(c - 8, 0), 48);
                                if (key >= ws && key < ws + 16) sc[mt][nj][rg] += rpbp[(kunit - w_r + 7) * 31 + (key - c + 15)]; else sc[mt][nj][rg] = -INFINITY; } }
            }
#pragma unroll
            for (int mt = 0; mt < MT; ++mt)
#pragma unroll
                for (int rg = 0; rg < 4; ++rg) {
                    float mx = fmaxf(fmaxf(sc[mt][0][rg], sc[mt][1][rg]), fmaxf(sc[mt][2][rg], sc[mt][3][rg]));
                    mx = dpp_max16(mx);
                    const float mn = fmaxf(mrun[mt][rg], mx), alpha = __expf(mrun[mt][rg] - mn); mrun[mt][rg] = mn;
                    float rs_ = 0.f;
#pragma unroll
                    for (int nj = 0; nj < 4; ++nj) { const float pe = __expf(sc[mt][nj][rg] - mn); sc[mt][nj][rg] = pe; rs_ += pe; }
                    rs_ = dpp_sum16(rs_);
                    lrun[mt][rg] = lrun[mt][rg] * alpha + rs_;
#pragma unroll
                    for (int ne = 0; ne < 4; ++ne) oacc[mt][ne][rg] *= alpha;
                }
#pragma unroll
            for (int mt = 0; mt < MT; ++mt)
#pragma unroll
                for (int nj = 0; nj < 4; ++nj)
#pragma unroll
                    for (int rg = 0; rg < 4; ++rg) PS[(16 * mt + 4 * g4 + rg) * AT_TS + 16 * nj + r16] = f2bf(sc[mt][nj][rg]);
            asm volatile("s_waitcnt lgkmcnt(0)" ::: "memory");
#pragma unroll
            for (int ks = 0; ks < 2; ++ks) {
                bf16x8_t pf[MT];
#pragma unroll
                for (int mt = 0; mt < MT; ++mt) pf[mt] = *(const bf16x8_t*)(PS + (16 * mt + r16) * AT_TS + 32 * ks + 8 * g4);
#pragma unroll
                for (int ne = 0; ne < 4; ++ne) { const bf16x8_t vf = *(const bf16x8_t*)(VT + (16 * ne + r16) * AT_TS + (((4 * ks + g4) ^ ((2 * ne + (r16 >> 3)) & 7)) << 3));
#pragma unroll
                    for (int mt = 0; mt < MT; ++mt) oacc[mt][ne] = MFMA16(pf[mt], vf, oacc[mt][ne]); }
            }
            asm volatile("s_waitcnt lgkmcnt(0)" ::: "memory");
        }
    }
#pragma unroll
    for (int mt = 0; mt < MT; ++mt)
#pragma unroll
        for (int rg = 0; rg < 4; ++rg) { const float inv = 1.0f / lrun[mt][rg];
#pragma unroll
            for (int ne = 0; ne < 4; ++ne) PS[(16 * mt + 4 * g4 + rg) * AT_TS + 16 * ne + r16] = f2bf(oacc[mt][ne][rg] * inv); }
    asm volatile("s_waitcnt lgkmcnt(0)" ::: "memory");
#pragma unroll
    for (int mt = 0; mt < MT; ++mt) {
        const int ocol = ((KIND == 0 || KIND == 2) ? MX_S : MX_N) + hq_mt[mt] * 64;
#pragma unroll
        for (int i = 0; i < 2; ++i) { const int rr = (lane_ >> 3) + 8 * i, ch = lane_ & 7;
            const u32x4 v = *(const u32x4*)(PS + (16 * mt + rr) * AT_TS + 8 * ch);
            int grow;
            if (KIND == 0) { const int rho = wave_ * 48 + mt * 16; grow = lat_row(b, 128 * qb + (rho & 127) + rr); }
            else if (KIND == 1) grow = lat_row(b, w_r * 64 + 32 * (wave_ & 1) + 16 * mt + rr);
            else grow = ctx_row(b, wave_ * 32 + mt * 16 + rr);
            *(u32x4*)(K.MIX() + (size_t)grow * D + ocol + 8 * ch) = v; }
    }
    asm volatile("s_waitcnt lgkmcnt(0)" ::: "memory");
}
DI void ph_attn(Ctx& K) {
    constexpr int N_SWA = NB * 2 * (L / 128), N_NAT = NB * 6 * (L / 256), N_C = NB * 6;
    const float* sinkp = ARG(swa_sink) + K.l * 6;
    for (int item = K.bid; item < N_SWA + N_NAT + 2 * N_C; item += K.nb) {
        if (item < N_SWA) attn_item<0>(K, item, sinkp, nullptr);
        else if (item < N_SWA + N_NAT) { const int it = item - N_SWA; const int h = (it >> 6) % 6; attn_item<1>(K, it, nullptr, ARG(nat_rpb) + ((size_t)K.l * 6 + h) * 15 * 31); }
        else if (item < N_SWA + N_NAT + N_C) attn_item<2>(K, item - N_SWA - N_NAT, sinkp, nullptr);
        else attn_item<3>(K, item - N_SWA - N_NAT - N_C, nullptr, nullptr);
    }
}

DI unsigned fkey(float f) { const unsigned u = __float_as_uint(f); return (u & 0x80000000u) ? ~u : (u | 0x80000000u); }
DI int mbcnt64(unsigned long long m) { return (int)__builtin_amdgcn_mbcnt_hi((unsigned)(m >> 32), __builtin_amdgcn_mbcnt_lo((unsigned)m, 0u)); }
template <int NV> DI unsigned radix_thr16(const unsigned (&k)[NV]) {
    unsigned prefix = 0u;
#pragma unroll 1
    for (int bit = 31; bit >= 0; --bit) {
        const unsigned cand = prefix | (1u << bit); int cnt = 0;
#pragma unroll
        for (int i = 0; i < NV; ++i) cnt += __popcll(__ballot(k[i] >= cand));
        if (cnt >= 16) { prefix = cand; if (cnt == 16) break; }
    }
    return prefix;
}
template <int NC, int NV> DI void radix_thr16_multi(const unsigned (&k)[NC][NV], unsigned (&T)[NC]) {
    bool exact[NC];
#pragma unroll
    for (int c = 0; c < NC; ++c) { T[c] = 0u; exact[c] = false; }
#pragma unroll 1
    for (int bit = 31; bit >= 0; --bit) {
        bool all = true;
#pragma unroll
        for (int c = 0; c < NC; ++c) {
            const unsigned cand = T[c] | (1u << bit); int cnt = 0;
#pragma unroll
            for (int i = 0; i < NV; ++i) cnt += __popcll(__ballot(k[c][i] >= cand));
            if (cnt >= 16) { T[c] = cand; exact[c] = (cnt == 16); }
            all = all && exact[c];
        }
        if (all) break;
    }
}
template <int NV> DI void select16(const unsigned (&k)[NV], unsigned T, bool (&sel)[NV], int (&pos)[NV]) {
    int ngt = 0; unsigned long long gtm[NV], eqm[NV];
#pragma unroll
    for (int i = 0; i < NV; ++i) { gtm[i] = __ballot(k[i] > T); eqm[i] = __ballot(k[i] == T); ngt += __popcll(gtm[i]); }
    const int need = 16 - ngt; int eqbase = 0, selbase = 0;
#pragma unroll
    for (int i = 0; i < NV; ++i) {
        const bool iseq = k[i] == T; const int erank = eqbase + mbcnt64(eqm[i]); eqbase += __popcll(eqm[i]);
        sel[i] = (k[i] > T) || (iseq && erank < need);
        const unsigned long long sm = __ballot(sel[i]); pos[i] = selbase + mbcnt64(sm); selbase += __popcll(sm);
    }
}
template <int CTRL> DI int dppi_(int x) { return __builtin_amdgcn_mov_dpp(x, CTRL, 0xf, 0xf, true); }
DI int row_sum_i(int x) { x += dppi_<0xB1>(x); x += dppi_<0x4E>(x); x += dppi_<0x141>(x); x += dppi_<0x128>(x); return x; }
DI int row_excl_scan_i(int x) { int s_ = x; s_ += dppi_<0x111>(s_); s_ += dppi_<0x112>(s_); s_ += dppi_<0x114>(s_); s_ += dppi_<0x118>(s_); return s_ - x; }
DI unsigned row_minmax_u(unsigned x, bool want_max) {
    unsigned y;
    y = (unsigned)dppi_<0xB1>((int)x); x = want_max ? max(x, y) : min(x, y); y = (unsigned)dppi_<0x4E>((int)x); x = want_max ? max(x, y) : min(x, y);
    y = (unsigned)dppi_<0x141>((int)x); x = want_max ? max(x, y) : min(x, y); y = (unsigned)dppi_<0x128>((int)x); x = want_max ? max(x, y) : min(x, y);
    return x;
}
template <int NK> DI unsigned row_radix_thr16(const unsigned (&k)[NK]) {
    unsigned lm = k[0];
#pragma unroll
    for (int i = 1; i < NK; ++i) lm = max(lm, k[i]);
    unsigned lo = row_minmax_u(lm, false), hi = row_minmax_u(lm, true) + 1u;
    bool done = false;
#pragma unroll 1
    for (int itn = 0; itn < 40; ++itn) {
        const unsigned span = hi - lo; done = done || (span <= 1u);
        const unsigned mid = lo + (span >> 1); int cnt = 0;
#pragma unroll
        for (int i = 0; i < NK; ++i) cnt += (k[i] >= mid) ? 1 : 0;
        cnt = row_sum_i(cnt);
        const bool ge = cnt >= 16;
        if (!done) { if (ge) lo = mid; else hi = mid; }
        done = done || (cnt == 16);
        if (__ballot(!done) == 0ull) break;
    }
    return lo;
}
template <int NK> DI void row_select16(const unsigned (&k)[NK], unsigned T, bool (&sel)[NK], int (&pos)[NK]) {
    int g = 0, q = 0;
#pragma unroll
    for (int i = 0; i < NK; ++i) { g += (k[i] > T) ? 1 : 0; q += (k[i] == T) ? 1 : 0; }
    const int need = 16 - row_sum_i(g);
    const int a = min(max(need - row_excl_scan_i(q), 0), q);
    int nxt = row_excl_scan_i(g + a), eqs = 0;
#pragma unroll
    for (int i = 0; i < NK; ++i) { const bool iseq = k[i] == T; sel[i] = (k[i] > T) || (iseq && eqs < a); eqs += iseq ? 1 : 0; pos[i] = nxt; nxt += sel[i] ? 1 : 0; }
}
constexpr int PS_SCS = 132;
constexpr int PSL_TOP = 8 * 2 * 16 * PS_SCS * 4;
static_assert(PSL_TOP + 8 * 1024 <= LDS_BYTES - 256, "peer select LDS map");
template <int PROBE> DI void ph_peer_select(Ctx& K) {
    float* SCR = (float*)K.lds + K.wave * 2 * 16 * PS_SCS; float* TOPV = (float*)(K.lds + PSL_TOP + K.wave * 1024); int* TOPI = (int*)(TOPV + 128);
    const int r16 = K.lane & 15, g4 = K.lane >> 4, h = K.wave;
    constexpr int N_IT = M / 16, N_FULL = (N_IT / 256) * 256, N_WORK = N_FULL + 4 * (N_IT - N_FULL);
    for (int wk = K.bid; wk < N_WORK; wk += K.nb) {
        const bool part = wk >= N_FULL; const int item = part ? N_FULL + ((wk - N_FULL) >> 2) : wk; const int tk_lo = part ? 4 * ((wk - N_FULL) & 3) : 0, tk_hi = part ? tk_lo + 4 : 16;
        const int t0 = item * 16;
#pragma unroll 1
        for (int p = 0; p < 2; ++p) {
            bf16x8_t aq[4];
            { const bf16_t* qp = K.QP() + (size_t)(t0 + r16) * 2048 + h * 256 + p * 128 + 8 * g4;
#pragma unroll
              for (int ks = 0; ks < 4; ++ks) aq[ks] = *(const bf16x8_t*)(qp + 32 * ks); }
            const size_t kb = (((size_t)K.l * 8 + h) * 2 + p) * 128 * 128 + (size_t)K.lane * 8;
#pragma unroll 2
            for (int nt = 0; nt < 8; ++nt) {
                bf16x8_t bh[4], bl[4];
#pragma unroll
                for (int ks = 0; ks < 4; ++ks) { bh[ks] = *(const bf16x8_t*)(K.SKH() + kb + (size_t)(nt * 4 + ks) * 512); bl[ks] = *(const bf16x8_t*)(K.SKL() + kb + (size_t)(nt * 4 + ks) * 512); }
                f32x4 c0 = {0.f, 0.f, 0.f, 0.f}, c1 = c0;
#pragma unroll
                for (int ks = 0; ks < 4; ++ks) { c0 = MFMA16(aq[ks], bh[ks], c0); c1 = MFMA16(aq[ks], bl[ks], c1); }
#pragma unroll
                for (int rg = 0; rg < 4; ++rg) SCR[(p * 16 + 4 * g4 + rg) * PS_SCS + 16 * nt + r16] = c0[rg] + c1[rg];
            }
        }
        asm volatile("s_waitcnt lgkmcnt(0)" ::: "memory");
        if (PROBE == 1) continue;
        const int rho = K.lane >> 4, j16 = K.lane & 15;
#pragma unroll 1
        for (int tk = tk_lo; tk < tk_hi; tk += 4) {
#pragma unroll 1
            for (int ps = 0; ps < 2; ++ps) {
                const int p = rho & 1, rr = 2 * ps + (rho >> 1);
                float v[8]; unsigned kk[8];
#pragma unroll
                for (int i = 0; i < 8; ++i) { v[i] = SCR[(p * 16 + tk + rr) * PS_SCS + j16 + 16 * i]; kk[i] = fkey(v[i]); }
                const unsigned T = row_radix_thr16<8>(kk);
                bool sel[8]; int pos[8]; row_select16<8>(kk, T, sel, pos);
#pragma unroll
                for (int i = 0; i < 8; ++i) if (sel[i]) { TOPV[(rr * 2 + p) * 16 + pos[i]] = v[i]; TOPI[(rr * 2 + p) * 16 + pos[i]] = j16 + 16 * i; }
            }
            asm volatile("s_waitcnt lgkmcnt(0)" ::: "memory");
            { const int r = t0 + tk + rho;
              const float vb = TOPV[(rho * 2 + 1) * 16 + j16]; const int ib = TOPI[(rho * 2 + 1) * 16 + j16];
              float cv[16]; unsigned ck[16];
#pragma unroll
              for (int i = 0; i < 16; ++i) { cv[i] = TOPV[(rho * 2) * 16 + i] + vb; ck[i] = fkey(cv[i]); }
              const unsigned T = row_radix_thr16<16>(ck);
              bool sel[16]; int pos[16]; row_select16<16>(ck, T, sel, pos);
              float mx = -3.0e38f;
#pragma unroll
              for (int i = 0; i < 16; ++i) mx = fmaxf(mx, sel[i] ? cv[i] : -3.0e38f);
              mx = dpp_max16(mx);
              float es = 0.f;
#pragma unroll
              for (int i = 0; i < 16; ++i) { cv[i] = sel[i] ? __expf(cv[i] - mx) : 0.f; es += cv[i]; }
              es = dpp_sum16(es);
              const float inv = 1.0f / es;
#pragma unroll
              for (int i = 0; i < 16; ++i) if (sel[i]) { K.PIDX()[(size_t)r * 128 + h * 16 + pos[i]] = TOPI[(rho * 2) * 16 + i] * 128 + ib; K.PG()[(size_t)r * 128 + h * 16 + pos[i]] = cv[i] * inv; }
            }
            asm volatile("s_waitcnt lgkmcnt(0)" ::: "memory");
        }
    }
}

constexpr int PUL_H = 0, PUL_SLOT = 4096, PUL_STRIDE = 4352;
struct PuMeta { float hs[2]; int ia[2], ib[2]; };
DI void pu_load(const Ctx& K, int r0, int step, PuMeta& m, unsigned char* hbuf) {
#pragma unroll
    for (int q = 0; q < 2; ++q) { const int r = r0 + q * step;
        if (r < M) { __builtin_amdgcn_global_load_lds((const unsigned*)(K.H8() + (size_t)r * D + K.lane * 16), (LAS unsigned*)(hbuf + q * 1024), 16, 0, 0);
            m.hs[q] = K.HS()[r]; m.ia[q] = K.PIDX()[(size_t)r * 128 + K.lane]; m.ib[q] = K.PIDX()[(size_t)r * 128 + 64 + K.lane]; }
        else { m.hs[q] = 0.f; m.ia[q] = -1; m.ib[q] = -1; } }
}
typedef int i32x4 __attribute__((ext_vector_type(4)));
DI int sel4i(const i32x4 v, int k) { return k == 0 ? v[0] : k == 1 ? v[1] : k == 2 ? v[2] : v[3]; }
template <int PROBE> DI void pu_item(const Ctx& K, const unsigned char* U, unsigned char* HL, int* SLOT, int R, int r0, int step, const PuMeta& m, int r16, int g4, float& dummy) {
    const float hs[2] = {m.hs[0], m.hs[1]};
    bool sa[2], sb[2]; int ra[2], rb[2]; int n = 0;
#pragma unroll
    for (int q = 0; q < 2; ++q) { sa[q] = (m.ia[q] >> 11) == R; sb[q] = (m.ib[q] >> 11) == R; const unsigned long long ma = __ballot(sa[q]), mb = __ballot(sb[q]);
        ra[q] = n + mbcnt64(ma); n += __popcll(ma); rb[q] = n + mbcnt64(mb); n += __popcll(mb); }
    const int E = r16 >> 2, qq = r16 & 3, rho = r16 >> 3;
#pragma unroll 1
    for (int base = 0; base < n; base += 32) {
#pragma unroll
        for (int q = 0; q < 2; ++q) {
            if (sa[q] && ra[q] >= base && ra[q] < base + 32) { SLOT[2 * (ra[q] - base)] = m.ia[q]; SLOT[2 * (ra[q] - base) + 1] = q * 128 + K.lane; }
            if (sb[q] && rb[q] >= base && rb[q] < base + 32) { SLOT[2 * (rb[q] - base)] = m.ib[q]; SLOT[2 * (rb[q] - base) + 1] = q * 128 + 64 + K.lane; } }
        asm volatile("s_waitcnt lgkmcnt(0)" ::: "memory");
        const bool two = base + 16 < n;
        i32x4 av[8][4];
#pragma unroll
        for (int t = 0; t < 4; ++t) { const int sl = 4 * t + E; const int e = (base + sl < n) ? SLOT[2 * sl] : SLOT[0]; const unsigned char* up = U + (size_t)e * D + 64 * g4 + 16 * qq;
#pragma unroll
            for (int s_ = 0; s_ < 4; ++s_) av[t][s_] = *(const i32x4*)(up + 256 * s_); }
        if (two) {
#pragma unroll
            for (int t = 4; t < 8; ++t) { const int sl = 4 * t + E; const int e = (base + sl < n) ? SLOT[2 * sl] : SLOT[0]; const unsigned char* up = U + (size_t)e * D + 64 * g4 + 16 * qq;
#pragma unroll
                for (int s_ = 0; s_ < 4; ++s_) av[t][s_] = *(const i32x4*)(up + 256 * s_); } }
        bool fin[2]; int fcode[2]; float fus[2], fvs[2];
#pragma unroll
        for (int p2 = 0; p2 < 2; ++p2) { const int sl = 4 * (4 * p2 + qq) + g4; fin[p2] = false; fcode[p2] = 0; fus[p2] = 0.f; fvs[p2] = 0.f;
            if ((r16 & 7) < 4 && base + sl < n) { const int code = SLOT[2 * sl + 1];
                if ((code >> 7) == rho) { const size_t eo = (size_t)K.l * 16384 + SLOT[2 * sl]; fin[p2] = true; fcode[p2] = code; fus[p2] = K.US()[eo]; fvs[p2] = K.VS()[eo]; } } }
        i32x4 hb[4];
#pragma unroll
        for (int s_ = 0; s_ < 4; ++s_) hb[s_] = *(const i32x4*)(HL + rho * 1024 + 64 * g4 + 16 * qq + 256 * s_);
        int w0, w1 = 0;
        { int rs[4];
#pragma unroll
          for (int t = 0; t < 4; ++t) { i32x4 acc = {0, 0, 0, 0};
#pragma unroll
              for (int s_ = 0; s_ < 4; ++s_) acc = __builtin_amdgcn_mfma_i32_16x16x64_i8(av[t][s_], hb[s_], acc, 0, 0, 0);
              int v = sel4i(acc, qq); v += dppi_<0xB1>(v); v += dppi_<0x4E>(v); rs[t] = v; }
          w0 = qq == 0 ? rs[0] : qq == 1 ? rs[1] : qq == 2 ? rs[2] : rs[3]; }
        if (two) { int rs[4];
#pragma unroll
            for (int t = 0; t < 4; ++t) { i32x4 acc = {0, 0, 0, 0};
#pragma unroll
                for (int s_ = 0; s_ < 4; ++s_) acc = __builtin_amdgcn_mfma_i32_16x16x64_i8(av[4 + t][s_], hb[s_], acc, 0, 0, 0);
                int v = sel4i(acc, qq); v += dppi_<0xB1>(v); v += dppi_<0x4E>(v); rs[t] = v; }
            w1 = qq == 0 ? rs[0] : qq == 1 ? rs[1] : qq == 2 ? rs[2] : rs[3]; }
#pragma unroll
        for (int p2 = 0; p2 < 2; ++p2) {
            const int di = p2 ? w1 : w0;
            if (fin[p2]) { const int code = fcode[p2];
                const float d = (float)di * fus[p2] * ((code >> 7) ? hs[1] : hs[0]);
                if (PROBE >= 2) dummy += gelu_erf(d);
                else (PROBE ? K.ST() : K.PA())[(size_t)(r0 + (code >> 7) * step) * 128 + (code & 127)] = gelu_erf(d) * fvs[p2]; }
        }
        asm volatile("s_waitcnt lgkmcnt(0)" ::: "memory");
    }
}
template <int PROBE> DI void ph_peer_u(Ctx& K) {
    const unsigned char* U = (const unsigned char*)K.UB() + (size_t)K.l * 16384 * D;
    unsigned char* HB = K.lds + K.wave * PUL_STRIDE; int* SLOT = (int*)(HB + PUL_SLOT);
    const int r16 = K.lane & 15, g4 = K.lane >> 4;
    const int step = K.nloc * NWAVES;
    float dummy = 0.f;
    for (int R = K.xg; R < 8; R += K.nxg) {
        int r = K.jx * NWAVES + K.wave; int par = 0;
        PuMeta cur, nxt;
        pu_load(K, r, step, cur, HB);
#pragma unroll 1
        for (; r < M; r += 2 * step) {
            asm volatile("s_waitcnt vmcnt(0)" ::: "memory");
            pu_load(K, r + 2 * step, step, nxt, HB + (par ^ 1) * 2048);
            pu_item<PROBE>(K, U, HB + par * 2048, SLOT, R, r, step, cur, r16, g4, dummy);
            cur = nxt; par ^= 1;
        }
    }
    if (PROBE >= 2) K.ST()[K.gw * 64 + K.lane] = dummy;
}
struct PvMeta { int ia, ib; float ga, gb, pa, pb; };
template <int PROBE> DI void pv_load(const Ctx& K, int r, PvMeta& m) {
    m.ia = K.PIDX()[(size_t)r * 128 + K.lane]; m.ib = K.PIDX()[(size_t)r * 128 + 64 + K.lane];
    m.ga = K.PG()[(size_t)r * 128 + K.lane]; m.pa = K.PA()[(size_t)r * 128 + K.lane]; m.gb = K.PG()[(size_t)r * 128 + 64 + K.lane]; m.pb = K.PA()[(size_t)r * 128 + 64 + K.lane];
}
template <int HALF, int PROBE> DI void pv_issue(const unsigned char* V, int slot, const PvMeta& m, u32x4 (&vv)[8], float (&ww)[8]) {
    const float w = HALF ? m.gb * m.pb : m.ga * m.pa; const int ix = HALF ? m.ib : m.ia;
#pragma unroll
    for (int i = 0; i < 8; ++i) {
        const int src = ((8 * i + slot) << 2);
        const int e = __builtin_amdgcn_ds_bpermute(src, ix);
        ww[i] = __uint_as_float((unsigned)__builtin_amdgcn_ds_bpermute(src, (int)__float_as_uint(w)));
        vv[i] = PROBE == 2 ? (u32x4){(unsigned)e, 1u, 2u, 3u} : *(const u32x4*)(V + (size_t)e * 128);
    }
}
typedef float f32x2_ __attribute__((ext_vector_type(2)));
DI void pv_accum(const u32x4 (&vv)[8], const float (&ww)[8], f32x2_ (&y)[8], float& sw) {
#pragma unroll
    for (int i = 0; i < 8; ++i) { sw += ww[i]; const unsigned w4[4] = {vv[i].x, vv[i].y, vv[i].z, vv[i].w}; const f32x2_ w2 = {ww[i], ww[i]};
#pragma unroll
        for (int q = 0; q < 4; ++q) { const f32x2_ lo = {(float)(w4[q] & 0xffu), (float)((w4[q] >> 8) & 0xffu)}, hi = {(float)((w4[q] >> 16) & 0xffu), (float)(w4[q] >> 24)};
            y[2 * q] = __builtin_elementwise_fma(w2, lo, y[2 * q]); y[2 * q + 1] = __builtin_elementwise_fma(w2, hi, y[2 * q + 1]); } }
}
template <int PROBE> DI void ph_peer_v(Ctx& K) {
    const int slot = K.lane >> 3, c = K.lane & 7;
    const float* gate = K.MOD() + (size_t)K.l * 3 * 6 * D + 5 * D;
    const int step = K.nloc * NWAVES;
    float* Xb = PROBE ? (float*)K.P() : K.X();
    for (int S = K.xg; S < 8; S += K.nxg) {
        const unsigned char* V = (const unsigned char*)K.VB() + ((size_t)K.l * 8 + S) * 16384 * 128 + c * 16;
        const int c0 = S * 128 + c * 16;
        const int r0 = K.jx * NWAVES + K.wave;
        const int nit = r0 < M ? (M - 1 - r0) / step + 1 : 0;
        PvMeta mA, mB; pv_load<PROBE>(K, min(r0, M - 1), mA); pv_load<PROBE>(K, min(r0 + step, M - 1), mB);
        f32x4 xq[4], xprev[4], x2[4], gp[4]; float yp[16]; int rp = -1, mvp = -1; PvMeta m2;
#pragma unroll
        for (int q = 0; q < 4; ++q) { xq[q] = *(const f32x4*)(Xb + (size_t)min(r0, M - 1) * D + c0 + 4 * q); xprev[q] = (f32x4){0.f, 0.f, 0.f, 0.f}; gp[q] = xprev[q]; }
#pragma unroll
        for (int q = 0; q < 16; ++q) yp[q] = 0.f;
#define PV_BODY(XPREV, XQ, XNEW, MA, MC, IT) do { \
            const int r = r0 + (IT) * step; \
            if (rp >= 0) { const int mv = modvec_of_row(rp); \
                if (mv != mvp) { mvp = mv; \
                    _Pragma("unroll") for (int q = 0; q < 4; ++q) gp[q] = *(const f32x4*)(gate + (size_t)mv * 6 * D + c0 + 4 * q); } } \
            { const float zdep = MA.ga * 0.0f; \
                _Pragma("unroll") for (int q = 0; q < 4; ++q) { XPREV[q].x += gp[q].x * yp[4 * q] + zdep; XPREV[q].y += gp[q].y * yp[4 * q + 1] + zdep; XPREV[q].z += gp[q].z * yp[4 * q + 2] + zdep; XPREV[q].w += gp[q].w * yp[4 * q + 3] + zdep; } \
                if (rp >= 0 && slot == 0) { float* xr = Xb + (size_t)rp * D + c0; \
                    _Pragma("unroll") for (int q = 0; q < 4; ++q) *(f32x4*)(xr + 4 * q) = XPREV[q]; } } \
            __builtin_amdgcn_sched_barrier(0); \
            u32x4 vA[8], vB[8]; float wA[8], wB[8]; \
            pv_issue<0, PROBE>(V, slot, MA, vA, wA); \
            pv_issue<1, PROBE>(V, slot, MA, vB, wB); \
            __builtin_amdgcn_sched_barrier(0); \
            { const float* xr = Xb + (size_t)min(r + step, M - 1) * D + c0; \
              _Pragma("unroll") for (int q = 0; q < 4; ++q) XNEW[q] = *(const f32x4*)(xr + 4 * q); } \
            pv_load<PROBE>(K, min(r + 2 * step, M - 1), MC); \
            __builtin_amdgcn_sched_barrier(0); \
            f32x2_ y2[8]; float sw = 0.f; \
            _Pragma("unroll") for (int i = 0; i < 8; ++i) y2[i] = (f32x2_){0.f, 0.f}; \
            pv_accum(vA, wA, y2, sw); \
            pv_accum(vB, wB, y2, sw); \
            _Pragma("unroll") for (int q = 0; q < 8; ++q) { yp[2 * q] = y2[q].x - 128.f * sw; yp[2 * q + 1] = y2[q].y - 128.f * sw; } \
            _Pragma("unroll") for (int q = 0; q < 16; ++q) { float v = yp[q]; v += dpp_<0x128>(v); \
                auto s1 = __builtin_amdgcn_permlane16_swap(__float_as_uint(v), __float_as_uint(v), false, false); v = __uint_as_float(s1[0]) + __uint_as_float(s1[1]); \
                auto s2 = __builtin_amdgcn_permlane32_swap(__float_as_uint(v), __float_as_uint(v), false, false); yp[q] = __uint_as_float(s2[0]) + __uint_as_float(s2[1]); } \
            rp = r; } while (0)
        f32x4 (*xfin)[4] = nullptr; (void)xfin;
        int it = 0;
#pragma unroll 1
        for (; it + 2 < nit; it += 3) {
            PV_BODY(xprev, xq, x2, mA, m2, it);
            PV_BODY(xq, x2, xprev, mB, mA, it + 1);
            PV_BODY(x2, xprev, xq, m2, mB, it + 2);
        }
        if (it < nit) { PV_BODY(xprev, xq, x2, mA, m2, it); ++it;
            if (it < nit) { PV_BODY(xq, x2, xprev, mB, mA, it); ++it;
#pragma unroll
                for (int q = 0; q < 4; ++q) xprev[q] = x2[q]; }
            else {
#pragma unroll
                for (int q = 0; q < 4; ++q) xprev[q] = xq[q]; } }
#undef PV_BODY
        if (rp >= 0) { const int mv = modvec_of_row(rp);
#pragma unroll
            for (int q = 0; q < 4; ++q) gp[q] = *(const f32x4*)(gate + (size_t)mv * 6 * D + c0 + 4 * q);
            if (slot == 0) { float* xr = Xb + (size_t)rp * D + c0;
#pragma unroll
                for (int q = 0; q < 4; ++q) { f32x4 x = xprev[q];
                    x.x += gp[q].x * yp[4 * q]; x.y += gp[q].y * yp[4 * q + 1]; x.z += gp[q].z * yp[4 * q + 2]; x.w += gp[q].w * yp[4 * q + 3]; *(f32x4*)(xr + 4 * q) = x; } } }
    }
}

DI void ph_final(Ctx& K) {
    for (int r = K.gw; r < NLAT; r += K.ngw) {
        const f32x4* xr = (const f32x4*)(K.X() + (size_t)(NCTX + r) * D); f32x4* o = (f32x4*)(((float*)argp_<float>(K, (unsigned)__builtin_offsetof(Args, out))) + (size_t)r * D);
        f32x4 v[4]; float ss = 0.f;
#pragma unroll
        for (int j = 0; j < 4; ++j) { v[j] = xr[j * 64 + K.lane]; ss += v[j].x * v[j].x + v[j].y * v[j].y + v[j].z * v[j].z + v[j].w * v[j].w; }
        ss = wave_sum(ss); const float rs = rsqrtf(ss * (1.0f / D) + EPS);
#pragma unroll
        for (int j = 0; j < 4; ++j) { const f32x4 w = ((const f32x4*)ARG(final_norm_w))[j * 64 + K.lane]; o[j * 64 + K.lane] = v[j] * rs * w; }
    }
}

#define XB_TMO      128
#define XB_XSUB(j)  (1280 + 64 * (j))
#define XB_XGEN(j)  (2304 + 64 * (j))
#define XB_TOP      3328
#define XB_TOPGEN   3392
#define XB_SPIN_CAP (1u << 22)
constexpr int CW_BAR = 4096;
DI unsigned xb_ld(unsigned* p)              { return __hip_atomic_load(p, __ATOMIC_RELAXED, __HIP_MEMORY_SCOPE_AGENT); }
DI unsigned xb_add(unsigned* p, unsigned v) { return __hip_atomic_fetch_add(p, v, __ATOMIC_RELAXED, __HIP_MEMORY_SCOPE_AGENT); }
#define XB_SPIN(cond, bar) do { unsigned _sp = 0; while (cond) { __builtin_amdgcn_s_sleep(1); \
    if ((++_sp & 255u) == 0u) { if (xb_ld(&(bar)[XB_TMO])) break; if (_sp > XB_SPIN_CAP) { atomicAdd(&(bar)[XB_TMO], 1u); break; } } } } while (0)
DI void xcd_barrier(unsigned* bar, unsigned x, unsigned nloc, unsigned nx) {
    asm volatile("s_waitcnt vmcnt(0)" ::: "memory");
    __syncthreads();
    if (threadIdx.x == 0) {
        __builtin_amdgcn_s_waitcnt(0);
        const unsigned old = xb_add(&bar[XB_XSUB(x)], 1u);
        const unsigned gen = old / nloc;
        if (old + 1u == (gen + 1u) * nloc) {
            __builtin_amdgcn_fence(__ATOMIC_RELEASE, "agent");
            asm volatile("s_waitcnt vmcnt(0)" ::: "memory");
            const unsigned og = xb_add(&bar[XB_TOP], 1u);
            const unsigned tg = og / nx;
            if (og + 1u == (tg + 1u) * nx) xb_add(&bar[XB_TOPGEN], 1u);
            else XB_SPIN(xb_ld(&bar[XB_TOPGEN]) == tg, bar);
            __builtin_amdgcn_fence(__ATOMIC_ACQUIRE, "agent");
            xb_add(&bar[XB_XGEN(x)], 1u);
            asm volatile("s_waitcnt vmcnt(0)" ::: "memory");
        } else {
            XB_SPIN(xb_ld(&bar[XB_XGEN(x)]) == gen, bar);
            __builtin_amdgcn_fence(__ATOMIC_ACQUIRE, "agent");
            asm volatile("s_waitcnt vmcnt(0)" ::: "memory");
        }
    }
    __syncthreads();
}

constexpr int PROBE_U = 0, PROBE_V = 0, PROBE_S = 0;
constexpr unsigned DUP_MASK = 0u;
constexpr int PH_PER_LAYER = 12, N_PHASES = 2 + PH_PER_LAYER * DEPTH;
__global__ void __launch_bounds__(NTHREADS) mk_fwd(Args args) {
    extern __shared__ __attribute__((aligned(16))) unsigned char lds[];
    cg::grid_group grid = cg::this_grid();
    constexpr unsigned ARGS_OFF = LDS_BYTES - 256;
    constexpr unsigned MISC_OFF = LDS_BYTES - 64;
    if (threadIdx.x == 0) {
        *(Args*)(lds + ARGS_OFF) = args;
        unsigned* ctl = (unsigned*)(args.ws + WS_CTL); unsigned* misc = (unsigned*)(lds + MISC_OFF);
        const unsigned xcc = (unsigned)__builtin_amdgcn_s_getreg((3 << 11) | 20) & 0xFu;
        misc[0] = xcc; misc[1] = __hip_atomic_fetch_add(ctl + 64 * xcc, 1u, __ATOMIC_RELAXED, __HIP_MEMORY_SCOPE_AGENT);
    }
    __syncthreads();
    int rep = 0;
#pragma unroll 1
    for (int ph = 0; ph < N_PHASES; ++ph) {
        int tid = threadIdx.x; asm volatile("" : "+v"(tid));
        unsigned aoff = ARGS_OFF; asm volatile("" : "+v"(aoff));
        size_t zoff = 0; asm volatile("" : "+s"(zoff));
        unsigned char* ws = args.ws + zoff;
        int bid = blockIdx.x; asm volatile("" : "+s"(bid)); int nb = gridDim.x; asm volatile("" : "+s"(nb));
        unsigned moff = MISC_OFF; asm volatile("" : "+v"(moff));
        Ctx K; { const unsigned* misc = (const unsigned*)(lds + moff); K.jx = __builtin_amdgcn_readfirstlane(misc[1]); K.xg = __builtin_amdgcn_readfirstlane(misc[2]); K.nxg = __builtin_amdgcn_readfirstlane(misc[3]); K.nloc = __builtin_amdgcn_readfirstlane(misc[4]); }
        K.aoff = aoff; K.lds = lds; K.tid = tid; K.lane = tid & 63; K.wave = tid >> 6; K.bid = bid; K.nb = nb; K.gw = bid * NWAVES + K.wave; K.ngw = nb * NWAVES;
        K.ws = ws;
        const int l = ph == 0 ? 0 : (ph - 1) / PH_PER_LAYER, k = ph == 0 ? -1 : (ph == N_PHASES - 1 ? -2 : (ph - 1) % PH_PER_LAYER);
        K.l = l;
        if (k == -1) ph_prologue(K);
        else if (k == -2) ph_final(K);
        else if (k == 0) ph_norm(K, ARG(norm_mix_w) + (size_t)l * D, 0);
        else if (k == 1) ph_gemm_store(K, K.H(), K.WIN() + (size_t)l * PW * D, PW, K.P(), K.ROPE());
        else if (k == 2) ph_hgrn_A(K);
        else if (k == 3) ph_attn(K);
        else if (k == 4) ph_hgrn_B(K);
        else if (k == 5) ph_hgrn_C(K);
        else if (k == 6) ph_gemm_resid(K, K.MIX(), K.WOUT() + (size_t)l * D * D, 2);
        else if (k == 7) ph_norm(K, ARG(norm_ffn_w) + (size_t)l * D, 3);
        else if (k == 8) ph_gemm_store(K, K.H(), K.WQ() + (size_t)l * 2048 * D, 2048, K.QP(), nullptr);
        else if (k == 9) { ph_peer_select<0>(K); if (PROBE_S) ph_peer_select<PROBE_S>(K); }
        else if (k == 10) { ph_peer_u<0>(K); if (PROBE_U) ph_peer_u<PROBE_U>(K); }
        else if (k == 11) { ph_peer_v<0>(K); if (PROBE_V) ph_peer_v<PROBE_V>(K); }
        if (k >= 0 && ((DUP_MASK >> k) & 1u)) { ++rep; if (rep < 2) { --ph; continue; } } rep = 0;
        if (ph == 0) grid.sync();
        else if (k != 2 && ph != N_PHASES - 1) { const unsigned* misc = (const unsigned*)(lds + moff); xcd_barrier((unsigned*)(args.ws + WS_CTL) + CW_BAR, misc[0], misc[4], misc[3]); }
        if (ph == 0) {
            if (threadIdx.x == 0) { unsigned* ctl = (unsigned*)(args.ws + WS_CTL); unsigned* misc = (unsigned*)(lds + MISC_OFF); const unsigned xcc = misc[0]; unsigned ord = 0, npop = 0, mine = 1;
                for (unsigned q = 0; q < 16; ++q) { const unsigned cq = __hip_atomic_load(ctl + 64 * q, __ATOMIC_RELAXED, __HIP_MEMORY_SCOPE_AGENT); if (cq) { ++npop; if (q < xcc) ++ord; } if (q == xcc) mine = cq; }
                misc[2] = ord; misc[3] = npop ? npop : 1u; misc[4] = mine ? mine : 1u; }
            __syncthreads();
        }
    }
}

extern "C" void kernel_launch(void* const* d_in, const int* in_sizes, int n_in, void* d_out, int out_size, void* d_ws, size_t ws_size, hipStream_t stream) {
    static int grid = 0;
    if (grid == 0) {
        if (n_in != 19 || out_size != NLAT * D || ws_size < WS_END) { fprintf(stderr, "kernel_launch: unexpected shapes (n_in %d out %d ws %zu need %zu)\n", n_in, out_size, ws_size, (size_t)WS_END); grid = -1; return; }
        int dev = 0, cus = 0, per_cu = 0;
        (void)hipGetDevice(&dev); (void)hipDeviceGetAttribute(&cus, hipDeviceAttributeMultiprocessorCount, dev);
        (void)hipFuncSetAttribute((const void*)mk_fwd, hipFuncAttributeMaxDynamicSharedMemorySize, LDS_BYTES);
        (void)hipOccupancyMaxActiveBlocksPerMultiprocessor(&per_cu, (const void*)mk_fwd, NTHREADS, LDS_BYTES);
        if (per_cu < 1) { fprintf(stderr, "kernel_launch: occupancy query says %d blocks/CU\n", per_cu); grid = -1; return; }
        grid = (cus / 8) * 8;
    }
    if (grid < 0) return;
    Args a{};
    a.x = (const float*)d_in[0]; a.c = (const float*)d_in[1]; a.ctx = (const float*)d_in[2]; a.c_ctx = (const float*)d_in[3]; a.w_mod = (const float*)d_in[4]; a.b_mod = (const float*)d_in[5];
    a.norm_mix_w = (const float*)d_in[6]; a.norm_ffn_w = (const float*)d_in[7]; a.w_in = (const float*)d_in[8]; a.lb_logits = (const float*)d_in[9]; a.hgrn_norm_w = (const float*)d_in[10];
    a.swa_sink = (const float*)d_in[11]; a.nat_rpb = (const float*)d_in[12]; a.w_out = (const float*)d_in[13]; a.peer_wq = (const float*)d_in[14]; a.peer_sk = (const float*)d_in[15];
    a.peer_u = (const float*)d_in[16]; a.peer_v = (const float*)d_in[17]; a.final_norm_w = (const float*)d_in[18];
    a.out = (float*)d_out; a.ws = (unsigned char*)d_ws;
    (void)hipMemsetAsync((unsigned char*)d_ws + WS_CTL, 0, CTL_BYTES, stream);
    void* kargs[] = {&a};
    hipError_t e = hipLaunchCooperativeKernel((const void*)mk_fwd, dim3(grid), dim3(NTHREADS), kargs, LDS_BYTES, stream);
    if (e != hipSuccess) fprintf(stderr, "kernel_launch: cooperative launch failed: %s (grid %d)\n", hipGetErrorString(e), grid);
}
```

```cpp
#include <hip/hip_runtime.h>
#include <hip/hip_cooperative_groups.h>
#include <cstdio>
#include <cstdint>
namespace cg = cooperative_groups;
#define DI __device__ __forceinline__
#define GP(T, p) ((T*)(__attribute__((address_space(1))) T*)(p))

typedef unsigned short bf16_t;
typedef float f32x4 __attribute__((ext_vector_type(4)));
typedef unsigned u32x4 __attribute__((ext_vector_type(4)));
typedef unsigned u32x2 __attribute__((ext_vector_type(2)));

constexpr int D = 1024, NB = 2, L = 16384, CL = 256, DEPTH = 4;
constexpr int NCTX = NB * CL, NLAT = NB * L, M = NCTX + NLAT;
constexpr int PW = 3072;
constexpr int C_HQ = 0, C_ZF = 256, C_ZB = 512, C_HV = 768, C_HG = 1024, C_SQ = 1280, C_SK = 1664, C_SV = 1792, C_NQ = 1920, C_NK = 2304, C_NV = 2688;
constexpr int MX_H = 0, MX_S = 256, MX_N = 640;
constexpr float EPS = 1e-6f;
constexpr int NTHREADS = 512, NWAVES = 8;
constexpr int LDS_BYTES = 163840;

constexpr size_t al256(size_t x) { return (x + 255) & ~(size_t)255; }
constexpr size_t WS_X = 0;
constexpr size_t WS_H = WS_X + al256((size_t)M * D * 4);
constexpr size_t WS_P = WS_H + al256((size_t)M * D * 2);
constexpr size_t WS_MIX = WS_P + al256((size_t)M * PW * 2);
constexpr size_t WS_OF = WS_MIX + al256((size_t)M * D * 2);
constexpr size_t WS_OB = WS_OF + al256((size_t)M * 256 * 4);
constexpr size_t WS_PIDX = WS_OB + al256((size_t)M * 256 * 4);
constexpr size_t WS_PG = WS_PIDX + al256((size_t)M * 128 * 4);
constexpr size_t WS_MOD = WS_PG + al256((size_t)M * 128 * 4);
constexpr size_t WS_LB = WS_MOD + al256((size_t)DEPTH * 3 * 6 * D * 4);
constexpr size_t WS_ROPE = WS_LB + al256((size_t)2 * DEPTH * 256 * 4);
constexpr size_t WS_WIN = WS_ROPE + al256((size_t)(256 + 256 + 64 + 64) * 16 * 4);
constexpr size_t WS_WOUT = WS_WIN + al256((size_t)DEPTH * PW * D * 2);
constexpr size_t WS_WQ = WS_WOUT + al256((size_t)DEPTH * D * D * 2);
constexpr size_t WS_AC = WS_WQ + al256((size_t)DEPTH * 2048 * D * 2);
constexpr size_t WS_UB_ = 0; constexpr size_t WS_UB = WS_AC + al256((size_t)16 * 260 * 64 * 4); constexpr size_t WS_UB_OLD = WS_WQ + al256((size_t)DEPTH * 2048 * D * 2);
constexpr size_t WS_VB = WS_UB + al256((size_t)DEPTH * 16384 * D * 2);
constexpr size_t WS_PA = WS_VB + al256((size_t)DEPTH * 16384 * D * 2);
constexpr size_t WS_VS = WS_PA + al256((size_t)M * 128 * 4);
constexpr size_t WS_US = WS_VS + al256((size_t)DEPTH * 16384 * 4);
constexpr size_t WS_H8 = WS_US + al256((size_t)DEPTH * 16384 * 4);
constexpr size_t WS_HS = WS_H8 + al256((size_t)M * D);
constexpr size_t WS_SKH = WS_HS + al256((size_t)M * 4);
constexpr size_t WS_SKL = WS_SKH + al256((size_t)DEPTH * 8 * 2 * 128 * 128 * 2);
constexpr size_t WS_CTL = WS_SKL + al256((size_t)DEPTH * 8 * 2 * 128 * 128 * 2);
constexpr size_t CTL_BYTES = 65536;
constexpr size_t WS_END = WS_CTL + CTL_BYTES;

struct Args {
    const float *x, *c, *ctx, *c_ctx, *w_mod, *b_mod, *norm_mix_w, *norm_ffn_w, *w_in, *lb_logits, *hgrn_norm_w, *swa_sink, *nat_rpb, *w_out, *peer_wq, *peer_sk, *peer_u, *peer_v, *final_norm_w;
    float* out; unsigned char* ws;
};

DI float bf2f(bf16_t v) { return __uint_as_float((unsigned)v << 16); }
DI bf16_t f2bf(float f) { unsigned u = __float_as_uint(f); return (bf16_t)((u + 0x7fffu + ((u >> 16) & 1u)) >> 16); }
DI unsigned pk2(float lo, float hi) { return (unsigned)f2bf(lo) | ((unsigned)f2bf(hi) << 16); }
DI float wave_sum(float v) {
#pragma unroll
    for (int o = 1; o < 64; o <<= 1) v += __shfl_xor(v, o);
    return v;
}
typedef __bf16 bf16x2_t __attribute__((ext_vector_type(2)));
DI float dot2bf(unsigned a, unsigned b, float acc) { return __builtin_amdgcn_fdot2_f32_bf16(__builtin_bit_cast(bf16x2_t, a), __builtin_bit_cast(bf16x2_t, b), acc, false); }
template <int CTRL> DI float dpp_(float x) { return __builtin_bit_cast(float, __builtin_amdgcn_mov_dpp(__builtin_bit_cast(int, x), CTRL, 0xf, 0xf, true)); }
DI float wave_sum_fast(float x) {
    x += dpp_<0xB1>(x); x += dpp_<0x4E>(x); x += dpp_<0x141>(x); x += dpp_<0x128>(x);
    auto s1 = __builtin_amdgcn_permlane16_swap(__float_as_uint(x), __float_as_uint(x), false, false); x = __uint_as_float(s1[0]) + __uint_as_float(s1[1]);
    auto s2 = __builtin_amdgcn_permlane32_swap(__float_as_uint(x), __float_as_uint(x), false, false); return __uint_as_float(s2[0]) + __uint_as_float(s2[1]);
}
DI float sigmoidf_(float z) { return 1.0f / (1.0f + __expf(-z)); }
DI float gelu_erf(float v) { return 0.5f * v * (1.0f + erff(v * 0.70710678118654752f)); }
DI int modvec_of_row(int r) { return r < NCTX ? 2 : (r - NCTX) / L; }
DI int batch_of_row(int r) { return r < NCTX ? r / CL : (r - NCTX) / L; }
DI int lat_row(int b, int t) { return NCTX + b * L + t; }
DI int ctx_row(int b, int s) { return b * CL + s; }
DI void unpack8(const u32x4 w, float* o) {
    o[0] = __uint_as_float(w.x << 16); o[1] = __uint_as_float(w.x & 0xffff0000u);
    o[2] = __uint_as_float(w.y << 16); o[3] = __uint_as_float(w.y & 0xffff0000u);
    o[4] = __uint_as_float(w.z << 16); o[5] = __uint_as_float(w.z & 0xffff0000u);
    o[6] = __uint_as_float(w.w << 16); o[7] = __uint_as_float(w.w & 0xffff0000u);
}
DI void load_row64(const bf16_t* p, float (&o)[64]) {
#pragma unroll
    for (int i = 0; i < 8; ++i) { const u32x4 w = *(const u32x4*)(p + 8 * i); unpack8(w, &o[8 * i]); }
}
DI void rope64(float (&x)[64], const float* cr, const float* sr, const float* cc, const float* sc) {
#pragma unroll
    for (int i = 0; i < 16; ++i) {
        const float c1 = cr[i], s1 = sr[i], a = x[i], b = x[16 + i];
        x[i] = a * c1 - b * s1; x[16 + i] = b * c1 + a * s1;
        const float c2 = cc[i], s2 = sc[i], e = x[32 + i], f = x[48 + i];
        x[32 + i] = e * c2 - f * s2; x[48 + i] = f * c2 + e * s2;
    }
}

namespace pg8 {
#define PG8_LAS __attribute__((address_space(3)))
typedef unsigned short bf16_t;
typedef short bf16x8 __attribute__((ext_vector_type(8)));
typedef float f32x4 __attribute__((ext_vector_type(4)));
typedef unsigned u32x4 __attribute__((ext_vector_type(4)));
constexpr int BM = 256, BK = 64, HALF = 128, HTB = HALF * BK * 2  , STAGE_BYTES = 8 * HTB, NXCD = 8, WGM = 8;

__host__ __device__ __forceinline__ int lds_byte(int r, int c) { const int st = (r >> 4) * 2 + (c >> 5), rr = r & 15, cc = c & 31, ob = rr * 64 + cc * 2; return st * 1024 + (ob ^ (((ob >> 9) & 1) << 5)); }
__host__ __device__ __forceinline__ void stage_rc(int b, int& R, int& C) { const int st = b / 1024, sb = b % 1024, swz = sb ^ (((sb >> 9) & 1) << 5); R = (st >> 1) * 16 + swz / 64; C = (st & 1) * 32 + (swz % 64) / 2; }
__host__ __device__ __forceinline__ int perm32(int rho) { const int n = rho >> 4, i = rho & 15; return 8 * (i >> 2) + 4 * n + (i & 3); }

struct Unit { int pm, pn; };
struct Gemm { const bf16_t* A; const bf16_t* Bt; int M, N, K; };

struct StaticOrder {
    int nM, nN, nwg, G, c;
    __host__ __device__ void init(int M, int N, int G_, int c_) { nM = M / BM; nN = N / BM; nwg = nM * nN; G = G_; c = c_; }
    __host__ __device__ bool next(int i, Unit& u) const {
        const long L = (long)i * G + c; if (L >= nwg) return false;
        int wgid = (int)L; { const int q = nwg / NXCD, r = nwg % NXCD, xcd = wgid % NXCD, off = wgid / NXCD; wgid = (xcd < r ? xcd * (q + 1) : r * (q + 1) + (xcd - r) * q) + off; }
        const int nig = WGM * nN, gid = wgid / nig, fm = gid * WGM, gsz = (nM - fm) < WGM ? (nM - fm) : WGM;
        u.pm = fm + ((wgid % nig) % gsz); u.pn = (wgid % nig) / gsz; return true;
    }
    __device__ __forceinline__ void a_ready(const Unit&) const {}
    __device__ __forceinline__ void done(const Unit&) const {}
};


__device__ __forceinline__ unsigned cvt_pk_bf16(float lo, float hi) { unsigned r; asm volatile("v_cvt_pk_bf16_f32 %0, %1, %2" : "=v"(r) : "v"(lo), "v"(hi)); return r; }
constexpr int EPI_LDS_OFF = STAGE_BYTES, EPI_LDS_WAVE = 2560;
struct EpiStore {
    static constexpr bool PERM = true, AFTER_DRAIN = false;
    bf16_t* O; int ldc; PG8_LAS unsigned char* lds; const float* rope; int nctx, seqlen, rowbase;
    __device__ __forceinline__ void operator()(const f32x4 (&acc)[2][2][4][2], const Unit& u, int wr, int wc, int fr, int fq) const {
        PG8_LAS unsigned char* T = lds + EPI_LDS_OFF + (wr * 4 + wc) * EPI_LDS_WAVE;
        const int lane = fr + 16 * fq, rr = lane >> 2, cc = lane & 3;
        const int row0 = rowbase + u.pm * BM + wr * 64, col0 = u.pn * BM + wc * 32;
        const bool dorope = rope != nullptr && (u.pn == 5 || u.pn == 6) && rowbase + u.pm * BM >= nctx;
#pragma unroll
        for (int ai = 0; ai < 2; ++ai)
#pragma unroll
            for (int m = 0; m < 4; ++m)
#pragma unroll
                for (int bj = 0; bj < 2; ++bj) { const f32x4 v0 = acc[ai][bj][m][0], v1 = acc[ai][bj][m][1];
                    u32x4 w; w.x = cvt_pk_bf16(v0[0], v0[1]); w.y = cvt_pk_bf16(v0[2], v0[3]); w.z = cvt_pk_bf16(v1[0], v1[1]); w.w = cvt_pk_bf16(v1[2], v1[3]);
                    *(PG8_LAS u32x4*)(T + fr * 80 + 16 * fq) = w;
                    asm volatile("s_waitcnt lgkmcnt(0)" ::: "memory");
                    u32x4 o = *(const PG8_LAS u32x4*)(T + rr * 80 + 16 * cc);
                    asm volatile("s_waitcnt lgkmcnt(0)" ::: "memory");
                    const int grow = row0 + ai * HALF + m * 16 + rr;
                    if (dorope) {
                        const int t = (grow - nctx) % seqlen; const bool second = (wc & 1) != 0;
                        const float* ct = rope + (second ? 8192 + (t & 63) * 16 : (t >> 6) * 16) + 8 * (cc & 1); const float* st = ct + (second ? 1024 : 4096);
                        const f32x4 c0 = *(const f32x4*)ct, c1 = *(const f32x4*)(ct + 4), s0 = *(const f32x4*)st, s1 = *(const f32x4*)(st + 4);
                        const float cs[8] = {c0[0], c0[1], c0[2], c0[3], c1[0], c1[1], c1[2], c1[3]}, sn[8] = {s0[0], s0[1], s0[2], s0[3], s1[0], s1[1], s1[2], s1[3]};
                        const unsigned ow[4] = {o.x, o.y, o.z, o.w}; unsigned rw[4];
                        const float sg = cc >= 2 ? 1.0f : -1.0f;
#pragma unroll
                        for (int q = 0; q < 4; ++q) { const unsigned pw = (unsigned)__builtin_amdgcn_mov_dpp((int)ow[q], 0x4E, 0xf, 0xf, true);
                            const float x0 = __uint_as_float(ow[q] << 16), x1 = __uint_as_float(ow[q] & 0xffff0000u), p0 = __uint_as_float(pw << 16), p1 = __uint_as_float(pw & 0xffff0000u);
                            rw[q] = cvt_pk_bf16(x0 * cs[2 * q] + sg * p0 * sn[2 * q], x1 * cs[2 * q + 1] + sg * p1 * sn[2 * q + 1]); }
                        o = (u32x4){rw[0], rw[1], rw[2], rw[3]}; }
                    *(u32x4*)(O + (size_t)grow * ldc + col0 + bj * HALF + 8 * cc) = o; }
    }
};
struct EpiResid {
    static constexpr bool PERM = false, AFTER_DRAIN = false;
    float* X; int ldc; const float* gate; int gstride, nctx, seqlen; PG8_LAS unsigned char* lds; int rowbase;
    __device__ __forceinline__ void operator()(const f32x4 (&acc)[2][2][4][2], const Unit& u, int wr, int wc, int fr, int fq) const {
        PG8_LAS float* T = (PG8_LAS float*)(lds + EPI_LDS_OFF + (wr * 4 + wc) * EPI_LDS_WAVE);
        const int lane = fr + 16 * fq, rr = lane >> 3, cc = lane & 7;
        const int r0 = rowbase + u.pm * BM; const int vsel = r0 < nctx ? 2 : (r0 - nctx) / seqlen;
        const int row0 = r0 + wr * 64, col0 = u.pn * BM + wc * 32 + 4 * cc;
#pragma unroll
        for (int bj = 0; bj < 2; ++bj) { const f32x4 g = *(const f32x4*)(gate + (size_t)vsel * gstride + col0 + bj * HALF);
#pragma unroll
            for (int ai = 0; ai < 2; ++ai)
#pragma unroll
                for (int m = 0; m < 4; ++m) {
#pragma unroll
                    for (int n = 0; n < 2; ++n) *(PG8_LAS f32x4*)(T + fr * 36 + 16 * n + 4 * fq) = acc[ai][bj][m][n];
                    asm volatile("s_waitcnt lgkmcnt(0)" ::: "memory");
                    const f32x4 t0 = *(const PG8_LAS f32x4*)(T + rr * 36 + 4 * cc), t1 = *(const PG8_LAS f32x4*)(T + (rr + 8) * 36 + 4 * cc);
                    asm volatile("s_waitcnt lgkmcnt(0)" ::: "memory");
                    float* x0 = X + (size_t)(row0 + ai * HALF + m * 16 + rr) * ldc + col0 + bj * HALF; float* x1 = x0 + (size_t)8 * ldc;
                    f32x4 a = *(const f32x4*)x0, b = *(const f32x4*)x1; a += g * t0; b += g * t1; *(f32x4*)x0 = a; *(f32x4*)x1 = b; } }
    }
};

template <class Epi, class Sched, bool ALIGN_EPI = false, bool SP2 = false>
__device__ __forceinline__ void gemm_phase(PG8_LAS unsigned char* lds, const Gemm g, const Sched& S, const Epi& E) {
    int tid_ = threadIdx.x; asm volatile("" : "+v"(tid_));
    const int tid = tid_, wid = __builtin_amdgcn_readfirstlane(tid >> 6), lane = tid & 63, wr = wid >> 2, wc = wid & 3, fr = lane & 15, fq = lane >> 4;
    const int K = g.K, nt = K / BK;
    unsigned voffA[2], voffB[2];
#pragma unroll
    for (int i = 0; i < 2; ++i) { int R, C; stage_rc(tid * 16 + i * 8192, R, C); const int Rb = Epi::PERM ? ((R & ~31) + perm32(R & 31)) : R;
        voffA[i] = (unsigned)(R * K + C) * 2u; voffB[i] = (unsigned)(Rb * K + C) * 2u; }
    const size_t kstep = (size_t)(BK * 2);
    const size_t hstep = (size_t)HALF * K * 2;
    const size_t tstep = 2 * hstep;
    const unsigned ldsw = (unsigned)wid * 1024u;
    const int aoff = lds_byte(wr * 64 + fr, fq * 8), boff = lds_byte(wc * 32 + fr, fq * 8);
#define PG8_SA(b, h) (((b) * 2 + (h)) * HTB)
#define PG8_SB(b, h) ((4 + (b) * 2 + (h)) * HTB)
#define PG8_STAGE(bufoff, gbase, voff) do { _Pragma("unroll") for (int _i = 0; _i < 2; ++_i) \
        __builtin_amdgcn_global_load_lds((const unsigned*)((const char*)(gbase) + (voff)[_i]), (PG8_LAS unsigned*)(lds + (bufoff) + ldsw + _i * 8192), 16, 0, 0); } while (0)
#define PG8_LDA(dst, b, h) do { _Pragma("unroll") for (int m = 0; m < 4; ++m) _Pragma("unroll") for (int k = 0; k < 2; ++k) dst[m][k] = *(const PG8_LAS bf16x8*)(lds + PG8_SA(b, h) + aoff + m * 2048 + k * 1024); } while (0)
#define PG8_LDB(dst, b, h) do { _Pragma("unroll") for (int n = 0; n < 2; ++n) _Pragma("unroll") for (int k = 0; k < 2; ++k) dst[n][k] = *(const PG8_LAS bf16x8*)(lds + PG8_SB(b, h) + boff + n * 2048 + k * 1024); } while (0)
#define PG8_MMA(ai, bj, At, Bt) do { __builtin_amdgcn_s_setprio(1); _Pragma("unroll") for (int m = 0; m < 4; ++m) _Pragma("unroll") for (int n = 0; n < 2; ++n) _Pragma("unroll") for (int k = 0; k < 2; ++k) \
        acc[ai][bj][m][n] = __builtin_amdgcn_mfma_f32_16x16x32_bf16(Bt[n][k], At[m][k], acc[ai][bj][m][n], 0, 0, 0); __builtin_amdgcn_s_setprio(0); } while (0)
#define PG8_WAIT_V(n) asm volatile("s_waitcnt vmcnt(" #n ")" ::: "memory")
#define PG8_WAIT_L(n) asm volatile("s_waitcnt lgkmcnt(" #n ")" ::: "memory")
#define PG8_BAR __builtin_amdgcn_s_barrier()
#define PG8_SCHED __builtin_amdgcn_sched_barrier(0)
    Unit cur, nxt; int ui = 0;
    if (!S.next(0, cur)) return;
    f32x4 acc[2][2][4][2];
#pragma unroll
    for (int a = 0; a < 2; ++a)
#pragma unroll
        for (int b = 0; b < 2; ++b)
#pragma unroll
            for (int m = 0; m < 4; ++m)
#pragma unroll
                for (int n = 0; n < 2; ++n) acc[a][b][m][n] = (f32x4){0.f, 0.f, 0.f, 0.f};
    bf16x8 At[4][2], B0[2][2], B1[2][2];
    const char* cA = (const char*)g.A + (size_t)cur.pm * tstep; const char* cB = (const char*)g.Bt + (size_t)cur.pn * tstep;
    S.a_ready(cur);
    if constexpr (SP2) {
        PG8_STAGE(PG8_SB(0, 0), cB, voffB); PG8_STAGE(PG8_SB(0, 1), cB + hstep, voffB); PG8_STAGE(PG8_SA(0, 0), cA, voffA); PG8_STAGE(PG8_SA(0, 1), cA + hstep, voffA);
        if (wr == 1) PG8_BAR;
        PG8_WAIT_V(2); PG8_BAR;
        PG8_STAGE(PG8_SB(1, 0), cB + kstep, voffB); PG8_STAGE(PG8_SA(1, 0), cA + kstep, voffA); PG8_STAGE(PG8_SB(1, 1), cB + hstep + kstep, voffB);
        PG8_WAIT_V(6); PG8_BAR;
    } else {
        PG8_STAGE(PG8_SB(0, 0), cB, voffB); PG8_STAGE(PG8_SA(0, 0), cA, voffA); PG8_STAGE(PG8_SB(0, 1), cB + hstep, voffB); PG8_STAGE(PG8_SA(0, 1), cA + hstep, voffA);
        if (wr == 1) PG8_BAR;
        PG8_WAIT_V(4); PG8_BAR;
        PG8_STAGE(PG8_SB(1, 0), cB + kstep, voffB); PG8_STAGE(PG8_SA(1, 0), cA + kstep, voffA); PG8_STAGE(PG8_SB(1, 1), cB + hstep + kstep, voffB);
        PG8_WAIT_V(6); PG8_BAR;
    }
    for (;;) {
        const bool has_next = S.next(ui + 1, nxt);
        const char* nA = has_next ? (const char*)g.A + (size_t)nxt.pm * tstep : cA; const char* nB = has_next ? (const char*)g.Bt + (size_t)nxt.pn * tstep : cB;
        for (int t = 0; t < nt; t += 2) {
            const bool last = (t == nt - 2);
            const char* a1 = cA + (size_t)(t + 1) * kstep;
            const char* a2 = last ? nA : cA + (size_t)(t + 2) * kstep; const char* b2 = last ? nB : cB + (size_t)(t + 2) * kstep;
            const char* a3 = a2 + kstep; const char* b3 = b2 + kstep;
            if (last && has_next) S.a_ready(nxt);
            if constexpr (SP2) {
            PG8_LDB(B0, 0, 0); PG8_LDB(B1, 0, 1); PG8_SCHED; PG8_LDA(At, 0, 0); PG8_STAGE(PG8_SA(1, 1), a1 + hstep, voffA);
            PG8_WAIT_V(8); PG8_WAIT_L(0); PG8_BAR; PG8_MMA(0, 0, At, B0); PG8_MMA(0, 1, At, B1); PG8_BAR; PG8_SCHED;
            PG8_LDA(At, 0, 1); PG8_STAGE(PG8_SB(0, 0), b2, voffB); PG8_STAGE(PG8_SB(0, 1), b2 + hstep, voffB); PG8_STAGE(PG8_SA(0, 0), a2, voffA);
            PG8_WAIT_V(8); PG8_WAIT_L(0); PG8_BAR; PG8_MMA(1, 0, At, B0); PG8_MMA(1, 1, At, B1); PG8_BAR; PG8_SCHED;
            PG8_LDB(B0, 1, 0); PG8_LDB(B1, 1, 1); PG8_SCHED; PG8_LDA(At, 1, 0); PG8_STAGE(PG8_SA(0, 1), a2 + hstep, voffA);
            PG8_WAIT_V(8); PG8_WAIT_L(0); PG8_BAR; PG8_MMA(0, 0, At, B0); PG8_MMA(0, 1, At, B1); PG8_BAR; PG8_SCHED;
            PG8_LDA(At, 1, 1); PG8_STAGE(PG8_SB(1, 0), b3, voffB); PG8_STAGE(PG8_SB(1, 1), b3 + hstep, voffB); PG8_STAGE(PG8_SA(1, 0), a3, voffA);
            PG8_WAIT_V(8); PG8_WAIT_L(0); PG8_BAR; PG8_MMA(1, 0, At, B0); PG8_MMA(1, 1, At, B1); PG8_BAR; PG8_SCHED;
            } else {
            PG8_LDB(B0, 0, 0); PG8_SCHED; PG8_LDA(At, 0, 0); PG8_STAGE(PG8_SA(1, 1), a1 + hstep, voffA);
            PG8_WAIT_L(8); PG8_BAR; PG8_WAIT_L(0); PG8_MMA(0, 0, At, B0); PG8_BAR; PG8_SCHED;
            PG8_LDB(B1, 0, 1); PG8_STAGE(PG8_SB(0, 0), b2, voffB);
            PG8_BAR; PG8_WAIT_L(0); PG8_MMA(0, 1, At, B1); PG8_BAR;
            PG8_LDA(At, 0, 1); PG8_STAGE(PG8_SA(0, 0), a2, voffA);
            PG8_BAR; PG8_WAIT_L(0); PG8_MMA(1, 0, At, B0); PG8_BAR; PG8_SCHED;
            PG8_STAGE(PG8_SB(0, 1), b2 + hstep, voffB);
            PG8_WAIT_V(6); PG8_BAR; PG8_MMA(1, 1, At, B1); PG8_BAR;
            PG8_LDB(B0, 1, 0); PG8_SCHED; PG8_LDA(At, 1, 0); PG8_STAGE(PG8_SA(0, 1), a2 + hstep, voffA);
            PG8_WAIT_L(8); PG8_BAR; PG8_WAIT_L(0); PG8_MMA(0, 0, At, B0); PG8_BAR; PG8_SCHED;
            PG8_LDB(B1, 1, 1); PG8_STAGE(PG8_SB(1, 0), b3, voffB);
            PG8_BAR; PG8_WAIT_L(0); PG8_MMA(0, 1, At, B1); PG8_BAR;
            PG8_LDA(At, 1, 1); PG8_STAGE(PG8_SA(1, 0), a3, voffA);
            PG8_BAR; PG8_WAIT_L(0); PG8_MMA(1, 0, At, B0); PG8_BAR; PG8_SCHED;
            PG8_STAGE(PG8_SB(1, 1), b3 + hstep, voffB);
            PG8_WAIT_V(6); PG8_BAR; PG8_MMA(1, 1, At, B1); PG8_BAR;
            }
        }
        if constexpr (ALIGN_EPI) { if (wr == 0) PG8_BAR; }
        if constexpr (!Epi::AFTER_DRAIN) { E(acc, cur, wr, wc, fr, fq); S.done(cur); }
        if (!has_next) break;
#pragma unroll
        for (int a = 0; a < 2; ++a)
#pragma unroll
            for (int b = 0; b < 2; ++b)
#pragma unroll
                for (int m = 0; m < 4; ++m)
#pragma unroll
                    for (int n = 0; n < 2; ++n) acc[a][b][m][n] = (f32x4){0.f, 0.f, 0.f, 0.f};
        cur = nxt; cA = nA; cB = nB; ++ui;
        if constexpr (ALIGN_EPI) { if (wr == 1) PG8_BAR; }
    }
    PG8_WAIT_V(0);
    if constexpr (!ALIGN_EPI) { if (wr == 0) PG8_BAR; }
    PG8_BAR;
    if constexpr (Epi::AFTER_DRAIN) { E.fused(acc, cur, wr, wc, fr, fq, lds, wid, lane); S.done(cur); }
#undef PG8_SA
#undef PG8_SB
#undef PG8_STAGE
#undef PG8_LDA
#undef PG8_LDB
#undef PG8_MMA
#undef PG8_WAIT_V
#undef PG8_WAIT_L
#undef PG8_BAR
#undef PG8_SCHED
}
}

struct Ctx {
    unsigned aoff; int l;
    unsigned char* ws;
    DI float* X() const { return GP(float, ws + WS_X); }
    DI bf16_t* H() const { return GP(bf16_t, ws + WS_H); }
    DI bf16_t* P() const { return GP(bf16_t, ws + WS_P); }
    DI bf16_t* QP() const { return GP(bf16_t, ws + WS_P); }
    DI bf16_t* MIX() const { return GP(bf16_t, ws + WS_MIX); }
    DI float* OF() const { return GP(float, ws + WS_OF); }
    DI float* OB() const { return GP(float, ws + WS_OB); }
    DI int* PIDX() const { return GP(int, ws + WS_PIDX); }
    DI float* PG() const { return GP(float, ws + WS_PG); }
    DI float* MOD() const { return GP(float, ws + WS_MOD); }
    DI float* LB() const { return GP(float, ws + WS_LB); }
    DI float* ROPE() const { return GP(float, ws + WS_ROPE); }
    DI bf16_t* WIN() const { return GP(bf16_t, ws + WS_WIN); }
    DI bf16_t* WOUT() const { return GP(bf16_t, ws + WS_WOUT); }
    DI bf16_t* WQ() const { return GP(bf16_t, ws + WS_WQ); }
    DI bf16_t* UB() const { return GP(bf16_t, ws + WS_UB); }
    DI float* ST() const { return GP(float, ws + WS_OF); }
    DI float* AC() const { return GP(float, ws + WS_AC); }
    DI float* PA() const { return GP(float, ws + WS_PA); }
    DI float* VS() const { return GP(float, ws + WS_VS); }
    DI float* US() const { return GP(float, ws + WS_US); }
    DI bf16_t* SKH() const { return GP(bf16_t, ws + WS_SKH); }
    DI bf16_t* SKL() const { return GP(bf16_t, ws + WS_SKL); }
    DI bf16_t* VB() const { return GP(bf16_t, ws + WS_VB); }
    DI unsigned char* H8() const { return GP(unsigned char, ws + WS_H8); }
    DI float* HS() const { return GP(float, ws + WS_HS); }
    unsigned char* lds; int tid, lane, wave, gw, ngw, bid, nb;
    int xg, nxg, jx, nloc;
};

#define LAS __attribute__((address_space(3)))
DI void transpose_item(const float* W, int Kd, int N, bf16_t* WT, LAS float* scr, int item, int lane) {
    const int nblk = N / 32, kb = item / nblk, nb = item % nblk, k0 = 64 * kb, n0 = 32 * nb;
#pragma unroll 8
    for (int i = 0; i < 32; ++i) { const int kk = 2 * i + (lane >> 5); scr[kk * 33 + (lane & 31)] = W[(size_t)(k0 + kk) * N + n0 + (lane & 31)]; }
    asm volatile("s_waitcnt lgkmcnt(0)" ::: "memory");
    const int c = lane & 7;
#pragma unroll
    for (int j = 0; j < 4; ++j) { const int n = (lane >> 3) + 8 * j; const LAS float* sp = scr + (8 * c) * 33 + n;
        u32x4 o; o.x = pk2(sp[0 * 33], sp[1 * 33]); o.y = pk2(sp[2 * 33], sp[3 * 33]); o.z = pk2(sp[4 * 33], sp[5 * 33]); o.w = pk2(sp[6 * 33], sp[7 * 33]);
        *(u32x4*)(WT + (size_t)(n0 + n) * Kd + k0 + 8 * c) = o; }
    asm volatile("s_waitcnt lgkmcnt(0)" ::: "memory");
}

template <class T> DI T* argp_(const Ctx& K, unsigned off) {
    const unsigned* p = (const unsigned*)(K.lds + K.aoff + off);
    const unsigned lo = __builtin_amdgcn_readfirstlane(p[0]), hi = __builtin_amdgcn_readfirstlane(p[1]);
    return GP(T, ((unsigned long long)hi << 32) | (unsigned long long)lo);
}
#define ARG(f) argp_<const float>(K, (unsigned)__builtin_offsetof(Args, f))

DI void ph_prologue(Ctx& K) {
    {
        LAS float* scr = (LAS float*)((LAS unsigned char*)K.lds + K.wave * 16384);
        constexpr int I_IN = (D / 64) * (PW / 32), I_OUT = (D / 64) * (D / 32), I_Q = (D / 64) * (2048 / 32), I_L = I_IN + I_OUT + I_Q;
        for (int it = K.gw; it < DEPTH * I_L; it += K.ngw) {
            const int l = it / I_L; int r = it % I_L;
            if (r < I_IN) { transpose_item(ARG(w_in) + (size_t)l * D * PW, D, PW, K.WIN() + (size_t)l * PW * D, scr, r, K.lane); continue; } r -= I_IN;
            if (r < I_OUT) { transpose_item(ARG(w_out) + (size_t)l * D * D, D, D, K.WOUT() + (size_t)l * D * D, scr, r, K.lane); continue; } r -= I_OUT;
            transpose_item(ARG(peer_wq) + (size_t)l * D * 2048, D, 2048, K.WQ() + (size_t)l * 2048 * D, scr, r, K.lane);
        }
    }
    const size_t gt = (size_t)K.bid * NTHREADS + K.tid, gs = (size_t)K.nb * NTHREADS;
    { const f32x4* s0 = (const f32x4*)ARG(ctx); const f32x4* s1 = (const f32x4*)ARG(x); f32x4* d = (f32x4*)K.X();
      const size_t n0 = (size_t)NCTX * D / 4, n1 = (size_t)NLAT * D / 4;
      for (size_t i = gt; i < n0 + n1; i += gs) d[i] = i < n0 ? s0[i] : s1[i - n0]; }
    { const float* sk = ARG(peer_sk);
      for (size_t i = gt; i < (size_t)DEPTH * 8 * 2 * 128 * 128; i += gs) { const float v = sk[i]; const bf16_t hi = f2bf(v);
          const size_t lhp = i >> 14; const int key = (int)(i >> 7) & 127, d = (int)i & 127;
          const size_t o = (((lhp * 8 + (key >> 4)) * 4 + (d >> 5)) * 64 + (key & 15) + 16 * ((d >> 3) & 3)) * 8 + (d & 7);
          K.SKH()[o] = hi; K.SKL()[o] = f2bf(v - bf2f(hi)); } }
    { const float* pu = ARG(peer_u); unsigned char* UQ = (unsigned char*)K.UB();
      for (int row0 = K.gw; row0 < DEPTH * 16384; row0 += 2 * K.ngw) {
          f32x4 v2[2][4];
#pragma unroll
          for (int t = 0; t < 2; ++t) { const int row = min(row0 + t * K.ngw, DEPTH * 16384 - 1); const f32x4* src = (const f32x4*)(pu + (size_t)row * D);
#pragma unroll
              for (int j = 0; j < 4; ++j) v2[t][j] = src[j * 64 + K.lane]; }
#pragma unroll
          for (int t = 0; t < 2; ++t) { const int row = row0 + t * K.ngw; if (row >= DEPTH * 16384) break;
              float mx = 0.f;
#pragma unroll
              for (int j = 0; j < 4; ++j) mx = fmaxf(mx, fmaxf(fmaxf(fabsf(v2[t][j].x), fabsf(v2[t][j].y)), fmaxf(fabsf(v2[t][j].z), fabsf(v2[t][j].w))));
#pragma unroll
              for (int o = 1; o < 64; o <<= 1) mx = fmaxf(mx, __shfl_xor(mx, o));
              const float sc = fmaxf(mx, 1e-30f) * (1.0f / 127.0f), inv = 1.0f / sc;
              if (K.lane == 0) K.US()[row] = sc;
#pragma unroll
              for (int j = 0; j < 4; ++j) { const int col = j * 256 + K.lane * 4; const f32x4 v = v2[t][j];
                  const unsigned q0 = (unsigned)((int)rintf(v.x * inv)) & 0xffu, q1 = (unsigned)((int)rintf(v.y * inv)) & 0xffu, q2 = (unsigned)((int)rintf(v.z * inv)) & 0xffu, q3 = (unsigned)((int)rintf(v.w * inv)) & 0xffu;
                  *(unsigned*)(UQ + (size_t)row * D + col) = q0 | (q1 << 8) | (q2 << 16) | (q3 << 24); } } } }
    { const float* pv = ARG(peer_v); unsigned char* VQ = (unsigned char*)K.VB();
      for (int row0 = K.gw; row0 < DEPTH * 16384; row0 += 2 * K.ngw) {
          f32x4 v2[2][4];
#pragma unroll
          for (int t = 0; t < 2; ++t) { const int row = min(row0 + t * K.ngw, DEPTH * 16384 - 1); const f32x4* src = (const f32x4*)(pv + (size_t)row * D);
#pragma unroll
              for (int j = 0; j < 4; ++j) v2[t][j] = src[j * 64 + K.lane]; }
#pragma unroll
          for (int t = 0; t < 2; ++t) { const int row = row0 + t * K.ngw; if (row >= DEPTH * 16384) break;
              float mx = 0.f;
#pragma unroll
              for (int j = 0; j < 4; ++j) mx = fmaxf(mx, fmaxf(fmaxf(fabsf(v2[t][j].x), fabsf(v2[t][j].y)), fmaxf(fabsf(v2[t][j].z), fabsf(v2[t][j].w))));
#pragma unroll
              for (int o = 1; o < 64; o <<= 1) mx = fmaxf(mx, __shfl_xor(mx, o));
              const float sc = fmaxf(mx, 1e-30f) * (1.0f / 127.0f), inv = 1.0f / sc;
              if (K.lane == 0) K.VS()[row] = sc;
              const int l = row >> 14, e = row & 16383;
#pragma unroll
              for (int j = 0; j < 4; ++j) { const int col = j * 256 + K.lane * 4; const f32x4 v = v2[t][j];
                  const unsigned q0 = (unsigned)((int)rintf(v.x * inv) + 128), q1 = (unsigned)((int)rintf(v.y * inv) + 128), q2 = (unsigned)((int)rintf(v.z * inv) + 128), q3 = (unsigned)((int)rintf(v.w * inv) + 128);
                  *(unsigned*)(VQ + (((size_t)l * 8 + (col >> 7)) * 16384 + e) * 128 + (col & 127)) = q0 | (q1 << 8) | (q2 << 16) | (q3 << 24); } } } }
    { float* sv = (float*)K.lds;
      float* part = sv + 3 * D;
      __syncthreads();
      for (int i = K.tid; i < 3 * D; i += NTHREADS) { const int v = i / D, k = i % D; const float c = v < 2 ? ARG(c)[v * D + k] : ARG(c_ctx)[k]; sv[i] = c * sigmoidf_(c); }
      __syncthreads();
      for (int item = K.bid; item < DEPTH * 24; item += K.nb) {
          const int l = item / 24, cb = item % 24;
          const float* w = ARG(w_mod) + (size_t)l * D * 6 * D + cb * 256 + K.lane * 4;
          f32x4 a0 = {0.f, 0.f, 0.f, 0.f}, a1 = a0, a2 = a0;
#pragma unroll 8
          for (int kk = 0; kk < 128; ++kk) { const int k = K.wave * 128 + kk; const f32x4 wv = *(const f32x4*)(w + (size_t)k * 6 * D);
              a0 += wv * sv[k]; a1 += wv * sv[D + k]; a2 += wv * sv[2 * D + k]; }
          *(f32x4*)(part + (K.wave * 3 + 0) * 256 + K.lane * 4) = a0; *(f32x4*)(part + (K.wave * 3 + 1) * 256 + K.lane * 4) = a1; *(f32x4*)(part + (K.wave * 3 + 2) * 256 + K.lane * 4) = a2;
          __syncthreads();
          for (int i = K.tid; i < 768; i += NTHREADS) { const int v = i / 256, cc = i % 256; float sum = 0.f;
#pragma unroll
              for (int w8 = 0; w8 < 8; ++w8) sum += part[(w8 * 3 + v) * 256 + cc];
              const int col = cb * 256 + cc; K.MOD()[((size_t)l * 3 + v) * 6 * D + col] = sum + ARG(b_mod)[(size_t)l * 6 * D + col]; }
          __syncthreads();
      } }
    for (size_t i = gt; i < 2 * 256; i += gs) {
        const int dir = (int)(i / 256), ch = (int)(i % 256);
        float lg[DEPTH], mx = -1e30f;
#pragma unroll
        for (int l = 0; l < DEPTH; ++l) { lg[l] = ARG(lb_logits)[((size_t)dir * DEPTH + l) * 256 + ch]; mx = fmaxf(mx, lg[l]); }
        float s = 0.f;
#pragma unroll
        for (int l = 0; l < DEPTH; ++l) { lg[l] = expf(lg[l] - mx); s += lg[l]; }
        float cum = 0.f;
#pragma unroll
        for (int l = 0; l < DEPTH; ++l) { if (l > 0) cum += lg[l] / s; K.LB()[((size_t)dir * DEPTH + l) * 256 + ch] = cum; }
    }
    for (size_t i = gt; i < (256 + 64) * 16; i += gs) {
        const int pos = (int)(i / 16), f = (int)(i % 16);
        const float inv = powf(10000.0f, -(float)f / 16.0f);
        if (pos < 256) { const float ang = (float)pos * inv; K.ROPE()[pos * 16 + f] = cosf(ang); K.ROPE()[4096 + pos * 16 + f] = sinf(ang); }
        else { const int pc = pos - 256; const float ang = (float)pc * inv; K.ROPE()[8192 + pc * 16 + f] = cosf(ang); K.ROPE()[8192 + 1024 + pc * 16 + f] = sinf(ang); }
    }
}

DI void ph_norm(Ctx& K, const float* nw, int shift_chunk) {
    const float* modl = K.MOD() + (size_t)K.l * 3 * 6 * D;
    for (int r = K.gw; r < M; r += K.ngw) {
        const f32x4* xr = (const f32x4*)(K.X() + (size_t)r * D);
        f32x4 v[4]; float ss = 0.f;
#pragma unroll
        for (int j = 0; j < 4; ++j) { v[j] = xr[j * 64 + K.lane]; ss += v[j].x * v[j].x + v[j].y * v[j].y + v[j].z * v[j].z + v[j].w * v[j].w; }
        ss = wave_sum(ss);
        const float rs = rsqrtf(ss * (1.0f / D) + EPS);
        const float* mv = modl + (size_t)modvec_of_row(r) * 6 * D;
        u32x2* ho = (u32x2*)(K.H() + (size_t)r * D);
#pragma unroll
        for (int j = 0; j < 4; ++j) {
            const int c4 = j * 64 + K.lane;
            const f32x4 w = ((const f32x4*)nw)[c4], sh = ((const f32x4*)(mv + shift_chunk * D))[c4], sc = ((const f32x4*)(mv + (shift_chunk + 1) * D))[c4];
            f32x4 y; y.x = v[j].x * rs * w.x * (1.f + sc.x) + sh.x; y.y = v[j].y * rs * w.y * (1.f + sc.y) + sh.y; y.z = v[j].z * rs * w.z * (1.f + sc.z) + sh.z; y.w = v[j].w * rs * w.w * (1.f + sc.w) + sh.w;
            u32x2 o; o.x = pk2(y.x, y.y); o.y = pk2(y.z, y.w); ho[c4] = o;
            if (shift_chunk == 3) { v[j].x = __uint_as_float(o.x << 16); v[j].y = __uint_as_float(o.x & 0xffff0000u); v[j].z = __uint_as_float(o.y << 16); v[j].w = __uint_as_float(o.y & 0xffff0000u); }
        }
        if (shift_chunk == 3) {
            float mx = 0.f;
#pragma unroll
            for (int j = 0; j < 4; ++j) mx = fmaxf(mx, fmaxf(fmaxf(fabsf(v[j].x), fabsf(v[j].y)), fmaxf(fabsf(v[j].z), fabsf(v[j].w))));
#pragma unroll
            for (int o = 1; o < 64; o <<= 1) mx = fmaxf(mx, __shfl_xor(mx, o));
            const float sc = fmaxf(mx, 1e-30f) * (1.0f / 127.0f), inv = 1.0f / sc;
            if (K.lane == 0) K.HS()[r] = sc;
#pragma unroll
            for (int j = 0; j < 4; ++j) { const unsigned q0 = (unsigned)((int)rintf(v[j].x * inv)) & 0xffu, q1 = (unsigned)((int)rintf(v[j].y * inv)) & 0xffu, q2 = (unsigned)((int)rintf(v[j].z * inv)) & 0xffu, q3 = (unsigned)((int)rintf(v[j].w * inv)) & 0xffu;
                *(unsigned*)(K.H8() + (size_t)r * D + (j * 64 + K.lane) * 4) = q0 | (q1 << 8) | (q2 << 16) | (q3 << 24); }
        }
    }
}

typedef short sg_bf16x8 __attribute__((ext_vector_type(8)));
template <int NT, bool RESID> DI void sg_ctx(Ctx& K, const bf16_t* A, const bf16_t* Bt, bf16_t* out, float* X, const float* gate) {
    constexpr int N = 1024 * NT, RS = 272, OFF_B = 64 * RS, BUF = (64 + 32 * NT) * RS;
    int tid = K.tid; asm volatile("" : "+v"(tid));
    const int lane = tid & 63, wave = __builtin_amdgcn_readfirstlane(tid >> 6), r16 = lane & 15, g4 = lane >> 4, mt = wave & 3, nh = wave >> 2;
    const int lrow = tid >> 4, lc = tid & 15;
    for (int u = K.bid; u < 256; u += K.nb) {
        const int xcd = u & 7, j = u >> 3, ct = xcd * 4 + (j & 3), rt = j >> 2;
        const int row0 = 64 * rt, col0 = 32 * NT * ct;
        const bf16_t* ga = A + (size_t)(row0 + lrow) * D + 8 * lc; const bf16_t* gb = Bt + (size_t)(col0 + lrow) * D + 8 * lc;
        u32x4 ra[3][2], rb[3][NT];
        f32x4 acc[NT];
#pragma unroll
        for (int n = 0; n < NT; ++n) acc[n] = (f32x4){0.f, 0.f, 0.f, 0.f};
#define SG_LOAD(s_, c_) do { ra[s_][0] = *(const u32x4*)(ga + 128 * (c_)); ra[s_][1] = *(const u32x4*)(ga + 32 * D + 128 * (c_)); \
        _Pragma("unroll") for (int i_ = 0; i_ < NT; ++i_) rb[s_][i_] = *(const u32x4*)(gb + (size_t)32 * i_ * D + 128 * (c_)); } while (0)
        SG_LOAD(0, 0); SG_LOAD(1, 1); SG_LOAD(2, 2);
        __syncthreads();
#pragma unroll
        for (int c = 0; c < 8; ++c) {
            unsigned char* buf = K.lds + (c & 1) * BUF;
            *(u32x4*)(buf + lrow * RS + 16 * lc) = ra[c % 3][0]; *(u32x4*)(buf + (lrow + 32) * RS + 16 * lc) = ra[c % 3][1];
#pragma unroll
            for (int i = 0; i < NT; ++i) *(u32x4*)(buf + OFF_B + (lrow + 32 * i) * RS + 16 * lc) = rb[c % 3][i];
            if (c + 3 < 8) SG_LOAD(c % 3, c + 3);
            __syncthreads();
#pragma unroll
            for (int ks = 0; ks < 4; ++ks) {
                const sg_bf16x8 af = *(const sg_bf16x8*)(buf + (16 * mt + r16) * RS + 64 * ks + 16 * g4);
#pragma unroll
                for (int n = 0; n < NT; ++n) { const sg_bf16x8 bf = *(const sg_bf16x8*)(buf + OFF_B + (16 * (NT * nh + n) + r16) * RS + 64 * ks + 16 * g4);
                    acc[n] = __builtin_amdgcn_mfma_f32_16x16x32_bf16(bf, af, acc[n], 0, 0, 0); }
            }
        }
#undef SG_LOAD
        const int row = row0 + 16 * mt + r16;
#pragma unroll
        for (int n = 0; n < NT; ++n) { const int col = col0 + 16 * (NT * nh + n) + 4 * g4;
            if constexpr (RESID) { float* xp = X + (size_t)row * D + col; const f32x4 g = *(const f32x4*)(gate + col); f32x4 x = *(const f32x4*)xp; x += g * acc[n]; *(f32x4*)xp = x; }
            else { u32x2 o; o.x = pk2(acc[n][0], acc[n][1]); o.y = pk2(acc[n][2], acc[n][3]); *(u32x2*)(out + (size_t)row * N + col) = o; } }
        __syncthreads();
    }
}
DI void ph_gemm_store(Ctx& K, const bf16_t* A, const bf16_t* Bt, int N, bf16_t* out, const float* rope) {
    { pg8::Gemm g{A + (size_t)NCTX * D, Bt, NLAT, N, D}; pg8::StaticOrder S; S.init(NLAT, N, K.nb, K.bid);
      pg8::EpiStore E{out, N, (LAS unsigned char*)K.lds, rope, NCTX, L, NCTX};
      pg8::gemm_phase<pg8::EpiStore, pg8::StaticOrder, true, true>((LAS unsigned char*)K.lds, g, S, E); }
    if (N == PW) sg_ctx<3, false>(K, A, Bt, out, nullptr, nullptr); else sg_ctx<2, false>(K, A, Bt, out, nullptr, nullptr);
}
DI void ph_gemm_resid(Ctx& K, const bf16_t* A, const bf16_t* Bt, int chunk) {
    const float* gate = K.MOD() + (size_t)K.l * 3 * 6 * D + (size_t)chunk * D;
    { pg8::Gemm g{A + (size_t)NCTX * D, Bt, NLAT, D, D}; pg8::StaticOrder S; S.init(NLAT, D, K.nb, K.bid);
      pg8::EpiResid E{K.X(), D, gate, 6 * D, NCTX, L, (LAS unsigned char*)K.lds, NCTX};
      pg8::gemm_phase<pg8::EpiResid, pg8::StaticOrder, true, true>((LAS unsigned char*)K.lds, g, S, E); }
    sg_ctx<1, true>(K, A, Bt, nullptr, K.X(), gate + (size_t)2 * 6 * D);
}

DI void ph_rope(Ctx& K) {
    const float* cosr = K.ROPE(); const float* sinr = K.ROPE() + 4096; const float* cosc = K.ROPE() + 8192; const float* sinc = K.ROPE() + 8192 + 1024;
    const size_t gt = (size_t)K.bid * NTHREADS + K.tid, gs = (size_t)K.nb * NTHREADS;
    for (size_t i = gt; i < (size_t)NLAT * 8 * 16; i += gs) {
        const int f = (int)(i & 15), hh = (int)((i >> 4) & 7), lr = (int)(i >> 7);
        const int t = lr % L, pr = t >> 6, pc = t & 63;
        bf16_t* p = K.P() + (size_t)(NCTX + lr) * PW + (hh < 6 ? C_SQ + hh * 64 : C_SK + (hh - 6) * 64);
        const float c1 = cosr[pr * 16 + f], s1 = sinr[pr * 16 + f], c2 = cosc[pc * 16 + f], s2 = sinc[pc * 16 + f];
        const float a = bf2f(p[f]), b = bf2f(p[16 + f]), e = bf2f(p[32 + f]), g = bf2f(p[48 + f]);
        p[f] = f2bf(a * c1 - b * s1); p[16 + f] = f2bf(b * c1 + a * s1); p[32 + f] = f2bf(e * c2 - g * s2); p[48 + f] = f2bf(g * c2 + e * s2);
    }
}

typedef short bf16x8_t __attribute__((ext_vector_type(8)));
#define MFMA16(a, b, c) __builtin_amdgcn_mfma_f32_16x16x32_bf16((a), (b), (c), 0, 0, 0)
constexpr int HG_NCH = (CL + L) / 64;
constexpr int HG_LFS = 68;
constexpr int HG_TS = 72;
constexpr int HGL_LF = 0, HGL_OM = HGL_LF + 2 * 64 * HG_LFS * 4, HGL_VT = HGL_OM + 2 * 64 * HG_LFS * 4, HGL_KT = HGL_VT + 64 * HG_TS * 2, HGL_SC = HGL_KT, HGL_OD = HGL_SC + 8 * 16 * HG_TS * 2, HGL_END = HGL_OD + 2 * 64 * HG_LFS * 4;
static_assert(HGL_KT + 2 * 64 * HG_TS * 2 <= LDS_BYTES && HGL_END <= LDS_BYTES, "hgrn LDS map");
DI int hg_block_row(int b, int tb, int tok) { return tb < 4 ? ctx_row(b, tb * 64 + tok) : lat_row(b, (tb - 4) * 64 + tok); }
DI int hg_bwd_chunk(int tb) { return tb < 4 ? 3 - tb : 4 + 255 - (tb - 4); }
DI void hg_prep(Ctx& K, int b, int h, int tb) {
    float* LF = (float*)(K.lds + HGL_LF); float* OM = (float*)(K.lds + HGL_OM); bf16_t* VT = (bf16_t*)(K.lds + HGL_VT);
    const int tok = K.tid >> 3, c = K.tid & 7;
    const bf16_t* pr = K.P() + (size_t)hg_block_row(b, tb, tok) * PW + h * 64 + 8 * c;
#pragma unroll
    for (int dir = 0; dir < 2; ++dir) {
        float z[8]; unpack8(*(const u32x4*)(pr + (dir ? C_ZB : C_ZF)), z);
        const float* lb = K.LB() + ((size_t)dir * DEPTH + K.l) * 256 + h * 64 + 8 * c;
        float lf[8], om[8];
#pragma unroll
        for (int j = 0; j < 8; ++j) { const float lbv = lb[j], sg = sigmoidf_(z[j]); const float f = fmaxf(lbv + (1.f - lbv) * sg, 1e-30f); lf[j] = __logf(f); om[j] = (1.f - lbv) * (1.f - sg); }
        float* lfp = LF + (dir * 64 + tok) * HG_LFS + 8 * c; float* omp = OM + (dir * 64 + tok) * HG_LFS + 8 * c;
        *(f32x4*)lfp = (f32x4){lf[0], lf[1], lf[2], lf[3]}; *(f32x4*)(lfp + 4) = (f32x4){lf[4], lf[5], lf[6], lf[7]};
        *(f32x4*)omp = (f32x4){om[0], om[1], om[2], om[3]}; *(f32x4*)(omp + 4) = (f32x4){om[4], om[5], om[6], om[7]};
    }
    { const u32x4 v = *(const u32x4*)(pr + C_HV);
      const unsigned w[4] = {v.x, v.y, v.z, v.w};
#pragma unroll
      for (int j = 0; j < 4; ++j) { VT[(8 * c + 2 * j) * HG_TS + tok] = (bf16_t)(w[j] & 0xffffu); VT[(8 * c + 2 * j + 1) * HG_TS + tok] = (bf16_t)(w[j] >> 16); } }
    __syncthreads();
    if (K.tid < 128) {
        const int dir = K.tid >> 6, d = K.tid & 63; float* col = LF + dir * 64 * HG_LFS + d;
        float v[64];
#pragma unroll
        for (int p = 0; p < 64; ++p) v[p] = col[(dir ? 63 - p : p) * HG_LFS];
#pragma unroll
        for (int p = 1; p < 64; ++p) v[p] += v[p - 1];
#pragma unroll
        for (int p = 0; p < 64; ++p) col[(dir ? 63 - p : p) * HG_LFS] = v[p];
    }
    __syncthreads();
}
DI void ph_hgrn_A(Ctx& K) {
    float* LF = (float*)(K.lds + HGL_LF); float* OM = (float*)(K.lds + HGL_OM); bf16_t* VT = (bf16_t*)(K.lds + HGL_VT); bf16_t* KT = (bf16_t*)(K.lds + HGL_KT);
    const int r16 = K.lane & 15, g4 = K.lane >> 4;
    for (int item = K.bid; item < NB * 4 * HG_NCH; item += K.nb) {
        const int tb = item % HG_NCH, h = (item / HG_NCH) & 3, b = item / (HG_NCH * 4);
        __syncthreads();
        hg_prep(K, b, h, tb);
        { const int tok = K.tid >> 3, c = K.tid & 7;
#pragma unroll
          for (int dir = 0; dir < 2; ++dir) {
              const float* bl = LF + (dir * 64 + (dir ? 0 : 63)) * HG_LFS + 8 * c; const float* bt = LF + (dir * 64 + tok) * HG_LFS + 8 * c; const float* om = OM + (dir * 64 + tok) * HG_LFS + 8 * c;
#pragma unroll
              for (int j = 0; j < 8; ++j) KT[(dir * 64 + 8 * c + j) * HG_TS + tok] = f2bf(om[j] * __expf(bl[j] - bt[j]));
          }
          if (K.tid < 128) { const int dir = K.tid >> 6, d = K.tid & 63; const int chain = (b * 2 + dir) * 4 + h, ch = dir ? hg_bwd_chunk(tb) : tb;
              K.AC()[((size_t)chain * HG_NCH + ch) * 64 + d] = __expf(LF[(dir * 64 + (dir ? 0 : 63)) * HG_LFS + d]); } }
        __syncthreads();
        { const int dir = K.wave >> 2, mi = K.wave & 3; const int chain = (b * 2 + dir) * 4 + h, ch = dir ? hg_bwd_chunk(tb) : tb;
          f32x4 acc[4];
#pragma unroll
          for (int nj = 0; nj < 4; ++nj) acc[nj] = (f32x4){0.f, 0.f, 0.f, 0.f};
#pragma unroll
          for (int ks = 0; ks < 2; ++ks) {
              const bf16x8_t av = *(const bf16x8_t*)(VT + (16 * mi + r16) * HG_TS + 32 * ks + 8 * g4);
#pragma unroll
              for (int nj = 0; nj < 4; ++nj) { const bf16x8_t bv = *(const bf16x8_t*)(KT + (dir * 64 + 16 * nj + r16) * HG_TS + 32 * ks + 8 * g4); acc[nj] = MFMA16(av, bv, acc[nj]); }
          }
          float* st = K.ST() + ((size_t)chain * HG_NCH + ch) * 4096;
#pragma unroll
          for (int nj = 0; nj < 4; ++nj)
#pragma unroll
              for (int rg = 0; rg < 4; ++rg) st[(16 * mi + 4 * g4 + rg) * 64 + 16 * nj + r16] = acc[nj][rg];
        }
    }
}
DI void ph_hgrn_B(Ctx& K) {
    const int gt = K.bid * NTHREADS + K.tid;
    if (gt < 16 * 4096) {
        const int chain = gt >> 12, idx = gt & 4095, d = idx & 63;
        float* st = K.ST() + (size_t)chain * HG_NCH * 4096 + idx; const float* ac = K.AC() + (size_t)chain * HG_NCH * 64 + d;
        float S = 0.f;
#pragma unroll 1
        for (int c0 = 0; c0 < HG_NCH; c0 += 26) {
            float u[26], a[26];
#pragma unroll
            for (int i = 0; i < 26; ++i) { u[i] = st[(size_t)(c0 + i) * 4096]; a[i] = ac[(c0 + i) * 64]; }
#pragma unroll
            for (int i = 0; i < 26; ++i) { st[(size_t)(c0 + i) * 4096] = S; S = a[i] * S + u[i]; }
        }
    }
}
DI void ph_hgrn_C(Ctx& K) {
    float* LF = (float*)(K.lds + HGL_LF); float* OM = (float*)(K.lds + HGL_OM); bf16_t* VT = (bf16_t*)(K.lds + HGL_VT); float* OD = (float*)(K.lds + HGL_OD);
    bf16_t* SC = (bf16_t*)(K.lds + HGL_SC) + K.wave * 16 * HG_TS;
    const int r16 = K.lane & 15, g4 = K.lane >> 4;
    for (int item = K.bid; item < NB * 4 * HG_NCH; item += K.nb) {
        const int tb = item % HG_NCH, h = (item / HG_NCH) & 3, b = item / (HG_NCH * 4);
        __syncthreads();
        hg_prep(K, b, h, tb);
        { const int dir = K.wave >> 2, mi = K.wave & 3; const int chain = (b * 2 + dir) * 4 + h, ch = dir ? hg_bwd_chunk(tb) : tb;
          const float* LFd = LF + dir * 64 * HG_LFS; const float* OMd = OM + dir * 64 * HG_LFS; const float* ref = LFd + 32 * HG_LFS;
          bf16x8_t aq1[2], aq2[2];
          { const int t = 16 * mi + r16; const bf16_t* qr = K.P() + (size_t)hg_block_row(b, tb, t) * PW + C_HQ + h * 64;
#pragma unroll
            for (int ks = 0; ks < 2; ++ks) { const int d0 = 32 * ks + 8 * g4; float q[8]; unpack8(*(const u32x4*)(qr + d0), q);
                u32x4 w1, w2; unsigned o1[4], o2[4];
#pragma unroll
                for (int j = 0; j < 4; ++j) { float x1[2], x2[2];
#pragma unroll
                    for (int e = 0; e < 2; ++e) { const int dd = d0 + 2 * j + e; const float qs = q[2 * j + e] * sigmoidf_(q[2 * j + e]); const float bt = LFd[t * HG_LFS + dd]; x1[e] = qs * __expf(bt - ref[dd]); x2[e] = qs * __expf(bt); }
                    o1[j] = pk2(x1[0], x1[1]); o2[j] = pk2(x2[0], x2[1]); }
                w1 = (u32x4){o1[0], o1[1], o1[2], o1[3]}; w2 = (u32x4){o2[0], o2[1], o2[2], o2[3]};
                aq1[ks] = __builtin_bit_cast(bf16x8_t, w1); aq2[ks] = __builtin_bit_cast(bf16x8_t, w2); } }
          f32x4 sc[4];
#pragma unroll
          for (int nj = 0; nj < 4; ++nj) { sc[nj] = (f32x4){0.f, 0.f, 0.f, 0.f}; const int s_ = 16 * nj + r16;
#pragma unroll
              for (int ks = 0; ks < 2; ++ks) { const int d0 = 32 * ks + 8 * g4; unsigned o[4];
#pragma unroll
                  for (int j = 0; j < 4; ++j) { const int dd = d0 + 2 * j; o[j] = pk2(OMd[s_ * HG_LFS + dd] * __expf(ref[dd] - LFd[s_ * HG_LFS + dd]), OMd[s_ * HG_LFS + dd + 1] * __expf(ref[dd + 1] - LFd[s_ * HG_LFS + dd + 1])); }
                  const u32x4 w = (u32x4){o[0], o[1], o[2], o[3]};
                  sc[nj] = MFMA16(aq1[ks], __builtin_bit_cast(bf16x8_t, w), sc[nj]); } }
#pragma unroll
          for (int nj = 0; nj < 4; ++nj)
#pragma unroll
              for (int rg = 0; rg < 4; ++rg) { const int tl = 4 * g4 + rg, t = 16 * mi + tl, s_ = 16 * nj + r16; const bool keep = dir ? (s_ >= t) : (s_ <= t);
                  SC[tl * HG_TS + s_] = f2bf(keep ? sc[nj][rg] : 0.f); }
          asm volatile("s_waitcnt lgkmcnt(0)" ::: "memory");
          f32x4 oacc[4];
#pragma unroll
          for (int nj = 0; nj < 4; ++nj) oacc[nj] = (f32x4){0.f, 0.f, 0.f, 0.f};
          const float* st = K.ST() + ((size_t)chain * HG_NCH + ch) * 4096;
#pragma unroll
          for (int ks = 0; ks < 2; ++ks) {
              const bf16x8_t as = *(const bf16x8_t*)(SC + r16 * HG_TS + 32 * ks + 8 * g4);
#pragma unroll
              for (int nj = 0; nj < 4; ++nj) {
                  const bf16x8_t bv = *(const bf16x8_t*)(VT + (16 * nj + r16) * HG_TS + 32 * ks + 8 * g4);
                  oacc[nj] = MFMA16(as, bv, oacc[nj]);
                  const float* sp = st + (16 * nj + r16) * 64 + 32 * ks + 8 * g4; const f32x4 s0 = *(const f32x4*)sp, s1 = *(const f32x4*)(sp + 4);
                  const u32x4 w = (u32x4){pk2(s0.x, s0.y), pk2(s0.z, s0.w), pk2(s1.x, s1.y), pk2(s1.z, s1.w)};
                  oacc[nj] = MFMA16(aq2[ks], __builtin_bit_cast(bf16x8_t, w), oacc[nj]);
              }
          }
#pragma unroll
          for (int nj = 0; nj < 4; ++nj)
#pragma unroll
              for (int rg = 0; rg < 4; ++rg) OD[(dir * 64 + 16 * mi + 4 * g4 + rg) * HG_LFS + 16 * nj + r16] = oacc[nj][rg];
        }
        __syncthreads();
        { const int tok = K.tid >> 3, c = K.tid & 7; const int row = hg_block_row(b, tb, tok);
          const float* o0 = OD + tok * HG_LFS + 8 * c; const float* o1 = OD + (64 + tok) * HG_LFS + 8 * c;
          float o[8], ss = 0.f;
#pragma unroll
          for (int j = 0; j < 8; ++j) { o[j] = o0[j] + o1[j]; ss += o[j] * o[j]; }
          ss += __shfl_xor(ss, 1); ss += __shfl_xor(ss, 2); ss += __shfl_xor(ss, 4);
          const float rs = rsqrtf(ss * (1.0f / 64.0f) + EPS);
          float gq[8]; unpack8(*(const u32x4*)(K.P() + (size_t)row * PW + C_HG + h * 64 + 8 * c), gq);
          const float* nw = ARG(hgrn_norm_w) + (size_t)K.l * 256 + h * 64 + 8 * c;
          float y[8];
#pragma unroll
          for (int j = 0; j < 8; ++j) y[j] = o[j] * rs * nw[j] * gq[j] * sigmoidf_(gq[j]);
          u32x4 w; w.x = pk2(y[0], y[1]); w.y = pk2(y[2], y[3]); w.z = pk2(y[4], y[5]); w.w = pk2(y[6], y[7]);
          *(u32x4*)(K.MIX() + (size_t)row * D + MX_H + h * 64 + 8 * c) = w; }
    }
}

constexpr int AT_TS = 72;
constexpr int ATL_K = 0, ATL_V = ATL_K + 64 * AT_TS * 2, ATL_P = ATL_V + 64 * AT_TS * 2, ATL_END = ATL_P + 8 * 48 * AT_TS * 2;
static_assert(ATL_END <= LDS_BYTES - 256, "attention LDS map");
DI float dpp_max16(float x) { x = fmaxf(x, dpp_<0xB1>(x)); x = fmaxf(x, dpp_<0x4E>(x)); x = fmaxf(x, dpp_<0x141>(x)); x = fmaxf(x, dpp_<0x128>(x)); return x; }
DI float dpp_sum16(float x) { x += dpp_<0xB1>(x); x += dpp_<0x4E>(x); x += dpp_<0x141>(x); x += dpp_<0x128>(x); return x; }
template <int KIND> DI void attn_item(Ctx& K, int idx, const float* sinkp, const float* rpbp) {
    constexpr int MT = KIND == 0 ? 3 : 2;
    int tid_ = K.tid; asm volatile("" : "+v"(tid_));
    const int lane_ = tid_ & 63, wave_ = tid_ >> 6;
    bf16_t* KT = (bf16_t*)(K.lds + ATL_K); bf16_t* VT = (bf16_t*)(K.lds + ATL_V); bf16_t* PS = (bf16_t*)(K.lds + ATL_P) + wave_ * 48 * AT_TS;
    const int r16 = lane_ & 15, g4 = lane_ >> 4;
    int b, hk, qb = 0;
    if (KIND == 0) { qb = idx & 127; hk = (idx >> 7) & 1; b = idx >> 8; }
    else if (KIND == 1) { qb = idx & 63; hk = (idx >> 6) % 6; b = (idx >> 6) / 6; }
    else { hk = idx % 6; b = idx / 6; }
    const int kcol = (KIND == 0) ? C_SK + hk * 64 : (KIND == 2) ? C_SK + (hk / 3) * 64 : C_NK + hk * 64;
    const int vcol = (KIND == 0) ? C_SV + hk * 64 : (KIND == 2) ? C_SV + (hk / 3) * 64 : C_NV + hk * 64;
    int t0 = 0, nloc = 0;
    if (KIND == 0) { const int k0 = max(2 * qb - 2, 0), k1 = min(2 * qb + 3, L / 64 - 1); t0 = k0; nloc = k1 - k0 + 1; }
    if (KIND == 1) { const int k0 = min(max(4 * qb - 4, 0), L / 64 - 8), k1 = min(max(4 * qb + 3 - 4, 0), L / 64 - 8) + 7; t0 = k0; nloc = k1 - k0 + 1; }
    const int ntiles = nloc + CL / 64;
    int w_r = 0, w_rs = 0;
    if (KIND == 1) { w_r = 4 * qb + (wave_ >> 1); w_rs = min(max(w_r - 4, 0), L / 64 - 8); }
    bf16x8_t qf[MT][2]; int qbase[MT], hq_mt[MT];
#pragma unroll
    for (int mt = 0; mt < MT; ++mt) {
        int arow, hq;
        if (KIND == 0) { const int rho = wave_ * 48 + mt * 16; hq = hk * 3 + rho / 128; hq_mt[mt] = hq; const int tb = 128 * qb + (rho & 127); arow = lat_row(b, tb + r16); qbase[mt] = tb; }
        else if (KIND == 1) { hq = hk; hq_mt[mt] = hq; const int cb = 32 * (wave_ & 1) + 16 * mt; arow = lat_row(b, w_r * 64 + cb + r16); qbase[mt] = cb; }
        else { hq = hk; hq_mt[mt] = hq; const int tb = wave_ * 32 + mt * 16; arow = ctx_row(b, tb + r16); qbase[mt] = 0; }
        const int qcol = (KIND == 0 || KIND == 2) ? C_SQ + hq * 64 : C_NQ + hq * 64;
#pragma unroll
        for (int ks = 0; ks < 2; ++ks) { float q[8]; unpack8(*(const u32x4*)(K.P() + (size_t)arow * PW + qcol + 32 * ks + 8 * g4), q);
            const u32x4 w = (u32x4){pk2(q[0] * 0.125f, q[1] * 0.125f), pk2(q[2] * 0.125f, q[3] * 0.125f), pk2(q[4] * 0.125f, q[5] * 0.125f), pk2(q[6] * 0.125f, q[7] * 0.125f)};
            qf[mt][ks] = __builtin_bit_cast(bf16x8_t, w); }
    }
    f32x4 oacc[MT][4]; float mrun[MT][4], lrun[MT][4];
#pragma unroll
    for (int mt = 0; mt < MT; ++mt) {
#pragma unroll
        for (int ne = 0; ne < 4; ++ne) oacc[mt][ne] = (f32x4){0.f, 0.f, 0.f, 0.f};
        const bool has_sink = (KIND == 0 || KIND == 2); const float sk = has_sink ? sinkp[hq_mt[mt]] : -1.0e30f;
#pragma unroll
        for (int rg = 0; rg < 4; ++rg) { mrun[mt][rg] = sk; lrun[mt][rg] = has_sink ? 1.0f : 0.0f; }
    }
    const int lkey = tid_ >> 3, lch = tid_ & 7;
    u32x4 pk_, pv_;
    { const int ti = 0; const int grow = (ti < nloc) ? lat_row(b, (t0 + ti) * 64 + lkey) : ctx_row(b, (ti - nloc) * 64 + lkey);
      const bf16_t* pr = K.P() + (size_t)grow * PW + 8 * lch; pk_ = *(const u32x4*)(pr + kcol); pv_ = *(const u32x4*)(pr + vcol); }
#pragma unroll 1
    for (int ti = 0; ti < ntiles; ++ti) {
        __syncthreads();
        *(u32x4*)(KT + lkey * AT_TS + 8 * lch) = pk_;
        { const unsigned w[4] = {pv_.x, pv_.y, pv_.z, pv_.w};
          const int vsw = (((lkey >> 3) ^ lch) << 3) + (lkey & 7);
#pragma unroll
          for (int j = 0; j < 4; ++j) { VT[(8 * lch + 2 * j) * AT_TS + vsw] = (bf16_t)(w[j] & 0xffffu); VT[(8 * lch + 2 * j + 1) * AT_TS + vsw] = (bf16_t)(w[j] >> 16); } }
        __syncthreads();
        if (ti + 1 < ntiles) { const int tn = ti + 1; const int grow = (tn < nloc) ? lat_row(b, (t0 + tn) * 64 + lkey) : ctx_row(b, (tn - nloc) * 64 + lkey);
            const bf16_t* pr = K.P() + (size_t)grow * PW + 8 * lch; pk_ = *(const u32x4*)(pr + kcol); pv_ = *(const u32x4*)(pr + vcol); }
        const bool local = ti < nloc; const int kunit = t0 + ti;
        bool active = true;
        if (KIND == 0 && local) active = true;
        if (KIND == 1 && local) active = (kunit >= w_rs) && (kunit < w_rs + 8);
        if (active) {
            f32x4 sc[MT][4];
#pragma unroll
            for (int mt = 0; mt < MT; ++mt)
#pragma unroll
                for (int nj = 0; nj < 4; ++nj) sc[mt][nj] = (f32x4){0.f, 0.f, 0.f, 0.f};
#pragma unroll
            for (int nj = 0; nj < 4; ++nj)
#pragma unroll
                for (int ks = 0; ks < 2; ++ks) { const bf16x8_t kf = *(const bf16x8_t*)(KT + (16 * nj + r16) * AT_TS + 32 * ks + 8 * g4);
#pragma unroll
                    for (int mt = 0; mt < MT; ++mt) sc[mt][nj] = MFMA16(qf[mt][ks], kf, sc[mt][nj]); }
            if (local) {
#pragma unroll
                for (int mt = 0; mt < MT; ++mt)
#pragma unroll
                    for (int nj = 0; nj < 4; ++nj)
#pragma unroll
                        for (int rg = 0; rg < 4; ++rg) { const int key = 16 * nj + r16;
                            if (KIND == 0) { const int dl = qbase[mt] + 4 * g4 + rg - (kunit * 64 + key); if (dl > 128 || dl < -128) sc[mt][nj][rg] = -INFINITY; }
                            if (KIND == 1) { const int c = qbase[mt] + 4 * g4 + rg, ws = min(max(c - 8, 0), 48);
                                if (key >= ws && key < ws + 16) sc[mt][nj][rg] += rpbp[(kunit - w_r + 7) * 31 + (key - c + 15)]; else sc[mt][nj][rg] = -INFINITY; } }
            }
#pragma unroll
            for (int mt = 0; mt < MT; ++mt)
#pragma unroll
                for (int rg = 0; rg < 4; ++rg) {
                    float mx = fmaxf(fmaxf(sc[mt][0][rg], sc[mt][1][rg]), fmaxf(sc[mt][2][rg], sc[mt][3][rg]));
                    mx = dpp_max16(mx);
                    const float mn = fmaxf(mrun[mt][rg], mx), alpha = __expf(mrun[mt][rg] - mn); mrun[mt][rg] = mn;
                    float rs_ = 0.f;
#pragma unroll
                    for (int nj = 0; nj < 4; ++nj) { const float pe = __expf(sc[mt][nj][rg] - mn); sc[mt][nj][rg] = pe; rs_ += pe; }
                    rs_ = dpp_sum16(rs_);
                    lrun[mt][rg] = lrun[mt][rg] * alpha + rs_;
#pragma unroll
                    for (int ne = 0; ne < 4; ++ne) oacc[mt][ne][rg] *= alpha;
                }
#pragma unroll
            for (int mt = 0; mt < MT; ++mt)
#pragma unroll
                for (int nj = 0; nj < 4; ++nj)
#pragma unroll
                    for (int rg = 0; rg < 4; ++rg) PS[(16 * mt + 4 * g4 + rg) * AT_TS + 16 * nj + r16] = f2bf(sc[mt][nj][rg]);
            asm volatile("s_waitcnt lgkmcnt(0)" ::: "memory");
#pragma unroll
            for (int ks = 0; ks < 2; ++ks) {
                bf16x8_t pf[MT];
#pragma unroll
                for (int mt = 0; mt < MT; ++mt) pf[mt] = *(const bf16x8_t*)(PS + (16 * mt + r16) * AT_TS + 32 * ks + 8 * g4);
#pragma unroll
                for (int ne = 0; ne < 4; ++ne) { const bf16x8_t vf = *(const bf16x8_t*)(VT + (16 * ne + r16) * AT_TS + (((4 * ks + g4) ^ ((2 * ne + (r16 >> 3)) & 7)) << 3));
#pragma unroll
                    for (int mt = 0; mt < MT; ++mt) oacc[mt][ne] = MFMA16(pf[mt], vf, oacc[mt][ne]); }
            }
            asm volatile("s_waitcnt lgkmcnt(0)" ::: "memory");
        }
    }
#pragma unroll
    for (int mt = 0; mt < MT; ++mt)
#pragma unroll
        for (int rg = 0; rg < 4; ++rg) { const float inv = 1.0f / lrun[mt][rg];
#pragma unroll
            for (int ne = 0; ne < 4; ++ne) PS[(16 * mt + 4 * g4 + rg) * AT_TS + 16 * ne + r16] = f2bf(oacc[mt][ne][rg] * inv); }
    asm volatile("s_waitcnt lgkmcnt(0)" ::: "memory");
#pragma unroll
    for (int mt = 0; mt < MT; ++mt) {
        const int ocol = ((KIND == 0 || KIND == 2) ? MX_S : MX_N) + hq_mt[mt] * 64;
#pragma unroll
        for (int i = 0; i < 2; ++i) { const int rr = (lane_ >> 3) + 8 * i, ch = lane_ & 7;
            const u32x4 v = *(const u32x4*)(PS + (16 * mt + rr) * AT_TS + 8 * ch);
            int grow;
            if (KIND == 0) { const int rho = wave_ * 48 + mt * 16; grow = lat_row(b, 128 * qb + (rho & 127) + rr); }
            else if (KIND == 1) grow = lat_row(b, w_r * 64 + 32 * (wave_ & 1) + 16 * mt + rr);
            else grow = ctx_row(b, wave_ * 32 + mt * 16 + rr);
            *(u32x4*)(K.MIX() + (size_t)grow * D + ocol + 8 * ch) = v; }
    }
    asm volatile("s_waitcnt lgkmcnt(0)" ::: "memory");
}
DI void ph_attn(Ctx& K) {
    constexpr int N_SWA = NB * 2 * (L / 128), N_NAT = NB * 6 * (L / 256), N_C = NB * 6;
    const float* sinkp = ARG(swa_sink) + K.l * 6;
    for (int item = K.bid; item < N_SWA + N_NAT + 2 * N_C; item += K.nb) {
        if (item < N_SWA) attn_item<0>(K, item, sinkp, nullptr);
        else if (item < N_SWA + N_NAT) { const int it = item - N_SWA; const int h = (it >> 6) % 6; attn_item<1>(K, it, nullptr, ARG(nat_rpb) + ((size_t)K.l * 6 + h) * 15 * 31); }
        else if (item < N_SWA + N_NAT + N_C) attn_item<2>(K, item - N_SWA - N_NAT, sinkp, nullptr);
        else attn_item<3>(K, item - N_SWA - N_NAT - N_C, nullptr, nullptr);
    }
}

DI unsigned fkey(float f) { const unsigned u = __float_as_uint(f); return (u & 0x80000000u) ? ~u : (u | 0x80000000u); }
DI int mbcnt64(unsigned long long m) { return (int)__builtin_amdgcn_mbcnt_hi((unsigned)(m >> 32), __builtin_amdgcn_mbcnt_lo((unsigned)m, 0u)); }
template <int NV> DI unsigned radix_thr16(const unsigned (&k)[NV]) {
    unsigned prefix = 0u;
#pragma unroll 1
    for (int bit = 31; bit >= 0; --bit) {
        const unsigned cand = prefix | (1u << bit); int cnt = 0;
#pragma unroll
        for (int i = 0; i < NV; ++i) cnt += __popcll(__ballot(k[i] >= cand));
        if (cnt >= 16) { prefix = cand; if (cnt == 16) break; }
    }
    return prefix;
}
template <int NC, int NV> DI void radix_thr16_multi(const unsigned (&k)[NC][NV], unsigned (&T)[NC]) {
    bool exact[NC];
#pragma unroll
    for (int c = 0; c < NC; ++c) { T[c] = 0u; exact[c] = false; }
#pragma unroll 1
    for (int bit = 31; bit >= 0; --bit) {
        bool all = true;
#pragma unroll
        for (int c = 0; c < NC; ++c) {
            const unsigned cand = T[c] | (1u << bit); int cnt = 0;
#pragma unroll
            for (int i = 0; i < NV; ++i) cnt += __popcll(__ballot(k[c][i] >= cand));
            if (cnt >= 16) { T[c] = cand; exact[c] = (cnt == 16); }
            all = all && exact[c];
        }
        if (all) break;
    }
}
template <int NV> DI void select16(const unsigned (&k)[NV], unsigned T, bool (&sel)[NV], int (&pos)[NV]) {
    int ngt = 0; unsigned long long gtm[NV], eqm[NV];
#pragma unroll
    for (int i = 0; i < NV; ++i) { gtm[i] = __ballot(k[i] > T); eqm[i] = __ballot(k[i] == T); ngt += __popcll(gtm[i]); }
    const int need = 16 - ngt; int eqbase = 0, selbase = 0;
#pragma unroll
    for (int i = 0; i < NV; ++i) {
        const bool iseq = k[i] == T; const int erank = eqbase + mbcnt64(eqm[i]); eqbase += __popcll(eqm[i]);
        sel[i] = (k[i] > T) || (iseq && erank < need);
        const unsigned long long sm = __ballot(sel[i]); pos[i] = selbase + mbcnt64(sm); selbase += __popcll(sm);
    }
}
template <int CTRL> DI int dppi_(int x) { return __builtin_amdgcn_mov_dpp(x, CTRL, 0xf, 0xf, true); }
DI int row_sum_i(int x) { x += dppi_<0xB1>(x); x += dppi_<0x4E>(x); x += dppi_<0x141>(x); x += dppi_<0x128>(x); return x; }
DI int row_excl_scan_i(int x) { int s_ = x; s_ += dppi_<0x111>(s_); s_ += dppi_<0x112>(s_); s_ += dppi_<0x114>(s_); s_ += dppi_<0x118>(s_); return s_ - x; }
DI unsigned row_minmax_u(unsigned x, bool want_max) {
    unsigned y;
    y = (unsigned)dppi_<0xB1>((int)x); x = want_max ? max(x, y) : min(x, y); y = (unsigned)dppi_<0x4E>((int)x); x = want_max ? max(x, y) : min(x, y);
    y = (unsigned)dppi_<0x141>((int)x); x = want_max ? max(x, y) : min(x, y); y = (unsigned)dppi_<0x128>((int)x); x = want_max ? max(x, y) : min(x, y);
    return x;
}
template <int NK> DI unsigned row_radix_thr16(const unsigned (&k)[NK]) {
    unsigned lm = k[0];
#pragma unroll
    for (int i = 1; i < NK; ++i) lm = max(lm, k[i]);
    unsigned lo = row_minmax_u(lm, false), hi = row_minmax_u(lm, true) + 1u;
    bool done = false;
#pragma unroll 1
    for (int itn = 0; itn < 40; ++itn) {
        const unsigned span = hi - lo; done = done || (span <= 1u);
        const unsigned mid = lo + (span >> 1); int cnt = 0;
#pragma unroll
        for (int i = 0; i < NK; ++i) cnt += (k[i] >= mid) ? 1 : 0;
        cnt = row_sum_i(cnt);
        const bool ge = cnt >= 16;
        if (!done) { if (ge) lo = mid; else hi = mid; }
        done = done || (cnt == 16);
        if (__ballot(!done) == 0ull) break;
    }
    return lo;
}
template <int NK> DI void row_select16(const unsigned (&k)[NK], unsigned T, bool (&sel)[NK], int (&pos)[NK]) {
    int g = 0, q = 0;
#pragma unroll
    for (int i = 0; i < NK; ++i) { g += (k[i] > T) ? 1 : 0; q += (k[i] == T) ? 1 : 0; }
    const int need = 16 - row_sum_i(g);
    const int a = min(max(need - row_excl_scan_i(q), 0), q);
    int nxt = row_excl_scan_i(g + a), eqs = 0;
#pragma unroll
    for (int i = 0; i < NK; ++i) { const bool iseq = k[i] == T; sel[i] = (k[i] > T) || (iseq && eqs < a); eqs += iseq ? 1 : 0; pos[i] = nxt; nxt += sel[i] ? 1 : 0; }
}
DI void ce_desc(unsigned& x, unsigned& y) { const unsigned hi = max(x, y), lo = min(x, y); x = hi; y = lo; }
DI void sort8_desc(unsigned (&a)[8]) {
    ce_desc(a[0], a[1]); ce_desc(a[2], a[3]); ce_desc(a[4], a[5]); ce_desc(a[6], a[7]); ce_desc(a[0], a[2]); ce_desc(a[1], a[3]); ce_desc(a[4], a[6]); ce_desc(a[5], a[7]);
    ce_desc(a[1], a[2]); ce_desc(a[5], a[6]); ce_desc(a[0], a[4]); ce_desc(a[3], a[7]); ce_desc(a[1], a[5]); ce_desc(a[2], a[6]); ce_desc(a[1], a[4]); ce_desc(a[3], a[6]);
    ce_desc(a[2], a[4]); ce_desc(a[3], a[5]); ce_desc(a[3], a[4]); }
DI void sort4_desc(unsigned (&a)[4]) { ce_desc(a[0], a[1]); ce_desc(a[2], a[3]); ce_desc(a[0], a[2]); ce_desc(a[1], a[3]); ce_desc(a[1], a[2]); }
DI float fkey_inv(unsigned k) { return __uint_as_float((k & 0x80000000u) ? (k & 0x7fffffffu) : ~k); }
DI void cex_(unsigned& k, int& ix, unsigned pk, int pi, bool lower) { const bool take = lower ? (pk > k) : (pk < k); k = take ? pk : k; ix = take ? pi : ix; }
template <int CTRL> DI void cex_dpp(unsigned& k, int& ix, bool lower) { const unsigned pk = (unsigned)dppi_<CTRL>((int)k); const int pi = dppi_<CTRL>(ix); cex_(k, ix, pk, pi, lower); }
DI void row_sort16_desc(unsigned& k, int& ix, int j16) {
    const bool l1 = (j16 & 1) == 0, l2 = (j16 & 2) == 0, l4 = (j16 & 4) == 0, l8 = (j16 & 8) == 0;
    cex_dpp<0xB1>(k, ix, l1);
    cex_dpp<0x1B>(k, ix, l2); cex_dpp<0xB1>(k, ix, l1);
    cex_dpp<0x141>(k, ix, l4); cex_dpp<0x4E>(k, ix, l2); cex_dpp<0xB1>(k, ix, l1);
    cex_dpp<0x140>(k, ix, l8);
    { const unsigned pk = (unsigned)__builtin_amdgcn_ds_swizzle((int)k, 0x101F); const int pi = __builtin_amdgcn_ds_swizzle(ix, 0x101F); cex_(k, ix, pk, pi, l4); }
    cex_dpp<0x4E>(k, ix, l2); cex_dpp<0xB1>(k, ix, l1);
}
constexpr int PSL_SK = 0, PSL_TOP = 131072;
static_assert(PSL_TOP + 8 * 1024 <= LDS_BYTES - 256, "peer select LDS map");
template <int PROBE> DI void ph_peer_select(Ctx& K) {
    float* TOPV = (float*)(K.lds + PSL_TOP + K.wave * 1024); int* TOPI = (int*)(TOPV + 128);
    const int r16 = K.lane & 15, g4 = K.lane >> 4, j16 = r16;
    const int nhg = K.nb < 8 ? K.nb : 8, grp = K.bid % nhg, jw = K.bid / nhg, nj = (K.nb - grp + nhg - 1) / nhg;
    constexpr int N_T = M / 16;
    const int nwv = nj * 8, wg = jw * 8 + K.wave;
    const int n_full = (N_T / nwv) * nwv, n_work = n_full + 4 * (N_T - n_full);
    for (int h = grp; h < 8; h += nhg) {
        __syncthreads();
        { const u32x4* sh = (const u32x4*)(K.SKH() + ((size_t)K.l * 8 + h) * 2 * 16384); const u32x4* sl = (const u32x4*)(K.SKL() + ((size_t)K.l * 8 + h) * 2 * 16384);
          u32x4* dst = (u32x4*)(K.lds + PSL_SK);
          u32x4 t[8];
#pragma unroll
          for (int i = 0; i < 8; ++i) t[i] = sh[K.tid + 512 * i];
#pragma unroll
          for (int i = 0; i < 8; ++i) dst[K.tid + 512 * i] = t[i];
#pragma unroll
          for (int i = 0; i < 8; ++i) t[i] = sl[K.tid + 512 * i];
#pragma unroll
          for (int i = 0; i < 8; ++i) dst[4096 + K.tid + 512 * i] = t[i]; }
        __syncthreads();
#pragma unroll 1
        for (int wk = wg; wk < n_work; wk += nwv) {
            const bool part = wk >= n_full; const int tile = part ? n_full + ((wk - n_full) >> 2) : wk; const int rg_lo = part ? ((wk - n_full) & 3) : 0, rg_hi = part ? rg_lo + 1 : 4;
            const int t0 = tile * 16;
            float S[2][8][4];
#pragma unroll
            for (int p = 0; p < 2; ++p) {
                bf16x8_t aq[4];
                { const bf16_t* qp = K.QP() + (size_t)(t0 + r16) * 2048 + h * 256 + p * 128 + 8 * g4;
#pragma unroll
                  for (int ks = 0; ks < 4; ++ks) aq[ks] = *(const bf16x8_t*)(qp + 32 * ks); }
                const unsigned char* kb = K.lds + PSL_SK + p * 32768 + K.lane * 16;
#pragma unroll
                for (int nt = 0; nt < 8; ++nt) {
                    f32x4 c0 = {0.f, 0.f, 0.f, 0.f}, c1 = c0;
#pragma unroll
                    for (int ks = 0; ks < 4; ++ks) { const bf16x8_t bh = *(const bf16x8_t*)(kb + (nt * 4 + ks) * 1024), bl = *(const bf16x8_t*)(kb + 65536 + (nt * 4 + ks) * 1024);
                        c0 = MFMA16(aq[ks], bh, c0); c1 = MFMA16(aq[ks], bl, c1); }
#pragma unroll
                    for (int rg = 0; rg < 4; ++rg) S[p][nt][rg] = c0[rg] + c1[rg];
                }
            }
            if (PROBE == 1) { float a = 0.f;
#pragma unroll
                for (int p = 0; p < 2; ++p)
#pragma unroll
                    for (int nt = 0; nt < 8; ++nt) a += S[p][nt][0] + S[p][nt][1] + S[p][nt][2] + S[p][nt][3];
                TOPV[K.lane] = a; continue; }
#pragma unroll 1
            for (int rg = 0; rg < 4; ++rg) {
                if (rg >= rg_lo && rg < rg_hi) {
                    unsigned a[2][8], mine[2] = {0u, 0u};
#pragma unroll
                    for (int p = 0; p < 2; ++p) {
#pragma unroll
                        for (int i = 0; i < 8; ++i) a[p][i] = (fkey(S[p][i][0]) & 0xFFFFFF80u) | (unsigned)(j16 + 16 * i);
                        sort8_desc(a[p]); }
#pragma unroll 1
                    for (int it = 0; it < 16; ++it) {
#pragma unroll
                        for (int p = 0; p < 2; ++p) { const unsigned m = row_minmax_u(a[p][0], true); const bool win = a[p][0] == m;
#pragma unroll
                            for (int i = 0; i < 7; ++i) a[p][i] = win ? a[p][i + 1] : a[p][i];
                            a[p][7] = win ? 0u : a[p][7];
                            mine[p] = (j16 == it) ? m : mine[p]; }
                    }
                    unsigned* TA = (unsigned*)TOPV + (g4 * 2) * 16; unsigned* TB = TA + 16;
                    TA[j16] = mine[0]; TB[j16] = mine[1];
                    asm volatile("s_waitcnt lgkmcnt(0)" ::: "memory");
                    { const int r = t0 + 4 * g4 + rg, t = j16;
                      int ci[4], cj[4];
                      ci[0] = 0; cj[0] = t;
                      ci[1] = t < 8 ? 1 : t; cj[1] = t < 8 ? t : 0;
                      ci[2] = t <= 4 ? 2 : t <= 8 ? 3 : t <= 11 ? 4 : t <= 13 ? 5 : 6; cj[2] = t <= 4 ? t : t <= 8 ? t - 5 : t <= 11 ? t - 9 : t <= 13 ? t - 12 : t - 14;
                      ci[3] = 7; cj[3] = t & 1;
                      unsigned c[4];
#pragma unroll
                      for (int q = 0; q < 4; ++q) { const float cv = fkey_inv(TA[ci[q]] & 0xFFFFFF80u) + fkey_inv(TB[cj[q]] & 0xFFFFFF80u); c[q] = (fkey(cv) & 0xFFFFFFC0u) | (unsigned)(t * 4 + q); }
                      if (t > 1) c[3] = 0u;
                      sort4_desc(c);
                      unsigned w = 0u;
#pragma unroll 1
                      for (int it = 0; it < 16; ++it) { const unsigned m = row_minmax_u(c[0], true); const bool win = c[0] == m;
                          c[0] = win ? c[1] : c[0]; c[1] = win ? c[2] : c[1]; c[2] = win ? c[3] : c[2]; c[3] = win ? 0u : c[3];
                          w = (j16 == it) ? m : w; }
                      const float val = fkey_inv(w & 0xFFFFFFC0u); const int tw = (int)(w >> 2) & 15, qw = (int)w & 3;
                      const int i2 = tw <= 4 ? 2 : tw <= 8 ? 3 : tw <= 11 ? 4 : tw <= 13 ? 5 : 6, j2 = tw <= 4 ? tw : tw <= 8 ? tw - 5 : tw <= 11 ? tw - 9 : tw <= 13 ? tw - 12 : tw - 14;
                      const int wi = qw == 0 ? 0 : qw == 1 ? (tw < 8 ? 1 : tw) : qw == 2 ? i2 : 7, wj = qw == 0 ? tw : qw == 1 ? (tw < 8 ? tw : 0) : qw == 2 ? j2 : (tw & 1);
                      const int e = (int)(TA[wi] & 127u) * 128 + (int)(TB[wj] & 127u);
                      const float mx = dpp_max16(val);
                      const float ex = __expf(val - mx), es = dpp_sum16(ex);
                      K.PIDX()[(size_t)r * 128 + h * 16 + j16] = e; K.PG()[(size_t)r * 128 + h * 16 + j16] = ex / es;
                    }
                    asm volatile("s_waitcnt lgkmcnt(0)" ::: "memory");
                }
#pragma unroll
                for (int p = 0; p < 2; ++p)
#pragma unroll
                    for (int i = 0; i < 8; ++i) { S[p][i][0] = S[p][i][1]; S[p][i][1] = S[p][i][2]; S[p][i][2] = S[p][i][3]; }
            }
        }
    }
}

constexpr int PUL_H = 0, PUL_SLOT = 4096, PUL_STRIDE = 4352;
struct PuMeta { float hs[2]; int ia[2], ib[2]; };
DI void pu_load(const Ctx& K, int r0, int step, PuMeta& m, unsigned char* hbuf) {
#pragma unroll
    for (int q = 0; q < 2; ++q) { const int r = r0 + q * step;
        if (r < M) { __builtin_amdgcn_global_load_lds((const unsigned*)(K.H8() + (size_t)r * D + K.lane * 16), (LAS unsigned*)(hbuf + q * 1024), 16, 0, 0);
            m.hs[q] = K.HS()[r]; m.ia[q] = K.PIDX()[(size_t)r * 128 + K.lane]; m.ib[q] = K.PIDX()[(size_t)r * 128 + 64 + K.lane]; }
        else { m.hs[q] = 0.f; m.ia[q] = -1; m.ib[q] = -1; } }
}
typedef int i32x4 __attribute__((ext_vector_type(4)));
DI int sel4i(const i32x4 v, int k) { return k == 0 ? v[0] : k == 1 ? v[1] : k == 2 ? v[2] : v[3]; }
template <int PROBE> DI void pu_item(const Ctx& K, const unsigned char* U, unsigned char* HL, int* SLOT, int R, int r0, int step, const PuMeta& m, int r16, int g4, float& dummy) {
    const float hs[2] = {m.hs[0], m.hs[1]};
    bool sa[2], sb[2]; int ra[2], rb[2]; int n = 0;
#pragma unroll
    for (int q = 0; q < 2; ++q) { sa[q] = (m.ia[q] >> 11) == R; sb[q] = (m.ib[q] >> 11) == R; const unsigned long long ma = __ballot(sa[q]), mb = __ballot(sb[q]);
        ra[q] = n + mbcnt64(ma); n += __popcll(ma); rb[q] = n + mbcnt64(mb); n += __popcll(mb); }
    const int E = r16 >> 2, qq = r16 & 3, rho = r16 >> 3;
#pragma unroll 1
    for (int base = 0; base < n; base += 32) {
#pragma unroll
        for (int q = 0; q < 2; ++q) {
            if (sa[q] && ra[q] >= base && ra[q] < base + 32) { SLOT[2 * (ra[q] - base)] = m.ia[q]; SLOT[2 * (ra[q] - base) + 1] = q * 128 + K.lane; }
            if (sb[q] && rb[q] >= base && rb[q] < base + 32) { SLOT[2 * (rb[q] - base)] = m.ib[q]; SLOT[2 * (rb[q] - base) + 1] = q * 128 + 64 + K.lane; } }
        asm volatile("s_waitcnt lgkmcnt(0)" ::: "memory");
        const bool two = base + 16 < n;
        i32x4 av[8][4];
#pragma unroll
        for (int t = 0; t < 4; ++t) { const int sl = 4 * t + E; const int e = (base + sl < n) ? SLOT[2 * sl] : SLOT[0]; const unsigned char* up = U + (size_t)e * D + 64 * g4 + 16 * qq;
#pragma unroll
            for (int s_ = 0; s_ < 4; ++s_) av[t][s_] = *(const i32x4*)(up + 256 * s_); }
        if (two) {
#pragma unroll
            for (int t = 4; t < 8; ++t) { const int sl = 4 * t + E; const int e = (base + sl < n) ? SLOT[2 * sl] : SLOT[0]; const unsigned char* up = U + (size_t)e * D + 64 * g4 + 16 * qq;
#pragma unroll
                for (int s_ = 0; s_ < 4; ++s_) av[t][s_] = *(const i32x4*)(up + 256 * s_); } }
        bool fin[2]; int fcode[2]; float fus[2], fvs[2];
#pragma unroll
        for (int p2 = 0; p2 < 2; ++p2) { const int sl = 4 * (4 * p2 + qq) + g4; fin[p2] = false; fcode[p2] = 0; fus[p2] = 0.f; fvs[p2] = 0.f;
            if ((r16 & 7) < 4 && base + sl < n) { const int code = SLOT[2 * sl + 1];
                if ((code >> 7) == rho) { const size_t eo = (size_t)K.l * 16384 + SLOT[2 * sl]; fin[p2] = true; fcode[p2] = code; fus[p2] = K.US()[eo]; fvs[p2] = K.VS()[eo]; } } }
        i32x4 hb[4];
#pragma unroll
        for (int s_ = 0; s_ < 4; ++s_) hb[s_] = *(const i32x4*)(HL + rho * 1024 + 64 * g4 + 16 * qq + 256 * s_);
        int w0, w1 = 0;
        { int rs[4];
#pragma unroll
          for (int t = 0; t < 4; ++t) { i32x4 acc = {0, 0, 0, 0};
#pragma unroll
              for (int s_ = 0; s_ < 4; ++s_) acc = __builtin_amdgcn_mfma_i32_16x16x64_i8(av[t][s_], hb[s_], acc, 0, 0, 0);
              int v = sel4i(acc, qq); v += dppi_<0xB1>(v); v += dppi_<0x4E>(v); rs[t] = v; }
          w0 = qq == 0 ? rs[0] : qq == 1 ? rs[1] : qq == 2 ? rs[2] : rs[3]; }
        if (two) { int rs[4];
#pragma unroll
            for (int t = 0; t < 4; ++t) { i32x4 acc = {0, 0, 0, 0};
#pragma unroll
                for (int s_ = 0; s_ < 4; ++s_) acc = __builtin_amdgcn_mfma_i32_16x16x64_i8(av[4 + t][s_], hb[s_], acc, 0, 0, 0);
                int v = sel4i(acc, qq); v += dppi_<0xB1>(v); v += dppi_<0x4E>(v); rs[t] = v; }
            w1 = qq == 0 ? rs[0] : qq == 1 ? rs[1] : qq == 2 ? rs[2] : rs[3]; }
#pragma unroll
        for (int p2 = 0; p2 < 2; ++p2) {
            const int di = p2 ? w1 : w0;
            if (fin[p2]) { const int code = fcode[p2];
                const float d = (float)di * fus[p2] * ((code >> 7) ? hs[1] : hs[0]);
                if (PROBE >= 2) dummy += gelu_erf(d);
                else (PROBE ? K.ST() : K.PA())[(size_t)(r0 + (code >> 7) * step) * 128 + (code & 127)] = gelu_erf(d) * fvs[p2]; }
        }
        asm volatile("s_waitcnt lgkmcnt(0)" ::: "memory");
    }
}
template <int PROBE> DI void ph_peer_u(Ctx& K) {
    const unsigned char* U = (const unsigned char*)K.UB() + (size_t)K.l * 16384 * D;
    unsigned char* HB = K.lds + K.wave * PUL_STRIDE; int* SLOT = (int*)(HB + PUL_SLOT);
    const int r16 = K.lane & 15, g4 = K.lane >> 4;
    const int step = K.nloc * NWAVES;
    float dummy = 0.f;
    for (int R = K.xg; R < 8; R += K.nxg) {
        int r = K.jx * NWAVES + K.wave; int par = 0;
        PuMeta cur, nxt;
        pu_load(K, r, step, cur, HB);
#pragma unroll 1
        for (; r < M; r += 2 * step) {
            asm volatile("s_waitcnt vmcnt(0)" ::: "memory");
            pu_load(K, r + 2 * step, step, nxt, HB + (par ^ 1) * 2048);
            pu_item<PROBE>(K, U, HB + par * 2048, SLOT, R, r, step, cur, r16, g4, dummy);
            cur = nxt; par ^= 1;
        }
    }
    if (PROBE >= 2) K.ST()[K.gw * 64 + K.lane] = dummy;
}
struct PvMeta { int ia, ib; float ga, gb, pa, pb; };
template <int PROBE> DI void pv_load(const Ctx& K, int r, PvMeta& m) {
    m.ia = K.PIDX()[(size_t)r * 128 + K.lane]; m.ib = K.PIDX()[(size_t)r * 128 + 64 + K.lane];
    m.ga = K.PG()[(size_t)r * 128 + K.lane]; m.pa = K.PA()[(size_t)r * 128 + K.lane]; m.gb = K.PG()[(size_t)r * 128 + 64 + K.lane]; m.pb = K.PA()[(size_t)r * 128 + 64 + K.lane];
}
template <int HALF, int PROBE> DI void pv_issue(const unsigned char* V, int slot, const PvMeta& m, u32x4 (&vv)[8], float (&ww)[8]) {
    const float w = HALF ? m.gb * m.pb : m.ga * m.pa; const int ix = HALF ? m.ib : m.ia;
#pragma unroll
    for (int i = 0; i < 8; ++i) {
        const int src = ((8 * i + slot) << 2);
        const int e = __builtin_amdgcn_ds_bpermute(src, ix);
        ww[i] = __uint_as_float((unsigned)__builtin_amdgcn_ds_bpermute(src, (int)__float_as_uint(w)));
        vv[i] = PROBE == 2 ? (u32x4){(unsigned)e, 1u, 2u, 3u} : *(const u32x4*)(V + (size_t)e * 128);
    }
}
typedef float f32x2_ __attribute__((ext_vector_type(2)));
DI void pv_accum(const u32x4 (&vv)[8], const float (&ww)[8], f32x2_ (&y)[8], float& sw) {
#pragma unroll
    for (int i = 0; i < 8; ++i) { sw += ww[i]; const unsigned w4[4] = {vv[i].x, vv[i].y, vv[i].z, vv[i].w}; const f32x2_ w2 = {ww[i], ww[i]};
#pragma unroll
        for (int q = 0; q < 4; ++q) { const f32x2_ lo = {(float)(w4[q] & 0xffu), (float)((w4[q] >> 8) & 0xffu)}, hi = {(float)((w4[q] >> 16) & 0xffu), (float)(w4[q] >> 24)};
            y[2 * q] = __builtin_elementwise_fma(w2, lo, y[2 * q]); y[2 * q + 1] = __builtin_elementwise_fma(w2, hi, y[2 * q + 1]); } }
}
template <int PROBE> DI void ph_peer_v(Ctx& K) {
    const int slot = K.lane >> 3, c = K.lane & 7;
    const float* gate = K.MOD() + (size_t)K.l * 3 * 6 * D + 5 * D;
    const int step = K.nloc * NWAVES;
    float* Xb = PROBE ? (float*)K.P() : K.X();
    for (int S = K.xg; S < 8; S += K.nxg) {
        const unsigned char* V = (const unsigned char*)K.VB() + ((size_t)K.l * 8 + S) * 16384 * 128 + c * 16;
        const int c0 = S * 128 + c * 16;
        const int r0 = K.jx * NWAVES + K.wave;
        const int nit = r0 < M ? (M - 1 - r0) / step + 1 : 0;
        PvMeta mA, mB; pv_load<PROBE>(K, min(r0, M - 1), mA); pv_load<PROBE>(K, min(r0 + step, M - 1), mB);
        f32x4 xq[4], xprev[4], x2[4], gp[4]; float yp[16]; int rp = -1, mvp = -1; PvMeta m2;
#pragma unroll
        for (int q = 0; q < 4; ++q) { xq[q] = *(const f32x4*)(Xb + (size_t)min(r0, M - 1) * D + c0 + 4 * q); xprev[q] = (f32x4){0.f, 0.f, 0.f, 0.f}; gp[q] = xprev[q]; }
#pragma unroll
        for (int q = 0; q < 16; ++q) yp[q] = 0.f;
#define PV_BODY(XPREV, XQ, XNEW, MA, MC, IT) do { \
            const int r = r0 + (IT) * step; \
            if (rp >= 0) { const int mv = modvec_of_row(rp); \
                if (mv != mvp) { mvp = mv; \
                    _Pragma("unroll") for (int q = 0; q < 4; ++q) gp[q] = *(const f32x4*)(gate + (size_t)mv * 6 * D + c0 + 4 * q); } } \
            { const float zdep = MA.ga * 0.0f; \
                _Pragma("unroll") for (int q = 0; q < 4; ++q) { XPREV[q].x += gp[q].x * yp[4 * q] + zdep; XPREV[q].y += gp[q].y * yp[4 * q + 1] + zdep; XPREV[q].z += gp[q].z * yp[4 * q + 2] + zdep; XPREV[q].w += gp[q].w * yp[4 * q + 3] + zdep; } \
                if (rp >= 0 && slot == 0) { float* xr = Xb + (size_t)rp * D + c0; \
                    _Pragma("unroll") for (int q = 0; q < 4; ++q) *(f32x4*)(xr + 4 * q) = XPREV[q]; } } \
            __builtin_amdgcn_sched_barrier(0); \
            u32x4 vA[8], vB[8]; float wA[8], wB[8]; \
            pv_issue<0, PROBE>(V, slot, MA, vA, wA); \
            pv_issue<1, PROBE>(V, slot, MA, vB, wB); \
            __builtin_amdgcn_sched_barrier(0); \
            { const float* xr = Xb + (size_t)min(r + step, M - 1) * D + c0; \
              _Pragma("unroll") for (int q = 0; q < 4; ++q) XNEW[q] = *(const f32x4*)(xr + 4 * q); } \
            pv_load<PROBE>(K, min(r + 2 * step, M - 1), MC); \
            __builtin_amdgcn_sched_barrier(0); \
            f32x2_ y2[8]; float sw = 0.f; \
            _Pragma("unroll") for (int i = 0; i < 8; ++i) y2[i] = (f32x2_){0.f, 0.f}; \
            pv_accum(vA, wA, y2, sw); \
            pv_accum(vB, wB, y2, sw); \
            _Pragma("unroll") for (int q = 0; q < 8; ++q) { yp[2 * q] = y2[q].x - 128.f * sw; yp[2 * q + 1] = y2[q].y - 128.f * sw; } \
            _Pragma("unroll") for (int q = 0; q < 16; ++q) { float v = yp[q]; v += dpp_<0x128>(v); \
                auto s1 = __builtin_amdgcn_permlane16_swap(__float_as_uint(v), __float_as_uint(v), false, false); v = __uint_as_float(s1[0]) + __uint_as_float(s1[1]); \
                auto s2 = __builtin_amdgcn_permlane32_swap(__float_as_uint(v), __float_as_uint(v), false, false); yp[q] = __uint_as_float(s2[0]) + __uint_as_float(s2[1]); } \
            rp = r; } while (0)
        f32x4 (*xfin)[4] = nullptr; (void)xfin;
        int it = 0;
#pragma unroll 1
        for (; it + 2 < nit; it += 3) {
            PV_BODY(xprev, xq, x2, mA, m2, it);
            PV_BODY(xq, x2, xprev, mB, mA, it + 1);
            PV_BODY(x2, xprev, xq, m2, mB, it + 2);
        }
        if (it < nit) { PV_BODY(xprev, xq, x2, mA, m2, it); ++it;
            if (it < nit) { PV_BODY(xq, x2, xprev, mB, mA, it); ++it;
#pragma unroll
                for (int q = 0; q < 4; ++q) xprev[q] = x2[q]; }
            else {
#pragma unroll
                for (int q = 0; q < 4; ++q) xprev[q] = xq[q]; } }
#undef PV_BODY
        if (rp >= 0) { const int mv = modvec_of_row(rp);
#pragma unroll
            for (int q = 0; q < 4; ++q) gp[q] = *(const f32x4*)(gate + (size_t)mv * 6 * D + c0 + 4 * q);
            if (slot == 0) { float* xr = Xb + (size_t)rp * D + c0;
#pragma unroll
                for (int q = 0; q < 4; ++q) { f32x4 x = xprev[q];
                    x.x += gp[q].x * yp[4 * q]; x.y += gp[q].y * yp[4 * q + 1]; x.z += gp[q].z * yp[4 * q + 2]; x.w += gp[q].w * yp[4 * q + 3]; *(f32x4*)(xr + 4 * q) = x; } } }
    }
}

DI void ph_final(Ctx& K) {
    for (int r = K.gw; r < NLAT; r += K.ngw) {
        const f32x4* xr = (const f32x4*)(K.X() + (size_t)(NCTX + r) * D); f32x4* o = (f32x4*)(((float*)argp_<float>(K, (unsigned)__builtin_offsetof(Args, out))) + (size_t)r * D);
        f32x4 v[4]; float ss = 0.f;
#pragma unroll
        for (int j = 0; j < 4; ++j) { v[j] = xr[j * 64 + K.lane]; ss += v[j].x * v[j].x + v[j].y * v[j].y + v[j].z * v[j].z + v[j].w * v[j].w; }
        ss = wave_sum(ss); const float rs = rsqrtf(ss * (1.0f / D) + EPS);
#pragma unroll
        for (int j = 0; j < 4; ++j) { const f32x4 w = ((const f32x4*)ARG(final_norm_w))[j * 64 + K.lane]; o[j * 64 + K.lane] = v[j] * rs * w; }
    }
}

#define XB_TMO      128
#define XB_XSUB(j)  (1280 + 64 * (j))
#define XB_XGEN(j)  (2304 + 64 * (j))
#define XB_TOP      3328
#define XB_TOPGEN   3392
#define XB_SPIN_CAP (1u << 22)
constexpr int CW_BAR = 4096;
DI unsigned xb_ld(unsigned* p)              { return __hip_atomic_load(p, __ATOMIC_RELAXED, __HIP_MEMORY_SCOPE_AGENT); }
DI unsigned xb_add(unsigned* p, unsigned v) { return __hip_atomic_fetch_add(p, v, __ATOMIC_RELAXED, __HIP_MEMORY_SCOPE_AGENT); }
#define XB_SPIN(cond, bar) do { unsigned _sp = 0; while (cond) { __builtin_amdgcn_s_sleep(1); \
    if ((++_sp & 255u) == 0u) { if (xb_ld(&(bar)[XB_TMO])) break; if (_sp > XB_SPIN_CAP) { atomicAdd(&(bar)[XB_TMO], 1u); break; } } } } while (0)
DI void xcd_barrier(unsigned* bar, unsigned x, unsigned nloc, unsigned nx) {
    asm volatile("s_waitcnt vmcnt(0)" ::: "memory");
    __syncthreads();
    if (threadIdx.x == 0) {
        __builtin_amdgcn_s_waitcnt(0);
        const unsigned old = xb_add(&bar[XB_XSUB(x)], 1u);
        const unsigned gen = old / nloc;
        if (old + 1u == (gen + 1u) * nloc) {
            __builtin_amdgcn_fence(__ATOMIC_RELEASE, "agent");
            asm volatile("s_waitcnt vmcnt(0)" ::: "memory");
            const unsigned og = xb_add(&bar[XB_TOP], 1u);
            const unsigned tg = og / nx;
            if (og + 1u == (tg + 1u) * nx) xb_add(&bar[XB_TOPGEN], 1u);
            else XB_SPIN(xb_ld(&bar[XB_TOPGEN]) == tg, bar);
            __builtin_amdgcn_fence(__ATOMIC_ACQUIRE, "agent");
            xb_add(&bar[XB_XGEN(x)], 1u);
            asm volatile("s_waitcnt vmcnt(0)" ::: "memory");
        } else {
            XB_SPIN(xb_ld(&bar[XB_XGEN(x)]) == gen, bar);
            __builtin_amdgcn_fence(__ATOMIC_ACQUIRE, "agent");
            asm volatile("s_waitcnt vmcnt(0)" ::: "memory");
        }
    }
    __syncthreads();
}

constexpr int PROBE_U = 0, PROBE_V = 0, PROBE_S = 0;
constexpr unsigned DUP_MASK = 0u;
constexpr int PH_PER_LAYER = 12, N_PHASES = 2 + PH_PER_LAYER * DEPTH;
__global__ void __launch_bounds__(NTHREADS) mk_fwd(Args args) {
    extern __shared__ __attribute__((aligned(16))) unsigned char lds[];
    cg::grid_group grid = cg::this_grid();
    constexpr unsigned ARGS_OFF = LDS_BYTES - 256;
    constexpr unsigned MISC_OFF = LDS_BYTES - 64;
    if (threadIdx.x == 0) {
        *(Args*)(lds + ARGS_OFF) = args;
        unsigned* ctl = (unsigned*)(args.ws + WS_CTL); unsigned* misc = (unsigned*)(lds + MISC_OFF);
        const unsigned xcc = (unsigned)__builtin_amdgcn_s_getreg((3 << 11) | 20) & 0xFu;
        misc[0] = xcc; misc[1] = __hip_atomic_fetch_add(ctl + 64 * xcc, 1u, __ATOMIC_RELAXED, __HIP_MEMORY_SCOPE_AGENT);
    }
    __syncthreads();
    int rep = 0;
#pragma unroll 1
    for (int ph = 0; ph < N_PHASES; ++ph) {
        int tid = threadIdx.x; asm volatile("" : "+v"(tid));
        unsigned aoff = ARGS_OFF; asm volatile("" : "+v"(aoff));
        size_t zoff = 0; asm volatile("" : "+s"(zoff));
        unsigned char* ws = args.ws + zoff;
        int bid = blockIdx.x; asm volatile("" : "+s"(bid)); int nb = gridDim.x; asm volatile("" : "+s"(nb));
        unsigned moff = MISC_OFF; asm volatile("" : "+v"(moff));
        Ctx K; { const unsigned* misc = (const unsigned*)(lds + moff); K.jx = __builtin_amdgcn_readfirstlane(misc[1]); K.xg = __builtin_amdgcn_readfirstlane(misc[2]); K.nxg = __builtin_amdgcn_readfirstlane(misc[3]); K.nloc = __builtin_amdgcn_readfirstlane(misc[4]); }
        K.aoff = aoff; K.lds = lds; K.tid = tid; K.lane = tid & 63; K.wave = tid >> 6; K.bid = bid; K.nb = nb; K.gw = bid * NWAVES + K.wave; K.ngw = nb * NWAVES;
        K.ws = ws;
        const int l = ph == 0 ? 0 : (ph - 1) / PH_PER_LAYER, k = ph == 0 ? -1 : (ph == N_PHASES - 1 ? -2 : (ph - 1) % PH_PER_LAYER);
        K.l = l;
        if (k == -1) ph_prologue(K);
        else if (k == -2) ph_final(K);
        else if (k == 0) ph_norm(K, ARG(norm_mix_w) + (size_t)l * D, 0);
        else if (k == 1) ph_gemm_store(K, K.H(), K.WIN() + (size_t)l * PW * D, PW, K.P(), K.ROPE());
        else if (k == 2) ph_hgrn_A(K);
        else if (k == 3) ph_attn(K);
        else if (k == 4) ph_hgrn_B(K);
        else if (k == 5) ph_hgrn_C(K);
        else if (k == 6) ph_gemm_resid(K, K.MIX(), K.WOUT() + (size_t)l * D * D, 2);
        else if (k == 7) ph_norm(K, ARG(norm_ffn_w) + (size_t)l * D, 3);
        else if (k == 8) ph_gemm_store(K, K.H(), K.WQ() + (size_t)l * 2048 * D, 2048, K.QP(), nullptr);
        else if (k == 9) { ph_peer_select<0>(K); if (PROBE_S) ph_peer_select<PROBE_S>(K); }
        else if (k == 10) { ph_peer_u<0>(K); if (PROBE_U) ph_peer_u<PROBE_U>(K); }
        else if (k == 11) { ph_peer_v<0>(K); if (PROBE_V) ph_peer_v<PROBE_V>(K); }
        if (k >= 0 && ((DUP_MASK >> k) & 1u)) { ++rep; if (rep < 2) { --ph; continue; } } rep = 0;
        if (ph == 0) grid.sync();
        else if (k != 2 && ph != N_PHASES - 1) { const unsigned* misc = (const unsigned*)(lds + moff); xcd_barrier((unsigned*)(args.ws + WS_CTL) + CW_BAR, misc[0], misc[4], misc[3]); }
        if (ph == 0) {
            if (threadIdx.x == 0) { unsigned* ctl = (unsigned*)(args.ws + WS_CTL); unsigned* misc = (unsigned*)(lds + MISC_OFF); const unsigned xcc = misc[0]; unsigned ord = 0, npop = 0, mine = 1;
                for (unsigned q = 0; q < 16; ++q) { const unsigned cq = __hip_atomic_load(ctl + 64 * q, __ATOMIC_RELAXED, __HIP_MEMORY_SCOPE_AGENT); if (cq) { ++npop; if (q < xcc) ++ord; } if (q == xcc) mine = cq; }
                misc[2] = ord; misc[3] = npop ? npop : 1u; misc[4] = mine ? mine : 1u; }
            __syncthreads();
        }
    }
}

extern "C" void kernel_launch(void* const* d_in, const int* in_sizes, int n_in, void* d_out, int out_size, void* d_ws, size_t ws_size, hipStream_t stream) {
    static int grid = 0;
    if (grid == 0) {
        if (n_in != 19 || out_size != NLAT * D || ws_size < WS_END) { fprintf(stderr, "kernel_launch: unexpected shapes (n_in %d out %d ws %zu need %zu)\n", n_in, out_size, ws_size, (size_t)WS_END); grid = -1; return; }
        int dev = 0, cus = 0, per_cu = 0;
        (void)hipGetDevice(&dev); (void)hipDeviceGetAttribute(&cus, hipDeviceAttributeMultiprocessorCount, dev);
        (void)hipFuncSetAttribute((const void*)mk_fwd, hipFuncAttributeMaxDynamicSharedMemorySize, LDS_BYTES);
        (void)hipOccupancyMaxActiveBlocksPerMultiprocessor(&per_cu, (const void*)mk_fwd, NTHREADS, LDS_BYTES);
        if (per_cu < 1) { fprintf(stderr, "kernel_launch: occupancy query says %d blocks/CU\n", per_cu); grid = -1; return; }
        grid = (cus / 8) * 8;
    }
    if (grid < 0) return;
    Args a{};
    a.x = (const float*)d_in[0]; a.c = (const float*)d_in[1]; a.ctx = (const float*)d_in[2]; a.c_ctx = (const float*)d_in[3]; a.w_mod = (const float*)d_in[4]; a.b_mod = (const float*)d_in[5];
    a.norm_mix_w = (const float*)d_in[6]; a.norm_ffn_w = (const float*)d_in[7]; a.w_in = (const float*)d_in[8]; a.lb_logits = (const float*)d_in[9]; a.hgrn_norm_w = (const float*)d_in[10];
    a.swa_sink = (const float*)d_in[11]; a.nat_rpb = (const float*)d_in[12]; a.w_out = (const float*)d_in[13]; a.peer_wq = (const float*)d_in[14]; a.peer_sk = (const float*)d_in[15];
    a.peer_u = (const float*)d_in[16]; a.peer_v = (const float*)d_in[17]; a.final_norm_w = (const float*)d_in[18];
    a.out = (float*)d_out; a.ws = (unsigned char*)d_ws;
    (void)hipMemsetAsync((unsigned char*)d_ws + WS_CTL, 0, CTL_BYTES, stream);
    void* kargs[] = {&a};
    hipError_t e = hipLaunchCooperativeKernel((const void*)mk_fwd, dim3(grid), dim3(NTHREADS), kargs, LDS_BYTES, stream);
    if (e != hipSuccess) fprintf(stderr, "kernel_launch: cooperative launch failed: %s (grid %d)\n", hipGetErrorString(e), grid);
}
```

```cpp
#include <hip/hip_runtime.h>
#include <hip/hip_cooperative_groups.h>
#include <cstdio>
#include <cstdint>
namespace cg = cooperative_groups;
#define DI __device__ __forceinline__
#define GP(T, p) ((T*)(__attribute__((address_space(1))) T*)(p))

typedef unsigned short bf16_t;
typedef float f32x4 __attribute__((ext_vector_type(4)));
typedef unsigned u32x4 __attribute__((ext_vector_type(4)));
typedef unsigned u32x2 __attribute__((ext_vector_type(2)));

constexpr int D = 1024, NB = 2, L = 16384, CL = 256, DEPTH = 4;
constexpr int NCTX = NB * CL, NLAT = NB * L, M = NCTX + NLAT;
constexpr int PW = 3072;
constexpr int C_HQ = 0, C_ZF = 256, C_ZB = 512, C_HV = 768, C_HG = 1024, C_SQ = 1280, C_SK = 1664, C_SV = 1792, C_NQ = 1920, C_NK = 2304, C_NV = 2688;
constexpr int MX_H = 0, MX_S = 256, MX_N = 640;
constexpr float EPS = 1e-6f;
constexpr int NTHREADS = 512, NWAVES = 8;
constexpr int LDS_BYTES = 163840;

constexpr size_t al256(size_t x) { return (x + 255) & ~(size_t)255; }
constexpr size_t WS_X = 0;
constexpr size_t WS_H = WS_X + al256((size_t)M * D * 4);
constexpr size_t WS_P = WS_H + al256((size_t)M * D * 2);
constexpr size_t WS_MIX = WS_P + al256((size_t)M * PW * 2);
constexpr size_t WS_OF = WS_MIX + al256((size_t)M * D * 2);
constexpr size_t WS_OB = WS_OF + al256((size_t)M * 256 * 4);
constexpr size_t WS_PIDX = WS_OB + al256((size_t)M * 256 * 4);
constexpr size_t WS_PG = WS_PIDX + al256((size_t)M * 128 * 4);
constexpr size_t WS_MOD = WS_PG + al256((size_t)M * 128 * 4);
constexpr size_t WS_LB = WS_MOD + al256((size_t)DEPTH * 3 * 6 * D * 4);
constexpr size_t WS_ROPE = WS_LB + al256((size_t)2 * DEPTH * 256 * 4);
constexpr size_t WS_WIN = WS_ROPE + al256((size_t)(256 + 256 + 64 + 64) * 16 * 4);
constexpr size_t WS_WOUT = WS_WIN + al256((size_t)DEPTH * PW * D * 2);
constexpr size_t WS_WQ = WS_WOUT + al256((size_t)DEPTH * D * D * 2);
constexpr size_t WS_AC = WS_WQ + al256((size_t)DEPTH * 2048 * D * 2);
constexpr size_t WS_UB_ = 0; constexpr size_t WS_UB = WS_AC + al256((size_t)16 * 260 * 64 * 4); constexpr size_t WS_UB_OLD = WS_WQ + al256((size_t)DEPTH * 2048 * D * 2);
constexpr size_t WS_VB = WS_UB + al256((size_t)DEPTH * 16384 * D * 2);
constexpr size_t WS_PA = WS_VB + al256((size_t)DEPTH * 16384 * D * 2);
constexpr size_t WS_VS = WS_PA + al256((size_t)M * 128 * 4);
constexpr size_t WS_US = WS_VS + al256((size_t)DEPTH * 16384 * 4);
constexpr size_t WS_H8 = WS_US + al256((size_t)DEPTH * 16384 * 4);
constexpr size_t WS_HS = WS_H8 + al256((size_t)M * D);
constexpr size_t WS_SKH = WS_HS + al256((size_t)M * 4);
constexpr size_t WS_SKL = WS_SKH + al256((size_t)DEPTH * 8 * 2 * 128 * 128 * 2);
constexpr size_t WS_CTL = WS_SKL + al256((size_t)DEPTH * 8 * 2 * 128 * 128 * 2);
constexpr size_t CTL_BYTES = 65536;
constexpr size_t WS_END = WS_CTL + CTL_BYTES;

struct Args {
    const float *x, *c, *ctx, *c_ctx, *w_mod, *b_mod, *norm_mix_w, *norm_ffn_w, *w_in, *lb_logits, *hgrn_norm_w, *swa_sink, *nat_rpb, *w_out, *peer_wq, *peer_sk, *peer_u, *peer_v, *final_norm_w;
    float* out; unsigned char* ws;
};

DI float bf2f(bf16_t v) { return __uint_as_float((unsigned)v << 16); }
DI bf16_t f2bf(float f) { unsigned u = __float_as_uint(f); return (bf16_t)((u + 0x7fffu + ((u >> 16) & 1u)) >> 16); }
DI unsigned pk2(float lo, float hi) { return (unsigned)f2bf(lo) | ((unsigned)f2bf(hi) << 16); }
DI float wave_sum(float v) {
#pragma unroll
    for (int o = 1; o < 64; o <<= 1) v += __shfl_xor(v, o);
    return v;
}
typedef __bf16 bf16x2_t __attribute__((ext_vector_type(2)));
DI float dot2bf(unsigned a, unsigned b, float acc) { return __builtin_amdgcn_fdot2_f32_bf16(__builtin_bit_cast(bf16x2_t, a), __builtin_bit_cast(bf16x2_t, b), acc, false); }
template <int CTRL> DI float dpp_(float x) { return __builtin_bit_cast(float, __builtin_amdgcn_mov_dpp(__builtin_bit_cast(int, x), CTRL, 0xf, 0xf, true)); }
DI float wave_sum_fast(float x) {
    x += dpp_<0xB1>(x); x += dpp_<0x4E>(x); x += dpp_<0x141>(x); x += dpp_<0x128>(x);
    auto s1 = __builtin_amdgcn_permlane16_swap(__float_as_uint(x), __float_as_uint(x), false, false); x = __uint_as_float(s1[0]) + __uint_as_float(s1[1]);
    auto s2 = __builtin_amdgcn_permlane32_swap(__float_as_uint(x), __float_as_uint(x), false, false); return __uint_as_float(s2[0]) + __uint_as_float(s2[1]);
}
DI float sigmoidf_(float z) { return 1.0f / (1.0f + __expf(-z)); }
DI float gelu_erf(float v) { return 0.5f * v * (1.0f + erff(v * 0.70710678118654752f)); }
DI int modvec_of_row(int r) { return r < NCTX ? 2 : (r - NCTX) / L; }
DI int batch_of_row(int r) { return r < NCTX ? r / CL : (r - NCTX) / L; }
DI int lat_row(int b, int t) { return NCTX + b * L + t; }
DI int ctx_row(int b, int s) { return b * CL + s; }
DI void unpack8(const u32x4 w, float* o) {
    o[0] = __uint_as_float(w.x << 16); o[1] = __uint_as_float(w.x & 0xffff0000u);
    o[2] = __uint_as_float(w.y << 16); o[3] = __uint_as_float(w.y & 0xffff0000u);
    o[4] = __uint_as_float(w.z << 16); o[5] = __uint_as_float(w.z & 0xffff0000u);
    o[6] = __uint_as_float(w.w << 16); o[7] = __uint_as_float(w.w & 0xffff0000u);
}
DI void load_row64(const bf16_t* p, float (&o)[64]) {
#pragma unroll
    for (int i = 0; i < 8; ++i) { const u32x4 w = *(const u32x4*)(p + 8 * i); unpack8(w, &o[8 * i]); }
}
DI void rope64(float (&x)[64], const float* cr, const float* sr, const float* cc, const float* sc) {
#pragma unroll
    for (int i = 0; i < 16; ++i) {
        const float c1 = cr[i], s1 = sr[i], a = x[i], b = x[16 + i];
        x[i] = a * c1 - b * s1; x[16 + i] = b * c1 + a * s1;
        const float c2 = cc[i], s2 = sc[i], e = x[32 + i], f = x[48 + i];
        x[32 + i] = e * c2 - f * s2; x[48 + i] = f * c2 + e * s2;
    }
}

namespace pg8 {
#define PG8_LAS __attribute__((address_space(3)))
typedef unsigned short bf16_t;
typedef short bf16x8 __attribute__((ext_vector_type(8)));
typedef float f32x4 __attribute__((ext_vector_type(4)));
typedef unsigned u32x4 __attribute__((ext_vector_type(4)));
constexpr int BM = 256, BK = 64, HALF = 128, HTB = HALF * BK * 2  , STAGE_BYTES = 8 * HTB, NXCD = 8, WGM = 8;

__host__ __device__ __forceinline__ int lds_byte(int r, int c) { const int st = (r >> 4) * 2 + (c >> 5), rr = r & 15, cc = c & 31, ob = rr * 64 + cc * 2; return st * 1024 + (ob ^ (((ob >> 9) & 1) << 5)); }
__host__ __device__ __forceinline__ void stage_rc(int b, int& R, int& C) { const int st = b / 1024, sb = b % 1024, swz = sb ^ (((sb >> 9) & 1) << 5); R = (st >> 1) * 16 + swz / 64; C = (st & 1) * 32 + (swz % 64) / 2; }
__host__ __device__ __forceinline__ int perm32(int rho) { const int n = rho >> 4, i = rho & 15; return 8 * (i >> 2) + 4 * n + (i & 3); }

struct Unit { int pm, pn; };
struct Gemm { const bf16_t* A; const bf16_t* Bt; int M, N, K; };

struct StaticOrder {
    int nM, nN, nwg, G, c;
    __host__ __device__ void init(int M, int N, int G_, int c_) { nM = M / BM; nN = N / BM; nwg = nM * nN; G = G_; c = c_; }
    __host__ __device__ bool next(int i, Unit& u) const {
        const long L = (long)i * G + c; if (L >= nwg) return false;
        int wgid = (int)L; { const int q = nwg / NXCD, r = nwg % NXCD, xcd = wgid % NXCD, off = wgid / NXCD; wgid = (xcd < r ? xcd * (q + 1) : r * (q + 1) + (xcd - r) * q) + off; }
        const int nig = WGM * nN, gid = wgid / nig, fm = gid * WGM, gsz = (nM - fm) < WGM ? (nM - fm) : WGM;
        u.pm = fm + ((wgid % nig) % gsz); u.pn = (wgid % nig) / gsz; return true;
    }
    __device__ __forceinline__ void a_ready(const Unit&) const {}
    __device__ __forceinline__ void done(const Unit&) const {}
};


__device__ __forceinline__ unsigned cvt_pk_bf16(float lo, float hi) { unsigned r; asm volatile("v_cvt_pk_bf16_f32 %0, %1, %2" : "=v"(r) : "v"(lo), "v"(hi)); return r; }
constexpr int EPI_LDS_OFF = STAGE_BYTES, EPI_LDS_WAVE = 2560;
struct EpiStore {
    static constexpr bool PERM = true, AFTER_DRAIN = false;
    bf16_t* O; int ldc; PG8_LAS unsigned char* lds; const float* rope; int nctx, seqlen, rowbase;
    __device__ __forceinline__ void operator()(const f32x4 (&acc)[2][2][4][2], const Unit& u, int wr, int wc, int fr, int fq) const {
        PG8_LAS unsigned char* T = lds + EPI_LDS_OFF + (wr * 4 + wc) * EPI_LDS_WAVE;
        const int lane = fr + 16 * fq, rr = lane >> 2, cc = lane & 3;
        const int row0 = rowbase + u.pm * BM + wr * 64, col0 = u.pn * BM + wc * 32;
        const bool dorope = rope != nullptr && (u.pn == 5 || u.pn == 6) && rowbase + u.pm * BM >= nctx;
#pragma unroll
        for (int ai = 0; ai < 2; ++ai)
#pragma unroll
            for (int m = 0; m < 4; ++m)
#pragma unroll
                for (int bj = 0; bj < 2; ++bj) { const f32x4 v0 = acc[ai][bj][m][0], v1 = acc[ai][bj][m][1];
                    u32x4 w; w.x = cvt_pk_bf16(v0[0], v0[1]); w.y = cvt_pk_bf16(v0[2], v0[3]); w.z = cvt_pk_bf16(v1[0], v1[1]); w.w = cvt_pk_bf16(v1[2], v1[3]);
                    *(PG8_LAS u32x4*)(T + fr * 80 + 16 * fq) = w;
                    asm volatile("s_waitcnt lgkmcnt(0)" ::: "memory");
                    u32x4 o = *(const PG8_LAS u32x4*)(T + rr * 80 + 16 * cc);
                    asm volatile("s_waitcnt lgkmcnt(0)" ::: "memory");
                    const int grow = row0 + ai * HALF + m * 16 + rr;
                    if (dorope) {
                        const int t = (grow - nctx) % seqlen; const bool second = (wc & 1) != 0;
                        const float* ct = rope + (second ? 8192 + (t & 63) * 16 : (t >> 6) * 16) + 8 * (cc & 1); const float* st = ct + (second ? 1024 : 4096);
                        const f32x4 c0 = *(const f32x4*)ct, c1 = *(const f32x4*)(ct + 4), s0 = *(const f32x4*)st, s1 = *(const f32x4*)(st + 4);
                        const float cs[8] = {c0[0], c0[1], c0[2], c0[3], c1[0], c1[1], c1[2], c1[3]}, sn[8] = {s0[0], s0[1], s0[2], s0[3], s1[0], s1[1], s1[2], s1[3]};
                        const unsigned ow[4] = {o.x, o.y, o.z, o.w}; unsigned rw[4];
                        const float sg = cc >= 2 ? 1.0f : -1.0f;
#pragma unroll
                        for (int q = 0; q < 4; ++q) { const unsigned pw = (unsigned)__builtin_amdgcn_mov_dpp((int)ow[q], 0x4E, 0xf, 0xf, true);
                            const float x0 = __uint_as_float(ow[q] << 16), x1 = __uint_as_float(ow[q] & 0xffff0000u), p0 = __uint_as_float(pw << 16), p1 = __uint_as_float(pw & 0xffff0000u);
                            rw[q] = cvt_pk_bf16(x0 * cs[2 * q] + sg * p0 * sn[2 * q], x1 * cs[2 * q + 1] + sg * p1 * sn[2 * q + 1]); }
                        o = (u32x4){rw[0], rw[1], rw[2], rw[3]}; }
                    *(u32x4*)(O + (size_t)grow * ldc + col0 + bj * HALF + 8 * cc) = o; }
    }
};
struct EpiResid {
    static constexpr bool PERM = false, AFTER_DRAIN = false;
    float* X; int ldc; const float* gate; int gstride, nctx, seqlen; PG8_LAS unsigned char* lds; int rowbase; const float* Xin;
    __device__ __forceinline__ void operator()(const f32x4 (&acc)[2][2][4][2], const Unit& u, int wr, int wc, int fr, int fq) const {
        PG8_LAS float* T = (PG8_LAS float*)(lds + EPI_LDS_OFF + (wr * 4 + wc) * EPI_LDS_WAVE);
        const int lane = fr + 16 * fq, rr = lane >> 3, cc = lane & 7;
        const int r0 = rowbase + u.pm * BM; const int vsel = r0 < nctx ? 2 : (r0 - nctx) / seqlen;
        const int row0 = r0 + wr * 64, col0 = u.pn * BM + wc * 32 + 4 * cc;
#pragma unroll
        for (int bj = 0; bj < 2; ++bj) { const f32x4 g = *(const f32x4*)(gate + (size_t)vsel * gstride + col0 + bj * HALF);
#pragma unroll
            for (int ai = 0; ai < 2; ++ai)
#pragma unroll
                for (int m = 0; m < 4; ++m) {
#pragma unroll
                    for (int n = 0; n < 2; ++n) *(PG8_LAS f32x4*)(T + fr * 36 + 16 * n + 4 * fq) = acc[ai][bj][m][n];
                    asm volatile("s_waitcnt lgkmcnt(0)" ::: "memory");
                    const f32x4 t0 = *(const PG8_LAS f32x4*)(T + rr * 36 + 4 * cc), t1 = *(const PG8_LAS f32x4*)(T + (rr + 8) * 36 + 4 * cc);
                    asm volatile("s_waitcnt lgkmcnt(0)" ::: "memory");
                    float* x0 = X + (size_t)(row0 + ai * HALF + m * 16 + rr) * ldc + col0 + bj * HALF; float* x1 = x0 + (size_t)8 * ldc;
                    const float* i0 = Xin + (size_t)(row0 - rowbase + ai * HALF + m * 16 + rr) * ldc + col0 + bj * HALF; const float* i1 = i0 + (size_t)8 * ldc;
                    f32x4 a = *(const f32x4*)i0, b = *(const f32x4*)i1; a += g * t0; b += g * t1; *(f32x4*)x0 = a; *(f32x4*)x1 = b; } }
    }
};

template <class Epi, class Sched, bool ALIGN_EPI = false, bool SP2 = false>
__device__ __forceinline__ void gemm_phase(PG8_LAS unsigned char* lds, const Gemm g, const Sched& S, const Epi& E, int tid_in) {
    int tid_ = tid_in; asm volatile("" : "+v"(tid_));
    const int tid = tid_, wid = __builtin_amdgcn_readfirstlane(tid >> 6), lane = tid & 63, wr = wid >> 2, wc = wid & 3, fr = lane & 15, fq = lane >> 4;
    const int K = g.K, nt = K / BK;
    unsigned voffA[2], voffB[2];
#pragma unroll
    for (int i = 0; i < 2; ++i) { int R, C; stage_rc(tid * 16 + i * 8192, R, C); const int Rb = Epi::PERM ? ((R & ~31) + perm32(R & 31)) : R;
        voffA[i] = (unsigned)(R * K + C) * 2u; voffB[i] = (unsigned)(Rb * K + C) * 2u; }
    const size_t kstep = (size_t)(BK * 2);
    const size_t hstep = (size_t)HALF * K * 2;
    const size_t tstep = 2 * hstep;
    const unsigned ldsw = (unsigned)wid * 1024u;
    const int aoff = lds_byte(wr * 64 + fr, fq * 8), boff = lds_byte(wc * 32 + fr, fq * 8);
#define PG8_SA(b, h) (((b) * 2 + (h)) * HTB)
#define PG8_SB(b, h) ((4 + (b) * 2 + (h)) * HTB)
#define PG8_STAGE(bufoff, gbase, voff) do { _Pragma("unroll") for (int _i = 0; _i < 2; ++_i) \
        __builtin_amdgcn_global_load_lds((const unsigned*)((const char*)(gbase) + (voff)[_i]), (PG8_LAS unsigned*)(lds + (bufoff) + ldsw + _i * 8192), 16, 0, 0); } while (0)
#define PG8_LDA(dst, b, h) do { _Pragma("unroll") for (int m = 0; m < 4; ++m) _Pragma("unroll") for (int k = 0; k < 2; ++k) dst[m][k] = *(const PG8_LAS bf16x8*)(lds + PG8_SA(b, h) + aoff + m * 2048 + k * 1024); } while (0)
#define PG8_LDB(dst, b, h) do { _Pragma("unroll") for (int n = 0; n < 2; ++n) _Pragma("unroll") for (int k = 0; k < 2; ++k) dst[n][k] = *(const PG8_LAS bf16x8*)(lds + PG8_SB(b, h) + boff + n * 2048 + k * 1024); } while (0)
#define PG8_MMA(ai, bj, At, Bt) do { __builtin_amdgcn_s_setprio(1); _Pragma("unroll") for (int m = 0; m < 4; ++m) _Pragma("unroll") for (int n = 0; n < 2; ++n) _Pragma("unroll") for (int k = 0; k < 2; ++k) \
        acc[ai][bj][m][n] = __builtin_amdgcn_mfma_f32_16x16x32_bf16(Bt[n][k], At[m][k], acc[ai][bj][m][n], 0, 0, 0); __builtin_amdgcn_s_setprio(0); } while (0)
#define PG8_WAIT_V(n) asm volatile("s_waitcnt vmcnt(" #n ")" ::: "memory")
#define PG8_WAIT_L(n) asm volatile("s_waitcnt lgkmcnt(" #n ")" ::: "memory")
#define PG8_BAR __builtin_amdgcn_s_barrier()
#define PG8_SCHED __builtin_amdgcn_sched_barrier(0)
    Unit cur, nxt; int ui = 0;
    if (!S.next(0, cur)) return;
    f32x4 acc[2][2][4][2];
#pragma unroll
    for (int a = 0; a < 2; ++a)
#pragma unroll
        for (int b = 0; b < 2; ++b)
#pragma unroll
            for (int m = 0; m < 4; ++m)
#pragma unroll
                for (int n = 0; n < 2; ++n) acc[a][b][m][n] = (f32x4){0.f, 0.f, 0.f, 0.f};
    bf16x8 At[4][2], B0[2][2], B1[2][2];
    const char* cA = (const char*)g.A + (size_t)cur.pm * tstep; const char* cB = (const char*)g.Bt + (size_t)cur.pn * tstep;
    S.a_ready(cur);
    if constexpr (SP2) {
        PG8_STAGE(PG8_SB(0, 0), cB, voffB); PG8_STAGE(PG8_SB(0, 1), cB + hstep, voffB); PG8_STAGE(PG8_SA(0, 0), cA, voffA); PG8_STAGE(PG8_SA(0, 1), cA + hstep, voffA);
        if (wr == 1) PG8_BAR;
        PG8_WAIT_V(2); PG8_BAR;
        PG8_STAGE(PG8_SB(1, 0), cB + kstep, voffB); PG8_STAGE(PG8_SA(1, 0), cA + kstep, voffA); PG8_STAGE(PG8_SB(1, 1), cB + hstep + kstep, voffB);
        PG8_WAIT_V(6); PG8_BAR;
    } else {
        PG8_STAGE(PG8_SB(0, 0), cB, voffB); PG8_STAGE(PG8_SA(0, 0), cA, voffA); PG8_STAGE(PG8_SB(0, 1), cB + hstep, voffB); PG8_STAGE(PG8_SA(0, 1), cA + hstep, voffA);
        if (wr == 1) PG8_BAR;
        PG8_WAIT_V(4); PG8_BAR;
        PG8_STAGE(PG8_SB(1, 0), cB + kstep, voffB); PG8_STAGE(PG8_SA(1, 0), cA + kstep, voffA); PG8_STAGE(PG8_SB(1, 1), cB + hstep + kstep, voffB);
        PG8_WAIT_V(6); PG8_BAR;
    }
    for (;;) {
        const bool has_next = S.next(ui + 1, nxt);
        const char* nA = has_next ? (const char*)g.A + (size_t)nxt.pm * tstep : cA; const char* nB = has_next ? (const char*)g.Bt + (size_t)nxt.pn * tstep : cB;
        for (int t = 0; t < nt; t += 2) {
            const bool last = (t == nt - 2);
            const char* a1 = cA + (size_t)(t + 1) * kstep;
            const char* a2 = last ? nA : cA + (size_t)(t + 2) * kstep; const char* b2 = last ? nB : cB + (size_t)(t + 2) * kstep;
            const char* a3 = a2 + kstep; const char* b3 = b2 + kstep;
            if (last && has_next) S.a_ready(nxt);
            if constexpr (SP2) {
            PG8_LDB(B0, 0, 0); PG8_LDB(B1, 0, 1); PG8_SCHED; PG8_LDA(At, 0, 0); PG8_STAGE(PG8_SA(1, 1), a1 + hstep, voffA);
            PG8_WAIT_V(8); PG8_WAIT_L(0); PG8_BAR; PG8_MMA(0, 0, At, B0); PG8_MMA(0, 1, At, B1); PG8_BAR; PG8_SCHED;
            PG8_LDA(At, 0, 1); PG8_STAGE(PG8_SB(0, 0), b2, voffB); PG8_STAGE(PG8_SB(0, 1), b2 + hstep, voffB); PG8_STAGE(PG8_SA(0, 0), a2, voffA);
            PG8_WAIT_V(8); PG8_WAIT_L(0); PG8_BAR; PG8_MMA(1, 0, At, B0); PG8_MMA(1, 1, At, B1); PG8_BAR; PG8_SCHED;
            PG8_LDB(B0, 1, 0); PG8_LDB(B1, 1, 1); PG8_SCHED; PG8_LDA(At, 1, 0); PG8_STAGE(PG8_SA(0, 1), a2 + hstep, voffA);
            PG8_WAIT_V(8); PG8_WAIT_L(0); PG8_BAR; PG8_MMA(0, 0, At, B0); PG8_MMA(0, 1, At, B1); PG8_BAR; PG8_SCHED;
            PG8_LDA(At, 1, 1); PG8_STAGE(PG8_SB(1, 0), b3, voffB); PG8_STAGE(PG8_SB(1, 1), b3 + hstep, voffB); PG8_STAGE(PG8_SA(1, 0), a3, voffA);
            PG8_WAIT_V(8); PG8_WAIT_L(0); PG8_BAR; PG8_MMA(1, 0, At, B0); PG8_MMA(1, 1, At, B1); PG8_BAR; PG8_SCHED;
            } else {
            PG8_LDB(B0, 0, 0); PG8_SCHED; PG8_LDA(At, 0, 0); PG8_STAGE(PG8_SA(1, 1), a1 + hstep, voffA);
            PG8_WAIT_L(8); PG8_BAR; PG8_WAIT_L(0); PG8_MMA(0, 0, At, B0); PG8_BAR; PG8_SCHED;
            PG8_LDB(B1, 0, 1); PG8_STAGE(PG8_SB(0, 0), b2, voffB);
            PG8_BAR; PG8_WAIT_L(0); PG8_MMA(0, 1, At, B1); PG8_BAR;
            PG8_LDA(At, 0, 1); PG8_STAGE(PG8_SA(0, 0), a2, voffA);
            PG8_BAR; PG8_WAIT_L(0); PG8_MMA(1, 0, At, B0); PG8_BAR; PG8_SCHED;
            PG8_STAGE(PG8_SB(0, 1), b2 + hstep, voffB);
            PG8_WAIT_V(6); PG8_BAR; PG8_MMA(1, 1, At, B1); PG8_BAR;
            PG8_LDB(B0, 1, 0); PG8_SCHED; PG8_LDA(At, 1, 0); PG8_STAGE(PG8_SA(0, 1), a2 + hstep, voffA);
            PG8_WAIT_L(8); PG8_BAR; PG8_WAIT_L(0); PG8_MMA(0, 0, At, B0); PG8_BAR; PG8_SCHED;
            PG8_LDB(B1, 1, 1); PG8_STAGE(PG8_SB(1, 0), b3, voffB);
            PG8_BAR; PG8_WAIT_L(0); PG8_MMA(0, 1, At, B1); PG8_BAR;
            PG8_LDA(At, 1, 1); PG8_STAGE(PG8_SA(1, 0), a3, voffA);
            PG8_BAR; PG8_WAIT_L(0); PG8_MMA(1, 0, At, B0); PG8_BAR; PG8_SCHED;
            PG8_STAGE(PG8_SB(1, 1), b3 + hstep, voffB);
            PG8_WAIT_V(6); PG8_BAR; PG8_MMA(1, 1, At, B1); PG8_BAR;
            }
        }
        if constexpr (ALIGN_EPI) { if (wr == 0) PG8_BAR; }
        if constexpr (!Epi::AFTER_DRAIN) { E(acc, cur, wr, wc, fr, fq); S.done(cur); }
        if (!has_next) break;
#pragma unroll
        for (int a = 0; a < 2; ++a)
#pragma unroll
            for (int b = 0; b < 2; ++b)
#pragma unroll
                for (int m = 0; m < 4; ++m)
#pragma unroll
                    for (int n = 0; n < 2; ++n) acc[a][b][m][n] = (f32x4){0.f, 0.f, 0.f, 0.f};
        cur = nxt; cA = nA; cB = nB; ++ui;
        if constexpr (ALIGN_EPI) { if (wr == 1) PG8_BAR; }
    }
    PG8_WAIT_V(0);
    if constexpr (!ALIGN_EPI) { if (wr == 0) PG8_BAR; }
    PG8_BAR;
    if constexpr (Epi::AFTER_DRAIN) { E.fused(acc, cur, wr, wc, fr, fq, lds, wid, lane); S.done(cur); }
#undef PG8_SA
#undef PG8_SB
#undef PG8_STAGE
#undef PG8_LDA
#undef PG8_LDB
#undef PG8_MMA
#undef PG8_WAIT_V
#undef PG8_WAIT_L
#undef PG8_BAR
#undef PG8_SCHED
}
}

struct Ctx {
    unsigned aoff; int l;
    unsigned char* ws;
    DI float* X() const { return GP(float, ws + WS_X); }
    DI bf16_t* H() const { return GP(bf16_t, ws + WS_H); }
    DI bf16_t* P() const { return GP(bf16_t, ws + WS_P); }
    DI bf16_t* QP() const { return GP(bf16_t, ws + WS_P); }
    DI bf16_t* MIX() const { return GP(bf16_t, ws + WS_MIX); }
    DI float* OF() const { return GP(float, ws + WS_OF); }
    DI float* OB() const { return GP(float, ws + WS_OB); }
    DI int* PIDX() const { return GP(int, ws + WS_PIDX); }
    DI float* PG() const { return GP(float, ws + WS_PG); }
    DI float* MOD() const { return GP(float, ws + WS_MOD); }
    DI float* LB() const { return GP(float, ws + WS_LB); }
    DI float* ROPE() const { return GP(float, ws + WS_ROPE); }
    DI bf16_t* WIN() const { return GP(bf16_t, ws + WS_WIN); }
    DI bf16_t* WOUT() const { return GP(bf16_t, ws + WS_WOUT); }
    DI bf16_t* WQ() const { return GP(bf16_t, ws + WS_WQ); }
    DI bf16_t* UB() const { return GP(bf16_t, ws + WS_UB); }
    DI float* ST() const { return GP(float, ws + WS_OF); }
    DI bf16_t* STB() const { return GP(bf16_t, ws + WS_OF); }
    DI float* AC() const { return GP(float, ws + WS_AC); }
    DI float* PA() const { return GP(float, ws + WS_PA); }
    DI float* VS() const { return GP(float, ws + WS_VS); }
    DI float* US() const { return GP(float, ws + WS_US); }
    DI bf16_t* SKH() const { return GP(bf16_t, ws + WS_SKH); }
    DI bf16_t* SKL() const { return GP(bf16_t, ws + WS_SKL); }
    DI bf16_t* VB() const { return GP(bf16_t, ws + WS_VB); }
    DI unsigned char* H8() const { return GP(unsigned char, ws + WS_H8); }
    DI float* HS() const { return GP(float, ws + WS_HS); }
    unsigned char* lds; int tid, lane, wave, gw, ngw, bid, nb;
    int xg, nxg, jx, nloc;
};

#define LAS __attribute__((address_space(3)))
DI void transpose_item(const float* W, int Kd, int N, bf16_t* WT, LAS float* scr, int item, int lane) {
    const int nblk = N / 32, kb = item / nblk, nb = item % nblk, k0 = 64 * kb, n0 = 32 * nb;
#pragma unroll 8
    for (int i = 0; i < 32; ++i) { const int kk = 2 * i + (lane >> 5); scr[kk * 33 + (lane & 31)] = W[(size_t)(k0 + kk) * N + n0 + (lane & 31)]; }
    asm volatile("s_waitcnt lgkmcnt(0)" ::: "memory");
    const int c = lane & 7;
#pragma unroll
    for (int j = 0; j < 4; ++j) { const int n = (lane >> 3) + 8 * j; const LAS float* sp = scr + (8 * c) * 33 + n;
        u32x4 o; o.x = pk2(sp[0 * 33], sp[1 * 33]); o.y = pk2(sp[2 * 33], sp[3 * 33]); o.z = pk2(sp[4 * 33], sp[5 * 33]); o.w = pk2(sp[6 * 33], sp[7 * 33]);
        *(u32x4*)(WT + (size_t)(n0 + n) * Kd + k0 + 8 * c) = o; }
    asm volatile("s_waitcnt lgkmcnt(0)" ::: "memory");
}

template <class T> DI T* argp_(const Ctx& K, unsigned off) {
    const unsigned* p = (const unsigned*)(K.lds + K.aoff + off);
    const unsigned lo = __builtin_amdgcn_readfirstlane(p[0]), hi = __builtin_amdgcn_readfirstlane(p[1]);
    return GP(T, ((unsigned long long)hi << 32) | (unsigned long long)lo);
}
#define ARG(f) argp_<const float>(K, (unsigned)__builtin_offsetof(Args, f))

DI void ph_prologue(Ctx& K) {
    {
        LAS float* scr = (LAS float*)((LAS unsigned char*)K.lds + K.wave * 16384);
        constexpr int I_IN = (D / 64) * (PW / 32), I_OUT = (D / 64) * (D / 32), I_Q = (D / 64) * (2048 / 32), I_L = I_IN + I_OUT + I_Q;
        for (int it = K.gw; it < DEPTH * I_L; it += K.ngw) {
            const int l = it / I_L; int r = it % I_L;
            if (r < I_IN) { transpose_item(ARG(w_in) + (size_t)l * D * PW, D, PW, K.WIN() + (size_t)l * PW * D, scr, r, K.lane); continue; } r -= I_IN;
            if (r < I_OUT) { transpose_item(ARG(w_out) + (size_t)l * D * D, D, D, K.WOUT() + (size_t)l * D * D, scr, r, K.lane); continue; } r -= I_OUT;
            transpose_item(ARG(peer_wq) + (size_t)l * D * 2048, D, 2048, K.WQ() + (size_t)l * 2048 * D, scr, r, K.lane);
        }
    }
    const size_t gt = (size_t)K.bid * NTHREADS + K.tid, gs = (size_t)K.nb * NTHREADS;
    { const float* sk = ARG(peer_sk);
      for (size_t i = gt; i < (size_t)DEPTH * 8 * 2 * 128 * 128; i += gs) { const float v = sk[i]; const bf16_t hi = f2bf(v);
          const size_t lhp = i >> 14; const int key = (int)(i >> 7) & 127, d = (int)i & 127;
          const size_t o = (((lhp * 8 + (key >> 4)) * 4 + (d >> 5)) * 64 + (key & 15) + 16 * ((d >> 3) & 3)) * 8 + (d & 7);
          K.SKH()[o] = hi; K.SKL()[o] = f2bf(v - bf2f(hi)); } }
    { const float* pu = ARG(peer_u); unsigned char* UQ = (unsigned char*)K.UB();
      for (int row0 = K.gw; row0 < DEPTH * 16384; row0 += 2 * K.ngw) {
          f32x4 v2[2][4];
#pragma unroll
          for (int t = 0; t < 2; ++t) { const int row = min(row0 + t * K.ngw, DEPTH * 16384 - 1); const f32x4* src = (const f32x4*)(pu + (size_t)row * D);
#pragma unroll
              for (int j = 0; j < 4; ++j) v2[t][j] = src[j * 64 + K.lane]; }
#pragma unroll
          for (int t = 0; t < 2; ++t) { const int row = row0 + t * K.ngw; if (row >= DEPTH * 16384) break;
              float mx = 0.f;
#pragma unroll
              for (int j = 0; j < 4; ++j) mx = fmaxf(mx, fmaxf(fmaxf(fabsf(v2[t][j].x), fabsf(v2[t][j].y)), fmaxf(fabsf(v2[t][j].z), fabsf(v2[t][j].w))));
#pragma unroll
              for (int o = 1; o < 64; o <<= 1) mx = fmaxf(mx, __shfl_xor(mx, o));
              const float sc = fmaxf(mx, 1e-30f) * (1.0f / 127.0f), inv = 1.0f / sc;
              if (K.lane == 0) K.US()[row] = sc;
#pragma unroll
              for (int j = 0; j < 4; ++j) { const int col = j * 256 + K.lane * 4; const f32x4 v = v2[t][j];
                  const unsigned q0 = (unsigned)((int)rintf(v.x * inv)) & 0xffu, q1 = (unsigned)((int)rintf(v.y * inv)) & 0xffu, q2 = (unsigned)((int)rintf(v.z * inv)) & 0xffu, q3 = (unsigned)((int)rintf(v.w * inv)) & 0xffu;
                  *(unsigned*)(UQ + (size_t)row * D + col) = q0 | (q1 << 8) | (q2 << 16) | (q3 << 24); } } } }
    { const float* pv = ARG(peer_v); unsigned char* VQ = (unsigned char*)K.VB();
      for (int row0 = K.gw; row0 < DEPTH * 16384; row0 += 2 * K.ngw) {
          f32x4 v2[2][4];
#pragma unroll
          for (int t = 0; t < 2; ++t) { const int row = min(row0 + t * K.ngw, DEPTH * 16384 - 1); const f32x4* src = (const f32x4*)(pv + (size_t)row * D);
#pragma unroll
              for (int j = 0; j < 4; ++j) v2[t][j] = src[j * 64 + K.lane]; }
#pragma unroll
          for (int t = 0; t < 2; ++t) { const int row = row0 + t * K.ngw; if (row >= DEPTH * 16384) break;
              float mx = 0.f;
#pragma unroll
              for (int j = 0; j < 4; ++j) mx = fmaxf(mx, fmaxf(fmaxf(fabsf(v2[t][j].x), fabsf(v2[t][j].y)), fmaxf(fabsf(v2[t][j].z), fabsf(v2[t][j].w))));
#pragma unroll
              for (int o = 1; o < 64; o <<= 1) mx = fmaxf(mx, __shfl_xor(mx, o));
              const float sc = fmaxf(mx, 1e-30f) * (1.0f / 127.0f), inv = 1.0f / sc;
              if (K.lane == 0) K.VS()[row] = sc;
              const int l = row >> 14, e = row & 16383;
#pragma unroll
              for (int j = 0; j < 4; ++j) { const int col = j * 256 + K.lane * 4; const f32x4 v = v2[t][j];
                  const unsigned q0 = (unsigned)((int)rintf(v.x * inv) + 128), q1 = (unsigned)((int)rintf(v.y * inv) + 128), q2 = (unsigned)((int)rintf(v.z * inv) + 128), q3 = (unsigned)((int)rintf(v.w * inv) + 128);
                  *(unsigned*)(VQ + (((size_t)l * 8 + (col >> 7)) * 16384 + e) * 128 + (col & 127)) = q0 | (q1 << 8) | (q2 << 16) | (q3 << 24); } } } }
    { float* sv = (float*)K.lds;
      float* part = sv + 3 * D;
      __syncthreads();
      for (int i = K.tid; i < 3 * D; i += NTHREADS) { const int v = i / D, k = i % D; const float c = v < 2 ? ARG(c)[v * D + k] : ARG(c_ctx)[k]; sv[i] = c * sigmoidf_(c); }
      __syncthreads();
      for (int item = K.bid; item < DEPTH * 48; item += K.nb) {
          const int l = item / 48, cb = item % 48, kp = K.lane >> 5, cl = (K.lane & 31) * 4;
          const float* w = ARG(w_mod) + (size_t)l * D * 6 * D + cb * 128 + cl;
          f32x4 a0 = {0.f, 0.f, 0.f, 0.f}, a1 = a0, a2 = a0;
#pragma unroll 16
          for (int kk = 0; kk < 64; ++kk) { const int k = K.wave * 128 + 2 * kk + kp; const f32x4 wv = *(const f32x4*)(w + (size_t)k * 6 * D);
              a0 += wv * sv[k]; a1 += wv * sv[D + k]; a2 += wv * sv[2 * D + k]; }
#pragma unroll
          for (int j = 0; j < 4; ++j) { a0[j] += __shfl_xor(a0[j], 32); a1[j] += __shfl_xor(a1[j], 32); a2[j] += __shfl_xor(a2[j], 32); }
          if (kp == 0) { *(f32x4*)(part + (K.wave * 3 + 0) * 128 + cl) = a0; *(f32x4*)(part + (K.wave * 3 + 1) * 128 + cl) = a1; *(f32x4*)(part + (K.wave * 3 + 2) * 128 + cl) = a2; }
          __syncthreads();
          for (int i = K.tid; i < 384; i += NTHREADS) { const int v = i / 128, cc = i % 128; float sum = 0.f;
#pragma unroll
              for (int w8 = 0; w8 < 8; ++w8) sum += part[(w8 * 3 + v) * 128 + cc];
              const int col = cb * 128 + cc; K.MOD()[((size_t)l * 3 + v) * 6 * D + col] = sum + ARG(b_mod)[(size_t)l * 6 * D + col]; }
          __syncthreads();
      } }
    for (size_t i = gt; i < 2 * 256; i += gs) {
        const int dir = (int)(i / 256), ch = (int)(i % 256);
        float lg[DEPTH], mx = -1e30f;
#pragma unroll
        for (int l = 0; l < DEPTH; ++l) { lg[l] = ARG(lb_logits)[((size_t)dir * DEPTH + l) * 256 + ch]; mx = fmaxf(mx, lg[l]); }
        float s = 0.f;
#pragma unroll
        for (int l = 0; l < DEPTH; ++l) { lg[l] = expf(lg[l] - mx); s += lg[l]; }
        float cum = 0.f;
#pragma unroll
        for (int l = 0; l < DEPTH; ++l) { if (l > 0) cum += lg[l] / s; K.LB()[((size_t)dir * DEPTH + l) * 256 + ch] = cum; }
    }
    for (size_t i = gt; i < (256 + 64) * 16; i += gs) {
        const int pos = (int)(i / 16), f = (int)(i % 16);
        const float inv = powf(10000.0f, -(float)f / 16.0f);
        if (pos < 256) { const float ang = (float)pos * inv; K.ROPE()[pos * 16 + f] = cosf(ang); K.ROPE()[4096 + pos * 16 + f] = sinf(ang); }
        else { const int pc = pos - 256; const float ang = (float)pc * inv; K.ROPE()[8192 + pc * 16 + f] = cosf(ang); K.ROPE()[8192 + 1024 + pc * 16 + f] = sinf(ang); }
    }
}

DI void ph_norm(Ctx& K, const float* nw, int shift_chunk) {
    const float* modl = K.MOD() + (size_t)K.l * 3 * 6 * D;
    for (int r = K.gw; r < M; r += K.ngw) {
        const f32x4* xr = (const f32x4*)((K.l == 0 && shift_chunk == 0) ? (r < NCTX ? ARG(ctx) + (size_t)r * D : ARG(x) + (size_t)(r - NCTX) * D) : K.X() + (size_t)r * D);
        f32x4 v[4]; float ss = 0.f;
#pragma unroll
        for (int j = 0; j < 4; ++j) { v[j] = xr[j * 64 + K.lane]; ss += v[j].x * v[j].x + v[j].y * v[j].y + v[j].z * v[j].z + v[j].w * v[j].w; }
        ss = wave_sum(ss);
        const float rs = rsqrtf(ss * (1.0f / D) + EPS);
        const float* mv = modl + (size_t)modvec_of_row(r) * 6 * D;
        u32x2* ho = (u32x2*)(K.H() + (size_t)r * D);
#pragma unroll
        for (int j = 0; j < 4; ++j) {
            const int c4 = j * 64 + K.lane;
            const f32x4 w = ((const f32x4*)nw)[c4], sh = ((const f32x4*)(mv + shift_chunk * D))[c4], sc = ((const f32x4*)(mv + (shift_chunk + 1) * D))[c4];
            f32x4 y; y.x = v[j].x * rs * w.x * (1.f + sc.x) + sh.x; y.y = v[j].y * rs * w.y * (1.f + sc.y) + sh.y; y.z = v[j].z * rs * w.z * (1.f + sc.z) + sh.z; y.w = v[j].w * rs * w.w * (1.f + sc.w) + sh.w;
            u32x2 o; o.x = pk2(y.x, y.y); o.y = pk2(y.z, y.w); ho[c4] = o;
            if (shift_chunk == 3) { v[j].x = __uint_as_float(o.x << 16); v[j].y = __uint_as_float(o.x & 0xffff0000u); v[j].z = __uint_as_float(o.y << 16); v[j].w = __uint_as_float(o.y & 0xffff0000u); }
        }
        if (shift_chunk == 3) {
            float mx = 0.f;
#pragma unroll
            for (int j = 0; j < 4; ++j) mx = fmaxf(mx, fmaxf(fmaxf(fabsf(v[j].x), fabsf(v[j].y)), fmaxf(fabsf(v[j].z), fabsf(v[j].w))));
#pragma unroll
            for (int o = 1; o < 64; o <<= 1) mx = fmaxf(mx, __shfl_xor(mx, o));
            const float sc = fmaxf(mx, 1e-30f) * (1.0f / 127.0f), inv = 1.0f / sc;
            if (K.lane == 0) K.HS()[r] = sc;
#pragma unroll
            for (int j = 0; j < 4; ++j) { const unsigned q0 = (unsigned)((int)rintf(v[j].x * inv)) & 0xffu, q1 = (unsigned)((int)rintf(v[j].y * inv)) & 0xffu, q2 = (unsigned)((int)rintf(v[j].z * inv)) & 0xffu, q3 = (unsigned)((int)rintf(v[j].w * inv)) & 0xffu;
                *(unsigned*)(K.H8() + (size_t)r * D + (j * 64 + K.lane) * 4) = q0 | (q1 << 8) | (q2 << 16) | (q3 << 24); }
        }
    }
}

typedef short sg_bf16x8 __attribute__((ext_vector_type(8)));
template <int NT, bool RESID> DI void sg_ctx(Ctx& K, const bf16_t* A, const bf16_t* Bt, bf16_t* out, float* X, const float* gate, const float* Xin) {
    constexpr int N = 1024 * NT, RS = 272, OFF_B = 64 * RS, BUF = (64 + 32 * NT) * RS;
    int tid = K.tid; asm volatile("" : "+v"(tid));
    const int lane = tid & 63, wave = __builtin_amdgcn_readfirstlane(tid >> 6), r16 = lane & 15, g4 = lane >> 4, mt = wave & 3, nh = wave >> 2;
    const int lrow = tid >> 4, lc = tid & 15;
    for (int u = K.bid; u < 256; u += K.nb) {
        const int xcd = u & 7, j = u >> 3, ct = xcd * 4 + (j & 3), rt = j >> 2;
        const int row0 = 64 * rt, col0 = 32 * NT * ct;
        const bf16_t* ga = A + (size_t)(row0 + lrow) * D + 8 * lc; const bf16_t* gb = Bt + (size_t)(col0 + lrow) * D + 8 * lc;
        u32x4 ra[3][2], rb[3][NT];
        f32x4 acc[NT];
#pragma unroll
        for (int n = 0; n < NT; ++n) acc[n] = (f32x4){0.f, 0.f, 0.f, 0.f};
#define SG_LOAD(s_, c_) do { ra[s_][0] = *(const u32x4*)(ga + 128 * (c_)); ra[s_][1] = *(const u32x4*)(ga + 32 * D + 128 * (c_)); \
        _Pragma("unroll") for (int i_ = 0; i_ < NT; ++i_) rb[s_][i_] = *(const u32x4*)(gb + (size_t)32 * i_ * D + 128 * (c_)); } while (0)
        SG_LOAD(0, 0); SG_LOAD(1, 1); SG_LOAD(2, 2);
        __syncthreads();
#pragma unroll
        for (int c = 0; c < 8; ++c) {
            unsigned char* buf = K.lds + (c & 1) * BUF;
            *(u32x4*)(buf + lrow * RS + 16 * lc) = ra[c % 3][0]; *(u32x4*)(buf + (lrow + 32) * RS + 16 * lc) = ra[c % 3][1];
#pragma unroll
            for (int i = 0; i < NT; ++i) *(u32x4*)(buf + OFF_B + (lrow + 32 * i) * RS + 16 * lc) = rb[c % 3][i];
            if (c + 3 < 8) SG_LOAD(c % 3, c + 3);
            __syncthreads();
#pragma unroll
            for (int ks = 0; ks < 4; ++ks) {
                const sg_bf16x8 af = *(const sg_bf16x8*)(buf + (16 * mt + r16) * RS + 64 * ks + 16 * g4);
#pragma unroll
                for (int n = 0; n < NT; ++n) { const sg_bf16x8 bf = *(const sg_bf16x8*)(buf + OFF_B + (16 * (NT * nh + n) + r16) * RS + 64 * ks + 16 * g4);
                    acc[n] = __builtin_amdgcn_mfma_f32_16x16x32_bf16(bf, af, acc[n], 0, 0, 0); }
            }
        }
#undef SG_LOAD
        const int row = row0 + 16 * mt + r16;
#pragma unroll
        for (int n = 0; n < NT; ++n) { const int col = col0 + 16 * (NT * nh + n) + 4 * g4;
            if constexpr (RESID) { float* xp = X + (size_t)row * D + col; const f32x4 g = *(const f32x4*)(gate + col); f32x4 x = *(const f32x4*)(Xin + (size_t)row * D + col); x += g * acc[n]; *(f32x4*)xp = x; }
            else { u32x2 o; o.x = pk2(acc[n][0], acc[n][1]); o.y = pk2(acc[n][2], acc[n][3]); *(u32x2*)(out + (size_t)row * N + col) = o; } }
        __syncthreads();
    }
}
DI void ph_gemm_store(Ctx& K, const bf16_t* A, const bf16_t* Bt, int N, bf16_t* out, const float* rope) {
    { pg8::Gemm g{A + (size_t)NCTX * D, Bt, NLAT, N, D}; pg8::StaticOrder S; S.init(NLAT, N, K.nb, K.bid);
      pg8::EpiStore E{out, N, (LAS unsigned char*)K.lds, rope, NCTX, L, NCTX};
      pg8::gemm_phase<pg8::EpiStore, pg8::StaticOrder, true, true>((LAS unsigned char*)K.lds, g, S, E, K.tid); }
    if (N == PW) sg_ctx<3, false>(K, A, Bt, out, nullptr, nullptr, nullptr); else sg_ctx<2, false>(K, A, Bt, out, nullptr, nullptr, nullptr);
}
DI void ph_gemm_resid(Ctx& K, const bf16_t* A, const bf16_t* Bt, int chunk) {
    const float* gate = K.MOD() + (size_t)K.l * 3 * 6 * D + (size_t)chunk * D;
    { pg8::Gemm g{A + (size_t)NCTX * D, Bt, NLAT, D, D}; pg8::StaticOrder S; S.init(NLAT, D, K.nb, K.bid);
      pg8::EpiResid E{K.X(), D, gate, 6 * D, NCTX, L, (LAS unsigned char*)K.lds, NCTX, K.l == 0 ? ARG(x) : (const float*)K.X() + (size_t)NCTX * D};
      pg8::gemm_phase<pg8::EpiResid, pg8::StaticOrder, true, true>((LAS unsigned char*)K.lds, g, S, E, K.tid); }
    sg_ctx<1, true>(K, A, Bt, nullptr, K.X(), gate + (size_t)2 * 6 * D, K.l == 0 ? ARG(ctx) : (const float*)K.X());
}

DI void ph_rope(Ctx& K) {
    const float* cosr = K.ROPE(); const float* sinr = K.ROPE() + 4096; const float* cosc = K.ROPE() + 8192; const float* sinc = K.ROPE() + 8192 + 1024;
    const size_t gt = (size_t)K.bid * NTHREADS + K.tid, gs = (size_t)K.nb * NTHREADS;
    for (size_t i = gt; i < (size_t)NLAT * 8 * 16; i += gs) {
        const int f = (int)(i & 15), hh = (int)((i >> 4) & 7), lr = (int)(i >> 7);
        const int t = lr % L, pr = t >> 6, pc = t & 63;
        bf16_t* p = K.P() + (size_t)(NCTX + lr) * PW + (hh < 6 ? C_SQ + hh * 64 : C_SK + (hh - 6) * 64);
        const float c1 = cosr[pr * 16 + f], s1 = sinr[pr * 16 + f], c2 = cosc[pc * 16 + f], s2 = sinc[pc * 16 + f];
        const float a = bf2f(p[f]), b = bf2f(p[16 + f]), e = bf2f(p[32 + f]), g = bf2f(p[48 + f]);
        p[f] = f2bf(a * c1 - b * s1); p[16 + f] = f2bf(b * c1 + a * s1); p[32 + f] = f2bf(e * c2 - g * s2); p[48 + f] = f2bf(g * c2 + e * s2);
    }
}

typedef short bf16x8_t __attribute__((ext_vector_type(8)));
#define MFMA16(a, b, c) __builtin_amdgcn_mfma_f32_16x16x32_bf16((a), (b), (c), 0, 0, 0)
constexpr int HG_NCH = (CL + L) / 64;
constexpr int HG_LFS = 68;
constexpr int HG_TS = 72;
constexpr int HGL_LF = 0, HGL_OM = HGL_LF + 2 * 64 * HG_LFS * 4, HGL_VT = HGL_OM + 2 * 64 * HG_LFS * 4, HGL_KT = HGL_VT + 64 * HG_TS * 2, HGL_SC = HGL_KT + 2 * 64 * HG_TS * 2, HGL_OD = HGL_SC + 8 * 16 * HG_TS * 2, HGL_END = HGL_OD + 2 * 64 * HG_LFS * 4;
static_assert(HGL_END <= LDS_BYTES - 256, "hgrn LDS map");
constexpr int HG_NIT = NB * 4 * HG_NCH;
DI int hg_block_row(int b, int tb, int tok) { return tb < 4 ? ctx_row(b, tb * 64 + tok) : lat_row(b, (tb - 4) * 64 + tok); }
DI int hg_bwd_chunk(int tb) { return tb < 4 ? 3 - tb : 4 + 255 - (tb - 4); }
DI int hg_sw(int row, int col) { return row * HG_TS + ((((col >> 3) ^ (row >> 3)) & 7) << 3) + (col & 7); }
struct HgIn { u32x4 zf, zb, hv; };
DI void hg_item(int item, int& b, int& h, int& tb) { tb = item % HG_NCH; h = (item / HG_NCH) & 3; b = item / (HG_NCH * 4); }
DI void hg_load(Ctx& K, int item, HgIn& r) {
    int b, h, tb; hg_item(item, b, h, tb); const int tok = K.tid >> 3, c = K.tid & 7;
    const bf16_t* pr = K.P() + (size_t)hg_block_row(b, tb, tok) * PW + h * 64 + 8 * c;
    r.zf = *(const u32x4*)(pr + C_ZF); r.zb = *(const u32x4*)(pr + C_ZB); r.hv = *(const u32x4*)(pr + C_HV);
}
DI void hg_prep1(Ctx& K, int h, const HgIn& r) {
    float* LF = (float*)(K.lds + HGL_LF); float* OM = (float*)(K.lds + HGL_OM); bf16_t* VT = (bf16_t*)(K.lds + HGL_VT);
    const int tok = K.tid >> 3, c = K.tid & 7;
#pragma unroll
    for (int dir = 0; dir < 2; ++dir) {
        float z[8]; unpack8(dir ? r.zb : r.zf, z);
        const float* lb = K.LB() + ((size_t)dir * DEPTH + K.l) * 256 + h * 64 + 8 * c;
        float lf[8], om[8];
#pragma unroll
        for (int j = 0; j < 8; ++j) { const float lbv = lb[j], sg = sigmoidf_(z[j]); const float f = fmaxf(lbv + (1.f - lbv) * sg, 1e-30f); lf[j] = __logf(f); om[j] = (1.f - lbv) * (1.f - sg); }
        float* lfp = LF + (dir * 64 + tok) * HG_LFS + 8 * c; float* omp = OM + (dir * 64 + tok) * HG_LFS + 8 * c;
        *(f32x4*)lfp = (f32x4){lf[0], lf[1], lf[2], lf[3]}; *(f32x4*)(lfp + 4) = (f32x4){lf[4], lf[5], lf[6], lf[7]};
        *(f32x4*)omp = (f32x4){om[0], om[1], om[2], om[3]}; *(f32x4*)(omp + 4) = (f32x4){om[4], om[5], om[6], om[7]};
    }
    { const unsigned w[4] = {r.hv.x, r.hv.y, r.hv.z, r.hv.w};
#pragma unroll
      for (int j = 0; j < 4; ++j) { VT[hg_sw(8 * c + 2 * j, tok)] = (bf16_t)(w[j] & 0xffffu); VT[hg_sw(8 * c + 2 * j + 1, tok)] = (bf16_t)(w[j] >> 16); } }
}
DI void hg_prep2(Ctx& K) {
    float* LF = (float*)(K.lds + HGL_LF);
    __syncthreads();
    if (K.tid < 128) {
        const int dir = K.tid >> 6, d = K.tid & 63; float* col = LF + dir * 64 * HG_LFS + d;
        float carry = 0.f;
#pragma unroll
        for (int hf = 0; hf < 2; ++hf) { float v[32];
#pragma unroll
            for (int p = 0; p < 32; ++p) v[p] = col[(dir ? 63 - (32 * hf + p) : 32 * hf + p) * HG_LFS];
            v[0] += carry;
#pragma unroll
            for (int p = 1; p < 32; ++p) v[p] += v[p - 1];
#pragma unroll
            for (int p = 0; p < 32; ++p) col[(dir ? 63 - (32 * hf + p) : 32 * hf + p) * HG_LFS] = v[p];
            carry = v[31]; }
    }
    __syncthreads();
}
DI void ph_hgrn_A(Ctx& K) {
    float* LF = (float*)(K.lds + HGL_LF); float* OM = (float*)(K.lds + HGL_OM); bf16_t* VT = (bf16_t*)(K.lds + HGL_VT); bf16_t* KT = (bf16_t*)(K.lds + HGL_KT);
    const int r16 = K.lane & 15, g4 = K.lane >> 4;
    if (K.bid >= HG_NIT) return;
    HgIn in; hg_load(K, K.bid, in);
#pragma unroll 1
    for (int item = K.bid; item < HG_NIT; item += K.nb) {
        int b, h, tb; hg_item(item, b, h, tb);
        __syncthreads();
        hg_prep1(K, h, in);
        hg_load(K, item + K.nb < HG_NIT ? item + K.nb : item, in);
        hg_prep2(K);
        { const int tok = K.tid >> 3, c = K.tid & 7;
#pragma unroll
          for (int dir = 0; dir < 2; ++dir) {
              const float* bl = LF + (dir * 64 + (dir ? 0 : 63)) * HG_LFS + 8 * c; const float* bt = LF + (dir * 64 + tok) * HG_LFS + 8 * c; const float* om = OM + (dir * 64 + tok) * HG_LFS + 8 * c;
#pragma unroll
              for (int j = 0; j < 8; ++j) KT[dir * 64 * HG_TS + hg_sw(8 * c + j, tok)] = f2bf(om[j] * __expf(bl[j] - bt[j]));
          }
          if (K.tid < 128) { const int dir = K.tid >> 6, d = K.tid & 63; const int chain = (b * 2 + dir) * 4 + h, ch = dir ? hg_bwd_chunk(tb) : tb;
              K.AC()[((size_t)chain * HG_NCH + ch) * 64 + d] = __expf(LF[(dir * 64 + (dir ? 0 : 63)) * HG_LFS + d]); } }
        __syncthreads();
        { const int dir = K.wave >> 2, mi = K.wave & 3; const int chain = (b * 2 + dir) * 4 + h, ch = dir ? hg_bwd_chunk(tb) : tb;
          f32x4 acc[4];
#pragma unroll
          for (int db = 0; db < 4; ++db) acc[db] = (f32x4){0.f, 0.f, 0.f, 0.f};
#pragma unroll
          for (int ks = 0; ks < 2; ++ks) {
              const bf16x8_t vv = *(const bf16x8_t*)(VT + hg_sw(16 * mi + r16, 32 * ks + 8 * g4));
#pragma unroll
              for (int db = 0; db < 4; ++db) { const bf16x8_t kv = *(const bf16x8_t*)(KT + dir * 64 * HG_TS + hg_sw(16 * db + r16, 32 * ks + 8 * g4)); acc[db] = MFMA16(kv, vv, acc[db]); }
          }
          bf16_t* st = K.STB() + ((size_t)chain * HG_NCH + ch) * 4096 + (size_t)K.lane * 8;
#pragma unroll
          for (int ks = 0; ks < 2; ++ks) { const u32x4 w = (u32x4){pk2(acc[2 * ks][0], acc[2 * ks][1]), pk2(acc[2 * ks][2], acc[2 * ks][3]), pk2(acc[2 * ks + 1][0], acc[2 * ks + 1][1]), pk2(acc[2 * ks + 1][2], acc[2 * ks + 1][3])};
              *(u32x4*)(st + (mi * 2 + ks) * 512) = w; }
        }
    }
}
DI void ph_hgrn_B(Ctx& K) {
    const int per = ((16 * 2048 + K.nb - 1) / K.nb + 63) & ~63;
    const int gt = K.bid * per + K.tid;
    if (K.tid < per && gt < 16 * 2048) {
        const int chain = gt >> 11, dw = gt & 2047, m = dw & 3, lane = (dw >> 2) & 63, ks = (dw >> 8) & 1;
        const int d0 = 32 * ks + 16 * (m >> 1) + 4 * (lane >> 4) + 2 * (m & 1);
        unsigned* st = (unsigned*)(K.STB() + (size_t)chain * HG_NCH * 4096) + dw; const float* ac = K.AC() + (size_t)chain * HG_NCH * 64 + d0;
        float S0 = 0.f, S1 = 0.f;
#pragma unroll 1
        for (int c0 = 0; c0 < HG_NCH; c0 += 26) {
            unsigned u[26]; float a0[26], a1[26];
#pragma unroll
            for (int i = 0; i < 26; ++i) { u[i] = st[(size_t)(c0 + i) * 2048]; const u32x2 av = *(const u32x2*)(ac + (c0 + i) * 64); a0[i] = __uint_as_float(av.x); a1[i] = __uint_as_float(av.y); }
#pragma unroll
            for (int i = 0; i < 26; ++i) { st[(size_t)(c0 + i) * 2048] = pk2(S0, S1); S0 = a0[i] * S0 + __uint_as_float(u[i] << 16); S1 = a1[i] * S1 + __uint_as_float(u[i] & 0xffff0000u); }
        }
    }
}
struct HgInC { u32x2 q[2][2]; u32x4 gq; u32x4 st[8]; };
DI void ph_hgrn_C(Ctx& K) {
    float* LF = (float*)(K.lds + HGL_LF); float* OM = (float*)(K.lds + HGL_OM); bf16_t* VT = (bf16_t*)(K.lds + HGL_VT); bf16_t* KP = (bf16_t*)(K.lds + HGL_KT); float* OD = (float*)(K.lds + HGL_OD);
    bf16_t* SC = (bf16_t*)(K.lds + HGL_SC) + K.wave * 16 * HG_TS;
    const int r16 = K.lane & 15, g4 = K.lane >> 4, dir = K.wave >> 2, mi = K.wave & 3;
    if (K.bid >= HG_NIT) return;
    HgIn in; HgInC ic;
    hg_load(K, K.bid, in);
#define HGC_LOAD_Q(it_) do { int b_, h_, tb_; hg_item(it_, b_, h_, tb_); const bf16_t* qr = K.P() + (size_t)hg_block_row(b_, tb_, 16 * mi + r16) * PW + C_HQ + h_ * 64 + 4 * g4; \
        _Pragma("unroll") for (int ks = 0; ks < 2; ++ks) { ic.q[ks][0] = *(const u32x2*)(qr + 32 * ks); ic.q[ks][1] = *(const u32x2*)(qr + 32 * ks + 16); } } while (0)
#define HGC_LOAD_ST(it_) do { int b_, h_, tb_; hg_item(it_, b_, h_, tb_); const int chain_ = (b_ * 2 + dir) * 4 + h_, ch_ = dir ? hg_bwd_chunk(tb_) : tb_; \
        const bf16_t* sp = K.STB() + ((size_t)chain_ * HG_NCH + ch_) * 4096 + (size_t)K.lane * 8; _Pragma("unroll") for (int i_ = 0; i_ < 8; ++i_) ic.st[i_] = *(const u32x4*)(sp + i_ * 512); } while (0)
#define HGC_LOAD_G(it_) do { int b_, h_, tb_; hg_item(it_, b_, h_, tb_); const int tok_ = K.tid >> 3, c_ = K.tid & 7; \
        ic.gq = *(const u32x4*)(K.P() + (size_t)hg_block_row(b_, tb_, tok_) * PW + C_HG + h_ * 64 + 8 * c_); } while (0)
    HGC_LOAD_Q(K.bid); HGC_LOAD_ST(K.bid); HGC_LOAD_G(K.bid);
#pragma unroll 1
    for (int item = K.bid; item < HG_NIT; item += K.nb) {
        int b, h, tb; hg_item(item, b, h, tb);
        const int nxt = item + K.nb < HG_NIT ? item + K.nb : item;
        __syncthreads();
        hg_prep1(K, h, in);
        hg_load(K, nxt, in);
        hg_prep2(K);
        {
          const int tok = K.tid >> 3, c = K.tid & 7;
#pragma unroll
          for (int dd = 0; dd < 2; ++dd) { const float* rf = LF + (dd * 64 + 32) * HG_LFS + 8 * c; const float* bs = LF + (dd * 64 + tok) * HG_LFS + 8 * c; const float* om = OM + (dd * 64 + tok) * HG_LFS + 8 * c;
              unsigned o[4];
#pragma unroll
              for (int j = 0; j < 4; ++j) o[j] = pk2(om[2 * j] * __expf(rf[2 * j] - bs[2 * j]), om[2 * j + 1] * __expf(rf[2 * j + 1] - bs[2 * j + 1]));
              *(u32x4*)(KP + (dd * 64 + tok) * HG_TS + 8 * c) = (u32x4){o[0], o[1], o[2], o[3]}; } }
        __syncthreads();
        f32x4 nw0, nw1;
        { const float* LFd = LF + dir * 64 * HG_LFS; const float* ref = LFd + 32 * HG_LFS;
          bf16x8_t aq1[2], aq2[2];
          { const int t = 16 * mi + r16;
#pragma unroll
            for (int ks = 0; ks < 2; ++ks) { unsigned o1[4], o2[4];
#pragma unroll
                for (int hf = 0; hf < 2; ++hf) { const int d0 = 32 * ks + 16 * hf + 4 * g4; const unsigned qw[2] = {ic.q[ks][hf].x, ic.q[ks][hf].y};
                    const f32x4 bt = *(const f32x4*)(LFd + t * HG_LFS + d0), rf = *(const f32x4*)(ref + d0);
#pragma unroll
                    for (int j = 0; j < 2; ++j) { const float qa = __uint_as_float(qw[j] << 16), qb = __uint_as_float(qw[j] & 0xffff0000u); const float sa = qa * sigmoidf_(qa), sb = qb * sigmoidf_(qb);
                        const float e1a = __expf(bt[2 * j] - rf[2 * j]), e1b = __expf(bt[2 * j + 1] - rf[2 * j + 1]), e2a = __expf(bt[2 * j]), e2b = __expf(bt[2 * j + 1]);
                        o1[2 * hf + j] = pk2(sa * e1a, sb * e1b); o2[2 * hf + j] = pk2(sa * e2a, sb * e2b); } }
                aq1[ks] = __builtin_bit_cast(bf16x8_t, (u32x4){o1[0], o1[1], o1[2], o1[3]}); aq2[ks] = __builtin_bit_cast(bf16x8_t, (u32x4){o2[0], o2[1], o2[2], o2[3]}); } }
          HGC_LOAD_Q(nxt);
          f32x4 sc[4];
#pragma unroll
          for (int nj = 0; nj < 4; ++nj) { sc[nj] = (f32x4){0.f, 0.f, 0.f, 0.f}; const bf16_t* kr = KP + (dir * 64 + 16 * nj + r16) * HG_TS + 4 * g4;
#pragma unroll
              for (int ks = 0; ks < 2; ++ks) { const u32x2 k0 = *(const u32x2*)(kr + 32 * ks), k1 = *(const u32x2*)(kr + 32 * ks + 16);
                  sc[nj] = MFMA16(aq1[ks], __builtin_bit_cast(bf16x8_t, (u32x4){k0.x, k0.y, k1.x, k1.y}), sc[nj]); } }
#pragma unroll
          for (int nj = 0; nj < 4; ++nj)
#pragma unroll
              for (int rg = 0; rg < 4; ++rg) { const int tl = 4 * g4 + rg, t = 16 * mi + tl, s_ = 16 * nj + r16; const bool keep = dir ? (s_ >= t) : (s_ <= t);
                  SC[tl * HG_TS + s_] = f2bf(keep ? sc[nj][rg] : 0.f); }
          asm volatile("s_waitcnt lgkmcnt(0)" ::: "memory");
          f32x4 oacc[4];
#pragma unroll
          for (int nj = 0; nj < 4; ++nj) oacc[nj] = (f32x4){0.f, 0.f, 0.f, 0.f};
#pragma unroll
          for (int ks = 0; ks < 2; ++ks) {
              const bf16x8_t as = *(const bf16x8_t*)(SC + r16 * HG_TS + 32 * ks + 8 * g4);
#pragma unroll
              for (int nj = 0; nj < 4; ++nj) {
                  const bf16x8_t bv = *(const bf16x8_t*)(VT + hg_sw(16 * nj + r16, 32 * ks + 8 * g4));
                  oacc[nj] = MFMA16(as, bv, oacc[nj]);
                  oacc[nj] = MFMA16(aq2[ks], __builtin_bit_cast(bf16x8_t, ic.st[nj * 2 + ks]), oacc[nj]);
              }
          }
          HGC_LOAD_ST(nxt);
          { const float* nwp = ARG(hgrn_norm_w) + (size_t)K.l * 256 + h * 64 + 8 * (K.tid & 7); nw0 = *(const f32x4*)nwp; nw1 = *(const f32x4*)(nwp + 4); }
#pragma unroll
          for (int nj = 0; nj < 4; ++nj)
#pragma unroll
              for (int rg = 0; rg < 4; ++rg) OD[(dir * 64 + 16 * mi + 4 * g4 + rg) * HG_LFS + 16 * nj + r16] = oacc[nj][rg];
        }
        __syncthreads();
        { const int tok = K.tid >> 3, c = K.tid & 7; const int row = hg_block_row(b, tb, tok);
          const float* o0 = OD + tok * HG_LFS + 8 * c; const float* o1 = OD + (64 + tok) * HG_LFS + 8 * c;
          float o[8], ss = 0.f;
#pragma unroll
          for (int j = 0; j < 8; ++j) { o[j] = o0[j] + o1[j]; ss += o[j] * o[j]; }
          ss += __shfl_xor(ss, 1); ss += __shfl_xor(ss, 2); ss += __shfl_xor(ss, 4);
          const float rs = rsqrtf(ss * (1.0f / 64.0f) + EPS);
          float gq[8]; unpack8(ic.gq, gq);
          const float nw[8] = {nw0[0], nw0[1], nw0[2], nw0[3], nw1[0], nw1[1], nw1[2], nw1[3]};
          float y[8];
#pragma unroll
          for (int j = 0; j < 8; ++j) y[j] = o[j] * rs * nw[j] * gq[j] * sigmoidf_(gq[j]);
          HGC_LOAD_G(nxt);
          u32x4 w; w.x = pk2(y[0], y[1]); w.y = pk2(y[2], y[3]); w.z = pk2(y[4], y[5]); w.w = pk2(y[6], y[7]);
          *(u32x4*)(K.MIX() + (size_t)row * D + MX_H + h * 64 + 8 * c) = w; }
    }
#undef HGC_LOAD_Q
#undef HGC_LOAD_ST
#undef HGC_LOAD_G
}

constexpr int AT_TS = 72;
constexpr int ATL_K = 0, ATL_V = ATL_K + 64 * AT_TS * 2, ATL_P = ATL_V + 64 * AT_TS * 2, ATL_END = ATL_P + 8 * 48 * AT_TS * 2;
static_assert(ATL_END <= LDS_BYTES - 256, "attention LDS map");
DI float dpp_max16(float x) { x = fmaxf(x, dpp_<0xB1>(x)); x = fmaxf(x, dpp_<0x4E>(x)); x = fmaxf(x, dpp_<0x141>(x)); x = fmaxf(x, dpp_<0x128>(x)); return x; }
DI float dpp_sum16(float x) { x += dpp_<0xB1>(x); x += dpp_<0x4E>(x); x += dpp_<0x141>(x); x += dpp_<0x128>(x); return x; }
DI unsigned cvtpk(float lo, float hi) { unsigned r; asm("v_cvt_pk_bf16_f32 %0, %1, %2" : "=v"(r) : "v"(lo), "v"(hi)); return r; }
DI float xg4_max(float x) { x = fmaxf(x, __shfl_xor(x, 16)); x = fmaxf(x, __shfl_xor(x, 32)); return x; }
template <int MT, int NJ, bool SAMEKB> DI void at_softmax_pv(f32x4 (&sT)[MT][NJ], float (&mrun)[MT], float (&lrun)[MT], f32x4 (&oacc)[MT][4], const bf16_t* VT, const int (&kb)[MT], int r16, int g4) {
    unsigned pb[MT][NJ / 2][4];
#pragma unroll
    for (int mt = 0; mt < MT; ++mt) {
        float mx = -INFINITY;
#pragma unroll
        for (int nj = 0; nj < NJ; ++nj) mx = fmaxf(mx, fmaxf(fmaxf(sT[mt][nj][0], sT[mt][nj][1]), fmaxf(sT[mt][nj][2], sT[mt][nj][3])));
        mx = xg4_max(mx);
        const float mn = fmaxf(mrun[mt], mx), alpha = __expf(mrun[mt] - mn); mrun[mt] = mn;
        float rs_ = 0.f;
#pragma unroll
        for (int nj = 0; nj < NJ; ++nj)
#pragma unroll
            for (int rg = 0; rg < 4; ++rg) { const float pe = __expf(sT[mt][nj][rg] - mn); sT[mt][nj][rg] = pe; rs_ += pe; }
        lrun[mt] = lrun[mt] * alpha + rs_;
#pragma unroll
        for (int ne = 0; ne < 4; ++ne) oacc[mt][ne] *= alpha;
#pragma unroll
        for (int ks = 0; ks < NJ / 2; ++ks) { pb[mt][ks][0] = cvtpk(sT[mt][2 * ks][0], sT[mt][2 * ks][1]); pb[mt][ks][1] = cvtpk(sT[mt][2 * ks][2], sT[mt][2 * ks][3]);
            pb[mt][ks][2] = cvtpk(sT[mt][2 * ks + 1][0], sT[mt][2 * ks + 1][1]); pb[mt][ks][3] = cvtpk(sT[mt][2 * ks + 1][2], sT[mt][2 * ks + 1][3]); }
    }
#pragma unroll
    for (int ks = 0; ks < NJ / 2; ++ks)
#pragma unroll
        for (int ne = 0; ne < 4; ++ne) { const int e = 16 * ne + r16, sw = (e >> 3) & 7;
            u32x4 vf_shared;
            if (SAMEKB) { const int blk = (kb[0] >> 3) + 4 * ks + (g4 >> 1); const u32x2 v0 = *(const u32x2*)(VT + e * AT_TS + ((blk ^ sw) << 3) + 4 * (g4 & 1)), v1 = *(const u32x2*)(VT + e * AT_TS + (((blk + 2) ^ sw) << 3) + 4 * (g4 & 1));
                vf_shared = (u32x4){v0.x, v0.y, v1.x, v1.y}; }
#pragma unroll
            for (int mt = 0; mt < MT; ++mt) { u32x4 vf = vf_shared;
                if (!SAMEKB) { const int blk = (kb[mt] >> 3) + 4 * ks + (g4 >> 1); const u32x2 v0 = *(const u32x2*)(VT + e * AT_TS + ((blk ^ sw) << 3) + 4 * (g4 & 1)), v1 = *(const u32x2*)(VT + e * AT_TS + (((blk + 2) ^ sw) << 3) + 4 * (g4 & 1));
                    vf = (u32x4){v0.x, v0.y, v1.x, v1.y}; }
                oacc[mt][ne] = MFMA16(__builtin_bit_cast(bf16x8_t, vf), __builtin_bit_cast(bf16x8_t, (u32x4){pb[mt][ks][0], pb[mt][ks][1], pb[mt][ks][2], pb[mt][ks][3]}), oacc[mt][ne]); } }
}
template <int KIND> DI void attn_item(Ctx& K, int idx, const float* sinkp, const float* rpbp) {
    constexpr int MT = KIND == 0 ? 3 : 2;
    int tid_ = K.tid; asm volatile("" : "+v"(tid_));
    const int lane_ = tid_ & 63, wave_ = tid_ >> 6;
    bf16_t* KT = (bf16_t*)(K.lds + ATL_K); bf16_t* VT = (bf16_t*)(K.lds + ATL_V); float* RPB = (float*)(K.lds + ATL_P);
    const int r16 = lane_ & 15, g4 = lane_ >> 4;
    int b, hk, qb = 0;
    if (KIND == 0) { qb = idx & 127; hk = (idx >> 7) & 1; b = idx >> 8; }
    else if (KIND == 1) { qb = idx & 63; hk = (idx >> 6) % 6; b = (idx >> 6) / 6; }
    else { hk = idx % 6; b = idx / 6; }
    const int kcol = (KIND == 0) ? C_SK + hk * 64 : (KIND == 2) ? C_SK + (hk / 3) * 64 : C_NK + hk * 64;
    const int vcol = (KIND == 0) ? C_SV + hk * 64 : (KIND == 2) ? C_SV + (hk / 3) * 64 : C_NV + hk * 64;
    int t0 = 0, nloc = 0;
    if (KIND == 0) { const int k0 = max(2 * qb - 2, 0), k1 = min(2 * qb + 3, L / 64 - 1); t0 = k0; nloc = k1 - k0 + 1; }
    if (KIND == 1) { const int k0 = min(max(4 * qb - 4, 0), L / 64 - 8), k1 = min(max(4 * qb + 3 - 4, 0), L / 64 - 8) + 7; t0 = k0; nloc = k1 - k0 + 1; }
    const int ntiles = nloc + CL / 64;
    int w_r = 0, w_rs = 0;
    if (KIND == 1) { w_r = 4 * qb + (wave_ >> 1); w_rs = min(max(w_r - 4, 0), L / 64 - 8); }
    bf16x8_t qf[MT][2]; int qbase[MT], hq_mt[MT], qrow[MT];
#pragma unroll
    for (int mt = 0; mt < MT; ++mt) {
        int arow, hq;
        if (KIND == 0) { const int rho = wave_ * 48 + mt * 16; hq = hk * 3 + rho / 128; hq_mt[mt] = hq; const int tb = 128 * qb + (rho & 127); arow = lat_row(b, tb + r16); qbase[mt] = tb; }
        else if (KIND == 1) { hq = hk; hq_mt[mt] = hq; const int cb = 32 * (wave_ & 1) + 16 * mt; arow = lat_row(b, w_r * 64 + cb + r16); qbase[mt] = cb; }
        else { hq = hk; hq_mt[mt] = hq; const int tb = wave_ * 32 + mt * 16; arow = ctx_row(b, tb + r16); qbase[mt] = 0; }
        qrow[mt] = arow;
        const int qcol = (KIND == 0 || KIND == 2) ? C_SQ + hq * 64 : C_NQ + hq * 64;
#pragma unroll
        for (int ks = 0; ks < 2; ++ks) { float q[8]; unpack8(*(const u32x4*)(K.P() + (size_t)arow * PW + qcol + 32 * ks + 8 * g4), q);
            const u32x4 w = (u32x4){pk2(q[0] * 0.125f, q[1] * 0.125f), pk2(q[2] * 0.125f, q[3] * 0.125f), pk2(q[4] * 0.125f, q[5] * 0.125f), pk2(q[6] * 0.125f, q[7] * 0.125f)};
            qf[mt][ks] = __builtin_bit_cast(bf16x8_t, w); }
    }
    f32x4 oacc[MT][4]; float mrun[MT], lrun[MT];
#pragma unroll
    for (int mt = 0; mt < MT; ++mt) {
#pragma unroll
        for (int ne = 0; ne < 4; ++ne) oacc[mt][ne] = (f32x4){0.f, 0.f, 0.f, 0.f};
        const bool has_sink = (KIND == 0 || KIND == 2);
        mrun[mt] = has_sink ? sinkp[hq_mt[mt]] : -1.0e30f; lrun[mt] = (has_sink && g4 == 0) ? 1.0f : 0.0f;
    }
    const int lkey = tid_ >> 3, lch = tid_ & 7;
    u32x4 pk_, pv_;
    { const int ti = 0; const int grow = (ti < nloc) ? lat_row(b, (t0 + ti) * 64 + lkey) : ctx_row(b, (ti - nloc) * 64 + lkey);
      const bf16_t* pr = K.P() + (size_t)grow * PW + 8 * lch; pk_ = *(const u32x4*)(pr + kcol); pv_ = *(const u32x4*)(pr + vcol); }
#pragma unroll 1
    for (int ti = 0; ti < ntiles; ++ti) {
        __syncthreads();
        *(u32x4*)(KT + lkey * AT_TS + 8 * lch) = pk_;
        { const unsigned w[4] = {pv_.x, pv_.y, pv_.z, pv_.w};
          const int vsw = (((lkey >> 3) ^ lch) << 3) + (lkey & 7);
#pragma unroll
          for (int j = 0; j < 4; ++j) { VT[(8 * lch + 2 * j) * AT_TS + vsw] = (bf16_t)(w[j] & 0xffffu); VT[(8 * lch + 2 * j + 1) * AT_TS + vsw] = (bf16_t)(w[j] >> 16); } }
        if (KIND == 1 && ti == 0 && tid_ < 15 * 31) RPB[tid_] = rpbp[tid_];
        __syncthreads();
        if (ti + 1 < ntiles) { const int tn = ti + 1; const int grow = (tn < nloc) ? lat_row(b, (t0 + tn) * 64 + lkey) : ctx_row(b, (tn - nloc) * 64 + lkey);
            const bf16_t* pr = K.P() + (size_t)grow * PW + 8 * lch; pk_ = *(const u32x4*)(pr + kcol); pv_ = *(const u32x4*)(pr + vcol); }
        const bool local = ti < nloc; const int kunit = t0 + ti;
        if (KIND == 1 && local) {
            if ((kunit >= w_rs) && (kunit < w_rs + 8)) {
                f32x4 sT[MT][2]; int kb[MT];
#pragma unroll
                for (int mt = 0; mt < MT; ++mt) { kb[mt] = min(max(qbase[mt] - 8, 0), 32);
#pragma unroll
                    for (int nj = 0; nj < 2; ++nj) { sT[mt][nj] = (f32x4){0.f, 0.f, 0.f, 0.f};
#pragma unroll
                        for (int ks = 0; ks < 2; ++ks) { const bf16x8_t kf = *(const bf16x8_t*)(KT + (kb[mt] + 16 * nj + r16) * AT_TS + 32 * ks + 8 * g4); sT[mt][nj] = MFMA16(kf, qf[mt][ks], sT[mt][nj]); } } }
                const float* rp = RPB + (kunit - w_r + 7) * 31 + 15;
#pragma unroll
                for (int mt = 0; mt < MT; ++mt) { const int c = qbase[mt] + r16, ws = min(max(c - 8, 0), 48);
#pragma unroll
                    for (int nj = 0; nj < 2; ++nj)
#pragma unroll
                        for (int rg = 0; rg < 4; ++rg) { const int key = kb[mt] + 16 * nj + 4 * g4 + rg; const bool ok = key >= ws && key < ws + 16;
                            sT[mt][nj][rg] = ok ? sT[mt][nj][rg] + rp[ok ? key - c : 0] : -INFINITY; } }
                at_softmax_pv<MT, 2, false>(sT, mrun, lrun, oacc, VT, kb, r16, g4);
            }
        } else {
            f32x4 sT[MT][4];
#pragma unroll
            for (int mt = 0; mt < MT; ++mt)
#pragma unroll
                for (int nj = 0; nj < 4; ++nj) sT[mt][nj] = (f32x4){0.f, 0.f, 0.f, 0.f};
#pragma unroll
            for (int nj = 0; nj < 4; ++nj)
#pragma unroll
                for (int ks = 0; ks < 2; ++ks) { const bf16x8_t kf = *(const bf16x8_t*)(KT + (16 * nj + r16) * AT_TS + 32 * ks + 8 * g4);
#pragma unroll
                    for (int mt = 0; mt < MT; ++mt) sT[mt][nj] = MFMA16(kf, qf[mt][ks], sT[mt][nj]); }
            if (KIND == 0 && local) {
#pragma unroll
                for (int mt = 0; mt < MT; ++mt) { const int dq = qbase[mt] + r16 - kunit * 64 - 4 * g4;
#pragma unroll
                    for (int nj = 0; nj < 4; ++nj)
#pragma unroll
                        for (int rg = 0; rg < 4; ++rg) { const int dl = dq - (16 * nj + rg); if (dl > 128 || dl < -128) sT[mt][nj][rg] = -INFINITY; } }
            }
            int kb0[MT];
#pragma unroll
            for (int mt = 0; mt < MT; ++mt) kb0[mt] = 0;
            at_softmax_pv<MT, 4, true>(sT, mrun, lrun, oacc, VT, kb0, r16, g4);
        }
    }
#pragma unroll
    for (int mt = 0; mt < MT; ++mt) {
        float l = lrun[mt]; l += __shfl_xor(l, 16); l += __shfl_xor(l, 32);
        const float inv = 1.0f / l;
        const int ocol = ((KIND == 0 || KIND == 2) ? MX_S : MX_N) + hq_mt[mt] * 64;
#pragma unroll
        for (int ne = 0; ne < 4; ++ne) { u32x2 o; o.x = cvtpk(oacc[mt][ne][0] * inv, oacc[mt][ne][1] * inv); o.y = cvtpk(oacc[mt][ne][2] * inv, oacc[mt][ne][3] * inv);
            *(u32x2*)(K.MIX() + (size_t)qrow[mt] * D + ocol + 16 * ne + 4 * g4) = o; }
    }
}
DI void ph_attn(Ctx& K) {
    constexpr int N_SWA = NB * 2 * (L / 128), N_NAT = NB * 6 * (L / 256), N_C = NB * 6;
    const float* sinkp = ARG(swa_sink) + K.l * 6;
    for (int item = K.bid; item < N_SWA + N_NAT + 2 * N_C; item += K.nb) {
        if (item < N_SWA) attn_item<0>(K, item, sinkp, nullptr);
        else if (item < N_SWA + N_NAT) { const int it = item - N_SWA; const int h = (it >> 6) % 6; attn_item<1>(K, it, nullptr, ARG(nat_rpb) + ((size_t)K.l * 6 + h) * 15 * 31); }
        else if (item < N_SWA + N_NAT + N_C) attn_item<2>(K, item - N_SWA - N_NAT, sinkp, nullptr);
        else attn_item<3>(K, item - N_SWA - N_NAT - N_C, nullptr, nullptr);
    }
}

DI unsigned fkey(float f) { const unsigned u = __float_as_uint(f); return (u & 0x80000000u) ? ~u : (u | 0x80000000u); }
DI int mbcnt64(unsigned long long m) { return (int)__builtin_amdgcn_mbcnt_hi((unsigned)(m >> 32), __builtin_amdgcn_mbcnt_lo((unsigned)m, 0u)); }
template <int NV> DI unsigned radix_thr16(const unsigned (&k)[NV]) {
    unsigned prefix = 0u;
#pragma unroll 1
    for (int bit = 31; bit >= 0; --bit) {
        const unsigned cand = prefix | (1u << bit); int cnt = 0;
#pragma unroll
        for (int i = 0; i < NV; ++i) cnt += __popcll(__ballot(k[i] >= cand));
        if (cnt >= 16) { prefix = cand; if (cnt == 16) break; }
    }
    return prefix;
}
template <int NC, int NV> DI void radix_thr16_multi(const unsigned (&k)[NC][NV], unsigned (&T)[NC]) {
    bool exact[NC];
#pragma unroll
    for (int c = 0; c < NC; ++c) { T[c] = 0u; exact[c] = false; }
#pragma unroll 1
    for (int bit = 31; bit >= 0; --bit) {
        bool all = true;
#pragma unroll
        for (int c = 0; c < NC; ++c) {
            const unsigned cand = T[c] | (1u << bit); int cnt = 0;
#pragma unroll
            for (int i = 0; i < NV; ++i) cnt += __popcll(__ballot(k[c][i] >= cand));
            if (cnt >= 16) { T[c] = cand; exact[c] = (cnt == 16); }
            all = all && exact[c];
        }
        if (all) break;
    }
}
template <int NV> DI void select16(const unsigned (&k)[NV], unsigned T, bool (&sel)[NV], int (&pos)[NV]) {
    int ngt = 0; unsigned long long gtm[NV], eqm[NV];
#pragma unroll
    for (int i = 0; i < NV; ++i) { gtm[i] = __ballot(k[i] > T); eqm[i] = __ballot(k[i] == T); ngt += __popcll(gtm[i]); }
    const int need = 16 - ngt; int eqbase = 0, selbase = 0;
#pragma unroll
    for (int i = 0; i < NV; ++i) {
        const bool iseq = k[i] == T; const int erank = eqbase + mbcnt64(eqm[i]); eqbase += __popcll(eqm[i]);
        sel[i] = (k[i] > T) || (iseq && erank < need);
        const unsigned long long sm = __ballot(sel[i]); pos[i] = selbase + mbcnt64(sm); selbase += __popcll(sm);
    }
}
template <int CTRL> DI int dppi_(int x) { return __builtin_amdgcn_mov_dpp(x, CTRL, 0xf, 0xf, true); }
DI int row_sum_i(int x) { x += dppi_<0xB1>(x); x += dppi_<0x4E>(x); x += dppi_<0x141>(x); x += dppi_<0x128>(x); return x; }
DI int row_excl_scan_i(int x) { int s_ = x; s_ += dppi_<0x111>(s_); s_ += dppi_<0x112>(s_); s_ += dppi_<0x114>(s_); s_ += dppi_<0x118>(s_); return s_ - x; }
DI unsigned row_minmax_u(unsigned x, bool want_max) {
    unsigned y;
    y = (unsigned)dppi_<0xB1>((int)x); x = want_max ? max(x, y) : min(x, y); y = (unsigned)dppi_<0x4E>((int)x); x = want_max ? max(x, y) : min(x, y);
    y = (unsigned)dppi_<0x141>((int)x); x = want_max ? max(x, y) : min(x, y); y = (unsigned)dppi_<0x128>((int)x); x = want_max ? max(x, y) : min(x, y);
    return x;
}
template <int NK> DI unsigned row_radix_thr16(const unsigned (&k)[NK]) {
    unsigned lm = k[0];
#pragma unroll
    for (int i = 1; i < NK; ++i) lm = max(lm, k[i]);
    unsigned lo = row_minmax_u(lm, false), hi = row_minmax_u(lm, true) + 1u;
    bool done = false;
#pragma unroll 1
    for (int itn = 0; itn < 40; ++itn) {
        const unsigned span = hi - lo; done = done || (span <= 1u);
        const unsigned mid = lo + (span >> 1); int cnt = 0;
#pragma unroll
        for (int i = 0; i < NK; ++i) cnt += (k[i] >= mid) ? 1 : 0;
        cnt = row_sum_i(cnt);
        const bool ge = cnt >= 16;
        if (!done) { if (ge) lo = mid; else hi = mid; }
        done = done || (cnt == 16);
        if (__ballot(!done) == 0ull) break;
    }
    return lo;
}
template <int NK> DI void row_select16(const unsigned (&k)[NK], unsigned T, bool (&sel)[NK], int (&pos)[NK]) {
    int g = 0, q = 0;
#pragma unroll
    for (int i = 0; i < NK; ++i) { g += (k[i] > T) ? 1 : 0; q += (k[i] == T) ? 1 : 0; }
    const int need = 16 - row_sum_i(g);
    const int a = min(max(need - row_excl_scan_i(q), 0), q);
    int nxt = row_excl_scan_i(g + a), eqs = 0;
#pragma unroll
    for (int i = 0; i < NK; ++i) { const bool iseq = k[i] == T; sel[i] = (k[i] > T) || (iseq && eqs < a); eqs += iseq ? 1 : 0; pos[i] = nxt; nxt += sel[i] ? 1 : 0; }
}
DI void ce_desc(unsigned& x, unsigned& y) { const unsigned hi = max(x, y), lo = min(x, y); x = hi; y = lo; }
DI void sort8_desc(unsigned (&a)[8]) {
    ce_desc(a[0], a[1]); ce_desc(a[2], a[3]); ce_desc(a[4], a[5]); ce_desc(a[6], a[7]); ce_desc(a[0], a[2]); ce_desc(a[1], a[3]); ce_desc(a[4], a[6]); ce_desc(a[5], a[7]);
    ce_desc(a[1], a[2]); ce_desc(a[5], a[6]); ce_desc(a[0], a[4]); ce_desc(a[3], a[7]); ce_desc(a[1], a[5]); ce_desc(a[2], a[6]); ce_desc(a[1], a[4]); ce_desc(a[3], a[6]);
    ce_desc(a[2], a[4]); ce_desc(a[3], a[5]); ce_desc(a[3], a[4]); }
DI void sort4_desc(unsigned (&a)[4]) { ce_desc(a[0], a[1]); ce_desc(a[2], a[3]); ce_desc(a[0], a[2]); ce_desc(a[1], a[3]); ce_desc(a[1], a[2]); }
DI float fkey_inv(unsigned k) { return __uint_as_float((k & 0x80000000u) ? (k & 0x7fffffffu) : ~k); }
DI void cex_(unsigned& k, int& ix, unsigned pk, int pi, bool lower) { const bool take = lower ? (pk > k) : (pk < k); k = take ? pk : k; ix = take ? pi : ix; }
template <int CTRL> DI void cex_dpp(unsigned& k, int& ix, bool lower) { const unsigned pk = (unsigned)dppi_<CTRL>((int)k); const int pi = dppi_<CTRL>(ix); cex_(k, ix, pk, pi, lower); }
DI void row_sort16_desc(unsigned& k, int& ix, int j16) {
    const bool l1 = (j16 & 1) == 0, l2 = (j16 & 2) == 0, l4 = (j16 & 4) == 0, l8 = (j16 & 8) == 0;
    cex_dpp<0xB1>(k, ix, l1);
    cex_dpp<0x1B>(k, ix, l2); cex_dpp<0xB1>(k, ix, l1);
    cex_dpp<0x141>(k, ix, l4); cex_dpp<0x4E>(k, ix, l2); cex_dpp<0xB1>(k, ix, l1);
    cex_dpp<0x140>(k, ix, l8);
    { const unsigned pk = (unsigned)__builtin_amdgcn_ds_swizzle((int)k, 0x101F); const int pi = __builtin_amdgcn_ds_swizzle(ix, 0x101F); cex_(k, ix, pk, pi, l4); }
    cex_dpp<0x4E>(k, ix, l2); cex_dpp<0xB1>(k, ix, l1);
}
constexpr int PSL_SK = 0, PSL_TOP = 131072;
static_assert(PSL_TOP + 8 * 1024 <= LDS_BYTES - 256, "peer select LDS map");
template <int PROBE> DI void ph_peer_select(Ctx& K) {
    float* TOPV = (float*)(K.lds + PSL_TOP + K.wave * 1024); int* TOPI = (int*)(TOPV + 128);
    const int r16 = K.lane & 15, g4 = K.lane >> 4, j16 = r16;
    const int nhg = K.nb < 8 ? K.nb : 8, grp = K.bid % nhg, jw = K.bid / nhg, nj = (K.nb - grp + nhg - 1) / nhg;
    constexpr int N_T = M / 16;
    const int nwv = nj * 8, wg = jw * 8 + K.wave;
    const int n_full = (N_T / nwv) * nwv, n_work = n_full + 4 * (N_T - n_full);
    for (int h = grp; h < 8; h += nhg) {
        __syncthreads();
        { const u32x4* sh = (const u32x4*)(K.SKH() + ((size_t)K.l * 8 + h) * 2 * 16384); const u32x4* sl = (const u32x4*)(K.SKL() + ((size_t)K.l * 8 + h) * 2 * 16384);
          u32x4* dst = (u32x4*)(K.lds + PSL_SK);
          u32x4 t[8];
#pragma unroll
          for (int i = 0; i < 8; ++i) t[i] = sh[K.tid + 512 * i];
#pragma unroll
          for (int i = 0; i < 8; ++i) dst[K.tid + 512 * i] = t[i];
#pragma unroll
          for (int i = 0; i < 8; ++i) t[i] = sl[K.tid + 512 * i];
#pragma unroll
          for (int i = 0; i < 8; ++i) dst[4096 + K.tid + 512 * i] = t[i]; }
        __syncthreads();
#pragma unroll 1
        for (int wk = wg; wk < n_work; wk += nwv) {
            const bool part = wk >= n_full; const int tile = part ? n_full + ((wk - n_full) >> 2) : wk; const int rg_lo = part ? ((wk - n_full) & 3) : 0, rg_hi = part ? rg_lo + 1 : 4;
            const int t0 = tile * 16;
            float S[2][8][4];
#pragma unroll
            for (int p = 0; p < 2; ++p) {
                bf16x8_t aq[4];
                { const bf16_t* qp = K.QP() + (size_t)(t0 + r16) * 2048 + h * 256 + p * 128 + 8 * g4;
#pragma unroll
                  for (int ks = 0; ks < 4; ++ks) aq[ks] = *(const bf16x8_t*)(qp + 32 * ks); }
                const unsigned char* kb = K.lds + PSL_SK + p * 32768 + K.lane * 16;
#pragma unroll
                for (int nt = 0; nt < 8; ++nt) {
                    f32x4 c0 = {0.f, 0.f, 0.f, 0.f}, c1 = c0;
#pragma unroll
                    for (int ks = 0; ks < 4; ++ks) { const bf16x8_t bh = *(const bf16x8_t*)(kb + (nt * 4 + ks) * 1024), bl = *(const bf16x8_t*)(kb + 65536 + (nt * 4 + ks) * 1024);
                        c0 = MFMA16(aq[ks], bh, c0); c1 = MFMA16(aq[ks], bl, c1); }
#pragma unroll
                    for (int rg = 0; rg < 4; ++rg) S[p][nt][rg] = c0[rg] + c1[rg];
                }
            }
            if (PROBE == 1) { float a = 0.f;
#pragma unroll
                for (int p = 0; p < 2; ++p)
#pragma unroll
                    for (int nt = 0; nt < 8; ++nt) a += S[p][nt][0] + S[p][nt][1] + S[p][nt][2] + S[p][nt][3];
                TOPV[K.lane] = a; continue; }
#pragma unroll 1
            for (int rg = 0; rg < 4; ++rg) {
                if (rg >= rg_lo && rg < rg_hi) {
                    unsigned a[2][8], mine[2] = {0u, 0u};
#pragma unroll
                    for (int p = 0; p < 2; ++p) {
#pragma unroll
                        for (int i = 0; i < 8; ++i) a[p][i] = (fkey(S[p][i][0]) & 0xFFFFFF80u) | (unsigned)(j16 + 16 * i);
                        sort8_desc(a[p]); }
#pragma unroll 1
                    for (int it = 0; it < 16; ++it) {
#pragma unroll
                        for (int p = 0; p < 2; ++p) { const unsigned m = row_minmax_u(a[p][0], true); const bool win = a[p][0] == m;
#pragma unroll
                            for (int i = 0; i < 7; ++i) a[p][i] = win ? a[p][i + 1] : a[p][i];
                            a[p][7] = win ? 0u : a[p][7];
                            mine[p] = (j16 == it) ? m : mine[p]; }
                    }
                    unsigned* TA = (unsigned*)TOPV + (g4 * 2) * 16; unsigned* TB = TA + 16;
                    TA[j16] = mine[0]; TB[j16] = mine[1];
                    asm volatile("s_waitcnt lgkmcnt(0)" ::: "memory");
                    { const int r = t0 + 4 * g4 + rg, t = j16;
                      int ci[4], cj[4];
                      ci[0] = 0; cj[0] = t;
                      ci[1] = t < 8 ? 1 : t; cj[1] = t < 8 ? t : 0;
                      ci[2] = t <= 4 ? 2 : t <= 8 ? 3 : t <= 11 ? 4 : t <= 13 ? 5 : 6; cj[2] = t <= 4 ? t : t <= 8 ? t - 5 : t <= 11 ? t - 9 : t <= 13 ? t - 12 : t - 14;
                      ci[3] = 7; cj[3] = t & 1;
                      unsigned c[4];
#pragma unroll
                      for (int q = 0; q < 4; ++q) { const float cv = fkey_inv(TA[ci[q]] & 0xFFFFFF80u) + fkey_inv(TB[cj[q]] & 0xFFFFFF80u); c[q] = (fkey(cv) & 0xFFFFFFC0u) | (unsigned)(t * 4 + q); }
                      if (t > 1) c[3] = 0u;
                      sort4_desc(c);
                      unsigned w = 0u;
#pragma unroll 1
                      for (int it = 0; it < 16; ++it) { const unsigned m = row_minmax_u(c[0], true); const bool win = c[0] == m;
                          c[0] = win ? c[1] : c[0]; c[1] = win ? c[2] : c[1]; c[2] = win ? c[3] : c[2]; c[3] = win ? 0u : c[3];
                          w = (j16 == it) ? m : w; }
                      const float val = fkey_inv(w & 0xFFFFFFC0u); const int tw = (int)(w >> 2) & 15, qw = (int)w & 3;
                      const int i2 = tw <= 4 ? 2 : tw <= 8 ? 3 : tw <= 11 ? 4 : tw <= 13 ? 5 : 6, j2 = tw <= 4 ? tw : tw <= 8 ? tw - 5 : tw <= 11 ? tw - 9 : tw <= 13 ? tw - 12 : tw - 14;
                      const int wi = qw == 0 ? 0 : qw == 1 ? (tw < 8 ? 1 : tw) : qw == 2 ? i2 : 7, wj = qw == 0 ? tw : qw == 1 ? (tw < 8 ? tw : 0) : qw == 2 ? j2 : (tw & 1);
                      const int e = (int)(TA[wi] & 127u) * 128 + (int)(TB[wj] & 127u);
                      const float mx = dpp_max16(val);
                      const float ex = __expf(val - mx), es = dpp_sum16(ex);
                      K.PIDX()[(size_t)r * 128 + h * 16 + j16] = e; K.PG()[(size_t)r * 128 + h * 16 + j16] = ex / es;
                    }
                    asm volatile("s_waitcnt lgkmcnt(0)" ::: "memory");
                }
#pragma unroll
                for (int p = 0; p < 2; ++p)
#pragma unroll
                    for (int i = 0; i < 8; ++i) { S[p][i][0] = S[p][i][1]; S[p][i][1] = S[p][i][2]; S[p][i][2] = S[p][i][3]; }
            }
        }
    }
}

constexpr int PUL_H = 0, PUL_SLOT = 4096, PUL_STRIDE = 4352;
struct PuMeta { float hs[2]; int ia[2], ib[2]; };
DI void pu_load(const Ctx& K, int r0, int step, PuMeta& m, unsigned char* hbuf) {
#pragma unroll
    for (int q = 0; q < 2; ++q) { const int r = r0 + q * step;
        if (r < M) { __builtin_amdgcn_global_load_lds((const unsigned*)(K.H8() + (size_t)r * D + K.lane * 16), (LAS unsigned*)(hbuf + q * 1024), 16, 0, 0);
            m.hs[q] = K.HS()[r]; m.ia[q] = K.PIDX()[(size_t)r * 128 + K.lane]; m.ib[q] = K.PIDX()[(size_t)r * 128 + 64 + K.lane]; }
        else { m.hs[q] = 0.f; m.ia[q] = -1; m.ib[q] = -1; } }
}
typedef int i32x4 __attribute__((ext_vector_type(4)));
DI int sel4i(const i32x4 v, int k) { return k == 0 ? v[0] : k == 1 ? v[1] : k == 2 ? v[2] : v[3]; }
template <int PROBE> DI void pu_item(const Ctx& K, const unsigned char* U, unsigned char* HL, int* SLOT, int R, int r0, int step, const PuMeta& m, int r16, int g4, float& dummy) {
    const float hs[2] = {m.hs[0], m.hs[1]};
    bool sa[2], sb[2]; int ra[2], rb[2]; int n = 0;
#pragma unroll
    for (int q = 0; q < 2; ++q) { sa[q] = (m.ia[q] >> 11) == R; sb[q] = (m.ib[q] >> 11) == R; const unsigned long long ma = __ballot(sa[q]), mb = __ballot(sb[q]);
        ra[q] = n + mbcnt64(ma); n += __popcll(ma); rb[q] = n + mbcnt64(mb); n += __popcll(mb); }
    const int E = r16 >> 2, qq = r16 & 3, rho = r16 >> 3;
#pragma unroll 1
    for (int base = 0; base < n; base += 32) {
#pragma unroll
        for (int q = 0; q < 2; ++q) {
            if (sa[q] && ra[q] >= base && ra[q] < base + 32) { SLOT[2 * (ra[q] - base)] = m.ia[q]; SLOT[2 * (ra[q] - base) + 1] = q * 128 + K.lane; }
            if (sb[q] && rb[q] >= base && rb[q] < base + 32) { SLOT[2 * (rb[q] - base)] = m.ib[q]; SLOT[2 * (rb[q] - base) + 1] = q * 128 + 64 + K.lane; } }
        asm volatile("s_waitcnt lgkmcnt(0)" ::: "memory");
        const bool two = base + 16 < n;
        i32x4 av[8][4];
#pragma unroll
        for (int t = 0; t < 4; ++t) { const int sl = 4 * t + E; const int e = (base + sl < n) ? SLOT[2 * sl] : SLOT[0]; const unsigned char* up = U + (size_t)e * D + 64 * g4 + 16 * qq;
#pragma unroll
            for (int s_ = 0; s_ < 4; ++s_) av[t][s_] = *(const i32x4*)(up + 256 * s_); }
        if (two) {
#pragma unroll
            for (int t = 4; t < 8; ++t) { const int sl = 4 * t + E; const int e = (base + sl < n) ? SLOT[2 * sl] : SLOT[0]; const unsigned char* up = U + (size_t)e * D + 64 * g4 + 16 * qq;
#pragma unroll
                for (int s_ = 0; s_ < 4; ++s_) av[t][s_] = *(const i32x4*)(up + 256 * s_); } }
        bool fin[2]; int fcode[2]; float fus[2], fvs[2];
#pragma unroll
        for (int p2 = 0; p2 < 2; ++p2) { const int sl = 4 * (4 * p2 + qq) + g4; fin[p2] = false; fcode[p2] = 0; fus[p2] = 0.f; fvs[p2] = 0.f;
            if ((r16 & 7) < 4 && base + sl < n) { const int code = SLOT[2 * sl + 1];
                if ((code >> 7) == rho) { const size_t eo = (size_t)K.l * 16384 + SLOT[2 * sl]; fin[p2] = true; fcode[p2] = code; fus[p2] = K.US()[eo]; fvs[p2] = K.VS()[eo]; } } }
        i32x4 hb[4];
#pragma unroll
        for (int s_ = 0; s_ < 4; ++s_) hb[s_] = *(const i32x4*)(HL + rho * 1024 + 64 * g4 + 16 * qq + 256 * s_);
        int w0, w1 = 0;
        { int rs[4];
#pragma unroll
          for (int t = 0; t < 4; ++t) { i32x4 acc = {0, 0, 0, 0};
#pragma unroll
              for (int s_ = 0; s_ < 4; ++s_) acc = __builtin_amdgcn_mfma_i32_16x16x64_i8(av[t][s_], hb[s_], acc, 0, 0, 0);
              int v = sel4i(acc, qq); v += dppi_<0xB1>(v); v += dppi_<0x4E>(v); rs[t] = v; }
          w0 = qq == 0 ? rs[0] : qq == 1 ? rs[1] : qq == 2 ? rs[2] : rs[3]; }
        if (two) { int rs[4];
#pragma unroll
            for (int t = 0; t < 4; ++t) { i32x4 acc = {0, 0, 0, 0};
#pragma unroll
                for (int s_ = 0; s_ < 4; ++s_) acc = __builtin_amdgcn_mfma_i32_16x16x64_i8(av[4 + t][s_], hb[s_], acc, 0, 0, 0);
                int v = sel4i(acc, qq); v += dppi_<0xB1>(v); v += dppi_<0x4E>(v); rs[t] = v; }
            w1 = qq == 0 ? rs[0] : qq == 1 ? rs[1] : qq == 2 ? rs[2] : rs[3]; }
#pragma unroll
        for (int p2 = 0; p2 < 2; ++p2) {
            const int di = p2 ? w1 : w0;
            if (fin[p2]) { const int code = fcode[p2];
                const float d = (float)di * fus[p2] * ((code >> 7) ? hs[1] : hs[0]);
                if (PROBE >= 2) dummy += gelu_erf(d);
                else (PROBE ? K.ST() : K.PA())[(size_t)(r0 + (code >> 7) * step) * 128 + (code & 127)] = gelu_erf(d) * fvs[p2]; }
        }
        asm volatile("s_waitcnt lgkmcnt(0)" ::: "memory");
    }
}
template <int PROBE> DI void ph_peer_u(Ctx& K) {
    const unsigned char* U = (const unsigned char*)K.UB() + (size_t)K.l * 16384 * D;
    unsigned char* HB = K.lds + K.wave * PUL_STRIDE; int* SLOT = (int*)(HB + PUL_SLOT);
    const int r16 = K.lane & 15, g4 = K.lane >> 4;
    const int step = K.nloc * NWAVES;
    float dummy = 0.f;
    for (int R = K.xg; R < 8; R += K.nxg) {
        int r = K.jx * NWAVES + K.wave; int par = 0;
        PuMeta cur, nxt;
        pu_load(K, r, step, cur, HB);
#pragma unroll 1
        for (; r < M; r += 2 * step) {
            asm volatile("s_waitcnt vmcnt(0)" ::: "memory");
            pu_load(K, r + 2 * step, step, nxt, HB + (par ^ 1) * 2048);
            pu_item<PROBE>(K, U, HB + par * 2048, SLOT, R, r, step, cur, r16, g4, dummy);
            cur = nxt; par ^= 1;
        }
    }
    if (PROBE >= 2) K.ST()[K.gw * 64 + K.lane] = dummy;
}
struct PvMeta { int ia, ib; float ga, gb, pa, pb; };
template <int PROBE> DI void pv_load(const Ctx& K, int r, PvMeta& m) {
    m.ia = K.PIDX()[(size_t)r * 128 + K.lane]; m.ib = K.PIDX()[(size_t)r * 128 + 64 + K.lane];
    m.ga = K.PG()[(size_t)r * 128 + K.lane]; m.pa = K.PA()[(size_t)r * 128 + K.lane]; m.gb = K.PG()[(size_t)r * 128 + 64 + K.lane]; m.pb = K.PA()[(size_t)r * 128 + 64 + K.lane];
}
template <int HALF, int PROBE> DI void pv_issue(const unsigned char* V, int slot, const PvMeta& m, u32x4 (&vv)[8], float (&ww)[8]) {
    const float w = HALF ? m.gb * m.pb : m.ga * m.pa; const int ix = HALF ? m.ib : m.ia;
#pragma unroll
    for (int i = 0; i < 8; ++i) {
        const int src = ((8 * i + slot) << 2);
        const int e = __builtin_amdgcn_ds_bpermute(src, ix);
        ww[i] = __uint_as_float((unsigned)__builtin_amdgcn_ds_bpermute(src, (int)__float_as_uint(w)));
        vv[i] = PROBE == 2 ? (u32x4){(unsigned)e, 1u, 2u, 3u} : *(const u32x4*)(V + (size_t)e * 128);
    }
}
typedef float f32x2_ __attribute__((ext_vector_type(2)));
DI void pv_accum(const u32x4 (&vv)[8], const float (&ww)[8], f32x2_ (&y)[8], float& sw) {
#pragma unroll
    for (int i = 0; i < 8; ++i) { sw += ww[i]; const unsigned w4[4] = {vv[i].x, vv[i].y, vv[i].z, vv[i].w}; const f32x2_ w2 = {ww[i], ww[i]};
#pragma unroll
        for (int q = 0; q < 4; ++q) { const f32x2_ lo = {(float)(w4[q] & 0xffu), (float)((w4[q] >> 8) & 0xffu)}, hi = {(float)((w4[q] >> 16) & 0xffu), (float)(w4[q] >> 24)};
            y[2 * q] = __builtin_elementwise_fma(w2, lo, y[2 * q]); y[2 * q + 1] = __builtin_elementwise_fma(w2, hi, y[2 * q + 1]); } }
}
template <int PROBE> DI void ph_peer_v(Ctx& K) {
    const int slot = K.lane >> 3, c = K.lane & 7;
    const float* gate = K.MOD() + (size_t)K.l * 3 * 6 * D + 5 * D;
    const int step = K.nloc * NWAVES;
    float* Xb = PROBE ? (float*)K.P() : K.X();
    for (int S = K.xg; S < 8; S += K.nxg) {
        const unsigned char* V = (const unsigned char*)K.VB() + ((size_t)K.l * 8 + S) * 16384 * 128 + c * 16;
        const int c0 = S * 128 + c * 16;
        const int r0 = K.jx * NWAVES + K.wave;
        const int nit = r0 < M ? (M - 1 - r0) / step + 1 : 0;
        PvMeta mA, mB; pv_load<PROBE>(K, min(r0, M - 1), mA); pv_load<PROBE>(K, min(r0 + step, M - 1), mB);
        f32x4 xq[4], xprev[4], x2[4], gp[4]; float yp[16]; int rp = -1, mvp = -1; PvMeta m2;
#pragma unroll
        for (int q = 0; q < 4; ++q) { xq[q] = *(const f32x4*)(Xb + (size_t)min(r0, M - 1) * D + c0 + 4 * q); xprev[q] = (f32x4){0.f, 0.f, 0.f, 0.f}; gp[q] = xprev[q]; }
#pragma unroll
        for (int q = 0; q < 16; ++q) yp[q] = 0.f;
#define PV_BODY(XPREV, XQ, XNEW, MA, MC, IT) do { \
            const int r = r0 + (IT) * step; \
            if (rp >= 0) { const int mv = modvec_of_row(rp); \
                if (mv != mvp) { mvp = mv; \
                    _Pragma("unroll") for (int q = 0; q < 4; ++q) gp[q] = *(const f32x4*)(gate + (size_t)mv * 6 * D + c0 + 4 * q); } } \
            { const float zdep = MA.ga * 0.0f; \
                _Pragma("unroll") for (int q = 0; q < 4; ++q) { XPREV[q].x += gp[q].x * yp[4 * q] + zdep; XPREV[q].y += gp[q].y * yp[4 * q + 1] + zdep; XPREV[q].z += gp[q].z * yp[4 * q + 2] + zdep; XPREV[q].w += gp[q].w * yp[4 * q + 3] + zdep; } \
                if (rp >= 0 && slot == 0) { float* xr = Xb + (size_t)rp * D + c0; \
                    _Pragma("unroll") for (int q = 0; q < 4; ++q) *(f32x4*)(xr + 4 * q) = XPREV[q]; } } \
            __builtin_amdgcn_sched_barrier(0); \
            u32x4 vA[8], vB[8]; float wA[8], wB[8]; \
            pv_issue<0, PROBE>(V, slot, MA, vA, wA); \
            pv_issue<1, PROBE>(V, slot, MA, vB, wB); \
            __builtin_amdgcn_sched_barrier(0); \
            { const float* xr = Xb + (size_t)min(r + step, M - 1) * D + c0; \
              _Pragma("unroll") for (int q = 0; q < 4; ++q) XNEW[q] = *(const f32x4*)(xr + 4 * q); } \
            pv_load<PROBE>(K, min(r + 2 * step, M - 1), MC); \
            __builtin_amdgcn_sched_barrier(0); \
            f32x2_ y2[8]; float sw = 0.f; \
            _Pragma("unroll") for (int i = 0; i < 8; ++i) y2[i] = (f32x2_){0.f, 0.f}; \
            pv_accum(vA, wA, y2, sw); \
            pv_accum(vB, wB, y2, sw); \
            _Pragma("unroll") for (int q = 0; q < 8; ++q) { yp[2 * q] = y2[q].x - 128.f * sw; yp[2 * q + 1] = y2[q].y - 128.f * sw; } \
            _Pragma("unroll") for (int q = 0; q < 16; ++q) { float v = yp[q]; v += dpp_<0x128>(v); \
                auto s1 = __builtin_amdgcn_permlane16_swap(__float_as_uint(v), __float_as_uint(v), false, false); v = __uint_as_float(s1[0]) + __uint_as_float(s1[1]); \
                auto s2 = __builtin_amdgcn_permlane32_swap(__float_as_uint(v), __float_as_uint(v), false, false); yp[q] = __uint_as_float(s2[0]) + __uint_as_float(s2[1]); } \
            rp = r; } while (0)
        f32x4 (*xfin)[4] = nullptr; (void)xfin;
        int it = 0;
#pragma unroll 1
        for (; it + 2 < nit; it += 3) {
            PV_BODY(xprev, xq, x2, mA, m2, it);
            PV_BODY(xq, x2, xprev, mB, mA, it + 1);
            PV_BODY(x2, xprev, xq, m2, mB, it + 2);
        }
        if (it < nit) { PV_BODY(xprev, xq, x2, mA, m2, it); ++it;
            if (it < nit) { PV_BODY(xq, x2, xprev, mB, mA, it); ++it;
#pragma unroll
                for (int q = 0; q < 4; ++q) xprev[q] = x2[q]; }
            else {
#pragma unroll
                for (int q = 0; q < 4; ++q) xprev[q] = xq[q]; } }
#undef PV_BODY
        if (rp >= 0) { const int mv = modvec_of_row(rp);
#pragma unroll
            for (int q = 0; q < 4; ++q) gp[q] = *(const f32x4*)(gate + (size_t)mv * 6 * D + c0 + 4 * q);
            if (slot == 0) { float* xr = Xb + (size_t)rp * D + c0;
#pragma unroll
                for (int q = 0; q < 4; ++q) { f32x4 x = xprev[q];
                    x.x += gp[q].x * yp[4 * q]; x.y += gp[q].y * yp[4 * q + 1]; x.z += gp[q].z * yp[4 * q + 2]; x.w += gp[q].w * yp[4 * q + 3]; *(f32x4*)(xr + 4 * q) = x; } } }
    }
}

DI void ph_final(Ctx& K) {
    for (int r = K.gw; r < NLAT; r += K.ngw) {
        const f32x4* xr = (const f32x4*)(K.X() + (size_t)(NCTX + r) * D); f32x4* o = (f32x4*)(((float*)argp_<float>(K, (unsigned)__builtin_offsetof(Args, out))) + (size_t)r * D);
        f32x4 v[4]; float ss = 0.f;
#pragma unroll
        for (int j = 0; j < 4; ++j) { v[j] = xr[j * 64 + K.lane]; ss += v[j].x * v[j].x + v[j].y * v[j].y + v[j].z * v[j].z + v[j].w * v[j].w; }
        ss = wave_sum(ss); const float rs = rsqrtf(ss * (1.0f / D) + EPS);
#pragma unroll
        for (int j = 0; j < 4; ++j) { const f32x4 w = ((const f32x4*)ARG(final_norm_w))[j * 64 + K.lane]; o[j * 64 + K.lane] = v[j] * rs * w; }
    }
}

#define XB_TMO      128
#define XB_XSUB(j)  (1280 + 64 * (j))
#define XB_XGEN(j)  (2304 + 64 * (j))
#define XB_TOP      3328
#define XB_TOPGEN   3392
#define XB_SPIN_CAP (1u << 22)
constexpr int CW_BAR = 4096;
DI unsigned xb_ld(unsigned* p)              { return __hip_atomic_load(p, __ATOMIC_RELAXED, __HIP_MEMORY_SCOPE_AGENT); }
DI unsigned xb_add(unsigned* p, unsigned v) { return __hip_atomic_fetch_add(p, v, __ATOMIC_RELAXED, __HIP_MEMORY_SCOPE_AGENT); }
#define XB_SPIN(cond, bar) do { unsigned _sp = 0; while (cond) { __builtin_amdgcn_s_sleep(1); \
    if ((++_sp & 255u) == 0u) { if (xb_ld(&(bar)[XB_TMO])) break; if (_sp > XB_SPIN_CAP) { atomicAdd(&(bar)[XB_TMO], 1u); break; } } } } while (0)
DI void xcd_barrier(unsigned* bar, unsigned x, unsigned nloc, unsigned nx, int tid) {
    asm volatile("s_waitcnt vmcnt(0)" ::: "memory");
    __syncthreads();
    if (tid == 0) {
        __builtin_amdgcn_s_waitcnt(0);
        const unsigned old = xb_add(&bar[XB_XSUB(x)], 1u);
        const unsigned gen = old / nloc;
        if (old + 1u == (gen + 1u) * nloc) {
            __builtin_amdgcn_fence(__ATOMIC_RELEASE, "agent");
            asm volatile("s_waitcnt vmcnt(0)" ::: "memory");
            const unsigned og = xb_add(&bar[XB_TOP], 1u);
            const unsigned tg = og / nx;
            if (og + 1u == (tg + 1u) * nx) xb_add(&bar[XB_TOPGEN], 1u);
            else XB_SPIN(xb_ld(&bar[XB_TOPGEN]) == tg, bar);
            __builtin_amdgcn_fence(__ATOMIC_ACQUIRE, "agent");
            xb_add(&bar[XB_XGEN(x)], 1u);
            asm volatile("s_waitcnt vmcnt(0)" ::: "memory");
        } else {
            XB_SPIN(xb_ld(&bar[XB_XGEN(x)]) == gen, bar);
            __builtin_amdgcn_fence(__ATOMIC_ACQUIRE, "agent");
            asm volatile("s_waitcnt vmcnt(0)" ::: "memory");
        }
    }
    __syncthreads();
}

constexpr int PROBE_U = 0, PROBE_V = 0, PROBE_S = 0;
constexpr unsigned DUP_MASK = 0u;
constexpr int PH_PER_LAYER = 12, N_PHASES = 2 + PH_PER_LAYER * DEPTH;
__global__ void __launch_bounds__(NTHREADS) mk_fwd(Args args) {
    extern __shared__ __attribute__((aligned(16))) unsigned char lds[];
    cg::grid_group grid = cg::this_grid();
    constexpr unsigned ARGS_OFF = LDS_BYTES - 256;
    constexpr unsigned MISC_OFF = LDS_BYTES - 64;
    if (threadIdx.x == 0) {
        *(Args*)(lds + ARGS_OFF) = args;
        unsigned* ctl = (unsigned*)(args.ws + WS_CTL); unsigned* misc = (unsigned*)(lds + MISC_OFF);
        const unsigned xcc = (unsigned)__builtin_amdgcn_s_getreg((3 << 11) | 20) & 0xFu;
        misc[0] = xcc; misc[1] = __hip_atomic_fetch_add(ctl + 64 * xcc, 1u, __ATOMIC_RELAXED, __HIP_MEMORY_SCOPE_AGENT);
    }
    __syncthreads();
    const int wid_s = __builtin_amdgcn_readfirstlane((int)threadIdx.x >> 6);
    int rep = 0;
#pragma unroll 1
    for (int ph = 0; ph < N_PHASES; ++ph) {
        unsigned ones = ~0u; asm volatile("" : "+s"(ones));
        int tid = (wid_s << 6) | (int)__builtin_amdgcn_mbcnt_hi(ones, __builtin_amdgcn_mbcnt_lo(ones, 0u)); asm volatile("" : "+v"(tid));
        unsigned aoff = ARGS_OFF; asm volatile("" : "+v"(aoff));
        size_t zoff = 0; asm volatile("" : "+s"(zoff));
        unsigned char* ws = args.ws + zoff;
        int bid = blockIdx.x; asm volatile("" : "+s"(bid)); int nb = gridDim.x; asm volatile("" : "+s"(nb));
        unsigned moff = MISC_OFF; asm volatile("" : "+v"(moff));
        Ctx K; unsigned xcc_s; { const unsigned* misc = (const unsigned*)(lds + moff); xcc_s = __builtin_amdgcn_readfirstlane(misc[0]); K.jx = __builtin_amdgcn_readfirstlane(misc[1]); K.xg = __builtin_amdgcn_readfirstlane(misc[2]); K.nxg = __builtin_amdgcn_readfirstlane(misc[3]); K.nloc = __builtin_amdgcn_readfirstlane(misc[4]); }
        K.aoff = aoff; K.lds = lds; K.tid = tid; K.lane = tid & 63; K.wave = tid >> 6; K.bid = bid; K.nb = nb; K.gw = bid * NWAVES + K.wave; K.ngw = nb * NWAVES;
        K.ws = ws;
        const int l = ph == 0 ? 0 : (ph - 1) / PH_PER_LAYER, k = ph == 0 ? -1 : (ph == N_PHASES - 1 ? -2 : (ph - 1) % PH_PER_LAYER);
        K.l = l;
        if (k == -1) ph_prologue(K);
        else if (k == -2) ph_final(K);
        else if (k == 0) ph_norm(K, ARG(norm_mix_w) + (size_t)l * D, 0);
        else if (k == 1) ph_gemm_store(K, K.H(), K.WIN() + (size_t)l * PW * D, PW, K.P(), K.ROPE());
        else if (k == 2) ph_hgrn_A(K);
        else if (k == 3) ph_attn(K);
        else if (k == 4) ph_hgrn_B(K);
        else if (k == 5) ph_hgrn_C(K);
        else if (k == 6) ph_gemm_resid(K, K.MIX(), K.WOUT() + (size_t)l * D * D, 2);
        else if (k == 7) ph_norm(K, ARG(norm_ffn_w) + (size_t)l * D, 3);
        else if (k == 8) ph_gemm_store(K, K.H(), K.WQ() + (size_t)l * 2048 * D, 2048, K.QP(), nullptr);
        else if (k == 9) { ph_peer_select<0>(K); if (PROBE_S) ph_peer_select<PROBE_S>(K); }
        else if (k == 10) { ph_peer_u<0>(K); if (PROBE_U) ph_peer_u<PROBE_U>(K); }
        else if (k == 11) { ph_peer_v<0>(K); if (PROBE_V) ph_peer_v<PROBE_V>(K); }
        if (k >= 0 && ((DUP_MASK >> k) & 1u)) { ++rep; if (rep < 2) { --ph; continue; } } rep = 0;
        if (ph == 0) grid.sync();
        else if (k != 2 && ph != N_PHASES - 1) xcd_barrier((unsigned*)(args.ws + WS_CTL) + CW_BAR, xcc_s, (unsigned)K.nloc, (unsigned)K.nxg, tid);
        if (ph == 0) {
            if (tid == 0) { unsigned* ctl = (unsigned*)(args.ws + WS_CTL); unsigned* misc = (unsigned*)(lds + MISC_OFF); const unsigned xcc = misc[0]; unsigned ord = 0, npop = 0, mine = 1;
                for (unsigned q = 0; q < 16; ++q) { const unsigned cq = __hip_atomic_load(ctl + 64 * q, __ATOMIC_RELAXED, __HIP_MEMORY_SCOPE_AGENT); if (cq) { ++npop; if (q < xcc) ++ord; } if (q == xcc) mine = cq; }
                misc[2] = ord; misc[3] = npop ? npop : 1u; misc[4] = mine ? mine : 1u; }
            __syncthreads();
        }
    }
}

extern "C" void kernel_launch(void* const* d_in, const int* in_sizes, int n_in, void* d_out, int out_size, void* d_ws, size_t ws_size, hipStream_t stream) {
    static int grid = 0;
    if (grid == 0) {
        if (n_in != 19 || out_size != NLAT * D || ws_size < WS_END) { fprintf(stderr, "kernel_launch: unexpected shapes (n_in %d out %d ws %zu need %zu)\n", n_in, out_size, ws_size, (size_t)WS_END); grid = -1; return; }
        int dev = 0, cus = 0, per_cu = 0;
        (void)hipGetDevice(&dev); (void)hipDeviceGetAttribute(&cus, hipDeviceAttributeMultiprocessorCount, dev);
        (void)hipFuncSetAttribute((const void*)mk_fwd, hipFuncAttributeMaxDynamicSharedMemorySize, LDS_BYTES);
        (void)hipOccupancyMaxActiveBlocksPerMultiprocessor(&per_cu, (const void*)mk_fwd, NTHREADS, LDS_BYTES);
        if (per_cu < 1) { fprintf(stderr, "kernel_launch: occupancy query says %d blocks/CU\n", per_cu); grid = -1; return; }
        grid = (cus / 8) * 8;
    }
    if (grid < 0) return;
    Args a{};
    a.x = (const float*)d_in[0]; a.c = (const float*)d_in[1]; a.ctx = (const float*)d_in[2]; a.c_ctx = (const float*)d_in[3]; a.w_mod = (const float*)d_in[4]; a.b_mod = (const float*)d_in[5];
    a.norm_mix_w = (const float*)d_in[6]; a.norm_ffn_w = (const float*)d_in[7]; a.w_in = (const float*)d_in[8]; a.lb_logits = (const float*)d_in[9]; a.hgrn_norm_w = (const float*)d_in[10];
    a.swa_sink = (const float*)d_in[11]; a.nat_rpb = (const float*)d_in[12]; a.w_out = (const float*)d_in[13]; a.peer_wq = (const float*)d_in[14]; a.peer_sk = (const float*)d_in[15];
    a.peer_u = (const float*)d_in[16]; a.peer_v = (const float*)d_in[17]; a.final_norm_w = (const float*)d_in[18];
    a.out = (float*)d_out; a.ws = (unsigned char*)d_ws;
    (void)hipMemsetAsync((unsigned char*)d_ws + WS_CTL, 0, CTL_BYTES, stream);
    void* kargs[] = {&a};
    hipError_t e = hipLaunchCooperativeKernel((const void*)mk_fwd, dim3(grid), dim3(NTHREADS), kargs, LDS_BYTES, stream);
    if (e != hipSuccess) fprintf(stderr, "kernel_launch: cooperative launch failed: %s (grid %d)\n", hipGetErrorString(e), grid);
}
```

```cpp
#include <hip/hip_runtime.h>
#include <hip/hip_cooperative_groups.h>
#include <cstdio>
#include <cstdint>
namespace cg = cooperative_groups;
#define DI __device__ __forceinline__
#define GP(T, p) ((T*)(__attribute__((address_space(1))) T*)(p))

typedef unsigned short bf16_t;
typedef float f32x4 __attribute__((ext_vector_type(4)));
typedef unsigned u32x4 __attribute__((ext_vector_type(4)));
typedef unsigned u32x2 __attribute__((ext_vector_type(2)));

constexpr int D = 1024, NB = 2, L = 16384, CL = 256, DEPTH = 4;
constexpr int NCTX = NB * CL, NLAT = NB * L, M = NCTX + NLAT;
constexpr int PW = 3072;
constexpr int C_HQ = 0, C_ZF = 256, C_ZB = 512, C_HV = 768, C_HG = 1024, C_SQ = 1280, C_SK = 1664, C_SV = 1792, C_NQ = 1920, C_NK = 2304, C_NV = 2688;
constexpr int MX_H = 0, MX_S = 256, MX_N = 640;
constexpr float EPS = 1e-6f;
constexpr int NTHREADS = 512, NWAVES = 8;
constexpr int LDS_BYTES = 163840;

constexpr size_t al256(size_t x) { return (x + 255) & ~(size_t)255; }
constexpr size_t WS_X = 0;
constexpr size_t WS_H = WS_X + al256((size_t)M * D * 4);
constexpr size_t WS_P = WS_H + al256((size_t)M * D * 2);
constexpr size_t WS_MIX = WS_P + al256((size_t)M * PW * 2);
constexpr size_t WS_OF = WS_MIX + al256((size_t)M * D * 2);
constexpr size_t WS_OB = WS_OF + al256((size_t)M * 256 * 4);
constexpr size_t WS_PIDX = WS_OB + al256((size_t)M * 256 * 4);
constexpr size_t WS_PG = WS_PIDX + al256((size_t)M * 128 * 4);
constexpr size_t WS_MOD = WS_PG + al256((size_t)M * 128 * 4);
constexpr size_t WS_LB = WS_MOD + al256((size_t)DEPTH * 3 * 6 * D * 4);
constexpr size_t WS_ROPE = WS_LB + al256((size_t)2 * DEPTH * 256 * 4);
constexpr size_t WS_WIN = WS_ROPE + al256((size_t)(256 + 256 + 64 + 64) * 16 * 4);
constexpr size_t WS_WOUT = WS_WIN + al256((size_t)DEPTH * PW * D * 2);
constexpr size_t WS_WQ = WS_WOUT + al256((size_t)DEPTH * D * D * 2);
constexpr size_t WS_AC = WS_WQ + al256((size_t)DEPTH * 2048 * D * 2);
constexpr size_t WS_UB_ = 0; constexpr size_t WS_UB = WS_AC + al256((size_t)16 * 260 * 64 * 4); constexpr size_t WS_UB_OLD = WS_WQ + al256((size_t)DEPTH * 2048 * D * 2);
constexpr size_t WS_VB = WS_UB + al256((size_t)DEPTH * 16384 * D * 2);
constexpr size_t WS_PA = WS_VB + al256((size_t)DEPTH * 16384 * D * 2);
constexpr size_t WS_VS = WS_PA + al256((size_t)M * 128 * 4);
constexpr size_t WS_US = WS_VS + al256((size_t)DEPTH * 16384 * 4);
constexpr size_t WS_H8 = WS_US + al256((size_t)DEPTH * 16384 * 4);
constexpr size_t WS_HS = WS_H8 + al256((size_t)M * D);
constexpr size_t WS_SKH = WS_HS + al256((size_t)M * 4);
constexpr size_t WS_SKL = WS_SKH + al256((size_t)DEPTH * 8 * 2 * 128 * 128 * 2);
constexpr size_t WS_CTL = WS_SKL + al256((size_t)DEPTH * 8 * 2 * 128 * 128 * 2);
constexpr size_t CTL_BYTES = 65536;
constexpr size_t WS_END = WS_CTL + CTL_BYTES;

struct Args {
    const float *x, *c, *ctx, *c_ctx, *w_mod, *b_mod, *norm_mix_w, *norm_ffn_w, *w_in, *lb_logits, *hgrn_norm_w, *swa_sink, *nat_rpb, *w_out, *peer_wq, *peer_sk, *peer_u, *peer_v, *final_norm_w;
    float* out; unsigned char* ws;
};

DI float bf2f(bf16_t v) { return __uint_as_float((unsigned)v << 16); }
DI bf16_t f2bf(float f) { unsigned u = __float_as_uint(f); return (bf16_t)((u + 0x7fffu + ((u >> 16) & 1u)) >> 16); }
DI unsigned pk2(float lo, float hi) { return (unsigned)f2bf(lo) | ((unsigned)f2bf(hi) << 16); }
DI float wave_sum(float v) {
#pragma unroll
    for (int o = 1; o < 64; o <<= 1) v += __shfl_xor(v, o);
    return v;
}
typedef __bf16 bf16x2_t __attribute__((ext_vector_type(2)));
DI float dot2bf(unsigned a, unsigned b, float acc) { return __builtin_amdgcn_fdot2_f32_bf16(__builtin_bit_cast(bf16x2_t, a), __builtin_bit_cast(bf16x2_t, b), acc, false); }
template <int CTRL> DI float dpp_(float x) { return __builtin_bit_cast(float, __builtin_amdgcn_mov_dpp(__builtin_bit_cast(int, x), CTRL, 0xf, 0xf, true)); }
DI float wave_sum_fast(float x) {
    x += dpp_<0xB1>(x); x += dpp_<0x4E>(x); x += dpp_<0x141>(x); x += dpp_<0x128>(x);
    auto s1 = __builtin_amdgcn_permlane16_swap(__float_as_uint(x), __float_as_uint(x), false, false); x = __uint_as_float(s1[0]) + __uint_as_float(s1[1]);
    auto s2 = __builtin_amdgcn_permlane32_swap(__float_as_uint(x), __float_as_uint(x), false, false); return __uint_as_float(s2[0]) + __uint_as_float(s2[1]);
}
DI float sigmoidf_(float z) { return 1.0f / (1.0f + __expf(-z)); }
DI float gelu_erf(float v) { return 0.5f * v * (1.0f + erff(v * 0.70710678118654752f)); }
DI int modvec_of_row(int r) { return r < NCTX ? 2 : (r - NCTX) / L; }
DI int batch_of_row(int r) { return r < NCTX ? r / CL : (r - NCTX) / L; }
DI int lat_row(int b, int t) { return NCTX + b * L + t; }
DI int ctx_row(int b, int s) { return b * CL + s; }
DI void unpack8(const u32x4 w, float* o) {
    o[0] = __uint_as_float(w.x << 16); o[1] = __uint_as_float(w.x & 0xffff0000u);
    o[2] = __uint_as_float(w.y << 16); o[3] = __uint_as_float(w.y & 0xffff0000u);
    o[4] = __uint_as_float(w.z << 16); o[5] = __uint_as_float(w.z & 0xffff0000u);
    o[6] = __uint_as_float(w.w << 16); o[7] = __uint_as_float(w.w & 0xffff0000u);
}
DI void load_row64(const bf16_t* p, float (&o)[64]) {
#pragma unroll
    for (int i = 0; i < 8; ++i) { const u32x4 w = *(const u32x4*)(p + 8 * i); unpack8(w, &o[8 * i]); }
}
DI void rope64(float (&x)[64], const float* cr, const float* sr, const float* cc, const float* sc) {
#pragma unroll
    for (int i = 0; i < 16; ++i) {
        const float c1 = cr[i], s1 = sr[i], a = x[i], b = x[16 + i];
        x[i] = a * c1 - b * s1; x[16 + i] = b * c1 + a * s1;
        const float c2 = cc[i], s2 = sc[i], e = x[32 + i], f = x[48 + i];
        x[32 + i] = e * c2 - f * s2; x[48 + i] = f * c2 + e * s2;
    }
}

namespace pg8 {
#define PG8_LAS __attribute__((address_space(3)))
typedef unsigned short bf16_t;
typedef short bf16x8 __attribute__((ext_vector_type(8)));
typedef float f32x4 __attribute__((ext_vector_type(4)));
typedef unsigned u32x4 __attribute__((ext_vector_type(4)));
constexpr int BM = 256, BK = 64, HALF = 128, HTB = HALF * BK * 2  , STAGE_BYTES = 8 * HTB, NXCD = 8, WGM = 8;

__host__ __device__ __forceinline__ int lds_byte(int r, int c) { const int st = (r >> 4) * 2 + (c >> 5), rr = r & 15, cc = c & 31, ob = rr * 64 + cc * 2; return st * 1024 + (ob ^ (((ob >> 9) & 1) << 5)); }
__host__ __device__ __forceinline__ void stage_rc(int b, int& R, int& C) { const int st = b / 1024, sb = b % 1024, swz = sb ^ (((sb >> 9) & 1) << 5); R = (st >> 1) * 16 + swz / 64; C = (st & 1) * 32 + (swz % 64) / 2; }
__host__ __device__ __forceinline__ int perm32(int rho) { const int n = rho >> 4, i = rho & 15; return 8 * (i >> 2) + 4 * n + (i & 3); }

struct Unit { int pm, pn; };
struct Gemm { const bf16_t* A; const bf16_t* Bt; int M, N, K; };

struct StaticOrder {
    int nM, nN, nwg, G, c;
    __host__ __device__ void init(int M, int N, int G_, int c_) { nM = M / BM; nN = N / BM; nwg = nM * nN; G = G_; c = c_; }
    __host__ __device__ bool next(int i, Unit& u) const {
        const long L = (long)i * G + c; if (L >= nwg) return false;
        int wgid = (int)L; { const int q = nwg / NXCD, r = nwg % NXCD, xcd = wgid % NXCD, off = wgid / NXCD; wgid = (xcd < r ? xcd * (q + 1) : r * (q + 1) + (xcd - r) * q) + off; }
        const int nig = WGM * nN, gid = wgid / nig, fm = gid * WGM, gsz = (nM - fm) < WGM ? (nM - fm) : WGM;
        u.pm = fm + ((wgid % nig) % gsz); u.pn = (wgid % nig) / gsz; return true;
    }
    __device__ __forceinline__ void a_ready(const Unit&) const {}
    __device__ __forceinline__ void done(const Unit&) const {}
};


__device__ __forceinline__ unsigned cvt_pk_bf16(float lo, float hi) { unsigned r; asm volatile("v_cvt_pk_bf16_f32 %0, %1, %2" : "=v"(r) : "v"(lo), "v"(hi)); return r; }
constexpr int EPI_LDS_OFF = STAGE_BYTES, EPI_LDS_WAVE = 2560;
struct EpiStore {
    static constexpr bool PERM = true, AFTER_DRAIN = false;
    bf16_t* O; int ldc; PG8_LAS unsigned char* lds; const float* rope; int nctx, seqlen, rowbase;
    __device__ __forceinline__ void operator()(const f32x4 (&acc)[2][2][4][2], const Unit& u, int wr, int wc, int fr, int fq) const {
        PG8_LAS unsigned char* T = lds + EPI_LDS_OFF + (wr * 4 + wc) * EPI_LDS_WAVE;
        const int lane = fr + 16 * fq, rr = lane >> 2, cc = lane & 3;
        const int row0 = rowbase + u.pm * BM + wr * 64, col0 = u.pn * BM + wc * 32;
        const bool dorope = rope != nullptr && (u.pn == 5 || u.pn == 6) && rowbase + u.pm * BM >= nctx;
#pragma unroll
        for (int ai = 0; ai < 2; ++ai)
#pragma unroll
            for (int m = 0; m < 4; ++m)
#pragma unroll
                for (int bj = 0; bj < 2; ++bj) { const f32x4 v0 = acc[ai][bj][m][0], v1 = acc[ai][bj][m][1];
                    u32x4 w; w.x = cvt_pk_bf16(v0[0], v0[1]); w.y = cvt_pk_bf16(v0[2], v0[3]); w.z = cvt_pk_bf16(v1[0], v1[1]); w.w = cvt_pk_bf16(v1[2], v1[3]);
                    *(PG8_LAS u32x4*)(T + fr * 80 + 16 * fq) = w;
                    asm volatile("s_waitcnt lgkmcnt(0)" ::: "memory");
                    u32x4 o = *(const PG8_LAS u32x4*)(T + rr * 80 + 16 * cc);
                    asm volatile("s_waitcnt lgkmcnt(0)" ::: "memory");
                    const int grow = row0 + ai * HALF + m * 16 + rr;
                    if (dorope) {
                        const int t = (grow - nctx) % seqlen; const bool second = (wc & 1) != 0;
                        const float* ct = rope + (second ? 8192 + (t & 63) * 16 : (t >> 6) * 16) + 8 * (cc & 1); const float* st = ct + (second ? 1024 : 4096);
                        const f32x4 c0 = *(const f32x4*)ct, c1 = *(const f32x4*)(ct + 4), s0 = *(const f32x4*)st, s1 = *(const f32x4*)(st + 4);
                        const float cs[8] = {c0[0], c0[1], c0[2], c0[3], c1[0], c1[1], c1[2], c1[3]}, sn[8] = {s0[0], s0[1], s0[2], s0[3], s1[0], s1[1], s1[2], s1[3]};
                        const unsigned ow[4] = {o.x, o.y, o.z, o.w}; unsigned rw[4];
                        const float sg = cc >= 2 ? 1.0f : -1.0f;
#pragma unroll
                        for (int q = 0; q < 4; ++q) { const unsigned pw = (unsigned)__builtin_amdgcn_mov_dpp((int)ow[q], 0x4E, 0xf, 0xf, true);
                            const float x0 = __uint_as_float(ow[q] << 16), x1 = __uint_as_float(ow[q] & 0xffff0000u), p0 = __uint_as_float(pw << 16), p1 = __uint_as_float(pw & 0xffff0000u);
                            rw[q] = cvt_pk_bf16(x0 * cs[2 * q] + sg * p0 * sn[2 * q], x1 * cs[2 * q + 1] + sg * p1 * sn[2 * q + 1]); }
                        o = (u32x4){rw[0], rw[1], rw[2], rw[3]}; }
                    *(u32x4*)(O + (size_t)grow * ldc + col0 + bj * HALF + 8 * cc) = o; }
    }
};
struct EpiResid {
    static constexpr bool PERM = false, AFTER_DRAIN = false;
    float* X; int ldc; const float* gate; int gstride, nctx, seqlen; PG8_LAS unsigned char* lds; int rowbase; const float* Xin;
    __device__ __forceinline__ void operator()(const f32x4 (&acc)[2][2][4][2], const Unit& u, int wr, int wc, int fr, int fq) const {
        PG8_LAS float* T = (PG8_LAS float*)(lds + EPI_LDS_OFF + (wr * 4 + wc) * EPI_LDS_WAVE);
        const int lane = fr + 16 * fq, rr = lane >> 3, cc = lane & 7;
        const int r0 = rowbase + u.pm * BM; const int vsel = r0 < nctx ? 2 : (r0 - nctx) / seqlen;
        const int row0 = r0 + wr * 64, col0 = u.pn * BM + wc * 32 + 4 * cc;
#pragma unroll
        for (int bj = 0; bj < 2; ++bj) { const f32x4 g = *(const f32x4*)(gate + (size_t)vsel * gstride + col0 + bj * HALF);
#pragma unroll
            for (int ai = 0; ai < 2; ++ai)
#pragma unroll
                for (int m = 0; m < 4; ++m) {
#pragma unroll
                    for (int n = 0; n < 2; ++n) *(PG8_LAS f32x4*)(T + fr * 36 + 16 * n + 4 * fq) = acc[ai][bj][m][n];
                    asm volatile("s_waitcnt lgkmcnt(0)" ::: "memory");
                    const f32x4 t0 = *(const PG8_LAS f32x4*)(T + rr * 36 + 4 * cc), t1 = *(const PG8_LAS f32x4*)(T + (rr + 8) * 36 + 4 * cc);
                    asm volatile("s_waitcnt lgkmcnt(0)" ::: "memory");
                    float* x0 = X + (size_t)(row0 + ai * HALF + m * 16 + rr) * ldc + col0 + bj * HALF; float* x1 = x0 + (size_t)8 * ldc;
                    const float* i0 = Xin + (size_t)(row0 - rowbase + ai * HALF + m * 16 + rr) * ldc + col0 + bj * HALF; const float* i1 = i0 + (size_t)8 * ldc;
                    f32x4 a = *(const f32x4*)i0, b = *(const f32x4*)i1; a += g * t0; b += g * t1; *(f32x4*)x0 = a; *(f32x4*)x1 = b; } }
    }
};

template <class Epi, class Sched, bool ALIGN_EPI = false, bool SP2 = false>
__device__ __forceinline__ void gemm_phase(PG8_LAS unsigned char* lds, const Gemm g, const Sched& S, const Epi& E, int tid_in) {
    int tid_ = tid_in; asm volatile("" : "+v"(tid_));
    const int tid = tid_, wid = __builtin_amdgcn_readfirstlane(tid >> 6), lane = tid & 63, wr = wid >> 2, wc = wid & 3, fr = lane & 15, fq = lane >> 4;
    const int K = g.K, nt = K / BK;
    unsigned voffA[2], voffB[2];
#pragma unroll
    for (int i = 0; i < 2; ++i) { int R, C; stage_rc(tid * 16 + i * 8192, R, C); const int Rb = Epi::PERM ? ((R & ~31) + perm32(R & 31)) : R;
        voffA[i] = (unsigned)(R * K + C) * 2u; voffB[i] = (unsigned)(Rb * K + C) * 2u; }
    const size_t kstep = (size_t)(BK * 2);
    const size_t hstep = (size_t)HALF * K * 2;
    const size_t tstep = 2 * hstep;
    const unsigned ldsw = (unsigned)wid * 1024u;
    const int aoff = lds_byte(wr * 64 + fr, fq * 8), boff = lds_byte(wc * 32 + fr, fq * 8);
#define PG8_SA(b, h) (((b) * 2 + (h)) * HTB)
#define PG8_SB(b, h) ((4 + (b) * 2 + (h)) * HTB)
#define PG8_STAGE(bufoff, gbase, voff) do { _Pragma("unroll") for (int _i = 0; _i < 2; ++_i) \
        __builtin_amdgcn_global_load_lds((const unsigned*)((const char*)(gbase) + (voff)[_i]), (PG8_LAS unsigned*)(lds + (bufoff) + ldsw + _i * 8192), 16, 0, 0); } while (0)
#define PG8_LDA(dst, b, h) do { _Pragma("unroll") for (int m = 0; m < 4; ++m) _Pragma("unroll") for (int k = 0; k < 2; ++k) dst[m][k] = *(const PG8_LAS bf16x8*)(lds + PG8_SA(b, h) + aoff + m * 2048 + k * 1024); } while (0)
#define PG8_LDB(dst, b, h) do { _Pragma("unroll") for (int n = 0; n < 2; ++n) _Pragma("unroll") for (int k = 0; k < 2; ++k) dst[n][k] = *(const PG8_LAS bf16x8*)(lds + PG8_SB(b, h) + boff + n * 2048 + k * 1024); } while (0)
#define PG8_MMA(ai, bj, At, Bt) do { __builtin_amdgcn_s_setprio(1); _Pragma("unroll") for (int m = 0; m < 4; ++m) _Pragma("unroll") for (int n = 0; n < 2; ++n) _Pragma("unroll") for (int k = 0; k < 2; ++k) \
        acc[ai][bj][m][n] = __builtin_amdgcn_mfma_f32_16x16x32_bf16(Bt[n][k], At[m][k], acc[ai][bj][m][n], 0, 0, 0); __builtin_amdgcn_s_setprio(0); } while (0)
#define PG8_WAIT_V(n) asm volatile("s_waitcnt vmcnt(" #n ")" ::: "memory")
#define PG8_WAIT_L(n) asm volatile("s_waitcnt lgkmcnt(" #n ")" ::: "memory")
#define PG8_BAR __builtin_amdgcn_s_barrier()
#define PG8_SCHED __builtin_amdgcn_sched_barrier(0)
    Unit cur, nxt; int ui = 0;
    if (!S.next(0, cur)) return;
    f32x4 acc[2][2][4][2];
#pragma unroll
    for (int a = 0; a < 2; ++a)
#pragma unroll
        for (int b = 0; b < 2; ++b)
#pragma unroll
            for (int m = 0; m < 4; ++m)
#pragma unroll
                for (int n = 0; n < 2; ++n) acc[a][b][m][n] = (f32x4){0.f, 0.f, 0.f, 0.f};
    bf16x8 At[4][2], B0[2][2], B1[2][2];
    const char* cA = (const char*)g.A + (size_t)cur.pm * tstep; const char* cB = (const char*)g.Bt + (size_t)cur.pn * tstep;
    S.a_ready(cur);
    if constexpr (SP2) {
        PG8_STAGE(PG8_SB(0, 0), cB, voffB); PG8_STAGE(PG8_SB(0, 1), cB + hstep, voffB); PG8_STAGE(PG8_SA(0, 0), cA, voffA); PG8_STAGE(PG8_SA(0, 1), cA + hstep, voffA);
        if (wr == 1) PG8_BAR;
        PG8_WAIT_V(2); PG8_BAR;
        PG8_STAGE(PG8_SB(1, 0), cB + kstep, voffB); PG8_STAGE(PG8_SA(1, 0), cA + kstep, voffA); PG8_STAGE(PG8_SB(1, 1), cB + hstep + kstep, voffB);
        PG8_WAIT_V(6); PG8_BAR;
    } else {
        PG8_STAGE(PG8_SB(0, 0), cB, voffB); PG8_STAGE(PG8_SA(0, 0), cA, voffA); PG8_STAGE(PG8_SB(0, 1), cB + hstep, voffB); PG8_STAGE(PG8_SA(0, 1), cA + hstep, voffA);
        if (wr == 1) PG8_BAR;
        PG8_WAIT_V(4); PG8_BAR;
        PG8_STAGE(PG8_SB(1, 0), cB + kstep, voffB); PG8_STAGE(PG8_SA(1, 0), cA + kstep, voffA); PG8_STAGE(PG8_SB(1, 1), cB + hstep + kstep, voffB);
        PG8_WAIT_V(6); PG8_BAR;
    }
    for (;;) {
        const bool has_next = S.next(ui + 1, nxt);
        const char* nA = has_next ? (const char*)g.A + (size_t)nxt.pm * tstep : cA; const char* nB = has_next ? (const char*)g.Bt + (size_t)nxt.pn * tstep : cB;
        for (int t = 0; t < nt; t += 2) {
            const bool last = (t == nt - 2);
            const char* a1 = cA + (size_t)(t + 1) * kstep;
            const char* a2 = last ? nA : cA + (size_t)(t + 2) * kstep; const char* b2 = last ? nB : cB + (size_t)(t + 2) * kstep;
            const char* a3 = a2 + kstep; const char* b3 = b2 + kstep;
            if (last && has_next) S.a_ready(nxt);
            if constexpr (SP2) {
            PG8_LDB(B0, 0, 0); PG8_LDB(B1, 0, 1); PG8_SCHED; PG8_LDA(At, 0, 0); PG8_STAGE(PG8_SA(1, 1), a1 + hstep, voffA);
            PG8_WAIT_V(8); PG8_WAIT_L(0); PG8_BAR; PG8_MMA(0, 0, At, B0); PG8_MMA(0, 1, At, B1); PG8_BAR; PG8_SCHED;
            PG8_LDA(At, 0, 1); PG8_STAGE(PG8_SB(0, 0), b2, voffB); PG8_STAGE(PG8_SB(0, 1), b2 + hstep, voffB); PG8_STAGE(PG8_SA(0, 0), a2, voffA);
            PG8_WAIT_V(8); PG8_WAIT_L(0); PG8_BAR; PG8_MMA(1, 0, At, B0); PG8_MMA(1, 1, At, B1); PG8_BAR; PG8_SCHED;
            PG8_LDB(B0, 1, 0); PG8_LDB(B1, 1, 1); PG8_SCHED; PG8_LDA(At, 1, 0); PG8_STAGE(PG8_SA(0, 1), a2 + hstep, voffA);
            PG8_WAIT_V(8); PG8_WAIT_L(0); PG8_BAR; PG8_MMA(0, 0, At, B0); PG8_MMA(0, 1, At, B1); PG8_BAR; PG8_SCHED;
            PG8_LDA(At, 1, 1); PG8_STAGE(PG8_SB(1, 0), b3, voffB); PG8_STAGE(PG8_SB(1, 1), b3 + hstep, voffB); PG8_STAGE(PG8_SA(1, 0), a3, voffA);
            PG8_WAIT_V(8); PG8_WAIT_L(0); PG8_BAR; PG8_MMA(1, 0, At, B0); PG8_MMA(1, 1, At, B1); PG8_BAR; PG8_SCHED;
            } else {
            PG8_LDB(B0, 0, 0); PG8_SCHED; PG8_LDA(At, 0, 0); PG8_STAGE(PG8_SA(1, 1), a1 + hstep, voffA);
            PG8_WAIT_L(8); PG8_BAR; PG8_WAIT_L(0); PG8_MMA(0, 0, At, B0); PG8_BAR; PG8_SCHED;
            PG8_LDB(B1, 0, 1); PG8_STAGE(PG8_SB(0, 0), b2, voffB);
            PG8_BAR; PG8_WAIT_L(0); PG8_MMA(0, 1, At, B1); PG8_BAR;
            PG8_LDA(At, 0, 1); PG8_STAGE(PG8_SA(0, 0), a2, voffA);
            PG8_BAR; PG8_WAIT_L(0); PG8_MMA(1, 0, At, B0); PG8_BAR; PG8_SCHED;
            PG8_STAGE(PG8_SB(0, 1), b2 + hstep, voffB);
            PG8_WAIT_V(6); PG8_BAR; PG8_MMA(1, 1, At, B1); PG8_BAR;
            PG8_LDB(B0, 1, 0); PG8_SCHED; PG8_LDA(At, 1, 0); PG8_STAGE(PG8_SA(0, 1), a2 + hstep, voffA);
            PG8_WAIT_L(8); PG8_BAR; PG8_WAIT_L(0); PG8_MMA(0, 0, At, B0); PG8_BAR; PG8_SCHED;
            PG8_LDB(B1, 1, 1); PG8_STAGE(PG8_SB(1, 0), b3, voffB);
            PG8_BAR; PG8_WAIT_L(0); PG8_MMA(0, 1, At, B1); PG8_BAR;
            PG8_LDA(At, 1, 1); PG8_STAGE(PG8_SA(1, 0), a3, voffA);
            PG8_BAR; PG8_WAIT_L(0); PG8_MMA(1, 0, At, B0); PG8_BAR; PG8_SCHED;
            PG8_STAGE(PG8_SB(1, 1), b3 + hstep, voffB);
            PG8_WAIT_V(6); PG8_BAR; PG8_MMA(1, 1, At, B1); PG8_BAR;
            }
        }
        if constexpr (ALIGN_EPI) { if (wr == 0) PG8_BAR; }
        if constexpr (!Epi::AFTER_DRAIN) { E(acc, cur, wr, wc, fr, fq); S.done(cur); }
        if (!has_next) break;
#pragma unroll
        for (int a = 0; a < 2; ++a)
#pragma unroll
            for (int b = 0; b < 2; ++b)
#pragma unroll
                for (int m = 0; m < 4; ++m)
#pragma unroll
                    for (int n = 0; n < 2; ++n) acc[a][b][m][n] = (f32x4){0.f, 0.f, 0.f, 0.f};
        cur = nxt; cA = nA; cB = nB; ++ui;
        if constexpr (ALIGN_EPI) { if (wr == 1) PG8_BAR; }
    }
    PG8_WAIT_V(0);
    if constexpr (!ALIGN_EPI) { if (wr == 0) PG8_BAR; }
    PG8_BAR;
    if constexpr (Epi::AFTER_DRAIN) { E.fused(acc, cur, wr, wc, fr, fq, lds, wid, lane); S.done(cur); }
#undef PG8_SA
#undef PG8_SB
#undef PG8_STAGE
#undef PG8_LDA
#undef PG8_LDB
#undef PG8_MMA
#undef PG8_WAIT_V
#undef PG8_WAIT_L
#undef PG8_BAR
#undef PG8_SCHED
}
}

struct Ctx {
    unsigned aoff; int l;
    unsigned char* ws;
    DI float* X() const { return GP(float, ws + WS_X); }
    DI bf16_t* H() const { return GP(bf16_t, ws + WS_H); }
    DI bf16_t* P() const { return GP(bf16_t, ws + WS_P); }
    DI bf16_t* QP() const { return GP(bf16_t, ws + WS_P); }
    DI bf16_t* MIX() const { return GP(bf16_t, ws + WS_MIX); }
    DI float* OF() const { return GP(float, ws + WS_OF); }
    DI float* OB() const { return GP(float, ws + WS_OB); }
    DI int* PIDX() const { return GP(int, ws + WS_PIDX); }
    DI float* PG() const { return GP(float, ws + WS_PG); }
    DI float* MOD() const { return GP(float, ws + WS_MOD); }
    DI float* LB() const { return GP(float, ws + WS_LB); }
    DI float* ROPE() const { return GP(float, ws + WS_ROPE); }
    DI bf16_t* WIN() const { return GP(bf16_t, ws + WS_WIN); }
    DI bf16_t* WOUT() const { return GP(bf16_t, ws + WS_WOUT); }
    DI bf16_t* WQ() const { return GP(bf16_t, ws + WS_WQ); }
    DI bf16_t* UB() const { return GP(bf16_t, ws + WS_UB); }
    DI float* ST() const { return GP(float, ws + WS_OF); }
    DI bf16_t* STB() const { return GP(bf16_t, ws + WS_OF); }
    DI float* AC() const { return GP(float, ws + WS_AC); }
    DI float* PA() const { return GP(float, ws + WS_PA); }
    DI float* VS() const { return GP(float, ws + WS_VS); }
    DI float* US() const { return GP(float, ws + WS_US); }
    DI bf16_t* SKH() const { return GP(bf16_t, ws + WS_SKH); }
    DI bf16_t* SKL() const { return GP(bf16_t, ws + WS_SKL); }
    DI bf16_t* VB() const { return GP(bf16_t, ws + WS_VB); }
    DI unsigned char* H8() const { return GP(unsigned char, ws + WS_H8); }
    DI float* HS() const { return GP(float, ws + WS_HS); }
    unsigned char* lds; int tid, lane, wave, gw, ngw, bid, nb;
    int xg, nxg, jx, nloc;
};

#define LAS __attribute__((address_space(3)))
DI void transpose_item(const float* W, int Kd, int N, bf16_t* WT, LAS float* scr, int item, int lane) {
    const int nblk = N / 32, kb = item / nblk, nb = item % nblk, k0 = 64 * kb, n0 = 32 * nb;
#pragma unroll 8
    for (int i = 0; i < 32; ++i) { const int kk = 2 * i + (lane >> 5); scr[kk * 33 + (lane & 31)] = W[(size_t)(k0 + kk) * N + n0 + (lane & 31)]; }
    asm volatile("s_waitcnt lgkmcnt(0)" ::: "memory");
    const int c = lane & 7;
#pragma unroll
    for (int j = 0; j < 4; ++j) { const int n = (lane >> 3) + 8 * j; const LAS float* sp = scr + (8 * c) * 33 + n;
        u32x4 o; o.x = pk2(sp[0 * 33], sp[1 * 33]); o.y = pk2(sp[2 * 33], sp[3 * 33]); o.z = pk2(sp[4 * 33], sp[5 * 33]); o.w = pk2(sp[6 * 33], sp[7 * 33]);
        *(u32x4*)(WT + (size_t)(n0 + n) * Kd + k0 + 8 * c) = o; }
    asm volatile("s_waitcnt lgkmcnt(0)" ::: "memory");
}

template <class T> DI T* argp_(const Ctx& K, unsigned off) {
    const unsigned* p = (const unsigned*)(K.lds + K.aoff + off);
    const unsigned lo = __builtin_amdgcn_readfirstlane(p[0]), hi = __builtin_amdgcn_readfirstlane(p[1]);
    return GP(T, ((unsigned long long)hi << 32) | (unsigned long long)lo);
}
#define ARG(f) argp_<const float>(K, (unsigned)__builtin_offsetof(Args, f))

DI void ph_prologue(Ctx& K) {
    {
        LAS float* scr = (LAS float*)((LAS unsigned char*)K.lds + K.wave * 16384);
        constexpr int I_IN = (D / 64) * (PW / 32), I_OUT = (D / 64) * (D / 32), I_Q = (D / 64) * (2048 / 32), I_L = I_IN + I_OUT + I_Q;
        for (int it = K.gw; it < DEPTH * I_L; it += K.ngw) {
            const int l = it / I_L; int r = it % I_L;
            if (r < I_IN) { transpose_item(ARG(w_in) + (size_t)l * D * PW, D, PW, K.WIN() + (size_t)l * PW * D, scr, r, K.lane); continue; } r -= I_IN;
            if (r < I_OUT) { transpose_item(ARG(w_out) + (size_t)l * D * D, D, D, K.WOUT() + (size_t)l * D * D, scr, r, K.lane); continue; } r -= I_OUT;
            transpose_item(ARG(peer_wq) + (size_t)l * D * 2048, D, 2048, K.WQ() + (size_t)l * 2048 * D, scr, r, K.lane);
        }
    }
    const size_t gt = (size_t)K.bid * NTHREADS + K.tid, gs = (size_t)K.nb * NTHREADS;
    { const float* sk = ARG(peer_sk);
      for (size_t i = gt; i < (size_t)DEPTH * 8 * 2 * 128 * 128; i += gs) { const float v = sk[i]; const bf16_t hi = f2bf(v);
          const size_t lhp = i >> 14; const int key = (int)(i >> 7) & 127, d = (int)i & 127;
          const size_t o = (((lhp * 8 + (key >> 4)) * 4 + (d >> 5)) * 64 + (key & 15) + 16 * ((d >> 3) & 3)) * 8 + (d & 7);
          K.SKH()[o] = hi; K.SKL()[o] = f2bf(v - bf2f(hi)); } }
    { const float* pu = ARG(peer_u); unsigned char* UQ = (unsigned char*)K.UB();
      for (int row0 = K.gw; row0 < DEPTH * 16384; row0 += 2 * K.ngw) {
          f32x4 v2[2][4];
#pragma unroll
          for (int t = 0; t < 2; ++t) { const int row = min(row0 + t * K.ngw, DEPTH * 16384 - 1); const f32x4* src = (const f32x4*)(pu + (size_t)row * D);
#pragma unroll
              for (int j = 0; j < 4; ++j) v2[t][j] = src[j * 64 + K.lane]; }
#pragma unroll
          for (int t = 0; t < 2; ++t) { const int row = row0 + t * K.ngw; if (row >= DEPTH * 16384) break;
              float mx = 0.f;
#pragma unroll
              for (int j = 0; j < 4; ++j) mx = fmaxf(mx, fmaxf(fmaxf(fabsf(v2[t][j].x), fabsf(v2[t][j].y)), fmaxf(fabsf(v2[t][j].z), fabsf(v2[t][j].w))));
#pragma unroll
              for (int o = 1; o < 64; o <<= 1) mx = fmaxf(mx, __shfl_xor(mx, o));
              const float sc = fmaxf(mx, 1e-30f) * (1.0f / 127.0f), inv = 1.0f / sc;
              if (K.lane == 0) K.US()[row] = sc;
#pragma unroll
              for (int j = 0; j < 4; ++j) { const int col = j * 256 + K.lane * 4; const f32x4 v = v2[t][j];
                  const unsigned q0 = (unsigned)((int)rintf(v.x * inv)) & 0xffu, q1 = (unsigned)((int)rintf(v.y * inv)) & 0xffu, q2 = (unsigned)((int)rintf(v.z * inv)) & 0xffu, q3 = (unsigned)((int)rintf(v.w * inv)) & 0xffu;
                  *(unsigned*)(UQ + (size_t)row * D + col) = q0 | (q1 << 8) | (q2 << 16) | (q3 << 24); } } } }
    { const float* pv = ARG(peer_v); unsigned char* VQ = (unsigned char*)K.VB();
      for (int row0 = K.gw; row0 < DEPTH * 16384; row0 += 2 * K.ngw) {
          f32x4 v2[2][4];
#pragma unroll
          for (int t = 0; t < 2; ++t) { const int row = min(row0 + t * K.ngw, DEPTH * 16384 - 1); const f32x4* src = (const f32x4*)(pv + (size_t)row * D);
#pragma unroll
              for (int j = 0; j < 4; ++j) v2[t][j] = src[j * 64 + K.lane]; }
#pragma unroll
          for (int t = 0; t < 2; ++t) { const int row = row0 + t * K.ngw; if (row >= DEPTH * 16384) break;
              float mx = 0.f;
#pragma unroll
              for (int j = 0; j < 4; ++j) mx = fmaxf(mx, fmaxf(fmaxf(fabsf(v2[t][j].x), fabsf(v2[t][j].y)), fmaxf(fabsf(v2[t][j].z), fabsf(v2[t][j].w))));
#pragma unroll
              for (int o = 1; o < 64; o <<= 1) mx = fmaxf(mx, __shfl_xor(mx, o));
              const float sc = fmaxf(mx, 1e-30f) * (1.0f / 127.0f), inv = 1.0f / sc;
              if (K.lane == 0) K.VS()[row] = sc;
              const int l = row >> 14, e = row & 16383;
#pragma unroll
              for (int j = 0; j < 4; ++j) { const int col = j * 256 + K.lane * 4; const f32x4 v = v2[t][j];
                  const unsigned q0 = (unsigned)((int)rintf(v.x * inv)) & 0xffu, q1 = (unsigned)((int)rintf(v.y * inv)) & 0xffu, q2 = (unsigned)((int)rintf(v.z * inv)) & 0xffu, q3 = (unsigned)((int)rintf(v.w * inv)) & 0xffu;
                  *(unsigned*)(VQ + (((size_t)l * 8 + (col >> 7)) * 16384 + e) * 128 + (col & 127)) = q0 | (q1 << 8) | (q2 << 16) | (q3 << 24); } } } }
    { float* sv = (float*)K.lds;
      float* part = sv + 3 * D;
      __syncthreads();
      for (int i = K.tid; i < 3 * D; i += NTHREADS) { const int v = i / D, k = i % D; const float c = v < 2 ? ARG(c)[v * D + k] : ARG(c_ctx)[k]; sv[i] = c * sigmoidf_(c); }
      __syncthreads();
      for (int item = K.bid; item < DEPTH * 48; item += K.nb) {
          const int l = item / 48, cb = item % 48, kp = K.lane >> 5, cl = (K.lane & 31) * 4;
          const float* w = ARG(w_mod) + (size_t)l * D * 6 * D + cb * 128 + cl;
          f32x4 a0 = {0.f, 0.f, 0.f, 0.f}, a1 = a0, a2 = a0;
#pragma unroll 16
          for (int kk = 0; kk < 64; ++kk) { const int k = K.wave * 128 + 2 * kk + kp; const f32x4 wv = *(const f32x4*)(w + (size_t)k * 6 * D);
              a0 += wv * sv[k]; a1 += wv * sv[D + k]; a2 += wv * sv[2 * D + k]; }
#pragma unroll
          for (int j = 0; j < 4; ++j) { a0[j] += __shfl_xor(a0[j], 32); a1[j] += __shfl_xor(a1[j], 32); a2[j] += __shfl_xor(a2[j], 32); }
          if (kp == 0) { *(f32x4*)(part + (K.wave * 3 + 0) * 128 + cl) = a0; *(f32x4*)(part + (K.wave * 3 + 1) * 128 + cl) = a1; *(f32x4*)(part + (K.wave * 3 + 2) * 128 + cl) = a2; }
          __syncthreads();
          for (int i = K.tid; i < 384; i += NTHREADS) { const int v = i / 128, cc = i % 128; float sum = 0.f;
#pragma unroll
              for (int w8 = 0; w8 < 8; ++w8) sum += part[(w8 * 3 + v) * 128 + cc];
              const int col = cb * 128 + cc; K.MOD()[((size_t)l * 3 + v) * 6 * D + col] = sum + ARG(b_mod)[(size_t)l * 6 * D + col]; }
          __syncthreads();
      } }
    for (size_t i = gt; i < 2 * 256; i += gs) {
        const int dir = (int)(i / 256), ch = (int)(i % 256);
        float lg[DEPTH], mx = -1e30f;
#pragma unroll
        for (int l = 0; l < DEPTH; ++l) { lg[l] = ARG(lb_logits)[((size_t)dir * DEPTH + l) * 256 + ch]; mx = fmaxf(mx, lg[l]); }
        float s = 0.f;
#pragma unroll
        for (int l = 0; l < DEPTH; ++l) { lg[l] = expf(lg[l] - mx); s += lg[l]; }
        float cum = 0.f;
#pragma unroll
        for (int l = 0; l < DEPTH; ++l) { if (l > 0) cum += lg[l] / s; K.LB()[((size_t)dir * DEPTH + l) * 256 + ch] = cum; }
    }
    for (size_t i = gt; i < (256 + 64) * 16; i += gs) {
        const int pos = (int)(i / 16), f = (int)(i % 16);
        const float inv = powf(10000.0f, -(float)f / 16.0f);
        if (pos < 256) { const float ang = (float)pos * inv; K.ROPE()[pos * 16 + f] = cosf(ang); K.ROPE()[4096 + pos * 16 + f] = sinf(ang); }
        else { const int pc = pos - 256; const float ang = (float)pc * inv; K.ROPE()[8192 + pc * 16 + f] = cosf(ang); K.ROPE()[8192 + 1024 + pc * 16 + f] = sinf(ang); }
    }
}

DI void ph_norm(Ctx& K, const float* nw, int shift_chunk) {
    const float* modl = K.MOD() + (size_t)K.l * 3 * 6 * D;
    for (int r = K.gw; r < M; r += K.ngw) {
        const f32x4* xr = (const f32x4*)((K.l == 0 && shift_chunk == 0) ? (r < NCTX ? ARG(ctx) + (size_t)r * D : ARG(x) + (size_t)(r - NCTX) * D) : K.X() + (size_t)r * D);
        f32x4 v[4]; float ss = 0.f;
#pragma unroll
        for (int j = 0; j < 4; ++j) { v[j] = xr[j * 64 + K.lane]; ss += v[j].x * v[j].x + v[j].y * v[j].y + v[j].z * v[j].z + v[j].w * v[j].w; }
        ss = wave_sum(ss);
        const float rs = rsqrtf(ss * (1.0f / D) + EPS);
        const float* mv = modl + (size_t)modvec_of_row(r) * 6 * D;
        u32x2* ho = (u32x2*)(K.H() + (size_t)r * D);
#pragma unroll
        for (int j = 0; j < 4; ++j) {
            const int c4 = j * 64 + K.lane;
            const f32x4 w = ((const f32x4*)nw)[c4], sh = ((const f32x4*)(mv + shift_chunk * D))[c4], sc = ((const f32x4*)(mv + (shift_chunk + 1) * D))[c4];
            f32x4 y; y.x = v[j].x * rs * w.x * (1.f + sc.x) + sh.x; y.y = v[j].y * rs * w.y * (1.f + sc.y) + sh.y; y.z = v[j].z * rs * w.z * (1.f + sc.z) + sh.z; y.w = v[j].w * rs * w.w * (1.f + sc.w) + sh.w;
            u32x2 o; o.x = pk2(y.x, y.y); o.y = pk2(y.z, y.w); ho[c4] = o;
            if (shift_chunk == 3) { v[j].x = __uint_as_float(o.x << 16); v[j].y = __uint_as_float(o.x & 0xffff0000u); v[j].z = __uint_as_float(o.y << 16); v[j].w = __uint_as_float(o.y & 0xffff0000u); }
        }
        if (shift_chunk == 3) {
            float mx = 0.f;
#pragma unroll
            for (int j = 0; j < 4; ++j) mx = fmaxf(mx, fmaxf(fmaxf(fabsf(v[j].x), fabsf(v[j].y)), fmaxf(fabsf(v[j].z), fabsf(v[j].w))));
#pragma unroll
            for (int o = 1; o < 64; o <<= 1) mx = fmaxf(mx, __shfl_xor(mx, o));
            const float sc = fmaxf(mx, 1e-30f) * (1.0f / 127.0f), inv = 1.0f / sc;
            if (K.lane == 0) K.HS()[r] = sc;
#pragma unroll
            for (int j = 0; j < 4; ++j) { const unsigned q0 = (unsigned)((int)rintf(v[j].x * inv)) & 0xffu, q1 = (unsigned)((int)rintf(v[j].y * inv)) & 0xffu, q2 = (unsigned)((int)rintf(v[j].z * inv)) & 0xffu, q3 = (unsigned)((int)rintf(v[j].w * inv)) & 0xffu;
                *(unsigned*)(K.H8() + (size_t)r * D + (j * 64 + K.lane) * 4) = q0 | (q1 << 8) | (q2 << 16) | (q3 << 24); }
        }
    }
}

typedef short sg_bf16x8 __attribute__((ext_vector_type(8)));
template <int NT, bool RESID> DI void sg_ctx(Ctx& K, const bf16_t* A, const bf16_t* Bt, bf16_t* out, float* X, const float* gate, const float* Xin) {
    constexpr int N = 1024 * NT, RS = 272, OFF_B = 64 * RS, BUF = (64 + 32 * NT) * RS;
    int tid = K.tid; asm volatile("" : "+v"(tid));
    const int lane = tid & 63, wave = __builtin_amdgcn_readfirstlane(tid >> 6), r16 = lane & 15, g4 = lane >> 4, mt = wave & 3, nh = wave >> 2;
    const int lrow = tid >> 4, lc = tid & 15;
    for (int u = K.bid; u < 256; u += K.nb) {
        const int xcd = u & 7, j = u >> 3, ct = xcd * 4 + (j & 3), rt = j >> 2;
        const int row0 = 64 * rt, col0 = 32 * NT * ct;
        const bf16_t* ga = A + (size_t)(row0 + lrow) * D + 8 * lc; const bf16_t* gb = Bt + (size_t)(col0 + lrow) * D + 8 * lc;
        u32x4 ra[3][2], rb[3][NT];
        f32x4 acc[NT];
#pragma unroll
        for (int n = 0; n < NT; ++n) acc[n] = (f32x4){0.f, 0.f, 0.f, 0.f};
#define SG_LOAD(s_, c_) do { ra[s_][0] = *(const u32x4*)(ga + 128 * (c_)); ra[s_][1] = *(const u32x4*)(ga + 32 * D + 128 * (c_)); \
        _Pragma("unroll") for (int i_ = 0; i_ < NT; ++i_) rb[s_][i_] = *(const u32x4*)(gb + (size_t)32 * i_ * D + 128 * (c_)); } while (0)
        SG_LOAD(0, 0); SG_LOAD(1, 1); SG_LOAD(2, 2);
        __syncthreads();
#pragma unroll
        for (int c = 0; c < 8; ++c) {
            unsigned char* buf = K.lds + (c & 1) * BUF;
            *(u32x4*)(buf + lrow * RS + 16 * lc) = ra[c % 3][0]; *(u32x4*)(buf + (lrow + 32) * RS + 16 * lc) = ra[c % 3][1];
#pragma unroll
            for (int i = 0; i < NT; ++i) *(u32x4*)(buf + OFF_B + (lrow + 32 * i) * RS + 16 * lc) = rb[c % 3][i];
            if (c + 3 < 8) SG_LOAD(c % 3, c + 3);
            __syncthreads();
#pragma unroll
            for (int ks = 0; ks < 4; ++ks) {
                const sg_bf16x8 af = *(const sg_bf16x8*)(buf + (16 * mt + r16) * RS + 64 * ks + 16 * g4);
#pragma unroll
                for (int n = 0; n < NT; ++n) { const sg_bf16x8 bf = *(const sg_bf16x8*)(buf + OFF_B + (16 * (NT * nh + n) + r16) * RS + 64 * ks + 16 * g4);
                    acc[n] = __builtin_amdgcn_mfma_f32_16x16x32_bf16(bf, af, acc[n], 0, 0, 0); }
            }
        }
#undef SG_LOAD
        const int row = row0 + 16 * mt + r16;
#pragma unroll
        for (int n = 0; n < NT; ++n) { const int col = col0 + 16 * (NT * nh + n) + 4 * g4;
            if constexpr (RESID) { float* xp = X + (size_t)row * D + col; const f32x4 g = *(const f32x4*)(gate + col); f32x4 x = *(const f32x4*)(Xin + (size_t)row * D + col); x += g * acc[n]; *(f32x4*)xp = x; }
            else { u32x2 o; o.x = pk2(acc[n][0], acc[n][1]); o.y = pk2(acc[n][2], acc[n][3]); *(u32x2*)(out + (size_t)row * N + col) = o; } }
        __syncthreads();
    }
}
DI void ph_gemm_store(Ctx& K, const bf16_t* A, const bf16_t* Bt, int N, bf16_t* out, const float* rope) {
    { pg8::Gemm g{A + (size_t)NCTX * D, Bt, NLAT, N, D}; pg8::StaticOrder S; S.init(NLAT, N, K.nb, K.bid);
      pg8::EpiStore E{out, N, (LAS unsigned char*)K.lds, rope, NCTX, L, NCTX};
      pg8::gemm_phase<pg8::EpiStore, pg8::StaticOrder, true, true>((LAS unsigned char*)K.lds, g, S, E, K.tid); }
    if (N == PW) sg_ctx<3, false>(K, A, Bt, out, nullptr, nullptr, nullptr); else sg_ctx<2, false>(K, A, Bt, out, nullptr, nullptr, nullptr);
}
DI void ph_gemm_resid(Ctx& K, const bf16_t* A, const bf16_t* Bt, int chunk) {
    const float* gate = K.MOD() + (size_t)K.l * 3 * 6 * D + (size_t)chunk * D;
    { pg8::Gemm g{A + (size_t)NCTX * D, Bt, NLAT, D, D}; pg8::StaticOrder S; S.init(NLAT, D, K.nb, K.bid);
      pg8::EpiResid E{K.X(), D, gate, 6 * D, NCTX, L, (LAS unsigned char*)K.lds, NCTX, K.l == 0 ? ARG(x) : (const float*)K.X() + (size_t)NCTX * D};
      pg8::gemm_phase<pg8::EpiResid, pg8::StaticOrder, true, true>((LAS unsigned char*)K.lds, g, S, E, K.tid); }
    sg_ctx<1, true>(K, A, Bt, nullptr, K.X(), gate + (size_t)2 * 6 * D, K.l == 0 ? ARG(ctx) : (const float*)K.X());
}

DI void ph_rope(Ctx& K) {
    const float* cosr = K.ROPE(); const float* sinr = K.ROPE() + 4096; const float* cosc = K.ROPE() + 8192; const float* sinc = K.ROPE() + 8192 + 1024;
    const size_t gt = (size_t)K.bid * NTHREADS + K.tid, gs = (size_t)K.nb * NTHREADS;
    for (size_t i = gt; i < (size_t)NLAT * 8 * 16; i += gs) {
        const int f = (int)(i & 15), hh = (int)((i >> 4) & 7), lr = (int)(i >> 7);
        const int t = lr % L, pr = t >> 6, pc = t & 63;
        bf16_t* p = K.P() + (size_t)(NCTX + lr) * PW + (hh < 6 ? C_SQ + hh * 64 : C_SK + (hh - 6) * 64);
        const float c1 = cosr[pr * 16 + f], s1 = sinr[pr * 16 + f], c2 = cosc[pc * 16 + f], s2 = sinc[pc * 16 + f];
        const float a = bf2f(p[f]), b = bf2f(p[16 + f]), e = bf2f(p[32 + f]), g = bf2f(p[48 + f]);
        p[f] = f2bf(a * c1 - b * s1); p[16 + f] = f2bf(b * c1 + a * s1); p[32 + f] = f2bf(e * c2 - g * s2); p[48 + f] = f2bf(g * c2 + e * s2);
    }
}

typedef short bf16x8_t __attribute__((ext_vector_type(8)));
#define MFMA16(a, b, c) __builtin_amdgcn_mfma_f32_16x16x32_bf16((a), (b), (c), 0, 0, 0)
constexpr int HG_NCH = (CL + L) / 64;
constexpr int HG_LFS = 68;
constexpr int HG_TS = 72;
constexpr int HGL_LF = 0, HGL_OM = HGL_LF + 2 * 64 * HG_LFS * 4, HGL_VT = HGL_OM + 2 * 64 * HG_LFS * 4, HGL_KT = HGL_VT + 64 * HG_TS * 2, HGL_SC = HGL_KT + 2 * 64 * HG_TS * 2, HGL_OD = HGL_SC + 8 * 16 * HG_TS * 2, HGL_END = HGL_OD + 2 * 64 * HG_LFS * 4;
static_assert(HGL_END <= LDS_BYTES - 256, "hgrn LDS map");
constexpr int HG_NIT = NB * 4 * HG_NCH;
DI int hg_block_row(int b, int tb, int tok) { return tb < 4 ? ctx_row(b, tb * 64 + tok) : lat_row(b, (tb - 4) * 64 + tok); }
DI int hg_bwd_chunk(int tb) { return tb < 4 ? 3 - tb : 4 + 255 - (tb - 4); }
DI int hg_sw(int row, int col) { return row * HG_TS + ((((col >> 3) ^ (row >> 3)) & 7) << 3) + (col & 7); }
struct HgIn { u32x4 zf, zb, hv; };
DI void hg_item(int item, int& b, int& h, int& tb) { tb = item % HG_NCH; h = (item / HG_NCH) & 3; b = item / (HG_NCH * 4); }
DI void hg_load(Ctx& K, int item, HgIn& r) {
    int b, h, tb; hg_item(item, b, h, tb); const int tok = K.tid >> 3, c = K.tid & 7;
    const bf16_t* pr = K.P() + (size_t)hg_block_row(b, tb, tok) * PW + h * 64 + 8 * c;
    r.zf = *(const u32x4*)(pr + C_ZF); r.zb = *(const u32x4*)(pr + C_ZB); r.hv = *(const u32x4*)(pr + C_HV);
}
DI void hg_prep1(Ctx& K, int h, const HgIn& r) {
    float* LF = (float*)(K.lds + HGL_LF); float* OM = (float*)(K.lds + HGL_OM); bf16_t* VT = (bf16_t*)(K.lds + HGL_VT);
    const int tok = K.tid >> 3, c = K.tid & 7;
#pragma unroll
    for (int dir = 0; dir < 2; ++dir) {
        float z[8]; unpack8(dir ? r.zb : r.zf, z);
        const float* lb = K.LB() + ((size_t)dir * DEPTH + K.l) * 256 + h * 64 + 8 * c;
        float lf[8], om[8];
#pragma unroll
        for (int j = 0; j < 8; ++j) { const float lbv = lb[j], sg = sigmoidf_(z[j]); const float f = fmaxf(lbv + (1.f - lbv) * sg, 1e-30f); lf[j] = __logf(f); om[j] = (1.f - lbv) * (1.f - sg); }
        float* lfp = LF + (dir * 64 + tok) * HG_LFS + 8 * c; float* omp = OM + (dir * 64 + tok) * HG_LFS + 8 * c;
        *(f32x4*)lfp = (f32x4){lf[0], lf[1], lf[2], lf[3]}; *(f32x4*)(lfp + 4) = (f32x4){lf[4], lf[5], lf[6], lf[7]};
        *(f32x4*)omp = (f32x4){om[0], om[1], om[2], om[3]}; *(f32x4*)(omp + 4) = (f32x4){om[4], om[5], om[6], om[7]};
    }
    { const unsigned w[4] = {r.hv.x, r.hv.y, r.hv.z, r.hv.w};
#pragma unroll
      for (int j = 0; j < 4; ++j) { VT[hg_sw(8 * c + 2 * j, tok)] = (bf16_t)(w[j] & 0xffffu); VT[hg_sw(8 * c + 2 * j + 1, tok)] = (bf16_t)(w[j] >> 16); } }
}
DI void hg_prep2(Ctx& K) {
    float* LF = (float*)(K.lds + HGL_LF);
    __syncthreads();
    if (K.tid < 128) {
        const int dir = K.tid >> 6, d = K.tid & 63; float* col = LF + dir * 64 * HG_LFS + d;
        float carry = 0.f;
#pragma unroll
        for (int hf = 0; hf < 2; ++hf) { float v[32];
#pragma unroll
            for (int p = 0; p < 32; ++p) v[p] = col[(dir ? 63 - (32 * hf + p) : 32 * hf + p) * HG_LFS];
            v[0] += carry;
#pragma unroll
            for (int p = 1; p < 32; ++p) v[p] += v[p - 1];
#pragma unroll
            for (int p = 0; p < 32; ++p) col[(dir ? 63 - (32 * hf + p) : 32 * hf + p) * HG_LFS] = v[p];
            carry = v[31]; }
    }
    __syncthreads();
}
DI void ph_hgrn_A(Ctx& K) {
    float* LF = (float*)(K.lds + HGL_LF); float* OM = (float*)(K.lds + HGL_OM); bf16_t* VT = (bf16_t*)(K.lds + HGL_VT); bf16_t* KT = (bf16_t*)(K.lds + HGL_KT);
    const int r16 = K.lane & 15, g4 = K.lane >> 4;
    if (K.bid >= HG_NIT) return;
    HgIn in; hg_load(K, K.bid, in);
#pragma unroll 1
    for (int item = K.bid; item < HG_NIT; item += K.nb) {
        int b, h, tb; hg_item(item, b, h, tb);
        __syncthreads();
        hg_prep1(K, h, in);
        hg_load(K, item + K.nb < HG_NIT ? item + K.nb : item, in);
        hg_prep2(K);
        { const int tok = K.tid >> 3, c = K.tid & 7;
#pragma unroll
          for (int dir = 0; dir < 2; ++dir) {
              const float* bl = LF + (dir * 64 + (dir ? 0 : 63)) * HG_LFS + 8 * c; const float* bt = LF + (dir * 64 + tok) * HG_LFS + 8 * c; const float* om = OM + (dir * 64 + tok) * HG_LFS + 8 * c;
#pragma unroll
              for (int j = 0; j < 8; ++j) KT[dir * 64 * HG_TS + hg_sw(8 * c + j, tok)] = f2bf(om[j] * __expf(bl[j] - bt[j]));
          }
          if (K.tid < 128) { const int dir = K.tid >> 6, d = K.tid & 63; const int chain = (b * 2 + dir) * 4 + h, ch = dir ? hg_bwd_chunk(tb) : tb;
              K.AC()[((size_t)chain * HG_NCH + ch) * 64 + d] = __expf(LF[(dir * 64 + (dir ? 0 : 63)) * HG_LFS + d]); } }
        __syncthreads();
        { const int dir = K.wave >> 2, mi = K.wave & 3; const int chain = (b * 2 + dir) * 4 + h, ch = dir ? hg_bwd_chunk(tb) : tb;
          f32x4 acc[4];
#pragma unroll
          for (int db = 0; db < 4; ++db) acc[db] = (f32x4){0.f, 0.f, 0.f, 0.f};
#pragma unroll
          for (int ks = 0; ks < 2; ++ks) {
              const bf16x8_t vv = *(const bf16x8_t*)(VT + hg_sw(16 * mi + r16, 32 * ks + 8 * g4));
#pragma unroll
              for (int db = 0; db < 4; ++db) { const bf16x8_t kv = *(const bf16x8_t*)(KT + dir * 64 * HG_TS + hg_sw(16 * db + r16, 32 * ks + 8 * g4)); acc[db] = MFMA16(kv, vv, acc[db]); }
          }
          bf16_t* st = K.STB() + ((size_t)chain * HG_NCH + ch) * 4096 + (size_t)K.lane * 8;
#pragma unroll
          for (int ks = 0; ks < 2; ++ks) { const u32x4 w = (u32x4){pk2(acc[2 * ks][0], acc[2 * ks][1]), pk2(acc[2 * ks][2], acc[2 * ks][3]), pk2(acc[2 * ks + 1][0], acc[2 * ks + 1][1]), pk2(acc[2 * ks + 1][2], acc[2 * ks + 1][3])};
              *(u32x4*)(st + (mi * 2 + ks) * 512) = w; }
        }
    }
}
DI void ph_hgrn_B(Ctx& K) {
    const int per = ((16 * 2048 + K.nb - 1) / K.nb + 63) & ~63;
    const int gt = K.bid * per + K.tid;
    if (K.tid < per && gt < 16 * 2048) {
        const int chain = gt >> 11, dw = gt & 2047, m = dw & 3, lane = (dw >> 2) & 63, ks = (dw >> 8) & 1;
        const int d0 = 32 * ks + 16 * (m >> 1) + 4 * (lane >> 4) + 2 * (m & 1);
        unsigned* st = (unsigned*)(K.STB() + (size_t)chain * HG_NCH * 4096) + dw; const float* ac = K.AC() + (size_t)chain * HG_NCH * 64 + d0;
        float S0 = 0.f, S1 = 0.f;
#pragma unroll 1
        for (int c0 = 0; c0 < HG_NCH; c0 += 26) {
            unsigned u[26]; float a0[26], a1[26];
#pragma unroll
            for (int i = 0; i < 26; ++i) { u[i] = st[(size_t)(c0 + i) * 2048]; const u32x2 av = *(const u32x2*)(ac + (c0 + i) * 64); a0[i] = __uint_as_float(av.x); a1[i] = __uint_as_float(av.y); }
#pragma unroll
            for (int i = 0; i < 26; ++i) { st[(size_t)(c0 + i) * 2048] = pk2(S0, S1); S0 = a0[i] * S0 + __uint_as_float(u[i] << 16); S1 = a1[i] * S1 + __uint_as_float(u[i] & 0xffff0000u); }
        }
    }
}
struct HgInC { u32x2 q[2][2]; u32x4 gq; u32x4 st[8]; };
DI void ph_hgrn_C(Ctx& K) {
    float* LF = (float*)(K.lds + HGL_LF); float* OM = (float*)(K.lds + HGL_OM); bf16_t* VT = (bf16_t*)(K.lds + HGL_VT); bf16_t* KP = (bf16_t*)(K.lds + HGL_KT); float* OD = (float*)(K.lds + HGL_OD);
    bf16_t* SC = (bf16_t*)(K.lds + HGL_SC) + K.wave * 16 * HG_TS;
    const int r16 = K.lane & 15, g4 = K.lane >> 4, dir = K.wave >> 2, mi = K.wave & 3;
    if (K.bid >= HG_NIT) return;
    HgIn in; HgInC ic;
    hg_load(K, K.bid, in);
#define HGC_LOAD_Q(it_) do { int b_, h_, tb_; hg_item(it_, b_, h_, tb_); const bf16_t* qr = K.P() + (size_t)hg_block_row(b_, tb_, 16 * mi + r16) * PW + C_HQ + h_ * 64 + 4 * g4; \
        _Pragma("unroll") for (int ks = 0; ks < 2; ++ks) { ic.q[ks][0] = *(const u32x2*)(qr + 32 * ks); ic.q[ks][1] = *(const u32x2*)(qr + 32 * ks + 16); } } while (0)
#define HGC_LOAD_ST(it_) do { int b_, h_, tb_; hg_item(it_, b_, h_, tb_); const int chain_ = (b_ * 2 + dir) * 4 + h_, ch_ = dir ? hg_bwd_chunk(tb_) : tb_; \
        const bf16_t* sp = K.STB() + ((size_t)chain_ * HG_NCH + ch_) * 4096 + (size_t)K.lane * 8; _Pragma("unroll") for (int i_ = 0; i_ < 8; ++i_) ic.st[i_] = *(const u32x4*)(sp + i_ * 512); } while (0)
#define HGC_LOAD_G(it_) do { int b_, h_, tb_; hg_item(it_, b_, h_, tb_); const int tok_ = K.tid >> 3, c_ = K.tid & 7; \
        ic.gq = *(const u32x4*)(K.P() + (size_t)hg_block_row(b_, tb_, tok_) * PW + C_HG + h_ * 64 + 8 * c_); } while (0)
    HGC_LOAD_Q(K.bid); HGC_LOAD_ST(K.bid); HGC_LOAD_G(K.bid);
#pragma unroll 1
    for (int item = K.bid; item < HG_NIT; item += K.nb) {
        int b, h, tb; hg_item(item, b, h, tb);
        const int nxt = item + K.nb < HG_NIT ? item + K.nb : item;
        __syncthreads();
        hg_prep1(K, h, in);
        hg_load(K, nxt, in);
        hg_prep2(K);
        {
          const int tok = K.tid >> 3, c = K.tid & 7;
#pragma unroll
          for (int dd = 0; dd < 2; ++dd) { const float* rf = LF + (dd * 64 + 32) * HG_LFS + 8 * c; const float* bs = LF + (dd * 64 + tok) * HG_LFS + 8 * c; const float* om = OM + (dd * 64 + tok) * HG_LFS + 8 * c;
              unsigned o[4];
#pragma unroll
              for (int j = 0; j < 4; ++j) o[j] = pk2(om[2 * j] * __expf(rf[2 * j] - bs[2 * j]), om[2 * j + 1] * __expf(rf[2 * j + 1] - bs[2 * j + 1]));
              *(u32x4*)(KP + (dd * 64 + tok) * HG_TS + 8 * c) = (u32x4){o[0], o[1], o[2], o[3]}; } }
        __syncthreads();
        f32x4 nw0, nw1;
        { const float* LFd = LF + dir * 64 * HG_LFS; const float* ref = LFd + 32 * HG_LFS;
          bf16x8_t aq1[2], aq2[2];
          { const int t = 16 * mi + r16;
#pragma unroll
            for (int ks = 0; ks < 2; ++ks) { unsigned o1[4], o2[4];
#pragma unroll
                for (int hf = 0; hf < 2; ++hf) { const int d0 = 32 * ks + 16 * hf + 4 * g4; const unsigned qw[2] = {ic.q[ks][hf].x, ic.q[ks][hf].y};
                    const f32x4 bt = *(const f32x4*)(LFd + t * HG_LFS + d0), rf = *(const f32x4*)(ref + d0);
#pragma unroll
                    for (int j = 0; j < 2; ++j) { const float qa = __uint_as_float(qw[j] << 16), qb = __uint_as_float(qw[j] & 0xffff0000u); const float sa = qa * sigmoidf_(qa), sb = qb * sigmoidf_(qb);
                        const float e1a = __expf(bt[2 * j] - rf[2 * j]), e1b = __expf(bt[2 * j + 1] - rf[2 * j + 1]), e2a = __expf(bt[2 * j]), e2b = __expf(bt[2 * j + 1]);
                        o1[2 * hf + j] = pk2(sa * e1a, sb * e1b); o2[2 * hf + j] = pk2(sa * e2a, sb * e2b); } }
                aq1[ks] = __builtin_bit_cast(bf16x8_t, (u32x4){o1[0], o1[1], o1[2], o1[3]}); aq2[ks] = __builtin_bit_cast(bf16x8_t, (u32x4){o2[0], o2[1], o2[2], o2[3]}); } }
          HGC_LOAD_Q(nxt);
          f32x4 sc[4];
#pragma unroll
          for (int nj = 0; nj < 4; ++nj) { sc[nj] = (f32x4){0.f, 0.f, 0.f, 0.f}; const bf16_t* kr = KP + (dir * 64 + 16 * nj + r16) * HG_TS + 4 * g4;
#pragma unroll
              for (int ks = 0; ks < 2; ++ks) { const u32x2 k0 = *(const u32x2*)(kr + 32 * ks), k1 = *(const u32x2*)(kr + 32 * ks + 16);
                  sc[nj] = MFMA16(aq1[ks], __builtin_bit_cast(bf16x8_t, (u32x4){k0.x, k0.y, k1.x, k1.y}), sc[nj]); } }
#pragma unroll
          for (int nj = 0; nj < 4; ++nj)
#pragma unroll
              for (int rg = 0; rg < 4; ++rg) { const int tl = 4 * g4 + rg, t = 16 * mi + tl, s_ = 16 * nj + r16; const bool keep = dir ? (s_ >= t) : (s_ <= t);
                  SC[tl * HG_TS + s_] = f2bf(keep ? sc[nj][rg] : 0.f); }
          asm volatile("s_waitcnt lgkmcnt(0)" ::: "memory");
          f32x4 oacc[4];
#pragma unroll
          for (int nj = 0; nj < 4; ++nj) oacc[nj] = (f32x4){0.f, 0.f, 0.f, 0.f};
#pragma unroll
          for (int ks = 0; ks < 2; ++ks) {
              const bf16x8_t as = *(const bf16x8_t*)(SC + r16 * HG_TS + 32 * ks + 8 * g4);
#pragma unroll
              for (int nj = 0; nj < 4; ++nj) {
                  const bf16x8_t bv = *(const bf16x8_t*)(VT + hg_sw(16 * nj + r16, 32 * ks + 8 * g4));
                  oacc[nj] = MFMA16(as, bv, oacc[nj]);
                  oacc[nj] = MFMA16(aq2[ks], __builtin_bit_cast(bf16x8_t, ic.st[nj * 2 + ks]), oacc[nj]);
              }
          }
          HGC_LOAD_ST(nxt);
          { const float* nwp = ARG(hgrn_norm_w) + (size_t)K.l * 256 + h * 64 + 8 * (K.tid & 7); nw0 = *(const f32x4*)nwp; nw1 = *(const f32x4*)(nwp + 4); }
#pragma unroll
          for (int nj = 0; nj < 4; ++nj)
#pragma unroll
              for (int rg = 0; rg < 4; ++rg) OD[(dir * 64 + 16 * mi + 4 * g4 + rg) * HG_LFS + 16 * nj + r16] = oacc[nj][rg];
        }
        __syncthreads();
        { const int tok = K.tid >> 3, c = K.tid & 7; const int row = hg_block_row(b, tb, tok);
          const float* o0 = OD + tok * HG_LFS + 8 * c; const float* o1 = OD + (64 + tok) * HG_LFS + 8 * c;
          float o[8], ss = 0.f;
#pragma unroll
          for (int j = 0; j < 8; ++j) { o[j] = o0[j] + o1[j]; ss += o[j] * o[j]; }
          ss += __shfl_xor(ss, 1); ss += __shfl_xor(ss, 2); ss += __shfl_xor(ss, 4);
          const float rs = rsqrtf(ss * (1.0f / 64.0f) + EPS);
          float gq[8]; unpack8(ic.gq, gq);
          const float nw[8] = {nw0[0], nw0[1], nw0[2], nw0[3], nw1[0], nw1[1], nw1[2], nw1[3]};
          float y[8];
#pragma unroll
          for (int j = 0; j < 8; ++j) y[j] = o[j] * rs * nw[j] * gq[j] * sigmoidf_(gq[j]);
          HGC_LOAD_G(nxt);
          u32x4 w; w.x = pk2(y[0], y[1]); w.y = pk2(y[2], y[3]); w.z = pk2(y[4], y[5]); w.w = pk2(y[6], y[7]);
          *(u32x4*)(K.MIX() + (size_t)row * D + MX_H + h * 64 + 8 * c) = w; }
    }
#undef HGC_LOAD_Q
#undef HGC_LOAD_ST
#undef HGC_LOAD_G
}

constexpr int AT_TS = 72;
constexpr int ATL_K = 0, ATL_V = ATL_K + 64 * AT_TS * 2, ATL_P = ATL_V + 64 * AT_TS * 2, ATL_END = ATL_P + 8 * 48 * AT_TS * 2;
static_assert(ATL_END <= LDS_BYTES - 256, "attention LDS map");
DI float dpp_max16(float x) { x = fmaxf(x, dpp_<0xB1>(x)); x = fmaxf(x, dpp_<0x4E>(x)); x = fmaxf(x, dpp_<0x141>(x)); x = fmaxf(x, dpp_<0x128>(x)); return x; }
DI float dpp_sum16(float x) { x += dpp_<0xB1>(x); x += dpp_<0x4E>(x); x += dpp_<0x141>(x); x += dpp_<0x128>(x); return x; }
DI unsigned cvtpk(float lo, float hi) { unsigned r; asm("v_cvt_pk_bf16_f32 %0, %1, %2" : "=v"(r) : "v"(lo), "v"(hi)); return r; }
DI float xg4_max(float x) { x = fmaxf(x, __shfl_xor(x, 16)); x = fmaxf(x, __shfl_xor(x, 32)); return x; }
template <int MT, int NJ, bool SAMEKB> DI void at_softmax_pv(f32x4 (&sT)[MT][NJ], float (&mrun)[MT], float (&lrun)[MT], f32x4 (&oacc)[MT][4], const bf16_t* VT, const int (&kb)[MT], int r16, int g4) {
    unsigned pb[MT][NJ / 2][4];
#pragma unroll
    for (int mt = 0; mt < MT; ++mt) {
        float mx = -INFINITY;
#pragma unroll
        for (int nj = 0; nj < NJ; ++nj) mx = fmaxf(mx, fmaxf(fmaxf(sT[mt][nj][0], sT[mt][nj][1]), fmaxf(sT[mt][nj][2], sT[mt][nj][3])));
        mx = xg4_max(mx);
        const float mn = fmaxf(mrun[mt], mx), alpha = __expf(mrun[mt] - mn); mrun[mt] = mn;
        float rs_ = 0.f;
#pragma unroll
        for (int nj = 0; nj < NJ; ++nj)
#pragma unroll
            for (int rg = 0; rg < 4; ++rg) { const float pe = __expf(sT[mt][nj][rg] - mn); sT[mt][nj][rg] = pe; rs_ += pe; }
        lrun[mt] = lrun[mt] * alpha + rs_;
#pragma unroll
        for (int ne = 0; ne < 4; ++ne) oacc[mt][ne] *= alpha;
#pragma unroll
        for (int ks = 0; ks < NJ / 2; ++ks) { pb[mt][ks][0] = cvtpk(sT[mt][2 * ks][0], sT[mt][2 * ks][1]); pb[mt][ks][1] = cvtpk(sT[mt][2 * ks][2], sT[mt][2 * ks][3]);
            pb[mt][ks][2] = cvtpk(sT[mt][2 * ks + 1][0], sT[mt][2 * ks + 1][1]); pb[mt][ks][3] = cvtpk(sT[mt][2 * ks + 1][2], sT[mt][2 * ks + 1][3]); }
    }
#pragma unroll
    for (int ks = 0; ks < NJ / 2; ++ks)
#pragma unroll
        for (int ne = 0; ne < 4; ++ne) { const int e = 16 * ne + r16, sw = (e >> 3) & 7;
            u32x4 vf_shared;
            if (SAMEKB) { const int blk = (kb[0] >> 3) + 4 * ks + (g4 >> 1); const u32x2 v0 = *(const u32x2*)(VT + e * AT_TS + ((blk ^ sw) << 3) + 4 * (g4 & 1)), v1 = *(const u32x2*)(VT + e * AT_TS + (((blk + 2) ^ sw) << 3) + 4 * (g4 & 1));
                vf_shared = (u32x4){v0.x, v0.y, v1.x, v1.y}; }
#pragma unroll
            for (int mt = 0; mt < MT; ++mt) { u32x4 vf = vf_shared;
                if (!SAMEKB) { const int blk = (kb[mt] >> 3) + 4 * ks + (g4 >> 1); const u32x2 v0 = *(const u32x2*)(VT + e * AT_TS + ((blk ^ sw) << 3) + 4 * (g4 & 1)), v1 = *(const u32x2*)(VT + e * AT_TS + (((blk + 2) ^ sw) << 3) + 4 * (g4 & 1));
                    vf = (u32x4){v0.x, v0.y, v1.x, v1.y}; }
                oacc[mt][ne] = MFMA16(__builtin_bit_cast(bf16x8_t, vf), __builtin_bit_cast(bf16x8_t, (u32x4){pb[mt][ks][0], pb[mt][ks][1], pb[mt][ks][2], pb[mt][ks][3]}), oacc[mt][ne]); } }
}
template <int KIND> DI void attn_item(Ctx& K, int idx, const float* sinkp, const float* rpbp) {
    constexpr int MT = KIND == 0 ? 3 : 2;
    int tid_ = K.tid; asm volatile("" : "+v"(tid_));
    const int lane_ = tid_ & 63, wave_ = tid_ >> 6;
    bf16_t* KT = (bf16_t*)(K.lds + ATL_K); bf16_t* VT = (bf16_t*)(K.lds + ATL_V); float* RPB = (float*)(K.lds + ATL_P);
    const int r16 = lane_ & 15, g4 = lane_ >> 4;
    int b, hk, qb = 0;
    if (KIND == 0) { qb = idx & 127; hk = (idx >> 7) & 1; b = idx >> 8; }
    else if (KIND == 1) { qb = idx & 63; hk = (idx >> 6) % 6; b = (idx >> 6) / 6; }
    else { hk = idx % 6; b = idx / 6; }
    const int kcol = (KIND == 0) ? C_SK + hk * 64 : (KIND == 2) ? C_SK + (hk / 3) * 64 : C_NK + hk * 64;
    const int vcol = (KIND == 0) ? C_SV + hk * 64 : (KIND == 2) ? C_SV + (hk / 3) * 64 : C_NV + hk * 64;
    int t0 = 0, nloc = 0;
    if (KIND == 0) { const int k0 = max(2 * qb - 2, 0), k1 = min(2 * qb + 3, L / 64 - 1); t0 = k0; nloc = k1 - k0 + 1; }
    if (KIND == 1) { const int k0 = min(max(4 * qb - 4, 0), L / 64 - 8), k1 = min(max(4 * qb + 3 - 4, 0), L / 64 - 8) + 7; t0 = k0; nloc = k1 - k0 + 1; }
    const int ntiles = nloc + CL / 64;
    int w_r = 0, w_rs = 0;
    if (KIND == 1) { w_r = 4 * qb + (wave_ >> 1); w_rs = min(max(w_r - 4, 0), L / 64 - 8); }
    bf16x8_t qf[MT][2]; int qbase[MT], hq_mt[MT], qrow[MT];
#pragma unroll
    for (int mt = 0; mt < MT; ++mt) {
        int arow, hq;
        if (KIND == 0) { const int rho = wave_ * 48 + mt * 16; hq = hk * 3 + rho / 128; hq_mt[mt] = hq; const int tb = 128 * qb + (rho & 127); arow = lat_row(b, tb + r16); qbase[mt] = tb; }
        else if (KIND == 1) { hq = hk; hq_mt[mt] = hq; const int cb = 32 * (wave_ & 1) + 16 * mt; arow = lat_row(b, w_r * 64 + cb + r16); qbase[mt] = cb; }
        else { hq = hk; hq_mt[mt] = hq; const int tb = wave_ * 32 + mt * 16; arow = ctx_row(b, tb + r16); qbase[mt] = 0; }
        qrow[mt] = arow;
        const int qcol = (KIND == 0 || KIND == 2) ? C_SQ + hq * 64 : C_NQ + hq * 64;
#pragma unroll
        for (int ks = 0; ks < 2; ++ks) { float q[8]; unpack8(*(const u32x4*)(K.P() + (size_t)arow * PW + qcol + 32 * ks + 8 * g4), q);
            const u32x4 w = (u32x4){pk2(q[0] * 0.125f, q[1] * 0.125f), pk2(q[2] * 0.125f, q[3] * 0.125f), pk2(q[4] * 0.125f, q[5] * 0.125f), pk2(q[6] * 0.125f, q[7] * 0.125f)};
            qf[mt][ks] = __builtin_bit_cast(bf16x8_t, w); }
    }
    f32x4 oacc[MT][4]; float mrun[MT], lrun[MT];
#pragma unroll
    for (int mt = 0; mt < MT; ++mt) {
#pragma unroll
        for (int ne = 0; ne < 4; ++ne) oacc[mt][ne] = (f32x4){0.f, 0.f, 0.f, 0.f};
        const bool has_sink = (KIND == 0 || KIND == 2);
        mrun[mt] = has_sink ? sinkp[hq_mt[mt]] : -1.0e30f; lrun[mt] = (has_sink && g4 == 0) ? 1.0f : 0.0f;
    }
    const int lkey = tid_ >> 3, lch = tid_ & 7;
    u32x4 pk_, pv_;
    { const int ti = 0; const int grow = (ti < nloc) ? lat_row(b, (t0 + ti) * 64 + lkey) : ctx_row(b, (ti - nloc) * 64 + lkey);
      const bf16_t* pr = K.P() + (size_t)grow * PW + 8 * lch; pk_ = *(const u32x4*)(pr + kcol); pv_ = *(const u32x4*)(pr + vcol); }
#pragma unroll 1
    for (int ti = 0; ti < ntiles; ++ti) {
        __syncthreads();
        *(u32x4*)(KT + lkey * AT_TS + 8 * lch) = pk_;
        { const unsigned w[4] = {pv_.x, pv_.y, pv_.z, pv_.w};
          const int vsw = (((lkey >> 3) ^ lch) << 3) + (lkey & 7);
#pragma unroll
          for (int j = 0; j < 4; ++j) { VT[(8 * lch + 2 * j) * AT_TS + vsw] = (bf16_t)(w[j] & 0xffffu); VT[(8 * lch + 2 * j + 1) * AT_TS + vsw] = (bf16_t)(w[j] >> 16); } }
        if (KIND == 1 && ti == 0 && tid_ < 15 * 31) RPB[tid_] = rpbp[tid_];
        __syncthreads();
        if (ti + 1 < ntiles) { const int tn = ti + 1; const int grow = (tn < nloc) ? lat_row(b, (t0 + tn) * 64 + lkey) : ctx_row(b, (tn - nloc) * 64 + lkey);
            const bf16_t* pr = K.P() + (size_t)grow * PW + 8 * lch; pk_ = *(const u32x4*)(pr + kcol); pv_ = *(const u32x4*)(pr + vcol); }
        const bool local = ti < nloc; const int kunit = t0 + ti;
        if (KIND == 1 && local) {
            if ((kunit >= w_rs) && (kunit < w_rs + 8)) {
                f32x4 sT[MT][2]; int kb[MT];
#pragma unroll
                for (int mt = 0; mt < MT; ++mt) { kb[mt] = min(max(qbase[mt] - 8, 0), 32);
#pragma unroll
                    for (int nj = 0; nj < 2; ++nj) { sT[mt][nj] = (f32x4){0.f, 0.f, 0.f, 0.f};
#pragma unroll
                        for (int ks = 0; ks < 2; ++ks) { const bf16x8_t kf = *(const bf16x8_t*)(KT + (kb[mt] + 16 * nj + r16) * AT_TS + 32 * ks + 8 * g4); sT[mt][nj] = MFMA16(kf, qf[mt][ks], sT[mt][nj]); } } }
                const float* rp = RPB + (kunit - w_r + 7) * 31 + 15;
#pragma unroll
                for (int mt = 0; mt < MT; ++mt) { const int c = qbase[mt] + r16, ws = min(max(c - 8, 0), 48);
#pragma unroll
                    for (int nj = 0; nj < 2; ++nj)
#pragma unroll
                        for (int rg = 0; rg < 4; ++rg) { const int key = kb[mt] + 16 * nj + 4 * g4 + rg; const bool ok = key >= ws && key < ws + 16;
                            sT[mt][nj][rg] = ok ? sT[mt][nj][rg] + rp[ok ? key - c : 0] : -INFINITY; } }
                at_softmax_pv<MT, 2, false>(sT, mrun, lrun, oacc, VT, kb, r16, g4);
            }
        } else {
            f32x4 sT[MT][4];
#pragma unroll
            for (int mt = 0; mt < MT; ++mt)
#pragma unroll
                for (int nj = 0; nj < 4; ++nj) sT[mt][nj] = (f32x4){0.f, 0.f, 0.f, 0.f};
#pragma unroll
            for (int nj = 0; nj < 4; ++nj)
#pragma unroll
                for (int ks = 0; ks < 2; ++ks) { const bf16x8_t kf = *(const bf16x8_t*)(KT + (16 * nj + r16) * AT_TS + 32 * ks + 8 * g4);
#pragma unroll
                    for (int mt = 0; mt < MT; ++mt) sT[mt][nj] = MFMA16(kf, qf[mt][ks], sT[mt][nj]); }
            if (KIND == 0 && local) {
#pragma unroll
                for (int mt = 0; mt < MT; ++mt) { const int dq = qbase[mt] + r16 - kunit * 64 - 4 * g4;
#pragma unroll
                    for (int nj = 0; nj < 4; ++nj)
#pragma unroll
                        for (int rg = 0; rg < 4; ++rg) { const int dl = dq - (16 * nj + rg); if (dl > 128 || dl < -128) sT[mt][nj][rg] = -INFINITY; } }
            }
            int kb0[MT];
#pragma unroll
            for (int mt = 0; mt < MT; ++mt) kb0[mt] = 0;
            at_softmax_pv<MT, 4, true>(sT, mrun, lrun, oacc, VT, kb0, r16, g4);
        }
    }
#pragma unroll
    for (int mt = 0; mt < MT; ++mt) {
        float l = lrun[mt]; l += __shfl_xor(l, 16); l += __shfl_xor(l, 32);
        const float inv = 1.0f / l;
        const int ocol = ((KIND == 0 || KIND == 2) ? MX_S : MX_N) + hq_mt[mt] * 64;
#pragma unroll
        for (int ne = 0; ne < 4; ++ne) { u32x2 o; o.x = cvtpk(oacc[mt][ne][0] * inv, oacc[mt][ne][1] * inv); o.y = cvtpk(oacc[mt][ne][2] * inv, oacc[mt][ne][3] * inv);
            *(u32x2*)(K.MIX() + (size_t)qrow[mt] * D + ocol + 16 * ne + 4 * g4) = o; }
    }
}
DI void ph_attn(Ctx& K) {
    constexpr int N_SWA = NB * 2 * (L / 128), N_NAT = NB * 6 * (L / 256), N_C = NB * 6;
    const float* sinkp = ARG(swa_sink) + K.l * 6;
    for (int item = K.bid; item < N_SWA + N_NAT + 2 * N_C; item += K.nb) {
        if (item < N_SWA) attn_item<0>(K, item, sinkp, nullptr);
        else if (item < N_SWA + N_NAT) { const int it = item - N_SWA; const int h = (it >> 6) % 6; attn_item<1>(K, it, nullptr, ARG(nat_rpb) + ((size_t)K.l * 6 + h) * 15 * 31); }
        else if (item < N_SWA + N_NAT + N_C) attn_item<2>(K, item - N_SWA - N_NAT, sinkp, nullptr);
        else attn_item<3>(K, item - N_SWA - N_NAT - N_C, nullptr, nullptr);
    }
}

DI unsigned fkey(float f) { const unsigned u = __float_as_uint(f); return (u & 0x80000000u) ? ~u : (u | 0x80000000u); }
DI int mbcnt64(unsigned long long m) { return (int)__builtin_amdgcn_mbcnt_hi((unsigned)(m >> 32), __builtin_amdgcn_mbcnt_lo((unsigned)m, 0u)); }
template <int NV> DI unsigned radix_thr16(const unsigned (&k)[NV]) {
    unsigned prefix = 0u;
#pragma unroll 1
    for (int bit = 31; bit >= 0; --bit) {
        const unsigned cand = prefix | (1u << bit); int cnt = 0;
#pragma unroll
        for (int i = 0; i < NV; ++i) cnt += __popcll(__ballot(k[i] >= cand));
        if (cnt >= 16) { prefix = cand; if (cnt == 16) break; }
    }
    return prefix;
}
template <int NC, int NV> DI void radix_thr16_multi(const unsigned (&k)[NC][NV], unsigned (&T)[NC]) {
    bool exact[NC];
#pragma unroll
    for (int c = 0; c < NC; ++c) { T[c] = 0u; exact[c] = false; }
#pragma unroll 1
    for (int bit = 31; bit >= 0; --bit) {
        bool all = true;
#pragma unroll
        for (int c = 0; c < NC; ++c) {
            const unsigned cand = T[c] | (1u << bit); int cnt = 0;
#pragma unroll
            for (int i = 0; i < NV; ++i) cnt += __popcll(__ballot(k[c][i] >= cand));
            if (cnt >= 16) { T[c] = cand; exact[c] = (cnt == 16); }
            all = all && exact[c];
        }
        if (all) break;
    }
}
template <int NV> DI void select16(const unsigned (&k)[NV], unsigned T, bool (&sel)[NV], int (&pos)[NV]) {
    int ngt = 0; unsigned long long gtm[NV], eqm[NV];
#pragma unroll
    for (int i = 0; i < NV; ++i) { gtm[i] = __ballot(k[i] > T); eqm[i] = __ballot(k[i] == T); ngt += __popcll(gtm[i]); }
    const int need = 16 - ngt; int eqbase = 0, selbase = 0;
#pragma unroll
    for (int i = 0; i < NV; ++i) {
        const bool iseq = k[i] == T; const int erank = eqbase + mbcnt64(eqm[i]); eqbase += __popcll(eqm[i]);
        sel[i] = (k[i] > T) || (iseq && erank < need);
        const unsigned long long sm = __ballot(sel[i]); pos[i] = selbase + mbcnt64(sm); selbase += __popcll(sm);
    }
}
template <int CTRL> DI int dppi_(int x) { return __builtin_amdgcn_mov_dpp(x, CTRL, 0xf, 0xf, true); }
DI int row_sum_i(int x) { x += dppi_<0xB1>(x); x += dppi_<0x4E>(x); x += dppi_<0x141>(x); x += dppi_<0x128>(x); return x; }
DI int row_excl_scan_i(int x) { int s_ = x; s_ += dppi_<0x111>(s_); s_ += dppi_<0x112>(s_); s_ += dppi_<0x114>(s_); s_ += dppi_<0x118>(s_); return s_ - x; }
DI unsigned row_minmax_u(unsigned x, bool want_max) {
    unsigned y;
    y = (unsigned)dppi_<0xB1>((int)x); x = want_max ? max(x, y) : min(x, y); y = (unsigned)dppi_<0x4E>((int)x); x = want_max ? max(x, y) : min(x, y);
    y = (unsigned)dppi_<0x141>((int)x); x = want_max ? max(x, y) : min(x, y); y = (unsigned)dppi_<0x128>((int)x); x = want_max ? max(x, y) : min(x, y);
    return x;
}
template <int NK> DI unsigned row_radix_thr16(const unsigned (&k)[NK]) {
    unsigned lm = k[0];
#pragma unroll
    for (int i = 1; i < NK; ++i) lm = max(lm, k[i]);
    unsigned lo = row_minmax_u(lm, false), hi = row_minmax_u(lm, true) + 1u;
    bool done = false;
#pragma unroll 1
    for (int itn = 0; itn < 40; ++itn) {
        const unsigned span = hi - lo; done = done || (span <= 1u);
        const unsigned mid = lo + (span >> 1); int cnt = 0;
#pragma unroll
        for (int i = 0; i < NK; ++i) cnt += (k[i] >= mid) ? 1 : 0;
        cnt = row_sum_i(cnt);
        const bool ge = cnt >= 16;
        if (!done) { if (ge) lo = mid; else hi = mid; }
        done = done || (cnt == 16);
        if (__ballot(!done) == 0ull) break;
    }
    return lo;
}
template <int NK> DI void row_select16(const unsigned (&k)[NK], unsigned T, bool (&sel)[NK], int (&pos)[NK]) {
    int g = 0, q = 0;
#pragma unroll
    for (int i = 0; i < NK; ++i) { g += (k[i] > T) ? 1 : 0; q += (k[i] == T) ? 1 : 0; }
    const int need = 16 - row_sum_i(g);
    const int a = min(max(need - row_excl_scan_i(q), 0), q);
    int nxt = row_excl_scan_i(g + a), eqs = 0;
#pragma unroll
    for (int i = 0; i < NK; ++i) { const bool iseq = k[i] == T; sel[i] = (k[i] > T) || (iseq && eqs < a); eqs += iseq ? 1 : 0; pos[i] = nxt; nxt += sel[i] ? 1 : 0; }
}
DI void ce_desc(unsigned& x, unsigned& y) { const unsigned hi = max(x, y), lo = min(x, y); x = hi; y = lo; }
DI void sort8_desc(unsigned (&a)[8]) {
    ce_desc(a[0], a[1]); ce_desc(a[2], a[3]); ce_desc(a[4], a[5]); ce_desc(a[6], a[7]); ce_desc(a[0], a[2]); ce_desc(a[1], a[3]); ce_desc(a[4], a[6]); ce_desc(a[5], a[7]);
    ce_desc(a[1], a[2]); ce_desc(a[5], a[6]); ce_desc(a[0], a[4]); ce_desc(a[3], a[7]); ce_desc(a[1], a[5]); ce_desc(a[2], a[6]); ce_desc(a[1], a[4]); ce_desc(a[3], a[6]);
    ce_desc(a[2], a[4]); ce_desc(a[3], a[5]); ce_desc(a[3], a[4]); }
DI void sort4_desc(unsigned (&a)[4]) { ce_desc(a[0], a[1]); ce_desc(a[2], a[3]); ce_desc(a[0], a[2]); ce_desc(a[1], a[3]); ce_desc(a[1], a[2]); }
DI float fkey_inv(unsigned k) { return __uint_as_float((k & 0x80000000u) ? (k & 0x7fffffffu) : ~k); }
DI void cex_(unsigned& k, int& ix, unsigned pk, int pi, bool lower) { const bool take = lower ? (pk > k) : (pk < k); k = take ? pk : k; ix = take ? pi : ix; }
template <int CTRL> DI void cex_dpp(unsigned& k, int& ix, bool lower) { const unsigned pk = (unsigned)dppi_<CTRL>((int)k); const int pi = dppi_<CTRL>(ix); cex_(k, ix, pk, pi, lower); }
DI void row_sort16_desc(unsigned& k, int& ix, int j16) {
    const bool l1 = (j16 & 1) == 0, l2 = (j16 & 2) == 0, l4 = (j16 & 4) == 0, l8 = (j16 & 8) == 0;
    cex_dpp<0xB1>(k, ix, l1);
    cex_dpp<0x1B>(k, ix, l2); cex_dpp<0xB1>(k, ix, l1);
    cex_dpp<0x141>(k, ix, l4); cex_dpp<0x4E>(k, ix, l2); cex_dpp<0xB1>(k, ix, l1);
    cex_dpp<0x140>(k, ix, l8);
    { const unsigned pk = (unsigned)__builtin_amdgcn_ds_swizzle((int)k, 0x101F); const int pi = __builtin_amdgcn_ds_swizzle(ix, 0x101F); cex_(k, ix, pk, pi, l4); }
    cex_dpp<0x4E>(k, ix, l2); cex_dpp<0xB1>(k, ix, l1);
}
constexpr int PSL_SK = 0, PSL_TOP = 131072;
static_assert(PSL_TOP + 8 * 1024 <= LDS_BYTES - 256, "peer select LDS map");
template <int PROBE> DI void ph_peer_select(Ctx& K) {
    float* TOPV = (float*)(K.lds + PSL_TOP + K.wave * 1024); int* TOPI = (int*)(TOPV + 128);
    const int r16 = K.lane & 15, g4 = K.lane >> 4, j16 = r16;
    const int nhg = K.nb < 8 ? K.nb : 8, grp = K.bid % nhg, jw = K.bid / nhg, nj = (K.nb - grp + nhg - 1) / nhg;
    constexpr int N_T = M / 16;
    const int nwv = nj * 8, wg = jw * 8 + K.wave;
    const int n_full = (N_T / nwv) * nwv, n_work = n_full + 4 * (N_T - n_full);
    for (int h = grp; h < 8; h += nhg) {
        __syncthreads();
        { const u32x4* sh = (const u32x4*)(K.SKH() + ((size_t)K.l * 8 + h) * 2 * 16384); const u32x4* sl = (const u32x4*)(K.SKL() + ((size_t)K.l * 8 + h) * 2 * 16384);
          u32x4* dst = (u32x4*)(K.lds + PSL_SK);
          u32x4 t[8];
#pragma unroll
          for (int i = 0; i < 8; ++i) t[i] = sh[K.tid + 512 * i];
#pragma unroll
          for (int i = 0; i < 8; ++i) dst[K.tid + 512 * i] = t[i];
#pragma unroll
          for (int i = 0; i < 8; ++i) t[i] = sl[K.tid + 512 * i];
#pragma unroll
          for (int i = 0; i < 8; ++i) dst[4096 + K.tid + 512 * i] = t[i]; }
        __syncthreads();
#pragma unroll 1
        for (int wk = wg; wk < n_work; wk += nwv) {
            const bool part = wk >= n_full; const int tile = part ? n_full + ((wk - n_full) >> 2) : wk; const int rg_lo = part ? ((wk - n_full) & 3) : 0, rg_hi = part ? rg_lo + 1 : 4;
            const int t0 = tile * 16;
            float S[2][8][4];
#pragma unroll
            for (int p = 0; p < 2; ++p) {
                bf16x8_t aq[4];
                { const bf16_t* qp = K.QP() + (size_t)(t0 + r16) * 2048 + h * 256 + p * 128 + 8 * g4;
#pragma unroll
                  for (int ks = 0; ks < 4; ++ks) aq[ks] = *(const bf16x8_t*)(qp + 32 * ks); }
                const unsigned char* kb = K.lds + PSL_SK + p * 32768 + K.lane * 16;
#pragma unroll
                for (int nt = 0; nt < 8; ++nt) {
                    f32x4 c0 = {0.f, 0.f, 0.f, 0.f}, c1 = c0;
#pragma unroll
                    for (int ks = 0; ks < 4; ++ks) { const bf16x8_t bh = *(const bf16x8_t*)(kb + (nt * 4 + ks) * 1024), bl = *(const bf16x8_t*)(kb + 65536 + (nt * 4 + ks) * 1024);
                        c0 = MFMA16(aq[ks], bh, c0); c1 = MFMA16(aq[ks], bl, c1); }
#pragma unroll
                    for (int rg = 0; rg < 4; ++rg) S[p][nt][rg] = c0[rg] + c1[rg];
                }
            }
            if (PROBE == 1) { float a = 0.f;
#pragma unroll
                for (int p = 0; p < 2; ++p)
#pragma unroll
                    for (int nt = 0; nt < 8; ++nt) a += S[p][nt][0] + S[p][nt][1] + S[p][nt][2] + S[p][nt][3];
                TOPV[K.lane] = a; continue; }
#pragma unroll 1
            for (int rg = 0; rg < 4; ++rg) {
                if (rg >= rg_lo && rg < rg_hi) {
                    unsigned a[2][8], mine[2] = {0u, 0u};
#pragma unroll
                    for (int p = 0; p < 2; ++p) {
#pragma unroll
                        for (int i = 0; i < 8; ++i) a[p][i] = (fkey(S[p][i][0]) & 0xFFFFFF80u) | (unsigned)(j16 + 16 * i);
                        sort8_desc(a[p]); }
#pragma unroll 1
                    for (int it = 0; it < 16; ++it) {
#pragma unroll
                        for (int p = 0; p < 2; ++p) { const unsigned m = row_minmax_u(a[p][0], true); const bool win = a[p][0] == m;
#pragma unroll
                            for (int i = 0; i < 7; ++i) a[p][i] = win ? a[p][i + 1] : a[p][i];
                            a[p][7] = win ? 0u : a[p][7];
                            mine[p] = (j16 == it) ? m : mine[p]; }
                    }
                    unsigned* TA = (unsigned*)TOPV + (g4 * 2) * 16; unsigned* TB = TA + 16;
                    TA[j16] = mine[0]; TB[j16] = mine[1];
                    asm volatile("s_waitcnt lgkmcnt(0)" ::: "memory");
                    { const int r = t0 + 4 * g4 + rg, t = j16;
                      int ci[4], cj[4];
                      ci[0] = 0; cj[0] = t;
                      ci[1] = t < 8 ? 1 : t; cj[1] = t < 8 ? t : 0;
                      ci[2] = t <= 4 ? 2 : t <= 8 ? 3 : t <= 11 ? 4 : t <= 13 ? 5 : 6; cj[2] = t <= 4 ? t : t <= 8 ? t - 5 : t <= 11 ? t - 9 : t <= 13 ? t - 12 : t - 14;
                      ci[3] = 7; cj[3] = t & 1;
                      unsigned c[4];
#pragma unroll
                      for (int q = 0; q < 4; ++q) { const float cv = fkey_inv(TA[ci[q]] & 0xFFFFFF80u) + fkey_inv(TB[cj[q]] & 0xFFFFFF80u); c[q] = (fkey(cv) & 0xFFFFFFC0u) | (unsigned)(t * 4 + q); }
                      if (t > 1) c[3] = 0u;
                      sort4_desc(c);
                      unsigned w = 0u;
#pragma unroll 1
                      for (int it = 0; it < 16; ++it) { const unsigned m = row_minmax_u(c[0], true); const bool win = c[0] == m;
                          c[0] = win ? c[1] : c[0]; c[1] = win ? c[2] : c[1]; c[2] = win ? c[3] : c[2]; c[3] = win ? 0u : c[3];
                          w = (j16 == it) ? m : w; }
                      const float val = fkey_inv(w & 0xFFFFFFC0u); const int tw = (int)(w >> 2) & 15, qw = (int)w & 3;
                      const int i2 = tw <= 4 ? 2 : tw <= 8 ? 3 : tw <= 11 ? 4 : tw <= 13 ? 5 : 6, j2 = tw <= 4 ? tw : tw <= 8 ? tw - 5 : tw <= 11 ? tw - 9 : tw <= 13 ? tw - 12 : tw - 14;
                      const int wi = qw == 0 ? 0 : qw == 1 ? (tw < 8 ? 1 : tw) : qw == 2 ? i2 : 7, wj = qw == 0 ? tw : qw == 1 ? (tw < 8 ? tw : 0) : qw == 2 ? j2 : (tw & 1);
                      const int e = (int)(TA[wi] & 127u) * 128 + (int)(TB[wj] & 127u);
                      const float mx = dpp_max16(val);
                      const float ex = __expf(val - mx), es = dpp_sum16(ex);
                      K.PIDX()[(size_t)r * 128 + h * 16 + j16] = e; K.PG()[(size_t)r * 128 + h * 16 + j16] = ex / es;
                    }
                    asm volatile("s_waitcnt lgkmcnt(0)" ::: "memory");
                }
#pragma unroll
                for (int p = 0; p < 2; ++p)
#pragma unroll
                    for (int i = 0; i < 8; ++i) { S[p][i][0] = S[p][i][1]; S[p][i][1] = S[p][i][2]; S[p][i][2] = S[p][i][3]; }
            }
        }
    }
}

constexpr int PU_NR = 4;
constexpr int PUL_H = 0, PUL_SLOT = 2 * PU_NR * 1024, PUL_STRIDE = PUL_SLOT + 256;
struct PuMeta { float hs[PU_NR]; int ia[PU_NR], ib[PU_NR]; };
DI void pu_load(const Ctx& K, int r0, int step, PuMeta& m, unsigned char* hbuf) {
    int rr[PU_NR];
#pragma unroll
    for (int q = 0; q < PU_NR; ++q) rr[q] = min(r0 + q * step, M - 1);
    __builtin_amdgcn_global_load_lds((const unsigned*)(K.H8() + (size_t)rr[0] * D + K.lane * 16), (LAS unsigned*)hbuf, 16, 0, 0);
    __builtin_amdgcn_global_load_lds((const unsigned*)(K.H8() + (size_t)rr[1] * D + K.lane * 16 - 1024), (LAS unsigned*)hbuf, 16, 1024, 0);
    __builtin_amdgcn_global_load_lds((const unsigned*)(K.H8() + (size_t)rr[2] * D + K.lane * 16 - 2048), (LAS unsigned*)hbuf, 16, 2048, 0);
    __builtin_amdgcn_global_load_lds((const unsigned*)(K.H8() + (size_t)rr[3] * D + K.lane * 16 - 3072), (LAS unsigned*)hbuf, 16, 3072, 0);
#pragma unroll
    for (int q = 0; q < PU_NR; ++q) { m.hs[q] = K.HS()[rr[q]]; m.ia[q] = K.PIDX()[(size_t)rr[q] * 128 + K.lane]; m.ib[q] = K.PIDX()[(size_t)rr[q] * 128 + 64 + K.lane]; }
}
typedef int i32x4 __attribute__((ext_vector_type(4)));
DI int sel4i(const i32x4 v, int k) { return k == 0 ? v[0] : k == 1 ? v[1] : k == 2 ? v[2] : v[3]; }
template <int PROBE> DI void pu_item(const Ctx& K, const unsigned char* U, unsigned char* HL, int* SLOT, int R, int r0, int step, const PuMeta& m, int r16, int g4, float& dummy) {
    bool sa[PU_NR], sb[PU_NR]; int ra[PU_NR], rb[PU_NR]; int n = 0;
#pragma unroll
    for (int q = 0; q < PU_NR; ++q) { const bool live = r0 + q * step < M; sa[q] = live && (m.ia[q] >> 11) == R; sb[q] = live && (m.ib[q] >> 11) == R; const unsigned long long ma = __ballot(sa[q]), mb = __ballot(sb[q]);
        ra[q] = n + mbcnt64(ma); n += __popcll(ma); rb[q] = n + mbcnt64(mb); n += __popcll(mb); }
    const int E = r16 >> 2, qq = r16 & 3, rho = r16 >> 2;
    const float hsm = rho == 0 ? m.hs[0] : rho == 1 ? m.hs[1] : rho == 2 ? m.hs[2] : m.hs[3];
#pragma unroll 1
    for (int base = 0; base < n; base += 32) {
#pragma unroll
        for (int q = 0; q < PU_NR; ++q) {
            if (sa[q] && ra[q] >= base && ra[q] < base + 32) { SLOT[2 * (ra[q] - base)] = m.ia[q]; SLOT[2 * (ra[q] - base) + 1] = q * 128 + K.lane; }
            if (sb[q] && rb[q] >= base && rb[q] < base + 32) { SLOT[2 * (rb[q] - base)] = m.ib[q]; SLOT[2 * (rb[q] - base) + 1] = q * 128 + 64 + K.lane; } }
        asm volatile("s_waitcnt lgkmcnt(0)" ::: "memory");
        const bool two = base + 16 < n;
        i32x4 av[8][4];
#pragma unroll
        for (int t = 0; t < 4; ++t) { const int sl = 4 * t + E; const int e = (base + sl < n) ? SLOT[2 * sl] : SLOT[0]; const unsigned char* up = U + (size_t)e * D + 64 * g4 + 16 * qq;
#pragma unroll
            for (int s_ = 0; s_ < 4; ++s_) av[t][s_] = *(const i32x4*)(up + 256 * s_); }
        if (two) {
#pragma unroll
            for (int t = 4; t < 8; ++t) { const int sl = 4 * t + E; const int e = (base + sl < n) ? SLOT[2 * sl] : SLOT[0]; const unsigned char* up = U + (size_t)e * D + 64 * g4 + 16 * qq;
#pragma unroll
                for (int s_ = 0; s_ < 4; ++s_) av[t][s_] = *(const i32x4*)(up + 256 * s_); } }
        bool fin[2]; int fcode[2]; float fus[2], fvs[2];
#pragma unroll
        for (int p2 = 0; p2 < 2; ++p2) { const int sl = 4 * (4 * p2 + qq) + g4; fin[p2] = false; fcode[p2] = 0; fus[p2] = 0.f; fvs[p2] = 0.f;
            if (base + sl < n) { const int code = SLOT[2 * sl + 1];
                if ((code >> 7) == rho) { const size_t eo = (size_t)K.l * 16384 + SLOT[2 * sl]; fin[p2] = true; fcode[p2] = code; fus[p2] = K.US()[eo]; fvs[p2] = K.VS()[eo]; } } }
        i32x4 hb[4];
#pragma unroll
        for (int s_ = 0; s_ < 4; ++s_) hb[s_] = *(const i32x4*)(HL + rho * 1024 + 64 * g4 + 16 * qq + 256 * s_);
        int w0, w1 = 0;
        { int rs[4];
#pragma unroll
          for (int t = 0; t < 4; ++t) { i32x4 acc = {0, 0, 0, 0};
#pragma unroll
              for (int s_ = 0; s_ < 4; ++s_) acc = __builtin_amdgcn_mfma_i32_16x16x64_i8(av[t][s_], hb[s_], acc, 0, 0, 0);
              int v = sel4i(acc, qq); v += dppi_<0xB1>(v); v += dppi_<0x4E>(v); rs[t] = v; }
          w0 = qq == 0 ? rs[0] : qq == 1 ? rs[1] : qq == 2 ? rs[2] : rs[3]; }
        if (two) { int rs[4];
#pragma unroll
            for (int t = 0; t < 4; ++t) { i32x4 acc = {0, 0, 0, 0};
#pragma unroll
                for (int s_ = 0; s_ < 4; ++s_) acc = __builtin_amdgcn_mfma_i32_16x16x64_i8(av[4 + t][s_], hb[s_], acc, 0, 0, 0);
                int v = sel4i(acc, qq); v += dppi_<0xB1>(v); v += dppi_<0x4E>(v); rs[t] = v; }
            w1 = qq == 0 ? rs[0] : qq == 1 ? rs[1] : qq == 2 ? rs[2] : rs[3]; }
#pragma unroll
        for (int p2 = 0; p2 < 2; ++p2) {
            const int di = p2 ? w1 : w0;
            if (fin[p2]) { const int code = fcode[p2];
                const float d = (float)di * fus[p2] * hsm;
                if (PROBE >= 2) dummy += gelu_erf(d);
                else (PROBE ? K.ST() : K.PA())[(size_t)(r0 + (code >> 7) * step) * 128 + (code & 127)] = gelu_erf(d) * fvs[p2]; }
        }
        asm volatile("s_waitcnt lgkmcnt(0)" ::: "memory");
    }
}
#define PU_TOUCH(m_) asm volatile("" :: "v"(m_.hs[0]), "v"(m_.hs[1]), "v"(m_.hs[2]), "v"(m_.hs[3]), "v"(m_.ia[0]), "v"(m_.ia[1]), "v"(m_.ia[2]), "v"(m_.ia[3]), "v"(m_.ib[0]), "v"(m_.ib[1]), "v"(m_.ib[2]), "v"(m_.ib[3]))
template <int PROBE> DI void ph_peer_u(Ctx& K) {
    const unsigned char* U = (const unsigned char*)K.UB() + (size_t)K.l * 16384 * D;
    unsigned char* HB = K.lds + K.wave * PUL_STRIDE; int* SLOT = (int*)(HB + PUL_SLOT);
    const int r16 = K.lane & 15, g4 = K.lane >> 4;
    const int step = K.nloc * NWAVES;
    float dummy = 0.f;
    for (int R = K.xg; R < 8; R += K.nxg) {
        int r = K.jx * NWAVES + K.wave; int par = 0;
        PuMeta mA, mB; (void)par;
        pu_load(K, r, step, mA, HB);
#pragma unroll 1
        for (; r < M; r += 2 * PU_NR * step) {
            asm volatile("s_waitcnt vmcnt(0)" ::: "memory");
            PU_TOUCH(mA);
            pu_load(K, r + PU_NR * step, step, mB, HB + PU_NR * 1024);
            pu_item<PROBE>(K, U, HB, SLOT, R, r, step, mA, r16, g4, dummy);
            asm volatile("s_waitcnt vmcnt(0)" ::: "memory");
            PU_TOUCH(mB);
            pu_load(K, r + 2 * PU_NR * step, step, mA, HB);
            pu_item<PROBE>(K, U, HB + PU_NR * 1024, SLOT, R, r + PU_NR * step, step, mB, r16, g4, dummy);
        }
    }
    if (PROBE >= 2) K.ST()[K.gw * 64 + K.lane] = dummy;
}
struct PvMeta { int ia, ib; float ga, gb, pa, pb; };
template <int PROBE> DI void pv_load(const Ctx& K, int r, PvMeta& m) {
    m.ia = K.PIDX()[(size_t)r * 128 + K.lane]; m.ib = K.PIDX()[(size_t)r * 128 + 64 + K.lane];
    m.ga = K.PG()[(size_t)r * 128 + K.lane]; m.pa = K.PA()[(size_t)r * 128 + K.lane]; m.gb = K.PG()[(size_t)r * 128 + 64 + K.lane]; m.pb = K.PA()[(size_t)r * 128 + 64 + K.lane];
}
template <int HALF, int PROBE> DI void pv_issue(const unsigned char* V, int slot, const PvMeta& m, u32x4 (&vv)[8]) {
    const int ix = HALF ? m.ib : m.ia;
#pragma unroll
    for (int i = 0; i < 8; ++i) {
        const int src = ((8 * i + slot) << 2);
        const int e = __builtin_amdgcn_ds_bpermute(src, ix);
        vv[i] = PROBE == 2 ? (u32x4){(unsigned)e, 1u, 2u, 3u} : *(const u32x4*)(V + (size_t)e * 128);
    }
}
DI void tr4x4(unsigned x0, unsigned x1, unsigned x2, unsigned x3, unsigned (&o)[4]) {
    const unsigned a = __builtin_amdgcn_perm(x1, x0, 0x05010400u), b = __builtin_amdgcn_perm(x1, x0, 0x07030602u), c = __builtin_amdgcn_perm(x3, x2, 0x05010400u), d = __builtin_amdgcn_perm(x3, x2, 0x07030602u);
    o[0] = __builtin_amdgcn_perm(c, a, 0x05040100u); o[1] = __builtin_amdgcn_perm(c, a, 0x07060302u); o[2] = __builtin_amdgcn_perm(d, b, 0x05040100u); o[3] = __builtin_amdgcn_perm(d, b, 0x07060302u);
}
DI unsigned u4(const u32x4& v, int d) { return d == 0 ? v.x : d == 1 ? v.y : d == 2 ? v.z : v.w; }
DI float pv_weights(const PvMeta& m, unsigned char* WQ, int lane) {
    const float wa = m.ga * m.pa, wb = m.gb * m.pb;
    float mx = fmaxf(fabsf(wa), fabsf(wb));
    mx = dpp_max16(mx); mx = fmaxf(mx, __shfl_xor(mx, 16)); mx = fmaxf(mx, __shfl_xor(mx, 32));
    const float s_hi = fmaxf(mx, 1e-30f) * (1.0f / 127.0f), i_hi = 1.0f / s_hi, s_lo = s_hi * (1.0f / 254.0f), i_lo = 254.0f * i_hi;
    const float ha = rintf(wa * i_hi), hb = rintf(wb * i_hi);
    const int la = (int)rintf((wa - ha * s_hi) * i_lo), lb = (int)rintf((wb - hb * s_hi) * i_lo);
    const int i = lane >> 3, sl = lane & 7; unsigned char* wp = WQ + (((sl & 1) * 4 + (sl >> 1)) << 4) + i;
    wp[0] = (unsigned char)(int)ha; wp[8] = (unsigned char)(int)hb; wp[128] = (unsigned char)la; wp[136] = (unsigned char)lb;
    return s_lo;
}
template <int PROBE> DI void ph_peer_v(Ctx& K) {
    const int slot = K.lane >> 3, c = K.lane & 7;
    const float* gate = K.MOD() + (size_t)K.l * 3 * 6 * D + 5 * D;
    const int step = K.nloc * NWAVES;
    float* Xb = PROBE ? (float*)K.P() : K.X();
    unsigned char* WQ = K.lds + K.wave * 256;
    for (int S = K.xg; S < 8; S += K.nxg) {
        const unsigned char* V = (const unsigned char*)K.VB() + ((size_t)K.l * 8 + S) * 16384 * 128 + c * 16;
        const int c0 = S * 128 + c * 16;
        const int r0 = K.jx * NWAVES + K.wave;
        const int nit = r0 < M ? (M - 1 - r0) / step + 1 : 0;
        PvMeta mA, mB; pv_load<PROBE>(K, min(r0, M - 1), mA); pv_load<PROBE>(K, min(r0 + step, M - 1), mB);
        f32x4 xq[4], xprev[4], x2[4], gp[4]; float yp[16]; int rp = -1, mvp = -1; PvMeta m2;
#pragma unroll
        for (int q = 0; q < 4; ++q) { xq[q] = *(const f32x4*)(Xb + (size_t)min(r0, M - 1) * D + c0 + 4 * q); xprev[q] = (f32x4){0.f, 0.f, 0.f, 0.f}; gp[q] = xprev[q]; }
#pragma unroll
        for (int q = 0; q < 16; ++q) yp[q] = 0.f;
#define PV_BODY(XPREV, XQ, XNEW, MA, MC, IT) do { \
            const int r = r0 + (IT) * step; \
            if (rp >= 0) { const int mv = modvec_of_row(rp); \
                if (mv != mvp) { mvp = mv; \
                    _Pragma("unroll") for (int q = 0; q < 4; ++q) gp[q] = *(const f32x4*)(gate + (size_t)mv * 6 * D + c0 + 4 * q); } } \
            { const float zdep = MA.ga * 0.0f; \
                _Pragma("unroll") for (int q = 0; q < 4; ++q) { XPREV[q].x += gp[q].x * yp[4 * q] + zdep; XPREV[q].y += gp[q].y * yp[4 * q + 1] + zdep; XPREV[q].z += gp[q].z * yp[4 * q + 2] + zdep; XPREV[q].w += gp[q].w * yp[4 * q + 3] + zdep; } \
                if (rp >= 0 && slot == 0) { float* xr = Xb + (size_t)rp * D + c0; \
                    _Pragma("unroll") for (int q = 0; q < 4; ++q) *(f32x4*)(xr + 4 * q) = XPREV[q]; } } \
            __builtin_amdgcn_sched_barrier(0); \
            const float s_lo = pv_weights(MA, WQ, K.lane); \
            u32x4 vA[8], vB[8]; \
            pv_issue<0, PROBE>(V, slot, MA, vA); \
            pv_issue<1, PROBE>(V, slot, MA, vB); \
            __builtin_amdgcn_sched_barrier(0); \
            { const float* xr = Xb + (size_t)min(r + step, M - 1) * D + c0; \
              _Pragma("unroll") for (int q = 0; q < 4; ++q) XNEW[q] = *(const f32x4*)(xr + 4 * q); } \
            pv_load<PROBE>(K, min(r + 2 * step, M - 1), MC); \
            __builtin_amdgcn_sched_barrier(0); \
            const i32x4 wq = *(const i32x4*)(WQ + ((((K.lane & 3) << 2) + (K.lane >> 4)) << 4)); \
            _Pragma("unroll") for (int d = 0; d < 4; ++d) { unsigned t0[4], t1[4], t2[4], t3[4]; \
                tr4x4(u4(vA[0], d), u4(vA[1], d), u4(vA[2], d), u4(vA[3], d), t0); tr4x4(u4(vA[4], d), u4(vA[5], d), u4(vA[6], d), u4(vA[7], d), t1); \
                tr4x4(u4(vB[0], d), u4(vB[1], d), u4(vB[2], d), u4(vB[3], d), t2); tr4x4(u4(vB[4], d), u4(vB[5], d), u4(vB[6], d), u4(vB[7], d), t3); \
                _Pragma("unroll") for (int bb = 0; bb < 4; ++bb) { const i32x4 bj = {(int)t0[bb], (int)t1[bb], (int)t2[bb], (int)t3[bb]}; \
                    const i32x4 dd = __builtin_amdgcn_mfma_i32_16x16x64_i8(wq, bj, (i32x4){0, 0, 0, 0}, 0, 0, 0); \
                    int tt = (K.lane & 8) ? dd[1] * 254 + dd[3] : dd[0] * 254 + dd[2]; tt += dppi_<0x128>(tt); \
                    yp[4 * d + bb] = (float)tt * s_lo; } } \
            rp = r; } while (0)
        f32x4 (*xfin)[4] = nullptr; (void)xfin;
        int it = 0;
#pragma unroll 1
        for (; it + 2 < nit; it += 3) {
            PV_BODY(xprev, xq, x2, mA, m2, it);
            PV_BODY(xq, x2, xprev, mB, mA, it + 1);
            PV_BODY(x2, xprev, xq, m2, mB, it + 2);
        }
        if (it < nit) { PV_BODY(xprev, xq, x2, mA, m2, it); ++it;
            if (it < nit) { PV_BODY(xq, x2, xprev, mB, mA, it); ++it;
#pragma unroll
                for (int q = 0; q < 4; ++q) xprev[q] = x2[q]; }
            else {
#pragma unroll
                for (int q = 0; q < 4; ++q) xprev[q] = xq[q]; } }
#undef PV_BODY
        if (rp >= 0) { const int mv = modvec_of_row(rp);
#pragma unroll
            for (int q = 0; q < 4; ++q) gp[q] = *(const f32x4*)(gate + (size_t)mv * 6 * D + c0 + 4 * q);
            if (slot == 0) { float* xr = Xb + (size_t)rp * D + c0;
#pragma unroll
                for (int q = 0; q < 4; ++q) { f32x4 x = xprev[q];
                    x.x += gp[q].x * yp[4 * q]; x.y += gp[q].y * yp[4 * q + 1]; x.z += gp[q].z * yp[4 * q + 2]; x.w += gp[q].w * yp[4 * q + 3]; *(f32x4*)(xr + 4 * q) = x; } } }
    }
}

DI void ph_final(Ctx& K) {
    for (int r = K.gw; r < NLAT; r += K.ngw) {
        const f32x4* xr = (const f32x4*)(K.X() + (size_t)(NCTX + r) * D); f32x4* o = (f32x4*)(((float*)argp_<float>(K, (unsigned)__builtin_offsetof(Args, out))) + (size_t)r * D);
        f32x4 v[4]; float ss = 0.f;
#pragma unroll
        for (int j = 0; j < 4; ++j) { v[j] = xr[j * 64 + K.lane]; ss += v[j].x * v[j].x + v[j].y * v[j].y + v[j].z * v[j].z + v[j].w * v[j].w; }
        ss = wave_sum(ss); const float rs = rsqrtf(ss * (1.0f / D) + EPS);
#pragma unroll
        for (int j = 0; j < 4; ++j) { const f32x4 w = ((const f32x4*)ARG(final_norm_w))[j * 64 + K.lane]; o[j * 64 + K.lane] = v[j] * rs * w; }
    }
}

#define XB_TMO      128
#define XB_XSUB(j)  (1280 + 64 * (j))
#define XB_XGEN(j)  (2304 + 64 * (j))
#define XB_TOP      3328
#define XB_TOPGEN   3392
#define XB_SPIN_CAP (1u << 22)
constexpr int CW_BAR = 4096;
DI unsigned xb_ld(unsigned* p)              { return __hip_atomic_load(p, __ATOMIC_RELAXED, __HIP_MEMORY_SCOPE_AGENT); }
DI unsigned xb_add(unsigned* p, unsigned v) { return __hip_atomic_fetch_add(p, v, __ATOMIC_RELAXED, __HIP_MEMORY_SCOPE_AGENT); }
#define XB_SPIN(cond, bar) do { unsigned _sp = 0; while (cond) { __builtin_amdgcn_s_sleep(1); \
    if ((++_sp & 255u) == 0u) { if (xb_ld(&(bar)[XB_TMO])) break; if (_sp > XB_SPIN_CAP) { atomicAdd(&(bar)[XB_TMO], 1u); break; } } } } while (0)
DI void xcd_barrier(unsigned* bar, unsigned x, unsigned nloc, unsigned nx, int tid) {
    asm volatile("s_waitcnt vmcnt(0)" ::: "memory");
    __syncthreads();
    if (tid == 0) {
        __builtin_amdgcn_s_waitcnt(0);
        const unsigned old = xb_add(&bar[XB_XSUB(x)], 1u);
        const unsigned gen = old / nloc;
        if (old + 1u == (gen + 1u) * nloc) {
            __builtin_amdgcn_fence(__ATOMIC_RELEASE, "agent");
            asm volatile("s_waitcnt vmcnt(0)" ::: "memory");
            const unsigned og = xb_add(&bar[XB_TOP], 1u);
            const unsigned tg = og / nx;
            if (og + 1u == (tg + 1u) * nx) xb_add(&bar[XB_TOPGEN], 1u);
            else XB_SPIN(xb_ld(&bar[XB_TOPGEN]) == tg, bar);
            __builtin_amdgcn_fence(__ATOMIC_ACQUIRE, "agent");
            xb_add(&bar[XB_XGEN(x)], 1u);
            asm volatile("s_waitcnt vmcnt(0)" ::: "memory");
        } else {
            XB_SPIN(xb_ld(&bar[XB_XGEN(x)]) == gen, bar);
            __builtin_amdgcn_fence(__ATOMIC_ACQUIRE, "agent");
            asm volatile("s_waitcnt vmcnt(0)" ::: "memory");
        }
    }
    __syncthreads();
}

constexpr int PROBE_U = 0, PROBE_V = 0, PROBE_S = 0;
constexpr unsigned DUP_MASK = 0u;
constexpr int PH_PER_LAYER = 12, N_PHASES = 2 + PH_PER_LAYER * DEPTH;
__global__ void __launch_bounds__(NTHREADS) mk_fwd(Args args) {
    extern __shared__ __attribute__((aligned(16))) unsigned char lds[];
    cg::grid_group grid = cg::this_grid();
    constexpr unsigned ARGS_OFF = LDS_BYTES - 256;
    constexpr unsigned MISC_OFF = LDS_BYTES - 64;
    if (threadIdx.x == 0) {
        *(Args*)(lds + ARGS_OFF) = args;
        unsigned* ctl = (unsigned*)(args.ws + WS_CTL); unsigned* misc = (unsigned*)(lds + MISC_OFF);
        const unsigned xcc = (unsigned)__builtin_amdgcn_s_getreg((3 << 11) | 20) & 0xFu;
        misc[0] = xcc; misc[1] = __hip_atomic_fetch_add(ctl + 64 * xcc, 1u, __ATOMIC_RELAXED, __HIP_MEMORY_SCOPE_AGENT);
    }
    __syncthreads();
    const int wid_s = __builtin_amdgcn_readfirstlane((int)threadIdx.x >> 6);
    int rep = 0;
#pragma unroll 1
    for (int ph = 0; ph < N_PHASES; ++ph) {
        unsigned ones = ~0u; asm volatile("" : "+s"(ones));
        int tid = (wid_s << 6) | (int)__builtin_amdgcn_mbcnt_hi(ones, __builtin_amdgcn_mbcnt_lo(ones, 0u)); asm volatile("" : "+v"(tid));
        unsigned aoff = ARGS_OFF; asm volatile("" : "+v"(aoff));
        size_t zoff = 0; asm volatile("" : "+s"(zoff));
        unsigned char* ws = args.ws + zoff;
        int bid = blockIdx.x; asm volatile("" : "+s"(bid)); int nb = gridDim.x; asm volatile("" : "+s"(nb));
        unsigned moff = MISC_OFF; asm volatile("" : "+v"(moff));
        Ctx K; unsigned xcc_s; { const unsigned* misc = (const unsigned*)(lds + moff); xcc_s = __builtin_amdgcn_readfirstlane(misc[0]); K.jx = __builtin_amdgcn_readfirstlane(misc[1]); K.xg = __builtin_amdgcn_readfirstlane(misc[2]); K.nxg = __builtin_amdgcn_readfirstlane(misc[3]); K.nloc = __builtin_amdgcn_readfirstlane(misc[4]); }
        K.aoff = aoff; K.lds = lds; K.tid = tid; K.lane = tid & 63; K.wave = tid >> 6; K.bid = bid; K.nb = nb; K.gw = bid * NWAVES + K.wave; K.ngw = nb * NWAVES;
        K.ws = ws;
        const int l = ph == 0 ? 0 : (ph - 1) / PH_PER_LAYER, k = ph == 0 ? -1 : (ph == N_PHASES - 1 ? -2 : (ph - 1) % PH_PER_LAYER);
        K.l = l;
        if (k == -1) ph_prologue(K);
        else if (k == -2) ph_final(K);
        else if (k == 0) ph_norm(K, ARG(norm_mix_w) + (size_t)l * D, 0);
        else if (k == 1) ph_gemm_store(K, K.H(), K.WIN() + (size_t)l * PW * D, PW, K.P(), K.ROPE());
        else if (k == 2) ph_hgrn_A(K);
        else if (k == 3) ph_attn(K);
        else if (k == 4) ph_hgrn_B(K);
        else if (k == 5) ph_hgrn_C(K);
        else if (k == 6) ph_gemm_resid(K, K.MIX(), K.WOUT() + (size_t)l * D * D, 2);
        else if (k == 7) ph_norm(K, ARG(norm_ffn_w) + (size_t)l * D, 3);
        else if (k == 8) ph_gemm_store(K, K.H(), K.WQ() + (size_t)l * 2048 * D, 2048, K.QP(), nullptr);
        else if (k == 9) { ph_peer_select<0>(K); if (PROBE_S) ph_peer_select<PROBE_S>(K); }
        else if (k == 10) { ph_peer_u<0>(K); if (PROBE_U) ph_peer_u<PROBE_U>(K); }
        else if (k == 11) { ph_peer_v<0>(K); if (PROBE_V) ph_peer_v<PROBE_V>(K); }
        if (k >= 0 && ((DUP_MASK >> k) & 1u)) { ++rep; if (rep < 2) { --ph; continue; } } rep = 0;
        if (ph == 0) grid.sync();
        else if (k != 2 && ph != N_PHASES - 1) xcd_barrier((unsigned*)(args.ws + WS_CTL) + CW_BAR, xcc_s, (unsigned)K.nloc, (unsigned)K.nxg, tid);
        if (ph == 0) {
            if (tid == 0) { unsigned* ctl = (unsigned*)(args.ws + WS_CTL); unsigned* misc = (unsigned*)(lds + MISC_OFF); const unsigned xcc = misc[0]; unsigned ord = 0, npop = 0, mine = 1;
                for (unsigned q = 0; q < 16; ++q) { const unsigned cq = __hip_atomic_load(ctl + 64 * q, __ATOMIC_RELAXED, __HIP_MEMORY_SCOPE_AGENT); if (cq) { ++npop; if (q < xcc) ++ord; } if (q == xcc) mine = cq; }
                misc[2] = ord; misc[3] = npop ? npop : 1u; misc[4] = mine ? mine : 1u; }
            __syncthreads();
        }
    }
}

extern "C" void kernel_launch(void* const* d_in, const int* in_sizes, int n_in, void* d_out, int out_size, void* d_ws, size_t ws_size, hipStream_t stream) {
    static int grid = 0;
    if (grid == 0) {
        if (n_in != 19 || out_size != NLAT * D || ws_size < WS_END) { fprintf(stderr, "kernel_launch: unexpected shapes (n_in %d out %d ws %zu need %zu)\n", n_in, out_size, ws_size, (size_t)WS_END); grid = -1; return; }
        int dev = 0, cus = 0, per_cu = 0;
        (void)hipGetDevice(&dev); (void)hipDeviceGetAttribute(&cus, hipDeviceAttributeMultiprocessorCount, dev);
        (void)hipFuncSetAttribute((const void*)mk_fwd, hipFuncAttributeMaxDynamicSharedMemorySize, LDS_BYTES);
        (void)hipOccupancyMaxActiveBlocksPerMultiprocessor(&per_cu, (const void*)mk_fwd, NTHREADS, LDS_BYTES);
        if (per_cu < 1) { fprintf(stderr, "kernel_launch: occupancy query says %d blocks/CU\n", per_cu); grid = -1; return; }
        grid = (cus / 8) * 8;
    }
    if (grid < 0) return;
    Args a{};
    a.x = (const float*)d_in[0]; a.c = (const float*)d_in[1]; a.ctx = (const float*)d_in[2]; a.c_ctx = (const float*)d_in[3]; a.w_mod = (const float*)d_in[4]; a.b_mod = (const float*)d_in[5];
    a.norm_mix_w = (const float*)d_in[6]; a.norm_ffn_w = (const float*)d_in[7]; a.w_in = (const float*)d_in[8]; a.lb_logits = (const float*)d_in[9]; a.hgrn_norm_w = (const float*)d_in[10];
    a.swa_sink = (const float*)d_in[11]; a.nat_rpb = (const float*)d_in[12]; a.w_out = (const float*)d_in[13]; a.peer_wq = (const float*)d_in[14]; a.peer_sk = (const float*)d_in[15];
    a.peer_u = (const float*)d_in[16]; a.peer_v = (const float*)d_in[17]; a.final_norm_w = (const float*)d_in[18];
    a.out = (float*)d_out; a.ws = (unsigned char*)d_ws;
    (void)hipMemsetAsync((unsigned char*)d_ws + WS_CTL, 0, CTL_BYTES, stream);
    void* kargs[] = {&a};
    hipError_t e = hipLaunchCooperativeKernel((const void*)mk_fwd, dim3(grid), dim3(NTHREADS), kargs, LDS_BYTES, stream);
    if (e != hipSuccess) fprintf(stderr, "kernel_launch: cooperative launch failed: %s (grid %d)\n", hipGetErrorString(e), grid);
}
```

```cpp
#include <hip/hip_runtime.h>
#include <hip/hip_cooperative_groups.h>
#include <cstdio>
#include <cstdint>
namespace cg = cooperative_groups;
#define DI __device__ __forceinline__
#define GP(T, p) ((T*)(__attribute__((address_space(1))) T*)(p))

typedef unsigned short bf16_t;
typedef float f32x4 __attribute__((ext_vector_type(4)));
typedef unsigned u32x4 __attribute__((ext_vector_type(4)));
typedef unsigned u32x2 __attribute__((ext_vector_type(2)));

constexpr int D = 1024, NB = 2, L = 16384, CL = 256, DEPTH = 4;
constexpr int NCTX = NB * CL, NLAT = NB * L, M = NCTX + NLAT;
constexpr int PW = 3072;
constexpr int C_HQ = 0, C_ZF = 256, C_ZB = 512, C_HV = 768, C_HG = 1024, C_SQ = 1280, C_SK = 1664, C_SV = 1792, C_NQ = 1920, C_NK = 2304, C_NV = 2688;
constexpr int MX_H = 0, MX_S = 256, MX_N = 640;
constexpr float EPS = 1e-6f;
constexpr int NTHREADS = 512, NWAVES = 8;
constexpr int LDS_BYTES = 163840;

constexpr size_t al256(size_t x) { return (x + 255) & ~(size_t)255; }
constexpr size_t WS_X = 0;
constexpr size_t WS_H = WS_X + al256((size_t)M * D * 4);
constexpr size_t WS_P = WS_H + al256((size_t)M * D * 2);
constexpr size_t WS_MIX = WS_P + al256((size_t)M * PW * 2);
constexpr size_t WS_OF = WS_MIX + al256((size_t)M * D * 2);
constexpr size_t WS_OB = WS_OF + al256((size_t)M * 256 * 4);
constexpr size_t WS_PIDX = WS_OB + al256((size_t)M * 256 * 4);
constexpr size_t WS_PG = WS_PIDX + al256((size_t)M * 128 * 4);
constexpr size_t WS_MOD = WS_PG + al256((size_t)M * 128 * 4);
constexpr size_t WS_LB = WS_MOD + al256((size_t)DEPTH * 3 * 6 * D * 4);
constexpr size_t WS_ROPE = WS_LB + al256((size_t)2 * DEPTH * 256 * 4);
constexpr size_t WS_WIN = WS_ROPE + al256((size_t)(256 + 256 + 64 + 64) * 16 * 4);
constexpr size_t WS_WOUT = WS_WIN + al256((size_t)DEPTH * PW * D * 2);
constexpr size_t WS_WQ = WS_WOUT + al256((size_t)DEPTH * D * D * 2);
constexpr size_t WS_AC = WS_WQ + al256((size_t)DEPTH * 2048 * D * 2);
constexpr size_t WS_UB_ = 0; constexpr size_t WS_UB = WS_AC + al256((size_t)16 * 260 * 64 * 4); constexpr size_t WS_UB_OLD = WS_WQ + al256((size_t)DEPTH * 2048 * D * 2);
constexpr size_t WS_VB = WS_UB + al256((size_t)DEPTH * 16384 * D * 2);
constexpr size_t WS_PA = WS_VB + al256((size_t)DEPTH * 16384 * D * 2);
constexpr size_t WS_VS = WS_PA + al256((size_t)M * 128 * 4);
constexpr size_t WS_US = WS_VS + al256((size_t)DEPTH * 16384 * 4);
constexpr size_t WS_H8 = WS_US + al256((size_t)DEPTH * 16384 * 4);
constexpr size_t WS_HS = WS_H8 + al256((size_t)M * D);
constexpr size_t WS_SKH = WS_HS + al256((size_t)M * 4);
constexpr size_t WS_SKL = WS_SKH + al256((size_t)DEPTH * 8 * 2 * 128 * 128 * 2);
constexpr size_t WS_CTL = WS_SKL + al256((size_t)DEPTH * 8 * 2 * 128 * 128 * 2);
constexpr size_t CTL_BYTES = 65536;
constexpr size_t WS_END = WS_CTL + CTL_BYTES;

struct Args {
    const float *x, *c, *ctx, *c_ctx, *w_mod, *b_mod, *norm_mix_w, *norm_ffn_w, *w_in, *lb_logits, *hgrn_norm_w, *swa_sink, *nat_rpb, *w_out, *peer_wq, *peer_sk, *peer_u, *peer_v, *final_norm_w;
    float* out; unsigned char* ws;
};

DI float bf2f(bf16_t v) { return __uint_as_float((unsigned)v << 16); }
DI bf16_t f2bf(float f) { unsigned u = __float_as_uint(f); return (bf16_t)((u + 0x7fffu + ((u >> 16) & 1u)) >> 16); }
DI unsigned pk2(float lo, float hi) { return (unsigned)f2bf(lo) | ((unsigned)f2bf(hi) << 16); }
DI float wave_sum(float v) {
#pragma unroll
    for (int o = 1; o < 64; o <<= 1) v += __shfl_xor(v, o);
    return v;
}
typedef __bf16 bf16x2_t __attribute__((ext_vector_type(2)));
DI float dot2bf(unsigned a, unsigned b, float acc) { return __builtin_amdgcn_fdot2_f32_bf16(__builtin_bit_cast(bf16x2_t, a), __builtin_bit_cast(bf16x2_t, b), acc, false); }
template <int CTRL> DI float dpp_(float x) { return __builtin_bit_cast(float, __builtin_amdgcn_mov_dpp(__builtin_bit_cast(int, x), CTRL, 0xf, 0xf, true)); }
DI float wave_sum_fast(float x) {
    x += dpp_<0xB1>(x); x += dpp_<0x4E>(x); x += dpp_<0x141>(x); x += dpp_<0x128>(x);
    auto s1 = __builtin_amdgcn_permlane16_swap(__float_as_uint(x), __float_as_uint(x), false, false); x = __uint_as_float(s1[0]) + __uint_as_float(s1[1]);
    auto s2 = __builtin_amdgcn_permlane32_swap(__float_as_uint(x), __float_as_uint(x), false, false); return __uint_as_float(s2[0]) + __uint_as_float(s2[1]);
}
DI float sigmoidf_(float z) { return 1.0f / (1.0f + __expf(-z)); }
DI float gelu_erf(float v) { return 0.5f * v * (1.0f + erff(v * 0.70710678118654752f)); }
DI int modvec_of_row(int r) { return r < NCTX ? 2 : (r - NCTX) / L; }
DI int batch_of_row(int r) { return r < NCTX ? r / CL : (r - NCTX) / L; }
DI int lat_row(int b, int t) { return NCTX + b * L + t; }
DI int ctx_row(int b, int s) { return b * CL + s; }
DI void unpack8(const u32x4 w, float* o) {
    o[0] = __uint_as_float(w.x << 16); o[1] = __uint_as_float(w.x & 0xffff0000u);
    o[2] = __uint_as_float(w.y << 16); o[3] = __uint_as_float(w.y & 0xffff0000u);
    o[4] = __uint_as_float(w.z << 16); o[5] = __uint_as_float(w.z & 0xffff0000u);
    o[6] = __uint_as_float(w.w << 16); o[7] = __uint_as_float(w.w & 0xffff0000u);
}
DI void load_row64(const bf16_t* p, float (&o)[64]) {
#pragma unroll
    for (int i = 0; i < 8; ++i) { const u32x4 w = *(const u32x4*)(p + 8 * i); unpack8(w, &o[8 * i]); }
}
DI void rope64(float (&x)[64], const float* cr, const float* sr, const float* cc, const float* sc) {
#pragma unroll
    for (int i = 0; i < 16; ++i) {
        const float c1 = cr[i], s1 = sr[i], a = x[i], b = x[16 + i];
        x[i] = a * c1 - b * s1; x[16 + i] = b * c1 + a * s1;
        const float c2 = cc[i], s2 = sc[i], e = x[32 + i], f = x[48 + i];
        x[32 + i] = e * c2 - f * s2; x[48 + i] = f * c2 + e * s2;
    }
}

namespace pg8 {
#define PG8_LAS __attribute__((address_space(3)))
typedef unsigned short bf16_t;
typedef short bf16x8 __attribute__((ext_vector_type(8)));
typedef float f32x4 __attribute__((ext_vector_type(4)));
typedef unsigned u32x4 __attribute__((ext_vector_type(4)));
constexpr int BM = 256, BK = 64, HALF = 128, HTB = HALF * BK * 2  , STAGE_BYTES = 8 * HTB, NXCD = 8, WGM = 8;

__host__ __device__ __forceinline__ int lds_byte(int r, int c) { const int st = (r >> 4) * 2 + (c >> 5), rr = r & 15, cc = c & 31, ob = rr * 64 + cc * 2; return st * 1024 + (ob ^ (((ob >> 9) & 1) << 5)); }
__host__ __device__ __forceinline__ void stage_rc(int b, int& R, int& C) { const int st = b / 1024, sb = b % 1024, swz = sb ^ (((sb >> 9) & 1) << 5); R = (st >> 1) * 16 + swz / 64; C = (st & 1) * 32 + (swz % 64) / 2; }
__host__ __device__ __forceinline__ int perm32(int rho) { const int n = rho >> 4, i = rho & 15; return 8 * (i >> 2) + 4 * n + (i & 3); }

struct Unit { int pm, pn; };
struct Gemm { const bf16_t* A; const bf16_t* Bt; int M, N, K; };

struct StaticOrder {
    int nM, nN, nwg, G, c;
    __host__ __device__ void init(int M, int N, int G_, int c_) { nM = M / BM; nN = N / BM; nwg = nM * nN; G = G_; c = c_; }
    __host__ __device__ bool next(int i, Unit& u) const {
        const long L = (long)i * G + c; if (L >= nwg) return false;
        int wgid = (int)L; { const int q = nwg / NXCD, r = nwg % NXCD, xcd = wgid % NXCD, off = wgid / NXCD; wgid = (xcd < r ? xcd * (q + 1) : r * (q + 1) + (xcd - r) * q) + off; }
        const int nig = WGM * nN, gid = wgid / nig, fm = gid * WGM, gsz = (nM - fm) < WGM ? (nM - fm) : WGM;
        u.pm = fm + ((wgid % nig) % gsz); u.pn = (wgid % nig) / gsz; return true;
    }
    __device__ __forceinline__ void a_ready(const Unit&) const {}
    __device__ __forceinline__ void done(const Unit&) const {}
};


__device__ __forceinline__ unsigned cvt_pk_bf16(float lo, float hi) { unsigned r; asm volatile("v_cvt_pk_bf16_f32 %0, %1, %2" : "=v"(r) : "v"(lo), "v"(hi)); return r; }
constexpr int EPI_LDS_OFF = STAGE_BYTES, EPI_LDS_WAVE = 2560;
struct EpiStore {
    static constexpr bool PERM = true, AFTER_DRAIN = false;
    bf16_t* O; int ldc; PG8_LAS unsigned char* lds; const float* rope; int nctx, seqlen, rowbase;
    __device__ __forceinline__ void operator()(const f32x4 (&acc)[2][2][4][2], const Unit& u, int wr, int wc, int fr, int fq) const {
        PG8_LAS unsigned char* T = lds + EPI_LDS_OFF + (wr * 4 + wc) * EPI_LDS_WAVE;
        const int lane = fr + 16 * fq, rr = lane >> 2, cc = lane & 3;
        const int row0 = rowbase + u.pm * BM + wr * 64, col0 = u.pn * BM + wc * 32;
        const bool dorope = rope != nullptr && (u.pn == 5 || u.pn == 6) && rowbase + u.pm * BM >= nctx;
#pragma unroll
        for (int ai = 0; ai < 2; ++ai)
#pragma unroll
            for (int m = 0; m < 4; ++m)
#pragma unroll
                for (int bj = 0; bj < 2; ++bj) { const f32x4 v0 = acc[ai][bj][m][0], v1 = acc[ai][bj][m][1];
                    u32x4 w; w.x = cvt_pk_bf16(v0[0], v0[1]); w.y = cvt_pk_bf16(v0[2], v0[3]); w.z = cvt_pk_bf16(v1[0], v1[1]); w.w = cvt_pk_bf16(v1[2], v1[3]);
                    *(PG8_LAS u32x4*)(T + fr * 80 + 16 * fq) = w;
                    asm volatile("s_waitcnt lgkmcnt(0)" ::: "memory");
                    u32x4 o = *(const PG8_LAS u32x4*)(T + rr * 80 + 16 * cc);
                    asm volatile("s_waitcnt lgkmcnt(0)" ::: "memory");
                    const int grow = row0 + ai * HALF + m * 16 + rr;
                    if (dorope) {
                        const int t = (grow - nctx) % seqlen; const bool second = (wc & 1) != 0;
                        const float* ct = rope + (second ? 8192 + (t & 63) * 16 : (t >> 6) * 16) + 8 * (cc & 1); const float* st = ct + (second ? 1024 : 4096);
                        const f32x4 c0 = *(const f32x4*)ct, c1 = *(const f32x4*)(ct + 4), s0 = *(const f32x4*)st, s1 = *(const f32x4*)(st + 4);
                        const float cs[8] = {c0[0], c0[1], c0[2], c0[3], c1[0], c1[1], c1[2], c1[3]}, sn[8] = {s0[0], s0[1], s0[2], s0[3], s1[0], s1[1], s1[2], s1[3]};
                        const unsigned ow[4] = {o.x, o.y, o.z, o.w}; unsigned rw[4];
                        const float sg = cc >= 2 ? 1.0f : -1.0f;
#pragma unroll
                        for (int q = 0; q < 4; ++q) { const unsigned pw = (unsigned)__builtin_amdgcn_mov_dpp((int)ow[q], 0x4E, 0xf, 0xf, true);
                            const float x0 = __uint_as_float(ow[q] << 16), x1 = __uint_as_float(ow[q] & 0xffff0000u), p0 = __uint_as_float(pw << 16), p1 = __uint_as_float(pw & 0xffff0000u);
                            rw[q] = cvt_pk_bf16(x0 * cs[2 * q] + sg * p0 * sn[2 * q], x1 * cs[2 * q + 1] + sg * p1 * sn[2 * q + 1]); }
                        o = (u32x4){rw[0], rw[1], rw[2], rw[3]}; }
                    *(u32x4*)(O + (size_t)grow * ldc + col0 + bj * HALF + 8 * cc) = o; }
    }
};
struct EpiResid {
    static constexpr bool PERM = false, AFTER_DRAIN = false;
    float* X; int ldc; const float* gate; int gstride, nctx, seqlen; PG8_LAS unsigned char* lds; int rowbase; const float* Xin;
    __device__ __forceinline__ void operator()(const f32x4 (&acc)[2][2][4][2], const Unit& u, int wr, int wc, int fr, int fq) const {
        PG8_LAS float* T = (PG8_LAS float*)(lds + EPI_LDS_OFF + (wr * 4 + wc) * EPI_LDS_WAVE);
        const int lane = fr + 16 * fq, rr = lane >> 3, cc = lane & 7;
        const int r0 = rowbase + u.pm * BM; const int vsel = r0 < nctx ? 2 : (r0 - nctx) / seqlen;
        const int row0 = r0 + wr * 64, col0 = u.pn * BM + wc * 32 + 4 * cc;
#pragma unroll
        for (int bj = 0; bj < 2; ++bj) { const f32x4 g = *(const f32x4*)(gate + (size_t)vsel * gstride + col0 + bj * HALF);
#pragma unroll
            for (int ai = 0; ai < 2; ++ai)
#pragma unroll
                for (int m = 0; m < 4; ++m) {
#pragma unroll
                    for (int n = 0; n < 2; ++n) *(PG8_LAS f32x4*)(T + fr * 36 + 16 * n + 4 * fq) = acc[ai][bj][m][n];
                    asm volatile("s_waitcnt lgkmcnt(0)" ::: "memory");
                    const f32x4 t0 = *(const PG8_LAS f32x4*)(T + rr * 36 + 4 * cc), t1 = *(const PG8_LAS f32x4*)(T + (rr + 8) * 36 + 4 * cc);
                    asm volatile("s_waitcnt lgkmcnt(0)" ::: "memory");
                    float* x0 = X + (size_t)(row0 + ai * HALF + m * 16 + rr) * ldc + col0 + bj * HALF; float* x1 = x0 + (size_t)8 * ldc;
                    const float* i0 = Xin + (size_t)(row0 - rowbase + ai * HALF + m * 16 + rr) * ldc + col0 + bj * HALF; const float* i1 = i0 + (size_t)8 * ldc;
                    f32x4 a = *(const f32x4*)i0, b = *(const f32x4*)i1; a += g * t0; b += g * t1; *(f32x4*)x0 = a; *(f32x4*)x1 = b; } }
    }
};

template <class Epi, class Sched, bool ALIGN_EPI = false, bool SP2 = false>
__device__ __forceinline__ void gemm_phase(PG8_LAS unsigned char* lds, const Gemm g, const Sched& S, const Epi& E, int tid_in) {
    int tid_ = tid_in; asm volatile("" : "+v"(tid_));
    const int tid = tid_, wid = __builtin_amdgcn_readfirstlane(tid >> 6), lane = tid & 63, wr = wid >> 2, wc = wid & 3, fr = lane & 15, fq = lane >> 4;
    const int K = g.K, nt = K / BK;
    unsigned voffA[2], voffB[2];
#pragma unroll
    for (int i = 0; i < 2; ++i) { int R, C; stage_rc(tid * 16 + i * 8192, R, C); const int Rb = Epi::PERM ? ((R & ~31) + perm32(R & 31)) : R;
        voffA[i] = (unsigned)(R * K + C) * 2u; voffB[i] = (unsigned)(Rb * K + C) * 2u; }
    const size_t kstep = (size_t)(BK * 2);
    const size_t hstep = (size_t)HALF * K * 2;
    const size_t tstep = 2 * hstep;
    const unsigned ldsw = (unsigned)wid * 1024u;
    const int aoff = lds_byte(wr * 64 + fr, fq * 8), boff = lds_byte(wc * 32 + fr, fq * 8);
#define PG8_SA(b, h) (((b) * 2 + (h)) * HTB)
#define PG8_SB(b, h) ((4 + (b) * 2 + (h)) * HTB)
#define PG8_STAGE(bufoff, gbase, voff) do { _Pragma("unroll") for (int _i = 0; _i < 2; ++_i) \
        __builtin_amdgcn_global_load_lds((const unsigned*)((const char*)(gbase) + (voff)[_i]), (PG8_LAS unsigned*)(lds + (bufoff) + ldsw + _i * 8192), 16, 0, 0); } while (0)
#define PG8_LDA(dst, b, h) do { _Pragma("unroll") for (int m = 0; m < 4; ++m) _Pragma("unroll") for (int k = 0; k < 2; ++k) dst[m][k] = *(const PG8_LAS bf16x8*)(lds + PG8_SA(b, h) + aoff + m * 2048 + k * 1024); } while (0)
#define PG8_LDB(dst, b, h) do { _Pragma("unroll") for (int n = 0; n < 2; ++n) _Pragma("unroll") for (int k = 0; k < 2; ++k) dst[n][k] = *(const PG8_LAS bf16x8*)(lds + PG8_SB(b, h) + boff + n * 2048 + k * 1024); } while (0)
#define PG8_MMA(ai, bj, At, Bt) do { __builtin_amdgcn_s_setprio(1); _Pragma("unroll") for (int m = 0; m < 4; ++m) _Pragma("unroll") for (int n = 0; n < 2; ++n) _Pragma("unroll") for (int k = 0; k < 2; ++k) \
        acc[ai][bj][m][n] = __builtin_amdgcn_mfma_f32_16x16x32_bf16(Bt[n][k], At[m][k], acc[ai][bj][m][n], 0, 0, 0); __builtin_amdgcn_s_setprio(0); } while (0)
#define PG8_WAIT_V(n) asm volatile("s_waitcnt vmcnt(" #n ")" ::: "memory")
#define PG8_WAIT_L(n) asm volatile("s_waitcnt lgkmcnt(" #n ")" ::: "memory")
#define PG8_BAR __builtin_amdgcn_s_barrier()
#define PG8_SCHED __builtin_amdgcn_sched_barrier(0)
    Unit cur, nxt; int ui = 0;
    if (!S.next(0, cur)) return;
    f32x4 acc[2][2][4][2];
#pragma unroll
    for (int a = 0; a < 2; ++a)
#pragma unroll
        for (int b = 0; b < 2; ++b)
#pragma unroll
            for (int m = 0; m < 4; ++m)
#pragma unroll
                for (int n = 0; n < 2; ++n) acc[a][b][m][n] = (f32x4){0.f, 0.f, 0.f, 0.f};
    bf16x8 At[4][2], B0[2][2], B1[2][2];
    const char* cA = (const char*)g.A + (size_t)cur.pm * tstep; const char* cB = (const char*)g.Bt + (size_t)cur.pn * tstep;
    S.a_ready(cur);
    if constexpr (SP2) {
        PG8_STAGE(PG8_SB(0, 0), cB, voffB); PG8_STAGE(PG8_SB(0, 1), cB + hstep, voffB); PG8_STAGE(PG8_SA(0, 0), cA, voffA); PG8_STAGE(PG8_SA(0, 1), cA + hstep, voffA);
        if (wr == 1) PG8_BAR;
        PG8_WAIT_V(2); PG8_BAR;
        PG8_STAGE(PG8_SB(1, 0), cB + kstep, voffB); PG8_STAGE(PG8_SA(1, 0), cA + kstep, voffA); PG8_STAGE(PG8_SB(1, 1), cB + hstep + kstep, voffB);
        PG8_WAIT_V(6); PG8_BAR;
    } else {
        PG8_STAGE(PG8_SB(0, 0), cB, voffB); PG8_STAGE(PG8_SA(0, 0), cA, voffA); PG8_STAGE(PG8_SB(0, 1), cB + hstep, voffB); PG8_STAGE(PG8_SA(0, 1), cA + hstep, voffA);
        if (wr == 1) PG8_BAR;
        PG8_WAIT_V(4); PG8_BAR;
        PG8_STAGE(PG8_SB(1, 0), cB + kstep, voffB); PG8_STAGE(PG8_SA(1, 0), cA + kstep, voffA); PG8_STAGE(PG8_SB(1, 1), cB + hstep + kstep, voffB);
        PG8_WAIT_V(6); PG8_BAR;
    }
    for (;;) {
        const bool has_next = S.next(ui + 1, nxt);
        const char* nA = has_next ? (const char*)g.A + (size_t)nxt.pm * tstep : cA; const char* nB = has_next ? (const char*)g.Bt + (size_t)nxt.pn * tstep : cB;
        for (int t = 0; t < nt; t += 2) {
            const bool last = (t == nt - 2);
            const char* a1 = cA + (size_t)(t + 1) * kstep;
            const char* a2 = last ? nA : cA + (size_t)(t + 2) * kstep; const char* b2 = last ? nB : cB + (size_t)(t + 2) * kstep;
            const char* a3 = a2 + kstep; const char* b3 = b2 + kstep;
            if (last && has_next) S.a_ready(nxt);
            if constexpr (SP2) {
            PG8_LDB(B0, 0, 0); PG8_LDB(B1, 0, 1); PG8_SCHED; PG8_LDA(At, 0, 0); PG8_STAGE(PG8_SA(1, 1), a1 + hstep, voffA);
            PG8_WAIT_V(8); PG8_WAIT_L(0); PG8_BAR; PG8_MMA(0, 0, At, B0); PG8_MMA(0, 1, At, B1); PG8_BAR; PG8_SCHED;
            PG8_LDA(At, 0, 1); PG8_STAGE(PG8_SB(0, 0), b2, voffB); PG8_STAGE(PG8_SB(0, 1), b2 + hstep, voffB); PG8_STAGE(PG8_SA(0, 0), a2, voffA);
            PG8_WAIT_V(8); PG8_WAIT_L(0); PG8_BAR; PG8_MMA(1, 0, At, B0); PG8_MMA(1, 1, At, B1); PG8_BAR; PG8_SCHED;
            PG8_LDB(B0, 1, 0); PG8_LDB(B1, 1, 1); PG8_SCHED; PG8_LDA(At, 1, 0); PG8_STAGE(PG8_SA(0, 1), a2 + hstep, voffA);
            PG8_WAIT_V(8); PG8_WAIT_L(0); PG8_BAR; PG8_MMA(0, 0, At, B0); PG8_MMA(0, 1, At, B1); PG8_BAR; PG8_SCHED;
            PG8_LDA(At, 1, 1); PG8_STAGE(PG8_SB(1, 0), b3, voffB); PG8_STAGE(PG8_SB(1, 1), b3 + hstep, voffB); PG8_STAGE(PG8_SA(1, 0), a3, voffA);
            PG8_WAIT_V(8); PG8_WAIT_L(0); PG8_BAR; PG8_MMA(1, 0, At, B0); PG8_MMA(1, 1, At, B1); PG8_BAR; PG8_SCHED;
            } else {
            PG8_LDB(B0, 0, 0); PG8_SCHED; PG8_LDA(At, 0, 0); PG8_STAGE(PG8_SA(1, 1), a1 + hstep, voffA);
            PG8_WAIT_L(8); PG8_BAR; PG8_WAIT_L(0); PG8_MMA(0, 0, At, B0); PG8_BAR; PG8_SCHED;
            PG8_LDB(B1, 0, 1); PG8_STAGE(PG8_SB(0, 0), b2, voffB);
            PG8_BAR; PG8_WAIT_L(0); PG8_MMA(0, 1, At, B1); PG8_BAR;
            PG8_LDA(At, 0, 1); PG8_STAGE(PG8_SA(0, 0), a2, voffA);
            PG8_BAR; PG8_WAIT_L(0); PG8_MMA(1, 0, At, B0); PG8_BAR; PG8_SCHED;
            PG8_STAGE(PG8_SB(0, 1), b2 + hstep, voffB);
            PG8_WAIT_V(6); PG8_BAR; PG8_MMA(1, 1, At, B1); PG8_BAR;
            PG8_LDB(B0, 1, 0); PG8_SCHED; PG8_LDA(At, 1, 0); PG8_STAGE(PG8_SA(0, 1), a2 + hstep, voffA);
            PG8_WAIT_L(8); PG8_BAR; PG8_WAIT_L(0); PG8_MMA(0, 0, At, B0); PG8_BAR; PG8_SCHED;
            PG8_LDB(B1, 1, 1); PG8_STAGE(PG8_SB(1, 0), b3, voffB);
            PG8_BAR; PG8_WAIT_L(0); PG8_MMA(0, 1, At, B1); PG8_BAR;
            PG8_LDA(At, 1, 1); PG8_STAGE(PG8_SA(1, 0), a3, voffA);
            PG8_BAR; PG8_WAIT_L(0); PG8_MMA(1, 0, At, B0); PG8_BAR; PG8_SCHED;
            PG8_STAGE(PG8_SB(1, 1), b3 + hstep, voffB);
            PG8_WAIT_V(6); PG8_BAR; PG8_MMA(1, 1, At, B1); PG8_BAR;
            }
        }
        if constexpr (ALIGN_EPI) { if (wr == 0) PG8_BAR; }
        if constexpr (!Epi::AFTER_DRAIN) { E(acc, cur, wr, wc, fr, fq); S.done(cur); }
        if (!has_next) break;
#pragma unroll
        for (int a = 0; a < 2; ++a)
#pragma unroll
            for (int b = 0; b < 2; ++b)
#pragma unroll
                for (int m = 0; m < 4; ++m)
#pragma unroll
                    for (int n = 0; n < 2; ++n) acc[a][b][m][n] = (f32x4){0.f, 0.f, 0.f, 0.f};
        cur = nxt; cA = nA; cB = nB; ++ui;
        if constexpr (ALIGN_EPI) { if (wr == 1) PG8_BAR; }
    }
    PG8_WAIT_V(0);
    if constexpr (!ALIGN_EPI) { if (wr == 0) PG8_BAR; }
    PG8_BAR;
    if constexpr (Epi::AFTER_DRAIN) { E.fused(acc, cur, wr, wc, fr, fq, lds, wid, lane); S.done(cur); }
#undef PG8_SA
#undef PG8_SB
#undef PG8_STAGE
#undef PG8_LDA
#undef PG8_LDB
#undef PG8_MMA
#undef PG8_WAIT_V
#undef PG8_WAIT_L
#undef PG8_BAR
#undef PG8_SCHED
}
}

struct Ctx {
    unsigned aoff; int l;
    unsigned char* ws;
    DI float* X() const { return GP(float, ws + WS_X); }
    DI bf16_t* H() const { return GP(bf16_t, ws + WS_H); }
    DI bf16_t* P() const { return GP(bf16_t, ws + WS_P); }
    DI bf16_t* QP() const { return GP(bf16_t, ws + WS_P); }
    DI bf16_t* MIX() const { return GP(bf16_t, ws + WS_MIX); }
    DI float* OF() const { return GP(float, ws + WS_OF); }
    DI float* OB() const { return GP(float, ws + WS_OB); }
    DI int* PIDX() const { return GP(int, ws + WS_PIDX); }
    DI float* PG() const { return GP(float, ws + WS_PG); }
    DI float* MOD() const { return GP(float, ws + WS_MOD); }
    DI float* LB() const { return GP(float, ws + WS_LB); }
    DI float* ROPE() const { return GP(float, ws + WS_ROPE); }
    DI bf16_t* WIN() const { return GP(bf16_t, ws + WS_WIN); }
    DI bf16_t* WOUT() const { return GP(bf16_t, ws + WS_WOUT); }
    DI bf16_t* WQ() const { return GP(bf16_t, ws + WS_WQ); }
    DI bf16_t* UB() const { return GP(bf16_t, ws + WS_UB); }
    DI float* ST() const { return GP(float, ws + WS_OF); }
    DI bf16_t* STB() const { return GP(bf16_t, ws + WS_OF); }
    DI float* AC() const { return GP(float, ws + WS_AC); }
    DI float* PA() const { return GP(float, ws + WS_PA); }
    DI float* VS() const { return GP(float, ws + WS_VS); }
    DI float* US() const { return GP(float, ws + WS_US); }
    DI bf16_t* SKH() const { return GP(bf16_t, ws + WS_SKH); }
    DI bf16_t* SKL() const { return GP(bf16_t, ws + WS_SKL); }
    DI bf16_t* VB() const { return GP(bf16_t, ws + WS_VB); }
    DI unsigned char* H8() const { return GP(unsigned char, ws + WS_H8); }
    DI float* HS() const { return GP(float, ws + WS_HS); }
    unsigned char* lds; int tid, lane, wave, gw, ngw, bid, nb;
    int xg, nxg, jx, nloc;
};

#define LAS __attribute__((address_space(3)))
DI void transpose_item(const float* W, int Kd, int N, bf16_t* WT, LAS float* scr, int item, int lane) {
    const int nblk = N / 32, kb = item / nblk, nb = item % nblk, k0 = 64 * kb, n0 = 32 * nb;
#pragma unroll 8
    for (int i = 0; i < 32; ++i) { const int kk = 2 * i + (lane >> 5); scr[kk * 33 + (lane & 31)] = W[(size_t)(k0 + kk) * N + n0 + (lane & 31)]; }
    asm volatile("s_waitcnt lgkmcnt(0)" ::: "memory");
    const int c = lane & 7;
#pragma unroll
    for (int j = 0; j < 4; ++j) { const int n = (lane >> 3) + 8 * j; const LAS float* sp = scr + (8 * c) * 33 + n;
        u32x4 o; o.x = pk2(sp[0 * 33], sp[1 * 33]); o.y = pk2(sp[2 * 33], sp[3 * 33]); o.z = pk2(sp[4 * 33], sp[5 * 33]); o.w = pk2(sp[6 * 33], sp[7 * 33]);
        *(u32x4*)(WT + (size_t)(n0 + n) * Kd + k0 + 8 * c) = o; }
    asm volatile("s_waitcnt lgkmcnt(0)" ::: "memory");
}

template <class T> DI T* argp_(const Ctx& K, unsigned off) {
    const unsigned* p = (const unsigned*)(K.lds + K.aoff + off);
    const unsigned lo = __builtin_amdgcn_readfirstlane(p[0]), hi = __builtin_amdgcn_readfirstlane(p[1]);
    return GP(T, ((unsigned long long)hi << 32) | (unsigned long long)lo);
}
#define ARG(f) argp_<const float>(K, (unsigned)__builtin_offsetof(Args, f))

DI void ph_prologue(Ctx& K) {
    {
        LAS float* scr = (LAS float*)((LAS unsigned char*)K.lds + K.wave * 16384);
        constexpr int I_IN = (D / 64) * (PW / 32), I_OUT = (D / 64) * (D / 32), I_Q = (D / 64) * (2048 / 32), I_L = I_IN + I_OUT + I_Q;
        for (int it = K.gw; it < DEPTH * I_L; it += K.ngw) {
            const int l = it / I_L; int r = it % I_L;
            if (r < I_IN) { transpose_item(ARG(w_in) + (size_t)l * D * PW, D, PW, K.WIN() + (size_t)l * PW * D, scr, r, K.lane); continue; } r -= I_IN;
            if (r < I_OUT) { transpose_item(ARG(w_out) + (size_t)l * D * D, D, D, K.WOUT() + (size_t)l * D * D, scr, r, K.lane); continue; } r -= I_OUT;
            transpose_item(ARG(peer_wq) + (size_t)l * D * 2048, D, 2048, K.WQ() + (size_t)l * 2048 * D, scr, r, K.lane);
        }
    }
    const size_t gt = (size_t)K.bid * NTHREADS + K.tid, gs = (size_t)K.nb * NTHREADS;
    { const float* sk = ARG(peer_sk);
      for (size_t i = gt; i < (size_t)DEPTH * 8 * 2 * 128 * 128; i += gs) { const float v = sk[i]; const bf16_t hi = f2bf(v);
          const size_t lhp = i >> 14; const int key = (int)(i >> 7) & 127, d = (int)i & 127;
          const size_t o = (((lhp * 8 + (key >> 4)) * 4 + (d >> 5)) * 64 + (key & 15) + 16 * ((d >> 3) & 3)) * 8 + (d & 7);
          K.SKH()[o] = hi; K.SKL()[o] = f2bf(v - bf2f(hi)); } }
    { const float* pu = ARG(peer_u); unsigned char* UQ = (unsigned char*)K.UB();
      for (int row0 = K.gw; row0 < DEPTH * 16384; row0 += 2 * K.ngw) {
          f32x4 v2[2][4];
#pragma unroll
          for (int t = 0; t < 2; ++t) { const int row = min(row0 + t * K.ngw, DEPTH * 16384 - 1); const f32x4* src = (const f32x4*)(pu + (size_t)row * D);
#pragma unroll
              for (int j = 0; j < 4; ++j) v2[t][j] = src[j * 64 + K.lane]; }
#pragma unroll
          for (int t = 0; t < 2; ++t) { const int row = row0 + t * K.ngw; if (row >= DEPTH * 16384) break;
              float mx = 0.f;
#pragma unroll
              for (int j = 0; j < 4; ++j) mx = fmaxf(mx, fmaxf(fmaxf(fabsf(v2[t][j].x), fabsf(v2[t][j].y)), fmaxf(fabsf(v2[t][j].z), fabsf(v2[t][j].w))));
#pragma unroll
              for (int o = 1; o < 64; o <<= 1) mx = fmaxf(mx, __shfl_xor(mx, o));
              const float sc = fmaxf(mx, 1e-30f) * (1.0f / 127.0f), inv = 1.0f / sc;
              if (K.lane == 0) K.US()[row] = sc;
#pragma unroll
              for (int j = 0; j < 4; ++j) { const int col = j * 256 + K.lane * 4; const f32x4 v = v2[t][j];
                  const unsigned q0 = (unsigned)((int)rintf(v.x * inv)) & 0xffu, q1 = (unsigned)((int)rintf(v.y * inv)) & 0xffu, q2 = (unsigned)((int)rintf(v.z * inv)) & 0xffu, q3 = (unsigned)((int)rintf(v.w * inv)) & 0xffu;
                  *(unsigned*)(UQ + (size_t)row * D + col) = q0 | (q1 << 8) | (q2 << 16) | (q3 << 24); } } } }
    { const float* pv = ARG(peer_v); unsigned char* VQ = (unsigned char*)K.VB();
      for (int row0 = K.gw; row0 < DEPTH * 16384; row0 += 2 * K.ngw) {
          f32x4 v2[2][4];
#pragma unroll
          for (int t = 0; t < 2; ++t) { const int row = min(row0 + t * K.ngw, DEPTH * 16384 - 1); const f32x4* src = (const f32x4*)(pv + (size_t)row * D);
#pragma unroll
              for (int j = 0; j < 4; ++j) v2[t][j] = src[j * 64 + K.lane]; }
#pragma unroll
          for (int t = 0; t < 2; ++t) { const int row = row0 + t * K.ngw; if (row >= DEPTH * 16384) break;
              float mx = 0.f;
#pragma unroll
              for (int j = 0; j < 4; ++j) mx = fmaxf(mx, fmaxf(fmaxf(fabsf(v2[t][j].x), fabsf(v2[t][j].y)), fmaxf(fabsf(v2[t][j].z), fabsf(v2[t][j].w))));
#pragma unroll
              for (int o = 1; o < 64; o <<= 1) mx = fmaxf(mx, __shfl_xor(mx, o));
              const float sc = fmaxf(mx, 1e-30f) * (1.0f / 127.0f), inv = 1.0f / sc;
              if (K.lane == 0) K.VS()[row] = sc;
              const int l = row >> 14, e = row & 16383;
#pragma unroll
              for (int j = 0; j < 4; ++j) { const int col = j * 256 + K.lane * 4; const f32x4 v = v2[t][j];
                  const unsigned q0 = (unsigned)((int)rintf(v.x * inv)) & 0xffu, q1 = (unsigned)((int)rintf(v.y * inv)) & 0xffu, q2 = (unsigned)((int)rintf(v.z * inv)) & 0xffu, q3 = (unsigned)((int)rintf(v.w * inv)) & 0xffu;
                  *(unsigned*)(VQ + (((size_t)l * 8 + (col >> 7)) * 16384 + e) * 128 + (col & 127)) = q0 | (q1 << 8) | (q2 << 16) | (q3 << 24); } } } }
    { float* sv = (float*)K.lds;
      float* part = sv + 3 * D;
      __syncthreads();
      for (int i = K.tid; i < 3 * D; i += NTHREADS) { const int v = i / D, k = i % D; const float c = v < 2 ? ARG(c)[v * D + k] : ARG(c_ctx)[k]; sv[i] = c * sigmoidf_(c); }
      __syncthreads();
      for (int item = K.bid; item < DEPTH * 48; item += K.nb) {
          const int l = item / 48, cb = item % 48, kp = K.lane >> 5, cl = (K.lane & 31) * 4;
          const float* w = ARG(w_mod) + (size_t)l * D * 6 * D + cb * 128 + cl;
          f32x4 a0 = {0.f, 0.f, 0.f, 0.f}, a1 = a0, a2 = a0;
#pragma unroll 16
          for (int kk = 0; kk < 64; ++kk) { const int k = K.wave * 128 + 2 * kk + kp; const f32x4 wv = *(const f32x4*)(w + (size_t)k * 6 * D);
              a0 += wv * sv[k]; a1 += wv * sv[D + k]; a2 += wv * sv[2 * D + k]; }
#pragma unroll
          for (int j = 0; j < 4; ++j) { a0[j] += __shfl_xor(a0[j], 32); a1[j] += __shfl_xor(a1[j], 32); a2[j] += __shfl_xor(a2[j], 32); }
          if (kp == 0) { *(f32x4*)(part + (K.wave * 3 + 0) * 128 + cl) = a0; *(f32x4*)(part + (K.wave * 3 + 1) * 128 + cl) = a1; *(f32x4*)(part + (K.wave * 3 + 2) * 128 + cl) = a2; }
          __syncthreads();
          for (int i = K.tid; i < 384; i += NTHREADS) { const int v = i / 128, cc = i % 128; float sum = 0.f;
#pragma unroll
              for (int w8 = 0; w8 < 8; ++w8) sum += part[(w8 * 3 + v) * 128 + cc];
              const int col = cb * 128 + cc; K.MOD()[((size_t)l * 3 + v) * 6 * D + col] = sum + ARG(b_mod)[(size_t)l * 6 * D + col]; }
          __syncthreads();
      } }
    for (size_t i = gt; i < 2 * 256; i += gs) {
        const int dir = (int)(i / 256), ch = (int)(i % 256);
        float lg[DEPTH], mx = -1e30f;
#pragma unroll
        for (int l = 0; l < DEPTH; ++l) { lg[l] = ARG(lb_logits)[((size_t)dir * DEPTH + l) * 256 + ch]; mx = fmaxf(mx, lg[l]); }
        float s = 0.f;
#pragma unroll
        for (int l = 0; l < DEPTH; ++l) { lg[l] = expf(lg[l] - mx); s += lg[l]; }
        float cum = 0.f;
#pragma unroll
        for (int l = 0; l < DEPTH; ++l) { if (l > 0) cum += lg[l] / s; K.LB()[((size_t)dir * DEPTH + l) * 256 + ch] = cum; }
    }
    for (size_t i = gt; i < (256 + 64) * 16; i += gs) {
        const int pos = (int)(i / 16), f = (int)(i % 16);
        const float inv = powf(10000.0f, -(float)f / 16.0f);
        if (pos < 256) { const float ang = (float)pos * inv; K.ROPE()[pos * 16 + f] = cosf(ang); K.ROPE()[4096 + pos * 16 + f] = sinf(ang); }
        else { const int pc = pos - 256; const float ang = (float)pc * inv; K.ROPE()[8192 + pc * 16 + f] = cosf(ang); K.ROPE()[8192 + 1024 + pc * 16 + f] = sinf(ang); }
    }
}

DI void ph_norm(Ctx& K, const float* nw, int shift_chunk) {
    const float* modl = K.MOD() + (size_t)K.l * 3 * 6 * D;
    for (int r = K.gw; r < M; r += K.ngw) {
        const f32x4* xr = (const f32x4*)((K.l == 0 && shift_chunk == 0) ? (r < NCTX ? ARG(ctx) + (size_t)r * D : ARG(x) + (size_t)(r - NCTX) * D) : K.X() + (size_t)r * D);
        f32x4 v[4]; float ss = 0.f;
#pragma unroll
        for (int j = 0; j < 4; ++j) { v[j] = xr[j * 64 + K.lane]; ss += v[j].x * v[j].x + v[j].y * v[j].y + v[j].z * v[j].z + v[j].w * v[j].w; }
        ss = wave_sum(ss);
        const float rs = rsqrtf(ss * (1.0f / D) + EPS);
        const float* mv = modl + (size_t)modvec_of_row(r) * 6 * D;
        u32x2* ho = (u32x2*)(K.H() + (size_t)r * D);
#pragma unroll
        for (int j = 0; j < 4; ++j) {
            const int c4 = j * 64 + K.lane;
            const f32x4 w = ((const f32x4*)nw)[c4], sh = ((const f32x4*)(mv + shift_chunk * D))[c4], sc = ((const f32x4*)(mv + (shift_chunk + 1) * D))[c4];
            f32x4 y; y.x = v[j].x * rs * w.x * (1.f + sc.x) + sh.x; y.y = v[j].y * rs * w.y * (1.f + sc.y) + sh.y; y.z = v[j].z * rs * w.z * (1.f + sc.z) + sh.z; y.w = v[j].w * rs * w.w * (1.f + sc.w) + sh.w;
            u32x2 o; o.x = pk2(y.x, y.y); o.y = pk2(y.z, y.w); ho[c4] = o;
            if (shift_chunk == 3) { v[j].x = __uint_as_float(o.x << 16); v[j].y = __uint_as_float(o.x & 0xffff0000u); v[j].z = __uint_as_float(o.y << 16); v[j].w = __uint_as_float(o.y & 0xffff0000u); }
        }
        if (shift_chunk == 3) {
            float mx = 0.f;
#pragma unroll
            for (int j = 0; j < 4; ++j) mx = fmaxf(mx, fmaxf(fmaxf(fabsf(v[j].x), fabsf(v[j].y)), fmaxf(fabsf(v[j].z), fabsf(v[j].w))));
#pragma unroll
            for (int o = 1; o < 64; o <<= 1) mx = fmaxf(mx, __shfl_xor(mx, o));
            const float sc = fmaxf(mx, 1e-30f) * (1.0f / 127.0f), inv = 1.0f / sc;
            if (K.lane == 0) K.HS()[r] = sc;
#pragma unroll
            for (int j = 0; j < 4; ++j) { const unsigned q0 = (unsigned)((int)rintf(v[j].x * inv)) & 0xffu, q1 = (unsigned)((int)rintf(v[j].y * inv)) & 0xffu, q2 = (unsigned)((int)rintf(v[j].z * inv)) & 0xffu, q3 = (unsigned)((int)rintf(v[j].w * inv)) & 0xffu;
                *(unsigned*)(K.H8() + (size_t)r * D + (j * 64 + K.lane) * 4) = q0 | (q1 << 8) | (q2 << 16) | (q3 << 24); }
        }
    }
}

typedef short sg_bf16x8 __attribute__((ext_vector_type(8)));
template <int NT, bool RESID> DI void sg_ctx(Ctx& K, const bf16_t* A, const bf16_t* Bt, bf16_t* out, float* X, const float* gate, const float* Xin) {
    constexpr int N = 1024 * NT, RS = 272, OFF_B = 64 * RS, BUF = (64 + 32 * NT) * RS;
    int tid = K.tid; asm volatile("" : "+v"(tid));
    const int lane = tid & 63, wave = __builtin_amdgcn_readfirstlane(tid >> 6), r16 = lane & 15, g4 = lane >> 4, mt = wave & 3, nh = wave >> 2;
    const int lrow = tid >> 4, lc = tid & 15;
    for (int u = K.bid; u < 256; u += K.nb) {
        const int xcd = u & 7, j = u >> 3, ct = xcd * 4 + (j & 3), rt = j >> 2;
        const int row0 = 64 * rt, col0 = 32 * NT * ct;
        const bf16_t* ga = A + (size_t)(row0 + lrow) * D + 8 * lc; const bf16_t* gb = Bt + (size_t)(col0 + lrow) * D + 8 * lc;
        u32x4 ra[3][2], rb[3][NT];
        f32x4 acc[NT];
#pragma unroll
        for (int n = 0; n < NT; ++n) acc[n] = (f32x4){0.f, 0.f, 0.f, 0.f};
#define SG_LOAD(s_, c_) do { ra[s_][0] = *(const u32x4*)(ga + 128 * (c_)); ra[s_][1] = *(const u32x4*)(ga + 32 * D + 128 * (c_)); \
        _Pragma("unroll") for (int i_ = 0; i_ < NT; ++i_) rb[s_][i_] = *(const u32x4*)(gb + (size_t)32 * i_ * D + 128 * (c_)); } while (0)
        SG_LOAD(0, 0); SG_LOAD(1, 1); SG_LOAD(2, 2);
        __syncthreads();
#pragma unroll
        for (int c = 0; c < 8; ++c) {
            unsigned char* buf = K.lds + (c & 1) * BUF;
            *(u32x4*)(buf + lrow * RS + 16 * lc) = ra[c % 3][0]; *(u32x4*)(buf + (lrow + 32) * RS + 16 * lc) = ra[c % 3][1];
#pragma unroll
            for (int i = 0; i < NT; ++i) *(u32x4*)(buf + OFF_B + (lrow + 32 * i) * RS + 16 * lc) = rb[c % 3][i];
            if (c + 3 < 8) SG_LOAD(c % 3, c + 3);
            __syncthreads();
#pragma unroll
            for (int ks = 0; ks < 4; ++ks) {
                const sg_bf16x8 af = *(const sg_bf16x8*)(buf + (16 * mt + r16) * RS + 64 * ks + 16 * g4);
#pragma unroll
                for (int n = 0; n < NT; ++n) { const sg_bf16x8 bf = *(const sg_bf16x8*)(buf + OFF_B + (16 * (NT * nh + n) + r16) * RS + 64 * ks + 16 * g4);
                    acc[n] = __builtin_amdgcn_mfma_f32_16x16x32_bf16(bf, af, acc[n], 0, 0, 0); }
            }
        }
#undef SG_LOAD
        const int row = row0 + 16 * mt + r16;
#pragma unroll
        for (int n = 0; n < NT; ++n) { const int col = col0 + 16 * (NT * nh + n) + 4 * g4;
            if constexpr (RESID) { float* xp = X + (size_t)row * D + col; const f32x4 g = *(const f32x4*)(gate + col); f32x4 x = *(const f32x4*)(Xin + (size_t)row * D + col); x += g * acc[n]; *(f32x4*)xp = x; }
            else { u32x2 o; o.x = pk2(acc[n][0], acc[n][1]); o.y = pk2(acc[n][2], acc[n][3]); *(u32x2*)(out + (size_t)row * N + col) = o; } }
        __syncthreads();
    }
}
DI void ph_gemm_store(Ctx& K, const bf16_t* A, const bf16_t* Bt, int N, bf16_t* out, const float* rope) {
    { pg8::Gemm g{A + (size_t)NCTX * D, Bt, NLAT, N, D}; pg8::StaticOrder S; S.init(NLAT, N, K.nb, K.bid);
      pg8::EpiStore E{out, N, (LAS unsigned char*)K.lds, rope, NCTX, L, NCTX};
      pg8::gemm_phase<pg8::EpiStore, pg8::StaticOrder, true, true>((LAS unsigned char*)K.lds, g, S, E, K.tid); }
    if (N == PW) sg_ctx<3, false>(K, A, Bt, out, nullptr, nullptr, nullptr); else sg_ctx<2, false>(K, A, Bt, out, nullptr, nullptr, nullptr);
}
DI void ph_gemm_resid(Ctx& K, const bf16_t* A, const bf16_t* Bt, int chunk) {
    const float* gate = K.MOD() + (size_t)K.l * 3 * 6 * D + (size_t)chunk * D;
    { pg8::Gemm g{A + (size_t)NCTX * D, Bt, NLAT, D, D}; pg8::StaticOrder S; S.init(NLAT, D, K.nb, K.bid);
      pg8::EpiResid E{K.X(), D, gate, 6 * D, NCTX, L, (LAS unsigned char*)K.lds, NCTX, K.l == 0 ? ARG(x) : (const float*)K.X() + (size_t)NCTX * D};
      pg8::gemm_phase<pg8::EpiResid, pg8::StaticOrder, true, true>((LAS unsigned char*)K.lds, g, S, E, K.tid); }
    sg_ctx<1, true>(K, A, Bt, nullptr, K.X(), gate + (size_t)2 * 6 * D, K.l == 0 ? ARG(ctx) : (const float*)K.X());
}

DI void ph_rope(Ctx& K) {
    const float* cosr = K.ROPE(); const float* sinr = K.ROPE() + 4096; const float* cosc = K.ROPE() + 8192; const float* sinc = K.ROPE() + 8192 + 1024;
    const size_t gt = (size_t)K.bid * NTHREADS + K.tid, gs = (size_t)K.nb * NTHREADS;
    for (size_t i = gt; i < (size_t)NLAT * 8 * 16; i += gs) {
        const int f = (int)(i & 15), hh = (int)((i >> 4) & 7), lr = (int)(i >> 7);
        const int t = lr % L, pr = t >> 6, pc = t & 63;
        bf16_t* p = K.P() + (size_t)(NCTX + lr) * PW + (hh < 6 ? C_SQ + hh * 64 : C_SK + (hh - 6) * 64);
        const float c1 = cosr[pr * 16 + f], s1 = sinr[pr * 16 + f], c2 = cosc[pc * 16 + f], s2 = sinc[pc * 16 + f];
        const float a = bf2f(p[f]), b = bf2f(p[16 + f]), e = bf2f(p[32 + f]), g = bf2f(p[48 + f]);
        p[f] = f2bf(a * c1 - b * s1); p[16 + f] = f2bf(b * c1 + a * s1); p[32 + f] = f2bf(e * c2 - g * s2); p[48 + f] = f2bf(g * c2 + e * s2);
    }
}

typedef short bf16x8_t __attribute__((ext_vector_type(8)));
#define MFMA16(a, b, c) __builtin_amdgcn_mfma_f32_16x16x32_bf16((a), (b), (c), 0, 0, 0)
constexpr int HG_NCH = (CL + L) / 64;
constexpr int HG_LFS = 68;
constexpr int HG_TS = 72;
constexpr int HGL_LF = 0, HGL_OM = HGL_LF + 2 * 64 * HG_LFS * 4, HGL_VT = HGL_OM + 2 * 64 * HG_LFS * 4, HGL_KT = HGL_VT + 64 * HG_TS * 2, HGL_SC = HGL_KT + 2 * 64 * HG_TS * 2, HGL_OD = HGL_SC + 8 * 16 * HG_TS * 2, HGL_END = HGL_OD + 2 * 64 * HG_LFS * 4;
static_assert(HGL_END <= LDS_BYTES - 256, "hgrn LDS map");
constexpr int HG_NIT = NB * 4 * HG_NCH;
DI int hg_block_row(int b, int tb, int tok) { return tb < 4 ? ctx_row(b, tb * 64 + tok) : lat_row(b, (tb - 4) * 64 + tok); }
DI int hg_bwd_chunk(int tb) { return tb < 4 ? 3 - tb : 4 + 255 - (tb - 4); }
DI int hg_sw(int row, int col) { return row * HG_TS + ((((col >> 3) ^ (row >> 3)) & 7) << 3) + (col & 7); }
struct HgIn { u32x4 zf, zb, hv; };
DI void hg_item(int item, int& b, int& h, int& tb) { tb = item % HG_NCH; h = (item / HG_NCH) & 3; b = item / (HG_NCH * 4); }
DI void hg_load(Ctx& K, int item, HgIn& r) {
    int b, h, tb; hg_item(item, b, h, tb); const int tok = K.tid >> 3, c = K.tid & 7;
    const bf16_t* pr = K.P() + (size_t)hg_block_row(b, tb, tok) * PW + h * 64 + 8 * c;
    r.zf = *(const u32x4*)(pr + C_ZF); r.zb = *(const u32x4*)(pr + C_ZB); r.hv = *(const u32x4*)(pr + C_HV);
}
DI void hg_prep1(Ctx& K, int h, const HgIn& r) {
    float* LF = (float*)(K.lds + HGL_LF); float* OM = (float*)(K.lds + HGL_OM); bf16_t* VT = (bf16_t*)(K.lds + HGL_VT);
    const int tok = K.tid >> 3, c = K.tid & 7;
#pragma unroll
    for (int dir = 0; dir < 2; ++dir) {
        float z[8]; unpack8(dir ? r.zb : r.zf, z);
        const float* lb = K.LB() + ((size_t)dir * DEPTH + K.l) * 256 + h * 64 + 8 * c;
        float lf[8], om[8];
#pragma unroll
        for (int j = 0; j < 8; ++j) { const float lbv = lb[j], sg = sigmoidf_(z[j]); const float f = fmaxf(lbv + (1.f - lbv) * sg, 1e-30f); lf[j] = __logf(f); om[j] = (1.f - lbv) * (1.f - sg); }
        float* lfp = LF + (dir * 64 + tok) * HG_LFS + 8 * c; float* omp = OM + (dir * 64 + tok) * HG_LFS + 8 * c;
        *(f32x4*)lfp = (f32x4){lf[0], lf[1], lf[2], lf[3]}; *(f32x4*)(lfp + 4) = (f32x4){lf[4], lf[5], lf[6], lf[7]};
        *(f32x4*)omp = (f32x4){om[0], om[1], om[2], om[3]}; *(f32x4*)(omp + 4) = (f32x4){om[4], om[5], om[6], om[7]};
    }
    { const unsigned w[4] = {r.hv.x, r.hv.y, r.hv.z, r.hv.w};
#pragma unroll
      for (int j = 0; j < 4; ++j) { VT[hg_sw(8 * c + 2 * j, tok)] = (bf16_t)(w[j] & 0xffffu); VT[hg_sw(8 * c + 2 * j + 1, tok)] = (bf16_t)(w[j] >> 16); } }
}
DI void hg_prep2(Ctx& K) {
    float* LF = (float*)(K.lds + HGL_LF);
    __syncthreads();
    if (K.tid < 128) {
        const int dir = K.tid >> 6, d = K.tid & 63; float* col = LF + dir * 64 * HG_LFS + d;
        float carry = 0.f;
#pragma unroll
        for (int hf = 0; hf < 2; ++hf) { float v[32];
#pragma unroll
            for (int p = 0; p < 32; ++p) v[p] = col[(dir ? 63 - (32 * hf + p) : 32 * hf + p) * HG_LFS];
            v[0] += carry;
#pragma unroll
            for (int p = 1; p < 32; ++p) v[p] += v[p - 1];
#pragma unroll
            for (int p = 0; p < 32; ++p) col[(dir ? 63 - (32 * hf + p) : 32 * hf + p) * HG_LFS] = v[p];
            carry = v[31]; }
    }
    __syncthreads();
}
DI void ph_hgrn_A(Ctx& K) {
    float* LF = (float*)(K.lds + HGL_LF); float* OM = (float*)(K.lds + HGL_OM); bf16_t* VT = (bf16_t*)(K.lds + HGL_VT); bf16_t* KT = (bf16_t*)(K.lds + HGL_KT);
    const int r16 = K.lane & 15, g4 = K.lane >> 4;
    if (K.bid >= HG_NIT) return;
    HgIn in; hg_load(K, K.bid, in);
#pragma unroll 1
    for (int item = K.bid; item < HG_NIT; item += K.nb) {
        int b, h, tb; hg_item(item, b, h, tb);
        __syncthreads();
        hg_prep1(K, h, in);
        hg_load(K, item + K.nb < HG_NIT ? item + K.nb : item, in);
        hg_prep2(K);
        { const int tok = K.tid >> 3, c = K.tid & 7;
#pragma unroll
          for (int dir = 0; dir < 2; ++dir) {
              const float* bl = LF + (dir * 64 + (dir ? 0 : 63)) * HG_LFS + 8 * c; const float* bt = LF + (dir * 64 + tok) * HG_LFS + 8 * c; const float* om = OM + (dir * 64 + tok) * HG_LFS + 8 * c;
#pragma unroll
              for (int j = 0; j < 8; ++j) KT[dir * 64 * HG_TS + hg_sw(8 * c + j, tok)] = f2bf(om[j] * __expf(bl[j] - bt[j]));
          }
          if (K.tid < 128) { const int dir = K.tid >> 6, d = K.tid & 63; const int chain = (b * 2 + dir) * 4 + h, ch = dir ? hg_bwd_chunk(tb) : tb;
              K.AC()[((size_t)chain * HG_NCH + ch) * 64 + d] = __expf(LF[(dir * 64 + (dir ? 0 : 63)) * HG_LFS + d]); } }
        __syncthreads();
        { const int dir = K.wave >> 2, mi = K.wave & 3; const int chain = (b * 2 + dir) * 4 + h, ch = dir ? hg_bwd_chunk(tb) : tb;
          f32x4 acc[4];
#pragma unroll
          for (int db = 0; db < 4; ++db) acc[db] = (f32x4){0.f, 0.f, 0.f, 0.f};
#pragma unroll
          for (int ks = 0; ks < 2; ++ks) {
              const bf16x8_t vv = *(const bf16x8_t*)(VT + hg_sw(16 * mi + r16, 32 * ks + 8 * g4));
#pragma unroll
              for (int db = 0; db < 4; ++db) { const bf16x8_t kv = *(const bf16x8_t*)(KT + dir * 64 * HG_TS + hg_sw(16 * db + r16, 32 * ks + 8 * g4)); acc[db] = MFMA16(kv, vv, acc[db]); }
          }
          bf16_t* st = K.STB() + ((size_t)chain * HG_NCH + ch) * 4096 + (size_t)K.lane * 8;
#pragma unroll
          for (int ks = 0; ks < 2; ++ks) { const u32x4 w = (u32x4){pk2(acc[2 * ks][0], acc[2 * ks][1]), pk2(acc[2 * ks][2], acc[2 * ks][3]), pk2(acc[2 * ks + 1][0], acc[2 * ks + 1][1]), pk2(acc[2 * ks + 1][2], acc[2 * ks + 1][3])};
              *(u32x4*)(st + (mi * 2 + ks) * 512) = w; }
        }
    }
}
DI void ph_hgrn_B(Ctx& K) {
    const int per = ((16 * 2048 + K.nb - 1) / K.nb + 63) & ~63;
    const int gt = K.bid * per + K.tid;
    if (K.tid < per && gt < 16 * 2048) {
        const int chain = gt >> 11, dw = gt & 2047, m = dw & 3, lane = (dw >> 2) & 63, ks = (dw >> 8) & 1;
        const int d0 = 32 * ks + 16 * (m >> 1) + 4 * (lane >> 4) + 2 * (m & 1);
        unsigned* st = (unsigned*)(K.STB() + (size_t)chain * HG_NCH * 4096) + dw; const float* ac = K.AC() + (size_t)chain * HG_NCH * 64 + d0;
        float S0 = 0.f, S1 = 0.f;
#pragma unroll 1
        for (int c0 = 0; c0 < HG_NCH; c0 += 26) {
            unsigned u[26]; float a0[26], a1[26];
#pragma unroll
            for (int i = 0; i < 26; ++i) { u[i] = st[(size_t)(c0 + i) * 2048]; const u32x2 av = *(const u32x2*)(ac + (c0 + i) * 64); a0[i] = __uint_as_float(av.x); a1[i] = __uint_as_float(av.y); }
#pragma unroll
            for (int i = 0; i < 26; ++i) { st[(size_t)(c0 + i) * 2048] = pk2(S0, S1); S0 = a0[i] * S0 + __uint_as_float(u[i] << 16); S1 = a1[i] * S1 + __uint_as_float(u[i] & 0xffff0000u); }
        }
    }
}
struct HgInC { u32x2 q[2][2]; u32x4 gq; u32x4 st[8]; };
DI void ph_hgrn_C(Ctx& K) {
    float* LF = (float*)(K.lds + HGL_LF); float* OM = (float*)(K.lds + HGL_OM); bf16_t* VT = (bf16_t*)(K.lds + HGL_VT); bf16_t* KP = (bf16_t*)(K.lds + HGL_KT); float* OD = (float*)(K.lds + HGL_OD);
    bf16_t* SC = (bf16_t*)(K.lds + HGL_SC) + K.wave * 16 * HG_TS;
    const int r16 = K.lane & 15, g4 = K.lane >> 4, dir = K.wave >> 2, mi = K.wave & 3;
    if (K.bid >= HG_NIT) return;
    HgIn in; HgInC ic;
    hg_load(K, K.bid, in);
#define HGC_LOAD_Q(it_) do { int b_, h_, tb_; hg_item(it_, b_, h_, tb_); const bf16_t* qr = K.P() + (size_t)hg_block_row(b_, tb_, 16 * mi + r16) * PW + C_HQ + h_ * 64 + 4 * g4; \
        _Pragma("unroll") for (int ks = 0; ks < 2; ++ks) { ic.q[ks][0] = *(const u32x2*)(qr + 32 * ks); ic.q[ks][1] = *(const u32x2*)(qr + 32 * ks + 16); } } while (0)
#define HGC_LOAD_ST(it_) do { int b_, h_, tb_; hg_item(it_, b_, h_, tb_); const int chain_ = (b_ * 2 + dir) * 4 + h_, ch_ = dir ? hg_bwd_chunk(tb_) : tb_; \
        const bf16_t* sp = K.STB() + ((size_t)chain_ * HG_NCH + ch_) * 4096 + (size_t)K.lane * 8; _Pragma("unroll") for (int i_ = 0; i_ < 8; ++i_) ic.st[i_] = *(const u32x4*)(sp + i_ * 512); } while (0)
#define HGC_LOAD_G(it_) do { int b_, h_, tb_; hg_item(it_, b_, h_, tb_); const int tok_ = K.tid >> 3, c_ = K.tid & 7; \
        ic.gq = *(const u32x4*)(K.P() + (size_t)hg_block_row(b_, tb_, tok_) * PW + C_HG + h_ * 64 + 8 * c_); } while (0)
    HGC_LOAD_Q(K.bid); HGC_LOAD_ST(K.bid); HGC_LOAD_G(K.bid);
#pragma unroll 1
    for (int item = K.bid; item < HG_NIT; item += K.nb) {
        int b, h, tb; hg_item(item, b, h, tb);
        const int nxt = item + K.nb < HG_NIT ? item + K.nb : item;
        __syncthreads();
        hg_prep1(K, h, in);
        hg_load(K, nxt, in);
        hg_prep2(K);
        {
          const int tok = K.tid >> 3, c = K.tid & 7;
#pragma unroll
          for (int dd = 0; dd < 2; ++dd) { const float* rf = LF + (dd * 64 + 32) * HG_LFS + 8 * c; const float* bs = LF + (dd * 64 + tok) * HG_LFS + 8 * c; const float* om = OM + (dd * 64 + tok) * HG_LFS + 8 * c;
              unsigned o[4];
#pragma unroll
              for (int j = 0; j < 4; ++j) o[j] = pk2(om[2 * j] * __expf(rf[2 * j] - bs[2 * j]), om[2 * j + 1] * __expf(rf[2 * j + 1] - bs[2 * j + 1]));
              *(u32x4*)(KP + (dd * 64 + tok) * HG_TS + 8 * c) = (u32x4){o[0], o[1], o[2], o[3]}; } }
        __syncthreads();
        f32x4 nw0, nw1;
        { const float* LFd = LF + dir * 64 * HG_LFS; const float* ref = LFd + 32 * HG_LFS;
          bf16x8_t aq1[2], aq2[2];
          { const int t = 16 * mi + r16;
#pragma unroll
            for (int ks = 0; ks < 2; ++ks) { unsigned o1[4], o2[4];
#pragma unroll
                for (int hf = 0; hf < 2; ++hf) { const int d0 = 32 * ks + 16 * hf + 4 * g4; const unsigned qw[2] = {ic.q[ks][hf].x, ic.q[ks][hf].y};
                    const f32x4 bt = *(const f32x4*)(LFd + t * HG_LFS + d0), rf = *(const f32x4*)(ref + d0);
#pragma unroll
                    for (int j = 0; j < 2; ++j) { const float qa = __uint_as_float(qw[j] << 16), qb = __uint_as_float(qw[j] & 0xffff0000u); const float sa = qa * sigmoidf_(qa), sb = qb * sigmoidf_(qb);
                        const float e1a = __expf(bt[2 * j] - rf[2 * j]), e1b = __expf(bt[2 * j + 1] - rf[2 * j + 1]), e2a = __expf(bt[2 * j]), e2b = __expf(bt[2 * j + 1]);
                        o1[2 * hf + j] = pk2(sa * e1a, sb * e1b); o2[2 * hf + j] = pk2(sa * e2a, sb * e2b); } }
                aq1[ks] = __builtin_bit_cast(bf16x8_t, (u32x4){o1[0], o1[1], o1[2], o1[3]}); aq2[ks] = __builtin_bit_cast(bf16x8_t, (u32x4){o2[0], o2[1], o2[2], o2[3]}); } }
          HGC_LOAD_Q(nxt);
          f32x4 sc[4];
#pragma unroll
          for (int nj = 0; nj < 4; ++nj) { sc[nj] = (f32x4){0.f, 0.f, 0.f, 0.f}; const bf16_t* kr = KP + (dir * 64 + 16 * nj + r16) * HG_TS + 4 * g4;
#pragma unroll
              for (int ks = 0; ks < 2; ++ks) { const u32x2 k0 = *(const u32x2*)(kr + 32 * ks), k1 = *(const u32x2*)(kr + 32 * ks + 16);
                  sc[nj] = MFMA16(aq1[ks], __builtin_bit_cast(bf16x8_t, (u32x4){k0.x, k0.y, k1.x, k1.y}), sc[nj]); } }
#pragma unroll
          for (int nj = 0; nj < 4; ++nj)
#pragma unroll
              for (int rg = 0; rg < 4; ++rg) { const int tl = 4 * g4 + rg, t = 16 * mi + tl, s_ = 16 * nj + r16; const bool keep = dir ? (s_ >= t) : (s_ <= t);
                  SC[tl * HG_TS + s_] = f2bf(keep ? sc[nj][rg] : 0.f); }
          asm volatile("s_waitcnt lgkmcnt(0)" ::: "memory");
          f32x4 oacc[4];
#pragma unroll
          for (int nj = 0; nj < 4; ++nj) oacc[nj] = (f32x4){0.f, 0.f, 0.f, 0.f};
#pragma unroll
          for (int ks = 0; ks < 2; ++ks) {
              const bf16x8_t as = *(const bf16x8_t*)(SC + r16 * HG_TS + 32 * ks + 8 * g4);
#pragma unroll
              for (int nj = 0; nj < 4; ++nj) {
                  const bf16x8_t bv = *(const bf16x8_t*)(VT + hg_sw(16 * nj + r16, 32 * ks + 8 * g4));
                  oacc[nj] = MFMA16(as, bv, oacc[nj]);
                  oacc[nj] = MFMA16(aq2[ks], __builtin_bit_cast(bf16x8_t, ic.st[nj * 2 + ks]), oacc[nj]);
              }
          }
          HGC_LOAD_ST(nxt);
          { const float* nwp = ARG(hgrn_norm_w) + (size_t)K.l * 256 + h * 64 + 8 * (K.tid & 7); nw0 = *(const f32x4*)nwp; nw1 = *(const f32x4*)(nwp + 4); }
#pragma unroll
          for (int nj = 0; nj < 4; ++nj)
#pragma unroll
              for (int rg = 0; rg < 4; ++rg) OD[(dir * 64 + 16 * mi + 4 * g4 + rg) * HG_LFS + 16 * nj + r16] = oacc[nj][rg];
        }
        __syncthreads();
        { const int tok = K.tid >> 3, c = K.tid & 7; const int row = hg_block_row(b, tb, tok);
          const float* o0 = OD + tok * HG_LFS + 8 * c; const float* o1 = OD + (64 + tok) * HG_LFS + 8 * c;
          float o[8], ss = 0.f;
#pragma unroll
          for (int j = 0; j < 8; ++j) { o[j] = o0[j] + o1[j]; ss += o[j] * o[j]; }
          ss += __shfl_xor(ss, 1); ss += __shfl_xor(ss, 2); ss += __shfl_xor(ss, 4);
          const float rs = rsqrtf(ss * (1.0f / 64.0f) + EPS);
          float gq[8]; unpack8(ic.gq, gq);
          const float nw[8] = {nw0[0], nw0[1], nw0[2], nw0[3], nw1[0], nw1[1], nw1[2], nw1[3]};
          float y[8];
#pragma unroll
          for (int j = 0; j < 8; ++j) y[j] = o[j] * rs * nw[j] * gq[j] * sigmoidf_(gq[j]);
          HGC_LOAD_G(nxt);
          u32x4 w; w.x = pk2(y[0], y[1]); w.y = pk2(y[2], y[3]); w.z = pk2(y[4], y[5]); w.w = pk2(y[6], y[7]);
          *(u32x4*)(K.MIX() + (size_t)row * D + MX_H + h * 64 + 8 * c) = w; }
    }
#undef HGC_LOAD_Q
#undef HGC_LOAD_ST
#undef HGC_LOAD_G
}

constexpr int AT_TS = 72;
constexpr int ATL_K = 0, ATL_V = ATL_K + 64 * AT_TS * 2, ATL_P = ATL_V + 64 * AT_TS * 2, ATL_END = ATL_P + 8 * 48 * AT_TS * 2;
static_assert(ATL_END <= LDS_BYTES - 256, "attention LDS map");
DI float dpp_max16(float x) { x = fmaxf(x, dpp_<0xB1>(x)); x = fmaxf(x, dpp_<0x4E>(x)); x = fmaxf(x, dpp_<0x141>(x)); x = fmaxf(x, dpp_<0x128>(x)); return x; }
DI float dpp_sum16(float x) { x += dpp_<0xB1>(x); x += dpp_<0x4E>(x); x += dpp_<0x141>(x); x += dpp_<0x128>(x); return x; }
DI unsigned cvtpk(float lo, float hi) { unsigned r; asm("v_cvt_pk_bf16_f32 %0, %1, %2" : "=v"(r) : "v"(lo), "v"(hi)); return r; }
DI float xg4_max(float x) { x = fmaxf(x, __shfl_xor(x, 16)); x = fmaxf(x, __shfl_xor(x, 32)); return x; }
template <int MT, int NJ, bool SAMEKB> DI void at_softmax_pv(f32x4 (&sT)[MT][NJ], float (&mrun)[MT], float (&lrun)[MT], f32x4 (&oacc)[MT][4], const bf16_t* VT, const int (&kb)[MT], int r16, int g4) {
    unsigned pb[MT][NJ / 2][4];
#pragma unroll
    for (int mt = 0; mt < MT; ++mt) {
        float mx = -INFINITY;
#pragma unroll
        for (int nj = 0; nj < NJ; ++nj) mx = fmaxf(mx, fmaxf(fmaxf(sT[mt][nj][0], sT[mt][nj][1]), fmaxf(sT[mt][nj][2], sT[mt][nj][3])));
        mx = xg4_max(mx);
        const float mn = fmaxf(mrun[mt], mx), alpha = __expf(mrun[mt] - mn); mrun[mt] = mn;
        float rs_ = 0.f;
#pragma unroll
        for (int nj = 0; nj < NJ; ++nj)
#pragma unroll
            for (int rg = 0; rg < 4; ++rg) { const float pe = __expf(sT[mt][nj][rg] - mn); sT[mt][nj][rg] = pe; rs_ += pe; }
        lrun[mt] = lrun[mt] * alpha + rs_;
#pragma unroll
        for (int ne = 0; ne < 4; ++ne) oacc[mt][ne] *= alpha;
#pragma unroll
        for (int ks = 0; ks < NJ / 2; ++ks) { pb[mt][ks][0] = cvtpk(sT[mt][2 * ks][0], sT[mt][2 * ks][1]); pb[mt][ks][1] = cvtpk(sT[mt][2 * ks][2], sT[mt][2 * ks][3]);
            pb[mt][ks][2] = cvtpk(sT[mt][2 * ks + 1][0], sT[mt][2 * ks + 1][1]); pb[mt][ks][3] = cvtpk(sT[mt][2 * ks + 1][2], sT[mt][2 * ks + 1][3]); }
    }
#pragma unroll
    for (int ks = 0; ks < NJ / 2; ++ks)
#pragma unroll
        for (int ne = 0; ne < 4; ++ne) { const int e = 16 * ne + r16, sw = (e >> 3) & 7;
            u32x4 vf_shared;
            if (SAMEKB) { const int blk = (kb[0] >> 3) + 4 * ks + (g4 >> 1); const u32x2 v0 = *(const u32x2*)(VT + e * AT_TS + ((blk ^ sw) << 3) + 4 * (g4 & 1)), v1 = *(const u32x2*)(VT + e * AT_TS + (((blk + 2) ^ sw) << 3) + 4 * (g4 & 1));
                vf_shared = (u32x4){v0.x, v0.y, v1.x, v1.y}; }
#pragma unroll
            for (int mt = 0; mt < MT; ++mt) { u32x4 vf = vf_shared;
                if (!SAMEKB) { const int blk = (kb[mt] >> 3) + 4 * ks + (g4 >> 1); const u32x2 v0 = *(const u32x2*)(VT + e * AT_TS + ((blk ^ sw) << 3) + 4 * (g4 & 1)), v1 = *(const u32x2*)(VT + e * AT_TS + (((blk + 2) ^ sw) << 3) + 4 * (g4 & 1));
                    vf = (u32x4){v0.x, v0.y, v1.x, v1.y}; }
                oacc[mt][ne] = MFMA16(__builtin_bit_cast(bf16x8_t, vf), __builtin_bit_cast(bf16x8_t, (u32x4){pb[mt][ks][0], pb[mt][ks][1], pb[mt][ks][2], pb[mt][ks][3]}), oacc[mt][ne]); } }
}
template <int KIND> DI void attn_item(Ctx& K, int idx, const float* sinkp, const float* rpbp) {
    constexpr int MT = KIND == 0 ? 3 : 2;
    int tid_ = K.tid; asm volatile("" : "+v"(tid_));
    const int lane_ = tid_ & 63, wave_ = tid_ >> 6;
    bf16_t* KT = (bf16_t*)(K.lds + ATL_K); bf16_t* VT = (bf16_t*)(K.lds + ATL_V); float* RPB = (float*)(K.lds + ATL_P);
    const int r16 = lane_ & 15, g4 = lane_ >> 4;
    int b, hk, qb = 0;
    if (KIND == 0) { qb = idx & 127; hk = (idx >> 7) & 1; b = idx >> 8; }
    else if (KIND == 1) { qb = idx & 63; hk = (idx >> 6) % 6; b = (idx >> 6) / 6; }
    else { hk = idx % 6; b = idx / 6; }
    const int kcol = (KIND == 0) ? C_SK + hk * 64 : (KIND == 2) ? C_SK + (hk / 3) * 64 : C_NK + hk * 64;
    const int vcol = (KIND == 0) ? C_SV + hk * 64 : (KIND == 2) ? C_SV + (hk / 3) * 64 : C_NV + hk * 64;
    int t0 = 0, nloc = 0;
    if (KIND == 0) { const int k0 = max(2 * qb - 2, 0), k1 = min(2 * qb + 3, L / 64 - 1); t0 = k0; nloc = k1 - k0 + 1; }
    if (KIND == 1) { const int k0 = min(max(4 * qb - 4, 0), L / 64 - 8), k1 = min(max(4 * qb + 3 - 4, 0), L / 64 - 8) + 7; t0 = k0; nloc = k1 - k0 + 1; }
    const int ntiles = nloc + CL / 64;
    int w_r = 0, w_rs = 0;
    if (KIND == 1) { w_r = 4 * qb + (wave_ >> 1); w_rs = min(max(w_r - 4, 0), L / 64 - 8); }
    bf16x8_t qf[MT][2]; int qbase[MT], hq_mt[MT], qrow[MT];
#pragma unroll
    for (int mt = 0; mt < MT; ++mt) {
        int arow, hq;
        if (KIND == 0) { const int rho = wave_ * 48 + mt * 16; hq = hk * 3 + rho / 128; hq_mt[mt] = hq; const int tb = 128 * qb + (rho & 127); arow = lat_row(b, tb + r16); qbase[mt] = tb; }
        else if (KIND == 1) { hq = hk; hq_mt[mt] = hq; const int cb = 32 * (wave_ & 1) + 16 * mt; arow = lat_row(b, w_r * 64 + cb + r16); qbase[mt] = cb; }
        else { hq = hk; hq_mt[mt] = hq; const int tb = wave_ * 32 + mt * 16; arow = ctx_row(b, tb + r16); qbase[mt] = 0; }
        qrow[mt] = arow;
        const int qcol = (KIND == 0 || KIND == 2) ? C_SQ + hq * 64 : C_NQ + hq * 64;
#pragma unroll
        for (int ks = 0; ks < 2; ++ks) { float q[8]; unpack8(*(const u32x4*)(K.P() + (size_t)arow * PW + qcol + 32 * ks + 8 * g4), q);
            const u32x4 w = (u32x4){pk2(q[0] * 0.125f, q[1] * 0.125f), pk2(q[2] * 0.125f, q[3] * 0.125f), pk2(q[4] * 0.125f, q[5] * 0.125f), pk2(q[6] * 0.125f, q[7] * 0.125f)};
            qf[mt][ks] = __builtin_bit_cast(bf16x8_t, w); }
    }
    f32x4 oacc[MT][4]; float mrun[MT], lrun[MT];
#pragma unroll
    for (int mt = 0; mt < MT; ++mt) {
#pragma unroll
        for (int ne = 0; ne < 4; ++ne) oacc[mt][ne] = (f32x4){0.f, 0.f, 0.f, 0.f};
        const bool has_sink = (KIND == 0 || KIND == 2);
        mrun[mt] = has_sink ? sinkp[hq_mt[mt]] : -1.0e30f; lrun[mt] = (has_sink && g4 == 0) ? 1.0f : 0.0f;
    }
    const int lkey = tid_ >> 3, lch = tid_ & 7;
    u32x4 pk_, pv_;
    { const int ti = 0; const int grow = (ti < nloc) ? lat_row(b, (t0 + ti) * 64 + lkey) : ctx_row(b, (ti - nloc) * 64 + lkey);
      const bf16_t* pr = K.P() + (size_t)grow * PW + 8 * lch; pk_ = *(const u32x4*)(pr + kcol); pv_ = *(const u32x4*)(pr + vcol); }
#pragma unroll 1
    for (int ti = 0; ti < ntiles; ++ti) {
        __syncthreads();
        *(u32x4*)(KT + lkey * AT_TS + 8 * lch) = pk_;
        { const unsigned w[4] = {pv_.x, pv_.y, pv_.z, pv_.w};
          const int vsw = (((lkey >> 3) ^ lch) << 3) + (lkey & 7);
#pragma unroll
          for (int j = 0; j < 4; ++j) { VT[(8 * lch + 2 * j) * AT_TS + vsw] = (bf16_t)(w[j] & 0xffffu); VT[(8 * lch + 2 * j + 1) * AT_TS + vsw] = (bf16_t)(w[j] >> 16); } }
        if (KIND == 1 && ti == 0 && tid_ < 15 * 31) RPB[tid_] = rpbp[tid_];
        __syncthreads();
        if (ti + 1 < ntiles) { const int tn = ti + 1; const int grow = (tn < nloc) ? lat_row(b, (t0 + tn) * 64 + lkey) : ctx_row(b, (tn - nloc) * 64 + lkey);
            const bf16_t* pr = K.P() + (size_t)grow * PW + 8 * lch; pk_ = *(const u32x4*)(pr + kcol); pv_ = *(const u32x4*)(pr + vcol); }
        const bool local = ti < nloc; const int kunit = t0 + ti;
        if (KIND == 1 && local) {
            if ((kunit >= w_rs) && (kunit < w_rs + 8)) {
                f32x4 sT[MT][2]; int kb[MT];
#pragma unroll
                for (int mt = 0; mt < MT; ++mt) { kb[mt] = min(max(qbase[mt] - 8, 0), 32);
#pragma unroll
                    for (int nj = 0; nj < 2; ++nj) { sT[mt][nj] = (f32x4){0.f, 0.f, 0.f, 0.f};
#pragma unroll
                        for (int ks = 0; ks < 2; ++ks) { const bf16x8_t kf = *(const bf16x8_t*)(KT + (kb[mt] + 16 * nj + r16) * AT_TS + 32 * ks + 8 * g4); sT[mt][nj] = MFMA16(kf, qf[mt][ks], sT[mt][nj]); } } }
                const float* rp = RPB + (kunit - w_r + 7) * 31 + 15;
#pragma unroll
                for (int mt = 0; mt < MT; ++mt) { const int c = qbase[mt] + r16, ws = min(max(c - 8, 0), 48);
#pragma unroll
                    for (int nj = 0; nj < 2; ++nj)
#pragma unroll
                        for (int rg = 0; rg < 4; ++rg) { const int key = kb[mt] + 16 * nj + 4 * g4 + rg; const bool ok = key >= ws && key < ws + 16;
                            sT[mt][nj][rg] = ok ? sT[mt][nj][rg] + rp[ok ? key - c : 0] : -INFINITY; } }
                at_softmax_pv<MT, 2, false>(sT, mrun, lrun, oacc, VT, kb, r16, g4);
            }
        } else {
            f32x4 sT[MT][4];
#pragma unroll
            for (int mt = 0; mt < MT; ++mt)
#pragma unroll
                for (int nj = 0; nj < 4; ++nj) sT[mt][nj] = (f32x4){0.f, 0.f, 0.f, 0.f};
#pragma unroll
            for (int nj = 0; nj < 4; ++nj)
#pragma unroll
                for (int ks = 0; ks < 2; ++ks) { const bf16x8_t kf = *(const bf16x8_t*)(KT + (16 * nj + r16) * AT_TS + 32 * ks + 8 * g4);
#pragma unroll
                    for (int mt = 0; mt < MT; ++mt) sT[mt][nj] = MFMA16(kf, qf[mt][ks], sT[mt][nj]); }
            if (KIND == 0 && local) {
#pragma unroll
                for (int mt = 0; mt < MT; ++mt) { const int dq = qbase[mt] + r16 - kunit * 64 - 4 * g4;
#pragma unroll
                    for (int nj = 0; nj < 4; ++nj)
#pragma unroll
                        for (int rg = 0; rg < 4; ++rg) { const int dl = dq - (16 * nj + rg); if (dl > 128 || dl < -128) sT[mt][nj][rg] = -INFINITY; } }
            }
            int kb0[MT];
#pragma unroll
            for (int mt = 0; mt < MT; ++mt) kb0[mt] = 0;
            at_softmax_pv<MT, 4, true>(sT, mrun, lrun, oacc, VT, kb0, r16, g4);
        }
    }
#pragma unroll
    for (int mt = 0; mt < MT; ++mt) {
        float l = lrun[mt]; l += __shfl_xor(l, 16); l += __shfl_xor(l, 32);
        const float inv = 1.0f / l;
        const int ocol = ((KIND == 0 || KIND == 2) ? MX_S : MX_N) + hq_mt[mt] * 64;
#pragma unroll
        for (int ne = 0; ne < 4; ++ne) { u32x2 o; o.x = cvtpk(oacc[mt][ne][0] * inv, oacc[mt][ne][1] * inv); o.y = cvtpk(oacc[mt][ne][2] * inv, oacc[mt][ne][3] * inv);
            *(u32x2*)(K.MIX() + (size_t)qrow[mt] * D + ocol + 16 * ne + 4 * g4) = o; }
    }
}
DI void ph_attn(Ctx& K) {
    constexpr int N_SWA = NB * 2 * (L / 128), N_NAT = NB * 6 * (L / 256), N_C = NB * 6;
    const float* sinkp = ARG(swa_sink) + K.l * 6;
    for (int item = K.bid; item < N_SWA + N_NAT + 2 * N_C; item += K.nb) {
        if (item < N_SWA) attn_item<0>(K, item, sinkp, nullptr);
        else if (item < N_SWA + N_NAT) { const int it = item - N_SWA; const int h = (it >> 6) % 6; attn_item<1>(K, it, nullptr, ARG(nat_rpb) + ((size_t)K.l * 6 + h) * 15 * 31); }
        else if (item < N_SWA + N_NAT + N_C) attn_item<2>(K, item - N_SWA - N_NAT, sinkp, nullptr);
        else attn_item<3>(K, item - N_SWA - N_NAT - N_C, nullptr, nullptr);
    }
}

DI unsigned fkey(float f) { const unsigned u = __float_as_uint(f); return (u & 0x80000000u) ? ~u : (u | 0x80000000u); }
DI int mbcnt64(unsigned long long m) { return (int)__builtin_amdgcn_mbcnt_hi((unsigned)(m >> 32), __builtin_amdgcn_mbcnt_lo((unsigned)m, 0u)); }
template <int NV> DI unsigned radix_thr16(const unsigned (&k)[NV]) {
    unsigned prefix = 0u;
#pragma unroll 1
    for (int bit = 31; bit >= 0; --bit) {
        const unsigned cand = prefix | (1u << bit); int cnt = 0;
#pragma unroll
        for (int i = 0; i < NV; ++i) cnt += __popcll(__ballot(k[i] >= cand));
        if (cnt >= 16) { prefix = cand; if (cnt == 16) break; }
    }
    return prefix;
}
template <int NC, int NV> DI void radix_thr16_multi(const unsigned (&k)[NC][NV], unsigned (&T)[NC]) {
    bool exact[NC];
#pragma unroll
    for (int c = 0; c < NC; ++c) { T[c] = 0u; exact[c] = false; }
#pragma unroll 1
    for (int bit = 31; bit >= 0; --bit) {
        bool all = true;
#pragma unroll
        for (int c = 0; c < NC; ++c) {
            const unsigned cand = T[c] | (1u << bit); int cnt = 0;
#pragma unroll
            for (int i = 0; i < NV; ++i) cnt += __popcll(__ballot(k[c][i] >= cand));
            if (cnt >= 16) { T[c] = cand; exact[c] = (cnt == 16); }
            all = all && exact[c];
        }
        if (all) break;
    }
}
template <int NV> DI void select16(const unsigned (&k)[NV], unsigned T, bool (&sel)[NV], int (&pos)[NV]) {
    int ngt = 0; unsigned long long gtm[NV], eqm[NV];
#pragma unroll
    for (int i = 0; i < NV; ++i) { gtm[i] = __ballot(k[i] > T); eqm[i] = __ballot(k[i] == T); ngt += __popcll(gtm[i]); }
    const int need = 16 - ngt; int eqbase = 0, selbase = 0;
#pragma unroll
    for (int i = 0; i < NV; ++i) {
        const bool iseq = k[i] == T; const int erank = eqbase + mbcnt64(eqm[i]); eqbase += __popcll(eqm[i]);
        sel[i] = (k[i] > T) || (iseq && erank < need);
        const unsigned long long sm = __ballot(sel[i]); pos[i] = selbase + mbcnt64(sm); selbase += __popcll(sm);
    }
}
template <int CTRL> DI int dppi_(int x) { return __builtin_amdgcn_mov_dpp(x, CTRL, 0xf, 0xf, true); }
DI int row_sum_i(int x) { x += dppi_<0xB1>(x); x += dppi_<0x4E>(x); x += dppi_<0x141>(x); x += dppi_<0x128>(x); return x; }
DI int row_excl_scan_i(int x) { int s_ = x; s_ += dppi_<0x111>(s_); s_ += dppi_<0x112>(s_); s_ += dppi_<0x114>(s_); s_ += dppi_<0x118>(s_); return s_ - x; }
DI unsigned row_minmax_u(unsigned x, bool want_max) {
    unsigned y;
    y = (unsigned)dppi_<0xB1>((int)x); x = want_max ? max(x, y) : min(x, y); y = (unsigned)dppi_<0x4E>((int)x); x = want_max ? max(x, y) : min(x, y);
    y = (unsigned)dppi_<0x141>((int)x); x = want_max ? max(x, y) : min(x, y); y = (unsigned)dppi_<0x128>((int)x); x = want_max ? max(x, y) : min(x, y);
    return x;
}
template <int NK> DI unsigned row_radix_thr16(const unsigned (&k)[NK]) {
    unsigned lm = k[0];
#pragma unroll
    for (int i = 1; i < NK; ++i) lm = max(lm, k[i]);
    unsigned lo = row_minmax_u(lm, false), hi = row_minmax_u(lm, true) + 1u;
    bool done = false;
#pragma unroll 1
    for (int itn = 0; itn < 40; ++itn) {
        const unsigned span = hi - lo; done = done || (span <= 1u);
        const unsigned mid = lo + (span >> 1); int cnt = 0;
#pragma unroll
        for (int i = 0; i < NK; ++i) cnt += (k[i] >= mid) ? 1 : 0;
        cnt = row_sum_i(cnt);
        const bool ge = cnt >= 16;
        if (!done) { if (ge) lo = mid; else hi = mid; }
        done = done || (cnt == 16);
        if (__ballot(!done) == 0ull) break;
    }
    return lo;
}
template <int NK> DI void row_select16(const unsigned (&k)[NK], unsigned T, bool (&sel)[NK], int (&pos)[NK]) {
    int g = 0, q = 0;
#pragma unroll
    for (int i = 0; i < NK; ++i) { g += (k[i] > T) ? 1 : 0; q += (k[i] == T) ? 1 : 0; }
    const int need = 16 - row_sum_i(g);
    const int a = min(max(need - row_excl_scan_i(q), 0), q);
    int nxt = row_excl_scan_i(g + a), eqs = 0;
#pragma unroll
    for (int i = 0; i < NK; ++i) { const bool iseq = k[i] == T; sel[i] = (k[i] > T) || (iseq && eqs < a); eqs += iseq ? 1 : 0; pos[i] = nxt; nxt += sel[i] ? 1 : 0; }
}
DI void ce_desc(unsigned& x, unsigned& y) { const unsigned hi = max(x, y), lo = min(x, y); x = hi; y = lo; }
DI void sort8_desc(unsigned (&a)[8]) {
    ce_desc(a[0], a[1]); ce_desc(a[2], a[3]); ce_desc(a[4], a[5]); ce_desc(a[6], a[7]); ce_desc(a[0], a[2]); ce_desc(a[1], a[3]); ce_desc(a[4], a[6]); ce_desc(a[5], a[7]);
    ce_desc(a[1], a[2]); ce_desc(a[5], a[6]); ce_desc(a[0], a[4]); ce_desc(a[3], a[7]); ce_desc(a[1], a[5]); ce_desc(a[2], a[6]); ce_desc(a[1], a[4]); ce_desc(a[3], a[6]);
    ce_desc(a[2], a[4]); ce_desc(a[3], a[5]); ce_desc(a[3], a[4]); }
DI void sort4_desc(unsigned (&a)[4]) { ce_desc(a[0], a[1]); ce_desc(a[2], a[3]); ce_desc(a[0], a[2]); ce_desc(a[1], a[3]); ce_desc(a[1], a[2]); }
DI float fkey_inv(unsigned k) { return __uint_as_float((k & 0x80000000u) ? (k & 0x7fffffffu) : ~k); }
DI void cex_(unsigned& k, int& ix, unsigned pk, int pi, bool lower) { const bool take = lower ? (pk > k) : (pk < k); k = take ? pk : k; ix = take ? pi : ix; }
template <int CTRL> DI void cex_dpp(unsigned& k, int& ix, bool lower) { const unsigned pk = (unsigned)dppi_<CTRL>((int)k); const int pi = dppi_<CTRL>(ix); cex_(k, ix, pk, pi, lower); }
DI void row_sort16_desc(unsigned& k, int& ix, int j16) {
    const bool l1 = (j16 & 1) == 0, l2 = (j16 & 2) == 0, l4 = (j16 & 4) == 0, l8 = (j16 & 8) == 0;
    cex_dpp<0xB1>(k, ix, l1);
    cex_dpp<0x1B>(k, ix, l2); cex_dpp<0xB1>(k, ix, l1);
    cex_dpp<0x141>(k, ix, l4); cex_dpp<0x4E>(k, ix, l2); cex_dpp<0xB1>(k, ix, l1);
    cex_dpp<0x140>(k, ix, l8);
    { const unsigned pk = (unsigned)__builtin_amdgcn_ds_swizzle((int)k, 0x101F); const int pi = __builtin_amdgcn_ds_swizzle(ix, 0x101F); cex_(k, ix, pk, pi, l4); }
    cex_dpp<0x4E>(k, ix, l2); cex_dpp<0xB1>(k, ix, l1);
}
constexpr int PSL_SK = 0, PSL_TOP = 131072;
static_assert(PSL_TOP + 8 * 1024 <= LDS_BYTES - 256, "peer select LDS map");
template <int PROBE> DI void ph_peer_select(Ctx& K) {
    float* TOPV = (float*)(K.lds + PSL_TOP + K.wave * 1024); int* TOPI = (int*)(TOPV + 128);
    const int r16 = K.lane & 15, g4 = K.lane >> 4, j16 = r16;
    const int nhg = K.nb < 8 ? K.nb : 8, grp = K.bid % nhg, jw = K.bid / nhg, nj = (K.nb - grp + nhg - 1) / nhg;
    constexpr int N_T = M / 16;
    const int nwv = nj * 8, wg = jw * 8 + K.wave;
    const int n_full = (N_T / nwv) * nwv, n_work = n_full + 4 * (N_T - n_full);
    for (int h = grp; h < 8; h += nhg) {
        __syncthreads();
        { const u32x4* sh = (const u32x4*)(K.SKH() + ((size_t)K.l * 8 + h) * 2 * 16384); const u32x4* sl = (const u32x4*)(K.SKL() + ((size_t)K.l * 8 + h) * 2 * 16384);
          u32x4* dst = (u32x4*)(K.lds + PSL_SK);
          u32x4 t[8];
#pragma unroll
          for (int i = 0; i < 8; ++i) t[i] = sh[K.tid + 512 * i];
#pragma unroll
          for (int i = 0; i < 8; ++i) dst[K.tid + 512 * i] = t[i];
#pragma unroll
          for (int i = 0; i < 8; ++i) t[i] = sl[K.tid + 512 * i];
#pragma unroll
          for (int i = 0; i < 8; ++i) dst[4096 + K.tid + 512 * i] = t[i]; }
        __syncthreads();
#pragma unroll 1
        for (int wk = wg; wk < n_work; wk += nwv) {
            const bool part = wk >= n_full; const int tile = part ? n_full + ((wk - n_full) >> 2) : wk; const int rg_lo = part ? ((wk - n_full) & 3) : 0, rg_hi = part ? rg_lo + 1 : 4;
            const int t0 = tile * 16;
            float S[2][8][4];
#pragma unroll
            for (int p = 0; p < 2; ++p) {
                bf16x8_t aq[4];
                { const bf16_t* qp = K.QP() + (size_t)(t0 + r16) * 2048 + h * 256 + p * 128 + 8 * g4;
#pragma unroll
                  for (int ks = 0; ks < 4; ++ks) aq[ks] = *(const bf16x8_t*)(qp + 32 * ks); }
                const unsigned char* kb = K.lds + PSL_SK + p * 32768 + K.lane * 16;
#pragma unroll
                for (int nt = 0; nt < 8; ++nt) {
                    f32x4 c0 = {0.f, 0.f, 0.f, 0.f}, c1 = c0;
#pragma unroll
                    for (int ks = 0; ks < 4; ++ks) { const bf16x8_t bh = *(const bf16x8_t*)(kb + (nt * 4 + ks) * 1024), bl = *(const bf16x8_t*)(kb + 65536 + (nt * 4 + ks) * 1024);
                        c0 = MFMA16(aq[ks], bh, c0); c1 = MFMA16(aq[ks], bl, c1); }
#pragma unroll
                    for (int rg = 0; rg < 4; ++rg) S[p][nt][rg] = c0[rg] + c1[rg];
                }
            }
            if (PROBE == 1) { float a = 0.f;
#pragma unroll
                for (int p = 0; p < 2; ++p)
#pragma unroll
                    for (int nt = 0; nt < 8; ++nt) a += S[p][nt][0] + S[p][nt][1] + S[p][nt][2] + S[p][nt][3];
                TOPV[K.lane] = a; continue; }
#pragma unroll 1
            for (int rg = 0; rg < 4; ++rg) {
                if (rg >= rg_lo && rg < rg_hi) {
                    unsigned a[2][8], mine[2] = {0u, 0u};
#pragma unroll
                    for (int p = 0; p < 2; ++p) {
#pragma unroll
                        for (int i = 0; i < 8; ++i) a[p][i] = (fkey(S[p][i][0]) & 0xFFFFFF80u) | (unsigned)(j16 + 16 * i);
                        sort8_desc(a[p]); }
#pragma unroll 1
                    for (int it = 0; it < 16; ++it) {
#pragma unroll
                        for (int p = 0; p < 2; ++p) { const unsigned m = row_minmax_u(a[p][0], true); const bool win = a[p][0] == m;
#pragma unroll
                            for (int i = 0; i < 7; ++i) a[p][i] = win ? a[p][i + 1] : a[p][i];
                            a[p][7] = win ? 0u : a[p][7];
                            mine[p] = (j16 == it) ? m : mine[p]; }
                    }
                    unsigned* TA = (unsigned*)TOPV + (g4 * 2) * 16; unsigned* TB = TA + 16;
                    TA[j16] = mine[0]; TB[j16] = mine[1];
                    asm volatile("s_waitcnt lgkmcnt(0)" ::: "memory");
                    { const int r = t0 + 4 * g4 + rg, t = j16;
                      int ci[4], cj[4];
                      ci[0] = 0; cj[0] = t;
                      ci[1] = t < 8 ? 1 : t; cj[1] = t < 8 ? t : 0;
                      ci[2] = t <= 4 ? 2 : t <= 8 ? 3 : t <= 11 ? 4 : t <= 13 ? 5 : 6; cj[2] = t <= 4 ? t : t <= 8 ? t - 5 : t <= 11 ? t - 9 : t <= 13 ? t - 12 : t - 14;
                      ci[3] = 7; cj[3] = t & 1;
                      unsigned c[4];
#pragma unroll
                      for (int q = 0; q < 4; ++q) { const float cv = fkey_inv(TA[ci[q]] & 0xFFFFFF80u) + fkey_inv(TB[cj[q]] & 0xFFFFFF80u); c[q] = (fkey(cv) & 0xFFFFFFC0u) | (unsigned)(t * 4 + q); }
                      if (t > 1) c[3] = 0u;
                      sort4_desc(c);
                      unsigned w = 0u;
#pragma unroll 1
                      for (int it = 0; it < 16; ++it) { const unsigned m = row_minmax_u(c[0], true); const bool win = c[0] == m;
                          c[0] = win ? c[1] : c[0]; c[1] = win ? c[2] : c[1]; c[2] = win ? c[3] : c[2]; c[3] = win ? 0u : c[3];
                          w = (j16 == it) ? m : w; }
                      const float val = fkey_inv(w & 0xFFFFFFC0u); const int tw = (int)(w >> 2) & 15, qw = (int)w & 3;
                      const int i2 = tw <= 4 ? 2 : tw <= 8 ? 3 : tw <= 11 ? 4 : tw <= 13 ? 5 : 6, j2 = tw <= 4 ? tw : tw <= 8 ? tw - 5 : tw <= 11 ? tw - 9 : tw <= 13 ? tw - 12 : tw - 14;
                      const int wi = qw == 0 ? 0 : qw == 1 ? (tw < 8 ? 1 : tw) : qw == 2 ? i2 : 7, wj = qw == 0 ? tw : qw == 1 ? (tw < 8 ? tw : 0) : qw == 2 ? j2 : (tw & 1);
                      const int e = (int)(TA[wi] & 127u) * 128 + (int)(TB[wj] & 127u);
                      const float mx = dpp_max16(val);
                      const float ex = __expf(val - mx), es = dpp_sum16(ex);
                      K.PIDX()[(size_t)r * 128 + h * 16 + j16] = e; K.PG()[(size_t)r * 128 + h * 16 + j16] = ex / es;
                    }
                    asm volatile("s_waitcnt lgkmcnt(0)" ::: "memory");
                }
#pragma unroll
                for (int p = 0; p < 2; ++p)
#pragma unroll
                    for (int i = 0; i < 8; ++i) { S[p][i][0] = S[p][i][1]; S[p][i][1] = S[p][i][2]; S[p][i][2] = S[p][i][3]; }
            }
        }
    }
}

constexpr int PU_NR = 4;
constexpr int PUL_H = 0, PUL_SLOT = 2 * PU_NR * 1024, PUL_STRIDE = PUL_SLOT + 256;
struct PuMeta { float hs[PU_NR]; int ia[PU_NR], ib[PU_NR]; };
DI void pu_load(const Ctx& K, int r0, int step, PuMeta& m, unsigned char* hbuf) {
    int rr[PU_NR];
#pragma unroll
    for (int q = 0; q < PU_NR; ++q) rr[q] = min(r0 + q * step, M - 1);
    __builtin_amdgcn_global_load_lds((const unsigned*)(K.H8() + (size_t)rr[0] * D + K.lane * 16), (LAS unsigned*)hbuf, 16, 0, 0);
    __builtin_amdgcn_global_load_lds((const unsigned*)(K.H8() + (size_t)rr[1] * D + K.lane * 16 - 1024), (LAS unsigned*)hbuf, 16, 1024, 0);
    __builtin_amdgcn_global_load_lds((const unsigned*)(K.H8() + (size_t)rr[2] * D + K.lane * 16 - 2048), (LAS unsigned*)hbuf, 16, 2048, 0);
    __builtin_amdgcn_global_load_lds((const unsigned*)(K.H8() + (size_t)rr[3] * D + K.lane * 16 - 3072), (LAS unsigned*)hbuf, 16, 3072, 0);
#pragma unroll
    for (int q = 0; q < PU_NR; ++q) { m.hs[q] = K.HS()[rr[q]]; m.ia[q] = K.PIDX()[(size_t)rr[q] * 128 + K.lane]; m.ib[q] = K.PIDX()[(size_t)rr[q] * 128 + 64 + K.lane]; }
}
typedef int i32x4 __attribute__((ext_vector_type(4)));
DI int sel4i(const i32x4 v, int k) { return k == 0 ? v[0] : k == 1 ? v[1] : k == 2 ? v[2] : v[3]; }
template <int PROBE> DI void pu_item(const Ctx& K, const unsigned char* U, unsigned char* HL, int* SLOT, int R, int r0, int step, const PuMeta& m, int r16, int g4, float& dummy) {
    bool sa[PU_NR], sb[PU_NR]; int ra[PU_NR], rb[PU_NR]; int n = 0;
#pragma unroll
    for (int q = 0; q < PU_NR; ++q) { const bool live = r0 + q * step < M; sa[q] = live && (m.ia[q] >> 11) == R; sb[q] = live && (m.ib[q] >> 11) == R; const unsigned long long ma = __ballot(sa[q]), mb = __ballot(sb[q]);
        ra[q] = n + mbcnt64(ma); n += __popcll(ma); rb[q] = n + mbcnt64(mb); n += __popcll(mb); }
    const int E = r16 >> 2, qq = r16 & 3, rho = r16 >> 2;
    const float hsm = rho == 0 ? m.hs[0] : rho == 1 ? m.hs[1] : rho == 2 ? m.hs[2] : m.hs[3];
#pragma unroll 1
    for (int base = 0; base < n; base += 32) {
#pragma unroll
        for (int q = 0; q < PU_NR; ++q) {
            if (sa[q] && ra[q] >= base && ra[q] < base + 32) { SLOT[2 * (ra[q] - base)] = m.ia[q]; SLOT[2 * (ra[q] - base) + 1] = q * 128 + K.lane; }
            if (sb[q] && rb[q] >= base && rb[q] < base + 32) { SLOT[2 * (rb[q] - base)] = m.ib[q]; SLOT[2 * (rb[q] - base) + 1] = q * 128 + 64 + K.lane; } }
        asm volatile("s_waitcnt lgkmcnt(0)" ::: "memory");
        const bool two = base + 16 < n;
        i32x4 av[8][4];
#pragma unroll
        for (int t = 0; t < 4; ++t) { const int sl = 4 * t + E; const int e = (base + sl < n) ? SLOT[2 * sl] : SLOT[0]; const unsigned char* up = U + ((unsigned)e * (unsigned)D + (unsigned)(64 * g4 + 16 * qq));
#pragma unroll
            for (int s_ = 0; s_ < 4; ++s_) av[t][s_] = *(const i32x4*)(up + 256 * s_); }
        if (two) {
#pragma unroll
            for (int t = 4; t < 8; ++t) { const int sl = 4 * t + E; const int e = (base + sl < n) ? SLOT[2 * sl] : SLOT[0]; const unsigned char* up = U + ((unsigned)e * (unsigned)D + (unsigned)(64 * g4 + 16 * qq));
#pragma unroll
                for (int s_ = 0; s_ < 4; ++s_) av[t][s_] = *(const i32x4*)(up + 256 * s_); } }
        bool fin[2]; int fcode[2]; float fus[2], fvs[2];
#pragma unroll
        for (int p2 = 0; p2 < 2; ++p2) { const int sl = 4 * (4 * p2 + qq) + g4; fin[p2] = false; fcode[p2] = 0; fus[p2] = 0.f; fvs[p2] = 0.f;
            if (base + sl < n) { const int code = SLOT[2 * sl + 1];
                if ((code >> 7) == rho) { const size_t eo = (size_t)K.l * 16384 + SLOT[2 * sl]; fin[p2] = true; fcode[p2] = code; fus[p2] = K.US()[eo]; fvs[p2] = K.VS()[eo]; } } }
        i32x4 hb[4];
#pragma unroll
        for (int s_ = 0; s_ < 4; ++s_) hb[s_] = *(const i32x4*)(HL + rho * 1024 + 64 * g4 + 16 * qq + 256 * s_);
        int w0, w1 = 0;
        { int rs[4];
#pragma unroll
          for (int t = 0; t < 4; ++t) { i32x4 acc = {0, 0, 0, 0};
#pragma unroll
              for (int s_ = 0; s_ < 4; ++s_) acc = __builtin_amdgcn_mfma_i32_16x16x64_i8(av[t][s_], hb[s_], acc, 0, 0, 0);
              int v = sel4i(acc, qq); v += dppi_<0xB1>(v); v += dppi_<0x4E>(v); rs[t] = v; }
          w0 = qq == 0 ? rs[0] : qq == 1 ? rs[1] : qq == 2 ? rs[2] : rs[3]; }
        if (two) { int rs[4];
#pragma unroll
            for (int t = 0; t < 4; ++t) { i32x4 acc = {0, 0, 0, 0};
#pragma unroll
                for (int s_ = 0; s_ < 4; ++s_) acc = __builtin_amdgcn_mfma_i32_16x16x64_i8(av[4 + t][s_], hb[s_], acc, 0, 0, 0);
                int v = sel4i(acc, qq); v += dppi_<0xB1>(v); v += dppi_<0x4E>(v); rs[t] = v; }
            w1 = qq == 0 ? rs[0] : qq == 1 ? rs[1] : qq == 2 ? rs[2] : rs[3]; }
#pragma unroll
        for (int p2 = 0; p2 < 2; ++p2) {
            const int di = p2 ? w1 : w0;
            if (fin[p2]) { const int code = fcode[p2];
                const float d = (float)di * fus[p2] * hsm;
                if (PROBE >= 2) dummy += gelu_erf(d);
                else (PROBE ? K.ST() : K.PA())[(size_t)(r0 + (code >> 7) * step) * 128 + (code & 127)] = gelu_erf(d) * fvs[p2]; }
        }
        asm volatile("s_waitcnt lgkmcnt(0)" ::: "memory");
    }
}
#define PU_TOUCH(m_) asm volatile("" :: "v"(m_.hs[0]), "v"(m_.hs[1]), "v"(m_.hs[2]), "v"(m_.hs[3]), "v"(m_.ia[0]), "v"(m_.ia[1]), "v"(m_.ia[2]), "v"(m_.ia[3]), "v"(m_.ib[0]), "v"(m_.ib[1]), "v"(m_.ib[2]), "v"(m_.ib[3]))
template <int PROBE> DI void ph_peer_u(Ctx& K) {
    const unsigned char* U = (const unsigned char*)K.UB() + (size_t)K.l * 16384 * D;
    unsigned char* HB = K.lds + K.wave * PUL_STRIDE; int* SLOT = (int*)(HB + PUL_SLOT);
    const int r16 = K.lane & 15, g4 = K.lane >> 4;
    const int step = K.nloc * NWAVES;
    float dummy = 0.f;
    for (int R = K.xg; R < 8; R += K.nxg) {
        int r = K.jx * NWAVES + K.wave; int par = 0;
        PuMeta mA, mB; (void)par;
        pu_load(K, r, step, mA, HB);
#pragma unroll 1
        for (; r < M; r += 2 * PU_NR * step) {
            asm volatile("s_waitcnt vmcnt(0)" ::: "memory");
            PU_TOUCH(mA);
            pu_load(K, r + PU_NR * step, step, mB, HB + PU_NR * 1024);
            pu_item<PROBE>(K, U, HB, SLOT, R, r, step, mA, r16, g4, dummy);
            asm volatile("s_waitcnt vmcnt(0)" ::: "memory");
            PU_TOUCH(mB);
            pu_load(K, r + 2 * PU_NR * step, step, mA, HB);
            pu_item<PROBE>(K, U, HB + PU_NR * 1024, SLOT, R, r + PU_NR * step, step, mB, r16, g4, dummy);
        }
    }
    if (PROBE >= 2) K.ST()[K.gw * 64 + K.lane] = dummy;
}
struct PvMeta { int ia, ib; float ga, gb, pa, pb; };
template <int PROBE> DI void pv_load(const Ctx& K, int r, PvMeta& m) {
    m.ia = K.PIDX()[(size_t)r * 128 + K.lane]; m.ib = K.PIDX()[(size_t)r * 128 + 64 + K.lane];
    m.ga = K.PG()[(size_t)r * 128 + K.lane]; m.pa = K.PA()[(size_t)r * 128 + K.lane]; m.gb = K.PG()[(size_t)r * 128 + 64 + K.lane]; m.pb = K.PA()[(size_t)r * 128 + 64 + K.lane];
}
template <int HALF, int PROBE> DI void pv_issue(const unsigned char* V, int slot, unsigned coff, const PvMeta& m, u32x4 (&vv)[8]) {
    const int ix = HALF ? m.ib : m.ia;
#pragma unroll
    for (int i = 0; i < 8; ++i) {
        const int src = ((8 * i + slot) << 2);
        const int e = __builtin_amdgcn_ds_bpermute(src, ix);
        vv[i] = PROBE == 2 ? (u32x4){(unsigned)e, 1u, 2u, 3u} : *(const u32x4*)(V + ((unsigned)e * 128u + coff));
    }
}
DI void tr4x4(unsigned x0, unsigned x1, unsigned x2, unsigned x3, unsigned (&o)[4]) {
    const unsigned a = __builtin_amdgcn_perm(x1, x0, 0x05010400u), b = __builtin_amdgcn_perm(x1, x0, 0x07030602u), c = __builtin_amdgcn_perm(x3, x2, 0x05010400u), d = __builtin_amdgcn_perm(x3, x2, 0x07030602u);
    o[0] = __builtin_amdgcn_perm(c, a, 0x05040100u); o[1] = __builtin_amdgcn_perm(c, a, 0x07060302u); o[2] = __builtin_amdgcn_perm(d, b, 0x05040100u); o[3] = __builtin_amdgcn_perm(d, b, 0x07060302u);
}
DI unsigned u4(const u32x4& v, int d) { return d == 0 ? v.x : d == 1 ? v.y : d == 2 ? v.z : v.w; }
DI float pv_weights(const PvMeta& m, unsigned char* WQ, int lane) {
    const float wa = m.ga * m.pa, wb = m.gb * m.pb;
    float mx = fmaxf(fabsf(wa), fabsf(wb));
    mx = dpp_max16(mx); mx = fmaxf(mx, __shfl_xor(mx, 16)); mx = fmaxf(mx, __shfl_xor(mx, 32));
    const float s_hi = fmaxf(mx, 1e-30f) * (1.0f / 127.0f), i_hi = 1.0f / s_hi, s_lo = s_hi * (1.0f / 254.0f), i_lo = 254.0f * i_hi;
    const float ha = rintf(wa * i_hi), hb = rintf(wb * i_hi);
    const int la = (int)rintf((wa - ha * s_hi) * i_lo), lb = (int)rintf((wb - hb * s_hi) * i_lo);
    const int i = lane >> 3, sl = lane & 7; unsigned char* wp = WQ + (((sl & 1) * 4 + (sl >> 1)) << 4) + i;
    wp[0] = (unsigned char)(int)ha; wp[8] = (unsigned char)(int)hb; wp[128] = (unsigned char)la; wp[136] = (unsigned char)lb;
    return s_lo;
}
template <int PROBE> DI void ph_peer_v(Ctx& K) {
    const int slot = K.lane >> 3, c = K.lane & 7;
    const float* gate = K.MOD() + (size_t)K.l * 3 * 6 * D + 5 * D;
    const int step = K.nloc * NWAVES;
    float* Xb = PROBE ? (float*)K.P() : K.X();
    unsigned char* WQ = K.lds + K.wave * 256;
    float* GPL = (float*)(K.lds + 8 * 256);
    for (int S = K.xg; S < 8; S += K.nxg) {
        const unsigned char* V = (const unsigned char*)K.VB() + ((size_t)K.l * 8 + S) * 16384 * 128;
        const int c0 = S * 128 + c * 16;
        __syncthreads();
        for (int i = K.tid; i < 3 * 128; i += NTHREADS) GPL[i] = gate[(size_t)(i >> 7) * 6 * D + S * 128 + (i & 127)];
        __syncthreads();
        const int r0 = K.jx * NWAVES + K.wave;
        const int nit = r0 < M ? (M - 1 - r0) / step + 1 : 0;
        PvMeta mA, mB; pv_load<PROBE>(K, min(r0, M - 1), mA); pv_load<PROBE>(K, min(r0 + step, M - 1), mB);
        f32x4 xq[4], xprev[4], x2[4]; float yp[16]; int rp = -1; PvMeta m2;
#pragma unroll
        for (int q = 0; q < 4; ++q) { xq[q] = *(const f32x4*)(Xb + (size_t)min(r0, M - 1) * D + c0 + 4 * q); xprev[q] = (f32x4){0.f, 0.f, 0.f, 0.f}; }
#pragma unroll
        for (int q = 0; q < 16; ++q) yp[q] = 0.f;
#define PV_BODY(XPREV, XQ, XNEW, MA, MC, IT) do { \
            const int r = r0 + (IT) * step; \
            { const float zdep = MA.ga * 0.0f; \
                f32x4 gp[4]; { const f32x4* gl = (const f32x4*)(GPL + modvec_of_row(max(rp, 0)) * 128 + (K.lane & 7) * 16); _Pragma("unroll") for (int q = 0; q < 4; ++q) gp[q] = gl[q]; } \
                _Pragma("unroll") for (int q = 0; q < 4; ++q) { XPREV[q].x += gp[q].x * yp[4 * q] + zdep; XPREV[q].y += gp[q].y * yp[4 * q + 1] + zdep; XPREV[q].z += gp[q].z * yp[4 * q + 2] + zdep; XPREV[q].w += gp[q].w * yp[4 * q + 3] + zdep; } \
                if (rp >= 0 && slot == 0) { float* xr = Xb + (size_t)rp * D + c0; \
                    _Pragma("unroll") for (int q = 0; q < 4; ++q) *(f32x4*)(xr + 4 * q) = XPREV[q]; } } \
            __builtin_amdgcn_sched_barrier(0); \
            const float s_lo = pv_weights(MA, WQ, K.lane); \
            u32x4 vA[8], vB[8]; \
            pv_issue<0, PROBE>(V, slot, (unsigned)c * 16u, MA, vA); \
            pv_issue<1, PROBE>(V, slot, (unsigned)c * 16u, MA, vB); \
            __builtin_amdgcn_sched_barrier(0); \
            { const float* xr = Xb + (size_t)min(r + step, M - 1) * D + c0; \
              _Pragma("unroll") for (int q = 0; q < 4; ++q) XNEW[q] = *(const f32x4*)(xr + 4 * q); } \
            pv_load<PROBE>(K, min(r + 2 * step, M - 1), MC); \
            __builtin_amdgcn_sched_barrier(0); \
            const i32x4 wq = *(const i32x4*)(WQ + ((((K.lane & 3) << 2) + (K.lane >> 4)) << 4)); \
            _Pragma("unroll") for (int d = 0; d < 4; ++d) { unsigned t0[4], t1[4], t2[4], t3[4]; \
                tr4x4(u4(vA[0], d), u4(vA[1], d), u4(vA[2], d), u4(vA[3], d), t0); tr4x4(u4(vA[4], d), u4(vA[5], d), u4(vA[6], d), u4(vA[7], d), t1); \
                tr4x4(u4(vB[0], d), u4(vB[1], d), u4(vB[2], d), u4(vB[3], d), t2); tr4x4(u4(vB[4], d), u4(vB[5], d), u4(vB[6], d), u4(vB[7], d), t3); \
                _Pragma("unroll") for (int bb = 0; bb < 4; ++bb) { const i32x4 bj = {(int)t0[bb], (int)t1[bb], (int)t2[bb], (int)t3[bb]}; \
                    const i32x4 dd = __builtin_amdgcn_mfma_i32_16x16x64_i8(wq, bj, (i32x4){0, 0, 0, 0}, 0, 0, 0); \
                    const int te = __mul24(dd[0], 254) + dd[2], to = __mul24(dd[1], 254) + dd[3];        \
                    const int tt = te + dppi_<0x128>(to);                                                    \
                    yp[4 * d + bb] = (float)tt * s_lo; } \
                __builtin_amdgcn_sched_barrier(0); } \
            rp = r; } while (0)
        f32x4 (*xfin)[4] = nullptr; (void)xfin;
        int it = 0;
#pragma unroll 1
        for (; it + 2 < nit; it += 3) {
            PV_BODY(xprev, xq, x2, mA, m2, it);
            PV_BODY(xq, x2, xprev, mB, mA, it + 1);
            PV_BODY(x2, xprev, xq, m2, mB, it + 2);
        }
        if (it < nit) { PV_BODY(xprev, xq, x2, mA, m2, it); ++it;
            if (it < nit) { PV_BODY(xq, x2, xprev, mB, mA, it); ++it;
#pragma unroll
                for (int q = 0; q < 4; ++q) xprev[q] = x2[q]; }
            else {
#pragma unroll
                for (int q = 0; q < 4; ++q) xprev[q] = xq[q]; } }
#undef PV_BODY
        if (rp >= 0) { const int mv = modvec_of_row(rp); f32x4 gp[4];
#pragma unroll
            for (int q = 0; q < 4; ++q) gp[q] = *(const f32x4*)(gate + (size_t)mv * 6 * D + c0 + 4 * q);
            if (slot == 0) { float* xr = Xb + (size_t)rp * D + c0;
#pragma unroll
                for (int q = 0; q < 4; ++q) { f32x4 x = xprev[q];
                    x.x += gp[q].x * yp[4 * q]; x.y += gp[q].y * yp[4 * q + 1]; x.z += gp[q].z * yp[4 * q + 2]; x.w += gp[q].w * yp[4 * q + 3]; *(f32x4*)(xr + 4 * q) = x; } } }
    }
}

DI void ph_final(Ctx& K) {
    for (int r = K.gw; r < NLAT; r += K.ngw) {
        const f32x4* xr = (const f32x4*)(K.X() + (size_t)(NCTX + r) * D); f32x4* o = (f32x4*)(((float*)argp_<float>(K, (unsigned)__builtin_offsetof(Args, out))) + (size_t)r * D);
        f32x4 v[4]; float ss = 0.f;
#pragma unroll
        for (int j = 0; j < 4; ++j) { v[j] = xr[j * 64 + K.lane]; ss += v[j].x * v[j].x + v[j].y * v[j].y + v[j].z * v[j].z + v[j].w * v[j].w; }
        ss = wave_sum(ss); const float rs = rsqrtf(ss * (1.0f / D) + EPS);
#pragma unroll
        for (int j = 0; j < 4; ++j) { const f32x4 w = ((const f32x4*)ARG(final_norm_w))[j * 64 + K.lane]; o[j * 64 + K.lane] = v[j] * rs * w; }
    }
}

#define XB_TMO      128
#define XB_XSUB(j)  (1280 + 64 * (j))
#define XB_XGEN(j)  (2304 + 64 * (j))
#define XB_TOP      3328
#define XB_TOPGEN   3392
#define XB_SPIN_CAP (1u << 22)
constexpr int CW_BAR = 4096;
DI unsigned xb_ld(unsigned* p)              { return __hip_atomic_load(p, __ATOMIC_RELAXED, __HIP_MEMORY_SCOPE_AGENT); }
DI unsigned xb_add(unsigned* p, unsigned v) { return __hip_atomic_fetch_add(p, v, __ATOMIC_RELAXED, __HIP_MEMORY_SCOPE_AGENT); }
#define XB_SPIN(cond, bar) do { unsigned _sp = 0; while (cond) { __builtin_amdgcn_s_sleep(1); \
    if ((++_sp & 255u) == 0u) { if (xb_ld(&(bar)[XB_TMO])) break; if (_sp > XB_SPIN_CAP) { atomicAdd(&(bar)[XB_TMO], 1u); break; } } } } while (0)
DI void xcd_barrier(unsigned* bar, unsigned x, unsigned nloc, unsigned nx, int tid) {
    asm volatile("s_waitcnt vmcnt(0)" ::: "memory");
    __syncthreads();
    if (tid == 0) {
        __builtin_amdgcn_s_waitcnt(0);
        const unsigned old = xb_add(&bar[XB_XSUB(x)], 1u);
        const unsigned gen = old / nloc;
        if (old + 1u == (gen + 1u) * nloc) {
            __builtin_amdgcn_fence(__ATOMIC_RELEASE, "agent");
            asm volatile("s_waitcnt vmcnt(0)" ::: "memory");
            const unsigned og = xb_add(&bar[XB_TOP], 1u);
            const unsigned tg = og / nx;
            if (og + 1u == (tg + 1u) * nx) xb_add(&bar[XB_TOPGEN], 1u);
            else XB_SPIN(xb_ld(&bar[XB_TOPGEN]) == tg, bar);
            __builtin_amdgcn_fence(__ATOMIC_ACQUIRE, "agent");
            xb_add(&bar[XB_XGEN(x)], 1u);
            asm volatile("s_waitcnt vmcnt(0)" ::: "memory");
        } else {
            XB_SPIN(xb_ld(&bar[XB_XGEN(x)]) == gen, bar);
            __builtin_amdgcn_fence(__ATOMIC_ACQUIRE, "agent");
            asm volatile("s_waitcnt vmcnt(0)" ::: "memory");
        }
    }
    __syncthreads();
}

constexpr int PROBE_U = 0, PROBE_V = 0, PROBE_S = 0;
constexpr unsigned DUP_MASK = 0u;
constexpr int PH_PER_LAYER = 12, N_PHASES = 2 + PH_PER_LAYER * DEPTH;
__global__ void __launch_bounds__(NTHREADS) mk_fwd(Args args) {
    extern __shared__ __attribute__((aligned(16))) unsigned char lds[];
    cg::grid_group grid = cg::this_grid();
    constexpr unsigned ARGS_OFF = LDS_BYTES - 256;
    constexpr unsigned MISC_OFF = LDS_BYTES - 64;
    if (threadIdx.x == 0) {
        *(Args*)(lds + ARGS_OFF) = args;
        unsigned* ctl = (unsigned*)(args.ws + WS_CTL); unsigned* misc = (unsigned*)(lds + MISC_OFF);
        const unsigned xcc = (unsigned)__builtin_amdgcn_s_getreg((3 << 11) | 20) & 0xFu;
        misc[0] = xcc; misc[1] = __hip_atomic_fetch_add(ctl + 64 * xcc, 1u, __ATOMIC_RELAXED, __HIP_MEMORY_SCOPE_AGENT);
    }
    __syncthreads();
    const int wid_s = __builtin_amdgcn_readfirstlane((int)threadIdx.x >> 6);
    int rep = 0;
#pragma unroll 1
    for (int ph = 0; ph < N_PHASES; ++ph) {
        unsigned ones = ~0u; asm volatile("" : "+s"(ones));
        int tid = (wid_s << 6) | (int)__builtin_amdgcn_mbcnt_hi(ones, __builtin_amdgcn_mbcnt_lo(ones, 0u)); asm volatile("" : "+v"(tid));
        unsigned aoff = ARGS_OFF; asm volatile("" : "+v"(aoff));
        size_t zoff = 0; asm volatile("" : "+s"(zoff));
        unsigned char* ws = args.ws + zoff;
        int bid = blockIdx.x; asm volatile("" : "+s"(bid)); int nb = gridDim.x; asm volatile("" : "+s"(nb));
        unsigned moff = MISC_OFF; asm volatile("" : "+v"(moff));
        Ctx K; unsigned xcc_s; { const unsigned* misc = (const unsigned*)(lds + moff); xcc_s = __builtin_amdgcn_readfirstlane(misc[0]); K.jx = __builtin_amdgcn_readfirstlane(misc[1]); K.xg = __builtin_amdgcn_readfirstlane(misc[2]); K.nxg = __builtin_amdgcn_readfirstlane(misc[3]); K.nloc = __builtin_amdgcn_readfirstlane(misc[4]); }
        K.aoff = aoff; K.lds = lds; K.tid = tid; K.lane = tid & 63; K.wave = tid >> 6; K.bid = bid; K.nb = nb; K.gw = bid * NWAVES + K.wave; K.ngw = nb * NWAVES;
        K.ws = ws;
        const int l = ph == 0 ? 0 : (ph - 1) / PH_PER_LAYER, k = ph == 0 ? -1 : (ph == N_PHASES - 1 ? -2 : (ph - 1) % PH_PER_LAYER);
        K.l = l;
        if (k == -1) ph_prologue(K);
        else if (k == -2) ph_final(K);
        else if (k == 0) ph_norm(K, ARG(norm_mix_w) + (size_t)l * D, 0);
        else if (k == 1) ph_gemm_store(K, K.H(), K.WIN() + (size_t)l * PW * D, PW, K.P(), K.ROPE());
        else if (k == 2) ph_hgrn_A(K);
        else if (k == 3) ph_attn(K);
        else if (k == 4) ph_hgrn_B(K);
        else if (k == 5) ph_hgrn_C(K);
        else if (k == 6) ph_gemm_resid(K, K.MIX(), K.WOUT() + (size_t)l * D * D, 2);
        else if (k == 7) ph_norm(K, ARG(norm_ffn_w) + (size_t)l * D, 3);
        else if (k == 8) ph_gemm_store(K, K.H(), K.WQ() + (size_t)l * 2048 * D, 2048, K.QP(), nullptr);
        else if (k == 9) { ph_peer_select<0>(K); if (PROBE_S) ph_peer_select<PROBE_S>(K); }
        else if (k == 10) { ph_peer_u<0>(K); if (PROBE_U) ph_peer_u<PROBE_U>(K); }
        else if (k == 11) { ph_peer_v<0>(K); if (PROBE_V) ph_peer_v<PROBE_V>(K); }
        if (k >= 0 && ((DUP_MASK >> k) & 1u)) { ++rep; if (rep < 2) { --ph; continue; } } rep = 0;
        if (ph == 0) grid.sync();
        else if (k != 2 && ph != N_PHASES - 1) xcd_barrier((unsigned*)(args.ws + WS_CTL) + CW_BAR, xcc_s, (unsigned)K.nloc, (unsigned)K.nxg, tid);
        if (ph == 0) {
            if (tid == 0) { unsigned* ctl = (unsigned*)(args.ws + WS_CTL); unsigned* misc = (unsigned*)(lds + MISC_OFF); const unsigned xcc = misc[0]; unsigned ord = 0, npop = 0, mine = 1;
                for (unsigned q = 0; q < 16; ++q) { const unsigned cq = __hip_atomic_load(ctl + 64 * q, __ATOMIC_RELAXED, __HIP_MEMORY_SCOPE_AGENT); if (cq) { ++npop; if (q < xcc) ++ord; } if (q == xcc) mine = cq; }
                misc[2] = ord; misc[3] = npop ? npop : 1u; misc[4] = mine ? mine : 1u; }
            __syncthreads();
        }
    }
}

extern "C" void kernel_launch(void* const* d_in, const int* in_sizes, int n_in, void* d_out, int out_size, void* d_ws, size_t ws_size, hipStream_t stream) {
    static int grid = 0;
    if (grid == 0) {
        if (n_in != 19 || out_size != NLAT * D || ws_size < WS_END) { fprintf(stderr, "kernel_launch: unexpected shapes (n_in %d out %d ws %zu need %zu)\n", n_in, out_size, ws_size, (size_t)WS_END); grid = -1; return; }
        int dev = 0, cus = 0, per_cu = 0;
        (void)hipGetDevice(&dev); (void)hipDeviceGetAttribute(&cus, hipDeviceAttributeMultiprocessorCount, dev);
        (void)hipFuncSetAttribute((const void*)mk_fwd, hipFuncAttributeMaxDynamicSharedMemorySize, LDS_BYTES);
        (void)hipOccupancyMaxActiveBlocksPerMultiprocessor(&per_cu, (const void*)mk_fwd, NTHREADS, LDS_BYTES);
        if (per_cu < 1) { fprintf(stderr, "kernel_launch: occupancy query says %d blocks/CU\n", per_cu); grid = -1; return; }
        grid = (cus / 8) * 8;
    }
    if (grid < 0) return;
    Args a{};
    a.x = (const float*)d_in[0]; a.c = (const float*)d_in[1]; a.ctx = (const float*)d_in[2]; a.c_ctx = (const float*)d_in[3]; a.w_mod = (const float*)d_in[4]; a.b_mod = (const float*)d_in[5];
    a.norm_mix_w = (const float*)d_in[6]; a.norm_ffn_w = (const float*)d_in[7]; a.w_in = (const float*)d_in[8]; a.lb_logits = (const float*)d_in[9]; a.hgrn_norm_w = (const float*)d_in[10];
    a.swa_sink = (const float*)d_in[11]; a.nat_rpb = (const float*)d_in[12]; a.w_out = (const float*)d_in[13]; a.peer_wq = (const float*)d_in[14]; a.peer_sk = (const float*)d_in[15];
    a.peer_u = (const float*)d_in[16]; a.peer_v = (const float*)d_in[17]; a.final_norm_w = (const float*)d_in[18];
    a.out = (float*)d_out; a.ws = (unsigned char*)d_ws;
    (void)hipMemsetAsync((unsigned char*)d_ws + WS_CTL, 0, CTL_BYTES, stream);
    void* kargs[] = {&a};
    hipError_t e = hipLaunchCooperativeKernel((const void*)mk_fwd, dim3(grid), dim3(NTHREADS), kargs, LDS_BYTES, stream);
    if (e != hipSuccess) fprintf(stderr, "kernel_launch: cooperative launch failed: %s (grid %d)\n", hipGetErrorString(e), grid);
}
```

```cpp
#include <hip/hip_runtime.h>
#include <hip/hip_cooperative_groups.h>
#include <cstdio>
#include <cstdint>
namespace cg = cooperative_groups;
#define DI __device__ __forceinline__
#define GP(T, p) ((T*)(__attribute__((address_space(1))) T*)(p))

typedef unsigned short bf16_t;
typedef float f32x4 __attribute__((ext_vector_type(4)));
typedef unsigned u32x4 __attribute__((ext_vector_type(4)));
typedef unsigned u32x2 __attribute__((ext_vector_type(2)));

constexpr int D = 1024, NB = 2, L = 16384, CL = 256, DEPTH = 4;
constexpr int NCTX = NB * CL, NLAT = NB * L, M = NCTX + NLAT;
constexpr int PW = 3072;
constexpr int C_HQ = 0, C_ZF = 256, C_ZB = 512, C_HV = 768, C_HG = 1024, C_SQ = 1280, C_SK = 1664, C_SV = 1792, C_NQ = 1920, C_NK = 2304, C_NV = 2688;
constexpr int MX_H = 0, MX_S = 256, MX_N = 640;
constexpr float EPS = 1e-6f;
constexpr int NTHREADS = 512, NWAVES = 8;
constexpr int LDS_BYTES = 163840;

constexpr size_t al256(size_t x) { return (x + 255) & ~(size_t)255; }
constexpr size_t WS_X = 0;
constexpr size_t WS_H = WS_X + al256((size_t)M * D * 4);
constexpr size_t WS_P = WS_H + al256((size_t)M * D * 2);
constexpr size_t WS_MIX = WS_P + al256((size_t)M * PW * 2);
constexpr size_t WS_OF = WS_MIX + al256((size_t)M * D * 2);
constexpr size_t WS_OB = WS_OF + al256((size_t)M * 256 * 4);
constexpr size_t WS_PIDX = WS_OB + al256((size_t)M * 256 * 4);
constexpr size_t WS_PG = WS_PIDX + al256((size_t)M * 128 * 4);
constexpr size_t WS_MOD = WS_PG + al256((size_t)M * 128 * 4);
constexpr size_t WS_LB = WS_MOD + al256((size_t)DEPTH * 3 * 6 * D * 4);
constexpr size_t WS_ROPE = WS_LB + al256((size_t)2 * DEPTH * 256 * 4);
constexpr size_t WS_WIN = WS_ROPE + al256((size_t)(256 + 256 + 64 + 64) * 16 * 4);
constexpr size_t WS_WOUT = WS_WIN + al256((size_t)DEPTH * PW * D * 2);
constexpr size_t WS_WQ = WS_WOUT + al256((size_t)DEPTH * D * D * 2);
constexpr size_t WS_AC = WS_WQ + al256((size_t)DEPTH * 2048 * D * 2);
constexpr size_t WS_UB_ = 0; constexpr size_t WS_UB = WS_AC + al256((size_t)16 * 260 * 64 * 4); constexpr size_t WS_UB_OLD = WS_WQ + al256((size_t)DEPTH * 2048 * D * 2);
constexpr size_t WS_VB = WS_UB + al256((size_t)DEPTH * 16384 * D * 2);
constexpr size_t WS_PA = WS_VB + al256((size_t)DEPTH * 16384 * D * 2);
constexpr size_t WS_VS = WS_PA + al256((size_t)M * 128 * 4);
constexpr size_t WS_US = WS_VS + al256((size_t)DEPTH * 16384 * 4);
constexpr size_t WS_H8 = WS_US + al256((size_t)DEPTH * 16384 * 4);
constexpr size_t WS_HS = WS_H8 + al256((size_t)M * D);
constexpr size_t WS_SKH = WS_HS + al256((size_t)M * 4);
constexpr size_t WS_SKL = WS_SKH + al256((size_t)DEPTH * 8 * 2 * 128 * 128 * 2);
constexpr size_t WS_CTL = WS_SKL + al256((size_t)DEPTH * 8 * 2 * 128 * 128 * 2);
constexpr size_t CTL_BYTES = 65536;
constexpr size_t WS_END = WS_CTL + CTL_BYTES;

struct Args {
    const float *x, *c, *ctx, *c_ctx, *w_mod, *b_mod, *norm_mix_w, *norm_ffn_w, *w_in, *lb_logits, *hgrn_norm_w, *swa_sink, *nat_rpb, *w_out, *peer_wq, *peer_sk, *peer_u, *peer_v, *final_norm_w;
    float* out; unsigned char* ws;
};

DI float bf2f(bf16_t v) { return __uint_as_float((unsigned)v << 16); }
DI bf16_t f2bf(float f) { unsigned u = __float_as_uint(f); return (bf16_t)((u + 0x7fffu + ((u >> 16) & 1u)) >> 16); }
DI unsigned pk2(float lo, float hi) { return (unsigned)f2bf(lo) | ((unsigned)f2bf(hi) << 16); }
DI float wave_sum(float v) {
#pragma unroll
    for (int o = 1; o < 64; o <<= 1) v += __shfl_xor(v, o);
    return v;
}
typedef __bf16 bf16x2_t __attribute__((ext_vector_type(2)));
DI float dot2bf(unsigned a, unsigned b, float acc) { return __builtin_amdgcn_fdot2_f32_bf16(__builtin_bit_cast(bf16x2_t, a), __builtin_bit_cast(bf16x2_t, b), acc, false); }
template <int CTRL> DI float dpp_(float x) { return __builtin_bit_cast(float, __builtin_amdgcn_mov_dpp(__builtin_bit_cast(int, x), CTRL, 0xf, 0xf, true)); }
DI float wave_sum_fast(float x) {
    x += dpp_<0xB1>(x); x += dpp_<0x4E>(x); x += dpp_<0x141>(x); x += dpp_<0x128>(x);
    auto s1 = __builtin_amdgcn_permlane16_swap(__float_as_uint(x), __float_as_uint(x), false, false); x = __uint_as_float(s1[0]) + __uint_as_float(s1[1]);
    auto s2 = __builtin_amdgcn_permlane32_swap(__float_as_uint(x), __float_as_uint(x), false, false); return __uint_as_float(s2[0]) + __uint_as_float(s2[1]);
}
DI float sigmoidf_(float z) { return 1.0f / (1.0f + __expf(-z)); }
DI float gelu_erf(float v) { return 0.5f * v * (1.0f + erff(v * 0.70710678118654752f)); }
DI int modvec_of_row(int r) { return r < NCTX ? 2 : (r - NCTX) / L; }
DI int batch_of_row(int r) { return r < NCTX ? r / CL : (r - NCTX) / L; }
DI int lat_row(int b, int t) { return NCTX + b * L + t; }
DI int ctx_row(int b, int s) { return b * CL + s; }
DI void unpack8(const u32x4 w, float* o) {
    o[0] = __uint_as_float(w.x << 16); o[1] = __uint_as_float(w.x & 0xffff0000u);
    o[2] = __uint_as_float(w.y << 16); o[3] = __uint_as_float(w.y & 0xffff0000u);
    o[4] = __uint_as_float(w.z << 16); o[5] = __uint_as_float(w.z & 0xffff0000u);
    o[6] = __uint_as_float(w.w << 16); o[7] = __uint_as_float(w.w & 0xffff0000u);
}
DI void load_row64(const bf16_t* p, float (&o)[64]) {
#pragma unroll
    for (int i = 0; i < 8; ++i) { const u32x4 w = *(const u32x4*)(p + 8 * i); unpack8(w, &o[8 * i]); }
}
DI void rope64(float (&x)[64], const float* cr, const float* sr, const float* cc, const float* sc) {
#pragma unroll
    for (int i = 0; i < 16; ++i) {
        const float c1 = cr[i], s1 = sr[i], a = x[i], b = x[16 + i];
        x[i] = a * c1 - b * s1; x[16 + i] = b * c1 + a * s1;
        const float c2 = cc[i], s2 = sc[i], e = x[32 + i], f = x[48 + i];
        x[32 + i] = e * c2 - f * s2; x[48 + i] = f * c2 + e * s2;
    }
}

namespace pg8 {
#define PG8_LAS __attribute__((address_space(3)))
typedef unsigned short bf16_t;
typedef short bf16x8 __attribute__((ext_vector_type(8)));
typedef float f32x4 __attribute__((ext_vector_type(4)));
typedef unsigned u32x4 __attribute__((ext_vector_type(4)));
constexpr int BM = 256, BK = 64, HALF = 128, HTB = HALF * BK * 2  , STAGE_BYTES = 8 * HTB, NXCD = 8, WGM = 8;

__host__ __device__ __forceinline__ int lds_byte(int r, int c) { const int st = (r >> 4) * 2 + (c >> 5), rr = r & 15, cc = c & 31, ob = rr * 64 + cc * 2; return st * 1024 + (ob ^ (((ob >> 9) & 1) << 5)); }
__host__ __device__ __forceinline__ void stage_rc(int b, int& R, int& C) { const int st = b / 1024, sb = b % 1024, swz = sb ^ (((sb >> 9) & 1) << 5); R = (st >> 1) * 16 + swz / 64; C = (st & 1) * 32 + (swz % 64) / 2; }
__host__ __device__ __forceinline__ int perm32(int rho) { const int n = rho >> 4, i = rho & 15; return 8 * (i >> 2) + 4 * n + (i & 3); }

struct Unit { int pm, pn; };
struct Gemm { const bf16_t* A; const bf16_t* Bt; int M, N, K; };

struct StaticOrder {
    int nM, nN, nwg, G, c;
    __host__ __device__ void init(int M, int N, int G_, int c_) { nM = M / BM; nN = N / BM; nwg = nM * nN; G = G_; c = c_; }
    __host__ __device__ bool next(int i, Unit& u) const {
        const long L = (long)i * G + c; if (L >= nwg) return false;
        int wgid = (int)L; { const int q = nwg / NXCD, r = nwg % NXCD, xcd = wgid % NXCD, off = wgid / NXCD; wgid = (xcd < r ? xcd * (q + 1) : r * (q + 1) + (xcd - r) * q) + off; }
        const int nig = WGM * nN, gid = wgid / nig, fm = gid * WGM, gsz = (nM - fm) < WGM ? (nM - fm) : WGM;
        u.pm = fm + ((wgid % nig) % gsz); u.pn = (wgid % nig) / gsz; return true;
    }
    __device__ __forceinline__ void a_ready(const Unit&) const {}
    __device__ __forceinline__ void done(const Unit&) const {}
};


__device__ __forceinline__ unsigned cvt_pk_bf16(float lo, float hi) { unsigned r; asm volatile("v_cvt_pk_bf16_f32 %0, %1, %2" : "=v"(r) : "v"(lo), "v"(hi)); return r; }
constexpr int EPI_LDS_OFF = STAGE_BYTES, EPI_LDS_WAVE = 2560;
struct EpiStore {
    static constexpr bool PERM = true, AFTER_DRAIN = false;
    bf16_t* O; int ldc; PG8_LAS unsigned char* lds; const float* rope; int nctx, seqlen, rowbase;
    __device__ __forceinline__ void operator()(const f32x4 (&acc)[2][2][4][2], const Unit& u, int wr, int wc, int fr, int fq) const {
        PG8_LAS unsigned char* T = lds + EPI_LDS_OFF + (wr * 4 + wc) * EPI_LDS_WAVE;
        const int lane = fr + 16 * fq, rr = lane >> 2, cc = lane & 3;
        const int row0 = rowbase + u.pm * BM + wr * 64, col0 = u.pn * BM + wc * 32;
        const bool dorope = rope != nullptr && (u.pn == 5 || u.pn == 6) && rowbase + u.pm * BM >= nctx;
#pragma unroll
        for (int ai = 0; ai < 2; ++ai)
#pragma unroll
            for (int m = 0; m < 4; ++m)
#pragma unroll
                for (int bj = 0; bj < 2; ++bj) { const f32x4 v0 = acc[ai][bj][m][0], v1 = acc[ai][bj][m][1];
                    u32x4 w; w.x = cvt_pk_bf16(v0[0], v0[1]); w.y = cvt_pk_bf16(v0[2], v0[3]); w.z = cvt_pk_bf16(v1[0], v1[1]); w.w = cvt_pk_bf16(v1[2], v1[3]);
                    *(PG8_LAS u32x4*)(T + fr * 80 + 16 * fq) = w;
                    asm volatile("s_waitcnt lgkmcnt(0)" ::: "memory");
                    u32x4 o = *(const PG8_LAS u32x4*)(T + rr * 80 + 16 * cc);
                    asm volatile("s_waitcnt lgkmcnt(0)" ::: "memory");
                    const int grow = row0 + ai * HALF + m * 16 + rr;
                    if (dorope) {
                        const int t = (grow - nctx) % seqlen; const bool second = (wc & 1) != 0;
                        const float* ct = rope + (second ? 8192 + (t & 63) * 16 : (t >> 6) * 16) + 8 * (cc & 1); const float* st = ct + (second ? 1024 : 4096);
                        const f32x4 c0 = *(const f32x4*)ct, c1 = *(const f32x4*)(ct + 4), s0 = *(const f32x4*)st, s1 = *(const f32x4*)(st + 4);
                        const float cs[8] = {c0[0], c0[1], c0[2], c0[3], c1[0], c1[1], c1[2], c1[3]}, sn[8] = {s0[0], s0[1], s0[2], s0[3], s1[0], s1[1], s1[2], s1[3]};
                        const unsigned ow[4] = {o.x, o.y, o.z, o.w}; unsigned rw[4];
                        const float sg = cc >= 2 ? 1.0f : -1.0f;
#pragma unroll
                        for (int q = 0; q < 4; ++q) { const unsigned pw = (unsigned)__builtin_amdgcn_mov_dpp((int)ow[q], 0x4E, 0xf, 0xf, true);
                            const float x0 = __uint_as_float(ow[q] << 16), x1 = __uint_as_float(ow[q] & 0xffff0000u), p0 = __uint_as_float(pw << 16), p1 = __uint_as_float(pw & 0xffff0000u);
                            rw[q] = cvt_pk_bf16(x0 * cs[2 * q] + sg * p0 * sn[2 * q], x1 * cs[2 * q + 1] + sg * p1 * sn[2 * q + 1]); }
                        o = (u32x4){rw[0], rw[1], rw[2], rw[3]}; }
                    *(u32x4*)(O + (size_t)grow * ldc + col0 + bj * HALF + 8 * cc) = o; }
    }
};
struct EpiResid {
    static constexpr bool PERM = false, AFTER_DRAIN = false;
    float* X; int ldc; const float* gate; int gstride, nctx, seqlen; PG8_LAS unsigned char* lds; int rowbase; const float* Xin;
    __device__ __forceinline__ void operator()(const f32x4 (&acc)[2][2][4][2], const Unit& u, int wr, int wc, int fr, int fq) const {
        PG8_LAS float* T = (PG8_LAS float*)(lds + EPI_LDS_OFF + (wr * 4 + wc) * EPI_LDS_WAVE);
        const int lane = fr + 16 * fq, rr = lane >> 3, cc = lane & 7;
        const int r0 = rowbase + u.pm * BM; const int vsel = r0 < nctx ? 2 : (r0 - nctx) / seqlen;
        const int row0 = r0 + wr * 64, col0 = u.pn * BM + wc * 32 + 4 * cc;
#pragma unroll
        for (int bj = 0; bj < 2; ++bj) { const f32x4 g = *(const f32x4*)(gate + (size_t)vsel * gstride + col0 + bj * HALF);
#pragma unroll
            for (int ai = 0; ai < 2; ++ai)
#pragma unroll
                for (int m = 0; m < 4; ++m) {
#pragma unroll
                    for (int n = 0; n < 2; ++n) *(PG8_LAS f32x4*)(T + fr * 36 + 16 * n + 4 * fq) = acc[ai][bj][m][n];
                    asm volatile("s_waitcnt lgkmcnt(0)" ::: "memory");
                    const f32x4 t0 = *(const PG8_LAS f32x4*)(T + rr * 36 + 4 * cc), t1 = *(const PG8_LAS f32x4*)(T + (rr + 8) * 36 + 4 * cc);
                    asm volatile("s_waitcnt lgkmcnt(0)" ::: "memory");
                    float* x0 = X + (size_t)(row0 + ai * HALF + m * 16 + rr) * ldc + col0 + bj * HALF; float* x1 = x0 + (size_t)8 * ldc;
                    const float* i0 = Xin + (size_t)(row0 - rowbase + ai * HALF + m * 16 + rr) * ldc + col0 + bj * HALF; const float* i1 = i0 + (size_t)8 * ldc;
                    f32x4 a = *(const f32x4*)i0, b = *(const f32x4*)i1; a += g * t0; b += g * t1; *(f32x4*)x0 = a; *(f32x4*)x1 = b; } }
    }
};

template <class Epi, class Sched, bool ALIGN_EPI = false, bool SP2 = false>
__device__ __forceinline__ void gemm_phase(PG8_LAS unsigned char* lds, const Gemm g, const Sched& S, const Epi& E, int tid_in) {
    int tid_ = tid_in; asm volatile("" : "+v"(tid_));
    const int tid = tid_, wid = __builtin_amdgcn_readfirstlane(tid >> 6), lane = tid & 63, wr = wid >> 2, wc = wid & 3, fr = lane & 15, fq = lane >> 4;
    const int K = g.K, nt = K / BK;
    unsigned voffA[2], voffB[2];
#pragma unroll
    for (int i = 0; i < 2; ++i) { int R, C; stage_rc(tid * 16 + i * 8192, R, C); const int Rb = Epi::PERM ? ((R & ~31) + perm32(R & 31)) : R;
        voffA[i] = (unsigned)(R * K + C) * 2u; voffB[i] = (unsigned)(Rb * K + C) * 2u; }
    const size_t kstep = (size_t)(BK * 2);
    const size_t hstep = (size_t)HALF * K * 2;
    const size_t tstep = 2 * hstep;
    const unsigned ldsw = (unsigned)wid * 1024u;
    const int aoff = lds_byte(wr * 64 + fr, fq * 8), boff = lds_byte(wc * 32 + fr, fq * 8);
#define PG8_SA(b, h) (((b) * 2 + (h)) * HTB)
#define PG8_SB(b, h) ((4 + (b) * 2 + (h)) * HTB)
#define PG8_STAGE(bufoff, gbase, voff) do { _Pragma("unroll") for (int _i = 0; _i < 2; ++_i) \
        __builtin_amdgcn_global_load_lds((const unsigned*)((const char*)(gbase) + (voff)[_i]), (PG8_LAS unsigned*)(lds + (bufoff) + ldsw + _i * 8192), 16, 0, 0); } while (0)
#define PG8_LDA(dst, b, h) do { _Pragma("unroll") for (int m = 0; m < 4; ++m) _Pragma("unroll") for (int k = 0; k < 2; ++k) dst[m][k] = *(const PG8_LAS bf16x8*)(lds + PG8_SA(b, h) + aoff + m * 2048 + k * 1024); } while (0)
#define PG8_LDB(dst, b, h) do { _Pragma("unroll") for (int n = 0; n < 2; ++n) _Pragma("unroll") for (int k = 0; k < 2; ++k) dst[n][k] = *(const PG8_LAS bf16x8*)(lds + PG8_SB(b, h) + boff + n * 2048 + k * 1024); } while (0)
#define PG8_MMA(ai, bj, At, Bt) do { __builtin_amdgcn_s_setprio(1); _Pragma("unroll") for (int m = 0; m < 4; ++m) _Pragma("unroll") for (int n = 0; n < 2; ++n) _Pragma("unroll") for (int k = 0; k < 2; ++k) \
        acc[ai][bj][m][n] = __builtin_amdgcn_mfma_f32_16x16x32_bf16(Bt[n][k], At[m][k], acc[ai][bj][m][n], 0, 0, 0); __builtin_amdgcn_s_setprio(0); } while (0)
#define PG8_WAIT_V(n) asm volatile("s_waitcnt vmcnt(" #n ")" ::: "memory")
#define PG8_WAIT_L(n) asm volatile("s_waitcnt lgkmcnt(" #n ")" ::: "memory")
#define PG8_BAR __builtin_amdgcn_s_barrier()
#define PG8_SCHED __builtin_amdgcn_sched_barrier(0)
    Unit cur, nxt; int ui = 0;
    if (!S.next(0, cur)) return;
    f32x4 acc[2][2][4][2];
#pragma unroll
    for (int a = 0; a < 2; ++a)
#pragma unroll
        for (int b = 0; b < 2; ++b)
#pragma unroll
            for (int m = 0; m < 4; ++m)
#pragma unroll
                for (int n = 0; n < 2; ++n) acc[a][b][m][n] = (f32x4){0.f, 0.f, 0.f, 0.f};
    bf16x8 At[4][2], B0[2][2], B1[2][2];
    const char* cA = (const char*)g.A + (size_t)cur.pm * tstep; const char* cB = (const char*)g.Bt + (size_t)cur.pn * tstep;
    S.a_ready(cur);
    if constexpr (SP2) {
        PG8_STAGE(PG8_SB(0, 0), cB, voffB); PG8_STAGE(PG8_SB(0, 1), cB + hstep, voffB); PG8_STAGE(PG8_SA(0, 0), cA, voffA); PG8_STAGE(PG8_SA(0, 1), cA + hstep, voffA);
        if (wr == 1) PG8_BAR;
        PG8_WAIT_V(2); PG8_BAR;
        PG8_STAGE(PG8_SB(1, 0), cB + kstep, voffB); PG8_STAGE(PG8_SA(1, 0), cA + kstep, voffA); PG8_STAGE(PG8_SB(1, 1), cB + hstep + kstep, voffB);
        PG8_WAIT_V(6); PG8_BAR;
    } else {
        PG8_STAGE(PG8_SB(0, 0), cB, voffB); PG8_STAGE(PG8_SA(0, 0), cA, voffA); PG8_STAGE(PG8_SB(0, 1), cB + hstep, voffB); PG8_STAGE(PG8_SA(0, 1), cA + hstep, voffA);
        if (wr == 1) PG8_BAR;
        PG8_WAIT_V(4); PG8_BAR;
        PG8_STAGE(PG8_SB(1, 0), cB + kstep, voffB); PG8_STAGE(PG8_SA(1, 0), cA + kstep, voffA); PG8_STAGE(PG8_SB(1, 1), cB + hstep + kstep, voffB);
        PG8_WAIT_V(6); PG8_BAR;
    }
    for (;;) {
        const bool has_next = S.next(ui + 1, nxt);
        const char* nA = has_next ? (const char*)g.A + (size_t)nxt.pm * tstep : cA; const char* nB = has_next ? (const char*)g.Bt + (size_t)nxt.pn * tstep : cB;
        for (int t = 0; t < nt; t += 2) {
            const bool last = (t == nt - 2);
            const char* a1 = cA + (size_t)(t + 1) * kstep;
            const char* a2 = last ? nA : cA + (size_t)(t + 2) * kstep; const char* b2 = last ? nB : cB + (size_t)(t + 2) * kstep;
            const char* a3 = a2 + kstep; const char* b3 = b2 + kstep;
            if (last && has_next) S.a_ready(nxt);
            if constexpr (SP2) {
            PG8_LDB(B0, 0, 0); PG8_LDB(B1, 0, 1); PG8_SCHED; PG8_LDA(At, 0, 0); PG8_STAGE(PG8_SA(1, 1), a1 + hstep, voffA);
            PG8_WAIT_V(8); PG8_WAIT_L(0); PG8_BAR; PG8_MMA(0, 0, At, B0); PG8_MMA(0, 1, At, B1); PG8_BAR; PG8_SCHED;
            PG8_LDA(At, 0, 1); PG8_STAGE(PG8_SB(0, 0), b2, voffB); PG8_STAGE(PG8_SB(0, 1), b2 + hstep, voffB); PG8_STAGE(PG8_SA(0, 0), a2, voffA);
            PG8_WAIT_V(8); PG8_WAIT_L(0); PG8_BAR; PG8_MMA(1, 0, At, B0); PG8_MMA(1, 1, At, B1); PG8_BAR; PG8_SCHED;
            PG8_LDB(B0, 1, 0); PG8_LDB(B1, 1, 1); PG8_SCHED; PG8_LDA(At, 1, 0); PG8_STAGE(PG8_SA(0, 1), a2 + hstep, voffA);
            PG8_WAIT_V(8); PG8_WAIT_L(0); PG8_BAR; PG8_MMA(0, 0, At, B0); PG8_MMA(0, 1, At, B1); PG8_BAR; PG8_SCHED;
            PG8_LDA(At, 1, 1); PG8_STAGE(PG8_SB(1, 0), b3, voffB); PG8_STAGE(PG8_SB(1, 1), b3 + hstep, voffB); PG8_STAGE(PG8_SA(1, 0), a3, voffA);
            PG8_WAIT_V(8); PG8_WAIT_L(0); PG8_BAR; PG8_MMA(1, 0, At, B0); PG8_MMA(1, 1, At, B1); PG8_BAR; PG8_SCHED;
            } else {
            PG8_LDB(B0, 0, 0); PG8_SCHED; PG8_LDA(At, 0, 0); PG8_STAGE(PG8_SA(1, 1), a1 + hstep, voffA);
            PG8_WAIT_L(8); PG8_BAR; PG8_WAIT_L(0); PG8_MMA(0, 0, At, B0); PG8_BAR; PG8_SCHED;
            PG8_LDB(B1, 0, 1); PG8_STAGE(PG8_SB(0, 0), b2, voffB);
            PG8_BAR; PG8_WAIT_L(0); PG8_MMA(0, 1, At, B1); PG8_BAR;
            PG8_LDA(At, 0, 1); PG8_STAGE(PG8_SA(0, 0), a2, voffA);
            PG8_BAR; PG8_WAIT_L(0); PG8_MMA(1, 0, At, B0); PG8_BAR; PG8_SCHED;
            PG8_STAGE(PG8_SB(0, 1), b2 + hstep, voffB);
            PG8_WAIT_V(6); PG8_BAR; PG8_MMA(1, 1, At, B1); PG8_BAR;
            PG8_LDB(B0, 1, 0); PG8_SCHED; PG8_LDA(At, 1, 0); PG8_STAGE(PG8_SA(0, 1), a2 + hstep, voffA);
            PG8_WAIT_L(8); PG8_BAR; PG8_WAIT_L(0); PG8_MMA(0, 0, At, B0); PG8_BAR; PG8_SCHED;
            PG8_LDB(B1, 1, 1); PG8_STAGE(PG8_SB(1, 0), b3, voffB);
            PG8_BAR; PG8_WAIT_L(0); PG8_MMA(0, 1, At, B1); PG8_BAR;
            PG8_LDA(At, 1, 1); PG8_STAGE(PG8_SA(1, 0), a3, voffA);
            PG8_BAR; PG8_WAIT_L(0); PG8_MMA(1, 0, At, B0); PG8_BAR; PG8_SCHED;
            PG8_STAGE(PG8_SB(1, 1), b3 + hstep, voffB);
            PG8_WAIT_V(6); PG8_BAR; PG8_MMA(1, 1, At, B1); PG8_BAR;
            }
        }
        if constexpr (ALIGN_EPI) { if (wr == 0) PG8_BAR; }
        if constexpr (!Epi::AFTER_DRAIN) { E(acc, cur, wr, wc, fr, fq); S.done(cur); }
        if (!has_next) break;
#pragma unroll
        for (int a = 0; a < 2; ++a)
#pragma unroll
            for (int b = 0; b < 2; ++b)
#pragma unroll
                for (int m = 0; m < 4; ++m)
#pragma unroll
                    for (int n = 0; n < 2; ++n) acc[a][b][m][n] = (f32x4){0.f, 0.f, 0.f, 0.f};
        cur = nxt; cA = nA; cB = nB; ++ui;
        if constexpr (ALIGN_EPI) { if (wr == 1) PG8_BAR; }
    }
    PG8_WAIT_V(0);
    if constexpr (!ALIGN_EPI) { if (wr == 0) PG8_BAR; }
    PG8_BAR;
    if constexpr (Epi::AFTER_DRAIN) { E.fused(acc, cur, wr, wc, fr, fq, lds, wid, lane); S.done(cur); }
#undef PG8_SA
#undef PG8_SB
#undef PG8_STAGE
#undef PG8_LDA
#undef PG8_LDB
#undef PG8_MMA
#undef PG8_WAIT_V
#undef PG8_WAIT_L
#undef PG8_BAR
#undef PG8_SCHED
}
}

struct Ctx {
    unsigned aoff; int l;
    unsigned char* ws;
    DI float* X() const { return GP(float, ws + WS_X); }
    DI bf16_t* H() const { return GP(bf16_t, ws + WS_H); }
    DI bf16_t* P() const { return GP(bf16_t, ws + WS_P); }
    DI bf16_t* QP() const { return GP(bf16_t, ws + WS_P); }
    DI bf16_t* MIX() const { return GP(bf16_t, ws + WS_MIX); }
    DI float* OF() const { return GP(float, ws + WS_OF); }
    DI float* OB() const { return GP(float, ws + WS_OB); }
    DI int* PIDX() const { return GP(int, ws + WS_PIDX); }
    DI float* PG() const { return GP(float, ws + WS_PG); }
    DI float* MOD() const { return GP(float, ws + WS_MOD); }
    DI float* LB() const { return GP(float, ws + WS_LB); }
    DI float* ROPE() const { return GP(float, ws + WS_ROPE); }
    DI bf16_t* WIN() const { return GP(bf16_t, ws + WS_WIN); }
    DI bf16_t* WOUT() const { return GP(bf16_t, ws + WS_WOUT); }
    DI bf16_t* WQ() const { return GP(bf16_t, ws + WS_WQ); }
    DI bf16_t* UB() const { return GP(bf16_t, ws + WS_UB); }
    DI float* ST() const { return GP(float, ws + WS_OF); }
    DI bf16_t* STB() const { return GP(bf16_t, ws + WS_OF); }
    DI float* AC() const { return GP(float, ws + WS_AC); }
    DI float* PA() const { return GP(float, ws + WS_PA); }
    DI float* VS() const { return GP(float, ws + WS_VS); }
    DI float* US() const { return GP(float, ws + WS_US); }
    DI bf16_t* SKH() const { return GP(bf16_t, ws + WS_SKH); }
    DI bf16_t* SKL() const { return GP(bf16_t, ws + WS_SKL); }
    DI bf16_t* VB() const { return GP(bf16_t, ws + WS_VB); }
    DI unsigned char* H8() const { return GP(unsigned char, ws + WS_H8); }
    DI float* HS() const { return GP(float, ws + WS_HS); }
    unsigned char* lds; int tid, lane, wave, gw, ngw, bid, nb;
    int xg, nxg, jx, nloc;
};

#define LAS __attribute__((address_space(3)))
DI void transpose_item(const float* W, int Kd, int N, bf16_t* WT, LAS float* scr, int item, int lane) {
    const int nblk = N / 32, kb = item / nblk, nb = item % nblk, k0 = 64 * kb, n0 = 32 * nb;
#pragma unroll 8
    for (int i = 0; i < 32; ++i) { const int kk = 2 * i + (lane >> 5); scr[kk * 33 + (lane & 31)] = W[(size_t)(k0 + kk) * N + n0 + (lane & 31)]; }
    asm volatile("s_waitcnt lgkmcnt(0)" ::: "memory");
    const int c = lane & 7;
#pragma unroll
    for (int j = 0; j < 4; ++j) { const int n = (lane >> 3) + 8 * j; const LAS float* sp = scr + (8 * c) * 33 + n;
        u32x4 o; o.x = pk2(sp[0 * 33], sp[1 * 33]); o.y = pk2(sp[2 * 33], sp[3 * 33]); o.z = pk2(sp[4 * 33], sp[5 * 33]); o.w = pk2(sp[6 * 33], sp[7 * 33]);
        *(u32x4*)(WT + (size_t)(n0 + n) * Kd + k0 + 8 * c) = o; }
    asm volatile("s_waitcnt lgkmcnt(0)" ::: "memory");
}

template <class T> DI T* argp_(const Ctx& K, unsigned off) {
    const unsigned* p = (const unsigned*)(K.lds + K.aoff + off);
    const unsigned lo = __builtin_amdgcn_readfirstlane(p[0]), hi = __builtin_amdgcn_readfirstlane(p[1]);
    return GP(T, ((unsigned long long)hi << 32) | (unsigned long long)lo);
}
#define ARG(f) argp_<const float>(K, (unsigned)__builtin_offsetof(Args, f))

DI void ph_prologue(Ctx& K) {
    {
        LAS float* scr = (LAS float*)((LAS unsigned char*)K.lds + K.wave * 16384);
        constexpr int I_IN = (D / 64) * (PW / 32), I_OUT = (D / 64) * (D / 32), I_Q = (D / 64) * (2048 / 32), I_L = I_IN + I_OUT + I_Q;
        for (int it = K.gw; it < DEPTH * I_L; it += K.ngw) {
            const int l = it / I_L; int r = it % I_L;
            if (r < I_IN) { transpose_item(ARG(w_in) + (size_t)l * D * PW, D, PW, K.WIN() + (size_t)l * PW * D, scr, r, K.lane); continue; } r -= I_IN;
            if (r < I_OUT) { transpose_item(ARG(w_out) + (size_t)l * D * D, D, D, K.WOUT() + (size_t)l * D * D, scr, r, K.lane); continue; } r -= I_OUT;
            transpose_item(ARG(peer_wq) + (size_t)l * D * 2048, D, 2048, K.WQ() + (size_t)l * 2048 * D, scr, r, K.lane);
        }
    }
    const size_t gt = (size_t)K.bid * NTHREADS + K.tid, gs = (size_t)K.nb * NTHREADS;
    { const float* sk = ARG(peer_sk);
      for (size_t i = gt; i < (size_t)DEPTH * 8 * 2 * 128 * 128; i += gs) { const float v = sk[i]; const bf16_t hi = f2bf(v);
          const size_t lhp = i >> 14; const int key = (int)(i >> 7) & 127, d = (int)i & 127;
          const size_t o = (((lhp * 8 + (key >> 4)) * 4 + (d >> 5)) * 64 + (key & 15) + 16 * ((d >> 3) & 3)) * 8 + (d & 7);
          K.SKH()[o] = hi; K.SKL()[o] = f2bf(v - bf2f(hi)); } }
    { const float* pu = ARG(peer_u); unsigned char* UQ = (unsigned char*)K.UB();
      for (int row0 = K.gw; row0 < DEPTH * 16384; row0 += 2 * K.ngw) {
          f32x4 v2[2][4];
#pragma unroll
          for (int t = 0; t < 2; ++t) { const int row = min(row0 + t * K.ngw, DEPTH * 16384 - 1); const f32x4* src = (const f32x4*)(pu + (size_t)row * D);
#pragma unroll
              for (int j = 0; j < 4; ++j) v2[t][j] = src[j * 64 + K.lane]; }
#pragma unroll
          for (int t = 0; t < 2; ++t) { const int row = row0 + t * K.ngw; if (row >= DEPTH * 16384) break;
              float mx = 0.f;
#pragma unroll
              for (int j = 0; j < 4; ++j) mx = fmaxf(mx, fmaxf(fmaxf(fabsf(v2[t][j].x), fabsf(v2[t][j].y)), fmaxf(fabsf(v2[t][j].z), fabsf(v2[t][j].w))));
#pragma unroll
              for (int o = 1; o < 64; o <<= 1) mx = fmaxf(mx, __shfl_xor(mx, o));
              const float sc = fmaxf(mx, 1e-30f) * (1.0f / 127.0f), inv = 1.0f / sc;
              if (K.lane == 0) K.US()[row] = sc;
#pragma unroll
              for (int j = 0; j < 4; ++j) { const int col = j * 256 + K.lane * 4; const f32x4 v = v2[t][j];
                  const unsigned q0 = (unsigned)((int)rintf(v.x * inv)) & 0xffu, q1 = (unsigned)((int)rintf(v.y * inv)) & 0xffu, q2 = (unsigned)((int)rintf(v.z * inv)) & 0xffu, q3 = (unsigned)((int)rintf(v.w * inv)) & 0xffu;
                  *(unsigned*)(UQ + (size_t)row * D + col) = q0 | (q1 << 8) | (q2 << 16) | (q3 << 24); } } } }
    { const float* pv = ARG(peer_v); unsigned char* VQ = (unsigned char*)K.VB();
      for (int row0 = K.gw; row0 < DEPTH * 16384; row0 += 2 * K.ngw) {
          f32x4 v2[2][4];
#pragma unroll
          for (int t = 0; t < 2; ++t) { const int row = min(row0 + t * K.ngw, DEPTH * 16384 - 1); const f32x4* src = (const f32x4*)(pv + (size_t)row * D);
#pragma unroll
              for (int j = 0; j < 4; ++j) v2[t][j] = src[j * 64 + K.lane]; }
#pragma unroll
          for (int t = 0; t < 2; ++t) { const int row = row0 + t * K.ngw; if (row >= DEPTH * 16384) break;
              float mx = 0.f;
#pragma unroll
              for (int j = 0; j < 4; ++j) mx = fmaxf(mx, fmaxf(fmaxf(fabsf(v2[t][j].x), fabsf(v2[t][j].y)), fmaxf(fabsf(v2[t][j].z), fabsf(v2[t][j].w))));
#pragma unroll
              for (int o = 1; o < 64; o <<= 1) mx = fmaxf(mx, __shfl_xor(mx, o));
              const float sc = fmaxf(mx, 1e-30f) * (1.0f / 127.0f), inv = 1.0f / sc;
              if (K.lane == 0) K.VS()[row] = sc;
              const int l = row >> 14, e = row & 16383;
#pragma unroll
              for (int j = 0; j < 4; ++j) { const int col = j * 256 + K.lane * 4; const f32x4 v = v2[t][j];
                  const unsigned q0 = (unsigned)((int)rintf(v.x * inv)) & 0xffu, q1 = (unsigned)((int)rintf(v.y * inv)) & 0xffu, q2 = (unsigned)((int)rintf(v.z * inv)) & 0xffu, q3 = (unsigned)((int)rintf(v.w * inv)) & 0xffu;
                  *(unsigned*)(VQ + (((size_t)l * 8 + (col >> 7)) * 16384 + e) * 128 + (col & 127)) = q0 | (q1 << 8) | (q2 << 16) | (q3 << 24); } } } }
    { float* sv = (float*)K.lds;
      float* part = sv + 3 * D;
      __syncthreads();
      for (int i = K.tid; i < 3 * D; i += NTHREADS) { const int v = i / D, k = i % D; const float c = v < 2 ? ARG(c)[v * D + k] : ARG(c_ctx)[k]; sv[i] = c * sigmoidf_(c); }
      __syncthreads();
      for (int item = K.bid; item < DEPTH * 48; item += K.nb) {
          const int l = item / 48, cb = item % 48, kp = K.lane >> 5, cl = (K.lane & 31) * 4;
          const float* w = ARG(w_mod) + (size_t)l * D * 6 * D + cb * 128 + cl;
          f32x4 a0 = {0.f, 0.f, 0.f, 0.f}, a1 = a0, a2 = a0;
#pragma unroll 16
          for (int kk = 0; kk < 64; ++kk) { const int k = K.wave * 128 + 2 * kk + kp; const f32x4 wv = *(const f32x4*)(w + (size_t)k * 6 * D);
              a0 += wv * sv[k]; a1 += wv * sv[D + k]; a2 += wv * sv[2 * D + k]; }
#pragma unroll
          for (int j = 0; j < 4; ++j) { a0[j] += __shfl_xor(a0[j], 32); a1[j] += __shfl_xor(a1[j], 32); a2[j] += __shfl_xor(a2[j], 32); }
          if (kp == 0) { *(f32x4*)(part + (K.wave * 3 + 0) * 128 + cl) = a0; *(f32x4*)(part + (K.wave * 3 + 1) * 128 + cl) = a1; *(f32x4*)(part + (K.wave * 3 + 2) * 128 + cl) = a2; }
          __syncthreads();
          for (int i = K.tid; i < 384; i += NTHREADS) { const int v = i / 128, cc = i % 128; float sum = 0.f;
#pragma unroll
              for (int w8 = 0; w8 < 8; ++w8) sum += part[(w8 * 3 + v) * 128 + cc];
              const int col = cb * 128 + cc; K.MOD()[((size_t)l * 3 + v) * 6 * D + col] = sum + ARG(b_mod)[(size_t)l * 6 * D + col]; }
          __syncthreads();
      } }
    for (size_t i = gt; i < 2 * 256; i += gs) {
        const int dir = (int)(i / 256), ch = (int)(i % 256);
        float lg[DEPTH], mx = -1e30f;
#pragma unroll
        for (int l = 0; l < DEPTH; ++l) { lg[l] = ARG(lb_logits)[((size_t)dir * DEPTH + l) * 256 + ch]; mx = fmaxf(mx, lg[l]); }
        float s = 0.f;
#pragma unroll
        for (int l = 0; l < DEPTH; ++l) { lg[l] = expf(lg[l] - mx); s += lg[l]; }
        float cum = 0.f;
#pragma unroll
        for (int l = 0; l < DEPTH; ++l) { if (l > 0) cum += lg[l] / s; K.LB()[((size_t)dir * DEPTH + l) * 256 + ch] = cum; }
    }
    for (size_t i = gt; i < (256 + 64) * 16; i += gs) {
        const int pos = (int)(i / 16), f = (int)(i % 16);
        const float inv = powf(10000.0f, -(float)f / 16.0f);
        if (pos < 256) { const float ang = (float)pos * inv; K.ROPE()[pos * 16 + f] = cosf(ang); K.ROPE()[4096 + pos * 16 + f] = sinf(ang); }
        else { const int pc = pos - 256; const float ang = (float)pc * inv; K.ROPE()[8192 + pc * 16 + f] = cosf(ang); K.ROPE()[8192 + 1024 + pc * 16 + f] = sinf(ang); }
    }
}

DI void ph_norm(Ctx& K, const float* nw, int shift_chunk) {
    const float* modl = K.MOD() + (size_t)K.l * 3 * 6 * D;
    const bool from_inputs = K.l == 0 && shift_chunk == 0;
    auto rowp = [&](int r) -> const f32x4* { return (const f32x4*)(from_inputs ? (r < NCTX ? ARG(ctx) + (size_t)r * D : ARG(x) + (size_t)(r - NCTX) * D) : K.X() + (size_t)r * D); };
    f32x4 vn[4], wsc[4], sh[4]; int mvc = -1;
    { const f32x4* xr = rowp(min(K.gw, M - 1));
#pragma unroll
      for (int j = 0; j < 4; ++j) vn[j] = xr[j * 64 + K.lane]; }
#pragma unroll 1
    for (int r = K.gw; r < M; r += K.ngw) {
        f32x4 v[4]; float ss = 0.f;
#pragma unroll
        for (int j = 0; j < 4; ++j) { v[j] = vn[j]; ss += v[j].x * v[j].x + v[j].y * v[j].y + v[j].z * v[j].z + v[j].w * v[j].w; }
        { const f32x4* xr = rowp(min(r + K.ngw, M - 1));
#pragma unroll
          for (int j = 0; j < 4; ++j) vn[j] = xr[j * 64 + K.lane]; }
        const int mvi = modvec_of_row(r);
        if (mvi != mvc) { mvc = mvi; const float* mv = modl + (size_t)mvi * 6 * D;
#pragma unroll
            for (int j = 0; j < 4; ++j) { const int c4 = j * 64 + K.lane; const f32x4 w = ((const f32x4*)nw)[c4], sc = ((const f32x4*)(mv + (shift_chunk + 1) * D))[c4]; sh[j] = ((const f32x4*)(mv + shift_chunk * D))[c4];
                wsc[j] = (f32x4){w.x * (1.f + sc.x), w.y * (1.f + sc.y), w.z * (1.f + sc.z), w.w * (1.f + sc.w)}; } }
        ss = wave_sum(ss);
        const float rs = rsqrtf(ss * (1.0f / D) + EPS);
        u32x2* ho = (u32x2*)(K.H() + (size_t)r * D);
#pragma unroll
        for (int j = 0; j < 4; ++j) {
            const int c4 = j * 64 + K.lane;
            f32x4 y; y.x = v[j].x * rs * wsc[j].x + sh[j].x; y.y = v[j].y * rs * wsc[j].y + sh[j].y; y.z = v[j].z * rs * wsc[j].z + sh[j].z; y.w = v[j].w * rs * wsc[j].w + sh[j].w;
            u32x2 o; o.x = pk2(y.x, y.y); o.y = pk2(y.z, y.w); ho[c4] = o;
            if (shift_chunk == 3) { v[j].x = __uint_as_float(o.x << 16); v[j].y = __uint_as_float(o.x & 0xffff0000u); v[j].z = __uint_as_float(o.y << 16); v[j].w = __uint_as_float(o.y & 0xffff0000u); }
        }
        if (shift_chunk == 3) {
            float mx = 0.f;
#pragma unroll
            for (int j = 0; j < 4; ++j) mx = fmaxf(mx, fmaxf(fmaxf(fabsf(v[j].x), fabsf(v[j].y)), fmaxf(fabsf(v[j].z), fabsf(v[j].w))));
#pragma unroll
            for (int o = 1; o < 64; o <<= 1) mx = fmaxf(mx, __shfl_xor(mx, o));
            const float sc = fmaxf(mx, 1e-30f) * (1.0f / 127.0f), inv = 1.0f / sc;
            if (K.lane == 0) K.HS()[r] = sc;
#pragma unroll
            for (int j = 0; j < 4; ++j) { const unsigned q0 = (unsigned)((int)rintf(v[j].x * inv)) & 0xffu, q1 = (unsigned)((int)rintf(v[j].y * inv)) & 0xffu, q2 = (unsigned)((int)rintf(v[j].z * inv)) & 0xffu, q3 = (unsigned)((int)rintf(v[j].w * inv)) & 0xffu;
                *(unsigned*)(K.H8() + (size_t)r * D + (j * 64 + K.lane) * 4) = q0 | (q1 << 8) | (q2 << 16) | (q3 << 24); }
        }
    }
}

typedef short sg_bf16x8 __attribute__((ext_vector_type(8)));
template <int NT, bool RESID> DI void sg_ctx(Ctx& K, const bf16_t* A, const bf16_t* Bt, bf16_t* out, float* X, const float* gate, const float* Xin) {
    constexpr int N = 1024 * NT, RS = 272, OFF_B = 64 * RS, BUF = (64 + 32 * NT) * RS;
    int tid = K.tid; asm volatile("" : "+v"(tid));
    const int lane = tid & 63, wave = __builtin_amdgcn_readfirstlane(tid >> 6), r16 = lane & 15, g4 = lane >> 4, mt = wave & 3, nh = wave >> 2;
    const int lrow = tid >> 4, lc = tid & 15;
    for (int u = K.bid; u < 256; u += K.nb) {
        const int xcd = u & 7, j = u >> 3, ct = xcd * 4 + (j & 3), rt = j >> 2;
        const int row0 = 64 * rt, col0 = 32 * NT * ct;
        const bf16_t* ga = A + (size_t)(row0 + lrow) * D + 8 * lc; const bf16_t* gb = Bt + (size_t)(col0 + lrow) * D + 8 * lc;
        u32x4 ra[3][2], rb[3][NT];
        f32x4 acc[NT];
#pragma unroll
        for (int n = 0; n < NT; ++n) acc[n] = (f32x4){0.f, 0.f, 0.f, 0.f};
#define SG_LOAD(s_, c_) do { ra[s_][0] = *(const u32x4*)(ga + 128 * (c_)); ra[s_][1] = *(const u32x4*)(ga + 32 * D + 128 * (c_)); \
        _Pragma("unroll") for (int i_ = 0; i_ < NT; ++i_) rb[s_][i_] = *(const u32x4*)(gb + (size_t)32 * i_ * D + 128 * (c_)); } while (0)
        SG_LOAD(0, 0); SG_LOAD(1, 1); SG_LOAD(2, 2);
        __syncthreads();
#pragma unroll
        for (int c = 0; c < 8; ++c) {
            unsigned char* buf = K.lds + (c & 1) * BUF;
            *(u32x4*)(buf + lrow * RS + 16 * lc) = ra[c % 3][0]; *(u32x4*)(buf + (lrow + 32) * RS + 16 * lc) = ra[c % 3][1];
#pragma unroll
            for (int i = 0; i < NT; ++i) *(u32x4*)(buf + OFF_B + (lrow + 32 * i) * RS + 16 * lc) = rb[c % 3][i];
            if (c + 3 < 8) SG_LOAD(c % 3, c + 3);
            __syncthreads();
#pragma unroll
            for (int ks = 0; ks < 4; ++ks) {
                const sg_bf16x8 af = *(const sg_bf16x8*)(buf + (16 * mt + r16) * RS + 64 * ks + 16 * g4);
#pragma unroll
                for (int n = 0; n < NT; ++n) { const sg_bf16x8 bf = *(const sg_bf16x8*)(buf + OFF_B + (16 * (NT * nh + n) + r16) * RS + 64 * ks + 16 * g4);
                    acc[n] = __builtin_amdgcn_mfma_f32_16x16x32_bf16(bf, af, acc[n], 0, 0, 0); }
            }
        }
#undef SG_LOAD
        const int row = row0 + 16 * mt + r16;
#pragma unroll
        for (int n = 0; n < NT; ++n) { const int col = col0 + 16 * (NT * nh + n) + 4 * g4;
            if constexpr (RESID) { float* xp = X + (size_t)row * D + col; const f32x4 g = *(const f32x4*)(gate + col); f32x4 x = *(const f32x4*)(Xin + (size_t)row * D + col); x += g * acc[n]; *(f32x4*)xp = x; }
            else { u32x2 o; o.x = pk2(acc[n][0], acc[n][1]); o.y = pk2(acc[n][2], acc[n][3]); *(u32x2*)(out + (size_t)row * N + col) = o; } }
        __syncthreads();
    }
}
DI void ph_gemm_store(Ctx& K, const bf16_t* A, const bf16_t* Bt, int N, bf16_t* out, const float* rope) {
    { pg8::Gemm g{A + (size_t)NCTX * D, Bt, NLAT, N, D}; pg8::StaticOrder S; S.init(NLAT, N, K.nb, K.bid);
      pg8::EpiStore E{out, N, (LAS unsigned char*)K.lds, rope, NCTX, L, NCTX};
      pg8::gemm_phase<pg8::EpiStore, pg8::StaticOrder, true, true>((LAS unsigned char*)K.lds, g, S, E, K.tid); }
    if (N == PW) sg_ctx<3, false>(K, A, Bt, out, nullptr, nullptr, nullptr); else sg_ctx<2, false>(K, A, Bt, out, nullptr, nullptr, nullptr);
}
DI void ph_gemm_resid(Ctx& K, const bf16_t* A, const bf16_t* Bt, int chunk) {
    const float* gate = K.MOD() + (size_t)K.l * 3 * 6 * D + (size_t)chunk * D;
    { pg8::Gemm g{A + (size_t)NCTX * D, Bt, NLAT, D, D}; pg8::StaticOrder S; S.init(NLAT, D, K.nb, K.bid);
      pg8::EpiResid E{K.X(), D, gate, 6 * D, NCTX, L, (LAS unsigned char*)K.lds, NCTX, K.l == 0 ? ARG(x) : (const float*)K.X() + (size_t)NCTX * D};
      pg8::gemm_phase<pg8::EpiResid, pg8::StaticOrder, true, true>((LAS unsigned char*)K.lds, g, S, E, K.tid); }
    sg_ctx<1, true>(K, A, Bt, nullptr, K.X(), gate + (size_t)2 * 6 * D, K.l == 0 ? ARG(ctx) : (const float*)K.X());
}

DI void ph_rope(Ctx& K) {
    const float* cosr = K.ROPE(); const float* sinr = K.ROPE() + 4096; const float* cosc = K.ROPE() + 8192; const float* sinc = K.ROPE() + 8192 + 1024;
    const size_t gt = (size_t)K.bid * NTHREADS + K.tid, gs = (size_t)K.nb * NTHREADS;
    for (size_t i = gt; i < (size_t)NLAT * 8 * 16; i += gs) {
        const int f = (int)(i & 15), hh = (int)((i >> 4) & 7), lr = (int)(i >> 7);
        const int t = lr % L, pr = t >> 6, pc = t & 63;
        bf16_t* p = K.P() + (size_t)(NCTX + lr) * PW + (hh < 6 ? C_SQ + hh * 64 : C_SK + (hh - 6) * 64);
        const float c1 = cosr[pr * 16 + f], s1 = sinr[pr * 16 + f], c2 = cosc[pc * 16 + f], s2 = sinc[pc * 16 + f];
        const float a = bf2f(p[f]), b = bf2f(p[16 + f]), e = bf2f(p[32 + f]), g = bf2f(p[48 + f]);
        p[f] = f2bf(a * c1 - b * s1); p[16 + f] = f2bf(b * c1 + a * s1); p[32 + f] = f2bf(e * c2 - g * s2); p[48 + f] = f2bf(g * c2 + e * s2);
    }
}

typedef short bf16x8_t __attribute__((ext_vector_type(8)));
#define MFMA16(a, b, c) __builtin_amdgcn_mfma_f32_16x16x32_bf16((a), (b), (c), 0, 0, 0)
constexpr int HG_NCH = (CL + L) / 64;
constexpr int HG_LFS = 68;
constexpr int HG_TS = 72;
constexpr int HGL_LF = 0, HGL_OM = HGL_LF + 2 * 64 * HG_LFS * 4, HGL_VT = HGL_OM + 2 * 64 * HG_LFS * 4, HGL_KT = HGL_VT + 64 * HG_TS * 2, HGL_SC = HGL_KT + 2 * 64 * HG_TS * 2, HGL_OD = HGL_SC + 8 * 16 * HG_TS * 2, HGL_END = HGL_OD + 2 * 64 * HG_LFS * 4;
static_assert(HGL_END <= LDS_BYTES - 256, "hgrn LDS map");
constexpr int HG_NIT = NB * 4 * HG_NCH;
DI int hg_block_row(int b, int tb, int tok) { return tb < 4 ? ctx_row(b, tb * 64 + tok) : lat_row(b, (tb - 4) * 64 + tok); }
DI int hg_bwd_chunk(int tb) { return tb < 4 ? 3 - tb : 4 + 255 - (tb - 4); }
DI int hg_sw(int row, int col) { return row * HG_TS + ((((col >> 3) ^ (row >> 3)) & 7) << 3) + (col & 7); }
struct HgIn { u32x4 zf, zb, hv; };
DI void hg_item(int item, int& b, int& h, int& tb) { tb = item % HG_NCH; h = (item / HG_NCH) & 3; b = item / (HG_NCH * 4); }
DI void hg_load(Ctx& K, int item, HgIn& r) {
    int b, h, tb; hg_item(item, b, h, tb); const int tok = K.tid >> 3, c = K.tid & 7;
    const bf16_t* pr = K.P() + (size_t)hg_block_row(b, tb, tok) * PW + h * 64 + 8 * c;
    r.zf = *(const u32x4*)(pr + C_ZF); r.zb = *(const u32x4*)(pr + C_ZB); r.hv = *(const u32x4*)(pr + C_HV);
}
DI void hg_prep1(Ctx& K, int h, const HgIn& r) {
    float* LF = (float*)(K.lds + HGL_LF); float* OM = (float*)(K.lds + HGL_OM); bf16_t* VT = (bf16_t*)(K.lds + HGL_VT);
    const int tok = K.tid >> 3, c = K.tid & 7;
#pragma unroll
    for (int dir = 0; dir < 2; ++dir) {
        float z[8]; unpack8(dir ? r.zb : r.zf, z);
        const float* lb = K.LB() + ((size_t)dir * DEPTH + K.l) * 256 + h * 64 + 8 * c;
        float lf[8], om[8];
#pragma unroll
        for (int j = 0; j < 8; ++j) { const float lbv = lb[j], sg = sigmoidf_(z[j]); const float f = fmaxf(lbv + (1.f - lbv) * sg, 1e-30f); lf[j] = __logf(f); om[j] = (1.f - lbv) * (1.f - sg); }
        float* lfp = LF + (dir * 64 + tok) * HG_LFS + 8 * c; float* omp = OM + (dir * 64 + tok) * HG_LFS + 8 * c;
        *(f32x4*)lfp = (f32x4){lf[0], lf[1], lf[2], lf[3]}; *(f32x4*)(lfp + 4) = (f32x4){lf[4], lf[5], lf[6], lf[7]};
        *(f32x4*)omp = (f32x4){om[0], om[1], om[2], om[3]}; *(f32x4*)(omp + 4) = (f32x4){om[4], om[5], om[6], om[7]};
    }
    { const unsigned w[4] = {r.hv.x, r.hv.y, r.hv.z, r.hv.w};
#pragma unroll
      for (int j = 0; j < 4; ++j) { VT[hg_sw(8 * c + 2 * j, tok)] = (bf16_t)(w[j] & 0xffffu); VT[hg_sw(8 * c + 2 * j + 1, tok)] = (bf16_t)(w[j] >> 16); } }
}
DI void hg_prep2(Ctx& K) {
    float* LF = (float*)(K.lds + HGL_LF);
    __syncthreads();
    if (K.tid < 128) {
        const int dir = K.tid >> 6, d = K.tid & 63; float* col = LF + dir * 64 * HG_LFS + d;
        float carry = 0.f;
#pragma unroll
        for (int hf = 0; hf < 2; ++hf) { float v[32];
#pragma unroll
            for (int p = 0; p < 32; ++p) v[p] = col[(dir ? 63 - (32 * hf + p) : 32 * hf + p) * HG_LFS];
            v[0] += carry;
#pragma unroll
            for (int p = 1; p < 32; ++p) v[p] += v[p - 1];
#pragma unroll
            for (int p = 0; p < 32; ++p) col[(dir ? 63 - (32 * hf + p) : 32 * hf + p) * HG_LFS] = v[p];
            carry = v[31]; }
    }
    __syncthreads();
}
DI void ph_hgrn_A(Ctx& K) {
    float* LF = (float*)(K.lds + HGL_LF); float* OM = (float*)(K.lds + HGL_OM); bf16_t* VT = (bf16_t*)(K.lds + HGL_VT); bf16_t* KT = (bf16_t*)(K.lds + HGL_KT);
    const int r16 = K.lane & 15, g4 = K.lane >> 4;
    if (K.bid >= HG_NIT) return;
    HgIn in; hg_load(K, K.bid, in);
#pragma unroll 1
    for (int item = K.bid; item < HG_NIT; item += K.nb) {
        int b, h, tb; hg_item(item, b, h, tb);
        __syncthreads();
        hg_prep1(K, h, in);
        hg_load(K, item + K.nb < HG_NIT ? item + K.nb : item, in);
        hg_prep2(K);
        { const int tok = K.tid >> 3, c = K.tid & 7;
#pragma unroll
          for (int dir = 0; dir < 2; ++dir) {
              const float* bl = LF + (dir * 64 + (dir ? 0 : 63)) * HG_LFS + 8 * c; const float* bt = LF + (dir * 64 + tok) * HG_LFS + 8 * c; const float* om = OM + (dir * 64 + tok) * HG_LFS + 8 * c;
#pragma unroll
              for (int j = 0; j < 8; ++j) KT[dir * 64 * HG_TS + hg_sw(8 * c + j, tok)] = f2bf(om[j] * __expf(bl[j] - bt[j]));
          }
          if (K.tid < 128) { const int dir = K.tid >> 6, d = K.tid & 63; const int chain = (b * 2 + dir) * 4 + h, ch = dir ? hg_bwd_chunk(tb) : tb;
              K.AC()[((size_t)chain * HG_NCH + ch) * 64 + d] = __expf(LF[(dir * 64 + (dir ? 0 : 63)) * HG_LFS + d]); } }
        __syncthreads();
        { const int dir = K.wave >> 2, mi = K.wave & 3; const int chain = (b * 2 + dir) * 4 + h, ch = dir ? hg_bwd_chunk(tb) : tb;
          f32x4 acc[4];
#pragma unroll
          for (int db = 0; db < 4; ++db) acc[db] = (f32x4){0.f, 0.f, 0.f, 0.f};
#pragma unroll
          for (int ks = 0; ks < 2; ++ks) {
              const bf16x8_t vv = *(const bf16x8_t*)(VT + hg_sw(16 * mi + r16, 32 * ks + 8 * g4));
#pragma unroll
              for (int db = 0; db < 4; ++db) { const bf16x8_t kv = *(const bf16x8_t*)(KT + dir * 64 * HG_TS + hg_sw(16 * db + r16, 32 * ks + 8 * g4)); acc[db] = MFMA16(kv, vv, acc[db]); }
          }
          bf16_t* st = K.STB() + ((size_t)chain * HG_NCH + ch) * 4096 + (size_t)K.lane * 8;
#pragma unroll
          for (int ks = 0; ks < 2; ++ks) { const u32x4 w = (u32x4){pk2(acc[2 * ks][0], acc[2 * ks][1]), pk2(acc[2 * ks][2], acc[2 * ks][3]), pk2(acc[2 * ks + 1][0], acc[2 * ks + 1][1]), pk2(acc[2 * ks + 1][2], acc[2 * ks + 1][3])};
              *(u32x4*)(st + (mi * 2 + ks) * 512) = w; }
        }
    }
}
DI void ph_hgrn_B(Ctx& K) {
    const int per = ((16 * 2048 + K.nb - 1) / K.nb + 63) & ~63;
    const int gt = K.bid * per + K.tid;
    if (K.tid < per && gt < 16 * 2048) {
        const int chain = gt >> 11, dw = gt & 2047, m = dw & 3, lane = (dw >> 2) & 63, ks = (dw >> 8) & 1;
        const int d0 = 32 * ks + 16 * (m >> 1) + 4 * (lane >> 4) + 2 * (m & 1);
        unsigned* st = (unsigned*)(K.STB() + (size_t)chain * HG_NCH * 4096) + dw; const float* ac = K.AC() + (size_t)chain * HG_NCH * 64 + d0;
        float S0 = 0.f, S1 = 0.f;
#pragma unroll 1
        for (int c0 = 0; c0 < HG_NCH; c0 += 26) {
            unsigned u[26]; float a0[26], a1[26];
#pragma unroll
            for (int i = 0; i < 26; ++i) { u[i] = st[(size_t)(c0 + i) * 2048]; const u32x2 av = *(const u32x2*)(ac + (c0 + i) * 64); a0[i] = __uint_as_float(av.x); a1[i] = __uint_as_float(av.y); }
#pragma unroll
            for (int i = 0; i < 26; ++i) { st[(size_t)(c0 + i) * 2048] = pk2(S0, S1); S0 = a0[i] * S0 + __uint_as_float(u[i] << 16); S1 = a1[i] * S1 + __uint_as_float(u[i] & 0xffff0000u); }
        }
    }
}
struct HgInC { u32x2 q[2][2]; u32x4 gq; u32x4 st[8]; };
DI void ph_hgrn_C(Ctx& K) {
    float* LF = (float*)(K.lds + HGL_LF); float* OM = (float*)(K.lds + HGL_OM); bf16_t* VT = (bf16_t*)(K.lds + HGL_VT); bf16_t* KP = (bf16_t*)(K.lds + HGL_KT); float* OD = (float*)(K.lds + HGL_OD);
    bf16_t* SC = (bf16_t*)(K.lds + HGL_SC) + K.wave * 16 * HG_TS;
    const int r16 = K.lane & 15, g4 = K.lane >> 4, dir = K.wave >> 2, mi = K.wave & 3;
    if (K.bid >= HG_NIT) return;
    HgIn in; HgInC ic;
    hg_load(K, K.bid, in);
#define HGC_LOAD_Q(it_) do { int b_, h_, tb_; hg_item(it_, b_, h_, tb_); const bf16_t* qr = K.P() + (size_t)hg_block_row(b_, tb_, 16 * mi + r16) * PW + C_HQ + h_ * 64 + 4 * g4; \
        _Pragma("unroll") for (int ks = 0; ks < 2; ++ks) { ic.q[ks][0] = *(const u32x2*)(qr + 32 * ks); ic.q[ks][1] = *(const u32x2*)(qr + 32 * ks + 16); } } while (0)
#define HGC_LOAD_ST(it_) do { int b_, h_, tb_; hg_item(it_, b_, h_, tb_); const int chain_ = (b_ * 2 + dir) * 4 + h_, ch_ = dir ? hg_bwd_chunk(tb_) : tb_; \
        const bf16_t* sp = K.STB() + ((size_t)chain_ * HG_NCH + ch_) * 4096 + (size_t)K.lane * 8; _Pragma("unroll") for (int i_ = 0; i_ < 8; ++i_) ic.st[i_] = *(const u32x4*)(sp + i_ * 512); } while (0)
#define HGC_LOAD_G(it_) do { int b_, h_, tb_; hg_item(it_, b_, h_, tb_); const int tok_ = K.tid >> 3, c_ = K.tid & 7; \
        ic.gq = *(const u32x4*)(K.P() + (size_t)hg_block_row(b_, tb_, tok_) * PW + C_HG + h_ * 64 + 8 * c_); } while (0)
    HGC_LOAD_Q(K.bid); HGC_LOAD_ST(K.bid); HGC_LOAD_G(K.bid);
#pragma unroll 1
    for (int item = K.bid; item < HG_NIT; item += K.nb) {
        int b, h, tb; hg_item(item, b, h, tb);
        const int nxt = item + K.nb < HG_NIT ? item + K.nb : item;
        __syncthreads();
        hg_prep1(K, h, in);
        hg_load(K, nxt, in);
        hg_prep2(K);
        {
          const int tok = K.tid >> 3, c = K.tid & 7;
#pragma unroll
          for (int dd = 0; dd < 2; ++dd) { const float* rf = LF + (dd * 64 + 32) * HG_LFS + 8 * c; const float* bs = LF + (dd * 64 + tok) * HG_LFS + 8 * c; const float* om = OM + (dd * 64 + tok) * HG_LFS + 8 * c;
              unsigned o[4];
#pragma unroll
              for (int j = 0; j < 4; ++j) o[j] = pk2(om[2 * j] * __expf(rf[2 * j] - bs[2 * j]), om[2 * j + 1] * __expf(rf[2 * j + 1] - bs[2 * j + 1]));
              *(u32x4*)(KP + (dd * 64 + tok) * HG_TS + 8 * c) = (u32x4){o[0], o[1], o[2], o[3]}; } }
        __syncthreads();
        f32x4 nw0, nw1;
        { const float* LFd = LF + dir * 64 * HG_LFS; const float* ref = LFd + 32 * HG_LFS;
          bf16x8_t aq1[2], aq2[2];
          { const int t = 16 * mi + r16;
#pragma unroll
            for (int ks = 0; ks < 2; ++ks) { unsigned o1[4], o2[4];
#pragma unroll
                for (int hf = 0; hf < 2; ++hf) { const int d0 = 32 * ks + 16 * hf + 4 * g4; const unsigned qw[2] = {ic.q[ks][hf].x, ic.q[ks][hf].y};
                    const f32x4 bt = *(const f32x4*)(LFd + t * HG_LFS + d0), rf = *(const f32x4*)(ref + d0);
#pragma unroll
                    for (int j = 0; j < 2; ++j) { const float qa = __uint_as_float(qw[j] << 16), qb = __uint_as_float(qw[j] & 0xffff0000u); const float sa = qa * sigmoidf_(qa), sb = qb * sigmoidf_(qb);
                        const float e1a = __expf(bt[2 * j] - rf[2 * j]), e1b = __expf(bt[2 * j + 1] - rf[2 * j + 1]), e2a = __expf(bt[2 * j]), e2b = __expf(bt[2 * j + 1]);
                        o1[2 * hf + j] = pk2(sa * e1a, sb * e1b); o2[2 * hf + j] = pk2(sa * e2a, sb * e2b); } }
                aq1[ks] = __builtin_bit_cast(bf16x8_t, (u32x4){o1[0], o1[1], o1[2], o1[3]}); aq2[ks] = __builtin_bit_cast(bf16x8_t, (u32x4){o2[0], o2[1], o2[2], o2[3]}); } }
          HGC_LOAD_Q(nxt);
          f32x4 sc[4];
#pragma unroll
          for (int nj = 0; nj < 4; ++nj) { sc[nj] = (f32x4){0.f, 0.f, 0.f, 0.f}; const bf16_t* kr = KP + (dir * 64 + 16 * nj + r16) * HG_TS + 4 * g4;
#pragma unroll
              for (int ks = 0; ks < 2; ++ks) { const u32x2 k0 = *(const u32x2*)(kr + 32 * ks), k1 = *(const u32x2*)(kr + 32 * ks + 16);
                  sc[nj] = MFMA16(aq1[ks], __builtin_bit_cast(bf16x8_t, (u32x4){k0.x, k0.y, k1.x, k1.y}), sc[nj]); } }
#pragma unroll
          for (int nj = 0; nj < 4; ++nj)
#pragma unroll
              for (int rg = 0; rg < 4; ++rg) { const int tl = 4 * g4 + rg, t = 16 * mi + tl, s_ = 16 * nj + r16; const bool keep = dir ? (s_ >= t) : (s_ <= t);
                  SC[tl * HG_TS + s_] = f2bf(keep ? sc[nj][rg] : 0.f); }
          asm volatile("s_waitcnt lgkmcnt(0)" ::: "memory");
          f32x4 oacc[4];
#pragma unroll
          for (int nj = 0; nj < 4; ++nj) oacc[nj] = (f32x4){0.f, 0.f, 0.f, 0.f};
#pragma unroll
          for (int ks = 0; ks < 2; ++ks) {
              const bf16x8_t as = *(const bf16x8_t*)(SC + r16 * HG_TS + 32 * ks + 8 * g4);
#pragma unroll
              for (int nj = 0; nj < 4; ++nj) {
                  const bf16x8_t bv = *(const bf16x8_t*)(VT + hg_sw(16 * nj + r16, 32 * ks + 8 * g4));
                  oacc[nj] = MFMA16(as, bv, oacc[nj]);
                  oacc[nj] = MFMA16(aq2[ks], __builtin_bit_cast(bf16x8_t, ic.st[nj * 2 + ks]), oacc[nj]);
              }
          }
          HGC_LOAD_ST(nxt);
          { const float* nwp = ARG(hgrn_norm_w) + (size_t)K.l * 256 + h * 64 + 8 * (K.tid & 7); nw0 = *(const f32x4*)nwp; nw1 = *(const f32x4*)(nwp + 4); }
#pragma unroll
          for (int nj = 0; nj < 4; ++nj)
#pragma unroll
              for (int rg = 0; rg < 4; ++rg) OD[(dir * 64 + 16 * mi + 4 * g4 + rg) * HG_LFS + 16 * nj + r16] = oacc[nj][rg];
        }
        __syncthreads();
        { const int tok = K.tid >> 3, c = K.tid & 7; const int row = hg_block_row(b, tb, tok);
          const float* o0 = OD + tok * HG_LFS + 8 * c; const float* o1 = OD + (64 + tok) * HG_LFS + 8 * c;
          float o[8], ss = 0.f;
#pragma unroll
          for (int j = 0; j < 8; ++j) { o[j] = o0[j] + o1[j]; ss += o[j] * o[j]; }
          ss += __shfl_xor(ss, 1); ss += __shfl_xor(ss, 2); ss += __shfl_xor(ss, 4);
          const float rs = rsqrtf(ss * (1.0f / 64.0f) + EPS);
          float gq[8]; unpack8(ic.gq, gq);
          const float nw[8] = {nw0[0], nw0[1], nw0[2], nw0[3], nw1[0], nw1[1], nw1[2], nw1[3]};
          float y[8];
#pragma unroll
          for (int j = 0; j < 8; ++j) y[j] = o[j] * rs * nw[j] * gq[j] * sigmoidf_(gq[j]);
          HGC_LOAD_G(nxt);
          u32x4 w; w.x = pk2(y[0], y[1]); w.y = pk2(y[2], y[3]); w.z = pk2(y[4], y[5]); w.w = pk2(y[6], y[7]);
          *(u32x4*)(K.MIX() + (size_t)row * D + MX_H + h * 64 + 8 * c) = w; }
    }
#undef HGC_LOAD_Q
#undef HGC_LOAD_ST
#undef HGC_LOAD_G
}

constexpr int AT_TS = 72;
constexpr int ATL_K = 0, ATL_V = ATL_K + 64 * AT_TS * 2, ATL_P = ATL_V + 64 * AT_TS * 2, ATL_END = ATL_P + 8 * 48 * AT_TS * 2;
static_assert(ATL_END <= LDS_BYTES - 256, "attention LDS map");
DI float dpp_max16(float x) { x = fmaxf(x, dpp_<0xB1>(x)); x = fmaxf(x, dpp_<0x4E>(x)); x = fmaxf(x, dpp_<0x141>(x)); x = fmaxf(x, dpp_<0x128>(x)); return x; }
DI float dpp_sum16(float x) { x += dpp_<0xB1>(x); x += dpp_<0x4E>(x); x += dpp_<0x141>(x); x += dpp_<0x128>(x); return x; }
DI unsigned cvtpk(float lo, float hi) { unsigned r; asm("v_cvt_pk_bf16_f32 %0, %1, %2" : "=v"(r) : "v"(lo), "v"(hi)); return r; }
DI float xg4_max(float x) { x = fmaxf(x, __shfl_xor(x, 16)); x = fmaxf(x, __shfl_xor(x, 32)); return x; }
template <int MT, int NJ, bool SAMEKB> DI void at_softmax_pv(f32x4 (&sT)[MT][NJ], float (&mrun)[MT], float (&lrun)[MT], f32x4 (&oacc)[MT][4], const bf16_t* VT, const int (&kb)[MT], int r16, int g4) {
    unsigned pb[MT][NJ / 2][4];
#pragma unroll
    for (int mt = 0; mt < MT; ++mt) {
        float mx = -INFINITY;
#pragma unroll
        for (int nj = 0; nj < NJ; ++nj) mx = fmaxf(mx, fmaxf(fmaxf(sT[mt][nj][0], sT[mt][nj][1]), fmaxf(sT[mt][nj][2], sT[mt][nj][3])));
        mx = xg4_max(mx);
        const float mn = fmaxf(mrun[mt], mx), alpha = __expf(mrun[mt] - mn); mrun[mt] = mn;
        float rs_ = 0.f;
#pragma unroll
        for (int nj = 0; nj < NJ; ++nj)
#pragma unroll
            for (int rg = 0; rg < 4; ++rg) { const float pe = __expf(sT[mt][nj][rg] - mn); sT[mt][nj][rg] = pe; rs_ += pe; }
        lrun[mt] = lrun[mt] * alpha + rs_;
#pragma unroll
        for (int ne = 0; ne < 4; ++ne) oacc[mt][ne] *= alpha;
#pragma unroll
        for (int ks = 0; ks < NJ / 2; ++ks) { pb[mt][ks][0] = cvtpk(sT[mt][2 * ks][0], sT[mt][2 * ks][1]); pb[mt][ks][1] = cvtpk(sT[mt][2 * ks][2], sT[mt][2 * ks][3]);
            pb[mt][ks][2] = cvtpk(sT[mt][2 * ks + 1][0], sT[mt][2 * ks + 1][1]); pb[mt][ks][3] = cvtpk(sT[mt][2 * ks + 1][2], sT[mt][2 * ks + 1][3]); }
    }
#pragma unroll
    for (int ks = 0; ks < NJ / 2; ++ks)
#pragma unroll
        for (int ne = 0; ne < 4; ++ne) { const int e = 16 * ne + r16, sw = (e >> 3) & 7;
            u32x4 vf_shared;
            if (SAMEKB) { const int blk = (kb[0] >> 3) + 4 * ks + (g4 >> 1); const u32x2 v0 = *(const u32x2*)(VT + e * AT_TS + ((blk ^ sw) << 3) + 4 * (g4 & 1)), v1 = *(const u32x2*)(VT + e * AT_TS + (((blk + 2) ^ sw) << 3) + 4 * (g4 & 1));
                vf_shared = (u32x4){v0.x, v0.y, v1.x, v1.y}; }
#pragma unroll
            for (int mt = 0; mt < MT; ++mt) { u32x4 vf = vf_shared;
                if (!SAMEKB) { const int blk = (kb[mt] >> 3) + 4 * ks + (g4 >> 1); const u32x2 v0 = *(const u32x2*)(VT + e * AT_TS + ((blk ^ sw) << 3) + 4 * (g4 & 1)), v1 = *(const u32x2*)(VT + e * AT_TS + (((blk + 2) ^ sw) << 3) + 4 * (g4 & 1));
                    vf = (u32x4){v0.x, v0.y, v1.x, v1.y}; }
                oacc[mt][ne] = MFMA16(__builtin_bit_cast(bf16x8_t, vf), __builtin_bit_cast(bf16x8_t, (u32x4){pb[mt][ks][0], pb[mt][ks][1], pb[mt][ks][2], pb[mt][ks][3]}), oacc[mt][ne]); } }
}
template <int KIND> DI void attn_item(Ctx& K, int idx, const float* sinkp, const float* rpbp) {
    constexpr int MT = KIND == 0 ? 3 : 2;
    int tid_ = K.tid; asm volatile("" : "+v"(tid_));
    const int lane_ = tid_ & 63, wave_ = tid_ >> 6;
    bf16_t* KT = (bf16_t*)(K.lds + ATL_K); bf16_t* VT = (bf16_t*)(K.lds + ATL_V); float* RPB = (float*)(K.lds + ATL_P);
    const int r16 = lane_ & 15, g4 = lane_ >> 4;
    int b, hk, qb = 0;
    if (KIND == 0) { qb = idx & 127; hk = (idx >> 7) & 1; b = idx >> 8; }
    else if (KIND == 1) { qb = idx & 63; hk = (idx >> 6) % 6; b = (idx >> 6) / 6; }
    else { hk = idx % 6; b = idx / 6; }
    const int kcol = (KIND == 0) ? C_SK + hk * 64 : (KIND == 2) ? C_SK + (hk / 3) * 64 : C_NK + hk * 64;
    const int vcol = (KIND == 0) ? C_SV + hk * 64 : (KIND == 2) ? C_SV + (hk / 3) * 64 : C_NV + hk * 64;
    int t0 = 0, nloc = 0;
    if (KIND == 0) { const int k0 = max(2 * qb - 2, 0), k1 = min(2 * qb + 3, L / 64 - 1); t0 = k0; nloc = k1 - k0 + 1; }
    if (KIND == 1) { const int k0 = min(max(4 * qb - 4, 0), L / 64 - 8), k1 = min(max(4 * qb + 3 - 4, 0), L / 64 - 8) + 7; t0 = k0; nloc = k1 - k0 + 1; }
    const int ntiles = nloc + CL / 64;
    int w_r = 0, w_rs = 0;
    if (KIND == 1) { w_r = 4 * qb + (wave_ >> 1); w_rs = min(max(w_r - 4, 0), L / 64 - 8); }
    bf16x8_t qf[MT][2]; int qbase[MT], hq_mt[MT], qrow[MT];
#pragma unroll
    for (int mt = 0; mt < MT; ++mt) {
        int arow, hq;
        if (KIND == 0) { const int rho = wave_ * 48 + mt * 16; hq = hk * 3 + rho / 128; hq_mt[mt] = hq; const int tb = 128 * qb + (rho & 127); arow = lat_row(b, tb + r16); qbase[mt] = tb; }
        else if (KIND == 1) { hq = hk; hq_mt[mt] = hq; const int cb = 32 * (wave_ & 1) + 16 * mt; arow = lat_row(b, w_r * 64 + cb + r16); qbase[mt] = cb; }
        else { hq = hk; hq_mt[mt] = hq; const int tb = wave_ * 32 + mt * 16; arow = ctx_row(b, tb + r16); qbase[mt] = 0; }
        qrow[mt] = arow;
        const int qcol = (KIND == 0 || KIND == 2) ? C_SQ + hq * 64 : C_NQ + hq * 64;
#pragma unroll
        for (int ks = 0; ks < 2; ++ks) { float q[8]; unpack8(*(const u32x4*)(K.P() + (size_t)arow * PW + qcol + 32 * ks + 8 * g4), q);
            const u32x4 w = (u32x4){pk2(q[0] * 0.125f, q[1] * 0.125f), pk2(q[2] * 0.125f, q[3] * 0.125f), pk2(q[4] * 0.125f, q[5] * 0.125f), pk2(q[6] * 0.125f, q[7] * 0.125f)};
            qf[mt][ks] = __builtin_bit_cast(bf16x8_t, w); }
    }
    f32x4 oacc[MT][4]; float mrun[MT], lrun[MT];
#pragma unroll
    for (int mt = 0; mt < MT; ++mt) {
#pragma unroll
        for (int ne = 0; ne < 4; ++ne) oacc[mt][ne] = (f32x4){0.f, 0.f, 0.f, 0.f};
        const bool has_sink = (KIND == 0 || KIND == 2);
        mrun[mt] = has_sink ? sinkp[hq_mt[mt]] : -1.0e30f; lrun[mt] = (has_sink && g4 == 0) ? 1.0f : 0.0f;
    }
    const int lkey = tid_ >> 3, lch = tid_ & 7;
    u32x4 pk_, pv_;
    { const int ti = 0; const int grow = (ti < nloc) ? lat_row(b, (t0 + ti) * 64 + lkey) : ctx_row(b, (ti - nloc) * 64 + lkey);
      const bf16_t* pr = K.P() + (size_t)grow * PW + 8 * lch; pk_ = *(const u32x4*)(pr + kcol); pv_ = *(const u32x4*)(pr + vcol); }
#pragma unroll 1
    for (int ti = 0; ti < ntiles; ++ti) {
        __syncthreads();
        *(u32x4*)(KT + lkey * AT_TS + 8 * lch) = pk_;
        { const unsigned w[4] = {pv_.x, pv_.y, pv_.z, pv_.w};
          const int vsw = (((lkey >> 3) ^ lch) << 3) + (lkey & 7);
#pragma unroll
          for (int j = 0; j < 4; ++j) { VT[(8 * lch + 2 * j) * AT_TS + vsw] = (bf16_t)(w[j] & 0xffffu); VT[(8 * lch + 2 * j + 1) * AT_TS + vsw] = (bf16_t)(w[j] >> 16); } }
        if (KIND == 1 && ti == 0 && tid_ < 15 * 31) RPB[tid_] = rpbp[tid_];
        __syncthreads();
        if (ti + 1 < ntiles) { const int tn = ti + 1; const int grow = (tn < nloc) ? lat_row(b, (t0 + tn) * 64 + lkey) : ctx_row(b, (tn - nloc) * 64 + lkey);
            const bf16_t* pr = K.P() + (size_t)grow * PW + 8 * lch; pk_ = *(const u32x4*)(pr + kcol); pv_ = *(const u32x4*)(pr + vcol); }
        const bool local = ti < nloc; const int kunit = t0 + ti;
        if (KIND == 1 && local) {
            if ((kunit >= w_rs) && (kunit < w_rs + 8)) {
                f32x4 sT[MT][2]; int kb[MT];
#pragma unroll
                for (int mt = 0; mt < MT; ++mt) { kb[mt] = min(max(qbase[mt] - 8, 0), 32);
#pragma unroll
                    for (int nj = 0; nj < 2; ++nj) { sT[mt][nj] = (f32x4){0.f, 0.f, 0.f, 0.f};
#pragma unroll
                        for (int ks = 0; ks < 2; ++ks) { const bf16x8_t kf = *(const bf16x8_t*)(KT + (kb[mt] + 16 * nj + r16) * AT_TS + 32 * ks + 8 * g4); sT[mt][nj] = MFMA16(kf, qf[mt][ks], sT[mt][nj]); } } }
                const float* rp = RPB + (kunit - w_r + 7) * 31 + 15;
#pragma unroll
                for (int mt = 0; mt < MT; ++mt) { const int c = qbase[mt] + r16, ws = min(max(c - 8, 0), 48);
#pragma unroll
                    for (int nj = 0; nj < 2; ++nj)
#pragma unroll
                        for (int rg = 0; rg < 4; ++rg) { const int key = kb[mt] + 16 * nj + 4 * g4 + rg; const bool ok = key >= ws && key < ws + 16;
                            sT[mt][nj][rg] = ok ? sT[mt][nj][rg] + rp[ok ? key - c : 0] : -INFINITY; } }
                at_softmax_pv<MT, 2, false>(sT, mrun, lrun, oacc, VT, kb, r16, g4);
            }
        } else {
            f32x4 sT[MT][4];
#pragma unroll
            for (int mt = 0; mt < MT; ++mt)
#pragma unroll
                for (int nj = 0; nj < 4; ++nj) sT[mt][nj] = (f32x4){0.f, 0.f, 0.f, 0.f};
#pragma unroll
            for (int nj = 0; nj < 4; ++nj)
#pragma unroll
                for (int ks = 0; ks < 2; ++ks) { const bf16x8_t kf = *(const bf16x8_t*)(KT + (16 * nj + r16) * AT_TS + 32 * ks + 8 * g4);
#pragma unroll
                    for (int mt = 0; mt < MT; ++mt) sT[mt][nj] = MFMA16(kf, qf[mt][ks], sT[mt][nj]); }
            if (KIND == 0 && local) {
#pragma unroll
                for (int mt = 0; mt < MT; ++mt) { const int dq = qbase[mt] + r16 - kunit * 64 - 4 * g4;
#pragma unroll
                    for (int nj = 0; nj < 4; ++nj)
#pragma unroll
                        for (int rg = 0; rg < 4; ++rg) { const int dl = dq - (16 * nj + rg); if (dl > 128 || dl < -128) sT[mt][nj][rg] = -INFINITY; } }
            }
            int kb0[MT];
#pragma unroll
            for (int mt = 0; mt < MT; ++mt) kb0[mt] = 0;
            at_softmax_pv<MT, 4, true>(sT, mrun, lrun, oacc, VT, kb0, r16, g4);
        }
    }
#pragma unroll
    for (int mt = 0; mt < MT; ++mt) {
        float l = lrun[mt]; l += __shfl_xor(l, 16); l += __shfl_xor(l, 32);
        const float inv = 1.0f / l;
        const int ocol = ((KIND == 0 || KIND == 2) ? MX_S : MX_N) + hq_mt[mt] * 64;
#pragma unroll
        for (int ne = 0; ne < 4; ++ne) { u32x2 o; o.x = cvtpk(oacc[mt][ne][0] * inv, oacc[mt][ne][1] * inv); o.y = cvtpk(oacc[mt][ne][2] * inv, oacc[mt][ne][3] * inv);
            *(u32x2*)(K.MIX() + (size_t)qrow[mt] * D + ocol + 16 * ne + 4 * g4) = o; }
    }
}
DI void ph_attn(Ctx& K) {
    constexpr int N_SWA = NB * 2 * (L / 128), N_NAT = NB * 6 * (L / 256), N_C = NB * 6;
    const float* sinkp = ARG(swa_sink) + K.l * 6;
    for (int item = K.bid; item < N_SWA + N_NAT + 2 * N_C; item += K.nb) {
        if (item < N_SWA) attn_item<0>(K, item, sinkp, nullptr);
        else if (item < N_SWA + N_NAT) { const int it = item - N_SWA; const int h = (it >> 6) % 6; attn_item<1>(K, it, nullptr, ARG(nat_rpb) + ((size_t)K.l * 6 + h) * 15 * 31); }
        else if (item < N_SWA + N_NAT + N_C) attn_item<2>(K, item - N_SWA - N_NAT, sinkp, nullptr);
        else attn_item<3>(K, item - N_SWA - N_NAT - N_C, nullptr, nullptr);
    }
}

DI unsigned fkey(float f) { const unsigned u = __float_as_uint(f); return (u & 0x80000000u) ? ~u : (u | 0x80000000u); }
DI int mbcnt64(unsigned long long m) { return (int)__builtin_amdgcn_mbcnt_hi((unsigned)(m >> 32), __builtin_amdgcn_mbcnt_lo((unsigned)m, 0u)); }
template <int NV> DI unsigned radix_thr16(const unsigned (&k)[NV]) {
    unsigned prefix = 0u;
#pragma unroll 1
    for (int bit = 31; bit >= 0; --bit) {
        const unsigned cand = prefix | (1u << bit); int cnt = 0;
#pragma unroll
        for (int i = 0; i < NV; ++i) cnt += __popcll(__ballot(k[i] >= cand));
        if (cnt >= 16) { prefix = cand; if (cnt == 16) break; }
    }
    return prefix;
}
template <int NC, int NV> DI void radix_thr16_multi(const unsigned (&k)[NC][NV], unsigned (&T)[NC]) {
    bool exact[NC];
#pragma unroll
    for (int c = 0; c < NC; ++c) { T[c] = 0u; exact[c] = false; }
#pragma unroll 1
    for (int bit = 31; bit >= 0; --bit) {
        bool all = true;
#pragma unroll
        for (int c = 0; c < NC; ++c) {
            const unsigned cand = T[c] | (1u << bit); int cnt = 0;
#pragma unroll
            for (int i = 0; i < NV; ++i) cnt += __popcll(__ballot(k[c][i] >= cand));
            if (cnt >= 16) { T[c] = cand; exact[c] = (cnt == 16); }
            all = all && exact[c];
        }
        if (all) break;
    }
}
template <int NV> DI void select16(const unsigned (&k)[NV], unsigned T, bool (&sel)[NV], int (&pos)[NV]) {
    int ngt = 0; unsigned long long gtm[NV], eqm[NV];
#pragma unroll
    for (int i = 0; i < NV; ++i) { gtm[i] = __ballot(k[i] > T); eqm[i] = __ballot(k[i] == T); ngt += __popcll(gtm[i]); }
    const int need = 16 - ngt; int eqbase = 0, selbase = 0;
#pragma unroll
    for (int i = 0; i < NV; ++i) {
        const bool iseq = k[i] == T; const int erank = eqbase + mbcnt64(eqm[i]); eqbase += __popcll(eqm[i]);
        sel[i] = (k[i] > T) || (iseq && erank < need);
        const unsigned long long sm = __ballot(sel[i]); pos[i] = selbase + mbcnt64(sm); selbase += __popcll(sm);
    }
}
template <int CTRL> DI int dppi_(int x) { return __builtin_amdgcn_mov_dpp(x, CTRL, 0xf, 0xf, true); }
DI int row_sum_i(int x) { x += dppi_<0xB1>(x); x += dppi_<0x4E>(x); x += dppi_<0x141>(x); x += dppi_<0x128>(x); return x; }
DI int row_excl_scan_i(int x) { int s_ = x; s_ += dppi_<0x111>(s_); s_ += dppi_<0x112>(s_); s_ += dppi_<0x114>(s_); s_ += dppi_<0x118>(s_); return s_ - x; }
DI unsigned row_minmax_u(unsigned x, bool want_max) {
    unsigned y;
    y = (unsigned)dppi_<0xB1>((int)x); x = want_max ? max(x, y) : min(x, y); y = (unsigned)dppi_<0x4E>((int)x); x = want_max ? max(x, y) : min(x, y);
    y = (unsigned)dppi_<0x141>((int)x); x = want_max ? max(x, y) : min(x, y); y = (unsigned)dppi_<0x128>((int)x); x = want_max ? max(x, y) : min(x, y);
    return x;
}
template <int NK> DI unsigned row_radix_thr16(const unsigned (&k)[NK]) {
    unsigned lm = k[0];
#pragma unroll
    for (int i = 1; i < NK; ++i) lm = max(lm, k[i]);
    unsigned lo = row_minmax_u(lm, false), hi = row_minmax_u(lm, true) + 1u;
    bool done = false;
#pragma unroll 1
    for (int itn = 0; itn < 40; ++itn) {
        const unsigned span = hi - lo; done = done || (span <= 1u);
        const unsigned mid = lo + (span >> 1); int cnt = 0;
#pragma unroll
        for (int i = 0; i < NK; ++i) cnt += (k[i] >= mid) ? 1 : 0;
        cnt = row_sum_i(cnt);
        const bool ge = cnt >= 16;
        if (!done) { if (ge) lo = mid; else hi = mid; }
        done = done || (cnt == 16);
        if (__ballot(!done) == 0ull) break;
    }
    return lo;
}
template <int NK> DI void row_select16(const unsigned (&k)[NK], unsigned T, bool (&sel)[NK], int (&pos)[NK]) {
    int g = 0, q = 0;
#pragma unroll
    for (int i = 0; i < NK; ++i) { g += (k[i] > T) ? 1 : 0; q += (k[i] == T) ? 1 : 0; }
    const int need = 16 - row_sum_i(g);
    const int a = min(max(need - row_excl_scan_i(q), 0), q);
    int nxt = row_excl_scan_i(g + a), eqs = 0;
#pragma unroll
    for (int i = 0; i < NK; ++i) { const bool iseq = k[i] == T; sel[i] = (k[i] > T) || (iseq && eqs < a); eqs += iseq ? 1 : 0; pos[i] = nxt; nxt += sel[i] ? 1 : 0; }
}
DI void ce_desc(unsigned& x, unsigned& y) { const unsigned hi = max(x, y), lo = min(x, y); x = hi; y = lo; }
DI void sort8_desc(unsigned (&a)[8]) {
    ce_desc(a[0], a[1]); ce_desc(a[2], a[3]); ce_desc(a[4], a[5]); ce_desc(a[6], a[7]); ce_desc(a[0], a[2]); ce_desc(a[1], a[3]); ce_desc(a[4], a[6]); ce_desc(a[5], a[7]);
    ce_desc(a[1], a[2]); ce_desc(a[5], a[6]); ce_desc(a[0], a[4]); ce_desc(a[3], a[7]); ce_desc(a[1], a[5]); ce_desc(a[2], a[6]); ce_desc(a[1], a[4]); ce_desc(a[3], a[6]);
    ce_desc(a[2], a[4]); ce_desc(a[3], a[5]); ce_desc(a[3], a[4]); }
DI void sort4_desc(unsigned (&a)[4]) { ce_desc(a[0], a[1]); ce_desc(a[2], a[3]); ce_desc(a[0], a[2]); ce_desc(a[1], a[3]); ce_desc(a[1], a[2]); }
DI float fkey_inv(unsigned k) { return __uint_as_float((k & 0x80000000u) ? (k & 0x7fffffffu) : ~k); }
DI void cex_(unsigned& k, int& ix, unsigned pk, int pi, bool lower) { const bool take = lower ? (pk > k) : (pk < k); k = take ? pk : k; ix = take ? pi : ix; }
template <int CTRL> DI void cex_dpp(unsigned& k, int& ix, bool lower) { const unsigned pk = (unsigned)dppi_<CTRL>((int)k); const int pi = dppi_<CTRL>(ix); cex_(k, ix, pk, pi, lower); }
DI void row_sort16_desc(unsigned& k, int& ix, int j16) {
    const bool l1 = (j16 & 1) == 0, l2 = (j16 & 2) == 0, l4 = (j16 & 4) == 0, l8 = (j16 & 8) == 0;
    cex_dpp<0xB1>(k, ix, l1);
    cex_dpp<0x1B>(k, ix, l2); cex_dpp<0xB1>(k, ix, l1);
    cex_dpp<0x141>(k, ix, l4); cex_dpp<0x4E>(k, ix, l2); cex_dpp<0xB1>(k, ix, l1);
    cex_dpp<0x140>(k, ix, l8);
    { const unsigned pk = (unsigned)__builtin_amdgcn_ds_swizzle((int)k, 0x101F); const int pi = __builtin_amdgcn_ds_swizzle(ix, 0x101F); cex_(k, ix, pk, pi, l4); }
    cex_dpp<0x4E>(k, ix, l2); cex_dpp<0xB1>(k, ix, l1);
}
constexpr int PSL_SK = 0, PSL_TOP = 131072;
static_assert(PSL_TOP + 8 * 1024 <= LDS_BYTES - 256, "peer select LDS map");
template <int PROBE> DI void ph_peer_select(Ctx& K) {
    float* TOPV = (float*)(K.lds + PSL_TOP + K.wave * 1024); int* TOPI = (int*)(TOPV + 128);
    const int r16 = K.lane & 15, g4 = K.lane >> 4, j16 = r16;
    const int nhg = K.nb < 8 ? K.nb : 8, grp = K.bid % nhg, jw = K.bid / nhg, nj = (K.nb - grp + nhg - 1) / nhg;
    constexpr int N_T = M / 16;
    const int nwv = nj * 8, wg = jw * 8 + K.wave;
    const int n_full = (N_T / nwv) * nwv, n_work = n_full + 4 * (N_T - n_full);
    for (int h = grp; h < 8; h += nhg) {
        __syncthreads();
        { const u32x4* sh = (const u32x4*)(K.SKH() + ((size_t)K.l * 8 + h) * 2 * 16384); const u32x4* sl = (const u32x4*)(K.SKL() + ((size_t)K.l * 8 + h) * 2 * 16384);
          u32x4* dst = (u32x4*)(K.lds + PSL_SK);
          u32x4 t[8];
#pragma unroll
          for (int i = 0; i < 8; ++i) t[i] = sh[K.tid + 512 * i];
#pragma unroll
          for (int i = 0; i < 8; ++i) dst[K.tid + 512 * i] = t[i];
#pragma unroll
          for (int i = 0; i < 8; ++i) t[i] = sl[K.tid + 512 * i];
#pragma unroll
          for (int i = 0; i < 8; ++i) dst[4096 + K.tid + 512 * i] = t[i]; }
        __syncthreads();
#pragma unroll 1
        for (int wk = wg; wk < n_work; wk += nwv) {
            const bool part = wk >= n_full; const int tile = part ? n_full + ((wk - n_full) >> 2) : wk; const int rg_lo = part ? ((wk - n_full) & 3) : 0, rg_hi = part ? rg_lo + 1 : 4;
            const int t0 = tile * 16;
            float S[2][8][4];
#pragma unroll
            for (int p = 0; p < 2; ++p) {
                bf16x8_t aq[4];
                { const bf16_t* qp = K.QP() + (size_t)(t0 + r16) * 2048 + h * 256 + p * 128 + 8 * g4;
#pragma unroll
                  for (int ks = 0; ks < 4; ++ks) aq[ks] = *(const bf16x8_t*)(qp + 32 * ks); }
                const unsigned char* kb = K.lds + PSL_SK + p * 32768 + K.lane * 16;
#pragma unroll
                for (int nt = 0; nt < 8; ++nt) {
                    f32x4 c0 = {0.f, 0.f, 0.f, 0.f}, c1 = c0;
#pragma unroll
                    for (int ks = 0; ks < 4; ++ks) { const bf16x8_t bh = *(const bf16x8_t*)(kb + (nt * 4 + ks) * 1024), bl = *(const bf16x8_t*)(kb + 65536 + (nt * 4 + ks) * 1024);
                        c0 = MFMA16(aq[ks], bh, c0); c1 = MFMA16(aq[ks], bl, c1); }
#pragma unroll
                    for (int rg = 0; rg < 4; ++rg) S[p][nt][rg] = c0[rg] + c1[rg];
                }
            }
            if (PROBE == 1) { float a = 0.f;
#pragma unroll
                for (int p = 0; p < 2; ++p)
#pragma unroll
                    for (int nt = 0; nt < 8; ++nt) a += S[p][nt][0] + S[p][nt][1] + S[p][nt][2] + S[p][nt][3];
                TOPV[K.lane] = a; continue; }
#pragma unroll 1
            for (int rg = 0; rg < 4; ++rg) {
                if (rg >= rg_lo && rg < rg_hi) {
                    unsigned a[2][8], mine[2] = {0u, 0u};
#pragma unroll
                    for (int p = 0; p < 2; ++p) {
#pragma unroll
                        for (int i = 0; i < 8; ++i) a[p][i] = (fkey(S[p][i][0]) & 0xFFFFFF80u) | (unsigned)(j16 + 16 * i);
                        sort8_desc(a[p]); }
#pragma unroll 1
                    for (int it = 0; it < 16; ++it) {
#pragma unroll
                        for (int p = 0; p < 2; ++p) { const unsigned m = row_minmax_u(a[p][0], true); const bool win = a[p][0] == m;
#pragma unroll
                            for (int i = 0; i < 7; ++i) a[p][i] = win ? a[p][i + 1] : a[p][i];
                            a[p][7] = win ? 0u : a[p][7];
                            mine[p] = (j16 == it) ? m : mine[p]; }
                    }
                    unsigned* TA = (unsigned*)TOPV + (g4 * 2) * 16; unsigned* TB = TA + 16;
                    TA[j16] = mine[0]; TB[j16] = mine[1];
                    asm volatile("s_waitcnt lgkmcnt(0)" ::: "memory");
                    { const int r = t0 + 4 * g4 + rg, t = j16;
                      int ci[4], cj[4];
                      ci[0] = 0; cj[0] = t;
                      ci[1] = t < 8 ? 1 : t; cj[1] = t < 8 ? t : 0;
                      ci[2] = t <= 4 ? 2 : t <= 8 ? 3 : t <= 11 ? 4 : t <= 13 ? 5 : 6; cj[2] = t <= 4 ? t : t <= 8 ? t - 5 : t <= 11 ? t - 9 : t <= 13 ? t - 12 : t - 14;
                      ci[3] = 7; cj[3] = t & 1;
                      unsigned c[4];
#pragma unroll
                      for (int q = 0; q < 4; ++q) { const float cv = fkey_inv(TA[ci[q]] & 0xFFFFFF80u) + fkey_inv(TB[cj[q]] & 0xFFFFFF80u); c[q] = (fkey(cv) & 0xFFFFFFC0u) | (unsigned)(t * 4 + q); }
                      if (t > 1) c[3] = 0u;
                      sort4_desc(c);
                      unsigned w = 0u;
#pragma unroll 1
                      for (int it = 0; it < 16; ++it) { const unsigned m = row_minmax_u(c[0], true); const bool win = c[0] == m;
                          c[0] = win ? c[1] : c[0]; c[1] = win ? c[2] : c[1]; c[2] = win ? c[3] : c[2]; c[3] = win ? 0u : c[3];
                          w = (j16 == it) ? m : w; }
                      const float val = fkey_inv(w & 0xFFFFFFC0u); const int tw = (int)(w >> 2) & 15, qw = (int)w & 3;
                      const int i2 = tw <= 4 ? 2 : tw <= 8 ? 3 : tw <= 11 ? 4 : tw <= 13 ? 5 : 6, j2 = tw <= 4 ? tw : tw <= 8 ? tw - 5 : tw <= 11 ? tw - 9 : tw <= 13 ? tw - 12 : tw - 14;
                      const int wi = qw == 0 ? 0 : qw == 1 ? (tw < 8 ? 1 : tw) : qw == 2 ? i2 : 7, wj = qw == 0 ? tw : qw == 1 ? (tw < 8 ? tw : 0) : qw == 2 ? j2 : (tw & 1);
                      const int e = (int)(TA[wi] & 127u) * 128 + (int)(TB[wj] & 127u);
                      const float mx = dpp_max16(val);
                      const float ex = __expf(val - mx), es = dpp_sum16(ex);
                      K.PIDX()[(size_t)r * 128 + h * 16 + j16] = e; K.PG()[(size_t)r * 128 + h * 16 + j16] = ex / es;
                    }
                    asm volatile("s_waitcnt lgkmcnt(0)" ::: "memory");
                }
#pragma unroll
                for (int p = 0; p < 2; ++p)
#pragma unroll
                    for (int i = 0; i < 8; ++i) { S[p][i][0] = S[p][i][1]; S[p][i][1] = S[p][i][2]; S[p][i][2] = S[p][i][3]; }
            }
        }
    }
}

constexpr int PU_NR = 4;
constexpr int PUL_H = 0, PUL_SLOT = 2 * PU_NR * 1024, PUL_STRIDE = PUL_SLOT + 256;
struct PuMeta { float hs[PU_NR]; int ia[PU_NR], ib[PU_NR]; };
DI void pu_load(const Ctx& K, int r0, int step, PuMeta& m, unsigned char* hbuf) {
    int rr[PU_NR];
#pragma unroll
    for (int q = 0; q < PU_NR; ++q) rr[q] = min(r0 + q * step, M - 1);
    __builtin_amdgcn_global_load_lds((const unsigned*)(K.H8() + (size_t)rr[0] * D + K.lane * 16), (LAS unsigned*)hbuf, 16, 0, 0);
    __builtin_amdgcn_global_load_lds((const unsigned*)(K.H8() + (size_t)rr[1] * D + K.lane * 16 - 1024), (LAS unsigned*)hbuf, 16, 1024, 0);
    __builtin_amdgcn_global_load_lds((const unsigned*)(K.H8() + (size_t)rr[2] * D + K.lane * 16 - 2048), (LAS unsigned*)hbuf, 16, 2048, 0);
    __builtin_amdgcn_global_load_lds((const unsigned*)(K.H8() + (size_t)rr[3] * D + K.lane * 16 - 3072), (LAS unsigned*)hbuf, 16, 3072, 0);
#pragma unroll
    for (int q = 0; q < PU_NR; ++q) { m.hs[q] = K.HS()[rr[q]]; m.ia[q] = K.PIDX()[(size_t)rr[q] * 128 + K.lane]; m.ib[q] = K.PIDX()[(size_t)rr[q] * 128 + 64 + K.lane]; }
}
typedef int i32x4 __attribute__((ext_vector_type(4)));
DI int sel4i(const i32x4 v, int k) { return k == 0 ? v[0] : k == 1 ? v[1] : k == 2 ? v[2] : v[3]; }
template <int PROBE> DI void pu_item(const Ctx& K, const unsigned char* U, unsigned char* HL, int* SLOT, int R, int r0, int step, const PuMeta& m, int r16, int g4, float& dummy) {
    bool sa[PU_NR], sb[PU_NR]; int ra[PU_NR], rb[PU_NR]; int n = 0;
#pragma unroll
    for (int q = 0; q < PU_NR; ++q) { const bool live = r0 + q * step < M; sa[q] = live && (m.ia[q] >> 11) == R; sb[q] = live && (m.ib[q] >> 11) == R; const unsigned long long ma = __ballot(sa[q]), mb = __ballot(sb[q]);
        ra[q] = n + mbcnt64(ma); n += __popcll(ma); rb[q] = n + mbcnt64(mb); n += __popcll(mb); }
    const int E = r16 >> 2, qq = r16 & 3, rho = r16 >> 2;
    const float hsm = rho == 0 ? m.hs[0] : rho == 1 ? m.hs[1] : rho == 2 ? m.hs[2] : m.hs[3];
#pragma unroll 1
    for (int base = 0; base < n; base += 32) {
#pragma unroll
        for (int q = 0; q < PU_NR; ++q) {
            if (sa[q] && ra[q] >= base && ra[q] < base + 32) { SLOT[2 * (ra[q] - base)] = m.ia[q]; SLOT[2 * (ra[q] - base) + 1] = q * 128 + K.lane; }
            if (sb[q] && rb[q] >= base && rb[q] < base + 32) { SLOT[2 * (rb[q] - base)] = m.ib[q]; SLOT[2 * (rb[q] - base) + 1] = q * 128 + 64 + K.lane; } }
        asm volatile("s_waitcnt lgkmcnt(0)" ::: "memory");
        const bool two = base + 16 < n;
        i32x4 av[8][4];
#pragma unroll
        for (int t = 0; t < 4; ++t) { const int sl = 4 * t + E; const int e = (base + sl < n) ? SLOT[2 * sl] : SLOT[0]; const unsigned char* up = U + ((unsigned)e * (unsigned)D + (unsigned)(64 * g4 + 16 * qq));
#pragma unroll
            for (int s_ = 0; s_ < 4; ++s_) av[t][s_] = *(const i32x4*)(up + 256 * s_); }
        if (two) {
#pragma unroll
            for (int t = 4; t < 8; ++t) { const int sl = 4 * t + E; const int e = (base + sl < n) ? SLOT[2 * sl] : SLOT[0]; const unsigned char* up = U + ((unsigned)e * (unsigned)D + (unsigned)(64 * g4 + 16 * qq));
#pragma unroll
                for (int s_ = 0; s_ < 4; ++s_) av[t][s_] = *(const i32x4*)(up + 256 * s_); } }
        bool fin[2]; int fcode[2]; float fus[2], fvs[2];
#pragma unroll
        for (int p2 = 0; p2 < 2; ++p2) { const int sl = 4 * (4 * p2 + qq) + g4; fin[p2] = false; fcode[p2] = 0; fus[p2] = 0.f; fvs[p2] = 0.f;
            if (base + sl < n) { const int code = SLOT[2 * sl + 1];
                if ((code >> 7) == rho) { const size_t eo = (size_t)K.l * 16384 + SLOT[2 * sl]; fin[p2] = true; fcode[p2] = code; fus[p2] = K.US()[eo]; fvs[p2] = K.VS()[eo]; } } }
        i32x4 hb[4];
#pragma unroll
        for (int s_ = 0; s_ < 4; ++s_) hb[s_] = *(const i32x4*)(HL + rho * 1024 + 64 * g4 + 16 * qq + 256 * s_);
        int w0, w1 = 0;
        { int rs[4];
#pragma unroll
          for (int t = 0; t < 4; ++t) { i32x4 acc = {0, 0, 0, 0};
#pragma unroll
              for (int s_ = 0; s_ < 4; ++s_) acc = __builtin_amdgcn_mfma_i32_16x16x64_i8(av[t][s_], hb[s_], acc, 0, 0, 0);
              int v = sel4i(acc, qq); v += dppi_<0xB1>(v); v += dppi_<0x4E>(v); rs[t] = v; }
          w0 = qq == 0 ? rs[0] : qq == 1 ? rs[1] : qq == 2 ? rs[2] : rs[3]; }
        if (two) { int rs[4];
#pragma unroll
            for (int t = 0; t < 4; ++t) { i32x4 acc = {0, 0, 0, 0};
#pragma unroll
                for (int s_ = 0; s_ < 4; ++s_) acc = __builtin_amdgcn_mfma_i32_16x16x64_i8(av[4 + t][s_], hb[s_], acc, 0, 0, 0);
                int v = sel4i(acc, qq); v += dppi_<0xB1>(v); v += dppi_<0x4E>(v); rs[t] = v; }
            w1 = qq == 0 ? rs[0] : qq == 1 ? rs[1] : qq == 2 ? rs[2] : rs[3]; }
#pragma unroll
        for (int p2 = 0; p2 < 2; ++p2) {
            const int di = p2 ? w1 : w0;
            if (fin[p2]) { const int code = fcode[p2];
                const float d = (float)di * fus[p2] * hsm;
                if (PROBE >= 2) dummy += gelu_erf(d);
                else (PROBE ? K.ST() : K.PA())[(size_t)(r0 + (code >> 7) * step) * 128 + (code & 127)] = gelu_erf(d) * fvs[p2]; }
        }
        asm volatile("s_waitcnt lgkmcnt(0)" ::: "memory");
    }
}
#define PU_TOUCH(m_) asm volatile("" :: "v"(m_.hs[0]), "v"(m_.hs[1]), "v"(m_.hs[2]), "v"(m_.hs[3]), "v"(m_.ia[0]), "v"(m_.ia[1]), "v"(m_.ia[2]), "v"(m_.ia[3]), "v"(m_.ib[0]), "v"(m_.ib[1]), "v"(m_.ib[2]), "v"(m_.ib[3]))
template <int PROBE> DI void ph_peer_u(Ctx& K) {
    const unsigned char* U = (const unsigned char*)K.UB() + (size_t)K.l * 16384 * D;
    unsigned char* HB = K.lds + K.wave * PUL_STRIDE; int* SLOT = (int*)(HB + PUL_SLOT);
    const int r16 = K.lane & 15, g4 = K.lane >> 4;
    const int step = K.nloc * NWAVES;
    float dummy = 0.f;
    for (int R = K.xg; R < 8; R += K.nxg) {
        int r = K.jx * NWAVES + K.wave; int par = 0;
        PuMeta mA, mB; (void)par;
        pu_load(K, r, step, mA, HB);
#pragma unroll 1
        for (; r < M; r += 2 * PU_NR * step) {
            asm volatile("s_waitcnt vmcnt(0)" ::: "memory");
            PU_TOUCH(mA);
            pu_load(K, r + PU_NR * step, step, mB, HB + PU_NR * 1024);
            pu_item<PROBE>(K, U, HB, SLOT, R, r, step, mA, r16, g4, dummy);
            asm volatile("s_waitcnt vmcnt(0)" ::: "memory");
            PU_TOUCH(mB);
            pu_load(K, r + 2 * PU_NR * step, step, mA, HB);
            pu_item<PROBE>(K, U, HB + PU_NR * 1024, SLOT, R, r + PU_NR * step, step, mB, r16, g4, dummy);
        }
    }
    if (PROBE >= 2) K.ST()[K.gw * 64 + K.lane] = dummy;
}
struct PvMeta { int ia, ib; float ga, gb, pa, pb; };
template <int PROBE> DI void pv_load(const Ctx& K, int r, PvMeta& m) {
    m.ia = K.PIDX()[(size_t)r * 128 + K.lane]; m.ib = K.PIDX()[(size_t)r * 128 + 64 + K.lane];
    m.ga = K.PG()[(size_t)r * 128 + K.lane]; m.pa = K.PA()[(size_t)r * 128 + K.lane]; m.gb = K.PG()[(size_t)r * 128 + 64 + K.lane]; m.pb = K.PA()[(size_t)r * 128 + 64 + K.lane];
}
template <int HALF, int PROBE> DI void pv_issue(const unsigned char* V, int slot, unsigned coff, const PvMeta& m, u32x4 (&vv)[8]) {
    const int ix = HALF ? m.ib : m.ia;
#pragma unroll
    for (int i = 0; i < 8; ++i) {
        const int src = ((8 * i + slot) << 2);
        const int e = __builtin_amdgcn_ds_bpermute(src, ix);
        vv[i] = PROBE == 2 ? (u32x4){(unsigned)e, 1u, 2u, 3u} : *(const u32x4*)(V + ((unsigned)e * 128u + coff));
    }
}
DI void tr4x4(unsigned x0, unsigned x1, unsigned x2, unsigned x3, unsigned (&o)[4]) {
    const unsigned a = __builtin_amdgcn_perm(x1, x0, 0x05010400u), b = __builtin_amdgcn_perm(x1, x0, 0x07030602u), c = __builtin_amdgcn_perm(x3, x2, 0x05010400u), d = __builtin_amdgcn_perm(x3, x2, 0x07030602u);
    o[0] = __builtin_amdgcn_perm(c, a, 0x05040100u); o[1] = __builtin_amdgcn_perm(c, a, 0x07060302u); o[2] = __builtin_amdgcn_perm(d, b, 0x05040100u); o[3] = __builtin_amdgcn_perm(d, b, 0x07060302u);
}
DI unsigned u4(const u32x4& v, int d) { return d == 0 ? v.x : d == 1 ? v.y : d == 2 ? v.z : v.w; }
DI float pv_weights(const PvMeta& m, unsigned char* WQ, int lane) {
    const float wa = m.ga * m.pa, wb = m.gb * m.pb;
    float mx = fmaxf(fabsf(wa), fabsf(wb));
    mx = dpp_max16(mx); mx = fmaxf(mx, __shfl_xor(mx, 16)); mx = fmaxf(mx, __shfl_xor(mx, 32));
    const float s_hi = fmaxf(mx, 1e-30f) * (1.0f / 127.0f), i_hi = 1.0f / s_hi, s_lo = s_hi * (1.0f / 254.0f), i_lo = 254.0f * i_hi;
    const float ha = rintf(wa * i_hi), hb = rintf(wb * i_hi);
    const int la = (int)rintf((wa - ha * s_hi) * i_lo), lb = (int)rintf((wb - hb * s_hi) * i_lo);
    const int i = lane >> 3, sl = lane & 7; unsigned char* wp = WQ + (((sl & 1) * 4 + (sl >> 1)) << 4) + i;
    wp[0] = (unsigned char)(int)ha; wp[8] = (unsigned char)(int)hb; wp[128] = (unsigned char)la; wp[136] = (unsigned char)lb;
    return s_lo;
}
template <int PROBE> DI void ph_peer_v(Ctx& K) {
    const int slot = K.lane >> 3, c = K.lane & 7;
    const float* gate = K.MOD() + (size_t)K.l * 3 * 6 * D + 5 * D;
    const int step = K.nloc * NWAVES;
    float* Xb = PROBE ? (float*)K.P() : K.X();
    unsigned char* WQ = K.lds + K.wave * 256;
    float* GPL = (float*)(K.lds + 8 * 256);
    for (int S = K.xg; S < 8; S += K.nxg) {
        const unsigned char* V = (const unsigned char*)K.VB() + ((size_t)K.l * 8 + S) * 16384 * 128;
        const int c0 = S * 128 + c * 16;
        __syncthreads();
        for (int i = K.tid; i < 3 * 128; i += NTHREADS) GPL[i] = gate[(size_t)(i >> 7) * 6 * D + S * 128 + (i & 127)];
        __syncthreads();
        const int r0 = K.jx * NWAVES + K.wave;
        const int nit = r0 < M ? (M - 1 - r0) / step + 1 : 0;
        PvMeta mA, mB; pv_load<PROBE>(K, min(r0, M - 1), mA); pv_load<PROBE>(K, min(r0 + step, M - 1), mB);
        f32x4 xq[4], xprev[4], x2[4]; float yp[16]; int rp = -1; PvMeta m2;
#pragma unroll
        for (int q = 0; q < 4; ++q) { xq[q] = *(const f32x4*)(Xb + (size_t)min(r0, M - 1) * D + c0 + 4 * q); xprev[q] = (f32x4){0.f, 0.f, 0.f, 0.f}; }
#pragma unroll
        for (int q = 0; q < 16; ++q) yp[q] = 0.f;
#define PV_BODY(XPREV, XQ, XNEW, MA, MC, IT) do { \
            const int r = r0 + (IT) * step; \
            { const float zdep = MA.ga * 0.0f; \
                f32x4 gp[4]; { const f32x4* gl = (const f32x4*)(GPL + modvec_of_row(max(rp, 0)) * 128 + (K.lane & 7) * 16); _Pragma("unroll") for (int q = 0; q < 4; ++q) gp[q] = gl[q]; } \
                _Pragma("unroll") for (int q = 0; q < 4; ++q) { XPREV[q].x += gp[q].x * yp[4 * q] + zdep; XPREV[q].y += gp[q].y * yp[4 * q + 1] + zdep; XPREV[q].z += gp[q].z * yp[4 * q + 2] + zdep; XPREV[q].w += gp[q].w * yp[4 * q + 3] + zdep; } \
                if (rp >= 0 && slot == 0) { float* xr = Xb + (size_t)rp * D + c0; \
                    _Pragma("unroll") for (int q = 0; q < 4; ++q) *(f32x4*)(xr + 4 * q) = XPREV[q]; } } \
            __builtin_amdgcn_sched_barrier(0); \
            const float s_lo = pv_weights(MA, WQ, K.lane); \
            u32x4 vA[8], vB[8]; \
            pv_issue<0, PROBE>(V, slot, (unsigned)c * 16u, MA, vA); \
            pv_issue<1, PROBE>(V, slot, (unsigned)c * 16u, MA, vB); \
            __builtin_amdgcn_sched_barrier(0); \
            { const float* xr = Xb + (size_t)min(r + step, M - 1) * D + c0; \
              _Pragma("unroll") for (int q = 0; q < 4; ++q) XNEW[q] = *(const f32x4*)(xr + 4 * q); } \
            pv_load<PROBE>(K, min(r + 2 * step, M - 1), MC); \
            __builtin_amdgcn_sched_barrier(0); \
            const i32x4 wq = *(const i32x4*)(WQ + ((((K.lane & 3) << 2) + (K.lane >> 4)) << 4)); \
            _Pragma("unroll") for (int d = 0; d < 4; ++d) { unsigned t0[4], t1[4], t2[4], t3[4]; \
                tr4x4(u4(vA[0], d), u4(vA[1], d), u4(vA[2], d), u4(vA[3], d), t0); tr4x4(u4(vA[4], d), u4(vA[5], d), u4(vA[6], d), u4(vA[7], d), t1); \
                tr4x4(u4(vB[0], d), u4(vB[1], d), u4(vB[2], d), u4(vB[3], d), t2); tr4x4(u4(vB[4], d), u4(vB[5], d), u4(vB[6], d), u4(vB[7], d), t3); \
                _Pragma("unroll") for (int bb = 0; bb < 4; ++bb) { const i32x4 bj = {(int)t0[bb], (int)t1[bb], (int)t2[bb], (int)t3[bb]}; \
                    const i32x4 dd = __builtin_amdgcn_mfma_i32_16x16x64_i8(wq, bj, (i32x4){0, 0, 0, 0}, 0, 0, 0); \
                    const int te = __mul24(dd[0], 254) + dd[2], to = __mul24(dd[1], 254) + dd[3];        \
                    const int tt = te + dppi_<0x128>(to);                                                    \
                    yp[4 * d + bb] = (float)tt * s_lo; } \
                __builtin_amdgcn_sched_barrier(0); } \
            rp = r; } while (0)
        f32x4 (*xfin)[4] = nullptr; (void)xfin;
        int it = 0;
#pragma unroll 1
        for (; it + 2 < nit; it += 3) {
            PV_BODY(xprev, xq, x2, mA, m2, it);
            PV_BODY(xq, x2, xprev, mB, mA, it + 1);
            PV_BODY(x2, xprev, xq, m2, mB, it + 2);
        }
        if (it < nit) { PV_BODY(xprev, xq, x2, mA, m2, it); ++it;
            if (it < nit) { PV_BODY(xq, x2, xprev, mB, mA, it); ++it;
#pragma unroll
                for (int q = 0; q < 4; ++q) xprev[q] = x2[q]; }
            else {
#pragma unroll
                for (int q = 0; q < 4; ++q) xprev[q] = xq[q]; } }
#undef PV_BODY
        if (rp >= 0) { const int mv = modvec_of_row(rp); f32x4 gp[4];
#pragma unroll
            for (int q = 0; q < 4; ++q) gp[q] = *(const f32x4*)(gate + (size_t)mv * 6 * D + c0 + 4 * q);
            if (slot == 0) { float* xr = Xb + (size_t)rp * D + c0;
#pragma unroll
                for (int q = 0; q < 4; ++q) { f32x4 x = xprev[q];
                    x.x += gp[q].x * yp[4 * q]; x.y += gp[q].y * yp[4 * q + 1]; x.z += gp[q].z * yp[4 * q + 2]; x.w += gp[q].w * yp[4 * q + 3]; *(f32x4*)(xr + 4 * q) = x; } } }
    }
}

DI void ph_final(Ctx& K) {
    f32x4 vn[4], w[4];
#pragma unroll
    for (int j = 0; j < 4; ++j) w[j] = ((const f32x4*)ARG(final_norm_w))[j * 64 + K.lane];
    { const f32x4* xr = (const f32x4*)(K.X() + (size_t)(NCTX + min(K.gw, NLAT - 1)) * D);
#pragma unroll
      for (int j = 0; j < 4; ++j) vn[j] = xr[j * 64 + K.lane]; }
    float* outp = (float*)argp_<float>(K, (unsigned)__builtin_offsetof(Args, out));
#pragma unroll 1
    for (int r = K.gw; r < NLAT; r += K.ngw) {
        f32x4* o = (f32x4*)(outp + (size_t)r * D);
        f32x4 v[4]; float ss = 0.f;
#pragma unroll
        for (int j = 0; j < 4; ++j) { v[j] = vn[j]; ss += v[j].x * v[j].x + v[j].y * v[j].y + v[j].z * v[j].z + v[j].w * v[j].w; }
        { const f32x4* xr = (const f32x4*)(K.X() + (size_t)(NCTX + min(r + K.ngw, NLAT - 1)) * D);
#pragma unroll
          for (int j = 0; j < 4; ++j) vn[j] = xr[j * 64 + K.lane]; }
        ss = wave_sum(ss); const float rs = rsqrtf(ss * (1.0f / D) + EPS);
#pragma unroll
        for (int j = 0; j < 4; ++j) o[j * 64 + K.lane] = v[j] * rs * w[j];
    }
}

#define XB_TMO      128
#define XB_XSUB(j)  (1280 + 64 * (j))
#define XB_XGEN(j)  (2304 + 64 * (j))
#define XB_TOP      3328
#define XB_TOPGEN   3392
#define XB_SPIN_CAP (1u << 22)
constexpr int CW_BAR = 4096;
DI unsigned xb_ld(unsigned* p)              { return __hip_atomic_load(p, __ATOMIC_RELAXED, __HIP_MEMORY_SCOPE_AGENT); }
DI unsigned xb_add(unsigned* p, unsigned v) { return __hip_atomic_fetch_add(p, v, __ATOMIC_RELAXED, __HIP_MEMORY_SCOPE_AGENT); }
#define XB_SPIN(cond, bar) do { unsigned _sp = 0; while (cond) { __builtin_amdgcn_s_sleep(1); \
    if ((++_sp & 255u) == 0u) { if (xb_ld(&(bar)[XB_TMO])) break; if (_sp > XB_SPIN_CAP) { atomicAdd(&(bar)[XB_TMO], 1u); break; } } } } while (0)
DI void xcd_barrier(unsigned* bar, unsigned x, unsigned nloc, unsigned nx, int tid) {
    asm volatile("s_waitcnt vmcnt(0)" ::: "memory");
    __syncthreads();
    if (tid == 0) {
        __builtin_amdgcn_s_waitcnt(0);
        const unsigned old = xb_add(&bar[XB_XSUB(x)], 1u);
        const unsigned gen = old / nloc;
        if (old + 1u == (gen + 1u) * nloc) {
            __builtin_amdgcn_fence(__ATOMIC_RELEASE, "agent");
            asm volatile("s_waitcnt vmcnt(0)" ::: "memory");
            const unsigned og = xb_add(&bar[XB_TOP], 1u);
            const unsigned tg = og / nx;
            if (og + 1u == (tg + 1u) * nx) xb_add(&bar[XB_TOPGEN], 1u);
            else XB_SPIN(xb_ld(&bar[XB_TOPGEN]) == tg, bar);
            __builtin_amdgcn_fence(__ATOMIC_ACQUIRE, "agent");
            xb_add(&bar[XB_XGEN(x)], 1u);
            asm volatile("s_waitcnt vmcnt(0)" ::: "memory");
        } else {
            XB_SPIN(xb_ld(&bar[XB_XGEN(x)]) == gen, bar);
            __builtin_amdgcn_fence(__ATOMIC_ACQUIRE, "agent");
            asm volatile("s_waitcnt vmcnt(0)" ::: "memory");
        }
    }
    __syncthreads();
}

constexpr int PROBE_U = 0, PROBE_V = 0, PROBE_S = 0;
constexpr unsigned DUP_MASK = 0u;
constexpr int PH_PER_LAYER = 12, N_PHASES = 2 + PH_PER_LAYER * DEPTH;
__global__ void __launch_bounds__(NTHREADS) mk_fwd(Args args) {
    extern __shared__ __attribute__((aligned(16))) unsigned char lds[];
    cg::grid_group grid = cg::this_grid();
    constexpr unsigned ARGS_OFF = LDS_BYTES - 256;
    constexpr unsigned MISC_OFF = LDS_BYTES - 64;
    if (threadIdx.x == 0) {
        *(Args*)(lds + ARGS_OFF) = args;
        unsigned* ctl = (unsigned*)(args.ws + WS_CTL); unsigned* misc = (unsigned*)(lds + MISC_OFF);
        const unsigned xcc = (unsigned)__builtin_amdgcn_s_getreg((3 << 11) | 20) & 0xFu;
        misc[0] = xcc; misc[1] = __hip_atomic_fetch_add(ctl + 64 * xcc, 1u, __ATOMIC_RELAXED, __HIP_MEMORY_SCOPE_AGENT);
    }
    __syncthreads();
    const int wid_s = __builtin_amdgcn_readfirstlane((int)threadIdx.x >> 6);
    int rep = 0;
#pragma unroll 1
    for (int ph = 0; ph < N_PHASES; ++ph) {
        unsigned ones = ~0u; asm volatile("" : "+s"(ones));
        int tid = (wid_s << 6) | (int)__builtin_amdgcn_mbcnt_hi(ones, __builtin_amdgcn_mbcnt_lo(ones, 0u)); asm volatile("" : "+v"(tid));
        unsigned aoff = ARGS_OFF; asm volatile("" : "+v"(aoff));
        size_t zoff = 0; asm volatile("" : "+s"(zoff));
        unsigned char* ws = args.ws + zoff;
        int bid = blockIdx.x; asm volatile("" : "+s"(bid)); int nb = gridDim.x; asm volatile("" : "+s"(nb));
        unsigned moff = MISC_OFF; asm volatile("" : "+v"(moff));
        Ctx K; unsigned xcc_s; { const unsigned* misc = (const unsigned*)(lds + moff); xcc_s = __builtin_amdgcn_readfirstlane(misc[0]); K.jx = __builtin_amdgcn_readfirstlane(misc[1]); K.xg = __builtin_amdgcn_readfirstlane(misc[2]); K.nxg = __builtin_amdgcn_readfirstlane(misc[3]); K.nloc = __builtin_amdgcn_readfirstlane(misc[4]); }
        K.aoff = aoff; K.lds = lds; K.tid = tid; K.lane = tid & 63; K.wave = tid >> 6; K.bid = bid; K.nb = nb; K.gw = bid * NWAVES + K.wave; K.ngw = nb * NWAVES;
        K.ws = ws;
        const int l = ph == 0 ? 0 : (ph - 1) / PH_PER_LAYER, k = ph == 0 ? -1 : (ph == N_PHASES - 1 ? -2 : (ph - 1) % PH_PER_LAYER);
        K.l = l;
        if (k == -1) ph_prologue(K);
        else if (k == -2) ph_final(K);
        else if (k == 0) ph_norm(K, ARG(norm_mix_w) + (size_t)l * D, 0);
        else if (k == 1) ph_gemm_store(K, K.H(), K.WIN() + (size_t)l * PW * D, PW, K.P(), K.ROPE());
        else if (k == 2) ph_hgrn_A(K);
        else if (k == 3) ph_attn(K);
        else if (k == 4) ph_hgrn_B(K);
        else if (k == 5) ph_hgrn_C(K);
        else if (k == 6) ph_gemm_resid(K, K.MIX(), K.WOUT() + (size_t)l * D * D, 2);
        else if (k == 7) ph_norm(K, ARG(norm_ffn_w) + (size_t)l * D, 3);
        else if (k == 8) ph_gemm_store(K, K.H(), K.WQ() + (size_t)l * 2048 * D, 2048, K.QP(), nullptr);
        else if (k == 9) { ph_peer_select<0>(K); if (PROBE_S) ph_peer_select<PROBE_S>(K); }
        else if (k == 10) { ph_peer_u<0>(K); if (PROBE_U) ph_peer_u<PROBE_U>(K); }
        else if (k == 11) { ph_peer_v<0>(K); if (PROBE_V) ph_peer_v<PROBE_V>(K); }
        if (k >= 0 && ((DUP_MASK >> k) & 1u)) { ++rep; if (rep < 2) { --ph; continue; } } rep = 0;
        if (ph == 0) grid.sync();
        else if (k != 2 && ph != N_PHASES - 1) xcd_barrier((unsigned*)(args.ws + WS_CTL) + CW_BAR, xcc_s, (unsigned)K.nloc, (unsigned)K.nxg, tid);
        if (ph == 0) {
            if (tid == 0) { unsigned* ctl = (unsigned*)(args.ws + WS_CTL); unsigned* misc = (unsigned*)(lds + MISC_OFF); const unsigned xcc = misc[0]; unsigned ord = 0, npop = 0, mine = 1;
                for (unsigned q = 0; q < 16; ++q) { const unsigned cq = __hip_atomic_load(ctl + 64 * q, __ATOMIC_RELAXED, __HIP_MEMORY_SCOPE_AGENT); if (cq) { ++npop; if (q < xcc) ++ord; } if (q == xcc) mine = cq; }
                misc[2] = ord; misc[3] = npop ? npop : 1u; misc[4] = mine ? mine : 1u; }
            __syncthreads();
        }
    }
}

extern "C" void kernel_launch(void* const* d_in, const int* in_sizes, int n_in, void* d_out, int out_size, void* d_ws, size_t ws_size, hipStream_t stream) {
    static int grid = 0;
    if (grid == 0) {
        if (n_in != 19 || out_size != NLAT * D || ws_size < WS_END) { fprintf(stderr, "kernel_launch: unexpected shapes (n_in %d out %d ws %zu need %zu)\n", n_in, out_size, ws_size, (size_t)WS_END); grid = -1; return; }
        int dev = 0, cus = 0, per_cu = 0;
        (void)hipGetDevice(&dev); (void)hipDeviceGetAttribute(&cus, hipDeviceAttributeMultiprocessorCount, dev);
        (void)hipFuncSetAttribute((const void*)mk_fwd, hipFuncAttributeMaxDynamicSharedMemorySize, LDS_BYTES);
        (void)hipOccupancyMaxActiveBlocksPerMultiprocessor(&per_cu, (const void*)mk_fwd, NTHREADS, LDS_BYTES);
        if (per_cu < 1) { fprintf(stderr, "kernel_launch: occupancy query says %d blocks/CU\n", per_cu); grid = -1; return; }
        grid = (cus / 8) * 8;
    }
    if (grid < 0) return;
    Args a{};
    a.x = (const float*)d_in[0]; a.c = (const float*)d_in[1]; a.ctx = (const float*)d_in[2]; a.c_ctx = (const float*)d_in[3]; a.w_mod = (const float*)d_in[4]; a.b_mod = (const float*)d_in[5];
    a.norm_mix_w = (const float*)d_in[6]; a.norm_ffn_w = (const float*)d_in[7]; a.w_in = (const float*)d_in[8]; a.lb_logits = (const float*)d_in[9]; a.hgrn_norm_w = (const float*)d_in[10];
    a.swa_sink = (const float*)d_in[11]; a.nat_rpb = (const float*)d_in[12]; a.w_out = (const float*)d_in[13]; a.peer_wq = (const float*)d_in[14]; a.peer_sk = (const float*)d_in[15];
    a.peer_u = (const float*)d_in[16]; a.peer_v = (const float*)d_in[17]; a.final_norm_w = (const float*)d_in[18];
    a.out = (float*)d_out; a.ws = (unsigned char*)d_ws;
    (void)hipMemsetAsync((unsigned char*)d_ws + WS_CTL, 0, CTL_BYTES, stream);
    void* kargs[] = {&a};
    hipError_t e = hipLaunchCooperativeKernel((const void*)mk_fwd, dim3(grid), dim3(NTHREADS), kargs, LDS_BYTES, stream);
    if (e != hipSuccess) fprintf(stderr, "kernel_launch: cooperative launch failed: %s (grid %d)\n", hipGetErrorString(e), grid);
}
```

```cpp
#include <hip/hip_runtime.h>
#include <hip/hip_cooperative_groups.h>
#include <cstdio>
#include <cstdint>
namespace cg = cooperative_groups;
#define DI __device__ __forceinline__
#define GP(T, p) ((T*)(__attribute__((address_space(1))) T*)(p))

typedef unsigned short bf16_t;
typedef float f32x4 __attribute__((ext_vector_type(4)));
typedef unsigned u32x4 __attribute__((ext_vector_type(4)));
typedef unsigned u32x2 __attribute__((ext_vector_type(2)));

constexpr int D = 1024, NB = 2, L = 16384, CL = 256, DEPTH = 4;
constexpr int NCTX = NB * CL, NLAT = NB * L, M = NCTX + NLAT;
constexpr int PW = 3072;
constexpr int C_HQ = 0, C_ZF = 256, C_ZB = 512, C_HV = 768, C_HG = 1024, C_SQ = 1280, C_SK = 1664, C_SV = 1792, C_NQ = 1920, C_NK = 2304, C_NV = 2688;
constexpr int MX_H = 0, MX_S = 256, MX_N = 640;
constexpr float EPS = 1e-6f;
constexpr int NTHREADS = 512, NWAVES = 8;
constexpr int LDS_BYTES = 163840;

constexpr size_t al256(size_t x) { return (x + 255) & ~(size_t)255; }
constexpr size_t WS_X = 0;
constexpr size_t WS_H = WS_X + al256((size_t)M * D * 4);
constexpr size_t WS_P = WS_H + al256((size_t)M * D * 2);
constexpr size_t WS_MIX = WS_P + al256((size_t)M * PW * 2);
constexpr size_t WS_OF = WS_MIX + al256((size_t)M * D * 2);
constexpr size_t WS_OB = WS_OF + al256((size_t)M * 256 * 4);
constexpr size_t WS_PIDX = WS_OB + al256((size_t)M * 256 * 4);
constexpr size_t WS_PG = WS_PIDX + al256((size_t)M * 128 * 4);
constexpr size_t WS_MOD = WS_PG + al256((size_t)M * 128 * 4);
constexpr size_t WS_LB = WS_MOD + al256((size_t)DEPTH * 3 * 6 * D * 4);
constexpr size_t WS_ROPE = WS_LB + al256((size_t)2 * DEPTH * 256 * 4);
constexpr size_t WS_WIN = WS_ROPE + al256((size_t)(256 + 256 + 64 + 64) * 16 * 4);
constexpr size_t WS_WOUT = WS_WIN + al256((size_t)DEPTH * PW * D * 2);
constexpr size_t WS_WQ = WS_WOUT + al256((size_t)DEPTH * D * D * 2);
constexpr size_t WS_AC = WS_WQ + al256((size_t)DEPTH * 2048 * D * 2);
constexpr size_t WS_UB_ = 0; constexpr size_t WS_UB = WS_AC + al256((size_t)16 * 260 * 64 * 4); constexpr size_t WS_UB_OLD = WS_WQ + al256((size_t)DEPTH * 2048 * D * 2);
constexpr size_t WS_VB = WS_UB + al256((size_t)DEPTH * 16384 * D * 2);
constexpr size_t WS_PA = WS_VB + al256((size_t)DEPTH * 16384 * D * 2);
constexpr size_t WS_VS = WS_PA + al256((size_t)M * 128 * 4);
constexpr size_t WS_US = WS_VS + al256((size_t)DEPTH * 16384 * 4);
constexpr size_t WS_H8 = WS_US + al256((size_t)DEPTH * 16384 * 4);
constexpr size_t WS_HS = WS_H8 + al256((size_t)M * D);
constexpr size_t WS_SKH = WS_HS + al256((size_t)M * 4);
constexpr size_t WS_SKL = WS_SKH + al256((size_t)DEPTH * 8 * 2 * 128 * 128 * 2);
constexpr size_t WS_CTL = WS_SKL + al256((size_t)DEPTH * 8 * 2 * 128 * 128 * 2);
constexpr size_t CTL_BYTES = 65536;
constexpr size_t WS_END = WS_CTL + CTL_BYTES;

struct Args {
    const float *x, *c, *ctx, *c_ctx, *w_mod, *b_mod, *norm_mix_w, *norm_ffn_w, *w_in, *lb_logits, *hgrn_norm_w, *swa_sink, *nat_rpb, *w_out, *peer_wq, *peer_sk, *peer_u, *peer_v, *final_norm_w;
    float* out; unsigned char* ws;
};

DI float bf2f(bf16_t v) { return __uint_as_float((unsigned)v << 16); }
DI bf16_t f2bf(float f) { unsigned u = __float_as_uint(f); return (bf16_t)((u + 0x7fffu + ((u >> 16) & 1u)) >> 16); }
DI unsigned pk2(float lo, float hi) { return (unsigned)f2bf(lo) | ((unsigned)f2bf(hi) << 16); }
DI float wave_sum(float v) {
#pragma unroll
    for (int o = 1; o < 64; o <<= 1) v += __shfl_xor(v, o);
    return v;
}
typedef __bf16 bf16x2_t __attribute__((ext_vector_type(2)));
template <int CTRL> DI float dpp_(float x) { return __builtin_bit_cast(float, __builtin_amdgcn_mov_dpp(__builtin_bit_cast(int, x), CTRL, 0xf, 0xf, true)); }
DI float wave_sum_fast(float x) {
    x += dpp_<0xB1>(x); x += dpp_<0x4E>(x); x += dpp_<0x141>(x); x += dpp_<0x128>(x);
    auto s1 = __builtin_amdgcn_permlane16_swap(__float_as_uint(x), __float_as_uint(x), false, false); x = __uint_as_float(s1[0]) + __uint_as_float(s1[1]);
    auto s2 = __builtin_amdgcn_permlane32_swap(__float_as_uint(x), __float_as_uint(x), false, false); return __uint_as_float(s2[0]) + __uint_as_float(s2[1]);
}
DI float sigmoidf_(float z) { return 1.0f / (1.0f + __expf(-z)); }
DI float gelu_erf(float v) { return 0.5f * v * (1.0f + erff(v * 0.70710678118654752f)); }
DI int modvec_of_row(int r) { return r < NCTX ? 2 : (r - NCTX) / L; }
DI int lat_row(int b, int t) { return NCTX + b * L + t; }
DI int ctx_row(int b, int s) { return b * CL + s; }
DI void unpack8(const u32x4 w, float* o) {
    o[0] = __uint_as_float(w.x << 16); o[1] = __uint_as_float(w.x & 0xffff0000u);
    o[2] = __uint_as_float(w.y << 16); o[3] = __uint_as_float(w.y & 0xffff0000u);
    o[4] = __uint_as_float(w.z << 16); o[5] = __uint_as_float(w.z & 0xffff0000u);
    o[6] = __uint_as_float(w.w << 16); o[7] = __uint_as_float(w.w & 0xffff0000u);
}
DI void load_row64(const bf16_t* p, float (&o)[64]) {
#pragma unroll
    for (int i = 0; i < 8; ++i) { const u32x4 w = *(const u32x4*)(p + 8 * i); unpack8(w, &o[8 * i]); }
}
DI void rope64(float (&x)[64], const float* cr, const float* sr, const float* cc, const float* sc) {
#pragma unroll
    for (int i = 0; i < 16; ++i) {
        const float c1 = cr[i], s1 = sr[i], a = x[i], b = x[16 + i];
        x[i] = a * c1 - b * s1; x[16 + i] = b * c1 + a * s1;
        const float c2 = cc[i], s2 = sc[i], e = x[32 + i], f = x[48 + i];
        x[32 + i] = e * c2 - f * s2; x[48 + i] = f * c2 + e * s2;
    }
}

namespace pg8 {
#define PG8_LAS __attribute__((address_space(3)))
typedef unsigned short bf16_t;
typedef short bf16x8 __attribute__((ext_vector_type(8)));
typedef float f32x4 __attribute__((ext_vector_type(4)));
typedef unsigned u32x4 __attribute__((ext_vector_type(4)));
constexpr int BM = 256, BK = 64, HALF = 128, HTB = HALF * BK * 2  , STAGE_BYTES = 8 * HTB, NXCD = 8, WGM = 8;

__host__ __device__ __forceinline__ int lds_byte(int r, int c) { const int st = (r >> 4) * 2 + (c >> 5), rr = r & 15, cc = c & 31, ob = rr * 64 + cc * 2; return st * 1024 + (ob ^ (((ob >> 9) & 1) << 5)); }
__host__ __device__ __forceinline__ void stage_rc(int b, int& R, int& C) { const int st = b / 1024, sb = b % 1024, swz = sb ^ (((sb >> 9) & 1) << 5); R = (st >> 1) * 16 + swz / 64; C = (st & 1) * 32 + (swz % 64) / 2; }
__host__ __device__ __forceinline__ int perm32(int rho) { const int n = rho >> 4, i = rho & 15; return 8 * (i >> 2) + 4 * n + (i & 3); }

struct Unit { int pm, pn; };
struct Gemm { const bf16_t* A; const bf16_t* Bt; int M, N, K; };

struct StaticOrder {
    int nM, nN, nwg, G, c;
    __host__ __device__ void init(int M, int N, int G_, int c_) { nM = M / BM; nN = N / BM; nwg = nM * nN; G = G_; c = c_; }
    __host__ __device__ bool next(int i, Unit& u) const {
        const long L = (long)i * G + c; if (L >= nwg) return false;
        int wgid = (int)L; { const int q = nwg / NXCD, r = nwg % NXCD, xcd = wgid % NXCD, off = wgid / NXCD; wgid = (xcd < r ? xcd * (q + 1) : r * (q + 1) + (xcd - r) * q) + off; }
        const int nig = WGM * nN, gid = wgid / nig, fm = gid * WGM, gsz = (nM - fm) < WGM ? (nM - fm) : WGM;
        u.pm = fm + ((wgid % nig) % gsz); u.pn = (wgid % nig) / gsz; return true;
    }
    __device__ __forceinline__ void a_ready(const Unit&) const {}
    __device__ __forceinline__ void done(const Unit&) const {}
};


__device__ __forceinline__ unsigned cvt_pk_bf16(float lo, float hi) { unsigned r; asm volatile("v_cvt_pk_bf16_f32 %0, %1, %2" : "=v"(r) : "v"(lo), "v"(hi)); return r; }
constexpr int EPI_LDS_OFF = STAGE_BYTES, EPI_LDS_WAVE = 2560;
struct EpiStore {
    static constexpr bool PERM = true, AFTER_DRAIN = false;
    bf16_t* O; int ldc; PG8_LAS unsigned char* lds; const float* rope; int nctx, seqlen, rowbase;
    __device__ __forceinline__ void operator()(const f32x4 (&acc)[2][2][4][2], const Unit& u, int wr, int wc, int fr, int fq) const {
        PG8_LAS unsigned char* T = lds + EPI_LDS_OFF + (wr * 4 + wc) * EPI_LDS_WAVE;
        const int lane = fr + 16 * fq, rr = lane >> 2, cc = lane & 3;
        const int row0 = rowbase + u.pm * BM + wr * 64, col0 = u.pn * BM + wc * 32;
        const bool dorope = rope != nullptr && (u.pn == 5 || u.pn == 6) && rowbase + u.pm * BM >= nctx;
#pragma unroll
        for (int ai = 0; ai < 2; ++ai)
#pragma unroll
            for (int m = 0; m < 4; ++m)
#pragma unroll
                for (int bj = 0; bj < 2; ++bj) { const f32x4 v0 = acc[ai][bj][m][0], v1 = acc[ai][bj][m][1];
                    u32x4 w; w.x = cvt_pk_bf16(v0[0], v0[1]); w.y = cvt_pk_bf16(v0[2], v0[3]); w.z = cvt_pk_bf16(v1[0], v1[1]); w.w = cvt_pk_bf16(v1[2], v1[3]);
                    *(PG8_LAS u32x4*)(T + fr * 80 + 16 * fq) = w;
                    asm volatile("s_waitcnt lgkmcnt(0)" ::: "memory");
                    u32x4 o = *(const PG8_LAS u32x4*)(T + rr * 80 + 16 * cc);
                    asm volatile("s_waitcnt lgkmcnt(0)" ::: "memory");
                    const int grow = row0 + ai * HALF + m * 16 + rr;
                    if (dorope) {
                        const int t = (grow - nctx) % seqlen; const bool second = (wc & 1) != 0;
                        const float* ct = rope + (second ? 8192 + (t & 63) * 16 : (t >> 6) * 16) + 8 * (cc & 1); const float* st = ct + (second ? 1024 : 4096);
                        const f32x4 c0 = *(const f32x4*)ct, c1 = *(const f32x4*)(ct + 4), s0 = *(const f32x4*)st, s1 = *(const f32x4*)(st + 4);
                        const float cs[8] = {c0[0], c0[1], c0[2], c0[3], c1[0], c1[1], c1[2], c1[3]}, sn[8] = {s0[0], s0[1], s0[2], s0[3], s1[0], s1[1], s1[2], s1[3]};
                        const unsigned ow[4] = {o.x, o.y, o.z, o.w}; unsigned rw[4];
                        const float sg = cc >= 2 ? 1.0f : -1.0f;
#pragma unroll
                        for (int q = 0; q < 4; ++q) { const unsigned pw = (unsigned)__builtin_amdgcn_mov_dpp((int)ow[q], 0x4E, 0xf, 0xf, true);
                            const float x0 = __uint_as_float(ow[q] << 16), x1 = __uint_as_float(ow[q] & 0xffff0000u), p0 = __uint_as_float(pw << 16), p1 = __uint_as_float(pw & 0xffff0000u);
                            rw[q] = cvt_pk_bf16(x0 * cs[2 * q] + sg * p0 * sn[2 * q], x1 * cs[2 * q + 1] + sg * p1 * sn[2 * q + 1]); }
                        o = (u32x4){rw[0], rw[1], rw[2], rw[3]}; }
                    *(u32x4*)(O + (size_t)grow * ldc + col0 + bj * HALF + 8 * cc) = o; }
    }
};
template <bool XF32> struct EpiResid {
    static constexpr bool PERM = false, AFTER_DRAIN = false;
    bf16_t* X; int ldc; const float* gate; int gstride, nctx, seqlen; PG8_LAS unsigned char* lds; int rowbase; const void* Xin;
    __device__ __forceinline__ void operator()(const f32x4 (&acc)[2][2][4][2], const Unit& u, int wr, int wc, int fr, int fq) const {
        PG8_LAS float* T = (PG8_LAS float*)(lds + EPI_LDS_OFF + (wr * 4 + wc) * EPI_LDS_WAVE);
        const int lane = fr + 16 * fq, rr = lane >> 3, cc = lane & 7;
        const int r0 = rowbase + u.pm * BM; const int vsel = r0 < nctx ? 2 : (r0 - nctx) / seqlen;
        const int row0 = r0 + wr * 64, col0 = u.pn * BM + wc * 32 + 4 * cc;
#pragma unroll
        for (int bj = 0; bj < 2; ++bj) { const f32x4 g = *(const f32x4*)(gate + (size_t)vsel * gstride + col0 + bj * HALF);
#pragma unroll
            for (int ai = 0; ai < 2; ++ai)
#pragma unroll
                for (int m = 0; m < 4; ++m) {
#pragma unroll
                    for (int n = 0; n < 2; ++n) *(PG8_LAS f32x4*)(T + fr * 36 + 16 * n + 4 * fq) = acc[ai][bj][m][n];
                    asm volatile("s_waitcnt lgkmcnt(0)" ::: "memory");
                    const f32x4 t0 = *(const PG8_LAS f32x4*)(T + rr * 36 + 4 * cc), t1 = *(const PG8_LAS f32x4*)(T + (rr + 8) * 36 + 4 * cc);
                    asm volatile("s_waitcnt lgkmcnt(0)" ::: "memory");
                    const size_t ro = (size_t)(row0 + ai * HALF + m * 16 + rr) * ldc + col0 + bj * HALF, io = (size_t)(row0 - rowbase + ai * HALF + m * 16 + rr) * ldc + col0 + bj * HALF;
                    f32x4 a, b;
                    if (XF32) { a = *(const f32x4*)((const float*)Xin + io); b = *(const f32x4*)((const float*)Xin + io + (size_t)8 * ldc); }
                    else { const unsigned* pa = (const unsigned*)((const bf16_t*)Xin + io); const unsigned* pb = (const unsigned*)((const bf16_t*)Xin + io + (size_t)8 * ldc); const unsigned a0 = pa[0], a1 = pa[1], b0 = pb[0], b1 = pb[1];
                        a = (f32x4){__uint_as_float(a0 << 16), __uint_as_float(a0 & 0xffff0000u), __uint_as_float(a1 << 16), __uint_as_float(a1 & 0xffff0000u)};
                        b = (f32x4){__uint_as_float(b0 << 16), __uint_as_float(b0 & 0xffff0000u), __uint_as_float(b1 << 16), __uint_as_float(b1 & 0xffff0000u)}; }
                    a += g * t0; b += g * t1;
                    unsigned* xa_ = (unsigned*)(X + ro); unsigned* xb_ = (unsigned*)(X + ro + (size_t)8 * ldc);
                    xa_[0] = cvt_pk_bf16(a[0], a[1]); xa_[1] = cvt_pk_bf16(a[2], a[3]); xb_[0] = cvt_pk_bf16(b[0], b[1]); xb_[1] = cvt_pk_bf16(b[2], b[3]); } }
    }
};

template <class Epi, class Sched, bool ALIGN_EPI = false, bool SP2 = false>
__device__ __forceinline__ void gemm_phase(PG8_LAS unsigned char* lds, const Gemm g, const Sched& S, const Epi& E, int tid_in) {
    int tid_ = tid_in; asm volatile("" : "+v"(tid_));
    const int tid = tid_, wid = __builtin_amdgcn_readfirstlane(tid >> 6), lane = tid & 63, wr = wid >> 2, wc = wid & 3, fr = lane & 15, fq = lane >> 4;
    const int K = g.K, nt = K / BK;
    unsigned voffA[2], voffB[2];
#pragma unroll
    for (int i = 0; i < 2; ++i) { int R, C; stage_rc(tid * 16 + i * 8192, R, C); const int Rb = Epi::PERM ? ((R & ~31) + perm32(R & 31)) : R;
        voffA[i] = (unsigned)(R * K + C) * 2u; voffB[i] = (unsigned)(Rb * K + C) * 2u; }
    const size_t kstep = (size_t)(BK * 2);
    const size_t hstep = (size_t)HALF * K * 2;
    const size_t tstep = 2 * hstep;
    const unsigned ldsw = (unsigned)wid * 1024u;
    const int aoff = lds_byte(wr * 64 + fr, fq * 8), boff = lds_byte(wc * 32 + fr, fq * 8);
#define PG8_SA(b, h) (((b) * 2 + (h)) * HTB)
#define PG8_SB(b, h) ((4 + (b) * 2 + (h)) * HTB)
#define PG8_STAGE(bufoff, gbase, voff) do { _Pragma("unroll") for (int _i = 0; _i < 2; ++_i) \
        __builtin_amdgcn_global_load_lds((const unsigned*)((const char*)(gbase) + (voff)[_i]), (PG8_LAS unsigned*)(lds + (bufoff) + ldsw + _i * 8192), 16, 0, 0); } while (0)
#define PG8_LDA(dst, b, h) do { _Pragma("unroll") for (int m = 0; m < 4; ++m) _Pragma("unroll") for (int k = 0; k < 2; ++k) dst[m][k] = *(const PG8_LAS bf16x8*)(lds + PG8_SA(b, h) + aoff + m * 2048 + k * 1024); } while (0)
#define PG8_LDB(dst, b, h) do { _Pragma("unroll") for (int n = 0; n < 2; ++n) _Pragma("unroll") for (int k = 0; k < 2; ++k) dst[n][k] = *(const PG8_LAS bf16x8*)(lds + PG8_SB(b, h) + boff + n * 2048 + k * 1024); } while (0)
#define PG8_MMA(ai, bj, At, Bt) do { __builtin_amdgcn_s_setprio(1); _Pragma("unroll") for (int m = 0; m < 4; ++m) _Pragma("unroll") for (int n = 0; n < 2; ++n) _Pragma("unroll") for (int k = 0; k < 2; ++k) \
        acc[ai][bj][m][n] = __builtin_amdgcn_mfma_f32_16x16x32_bf16(Bt[n][k], At[m][k], acc[ai][bj][m][n], 0, 0, 0); __builtin_amdgcn_s_setprio(0); } while (0)
#define PG8_WAIT_V(n) asm volatile("s_waitcnt vmcnt(" #n ")" ::: "memory")
#define PG8_WAIT_L(n) asm volatile("s_waitcnt lgkmcnt(" #n ")" ::: "memory")
#define PG8_BAR __builtin_amdgcn_s_barrier()
#define PG8_SCHED __builtin_amdgcn_sched_barrier(0)
    Unit cur, nxt; int ui = 0;
    if (!S.next(0, cur)) return;
    f32x4 acc[2][2][4][2];
#pragma unroll
    for (int a = 0; a < 2; ++a)
#pragma unroll
        for (int b = 0; b < 2; ++b)
#pragma unroll
            for (int m = 0; m < 4; ++m)
#pragma unroll
                for (int n = 0; n < 2; ++n) acc[a][b][m][n] = (f32x4){0.f, 0.f, 0.f, 0.f};
    bf16x8 At[4][2], B0[2][2], B1[2][2];
    const char* cA = (const char*)g.A + (size_t)cur.pm * tstep; const char* cB = (const char*)g.Bt + (size_t)cur.pn * tstep;
    S.a_ready(cur);
    if constexpr (SP2) {
        PG8_STAGE(PG8_SB(0, 0), cB, voffB); PG8_STAGE(PG8_SB(0, 1), cB + hstep, voffB); PG8_STAGE(PG8_SA(0, 0), cA, voffA); PG8_STAGE(PG8_SA(0, 1), cA + hstep, voffA);
        if (wr == 1) PG8_BAR;
        PG8_WAIT_V(2); PG8_BAR;
        PG8_STAGE(PG8_SB(1, 0), cB + kstep, voffB); PG8_STAGE(PG8_SA(1, 0), cA + kstep, voffA); PG8_STAGE(PG8_SB(1, 1), cB + hstep + kstep, voffB);
        PG8_WAIT_V(6); PG8_BAR;
    } else {
        PG8_STAGE(PG8_SB(0, 0), cB, voffB); PG8_STAGE(PG8_SA(0, 0), cA, voffA); PG8_STAGE(PG8_SB(0, 1), cB + hstep, voffB); PG8_STAGE(PG8_SA(0, 1), cA + hstep, voffA);
        if (wr == 1) PG8_BAR;
        PG8_WAIT_V(4); PG8_BAR;
        PG8_STAGE(PG8_SB(1, 0), cB + kstep, voffB); PG8_STAGE(PG8_SA(1, 0), cA + kstep, voffA); PG8_STAGE(PG8_SB(1, 1), cB + hstep + kstep, voffB);
        PG8_WAIT_V(6); PG8_BAR;
    }
    for (;;) {
        const bool has_next = S.next(ui + 1, nxt);
        const char* nA = has_next ? (const char*)g.A + (size_t)nxt.pm * tstep : cA; const char* nB = has_next ? (const char*)g.Bt + (size_t)nxt.pn * tstep : cB;
        for (int t = 0; t < nt; t += 2) {
            const bool last = (t == nt - 2);
            const char* a1 = cA + (size_t)(t + 1) * kstep;
            const char* a2 = last ? nA : cA + (size_t)(t + 2) * kstep; const char* b2 = last ? nB : cB + (size_t)(t + 2) * kstep;
            const char* a3 = a2 + kstep; const char* b3 = b2 + kstep;
            if (last && has_next) S.a_ready(nxt);
            if constexpr (SP2) {
            PG8_LDB(B0, 0, 0); PG8_LDB(B1, 0, 1); PG8_SCHED; PG8_LDA(At, 0, 0); PG8_STAGE(PG8_SA(1, 1), a1 + hstep, voffA);
            PG8_WAIT_V(8); PG8_WAIT_L(0); PG8_BAR; PG8_MMA(0, 0, At, B0); PG8_MMA(0, 1, At, B1); PG8_BAR; PG8_SCHED;
            PG8_LDA(At, 0, 1); PG8_STAGE(PG8_SB(0, 0), b2, voffB); PG8_STAGE(PG8_SB(0, 1), b2 + hstep, voffB); PG8_STAGE(PG8_SA(0, 0), a2, voffA);
            PG8_WAIT_V(8); PG8_WAIT_L(0); PG8_BAR; PG8_MMA(1, 0, At, B0); PG8_MMA(1, 1, At, B1); PG8_BAR; PG8_SCHED;
            PG8_LDB(B0, 1, 0); PG8_LDB(B1, 1, 1); PG8_SCHED; PG8_LDA(At, 1, 0); PG8_STAGE(PG8_SA(0, 1), a2 + hstep, voffA);
            PG8_WAIT_V(8); PG8_WAIT_L(0); PG8_BAR; PG8_MMA(0, 0, At, B0); PG8_MMA(0, 1, At, B1); PG8_BAR; PG8_SCHED;
            PG8_LDA(At, 1, 1); PG8_STAGE(PG8_SB(1, 0), b3, voffB); PG8_STAGE(PG8_SB(1, 1), b3 + hstep, voffB); PG8_STAGE(PG8_SA(1, 0), a3, voffA);
            PG8_WAIT_V(8); PG8_WAIT_L(0); PG8_BAR; PG8_MMA(1, 0, At, B0); PG8_MMA(1, 1, At, B1); PG8_BAR; PG8_SCHED;
            } else {
            PG8_LDB(B0, 0, 0); PG8_SCHED; PG8_LDA(At, 0, 0); PG8_STAGE(PG8_SA(1, 1), a1 + hstep, voffA);
            PG8_WAIT_L(8); PG8_BAR; PG8_WAIT_L(0); PG8_MMA(0, 0, At, B0); PG8_BAR; PG8_SCHED;
            PG8_LDB(B1, 0, 1); PG8_STAGE(PG8_SB(0, 0), b2, voffB);
            PG8_BAR; PG8_WAIT_L(0); PG8_MMA(0, 1, At, B1); PG8_BAR;
            PG8_LDA(At, 0, 1); PG8_STAGE(PG8_SA(0, 0), a2, voffA);
            PG8_BAR; PG8_WAIT_L(0); PG8_MMA(1, 0, At, B0); PG8_BAR; PG8_SCHED;
            PG8_STAGE(PG8_SB(0, 1), b2 + hstep, voffB);
            PG8_WAIT_V(6); PG8_BAR; PG8_MMA(1, 1, At, B1); PG8_BAR;
            PG8_LDB(B0, 1, 0); PG8_SCHED; PG8_LDA(At, 1, 0); PG8_STAGE(PG8_SA(0, 1), a2 + hstep, voffA);
            PG8_WAIT_L(8); PG8_BAR; PG8_WAIT_L(0); PG8_MMA(0, 0, At, B0); PG8_BAR; PG8_SCHED;
            PG8_LDB(B1, 1, 1); PG8_STAGE(PG8_SB(1, 0), b3, voffB);
            PG8_BAR; PG8_WAIT_L(0); PG8_MMA(0, 1, At, B1); PG8_BAR;
            PG8_LDA(At, 1, 1); PG8_STAGE(PG8_SA(1, 0), a3, voffA);
            PG8_BAR; PG8_WAIT_L(0); PG8_MMA(1, 0, At, B0); PG8_BAR; PG8_SCHED;
            PG8_STAGE(PG8_SB(1, 1), b3 + hstep, voffB);
            PG8_WAIT_V(6); PG8_BAR; PG8_MMA(1, 1, At, B1); PG8_BAR;
            }
        }
        if constexpr (ALIGN_EPI) { if (wr == 0) PG8_BAR; }
        if constexpr (!Epi::AFTER_DRAIN) { E(acc, cur, wr, wc, fr, fq); S.done(cur); }
        if (!has_next) break;
#pragma unroll
        for (int a = 0; a < 2; ++a)
#pragma unroll
            for (int b = 0; b < 2; ++b)
#pragma unroll
                for (int m = 0; m < 4; ++m)
#pragma unroll
                    for (int n = 0; n < 2; ++n) acc[a][b][m][n] = (f32x4){0.f, 0.f, 0.f, 0.f};
        cur = nxt; cA = nA; cB = nB; ++ui;
        if constexpr (ALIGN_EPI) { if (wr == 1) PG8_BAR; }
    }
    PG8_WAIT_V(0);
    if constexpr (!ALIGN_EPI) { if (wr == 0) PG8_BAR; }
    PG8_BAR;
    if constexpr (Epi::AFTER_DRAIN) { E.fused(acc, cur, wr, wc, fr, fq, lds, wid, lane); S.done(cur); }
#undef PG8_SA
#undef PG8_SB
#undef PG8_STAGE
#undef PG8_LDA
#undef PG8_LDB
#undef PG8_MMA
#undef PG8_WAIT_V
#undef PG8_WAIT_L
#undef PG8_BAR
#undef PG8_SCHED
}
}

struct Ctx {
    unsigned aoff; int l;
    unsigned char* ws;
    DI bf16_t* XB() const { return GP(bf16_t, ws + WS_X); }
    DI bf16_t* H() const { return GP(bf16_t, ws + WS_H); }
    DI bf16_t* P() const { return GP(bf16_t, ws + WS_P); }
    DI bf16_t* QP() const { return GP(bf16_t, ws + WS_P); }
    DI bf16_t* MIX() const { return GP(bf16_t, ws + WS_MIX); }
    DI unsigned short* PIDX16() const { return GP(unsigned short, ws + WS_PIDX); }
    DI unsigned* PIDX32() const { return GP(unsigned, ws + WS_PIDX); }
    DI unsigned short* W16() const { return GP(unsigned short, ws + WS_PA); }
    DI unsigned* W32() const { return GP(unsigned, ws + WS_PA); }
    DI float* PG() const { return GP(float, ws + WS_PG); }
    DI float* MOD() const { return GP(float, ws + WS_MOD); }
    DI float* LB() const { return GP(float, ws + WS_LB); }
    DI float* ROPE() const { return GP(float, ws + WS_ROPE); }
    DI bf16_t* WIN() const { return GP(bf16_t, ws + WS_WIN); }
    DI bf16_t* WOUT() const { return GP(bf16_t, ws + WS_WOUT); }
    DI bf16_t* WQ() const { return GP(bf16_t, ws + WS_WQ); }
    DI bf16_t* UB() const { return GP(bf16_t, ws + WS_UB); }
    DI bf16_t* STB() const { return GP(bf16_t, ws + WS_OF); }
    DI float* AC() const { return GP(float, ws + WS_AC); }
    DI float* VS() const { return GP(float, ws + WS_VS); }
    DI float* US() const { return GP(float, ws + WS_US); }
    DI bf16_t* SKH() const { return GP(bf16_t, ws + WS_SKH); }
    DI bf16_t* SKL() const { return GP(bf16_t, ws + WS_SKL); }
    DI bf16_t* VB() const { return GP(bf16_t, ws + WS_VB); }
    DI unsigned char* H8() const { return GP(unsigned char, ws + WS_H8); }
    DI float* HS() const { return GP(float, ws + WS_HS); }
    unsigned char* lds; int tid, lane, wave, gw, ngw, bid, nb;
    int xg, nxg, jx, nloc;
};

#define LAS __attribute__((address_space(3)))
DI void transpose_item(const float* W, int Kd, int N, bf16_t* WT, LAS float* scr, int item, int lane) {
    const int nblk = N / 32, kb = item / nblk, nb = item % nblk, k0 = 64 * kb, n0 = 32 * nb;
#pragma unroll 8
    for (int i = 0; i < 32; ++i) { const int kk = 2 * i + (lane >> 5); scr[kk * 33 + (lane & 31)] = W[(size_t)(k0 + kk) * N + n0 + (lane & 31)]; }
    asm volatile("s_waitcnt lgkmcnt(0)" ::: "memory");
    const int c = lane & 7;
#pragma unroll
    for (int j = 0; j < 4; ++j) { const int n = (lane >> 3) + 8 * j; const LAS float* sp = scr + (8 * c) * 33 + n;
        u32x4 o; o.x = pk2(sp[0 * 33], sp[1 * 33]); o.y = pk2(sp[2 * 33], sp[3 * 33]); o.z = pk2(sp[4 * 33], sp[5 * 33]); o.w = pk2(sp[6 * 33], sp[7 * 33]);
        *(u32x4*)(WT + (size_t)(n0 + n) * Kd + k0 + 8 * c) = o; }
    asm volatile("s_waitcnt lgkmcnt(0)" ::: "memory");
}

template <class T> DI T* argp_(const Ctx& K, unsigned off) {
    const unsigned* p = (const unsigned*)(K.lds + K.aoff + off);
    const unsigned lo = __builtin_amdgcn_readfirstlane(p[0]), hi = __builtin_amdgcn_readfirstlane(p[1]);
    return GP(T, ((unsigned long long)hi << 32) | (unsigned long long)lo);
}
#define ARG(f) argp_<const float>(K, (unsigned)__builtin_offsetof(Args, f))

DI void ph_prologue(Ctx& K) {
    {
        LAS float* scr = (LAS float*)((LAS unsigned char*)K.lds + K.wave * 16384);
        constexpr int I_IN = (D / 64) * (PW / 32), I_OUT = (D / 64) * (D / 32), I_Q = (D / 64) * (2048 / 32), I_L = I_IN + I_OUT + I_Q;
        for (int it = K.gw; it < DEPTH * I_L; it += K.ngw) {
            const int l = it / I_L; int r = it % I_L;
            if (r < I_IN) { transpose_item(ARG(w_in) + (size_t)l * D * PW, D, PW, K.WIN() + (size_t)l * PW * D, scr, r, K.lane); continue; } r -= I_IN;
            if (r < I_OUT) { transpose_item(ARG(w_out) + (size_t)l * D * D, D, D, K.WOUT() + (size_t)l * D * D, scr, r, K.lane); continue; } r -= I_OUT;
            transpose_item(ARG(peer_wq) + (size_t)l * D * 2048, D, 2048, K.WQ() + (size_t)l * 2048 * D, scr, r, K.lane);
        }
    }
    const size_t gt = (size_t)K.bid * NTHREADS + K.tid, gs = (size_t)K.nb * NTHREADS;
    { const float* sk = ARG(peer_sk);
      for (size_t i = gt; i < (size_t)DEPTH * 8 * 2 * 128 * 128; i += gs) { const float v = sk[i]; const bf16_t hi = f2bf(v);
          const size_t lhp = i >> 14; const int key = (int)(i >> 7) & 127, d = (int)i & 127;
          const size_t o = (((lhp * 8 + (key >> 4)) * 4 + (d >> 5)) * 64 + (key & 15) + 16 * ((d >> 3) & 3)) * 8 + (d & 7);
          K.SKH()[o] = hi; K.SKL()[o] = f2bf(v - bf2f(hi)); } }
    { const float* pu = ARG(peer_u); unsigned char* UQ = (unsigned char*)K.UB();
      for (int row0 = K.gw; row0 < DEPTH * 16384; row0 += 2 * K.ngw) {
          f32x4 v2[2][4];
#pragma unroll
          for (int t = 0; t < 2; ++t) { const int row = min(row0 + t * K.ngw, DEPTH * 16384 - 1); const f32x4* src = (const f32x4*)(pu + (size_t)row * D);
#pragma unroll
              for (int j = 0; j < 4; ++j) v2[t][j] = src[j * 64 + K.lane]; }
#pragma unroll
          for (int t = 0; t < 2; ++t) { const int row = row0 + t * K.ngw; if (row >= DEPTH * 16384) break;
              float mx = 0.f;
#pragma unroll
              for (int j = 0; j < 4; ++j) mx = fmaxf(mx, fmaxf(fmaxf(fabsf(v2[t][j].x), fabsf(v2[t][j].y)), fmaxf(fabsf(v2[t][j].z), fabsf(v2[t][j].w))));
#pragma unroll
              for (int o = 1; o < 64; o <<= 1) mx = fmaxf(mx, __shfl_xor(mx, o));
              const float sc = fmaxf(mx, 1e-30f) * (1.0f / 127.0f), inv = 1.0f / sc;
              if (K.lane == 0) K.US()[row] = sc;
#pragma unroll
              for (int j = 0; j < 4; ++j) { const int col = j * 256 + K.lane * 4; const f32x4 v = v2[t][j];
                  const unsigned q0 = (unsigned)((int)rintf(v.x * inv)) & 0xffu, q1 = (unsigned)((int)rintf(v.y * inv)) & 0xffu, q2 = (unsigned)((int)rintf(v.z * inv)) & 0xffu, q3 = (unsigned)((int)rintf(v.w * inv)) & 0xffu;
                  *(unsigned*)(UQ + (size_t)row * D + col) = q0 | (q1 << 8) | (q2 << 16) | (q3 << 24); } } } }
    { const float* pv = ARG(peer_v); unsigned char* VQ = (unsigned char*)K.VB();
      for (int row0 = K.gw; row0 < DEPTH * 16384; row0 += 2 * K.ngw) {
          f32x4 v2[2][4];
#pragma unroll
          for (int t = 0; t < 2; ++t) { const int row = min(row0 + t * K.ngw, DEPTH * 16384 - 1); const f32x4* src = (const f32x4*)(pv + (size_t)row * D);
#pragma unroll
              for (int j = 0; j < 4; ++j) v2[t][j] = src[j * 64 + K.lane]; }
#pragma unroll
          for (int t = 0; t < 2; ++t) { const int row = row0 + t * K.ngw; if (row >= DEPTH * 16384) break;
              float mx = 0.f;
#pragma unroll
              for (int j = 0; j < 4; ++j) mx = fmaxf(mx, fmaxf(fmaxf(fabsf(v2[t][j].x), fabsf(v2[t][j].y)), fmaxf(fabsf(v2[t][j].z), fabsf(v2[t][j].w))));
#pragma unroll
              for (int o = 1; o < 64; o <<= 1) mx = fmaxf(mx, __shfl_xor(mx, o));
              const float sc = fmaxf(mx, 1e-30f) * (1.0f / 127.0f), inv = 1.0f / sc;
              if (K.lane == 0) K.VS()[row] = sc;
              const int l = row >> 14, e = row & 16383;
#pragma unroll
              for (int j = 0; j < 4; ++j) { const int col = j * 256 + K.lane * 4; const f32x4 v = v2[t][j];
                  const unsigned q0 = (unsigned)((int)rintf(v.x * inv)) & 0xffu, q1 = (unsigned)((int)rintf(v.y * inv)) & 0xffu, q2 = (unsigned)((int)rintf(v.z * inv)) & 0xffu, q3 = (unsigned)((int)rintf(v.w * inv)) & 0xffu;
                  *(unsigned*)(VQ + (((size_t)l * 8 + (col >> 7)) * 16384 + e) * 128 + (col & 127)) = q0 | (q1 << 8) | (q2 << 16) | (q3 << 24); } } } }
    { float* sv = (float*)K.lds;
      float* part = sv + 3 * D;
      __syncthreads();
      for (int i = K.tid; i < 3 * D; i += NTHREADS) { const int v = i / D, k = i % D; const float c = v < 2 ? ARG(c)[v * D + k] : ARG(c_ctx)[k]; sv[i] = c * sigmoidf_(c); }
      __syncthreads();
      for (int item = K.bid; item < DEPTH * 48; item += K.nb) {
          const int l = item / 48, cb = item % 48, kp = K.lane >> 5, cl = (K.lane & 31) * 4;
          const float* w = ARG(w_mod) + (size_t)l * D * 6 * D + cb * 128 + cl;
          f32x4 a0 = {0.f, 0.f, 0.f, 0.f}, a1 = a0, a2 = a0;
#pragma unroll 16
          for (int kk = 0; kk < 64; ++kk) { const int k = K.wave * 128 + 2 * kk + kp; const f32x4 wv = *(const f32x4*)(w + (size_t)k * 6 * D);
              a0 += wv * sv[k]; a1 += wv * sv[D + k]; a2 += wv * sv[2 * D + k]; }
#pragma unroll
          for (int j = 0; j < 4; ++j) { a0[j] += __shfl_xor(a0[j], 32); a1[j] += __shfl_xor(a1[j], 32); a2[j] += __shfl_xor(a2[j], 32); }
          if (kp == 0) { *(f32x4*)(part + (K.wave * 3 + 0) * 128 + cl) = a0; *(f32x4*)(part + (K.wave * 3 + 1) * 128 + cl) = a1; *(f32x4*)(part + (K.wave * 3 + 2) * 128 + cl) = a2; }
          __syncthreads();
          for (int i = K.tid; i < 384; i += NTHREADS) { const int v = i / 128, cc = i % 128; float sum = 0.f;
#pragma unroll
              for (int w8 = 0; w8 < 8; ++w8) sum += part[(w8 * 3 + v) * 128 + cc];
              const int col = cb * 128 + cc; K.MOD()[((size_t)l * 3 + v) * 6 * D + col] = sum + ARG(b_mod)[(size_t)l * 6 * D + col]; }
          __syncthreads();
      } }
    for (size_t i = gt; i < 2 * 256; i += gs) {
        const int dir = (int)(i / 256), ch = (int)(i % 256);
        float lg[DEPTH], mx = -1e30f;
#pragma unroll
        for (int l = 0; l < DEPTH; ++l) { lg[l] = ARG(lb_logits)[((size_t)dir * DEPTH + l) * 256 + ch]; mx = fmaxf(mx, lg[l]); }
        float s = 0.f;
#pragma unroll
        for (int l = 0; l < DEPTH; ++l) { lg[l] = expf(lg[l] - mx); s += lg[l]; }
        float cum = 0.f;
#pragma unroll
        for (int l = 0; l < DEPTH; ++l) { if (l > 0) cum += lg[l] / s; K.LB()[((size_t)dir * DEPTH + l) * 256 + ch] = cum; }
    }
    for (size_t i = gt; i < (256 + 64) * 16; i += gs) {
        const int pos = (int)(i / 16), f = (int)(i % 16);
        const float inv = powf(10000.0f, -(float)f / 16.0f);
        if (pos < 256) { const float ang = (float)pos * inv; K.ROPE()[pos * 16 + f] = cosf(ang); K.ROPE()[4096 + pos * 16 + f] = sinf(ang); }
        else { const int pc = pos - 256; const float ang = (float)pc * inv; K.ROPE()[8192 + pc * 16 + f] = cosf(ang); K.ROPE()[8192 + 1024 + pc * 16 + f] = sinf(ang); }
    }
}

template <bool F32IN> DI void ph_norm_t(Ctx& K, const float* nw, int shift_chunk) {
    const float* modl = K.MOD() + (size_t)K.l * 3 * 6 * D;
    f32x4 vn[4]; u32x2 vb[4]; f32x4 wsc[4], sh[4]; int mvc = -1;
    auto req = [&](int r) { if (F32IN) { const f32x4* xr = (const f32x4*)(r < NCTX ? ARG(ctx) + (size_t)r * D : ARG(x) + (size_t)(r - NCTX) * D);
#pragma unroll
            for (int j = 0; j < 4; ++j) vn[j] = xr[j * 64 + K.lane]; }
        else { const u32x2* xr = (const u32x2*)(K.XB() + (size_t)r * D);
#pragma unroll
            for (int j = 0; j < 4; ++j) vb[j] = xr[j * 64 + K.lane]; } };
    req(min(K.gw, M - 1));
#pragma unroll 1
    for (int r = K.gw; r < M; r += K.ngw) {
        f32x4 v[4]; float ss = 0.f;
#pragma unroll
        for (int j = 0; j < 4; ++j) { if (F32IN) v[j] = vn[j]; else v[j] = (f32x4){__uint_as_float(vb[j].x << 16), __uint_as_float(vb[j].x & 0xffff0000u), __uint_as_float(vb[j].y << 16), __uint_as_float(vb[j].y & 0xffff0000u)};
            ss += v[j].x * v[j].x + v[j].y * v[j].y + v[j].z * v[j].z + v[j].w * v[j].w; }
        req(min(r + K.ngw, M - 1));
        const int mvi = modvec_of_row(r);
        if (mvi != mvc) { mvc = mvi; const float* mv = modl + (size_t)mvi * 6 * D;
#pragma unroll
            for (int j = 0; j < 4; ++j) { const int c4 = j * 64 + K.lane; const f32x4 w = ((const f32x4*)nw)[c4], sc = ((const f32x4*)(mv + (shift_chunk + 1) * D))[c4]; sh[j] = ((const f32x4*)(mv + shift_chunk * D))[c4];
                wsc[j] = (f32x4){w.x * (1.f + sc.x), w.y * (1.f + sc.y), w.z * (1.f + sc.z), w.w * (1.f + sc.w)}; } }
        ss = wave_sum(ss);
        const float rs = rsqrtf(ss * (1.0f / D) + EPS);
        u32x2* ho = (u32x2*)(K.H() + (size_t)r * D);
#pragma unroll
        for (int j = 0; j < 4; ++j) {
            const int c4 = j * 64 + K.lane;
            f32x4 y; y.x = v[j].x * rs * wsc[j].x + sh[j].x; y.y = v[j].y * rs * wsc[j].y + sh[j].y; y.z = v[j].z * rs * wsc[j].z + sh[j].z; y.w = v[j].w * rs * wsc[j].w + sh[j].w;
            u32x2 o; o.x = pk2(y.x, y.y); o.y = pk2(y.z, y.w); ho[c4] = o;
            if (shift_chunk == 3) { v[j].x = __uint_as_float(o.x << 16); v[j].y = __uint_as_float(o.x & 0xffff0000u); v[j].z = __uint_as_float(o.y << 16); v[j].w = __uint_as_float(o.y & 0xffff0000u); }
        }
        if (shift_chunk == 3) {
            float mx = 0.f;
#pragma unroll
            for (int j = 0; j < 4; ++j) mx = fmaxf(mx, fmaxf(fmaxf(fabsf(v[j].x), fabsf(v[j].y)), fmaxf(fabsf(v[j].z), fabsf(v[j].w))));
#pragma unroll
            for (int o = 1; o < 64; o <<= 1) mx = fmaxf(mx, __shfl_xor(mx, o));
            const float sc = fmaxf(mx, 1e-30f) * (1.0f / 127.0f), inv = 1.0f / sc;
            if (K.lane == 0) K.HS()[r] = sc;
#pragma unroll
            for (int j = 0; j < 4; ++j) { const unsigned q0 = (unsigned)((int)rintf(v[j].x * inv)) & 0xffu, q1 = (unsigned)((int)rintf(v[j].y * inv)) & 0xffu, q2 = (unsigned)((int)rintf(v[j].z * inv)) & 0xffu, q3 = (unsigned)((int)rintf(v[j].w * inv)) & 0xffu;
                *(unsigned*)(K.H8() + (size_t)r * D + (j * 64 + K.lane) * 4) = q0 | (q1 << 8) | (q2 << 16) | (q3 << 24); }
        }
    }
}
DI void ph_norm(Ctx& K, const float* nw, int shift_chunk) { if (K.l == 0 && shift_chunk == 0) ph_norm_t<true>(K, nw, shift_chunk); else ph_norm_t<false>(K, nw, shift_chunk); }

typedef short sg_bf16x8 __attribute__((ext_vector_type(8)));
template <int NT, bool RESID> DI void sg_ctx(Ctx& K, const bf16_t* A, const bf16_t* Bt, bf16_t* out, bf16_t* X, const float* gate, const float* Xin) {
    constexpr int N = 1024 * NT, RS = 272, OFF_B = 64 * RS, BUF = (64 + 32 * NT) * RS;
    int tid = K.tid; asm volatile("" : "+v"(tid));
    const int lane = tid & 63, wave = __builtin_amdgcn_readfirstlane(tid >> 6), r16 = lane & 15, g4 = lane >> 4, mt = wave & 3, nh = wave >> 2;
    const int lrow = tid >> 4, lc = tid & 15;
    for (int u = K.bid; u < 256; u += K.nb) {
        const int xcd = u & 7, j = u >> 3, ct = xcd * 4 + (j & 3), rt = j >> 2;
        const int row0 = 64 * rt, col0 = 32 * NT * ct;
        const bf16_t* ga = A + (size_t)(row0 + lrow) * D + 8 * lc; const bf16_t* gb = Bt + (size_t)(col0 + lrow) * D + 8 * lc;
        u32x4 ra[3][2], rb[3][NT];
        f32x4 acc[NT];
#pragma unroll
        for (int n = 0; n < NT; ++n) acc[n] = (f32x4){0.f, 0.f, 0.f, 0.f};
#define SG_LOAD(s_, c_) do { ra[s_][0] = *(const u32x4*)(ga + 128 * (c_)); ra[s_][1] = *(const u32x4*)(ga + 32 * D + 128 * (c_)); \
        _Pragma("unroll") for (int i_ = 0; i_ < NT; ++i_) rb[s_][i_] = *(const u32x4*)(gb + (size_t)32 * i_ * D + 128 * (c_)); } while (0)
        SG_LOAD(0, 0); SG_LOAD(1, 1); SG_LOAD(2, 2);
        __syncthreads();
#pragma unroll
        for (int c = 0; c < 8; ++c) {
            unsigned char* buf = K.lds + (c & 1) * BUF;
            *(u32x4*)(buf + lrow * RS + 16 * lc) = ra[c % 3][0]; *(u32x4*)(buf + (lrow + 32) * RS + 16 * lc) = ra[c % 3][1];
#pragma unroll
            for (int i = 0; i < NT; ++i) *(u32x4*)(buf + OFF_B + (lrow + 32 * i) * RS + 16 * lc) = rb[c % 3][i];
            if (c + 3 < 8) SG_LOAD(c % 3, c + 3);
            __syncthreads();
#pragma unroll
            for (int ks = 0; ks < 4; ++ks) {
                const sg_bf16x8 af = *(const sg_bf16x8*)(buf + (16 * mt + r16) * RS + 64 * ks + 16 * g4);
#pragma unroll
                for (int n = 0; n < NT; ++n) { const sg_bf16x8 bf = *(const sg_bf16x8*)(buf + OFF_B + (16 * (NT * nh + n) + r16) * RS + 64 * ks + 16 * g4);
                    acc[n] = __builtin_amdgcn_mfma_f32_16x16x32_bf16(bf, af, acc[n], 0, 0, 0); }
            }
        }
#undef SG_LOAD
        const int row = row0 + 16 * mt + r16;
#pragma unroll
        for (int n = 0; n < NT; ++n) { const int col = col0 + 16 * (NT * nh + n) + 4 * g4;
            if constexpr (RESID) { unsigned* xp = (unsigned*)(X + (size_t)row * D + col); const f32x4 g = *(const f32x4*)(gate + col); f32x4 x;
                if (Xin) x = *(const f32x4*)(Xin + (size_t)row * D + col); else { const unsigned x0 = xp[0], x1 = xp[1]; x = (f32x4){__uint_as_float(x0 << 16), __uint_as_float(x0 & 0xffff0000u), __uint_as_float(x1 << 16), __uint_as_float(x1 & 0xffff0000u)}; }
                x += g * acc[n]; xp[0] = pk2(x[0], x[1]); xp[1] = pk2(x[2], x[3]); }
            else { u32x2 o; o.x = pk2(acc[n][0], acc[n][1]); o.y = pk2(acc[n][2], acc[n][3]); *(u32x2*)(out + (size_t)row * N + col) = o; } }
        __syncthreads();
    }
}
DI void ph_gemm_store(Ctx& K, const bf16_t* A, const bf16_t* Bt, int N, bf16_t* out, const float* rope) {
    { pg8::Gemm g{A + (size_t)NCTX * D, Bt, NLAT, N, D}; pg8::StaticOrder S; S.init(NLAT, N, K.nb, K.bid);
      pg8::EpiStore E{out, N, (LAS unsigned char*)K.lds, rope, NCTX, L, NCTX};
      pg8::gemm_phase<pg8::EpiStore, pg8::StaticOrder, true, true>((LAS unsigned char*)K.lds, g, S, E, K.tid); }
    if (N == PW) sg_ctx<3, false>(K, A, Bt, out, nullptr, nullptr, nullptr); else sg_ctx<2, false>(K, A, Bt, out, nullptr, nullptr, nullptr);
}
DI void ph_gemm_resid(Ctx& K, const bf16_t* A, const bf16_t* Bt, int chunk) {
    const float* gate = K.MOD() + (size_t)K.l * 3 * 6 * D + (size_t)chunk * D;
    { pg8::Gemm g{A + (size_t)NCTX * D, Bt, NLAT, D, D}; pg8::StaticOrder S; S.init(NLAT, D, K.nb, K.bid);
      if (K.l == 0) { pg8::EpiResid<true> E{K.XB(), D, gate, 6 * D, NCTX, L, (LAS unsigned char*)K.lds, NCTX, (const void*)ARG(x)};
          pg8::gemm_phase<pg8::EpiResid<true>, pg8::StaticOrder, true, true>((LAS unsigned char*)K.lds, g, S, E, K.tid); }
      else { pg8::EpiResid<false> E{K.XB(), D, gate, 6 * D, NCTX, L, (LAS unsigned char*)K.lds, NCTX, (const void*)(K.XB() + (size_t)NCTX * D)};
          pg8::gemm_phase<pg8::EpiResid<false>, pg8::StaticOrder, true, true>((LAS unsigned char*)K.lds, g, S, E, K.tid); } }
    sg_ctx<1, true>(K, A, Bt, nullptr, K.XB(), gate + (size_t)2 * 6 * D, K.l == 0 ? ARG(ctx) : nullptr);
}

typedef short bf16x8_t __attribute__((ext_vector_type(8)));
#define MFMA16(a, b, c) __builtin_amdgcn_mfma_f32_16x16x32_bf16((a), (b), (c), 0, 0, 0)
constexpr int HG_NCH = (CL + L) / 64;
constexpr int HG_LFS = 68;
constexpr int HG_TS = 72;
constexpr int HGL_LF = 0, HGL_OM = HGL_LF + 2 * 64 * HG_LFS * 4, HGL_VT = HGL_OM + 2 * 64 * HG_LFS * 4, HGL_KT = HGL_VT + 64 * HG_TS * 2, HGL_SC = HGL_KT + 2 * 64 * HG_TS * 2, HGL_OD = HGL_SC + 8 * 16 * HG_TS * 2, HGL_LB = HGL_OD + 2 * 64 * HG_LFS * 4, HGL_END = HGL_LB + 3 * 256 * 4;
static_assert(HGL_END <= LDS_BYTES - 256, "hgrn LDS map");
constexpr int HG_NIT = NB * 4 * HG_NCH;
DI int hg_block_row(int b, int tb, int tok) { return tb < 4 ? ctx_row(b, tb * 64 + tok) : lat_row(b, (tb - 4) * 64 + tok); }
DI int hg_bwd_chunk(int tb) { return tb < 4 ? 3 - tb : 4 + 255 - (tb - 4); }
DI int hg_sw(int row, int col) { return row * HG_TS + ((((col >> 3) ^ (row >> 3)) & 7) << 3) + (col & 7); }
struct HgIn { u32x4 zf, zb, hv; };
DI void hg_item(int item, int& b, int& h, int& tb) { tb = item % HG_NCH; h = (item / HG_NCH) & 3; b = item / (HG_NCH * 4); }
DI void hg_load(Ctx& K, int item, HgIn& r) {
    int b, h, tb; hg_item(item, b, h, tb); const int tok = K.tid >> 3, c = K.tid & 7;
    const bf16_t* pr = K.P() + (size_t)hg_block_row(b, tb, tok) * PW + h * 64 + 8 * c;
    r.zf = *(const u32x4*)(pr + C_ZF); r.zb = *(const u32x4*)(pr + C_ZB); r.hv = *(const u32x4*)(pr + C_HV);
}
DI void hg_prep1(Ctx& K, int h, const HgIn& r) {
    float* LF = (float*)(K.lds + HGL_LF); float* OM = (float*)(K.lds + HGL_OM); bf16_t* VT = (bf16_t*)(K.lds + HGL_VT);
    const int tok = K.tid >> 3, c = K.tid & 7;
#pragma unroll
    for (int dir = 0; dir < 2; ++dir) {
        float z[8]; unpack8(dir ? r.zb : r.zf, z);
        const float* lb = (const float*)(K.lds + HGL_LB) + dir * 256 + h * 64 + 8 * c;
        float lf[8], om[8];
#pragma unroll
        for (int j = 0; j < 8; ++j) { const float lbv = lb[j], sg = sigmoidf_(z[j]); const float f = fmaxf(lbv + (1.f - lbv) * sg, 1e-30f); lf[j] = __logf(f); om[j] = (1.f - lbv) * (1.f - sg); }
        float* lfp = LF + (dir * 64 + tok) * HG_LFS + 8 * c; float* omp = OM + (dir * 64 + tok) * HG_LFS + 8 * c;
        *(f32x4*)lfp = (f32x4){lf[0], lf[1], lf[2], lf[3]}; *(f32x4*)(lfp + 4) = (f32x4){lf[4], lf[5], lf[6], lf[7]};
        *(f32x4*)omp = (f32x4){om[0], om[1], om[2], om[3]}; *(f32x4*)(omp + 4) = (f32x4){om[4], om[5], om[6], om[7]};
    }
    { const unsigned w[4] = {r.hv.x, r.hv.y, r.hv.z, r.hv.w};
#pragma unroll
      for (int j = 0; j < 4; ++j) { VT[hg_sw(8 * c + 2 * j, tok)] = (bf16_t)(w[j] & 0xffffu); VT[hg_sw(8 * c + 2 * j + 1, tok)] = (bf16_t)(w[j] >> 16); } }
}
DI void hg_prep2(Ctx& K) {
    float* LF = (float*)(K.lds + HGL_LF);
    __syncthreads();
    if (K.tid < 128) {
        const int dir = K.tid >> 6, d = K.tid & 63; float* col = LF + dir * 64 * HG_LFS + d;
        float carry = 0.f;
#pragma unroll
        for (int hf = 0; hf < 2; ++hf) { float v[32];
#pragma unroll
            for (int p = 0; p < 32; ++p) v[p] = col[(dir ? 63 - (32 * hf + p) : 32 * hf + p) * HG_LFS];
            v[0] += carry;
#pragma unroll
            for (int p = 1; p < 32; ++p) v[p] += v[p - 1];
#pragma unroll
            for (int p = 0; p < 32; ++p) col[(dir ? 63 - (32 * hf + p) : 32 * hf + p) * HG_LFS] = v[p];
            carry = v[31]; }
    }
    __syncthreads();
}
DI void hg_stage_consts(Ctx& K) {
    float* LBL = (float*)(K.lds + HGL_LB);
    for (int i = K.tid; i < 768; i += NTHREADS) LBL[i] = i < 512 ? K.LB()[((size_t)(i >> 8) * DEPTH + K.l) * 256 + (i & 255)] : ARG(hgrn_norm_w)[(size_t)K.l * 256 + (i - 512)];
}
DI void ph_hgrn_A(Ctx& K) {
    float* LF = (float*)(K.lds + HGL_LF); float* OM = (float*)(K.lds + HGL_OM); bf16_t* VT = (bf16_t*)(K.lds + HGL_VT); bf16_t* KT = (bf16_t*)(K.lds + HGL_KT);
    const int r16 = K.lane & 15, g4 = K.lane >> 4;
    if (K.bid >= HG_NIT) return;
    HgIn in; hg_load(K, K.bid, in);
    hg_stage_consts(K);
#pragma unroll 1
    for (int item = K.bid; item < HG_NIT; item += K.nb) {
        int b, h, tb; hg_item(item, b, h, tb);
        __syncthreads();
        hg_prep1(K, h, in);
        hg_load(K, item + K.nb < HG_NIT ? item + K.nb : item, in);
        hg_prep2(K);
        { const int tok = K.tid >> 3, c = K.tid & 7;
#pragma unroll
          for (int dir = 0; dir < 2; ++dir) {
              const float* bl = LF + (dir * 64 + (dir ? 0 : 63)) * HG_LFS + 8 * c; const float* bt = LF + (dir * 64 + tok) * HG_LFS + 8 * c; const float* om = OM + (dir * 64 + tok) * HG_LFS + 8 * c;
#pragma unroll
              for (int j = 0; j < 8; ++j) KT[dir * 64 * HG_TS + hg_sw(8 * c + j, tok)] = f2bf(om[j] * __expf(bl[j] - bt[j]));
          }
          if (K.tid < 128) { const int dir = K.tid >> 6, d = K.tid & 63; const int chain = (b * 2 + dir) * 4 + h, ch = dir ? hg_bwd_chunk(tb) : tb;
              K.AC()[((size_t)chain * HG_NCH + ch) * 64 + d] = __expf(LF[(dir * 64 + (dir ? 0 : 63)) * HG_LFS + d]); } }
        __syncthreads();
        { const int dir = K.wave >> 2, mi = K.wave & 3; const int chain = (b * 2 + dir) * 4 + h, ch = dir ? hg_bwd_chunk(tb) : tb;
          f32x4 acc[4];
#pragma unroll
          for (int db = 0; db < 4; ++db) acc[db] = (f32x4){0.f, 0.f, 0.f, 0.f};
#pragma unroll
          for (int ks = 0; ks < 2; ++ks) {
              const bf16x8_t vv = *(const bf16x8_t*)(VT + hg_sw(16 * mi + r16, 32 * ks + 8 * g4));
#pragma unroll
              for (int db = 0; db < 4; ++db) { const bf16x8_t kv = *(const bf16x8_t*)(KT + dir * 64 * HG_TS + hg_sw(16 * db + r16, 32 * ks + 8 * g4)); acc[db] = MFMA16(kv, vv, acc[db]); }
          }
          bf16_t* st = K.STB() + ((size_t)chain * HG_NCH + ch) * 4096 + (size_t)K.lane * 8;
#pragma unroll
          for (int ks = 0; ks < 2; ++ks) { const u32x4 w = (u32x4){pk2(acc[2 * ks][0], acc[2 * ks][1]), pk2(acc[2 * ks][2], acc[2 * ks][3]), pk2(acc[2 * ks + 1][0], acc[2 * ks + 1][1]), pk2(acc[2 * ks + 1][2], acc[2 * ks + 1][3])};
              *(u32x4*)(st + (mi * 2 + ks) * 512) = w; }
        }
    }
}
DI void ph_hgrn_B(Ctx& K) {
    const int per = ((16 * 2048 + K.nb - 1) / K.nb + 63) & ~63;
    const int gt = K.bid * per + K.tid;
    if (K.tid < per && gt < 16 * 2048) {
        const int chain = gt >> 11, dw = gt & 2047, m = dw & 3, lane = (dw >> 2) & 63, ks = (dw >> 8) & 1;
        const int d0 = 32 * ks + 16 * (m >> 1) + 4 * (lane >> 4) + 2 * (m & 1);
        unsigned* st = (unsigned*)(K.STB() + (size_t)chain * HG_NCH * 4096) + dw; const float* ac = K.AC() + (size_t)chain * HG_NCH * 64 + d0;
        float S0 = 0.f, S1 = 0.f;
#pragma unroll 1
        for (int c0 = 0; c0 < HG_NCH; c0 += 26) {
            unsigned u[26]; float a0[26], a1[26];
#pragma unroll
            for (int i = 0; i < 26; ++i) { u[i] = st[(size_t)(c0 + i) * 2048]; const u32x2 av = *(const u32x2*)(ac + (c0 + i) * 64); a0[i] = __uint_as_float(av.x); a1[i] = __uint_as_float(av.y); }
#pragma unroll
            for (int i = 0; i < 26; ++i) { st[(size_t)(c0 + i) * 2048] = pk2(S0, S1); S0 = a0[i] * S0 + __uint_as_float(u[i] << 16); S1 = a1[i] * S1 + __uint_as_float(u[i] & 0xffff0000u); }
        }
    }
}
struct HgInC { u32x2 q[2][2]; u32x4 gq; u32x4 st[8]; };
DI void ph_hgrn_C(Ctx& K) {
    float* LF = (float*)(K.lds + HGL_LF); float* OM = (float*)(K.lds + HGL_OM); bf16_t* VT = (bf16_t*)(K.lds + HGL_VT); bf16_t* KP = (bf16_t*)(K.lds + HGL_KT); float* OD = (float*)(K.lds + HGL_OD);
    bf16_t* SC = (bf16_t*)(K.lds + HGL_SC) + K.wave * 16 * HG_TS;
    const int r16 = K.lane & 15, g4 = K.lane >> 4, dir = K.wave >> 2, mi = K.wave & 3;
    if (K.bid >= HG_NIT) return;
    HgIn in; HgInC ic;
    hg_load(K, K.bid, in);
#define HGC_LOAD_Q(it_) do { int b_, h_, tb_; hg_item(it_, b_, h_, tb_); const bf16_t* qr = K.P() + (size_t)hg_block_row(b_, tb_, 16 * mi + r16) * PW + C_HQ + h_ * 64 + 4 * g4; \
        _Pragma("unroll") for (int ks = 0; ks < 2; ++ks) { ic.q[ks][0] = *(const u32x2*)(qr + 32 * ks); ic.q[ks][1] = *(const u32x2*)(qr + 32 * ks + 16); } } while (0)
#define HGC_LOAD_ST(it_) do { int b_, h_, tb_; hg_item(it_, b_, h_, tb_); const int chain_ = (b_ * 2 + dir) * 4 + h_, ch_ = dir ? hg_bwd_chunk(tb_) : tb_; \
        const bf16_t* sp = K.STB() + ((size_t)chain_ * HG_NCH + ch_) * 4096 + (size_t)K.lane * 8; _Pragma("unroll") for (int i_ = 0; i_ < 8; ++i_) ic.st[i_] = *(const u32x4*)(sp + i_ * 512); } while (0)
#define HGC_LOAD_G(it_) do { int b_, h_, tb_; hg_item(it_, b_, h_, tb_); const int tok_ = K.tid >> 3, c_ = K.tid & 7; \
        ic.gq = *(const u32x4*)(K.P() + (size_t)hg_block_row(b_, tb_, tok_) * PW + C_HG + h_ * 64 + 8 * c_); } while (0)
    HGC_LOAD_Q(K.bid); HGC_LOAD_ST(K.bid); HGC_LOAD_G(K.bid);
    hg_stage_consts(K);
#pragma unroll 1
    for (int item = K.bid; item < HG_NIT; item += K.nb) {
        int b, h, tb; hg_item(item, b, h, tb);
        const int nxt = item + K.nb < HG_NIT ? item + K.nb : item;
        __syncthreads();
        hg_prep1(K, h, in);
        hg_load(K, nxt, in);
        hg_prep2(K);
        {
          const int tok = K.tid >> 3, c = K.tid & 7;
#pragma unroll
          for (int dd = 0; dd < 2; ++dd) { const float* rf = LF + (dd * 64 + 32) * HG_LFS + 8 * c; const float* bs = LF + (dd * 64 + tok) * HG_LFS + 8 * c; const float* om = OM + (dd * 64 + tok) * HG_LFS + 8 * c;
              unsigned o[4];
#pragma unroll
              for (int j = 0; j < 4; ++j) o[j] = pk2(om[2 * j] * __expf(rf[2 * j] - bs[2 * j]), om[2 * j + 1] * __expf(rf[2 * j + 1] - bs[2 * j + 1]));
              *(u32x4*)(KP + (dd * 64 + tok) * HG_TS + 8 * c) = (u32x4){o[0], o[1], o[2], o[3]}; } }
        __syncthreads();
        f32x4 nw0, nw1;
        { const float* LFd = LF + dir * 64 * HG_LFS; const float* ref = LFd + 32 * HG_LFS;
          bf16x8_t aq1[2], aq2[2];
          { const int t = 16 * mi + r16;
#pragma unroll
            for (int ks = 0; ks < 2; ++ks) { unsigned o1[4], o2[4];
#pragma unroll
                for (int hf = 0; hf < 2; ++hf) { const int d0 = 32 * ks + 16 * hf + 4 * g4; const unsigned qw[2] = {ic.q[ks][hf].x, ic.q[ks][hf].y};
                    const f32x4 bt = *(const f32x4*)(LFd + t * HG_LFS + d0), rf = *(const f32x4*)(ref + d0);
#pragma unroll
                    for (int j = 0; j < 2; ++j) { const float qa = __uint_as_float(qw[j] << 16), qb = __uint_as_float(qw[j] & 0xffff0000u); const float sa = qa * sigmoidf_(qa), sb = qb * sigmoidf_(qb);
                        const float e1a = __expf(bt[2 * j] - rf[2 * j]), e1b = __expf(bt[2 * j + 1] - rf[2 * j + 1]), e2a = __expf(bt[2 * j]), e2b = __expf(bt[2 * j + 1]);
                        o1[2 * hf + j] = pk2(sa * e1a, sb * e1b); o2[2 * hf + j] = pk2(sa * e2a, sb * e2b); } }
                aq1[ks] = __builtin_bit_cast(bf16x8_t, (u32x4){o1[0], o1[1], o1[2], o1[3]}); aq2[ks] = __builtin_bit_cast(bf16x8_t, (u32x4){o2[0], o2[1], o2[2], o2[3]}); } }
          HGC_LOAD_Q(nxt);
          f32x4 sc[4];
#pragma unroll
          for (int nj = 0; nj < 4; ++nj) { sc[nj] = (f32x4){0.f, 0.f, 0.f, 0.f}; const bf16_t* kr = KP + (dir * 64 + 16 * nj + r16) * HG_TS + 4 * g4;
#pragma unroll
              for (int ks = 0; ks < 2; ++ks) { const u32x2 k0 = *(const u32x2*)(kr + 32 * ks), k1 = *(const u32x2*)(kr + 32 * ks + 16);
                  sc[nj] = MFMA16(aq1[ks], __builtin_bit_cast(bf16x8_t, (u32x4){k0.x, k0.y, k1.x, k1.y}), sc[nj]); } }
#pragma unroll
          for (int nj = 0; nj < 4; ++nj)
#pragma unroll
              for (int rg = 0; rg < 4; ++rg) { const int tl = 4 * g4 + rg, t = 16 * mi + tl, s_ = 16 * nj + r16; const bool keep = dir ? (s_ >= t) : (s_ <= t);
                  SC[tl * HG_TS + s_] = f2bf(keep ? sc[nj][rg] : 0.f); }
          asm volatile("s_waitcnt lgkmcnt(0)" ::: "memory");
          f32x4 oacc[4];
#pragma unroll
          for (int nj = 0; nj < 4; ++nj) oacc[nj] = (f32x4){0.f, 0.f, 0.f, 0.f};
#pragma unroll
          for (int ks = 0; ks < 2; ++ks) {
              const bf16x8_t as = *(const bf16x8_t*)(SC + r16 * HG_TS + 32 * ks + 8 * g4);
#pragma unroll
              for (int nj = 0; nj < 4; ++nj) {
                  const bf16x8_t bv = *(const bf16x8_t*)(VT + hg_sw(16 * nj + r16, 32 * ks + 8 * g4));
                  oacc[nj] = MFMA16(as, bv, oacc[nj]);
                  oacc[nj] = MFMA16(aq2[ks], __builtin_bit_cast(bf16x8_t, ic.st[nj * 2 + ks]), oacc[nj]);
              }
          }
          HGC_LOAD_ST(nxt);
          { const float* nwp = (const float*)(K.lds + HGL_LB) + 512 + h * 64 + 8 * (K.tid & 7); nw0 = *(const f32x4*)nwp; nw1 = *(const f32x4*)(nwp + 4); }
#pragma unroll
          for (int nj = 0; nj < 4; ++nj)
#pragma unroll
              for (int rg = 0; rg < 4; ++rg) OD[(dir * 64 + 16 * mi + 4 * g4 + rg) * HG_LFS + 16 * nj + r16] = oacc[nj][rg];
        }
        __syncthreads();
        { const int tok = K.tid >> 3, c = K.tid & 7; const int row = hg_block_row(b, tb, tok);
          const float* o0 = OD + tok * HG_LFS + 8 * c; const float* o1 = OD + (64 + tok) * HG_LFS + 8 * c;
          float o[8], ss = 0.f;
#pragma unroll
          for (int j = 0; j < 8; ++j) { o[j] = o0[j] + o1[j]; ss += o[j] * o[j]; }
          ss += __shfl_xor(ss, 1); ss += __shfl_xor(ss, 2); ss += __shfl_xor(ss, 4);
          const float rs = rsqrtf(ss * (1.0f / 64.0f) + EPS);
          float gq[8]; unpack8(ic.gq, gq);
          const float nw[8] = {nw0[0], nw0[1], nw0[2], nw0[3], nw1[0], nw1[1], nw1[2], nw1[3]};
          float y[8];
#pragma unroll
          for (int j = 0; j < 8; ++j) y[j] = o[j] * rs * nw[j] * gq[j] * sigmoidf_(gq[j]);
          HGC_LOAD_G(nxt);
          u32x4 w; w.x = pk2(y[0], y[1]); w.y = pk2(y[2], y[3]); w.z = pk2(y[4], y[5]); w.w = pk2(y[6], y[7]);
          *(u32x4*)(K.MIX() + (size_t)row * D + MX_H + h * 64 + 8 * c) = w; }
    }
#undef HGC_LOAD_Q
#undef HGC_LOAD_ST
#undef HGC_LOAD_G
}

constexpr int AT_TS = 72;
constexpr int ATL_K = 0, ATL_V = ATL_K + 64 * AT_TS * 2, ATL_P = ATL_V + 64 * AT_TS * 2, ATL_END = ATL_P + 8 * 48 * AT_TS * 2;
static_assert(ATL_END <= LDS_BYTES - 256, "attention LDS map");
DI float dpp_max16(float x) { x = fmaxf(x, dpp_<0xB1>(x)); x = fmaxf(x, dpp_<0x4E>(x)); x = fmaxf(x, dpp_<0x141>(x)); x = fmaxf(x, dpp_<0x128>(x)); return x; }
DI float dpp_sum16(float x) { x += dpp_<0xB1>(x); x += dpp_<0x4E>(x); x += dpp_<0x141>(x); x += dpp_<0x128>(x); return x; }
DI unsigned cvtpk(float lo, float hi) { unsigned r; asm("v_cvt_pk_bf16_f32 %0, %1, %2" : "=v"(r) : "v"(lo), "v"(hi)); return r; }
DI float xg4_max(float x) { x = fmaxf(x, __shfl_xor(x, 16)); x = fmaxf(x, __shfl_xor(x, 32)); return x; }
template <int MT, int NJ, bool SAMEKB> DI void at_pv(const unsigned (&pb)[MT][NJ / 2][4], f32x4 (&oacc)[MT][4], const bf16_t* VT, const int (&kb)[MT], int r16, int g4) {
#pragma unroll
    for (int ks = 0; ks < NJ / 2; ++ks)
#pragma unroll
        for (int ne = 0; ne < 4; ++ne) { const int e = 16 * ne + r16, sw = (e >> 3) & 7;
            u32x4 vf_shared;
            if (SAMEKB) { const int blk = (kb[0] >> 3) + 4 * ks + (g4 >> 1); const u32x2 v0 = *(const u32x2*)(VT + e * AT_TS + ((blk ^ sw) << 3) + 4 * (g4 & 1)), v1 = *(const u32x2*)(VT + e * AT_TS + (((blk + 2) ^ sw) << 3) + 4 * (g4 & 1));
                vf_shared = (u32x4){v0.x, v0.y, v1.x, v1.y}; }
#pragma unroll
            for (int mt = 0; mt < MT; ++mt) { u32x4 vf = vf_shared;
                if (!SAMEKB) { const int blk = (kb[mt] >> 3) + 4 * ks + (g4 >> 1); const u32x2 v0 = *(const u32x2*)(VT + e * AT_TS + ((blk ^ sw) << 3) + 4 * (g4 & 1)), v1 = *(const u32x2*)(VT + e * AT_TS + (((blk + 2) ^ sw) << 3) + 4 * (g4 & 1));
                    vf = (u32x4){v0.x, v0.y, v1.x, v1.y}; }
                oacc[mt][ne] = MFMA16(__builtin_bit_cast(bf16x8_t, vf), __builtin_bit_cast(bf16x8_t, (u32x4){pb[mt][ks][0], pb[mt][ks][1], pb[mt][ks][2], pb[mt][ks][3]}), oacc[mt][ne]); } }
}
template <int MT, int NJ, bool SAMEKB> DI void at_softmax_pv(f32x4 (&sT)[MT][NJ], float (&mrun)[MT], float (&lrun)[MT], f32x4 (&oacc)[MT][4], const bf16_t* VT, const int (&kb)[MT], int r16, int g4) {
    unsigned pb[MT][NJ / 2][4];
#pragma unroll
    for (int mt = 0; mt < MT; ++mt) {
        float mx = -INFINITY;
#pragma unroll
        for (int nj = 0; nj < NJ; ++nj) mx = fmaxf(mx, fmaxf(fmaxf(sT[mt][nj][0], sT[mt][nj][1]), fmaxf(sT[mt][nj][2], sT[mt][nj][3])));
        mx = xg4_max(mx) * 1.44269504f;
        const float mn = fmaxf(mrun[mt], mx), alpha = __builtin_amdgcn_exp2f(mrun[mt] - mn); mrun[mt] = mn;
        float rs_ = 0.f;
#pragma unroll
        for (int nj = 0; nj < NJ; ++nj)
#pragma unroll
            for (int rg = 0; rg < 4; ++rg) { const float pe = __builtin_amdgcn_exp2f(__builtin_fmaf(sT[mt][nj][rg], 1.44269504f, -mn)); sT[mt][nj][rg] = pe; rs_ += pe; }
        lrun[mt] = lrun[mt] * alpha + rs_;
#pragma unroll
        for (int ne = 0; ne < 4; ++ne) oacc[mt][ne] *= alpha;
#pragma unroll
        for (int ks = 0; ks < NJ / 2; ++ks) { pb[mt][ks][0] = cvtpk(sT[mt][2 * ks][0], sT[mt][2 * ks][1]); pb[mt][ks][1] = cvtpk(sT[mt][2 * ks][2], sT[mt][2 * ks][3]);
            pb[mt][ks][2] = cvtpk(sT[mt][2 * ks + 1][0], sT[mt][2 * ks + 1][1]); pb[mt][ks][3] = cvtpk(sT[mt][2 * ks + 1][2], sT[mt][2 * ks + 1][3]); }
    }
    at_pv<MT, NJ, SAMEKB>(pb, oacc, VT, kb, r16, g4);
}
template <int MT> DI void at_softmax_pv_nat(const f32x4 (&sT)[MT][2], float (&mrun)[MT], float (&lrun)[MT], f32x4 (&oacc)[MT][4], const bf16_t* VT, const int (&kb)[MT], const int (&qbase)[MT], const float* rp, int r16, int g4) {
    unsigned pb[MT][1][4];
#pragma unroll
    for (int mt = 0; mt < MT; ++mt) {
        const int c = qbase[mt] + r16, ws = min(max(c - 8, 0), 48), k00 = kb[mt] + 4 * g4;
        float v[4]; bool in0[4]; float mx = -INFINITY;
#pragma unroll
        for (int rg = 0; rg < 4; ++rg) { const int k0 = k00 + rg; in0[rg] = (unsigned)(k0 - ws) < 16u;
            v[rg] = (in0[rg] ? sT[mt][0][rg] : sT[mt][1][rg]) + rp[k0 - c + (in0[rg] ? 0 : 16)]; mx = fmaxf(mx, v[rg]); }
        mx = xg4_max(mx) * 1.44269504f;
        const float mn = fmaxf(mrun[mt], mx), alpha = __builtin_amdgcn_exp2f(mrun[mt] - mn); mrun[mt] = mn;
        float rs_ = 0.f, p0[4], p1[4];
#pragma unroll
        for (int rg = 0; rg < 4; ++rg) { const float pe = __builtin_amdgcn_exp2f(__builtin_fmaf(v[rg], 1.44269504f, -mn)); rs_ += pe; p0[rg] = in0[rg] ? pe : 0.f; p1[rg] = in0[rg] ? 0.f : pe; }
        lrun[mt] = lrun[mt] * alpha + rs_;
#pragma unroll
        for (int ne = 0; ne < 4; ++ne) oacc[mt][ne] *= alpha;
        pb[mt][0][0] = cvtpk(p0[0], p0[1]); pb[mt][0][1] = cvtpk(p0[2], p0[3]); pb[mt][0][2] = cvtpk(p1[0], p1[1]); pb[mt][0][3] = cvtpk(p1[2], p1[3]);
    }
    at_pv<MT, 2, false>(pb, oacc, VT, kb, r16, g4);
}
template <int KIND> DI void attn_item(Ctx& K, int idx, const float* sinkp, const float* rpbp) {
    constexpr int MT = KIND == 0 ? 3 : 2;
    int tid_ = K.tid; asm volatile("" : "+v"(tid_));
    const int lane_ = tid_ & 63, wave_ = tid_ >> 6;
    bf16_t* KT = (bf16_t*)(K.lds + ATL_K); bf16_t* VT = (bf16_t*)(K.lds + ATL_V); float* RPB = (float*)(K.lds + ATL_P);
    const int r16 = lane_ & 15, g4 = lane_ >> 4;
    int b, hk, qb = 0;
    if (KIND == 0) { qb = idx & 127; hk = (idx >> 7) & 1; b = idx >> 8; }
    else if (KIND == 1) { qb = idx & 63; hk = (idx >> 6) % 6; b = (idx >> 6) / 6; }
    else { hk = idx % 6; b = idx / 6; }
    const int kcol = (KIND == 0) ? C_SK + hk * 64 : (KIND == 2) ? C_SK + (hk / 3) * 64 : C_NK + hk * 64;
    const int vcol = (KIND == 0) ? C_SV + hk * 64 : (KIND == 2) ? C_SV + (hk / 3) * 64 : C_NV + hk * 64;
    int t0 = 0, nloc = 0;
    if (KIND == 0) { const int k0 = max(2 * qb - 2, 0), k1 = min(2 * qb + 3, L / 64 - 1); t0 = k0; nloc = k1 - k0 + 1; }
    if (KIND == 1) { const int k0 = min(max(4 * qb - 4, 0), L / 64 - 8), k1 = min(max(4 * qb + 3 - 4, 0), L / 64 - 8) + 7; t0 = k0; nloc = k1 - k0 + 1; }
    const int ntiles = nloc + CL / 64;
    int w_r = 0, w_rs = 0;
    if (KIND == 1) { w_r = 4 * qb + (wave_ >> 1); w_rs = min(max(w_r - 4, 0), L / 64 - 8); }
    bf16x8_t qf[MT][2]; int qbase[MT], hq_mt[MT], qrow[MT];
#pragma unroll
    for (int mt = 0; mt < MT; ++mt) {
        int arow, hq;
        if (KIND == 0) { const int rho = wave_ * 48 + mt * 16; hq = hk * 3 + rho / 128; hq_mt[mt] = hq; const int tb = 128 * qb + (rho & 127); arow = lat_row(b, tb + r16); qbase[mt] = tb; }
        else if (KIND == 1) { hq = hk; hq_mt[mt] = hq; const int cb = 32 * (wave_ & 1) + 16 * mt; arow = lat_row(b, w_r * 64 + cb + r16); qbase[mt] = cb; }
        else { hq = hk; hq_mt[mt] = hq; const int tb = wave_ * 32 + mt * 16; arow = ctx_row(b, tb + r16); qbase[mt] = 0; }
        qrow[mt] = arow;
        const int qcol = (KIND == 0 || KIND == 2) ? C_SQ + hq * 64 : C_NQ + hq * 64;
#pragma unroll
        for (int ks = 0; ks < 2; ++ks) { float q[8]; unpack8(*(const u32x4*)(K.P() + (size_t)arow * PW + qcol + 32 * ks + 8 * g4), q);
            const u32x4 w = (u32x4){pk2(q[0] * 0.125f, q[1] * 0.125f), pk2(q[2] * 0.125f, q[3] * 0.125f), pk2(q[4] * 0.125f, q[5] * 0.125f), pk2(q[6] * 0.125f, q[7] * 0.125f)};
            qf[mt][ks] = __builtin_bit_cast(bf16x8_t, w); }
    }
    f32x4 oacc[MT][4]; float mrun[MT], lrun[MT];
#pragma unroll
    for (int mt = 0; mt < MT; ++mt) {
#pragma unroll
        for (int ne = 0; ne < 4; ++ne) oacc[mt][ne] = (f32x4){0.f, 0.f, 0.f, 0.f};
        const bool has_sink = (KIND == 0 || KIND == 2);
        mrun[mt] = has_sink ? sinkp[hq_mt[mt]] * 1.44269504f : -1.0e30f; lrun[mt] = (has_sink && g4 == 0) ? 1.0f : 0.0f;
    }
    const int lkey = tid_ >> 3, lch = tid_ & 7;
    u32x4 pk_, pv_;
    { const int ti = 0; const int grow = (ti < nloc) ? lat_row(b, (t0 + ti) * 64 + lkey) : ctx_row(b, (ti - nloc) * 64 + lkey);
      const bf16_t* pr = K.P() + (size_t)grow * PW + 8 * lch; pk_ = *(const u32x4*)(pr + kcol); pv_ = *(const u32x4*)(pr + vcol); }
#pragma unroll 1
    for (int ti = 0; ti < ntiles; ++ti) {
        __syncthreads();
        *(u32x4*)(KT + lkey * AT_TS + 8 * lch) = pk_;
        { const unsigned w[4] = {pv_.x, pv_.y, pv_.z, pv_.w};
          const int vsw = (((lkey >> 3) ^ lch) << 3) + (lkey & 7);
#pragma unroll
          for (int j = 0; j < 4; ++j) { VT[(8 * lch + 2 * j) * AT_TS + vsw] = (bf16_t)(w[j] & 0xffffu); VT[(8 * lch + 2 * j + 1) * AT_TS + vsw] = (bf16_t)(w[j] >> 16); } }
        if (KIND == 1 && ti == 0 && tid_ < 15 * 31) RPB[tid_] = rpbp[tid_];
        __syncthreads();
        if (ti + 1 < ntiles) { const int tn = ti + 1; const int grow = (tn < nloc) ? lat_row(b, (t0 + tn) * 64 + lkey) : ctx_row(b, (tn - nloc) * 64 + lkey);
            const bf16_t* pr = K.P() + (size_t)grow * PW + 8 * lch; pk_ = *(const u32x4*)(pr + kcol); pv_ = *(const u32x4*)(pr + vcol); }
        const bool local = ti < nloc; const int kunit = t0 + ti;
        if (KIND == 1 && local) {
            if ((kunit >= w_rs) && (kunit < w_rs + 8)) {
                f32x4 sT[MT][2]; int kb[MT];
#pragma unroll
                for (int mt = 0; mt < MT; ++mt) { kb[mt] = min(max(qbase[mt] - 8, 0), 32);
#pragma unroll
                    for (int nj = 0; nj < 2; ++nj) { sT[mt][nj] = (f32x4){0.f, 0.f, 0.f, 0.f};
#pragma unroll
                        for (int ks = 0; ks < 2; ++ks) { const bf16x8_t kf = *(const bf16x8_t*)(KT + (kb[mt] + 16 * nj + r16) * AT_TS + 32 * ks + 8 * g4); sT[mt][nj] = MFMA16(kf, qf[mt][ks], sT[mt][nj]); } } }
                const float* rp = RPB + (kunit - w_r + 7) * 31 + 15;
                at_softmax_pv_nat<MT>(sT, mrun, lrun, oacc, VT, kb, qbase, rp, r16, g4);
            }
        } else {
            f32x4 sT[MT][4];
#pragma unroll
            for (int mt = 0; mt < MT; ++mt)
#pragma unroll
                for (int nj = 0; nj < 4; ++nj) sT[mt][nj] = (f32x4){0.f, 0.f, 0.f, 0.f};
#pragma unroll
            for (int nj = 0; nj < 4; ++nj)
#pragma unroll
                for (int ks = 0; ks < 2; ++ks) { const bf16x8_t kf = *(const bf16x8_t*)(KT + (16 * nj + r16) * AT_TS + 32 * ks + 8 * g4);
#pragma unroll
                    for (int mt = 0; mt < MT; ++mt) sT[mt][nj] = MFMA16(kf, qf[mt][ks], sT[mt][nj]); }
            if (KIND == 0 && local) {
#pragma unroll
                for (int mt = 0; mt < MT; ++mt) { const int dq = qbase[mt] + r16 - kunit * 64 - 4 * g4;
#pragma unroll
                    for (int nj = 0; nj < 4; ++nj)
#pragma unroll
                        for (int rg = 0; rg < 4; ++rg) { const int dl = dq - (16 * nj + rg); if (dl > 128 || dl < -128) sT[mt][nj][rg] = -INFINITY; } }
            }
            int kb0[MT];
#pragma unroll
            for (int mt = 0; mt < MT; ++mt) kb0[mt] = 0;
            at_softmax_pv<MT, 4, true>(sT, mrun, lrun, oacc, VT, kb0, r16, g4);
        }
    }
#pragma unroll
    for (int mt = 0; mt < MT; ++mt) {
        float l = lrun[mt]; l += __shfl_xor(l, 16); l += __shfl_xor(l, 32);
        const float inv = 1.0f / l;
        const int ocol = ((KIND == 0 || KIND == 2) ? MX_S : MX_N) + hq_mt[mt] * 64;
#pragma unroll
        for (int ne = 0; ne < 4; ++ne) { u32x2 o; o.x = cvtpk(oacc[mt][ne][0] * inv, oacc[mt][ne][1] * inv); o.y = cvtpk(oacc[mt][ne][2] * inv, oacc[mt][ne][3] * inv);
            *(u32x2*)(K.MIX() + (size_t)qrow[mt] * D + ocol + 16 * ne + 4 * g4) = o; }
    }
}
DI void ph_attn(Ctx& K) {
    constexpr int N_SWA = NB * 2 * (L / 128), N_NAT = NB * 6 * (L / 256), N_C = NB * 6;
    const float* sinkp = ARG(swa_sink) + K.l * 6;
    for (int item = K.bid; item < N_SWA + N_NAT + 2 * N_C; item += K.nb) {
        if (item < N_SWA) attn_item<0>(K, item, sinkp, nullptr);
        else if (item < N_SWA + N_NAT) { const int it = item - N_SWA; const int h = (it >> 6) % 6; attn_item<1>(K, it, nullptr, ARG(nat_rpb) + ((size_t)K.l * 6 + h) * 15 * 31); }
        else if (item < N_SWA + N_NAT + N_C) attn_item<2>(K, item - N_SWA - N_NAT, sinkp, nullptr);
        else attn_item<3>(K, item - N_SWA - N_NAT - N_C, nullptr, nullptr);
    }
}

DI unsigned fkey(float f) { const unsigned u = __float_as_uint(f); return (u & 0x80000000u) ? ~u : (u | 0x80000000u); }
DI int mbcnt64(unsigned long long m) { return (int)__builtin_amdgcn_mbcnt_hi((unsigned)(m >> 32), __builtin_amdgcn_mbcnt_lo((unsigned)m, 0u)); }
template <int CTRL> DI int dppi_(int x) { return __builtin_amdgcn_mov_dpp(x, CTRL, 0xf, 0xf, true); }
DI int row_sum_i(int x) { x += dppi_<0xB1>(x); x += dppi_<0x4E>(x); x += dppi_<0x141>(x); x += dppi_<0x128>(x); return x; }
DI int row_excl_scan_i(int x) { int s_ = x; s_ += dppi_<0x111>(s_); s_ += dppi_<0x112>(s_); s_ += dppi_<0x114>(s_); s_ += dppi_<0x118>(s_); return s_ - x; }
DI unsigned row_minmax_u(unsigned x, bool want_max) {
    unsigned y;
    y = (unsigned)dppi_<0xB1>((int)x); x = want_max ? max(x, y) : min(x, y); y = (unsigned)dppi_<0x4E>((int)x); x = want_max ? max(x, y) : min(x, y);
    y = (unsigned)dppi_<0x141>((int)x); x = want_max ? max(x, y) : min(x, y); y = (unsigned)dppi_<0x128>((int)x); x = want_max ? max(x, y) : min(x, y);
    return x;
}
DI void ce_desc(unsigned& x, unsigned& y) { const unsigned hi = max(x, y), lo = min(x, y); x = hi; y = lo; }
DI void sort8_desc(unsigned (&a)[8]) {
    ce_desc(a[0], a[1]); ce_desc(a[2], a[3]); ce_desc(a[4], a[5]); ce_desc(a[6], a[7]); ce_desc(a[0], a[2]); ce_desc(a[1], a[3]); ce_desc(a[4], a[6]); ce_desc(a[5], a[7]);
    ce_desc(a[1], a[2]); ce_desc(a[5], a[6]); ce_desc(a[0], a[4]); ce_desc(a[3], a[7]); ce_desc(a[1], a[5]); ce_desc(a[2], a[6]); ce_desc(a[1], a[4]); ce_desc(a[3], a[6]);
    ce_desc(a[2], a[4]); ce_desc(a[3], a[5]); ce_desc(a[3], a[4]); }
DI void sort4_desc(unsigned (&a)[4]) { ce_desc(a[0], a[1]); ce_desc(a[2], a[3]); ce_desc(a[0], a[2]); ce_desc(a[1], a[3]); ce_desc(a[1], a[2]); }
DI float fkey_inv(unsigned k) { return __uint_as_float((k & 0x80000000u) ? (k & 0x7fffffffu) : ~k); }
constexpr int PSL_SK = 0, PSL_TOP = 131072;
static_assert(PSL_TOP + 8 * 1024 <= LDS_BYTES - 256, "peer select LDS map");
template <int PROBE> DI void ph_peer_select(Ctx& K) {
    float* TOPV = (float*)(K.lds + PSL_TOP + K.wave * 1024); int* TOPI = (int*)(TOPV + 128);
    const int r16 = K.lane & 15, g4 = K.lane >> 4, j16 = r16;
    const int nhg = K.nb < 8 ? K.nb : 8, grp = K.bid % nhg, jw = K.bid / nhg, nj = (K.nb - grp + nhg - 1) / nhg;
    constexpr int N_T = M / 16;
    const int nwv = nj * 8, wg = jw * 8 + K.wave;
    const int n_full = (N_T / nwv) * nwv, n_work = n_full + 4 * (N_T - n_full);
    for (int h = grp; h < 8; h += nhg) {
        __syncthreads();
        { const u32x4* sh = (const u32x4*)(K.SKH() + ((size_t)K.l * 8 + h) * 2 * 16384); const u32x4* sl = (const u32x4*)(K.SKL() + ((size_t)K.l * 8 + h) * 2 * 16384);
          u32x4* dst = (u32x4*)(K.lds + PSL_SK);
          u32x4 t[8];
#pragma unroll
          for (int i = 0; i < 8; ++i) t[i] = sh[K.tid + 512 * i];
#pragma unroll
          for (int i = 0; i < 8; ++i) dst[K.tid + 512 * i] = t[i];
#pragma unroll
          for (int i = 0; i < 8; ++i) t[i] = sl[K.tid + 512 * i];
#pragma unroll
          for (int i = 0; i < 8; ++i) dst[4096 + K.tid + 512 * i] = t[i]; }
        __syncthreads();
#pragma unroll 1
        for (int wk = wg; wk < n_work; wk += nwv) {
            const bool part = wk >= n_full; const int tile = part ? n_full + ((wk - n_full) >> 2) : wk; const int rg_lo = part ? ((wk - n_full) & 3) : 0, rg_hi = part ? rg_lo + 1 : 4;
            const int t0 = tile * 16;
            float S[2][8][4];
#pragma unroll
            for (int p = 0; p < 2; ++p) {
                bf16x8_t aq[4];
                { const bf16_t* qp = K.QP() + (size_t)(t0 + r16) * 2048 + h * 256 + p * 128 + 8 * g4;
#pragma unroll
                  for (int ks = 0; ks < 4; ++ks) aq[ks] = *(const bf16x8_t*)(qp + 32 * ks); }
                const unsigned char* kb = K.lds + PSL_SK + p * 32768 + K.lane * 16;
#pragma unroll
                for (int nt = 0; nt < 8; ++nt) {
                    f32x4 c0 = {0.f, 0.f, 0.f, 0.f}, c1 = c0;
#pragma unroll
                    for (int ks = 0; ks < 4; ++ks) { const bf16x8_t bh = *(const bf16x8_t*)(kb + (nt * 4 + ks) * 1024), bl = *(const bf16x8_t*)(kb + 65536 + (nt * 4 + ks) * 1024);
                        c0 = MFMA16(aq[ks], bh, c0); c1 = MFMA16(aq[ks], bl, c1); }
#pragma unroll
                    for (int rg = 0; rg < 4; ++rg) S[p][nt][rg] = c0[rg] + c1[rg];
                }
            }
            if (PROBE == 1) { float a = 0.f;
#pragma unroll
                for (int p = 0; p < 2; ++p)
#pragma unroll
                    for (int nt = 0; nt < 8; ++nt) a += S[p][nt][0] + S[p][nt][1] + S[p][nt][2] + S[p][nt][3];
                TOPV[K.lane] = a; continue; }
#pragma unroll 1
            for (int rg = 0; rg < 4; ++rg) {
                if (rg >= rg_lo && rg < rg_hi) {
                    unsigned a[2][8], mine[2] = {0u, 0u};
#pragma unroll
                    for (int p = 0; p < 2; ++p) {
#pragma unroll
                        for (int i = 0; i < 8; ++i) a[p][i] = (fkey(S[p][i][0]) & 0xFFFFFF80u) | (unsigned)(j16 + 16 * i);
                        sort8_desc(a[p]); }
#pragma unroll 1
                    for (int it = 0; it < 16; ++it) {
#pragma unroll
                        for (int p = 0; p < 2; ++p) { const unsigned m = row_minmax_u(a[p][0], true); const bool win = a[p][0] == m;
#pragma unroll
                            for (int i = 0; i < 7; ++i) a[p][i] = win ? a[p][i + 1] : a[p][i];
                            a[p][7] = win ? 0u : a[p][7];
                            mine[p] = (j16 == it) ? m : mine[p]; }
                    }
                    unsigned* TA = (unsigned*)TOPV + (g4 * 2) * 16; unsigned* TB = TA + 16;
                    TA[j16] = mine[0]; TB[j16] = mine[1];
                    asm volatile("s_waitcnt lgkmcnt(0)" ::: "memory");
                    { const int r = t0 + 4 * g4 + rg, t = j16;
                      int ci[4], cj[4];
                      ci[0] = 0; cj[0] = t;
                      ci[1] = t < 8 ? 1 : t; cj[1] = t < 8 ? t : 0;
                      ci[2] = t <= 4 ? 2 : t <= 8 ? 3 : t <= 11 ? 4 : t <= 13 ? 5 : 6; cj[2] = t <= 4 ? t : t <= 8 ? t - 5 : t <= 11 ? t - 9 : t <= 13 ? t - 12 : t - 14;
                      ci[3] = 7; cj[3] = t & 1;
                      unsigned c[4];
#pragma unroll
                      for (int q = 0; q < 4; ++q) { const float cv = fkey_inv(TA[ci[q]] & 0xFFFFFF80u) + fkey_inv(TB[cj[q]] & 0xFFFFFF80u); c[q] = (fkey(cv) & 0xFFFFFFC0u) | (unsigned)(t * 4 + q); }
                      if (t > 1) c[3] = 0u;
                      sort4_desc(c);
                      unsigned w = 0u;
#pragma unroll 1
                      for (int it = 0; it < 16; ++it) { const unsigned m = row_minmax_u(c[0], true); const bool win = c[0] == m;
                          c[0] = win ? c[1] : c[0]; c[1] = win ? c[2] : c[1]; c[2] = win ? c[3] : c[2]; c[3] = win ? 0u : c[3];
                          w = (j16 == it) ? m : w; }
                      const float val = fkey_inv(w & 0xFFFFFFC0u); const int tw = (int)(w >> 2) & 15, qw = (int)w & 3;
                      const int i2 = tw <= 4 ? 2 : tw <= 8 ? 3 : tw <= 11 ? 4 : tw <= 13 ? 5 : 6, j2 = tw <= 4 ? tw : tw <= 8 ? tw - 5 : tw <= 11 ? tw - 9 : tw <= 13 ? tw - 12 : tw - 14;
                      const int wi = qw == 0 ? 0 : qw == 1 ? (tw < 8 ? 1 : tw) : qw == 2 ? i2 : 7, wj = qw == 0 ? tw : qw == 1 ? (tw < 8 ? tw : 0) : qw == 2 ? j2 : (tw & 1);
                      const int e = (int)(TA[wi] & 127u) * 128 + (int)(TB[wj] & 127u);
                      const float mx = dpp_max16(val);
                      const float ex = __expf(val - mx), es = dpp_sum16(ex);
                      { const int pos = h * 16 + j16; K.PIDX16()[((size_t)r * 64 + (pos & 63)) * 2 + (pos >> 6)] = (unsigned short)e; K.PG()[(size_t)r * 128 + pos] = ex / es; }
                    }
                    asm volatile("s_waitcnt lgkmcnt(0)" ::: "memory");
                }
#pragma unroll
                for (int p = 0; p < 2; ++p)
#pragma unroll
                    for (int i = 0; i < 8; ++i) { S[p][i][0] = S[p][i][1]; S[p][i][1] = S[p][i][2]; S[p][i][2] = S[p][i][3]; }
            }
        }
    }
}

constexpr int PU_NR = 4;
constexpr int PUL_H = 0, PUL_SLOT = 2 * PU_NR * 1024, PUL_STRIDE = PUL_SLOT + (PU_NR * 128 + 32) * 8;
static_assert(8 * PUL_STRIDE <= LDS_BYTES - 256, "u pass LDS map");
struct PuMeta { float hs[PU_NR]; unsigned iab[PU_NR]; };
DI void pu_load(const Ctx& K, int r0, int step, PuMeta& m, unsigned char* hbuf) {
    int rr[PU_NR];
#pragma unroll
    for (int q = 0; q < PU_NR; ++q) rr[q] = min(r0 + q * step, M - 1);
    __builtin_amdgcn_global_load_lds((const unsigned*)(K.H8() + (size_t)rr[0] * D + K.lane * 16), (LAS unsigned*)hbuf, 16, 0, 0);
    __builtin_amdgcn_global_load_lds((const unsigned*)(K.H8() + (size_t)rr[1] * D + K.lane * 16 - 1024), (LAS unsigned*)hbuf, 16, 1024, 0);
    __builtin_amdgcn_global_load_lds((const unsigned*)(K.H8() + (size_t)rr[2] * D + K.lane * 16 - 2048), (LAS unsigned*)hbuf, 16, 2048, 0);
    __builtin_amdgcn_global_load_lds((const unsigned*)(K.H8() + (size_t)rr[3] * D + K.lane * 16 - 3072), (LAS unsigned*)hbuf, 16, 3072, 0);
#pragma unroll
    for (int q = 0; q < PU_NR; ++q) { m.hs[q] = K.HS()[rr[q]]; m.iab[q] = K.PIDX32()[(size_t)rr[q] * 64 + K.lane]; }
}
typedef int i32x4 __attribute__((ext_vector_type(4)));
DI int sel4i(const i32x4 v, int k) { return k == 0 ? v[0] : k == 1 ? v[1] : k == 2 ? v[2] : v[3]; }
template <int PROBE> DI void pu_item(const Ctx& K, const unsigned char* U, unsigned char* HL, int* SLOT, int R, int r0, int step, const PuMeta& m, int r16, int g4, float& dummy) {
    bool sa[PU_NR], sb[PU_NR]; int ra[PU_NR], rb[PU_NR]; int n = 0;
    int eia[PU_NR], eib[PU_NR];
#pragma unroll
    for (int q = 0; q < PU_NR; ++q) { eia[q] = (int)(m.iab[q] & 0xffffu); eib[q] = (int)(m.iab[q] >> 16); }
#pragma unroll
    for (int q = 0; q < PU_NR; ++q) { const bool live = r0 + q * step < M; sa[q] = live && (eia[q] >> 11) == R; sb[q] = live && (eib[q] >> 11) == R; const unsigned long long ma = __ballot(sa[q]), mb = __ballot(sb[q]);
        ra[q] = n + mbcnt64(ma); n += __popcll(ma); rb[q] = n + mbcnt64(mb); n += __popcll(mb); }
    const int E = r16 >> 2, qq = r16 & 3, rho = r16 >> 2;
    const float hsm = rho == 0 ? m.hs[0] : rho == 1 ? m.hs[1] : rho == 2 ? m.hs[2] : m.hs[3];
#pragma unroll
    for (int q = 0; q < PU_NR; ++q) {
        if (sa[q]) { SLOT[2 * ra[q]] = eia[q]; SLOT[2 * ra[q] + 1] = q * 128 + K.lane; }
        if (sb[q]) { SLOT[2 * rb[q]] = eib[q]; SLOT[2 * rb[q] + 1] = q * 128 + 64 + K.lane; } }
    asm volatile("s_waitcnt lgkmcnt(0)" ::: "memory");
#pragma unroll 1
    for (int base = 0; base < n; base += 32) {
        const int* SLB = SLOT + 2 * base;
        const bool two = base + 16 < n;
        i32x4 av[8][4];
#pragma unroll
        for (int t = 0; t < 4; ++t) { const int sl = 4 * t + E; const int e = (base + sl < n) ? SLB[2 * sl] : SLOT[0]; const unsigned char* up = U + ((unsigned)e * (unsigned)D + (unsigned)(64 * g4 + 16 * qq));
#pragma unroll
            for (int s_ = 0; s_ < 4; ++s_) av[t][s_] = *(const i32x4*)(up + 256 * s_); }
        if (two) {
#pragma unroll
            for (int t = 4; t < 8; ++t) { const int sl = 4 * t + E; const int e = (base + sl < n) ? SLB[2 * sl] : SLOT[0]; const unsigned char* up = U + ((unsigned)e * (unsigned)D + (unsigned)(64 * g4 + 16 * qq));
#pragma unroll
                for (int s_ = 0; s_ < 4; ++s_) av[t][s_] = *(const i32x4*)(up + 256 * s_); } }
        bool fin[2]; int fcode[2]; float fus[2], fvs[2], fpg[2];
#pragma unroll
        for (int p2 = 0; p2 < 2; ++p2) { const int sl = 4 * (4 * p2 + qq) + g4; fin[p2] = false; fcode[p2] = 0; fus[p2] = 0.f; fvs[p2] = 0.f; fpg[p2] = 0.f;
            if (base + sl < n) { const int code = SLB[2 * sl + 1];
                if ((code >> 7) == rho) { const size_t eo = (size_t)K.l * 16384 + SLB[2 * sl]; fin[p2] = true; fcode[p2] = code; fus[p2] = K.US()[eo]; fvs[p2] = K.VS()[eo]; fpg[p2] = K.PG()[(size_t)(r0 + (code >> 7) * step) * 128 + (code & 127)]; } } }
        i32x4 hb[4];
#pragma unroll
        for (int s_ = 0; s_ < 4; ++s_) hb[s_] = *(const i32x4*)(HL + rho * 1024 + 64 * g4 + 16 * qq + 256 * s_);
        int w0, w1 = 0;
        { int rs[4];
#pragma unroll
          for (int t = 0; t < 4; ++t) { i32x4 acc = {0, 0, 0, 0};
#pragma unroll
              for (int s_ = 0; s_ < 4; ++s_) acc = __builtin_amdgcn_mfma_i32_16x16x64_i8(av[t][s_], hb[s_], acc, 0, 0, 0);
              int v = sel4i(acc, qq); v += dppi_<0xB1>(v); v += dppi_<0x4E>(v); rs[t] = v; }
          w0 = qq == 0 ? rs[0] : qq == 1 ? rs[1] : qq == 2 ? rs[2] : rs[3]; }
        if (two) { int rs[4];
#pragma unroll
            for (int t = 0; t < 4; ++t) { i32x4 acc = {0, 0, 0, 0};
#pragma unroll
                for (int s_ = 0; s_ < 4; ++s_) acc = __builtin_amdgcn_mfma_i32_16x16x64_i8(av[4 + t][s_], hb[s_], acc, 0, 0, 0);
                int v = sel4i(acc, qq); v += dppi_<0xB1>(v); v += dppi_<0x4E>(v); rs[t] = v; }
            w1 = qq == 0 ? rs[0] : qq == 1 ? rs[1] : qq == 2 ? rs[2] : rs[3]; }
#pragma unroll
        for (int p2 = 0; p2 < 2; ++p2) {
            const int di = p2 ? w1 : w0;
            if (fin[p2]) { const int code = fcode[p2];
                const float d = (float)di * fus[p2] * hsm;
                const int pos = code & 127;
                K.W16()[((size_t)(r0 + (code >> 7) * step) * 64 + (pos & 63)) * 2 + (pos >> 6)] = f2bf(fpg[p2] * gelu_erf(d) * fvs[p2]); (void)dummy; }
        }
        asm volatile("s_waitcnt lgkmcnt(0)" ::: "memory");
    }
}
#define PU_TOUCH(m_) asm volatile("" :: "v"(m_.hs[0]), "v"(m_.hs[1]), "v"(m_.hs[2]), "v"(m_.hs[3]), "v"(m_.iab[0]), "v"(m_.iab[1]), "v"(m_.iab[2]), "v"(m_.iab[3]))
template <int PROBE> DI void ph_peer_u(Ctx& K) {
    const unsigned char* U = (const unsigned char*)K.UB() + (size_t)K.l * 16384 * D;
    unsigned char* HB = K.lds + K.wave * PUL_STRIDE; int* SLOT = (int*)(HB + PUL_SLOT);
    const int r16 = K.lane & 15, g4 = K.lane >> 4;
    const int step = K.nloc * NWAVES;
    float dummy = 0.f;
    for (int R = K.xg; R < 8; R += K.nxg) {
        int r = K.jx * NWAVES + K.wave; int par = 0;
        PuMeta mA, mB; (void)par;
        pu_load(K, r, step, mA, HB);
#pragma unroll 1
        for (; r < M; r += 2 * PU_NR * step) {
            asm volatile("s_waitcnt vmcnt(0)" ::: "memory");
            PU_TOUCH(mA);
            pu_load(K, r + PU_NR * step, step, mB, HB + PU_NR * 1024);
            pu_item<PROBE>(K, U, HB, SLOT, R, r, step, mA, r16, g4, dummy);
            asm volatile("s_waitcnt vmcnt(0)" ::: "memory");
            PU_TOUCH(mB);
            pu_load(K, r + 2 * PU_NR * step, step, mA, HB);
            pu_item<PROBE>(K, U, HB + PU_NR * 1024, SLOT, R, r + PU_NR * step, step, mB, r16, g4, dummy);
        }
    }
}
struct PvMeta { unsigned iab, wab; };
template <int PROBE> DI void pv_load(const Ctx& K, int r, PvMeta& m) {
    m.iab = K.PIDX32()[(size_t)r * 64 + K.lane]; m.wab = K.W32()[(size_t)r * 64 + K.lane];
}
template <int HALF, int PROBE> DI void pv_issue(const unsigned char* V, int slot, unsigned coff, const PvMeta& m, u32x4 (&vv)[8]) {
    const int ix = HALF ? (int)(m.iab >> 16) : (int)(m.iab & 0xffffu);
#pragma unroll
    for (int i = 0; i < 8; ++i) {
        const int src = ((8 * i + slot) << 2);
        const int e = __builtin_amdgcn_ds_bpermute(src, ix);
        vv[i] = PROBE == 2 ? (u32x4){(unsigned)e, 1u, 2u, 3u} : *(const u32x4*)(V + ((unsigned)e * 128u + coff));
    }
}
DI void tr4x4(unsigned x0, unsigned x1, unsigned x2, unsigned x3, unsigned (&o)[4]) {
    const unsigned a = __builtin_amdgcn_perm(x1, x0, 0x05010400u), b = __builtin_amdgcn_perm(x1, x0, 0x07030602u), c = __builtin_amdgcn_perm(x3, x2, 0x05010400u), d = __builtin_amdgcn_perm(x3, x2, 0x07030602u);
    o[0] = __builtin_amdgcn_perm(c, a, 0x05040100u); o[1] = __builtin_amdgcn_perm(c, a, 0x07060302u); o[2] = __builtin_amdgcn_perm(d, b, 0x05040100u); o[3] = __builtin_amdgcn_perm(d, b, 0x07060302u);
}
DI unsigned u4(const u32x4& v, int d) { return d == 0 ? v.x : d == 1 ? v.y : d == 2 ? v.z : v.w; }
DI float pv_weights(const PvMeta& m, unsigned char* WQ, int lane) {
    const float wa = __uint_as_float(m.wab << 16), wb = __uint_as_float(m.wab & 0xffff0000u);
    float mx = fmaxf(fabsf(wa), fabsf(wb));
    mx = dpp_max16(mx); mx = fmaxf(mx, __shfl_xor(mx, 16)); mx = fmaxf(mx, __shfl_xor(mx, 32));
    const float s_hi = fmaxf(mx, 1e-30f) * (1.0f / 127.0f), i_hi = 1.0f / s_hi, s_lo = s_hi * (1.0f / 254.0f), i_lo = 254.0f * i_hi;
    const float ha = rintf(wa * i_hi), hb = rintf(wb * i_hi);
    const int la = (int)rintf((wa - ha * s_hi) * i_lo), lb = (int)rintf((wb - hb * s_hi) * i_lo);
    const int i = lane >> 3, sl = lane & 7; unsigned char* wp = WQ + (((sl & 1) * 4 + (sl >> 1)) << 4) + i;
    wp[0] = (unsigned char)(int)ha; wp[8] = (unsigned char)(int)hb; wp[128] = (unsigned char)la; wp[136] = (unsigned char)lb;
    return s_lo;
}
template <int PROBE> DI void ph_peer_v(Ctx& K) {
    const int slot = K.lane >> 3, c = K.lane & 7;
    const float* gate = K.MOD() + (size_t)K.l * 3 * 6 * D + 5 * D;
    const int step = K.nloc * NWAVES;
    bf16_t* Xb = K.XB();
    unsigned char* WQ = K.lds + K.wave * 256;
    float* GPL = (float*)(K.lds + 8 * 256);
    for (int S = K.xg; S < 8; S += K.nxg) {
        const unsigned char* V = (const unsigned char*)K.VB() + ((size_t)K.l * 8 + S) * 16384 * 128;
        const int c0 = S * 128 + c * 16;
        __syncthreads();
        for (int i = K.tid; i < 3 * 128; i += NTHREADS) GPL[i] = gate[(size_t)(i >> 7) * 6 * D + S * 128 + (i & 127)];
        __syncthreads();
        const int r0 = K.jx * NWAVES + K.wave;
        const int nit = r0 < M ? (M - 1 - r0) / step + 1 : 0;
        PvMeta mA, mB; pv_load<PROBE>(K, min(r0, M - 1), mA); pv_load<PROBE>(K, min(r0 + step, M - 1), mB);
        u32x4 xq[2], xprev[2], x2[2]; float yp[16]; int rp = -1; PvMeta m2;
#pragma unroll
        for (int q = 0; q < 2; ++q) { xq[q] = *(const u32x4*)(Xb + (size_t)min(r0, M - 1) * D + c0 + 8 * q); xprev[q] = (u32x4){0u, 0u, 0u, 0u}; }
#pragma unroll
        for (int q = 0; q < 16; ++q) yp[q] = 0.f;
#define PV_BODY(XPREV, XQ, XNEW, MA, MC, IT) do { \
            const int r = r0 + (IT) * step; \
            { const float zdep = __uint_as_float(MA.wab << 16) * 0.0f; \
                f32x4 gp[4]; { const f32x4* gl = (const f32x4*)(GPL + modvec_of_row(max(rp, 0)) * 128 + (K.lane & 7) * 16); _Pragma("unroll") for (int q = 0; q < 4; ++q) gp[q] = gl[q]; } \
                u32x4 xo[2]; \
                _Pragma("unroll") for (int q = 0; q < 4; ++q) { const unsigned w0_ = u4(XPREV[q >> 1], 2 * (q & 1)), w1_ = u4(XPREV[q >> 1], 2 * (q & 1) + 1); \
                    const float n0 = __uint_as_float(w0_ << 16) + gp[q].x * yp[4 * q] + zdep, n1 = __uint_as_float(w0_ & 0xffff0000u) + gp[q].y * yp[4 * q + 1] + zdep; \
                    const float n2 = __uint_as_float(w1_ << 16) + gp[q].z * yp[4 * q + 2] + zdep, n3 = __uint_as_float(w1_ & 0xffff0000u) + gp[q].w * yp[4 * q + 3] + zdep; \
                    const unsigned p0 = cvtpk(n0, n1), p1 = cvtpk(n2, n3); \
                    if ((q & 1) == 0) { xo[q >> 1].x = p0; xo[q >> 1].y = p1; } else { xo[q >> 1].z = p0; xo[q >> 1].w = p1; } } \
                if (rp >= 0 && slot == 0) { bf16_t* xr = Xb + (size_t)rp * D + c0; \
                    _Pragma("unroll") for (int q = 0; q < 2; ++q) *(u32x4*)(xr + 8 * q) = xo[q]; } } \
            __builtin_amdgcn_sched_barrier(0); \
            const float s_lo = pv_weights(MA, WQ, K.lane); \
            u32x4 vA[8], vB[8]; \
            pv_issue<0, PROBE>(V, slot, (unsigned)c * 16u, MA, vA); \
            pv_issue<1, PROBE>(V, slot, (unsigned)c * 16u, MA, vB); \
            __builtin_amdgcn_sched_barrier(0); \
            { const bf16_t* xr = Xb + (size_t)min(r + step, M - 1) * D + c0; \
              _Pragma("unroll") for (int q = 0; q < 2; ++q) XNEW[q] = *(const u32x4*)(xr + 8 * q); } \
            pv_load<PROBE>(K, min(r + 2 * step, M - 1), MC); \
            __builtin_amdgcn_sched_barrier(0); \
            const i32x4 wq = *(const i32x4*)(WQ + ((((K.lane & 3) << 2) + (K.lane >> 4)) << 4)); \
            _Pragma("unroll") for (int d = 0; d < 4; ++d) { unsigned t0[4], t1[4], t2[4], t3[4]; \
                tr4x4(u4(vA[0], d), u4(vA[1], d), u4(vA[2], d), u4(vA[3], d), t0); tr4x4(u4(vA[4], d), u4(vA[5], d), u4(vA[6], d), u4(vA[7], d), t1); \
                tr4x4(u4(vB[0], d), u4(vB[1], d), u4(vB[2], d), u4(vB[3], d), t2); tr4x4(u4(vB[4], d), u4(vB[5], d), u4(vB[6], d), u4(vB[7], d), t3); \
                _Pragma("unroll") for (int bb = 0; bb < 4; ++bb) { const i32x4 bj = {(int)t0[bb], (int)t1[bb], (int)t2[bb], (int)t3[bb]}; \
                    const i32x4 dd = __builtin_amdgcn_mfma_i32_16x16x64_i8(wq, bj, (i32x4){0, 0, 0, 0}, 0, 0, 0); \
                    const int te = __mul24(dd[0], 254) + dd[2], to = __mul24(dd[1], 254) + dd[3];        \
                    const int tt = te + dppi_<0x128>(to);                                                    \
                    yp[4 * d + bb] = (float)tt * s_lo; } \
                __builtin_amdgcn_sched_barrier(0); } \
            rp = r; } while (0)
        int it = 0;
#pragma unroll 1
        for (; it + 2 < nit; it += 3) {
            PV_BODY(xprev, xq, x2, mA, m2, it);
            PV_BODY(xq, x2, xprev, mB, mA, it + 1);
            PV_BODY(x2, xprev, xq, m2, mB, it + 2);
        }
        if (it < nit) { PV_BODY(xprev, xq, x2, mA, m2, it); ++it;
            if (it < nit) { PV_BODY(xq, x2, xprev, mB, mA, it); ++it;
#pragma unroll
                for (int q = 0; q < 2; ++q) xprev[q] = x2[q]; }
            else {
#pragma unroll
                for (int q = 0; q < 2; ++q) xprev[q] = xq[q]; } }
#undef PV_BODY
        if (rp >= 0) { const int mv = modvec_of_row(rp); f32x4 gp[4];
#pragma unroll
            for (int q = 0; q < 4; ++q) gp[q] = *(const f32x4*)(gate + (size_t)mv * 6 * D + c0 + 4 * q);
            if (slot == 0) { bf16_t* xr = Xb + (size_t)rp * D + c0; u32x4 xo[2];
#pragma unroll
                for (int q = 0; q < 4; ++q) { const unsigned w0_ = u4(xprev[q >> 1], 2 * (q & 1)), w1_ = u4(xprev[q >> 1], 2 * (q & 1) + 1);
                    const unsigned p0 = cvtpk(__uint_as_float(w0_ << 16) + gp[q].x * yp[4 * q], __uint_as_float(w0_ & 0xffff0000u) + gp[q].y * yp[4 * q + 1]);
                    const unsigned p1 = cvtpk(__uint_as_float(w1_ << 16) + gp[q].z * yp[4 * q + 2], __uint_as_float(w1_ & 0xffff0000u) + gp[q].w * yp[4 * q + 3]);
                    if ((q & 1) == 0) { xo[q >> 1].x = p0; xo[q >> 1].y = p1; } else { xo[q >> 1].z = p0; xo[q >> 1].w = p1; } }
#pragma unroll
                for (int q = 0; q < 2; ++q) *(u32x4*)(xr + 8 * q) = xo[q]; } }
    }
}

DI void ph_final(Ctx& K) {
    u32x2 vn[4]; f32x4 w[4];
#pragma unroll
    for (int j = 0; j < 4; ++j) w[j] = ((const f32x4*)ARG(final_norm_w))[j * 64 + K.lane];
    { const u32x2* xr = (const u32x2*)(K.XB() + (size_t)(NCTX + min(K.gw, NLAT - 1)) * D);
#pragma unroll
      for (int j = 0; j < 4; ++j) vn[j] = xr[j * 64 + K.lane]; }
    float* outp = (float*)argp_<float>(K, (unsigned)__builtin_offsetof(Args, out));
#pragma unroll 1
    for (int r = K.gw; r < NLAT; r += K.ngw) {
        f32x4* o = (f32x4*)(outp + (size_t)r * D);
        f32x4 v[4]; float ss = 0.f;
#pragma unroll
        for (int j = 0; j < 4; ++j) { v[j] = (f32x4){__uint_as_float(vn[j].x << 16), __uint_as_float(vn[j].x & 0xffff0000u), __uint_as_float(vn[j].y << 16), __uint_as_float(vn[j].y & 0xffff0000u)};
            ss += v[j].x * v[j].x + v[j].y * v[j].y + v[j].z * v[j].z + v[j].w * v[j].w; }
        { const u32x2* xr = (const u32x2*)(K.XB() + (size_t)(NCTX + min(r + K.ngw, NLAT - 1)) * D);
#pragma unroll
          for (int j = 0; j < 4; ++j) vn[j] = xr[j * 64 + K.lane]; }
        ss = wave_sum(ss); const float rs = rsqrtf(ss * (1.0f / D) + EPS);
#pragma unroll
        for (int j = 0; j < 4; ++j) o[j * 64 + K.lane] = v[j] * rs * w[j];
    }
}

#define XB_TMO      128
#define XB_XSUB(j)  (1280 + 64 * (j))
#define XB_XGEN(j)  (2304 + 64 * (j))
#define XB_TOP      3328
#define XB_TOPGEN   3392
#define XB_SPIN_CAP (1u << 22)
constexpr int CW_BAR = 4096;
DI unsigned xb_ld(unsigned* p)              { return __hip_atomic_load(p, __ATOMIC_RELAXED, __HIP_MEMORY_SCOPE_AGENT); }
DI unsigned xb_add(unsigned* p, unsigned v) { return __hip_atomic_fetch_add(p, v, __ATOMIC_RELAXED, __HIP_MEMORY_SCOPE_AGENT); }
#define XB_SPIN(cond, bar) do { unsigned _sp = 0; while (cond) { __builtin_amdgcn_s_sleep(1); \
    if ((++_sp & 255u) == 0u) { if (xb_ld(&(bar)[XB_TMO])) break; if (_sp > XB_SPIN_CAP) { atomicAdd(&(bar)[XB_TMO], 1u); break; } } } } while (0)
DI void xcd_barrier(unsigned* bar, unsigned x, unsigned nloc, unsigned nx, int tid) {
    asm volatile("s_waitcnt vmcnt(0)" ::: "memory");
    __syncthreads();
    if (tid == 0) {
        __builtin_amdgcn_s_waitcnt(0);
        const unsigned old = xb_add(&bar[XB_XSUB(x)], 1u);
        const unsigned gen = old / nloc;
        if (old + 1u == (gen + 1u) * nloc) {
            __builtin_amdgcn_fence(__ATOMIC_RELEASE, "agent");
            asm volatile("s_waitcnt vmcnt(0)" ::: "memory");
            const unsigned og = xb_add(&bar[XB_TOP], 1u);
            const unsigned tg = og / nx;
            if (og + 1u == (tg + 1u) * nx) xb_add(&bar[XB_TOPGEN], 1u);
            else XB_SPIN(xb_ld(&bar[XB_TOPGEN]) == tg, bar);
            __builtin_amdgcn_fence(__ATOMIC_ACQUIRE, "agent");
            xb_add(&bar[XB_XGEN(x)], 1u);
            asm volatile("s_waitcnt vmcnt(0)" ::: "memory");
        } else {
            XB_SPIN(xb_ld(&bar[XB_XGEN(x)]) == gen, bar);
            __builtin_amdgcn_fence(__ATOMIC_ACQUIRE, "agent");
            asm volatile("s_waitcnt vmcnt(0)" ::: "memory");
        }
    }
    __syncthreads();
}

constexpr int PROBE_U = 0, PROBE_V = 0, PROBE_S = 0;
constexpr unsigned DUP_MASK = 0u;
constexpr int PH_PER_LAYER = 12, N_PHASES = 2 + PH_PER_LAYER * DEPTH;
__global__ void __launch_bounds__(NTHREADS) mk_fwd(Args args) {
    extern __shared__ __attribute__((aligned(16))) unsigned char lds[];
    cg::grid_group grid = cg::this_grid();
    constexpr unsigned ARGS_OFF = LDS_BYTES - 256;
    constexpr unsigned MISC_OFF = LDS_BYTES - 64;
    if (threadIdx.x == 0) {
        *(Args*)(lds + ARGS_OFF) = args;
        unsigned* ctl = (unsigned*)(args.ws + WS_CTL); unsigned* misc = (unsigned*)(lds + MISC_OFF);
        const unsigned xcc = (unsigned)__builtin_amdgcn_s_getreg((3 << 11) | 20) & 0xFu;
        misc[0] = xcc; misc[1] = __hip_atomic_fetch_add(ctl + 64 * xcc, 1u, __ATOMIC_RELAXED, __HIP_MEMORY_SCOPE_AGENT);
    }
    __syncthreads();
    const int wid_s = __builtin_amdgcn_readfirstlane((int)threadIdx.x >> 6);
    int rep = 0;
#pragma unroll 1
    for (int ph = 0; ph < N_PHASES; ++ph) {
        unsigned ones = ~0u; asm volatile("" : "+s"(ones));
        int tid = (wid_s << 6) | (int)__builtin_amdgcn_mbcnt_hi(ones, __builtin_amdgcn_mbcnt_lo(ones, 0u)); asm volatile("" : "+v"(tid));
        unsigned aoff = ARGS_OFF; asm volatile("" : "+v"(aoff));
        size_t zoff = 0; asm volatile("" : "+s"(zoff));
        unsigned char* ws = args.ws + zoff;
        int bid = blockIdx.x; asm volatile("" : "+s"(bid)); int nb = gridDim.x; asm volatile("" : "+s"(nb));
        unsigned moff = MISC_OFF; asm volatile("" : "+v"(moff));
        Ctx K; unsigned xcc_s; { const unsigned* misc = (const unsigned*)(lds + moff); xcc_s = __builtin_amdgcn_readfirstlane(misc[0]); K.jx = __builtin_amdgcn_readfirstlane(misc[1]); K.xg = __builtin_amdgcn_readfirstlane(misc[2]); K.nxg = __builtin_amdgcn_readfirstlane(misc[3]); K.nloc = __builtin_amdgcn_readfirstlane(misc[4]); }
        K.aoff = aoff; K.lds = lds; K.tid = tid; K.lane = tid & 63; K.wave = tid >> 6; K.bid = bid; K.nb = nb; K.gw = bid * NWAVES + K.wave; K.ngw = nb * NWAVES;
        K.ws = ws;
        const int l = ph == 0 ? 0 : (ph - 1) / PH_PER_LAYER, k = ph == 0 ? -1 : (ph == N_PHASES - 1 ? -2 : (ph - 1) % PH_PER_LAYER);
        K.l = l;
        if (k == -1) ph_prologue(K);
        else if (k == -2) ph_final(K);
        else if (k == 0) ph_norm(K, ARG(norm_mix_w) + (size_t)l * D, 0);
        else if (k == 1) ph_gemm_store(K, K.H(), K.WIN() + (size_t)l * PW * D, PW, K.P(), K.ROPE());
        else if (k == 2) ph_hgrn_A(K);
        else if (k == 3) ph_attn(K);
        else if (k == 4) ph_hgrn_B(K);
        else if (k == 5) ph_hgrn_C(K);
        else if (k == 6) ph_gemm_resid(K, K.MIX(), K.WOUT() + (size_t)l * D * D, 2);
        else if (k == 7) ph_norm(K, ARG(norm_ffn_w) + (size_t)l * D, 3);
        else if (k == 8) ph_gemm_store(K, K.H(), K.WQ() + (size_t)l * 2048 * D, 2048, K.QP(), nullptr);
        else if (k == 9) { ph_peer_select<0>(K); if (PROBE_S) ph_peer_select<PROBE_S>(K); }
        else if (k == 10) { ph_peer_u<0>(K); if (PROBE_U) ph_peer_u<PROBE_U>(K); }
        else if (k == 11) { ph_peer_v<0>(K); if (PROBE_V) ph_peer_v<PROBE_V>(K); }
        if (k >= 0 && ((DUP_MASK >> k) & 1u)) { ++rep; if (rep < 2) { --ph; continue; } } rep = 0;
        if (ph == 0) grid.sync();
        else if (k != 2 && ph != N_PHASES - 1) xcd_barrier((unsigned*)(args.ws + WS_CTL) + CW_BAR, xcc_s, (unsigned)K.nloc, (unsigned)K.nxg, tid);
        if (ph == 0) {
            if (tid == 0) { unsigned* ctl = (unsigned*)(args.ws + WS_CTL); unsigned* misc = (unsigned*)(lds + MISC_OFF); const unsigned xcc = misc[0]; unsigned ord = 0, npop = 0, mine = 1;
                for (unsigned q = 0; q < 16; ++q) { const unsigned cq = __hip_atomic_load(ctl + 64 * q, __ATOMIC_RELAXED, __HIP_MEMORY_SCOPE_AGENT); if (cq) { ++npop; if (q < xcc) ++ord; } if (q == xcc) mine = cq; }
                misc[2] = ord; misc[3] = npop ? npop : 1u; misc[4] = mine ? mine : 1u; }
            __syncthreads();
        }
    }
}

extern "C" void kernel_launch(void* const* d_in, const int* in_sizes, int n_in, void* d_out, int out_size, void* d_ws, size_t ws_size, hipStream_t stream) {
    static int grid = 0;
    if (grid == 0) {
        if (n_in != 19 || out_size != NLAT * D || ws_size < WS_END) { fprintf(stderr, "kernel_launch: unexpected shapes (n_in %d out %d ws %zu need %zu)\n", n_in, out_size, ws_size, (size_t)WS_END); grid = -1; return; }
        int dev = 0, cus = 0, per_cu = 0;
        (void)hipGetDevice(&dev); (void)hipDeviceGetAttribute(&cus, hipDeviceAttributeMultiprocessorCount, dev);
        (void)hipFuncSetAttribute((const void*)mk_fwd, hipFuncAttributeMaxDynamicSharedMemorySize, LDS_BYTES);
        (void)hipOccupancyMaxActiveBlocksPerMultiprocessor(&per_cu, (const void*)mk_fwd, NTHREADS, LDS_BYTES);
        if (per_cu < 1) { fprintf(stderr, "kernel_launch: occupancy query says %d blocks/CU\n", per_cu); grid = -1; return; }
        grid = (cus / 8) * 8;
    }
    if (grid < 0) return;
    Args a{};
    a.x = (const float*)d_in[0]; a.c = (const float*)d_in[1]; a.ctx = (const float*)d_in[2]; a.c_ctx = (const float*)d_in[3]; a.w_mod = (const float*)d_in[4]; a.b_mod = (const float*)d_in[5];
    a.norm_mix_w = (const float*)d_in[6]; a.norm_ffn_w = (const float*)d_in[7]; a.w_in = (const float*)d_in[8]; a.lb_logits = (const float*)d_in[9]; a.hgrn_norm_w = (const float*)d_in[10];
    a.swa_sink = (const float*)d_in[11]; a.nat_rpb = (const float*)d_in[12]; a.w_out = (const float*)d_in[13]; a.peer_wq = (const float*)d_in[14]; a.peer_sk = (const float*)d_in[15];
    a.peer_u = (const float*)d_in[16]; a.peer_v = (const float*)d_in[17]; a.final_norm_w = (const float*)d_in[18];
    a.out = (float*)d_out; a.ws = (unsigned char*)d_ws;
    (void)hipMemsetAsync((unsigned char*)d_ws + WS_CTL, 0, CTL_BYTES, stream);
    void* kargs[] = {&a};
    hipError_t e = hipLaunchCooperativeKernel((const void*)mk_fwd, dim3(grid), dim3(NTHREADS), kargs, LDS_BYTES, stream);
    if (e != hipSuccess) fprintf(stderr, "kernel_launch: cooperative launch failed: %s (grid %d)\n", hipGetErrorString(e), grid);
}
```

```cpp
#include <hip/hip_runtime.h>
#include <hip/hip_cooperative_groups.h>
#include <cstdio>
#include <cstdint>
namespace cg = cooperative_groups;
#define DI __device__ __forceinline__
#define GP(T, p) ((T*)(__attribute__((address_space(1))) T*)(p))

typedef unsigned short bf16_t;
typedef float f32x4 __attribute__((ext_vector_type(4)));
typedef unsigned u32x4 __attribute__((ext_vector_type(4)));
typedef unsigned u32x2 __attribute__((ext_vector_type(2)));

constexpr int D = 1024, NB = 2, L = 16384, CL = 256, DEPTH = 4;
constexpr int NCTX = NB * CL, NLAT = NB * L, M = NCTX + NLAT;
constexpr int PW = 3072;
constexpr int C_HQ = 0, C_ZF = 256, C_ZB = 512, C_HV = 768, C_HG = 1024, C_SQ = 1280, C_SK = 1664, C_SV = 1792, C_NQ = 1920, C_NK = 2304, C_NV = 2688;
constexpr int MX_H = 0, MX_S = 256, MX_N = 640;
constexpr float EPS = 1e-6f;
constexpr int NTHREADS = 512, NWAVES = 8;
constexpr int LDS_BYTES = 163840;

constexpr size_t al256(size_t x) { return (x + 255) & ~(size_t)255; }
constexpr size_t WS_X = 0;
constexpr size_t WS_H = WS_X + al256((size_t)M * D * 4);
constexpr size_t WS_P = WS_H + al256((size_t)M * D * 2);
constexpr size_t WS_MIX = WS_P + al256((size_t)M * PW * 2);
constexpr size_t WS_OF = WS_MIX + al256((size_t)M * D * 2);
constexpr size_t WS_OB = WS_OF + al256((size_t)M * 256 * 4);
constexpr size_t WS_PIDX = WS_OB + al256((size_t)M * 256 * 4);
constexpr size_t WS_PG = WS_PIDX + al256((size_t)M * 128 * 4);
constexpr size_t WS_MOD = WS_PG + al256((size_t)M * 128 * 4);
constexpr size_t WS_LB = WS_MOD + al256((size_t)DEPTH * 3 * 6 * D * 4);
constexpr size_t WS_ROPE = WS_LB + al256((size_t)2 * DEPTH * 256 * 4);
constexpr size_t WS_WIN = WS_ROPE + al256((size_t)(256 + 256 + 64 + 64) * 16 * 4);
constexpr size_t WS_WOUT = WS_WIN + al256((size_t)DEPTH * PW * D * 2);
constexpr size_t WS_WQ = WS_WOUT + al256((size_t)DEPTH * D * D * 2);
constexpr size_t WS_AC = WS_WQ + al256((size_t)DEPTH * 2048 * D * 2);
constexpr size_t WS_UB_ = 0; constexpr size_t WS_UB = WS_AC + al256((size_t)16 * 260 * 64 * 4); constexpr size_t WS_UB_OLD = WS_WQ + al256((size_t)DEPTH * 2048 * D * 2);
constexpr size_t WS_VB = WS_UB + al256((size_t)DEPTH * 16384 * D * 2);
constexpr size_t WS_PA = WS_VB + al256((size_t)DEPTH * 16384 * D * 2);
constexpr size_t WS_VS = WS_PA + al256((size_t)M * 128 * 4);
constexpr size_t WS_US = WS_VS + al256((size_t)DEPTH * 16384 * 4);
constexpr size_t WS_H8 = WS_US + al256((size_t)DEPTH * 16384 * 4);
constexpr size_t WS_HS = WS_H8 + al256((size_t)M * D);
constexpr size_t WS_SKH = WS_HS + al256((size_t)M * 4);
constexpr size_t WS_SKL = WS_SKH + al256((size_t)DEPTH * 8 * 2 * 128 * 128 * 2);
constexpr size_t WS_CTL = WS_SKL + al256((size_t)DEPTH * 8 * 2 * 128 * 128 * 2);
constexpr size_t CTL_BYTES = 65536;
constexpr size_t WS_END = WS_CTL + CTL_BYTES;

struct Args {
    const float *x, *c, *ctx, *c_ctx, *w_mod, *b_mod, *norm_mix_w, *norm_ffn_w, *w_in, *lb_logits, *hgrn_norm_w, *swa_sink, *nat_rpb, *w_out, *peer_wq, *peer_sk, *peer_u, *peer_v, *final_norm_w;
    float* out; unsigned char* ws;
};

DI float bf2f(bf16_t v) { return __uint_as_float((unsigned)v << 16); }
DI bf16_t f2bf(float f) { unsigned u = __float_as_uint(f); return (bf16_t)((u + 0x7fffu + ((u >> 16) & 1u)) >> 16); }
DI unsigned pk2(float lo, float hi) { return (unsigned)f2bf(lo) | ((unsigned)f2bf(hi) << 16); }
DI float wave_sum(float v) {
#pragma unroll
    for (int o = 1; o < 64; o <<= 1) v += __shfl_xor(v, o);
    return v;
}
typedef __bf16 bf16x2_t __attribute__((ext_vector_type(2)));
template <int CTRL> DI float dpp_(float x) { return __builtin_bit_cast(float, __builtin_amdgcn_mov_dpp(__builtin_bit_cast(int, x), CTRL, 0xf, 0xf, true)); }
DI float wave_sum_fast(float x) {
    x += dpp_<0xB1>(x); x += dpp_<0x4E>(x); x += dpp_<0x141>(x); x += dpp_<0x128>(x);
    auto s1 = __builtin_amdgcn_permlane16_swap(__float_as_uint(x), __float_as_uint(x), false, false); x = __uint_as_float(s1[0]) + __uint_as_float(s1[1]);
    auto s2 = __builtin_amdgcn_permlane32_swap(__float_as_uint(x), __float_as_uint(x), false, false); return __uint_as_float(s2[0]) + __uint_as_float(s2[1]);
}
DI float sigmoidf_(float z) { return 1.0f / (1.0f + __expf(-z)); }
DI float gelu_erf(float v) { return 0.5f * v * (1.0f + erff(v * 0.70710678118654752f)); }
DI int modvec_of_row(int r) { return r < NCTX ? 2 : (r - NCTX) / L; }
DI int lat_row(int b, int t) { return NCTX + b * L + t; }
DI int ctx_row(int b, int s) { return b * CL + s; }
DI void unpack8(const u32x4 w, float* o) {
    o[0] = __uint_as_float(w.x << 16); o[1] = __uint_as_float(w.x & 0xffff0000u);
    o[2] = __uint_as_float(w.y << 16); o[3] = __uint_as_float(w.y & 0xffff0000u);
    o[4] = __uint_as_float(w.z << 16); o[5] = __uint_as_float(w.z & 0xffff0000u);
    o[6] = __uint_as_float(w.w << 16); o[7] = __uint_as_float(w.w & 0xffff0000u);
}
DI void load_row64(const bf16_t* p, float (&o)[64]) {
#pragma unroll
    for (int i = 0; i < 8; ++i) { const u32x4 w = *(const u32x4*)(p + 8 * i); unpack8(w, &o[8 * i]); }
}
DI void rope64(float (&x)[64], const float* cr, const float* sr, const float* cc, const float* sc) {
#pragma unroll
    for (int i = 0; i < 16; ++i) {
        const float c1 = cr[i], s1 = sr[i], a = x[i], b = x[16 + i];
        x[i] = a * c1 - b * s1; x[16 + i] = b * c1 + a * s1;
        const float c2 = cc[i], s2 = sc[i], e = x[32 + i], f = x[48 + i];
        x[32 + i] = e * c2 - f * s2; x[48 + i] = f * c2 + e * s2;
    }
}

namespace pg8 {
#define PG8_LAS __attribute__((address_space(3)))
typedef unsigned short bf16_t;
typedef short bf16x8 __attribute__((ext_vector_type(8)));
typedef float f32x4 __attribute__((ext_vector_type(4)));
typedef unsigned u32x4 __attribute__((ext_vector_type(4)));
constexpr int BM = 256, BK = 64, HALF = 128, HTB = HALF * BK * 2  , STAGE_BYTES = 8 * HTB, NXCD = 8, WGM = 8;

__host__ __device__ __forceinline__ int lds_byte(int r, int c) { const int st = (r >> 4) * 2 + (c >> 5), rr = r & 15, cc = c & 31, ob = rr * 64 + cc * 2; return st * 1024 + (ob ^ (((ob >> 9) & 1) << 5)); }
__host__ __device__ __forceinline__ void stage_rc(int b, int& R, int& C) { const int st = b / 1024, sb = b % 1024, swz = sb ^ (((sb >> 9) & 1) << 5); R = (st >> 1) * 16 + swz / 64; C = (st & 1) * 32 + (swz % 64) / 2; }
__host__ __device__ __forceinline__ int perm32(int rho) { const int n = rho >> 4, i = rho & 15; return 8 * (i >> 2) + 4 * n + (i & 3); }

struct Unit { int pm, pn; };
struct Gemm { const bf16_t* A; const bf16_t* Bt; int M, N, K; };

struct StaticOrder {
    int nM, nN, nwg, G, c;
    __host__ __device__ void init(int M, int N, int G_, int c_) { nM = M / BM; nN = N / BM; nwg = nM * nN; G = G_; c = c_; }
    __host__ __device__ bool next(int i, Unit& u) const {
        const long L = (long)i * G + c; if (L >= nwg) return false;
        int wgid = (int)L; { const int q = nwg / NXCD, r = nwg % NXCD, xcd = wgid % NXCD, off = wgid / NXCD; wgid = (xcd < r ? xcd * (q + 1) : r * (q + 1) + (xcd - r) * q) + off; }
        const int nig = WGM * nN, gid = wgid / nig, fm = gid * WGM, gsz = (nM - fm) < WGM ? (nM - fm) : WGM;
        u.pm = fm + ((wgid % nig) % gsz); u.pn = (wgid % nig) / gsz; return true;
    }
    __device__ __forceinline__ void a_ready(const Unit&) const {}
    __device__ __forceinline__ void done(const Unit&) const {}
};


__device__ __forceinline__ unsigned cvt_pk_bf16(float lo, float hi) { unsigned r; asm volatile("v_cvt_pk_bf16_f32 %0, %1, %2" : "=v"(r) : "v"(lo), "v"(hi)); return r; }
constexpr int EPI_LDS_OFF = STAGE_BYTES, EPI_LDS_WAVE = 2560;
struct EpiStore {
    static constexpr bool PERM = true, AFTER_DRAIN = false;
    bf16_t* O; int ldc; PG8_LAS unsigned char* lds; const float* rope; int nctx, seqlen, rowbase;
    __device__ __forceinline__ void operator()(const f32x4 (&acc)[2][2][4][2], const Unit& u, int wr, int wc, int fr, int fq) const {
        PG8_LAS unsigned char* T = lds + EPI_LDS_OFF + (wr * 4 + wc) * EPI_LDS_WAVE;
        const int lane = fr + 16 * fq, rr = lane >> 2, cc = lane & 3;
        const int row0 = rowbase + u.pm * BM + wr * 64, col0 = u.pn * BM + wc * 32;
        const bool dorope = rope != nullptr && (u.pn == 5 || u.pn == 6) && rowbase + u.pm * BM >= nctx;
#pragma unroll
        for (int ai = 0; ai < 2; ++ai)
#pragma unroll
            for (int m = 0; m < 4; ++m)
#pragma unroll
                for (int bj = 0; bj < 2; ++bj) { const f32x4 v0 = acc[ai][bj][m][0], v1 = acc[ai][bj][m][1];
                    u32x4 w; w.x = cvt_pk_bf16(v0[0], v0[1]); w.y = cvt_pk_bf16(v0[2], v0[3]); w.z = cvt_pk_bf16(v1[0], v1[1]); w.w = cvt_pk_bf16(v1[2], v1[3]);
                    *(PG8_LAS u32x4*)(T + fr * 80 + 16 * fq) = w;
                    asm volatile("s_waitcnt lgkmcnt(0)" ::: "memory");
                    u32x4 o = *(const PG8_LAS u32x4*)(T + rr * 80 + 16 * cc);
                    asm volatile("s_waitcnt lgkmcnt(0)" ::: "memory");
                    const int grow = row0 + ai * HALF + m * 16 + rr;
                    if (dorope) {
                        const int t = (grow - nctx) % seqlen; const bool second = (wc & 1) != 0;
                        const float* ct = rope + (second ? 8192 + (t & 63) * 16 : (t >> 6) * 16) + 8 * (cc & 1); const float* st = ct + (second ? 1024 : 4096);
                        const f32x4 c0 = *(const f32x4*)ct, c1 = *(const f32x4*)(ct + 4), s0 = *(const f32x4*)st, s1 = *(const f32x4*)(st + 4);
                        const float cs[8] = {c0[0], c0[1], c0[2], c0[3], c1[0], c1[1], c1[2], c1[3]}, sn[8] = {s0[0], s0[1], s0[2], s0[3], s1[0], s1[1], s1[2], s1[3]};
                        const unsigned ow[4] = {o.x, o.y, o.z, o.w}; unsigned rw[4];
                        const float sg = cc >= 2 ? 1.0f : -1.0f;
#pragma unroll
                        for (int q = 0; q < 4; ++q) { const unsigned pw = (unsigned)__builtin_amdgcn_mov_dpp((int)ow[q], 0x4E, 0xf, 0xf, true);
                            const float x0 = __uint_as_float(ow[q] << 16), x1 = __uint_as_float(ow[q] & 0xffff0000u), p0 = __uint_as_float(pw << 16), p1 = __uint_as_float(pw & 0xffff0000u);
                            rw[q] = cvt_pk_bf16(x0 * cs[2 * q] + sg * p0 * sn[2 * q], x1 * cs[2 * q + 1] + sg * p1 * sn[2 * q + 1]); }
                        o = (u32x4){rw[0], rw[1], rw[2], rw[3]}; }
                    *(u32x4*)(O + (size_t)grow * ldc + col0 + bj * HALF + 8 * cc) = o; }
    }
};
template <bool XF32> struct EpiResid {
    static constexpr bool PERM = false, AFTER_DRAIN = false;
    bf16_t* X; int ldc; const float* gate; int gstride, nctx, seqlen; PG8_LAS unsigned char* lds; int rowbase; const void* Xin;
    __device__ __forceinline__ void operator()(const f32x4 (&acc)[2][2][4][2], const Unit& u, int wr, int wc, int fr, int fq) const {
        PG8_LAS float* T = (PG8_LAS float*)(lds + EPI_LDS_OFF + (wr * 4 + wc) * EPI_LDS_WAVE);
        const int lane = fr + 16 * fq, rr = lane >> 3, cc = lane & 7;
        const int r0 = rowbase + u.pm * BM; const int vsel = r0 < nctx ? 2 : (r0 - nctx) / seqlen;
        const int row0 = r0 + wr * 64, col0 = u.pn * BM + wc * 32 + 4 * cc;
#pragma unroll
        for (int bj = 0; bj < 2; ++bj) { const f32x4 g = *(const f32x4*)(gate + (size_t)vsel * gstride + col0 + bj * HALF);
#pragma unroll
            for (int ai = 0; ai < 2; ++ai)
#pragma unroll
                for (int m = 0; m < 4; ++m) {
#pragma unroll
                    for (int n = 0; n < 2; ++n) *(PG8_LAS f32x4*)(T + fr * 36 + 16 * n + 4 * fq) = acc[ai][bj][m][n];
                    asm volatile("s_waitcnt lgkmcnt(0)" ::: "memory");
                    const f32x4 t0 = *(const PG8_LAS f32x4*)(T + rr * 36 + 4 * cc), t1 = *(const PG8_LAS f32x4*)(T + (rr + 8) * 36 + 4 * cc);
                    asm volatile("s_waitcnt lgkmcnt(0)" ::: "memory");
                    const size_t ro = (size_t)(row0 + ai * HALF + m * 16 + rr) * ldc + col0 + bj * HALF, io = (size_t)(row0 - rowbase + ai * HALF + m * 16 + rr) * ldc + col0 + bj * HALF;
                    f32x4 a, b;
                    if (XF32) { a = *(const f32x4*)((const float*)Xin + io); b = *(const f32x4*)((const float*)Xin + io + (size_t)8 * ldc); }
                    else { const unsigned* pa = (const unsigned*)((const bf16_t*)Xin + io); const unsigned* pb = (const unsigned*)((const bf16_t*)Xin + io + (size_t)8 * ldc); const unsigned a0 = pa[0], a1 = pa[1], b0 = pb[0], b1 = pb[1];
                        a = (f32x4){__uint_as_float(a0 << 16), __uint_as_float(a0 & 0xffff0000u), __uint_as_float(a1 << 16), __uint_as_float(a1 & 0xffff0000u)};
                        b = (f32x4){__uint_as_float(b0 << 16), __uint_as_float(b0 & 0xffff0000u), __uint_as_float(b1 << 16), __uint_as_float(b1 & 0xffff0000u)}; }
                    a += g * t0; b += g * t1;
                    unsigned* xa_ = (unsigned*)(X + ro); unsigned* xb_ = (unsigned*)(X + ro + (size_t)8 * ldc);
                    xa_[0] = cvt_pk_bf16(a[0], a[1]); xa_[1] = cvt_pk_bf16(a[2], a[3]); xb_[0] = cvt_pk_bf16(b[0], b[1]); xb_[1] = cvt_pk_bf16(b[2], b[3]); } }
    }
};

template <class Epi, class Sched, bool ALIGN_EPI = false, bool SP2 = false>
__device__ __forceinline__ void gemm_phase(PG8_LAS unsigned char* lds, const Gemm g, const Sched& S, const Epi& E, int tid_in) {
    int tid_ = tid_in; asm volatile("" : "+v"(tid_));
    const int tid = tid_, wid = __builtin_amdgcn_readfirstlane(tid >> 6), lane = tid & 63, wr = wid >> 2, wc = wid & 3, fr = lane & 15, fq = lane >> 4;
    const int K = g.K, nt = K / BK;
    unsigned voffA[2], voffB[2];
#pragma unroll
    for (int i = 0; i < 2; ++i) { int R, C; stage_rc(tid * 16 + i * 8192, R, C); const int Rb = Epi::PERM ? ((R & ~31) + perm32(R & 31)) : R;
        voffA[i] = (unsigned)(R * K + C) * 2u; voffB[i] = (unsigned)(Rb * K + C) * 2u; }
    const size_t kstep = (size_t)(BK * 2);
    const size_t hstep = (size_t)HALF * K * 2;
    const size_t tstep = 2 * hstep;
    const unsigned ldsw = (unsigned)wid * 1024u;
    const int aoff = lds_byte(wr * 64 + fr, fq * 8), boff = lds_byte(wc * 32 + fr, fq * 8);
#define PG8_SA(b, h) (((b) * 2 + (h)) * HTB)
#define PG8_SB(b, h) ((4 + (b) * 2 + (h)) * HTB)
#define PG8_STAGE(bufoff, gbase, voff) do { _Pragma("unroll") for (int _i = 0; _i < 2; ++_i) \
        __builtin_amdgcn_global_load_lds((const unsigned*)((const char*)(gbase) + (voff)[_i]), (PG8_LAS unsigned*)(lds + (bufoff) + ldsw + _i * 8192), 16, 0, 0); } while (0)
#define PG8_LDA(dst, b, h) do { _Pragma("unroll") for (int m = 0; m < 4; ++m) _Pragma("unroll") for (int k = 0; k < 2; ++k) dst[m][k] = *(const PG8_LAS bf16x8*)(lds + PG8_SA(b, h) + aoff + m * 2048 + k * 1024); } while (0)
#define PG8_LDB(dst, b, h) do { _Pragma("unroll") for (int n = 0; n < 2; ++n) _Pragma("unroll") for (int k = 0; k < 2; ++k) dst[n][k] = *(const PG8_LAS bf16x8*)(lds + PG8_SB(b, h) + boff + n * 2048 + k * 1024); } while (0)
#define PG8_MMA(ai, bj, At, Bt) do { __builtin_amdgcn_s_setprio(1); _Pragma("unroll") for (int m = 0; m < 4; ++m) _Pragma("unroll") for (int n = 0; n < 2; ++n) _Pragma("unroll") for (int k = 0; k < 2; ++k) \
        acc[ai][bj][m][n] = __builtin_amdgcn_mfma_f32_16x16x32_bf16(Bt[n][k], At[m][k], acc[ai][bj][m][n], 0, 0, 0); __builtin_amdgcn_s_setprio(0); } while (0)
#define PG8_WAIT_V(n) asm volatile("s_waitcnt vmcnt(" #n ")" ::: "memory")
#define PG8_WAIT_L(n) asm volatile("s_waitcnt lgkmcnt(" #n ")" ::: "memory")
#define PG8_BAR __builtin_amdgcn_s_barrier()
#define PG8_SCHED __builtin_amdgcn_sched_barrier(0)
    Unit cur, nxt; int ui = 0;
    if (!S.next(0, cur)) return;
    f32x4 acc[2][2][4][2];
#pragma unroll
    for (int a = 0; a < 2; ++a)
#pragma unroll
        for (int b = 0; b < 2; ++b)
#pragma unroll
            for (int m = 0; m < 4; ++m)
#pragma unroll
                for (int n = 0; n < 2; ++n) acc[a][b][m][n] = (f32x4){0.f, 0.f, 0.f, 0.f};
    bf16x8 At[4][2], B0[2][2], B1[2][2];
    const char* cA = (const char*)g.A + (size_t)cur.pm * tstep; const char* cB = (const char*)g.Bt + (size_t)cur.pn * tstep;
    S.a_ready(cur);
    if constexpr (SP2) {
        PG8_STAGE(PG8_SB(0, 0), cB, voffB); PG8_STAGE(PG8_SB(0, 1), cB + hstep, voffB); PG8_STAGE(PG8_SA(0, 0), cA, voffA); PG8_STAGE(PG8_SA(0, 1), cA + hstep, voffA);
        if (wr == 1) PG8_BAR;
        PG8_WAIT_V(2); PG8_BAR;
        PG8_STAGE(PG8_SB(1, 0), cB + kstep, voffB); PG8_STAGE(PG8_SA(1, 0), cA + kstep, voffA); PG8_STAGE(PG8_SB(1, 1), cB + hstep + kstep, voffB);
        PG8_WAIT_V(6); PG8_BAR;
    } else {
        PG8_STAGE(PG8_SB(0, 0), cB, voffB); PG8_STAGE(PG8_SA(0, 0), cA, voffA); PG8_STAGE(PG8_SB(0, 1), cB + hstep, voffB); PG8_STAGE(PG8_SA(0, 1), cA + hstep, voffA);
        if (wr == 1) PG8_BAR;
        PG8_WAIT_V(4); PG8_BAR;
        PG8_STAGE(PG8_SB(1, 0), cB + kstep, voffB); PG8_STAGE(PG8_SA(1, 0), cA + kstep, voffA); PG8_STAGE(PG8_SB(1, 1), cB + hstep + kstep, voffB);
        PG8_WAIT_V(6); PG8_BAR;
    }
    for (;;) {
        const bool has_next = S.next(ui + 1, nxt);
        const char* nA = has_next ? (const char*)g.A + (size_t)nxt.pm * tstep : cA; const char* nB = has_next ? (const char*)g.Bt + (size_t)nxt.pn * tstep : cB;
        for (int t = 0; t < nt; t += 2) {
            const bool last = (t == nt - 2);
            const char* a1 = cA + (size_t)(t + 1) * kstep;
            const char* a2 = last ? nA : cA + (size_t)(t + 2) * kstep; const char* b2 = last ? nB : cB + (size_t)(t + 2) * kstep;
            const char* a3 = a2 + kstep; const char* b3 = b2 + kstep;
            if (last && has_next) S.a_ready(nxt);
            if constexpr (SP2) {
            PG8_LDB(B0, 0, 0); PG8_LDB(B1, 0, 1); PG8_SCHED; PG8_LDA(At, 0, 0); PG8_STAGE(PG8_SA(1, 1), a1 + hstep, voffA);
            PG8_WAIT_V(8); PG8_WAIT_L(0); PG8_BAR; PG8_MMA(0, 0, At, B0); PG8_MMA(0, 1, At, B1); PG8_BAR; PG8_SCHED;
            PG8_LDA(At, 0, 1); PG8_STAGE(PG8_SB(0, 0), b2, voffB); PG8_STAGE(PG8_SB(0, 1), b2 + hstep, voffB); PG8_STAGE(PG8_SA(0, 0), a2, voffA);
            PG8_WAIT_V(8); PG8_WAIT_L(0); PG8_BAR; PG8_MMA(1, 0, At, B0); PG8_MMA(1, 1, At, B1); PG8_BAR; PG8_SCHED;
            PG8_LDB(B0, 1, 0); PG8_LDB(B1, 1, 1); PG8_SCHED; PG8_LDA(At, 1, 0); PG8_STAGE(PG8_SA(0, 1), a2 + hstep, voffA);
            PG8_WAIT_V(8); PG8_WAIT_L(0); PG8_BAR; PG8_MMA(0, 0, At, B0); PG8_MMA(0, 1, At, B1); PG8_BAR; PG8_SCHED;
            PG8_LDA(At, 1, 1); PG8_STAGE(PG8_SB(1, 0), b3, voffB); PG8_STAGE(PG8_SB(1, 1), b3 + hstep, voffB); PG8_STAGE(PG8_SA(1, 0), a3, voffA);
            PG8_WAIT_V(8); PG8_WAIT_L(0); PG8_BAR; PG8_MMA(1, 0, At, B0); PG8_MMA(1, 1, At, B1); PG8_BAR; PG8_SCHED;
            } else {
            PG8_LDB(B0, 0, 0); PG8_SCHED; PG8_LDA(At, 0, 0); PG8_STAGE(PG8_SA(1, 1), a1 + hstep, voffA);
            PG8_WAIT_L(8); PG8_BAR; PG8_WAIT_L(0); PG8_MMA(0, 0, At, B0); PG8_BAR; PG8_SCHED;
            PG8_LDB(B1, 0, 1); PG8_STAGE(PG8_SB(0, 0), b2, voffB);
            PG8_BAR; PG8_WAIT_L(0); PG8_MMA(0, 1, At, B1); PG8_BAR;
            PG8_LDA(At, 0, 1); PG8_STAGE(PG8_SA(0, 0), a2, voffA);
            PG8_BAR; PG8_WAIT_L(0); PG8_MMA(1, 0, At, B0); PG8_BAR; PG8_SCHED;
            PG8_STAGE(PG8_SB(0, 1), b2 + hstep, voffB);
            PG8_WAIT_V(6); PG8_BAR; PG8_MMA(1, 1, At, B1); PG8_BAR;
            PG8_LDB(B0, 1, 0); PG8_SCHED; PG8_LDA(At, 1, 0); PG8_STAGE(PG8_SA(0, 1), a2 + hstep, voffA);
            PG8_WAIT_L(8); PG8_BAR; PG8_WAIT_L(0); PG8_MMA(0, 0, At, B0); PG8_BAR; PG8_SCHED;
            PG8_LDB(B1, 1, 1); PG8_STAGE(PG8_SB(1, 0), b3, voffB);
            PG8_BAR; PG8_WAIT_L(0); PG8_MMA(0, 1, At, B1); PG8_BAR;
            PG8_LDA(At, 1, 1); PG8_STAGE(PG8_SA(1, 0), a3, voffA);
            PG8_BAR; PG8_WAIT_L(0); PG8_MMA(1, 0, At, B0); PG8_BAR; PG8_SCHED;
            PG8_STAGE(PG8_SB(1, 1), b3 + hstep, voffB);
            PG8_WAIT_V(6); PG8_BAR; PG8_MMA(1, 1, At, B1); PG8_BAR;
            }
        }
        if constexpr (ALIGN_EPI) { if (wr == 0) PG8_BAR; }
        if constexpr (!Epi::AFTER_DRAIN) { E(acc, cur, wr, wc, fr, fq); S.done(cur); }
        if (!has_next) break;
#pragma unroll
        for (int a = 0; a < 2; ++a)
#pragma unroll
            for (int b = 0; b < 2; ++b)
#pragma unroll
                for (int m = 0; m < 4; ++m)
#pragma unroll
                    for (int n = 0; n < 2; ++n) acc[a][b][m][n] = (f32x4){0.f, 0.f, 0.f, 0.f};
        cur = nxt; cA = nA; cB = nB; ++ui;
        if constexpr (ALIGN_EPI) { if (wr == 1) PG8_BAR; }
    }
    PG8_WAIT_V(0);
    if constexpr (!ALIGN_EPI) { if (wr == 0) PG8_BAR; }
    PG8_BAR;
    if constexpr (Epi::AFTER_DRAIN) { E.fused(acc, cur, wr, wc, fr, fq, lds, wid, lane); S.done(cur); }
#undef PG8_SA
#undef PG8_SB
#undef PG8_STAGE
#undef PG8_LDA
#undef PG8_LDB
#undef PG8_MMA
#undef PG8_WAIT_V
#undef PG8_WAIT_L
#undef PG8_BAR
#undef PG8_SCHED
}
}

struct Ctx {
    unsigned aoff; int l;
    unsigned char* ws;
    DI bf16_t* XB() const { return GP(bf16_t, ws + WS_X); }
    DI bf16_t* H() const { return GP(bf16_t, ws + WS_H); }
    DI bf16_t* P() const { return GP(bf16_t, ws + WS_P); }
    DI bf16_t* QP() const { return GP(bf16_t, ws + WS_P); }
    DI bf16_t* MIX() const { return GP(bf16_t, ws + WS_MIX); }
    DI unsigned short* PIDX16() const { return GP(unsigned short, ws + WS_PIDX); }
    DI unsigned* PIDX32() const { return GP(unsigned, ws + WS_PIDX); }
    DI unsigned short* W16() const { return GP(unsigned short, ws + WS_PA); }
    DI unsigned* W32() const { return GP(unsigned, ws + WS_PA); }
    DI float* PG() const { return GP(float, ws + WS_PG); }
    DI float* MOD() const { return GP(float, ws + WS_MOD); }
    DI float* LB() const { return GP(float, ws + WS_LB); }
    DI float* ROPE() const { return GP(float, ws + WS_ROPE); }
    DI bf16_t* WIN() const { return GP(bf16_t, ws + WS_WIN); }
    DI bf16_t* WOUT() const { return GP(bf16_t, ws + WS_WOUT); }
    DI bf16_t* WQ() const { return GP(bf16_t, ws + WS_WQ); }
    DI bf16_t* UB() const { return GP(bf16_t, ws + WS_UB); }
    DI bf16_t* STB() const { return GP(bf16_t, ws + WS_OF); }
    DI float* AC() const { return GP(float, ws + WS_AC); }
    DI float* VS() const { return GP(float, ws + WS_VS); }
    DI float* US() const { return GP(float, ws + WS_US); }
    DI bf16_t* SKH() const { return GP(bf16_t, ws + WS_SKH); }
    DI bf16_t* SKL() const { return GP(bf16_t, ws + WS_SKL); }
    DI bf16_t* VB() const { return GP(bf16_t, ws + WS_VB); }
    DI unsigned char* H8() const { return GP(unsigned char, ws + WS_H8); }
    DI float* HS() const { return GP(float, ws + WS_HS); }
    unsigned char* lds; int tid, lane, wave, gw, ngw, bid, nb;
    int xg, nxg, jx, nloc;
};

#define LAS __attribute__((address_space(3)))
DI void transpose_item(const float* W, int Kd, int N, bf16_t* WT, LAS float* scr, int item, int lane) {
    const int nblk = N / 32, kb = item / nblk, nb = item % nblk, k0 = 64 * kb, n0 = 32 * nb;
#pragma unroll 8
    for (int i = 0; i < 32; ++i) { const int kk = 2 * i + (lane >> 5); scr[kk * 33 + (lane & 31)] = W[(size_t)(k0 + kk) * N + n0 + (lane & 31)]; }
    asm volatile("s_waitcnt lgkmcnt(0)" ::: "memory");
    const int c = lane & 7;
#pragma unroll
    for (int j = 0; j < 4; ++j) { const int n = (lane >> 3) + 8 * j; const LAS float* sp = scr + (8 * c) * 33 + n;
        u32x4 o; o.x = pk2(sp[0 * 33], sp[1 * 33]); o.y = pk2(sp[2 * 33], sp[3 * 33]); o.z = pk2(sp[4 * 33], sp[5 * 33]); o.w = pk2(sp[6 * 33], sp[7 * 33]);
        *(u32x4*)(WT + (size_t)(n0 + n) * Kd + k0 + 8 * c) = o; }
    asm volatile("s_waitcnt lgkmcnt(0)" ::: "memory");
}

template <class T> DI T* argp_(const Ctx& K, unsigned off) {
    const unsigned* p = (const unsigned*)(K.lds + K.aoff + off);
    const unsigned lo = __builtin_amdgcn_readfirstlane(p[0]), hi = __builtin_amdgcn_readfirstlane(p[1]);
    return GP(T, ((unsigned long long)hi << 32) | (unsigned long long)lo);
}
#define ARG(f) argp_<const float>(K, (unsigned)__builtin_offsetof(Args, f))

DI void ph_prologue(Ctx& K) {
    {
        LAS float* scr = (LAS float*)((LAS unsigned char*)K.lds + K.wave * 16384);
        constexpr int I_IN = (D / 64) * (PW / 32), I_OUT = (D / 64) * (D / 32), I_Q = (D / 64) * (2048 / 32), I_L = I_IN + I_OUT + I_Q;
        for (int it = K.gw; it < DEPTH * I_L; it += K.ngw) {
            const int l = it / I_L; int r = it % I_L;
            if (r < I_IN) { transpose_item(ARG(w_in) + (size_t)l * D * PW, D, PW, K.WIN() + (size_t)l * PW * D, scr, r, K.lane); continue; } r -= I_IN;
            if (r < I_OUT) { transpose_item(ARG(w_out) + (size_t)l * D * D, D, D, K.WOUT() + (size_t)l * D * D, scr, r, K.lane); continue; } r -= I_OUT;
            transpose_item(ARG(peer_wq) + (size_t)l * D * 2048, D, 2048, K.WQ() + (size_t)l * 2048 * D, scr, r, K.lane);
        }
    }
    const size_t gt = (size_t)K.bid * NTHREADS + K.tid, gs = (size_t)K.nb * NTHREADS;
    { const float* sk = ARG(peer_sk);
      for (size_t i = gt; i < (size_t)DEPTH * 8 * 2 * 128 * 128; i += gs) { const float v = sk[i]; const bf16_t hi = f2bf(v);
          const size_t lhp = i >> 14; const int key = (int)(i >> 7) & 127, d = (int)i & 127;
          const size_t o = (((lhp * 8 + (key >> 4)) * 4 + (d >> 5)) * 64 + (key & 15) + 16 * ((d >> 3) & 3)) * 8 + (d & 7);
          K.SKH()[o] = hi; K.SKL()[o] = f2bf(v - bf2f(hi)); } }
    { const float* pu = ARG(peer_u); unsigned char* UQ = (unsigned char*)K.UB();
      for (int row0 = K.gw; row0 < DEPTH * 16384; row0 += 2 * K.ngw) {
          f32x4 v2[2][4];
#pragma unroll
          for (int t = 0; t < 2; ++t) { const int row = min(row0 + t * K.ngw, DEPTH * 16384 - 1); const f32x4* src = (const f32x4*)(pu + (size_t)row * D);
#pragma unroll
              for (int j = 0; j < 4; ++j) v2[t][j] = src[j * 64 + K.lane]; }
#pragma unroll
          for (int t = 0; t < 2; ++t) { const int row = row0 + t * K.ngw; if (row >= DEPTH * 16384) break;
              float mx = 0.f;
#pragma unroll
              for (int j = 0; j < 4; ++j) mx = fmaxf(mx, fmaxf(fmaxf(fabsf(v2[t][j].x), fabsf(v2[t][j].y)), fmaxf(fabsf(v2[t][j].z), fabsf(v2[t][j].w))));
#pragma unroll
              for (int o = 1; o < 64; o <<= 1) mx = fmaxf(mx, __shfl_xor(mx, o));
              const float sc = fmaxf(mx, 1e-30f) * (1.0f / 127.0f), inv = 1.0f / sc;
              if (K.lane == 0) K.US()[row] = sc;
#pragma unroll
              for (int j = 0; j < 4; ++j) { const int col = j * 256 + K.lane * 4; const f32x4 v = v2[t][j];
                  const unsigned q0 = (unsigned)((int)rintf(v.x * inv)) & 0xffu, q1 = (unsigned)((int)rintf(v.y * inv)) & 0xffu, q2 = (unsigned)((int)rintf(v.z * inv)) & 0xffu, q3 = (unsigned)((int)rintf(v.w * inv)) & 0xffu;
                  *(unsigned*)(UQ + (size_t)row * D + col) = q0 | (q1 << 8) | (q2 << 16) | (q3 << 24); } } } }
    { const float* pv = ARG(peer_v); unsigned char* VQ = (unsigned char*)K.VB();
      for (int row0 = K.gw; row0 < DEPTH * 16384; row0 += 2 * K.ngw) {
          f32x4 v2[2][4];
#pragma unroll
          for (int t = 0; t < 2; ++t) { const int row = min(row0 + t * K.ngw, DEPTH * 16384 - 1); const f32x4* src = (const f32x4*)(pv + (size_t)row * D);
#pragma unroll
              for (int j = 0; j < 4; ++j) v2[t][j] = src[j * 64 + K.lane]; }
#pragma unroll
          for (int t = 0; t < 2; ++t) { const int row = row0 + t * K.ngw; if (row >= DEPTH * 16384) break;
              float mx = 0.f;
#pragma unroll
              for (int j = 0; j < 4; ++j) mx = fmaxf(mx, fmaxf(fmaxf(fabsf(v2[t][j].x), fabsf(v2[t][j].y)), fmaxf(fabsf(v2[t][j].z), fabsf(v2[t][j].w))));
#pragma unroll
              for (int o = 1; o < 64; o <<= 1) mx = fmaxf(mx, __shfl_xor(mx, o));
              const float sc = fmaxf(mx, 1e-30f) * (1.0f / 127.0f), inv = 1.0f / sc;
              if (K.lane == 0) K.VS()[row] = sc;
              const int l = row >> 14, e = row & 16383;
#pragma unroll
              for (int j = 0; j < 4; ++j) { const int col = j * 256 + K.lane * 4; const f32x4 v = v2[t][j];
                  const unsigned q0 = (unsigned)((int)rintf(v.x * inv)) & 0xffu, q1 = (unsigned)((int)rintf(v.y * inv)) & 0xffu, q2 = (unsigned)((int)rintf(v.z * inv)) & 0xffu, q3 = (unsigned)((int)rintf(v.w * inv)) & 0xffu;
                  *(unsigned*)(VQ + (((size_t)l * 8 + (col >> 7)) * 16384 + e) * 128 + (col & 127)) = q0 | (q1 << 8) | (q2 << 16) | (q3 << 24); } } } }
    { float* sv = (float*)K.lds;
      float* part = sv + 3 * D;
      __syncthreads();
      for (int i = K.tid; i < 3 * D; i += NTHREADS) { const int v = i / D, k = i % D; const float c = v < 2 ? ARG(c)[v * D + k] : ARG(c_ctx)[k]; sv[i] = c * sigmoidf_(c); }
      __syncthreads();
      for (int item = K.bid; item < DEPTH * 48; item += K.nb) {
          const int l = item / 48, cb = item % 48, kp = K.lane >> 5, cl = (K.lane & 31) * 4;
          const float* w = ARG(w_mod) + (size_t)l * D * 6 * D + cb * 128 + cl;
          f32x4 a0 = {0.f, 0.f, 0.f, 0.f}, a1 = a0, a2 = a0;
#pragma unroll 16
          for (int kk = 0; kk < 64; ++kk) { const int k = K.wave * 128 + 2 * kk + kp; const f32x4 wv = *(const f32x4*)(w + (size_t)k * 6 * D);
              a0 += wv * sv[k]; a1 += wv * sv[D + k]; a2 += wv * sv[2 * D + k]; }
#pragma unroll
          for (int j = 0; j < 4; ++j) { a0[j] += __shfl_xor(a0[j], 32); a1[j] += __shfl_xor(a1[j], 32); a2[j] += __shfl_xor(a2[j], 32); }
          if (kp == 0) { *(f32x4*)(part + (K.wave * 3 + 0) * 128 + cl) = a0; *(f32x4*)(part + (K.wave * 3 + 1) * 128 + cl) = a1; *(f32x4*)(part + (K.wave * 3 + 2) * 128 + cl) = a2; }
          __syncthreads();
          for (int i = K.tid; i < 384; i += NTHREADS) { const int v = i / 128, cc = i % 128; float sum = 0.f;
#pragma unroll
              for (int w8 = 0; w8 < 8; ++w8) sum += part[(w8 * 3 + v) * 128 + cc];
              const int col = cb * 128 + cc; K.MOD()[((size_t)l * 3 + v) * 6 * D + col] = sum + ARG(b_mod)[(size_t)l * 6 * D + col]; }
          __syncthreads();
      } }
    for (size_t i = gt; i < 2 * 256; i += gs) {
        const int dir = (int)(i / 256), ch = (int)(i % 256);
        float lg[DEPTH], mx = -1e30f;
#pragma unroll
        for (int l = 0; l < DEPTH; ++l) { lg[l] = ARG(lb_logits)[((size_t)dir * DEPTH + l) * 256 + ch]; mx = fmaxf(mx, lg[l]); }
        float s = 0.f;
#pragma unroll
        for (int l = 0; l < DEPTH; ++l) { lg[l] = expf(lg[l] - mx); s += lg[l]; }
        float cum = 0.f;
#pragma unroll
        for (int l = 0; l < DEPTH; ++l) { if (l > 0) cum += lg[l] / s; K.LB()[((size_t)dir * DEPTH + l) * 256 + ch] = cum; }
    }
    for (size_t i = gt; i < (256 + 64) * 16; i += gs) {
        const int pos = (int)(i / 16), f = (int)(i % 16);
        const float inv = powf(10000.0f, -(float)f / 16.0f);
        if (pos < 256) { const float ang = (float)pos * inv; K.ROPE()[pos * 16 + f] = cosf(ang); K.ROPE()[4096 + pos * 16 + f] = sinf(ang); }
        else { const int pc = pos - 256; const float ang = (float)pc * inv; K.ROPE()[8192 + pc * 16 + f] = cosf(ang); K.ROPE()[8192 + 1024 + pc * 16 + f] = sinf(ang); }
    }
}

template <bool F32IN> DI void ph_norm_t(Ctx& K, const float* nw, int shift_chunk) {
    const float* modl = K.MOD() + (size_t)K.l * 3 * 6 * D;
    f32x4 vn[4]; u32x2 vb[4]; f32x4 wsc[4], sh[4]; int mvc = -1;
    auto req = [&](int r) { if (F32IN) { const f32x4* xr = (const f32x4*)(r < NCTX ? ARG(ctx) + (size_t)r * D : ARG(x) + (size_t)(r - NCTX) * D);
#pragma unroll
            for (int j = 0; j < 4; ++j) vn[j] = xr[j * 64 + K.lane]; }
        else { const u32x2* xr = (const u32x2*)(K.XB() + (size_t)r * D);
#pragma unroll
            for (int j = 0; j < 4; ++j) vb[j] = xr[j * 64 + K.lane]; } };
    req(min(K.gw, M - 1));
#pragma unroll 1
    for (int r = K.gw; r < M; r += K.ngw) {
        f32x4 v[4]; float ss = 0.f;
#pragma unroll
        for (int j = 0; j < 4; ++j) { if (F32IN) v[j] = vn[j]; else v[j] = (f32x4){__uint_as_float(vb[j].x << 16), __uint_as_float(vb[j].x & 0xffff0000u), __uint_as_float(vb[j].y << 16), __uint_as_float(vb[j].y & 0xffff0000u)};
            ss += v[j].x * v[j].x + v[j].y * v[j].y + v[j].z * v[j].z + v[j].w * v[j].w; }
        req(min(r + K.ngw, M - 1));
        const int mvi = modvec_of_row(r);
        if (mvi != mvc) { mvc = mvi; const float* mv = modl + (size_t)mvi * 6 * D;
#pragma unroll
            for (int j = 0; j < 4; ++j) { const int c4 = j * 64 + K.lane; const f32x4 w = ((const f32x4*)nw)[c4], sc = ((const f32x4*)(mv + (shift_chunk + 1) * D))[c4]; sh[j] = ((const f32x4*)(mv + shift_chunk * D))[c4];
                wsc[j] = (f32x4){w.x * (1.f + sc.x), w.y * (1.f + sc.y), w.z * (1.f + sc.z), w.w * (1.f + sc.w)}; } }
        ss = wave_sum(ss);
        const float rs = rsqrtf(ss * (1.0f / D) + EPS);
        u32x2* ho = (u32x2*)(K.H() + (size_t)r * D);
#pragma unroll
        for (int j = 0; j < 4; ++j) {
            const int c4 = j * 64 + K.lane;
            f32x4 y; y.x = v[j].x * rs * wsc[j].x + sh[j].x; y.y = v[j].y * rs * wsc[j].y + sh[j].y; y.z = v[j].z * rs * wsc[j].z + sh[j].z; y.w = v[j].w * rs * wsc[j].w + sh[j].w;
            u32x2 o; o.x = pk2(y.x, y.y); o.y = pk2(y.z, y.w); ho[c4] = o;
            if (shift_chunk == 3) { v[j].x = __uint_as_float(o.x << 16); v[j].y = __uint_as_float(o.x & 0xffff0000u); v[j].z = __uint_as_float(o.y << 16); v[j].w = __uint_as_float(o.y & 0xffff0000u); }
        }
        if (shift_chunk == 3) {
            float mx = 0.f;
#pragma unroll
            for (int j = 0; j < 4; ++j) mx = fmaxf(mx, fmaxf(fmaxf(fabsf(v[j].x), fabsf(v[j].y)), fmaxf(fabsf(v[j].z), fabsf(v[j].w))));
#pragma unroll
            for (int o = 1; o < 64; o <<= 1) mx = fmaxf(mx, __shfl_xor(mx, o));
            const float sc = fmaxf(mx, 1e-30f) * (1.0f / 127.0f), inv = 1.0f / sc;
            if (K.lane == 0) K.HS()[r] = sc;
#pragma unroll
            for (int j = 0; j < 4; ++j) { const unsigned q0 = (unsigned)((int)rintf(v[j].x * inv)) & 0xffu, q1 = (unsigned)((int)rintf(v[j].y * inv)) & 0xffu, q2 = (unsigned)((int)rintf(v[j].z * inv)) & 0xffu, q3 = (unsigned)((int)rintf(v[j].w * inv)) & 0xffu;
                *(unsigned*)(K.H8() + (size_t)r * D + (j * 64 + K.lane) * 4) = q0 | (q1 << 8) | (q2 << 16) | (q3 << 24); }
        }
    }
}
DI void ph_norm(Ctx& K, const float* nw, int shift_chunk) { if (K.l == 0 && shift_chunk == 0) ph_norm_t<true>(K, nw, shift_chunk); else ph_norm_t<false>(K, nw, shift_chunk); }

typedef short sg_bf16x8 __attribute__((ext_vector_type(8)));
template <int NT, bool RESID> DI void sg_ctx(Ctx& K, const bf16_t* A, const bf16_t* Bt, bf16_t* out, bf16_t* X, const float* gate, const float* Xin) {
    constexpr int N = 1024 * NT, RS = 272, OFF_B = 64 * RS, BUF = (64 + 32 * NT) * RS;
    int tid = K.tid; asm volatile("" : "+v"(tid));
    const int lane = tid & 63, wave = __builtin_amdgcn_readfirstlane(tid >> 6), r16 = lane & 15, g4 = lane >> 4, mt = wave & 3, nh = wave >> 2;
    const int lrow = tid >> 4, lc = tid & 15;
    for (int u = K.bid; u < 256; u += K.nb) {
        const int xcd = u & 7, j = u >> 3, ct = xcd * 4 + (j & 3), rt = j >> 2;
        const int row0 = 64 * rt, col0 = 32 * NT * ct;
        const bf16_t* ga = A + (size_t)(row0 + lrow) * D + 8 * lc; const bf16_t* gb = Bt + (size_t)(col0 + lrow) * D + 8 * lc;
        u32x4 ra[3][2], rb[3][NT];
        f32x4 acc[NT];
#pragma unroll
        for (int n = 0; n < NT; ++n) acc[n] = (f32x4){0.f, 0.f, 0.f, 0.f};
#define SG_LOAD(s_, c_) do { ra[s_][0] = *(const u32x4*)(ga + 128 * (c_)); ra[s_][1] = *(const u32x4*)(ga + 32 * D + 128 * (c_)); \
        _Pragma("unroll") for (int i_ = 0; i_ < NT; ++i_) rb[s_][i_] = *(const u32x4*)(gb + (size_t)32 * i_ * D + 128 * (c_)); } while (0)
        SG_LOAD(0, 0); SG_LOAD(1, 1); SG_LOAD(2, 2);
        __syncthreads();
#pragma unroll
        for (int c = 0; c < 8; ++c) {
            unsigned char* buf = K.lds + (c & 1) * BUF;
            *(u32x4*)(buf + lrow * RS + 16 * lc) = ra[c % 3][0]; *(u32x4*)(buf + (lrow + 32) * RS + 16 * lc) = ra[c % 3][1];
#pragma unroll
            for (int i = 0; i < NT; ++i) *(u32x4*)(buf + OFF_B + (lrow + 32 * i) * RS + 16 * lc) = rb[c % 3][i];
            if (c + 3 < 8) SG_LOAD(c % 3, c + 3);
            __syncthreads();
#pragma unroll
            for (int ks = 0; ks < 4; ++ks) {
                const sg_bf16x8 af = *(const sg_bf16x8*)(buf + (16 * mt + r16) * RS + 64 * ks + 16 * g4);
#pragma unroll
                for (int n = 0; n < NT; ++n) { const sg_bf16x8 bf = *(const sg_bf16x8*)(buf + OFF_B + (16 * (NT * nh + n) + r16) * RS + 64 * ks + 16 * g4);
                    acc[n] = __builtin_amdgcn_mfma_f32_16x16x32_bf16(bf, af, acc[n], 0, 0, 0); }
            }
        }
#undef SG_LOAD
        const int row = row0 + 16 * mt + r16;
#pragma unroll
        for (int n = 0; n < NT; ++n) { const int col = col0 + 16 * (NT * nh + n) + 4 * g4;
            if constexpr (RESID) { unsigned* xp = (unsigned*)(X + (size_t)row * D + col); const f32x4 g = *(const f32x4*)(gate + col); f32x4 x;
                if (Xin) x = *(const f32x4*)(Xin + (size_t)row * D + col); else { const unsigned x0 = xp[0], x1 = xp[1]; x = (f32x4){__uint_as_float(x0 << 16), __uint_as_float(x0 & 0xffff0000u), __uint_as_float(x1 << 16), __uint_as_float(x1 & 0xffff0000u)}; }
                x += g * acc[n]; xp[0] = pk2(x[0], x[1]); xp[1] = pk2(x[2], x[3]); }
            else { u32x2 o; o.x = pk2(acc[n][0], acc[n][1]); o.y = pk2(acc[n][2], acc[n][3]); *(u32x2*)(out + (size_t)row * N + col) = o; } }
        __syncthreads();
    }
}
DI void ph_gemm_store(Ctx& K, const bf16_t* A, const bf16_t* Bt, int N, bf16_t* out, const float* rope) {
    { pg8::Gemm g{A + (size_t)NCTX * D, Bt, NLAT, N, D}; pg8::StaticOrder S; S.init(NLAT, N, K.nb, K.bid);
      pg8::EpiStore E{out, N, (LAS unsigned char*)K.lds, rope, NCTX, L, NCTX};
      pg8::gemm_phase<pg8::EpiStore, pg8::StaticOrder, true, true>((LAS unsigned char*)K.lds, g, S, E, K.tid); }
    if (N == PW) sg_ctx<3, false>(K, A, Bt, out, nullptr, nullptr, nullptr); else sg_ctx<2, false>(K, A, Bt, out, nullptr, nullptr, nullptr);
}
DI void ph_gemm_resid(Ctx& K, const bf16_t* A, const bf16_t* Bt, int chunk) {
    const float* gate = K.MOD() + (size_t)K.l * 3 * 6 * D + (size_t)chunk * D;
    { pg8::Gemm g{A + (size_t)NCTX * D, Bt, NLAT, D, D}; pg8::StaticOrder S; S.init(NLAT, D, K.nb, K.bid);
      if (K.l == 0) { pg8::EpiResid<true> E{K.XB(), D, gate, 6 * D, NCTX, L, (LAS unsigned char*)K.lds, NCTX, (const void*)ARG(x)};
          pg8::gemm_phase<pg8::EpiResid<true>, pg8::StaticOrder, true, true>((LAS unsigned char*)K.lds, g, S, E, K.tid); }
      else { pg8::EpiResid<false> E{K.XB(), D, gate, 6 * D, NCTX, L, (LAS unsigned char*)K.lds, NCTX, (const void*)(K.XB() + (size_t)NCTX * D)};
          pg8::gemm_phase<pg8::EpiResid<false>, pg8::StaticOrder, true, true>((LAS unsigned char*)K.lds, g, S, E, K.tid); } }
    sg_ctx<1, true>(K, A, Bt, nullptr, K.XB(), gate + (size_t)2 * 6 * D, K.l == 0 ? ARG(ctx) : nullptr);
}

typedef short bf16x8_t __attribute__((ext_vector_type(8)));
#define MFMA16(a, b, c) __builtin_amdgcn_mfma_f32_16x16x32_bf16((a), (b), (c), 0, 0, 0)
constexpr int HG_NCH = (CL + L) / 64;
constexpr int HG_LFS = 68;
constexpr int HG_TS = 72;
constexpr int HGL_LF = 0, HGL_OM = HGL_LF + 2 * 64 * HG_LFS * 4, HGL_VT = HGL_OM + 2 * 64 * HG_LFS * 4, HGL_KT = HGL_VT + 64 * HG_TS * 2, HGL_SC = HGL_KT + 2 * 64 * HG_TS * 2, HGL_OD = HGL_SC + 8 * 16 * HG_TS * 2, HGL_LB = HGL_OD + 2 * 64 * HG_LFS * 4, HGL_END = HGL_LB + 3 * 256 * 4;
static_assert(HGL_END <= LDS_BYTES - 256, "hgrn LDS map");
constexpr int HG_NIT = NB * 4 * HG_NCH;
DI int hg_block_row(int b, int tb, int tok) { return tb < 4 ? ctx_row(b, tb * 64 + tok) : lat_row(b, (tb - 4) * 64 + tok); }
DI int hg_bwd_chunk(int tb) { return tb < 4 ? 3 - tb : 4 + 255 - (tb - 4); }
DI int hg_sw(int row, int col) { return row * HG_TS + ((((col >> 3) ^ (row >> 3)) & 7) << 3) + (col & 7); }
struct HgIn { u32x4 zf, zb, hv; };
DI void hg_item(int item, int& b, int& h, int& tb) { tb = item % HG_NCH; h = (item / HG_NCH) & 3; b = item / (HG_NCH * 4); }
DI void hg_load(Ctx& K, int item, HgIn& r) {
    int b, h, tb; hg_item(item, b, h, tb); const int tok = K.tid >> 3, c = K.tid & 7;
    const bf16_t* pr = K.P() + (size_t)hg_block_row(b, tb, tok) * PW + h * 64 + 8 * c;
    r.zf = *(const u32x4*)(pr + C_ZF); r.zb = *(const u32x4*)(pr + C_ZB); r.hv = *(const u32x4*)(pr + C_HV);
}
DI void hg_prep1(Ctx& K, int h, const HgIn& r) {
    float* LF = (float*)(K.lds + HGL_LF); float* OM = (float*)(K.lds + HGL_OM); bf16_t* VT = (bf16_t*)(K.lds + HGL_VT);
    const int tok = K.tid >> 3, c = K.tid & 7;
#pragma unroll
    for (int dir = 0; dir < 2; ++dir) {
        float z[8]; unpack8(dir ? r.zb : r.zf, z);
        const float* lb = (const float*)(K.lds + HGL_LB) + dir * 256 + h * 64 + 8 * c;
        float lf[8], om[8];
#pragma unroll
        for (int j = 0; j < 8; ++j) { const float lbv = lb[j], sg = sigmoidf_(z[j]); const float f = fmaxf(lbv + (1.f - lbv) * sg, 1e-30f); lf[j] = __logf(f); om[j] = (1.f - lbv) * (1.f - sg); }
        float* lfp = LF + (dir * 64 + tok) * HG_LFS + 8 * c; float* omp = OM + (dir * 64 + tok) * HG_LFS + 8 * c;
        *(f32x4*)lfp = (f32x4){lf[0], lf[1], lf[2], lf[3]}; *(f32x4*)(lfp + 4) = (f32x4){lf[4], lf[5], lf[6], lf[7]};
        *(f32x4*)omp = (f32x4){om[0], om[1], om[2], om[3]}; *(f32x4*)(omp + 4) = (f32x4){om[4], om[5], om[6], om[7]};
    }
    { const unsigned w[4] = {r.hv.x, r.hv.y, r.hv.z, r.hv.w};
#pragma unroll
      for (int j = 0; j < 4; ++j) { VT[hg_sw(8 * c + 2 * j, tok)] = (bf16_t)(w[j] & 0xffffu); VT[hg_sw(8 * c + 2 * j + 1, tok)] = (bf16_t)(w[j] >> 16); } }
}
DI void hg_prep2(Ctx& K) {
    float* LF = (float*)(K.lds + HGL_LF);
    __syncthreads();
    if (K.tid < 128) {
        const int dir = K.tid >> 6, d = K.tid & 63; float* col = LF + dir * 64 * HG_LFS + d;
        float carry = 0.f;
#pragma unroll
        for (int hf = 0; hf < 2; ++hf) { float v[32];
#pragma unroll
            for (int p = 0; p < 32; ++p) v[p] = col[(dir ? 63 - (32 * hf + p) : 32 * hf + p) * HG_LFS];
            v[0] += carry;
#pragma unroll
            for (int p = 1; p < 32; ++p) v[p] += v[p - 1];
#pragma unroll
            for (int p = 0; p < 32; ++p) col[(dir ? 63 - (32 * hf + p) : 32 * hf + p) * HG_LFS] = v[p];
            carry = v[31]; }
    }
    __syncthreads();
}
DI void hg_stage_consts(Ctx& K) {
    float* LBL = (float*)(K.lds + HGL_LB);
    for (int i = K.tid; i < 768; i += NTHREADS) LBL[i] = i < 512 ? K.LB()[((size_t)(i >> 8) * DEPTH + K.l) * 256 + (i & 255)] : ARG(hgrn_norm_w)[(size_t)K.l * 256 + (i - 512)];
}
DI void ph_hgrn_A(Ctx& K) {
    float* LF = (float*)(K.lds + HGL_LF); float* OM = (float*)(K.lds + HGL_OM); bf16_t* VT = (bf16_t*)(K.lds + HGL_VT); bf16_t* KT = (bf16_t*)(K.lds + HGL_KT);
    const int r16 = K.lane & 15, g4 = K.lane >> 4;
    if (K.bid >= HG_NIT) return;
    HgIn in; hg_load(K, K.bid, in);
    hg_stage_consts(K);
#pragma unroll 1
    for (int item = K.bid; item < HG_NIT; item += K.nb) {
        int b, h, tb; hg_item(item, b, h, tb);
        __syncthreads();
        hg_prep1(K, h, in);
        hg_load(K, item + K.nb < HG_NIT ? item + K.nb : item, in);
        hg_prep2(K);
        { const int tok = K.tid >> 3, c = K.tid & 7;
#pragma unroll
          for (int dir = 0; dir < 2; ++dir) {
              const float* bl = LF + (dir * 64 + (dir ? 0 : 63)) * HG_LFS + 8 * c; const float* bt = LF + (dir * 64 + tok) * HG_LFS + 8 * c; const float* om = OM + (dir * 64 + tok) * HG_LFS + 8 * c;
#pragma unroll
              for (int j = 0; j < 8; ++j) KT[dir * 64 * HG_TS + hg_sw(8 * c + j, tok)] = f2bf(om[j] * __expf(bl[j] - bt[j]));
          }
          if (K.tid < 128) { const int dir = K.tid >> 6, d = K.tid & 63; const int chain = (b * 2 + dir) * 4 + h, ch = dir ? hg_bwd_chunk(tb) : tb;
              K.AC()[((size_t)chain * HG_NCH + ch) * 64 + d] = __expf(LF[(dir * 64 + (dir ? 0 : 63)) * HG_LFS + d]); } }
        __syncthreads();
        { const int dir = K.wave >> 2, mi = K.wave & 3; const int chain = (b * 2 + dir) * 4 + h, ch = dir ? hg_bwd_chunk(tb) : tb;
          f32x4 acc[4];
#pragma unroll
          for (int db = 0; db < 4; ++db) acc[db] = (f32x4){0.f, 0.f, 0.f, 0.f};
#pragma unroll
          for (int ks = 0; ks < 2; ++ks) {
              const bf16x8_t vv = *(const bf16x8_t*)(VT + hg_sw(16 * mi + r16, 32 * ks + 8 * g4));
#pragma unroll
              for (int db = 0; db < 4; ++db) { const bf16x8_t kv = *(const bf16x8_t*)(KT + dir * 64 * HG_TS + hg_sw(16 * db + r16, 32 * ks + 8 * g4)); acc[db] = MFMA16(kv, vv, acc[db]); }
          }
          bf16_t* st = K.STB() + ((size_t)chain * HG_NCH + ch) * 4096 + (size_t)K.lane * 8;
#pragma unroll
          for (int ks = 0; ks < 2; ++ks) { const u32x4 w = (u32x4){pk2(acc[2 * ks][0], acc[2 * ks][1]), pk2(acc[2 * ks][2], acc[2 * ks][3]), pk2(acc[2 * ks + 1][0], acc[2 * ks + 1][1]), pk2(acc[2 * ks + 1][2], acc[2 * ks + 1][3])};
              *(u32x4*)(st + (mi * 2 + ks) * 512) = w; }
        }
    }
}
DI void ph_hgrn_B(Ctx& K) {
    const int per = ((16 * 2048 + K.nb - 1) / K.nb + 63) & ~63;
    const int gt = K.bid * per + K.tid;
    if (K.tid < per && gt < 16 * 2048) {
        const int chain = gt >> 11, dw = gt & 2047, m = dw & 3, lane = (dw >> 2) & 63, ks = (dw >> 8) & 1;
        const int d0 = 32 * ks + 16 * (m >> 1) + 4 * (lane >> 4) + 2 * (m & 1);
        unsigned* st = (unsigned*)(K.STB() + (size_t)chain * HG_NCH * 4096) + dw; const float* ac = K.AC() + (size_t)chain * HG_NCH * 64 + d0;
        float S0 = 0.f, S1 = 0.f;
#pragma unroll 1
        for (int c0 = 0; c0 < HG_NCH; c0 += 26) {
            unsigned u[26]; float a0[26], a1[26];
#pragma unroll
            for (int i = 0; i < 26; ++i) { u[i] = st[(size_t)(c0 + i) * 2048]; const u32x2 av = *(const u32x2*)(ac + (c0 + i) * 64); a0[i] = __uint_as_float(av.x); a1[i] = __uint_as_float(av.y); }
#pragma unroll
            for (int i = 0; i < 26; ++i) { st[(size_t)(c0 + i) * 2048] = pk2(S0, S1); S0 = a0[i] * S0 + __uint_as_float(u[i] << 16); S1 = a1[i] * S1 + __uint_as_float(u[i] & 0xffff0000u); }
        }
    }
}
struct HgInC { u32x2 q[2][2]; u32x4 gq; u32x4 st[8]; };
DI void ph_hgrn_C(Ctx& K) {
    float* LF = (float*)(K.lds + HGL_LF); float* OM = (float*)(K.lds + HGL_OM); bf16_t* VT = (bf16_t*)(K.lds + HGL_VT); bf16_t* KP = (bf16_t*)(K.lds + HGL_KT); float* OD = (float*)(K.lds + HGL_OD);
    bf16_t* SC = (bf16_t*)(K.lds + HGL_SC) + K.wave * 16 * HG_TS;
    const int r16 = K.lane & 15, g4 = K.lane >> 4, dir = K.wave >> 2, mi = K.wave & 3;
    if (K.bid >= HG_NIT) return;
    HgIn in; HgInC ic;
    hg_load(K, K.bid, in);
#define HGC_LOAD_Q(it_) do { int b_, h_, tb_; hg_item(it_, b_, h_, tb_); const bf16_t* qr = K.P() + (size_t)hg_block_row(b_, tb_, 16 * mi + r16) * PW + C_HQ + h_ * 64 + 4 * g4; \
        _Pragma("unroll") for (int ks = 0; ks < 2; ++ks) { ic.q[ks][0] = *(const u32x2*)(qr + 32 * ks); ic.q[ks][1] = *(const u32x2*)(qr + 32 * ks + 16); } } while (0)
#define HGC_LOAD_ST(it_) do { int b_, h_, tb_; hg_item(it_, b_, h_, tb_); const int chain_ = (b_ * 2 + dir) * 4 + h_, ch_ = dir ? hg_bwd_chunk(tb_) : tb_; \
        const bf16_t* sp = K.STB() + ((size_t)chain_ * HG_NCH + ch_) * 4096 + (size_t)K.lane * 8; _Pragma("unroll") for (int i_ = 0; i_ < 8; ++i_) ic.st[i_] = *(const u32x4*)(sp + i_ * 512); } while (0)
#define HGC_LOAD_G(it_) do { int b_, h_, tb_; hg_item(it_, b_, h_, tb_); const int tok_ = K.tid >> 3, c_ = K.tid & 7; \
        ic.gq = *(const u32x4*)(K.P() + (size_t)hg_block_row(b_, tb_, tok_) * PW + C_HG + h_ * 64 + 8 * c_); } while (0)
    HGC_LOAD_Q(K.bid); HGC_LOAD_ST(K.bid); HGC_LOAD_G(K.bid);
    hg_stage_consts(K);
#pragma unroll 1
    for (int item = K.bid; item < HG_NIT; item += K.nb) {
        int b, h, tb; hg_item(item, b, h, tb);
        const int nxt = item + K.nb < HG_NIT ? item + K.nb : item;
        __syncthreads();
        hg_prep1(K, h, in);
        hg_load(K, nxt, in);
        hg_prep2(K);
        {
          const int tok = K.tid >> 3, c = K.tid & 7;
#pragma unroll
          for (int dd = 0; dd < 2; ++dd) { const float* rf = LF + (dd * 64 + 32) * HG_LFS + 8 * c; const float* bs = LF + (dd * 64 + tok) * HG_LFS + 8 * c; const float* om = OM + (dd * 64 + tok) * HG_LFS + 8 * c;
              unsigned o[4];
#pragma unroll
              for (int j = 0; j < 4; ++j) o[j] = pk2(om[2 * j] * __expf(rf[2 * j] - bs[2 * j]), om[2 * j + 1] * __expf(rf[2 * j + 1] - bs[2 * j + 1]));
              *(u32x4*)(KP + (dd * 64 + tok) * HG_TS + 8 * c) = (u32x4){o[0], o[1], o[2], o[3]}; } }
        __syncthreads();
        f32x4 nw0, nw1;
        { const float* LFd = LF + dir * 64 * HG_LFS; const float* ref = LFd + 32 * HG_LFS;
          bf16x8_t aq1[2], aq2[2];
          { const int t = 16 * mi + r16;
#pragma unroll
            for (int ks = 0; ks < 2; ++ks) { unsigned o1[4], o2[4];
#pragma unroll
                for (int hf = 0; hf < 2; ++hf) { const int d0 = 32 * ks + 16 * hf + 4 * g4; const unsigned qw[2] = {ic.q[ks][hf].x, ic.q[ks][hf].y};
                    const f32x4 bt = *(const f32x4*)(LFd + t * HG_LFS + d0), rf = *(const f32x4*)(ref + d0);
#pragma unroll
                    for (int j = 0; j < 2; ++j) { const float qa = __uint_as_float(qw[j] << 16), qb = __uint_as_float(qw[j] & 0xffff0000u); const float sa = qa * sigmoidf_(qa), sb = qb * sigmoidf_(qb);
                        const float e1a = __expf(bt[2 * j] - rf[2 * j]), e1b = __expf(bt[2 * j + 1] - rf[2 * j + 1]), e2a = __expf(bt[2 * j]), e2b = __expf(bt[2 * j + 1]);
                        o1[2 * hf + j] = pk2(sa * e1a, sb * e1b); o2[2 * hf + j] = pk2(sa * e2a, sb * e2b); } }
                aq1[ks] = __builtin_bit_cast(bf16x8_t, (u32x4){o1[0], o1[1], o1[2], o1[3]}); aq2[ks] = __builtin_bit_cast(bf16x8_t, (u32x4){o2[0], o2[1], o2[2], o2[3]}); } }
          HGC_LOAD_Q(nxt);
          f32x4 sc[4];
#pragma unroll
          for (int nj = 0; nj < 4; ++nj) { sc[nj] = (f32x4){0.f, 0.f, 0.f, 0.f}; const bf16_t* kr = KP + (dir * 64 + 16 * nj + r16) * HG_TS + 4 * g4;
#pragma unroll
              for (int ks = 0; ks < 2; ++ks) { const u32x2 k0 = *(const u32x2*)(kr + 32 * ks), k1 = *(const u32x2*)(kr + 32 * ks + 16);
                  sc[nj] = MFMA16(aq1[ks], __builtin_bit_cast(bf16x8_t, (u32x4){k0.x, k0.y, k1.x, k1.y}), sc[nj]); } }
#pragma unroll
          for (int nj = 0; nj < 4; ++nj)
#pragma unroll
              for (int rg = 0; rg < 4; ++rg) { const int tl = 4 * g4 + rg, t = 16 * mi + tl, s_ = 16 * nj + r16; const bool keep = dir ? (s_ >= t) : (s_ <= t);
                  SC[tl * HG_TS + s_] = f2bf(keep ? sc[nj][rg] : 0.f); }
          asm volatile("s_waitcnt lgkmcnt(0)" ::: "memory");
          f32x4 oacc[4];
#pragma unroll
          for (int nj = 0; nj < 4; ++nj) oacc[nj] = (f32x4){0.f, 0.f, 0.f, 0.f};
#pragma unroll
          for (int ks = 0; ks < 2; ++ks) {
              const bf16x8_t as = *(const bf16x8_t*)(SC + r16 * HG_TS + 32 * ks + 8 * g4);
#pragma unroll
              for (int nj = 0; nj < 4; ++nj) {
                  const bf16x8_t bv = *(const bf16x8_t*)(VT + hg_sw(16 * nj + r16, 32 * ks + 8 * g4));
                  oacc[nj] = MFMA16(as, bv, oacc[nj]);
                  oacc[nj] = MFMA16(aq2[ks], __builtin_bit_cast(bf16x8_t, ic.st[nj * 2 + ks]), oacc[nj]);
              }
          }
          HGC_LOAD_ST(nxt);
          { const float* nwp = (const float*)(K.lds + HGL_LB) + 512 + h * 64 + 8 * (K.tid & 7); nw0 = *(const f32x4*)nwp; nw1 = *(const f32x4*)(nwp + 4); }
#pragma unroll
          for (int nj = 0; nj < 4; ++nj)
#pragma unroll
              for (int rg = 0; rg < 4; ++rg) OD[(dir * 64 + 16 * mi + 4 * g4 + rg) * HG_LFS + 16 * nj + r16] = oacc[nj][rg];
        }
        __syncthreads();
        { const int tok = K.tid >> 3, c = K.tid & 7; const int row = hg_block_row(b, tb, tok);
          const float* o0 = OD + tok * HG_LFS + 8 * c; const float* o1 = OD + (64 + tok) * HG_LFS + 8 * c;
          float o[8], ss = 0.f;
#pragma unroll
          for (int j = 0; j < 8; ++j) { o[j] = o0[j] + o1[j]; ss += o[j] * o[j]; }
          ss += __shfl_xor(ss, 1); ss += __shfl_xor(ss, 2); ss += __shfl_xor(ss, 4);
          const float rs = rsqrtf(ss * (1.0f / 64.0f) + EPS);
          float gq[8]; unpack8(ic.gq, gq);
          const float nw[8] = {nw0[0], nw0[1], nw0[2], nw0[3], nw1[0], nw1[1], nw1[2], nw1[3]};
          float y[8];
#pragma unroll
          for (int j = 0; j < 8; ++j) y[j] = o[j] * rs * nw[j] * gq[j] * sigmoidf_(gq[j]);
          HGC_LOAD_G(nxt);
          u32x4 w; w.x = pk2(y[0], y[1]); w.y = pk2(y[2], y[3]); w.z = pk2(y[4], y[5]); w.w = pk2(y[6], y[7]);
          *(u32x4*)(K.MIX() + (size_t)row * D + MX_H + h * 64 + 8 * c) = w; }
    }
#undef HGC_LOAD_Q
#undef HGC_LOAD_ST
#undef HGC_LOAD_G
}

constexpr int AT_TS = 72;
constexpr int ATL_K = 0, ATL_V = ATL_K + 64 * AT_TS * 2, ATL_P = ATL_V + 64 * AT_TS * 2, ATL_END = ATL_P + 8 * 48 * AT_TS * 2;
static_assert(ATL_END <= LDS_BYTES - 256, "attention LDS map");
DI float dpp_max16(float x) { x = fmaxf(x, dpp_<0xB1>(x)); x = fmaxf(x, dpp_<0x4E>(x)); x = fmaxf(x, dpp_<0x141>(x)); x = fmaxf(x, dpp_<0x128>(x)); return x; }
DI float dpp_sum16(float x) { x += dpp_<0xB1>(x); x += dpp_<0x4E>(x); x += dpp_<0x141>(x); x += dpp_<0x128>(x); return x; }
DI unsigned cvtpk(float lo, float hi) { unsigned r; asm("v_cvt_pk_bf16_f32 %0, %1, %2" : "=v"(r) : "v"(lo), "v"(hi)); return r; }
DI float xg4_max(float x) { x = fmaxf(x, __shfl_xor(x, 16)); x = fmaxf(x, __shfl_xor(x, 32)); return x; }
template <int MT, int NJ, bool SAMEKB> DI void at_pv(const unsigned (&pb)[MT][NJ / 2][4], f32x4 (&oacc)[MT][4], const bf16_t* VT, const int (&kb)[MT], int r16, int g4) {
#pragma unroll
    for (int ks = 0; ks < NJ / 2; ++ks)
#pragma unroll
        for (int ne = 0; ne < 4; ++ne) { const int e = 16 * ne + r16, sw = (e >> 3) & 7;
            u32x4 vf_shared;
            if (SAMEKB) { const int blk = (kb[0] >> 3) + 4 * ks + (g4 >> 1); const u32x2 v0 = *(const u32x2*)(VT + e * AT_TS + ((blk ^ sw) << 3) + 4 * (g4 & 1)), v1 = *(const u32x2*)(VT + e * AT_TS + (((blk + 2) ^ sw) << 3) + 4 * (g4 & 1));
                vf_shared = (u32x4){v0.x, v0.y, v1.x, v1.y}; }
#pragma unroll
            for (int mt = 0; mt < MT; ++mt) { u32x4 vf = vf_shared;
                if (!SAMEKB) { const int blk = (kb[mt] >> 3) + 4 * ks + (g4 >> 1); const u32x2 v0 = *(const u32x2*)(VT + e * AT_TS + ((blk ^ sw) << 3) + 4 * (g4 & 1)), v1 = *(const u32x2*)(VT + e * AT_TS + (((blk + 2) ^ sw) << 3) + 4 * (g4 & 1));
                    vf = (u32x4){v0.x, v0.y, v1.x, v1.y}; }
                oacc[mt][ne] = MFMA16(__builtin_bit_cast(bf16x8_t, vf), __builtin_bit_cast(bf16x8_t, (u32x4){pb[mt][ks][0], pb[mt][ks][1], pb[mt][ks][2], pb[mt][ks][3]}), oacc[mt][ne]); } }
}
template <int MT, int NJ, bool SAMEKB> DI void at_softmax_pv(f32x4 (&sT)[MT][NJ], float (&mrun)[MT], float (&lrun)[MT], f32x4 (&oacc)[MT][4], const bf16_t* VT, const int (&kb)[MT], int r16, int g4) {
    unsigned pb[MT][NJ / 2][4];
#pragma unroll
    for (int mt = 0; mt < MT; ++mt) {
        float mx = -INFINITY;
#pragma unroll
        for (int nj = 0; nj < NJ; ++nj) mx = fmaxf(mx, fmaxf(fmaxf(sT[mt][nj][0], sT[mt][nj][1]), fmaxf(sT[mt][nj][2], sT[mt][nj][3])));
        mx = xg4_max(mx) * 1.44269504f;
        const float mn = fmaxf(mrun[mt], mx), alpha = __builtin_amdgcn_exp2f(mrun[mt] - mn); mrun[mt] = mn;
        float rs_ = 0.f;
#pragma unroll
        for (int nj = 0; nj < NJ; ++nj)
#pragma unroll
            for (int rg = 0; rg < 4; ++rg) { const float pe = __builtin_amdgcn_exp2f(__builtin_fmaf(sT[mt][nj][rg], 1.44269504f, -mn)); sT[mt][nj][rg] = pe; rs_ += pe; }
        lrun[mt] = lrun[mt] * alpha + rs_;
#pragma unroll
        for (int ne = 0; ne < 4; ++ne) oacc[mt][ne] *= alpha;
#pragma unroll
        for (int ks = 0; ks < NJ / 2; ++ks) { pb[mt][ks][0] = cvtpk(sT[mt][2 * ks][0], sT[mt][2 * ks][1]); pb[mt][ks][1] = cvtpk(sT[mt][2 * ks][2], sT[mt][2 * ks][3]);
            pb[mt][ks][2] = cvtpk(sT[mt][2 * ks + 1][0], sT[mt][2 * ks + 1][1]); pb[mt][ks][3] = cvtpk(sT[mt][2 * ks + 1][2], sT[mt][2 * ks + 1][3]); }
    }
    at_pv<MT, NJ, SAMEKB>(pb, oacc, VT, kb, r16, g4);
}
template <int MT> DI void at_softmax_pv_nat(const f32x4 (&sT)[MT][2], float (&mrun)[MT], float (&lrun)[MT], f32x4 (&oacc)[MT][4], const bf16_t* VT, const int (&kb)[MT], const int (&qbase)[MT], const float* rp, int r16, int g4) {
    unsigned pb[MT][1][4];
#pragma unroll
    for (int mt = 0; mt < MT; ++mt) {
        const int c = qbase[mt] + r16, ws = min(max(c - 8, 0), 48), k00 = kb[mt] + 4 * g4;
        float v[4]; bool in0[4]; float mx = -INFINITY;
#pragma unroll
        for (int rg = 0; rg < 4; ++rg) { const int k0 = k00 + rg; in0[rg] = (unsigned)(k0 - ws) < 16u;
            v[rg] = (in0[rg] ? sT[mt][0][rg] : sT[mt][1][rg]) + rp[k0 - c + (in0[rg] ? 0 : 16)]; mx = fmaxf(mx, v[rg]); }
        mx = xg4_max(mx) * 1.44269504f;
        const float mn = fmaxf(mrun[mt], mx), alpha = __builtin_amdgcn_exp2f(mrun[mt] - mn); mrun[mt] = mn;
        float rs_ = 0.f, p0[4], p1[4];
#pragma unroll
        for (int rg = 0; rg < 4; ++rg) { const float pe = __builtin_amdgcn_exp2f(__builtin_fmaf(v[rg], 1.44269504f, -mn)); rs_ += pe; p0[rg] = in0[rg] ? pe : 0.f; p1[rg] = in0[rg] ? 0.f : pe; }
        lrun[mt] = lrun[mt] * alpha + rs_;
#pragma unroll
        for (int ne = 0; ne < 4; ++ne) oacc[mt][ne] *= alpha;
        pb[mt][0][0] = cvtpk(p0[0], p0[1]); pb[mt][0][1] = cvtpk(p0[2], p0[3]); pb[mt][0][2] = cvtpk(p1[0], p1[1]); pb[mt][0][3] = cvtpk(p1[2], p1[3]);
    }
    at_pv<MT, 2, false>(pb, oacc, VT, kb, r16, g4);
}
template <int KIND> DI void attn_item(Ctx& K, int idx, const float* sinkp, const float* rpbp) {
    constexpr int MT = KIND == 0 ? 3 : 2;
    int tid_ = K.tid; asm volatile("" : "+v"(tid_));
    const int lane_ = tid_ & 63, wave_ = tid_ >> 6;
    bf16_t* KT = (bf16_t*)(K.lds + ATL_K); bf16_t* VT = (bf16_t*)(K.lds + ATL_V); float* RPB = (float*)(K.lds + ATL_P);
    const int r16 = lane_ & 15, g4 = lane_ >> 4;
    int b, hk, qb = 0;
    if (KIND == 0) { qb = idx & 127; hk = (idx >> 7) & 1; b = idx >> 8; }
    else if (KIND == 1) { qb = idx & 63; hk = (idx >> 6) % 6; b = (idx >> 6) / 6; }
    else { hk = idx % 6; b = idx / 6; }
    const int kcol = (KIND == 0) ? C_SK + hk * 64 : (KIND == 2) ? C_SK + (hk / 3) * 64 : C_NK + hk * 64;
    const int vcol = (KIND == 0) ? C_SV + hk * 64 : (KIND == 2) ? C_SV + (hk / 3) * 64 : C_NV + hk * 64;
    int t0 = 0, nloc = 0;
    if (KIND == 0) { const int k0 = max(2 * qb - 2, 0), k1 = min(2 * qb + 3, L / 64 - 1); t0 = k0; nloc = k1 - k0 + 1; }
    if (KIND == 1) { const int k0 = min(max(4 * qb - 4, 0), L / 64 - 8), k1 = min(max(4 * qb + 3 - 4, 0), L / 64 - 8) + 7; t0 = k0; nloc = k1 - k0 + 1; }
    const int ntiles = nloc + CL / 64;
    int w_r = 0, w_rs = 0;
    if (KIND == 1) { w_r = 4 * qb + (wave_ >> 1); w_rs = min(max(w_r - 4, 0), L / 64 - 8); }
    bf16x8_t qf[MT][2]; int qbase[MT], hq_mt[MT], qrow[MT];
#pragma unroll
    for (int mt = 0; mt < MT; ++mt) {
        int arow, hq;
        if (KIND == 0) { const int rho = wave_ * 48 + mt * 16; hq = hk * 3 + rho / 128; hq_mt[mt] = hq; const int tb = 128 * qb + (rho & 127); arow = lat_row(b, tb + r16); qbase[mt] = tb; }
        else if (KIND == 1) { hq = hk; hq_mt[mt] = hq; const int cb = 32 * (wave_ & 1) + 16 * mt; arow = lat_row(b, w_r * 64 + cb + r16); qbase[mt] = cb; }
        else { hq = hk; hq_mt[mt] = hq; const int tb = wave_ * 32 + mt * 16; arow = ctx_row(b, tb + r16); qbase[mt] = 0; }
        qrow[mt] = arow;
        const int qcol = (KIND == 0 || KIND == 2) ? C_SQ + hq * 64 : C_NQ + hq * 64;
#pragma unroll
        for (int ks = 0; ks < 2; ++ks) { float q[8]; unpack8(*(const u32x4*)(K.P() + (size_t)arow * PW + qcol + 32 * ks + 8 * g4), q);
            const u32x4 w = (u32x4){pk2(q[0] * 0.125f, q[1] * 0.125f), pk2(q[2] * 0.125f, q[3] * 0.125f), pk2(q[4] * 0.125f, q[5] * 0.125f), pk2(q[6] * 0.125f, q[7] * 0.125f)};
            qf[mt][ks] = __builtin_bit_cast(bf16x8_t, w); }
    }
    f32x4 oacc[MT][4]; float mrun[MT], lrun[MT];
#pragma unroll
    for (int mt = 0; mt < MT; ++mt) {
#pragma unroll
        for (int ne = 0; ne < 4; ++ne) oacc[mt][ne] = (f32x4){0.f, 0.f, 0.f, 0.f};
        const bool has_sink = (KIND == 0 || KIND == 2);
        mrun[mt] = has_sink ? sinkp[hq_mt[mt]] * 1.44269504f : -1.0e30f; lrun[mt] = (has_sink && g4 == 0) ? 1.0f : 0.0f;
    }
    const int lkey = tid_ >> 3, lch = tid_ & 7;
    auto ldtile = [&](int tn, u32x4& pk, u32x4& pv) { const int tc = min(tn, ntiles - 1);
        const int grow = (tc < nloc) ? lat_row(b, (t0 + tc) * 64 + lkey) : ctx_row(b, (tc - nloc) * 64 + lkey);
        const bf16_t* pr = K.P() + (size_t)grow * PW + 8 * lch; pk = *(const u32x4*)(pr + kcol); pv = *(const u32x4*)(pr + vcol); };
    auto stage = [&](int ti, u32x4& pk, u32x4& pv) {
        __syncthreads();
        *(u32x4*)(KT + lkey * AT_TS + 8 * lch) = pk;
        { const unsigned w[4] = {pv.x, pv.y, pv.z, pv.w};
          const int vsw = (((lkey >> 3) ^ lch) << 3) + (lkey & 7);
#pragma unroll
          for (int j = 0; j < 4; ++j) { VT[(8 * lch + 2 * j) * AT_TS + vsw] = (bf16_t)(w[j] & 0xffffu); VT[(8 * lch + 2 * j + 1) * AT_TS + vsw] = (bf16_t)(w[j] >> 16); } }
        if (KIND == 1 && ti == 0 && tid_ < 15 * 31) RPB[tid_] = rpbp[tid_];
        ldtile(ti + 2, pk, pv);
        __syncthreads(); };
    auto compute = [&](int ti) {
        const bool local = ti < nloc; const int kunit = t0 + ti;
        if (KIND == 1 && local) {
            if ((kunit >= w_rs) && (kunit < w_rs + 8)) {
                f32x4 sT[MT][2]; int kb[MT];
#pragma unroll
                for (int mt = 0; mt < MT; ++mt) { kb[mt] = min(max(qbase[mt] - 8, 0), 32);
#pragma unroll
                    for (int nj = 0; nj < 2; ++nj) { sT[mt][nj] = (f32x4){0.f, 0.f, 0.f, 0.f};
#pragma unroll
                        for (int ks = 0; ks < 2; ++ks) { const bf16x8_t kf = *(const bf16x8_t*)(KT + (kb[mt] + 16 * nj + r16) * AT_TS + 32 * ks + 8 * g4); sT[mt][nj] = MFMA16(kf, qf[mt][ks], sT[mt][nj]); } } }
                const float* rp = RPB + (kunit - w_r + 7) * 31 + 15;
                at_softmax_pv_nat<MT>(sT, mrun, lrun, oacc, VT, kb, qbase, rp, r16, g4);
            }
        } else {
            f32x4 sT[MT][4];
#pragma unroll
            for (int mt = 0; mt < MT; ++mt)
#pragma unroll
                for (int nj = 0; nj < 4; ++nj) sT[mt][nj] = (f32x4){0.f, 0.f, 0.f, 0.f};
#pragma unroll
            for (int nj = 0; nj < 4; ++nj)
#pragma unroll
                for (int ks = 0; ks < 2; ++ks) { const bf16x8_t kf = *(const bf16x8_t*)(KT + (16 * nj + r16) * AT_TS + 32 * ks + 8 * g4);
#pragma unroll
                    for (int mt = 0; mt < MT; ++mt) sT[mt][nj] = MFMA16(kf, qf[mt][ks], sT[mt][nj]); }
            if (KIND == 0 && local) {
#pragma unroll
                for (int mt = 0; mt < MT; ++mt) { const int dq = qbase[mt] + r16 - kunit * 64 - 4 * g4;
#pragma unroll
                    for (int nj = 0; nj < 4; ++nj)
#pragma unroll
                        for (int rg = 0; rg < 4; ++rg) { const int dl = dq - (16 * nj + rg); if (dl > 128 || dl < -128) sT[mt][nj][rg] = -INFINITY; } }
            }
            int kb0[MT];
#pragma unroll
            for (int mt = 0; mt < MT; ++mt) kb0[mt] = 0;
            at_softmax_pv<MT, 4, true>(sT, mrun, lrun, oacc, VT, kb0, r16, g4);
        }
    };
    u32x4 pkA, pvA, pkB, pvB;
    ldtile(0, pkA, pvA); ldtile(1, pkB, pvB);
#pragma unroll 1
    for (int ti = 0; ti < ntiles; ti += 2) {
        stage(ti, pkA, pvA); compute(ti);
        stage(ti + 1, pkB, pvB); if (ti + 1 < ntiles) compute(ti + 1);
    }
#pragma unroll
    for (int mt = 0; mt < MT; ++mt) {
        float l = lrun[mt]; l += __shfl_xor(l, 16); l += __shfl_xor(l, 32);
        const float inv = 1.0f / l;
        const int ocol = ((KIND == 0 || KIND == 2) ? MX_S : MX_N) + hq_mt[mt] * 64;
#pragma unroll
        for (int ne = 0; ne < 4; ++ne) { u32x2 o; o.x = cvtpk(oacc[mt][ne][0] * inv, oacc[mt][ne][1] * inv); o.y = cvtpk(oacc[mt][ne][2] * inv, oacc[mt][ne][3] * inv);
            *(u32x2*)(K.MIX() + (size_t)qrow[mt] * D + ocol + 16 * ne + 4 * g4) = o; }
    }
}
DI void ph_attn(Ctx& K) {
    constexpr int N_SWA = NB * 2 * (L / 128), N_NAT = NB * 6 * (L / 256), N_C = NB * 6;
    const float* sinkp = ARG(swa_sink) + K.l * 6;
    for (int item = K.bid; item < N_SWA + N_NAT + 2 * N_C; item += K.nb) {
        if (item < N_SWA) attn_item<0>(K, item, sinkp, nullptr);
        else if (item < N_SWA + N_NAT) { const int it = item - N_SWA; const int h = (it >> 6) % 6; attn_item<1>(K, it, nullptr, ARG(nat_rpb) + ((size_t)K.l * 6 + h) * 15 * 31); }
        else if (item < N_SWA + N_NAT + N_C) attn_item<2>(K, item - N_SWA - N_NAT, sinkp, nullptr);
        else attn_item<3>(K, item - N_SWA - N_NAT - N_C, nullptr, nullptr);
    }
}

DI unsigned fkey(float f) { const unsigned u = __float_as_uint(f); return (u & 0x80000000u) ? ~u : (u | 0x80000000u); }
DI int mbcnt64(unsigned long long m) { return (int)__builtin_amdgcn_mbcnt_hi((unsigned)(m >> 32), __builtin_amdgcn_mbcnt_lo((unsigned)m, 0u)); }
template <int CTRL> DI int dppi_(int x) { return __builtin_amdgcn_mov_dpp(x, CTRL, 0xf, 0xf, true); }
DI int row_sum_i(int x) { x += dppi_<0xB1>(x); x += dppi_<0x4E>(x); x += dppi_<0x141>(x); x += dppi_<0x128>(x); return x; }
DI int row_excl_scan_i(int x) { int s_ = x; s_ += dppi_<0x111>(s_); s_ += dppi_<0x112>(s_); s_ += dppi_<0x114>(s_); s_ += dppi_<0x118>(s_); return s_ - x; }
DI unsigned row_minmax_u(unsigned x, bool want_max) {
    unsigned y;
    y = (unsigned)dppi_<0xB1>((int)x); x = want_max ? max(x, y) : min(x, y); y = (unsigned)dppi_<0x4E>((int)x); x = want_max ? max(x, y) : min(x, y);
    y = (unsigned)dppi_<0x141>((int)x); x = want_max ? max(x, y) : min(x, y); y = (unsigned)dppi_<0x128>((int)x); x = want_max ? max(x, y) : min(x, y);
    return x;
}
DI void ce_desc(unsigned& x, unsigned& y) { const unsigned hi = max(x, y), lo = min(x, y); x = hi; y = lo; }
DI void sort8_desc(unsigned (&a)[8]) {
    ce_desc(a[0], a[1]); ce_desc(a[2], a[3]); ce_desc(a[4], a[5]); ce_desc(a[6], a[7]); ce_desc(a[0], a[2]); ce_desc(a[1], a[3]); ce_desc(a[4], a[6]); ce_desc(a[5], a[7]);
    ce_desc(a[1], a[2]); ce_desc(a[5], a[6]); ce_desc(a[0], a[4]); ce_desc(a[3], a[7]); ce_desc(a[1], a[5]); ce_desc(a[2], a[6]); ce_desc(a[1], a[4]); ce_desc(a[3], a[6]);
    ce_desc(a[2], a[4]); ce_desc(a[3], a[5]); ce_desc(a[3], a[4]); }
DI void sort4_desc(unsigned (&a)[4]) { ce_desc(a[0], a[1]); ce_desc(a[2], a[3]); ce_desc(a[0], a[2]); ce_desc(a[1], a[3]); ce_desc(a[1], a[2]); }
DI float fkey_inv(unsigned k) { return __uint_as_float((k & 0x80000000u) ? (k & 0x7fffffffu) : ~k); }
constexpr int PSL_SK = 0, PSL_TOP = 131072;
static_assert(PSL_TOP + 8 * 1024 <= LDS_BYTES - 256, "peer select LDS map");
template <int PROBE> DI void ph_peer_select(Ctx& K) {
    float* TOPV = (float*)(K.lds + PSL_TOP + K.wave * 1024); int* TOPI = (int*)(TOPV + 128);
    const int r16 = K.lane & 15, g4 = K.lane >> 4, j16 = r16;
    const int nhg = K.nb < 8 ? K.nb : 8, grp = K.bid % nhg, jw = K.bid / nhg, nj = (K.nb - grp + nhg - 1) / nhg;
    constexpr int N_T = M / 16;
    const int nwv = nj * 8, wg = jw * 8 + K.wave;
    const int n_full = (N_T / nwv) * nwv, n_work = n_full + 4 * (N_T - n_full);
    for (int h = grp; h < 8; h += nhg) {
        __syncthreads();
        { const u32x4* sh = (const u32x4*)(K.SKH() + ((size_t)K.l * 8 + h) * 2 * 16384); const u32x4* sl = (const u32x4*)(K.SKL() + ((size_t)K.l * 8 + h) * 2 * 16384);
          u32x4* dst = (u32x4*)(K.lds + PSL_SK);
          u32x4 t[8];
#pragma unroll
          for (int i = 0; i < 8; ++i) t[i] = sh[K.tid + 512 * i];
#pragma unroll
          for (int i = 0; i < 8; ++i) dst[K.tid + 512 * i] = t[i];
#pragma unroll
          for (int i = 0; i < 8; ++i) t[i] = sl[K.tid + 512 * i];
#pragma unroll
          for (int i = 0; i < 8; ++i) dst[4096 + K.tid + 512 * i] = t[i]; }
        __syncthreads();
#pragma unroll 1
        for (int wk = wg; wk < n_work; wk += nwv) {
            const bool part = wk >= n_full; const int tile = part ? n_full + ((wk - n_full) >> 2) : wk; const int rg_lo = part ? ((wk - n_full) & 3) : 0, rg_hi = part ? rg_lo + 1 : 4;
            const int t0 = tile * 16;
            float S[2][8][4];
#pragma unroll
            for (int p = 0; p < 2; ++p) {
                bf16x8_t aq[4];
                { const bf16_t* qp = K.QP() + (size_t)(t0 + r16) * 2048 + h * 256 + p * 128 + 8 * g4;
#pragma unroll
                  for (int ks = 0; ks < 4; ++ks) aq[ks] = *(const bf16x8_t*)(qp + 32 * ks); }
                const unsigned char* kb = K.lds + PSL_SK + p * 32768 + K.lane * 16;
#pragma unroll
                for (int nt = 0; nt < 8; ++nt) {
                    f32x4 c0 = {0.f, 0.f, 0.f, 0.f}, c1 = c0;
#pragma unroll
                    for (int ks = 0; ks < 4; ++ks) { const bf16x8_t bh = *(const bf16x8_t*)(kb + (nt * 4 + ks) * 1024), bl = *(const bf16x8_t*)(kb + 65536 + (nt * 4 + ks) * 1024);
                        c0 = MFMA16(aq[ks], bh, c0); c1 = MFMA16(aq[ks], bl, c1); }
#pragma unroll
                    for (int rg = 0; rg < 4; ++rg) S[p][nt][rg] = c0[rg] + c1[rg];
                }
            }
            if (PROBE == 1) { float a = 0.f;
#pragma unroll
                for (int p = 0; p < 2; ++p)
#pragma unroll
                    for (int nt = 0; nt < 8; ++nt) a += S[p][nt][0] + S[p][nt][1] + S[p][nt][2] + S[p][nt][3];
                TOPV[K.lane] = a; continue; }
#pragma unroll 1
            for (int rg = 0; rg < 4; ++rg) {
                if (rg >= rg_lo && rg < rg_hi) {
                    unsigned a[2][8], mine[2] = {0u, 0u};
#pragma unroll
                    for (int p = 0; p < 2; ++p) {
#pragma unroll
                        for (int i = 0; i < 8; ++i) a[p][i] = (fkey(S[p][i][0]) & 0xFFFFFF80u) | (unsigned)(j16 + 16 * i);
                        sort8_desc(a[p]); }
#pragma unroll 1
                    for (int it = 0; it < 16; ++it) {
#pragma unroll
                        for (int p = 0; p < 2; ++p) { const unsigned m = row_minmax_u(a[p][0], true); const bool win = a[p][0] == m;
#pragma unroll
                            for (int i = 0; i < 7; ++i) a[p][i] = win ? a[p][i + 1] : a[p][i];
                            a[p][7] = win ? 0u : a[p][7];
                            mine[p] = (j16 == it) ? m : mine[p]; }
                    }
                    unsigned* TA = (unsigned*)TOPV + (g4 * 2) * 16; unsigned* TB = TA + 16;
                    TA[j16] = mine[0]; TB[j16] = mine[1];
                    asm volatile("s_waitcnt lgkmcnt(0)" ::: "memory");
                    { const int r = t0 + 4 * g4 + rg, t = j16;
                      int ci[4], cj[4];
                      ci[0] = 0; cj[0] = t;
                      ci[1] = t < 8 ? 1 : t; cj[1] = t < 8 ? t : 0;
                      ci[2] = t <= 4 ? 2 : t <= 8 ? 3 : t <= 11 ? 4 : t <= 13 ? 5 : 6; cj[2] = t <= 4 ? t : t <= 8 ? t - 5 : t <= 11 ? t - 9 : t <= 13 ? t - 12 : t - 14;
                      ci[3] = 7; cj[3] = t & 1;
                      unsigned c[4];
#pragma unroll
                      for (int q = 0; q < 4; ++q) { const float cv = fkey_inv(TA[ci[q]] & 0xFFFFFF80u) + fkey_inv(TB[cj[q]] & 0xFFFFFF80u); c[q] = (fkey(cv) & 0xFFFFFFC0u) | (unsigned)(t * 4 + q); }
                      if (t > 1) c[3] = 0u;
                      sort4_desc(c);
                      unsigned w = 0u;
#pragma unroll 1
                      for (int it = 0; it < 16; ++it) { const unsigned m = row_minmax_u(c[0], true); const bool win = c[0] == m;
                          c[0] = win ? c[1] : c[0]; c[1] = win ? c[2] : c[1]; c[2] = win ? c[3] : c[2]; c[3] = win ? 0u : c[3];
                          w = (j16 == it) ? m : w; }
                      const float val = fkey_inv(w & 0xFFFFFFC0u); const int tw = (int)(w >> 2) & 15, qw = (int)w & 3;
                      const int i2 = tw <= 4 ? 2 : tw <= 8 ? 3 : tw <= 11 ? 4 : tw <= 13 ? 5 : 6, j2 = tw <= 4 ? tw : tw <= 8 ? tw - 5 : tw <= 11 ? tw - 9 : tw <= 13 ? tw - 12 : tw - 14;
                      const int wi = qw == 0 ? 0 : qw == 1 ? (tw < 8 ? 1 : tw) : qw == 2 ? i2 : 7, wj = qw == 0 ? tw : qw == 1 ? (tw < 8 ? tw : 0) : qw == 2 ? j2 : (tw & 1);
                      const int e = (int)(TA[wi] & 127u) * 128 + (int)(TB[wj] & 127u);
                      const float mx = dpp_max16(val);
                      const float ex = __expf(val - mx), es = dpp_sum16(ex);
                      { const int pos = h * 16 + j16; K.PIDX16()[((size_t)r * 64 + (pos & 63)) * 2 + (pos >> 6)] = (unsigned short)e; K.PG()[(size_t)r * 128 + pos] = ex / es; }
                    }
                    asm volatile("s_waitcnt lgkmcnt(0)" ::: "memory");
                }
#pragma unroll
                for (int p = 0; p < 2; ++p)
#pragma unroll
                    for (int i = 0; i < 8; ++i) { S[p][i][0] = S[p][i][1]; S[p][i][1] = S[p][i][2]; S[p][i][2] = S[p][i][3]; }
            }
        }
    }
}

constexpr int PU_NR = 4;
constexpr int PUL_H = 0, PUL_SLOT = 2 * PU_NR * 1024, PUL_STRIDE = PUL_SLOT + (PU_NR * 128 + 32) * 8;
static_assert(8 * PUL_STRIDE <= LDS_BYTES - 256, "u pass LDS map");
struct PuMeta { float hs[PU_NR]; unsigned iab[PU_NR]; };
DI void pu_load(const Ctx& K, int r0, int step, PuMeta& m, unsigned char* hbuf) {
    int rr[PU_NR];
#pragma unroll
    for (int q = 0; q < PU_NR; ++q) rr[q] = min(r0 + q * step, M - 1);
    __builtin_amdgcn_global_load_lds((const unsigned*)(K.H8() + (size_t)rr[0] * D + K.lane * 16), (LAS unsigned*)hbuf, 16, 0, 0);
    __builtin_amdgcn_global_load_lds((const unsigned*)(K.H8() + (size_t)rr[1] * D + K.lane * 16 - 1024), (LAS unsigned*)hbuf, 16, 1024, 0);
    __builtin_amdgcn_global_load_lds((const unsigned*)(K.H8() + (size_t)rr[2] * D + K.lane * 16 - 2048), (LAS unsigned*)hbuf, 16, 2048, 0);
    __builtin_amdgcn_global_load_lds((const unsigned*)(K.H8() + (size_t)rr[3] * D + K.lane * 16 - 3072), (LAS unsigned*)hbuf, 16, 3072, 0);
#pragma unroll
    for (int q = 0; q < PU_NR; ++q) { m.hs[q] = K.HS()[rr[q]]; m.iab[q] = K.PIDX32()[(size_t)rr[q] * 64 + K.lane]; }
}
typedef int i32x4 __attribute__((ext_vector_type(4)));
DI int sel4i(const i32x4 v, int k) { return k == 0 ? v[0] : k == 1 ? v[1] : k == 2 ? v[2] : v[3]; }
template <int PROBE> DI void pu_item(const Ctx& K, const unsigned char* U, unsigned char* HL, int* SLOT, int R, int r0, int step, const PuMeta& m, int r16, int g4, float& dummy) {
    bool sa[PU_NR], sb[PU_NR]; int ra[PU_NR], rb[PU_NR]; int n = 0;
    int eia[PU_NR], eib[PU_NR];
#pragma unroll
    for (int q = 0; q < PU_NR; ++q) { eia[q] = (int)(m.iab[q] & 0xffffu); eib[q] = (int)(m.iab[q] >> 16); }
#pragma unroll
    for (int q = 0; q < PU_NR; ++q) { const bool live = r0 + q * step < M; sa[q] = live && (eia[q] >> 11) == R; sb[q] = live && (eib[q] >> 11) == R; const unsigned long long ma = __ballot(sa[q]), mb = __ballot(sb[q]);
        ra[q] = n + mbcnt64(ma); n += __popcll(ma); rb[q] = n + mbcnt64(mb); n += __popcll(mb); }
    const int E = r16 >> 2, qq = r16 & 3, rho = r16 >> 2;
    const float hsm = rho == 0 ? m.hs[0] : rho == 1 ? m.hs[1] : rho == 2 ? m.hs[2] : m.hs[3];
#pragma unroll
    for (int q = 0; q < PU_NR; ++q) {
        if (sa[q]) { SLOT[2 * ra[q]] = eia[q]; SLOT[2 * ra[q] + 1] = q * 128 + K.lane; }
        if (sb[q]) { SLOT[2 * rb[q]] = eib[q]; SLOT[2 * rb[q] + 1] = q * 128 + 64 + K.lane; } }
    asm volatile("s_waitcnt lgkmcnt(0)" ::: "memory");
#pragma unroll 1
    for (int base = 0; base < n; base += 32) {
        const int* SLB = SLOT + 2 * base;
        const bool two = base + 16 < n;
        i32x4 av[8][4];
#pragma unroll
        for (int t = 0; t < 4; ++t) { const int sl = 4 * t + E; const int e = (base + sl < n) ? SLB[2 * sl] : SLOT[0]; const unsigned char* up = U + ((unsigned)e * (unsigned)D + (unsigned)(64 * g4 + 16 * qq));
#pragma unroll
            for (int s_ = 0; s_ < 4; ++s_) av[t][s_] = *(const i32x4*)(up + 256 * s_); }
        if (two) {
#pragma unroll
            for (int t = 4; t < 8; ++t) { const int sl = 4 * t + E; const int e = (base + sl < n) ? SLB[2 * sl] : SLOT[0]; const unsigned char* up = U + ((unsigned)e * (unsigned)D + (unsigned)(64 * g4 + 16 * qq));
#pragma unroll
                for (int s_ = 0; s_ < 4; ++s_) av[t][s_] = *(const i32x4*)(up + 256 * s_); } }
        bool fin[2]; int fcode[2]; float fus[2], fvs[2], fpg[2];
#pragma unroll
        for (int p2 = 0; p2 < 2; ++p2) { const int sl = 4 * (4 * p2 + qq) + g4; fin[p2] = false; fcode[p2] = 0; fus[p2] = 0.f; fvs[p2] = 0.f; fpg[p2] = 0.f;
            if (base + sl < n) { const int code = SLB[2 * sl + 1];
                if ((code >> 7) == rho) { const size_t eo = (size_t)K.l * 16384 + SLB[2 * sl]; fin[p2] = true; fcode[p2] = code; fus[p2] = K.US()[eo]; fvs[p2] = K.VS()[eo]; fpg[p2] = K.PG()[(size_t)(r0 + (code >> 7) * step) * 128 + (code & 127)]; } } }
        i32x4 hb[4];
#pragma unroll
        for (int s_ = 0; s_ < 4; ++s_) hb[s_] = *(const i32x4*)(HL + rho * 1024 + 64 * g4 + 16 * qq + 256 * s_);
        int w0, w1 = 0;
        { int rs[4];
#pragma unroll
          for (int t = 0; t < 4; ++t) { i32x4 acc = {0, 0, 0, 0};
#pragma unroll
              for (int s_ = 0; s_ < 4; ++s_) acc = __builtin_amdgcn_mfma_i32_16x16x64_i8(av[t][s_], hb[s_], acc, 0, 0, 0);
              int v = sel4i(acc, qq); v += dppi_<0xB1>(v); v += dppi_<0x4E>(v); rs[t] = v; }
          w0 = qq == 0 ? rs[0] : qq == 1 ? rs[1] : qq == 2 ? rs[2] : rs[3]; }
        if (two) { int rs[4];
#pragma unroll
            for (int t = 0; t < 4; ++t) { i32x4 acc = {0, 0, 0, 0};
#pragma unroll
                for (int s_ = 0; s_ < 4; ++s_) acc = __builtin_amdgcn_mfma_i32_16x16x64_i8(av[4 + t][s_], hb[s_], acc, 0, 0, 0);
                int v = sel4i(acc, qq); v += dppi_<0xB1>(v); v += dppi_<0x4E>(v); rs[t] = v; }
            w1 = qq == 0 ? rs[0] : qq == 1 ? rs[1] : qq == 2 ? rs[2] : rs[3]; }
#pragma unroll
        for (int p2 = 0; p2 < 2; ++p2) {
            const int di = p2 ? w1 : w0;
            if (fin[p2]) { const int code = fcode[p2];
                const float d = (float)di * fus[p2] * hsm;
                const int pos = code & 127;
                K.W16()[((size_t)(r0 + (code >> 7) * step) * 64 + (pos & 63)) * 2 + (pos >> 6)] = f2bf(fpg[p2] * gelu_erf(d) * fvs[p2]); (void)dummy; }
        }
        asm volatile("s_waitcnt lgkmcnt(0)" ::: "memory");
    }
}
#define PU_TOUCH(m_) asm volatile("" :: "v"(m_.hs[0]), "v"(m_.hs[1]), "v"(m_.hs[2]), "v"(m_.hs[3]), "v"(m_.iab[0]), "v"(m_.iab[1]), "v"(m_.iab[2]), "v"(m_.iab[3]))
template <int PROBE> DI void ph_peer_u(Ctx& K) {
    const unsigned char* U = (const unsigned char*)K.UB() + (size_t)K.l * 16384 * D;
    unsigned char* HB = K.lds + K.wave * PUL_STRIDE; int* SLOT = (int*)(HB + PUL_SLOT);
    const int r16 = K.lane & 15, g4 = K.lane >> 4;
    const int step = K.nloc * NWAVES;
    float dummy = 0.f;
    for (int R = K.xg; R < 8; R += K.nxg) {
        int r = K.jx * NWAVES + K.wave; int par = 0;
        PuMeta mA, mB; (void)par;
        pu_load(K, r, step, mA, HB);
#pragma unroll 1
        for (; r < M; r += 2 * PU_NR * step) {
            asm volatile("s_waitcnt vmcnt(0)" ::: "memory");
            PU_TOUCH(mA);
            pu_load(K, r + PU_NR * step, step, mB, HB + PU_NR * 1024);
            pu_item<PROBE>(K, U, HB, SLOT, R, r, step, mA, r16, g4, dummy);
            asm volatile("s_waitcnt vmcnt(0)" ::: "memory");
            PU_TOUCH(mB);
            pu_load(K, r + 2 * PU_NR * step, step, mA, HB);
            pu_item<PROBE>(K, U, HB + PU_NR * 1024, SLOT, R, r + PU_NR * step, step, mB, r16, g4, dummy);
        }
    }
}
struct PvMeta { unsigned iab, wab; };
template <int PROBE> DI void pv_load(const Ctx& K, int r, PvMeta& m) {
    m.iab = K.PIDX32()[(size_t)r * 64 + K.lane]; m.wab = K.W32()[(size_t)r * 64 + K.lane];
}
template <int HALF, int PROBE> DI void pv_issue(const unsigned char* V, int slot, unsigned coff, const PvMeta& m, u32x4 (&vv)[8]) {
    const int ix = HALF ? (int)(m.iab >> 16) : (int)(m.iab & 0xffffu);
#pragma unroll
    for (int i = 0; i < 8; ++i) {
        const int src = ((8 * i + slot) << 2);
        const int e = __builtin_amdgcn_ds_bpermute(src, ix);
        vv[i] = PROBE == 2 ? (u32x4){(unsigned)e, 1u, 2u, 3u} : *(const u32x4*)(V + ((unsigned)e * 128u + coff));
    }
}
DI void tr4x4(unsigned x0, unsigned x1, unsigned x2, unsigned x3, unsigned (&o)[4]) {
    const unsigned a = __builtin_amdgcn_perm(x1, x0, 0x05010400u), b = __builtin_amdgcn_perm(x1, x0, 0x07030602u), c = __builtin_amdgcn_perm(x3, x2, 0x05010400u), d = __builtin_amdgcn_perm(x3, x2, 0x07030602u);
    o[0] = __builtin_amdgcn_perm(c, a, 0x05040100u); o[1] = __builtin_amdgcn_perm(c, a, 0x07060302u); o[2] = __builtin_amdgcn_perm(d, b, 0x05040100u); o[3] = __builtin_amdgcn_perm(d, b, 0x07060302u);
}
DI unsigned u4(const u32x4& v, int d) { return d == 0 ? v.x : d == 1 ? v.y : d == 2 ? v.z : v.w; }
DI float pv_weights(const PvMeta& m, unsigned char* WQ, int lane) {
    const float wa = __uint_as_float(m.wab << 16), wb = __uint_as_float(m.wab & 0xffff0000u);
    float mx = fmaxf(fabsf(wa), fabsf(wb));
    mx = dpp_max16(mx); mx = fmaxf(mx, __shfl_xor(mx, 16)); mx = fmaxf(mx, __shfl_xor(mx, 32));
    const float s_hi = fmaxf(mx, 1e-30f) * (1.0f / 127.0f), i_hi = 1.0f / s_hi, s_lo = s_hi * (1.0f / 254.0f), i_lo = 254.0f * i_hi;
    const float ha = rintf(wa * i_hi), hb = rintf(wb * i_hi);
    const int la = (int)rintf((wa - ha * s_hi) * i_lo), lb = (int)rintf((wb - hb * s_hi) * i_lo);
    const int i = lane >> 3, sl = lane & 7; unsigned char* wp = WQ + (((sl & 1) * 4 + (sl >> 1)) << 4) + i;
    wp[0] = (unsigned char)(int)ha; wp[8] = (unsigned char)(int)hb; wp[128] = (unsigned char)la; wp[136] = (unsigned char)lb;
    return s_lo;
}
template <int PROBE> DI void ph_peer_v(Ctx& K) {
    const int slot = K.lane >> 3, c = K.lane & 7;
    const float* gate = K.MOD() + (size_t)K.l * 3 * 6 * D + 5 * D;
    const int step = K.nloc * NWAVES;
    bf16_t* Xb = K.XB();
    unsigned char* WQ = K.lds + K.wave * 256;
    float* GPL = (float*)(K.lds + 8 * 256);
    for (int S = K.xg; S < 8; S += K.nxg) {
        const unsigned char* V = (const unsigned char*)K.VB() + ((size_t)K.l * 8 + S) * 16384 * 128;
        const int c0 = S * 128 + c * 16;
        __syncthreads();
        for (int i = K.tid; i < 3 * 128; i += NTHREADS) GPL[i] = gate[(size_t)(i >> 7) * 6 * D + S * 128 + (i & 127)];
        __syncthreads();
        const int r0 = K.jx * NWAVES + K.wave;
        const int nit = r0 < M ? (M - 1 - r0) / step + 1 : 0;
        PvMeta mA, mB; pv_load<PROBE>(K, min(r0, M - 1), mA); pv_load<PROBE>(K, min(r0 + step, M - 1), mB);
        u32x4 xq[2], xprev[2], x2[2]; float yp[16]; int rp = -1; PvMeta m2;
#pragma unroll
        for (int q = 0; q < 2; ++q) { xq[q] = *(const u32x4*)(Xb + (size_t)min(r0, M - 1) * D + c0 + 8 * q); xprev[q] = (u32x4){0u, 0u, 0u, 0u}; }
#pragma unroll
        for (int q = 0; q < 16; ++q) yp[q] = 0.f;
#define PV_BODY(XPREV, XQ, XNEW, MA, MC, IT) do { \
            const int r = r0 + (IT) * step; \
            { const float zdep = __uint_as_float(MA.wab << 16) * 0.0f; \
                f32x4 gp[4]; { const f32x4* gl = (const f32x4*)(GPL + modvec_of_row(max(rp, 0)) * 128 + (K.lane & 7) * 16); _Pragma("unroll") for (int q = 0; q < 4; ++q) gp[q] = gl[q]; } \
                u32x4 xo[2]; \
                _Pragma("unroll") for (int q = 0; q < 4; ++q) { const unsigned w0_ = u4(XPREV[q >> 1], 2 * (q & 1)), w1_ = u4(XPREV[q >> 1], 2 * (q & 1) + 1); \
                    const float n0 = __uint_as_float(w0_ << 16) + gp[q].x * yp[4 * q] + zdep, n1 = __uint_as_float(w0_ & 0xffff0000u) + gp[q].y * yp[4 * q + 1] + zdep; \
                    const float n2 = __uint_as_float(w1_ << 16) + gp[q].z * yp[4 * q + 2] + zdep, n3 = __uint_as_float(w1_ & 0xffff0000u) + gp[q].w * yp[4 * q + 3] + zdep; \
                    const unsigned p0 = cvtpk(n0, n1), p1 = cvtpk(n2, n3); \
                    if ((q & 1) == 0) { xo[q >> 1].x = p0; xo[q >> 1].y = p1; } else { xo[q >> 1].z = p0; xo[q >> 1].w = p1; } } \
                if (rp >= 0 && slot == 0) { bf16_t* xr = Xb + (size_t)rp * D + c0; \
                    _Pragma("unroll") for (int q = 0; q < 2; ++q) *(u32x4*)(xr + 8 * q) = xo[q]; } } \
            __builtin_amdgcn_sched_barrier(0); \
            const float s_lo = pv_weights(MA, WQ, K.lane); \
            u32x4 vA[8], vB[8]; \
            pv_issue<0, PROBE>(V, slot, (unsigned)c * 16u, MA, vA); \
            pv_issue<1, PROBE>(V, slot, (unsigned)c * 16u, MA, vB); \
            __builtin_amdgcn_sched_barrier(0); \
            { const bf16_t* xr = Xb + (size_t)min(r + step, M - 1) * D + c0; \
              _Pragma("unroll") for (int q = 0; q < 2; ++q) XNEW[q] = *(const u32x4*)(xr + 8 * q); } \
            pv_load<PROBE>(K, min(r + 2 * step, M - 1), MC); \
            __builtin_amdgcn_sched_barrier(0); \
            const i32x4 wq = *(const i32x4*)(WQ + ((((K.lane & 3) << 2) + (K.lane >> 4)) << 4)); \
            _Pragma("unroll") for (int d = 0; d < 4; ++d) { unsigned t0[4], t1[4], t2[4], t3[4]; \
                tr4x4(u4(vA[0], d), u4(vA[1], d), u4(vA[2], d), u4(vA[3], d), t0); tr4x4(u4(vA[4], d), u4(vA[5], d), u4(vA[6], d), u4(vA[7], d), t1); \
                tr4x4(u4(vB[0], d), u4(vB[1], d), u4(vB[2], d), u4(vB[3], d), t2); tr4x4(u4(vB[4], d), u4(vB[5], d), u4(vB[6], d), u4(vB[7], d), t3); \
                _Pragma("unroll") for (int bb = 0; bb < 4; ++bb) { const i32x4 bj = {(int)t0[bb], (int)t1[bb], (int)t2[bb], (int)t3[bb]}; \
                    const i32x4 dd = __builtin_amdgcn_mfma_i32_16x16x64_i8(wq, bj, (i32x4){0, 0, 0, 0}, 0, 0, 0); \
                    const int te = __mul24(dd[0], 254) + dd[2], to = __mul24(dd[1], 254) + dd[3];        \
                    const int tt = te + dppi_<0x128>(to);                                                    \
                    yp[4 * d + bb] = (float)tt * s_lo; } \
                __builtin_amdgcn_sched_barrier(0); } \
            rp = r; } while (0)
        int it = 0;
#pragma unroll 1
        for (; it + 2 < nit; it += 3) {
            PV_BODY(xprev, xq, x2, mA, m2, it);
            PV_BODY(xq, x2, xprev, mB, mA, it + 1);
            PV_BODY(x2, xprev, xq, m2, mB, it + 2);
        }
        if (it < nit) { PV_BODY(xprev, xq, x2, mA, m2, it); ++it;
            if (it < nit) { PV_BODY(xq, x2, xprev, mB, mA, it); ++it;
#pragma unroll
                for (int q = 0; q < 2; ++q) xprev[q] = x2[q]; }
            else {
#pragma unroll
                for (int q = 0; q < 2; ++q) xprev[q] = xq[q]; } }
#undef PV_BODY
        if (rp >= 0) { const int mv = modvec_of_row(rp); f32x4 gp[4];
#pragma unroll
            for (int q = 0; q < 4; ++q) gp[q] = *(const f32x4*)(gate + (size_t)mv * 6 * D + c0 + 4 * q);
            if (slot == 0) { bf16_t* xr = Xb + (size_t)rp * D + c0; u32x4 xo[2];
#pragma unroll
                for (int q = 0; q < 4; ++q) { const unsigned w0_ = u4(xprev[q >> 1], 2 * (q & 1)), w1_ = u4(xprev[q >> 1], 2 * (q & 1) + 1);
                    const unsigned p0 = cvtpk(__uint_as_float(w0_ << 16) + gp[q].x * yp[4 * q], __uint_as_float(w0_ & 0xffff0000u) + gp[q].y * yp[4 * q + 1]);
                    const unsigned p1 = cvtpk(__uint_as_float(w1_ << 16) + gp[q].z * yp[4 * q + 2], __uint_as_float(w1_ & 0xffff0000u) + gp[q].w * yp[4 * q + 3]);
                    if ((q & 1) == 0) { xo[q >> 1].x = p0; xo[q >> 1].y = p1; } else { xo[q >> 1].z = p0; xo[q >> 1].w = p1; } }
#pragma unroll
                for (int q = 0; q < 2; ++q) *(u32x4*)(xr + 8 * q) = xo[q]; } }
    }
}

DI void ph_final(Ctx& K) {
    u32x2 vn[4]; f32x4 w[4];
#pragma unroll
    for (int j = 0; j < 4; ++j) w[j] = ((const f32x4*)ARG(final_norm_w))[j * 64 + K.lane];
    { const u32x2* xr = (const u32x2*)(K.XB() + (size_t)(NCTX + min(K.gw, NLAT - 1)) * D);
#pragma unroll
      for (int j = 0; j < 4; ++j) vn[j] = xr[j * 64 + K.lane]; }
    float* outp = (float*)argp_<float>(K, (unsigned)__builtin_offsetof(Args, out));
#pragma unroll 1
    for (int r = K.gw; r < NLAT; r += K.ngw) {
        f32x4* o = (f32x4*)(outp + (size_t)r * D);
        f32x4 v[4]; float ss = 0.f;
#pragma unroll
        for (int j = 0; j < 4; ++j) { v[j] = (f32x4){__uint_as_float(vn[j].x << 16), __uint_as_float(vn[j].x & 0xffff0000u), __uint_as_float(vn[j].y << 16), __uint_as_float(vn[j].y & 0xffff0000u)};
            ss += v[j].x * v[j].x + v[j].y * v[j].y + v[j].z * v[j].z + v[j].w * v[j].w; }
        { const u32x2* xr = (const u32x2*)(K.XB() + (size_t)(NCTX + min(r + K.ngw, NLAT - 1)) * D);
#pragma unroll
          for (int j = 0; j < 4; ++j) vn[j] = xr[j * 64 + K.lane]; }
        ss = wave_sum(ss); const float rs = rsqrtf(ss * (1.0f / D) + EPS);
#pragma unroll
        for (int j = 0; j < 4; ++j) o[j * 64 + K.lane] = v[j] * rs * w[j];
    }
}

#define XB_TMO      128
#define XB_XSUB(j)  (1280 + 64 * (j))
#define XB_XGEN(j)  (2304 + 64 * (j))
#define XB_TOP      3328
#define XB_TOPGEN   3392
#define XB_SPIN_CAP (1u << 22)
constexpr int CW_BAR = 4096;
DI unsigned xb_ld(unsigned* p)              { return __hip_atomic_load(p, __ATOMIC_RELAXED, __HIP_MEMORY_SCOPE_AGENT); }
DI unsigned xb_add(unsigned* p, unsigned v) { return __hip_atomic_fetch_add(p, v, __ATOMIC_RELAXED, __HIP_MEMORY_SCOPE_AGENT); }
#define XB_SPIN(cond, bar) do { unsigned _sp = 0; while (cond) { __builtin_amdgcn_s_sleep(1); \
    if ((++_sp & 255u) == 0u) { if (xb_ld(&(bar)[XB_TMO])) break; if (_sp > XB_SPIN_CAP) { atomicAdd(&(bar)[XB_TMO], 1u); break; } } } } while (0)
DI void xcd_barrier(unsigned* bar, unsigned x, unsigned nloc, unsigned nx, int tid) {
    asm volatile("s_waitcnt vmcnt(0)" ::: "memory");
    __syncthreads();
    if (tid == 0) {
        __builtin_amdgcn_s_waitcnt(0);
        const unsigned old = xb_add(&bar[XB_XSUB(x)], 1u);
        const unsigned gen = old / nloc;
        if (old + 1u == (gen + 1u) * nloc) {
            __builtin_amdgcn_fence(__ATOMIC_RELEASE, "agent");
            asm volatile("s_waitcnt vmcnt(0)" ::: "memory");
            const unsigned og = xb_add(&bar[XB_TOP], 1u);
            const unsigned tg = og / nx;
            if (og + 1u == (tg + 1u) * nx) xb_add(&bar[XB_TOPGEN], 1u);
            else XB_SPIN(xb_ld(&bar[XB_TOPGEN]) == tg, bar);
            __builtin_amdgcn_fence(__ATOMIC_ACQUIRE, "agent");
            xb_add(&bar[XB_XGEN(x)], 1u);
            asm volatile("s_waitcnt vmcnt(0)" ::: "memory");
        } else {
            XB_SPIN(xb_ld(&bar[XB_XGEN(x)]) == gen, bar);
            __builtin_amdgcn_fence(__ATOMIC_ACQUIRE, "agent");
            asm volatile("s_waitcnt vmcnt(0)" ::: "memory");
        }
    }
    __syncthreads();
}

constexpr int PROBE_U = 0, PROBE_V = 0, PROBE_S = 0;
constexpr unsigned DUP_MASK = 0u;
constexpr int PH_PER_LAYER = 12, N_PHASES = 2 + PH_PER_LAYER * DEPTH;
__global__ void __launch_bounds__(NTHREADS) mk_fwd(Args args) {
    extern __shared__ __attribute__((aligned(16))) unsigned char lds[];
    cg::grid_group grid = cg::this_grid();
    constexpr unsigned ARGS_OFF = LDS_BYTES - 256;
    constexpr unsigned MISC_OFF = LDS_BYTES - 64;
    if (threadIdx.x == 0) {
        *(Args*)(lds + ARGS_OFF) = args;
        unsigned* ctl = (unsigned*)(args.ws + WS_CTL); unsigned* misc = (unsigned*)(lds + MISC_OFF);
        const unsigned xcc = (unsigned)__builtin_amdgcn_s_getreg((3 << 11) | 20) & 0xFu;
        misc[0] = xcc; misc[1] = __hip_atomic_fetch_add(ctl + 64 * xcc, 1u, __ATOMIC_RELAXED, __HIP_MEMORY_SCOPE_AGENT);
    }
    __syncthreads();
    const int wid_s = __builtin_amdgcn_readfirstlane((int)threadIdx.x >> 6);
    int rep = 0;
#pragma unroll 1
    for (int ph = 0; ph < N_PHASES; ++ph) {
        unsigned ones = ~0u; asm volatile("" : "+s"(ones));
        int tid = (wid_s << 6) | (int)__builtin_amdgcn_mbcnt_hi(ones, __builtin_amdgcn_mbcnt_lo(ones, 0u)); asm volatile("" : "+v"(tid));
        unsigned aoff = ARGS_OFF; asm volatile("" : "+v"(aoff));
        size_t zoff = 0; asm volatile("" : "+s"(zoff));
        unsigned char* ws = args.ws + zoff;
        int bid = blockIdx.x; asm volatile("" : "+s"(bid)); int nb = gridDim.x; asm volatile("" : "+s"(nb));
        unsigned moff = MISC_OFF; asm volatile("" : "+v"(moff));
        Ctx K; unsigned xcc_s; { const unsigned* misc = (const unsigned*)(lds + moff); xcc_s = __builtin_amdgcn_readfirstlane(misc[0]); K.jx = __builtin_amdgcn_readfirstlane(misc[1]); K.xg = __builtin_amdgcn_readfirstlane(misc[2]); K.nxg = __builtin_amdgcn_readfirstlane(misc[3]); K.nloc = __builtin_amdgcn_readfirstlane(misc[4]); }
        K.aoff = aoff; K.lds = lds; K.tid = tid; K.lane = tid & 63; K.wave = tid >> 6; K.bid = bid; K.nb = nb; K.gw = bid * NWAVES + K.wave; K.ngw = nb * NWAVES;
        K.ws = ws;
        const int l = ph == 0 ? 0 : (ph - 1) / PH_PER_LAYER, k = ph == 0 ? -1 : (ph == N_PHASES - 1 ? -2 : (ph - 1) % PH_PER_LAYER);
        K.l = l;
        if (k == -1) ph_prologue(K);
        else if (k == -2) ph_final(K);
        else if (k == 0) ph_norm(K, ARG(norm_mix_w) + (size_t)l * D, 0);
        else if (k == 1) ph_gemm_store(K, K.H(), K.WIN() + (size_t)l * PW * D, PW, K.P(), K.ROPE());
        else if (k == 2) ph_hgrn_A(K);
        else if (k == 3) ph_attn(K);
        else if (k == 4) ph_hgrn_B(K);
        else if (k == 5) ph_hgrn_C(K);
        else if (k == 6) ph_gemm_resid(K, K.MIX(), K.WOUT() + (size_t)l * D * D, 2);
        else if (k == 7) ph_norm(K, ARG(norm_ffn_w) + (size_t)l * D, 3);
        else if (k == 8) ph_gemm_store(K, K.H(), K.WQ() + (size_t)l * 2048 * D, 2048, K.QP(), nullptr);
        else if (k == 9) { ph_peer_select<0>(K); if (PROBE_S) ph_peer_select<PROBE_S>(K); }
        else if (k == 10) { ph_peer_u<0>(K); if (PROBE_U) ph_peer_u<PROBE_U>(K); }
        else if (k == 11) { ph_peer_v<0>(K); if (PROBE_V) ph_peer_v<PROBE_V>(K); }
        if (k >= 0 && ((DUP_MASK >> k) & 1u)) { ++rep; if (rep < 2) { --ph; continue; } } rep = 0;
        if (ph == 0) grid.sync();
        else if (k != 2 && ph != N_PHASES - 1) xcd_barrier((unsigned*)(args.ws + WS_CTL) + CW_BAR, xcc_s, (unsigned)K.nloc, (unsigned)K.nxg, tid);
        if (ph == 0) {
            if (tid == 0) { unsigned* ctl = (unsigned*)(args.ws + WS_CTL); unsigned* misc = (unsigned*)(lds + MISC_OFF); const unsigned xcc = misc[0]; unsigned ord = 0, npop = 0, mine = 1;
                for (unsigned q = 0; q < 16; ++q) { const unsigned cq = __hip_atomic_load(ctl + 64 * q, __ATOMIC_RELAXED, __HIP_MEMORY_SCOPE_AGENT); if (cq) { ++npop; if (q < xcc) ++ord; } if (q == xcc) mine = cq; }
                misc[2] = ord; misc[3] = npop ? npop : 1u; misc[4] = mine ? mine : 1u; }
            __syncthreads();
        }
    }
}

extern "C" void kernel_launch(void* const* d_in, const int* in_sizes, int n_in, void* d_out, int out_size, void* d_ws, size_t ws_size, hipStream_t stream) {
    static int grid = 0;
    if (grid == 0) {
        if (n_in != 19 || out_size != NLAT * D || ws_size < WS_END) { fprintf(stderr, "kernel_launch: unexpected shapes (n_in %d out %d ws %zu need %zu)\n", n_in, out_size, ws_size, (size_t)WS_END); grid = -1; return; }
        int dev = 0, cus = 0, per_cu = 0;
        (void)hipGetDevice(&dev); (void)hipDeviceGetAttribute(&cus, hipDeviceAttributeMultiprocessorCount, dev);
        (void)hipFuncSetAttribute((const void*)mk_fwd, hipFuncAttributeMaxDynamicSharedMemorySize, LDS_BYTES);
        (void)hipOccupancyMaxActiveBlocksPerMultiprocessor(&per_cu, (const void*)mk_fwd, NTHREADS, LDS_BYTES);
        if (per_cu < 1) { fprintf(stderr, "kernel_launch: occupancy query says %d blocks/CU\n", per_cu); grid = -1; return; }
        grid = (cus / 8) * 8;
    }
    if (grid < 0) return;
    Args a{};
    a.x = (const float*)d_in[0]; a.c = (const float*)d_in[1]; a.ctx = (const float*)d_in[2]; a.c_ctx = (const float*)d_in[3]; a.w_mod = (const float*)d_in[4]; a.b_mod = (const float*)d_in[5];
    a.norm_mix_w = (const float*)d_in[6]; a.norm_ffn_w = (const float*)d_in[7]; a.w_in = (const float*)d_in[8]; a.lb_logits = (const float*)d_in[9]; a.hgrn_norm_w = (const float*)d_in[10];
    a.swa_sink = (const float*)d_in[11]; a.nat_rpb = (const float*)d_in[12]; a.w_out = (const float*)d_in[13]; a.peer_wq = (const float*)d_in[14]; a.peer_sk = (const float*)d_in[15];
    a.peer_u = (const float*)d_in[16]; a.peer_v = (const float*)d_in[17]; a.final_norm_w = (const float*)d_in[18];
    a.out = (float*)d_out; a.ws = (unsigned char*)d_ws;
    (void)hipMemsetAsync((unsigned char*)d_ws + WS_CTL, 0, CTL_BYTES, stream);
    void* kargs[] = {&a};
    hipError_t e = hipLaunchCooperativeKernel((const void*)mk_fwd, dim3(grid), dim3(NTHREADS), kargs, LDS_BYTES, stream);
    if (e != hipSuccess) fprintf(stderr, "kernel_launch: cooperative launch failed: %s (grid %d)\n", hipGetErrorString(e), grid);
}
```
